# Optimizing an MI355X kernel written in HIP

```python
import jax
import jax.numpy as jnp
from jax import lax
import numpy as np

D_MODEL = 1024
BATCH = 16
SEQ = 2048
DEPTH = 2

CHUNK = 64
MIX_WIDTH = D_MODEL
GROUP_WIDTH = MIX_WIDTH // 4
HEAD_DIM = GROUP_WIDTH // 4
CONV_WIDTH = 4
ROPE_THETA = 10000.0
EPS = 1e-6
RET_HEADS = 4
RET_DK = HEAD_DIM
RET_DV = HEAD_DIM
LRU_WIDTH = GROUP_WIDTH
LRU_BLOCKS = 4
LRU_BLOCK = LRU_WIDTH // LRU_BLOCKS
LRU_C = 8.0
MLA_HEADS = 4
MLA_NOPE = HEAD_DIM
MLA_ROPE = HEAD_DIM // 2
MLA_V = HEAD_DIM
MLA_Q_LORA = 3 * GROUP_WIDTH // 4
MLA_KV_LORA = GROUP_WIDTH // 2
Q_BLOCK = 128
GDN_HEADS = 4
GDN_DK = HEAD_DIM
GDN_DV = HEAD_DIM
GDN_QKV = 2 * GDN_HEADS * GDN_DK + GDN_HEADS * GDN_DV
N_MEM = 256
XA_HEADS = 4
XA_HEAD_DIM = D_MODEL // XA_HEADS
D_FF = 4 * D_MODEL
IN_SIZES = (
    RET_HEADS * RET_DK, RET_HEADS * RET_DK, RET_HEADS * RET_DV, RET_HEADS * RET_DV,
    LRU_WIDTH, LRU_WIDTH,
    MLA_Q_LORA, MLA_KV_LORA, MLA_ROPE,
    GDN_QKV, GDN_HEADS * GDN_DV, GDN_HEADS, GDN_HEADS,
)
IN_COLS = sum(IN_SIZES)

kernel_name = "hymba_style_chunk_causal_hybrid_trunk"

F32 = jnp.float32


def split_cols(z, sizes):
    points = []
    acc = 0
    for s in sizes[:-1]:
        acc += s
        points.append(acc)
    return jnp.split(z, points, axis=-1)


def rmsnorm(x, g):
    xf = x.astype(F32)
    y = xf * lax.rsqrt(jnp.mean(xf * xf, axis=-1, keepdims=True) + EPS)
    return (y * g.astype(F32)).astype(x.dtype)


def l2norm(t):
    return t * lax.rsqrt(jnp.sum(t * t, axis=-1, keepdims=True) + EPS)


def rope(x, pos):
    half = x.shape[-1] // 2
    inv_freq = jnp.power(ROPE_THETA, -jnp.arange(half, dtype=F32) / half)
    ang = pos.astype(F32)[..., None] * inv_freq
    cos = jnp.cos(ang)[:, :, None, :]
    sin = jnp.sin(ang)[:, :, None, :]
    xf = x.astype(F32)
    x1, x2 = xf[..., :half], xf[..., half:]
    return jnp.concatenate([x1 * cos - x2 * sin, x1 * sin + x2 * cos], axis=-1).astype(x.dtype)


def causal_conv(x, w):
    k, c = w.shape
    return lax.conv_general_dilated(
        x, w[:, None, :].astype(x.dtype), window_strides=(1,), padding=[(k - 1, 0)],
        dimension_numbers=("NWC", "WIO", "NWC"), feature_group_count=c)


def retention(q, k, v, gate, pos, gn_gain):
    b, s, _ = q.shape
    n = s // CHUNK
    h = RET_HEADS
    q = rope(q.reshape(b, s, h, RET_DK), pos).astype(F32) * (RET_DK ** -0.5)
    k = rope(k.reshape(b, s, h, RET_DK), pos).astype(F32)
    v = v.reshape(b, s, h, RET_DV).astype(F32)
    log_gamma = jnp.log1p(-jnp.exp2(-5.0 - jnp.arange(h, dtype=F32)))
    idx = jnp.arange(CHUNK, dtype=F32)
    intra_decay = jnp.exp(jnp.abs(idx[:, None] - idx[None, :])[None] * log_gamma[:, None, None])
    xi = jnp.exp((idx[:, None] + 1.0) * log_gamma)
    zeta = jnp.exp((CHUNK - 1.0 - idx)[:, None] * log_gamma)
    chunk_decay = jnp.exp(CHUNK * log_gamma)
    qc = q.reshape(b, n, CHUNK, h, RET_DK)
    kc = k.reshape(b, n, CHUNK, h, RET_DK)
    vc = v.reshape(b, n, CHUNK, h, RET_DV)
    scores = jnp.einsum("bnihd,bnjhd->bnhij", qc, kc) * intra_decay
    intra = jnp.einsum("bnhij,bnjhe->bnihe", scores, vc)

    def step(state, inp):
        q_c, k_c, v_c = inp
        cross = jnp.einsum("bihd,bhde->bihe", q_c, state) * xi[None, :, :, None]
        state = state * chunk_decay[None, :, None, None] + jnp.einsum(
            "bjhd,bjhe->bhde", k_c * zeta[None, :, :, None], v_c)
        return state, cross

    state0 = jnp.zeros((b, h, RET_DK, RET_DV), F32)
    to_chunk_major = lambda t: t.transpose(1, 0, 2, 3, 4)
    _, cross = lax.scan(step, state0, (to_chunk_major(qc), to_chunk_major(kc), to_chunk_major(vc)))
    o = (intra + to_chunk_major(cross)).reshape(b, s, h, RET_DV)
    mu = jnp.mean(o, axis=-1, keepdims=True)
    var = jnp.mean(jnp.square(o - mu), axis=-1, keepdims=True)
    o = (o - mu) * lax.rsqrt(var + EPS) * gn_gain.astype(F32)
    return (o.reshape(b, s, h * RET_DV) * jax.nn.silu(gate.astype(F32))).astype(gate.dtype)


def rg_lru_branch(xb, gb, conv_w, conv_b, wa, ba, wx, bx, lam):
    b, s, w = xb.shape
    xc = (causal_conv(xb, conv_w) + conv_b).astype(F32)
    xr = xc.reshape(b, s, LRU_BLOCKS, LRU_BLOCK)
    r = jax.nn.sigmoid(jnp.einsum("bsnc,ncd->bsnd", xr, wa.astype(F32)).reshape(b, s, w) + ba)
    i = jax.nn.sigmoid(jnp.einsum("bsnc,ncd->bsnd", xr, wx.astype(F32)).reshape(b, s, w) + bx)
    log_a = -LRU_C * r * jax.nn.softplus(-lam.astype(F32))
    a = jnp.exp(log_a)
    u = jnp.sqrt(-jnp.expm1(2.0 * log_a)) * (i * xc)

    def combine(left, right):
        a1, b1 = left
        a2, b2 = right
        return a1 * a2, a2 * b1 + b2

    _, hs = lax.associative_scan(combine, (a, u), axis=1)
    return (hs * jax.nn.gelu(gb.astype(F32))).astype(xb.dtype)


def mla(c_q, c_kv, k_rope_raw, pos, q_norm, w_uq, kv_norm, w_ukv):
    b, s, _ = c_q.shape
    h = MLA_HEADS
    q = (rmsnorm(c_q, q_norm) @ w_uq).reshape(b, s, h, MLA_NOPE + MLA_ROPE)
    q_nope = q[..., :MLA_NOPE]
    q_rope = rope(q[..., MLA_NOPE:], pos)
    kv = (rmsnorm(c_kv, kv_norm) @ w_ukv).reshape(b, s, h, MLA_NOPE + MLA_V)
    k_nope, v = kv[..., :MLA_NOPE], kv[..., MLA_NOPE:]
    k_rope = rope(k_rope_raw[:, :, None, :], pos)[:, :, 0, :]
    scale = (MLA_NOPE + MLA_ROPE) ** -0.5
    nq = s // Q_BLOCK
    qn_blocks = q_nope.reshape(b, nq, Q_BLOCK, h, MLA_NOPE).transpose(1, 0, 2, 3, 4)
    qr_blocks = q_rope.reshape(b, nq, Q_BLOCK, h, MLA_ROPE).transpose(1, 0, 2, 3, 4)
    key_chunk = jnp.arange(s) // CHUNK

    def attend(args):
        qn, qr, blk = args
        sc = (jnp.einsum("bqhd,bkhd->bhqk", qn, k_nope)
              + jnp.einsum("bqhr,bkr->bhqk", qr, k_rope)).astype(F32) * scale
        q_chunk = (blk * Q_BLOCK + jnp.arange(Q_BLOCK)) // CHUNK
        mask = key_chunk[None, :] <= q_chunk[:, None]
        p = jax.nn.softmax(jnp.where(mask, sc, -jnp.inf), axis=-1)
        return jnp.einsum("bhqk,bkhe->bqhe", p.astype(v.dtype), v)

    o = lax.map(attend, (qn_blocks, qr_blocks, jnp.arange(nq)))
    return o.transpose(1, 0, 2, 3, 4).reshape(b, s, h * MLA_V)


def gated_deltanet(qkv, gate, b_raw, a_raw, conv_w, a_log, dt_bias, norm_g):
    b, s, _ = qkv.shape
    h = GDN_HEADS
    n = s // CHUNK
    c = CHUNK
    qkv = jax.nn.silu(causal_conv(qkv, conv_w).astype(F32))
    q, k, v = jnp.split(qkv, [h * GDN_DK, 2 * h * GDN_DK], axis=-1)
    heads = lambda t, d: t.reshape(b, n, c, h, d).transpose(0, 3, 1, 2, 4)
    q = l2norm(heads(q, GDN_DK)) * (GDN_DK ** -0.5)
    k = l2norm(heads(k, GDN_DK))
    v = heads(v, GDN_DV)
    beta = jax.nn.sigmoid(b_raw.astype(F32)).reshape(b, n, c, h).transpose(0, 3, 1, 2)
    g = -jnp.exp(a_log.astype(F32)) * jax.nn.softplus(a_raw.astype(F32) + dt_bias.astype(F32))
    gc = jnp.cumsum(g.reshape(b, n, c, h).transpose(0, 3, 1, 2), axis=-1)
    idx = jnp.arange(c)
    causal = idx[:, None] >= idx[None, :]
    strict = idx[:, None] > idx[None, :]
    decay = jnp.exp(jnp.where(causal, gc[..., :, None] - gc[..., None, :], -jnp.inf))
    kb = k * beta[..., None]
    vb = v * beta[..., None]
    lower = jnp.where(strict, jnp.einsum("bhnid,bhnjd->bhnij", kb, k) * decay, 0.0)
    rhs = jnp.concatenate([vb, kb * jnp.exp(gc)[..., None]], axis=-1)
    sol = lax.linalg.triangular_solve(lower + jnp.eye(c, dtype=F32), rhs,
                                      left_side=True, lower=True, unit_diagonal=True)
    u, w = sol[..., :GDN_DV], sol[..., GDN_DV:]
    attn = jnp.where(causal, jnp.einsum("bhnid,bhnjd->bhnij", q, k) * decay, 0.0)
    g_last = gc[..., -1]
    q_dec = q * jnp.exp(gc)[..., None]
    k_dec = k * jnp.exp(g_last[..., None] - gc)[..., None]

    def step(state, inp):
        u_c, w_c, q_c, k_c, attn_c, gl = inp
        v_new = u_c - jnp.einsum("bhcd,bhde->bhce", w_c, state)
        o_c = jnp.einsum("bhcd,bhde->bhce", q_c, state) + jnp.einsum("bhij,bhje->bhie", attn_c, v_new)
        state = state * jnp.exp(gl)[..., None, None] + jnp.einsum("bhcd,bhce->bhde", k_c, v_new)
        return state, o_c

    cm = lambda t: t.transpose(2, 0, 1, 3, 4)
    state0 = jnp.zeros((b, h, GDN_DK, GDN_DV), F32)
    _, o = lax.scan(step, state0, (cm(u), cm(w), cm(q_dec), cm(k_dec), cm(attn), g_last.transpose(2, 0, 1)))
    o = o.transpose(1, 0, 3, 2, 4).reshape(b, s, h, GDN_DV)
    o = rmsnorm(o, norm_g) * jax.nn.silu(gate.astype(F32).reshape(b, s, h, GDN_DV))
    return o.reshape(b, s, h * GDN_DV).astype(gate.dtype)


def memory_xattn(hq, mem_n, wq, wkv, wo):
    b, s, d = hq.shape
    m = mem_n.shape[1]
    q = (hq @ wq).reshape(b, s, XA_HEADS, XA_HEAD_DIM)
    kv = (mem_n @ wkv).reshape(b, m, 2, XA_HEADS, XA_HEAD_DIM)
    k, v = kv[:, :, 0], kv[:, :, 1]
    sc = jnp.einsum("bqhd,bmhd->bhqm", q, k).astype(F32) * (XA_HEAD_DIM ** -0.5)
    p = jax.nn.softmax(sc, axis=-1)
    o = jnp.einsum("bhqm,bmhd->bqhd", p.astype(v.dtype), v).reshape(b, s, d)
    return o @ wo


def setup_inputs(seed: int = 0) -> dict:
    key = jax.random.key(seed)
    ks = iter(jax.random.split(key, 48))
    L = DEPTH

    def nrm(shape, scale):
        return jax.random.normal(next(ks), shape, F32) * scale

    def gain(shape):
        return 1.0 + nrm(shape, 0.05)

    x = nrm((BATCH, SEQ, D_MODEL), 1.0)
    mem = nrm((BATCH, N_MEM, D_MODEL), 1.0)
    start = jax.random.randint(next(ks), (BATCH, 1), 0, 64, dtype=jnp.int32) * CHUNK
    positions = (start + jnp.arange(SEQ, dtype=jnp.int32)[None, :]).astype(jnp.int32)
    u = jax.random.uniform(next(ks), (L, LRU_WIDTH), F32, minval=0.9, maxval=0.999)
    sg = u ** (1.0 / LRU_C)
    lru_lambda = jnp.log(sg) - jnp.log1p(-sg)
    gdn_a_log = jnp.log(jax.random.uniform(next(ks), (L, GDN_HEADS), F32, minval=1.0, maxval=16.0))
    dt = jnp.exp(jax.random.uniform(next(ks), (L, GDN_HEADS), F32,
                                    minval=float(np.log(1e-3)), maxval=float(np.log(1e-1))))
    gdn_dt_bias = dt + jnp.log(-jnp.expm1(-dt))
    return {
        "x": x,
        "mem": mem,
        "positions": positions,
        "norm_mix": gain((L, D_MODEL)),
        "w_in": nrm((L, D_MODEL, IN_COLS), D_MODEL ** -0.5),
        "ret_gn": gain((L, RET_HEADS, RET_DV)),
        "lru_conv_w": nrm((L, CONV_WIDTH, LRU_WIDTH), CONV_WIDTH ** -0.5),
        "lru_conv_b": nrm((L, LRU_WIDTH), 0.02),
        "lru_wa": nrm((L, LRU_BLOCKS, LRU_BLOCK, LRU_BLOCK), LRU_BLOCK ** -0.5),
        "lru_ba": nrm((L, LRU_WIDTH), 0.02),
        "lru_wx": nrm((L, LRU_BLOCKS, LRU_BLOCK, LRU_BLOCK), LRU_BLOCK ** -0.5),
        "lru_bx": nrm((L, LRU_WIDTH), 0.02),
        "lru_lambda": lru_lambda,
        "mla_q_norm": gain((L, MLA_Q_LORA)),
        "mla_w_uq": nrm((L, MLA_Q_LORA, MLA_HEADS * (MLA_NOPE + MLA_ROPE)), MLA_Q_LORA ** -0.5),
        "mla_kv_norm": gain((L, MLA_KV_LORA)),
        "mla_w_ukv": nrm((L, MLA_KV_LORA, MLA_HEADS * (MLA_NOPE + MLA_V)), MLA_KV_LORA ** -0.5),
        "gdn_conv_w": nrm((L, CONV_WIDTH, GDN_QKV), CONV_WIDTH ** -0.5),
        "gdn_a_log": gdn_a_log,
        "gdn_dt_bias": gdn_dt_bias,
        "gdn_norm": gain((L, GDN_DV)),
        "w_out": nrm((L, MIX_WIDTH, D_MODEL), MIX_WIDTH ** -0.5),
        "norm_xattn": gain((L, D_MODEL)),
        "norm_mem": gain((L, D_MODEL)),
        "xa_wq": nrm((L, D_MODEL, D_MODEL), D_MODEL ** -0.5),
        "xa_wkv": nrm((L, D_MODEL, 2 * D_MODEL), D_MODEL ** -0.5),
        "xa_wo": nrm((L, D_MODEL, D_MODEL), D_MODEL ** -0.5),
        "norm_mlp": gain((L, D_MODEL)),
        "mlp_w1": nrm((L, D_MODEL, D_FF), D_MODEL ** -0.5),
        "mlp_w2": nrm((L, D_FF, D_MODEL), D_FF ** -0.5),
        "final_norm": gain((D_MODEL,)),
    }


def reference(x, mem, positions, norm_mix, w_in, ret_gn, lru_conv_w, lru_conv_b, lru_wa, lru_ba,
              lru_wx, lru_bx, lru_lambda, mla_q_norm, mla_w_uq, mla_kv_norm, mla_w_ukv,
              gdn_conv_w, gdn_a_log, gdn_dt_bias, gdn_norm, w_out, norm_xattn, norm_mem,
              xa_wq, xa_wkv, xa_wo, norm_mlp, mlp_w1, mlp_w2, final_norm):
    for l in range(DEPTH):
        h = rmsnorm(x, norm_mix[l])
        z = h @ w_in[l]
        (rq, rk, rv, rg, lx, lg, cq, ckv, kr, gqkv, gg, gb, ga) = split_cols(z, IN_SIZES)
        y_a = retention(rq, rk, rv, rg, positions, ret_gn[l])
        y_b = rg_lru_branch(lx, lg, lru_conv_w[l], lru_conv_b[l], lru_wa[l], lru_ba[l],
                            lru_wx[l], lru_bx[l], lru_lambda[l])
        y_c = mla(cq, ckv, kr, positions, mla_q_norm[l], mla_w_uq[l], mla_kv_norm[l], mla_w_ukv[l])
        y_d = gated_deltanet(gqkv, gg, gb, ga, gdn_conv_w[l], gdn_a_log[l], gdn_dt_bias[l], gdn_norm[l])
        x = x + jnp.concatenate([y_a, y_b, y_c, y_d], axis=-1) @ w_out[l]
        x = x + memory_xattn(rmsnorm(x, norm_xattn[l]), rmsnorm(mem, norm_mem[l]),
                             xa_wq[l], xa_wkv[l], xa_wo[l])
        h = rmsnorm(x, norm_mlp[l])
        x = x + jnp.square(jax.nn.relu(h @ mlp_w1[l])) @ mlp_w2[l]
    return rmsnorm(x, final_norm)
```

```cpp
#include <hip/hip_runtime.h>
#include <cstdio>
#include <cstdint>

#ifndef N_LAUNCHES
#define N_LAUNCHES 0
#endif

#define LAS __attribute__((address_space(3)))
typedef unsigned short bf16_t;
typedef short bf16x8 __attribute__((ext_vector_type(8)));
typedef float f32x4 __attribute__((ext_vector_type(4)));
typedef float f32x2 __attribute__((ext_vector_type(2)));
typedef unsigned u32x4 __attribute__((ext_vector_type(4)));
typedef unsigned u32x2 __attribute__((ext_vector_type(2)));

constexpr int T_TOK = 32768, DM = 1024, SEQ = 2048, NBATCH = 16, NCHUNK = 32, ZP = 3072, DFF = 4096, NMEM = 256;
constexpr int Z_RQ = 0, Z_RK = 256, Z_RV = 512, Z_RG = 768, Z_LX = 1024, Z_LG = 1280, Z_CQ = 1536, Z_CKV = 1728, Z_KR = 1856,
              Z_GQKV = 1888, Z_GG = 2656, Z_GB = 2912, Z_GA = 2916, IN_COLS = 2920;
constexpr float EPS = 1e-6f;
constexpr float LOG2E = 1.4426950408889634f;

constexpr size_t MiB = 1024 * 1024;
constexpr size_t WS_CTL = 0;
constexpr size_t CTL_BYTES = 65536;
constexpr size_t WS_PART = WS_CTL + CTL_BYTES;
constexpr size_t WS_LRUS = WS_PART + (size_t)T_TOK * 16 * 4;
constexpr size_t WS_GL = WS_LRUS + (size_t)2 * 16 * 32 * 256 * 4;
constexpr size_t WS_W = WS_GL + 65536;
constexpr size_t W_IN = 0, W_OUT = W_IN + (size_t)ZP * DM, W_Q = W_OUT + (size_t)DM * DM, W_KV = W_Q + (size_t)DM * DM, W_O = W_KV + (size_t)2 * DM * DM,
                 W_1 = W_O + (size_t)DM * DM, W_2 = W_1 + (size_t)DFF * DM, W_UQ = W_2 + (size_t)DFF * DM, W_UKV = W_UQ + 384 * 192, W_A = W_UKV + 512 * 128,
                 W_X = W_A + 4 * 64 * 64, W_LAYER = W_X + 4 * 64 * 64;
constexpr size_t WS_XB = WS_W + 2 * W_LAYER * 2;
constexpr size_t XB_BYTES = (size_t)T_TOK * DM * 2;
constexpr size_t MLA_Q_OFF = 0, MLA_K_OFF = (size_t)T_TOK * 4 * 96 * 2, MLA_VT_OFF = 2 * MLA_K_OFF;
constexpr size_t WS_KVM = WS_XB + XB_BYTES;
constexpr size_t KVM_LAYER = (size_t)2 * 4096 * 1024 * 2;
constexpr size_t WS_R = WS_KVM + 2 * KVM_LAYER;
constexpr size_t R_Y = (size_t)T_TOK * ZP * 2;
constexpr size_t R_OX = (size_t)T_TOK * DM * 2;
constexpr size_t WS_GDN = WS_R + 256 * MiB;
constexpr size_t WS_END = WS_GDN + 80 * MiB;
static_assert(WS_END <= 512 * MiB, "workspace map exceeds 512 MiB");
static_assert(WS_XB % 256 == 0 && WS_R % 256 == 0 && WS_GDN % 256 == 0 && WS_W % 256 == 0, "alignment");
constexpr int CW_BAR = 0;
constexpr int CW_QUEUE = 4096;

constexpr int LDS_BYTES = 132 * 1024;
constexpr int LDS_CTL = LDS_BYTES - 256;

typedef __bf16 bf16x2_t __attribute__((ext_vector_type(2)));
__device__ __forceinline__ unsigned pk2(float lo, float hi) { f32x2 t = {lo, hi}; bf16x2_t v = __builtin_convertvector(t, bf16x2_t); return __builtin_bit_cast(unsigned, v); }
__device__ __forceinline__ float bflo(unsigned w) { return __uint_as_float(w << 16); }
__device__ __forceinline__ float bfhi(unsigned w) { return __uint_as_float(w & 0xffff0000u); }
__device__ __forceinline__ float bf2f(bf16_t v) { return __uint_as_float((unsigned)v << 16); }
__device__ __forceinline__ bf16_t f2bf(float f) { return (bf16_t)(pk2(f, 0.f) & 0xffffu); }
__device__ __forceinline__ f32x4 mfma16(bf16x8 a, bf16x8 b, f32x4 c) { return __builtin_amdgcn_mfma_f32_16x16x32_bf16(a, b, c, 0, 0, 0); }
__device__ __forceinline__ float sigmoidf_(float x) { return 1.0f / (1.0f + __expf(-x)); }
__device__ __forceinline__ float siluf_(float x) { return x / (1.0f + __expf(-x)); }
__device__ __forceinline__ float softplusf_(float x) { return x > 20.f ? x : log1pf(__expf(x)); }
__device__ __forceinline__ float geluf_(float x) { const float u = 0.7978845608028654f * (x + 0.044715f * x * x * x); const float e = __expf(2.f * u); const float th = 1.f - 2.f / (e + 1.f); return 0.5f * x * (1.f + th); }
__device__ __forceinline__ float wave_sum(float v) {
#pragma unroll
    for (int o = 1; o < 64; o <<= 1) v += __shfl_xor(v, o);
    return v;
}
__device__ __forceinline__ void sincos_rev(float ang, float& s, float& c) {
    float rev = ang * 0.15915494309189535f; rev = rev - floorf(rev);
    s = __builtin_amdgcn_sinf(rev); c = __builtin_amdgcn_cosf(rev);
}
__device__ __forceinline__ bf16x8 mk8(u32x2 lo, u32x2 hi) { u32x4 t; t.x = lo.x; t.y = lo.y; t.z = hi.x; t.w = hi.y; return __builtin_bit_cast(bf16x8, t); }
__device__ __forceinline__ bf16x8 pack8(f32x4 a, f32x4 b) { u32x4 t; t.x = pk2(a.x, a.y); t.y = pk2(a.z, a.w); t.z = pk2(b.x, b.y); t.w = pk2(b.z, b.w); return __builtin_bit_cast(bf16x8, t); }

#define XB_TMO      128
#define XB_XCNT(j)  (256  + 64 * (j))
#define XB_XSUB(j)  (1280 + 64 * (j))
#define XB_XGEN(j)  (2304 + 64 * (j))
#define XB_TOP      3328
#define XB_TOPGEN   3392
#define XCD_BAR_WORDS 3456
#define XB_SPIN_CAP (1u << 22)
__device__ __forceinline__ unsigned xb_ld(unsigned* p)              { return __hip_atomic_load(p, __ATOMIC_RELAXED, __HIP_MEMORY_SCOPE_AGENT); }
__device__ __forceinline__ unsigned xb_add(unsigned* p, unsigned v) { return __hip_atomic_fetch_add(p, v, __ATOMIC_RELAXED, __HIP_MEMORY_SCOPE_AGENT); }
__device__ __forceinline__ unsigned xb_xcc_id() { return (unsigned)__builtin_amdgcn_s_getreg((3 << 11) | 20) & 0xFu; }
#define XB_SPIN(cond, bar) do { unsigned _sp = 0; while (cond) { __builtin_amdgcn_s_sleep(1); \
    if ((++_sp & 255u) == 0u) { if (xb_ld(&(bar)[XB_TMO])) break; if (_sp > XB_SPIN_CAP) { atomicAdd(&(bar)[XB_TMO], 1u); break; } } } } while (0)
struct XcdBarrier { unsigned* bar; unsigned x; volatile LAS unsigned* st; };
__device__ __forceinline__ XcdBarrier xcd_barrier_post(unsigned* bar, volatile LAS unsigned* st) {
    XcdBarrier b; b.bar = bar; b.x = xb_xcc_id(); b.st = st;
    if (threadIdx.x == 0) (void)xb_add(&bar[XB_XCNT(b.x)], 1u);
    return b;
}
__device__ __forceinline__ void xcd_barrier_complete(unsigned* bar, unsigned x, unsigned& nloc, unsigned& nx) {
    const unsigned G = gridDim.x * gridDim.y * gridDim.z;
    unsigned sum, cnt, mine, sp = 0u;
    for (;;) {
        sum = 0u; cnt = 0u; mine = 0u;
#pragma unroll
        for (unsigned j = 0; j < 16; ++j) { const unsigned c = xb_ld(&bar[XB_XCNT(j)]); sum += c; cnt += (c > 0u) ? 1u : 0u; mine = (j == x) ? c : mine; }
        if (sum == G) break;
        __builtin_amdgcn_s_sleep(1);
        if ((++sp & 255u) == 0u) { if (xb_ld(&bar[XB_TMO])) break; if (sp > XB_SPIN_CAP) { atomicAdd(&bar[XB_TMO], 1u); break; } }
    }
    nloc = mine > 0u ? mine : 1u; nx = cnt > 0u ? cnt : 1u;
}
__device__ __forceinline__ void xcd_barrier(const XcdBarrier& b) {
    asm volatile("s_waitcnt vmcnt(0)" ::: "memory");
    __syncthreads();
    if (threadIdx.x == 0) {
        unsigned* bar = b.bar;
        __builtin_amdgcn_s_waitcnt(0);
        unsigned nloc = b.st[0], nx = b.st[1];
        if (nloc == 0u) { xcd_barrier_complete(bar, b.x, nloc, nx); b.st[0] = nloc; b.st[1] = nx; }
        const unsigned old = xb_add(&bar[XB_XSUB(b.x)], 1u);
        const unsigned gen = old / nloc;
        if (old + 1u == (gen + 1u) * nloc) {
            __builtin_amdgcn_fence(__ATOMIC_RELEASE, "agent");
            asm volatile("s_waitcnt vmcnt(0)" ::: "memory");
            const unsigned og = xb_add(&bar[XB_TOP], 1u);
            const unsigned tg = og / nx;
            if (og + 1u == (tg + 1u) * nx) xb_add(&bar[XB_TOPGEN], 1u);
            else XB_SPIN(xb_ld(&bar[XB_TOPGEN]) == tg, bar);
            __builtin_amdgcn_fence(__ATOMIC_ACQUIRE, "agent");
            xb_add(&bar[XB_XGEN(b.x)], 1u);
            asm volatile("s_waitcnt vmcnt(0)" ::: "memory");
        } else {
            XB_SPIN(xb_ld(&bar[XB_XGEN(b.x)]) == gen, bar);
            __builtin_amdgcn_fence(__ATOMIC_ACQUIRE, "agent");
            asm volatile("s_waitcnt vmcnt(0)" ::: "memory");
        }
    }
    __syncthreads();
}

namespace pg8 {
constexpr int BM = 256, BK = 64, HALF = 128, HTB = HALF * BK * 2, STAGE_BYTES = 8 * HTB, NXCD = 8, WGM = 8;
__host__ __device__ __forceinline__ int lds_byte(int r, int c) { const int st = (r >> 4) * 2 + (c >> 5), rr = r & 15, cc = c & 31, ob = rr * 64 + cc * 2; return st * 1024 + (ob ^ (((ob >> 9) & 1) << 5)); }
__host__ __device__ __forceinline__ void stage_rc(int b, int& R, int& C) { const int st = b / 1024, sb = b % 1024, swz = sb ^ (((sb >> 9) & 1) << 5); R = (st >> 1) * 16 + swz / 64; C = (st & 1) * 32 + (swz % 64) / 2; }
__host__ __device__ __forceinline__ int perm32(int rho) { const int n = rho >> 4, i = rho & 15; return 8 * (i >> 2) + 4 * n + (i & 3); }
struct Unit { int pm, pn; };
struct Gemm { const bf16_t* A; const bf16_t* Bt; int M, N, K; };
struct StaticOrder {
    int nM, nN, nwg, G, c;
    __host__ __device__ void init(int M, int N, int G_, int c_) { nM = M / BM; nN = N / BM; nwg = nM * nN; G = G_; c = c_; }
    __host__ __device__ bool next(int i, Unit& u) const {
        const long L = (long)i * G + c; if (L >= nwg) return false;
        int wgid = (int)L; { const int q = nwg / NXCD, r = nwg % NXCD, xcd = wgid % NXCD, off = wgid / NXCD; wgid = (xcd < r ? xcd * (q + 1) : r * (q + 1) + (xcd - r) * q) + off; }
        const int nig = WGM * nN, gid = wgid / nig, fm = gid * WGM, gsz = (nM - fm) < WGM ? (nM - fm) : WGM;
        u.pm = fm + ((wgid % nig) % gsz); u.pn = (wgid % nig) / gsz; return true;
    }
    __device__ __forceinline__ void a_ready(const Unit&) const {}
    __device__ __forceinline__ void done(const Unit&) const {}
};

template <int ACT> struct EpiScaleBf16 {
    static constexpr bool PERM = true;
    bf16_t* O; int ldc; const float* part;
    __device__ __forceinline__ void operator()(const f32x4 (&acc)[2][2][4][2], const Unit& u, int wr, int wc, int fr, int fq) const {
        const int row0 = u.pm * BM + wr * 64 + fr, col0 = u.pn * BM + wc * 32 + 8 * fq;
#pragma unroll
        for (int ai = 0; ai < 2; ++ai)
#pragma unroll
            for (int m = 0; m < 4; ++m) {
                const int row = row0 + ai * HALF + m * 16;
                float sc = 1.0f;
                if (part) { const f32x4* pp = (const f32x4*)(part + (size_t)row * 16); const f32x4 a = pp[0], b = pp[1], c = pp[2], d = pp[3];
                    const float s = ((a.x + a.y) + (a.z + a.w)) + ((b.x + b.y) + (b.z + b.w)) + ((c.x + c.y) + (c.z + c.w)) + ((d.x + d.y) + (d.z + d.w));
                    sc = rsqrtf(s * (1.0f / 1024.0f) + EPS); }
                bf16_t* rowp = O + (size_t)row * ldc + col0;
#pragma unroll
                for (int bj = 0; bj < 2; ++bj) { f32x4 v0 = acc[ai][bj][m][0] * sc, v1 = acc[ai][bj][m][1] * sc;
                    if (ACT == 1) {
#pragma unroll
                        for (int j = 0; j < 4; ++j) { const float a0 = fmaxf(v0[j], 0.f), a1 = fmaxf(v1[j], 0.f); v0[j] = a0 * a0; v1[j] = a1 * a1; } }
                    u32x4 w; w.x = pk2(v0[0], v0[1]); w.y = pk2(v0[2], v0[3]); w.z = pk2(v1[0], v1[1]); w.w = pk2(v1[2], v1[3]);
                    *(u32x4*)(rowp + bj * HALF) = w; }
            }
    }
};
struct EpiResid {
    static constexpr bool PERM = false;
    float* X; bf16_t* XB; float* part;
    __device__ __forceinline__ void operator()(const f32x4 (&acc)[2][2][4][2], const Unit& u, int wr, int wc, int fr, int fq) const {
        const int row0 = u.pm * BM + wr * 64 + fr, col0 = u.pn * BM + wc * 32 + 4 * fq;
#pragma unroll
        for (int ai = 0; ai < 2; ++ai)
#pragma unroll
            for (int m = 0; m < 4; ++m) {
                const int row = row0 + ai * HALF + m * 16;
                float* xp = X + (size_t)row * DM + col0; bf16_t* bp = XB + (size_t)row * DM + col0;
                float ss = 0.f;
#pragma unroll
                for (int bj = 0; bj < 2; ++bj)
#pragma unroll
                    for (int n = 0; n < 2; ++n) { const f32x4 v = *(const f32x4*)(xp + bj * HALF + n * 16) + acc[ai][bj][m][n];
                        *(f32x4*)(xp + bj * HALF + n * 16) = v; ss += (v.x * v.x + v.y * v.y) + (v.z * v.z + v.w * v.w);
                        u32x2 w; w.x = pk2(v.x, v.y); w.y = pk2(v.z, v.w); *(u32x2*)(bp + bj * HALF + n * 16) = w; }
                ss += __shfl_xor(ss, 16); ss += __shfl_xor(ss, 32);
                if (fq == 0) part[(size_t)row * 16 + u.pn * 4 + wc] = ss;
            }
    }
};

template <class Epi, class Sched>
__device__ __forceinline__ void gemm_phase(LAS unsigned char* lds, const Gemm g, const Sched& S, const Epi& E, const int tid) {
    const int wid = __builtin_amdgcn_readfirstlane(tid >> 6), lane = tid & 63, wr = wid >> 2, wc = wid & 3, fr = lane & 15, fq = lane >> 4;
    const int K = g.K, nt = K / BK;
    unsigned voffA[2], voffB[2];
#pragma unroll
    for (int i = 0; i < 2; ++i) { int R, C; stage_rc(tid * 16 + i * 8192, R, C); const int Rb = Epi::PERM ? ((R & ~31) + perm32(R & 31)) : R;
        voffA[i] = (unsigned)(R * K + C) * 2u; voffB[i] = (unsigned)(Rb * K + C) * 2u; }
    const size_t kstep = (size_t)(BK * 2);
    const size_t hstep = (size_t)HALF * K * 2;
    const size_t tstep = 2 * hstep;
    const unsigned ldsw = (unsigned)wid * 1024u;
    const int aoff = lds_byte(wr * 64 + fr, fq * 8), boff = lds_byte(wc * 32 + fr, fq * 8);
#define PG8_SA(b, h) (((b) * 2 + (h)) * HTB)
#define PG8_SB(b, h) ((4 + (b) * 2 + (h)) * HTB)
#define PG8_STAGE(bufoff, gbase, voff) do { _Pragma("unroll") for (int _i = 0; _i < 2; ++_i) \
        __builtin_amdgcn_global_load_lds((const unsigned*)((const char*)(gbase) + (voff)[_i]), (LAS unsigned*)(lds + (bufoff) + ldsw + _i * 8192), 16, 0, 0); } while (0)
#define PG8_LDA(dst, b, h) do { _Pragma("unroll") for (int m = 0; m < 4; ++m) _Pragma("unroll") for (int k = 0; k < 2; ++k) dst[m][k] = *(const LAS bf16x8*)(lds + PG8_SA(b, h) + aoff + m * 2048 + k * 1024); } while (0)
#define PG8_LDB(dst, b, h) do { _Pragma("unroll") for (int n = 0; n < 2; ++n) _Pragma("unroll") for (int k = 0; k < 2; ++k) dst[n][k] = *(const LAS bf16x8*)(lds + PG8_SB(b, h) + boff + n * 2048 + k * 1024); } while (0)
#define PG8_MMA(ai, bj, At, Bt) do { __builtin_amdgcn_s_setprio(1); _Pragma("unroll") for (int m = 0; m < 4; ++m) _Pragma("unroll") for (int n = 0; n < 2; ++n) _Pragma("unroll") for (int k = 0; k < 2; ++k) \
        acc[ai][bj][m][n] = __builtin_amdgcn_mfma_f32_16x16x32_bf16(Bt[n][k], At[m][k], acc[ai][bj][m][n], 0, 0, 0); __builtin_amdgcn_s_setprio(0); } while (0)
#define PG8_WAIT_V(n) asm volatile("s_waitcnt vmcnt(" #n ")" ::: "memory")
#define PG8_WAIT_L(n) asm volatile("s_waitcnt lgkmcnt(" #n ")" ::: "memory")
#define PG8_BAR __builtin_amdgcn_s_barrier()
#define PG8_SCHED __builtin_amdgcn_sched_barrier(0)
    Unit cur, nxt; int ui = 0;
    if (!S.next(0, cur)) return;
    f32x4 acc[2][2][4][2];
#pragma unroll
    for (int a = 0; a < 2; ++a)
#pragma unroll
        for (int b = 0; b < 2; ++b)
#pragma unroll
            for (int m = 0; m < 4; ++m)
#pragma unroll
                for (int n = 0; n < 2; ++n) acc[a][b][m][n] = (f32x4){0.f, 0.f, 0.f, 0.f};
    bf16x8 At[4][2], B0[2][2], B1[2][2];
    const char* cA = (const char*)g.A + (size_t)cur.pm * tstep; const char* cB = (const char*)g.Bt + (size_t)cur.pn * tstep;
    S.a_ready(cur);
    PG8_STAGE(PG8_SB(0, 0), cB, voffB); PG8_STAGE(PG8_SA(0, 0), cA, voffA); PG8_STAGE(PG8_SB(0, 1), cB + hstep, voffB); PG8_STAGE(PG8_SA(0, 1), cA + hstep, voffA);
    if (wr == 1) PG8_BAR;
    PG8_WAIT_V(4); PG8_BAR;
    PG8_STAGE(PG8_SB(1, 0), cB + kstep, voffB); PG8_STAGE(PG8_SA(1, 0), cA + kstep, voffA); PG8_STAGE(PG8_SB(1, 1), cB + hstep + kstep, voffB);
    PG8_WAIT_V(6); PG8_BAR;
    for (;;) {
        const bool has_next = S.next(ui + 1, nxt);
        const char* nA = has_next ? (const char*)g.A + (size_t)nxt.pm * tstep : cA; const char* nB = has_next ? (const char*)g.Bt + (size_t)nxt.pn * tstep : cB;
        for (int t = 0; t < nt; t += 2) {
            const bool last = (t == nt - 2);
            const char* a1 = cA + (size_t)(t + 1) * kstep;
            const char* a2 = last ? nA : cA + (size_t)(t + 2) * kstep; const char* b2 = last ? nB : cB + (size_t)(t + 2) * kstep;
            const char* a3 = a2 + kstep; const char* b3 = b2 + kstep;
            if (last && has_next) S.a_ready(nxt);
            PG8_LDB(B0, 0, 0); PG8_SCHED; PG8_LDA(At, 0, 0); PG8_STAGE(PG8_SA(1, 1), a1 + hstep, voffA);
            PG8_WAIT_L(8); PG8_BAR; PG8_WAIT_L(0); PG8_MMA(0, 0, At, B0); PG8_BAR; PG8_SCHED;
            PG8_LDB(B1, 0, 1); PG8_STAGE(PG8_SB(0, 0), b2, voffB);
            PG8_BAR; PG8_WAIT_L(0); PG8_MMA(0, 1, At, B1); PG8_BAR;
            PG8_LDA(At, 0, 1); PG8_STAGE(PG8_SA(0, 0), a2, voffA);
            PG8_BAR; PG8_WAIT_L(0); PG8_MMA(1, 0, At, B0); PG8_BAR; PG8_SCHED;
            PG8_STAGE(PG8_SB(0, 1), b2 + hstep, voffB);
            PG8_WAIT_V(6); PG8_BAR; PG8_MMA(1, 1, At, B1); PG8_BAR;
            PG8_LDB(B0, 1, 0); PG8_SCHED; PG8_LDA(At, 1, 0); PG8_STAGE(PG8_SA(0, 1), a2 + hstep, voffA);
            PG8_WAIT_L(8); PG8_BAR; PG8_WAIT_L(0); PG8_MMA(0, 0, At, B0); PG8_BAR; PG8_SCHED;
            PG8_LDB(B1, 1, 1); PG8_STAGE(PG8_SB(1, 0), b3, voffB);
            PG8_BAR; PG8_WAIT_L(0); PG8_MMA(0, 1, At, B1); PG8_BAR;
            PG8_LDA(At, 1, 1); PG8_STAGE(PG8_SA(1, 0), a3, voffA);
            PG8_BAR; PG8_WAIT_L(0); PG8_MMA(1, 0, At, B0); PG8_BAR; PG8_SCHED;
            PG8_STAGE(PG8_SB(1, 1), b3 + hstep, voffB);
            PG8_WAIT_V(6); PG8_BAR; PG8_MMA(1, 1, At, B1); PG8_BAR;
        }
        E(acc, cur, wr, wc, fr, fq); S.done(cur);
        if (!has_next) break;
#pragma unroll
        for (int a = 0; a < 2; ++a)
#pragma unroll
            for (int b = 0; b < 2; ++b)
#pragma unroll
                for (int m = 0; m < 4; ++m)
#pragma unroll
                    for (int n = 0; n < 2; ++n) acc[a][b][m][n] = (f32x4){0.f, 0.f, 0.f, 0.f};
        cur = nxt; cA = nA; cB = nB; ++ui;
    }
    PG8_WAIT_V(0);
    if (wr == 0) PG8_BAR;
    PG8_BAR;
#undef PG8_SA
#undef PG8_SB
#undef PG8_STAGE
#undef PG8_LDA
#undef PG8_LDB
#undef PG8_MMA
#undef PG8_WAIT_V
#undef PG8_WAIT_L
#undef PG8_BAR
#undef PG8_SCHED
}
}

struct Params {
    const float* x; const float* mem; const int* pos;
    const float* norm_mix; const float* w_in; const float* ret_gn;
    const float* lru_conv_w; const float* lru_conv_b; const float* lru_wa; const float* lru_ba; const float* lru_wx; const float* lru_bx; const float* lru_lambda;
    const float* mla_q_norm; const float* mla_w_uq; const float* mla_kv_norm; const float* mla_w_ukv;
    const float* gdn_conv_w; const float* gdn_a_log; const float* gdn_dt_bias; const float* gdn_norm;
    const float* w_out; const float* norm_xattn; const float* norm_mem; const float* xa_wq; const float* xa_wkv; const float* xa_wo;
    const float* norm_mlp; const float* mlp_w1; const float* mlp_w2; const float* final_norm;
    float* out; unsigned char* ws;
    int ph_lo, ph_hi;
};

__device__ __forceinline__ bf16_t* wl(const Params& P, int l, size_t off) { return (bf16_t*)(P.ws + WS_W) + (size_t)l * W_LAYER + off; }

__device__ __forceinline__ void transpose_tile(const float* src, int K, int N, const float* gain, float scale, bf16_t* dst, int kb, int nb, LAS float* scr, int tid) {
#pragma unroll
    for (int i = 0; i < 8; ++i) { const int kk = (tid >> 6) + 8 * i, k = kb * 64 + kk, n = nb * 64 + (tid & 63);
        float v = 0.f; if (n < N) { v = src[(size_t)k * N + n] * scale; if (gain) v *= gain[k]; }
        scr[kk * 65 + (tid & 63)] = v; }
    __syncthreads();
    { const int nl = tid >> 3, k0 = (tid & 7) * 8; const LAS float* s = scr + k0 * 65 + nl;
      u32x4 o; o.x = pk2(s[0], s[65]); o.y = pk2(s[2 * 65], s[3 * 65]); o.z = pk2(s[4 * 65], s[5 * 65]); o.w = pk2(s[6 * 65], s[7 * 65]);
      *(u32x4*)(dst + (size_t)(nb * 64 + nl) * K + kb * 64 + k0) = o; }
    __syncthreads();
}
__device__ __forceinline__ void p0_prologue(const Params& P, LAS unsigned char* lds, int tid) {
    LAS float* scr = (LAS float*)lds;
    constexpr int T_IN = 16 * 48, T_SQ = 256, T_KV = 512, T_W1 = 1024, T_W2 = 1024, T_UQ = 18, T_UKV = 16, T_LRU = 8;
    constexpr int T_LAYER = T_IN + 3 * T_SQ + T_KV + T_W1 + T_W2 + T_UQ + T_UKV + T_LRU;
    for (int it = blockIdx.x; it < 2 * T_LAYER; it += gridDim.x) {
        const int l = it / T_LAYER; int r = it % T_LAYER;
        const float* src; const float* gain = nullptr; float scale = 1.f; bf16_t* dst; int K, N, nnb;
        if (r < T_IN) { src = P.w_in + (size_t)l * DM * IN_COLS; K = DM; N = IN_COLS; nnb = 48; gain = P.norm_mix + l * DM; dst = wl(P, l, W_IN); }
        else if ((r -= T_IN) < T_SQ) { src = P.w_out + (size_t)l * DM * DM; K = DM; N = DM; nnb = 16; dst = wl(P, l, W_OUT); }
        else if ((r -= T_SQ) < T_SQ) { src = P.xa_wq + (size_t)l * DM * DM; K = DM; N = DM; nnb = 16; gain = P.norm_xattn + l * DM; scale = 0.0625f * LOG2E; dst = wl(P, l, W_Q); }
        else if ((r -= T_SQ) < T_KV) { src = P.xa_wkv + (size_t)l * DM * 2 * DM; K = DM; N = 2 * DM; nnb = 32; gain = P.norm_mem + l * DM; dst = wl(P, l, W_KV); }
        else if ((r -= T_KV) < T_SQ) { src = P.xa_wo + (size_t)l * DM * DM; K = DM; N = DM; nnb = 16; dst = wl(P, l, W_O); }
        else if ((r -= T_SQ) < T_W1) { src = P.mlp_w1 + (size_t)l * DM * DFF; K = DM; N = DFF; nnb = 64; gain = P.norm_mlp + l * DM; dst = wl(P, l, W_1); }
        else if ((r -= T_W1) < T_W2) { src = P.mlp_w2 + (size_t)l * DFF * DM; K = DFF; N = DM; nnb = 16; dst = wl(P, l, W_2); }
        else if ((r -= T_W2) < T_UQ) { src = P.mla_w_uq + (size_t)l * 192 * 384; K = 192; N = 384; nnb = 6; gain = P.mla_q_norm + l * 192; dst = wl(P, l, W_UQ); }
        else if ((r -= T_UQ) < T_UKV) { src = P.mla_w_ukv + (size_t)l * 128 * 512; K = 128; N = 512; nnb = 8; gain = P.mla_kv_norm + l * 128; dst = wl(P, l, W_UKV); }
        else { r -= T_UKV; const int which = r >> 2, nb4 = r & 3; src = (which ? P.lru_wx : P.lru_wa) + (size_t)l * 4 * 4096 + nb4 * 4096; K = 64; N = 64; nnb = 1; dst = wl(P, l, which ? W_X : W_A) + nb4 * 4096; r = 0; }
        transpose_tile(src, K, N, gain, scale, dst, r / nnb, r % nnb, scr, tid);
    }
    const int wave = tid >> 6, lane = tid & 63;
    const int gw = blockIdx.x * 8 + wave, ngw = gridDim.x * 8;
    bf16_t* xb = (bf16_t*)(P.ws + WS_XB); float* part = (float*)(P.ws + WS_PART); bf16_t* memn = (bf16_t*)(P.ws + WS_GDN);
    for (int row = gw; row < T_TOK + NBATCH * NMEM; row += ngw) {
        const bool isx = row < T_TOK; const int r2 = isx ? row : row - T_TOK;
        const f32x4* src = (const f32x4*)((isx ? P.x : P.mem) + (size_t)r2 * DM) + lane;
        f32x4 v[4]; float s = 0.f;
#pragma unroll
        for (int j = 0; j < 4; ++j) { v[j] = src[64 * j]; s += (v[j].x * v[j].x + v[j].y * v[j].y) + (v[j].z * v[j].z + v[j].w * v[j].w); }
        s = wave_sum(s);
        if (isx) {
            f32x4* o = (f32x4*)(P.out + (size_t)row * DM) + lane; u32x2* ob = (u32x2*)(xb + (size_t)row * DM) + lane;
#pragma unroll
            for (int j = 0; j < 4; ++j) { o[64 * j] = v[j]; u32x2 w; w.x = pk2(v[j].x, v[j].y); w.y = pk2(v[j].z, v[j].w); ob[64 * j] = w; }
            if (lane < 16) part[(size_t)row * 16 + lane] = lane == 0 ? s : 0.f;
        } else {
            const float rs = rsqrtf(s * (1.0f / 1024.0f) + EPS); u32x2* ob = (u32x2*)(memn + (size_t)r2 * DM) + lane;
#pragma unroll
            for (int j = 0; j < 4; ++j) { u32x2 w; w.x = pk2(v[j].x * rs, v[j].y * rs); w.y = pk2(v[j].z * rs, v[j].w * rs); ob[64 * j] = w; }
        }
    }
}
__device__ __forceinline__ void final_norm_phase(const Params& P, int tid) {
    const int wave = tid >> 6, lane = tid & 63; const float* part = (const float*)(P.ws + WS_PART);
    f32x4 g[4];
#pragma unroll
    for (int j = 0; j < 4; ++j) g[j] = ((const f32x4*)P.final_norm)[64 * j + lane];
    for (int row = blockIdx.x * 8 + wave; row < T_TOK; row += gridDim.x * 8) {
        float s = lane < 16 ? part[(size_t)row * 16 + lane] : 0.f; s = wave_sum(s);
        const float rs = rsqrtf(s * (1.0f / 1024.0f) + EPS);
        f32x4* o = (f32x4*)(P.out + (size_t)row * DM) + lane;
#pragma unroll
        for (int j = 0; j < 4; ++j) { f32x4 v = o[64 * j]; o[64 * j] = v * rs * g[j]; }
    }
}

__device__ __forceinline__ void mla_pre_tile(const Params& P, int l, int rt, int lane) {
    const int fr = lane & 15, fq = lane >> 4;
    const bf16_t* z = (const bf16_t*)(P.ws + WS_R);
    bf16_t* Qo = (bf16_t*)(P.ws + WS_XB + MLA_Q_OFF); bf16_t* Ko = (bf16_t*)(P.ws + WS_XB + MLA_K_OFF); bf16_t* Vo = (bf16_t*)(P.ws + WS_XB + MLA_VT_OFF);
    const bf16_t* Wuq = wl(P, l, W_UQ); const bf16_t* Wukv = wl(P, l, W_UKV);
    const int tok0 = rt * 16, b = tok0 >> 11, s0 = tok0 & 2047;
    const bf16_t* zr = z + (size_t)(tok0 + fr) * ZP;
    bf16x8 cq[6], ckv[4]; float sq = 0.f, skv = 0.f;
#pragma unroll
    for (int s = 0; s < 6; ++s) { const u32x4 w = *(const u32x4*)(zr + Z_CQ + 32 * s + 8 * fq); cq[s] = __builtin_bit_cast(bf16x8, w);
        sq += bflo(w.x) * bflo(w.x) + bfhi(w.x) * bfhi(w.x) + bflo(w.y) * bflo(w.y) + bfhi(w.y) * bfhi(w.y) + bflo(w.z) * bflo(w.z) + bfhi(w.z) * bfhi(w.z) + bflo(w.w) * bflo(w.w) + bfhi(w.w) * bfhi(w.w); }
#pragma unroll
    for (int s = 0; s < 4; ++s) { const u32x4 w = *(const u32x4*)(zr + Z_CKV + 32 * s + 8 * fq); ckv[s] = __builtin_bit_cast(bf16x8, w);
        skv += bflo(w.x) * bflo(w.x) + bfhi(w.x) * bfhi(w.x) + bflo(w.y) * bflo(w.y) + bfhi(w.y) * bfhi(w.y) + bflo(w.z) * bflo(w.z) + bfhi(w.z) * bfhi(w.z) + bflo(w.w) * bflo(w.w) + bfhi(w.w) * bfhi(w.w); }
    sq += __shfl_xor(sq, 16); sq += __shfl_xor(sq, 32); skv += __shfl_xor(skv, 16); skv += __shfl_xor(skv, 32);
    const float rq = rsqrtf(sq * (1.0f / 192.0f) + EPS), rkv = rsqrtf(skv * (1.0f / 128.0f) + EPS);
    const float qsc = rq * 0.10206207261596575f * LOG2E;
    const float pos = (float)P.pos[tok0 + fr];
    float sn[4], cs[4];
#pragma unroll
    for (int r = 0; r < 4; ++r) { const float invf = exp2f(-(float)(4 * fq + r) * (13.287712379549449f / 16.0f)); sincos_rev(pos * invf, sn[r], cs[r]); }
    const size_t tokrow = (size_t)b * 4 * SEQ + (s0 + fr);
#pragma unroll 1
    for (int h = 0; h < 4; ++h) {
        bf16_t* qrow = Qo + (tokrow + (size_t)h * SEQ) * 96;
#pragma unroll 1
        for (int nt = 0; nt < 4; ++nt) { f32x4 a = {0.f, 0.f, 0.f, 0.f};
#pragma unroll
            for (int s = 0; s < 6; ++s) { const bf16x8 wf = *(const bf16x8*)(Wuq + (size_t)(h * 96 + nt * 16 + fr) * 192 + 32 * s + 8 * fq); a = mfma16(wf, cq[s], a); }
            a = a * qsc; u32x2 w; w.x = pk2(a.x, a.y); w.y = pk2(a.z, a.w); *(u32x2*)(qrow + nt * 16 + 4 * fq) = w; }
        f32x4 x1 = {0.f, 0.f, 0.f, 0.f}, x2 = {0.f, 0.f, 0.f, 0.f}, y1, y2;
#pragma unroll
        for (int s = 0; s < 6; ++s) { const bf16x8 wf1 = *(const bf16x8*)(Wuq + (size_t)(h * 96 + 64 + fr) * 192 + 32 * s + 8 * fq), wf2 = *(const bf16x8*)(Wuq + (size_t)(h * 96 + 80 + fr) * 192 + 32 * s + 8 * fq);
            x1 = mfma16(wf1, cq[s], x1); x2 = mfma16(wf2, cq[s], x2); }
        x1 = x1 * qsc; x2 = x2 * qsc;
#pragma unroll
        for (int r = 0; r < 4; ++r) { y1[r] = x1[r] * cs[r] - x2[r] * sn[r]; y2[r] = x1[r] * sn[r] + x2[r] * cs[r]; }
        { u32x2 w; w.x = pk2(y1.x, y1.y); w.y = pk2(y1.z, y1.w); *(u32x2*)(qrow + 64 + 4 * fq) = w; w.x = pk2(y2.x, y2.y); w.y = pk2(y2.z, y2.w); *(u32x2*)(qrow + 80 + 4 * fq) = w; }
    }
    u32x2 kr1, kr2;
    { const u32x2 a = *(const u32x2*)(zr + Z_KR + 4 * fq), c = *(const u32x2*)(zr + Z_KR + 16 + 4 * fq);
      const float x1[4] = {bflo(a.x), bfhi(a.x), bflo(a.y), bfhi(a.y)}, x2[4] = {bflo(c.x), bfhi(c.x), bflo(c.y), bfhi(c.y)}; float y1[4], y2[4];
#pragma unroll
      for (int r = 0; r < 4; ++r) { y1[r] = x1[r] * cs[r] - x2[r] * sn[r]; y2[r] = x1[r] * sn[r] + x2[r] * cs[r]; }
      kr1.x = pk2(y1[0], y1[1]); kr1.y = pk2(y1[2], y1[3]); kr2.x = pk2(y2[0], y2[1]); kr2.y = pk2(y2[2], y2[3]); }
    float rkv_r[4];
#pragma unroll
    for (int r = 0; r < 4; ++r) rkv_r[r] = __shfl(rkv, 4 * fq + r);
    const int chunk = s0 >> 6, key0 = (s0 & 63) + 4 * fq;
#pragma unroll 1
    for (int h = 0; h < 4; ++h) {
        bf16_t* krow = Ko + (tokrow + (size_t)h * SEQ) * 96;
#pragma unroll 1
        for (int nt = 0; nt < 4; ++nt) { f32x4 a = {0.f, 0.f, 0.f, 0.f};
#pragma unroll
            for (int s = 0; s < 4; ++s) { const bf16x8 wf = *(const bf16x8*)(Wukv + (size_t)(h * 128 + nt * 16 + fr) * 128 + 32 * s + 8 * fq); a = mfma16(wf, ckv[s], a); }
            a = a * rkv; u32x2 w; w.x = pk2(a.x, a.y); w.y = pk2(a.z, a.w); *(u32x2*)(krow + nt * 16 + 4 * fq) = w; }
        *(u32x2*)(krow + 64 + 4 * fq) = kr1; *(u32x2*)(krow + 80 + 4 * fq) = kr2;
        bf16_t* vt = Vo + ((size_t)((b * 4 + h) * NCHUNK + chunk) * 64) * 64;
#pragma unroll 1
        for (int nt = 0; nt < 4; ++nt) { f32x4 a = {0.f, 0.f, 0.f, 0.f};
#pragma unroll
            for (int s = 0; s < 4; ++s) { const bf16x8 wf = *(const bf16x8*)(Wukv + (size_t)(h * 128 + 64 + nt * 16 + fr) * 128 + 32 * s + 8 * fq); a = mfma16(ckv[s], wf, a); }
            u32x2 w; w.x = pk2(a.x * rkv_r[0], a.y * rkv_r[1]); w.y = pk2(a.z * rkv_r[2], a.w * rkv_r[3]);
            *(u32x2*)(vt + (size_t)(nt * 16 + fr) * 64 + key0) = w; }
    }
}

template <int DQK, int DV>
__device__ __forceinline__ void flash_item(LAS unsigned char* lds, const bf16_t* Qw, int ldq, const bf16_t* Kb, int ldk, const bf16_t* VTb, int ldv, int vts,
                                           bf16_t* Ow, int ldo, int ntiles, int wave_limit, int tid, int lane) {
    constexpr int KROW = DQK + 8, KS = DQK / 32, ET = DV / 16;
    LAS bf16_t* Kt = (LAS bf16_t*)lds; LAS bf16_t* Vt = (LAS bf16_t*)(lds + 64 * KROW * 2);
    const int fr = lane & 15, fq = lane >> 4;
    bf16x8 qf[KS];
#pragma unroll
    for (int s = 0; s < KS; ++s) qf[s] = *(const bf16x8*)(Qw + (size_t)fr * ldq + 32 * s + 8 * fq);
    f32x4 ot[ET];
#pragma unroll
    for (int e = 0; e < ET; ++e) ot[e] = (f32x4){0.f, 0.f, 0.f, 0.f};
    float m_run = -1e30f, l_run = 0.f;
    for (int j = 0; j < ntiles; ++j) {
        __syncthreads();
        constexpr int KP = 64 * DQK / 8;
#pragma unroll
        for (int i = 0; i < (KP + 511) / 512; ++i) { const int idx = tid + i * 512; if (idx < KP) { const int row = idx / (DQK / 8), pc = idx % (DQK / 8);
            *(LAS u32x4*)(Kt + row * KROW + pc * 8) = *(const u32x4*)(Kb + (size_t)(j * 64 + row) * ldk + pc * 8); } }
        constexpr int VP = DV * 8;
#pragma unroll
        for (int i = 0; i < (VP + 511) / 512; ++i) { const int idx = tid + i * 512; if (idx < VP) { const int row = idx >> 3, pc = idx & 7;
            *(LAS u32x4*)(Vt + row * 72 + pc * 8) = *(const u32x4*)(VTb + (size_t)j * vts + (size_t)row * ldv + pc * 8); } }
        __syncthreads();
        if (j < wave_limit) {
            f32x4 st[4];
#pragma unroll
            for (int kt = 0; kt < 4; ++kt) { f32x4 a = {0.f, 0.f, 0.f, 0.f};
#pragma unroll
                for (int s = 0; s < KS; ++s) { const bf16x8 kf = *(const LAS bf16x8*)(Kt + (kt * 16 + fr) * KROW + 32 * s + 8 * fq); a = mfma16(kf, qf[s], a); }
                st[kt] = a; }
            float mx = fmaxf(fmaxf(fmaxf(st[0].x, st[0].y), fmaxf(st[0].z, st[0].w)), fmaxf(fmaxf(st[1].x, st[1].y), fmaxf(st[1].z, st[1].w)));
            mx = fmaxf(mx, fmaxf(fmaxf(fmaxf(st[2].x, st[2].y), fmaxf(st[2].z, st[2].w)), fmaxf(fmaxf(st[3].x, st[3].y), fmaxf(st[3].z, st[3].w))));
            mx = fmaxf(mx, __shfl_xor(mx, 16)); mx = fmaxf(mx, __shfl_xor(mx, 32));
            const float m_new = fmaxf(m_run, mx), alpha = exp2f(m_run - m_new);
            float ls = 0.f;
#pragma unroll
            for (int kt = 0; kt < 4; ++kt)
#pragma unroll
                for (int r = 0; r < 4; ++r) { const float p = exp2f(st[kt][r] - m_new); st[kt][r] = p; ls += p; }
            l_run = l_run * alpha + ls; m_run = m_new;
#pragma unroll
            for (int e = 0; e < ET; ++e) ot[e] = ot[e] * alpha;
            const bf16x8 pf0 = pack8(st[0], st[1]), pf1 = pack8(st[2], st[3]);
#pragma unroll
            for (int e = 0; e < ET; ++e) {
                const LAS bf16_t* vr = Vt + (e * 16 + fr) * 72 + 4 * fq;
                const bf16x8 v0 = mk8(*(const LAS u32x2*)(vr), *(const LAS u32x2*)(vr + 16)), v1 = mk8(*(const LAS u32x2*)(vr + 32), *(const LAS u32x2*)(vr + 48));
                ot[e] = mfma16(v0, pf0, ot[e]); ot[e] = mfma16(v1, pf1, ot[e]); }
        }
    }
    l_run += __shfl_xor(l_run, 16); l_run += __shfl_xor(l_run, 32);
    const float inv = 1.0f / l_run;
#pragma unroll
    for (int e = 0; e < ET; ++e) { u32x2 w; w.x = pk2(ot[e].x * inv, ot[e].y * inv); w.y = pk2(ot[e].z * inv, ot[e].w * inv);
        *(u32x2*)(Ow + (size_t)fr * ldo + e * 16 + 4 * fq) = w; }
}
__device__ __forceinline__ void mla_attn_item(const Params& P, LAS unsigned char* lds, int it, int tid, int wave, int lane) {
    const int qt = 15 - (it >> 6), bh = it & 63;
    const bf16_t* Q = (const bf16_t*)(P.ws + WS_XB + MLA_Q_OFF) + ((size_t)bh * SEQ + qt * 128 + wave * 16) * 96;
    const bf16_t* K = (const bf16_t*)(P.ws + WS_XB + MLA_K_OFF) + (size_t)bh * SEQ * 96;
    const bf16_t* VT = (const bf16_t*)(P.ws + WS_XB + MLA_VT_OFF) + (size_t)bh * NCHUNK * 4096;
    bf16_t* y = (bf16_t*)(P.ws + WS_R + R_Y) + ((size_t)(bh >> 2) * SEQ + qt * 128 + wave * 16) * DM + 512 + (bh & 3) * 64;
    flash_item<96, 64>(lds, Q, 96, K, 96, VT, 64, 4096, y, DM, 2 * qt + 2, 2 * qt + (wave >> 2) + 1, tid, lane);
}
__device__ __forceinline__ void xa_item(const Params& P, int l, LAS unsigned char* lds, int it, int tid, int wave, int lane) {
    const int qt = it & 15, h = (it >> 4) & 3, b = it >> 6;
    const size_t qoff = ((size_t)b * SEQ + qt * 128 + wave * 16) * DM + h * 256;
    const bf16_t* Q = (const bf16_t*)(P.ws + WS_R) + qoff; bf16_t* O = (bf16_t*)(P.ws + WS_R + R_OX) + qoff;
    const bf16_t* K = (const bf16_t*)(P.ws + WS_KVM + (size_t)l * KVM_LAYER) + (size_t)b * NMEM * DM + h * 256;
    const bf16_t* VT = (const bf16_t*)(P.ws + WS_KVM + (size_t)l * KVM_LAYER + (size_t)4096 * 1024 * 2) + (size_t)h * 256 * 4096 + b * NMEM;
    flash_item<256, 256>(lds, Q, DM, K, DM, VT, 4096, 64, O, DM, 4, 4, tid, lane);
}

constexpr int GP_KN = 0, GP_KB = 9216, GP_QN = 18432, GP_L = 9216, GP_RHS = 27648, GP_G = 60416, GP_GC = 60672, GP_HEAD = 61440;
__device__ __forceinline__ bf16_t* gdn_buf(const Params& P, int chh, int k) { return (bf16_t*)(P.ws + WS_GDN) + ((size_t)chh * 5 + k) * 4096; }
__device__ __forceinline__ void gdn_pre_item(const Params& P, int l, LAS unsigned char* lds, int it, int tid) {
    const int hp = it & 1, n = (it >> 1) & 31, b = it >> 6;
    const int hh = tid >> 8, h = 2 * hp + hh, tt = tid & 255, c = tt >> 2, qr = tt & 3, lane = tid & 63;
    LAS unsigned char* L = lds + hh * GP_HEAD;
    const bf16_t* z = (const bf16_t*)(P.ws + WS_R);
    const int s = n * 64 + c; const size_t tok = (size_t)b * SEQ + s;
    const float* cw = P.gdn_conv_w + (size_t)l * 4 * 768;
    const int chh = (b * NCHUNK + n) * 4 + h;
    float q[16], k[16], v[16];
#pragma unroll
    for (int part = 0; part < 3; ++part) {
        float* dst = part == 0 ? q : (part == 1 ? k : v);
        const int ch0 = part * 256 + h * 64 + qr * 16;
#pragma unroll
        for (int i = 0; i < 16; ++i) dst[i] = 0.f;
#pragma unroll
        for (int kk = 0; kk < 4; ++kk) { if (s - 3 + kk >= 0) {
            const bf16_t* zr = z + (tok - 3 + kk) * ZP + Z_GQKV + ch0; const u32x4 w0 = *(const u32x4*)zr, w1 = *(const u32x4*)(zr + 8);
            const float* wr = cw + kk * 768 + ch0; const f32x4 c0 = *(const f32x4*)wr, c1 = *(const f32x4*)(wr + 4), c2 = *(const f32x4*)(wr + 8), c3 = *(const f32x4*)(wr + 12);
            dst[0] += c0.x * bflo(w0.x); dst[1] += c0.y * bfhi(w0.x); dst[2] += c0.z * bflo(w0.y); dst[3] += c0.w * bfhi(w0.y);
            dst[4] += c1.x * bflo(w0.z); dst[5] += c1.y * bfhi(w0.z); dst[6] += c1.z * bflo(w0.w); dst[7] += c1.w * bfhi(w0.w);
            dst[8] += c2.x * bflo(w1.x); dst[9] += c2.y * bfhi(w1.x); dst[10] += c2.z * bflo(w1.y); dst[11] += c2.w * bfhi(w1.y);
            dst[12] += c3.x * bflo(w1.z); dst[13] += c3.y * bfhi(w1.z); dst[14] += c3.z * bflo(w1.w); dst[15] += c3.w * bfhi(w1.w); } }
#pragma unroll
        for (int i = 0; i < 16; ++i) dst[i] = siluf_(dst[i]);
    }
    float sq = 0.f, sk = 0.f;
#pragma unroll
    for (int i = 0; i < 16; ++i) { sq += q[i] * q[i]; sk += k[i] * k[i]; }
    sq += __shfl_xor(sq, 1); sq += __shfl_xor(sq, 2); sk += __shfl_xor(sk, 1); sk += __shfl_xor(sk, 2);
    const float rq = rsqrtf(sq + EPS) * 0.125f, rk = rsqrtf(sk + EPS);
    const bf16_t* zt = z + tok * ZP;
    const float beta = sigmoidf_(bf2f(zt[Z_GB + h]));
    const float g = -__expf(P.gdn_a_log[l * 4 + h]) * softplusf_(bf2f(zt[Z_GA + h]) + P.gdn_dt_bias[l * 4 + h]);
    {
        u32x4 w0, w1;
#define PK16(dst0, dst1, src, sc) do { dst0.x = pk2(src[0] * (sc), src[1] * (sc)); dst0.y = pk2(src[2] * (sc), src[3] * (sc)); dst0.z = pk2(src[4] * (sc), src[5] * (sc)); dst0.w = pk2(src[6] * (sc), src[7] * (sc)); \
        dst1.x = pk2(src[8] * (sc), src[9] * (sc)); dst1.y = pk2(src[10] * (sc), src[11] * (sc)); dst1.z = pk2(src[12] * (sc), src[13] * (sc)); dst1.w = pk2(src[14] * (sc), src[15] * (sc)); } while (0)
        PK16(w0, w1, k, rk);        *(LAS u32x4*)(L + GP_KN + (c * 72 + qr * 16) * 2) = w0; *(LAS u32x4*)(L + GP_KN + (c * 72 + qr * 16 + 8) * 2) = w1;
        PK16(w0, w1, k, rk * beta); *(LAS u32x4*)(L + GP_KB + (c * 72 + qr * 16) * 2) = w0; *(LAS u32x4*)(L + GP_KB + (c * 72 + qr * 16 + 8) * 2) = w1;
        PK16(w0, w1, q, rq);        *(LAS u32x4*)(L + GP_QN + (c * 72 + qr * 16) * 2) = w0; *(LAS u32x4*)(L + GP_QN + (c * 72 + qr * 16 + 8) * 2) = w1;
        LAS float* rhs = (LAS float*)(L + GP_RHS) + c * 128 + qr * 16;
#pragma unroll
        for (int i = 0; i < 4; ++i) *(LAS f32x4*)(rhs + 4 * i) = (f32x4){v[4 * i] * beta, v[4 * i + 1] * beta, v[4 * i + 2] * beta, v[4 * i + 3] * beta};
        if (qr == 0) ((LAS float*)(L + GP_G))[c] = g;
    }
    __syncthreads();
    {
        float gc = 0.f, run = 0.f; const LAS float* G = (const LAS float*)(L + GP_G);
        for (int i = 0; i < 64; ++i) { run += G[i]; gc = (i == c) ? run : gc; }
        const float eg = __expf(gc), ek = __expf(run - gc);
        LAS float* rhs = (LAS float*)(L + GP_RHS) + c * 128 + 64 + qr * 16;
#pragma unroll
        for (int i = 0; i < 4; ++i) *(LAS f32x4*)(rhs + 4 * i) = (f32x4){k[4 * i] * rk * beta * eg, k[4 * i + 1] * rk * beta * eg, k[4 * i + 2] * rk * beta * eg, k[4 * i + 3] * rk * beta * eg};
        u32x4 w0, w1; PK16(w0, w1, q, rq * eg);
        bf16_t* qd = gdn_buf(P, chh, 3) + c * 64 + qr * 16; *(u32x4*)qd = w0; *(u32x4*)(qd + 8) = w1;
        bf16_t* kdt = gdn_buf(P, chh, 4) + (qr * 16) * 64 + c;
#pragma unroll
        for (int i = 0; i < 16; ++i) kdt[i * 64] = f2bf(k[i] * rk * ek);
        if (qr == 0) ((LAS float*)(L + GP_GC))[c] = gc;
        if (tt == 0) ((float*)(P.ws + WS_GL))[chh] = __expf(run);
    }
#undef PK16
    __syncthreads();
    {
        const int it4 = (tid >> 6) & 3, fr = lane & 15, fq = lane >> 4;
        const LAS bf16_t* Kn = (const LAS bf16_t*)(L + GP_KN); const LAS bf16_t* KB = (const LAS bf16_t*)(L + GP_KB); const LAS bf16_t* Qn = (const LAS bf16_t*)(L + GP_QN);
        const LAS float* GC = (const LAS float*)(L + GP_GC);
        const bf16x8 a0 = *(const LAS bf16x8*)(KB + (it4 * 16 + fr) * 72 + 8 * fq), a1 = *(const LAS bf16x8*)(KB + (it4 * 16 + fr) * 72 + 32 + 8 * fq);
        const bf16x8 q0 = *(const LAS bf16x8*)(Qn + (it4 * 16 + fr) * 72 + 8 * fq), q1 = *(const LAS bf16x8*)(Qn + (it4 * 16 + fr) * 72 + 32 + 8 * fq);
        float gci[4];
#pragma unroll
        for (int r = 0; r < 4; ++r) gci[r] = GC[it4 * 16 + 4 * fq + r];
        f32x4 lv[4]; bf16_t* att = gdn_buf(P, chh, 2);
#pragma unroll
        for (int jt = 0; jt < 4; ++jt) {
            const bf16x8 b0 = *(const LAS bf16x8*)(Kn + (jt * 16 + fr) * 72 + 8 * fq), b1 = *(const LAS bf16x8*)(Kn + (jt * 16 + fr) * 72 + 32 + 8 * fq);
            f32x4 al = {0.f, 0.f, 0.f, 0.f}, aa = {0.f, 0.f, 0.f, 0.f};
            al = mfma16(a0, b0, al); al = mfma16(a1, b1, al); aa = mfma16(q0, b0, aa); aa = mfma16(q1, b1, aa);
            const int j = jt * 16 + fr; const float gcj = GC[j];
#pragma unroll
            for (int r = 0; r < 4; ++r) { const int i = it4 * 16 + 4 * fq + r; const float dec = __expf(fminf(gci[r] - gcj, 0.f));
                lv[jt][r] = (i > j) ? al[r] * dec : 0.f; att[i * 64 + j] = f2bf((i >= j) ? aa[r] * dec : 0.f); }
        }
        __syncthreads();
        LAS float* Lm = (LAS float*)(L + GP_L);
#pragma unroll
        for (int jt = 0; jt < 4; ++jt)
#pragma unroll
            for (int r = 0; r < 4; ++r) Lm[(it4 * 16 + 4 * fq + r) * 64 + jt * 16 + fr] = lv[jt][r];
    }
    __syncthreads();
    if (tt < 128) {
        const LAS float* Lm = (const LAS float*)(L + GP_L); const LAS float* rhs = (const LAS float*)(L + GP_RHS) + tt;
        float x[64];
#pragma unroll
        for (int i = 0; i < 64; ++i) {
            float a0 = rhs[i * 128], a1 = 0.f;
#pragma unroll
            for (int j4 = 0; j4 < (i + 3) / 4; ++j4) { const f32x4 lr = *(const LAS f32x4*)(Lm + i * 64 + 4 * j4);
                if (4 * j4 + 0 < i) a0 -= lr.x * x[4 * j4 + 0]; if (4 * j4 + 1 < i) a1 -= lr.y * x[4 * j4 + 1];
                if (4 * j4 + 2 < i) a0 -= lr.z * x[4 * j4 + 2]; if (4 * j4 + 3 < i) a1 -= lr.w * x[4 * j4 + 3]; }
            x[i] = a0 + a1;
        }
        if (tt < 64) { bf16_t* ut = gdn_buf(P, chh, 1) + tt * 64;
#pragma unroll
            for (int g8 = 0; g8 < 8; ++g8) { u32x4 w; w.x = pk2(x[8 * g8], x[8 * g8 + 1]); w.y = pk2(x[8 * g8 + 2], x[8 * g8 + 3]); w.z = pk2(x[8 * g8 + 4], x[8 * g8 + 5]); w.w = pk2(x[8 * g8 + 6], x[8 * g8 + 7]); *(u32x4*)(ut + 8 * g8) = w; }
        } else { bf16_t* wo = gdn_buf(P, chh, 0) + (tt - 64);
#pragma unroll
            for (int i = 0; i < 64; ++i) wo[i * 64] = f2bf(x[i]); }
    }
    __syncthreads();
}

__device__ __forceinline__ bf16x8 lda_perm(const bf16_t* X, int row, int s, int fq) { const bf16_t* p = X + row * 64 + 32 * s + 4 * fq; return mk8(*(const u32x2*)p, *(const u32x2*)(p + 16)); }
__device__ __forceinline__ void gdn_chain_item(const Params& P, int l, LAS unsigned char* lds, int gi, int tid, int wave, int lane) {
    const int bh = gi * 2 + (wave >> 2), eb = wave & 3, b = bh >> 2, h = bh & 3, fr = lane & 15, fq = lane >> 4;
    const bf16_t* z = (const bf16_t*)(P.ws + WS_R); bf16_t* y = (bf16_t*)(P.ws + WS_R + R_Y);
    LAS float* part = (LAS float*)lds;
    const float ng = P.gdn_norm[l * 64 + eb * 16 + fr];
    f32x4 S[4];
#pragma unroll
    for (int t = 0; t < 4; ++t) S[t] = (f32x4){0.f, 0.f, 0.f, 0.f};
    for (int n = 0; n < NCHUNK; ++n) {
        const int chh = (b * NCHUNK + n) * 4 + h;
        const bf16_t* W = gdn_buf(P, chh, 0); const bf16_t* UT = gdn_buf(P, chh, 1); const bf16_t* ATT = gdn_buf(P, chh, 2); const bf16_t* QD = gdn_buf(P, chh, 3); const bf16_t* KDT = gdn_buf(P, chh, 4);
        const float egl = ((const float*)(P.ws + WS_GL))[chh];
        const bf16x8 sb0 = pack8(S[0], S[1]), sb1 = pack8(S[2], S[3]);
        f32x4 vn[4], o[4];
#pragma unroll
        for (int ct = 0; ct < 4; ++ct) {
            f32x4 a = {0.f, 0.f, 0.f, 0.f}; a = mfma16(lda_perm(W, ct * 16 + fr, 0, fq), sb0, a); a = mfma16(lda_perm(W, ct * 16 + fr, 1, fq), sb1, a);
            const u32x2 uw = *(const u32x2*)(UT + (eb * 16 + fr) * 64 + ct * 16 + 4 * fq);
            vn[ct] = (f32x4){bflo(uw.x) - a.x, bfhi(uw.x) - a.y, bflo(uw.y) - a.z, bfhi(uw.y) - a.w};
            f32x4 oo = {0.f, 0.f, 0.f, 0.f}; oo = mfma16(lda_perm(QD, ct * 16 + fr, 0, fq), sb0, oo); oo = mfma16(lda_perm(QD, ct * 16 + fr, 1, fq), sb1, oo); o[ct] = oo;
        }
        const bf16x8 vb0 = pack8(vn[0], vn[1]), vb1 = pack8(vn[2], vn[3]);
#pragma unroll
        for (int ct = 0; ct < 4; ++ct) { o[ct] = mfma16(lda_perm(ATT, ct * 16 + fr, 0, fq), vb0, o[ct]); o[ct] = mfma16(lda_perm(ATT, ct * 16 + fr, 1, fq), vb1, o[ct]); }
#pragma unroll
        for (int dt = 0; dt < 4; ++dt) { f32x4 a = S[dt] * egl; a = mfma16(lda_perm(KDT, dt * 16 + fr, 0, fq), vb0, a); a = mfma16(lda_perm(KDT, dt * 16 + fr, 1, fq), vb1, a); S[dt] = a; }
        LAS float* pw = part + (n & 1) * 512;
#pragma unroll
        for (int ct = 0; ct < 4; ++ct)
#pragma unroll
            for (int r = 0; r < 4; ++r) { float s2 = o[ct][r] * o[ct][r]; s2 += __shfl_xor(s2, 1); s2 += __shfl_xor(s2, 2); s2 += __shfl_xor(s2, 4); s2 += __shfl_xor(s2, 8);
                if (fr == 0) pw[wave * 64 + ct * 16 + 4 * fq + r] = s2; }
        __syncthreads();
        const int w0 = wave & 4;
#pragma unroll
        for (int ct = 0; ct < 4; ++ct)
#pragma unroll
            for (int r = 0; r < 4; ++r) { const int c = ct * 16 + 4 * fq + r;
                const float tot = (pw[w0 * 64 + c] + pw[(w0 + 1) * 64 + c]) + (pw[(w0 + 2) * 64 + c] + pw[(w0 + 3) * 64 + c]);
                const size_t tok = (size_t)b * SEQ + n * 64 + c;
                const float gate = bf2f(z[tok * ZP + Z_GG + h * 64 + eb * 16 + fr]);
                y[tok * DM + 768 + h * 64 + eb * 16 + fr] = f2bf(o[ct][r] * rsqrtf(tot * (1.0f / 64.0f) + EPS) * ng * siluf_(gate)); }
    }
    __syncthreads();
}

constexpr int RT_Q = 0, RT_K = 9216, RT_KZT = 18432, RT_VT = 27648, RT_P = 36864, RT_ST = 46080, RT_O = 55296;
__device__ __forceinline__ void ret_chain_item(const Params& P, int l, LAS unsigned char* lds, int it, int tid, int wave, int lane) {
    const int b = it >> 2, h = it & 3, fr = lane & 15, fq = lane >> 4;
    const bf16_t* z = (const bf16_t*)(P.ws + WS_R); bf16_t* y = (bf16_t*)(P.ws + WS_R + R_Y);
    LAS bf16_t* Qs = (LAS bf16_t*)(lds + RT_Q); LAS bf16_t* Ks = (LAS bf16_t*)(lds + RT_K); LAS bf16_t* KzT = (LAS bf16_t*)(lds + RT_KZT); LAS bf16_t* VT = (LAS bf16_t*)(lds + RT_VT);
    LAS bf16_t* Pm = (LAS bf16_t*)(lds + RT_P); LAS bf16_t* ST = (LAS bf16_t*)(lds + RT_ST); LAS float* Of = (LAS float*)(lds + RT_O);
    const float lg = log1pf(-exp2f(-5.0f - (float)h));
    const float cdec = __expf(64.0f * lg);
    for (int i = tid; i < 64 * 72 / 2; i += 512) ((LAS unsigned*)ST)[i] = 0u;
    const int it4 = wave >> 1, jt0 = 2 * (wave & 1);
    f32x4 S[2] = {{0.f, 0.f, 0.f, 0.f}, {0.f, 0.f, 0.f, 0.f}};
    const int lc = tid >> 3, pg = tid & 7;
    float invf[4];
#pragma unroll
    for (int ii = 0; ii < 4; ++ii) invf[ii] = exp2f(-(float)(4 * pg + ii) * (13.287712379549449f / 32.0f));
    const float zeta = __expf((63.0f - (float)lc) * lg);
    f32x4 gn0 = *(const f32x4*)(P.ret_gn + l * 256 + h * 64 + 8 * pg), gn1 = *(const f32x4*)(P.ret_gn + l * 256 + h * 64 + 8 * pg + 4);
    __syncthreads();
    for (int n = 0; n < NCHUNK; ++n) {
        const size_t tok = (size_t)b * SEQ + n * 64 + lc; const bf16_t* zr = z + tok * ZP;
        {
            const u32x2 q1w = *(const u32x2*)(zr + Z_RQ + h * 64 + 4 * pg), q2w = *(const u32x2*)(zr + Z_RQ + h * 64 + 32 + 4 * pg);
            const u32x2 k1w = *(const u32x2*)(zr + Z_RK + h * 64 + 4 * pg), k2w = *(const u32x2*)(zr + Z_RK + h * 64 + 32 + 4 * pg);
            const u32x4 vw = *(const u32x4*)(zr + Z_RV + h * 64 + 8 * pg);
            const float pos = (float)P.pos[tok];
            const float q1[4] = {bflo(q1w.x), bfhi(q1w.x), bflo(q1w.y), bfhi(q1w.y)}, q2[4] = {bflo(q2w.x), bfhi(q2w.x), bflo(q2w.y), bfhi(q2w.y)};
            const float k1[4] = {bflo(k1w.x), bfhi(k1w.x), bflo(k1w.y), bfhi(k1w.y)}, k2[4] = {bflo(k2w.x), bfhi(k2w.x), bflo(k2w.y), bfhi(k2w.y)};
            float qa[4], qb[4], ka[4], kb[4];
#pragma unroll
            for (int ii = 0; ii < 4; ++ii) { float sn, cs; sincos_rev(pos * invf[ii], sn, cs);
                qa[ii] = (q1[ii] * cs - q2[ii] * sn) * 0.125f; qb[ii] = (q1[ii] * sn + q2[ii] * cs) * 0.125f;
                ka[ii] = k1[ii] * cs - k2[ii] * sn; kb[ii] = k1[ii] * sn + k2[ii] * cs; }
            u32x2 w; w.x = pk2(qa[0], qa[1]); w.y = pk2(qa[2], qa[3]); *(LAS u32x2*)(Qs + lc * 72 + 4 * pg) = w;
            w.x = pk2(qb[0], qb[1]); w.y = pk2(qb[2], qb[3]); *(LAS u32x2*)(Qs + lc * 72 + 32 + 4 * pg) = w;
            w.x = pk2(ka[0], ka[1]); w.y = pk2(ka[2], ka[3]); *(LAS u32x2*)(Ks + lc * 72 + 4 * pg) = w;
            w.x = pk2(kb[0], kb[1]); w.y = pk2(kb[2], kb[3]); *(LAS u32x2*)(Ks + lc * 72 + 32 + 4 * pg) = w;
#pragma unroll
            for (int ii = 0; ii < 4; ++ii) { KzT[(4 * pg + ii) * 72 + lc] = f2bf(ka[ii] * zeta); KzT[(32 + 4 * pg + ii) * 72 + lc] = f2bf(kb[ii] * zeta); }
            const unsigned vv[4] = {vw.x, vw.y, vw.z, vw.w};
#pragma unroll
            for (int ii = 0; ii < 4; ++ii) { VT[(8 * pg + 2 * ii) * 72 + lc] = (bf16_t)(vv[ii] & 0xffffu); VT[(8 * pg + 2 * ii + 1) * 72 + lc] = (bf16_t)(vv[ii] >> 16); }
        }
        __syncthreads();
        const bf16x8 a0 = *(const LAS bf16x8*)(Qs + (it4 * 16 + fr) * 72 + 8 * fq), a1 = *(const LAS bf16x8*)(Qs + (it4 * 16 + fr) * 72 + 32 + 8 * fq);
        f32x4 cross[2];
#pragma unroll
        for (int t = 0; t < 2; ++t) { const int jt = jt0 + t;
            f32x4 p = {0.f, 0.f, 0.f, 0.f};
            p = mfma16(a0, *(const LAS bf16x8*)(Ks + (jt * 16 + fr) * 72 + 8 * fq), p); p = mfma16(a1, *(const LAS bf16x8*)(Ks + (jt * 16 + fr) * 72 + 32 + 8 * fq), p);
            f32x4 cr = {0.f, 0.f, 0.f, 0.f};
            cr = mfma16(a0, *(const LAS bf16x8*)(ST + (jt * 16 + fr) * 72 + 8 * fq), cr); cr = mfma16(a1, *(const LAS bf16x8*)(ST + (jt * 16 + fr) * 72 + 32 + 8 * fq), cr);
#pragma unroll
            for (int r = 0; r < 4; ++r) { const int i = it4 * 16 + 4 * fq + r, j = jt * 16 + fr; const int dd = i > j ? i - j : j - i;
                Pm[i * 72 + j] = f2bf(p[r] * __expf((float)dd * lg)); cr[r] *= __expf((float)(i + 1) * lg); }
            cross[t] = cr; }
        __syncthreads();
        const bf16x8 p0 = *(const LAS bf16x8*)(Pm + (it4 * 16 + fr) * 72 + 8 * fq), p1 = *(const LAS bf16x8*)(Pm + (it4 * 16 + fr) * 72 + 32 + 8 * fq);
        const bf16x8 kz0 = *(const LAS bf16x8*)(KzT + (it4 * 16 + fr) * 72 + 8 * fq), kz1 = *(const LAS bf16x8*)(KzT + (it4 * 16 + fr) * 72 + 32 + 8 * fq);
#pragma unroll
        for (int t = 0; t < 2; ++t) { const int et = jt0 + t;
            const bf16x8 v0 = *(const LAS bf16x8*)(VT + (et * 16 + fr) * 72 + 8 * fq), v1 = *(const LAS bf16x8*)(VT + (et * 16 + fr) * 72 + 32 + 8 * fq);
            f32x4 o = cross[t]; o = mfma16(p0, v0, o); o = mfma16(p1, v1, o);
#pragma unroll
            for (int r = 0; r < 4; ++r) Of[(it4 * 16 + 4 * fq + r) * 65 + et * 16 + fr] = o[r];
            f32x4 s = S[t] * cdec; s = mfma16(kz0, v0, s); s = mfma16(kz1, v1, s); S[t] = s;
            u32x2 w; w.x = pk2(s.x, s.y); w.y = pk2(s.z, s.w); *(LAS u32x2*)(ST + (et * 16 + fr) * 72 + it4 * 16 + 4 * fq) = w; }
        __syncthreads();
        {
            float ov[8]; float sm = 0.f;
#pragma unroll
            for (int j = 0; j < 8; ++j) { ov[j] = Of[lc * 65 + 8 * pg + j]; sm += ov[j]; }
            sm += __shfl_xor(sm, 1); sm += __shfl_xor(sm, 2); sm += __shfl_xor(sm, 4);
            const float mu = sm * (1.0f / 64.0f); float vs = 0.f;
#pragma unroll
            for (int j = 0; j < 8; ++j) { ov[j] -= mu; vs += ov[j] * ov[j]; }
            vs += __shfl_xor(vs, 1); vs += __shfl_xor(vs, 2); vs += __shfl_xor(vs, 4);
            const float rs = rsqrtf(vs * (1.0f / 64.0f) + EPS);
            const u32x4 gw = *(const u32x4*)(zr + Z_RG + h * 64 + 8 * pg);
            const float gt[8] = {bflo(gw.x), bfhi(gw.x), bflo(gw.y), bfhi(gw.y), bflo(gw.z), bfhi(gw.z), bflo(gw.w), bfhi(gw.w)};
            const float gnv[8] = {gn0.x, gn0.y, gn0.z, gn0.w, gn1.x, gn1.y, gn1.z, gn1.w};
            float r8[8];
#pragma unroll
            for (int j = 0; j < 8; ++j) r8[j] = ov[j] * rs * gnv[j] * siluf_(gt[j]);
            u32x4 w; w.x = pk2(r8[0], r8[1]); w.y = pk2(r8[2], r8[3]); w.z = pk2(r8[4], r8[5]); w.w = pk2(r8[6], r8[7]);
            *(u32x4*)(y + tok * DM + h * 64 + 8 * pg) = w;
        }
    }
    __syncthreads();
}

constexpr int LR_XC = 0, LR_AU = 33792, LR_HIN = 99584;
__device__ __forceinline__ void lru_item(const Params& P, int l, LAS unsigned char* lds, int it, int mode, int tid, int wave, int lane) {
    const int b = it >> 5, n = it & 31, fr = lane & 15, fq = lane >> 4;
    const bf16_t* z = (const bf16_t*)(P.ws + WS_R); bf16_t* y = (bf16_t*)(P.ws + WS_R + R_Y);
    LAS bf16_t* XC = (LAS bf16_t*)(lds + LR_XC); LAS f32x2* AU = (LAS f32x2*)(lds + LR_AU); LAS float* HIN = (LAS float*)(lds + LR_HIN);
    float* sumA = (float*)(P.ws + WS_LRUS); float* sumH = sumA + 16 * 32 * 256;
    {
        const int c = tid >> 3, cg = tid & 7, s = n * 64 + c; const size_t tok = (size_t)b * SEQ + s;
        const float* cw = P.lru_conv_w + (size_t)l * 4 * 256; const float* cb = P.lru_conv_b + l * 256;
#pragma unroll
        for (int g = 0; g < 4; ++g) { const int ch0 = cg * 32 + g * 8;
            const f32x4 b0 = *(const f32x4*)(cb + ch0), b1 = *(const f32x4*)(cb + ch0 + 4);
            float a[8] = {b0.x, b0.y, b0.z, b0.w, b1.x, b1.y, b1.z, b1.w};
#pragma unroll
            for (int kk = 0; kk < 4; ++kk) if (s - 3 + kk >= 0) { const u32x4 w = *(const u32x4*)(z + (tok - 3 + kk) * ZP + Z_LX + ch0);
                const f32x4 c0 = *(const f32x4*)(cw + kk * 256 + ch0), c1 = *(const f32x4*)(cw + kk * 256 + ch0 + 4);
                a[0] += c0.x * bflo(w.x); a[1] += c0.y * bfhi(w.x); a[2] += c0.z * bflo(w.y); a[3] += c0.w * bfhi(w.y);
                a[4] += c1.x * bflo(w.z); a[5] += c1.y * bfhi(w.z); a[6] += c1.z * bflo(w.w); a[7] += c1.w * bfhi(w.w); }
            u32x4 o; o.x = pk2(a[0], a[1]); o.y = pk2(a[2], a[3]); o.z = pk2(a[4], a[5]); o.w = pk2(a[6], a[7]);
            *(LAS u32x4*)(XC + c * 264 + ch0) = o; }
    }
    float hcar = 0.f, aprod = 1.f;
    if (tid < 256) {
        if (mode == 1) { for (int m = 0; m < n; ++m) hcar = sumA[(b * 32 + m) * 256 + tid] * hcar + sumH[(b * 32 + m) * 256 + tid]; }
    }
    const int nb = wave >> 1, rt = wave & 1;
    const bf16_t* wa = wl(P, l, W_A) + nb * 4096; const bf16_t* wx = wl(P, l, W_X) + nb * 4096;
    bf16x8 fa[4][2], fx[4][2]; float ba[4], bx[4], spl[4];
#pragma unroll
    for (int dt = 0; dt < 4; ++dt) {
#pragma unroll
        for (int s = 0; s < 2; ++s) { fa[dt][s] = *(const bf16x8*)(wa + (dt * 16 + fr) * 64 + 32 * s + 8 * fq); fx[dt][s] = *(const bf16x8*)(wx + (dt * 16 + fr) * 64 + 32 * s + 8 * fq); }
        const int d = nb * 64 + dt * 16 + fr; ba[dt] = P.lru_ba[l * 256 + d]; bx[dt] = P.lru_bx[l * 256 + d]; spl[dt] = softplusf_(-P.lru_lambda[l * 256 + d]); }
    __syncthreads();
    for (int half = 0; half < 2; ++half) {
        const int trow = half * 32 + rt * 16;
        const bf16x8 x0 = *(const LAS bf16x8*)(XC + (trow + fr) * 264 + nb * 64 + 8 * fq), x1 = *(const LAS bf16x8*)(XC + (trow + fr) * 264 + nb * 64 + 32 + 8 * fq);
#pragma unroll
        for (int dt = 0; dt < 4; ++dt) {
            f32x4 ar = {0.f, 0.f, 0.f, 0.f}, ai = {0.f, 0.f, 0.f, 0.f};
            ar = mfma16(x0, fa[dt][0], ar); ar = mfma16(x1, fa[dt][1], ar); ai = mfma16(x0, fx[dt][0], ai); ai = mfma16(x1, fx[dt][1], ai);
            const int d = nb * 64 + dt * 16 + fr;
#pragma unroll
            for (int r = 0; r < 4; ++r) { const int tl = rt * 16 + 4 * fq + r;
                const float xcv = bf2f(XC[(half * 32 + tl) * 264 + d]);
                const float rr = sigmoidf_(ar[r] + ba[dt]), ii = sigmoidf_(ai[r] + bx[dt]);
                const float la = -8.0f * rr * spl[dt]; const float a = __expf(la);
                const float u = sqrtf(-expm1f(2.0f * la)) * (ii * xcv);
                AU[tl * 257 + d] = (f32x2){a, u}; }
        }
        __syncthreads();
        if (tid < 256) {
            const size_t tok0 = (size_t)b * SEQ + n * 64 + half * 32;
            for (int tk = 0; tk < 32; ++tk) { const f32x2 au = AU[tk * 257 + tid]; hcar = au.x * hcar + au.y; aprod *= au.x;
                if (mode == 1) { const float gate = bf2f(z[(tok0 + tk) * ZP + Z_LG + tid]); y[(tok0 + tk) * DM + 256 + tid] = f2bf(hcar * geluf_(gate)); } }
        }
        __syncthreads();
    }
    if (mode == 0 && tid < 256) { sumA[(b * 32 + n) * 256 + tid] = aprod; sumH[(b * 32 + n) * 256 + tid] = hcar; }
}

constexpr int N_PHASES = 21;
constexpr int Q_RET = 64, Q_GDN = 32, Q_LRU = 512, Q_MLA = 1024, Q_TOTAL = Q_RET + Q_GDN + Q_LRU + Q_MLA;

__global__ void __launch_bounds__(512, 2) hymba_fwd(Params P) {
    extern __shared__ __attribute__((aligned(16))) unsigned char lds_raw[];
    LAS unsigned char* lds = (LAS unsigned char*)lds_raw;
    volatile LAS unsigned* LC = (volatile LAS unsigned*)(lds + LDS_CTL);
    const int G = gridDim.x;
#define SUB_TID() int tid2 = tid; asm volatile("" : "+v"(tid2)); const int lane2 = tid2 & 63, wave2 = __builtin_amdgcn_readfirstlane(tid2 >> 6); (void)lane2; (void)wave2
#define PH_TID() int tid = threadIdx.x; asm volatile("" : "+v"(tid)); const int lane = tid & 63, wave = __builtin_amdgcn_readfirstlane(tid >> 6); (void)lane; (void)wave
    unsigned* ctl = (unsigned*)(P.ws + WS_CTL);
    if (threadIdx.x < 64) LC[threadIdx.x] = 0u;
    __syncthreads();
    const int lo = P.ph_lo, hi = P.ph_hi;
    XcdBarrier bar; bar.bar = ctl + CW_BAR; bar.x = 0; bar.st = LC;
    if (hi - lo > 1) bar = xcd_barrier_post(ctl + CW_BAR, LC);
#ifndef PHASE_MASK
#define PHASE_MASK 0xFFFFFFFFu
#endif
#define EN(t) ((PHASE_MASK >> (t)) & 1u)
#define IN(k) (lo <= (k) && (k) < hi)
#define SEAM(k) do { if (IN(k) && IN((k) + 1)) xcd_barrier(bar); } while (0)

    bf16_t* xb = (bf16_t*)(P.ws + WS_XB); float* part = (float*)(P.ws + WS_PART);
    bf16_t* zb = (bf16_t*)(P.ws + WS_R); bf16_t* yb = (bf16_t*)(P.ws + WS_R + R_Y); bf16_t* oxb = (bf16_t*)(P.ws + WS_R + R_OX);

    if (IN(0) && EN(0)) { PH_TID(); p0_prologue(P, lds, tid); }
    SEAM(0);
    if (IN(1) && EN(1)) {
        PH_TID();
        const int which = blockIdx.x >> 6, l = which >> 1, isv = which & 1;
        if (which < 4) {
            const bf16_t* memn = (const bf16_t*)(P.ws + WS_GDN); const bf16_t* wkv = wl(P, l, W_KV);
            bf16_t* kout = (bf16_t*)(P.ws + WS_KVM + (size_t)l * KVM_LAYER); bf16_t* vout = kout + (size_t)4096 * 1024;
            pg8::Gemm g; pg8::EpiScaleBf16<0> E; pg8::StaticOrder S;
            if (!isv) { g = pg8::Gemm{memn, wkv, 4096, 1024, 1024}; E = pg8::EpiScaleBf16<0>{kout, 1024, nullptr}; S.init(4096, 1024, 64, blockIdx.x & 63); }
            else { g = pg8::Gemm{wkv + (size_t)1024 * 1024, memn, 1024, 4096, 1024}; E = pg8::EpiScaleBf16<0>{vout, 4096, nullptr}; S.init(1024, 4096, 64, blockIdx.x & 63); }
            pg8::gemm_phase(lds, g, S, E, tid);
        }
    }
    SEAM(1);
#pragma unroll 1
    for (int l = 0; l < 2; ++l) {
        const int pb = 2 + 9 * l;
        if (IN(pb + 0) && EN(2)) { PH_TID();
            pg8::Gemm g{xb, wl(P, l, W_IN), T_TOK, ZP, DM}; pg8::StaticOrder S; S.init(T_TOK, ZP, G, blockIdx.x);
            pg8::EpiScaleBf16<0> E{zb, ZP, part}; pg8::gemm_phase(lds, g, S, E, tid);
        }
        SEAM(pb + 0);
        if (IN(pb + 1)) {
            PH_TID();
            if (EN(3)) { SUB_TID(); for (int it = blockIdx.x; it < 1024; it += G) gdn_pre_item(P, l, lds, it, tid2); }
            if (EN(4)) { SUB_TID(); for (int it = blockIdx.x; it < 512; it += G) { lru_item(P, l, lds, it, 0, tid2, wave2, lane2); __syncthreads(); } }
            if (EN(5)) { SUB_TID(); for (int rt = blockIdx.x * 8 + wave2; rt < 2048; rt += G * 8) mla_pre_tile(P, l, rt, lane2); }
        }
        SEAM(pb + 1);
        if (IN(pb + 2)) {
            PH_TID();
            unsigned* qh = ctl + CW_QUEUE + 64 * l;
            for (;;) {
                if (tid == 0) LC[4] = __hip_atomic_fetch_add(qh, 1u, __ATOMIC_RELAXED, __HIP_MEMORY_SCOPE_AGENT);
                __syncthreads();
                const int it = (int)LC[4];
                __syncthreads();
                if (it >= Q_TOTAL) break;
                if (it < Q_RET) { if (EN(6)) { SUB_TID(); ret_chain_item(P, l, lds, it, tid2, wave2, lane2); } }
                else if (it < Q_RET + Q_GDN) { if (EN(7)) { SUB_TID(); gdn_chain_item(P, l, lds, it - Q_RET, tid2, wave2, lane2); } }
                else if (it < Q_RET + Q_GDN + Q_LRU) { if (EN(8)) { SUB_TID(); lru_item(P, l, lds, it - Q_RET - Q_GDN, 1, tid2, wave2, lane2); } __syncthreads(); }
                else { if (EN(9)) { SUB_TID(); mla_attn_item(P, lds, it - Q_RET - Q_GDN - Q_LRU, tid2, wave2, lane2); } __syncthreads(); }
            }
        }
        SEAM(pb + 2);
        if (IN(pb + 3) && EN(10)) { PH_TID();
            pg8::Gemm g{yb, wl(P, l, W_OUT), T_TOK, DM, DM}; pg8::StaticOrder S; S.init(T_TOK, DM, G, blockIdx.x);
            pg8::EpiResid E{P.out, xb, part}; pg8::gemm_phase(lds, g, S, E, tid);
        }
        SEAM(pb + 3);
        if (IN(pb + 4) && EN(11)) { PH_TID();
            pg8::Gemm g{xb, wl(P, l, W_Q), T_TOK, DM, DM}; pg8::StaticOrder S; S.init(T_TOK, DM, G, blockIdx.x);
            pg8::EpiScaleBf16<0> E{zb, DM, part}; pg8::gemm_phase(lds, g, S, E, tid);
        }
        SEAM(pb + 4);
        if (IN(pb + 5) && EN(12)) { PH_TID(); for (int it = blockIdx.x; it < 1024; it += G) { xa_item(P, l, lds, it, tid, wave, lane); __syncthreads(); } }
        SEAM(pb + 5);
        if (IN(pb + 6) && EN(13)) { PH_TID();
            pg8::Gemm g{oxb, wl(P, l, W_O), T_TOK, DM, DM}; pg8::StaticOrder S; S.init(T_TOK, DM, G, blockIdx.x);
            pg8::EpiResid E{P.out, xb, part}; pg8::gemm_phase(lds, g, S, E, tid);
        }
        SEAM(pb + 6);
        if (IN(pb + 7) && EN(14)) { PH_TID();
            pg8::Gemm g{xb, wl(P, l, W_1), T_TOK, DFF, DM}; pg8::StaticOrder S; S.init(T_TOK, DFF, G, blockIdx.x);
            pg8::EpiScaleBf16<1> E{zb, DFF, part}; pg8::gemm_phase(lds, g, S, E, tid);
        }
        SEAM(pb + 7);
        if (IN(pb + 8) && EN(15)) { PH_TID();
            pg8::Gemm g{zb, wl(P, l, W_2), T_TOK, DM, DFF}; pg8::StaticOrder S; S.init(T_TOK, DM, G, blockIdx.x);
            pg8::EpiResid E{P.out, xb, part}; pg8::gemm_phase(lds, g, S, E, tid);
        }
        SEAM(pb + 8);
    }
    if (IN(20) && EN(16)) { PH_TID(); final_norm_phase(P, tid); }
#undef IN
#undef SEAM
}

extern "C" void kernel_launch(void* const* d_in, const int* in_sizes, int n_in, void* d_out, int out_size, void* d_ws, size_t ws_size, hipStream_t stream) {
    static int grid = 0;
    if (grid == 0) {
        if (n_in != 31 || out_size != T_TOK * DM || ws_size < WS_END) { fprintf(stderr, "kernel_launch: unexpected shapes (n_in %d out %d ws %zu, need %zu)\n", n_in, out_size, ws_size, (size_t)WS_END); grid = -1; return; }
        if (hipFuncSetAttribute((const void*)hymba_fwd, hipFuncAttributeMaxDynamicSharedMemorySize, LDS_BYTES) != hipSuccess) { fprintf(stderr, "kernel_launch: hipFuncSetAttribute failed\n"); grid = -1; return; }
        int dev = 0, cus = 0, per_cu = 0;
        (void)hipGetDevice(&dev); (void)hipDeviceGetAttribute(&cus, hipDeviceAttributeMultiprocessorCount, dev);
        (void)hipOccupancyMaxActiveBlocksPerMultiprocessor(&per_cu, (const void*)hymba_fwd, 512, LDS_BYTES);
        (void)hipGetLastError();
        if (cus != 256 || per_cu < 1) fprintf(stderr, "kernel_launch: note: cus %d per_cu %d\n", cus, per_cu);
        grid = 256;
    }
    if (grid < 0) return;
    (void)hipMemsetAsync((char*)d_ws + WS_CTL, 0, CTL_BYTES, stream);
    Params p{};
    p.x = (const float*)d_in[0]; p.mem = (const float*)d_in[1]; p.pos = (const int*)d_in[2];
    p.norm_mix = (const float*)d_in[3]; p.w_in = (const float*)d_in[4]; p.ret_gn = (const float*)d_in[5];
    p.lru_conv_w = (const float*)d_in[6]; p.lru_conv_b = (const float*)d_in[7]; p.lru_wa = (const float*)d_in[8]; p.lru_ba = (const float*)d_in[9];
    p.lru_wx = (const float*)d_in[10]; p.lru_bx = (const float*)d_in[11]; p.lru_lambda = (const float*)d_in[12];
    p.mla_q_norm = (const float*)d_in[13]; p.mla_w_uq = (const float*)d_in[14]; p.mla_kv_norm = (const float*)d_in[15]; p.mla_w_ukv = (const float*)d_in[16];
    p.gdn_conv_w = (const float*)d_in[17]; p.gdn_a_log = (const float*)d_in[18]; p.gdn_dt_bias = (const float*)d_in[19]; p.gdn_norm = (const float*)d_in[20];
    p.w_out = (const float*)d_in[21]; p.norm_xattn = (const float*)d_in[22]; p.norm_mem = (const float*)d_in[23];
    p.xa_wq = (const float*)d_in[24]; p.xa_wkv = (const float*)d_in[25]; p.xa_wo = (const float*)d_in[26];
    p.norm_mlp = (const float*)d_in[27]; p.mlp_w1 = (const float*)d_in[28]; p.mlp_w2 = (const float*)d_in[29]; p.final_norm = (const float*)d_in[30];
    p.out = (float*)d_out; p.ws = (unsigned char*)d_ws;
#if N_LAUNCHES == 1
    p.ph_lo = 0; p.ph_hi = N_PHASES;
    void* args[] = {&p};
    hipError_t e = hipLaunchCooperativeKernel((const void*)hymba_fwd, dim3(grid), dim3(512), args, LDS_BYTES, stream);
    if (e != hipSuccess) fprintf(stderr, "kernel_launch: cooperative launch failed: %s\n", hipGetErrorString(e));
#else
    for (int ph = 0; ph < N_PHASES; ++ph) { p.ph_lo = ph; p.ph_hi = ph + 1; hipLaunchKernelGGL(hymba_fwd, dim3(grid), dim3(512), LDS_BYTES, stream, p); }
#endif
}
```

```cpp
#include <hip/hip_runtime.h>
#include <cstdio>
#include <cstdint>

#ifndef N_LAUNCHES
#define N_LAUNCHES 1
#endif

#define LAS __attribute__((address_space(3)))
typedef unsigned short bf16_t;
typedef short bf16x8 __attribute__((ext_vector_type(8)));
typedef float f32x4 __attribute__((ext_vector_type(4)));
typedef float f32x2 __attribute__((ext_vector_type(2)));
typedef unsigned u32x4 __attribute__((ext_vector_type(4)));
typedef unsigned u32x2 __attribute__((ext_vector_type(2)));

constexpr int T_TOK = 32768, DM = 1024, SEQ = 2048, NBATCH = 16, NCHUNK = 32, ZP = 3072, DFF = 4096, NMEM = 256;
constexpr int Z_RQ = 0, Z_RK = 256, Z_RV = 512, Z_RG = 768, Z_LX = 1024, Z_LG = 1280, Z_CQ = 1536, Z_CKV = 1728, Z_KR = 1856,
              Z_GQKV = 1888, Z_GG = 2656, Z_GB = 2912, Z_GA = 2916, IN_COLS = 2920;
constexpr float EPS = 1e-6f;
constexpr float LOG2E = 1.4426950408889634f;

constexpr size_t MiB = 1024 * 1024;
constexpr size_t WS_CTL = 0;
constexpr size_t CTL_BYTES = 65536;
constexpr size_t WS_PART = WS_CTL + CTL_BYTES;
constexpr size_t WS_LRUS = WS_PART + (size_t)T_TOK * 16 * 4;
constexpr size_t WS_GL = WS_LRUS + (size_t)2 * 16 * 32 * 256 * 4;
constexpr size_t WS_W = WS_GL + 65536;
constexpr size_t W_IN = 0, W_OUT = W_IN + (size_t)ZP * DM, W_Q = W_OUT + (size_t)DM * DM, W_KV = W_Q + (size_t)DM * DM, W_O = W_KV + (size_t)2 * DM * DM,
                 W_1 = W_O + (size_t)DM * DM, W_2 = W_1 + (size_t)DFF * DM, W_UQ = W_2 + (size_t)DFF * DM, W_UKV = W_UQ + 384 * 192, W_A = W_UKV + 512 * 128,
                 W_X = W_A + 4 * 64 * 64, W_LAYER = W_X + 4 * 64 * 64;
constexpr size_t WS_XB = WS_W + 2 * W_LAYER * 2;
constexpr size_t XB_BYTES = (size_t)T_TOK * DM * 2;
constexpr size_t MLA_Q_OFF = 0, MLA_K_OFF = (size_t)T_TOK * 4 * 96 * 2, MLA_VT_OFF = 2 * MLA_K_OFF;
constexpr size_t WS_KVM = WS_XB + XB_BYTES;
constexpr size_t KVM_LAYER = (size_t)2 * 4096 * 1024 * 2;
constexpr size_t WS_R = WS_KVM + 2 * KVM_LAYER;
constexpr size_t R_Y = (size_t)T_TOK * ZP * 2;
constexpr size_t R_OX = (size_t)T_TOK * DM * 2;
constexpr size_t WS_GDN = WS_R + 256 * MiB;
constexpr size_t WS_END = WS_GDN + 80 * MiB;
static_assert(WS_END <= 512 * MiB, "workspace map exceeds 512 MiB");
static_assert(WS_XB % 256 == 0 && WS_R % 256 == 0 && WS_GDN % 256 == 0 && WS_W % 256 == 0, "alignment");
constexpr int CW_BAR = 0;
constexpr int CW_QUEUE = 4096;

constexpr int LDS_BYTES = 132 * 1024;
constexpr int LDS_CTL = LDS_BYTES - 256;

typedef __bf16 bf16x2_t __attribute__((ext_vector_type(2)));
__device__ __forceinline__ unsigned pk2(float lo, float hi) { f32x2 t = {lo, hi}; bf16x2_t v = __builtin_convertvector(t, bf16x2_t); return __builtin_bit_cast(unsigned, v); }
__device__ __forceinline__ float bflo(unsigned w) { return __uint_as_float(w << 16); }
__device__ __forceinline__ float bfhi(unsigned w) { return __uint_as_float(w & 0xffff0000u); }
__device__ __forceinline__ float bf2f(bf16_t v) { return __uint_as_float((unsigned)v << 16); }
__device__ __forceinline__ bf16_t f2bf(float f) { return (bf16_t)(pk2(f, 0.f) & 0xffffu); }
__device__ __forceinline__ f32x4 mfma16(bf16x8 a, bf16x8 b, f32x4 c) { return __builtin_amdgcn_mfma_f32_16x16x32_bf16(a, b, c, 0, 0, 0); }
__device__ __forceinline__ float sigmoidf_(float x) { return 1.0f / (1.0f + __expf(-x)); }
__device__ __forceinline__ float siluf_(float x) { return x / (1.0f + __expf(-x)); }
__device__ __forceinline__ float softplusf_(float x) { return x > 20.f ? x : log1pf(__expf(x)); }
__device__ __forceinline__ float geluf_(float x) { const float u = 0.7978845608028654f * (x + 0.044715f * x * x * x); const float e = __expf(2.f * u); const float th = 1.f - 2.f / (e + 1.f); return 0.5f * x * (1.f + th); }
__device__ __forceinline__ float wave_sum(float v) {
#pragma unroll
    for (int o = 1; o < 64; o <<= 1) v += __shfl_xor(v, o);
    return v;
}
__device__ __forceinline__ void sincos_rev(float ang, float& s, float& c) {
    float rev = ang * 0.15915494309189535f; rev = rev - floorf(rev);
    s = __builtin_amdgcn_sinf(rev); c = __builtin_amdgcn_cosf(rev);
}
__device__ __forceinline__ bf16x8 mk8(u32x2 lo, u32x2 hi) { u32x4 t; t.x = lo.x; t.y = lo.y; t.z = hi.x; t.w = hi.y; return __builtin_bit_cast(bf16x8, t); }
__device__ __forceinline__ bf16x8 pack8(f32x4 a, f32x4 b) { u32x4 t; t.x = pk2(a.x, a.y); t.y = pk2(a.z, a.w); t.z = pk2(b.x, b.y); t.w = pk2(b.z, b.w); return __builtin_bit_cast(bf16x8, t); }

#define XB_TMO      128
#define XB_XCNT(j)  (256  + 64 * (j))
#define XB_XSUB(j)  (1280 + 64 * (j))
#define XB_XGEN(j)  (2304 + 64 * (j))
#define XB_TOP      3328
#define XB_TOPGEN   3392
#define XCD_BAR_WORDS 3456
#define XB_SPIN_CAP (1u << 22)
__device__ __forceinline__ unsigned xb_ld(unsigned* p)              { return __hip_atomic_load(p, __ATOMIC_RELAXED, __HIP_MEMORY_SCOPE_AGENT); }
__device__ __forceinline__ unsigned xb_add(unsigned* p, unsigned v) { return __hip_atomic_fetch_add(p, v, __ATOMIC_RELAXED, __HIP_MEMORY_SCOPE_AGENT); }
__device__ __forceinline__ unsigned xb_xcc_id() { return (unsigned)__builtin_amdgcn_s_getreg((3 << 11) | 20) & 0xFu; }
#define XB_SPIN(cond, bar) do { unsigned _sp = 0; while (cond) { __builtin_amdgcn_s_sleep(1); \
    if ((++_sp & 255u) == 0u) { if (xb_ld(&(bar)[XB_TMO])) break; if (_sp > XB_SPIN_CAP) { atomicAdd(&(bar)[XB_TMO], 1u); break; } } } } while (0)
struct XcdBarrier { unsigned* bar; unsigned x; volatile LAS unsigned* st; };
__device__ __forceinline__ XcdBarrier xcd_barrier_post(unsigned* bar, volatile LAS unsigned* st) {
    XcdBarrier b; b.bar = bar; b.x = xb_xcc_id(); b.st = st;
    if (threadIdx.x == 0) (void)xb_add(&bar[XB_XCNT(b.x)], 1u);
    return b;
}
__device__ __forceinline__ void xcd_barrier_complete(unsigned* bar, unsigned x, unsigned& nloc, unsigned& nx) {
    const unsigned G = gridDim.x * gridDim.y * gridDim.z;
    unsigned sum, cnt, mine, sp = 0u;
    for (;;) {
        sum = 0u; cnt = 0u; mine = 0u;
#pragma unroll
        for (unsigned j = 0; j < 16; ++j) { const unsigned c = xb_ld(&bar[XB_XCNT(j)]); sum += c; cnt += (c > 0u) ? 1u : 0u; mine = (j == x) ? c : mine; }
        if (sum == G) break;
        __builtin_amdgcn_s_sleep(1);
        if ((++sp & 255u) == 0u) { if (xb_ld(&bar[XB_TMO])) break; if (sp > XB_SPIN_CAP) { atomicAdd(&bar[XB_TMO], 1u); break; } }
    }
    nloc = mine > 0u ? mine : 1u; nx = cnt > 0u ? cnt : 1u;
}
__device__ __forceinline__ void xcd_barrier(const XcdBarrier& b) {
    asm volatile("s_waitcnt vmcnt(0)" ::: "memory");
    __syncthreads();
    if (threadIdx.x == 0) {
        unsigned* bar = b.bar;
        __builtin_amdgcn_s_waitcnt(0);
        unsigned nloc = b.st[0], nx = b.st[1];
        if (nloc == 0u) { xcd_barrier_complete(bar, b.x, nloc, nx); b.st[0] = nloc; b.st[1] = nx; }
        const unsigned old = xb_add(&bar[XB_XSUB(b.x)], 1u);
        const unsigned gen = old / nloc;
        if (old + 1u == (gen + 1u) * nloc) {
            __builtin_amdgcn_fence(__ATOMIC_RELEASE, "agent");
            asm volatile("s_waitcnt vmcnt(0)" ::: "memory");
            const unsigned og = xb_add(&bar[XB_TOP], 1u);
            const unsigned tg = og / nx;
            if (og + 1u == (tg + 1u) * nx) xb_add(&bar[XB_TOPGEN], 1u);
            else XB_SPIN(xb_ld(&bar[XB_TOPGEN]) == tg, bar);
            __builtin_amdgcn_fence(__ATOMIC_ACQUIRE, "agent");
            xb_add(&bar[XB_XGEN(b.x)], 1u);
            asm volatile("s_waitcnt vmcnt(0)" ::: "memory");
        } else {
            XB_SPIN(xb_ld(&bar[XB_XGEN(b.x)]) == gen, bar);
            __builtin_amdgcn_fence(__ATOMIC_ACQUIRE, "agent");
            asm volatile("s_waitcnt vmcnt(0)" ::: "memory");
        }
    }
    __syncthreads();
}

namespace pg8 {
constexpr int BM = 256, BK = 64, HALF = 128, HTB = HALF * BK * 2, STAGE_BYTES = 8 * HTB, NXCD = 8, WGM = 8;
__host__ __device__ __forceinline__ int lds_byte(int r, int c) { const int st = (r >> 4) * 2 + (c >> 5), rr = r & 15, cc = c & 31, ob = rr * 64 + cc * 2; return st * 1024 + (ob ^ (((ob >> 9) & 1) << 5)); }
__host__ __device__ __forceinline__ void stage_rc(int b, int& R, int& C) { const int st = b / 1024, sb = b % 1024, swz = sb ^ (((sb >> 9) & 1) << 5); R = (st >> 1) * 16 + swz / 64; C = (st & 1) * 32 + (swz % 64) / 2; }
__host__ __device__ __forceinline__ int perm32(int rho) { const int n = rho >> 4, i = rho & 15; return 8 * (i >> 2) + 4 * n + (i & 3); }
struct Unit { int pm, pn; };
struct Gemm { const bf16_t* A; const bf16_t* Bt; int M, N, K; };
struct StaticOrder {
    int nM, nN, nwg, G, c;
    __host__ __device__ void init(int M, int N, int G_, int c_) { nM = M / BM; nN = N / BM; nwg = nM * nN; G = G_; c = c_; }
    __host__ __device__ bool next(int i, Unit& u) const {
        const long L = (long)i * G + c; if (L >= nwg) return false;
        int wgid = (int)L; { const int q = nwg / NXCD, r = nwg % NXCD, xcd = wgid % NXCD, off = wgid / NXCD; wgid = (xcd < r ? xcd * (q + 1) : r * (q + 1) + (xcd - r) * q) + off; }
        const int nig = WGM * nN, gid = wgid / nig, fm = gid * WGM, gsz = (nM - fm) < WGM ? (nM - fm) : WGM;
        u.pm = fm + ((wgid % nig) % gsz); u.pn = (wgid % nig) / gsz; return true;
    }
    __device__ __forceinline__ void a_ready(const Unit&) const {}
    __device__ __forceinline__ void done(const Unit&) const {}
};

template <int ACT> struct EpiScaleBf16 {
    static constexpr bool PERM = true;
    bf16_t* O; int ldc; const float* part;
    __device__ __forceinline__ void operator()(const f32x4 (&acc)[2][2][4][2], const Unit& u, int wr, int wc, int fr, int fq) const {
        const int row0 = u.pm * BM + wr * 64 + fr, col0 = u.pn * BM + wc * 32 + 8 * fq;
#pragma unroll
        for (int ai = 0; ai < 2; ++ai)
#pragma unroll
            for (int m = 0; m < 4; ++m) {
                const int row = row0 + ai * HALF + m * 16;
                float sc = 1.0f;
                if (part) { const f32x4* pp = (const f32x4*)(part + (size_t)row * 16); const f32x4 a = pp[0], b = pp[1], c = pp[2], d = pp[3];
                    const float s = ((a.x + a.y) + (a.z + a.w)) + ((b.x + b.y) + (b.z + b.w)) + ((c.x + c.y) + (c.z + c.w)) + ((d.x + d.y) + (d.z + d.w));
                    sc = rsqrtf(s * (1.0f / 1024.0f) + EPS); }
                bf16_t* rowp = O + (size_t)row * ldc + col0;
#pragma unroll
                for (int bj = 0; bj < 2; ++bj) { f32x4 v0 = acc[ai][bj][m][0] * sc, v1 = acc[ai][bj][m][1] * sc;
                    if (ACT == 1) {
#pragma unroll
                        for (int j = 0; j < 4; ++j) { const float a0 = fmaxf(v0[j], 0.f), a1 = fmaxf(v1[j], 0.f); v0[j] = a0 * a0; v1[j] = a1 * a1; } }
                    u32x4 w; w.x = pk2(v0[0], v0[1]); w.y = pk2(v0[2], v0[3]); w.z = pk2(v1[0], v1[1]); w.w = pk2(v1[2], v1[3]);
                    *(u32x4*)(rowp + bj * HALF) = w; }
            }
    }
};
struct EpiResid {
    static constexpr bool PERM = false;
    float* X; bf16_t* XB; float* part;
    __device__ __forceinline__ void operator()(const f32x4 (&acc)[2][2][4][2], const Unit& u, int wr, int wc, int fr, int fq) const {
        const int row0 = u.pm * BM + wr * 64 + fr, col0 = u.pn * BM + wc * 32 + 4 * fq;
#pragma unroll
        for (int ai = 0; ai < 2; ++ai)
#pragma unroll
            for (int m = 0; m < 4; ++m) {
                const int row = row0 + ai * HALF + m * 16;
                float* xp = X + (size_t)row * DM + col0; bf16_t* bp = XB + (size_t)row * DM + col0;
                float ss = 0.f;
#pragma unroll
                for (int bj = 0; bj < 2; ++bj)
#pragma unroll
                    for (int n = 0; n < 2; ++n) { const f32x4 v = *(const f32x4*)(xp + bj * HALF + n * 16) + acc[ai][bj][m][n];
                        *(f32x4*)(xp + bj * HALF + n * 16) = v; ss += (v.x * v.x + v.y * v.y) + (v.z * v.z + v.w * v.w);
                        u32x2 w; w.x = pk2(v.x, v.y); w.y = pk2(v.z, v.w); *(u32x2*)(bp + bj * HALF + n * 16) = w; }
                ss += __shfl_xor(ss, 16); ss += __shfl_xor(ss, 32);
                if (fq == 0) part[(size_t)row * 16 + u.pn * 4 + wc] = ss;
            }
    }
};

template <class Epi, class Sched>
__device__ __forceinline__ void gemm_phase(LAS unsigned char* lds, const Gemm g, const Sched& S, const Epi& E, const int tid) {
    const int wid = __builtin_amdgcn_readfirstlane(tid >> 6), lane = tid & 63, wr = wid >> 2, wc = wid & 3, fr = lane & 15, fq = lane >> 4;
    const int K = g.K, nt = K / BK;
    unsigned voffA[2], voffB[2];
#pragma unroll
    for (int i = 0; i < 2; ++i) { int R, C; stage_rc(tid * 16 + i * 8192, R, C); const int Rb = Epi::PERM ? ((R & ~31) + perm32(R & 31)) : R;
        voffA[i] = (unsigned)(R * K + C) * 2u; voffB[i] = (unsigned)(Rb * K + C) * 2u; }
    const size_t kstep = (size_t)(BK * 2);
    const size_t hstep = (size_t)HALF * K * 2;
    const size_t tstep = 2 * hstep;
    const unsigned ldsw = (unsigned)wid * 1024u;
    const int aoff = lds_byte(wr * 64 + fr, fq * 8), boff = lds_byte(wc * 32 + fr, fq * 8);
#define PG8_SA(b, h) (((b) * 2 + (h)) * HTB)
#define PG8_SB(b, h) ((4 + (b) * 2 + (h)) * HTB)
#define PG8_STAGE(bufoff, gbase, voff) do { _Pragma("unroll") for (int _i = 0; _i < 2; ++_i) \
        __builtin_amdgcn_global_load_lds((const unsigned*)((const char*)(gbase) + (voff)[_i]), (LAS unsigned*)(lds + (bufoff) + ldsw + _i * 8192), 16, 0, 0); } while (0)
#define PG8_LDA(dst, b, h) do { _Pragma("unroll") for (int m = 0; m < 4; ++m) _Pragma("unroll") for (int k = 0; k < 2; ++k) dst[m][k] = *(const LAS bf16x8*)(lds + PG8_SA(b, h) + aoff + m * 2048 + k * 1024); } while (0)
#define PG8_LDB(dst, b, h) do { _Pragma("unroll") for (int n = 0; n < 2; ++n) _Pragma("unroll") for (int k = 0; k < 2; ++k) dst[n][k] = *(const LAS bf16x8*)(lds + PG8_SB(b, h) + boff + n * 2048 + k * 1024); } while (0)
#define PG8_MMA(ai, bj, At, Bt) do { __builtin_amdgcn_s_setprio(1); _Pragma("unroll") for (int m = 0; m < 4; ++m) _Pragma("unroll") for (int n = 0; n < 2; ++n) _Pragma("unroll") for (int k = 0; k < 2; ++k) \
        acc[ai][bj][m][n] = __builtin_amdgcn_mfma_f32_16x16x32_bf16(Bt[n][k], At[m][k], acc[ai][bj][m][n], 0, 0, 0); __builtin_amdgcn_s_setprio(0); } while (0)
#define PG8_WAIT_V(n) asm volatile("s_waitcnt vmcnt(" #n ")" ::: "memory")
#define PG8_WAIT_L(n) asm volatile("s_waitcnt lgkmcnt(" #n ")" ::: "memory")
#define PG8_BAR __builtin_amdgcn_s_barrier()
#define PG8_SCHED __builtin_amdgcn_sched_barrier(0)
    Unit cur, nxt; int ui = 0;
    if (!S.next(0, cur)) return;
    f32x4 acc[2][2][4][2];
#pragma unroll
    for (int a = 0; a < 2; ++a)
#pragma unroll
        for (int b = 0; b < 2; ++b)
#pragma unroll
            for (int m = 0; m < 4; ++m)
#pragma unroll
                for (int n = 0; n < 2; ++n) acc[a][b][m][n] = (f32x4){0.f, 0.f, 0.f, 0.f};
    bf16x8 At[4][2], B0[2][2], B1[2][2];
    const char* cA = (const char*)g.A + (size_t)cur.pm * tstep; const char* cB = (const char*)g.Bt + (size_t)cur.pn * tstep;
    S.a_ready(cur);
    PG8_STAGE(PG8_SB(0, 0), cB, voffB); PG8_STAGE(PG8_SA(0, 0), cA, voffA); PG8_STAGE(PG8_SB(0, 1), cB + hstep, voffB); PG8_STAGE(PG8_SA(0, 1), cA + hstep, voffA);
    if (wr == 1) PG8_BAR;
    PG8_WAIT_V(4); PG8_BAR;
    PG8_STAGE(PG8_SB(1, 0), cB + kstep, voffB); PG8_STAGE(PG8_SA(1, 0), cA + kstep, voffA); PG8_STAGE(PG8_SB(1, 1), cB + hstep + kstep, voffB);
    PG8_WAIT_V(6); PG8_BAR;
    for (;;) {
        const bool has_next = S.next(ui + 1, nxt);
        const char* nA = has_next ? (const char*)g.A + (size_t)nxt.pm * tstep : cA; const char* nB = has_next ? (const char*)g.Bt + (size_t)nxt.pn * tstep : cB;
        for (int t = 0; t < nt; t += 2) {
            const bool last = (t == nt - 2);
            const char* a1 = cA + (size_t)(t + 1) * kstep;
            const char* a2 = last ? nA : cA + (size_t)(t + 2) * kstep; const char* b2 = last ? nB : cB + (size_t)(t + 2) * kstep;
            const char* a3 = a2 + kstep; const char* b3 = b2 + kstep;
            if (last && has_next) S.a_ready(nxt);
            PG8_LDB(B0, 0, 0); PG8_SCHED; PG8_LDA(At, 0, 0); PG8_STAGE(PG8_SA(1, 1), a1 + hstep, voffA);
            PG8_WAIT_L(8); PG8_BAR; PG8_WAIT_L(0); PG8_MMA(0, 0, At, B0); PG8_BAR; PG8_SCHED;
            PG8_LDB(B1, 0, 1); PG8_STAGE(PG8_SB(0, 0), b2, voffB);
            PG8_BAR; PG8_WAIT_L(0); PG8_MMA(0, 1, At, B1); PG8_BAR;
            PG8_LDA(At, 0, 1); PG8_STAGE(PG8_SA(0, 0), a2, voffA);
            PG8_BAR; PG8_WAIT_L(0); PG8_MMA(1, 0, At, B0); PG8_BAR; PG8_SCHED;
            PG8_STAGE(PG8_SB(0, 1), b2 + hstep, voffB);
            PG8_WAIT_V(6); PG8_BAR; PG8_MMA(1, 1, At, B1); PG8_BAR;
            PG8_LDB(B0, 1, 0); PG8_SCHED; PG8_LDA(At, 1, 0); PG8_STAGE(PG8_SA(0, 1), a2 + hstep, voffA);
            PG8_WAIT_L(8); PG8_BAR; PG8_WAIT_L(0); PG8_MMA(0, 0, At, B0); PG8_BAR; PG8_SCHED;
            PG8_LDB(B1, 1, 1); PG8_STAGE(PG8_SB(1, 0), b3, voffB);
            PG8_BAR; PG8_WAIT_L(0); PG8_MMA(0, 1, At, B1); PG8_BAR;
            PG8_LDA(At, 1, 1); PG8_STAGE(PG8_SA(1, 0), a3, voffA);
            PG8_BAR; PG8_WAIT_L(0); PG8_MMA(1, 0, At, B0); PG8_BAR; PG8_SCHED;
            PG8_STAGE(PG8_SB(1, 1), b3 + hstep, voffB);
            PG8_WAIT_V(6); PG8_BAR; PG8_MMA(1, 1, At, B1); PG8_BAR;
        }
        E(acc, cur, wr, wc, fr, fq); S.done(cur);
        if (!has_next) break;
#pragma unroll
        for (int a = 0; a < 2; ++a)
#pragma unroll
            for (int b = 0; b < 2; ++b)
#pragma unroll
                for (int m = 0; m < 4; ++m)
#pragma unroll
                    for (int n = 0; n < 2; ++n) acc[a][b][m][n] = (f32x4){0.f, 0.f, 0.f, 0.f};
        cur = nxt; cA = nA; cB = nB; ++ui;
    }
    PG8_WAIT_V(0);
    if (wr == 0) PG8_BAR;
    PG8_BAR;
#undef PG8_SA
#undef PG8_SB
#undef PG8_STAGE
#undef PG8_LDA
#undef PG8_LDB
#undef PG8_MMA
#undef PG8_WAIT_V
#undef PG8_WAIT_L
#undef PG8_BAR
#undef PG8_SCHED
}
}

struct Params {
    const float* x; const float* mem; const int* pos;
    const float* norm_mix; const float* w_in; const float* ret_gn;
    const float* lru_conv_w; const float* lru_conv_b; const float* lru_wa; const float* lru_ba; const float* lru_wx; const float* lru_bx; const float* lru_lambda;
    const float* mla_q_norm; const float* mla_w_uq; const float* mla_kv_norm; const float* mla_w_ukv;
    const float* gdn_conv_w; const float* gdn_a_log; const float* gdn_dt_bias; const float* gdn_norm;
    const float* w_out; const float* norm_xattn; const float* norm_mem; const float* xa_wq; const float* xa_wkv; const float* xa_wo;
    const float* norm_mlp; const float* mlp_w1; const float* mlp_w2; const float* final_norm;
    float* out; unsigned char* ws;
    int ph_lo, ph_hi;
};

__device__ __forceinline__ bf16_t* wl(const Params& P, int l, size_t off) { return (bf16_t*)(P.ws + WS_W) + (size_t)l * W_LAYER + off; }

__device__ __forceinline__ void transpose_tile(const float* src, int K, int N, const float* gain, float scale, bf16_t* dst, int kb, int nb, LAS float* scr, int tid) {
#pragma unroll
    for (int i = 0; i < 8; ++i) { const int kk = (tid >> 6) + 8 * i, k = kb * 64 + kk, n = nb * 64 + (tid & 63);
        float v = 0.f; if (n < N) { v = src[(size_t)k * N + n] * scale; if (gain) v *= gain[k]; }
        scr[kk * 65 + (tid & 63)] = v; }
    __syncthreads();
    { const int nl = tid >> 3, k0 = (tid & 7) * 8; const LAS float* s = scr + k0 * 65 + nl;
      u32x4 o; o.x = pk2(s[0], s[65]); o.y = pk2(s[2 * 65], s[3 * 65]); o.z = pk2(s[4 * 65], s[5 * 65]); o.w = pk2(s[6 * 65], s[7 * 65]);
      *(u32x4*)(dst + (size_t)(nb * 64 + nl) * K + kb * 64 + k0) = o; }
    __syncthreads();
}
__device__ __forceinline__ void p0_prologue(const Params& P, LAS unsigned char* lds, int tid) {
    LAS float* scr = (LAS float*)lds;
    constexpr int T_IN = 16 * 48, T_SQ = 256, T_KV = 512, T_W1 = 1024, T_W2 = 1024, T_UQ = 18, T_UKV = 16, T_LRU = 8;
    constexpr int T_LAYER = T_IN + 3 * T_SQ + T_KV + T_W1 + T_W2 + T_UQ + T_UKV + T_LRU;
    for (int it = blockIdx.x; it < 2 * T_LAYER; it += gridDim.x) {
        const int l = it / T_LAYER; int r = it % T_LAYER;
        const float* src; const float* gain = nullptr; float scale = 1.f; bf16_t* dst; int K, N, nnb;
        if (r < T_IN) { src = P.w_in + (size_t)l * DM * IN_COLS; K = DM; N = IN_COLS; nnb = 48; gain = P.norm_mix + l * DM; dst = wl(P, l, W_IN); }
        else if ((r -= T_IN) < T_SQ) { src = P.w_out + (size_t)l * DM * DM; K = DM; N = DM; nnb = 16; dst = wl(P, l, W_OUT); }
        else if ((r -= T_SQ) < T_SQ) { src = P.xa_wq + (size_t)l * DM * DM; K = DM; N = DM; nnb = 16; gain = P.norm_xattn + l * DM; scale = 0.0625f * LOG2E; dst = wl(P, l, W_Q); }
        else if ((r -= T_SQ) < T_KV) { src = P.xa_wkv + (size_t)l * DM * 2 * DM; K = DM; N = 2 * DM; nnb = 32; gain = P.norm_mem + l * DM; dst = wl(P, l, W_KV); }
        else if ((r -= T_KV) < T_SQ) { src = P.xa_wo + (size_t)l * DM * DM; K = DM; N = DM; nnb = 16; dst = wl(P, l, W_O); }
        else if ((r -= T_SQ) < T_W1) { src = P.mlp_w1 + (size_t)l * DM * DFF; K = DM; N = DFF; nnb = 64; gain = P.norm_mlp + l * DM; dst = wl(P, l, W_1); }
        else if ((r -= T_W1) < T_W2) { src = P.mlp_w2 + (size_t)l * DFF * DM; K = DFF; N = DM; nnb = 16; dst = wl(P, l, W_2); }
        else if ((r -= T_W2) < T_UQ) { src = P.mla_w_uq + (size_t)l * 192 * 384; K = 192; N = 384; nnb = 6; gain = P.mla_q_norm + l * 192; dst = wl(P, l, W_UQ); }
        else if ((r -= T_UQ) < T_UKV) { src = P.mla_w_ukv + (size_t)l * 128 * 512; K = 128; N = 512; nnb = 8; gain = P.mla_kv_norm + l * 128; dst = wl(P, l, W_UKV); }
        else { r -= T_UKV; const int which = r >> 2, nb4 = r & 3; src = (which ? P.lru_wx : P.lru_wa) + (size_t)l * 4 * 4096 + nb4 * 4096; K = 64; N = 64; nnb = 1; dst = wl(P, l, which ? W_X : W_A) + nb4 * 4096; r = 0; }
        transpose_tile(src, K, N, gain, scale, dst, r / nnb, r % nnb, scr, tid);
    }
    const int wave = tid >> 6, lane = tid & 63;
    const int gw = blockIdx.x * 8 + wave, ngw = gridDim.x * 8;
    bf16_t* xb = (bf16_t*)(P.ws + WS_XB); float* part = (float*)(P.ws + WS_PART); bf16_t* memn = (bf16_t*)(P.ws + WS_GDN);
    for (int row = gw; row < T_TOK + NBATCH * NMEM; row += ngw) {
        const bool isx = row < T_TOK; const int r2 = isx ? row : row - T_TOK;
        const f32x4* src = (const f32x4*)((isx ? P.x : P.mem) + (size_t)r2 * DM) + lane;
        f32x4 v[4]; float s = 0.f;
#pragma unroll
        for (int j = 0; j < 4; ++j) { v[j] = src[64 * j]; s += (v[j].x * v[j].x + v[j].y * v[j].y) + (v[j].z * v[j].z + v[j].w * v[j].w); }
        s = wave_sum(s);
        if (isx) {
            f32x4* o = (f32x4*)(P.out + (size_t)row * DM) + lane; u32x2* ob = (u32x2*)(xb + (size_t)row * DM) + lane;
#pragma unroll
            for (int j = 0; j < 4; ++j) { o[64 * j] = v[j]; u32x2 w; w.x = pk2(v[j].x, v[j].y); w.y = pk2(v[j].z, v[j].w); ob[64 * j] = w; }
            if (lane < 16) part[(size_t)row * 16 + lane] = lane == 0 ? s : 0.f;
        } else {
            const float rs = rsqrtf(s * (1.0f / 1024.0f) + EPS); u32x2* ob = (u32x2*)(memn + (size_t)r2 * DM) + lane;
#pragma unroll
            for (int j = 0; j < 4; ++j) { u32x2 w; w.x = pk2(v[j].x * rs, v[j].y * rs); w.y = pk2(v[j].z * rs, v[j].w * rs); ob[64 * j] = w; }
        }
    }
}
__device__ __forceinline__ void final_norm_phase(const Params& P, int tid) {
    const int wave = tid >> 6, lane = tid & 63; const float* part = (const float*)(P.ws + WS_PART);
    f32x4 g[4];
#pragma unroll
    for (int j = 0; j < 4; ++j) g[j] = ((const f32x4*)P.final_norm)[64 * j + lane];
    for (int row = blockIdx.x * 8 + wave; row < T_TOK; row += gridDim.x * 8) {
        float s = lane < 16 ? part[(size_t)row * 16 + lane] : 0.f; s = wave_sum(s);
        const float rs = rsqrtf(s * (1.0f / 1024.0f) + EPS);
        f32x4* o = (f32x4*)(P.out + (size_t)row * DM) + lane;
#pragma unroll
        for (int j = 0; j < 4; ++j) { f32x4 v = o[64 * j]; o[64 * j] = v * rs * g[j]; }
    }
}

__device__ __forceinline__ void mla_pre_tile(const Params& P, int l, int rt, int lane) {
    const int fr = lane & 15, fq = lane >> 4;
    const bf16_t* z = (const bf16_t*)(P.ws + WS_R);
    bf16_t* Qo = (bf16_t*)(P.ws + WS_XB + MLA_Q_OFF); bf16_t* Ko = (bf16_t*)(P.ws + WS_XB + MLA_K_OFF); bf16_t* Vo = (bf16_t*)(P.ws + WS_XB + MLA_VT_OFF);
    const bf16_t* Wuq = wl(P, l, W_UQ); const bf16_t* Wukv = wl(P, l, W_UKV);
    const int tok0 = rt * 16, b = tok0 >> 11, s0 = tok0 & 2047;
    const bf16_t* zr = z + (size_t)(tok0 + fr) * ZP;
    bf16x8 cq[6], ckv[4]; float sq = 0.f, skv = 0.f;
#pragma unroll
    for (int s = 0; s < 6; ++s) { const u32x4 w = *(const u32x4*)(zr + Z_CQ + 32 * s + 8 * fq); cq[s] = __builtin_bit_cast(bf16x8, w);
        sq += bflo(w.x) * bflo(w.x) + bfhi(w.x) * bfhi(w.x) + bflo(w.y) * bflo(w.y) + bfhi(w.y) * bfhi(w.y) + bflo(w.z) * bflo(w.z) + bfhi(w.z) * bfhi(w.z) + bflo(w.w) * bflo(w.w) + bfhi(w.w) * bfhi(w.w); }
#pragma unroll
    for (int s = 0; s < 4; ++s) { const u32x4 w = *(const u32x4*)(zr + Z_CKV + 32 * s + 8 * fq); ckv[s] = __builtin_bit_cast(bf16x8, w);
        skv += bflo(w.x) * bflo(w.x) + bfhi(w.x) * bfhi(w.x) + bflo(w.y) * bflo(w.y) + bfhi(w.y) * bfhi(w.y) + bflo(w.z) * bflo(w.z) + bfhi(w.z) * bfhi(w.z) + bflo(w.w) * bflo(w.w) + bfhi(w.w) * bfhi(w.w); }
    sq += __shfl_xor(sq, 16); sq += __shfl_xor(sq, 32); skv += __shfl_xor(skv, 16); skv += __shfl_xor(skv, 32);
    const float rq = rsqrtf(sq * (1.0f / 192.0f) + EPS), rkv = rsqrtf(skv * (1.0f / 128.0f) + EPS);
    const float qsc = rq * 0.10206207261596575f * LOG2E;
    const float pos = (float)P.pos[tok0 + fr];
    float sn[4], cs[4];
#pragma unroll
    for (int r = 0; r < 4; ++r) { const float invf = exp2f(-(float)(4 * fq + r) * (13.287712379549449f / 16.0f)); sincos_rev(pos * invf, sn[r], cs[r]); }
    const size_t tokrow = (size_t)b * 4 * SEQ + (s0 + fr);
#pragma unroll 1
    for (int h = 0; h < 4; ++h) {
        bf16_t* qrow = Qo + (tokrow + (size_t)h * SEQ) * 96;
#pragma unroll 1
        for (int nt = 0; nt < 4; ++nt) { f32x4 a = {0.f, 0.f, 0.f, 0.f};
#pragma unroll
            for (int s = 0; s < 6; ++s) { const bf16x8 wf = *(const bf16x8*)(Wuq + (size_t)(h * 96 + nt * 16 + fr) * 192 + 32 * s + 8 * fq); a = mfma16(wf, cq[s], a); }
            a = a * qsc; u32x2 w; w.x = pk2(a.x, a.y); w.y = pk2(a.z, a.w); *(u32x2*)(qrow + nt * 16 + 4 * fq) = w; }
        f32x4 x1 = {0.f, 0.f, 0.f, 0.f}, x2 = {0.f, 0.f, 0.f, 0.f}, y1, y2;
#pragma unroll
        for (int s = 0; s < 6; ++s) { const bf16x8 wf1 = *(const bf16x8*)(Wuq + (size_t)(h * 96 + 64 + fr) * 192 + 32 * s + 8 * fq), wf2 = *(const bf16x8*)(Wuq + (size_t)(h * 96 + 80 + fr) * 192 + 32 * s + 8 * fq);
            x1 = mfma16(wf1, cq[s], x1); x2 = mfma16(wf2, cq[s], x2); }
        x1 = x1 * qsc; x2 = x2 * qsc;
#pragma unroll
        for (int r = 0; r < 4; ++r) { y1[r] = x1[r] * cs[r] - x2[r] * sn[r]; y2[r] = x1[r] * sn[r] + x2[r] * cs[r]; }
        { u32x2 w; w.x = pk2(y1.x, y1.y); w.y = pk2(y1.z, y1.w); *(u32x2*)(qrow + 64 + 4 * fq) = w; w.x = pk2(y2.x, y2.y); w.y = pk2(y2.z, y2.w); *(u32x2*)(qrow + 80 + 4 * fq) = w; }
    }
    u32x2 kr1, kr2;
    { const u32x2 a = *(const u32x2*)(zr + Z_KR + 4 * fq), c = *(const u32x2*)(zr + Z_KR + 16 + 4 * fq);
      const float x1[4] = {bflo(a.x), bfhi(a.x), bflo(a.y), bfhi(a.y)}, x2[4] = {bflo(c.x), bfhi(c.x), bflo(c.y), bfhi(c.y)}; float y1[4], y2[4];
#pragma unroll
      for (int r = 0; r < 4; ++r) { y1[r] = x1[r] * cs[r] - x2[r] * sn[r]; y2[r] = x1[r] * sn[r] + x2[r] * cs[r]; }
      kr1.x = pk2(y1[0], y1[1]); kr1.y = pk2(y1[2], y1[3]); kr2.x = pk2(y2[0], y2[1]); kr2.y = pk2(y2[2], y2[3]); }
    float rkv_r[4];
#pragma unroll
    for (int r = 0; r < 4; ++r) rkv_r[r] = __shfl(rkv, 4 * fq + r);
    const int chunk = s0 >> 6, key0 = (s0 & 63) + 4 * fq;
#pragma unroll 1
    for (int h = 0; h < 4; ++h) {
        bf16_t* krow = Ko + (tokrow + (size_t)h * SEQ) * 96;
#pragma unroll 1
        for (int nt = 0; nt < 4; ++nt) { f32x4 a = {0.f, 0.f, 0.f, 0.f};
#pragma unroll
            for (int s = 0; s < 4; ++s) { const bf16x8 wf = *(const bf16x8*)(Wukv + (size_t)(h * 128 + nt * 16 + fr) * 128 + 32 * s + 8 * fq); a = mfma16(wf, ckv[s], a); }
            a = a * rkv; u32x2 w; w.x = pk2(a.x, a.y); w.y = pk2(a.z, a.w); *(u32x2*)(krow + nt * 16 + 4 * fq) = w; }
        *(u32x2*)(krow + 64 + 4 * fq) = kr1; *(u32x2*)(krow + 80 + 4 * fq) = kr2;
        bf16_t* vt = Vo + ((size_t)((b * 4 + h) * NCHUNK + chunk) * 64) * 64;
#pragma unroll 1
        for (int nt = 0; nt < 4; ++nt) { f32x4 a = {0.f, 0.f, 0.f, 0.f};
#pragma unroll
            for (int s = 0; s < 4; ++s) { const bf16x8 wf = *(const bf16x8*)(Wukv + (size_t)(h * 128 + 64 + nt * 16 + fr) * 128 + 32 * s + 8 * fq); a = mfma16(ckv[s], wf, a); }
            u32x2 w; w.x = pk2(a.x * rkv_r[0], a.y * rkv_r[1]); w.y = pk2(a.z * rkv_r[2], a.w * rkv_r[3]);
            *(u32x2*)(vt + (size_t)(nt * 16 + fr) * 64 + key0) = w; }
    }
}

template <int DQK, int DV>
__device__ __forceinline__ void flash_item(LAS unsigned char* lds, const bf16_t* Qw, int ldq, const bf16_t* Kb, int ldk, const bf16_t* VTb, int ldv, int vts,
                                           bf16_t* Ow, int ldo, int ntiles, int wave_limit, int tid, int lane) {
    constexpr int KROW = DQK + 8, KS = DQK / 32, ET = DV / 16;
    LAS bf16_t* Kt = (LAS bf16_t*)lds; LAS bf16_t* Vt = (LAS bf16_t*)(lds + 64 * KROW * 2);
    const int fr = lane & 15, fq = lane >> 4;
    bf16x8 qf[KS];
#pragma unroll
    for (int s = 0; s < KS; ++s) qf[s] = *(const bf16x8*)(Qw + (size_t)fr * ldq + 32 * s + 8 * fq);
    f32x4 ot[ET];
#pragma unroll
    for (int e = 0; e < ET; ++e) ot[e] = (f32x4){0.f, 0.f, 0.f, 0.f};
    float m_run = -1e30f, l_run = 0.f;
    for (int j = 0; j < ntiles; ++j) {
        __syncthreads();
        constexpr int KP = 64 * DQK / 8;
#pragma unroll
        for (int i = 0; i < (KP + 511) / 512; ++i) { const int idx = tid + i * 512; if (idx < KP) { const int row = idx / (DQK / 8), pc = idx % (DQK / 8);
            *(LAS u32x4*)(Kt + row * KROW + pc * 8) = *(const u32x4*)(Kb + (size_t)(j * 64 + row) * ldk + pc * 8); } }
        constexpr int VP = DV * 8;
#pragma unroll
        for (int i = 0; i < (VP + 511) / 512; ++i) { const int idx = tid + i * 512; if (idx < VP) { const int row = idx >> 3, pc = idx & 7;
            *(LAS u32x4*)(Vt + row * 72 + pc * 8) = *(const u32x4*)(VTb + (size_t)j * vts + (size_t)row * ldv + pc * 8); } }
        __syncthreads();
        if (j < wave_limit) {
            f32x4 st[4];
#pragma unroll
            for (int kt = 0; kt < 4; ++kt) { f32x4 a = {0.f, 0.f, 0.f, 0.f};
#pragma unroll
                for (int s = 0; s < KS; ++s) { const bf16x8 kf = *(const LAS bf16x8*)(Kt + (kt * 16 + fr) * KROW + 32 * s + 8 * fq); a = mfma16(kf, qf[s], a); }
                st[kt] = a; }
            float mx = fmaxf(fmaxf(fmaxf(st[0].x, st[0].y), fmaxf(st[0].z, st[0].w)), fmaxf(fmaxf(st[1].x, st[1].y), fmaxf(st[1].z, st[1].w)));
            mx = fmaxf(mx, fmaxf(fmaxf(fmaxf(st[2].x, st[2].y), fmaxf(st[2].z, st[2].w)), fmaxf(fmaxf(st[3].x, st[3].y), fmaxf(st[3].z, st[3].w))));
            mx = fmaxf(mx, __shfl_xor(mx, 16)); mx = fmaxf(mx, __shfl_xor(mx, 32));
            const float m_new = fmaxf(m_run, mx), alpha = exp2f(m_run - m_new);
            float ls = 0.f;
#pragma unroll
            for (int kt = 0; kt < 4; ++kt)
#pragma unroll
                for (int r = 0; r < 4; ++r) { const float p = exp2f(st[kt][r] - m_new); st[kt][r] = p; ls += p; }
            l_run = l_run * alpha + ls; m_run = m_new;
#pragma unroll
            for (int e = 0; e < ET; ++e) ot[e] = ot[e] * alpha;
            const bf16x8 pf0 = pack8(st[0], st[1]), pf1 = pack8(st[2], st[3]);
#pragma unroll
            for (int e = 0; e < ET; ++e) {
                const LAS bf16_t* vr = Vt + (e * 16 + fr) * 72 + 4 * fq;
                const bf16x8 v0 = mk8(*(const LAS u32x2*)(vr), *(const LAS u32x2*)(vr + 16)), v1 = mk8(*(const LAS u32x2*)(vr + 32), *(const LAS u32x2*)(vr + 48));
                ot[e] = mfma16(v0, pf0, ot[e]); ot[e] = mfma16(v1, pf1, ot[e]); }
        }
    }
    l_run += __shfl_xor(l_run, 16); l_run += __shfl_xor(l_run, 32);
    const float inv = 1.0f / l_run;
#pragma unroll
    for (int e = 0; e < ET; ++e) { u32x2 w; w.x = pk2(ot[e].x * inv, ot[e].y * inv); w.y = pk2(ot[e].z * inv, ot[e].w * inv);
        *(u32x2*)(Ow + (size_t)fr * ldo + e * 16 + 4 * fq) = w; }
}
__device__ __forceinline__ void mla_attn_item(const Params& P, LAS unsigned char* lds, int it, int tid, int wave, int lane) {
    const int qt = 15 - (it >> 6), bh = it & 63;
    const bf16_t* Q = (const bf16_t*)(P.ws + WS_XB + MLA_Q_OFF) + ((size_t)bh * SEQ + qt * 128 + wave * 16) * 96;
    const bf16_t* K = (const bf16_t*)(P.ws + WS_XB + MLA_K_OFF) + (size_t)bh * SEQ * 96;
    const bf16_t* VT = (const bf16_t*)(P.ws + WS_XB + MLA_VT_OFF) + (size_t)bh * NCHUNK * 4096;
    bf16_t* y = (bf16_t*)(P.ws + WS_R + R_Y) + ((size_t)(bh >> 2) * SEQ + qt * 128 + wave * 16) * DM + 512 + (bh & 3) * 64;
    flash_item<96, 64>(lds, Q, 96, K, 96, VT, 64, 4096, y, DM, 2 * qt + 2, 2 * qt + (wave >> 2) + 1, tid, lane);
}
__device__ __forceinline__ void xa_item(const Params& P, int l, LAS unsigned char* lds, int it, int tid, int wave, int lane) {
    const int qt = it & 15, h = (it >> 4) & 3, b = it >> 6;
    const size_t qoff = ((size_t)b * SEQ + qt * 128 + wave * 16) * DM + h * 256;
    const bf16_t* Q = (const bf16_t*)(P.ws + WS_R) + qoff; bf16_t* O = (bf16_t*)(P.ws + WS_R + R_OX) + qoff;
    const bf16_t* K = (const bf16_t*)(P.ws + WS_KVM + (size_t)l * KVM_LAYER) + (size_t)b * NMEM * DM + h * 256;
    const bf16_t* VT = (const bf16_t*)(P.ws + WS_KVM + (size_t)l * KVM_LAYER + (size_t)4096 * 1024 * 2) + (size_t)h * 256 * 4096 + b * NMEM;
    flash_item<256, 256>(lds, Q, DM, K, DM, VT, 4096, 64, O, DM, 4, 4, tid, lane);
}

constexpr int GP_KN = 0, GP_KB = 9216, GP_QN = 18432, GP_L = 9216, GP_RHS = 27648, GP_G = 60416, GP_GC = 60672, GP_HEAD = 61440;
__device__ __forceinline__ bf16_t* gdn_buf(const Params& P, int chh, int k) { return (bf16_t*)(P.ws + WS_GDN) + ((size_t)chh * 5 + k) * 4096; }
__device__ __forceinline__ void gdn_pre_item(const Params& P, int l, LAS unsigned char* lds, int it, int tid) {
    const int hp = it & 1, n = (it >> 1) & 31, b = it >> 6;
    const int hh = tid >> 8, h = 2 * hp + hh, tt = tid & 255, c = tt >> 2, qr = tt & 3, lane = tid & 63;
    LAS unsigned char* L = lds + hh * GP_HEAD;
    const bf16_t* z = (const bf16_t*)(P.ws + WS_R);
    const int s = n * 64 + c; const size_t tok = (size_t)b * SEQ + s;
    const float* cw = P.gdn_conv_w + (size_t)l * 4 * 768;
    const int chh = (b * NCHUNK + n) * 4 + h;
    float q[16], k[16], v[16];
#pragma unroll
    for (int part = 0; part < 3; ++part) {
        float* dst = part == 0 ? q : (part == 1 ? k : v);
        const int ch0 = part * 256 + h * 64 + qr * 16;
#pragma unroll
        for (int i = 0; i < 16; ++i) dst[i] = 0.f;
#pragma unroll
        for (int kk = 0; kk < 4; ++kk) { if (s - 3 + kk >= 0) {
            const bf16_t* zr = z + (tok - 3 + kk) * ZP + Z_GQKV + ch0; const u32x4 w0 = *(const u32x4*)zr, w1 = *(const u32x4*)(zr + 8);
            const float* wr = cw + kk * 768 + ch0; const f32x4 c0 = *(const f32x4*)wr, c1 = *(const f32x4*)(wr + 4), c2 = *(const f32x4*)(wr + 8), c3 = *(const f32x4*)(wr + 12);
            dst[0] += c0.x * bflo(w0.x); dst[1] += c0.y * bfhi(w0.x); dst[2] += c0.z * bflo(w0.y); dst[3] += c0.w * bfhi(w0.y);
            dst[4] += c1.x * bflo(w0.z); dst[5] += c1.y * bfhi(w0.z); dst[6] += c1.z * bflo(w0.w); dst[7] += c1.w * bfhi(w0.w);
            dst[8] += c2.x * bflo(w1.x); dst[9] += c2.y * bfhi(w1.x); dst[10] += c2.z * bflo(w1.y); dst[11] += c2.w * bfhi(w1.y);
            dst[12] += c3.x * bflo(w1.z); dst[13] += c3.y * bfhi(w1.z); dst[14] += c3.z * bflo(w1.w); dst[15] += c3.w * bfhi(w1.w); } }
#pragma unroll
        for (int i = 0; i < 16; ++i) dst[i] = siluf_(dst[i]);
    }
    float sq = 0.f, sk = 0.f;
#pragma unroll
    for (int i = 0; i < 16; ++i) { sq += q[i] * q[i]; sk += k[i] * k[i]; }
    sq += __shfl_xor(sq, 1); sq += __shfl_xor(sq, 2); sk += __shfl_xor(sk, 1); sk += __shfl_xor(sk, 2);
    const float rq = rsqrtf(sq + EPS) * 0.125f, rk = rsqrtf(sk + EPS);
    const bf16_t* zt = z + tok * ZP;
    const float beta = sigmoidf_(bf2f(zt[Z_GB + h]));
    const float g = -__expf(P.gdn_a_log[l * 4 + h]) * softplusf_(bf2f(zt[Z_GA + h]) + P.gdn_dt_bias[l * 4 + h]);
    {
        u32x4 w0, w1;
#define PK16(dst0, dst1, src, sc) do { dst0.x = pk2(src[0] * (sc), src[1] * (sc)); dst0.y = pk2(src[2] * (sc), src[3] * (sc)); dst0.z = pk2(src[4] * (sc), src[5] * (sc)); dst0.w = pk2(src[6] * (sc), src[7] * (sc)); \
        dst1.x = pk2(src[8] * (sc), src[9] * (sc)); dst1.y = pk2(src[10] * (sc), src[11] * (sc)); dst1.z = pk2(src[12] * (sc), src[13] * (sc)); dst1.w = pk2(src[14] * (sc), src[15] * (sc)); } while (0)
        PK16(w0, w1, k, rk);        *(LAS u32x4*)(L + GP_KN + (c * 72 + qr * 16) * 2) = w0; *(LAS u32x4*)(L + GP_KN + (c * 72 + qr * 16 + 8) * 2) = w1;
        PK16(w0, w1, k, rk * beta); *(LAS u32x4*)(L + GP_KB + (c * 72 + qr * 16) * 2) = w0; *(LAS u32x4*)(L + GP_KB + (c * 72 + qr * 16 + 8) * 2) = w1;
        PK16(w0, w1, q, rq);        *(LAS u32x4*)(L + GP_QN + (c * 72 + qr * 16) * 2) = w0; *(LAS u32x4*)(L + GP_QN + (c * 72 + qr * 16 + 8) * 2) = w1;
        LAS float* rhs = (LAS float*)(L + GP_RHS) + c * 128 + qr * 16;
#pragma unroll
        for (int i = 0; i < 4; ++i) *(LAS f32x4*)(rhs + 4 * i) = (f32x4){v[4 * i] * beta, v[4 * i + 1] * beta, v[4 * i + 2] * beta, v[4 * i + 3] * beta};
        if (qr == 0) ((LAS float*)(L + GP_G))[c] = g;
    }
    __syncthreads();
    {
        float gc = 0.f, run = 0.f; const LAS float* G = (const LAS float*)(L + GP_G);
        for (int i = 0; i < 64; ++i) { run += G[i]; gc = (i == c) ? run : gc; }
        const float eg = __expf(gc), ek = __expf(run - gc);
        LAS float* rhs = (LAS float*)(L + GP_RHS) + c * 128 + 64 + qr * 16;
#pragma unroll
        for (int i = 0; i < 4; ++i) *(LAS f32x4*)(rhs + 4 * i) = (f32x4){k[4 * i] * rk * beta * eg, k[4 * i + 1] * rk * beta * eg, k[4 * i + 2] * rk * beta * eg, k[4 * i + 3] * rk * beta * eg};
        u32x4 w0, w1; PK16(w0, w1, q, rq * eg);
        bf16_t* qd = gdn_buf(P, chh, 3) + c * 64 + qr * 16; *(u32x4*)qd = w0; *(u32x4*)(qd + 8) = w1;
        bf16_t* kdt = gdn_buf(P, chh, 4) + (qr * 16) * 64 + c;
#pragma unroll
        for (int i = 0; i < 16; ++i) kdt[i * 64] = f2bf(k[i] * rk * ek);
        if (qr == 0) ((LAS float*)(L + GP_GC))[c] = gc;
        if (tt == 0) ((float*)(P.ws + WS_GL))[chh] = __expf(run);
    }
#undef PK16
    __syncthreads();
    {
        const int it4 = (tid >> 6) & 3, fr = lane & 15, fq = lane >> 4;
        const LAS bf16_t* Kn = (const LAS bf16_t*)(L + GP_KN); const LAS bf16_t* KB = (const LAS bf16_t*)(L + GP_KB); const LAS bf16_t* Qn = (const LAS bf16_t*)(L + GP_QN);
        const LAS float* GC = (const LAS float*)(L + GP_GC);
        const bf16x8 a0 = *(const LAS bf16x8*)(KB + (it4 * 16 + fr) * 72 + 8 * fq), a1 = *(const LAS bf16x8*)(KB + (it4 * 16 + fr) * 72 + 32 + 8 * fq);
        const bf16x8 q0 = *(const LAS bf16x8*)(Qn + (it4 * 16 + fr) * 72 + 8 * fq), q1 = *(const LAS bf16x8*)(Qn + (it4 * 16 + fr) * 72 + 32 + 8 * fq);
        float gci[4];
#pragma unroll
        for (int r = 0; r < 4; ++r) gci[r] = GC[it4 * 16 + 4 * fq + r];
        f32x4 lv[4]; bf16_t* att = gdn_buf(P, chh, 2);
#pragma unroll
        for (int jt = 0; jt < 4; ++jt) {
            const bf16x8 b0 = *(const LAS bf16x8*)(Kn + (jt * 16 + fr) * 72 + 8 * fq), b1 = *(const LAS bf16x8*)(Kn + (jt * 16 + fr) * 72 + 32 + 8 * fq);
            f32x4 al = {0.f, 0.f, 0.f, 0.f}, aa = {0.f, 0.f, 0.f, 0.f};
            al = mfma16(a0, b0, al); al = mfma16(a1, b1, al); aa = mfma16(q0, b0, aa); aa = mfma16(q1, b1, aa);
            const int j = jt * 16 + fr; const float gcj = GC[j];
#pragma unroll
            for (int r = 0; r < 4; ++r) { const int i = it4 * 16 + 4 * fq + r; const float dec = __expf(fminf(gci[r] - gcj, 0.f));
                lv[jt][r] = (i > j) ? al[r] * dec : 0.f; att[i * 64 + j] = f2bf((i >= j) ? aa[r] * dec : 0.f); }
        }
        __syncthreads();
        LAS float* Lm = (LAS float*)(L + GP_L);
#pragma unroll
        for (int jt = 0; jt < 4; ++jt)
#pragma unroll
            for (int r = 0; r < 4; ++r) Lm[(it4 * 16 + 4 * fq + r) * 64 + jt * 16 + fr] = lv[jt][r];
    }
    __syncthreads();
    if (tt < 128) {
        const LAS float* Lm = (const LAS float*)(L + GP_L); const LAS float* rhs = (const LAS float*)(L + GP_RHS) + tt;
        float x[64];
#pragma unroll
        for (int i = 0; i < 64; ++i) {
            float a0 = rhs[i * 128], a1 = 0.f;
#pragma unroll
            for (int j4 = 0; j4 < (i + 3) / 4; ++j4) { const f32x4 lr = *(const LAS f32x4*)(Lm + i * 64 + 4 * j4);
                if (4 * j4 + 0 < i) a0 -= lr.x * x[4 * j4 + 0]; if (4 * j4 + 1 < i) a1 -= lr.y * x[4 * j4 + 1];
                if (4 * j4 + 2 < i) a0 -= lr.z * x[4 * j4 + 2]; if (4 * j4 + 3 < i) a1 -= lr.w * x[4 * j4 + 3]; }
            x[i] = a0 + a1;
        }
        if (tt < 64) { bf16_t* ut = gdn_buf(P, chh, 1) + tt * 64;
#pragma unroll
            for (int g8 = 0; g8 < 8; ++g8) { u32x4 w; w.x = pk2(x[8 * g8], x[8 * g8 + 1]); w.y = pk2(x[8 * g8 + 2], x[8 * g8 + 3]); w.z = pk2(x[8 * g8 + 4], x[8 * g8 + 5]); w.w = pk2(x[8 * g8 + 6], x[8 * g8 + 7]); *(u32x4*)(ut + 8 * g8) = w; }
        } else { bf16_t* wo = gdn_buf(P, chh, 0) + (tt - 64);
#pragma unroll
            for (int i = 0; i < 64; ++i) wo[i * 64] = f2bf(x[i]); }
    }
    __syncthreads();
}

__device__ __forceinline__ bf16x8 lda_perm(const bf16_t* X, int row, int s, int fq) { const bf16_t* p = X + row * 64 + 32 * s + 4 * fq; return mk8(*(const u32x2*)p, *(const u32x2*)(p + 16)); }
__device__ __forceinline__ void gdn_chain_item(const Params& P, int l, LAS unsigned char* lds, int gi, int tid, int wave, int lane) {
    const int bh = gi * 2 + (wave >> 2), eb = wave & 3, b = bh >> 2, h = bh & 3, fr = lane & 15, fq = lane >> 4;
    const bf16_t* z = (const bf16_t*)(P.ws + WS_R); bf16_t* y = (bf16_t*)(P.ws + WS_R + R_Y);
    LAS float* part = (LAS float*)lds;
    const float ng = P.gdn_norm[l * 64 + eb * 16 + fr];
    f32x4 S[4];
#pragma unroll
    for (int t = 0; t < 4; ++t) S[t] = (f32x4){0.f, 0.f, 0.f, 0.f};
    for (int n = 0; n < NCHUNK; ++n) {
        const int chh = (b * NCHUNK + n) * 4 + h;
        const bf16_t* W = gdn_buf(P, chh, 0); const bf16_t* UT = gdn_buf(P, chh, 1); const bf16_t* ATT = gdn_buf(P, chh, 2); const bf16_t* QD = gdn_buf(P, chh, 3); const bf16_t* KDT = gdn_buf(P, chh, 4);
        const float egl = ((const float*)(P.ws + WS_GL))[chh];
        const bf16x8 sb0 = pack8(S[0], S[1]), sb1 = pack8(S[2], S[3]);
        f32x4 vn[4], o[4];
#pragma unroll
        for (int ct = 0; ct < 4; ++ct) {
            f32x4 a = {0.f, 0.f, 0.f, 0.f}; a = mfma16(lda_perm(W, ct * 16 + fr, 0, fq), sb0, a); a = mfma16(lda_perm(W, ct * 16 + fr, 1, fq), sb1, a);
            const u32x2 uw = *(const u32x2*)(UT + (eb * 16 + fr) * 64 + ct * 16 + 4 * fq);
            vn[ct] = (f32x4){bflo(uw.x) - a.x, bfhi(uw.x) - a.y, bflo(uw.y) - a.z, bfhi(uw.y) - a.w};
            f32x4 oo = {0.f, 0.f, 0.f, 0.f}; oo = mfma16(lda_perm(QD, ct * 16 + fr, 0, fq), sb0, oo); oo = mfma16(lda_perm(QD, ct * 16 + fr, 1, fq), sb1, oo); o[ct] = oo;
        }
        const bf16x8 vb0 = pack8(vn[0], vn[1]), vb1 = pack8(vn[2], vn[3]);
#pragma unroll
        for (int ct = 0; ct < 4; ++ct) { o[ct] = mfma16(lda_perm(ATT, ct * 16 + fr, 0, fq), vb0, o[ct]); o[ct] = mfma16(lda_perm(ATT, ct * 16 + fr, 1, fq), vb1, o[ct]); }
#pragma unroll
        for (int dt = 0; dt < 4; ++dt) { f32x4 a = S[dt] * egl; a = mfma16(lda_perm(KDT, dt * 16 + fr, 0, fq), vb0, a); a = mfma16(lda_perm(KDT, dt * 16 + fr, 1, fq), vb1, a); S[dt] = a; }
        LAS float* pw = part + (n & 1) * 512;
#pragma unroll
        for (int ct = 0; ct < 4; ++ct)
#pragma unroll
            for (int r = 0; r < 4; ++r) { float s2 = o[ct][r] * o[ct][r]; s2 += __shfl_xor(s2, 1); s2 += __shfl_xor(s2, 2); s2 += __shfl_xor(s2, 4); s2 += __shfl_xor(s2, 8);
                if (fr == 0) pw[wave * 64 + ct * 16 + 4 * fq + r] = s2; }
        __syncthreads();
        const int w0 = wave & 4;
#pragma unroll
        for (int ct = 0; ct < 4; ++ct)
#pragma unroll
            for (int r = 0; r < 4; ++r) { const int c = ct * 16 + 4 * fq + r;
                const float tot = (pw[w0 * 64 + c] + pw[(w0 + 1) * 64 + c]) + (pw[(w0 + 2) * 64 + c] + pw[(w0 + 3) * 64 + c]);
                const size_t tok = (size_t)b * SEQ + n * 64 + c;
                const float gate = bf2f(z[tok * ZP + Z_GG + h * 64 + eb * 16 + fr]);
                y[tok * DM + 768 + h * 64 + eb * 16 + fr] = f2bf(o[ct][r] * rsqrtf(tot * (1.0f / 64.0f) + EPS) * ng * siluf_(gate)); }
    }
    __syncthreads();
}

constexpr int RT_Q = 0, RT_K = 9216, RT_KZT = 18432, RT_VT = 27648, RT_P = 36864, RT_ST = 46080, RT_O = 55296;
__device__ __forceinline__ void ret_chain_item(const Params& P, int l, LAS unsigned char* lds, int it, int tid, int wave, int lane) {
    const int b = it >> 2, h = it & 3, fr = lane & 15, fq = lane >> 4;
    const bf16_t* z = (const bf16_t*)(P.ws + WS_R); bf16_t* y = (bf16_t*)(P.ws + WS_R + R_Y);
    LAS bf16_t* Qs = (LAS bf16_t*)(lds + RT_Q); LAS bf16_t* Ks = (LAS bf16_t*)(lds + RT_K); LAS bf16_t* KzT = (LAS bf16_t*)(lds + RT_KZT); LAS bf16_t* VT = (LAS bf16_t*)(lds + RT_VT);
    LAS bf16_t* Pm = (LAS bf16_t*)(lds + RT_P); LAS bf16_t* ST = (LAS bf16_t*)(lds + RT_ST); LAS float* Of = (LAS float*)(lds + RT_O);
    const float lg = log1pf(-exp2f(-5.0f - (float)h));
    const float cdec = __expf(64.0f * lg);
    for (int i = tid; i < 64 * 72 / 2; i += 512) ((LAS unsigned*)ST)[i] = 0u;
    const int it4 = wave >> 1, jt0 = 2 * (wave & 1);
    f32x4 S[2] = {{0.f, 0.f, 0.f, 0.f}, {0.f, 0.f, 0.f, 0.f}};
    const int lc = tid >> 3, pg = tid & 7;
    float invf[4];
#pragma unroll
    for (int ii = 0; ii < 4; ++ii) invf[ii] = exp2f(-(float)(4 * pg + ii) * (13.287712379549449f / 32.0f));
    const float zeta = __expf((63.0f - (float)lc) * lg);
    f32x4 gn0 = *(const f32x4*)(P.ret_gn + l * 256 + h * 64 + 8 * pg), gn1 = *(const f32x4*)(P.ret_gn + l * 256 + h * 64 + 8 * pg + 4);
    __syncthreads();
    for (int n = 0; n < NCHUNK; ++n) {
        const size_t tok = (size_t)b * SEQ + n * 64 + lc; const bf16_t* zr = z + tok * ZP;
        {
            const u32x2 q1w = *(const u32x2*)(zr + Z_RQ + h * 64 + 4 * pg), q2w = *(const u32x2*)(zr + Z_RQ + h * 64 + 32 + 4 * pg);
            const u32x2 k1w = *(const u32x2*)(zr + Z_RK + h * 64 + 4 * pg), k2w = *(const u32x2*)(zr + Z_RK + h * 64 + 32 + 4 * pg);
            const u32x4 vw = *(const u32x4*)(zr + Z_RV + h * 64 + 8 * pg);
            const float pos = (float)P.pos[tok];
            const float q1[4] = {bflo(q1w.x), bfhi(q1w.x), bflo(q1w.y), bfhi(q1w.y)}, q2[4] = {bflo(q2w.x), bfhi(q2w.x), bflo(q2w.y), bfhi(q2w.y)};
            const float k1[4] = {bflo(k1w.x), bfhi(k1w.x), bflo(k1w.y), bfhi(k1w.y)}, k2[4] = {bflo(k2w.x), bfhi(k2w.x), bflo(k2w.y), bfhi(k2w.y)};
            float qa[4], qb[4], ka[4], kb[4];
#pragma unroll
            for (int ii = 0; ii < 4; ++ii) { float sn, cs; sincos_rev(pos * invf[ii], sn, cs);
                qa[ii] = (q1[ii] * cs - q2[ii] * sn) * 0.125f; qb[ii] = (q1[ii] * sn + q2[ii] * cs) * 0.125f;
                ka[ii] = k1[ii] * cs - k2[ii] * sn; kb[ii] = k1[ii] * sn + k2[ii] * cs; }
            u32x2 w; w.x = pk2(qa[0], qa[1]); w.y = pk2(qa[2], qa[3]); *(LAS u32x2*)(Qs + lc * 72 + 4 * pg) = w;
            w.x = pk2(qb[0], qb[1]); w.y = pk2(qb[2], qb[3]); *(LAS u32x2*)(Qs + lc * 72 + 32 + 4 * pg) = w;
            w.x = pk2(ka[0], ka[1]); w.y = pk2(ka[2], ka[3]); *(LAS u32x2*)(Ks + lc * 72 + 4 * pg) = w;
            w.x = pk2(kb[0], kb[1]); w.y = pk2(kb[2], kb[3]); *(LAS u32x2*)(Ks + lc * 72 + 32 + 4 * pg) = w;
#pragma unroll
            for (int ii = 0; ii < 4; ++ii) { KzT[(4 * pg + ii) * 72 + lc] = f2bf(ka[ii] * zeta); KzT[(32 + 4 * pg + ii) * 72 + lc] = f2bf(kb[ii] * zeta); }
            const unsigned vv[4] = {vw.x, vw.y, vw.z, vw.w};
#pragma unroll
            for (int ii = 0; ii < 4; ++ii) { VT[(8 * pg + 2 * ii) * 72 + lc] = (bf16_t)(vv[ii] & 0xffffu); VT[(8 * pg + 2 * ii + 1) * 72 + lc] = (bf16_t)(vv[ii] >> 16); }
        }
        __syncthreads();
        const bf16x8 a0 = *(const LAS bf16x8*)(Qs + (it4 * 16 + fr) * 72 + 8 * fq), a1 = *(const LAS bf16x8*)(Qs + (it4 * 16 + fr) * 72 + 32 + 8 * fq);
        f32x4 cross[2];
#pragma unroll
        for (int t = 0; t < 2; ++t) { const int jt = jt0 + t;
            f32x4 p = {0.f, 0.f, 0.f, 0.f};
            p = mfma16(a0, *(const LAS bf16x8*)(Ks + (jt * 16 + fr) * 72 + 8 * fq), p); p = mfma16(a1, *(const LAS bf16x8*)(Ks + (jt * 16 + fr) * 72 + 32 + 8 * fq), p);
            f32x4 cr = {0.f, 0.f, 0.f, 0.f};
            cr = mfma16(a0, *(const LAS bf16x8*)(ST + (jt * 16 + fr) * 72 + 8 * fq), cr); cr = mfma16(a1, *(const LAS bf16x8*)(ST + (jt * 16 + fr) * 72 + 32 + 8 * fq), cr);
#pragma unroll
            for (int r = 0; r < 4; ++r) { const int i = it4 * 16 + 4 * fq + r, j = jt * 16 + fr; const int dd = i > j ? i - j : j - i;
                Pm[i * 72 + j] = f2bf(p[r] * __expf((float)dd * lg)); cr[r] *= __expf((float)(i + 1) * lg); }
            cross[t] = cr; }
        __syncthreads();
        const bf16x8 p0 = *(const LAS bf16x8*)(Pm + (it4 * 16 + fr) * 72 + 8 * fq), p1 = *(const LAS bf16x8*)(Pm + (it4 * 16 + fr) * 72 + 32 + 8 * fq);
        const bf16x8 kz0 = *(const LAS bf16x8*)(KzT + (it4 * 16 + fr) * 72 + 8 * fq), kz1 = *(const LAS bf16x8*)(KzT + (it4 * 16 + fr) * 72 + 32 + 8 * fq);
#pragma unroll
        for (int t = 0; t < 2; ++t) { const int et = jt0 + t;
            const bf16x8 v0 = *(const LAS bf16x8*)(VT + (et * 16 + fr) * 72 + 8 * fq), v1 = *(const LAS bf16x8*)(VT + (et * 16 + fr) * 72 + 32 + 8 * fq);
            f32x4 o = cross[t]; o = mfma16(p0, v0, o); o = mfma16(p1, v1, o);
#pragma unroll
            for (int r = 0; r < 4; ++r) Of[(it4 * 16 + 4 * fq + r) * 65 + et * 16 + fr] = o[r];
            f32x4 s = S[t] * cdec; s = mfma16(kz0, v0, s); s = mfma16(kz1, v1, s); S[t] = s;
            u32x2 w; w.x = pk2(s.x, s.y); w.y = pk2(s.z, s.w); *(LAS u32x2*)(ST + (et * 16 + fr) * 72 + it4 * 16 + 4 * fq) = w; }
        __syncthreads();
        {
            float ov[8]; float sm = 0.f;
#pragma unroll
            for (int j = 0; j < 8; ++j) { ov[j] = Of[lc * 65 + 8 * pg + j]; sm += ov[j]; }
            sm += __shfl_xor(sm, 1); sm += __shfl_xor(sm, 2); sm += __shfl_xor(sm, 4);
            const float mu = sm * (1.0f / 64.0f); float vs = 0.f;
#pragma unroll
            for (int j = 0; j < 8; ++j) { ov[j] -= mu; vs += ov[j] * ov[j]; }
            vs += __shfl_xor(vs, 1); vs += __shfl_xor(vs, 2); vs += __shfl_xor(vs, 4);
            const float rs = rsqrtf(vs * (1.0f / 64.0f) + EPS);
            const u32x4 gw = *(const u32x4*)(zr + Z_RG + h * 64 + 8 * pg);
            const float gt[8] = {bflo(gw.x), bfhi(gw.x), bflo(gw.y), bfhi(gw.y), bflo(gw.z), bfhi(gw.z), bflo(gw.w), bfhi(gw.w)};
            const float gnv[8] = {gn0.x, gn0.y, gn0.z, gn0.w, gn1.x, gn1.y, gn1.z, gn1.w};
            float r8[8];
#pragma unroll
            for (int j = 0; j < 8; ++j) r8[j] = ov[j] * rs * gnv[j] * siluf_(gt[j]);
            u32x4 w; w.x = pk2(r8[0], r8[1]); w.y = pk2(r8[2], r8[3]); w.z = pk2(r8[4], r8[5]); w.w = pk2(r8[6], r8[7]);
            *(u32x4*)(y + tok * DM + h * 64 + 8 * pg) = w;
        }
    }
    __syncthreads();
}

constexpr int LR_XC = 0, LR_AU = 33792, LR_HIN = 99584;
__device__ __forceinline__ void lru_item(const Params& P, int l, LAS unsigned char* lds, int it, int mode, int tid, int wave, int lane) {
    const int b = it >> 5, n = it & 31, fr = lane & 15, fq = lane >> 4;
    const bf16_t* z = (const bf16_t*)(P.ws + WS_R); bf16_t* y = (bf16_t*)(P.ws + WS_R + R_Y);
    LAS bf16_t* XC = (LAS bf16_t*)(lds + LR_XC); LAS f32x2* AU = (LAS f32x2*)(lds + LR_AU); LAS float* HIN = (LAS float*)(lds + LR_HIN);
    float* sumA = (float*)(P.ws + WS_LRUS); float* sumH = sumA + 16 * 32 * 256;
    {
        const int c = tid >> 3, cg = tid & 7, s = n * 64 + c; const size_t tok = (size_t)b * SEQ + s;
        const float* cw = P.lru_conv_w + (size_t)l * 4 * 256; const float* cb = P.lru_conv_b + l * 256;
#pragma unroll
        for (int g = 0; g < 4; ++g) { const int ch0 = cg * 32 + g * 8;
            const f32x4 b0 = *(const f32x4*)(cb + ch0), b1 = *(const f32x4*)(cb + ch0 + 4);
            float a[8] = {b0.x, b0.y, b0.z, b0.w, b1.x, b1.y, b1.z, b1.w};
#pragma unroll
            for (int kk = 0; kk < 4; ++kk) if (s - 3 + kk >= 0) { const u32x4 w = *(const u32x4*)(z + (tok - 3 + kk) * ZP + Z_LX + ch0);
                const f32x4 c0 = *(const f32x4*)(cw + kk * 256 + ch0), c1 = *(const f32x4*)(cw + kk * 256 + ch0 + 4);
                a[0] += c0.x * bflo(w.x); a[1] += c0.y * bfhi(w.x); a[2] += c0.z * bflo(w.y); a[3] += c0.w * bfhi(w.y);
                a[4] += c1.x * bflo(w.z); a[5] += c1.y * bfhi(w.z); a[6] += c1.z * bflo(w.w); a[7] += c1.w * bfhi(w.w); }
            u32x4 o; o.x = pk2(a[0], a[1]); o.y = pk2(a[2], a[3]); o.z = pk2(a[4], a[5]); o.w = pk2(a[6], a[7]);
            *(LAS u32x4*)(XC + c * 264 + ch0) = o; }
    }
    float hcar = 0.f, aprod = 1.f;
    if (tid < 256) {
        if (mode == 1) { for (int m = 0; m < n; ++m) hcar = sumA[(b * 32 + m) * 256 + tid] * hcar + sumH[(b * 32 + m) * 256 + tid]; }
    }
    const int nb = wave >> 1, rt = wave & 1;
    const bf16_t* wa = wl(P, l, W_A) + nb * 4096; const bf16_t* wx = wl(P, l, W_X) + nb * 4096;
    bf16x8 fa[4][2], fx[4][2]; float ba[4], bx[4], spl[4];
#pragma unroll
    for (int dt = 0; dt < 4; ++dt) {
#pragma unroll
        for (int s = 0; s < 2; ++s) { fa[dt][s] = *(const bf16x8*)(wa + (dt * 16 + fr) * 64 + 32 * s + 8 * fq); fx[dt][s] = *(const bf16x8*)(wx + (dt * 16 + fr) * 64 + 32 * s + 8 * fq); }
        const int d = nb * 64 + dt * 16 + fr; ba[dt] = P.lru_ba[l * 256 + d]; bx[dt] = P.lru_bx[l * 256 + d]; spl[dt] = softplusf_(-P.lru_lambda[l * 256 + d]); }
    __syncthreads();
    for (int half = 0; half < 2; ++half) {
        const int trow = half * 32 + rt * 16;
        const bf16x8 x0 = *(const LAS bf16x8*)(XC + (trow + fr) * 264 + nb * 64 + 8 * fq), x1 = *(const LAS bf16x8*)(XC + (trow + fr) * 264 + nb * 64 + 32 + 8 * fq);
#pragma unroll
        for (int dt = 0; dt < 4; ++dt) {
            f32x4 ar = {0.f, 0.f, 0.f, 0.f}, ai = {0.f, 0.f, 0.f, 0.f};
            ar = mfma16(x0, fa[dt][0], ar); ar = mfma16(x1, fa[dt][1], ar); ai = mfma16(x0, fx[dt][0], ai); ai = mfma16(x1, fx[dt][1], ai);
            const int d = nb * 64 + dt * 16 + fr;
#pragma unroll
            for (int r = 0; r < 4; ++r) { const int tl = rt * 16 + 4 * fq + r;
                const float xcv = bf2f(XC[(half * 32 + tl) * 264 + d]);
                const float rr = sigmoidf_(ar[r] + ba[dt]), ii = sigmoidf_(ai[r] + bx[dt]);
                const float la = -8.0f * rr * spl[dt]; const float a = __expf(la);
                const float u = sqrtf(-expm1f(2.0f * la)) * (ii * xcv);
                AU[tl * 257 + d] = (f32x2){a, u}; }
        }
        __syncthreads();
        if (tid < 256) {
            const size_t tok0 = (size_t)b * SEQ + n * 64 + half * 32;
            for (int tk = 0; tk < 32; ++tk) { const f32x2 au = AU[tk * 257 + tid]; hcar = au.x * hcar + au.y; aprod *= au.x;
                if (mode == 1) { const float gate = bf2f(z[(tok0 + tk) * ZP + Z_LG + tid]); y[(tok0 + tk) * DM + 256 + tid] = f2bf(hcar * geluf_(gate)); } }
        }
        __syncthreads();
    }
    if (mode == 0 && tid < 256) { sumA[(b * 32 + n) * 256 + tid] = aprod; sumH[(b * 32 + n) * 256 + tid] = hcar; }
}

constexpr int N_PHASES = 21;
constexpr int Q_RET = 64, Q_GDN = 32, Q_LRU = 512, Q_MLA = 1024, Q_TOTAL = Q_RET + Q_GDN + Q_LRU + Q_MLA;

__global__ void __launch_bounds__(512, 2) hymba_fwd(Params P) {
    extern __shared__ __attribute__((aligned(16))) unsigned char lds_raw[];
    LAS unsigned char* lds = (LAS unsigned char*)lds_raw;
    volatile LAS unsigned* LC = (volatile LAS unsigned*)(lds + LDS_CTL);
    const int G = gridDim.x;
#define SUB_TID() int tid2 = tid; asm volatile("" : "+v"(tid2)); const int lane2 = tid2 & 63, wave2 = __builtin_amdgcn_readfirstlane(tid2 >> 6); (void)lane2; (void)wave2
#define PH_TID() int tid = threadIdx.x; asm volatile("" : "+v"(tid)); const int lane = tid & 63, wave = __builtin_amdgcn_readfirstlane(tid >> 6); (void)lane; (void)wave
    unsigned* ctl = (unsigned*)(P.ws + WS_CTL);
    if (threadIdx.x < 64) LC[threadIdx.x] = 0u;
    __syncthreads();
    const int lo = P.ph_lo, hi = P.ph_hi;
    XcdBarrier bar; bar.bar = ctl + CW_BAR; bar.x = 0; bar.st = LC;
    if (hi - lo > 1) bar = xcd_barrier_post(ctl + CW_BAR, LC);
#ifndef PHASE_MASK
#define PHASE_MASK 0xFFFFFFFFu
#endif
#define EN(t) ((PHASE_MASK >> (t)) & 1u)
#define IN(k) (lo <= (k) && (k) < hi)
#define SEAM(k) do { if (IN(k) && IN((k) + 1)) xcd_barrier(bar); } while (0)

    bf16_t* xb = (bf16_t*)(P.ws + WS_XB); float* part = (float*)(P.ws + WS_PART);
    bf16_t* zb = (bf16_t*)(P.ws + WS_R); bf16_t* yb = (bf16_t*)(P.ws + WS_R + R_Y); bf16_t* oxb = (bf16_t*)(P.ws + WS_R + R_OX);

    if (IN(0) && EN(0)) { PH_TID(); p0_prologue(P, lds, tid); }
    SEAM(0);
    if (IN(1) && EN(1)) {
        PH_TID();
        const int which = blockIdx.x >> 6, l = which >> 1, isv = which & 1;
        if (which < 4) {
            const bf16_t* memn = (const bf16_t*)(P.ws + WS_GDN); const bf16_t* wkv = wl(P, l, W_KV);
            bf16_t* kout = (bf16_t*)(P.ws + WS_KVM + (size_t)l * KVM_LAYER); bf16_t* vout = kout + (size_t)4096 * 1024;
            pg8::Gemm g; pg8::EpiScaleBf16<0> E; pg8::StaticOrder S;
            if (!isv) { g = pg8::Gemm{memn, wkv, 4096, 1024, 1024}; E = pg8::EpiScaleBf16<0>{kout, 1024, nullptr}; S.init(4096, 1024, 64, blockIdx.x & 63); }
            else { g = pg8::Gemm{wkv + (size_t)1024 * 1024, memn, 1024, 4096, 1024}; E = pg8::EpiScaleBf16<0>{vout, 4096, nullptr}; S.init(1024, 4096, 64, blockIdx.x & 63); }
            pg8::gemm_phase(lds, g, S, E, tid);
        }
    }
    SEAM(1);
#pragma unroll 1
    for (int l = 0; l < 2; ++l) {
        const int pb = 2 + 9 * l;
        if (IN(pb + 0) && EN(2)) { PH_TID();
            pg8::Gemm g{xb, wl(P, l, W_IN), T_TOK, ZP, DM}; pg8::StaticOrder S; S.init(T_TOK, ZP, G, blockIdx.x);
            pg8::EpiScaleBf16<0> E{zb, ZP, part}; pg8::gemm_phase(lds, g, S, E, tid);
        }
        SEAM(pb + 0);
        if (IN(pb + 1)) {
            PH_TID();
            if (EN(3)) { SUB_TID(); for (int it = blockIdx.x; it < 1024; it += G) gdn_pre_item(P, l, lds, it, tid2); }
            if (EN(4)) { SUB_TID(); for (int it = blockIdx.x; it < 512; it += G) { lru_item(P, l, lds, it, 0, tid2, wave2, lane2); __syncthreads(); } }
            if (EN(5)) { SUB_TID(); for (int rt = blockIdx.x * 8 + wave2; rt < 2048; rt += G * 8) mla_pre_tile(P, l, rt, lane2); }
        }
        SEAM(pb + 1);
        if (IN(pb + 2)) {
            PH_TID();
            unsigned* qh = ctl + CW_QUEUE + 64 * l;
            for (;;) {
                if (tid == 0) LC[4] = __hip_atomic_fetch_add(qh, 1u, __ATOMIC_RELAXED, __HIP_MEMORY_SCOPE_AGENT);
                __syncthreads();
                const int it = (int)LC[4];
                __syncthreads();
                if (it >= Q_TOTAL) break;
                if (it < Q_RET) { if (EN(6)) { SUB_TID(); ret_chain_item(P, l, lds, it, tid2, wave2, lane2); } }
                else if (it < Q_RET + Q_GDN) { if (EN(7)) { SUB_TID(); gdn_chain_item(P, l, lds, it - Q_RET, tid2, wave2, lane2); } }
                else if (it < Q_RET + Q_GDN + Q_LRU) { if (EN(8)) { SUB_TID(); lru_item(P, l, lds, it - Q_RET - Q_GDN, 1, tid2, wave2, lane2); } __syncthreads(); }
                else { if (EN(9)) { SUB_TID(); mla_attn_item(P, lds, it - Q_RET - Q_GDN - Q_LRU, tid2, wave2, lane2); } __syncthreads(); }
            }
        }
        SEAM(pb + 2);
        if (IN(pb + 3) && EN(10)) { PH_TID();
            pg8::Gemm g{yb, wl(P, l, W_OUT), T_TOK, DM, DM}; pg8::StaticOrder S; S.init(T_TOK, DM, G, blockIdx.x);
            pg8::EpiResid E{P.out, xb, part}; pg8::gemm_phase(lds, g, S, E, tid);
        }
        SEAM(pb + 3);
        if (IN(pb + 4) && EN(11)) { PH_TID();
            pg8::Gemm g{xb, wl(P, l, W_Q), T_TOK, DM, DM}; pg8::StaticOrder S; S.init(T_TOK, DM, G, blockIdx.x);
            pg8::EpiScaleBf16<0> E{zb, DM, part}; pg8::gemm_phase(lds, g, S, E, tid);
        }
        SEAM(pb + 4);
        if (IN(pb + 5) && EN(12)) { PH_TID(); for (int it = blockIdx.x; it < 1024; it += G) { xa_item(P, l, lds, it, tid, wave, lane); __syncthreads(); } }
        SEAM(pb + 5);
        if (IN(pb + 6) && EN(13)) { PH_TID();
            pg8::Gemm g{oxb, wl(P, l, W_O), T_TOK, DM, DM}; pg8::StaticOrder S; S.init(T_TOK, DM, G, blockIdx.x);
            pg8::EpiResid E{P.out, xb, part}; pg8::gemm_phase(lds, g, S, E, tid);
        }
        SEAM(pb + 6);
        if (IN(pb + 7) && EN(14)) { PH_TID();
            pg8::Gemm g{xb, wl(P, l, W_1), T_TOK, DFF, DM}; pg8::StaticOrder S; S.init(T_TOK, DFF, G, blockIdx.x);
            pg8::EpiScaleBf16<1> E{zb, DFF, part}; pg8::gemm_phase(lds, g, S, E, tid);
        }
        SEAM(pb + 7);
        if (IN(pb + 8) && EN(15)) { PH_TID();
            pg8::Gemm g{zb, wl(P, l, W_2), T_TOK, DM, DFF}; pg8::StaticOrder S; S.init(T_TOK, DM, G, blockIdx.x);
            pg8::EpiResid E{P.out, xb, part}; pg8::gemm_phase(lds, g, S, E, tid);
        }
        SEAM(pb + 8);
    }
    if (IN(20) && EN(16)) { PH_TID(); final_norm_phase(P, tid); }
#undef IN
#undef SEAM
}

extern "C" void kernel_launch(void* const* d_in, const int* in_sizes, int n_in, void* d_out, int out_size, void* d_ws, size_t ws_size, hipStream_t stream) {
    static int grid = 0;
    if (grid == 0) {
        if (n_in != 31 || out_size != T_TOK * DM || ws_size < WS_END) { fprintf(stderr, "kernel_launch: unexpected shapes (n_in %d out %d ws %zu, need %zu)\n", n_in, out_size, ws_size, (size_t)WS_END); grid = -1; return; }
        if (hipFuncSetAttribute((const void*)hymba_fwd, hipFuncAttributeMaxDynamicSharedMemorySize, LDS_BYTES) != hipSuccess) { fprintf(stderr, "kernel_launch: hipFuncSetAttribute failed\n"); grid = -1; return; }
        int dev = 0, cus = 0, per_cu = 0;
        (void)hipGetDevice(&dev); (void)hipDeviceGetAttribute(&cus, hipDeviceAttributeMultiprocessorCount, dev);
        (void)hipOccupancyMaxActiveBlocksPerMultiprocessor(&per_cu, (const void*)hymba_fwd, 512, LDS_BYTES);
        (void)hipGetLastError();
        if (cus != 256 || per_cu < 1) fprintf(stderr, "kernel_launch: note: cus %d per_cu %d\n", cus, per_cu);
        grid = 256;
    }
    if (grid < 0) return;
    (void)hipMemsetAsync((char*)d_ws + WS_CTL, 0, CTL_BYTES, stream);
    Params p{};
    p.x = (const float*)d_in[0]; p.mem = (const float*)d_in[1]; p.pos = (const int*)d_in[2];
    p.norm_mix = (const float*)d_in[3]; p.w_in = (const float*)d_in[4]; p.ret_gn = (const float*)d_in[5];
    p.lru_conv_w = (const float*)d_in[6]; p.lru_conv_b = (const float*)d_in[7]; p.lru_wa = (const float*)d_in[8]; p.lru_ba = (const float*)d_in[9];
    p.lru_wx = (const float*)d_in[10]; p.lru_bx = (const float*)d_in[11]; p.lru_lambda = (const float*)d_in[12];
    p.mla_q_norm = (const float*)d_in[13]; p.mla_w_uq = (const float*)d_in[14]; p.mla_kv_norm = (const float*)d_in[15]; p.mla_w_ukv = (const float*)d_in[16];
    p.gdn_conv_w = (const float*)d_in[17]; p.gdn_a_log = (const float*)d_in[18]; p.gdn_dt_bias = (const float*)d_in[19]; p.gdn_norm = (const float*)d_in[20];
    p.w_out = (const float*)d_in[21]; p.norm_xattn = (const float*)d_in[22]; p.norm_mem = (const float*)d_in[23];
    p.xa_wq = (const float*)d_in[24]; p.xa_wkv = (const float*)d_in[25]; p.xa_wo = (const float*)d_in[26];
    p.norm_mlp = (const float*)d_in[27]; p.mlp_w1 = (const float*)d_in[28]; p.mlp_w2 = (const float*)d_in[29]; p.final_norm = (const float*)d_in[30];
    p.out = (float*)d_out; p.ws = (unsigned char*)d_ws;
#if N_LAUNCHES == 1
    p.ph_lo = 0; p.ph_hi = N_PHASES;
    void* args[] = {&p};
    hipError_t e = hipLaunchCooperativeKernel((const void*)hymba_fwd, dim3(grid), dim3(512), args, LDS_BYTES, stream);
    if (e != hipSuccess) fprintf(stderr, "kernel_launch: cooperative launch failed: %s\n", hipGetErrorString(e));
#else
    for (int ph = 0; ph < N_PHASES; ++ph) { p.ph_lo = ph; p.ph_hi = ph + 1; hipLaunchKernelGGL(hymba_fwd, dim3(grid), dim3(512), LDS_BYTES, stream, p); }
#endif
}
```

```cpp
#include <hip/hip_runtime.h>
#include <cstdio>
#include <cstdint>

#ifndef N_LAUNCHES
#define N_LAUNCHES 1
#endif

#define LAS __attribute__((address_space(3)))
typedef unsigned short bf16_t;
typedef short bf16x8 __attribute__((ext_vector_type(8)));
typedef float f32x4 __attribute__((ext_vector_type(4)));
typedef float f32x2 __attribute__((ext_vector_type(2)));
typedef unsigned u32x4 __attribute__((ext_vector_type(4)));
typedef unsigned u32x2 __attribute__((ext_vector_type(2)));

constexpr int T_TOK = 32768, DM = 1024, SEQ = 2048, NBATCH = 16, NCHUNK = 32, ZP = 3072, DFF = 4096, NMEM = 256;
constexpr int Z_RQ = 0, Z_RK = 256, Z_RV = 512, Z_RG = 768, Z_LX = 1024, Z_LG = 1280, Z_CQ = 1536, Z_CKV = 1728, Z_KR = 1856,
              Z_GQKV = 1888, Z_GG = 2656, Z_GB = 2912, Z_GA = 2916, IN_COLS = 2920;
constexpr float EPS = 1e-6f;
constexpr float LOG2E = 1.4426950408889634f;

constexpr size_t MiB = 1024 * 1024;
constexpr size_t WS_CTL = 0;
constexpr size_t CTL_BYTES = 65536;
constexpr size_t WS_PART = WS_CTL + CTL_BYTES;
constexpr size_t WS_LRUS = WS_PART + (size_t)T_TOK * 16 * 4;
constexpr size_t WS_GL = WS_LRUS + (size_t)2 * 16 * 32 * 256 * 4;
constexpr size_t WS_W = WS_GL + 65536;
constexpr size_t W_IN = 0, W_OUT = W_IN + (size_t)ZP * DM, W_Q = W_OUT + (size_t)DM * DM, W_KV = W_Q + (size_t)DM * DM, W_O = W_KV + (size_t)2 * DM * DM,
                 W_1 = W_O + (size_t)DM * DM, W_2 = W_1 + (size_t)DFF * DM, W_UQ = W_2 + (size_t)DFF * DM, W_UKV = W_UQ + 384 * 192, W_A = W_UKV + 512 * 128,
                 W_X = W_A + 4 * 64 * 64, W_LAYER = W_X + 4 * 64 * 64;
constexpr size_t WS_XB = WS_W + 2 * W_LAYER * 2;
constexpr size_t XB_BYTES = (size_t)T_TOK * DM * 2;
constexpr size_t MLA_Q_OFF = 0, MLA_K_OFF = (size_t)T_TOK * 4 * 96 * 2, MLA_VT_OFF = 2 * MLA_K_OFF;
constexpr size_t WS_KVM = WS_XB + XB_BYTES;
constexpr size_t KVM_LAYER = (size_t)2 * 4096 * 1024 * 2;
constexpr size_t WS_R = WS_KVM + 2 * KVM_LAYER;
constexpr size_t R_Y = (size_t)T_TOK * ZP * 2;
constexpr size_t R_OX = (size_t)T_TOK * DM * 2;
constexpr size_t WS_GDN = WS_R + 256 * MiB;
constexpr size_t WS_END = WS_GDN + 80 * MiB;
static_assert(WS_END <= 512 * MiB, "workspace map exceeds 512 MiB");
static_assert(WS_XB % 256 == 0 && WS_R % 256 == 0 && WS_GDN % 256 == 0 && WS_W % 256 == 0, "alignment");
constexpr int CW_BAR = 0;
constexpr int CW_QUEUE = 4096;

constexpr int LDS_BYTES = 132 * 1024;
constexpr int LDS_CTL = LDS_BYTES - 256;

typedef __bf16 bf16x2_t __attribute__((ext_vector_type(2)));
__device__ __forceinline__ unsigned pk2(float lo, float hi) { f32x2 t = {lo, hi}; bf16x2_t v = __builtin_convertvector(t, bf16x2_t); return __builtin_bit_cast(unsigned, v); }
__device__ __forceinline__ float bflo(unsigned w) { return __uint_as_float(w << 16); }
__device__ __forceinline__ float bfhi(unsigned w) { return __uint_as_float(w & 0xffff0000u); }
__device__ __forceinline__ float bf2f(bf16_t v) { return __uint_as_float((unsigned)v << 16); }
__device__ __forceinline__ bf16_t f2bf(float f) { return (bf16_t)(pk2(f, 0.f) & 0xffffu); }
__device__ __forceinline__ f32x4 mfma16(bf16x8 a, bf16x8 b, f32x4 c) { return __builtin_amdgcn_mfma_f32_16x16x32_bf16(a, b, c, 0, 0, 0); }
__device__ __forceinline__ float sigmoidf_(float x) { return 1.0f / (1.0f + __expf(-x)); }
__device__ __forceinline__ float siluf_(float x) { return x / (1.0f + __expf(-x)); }
__device__ __forceinline__ float softplusf_(float x) { return x > 20.f ? x : log1pf(__expf(x)); }
__device__ __forceinline__ float geluf_(float x) { const float u = 0.7978845608028654f * (x + 0.044715f * x * x * x); const float e = __expf(2.f * u); const float th = 1.f - 2.f / (e + 1.f); return 0.5f * x * (1.f + th); }
__device__ __forceinline__ float wave_sum(float v) {
#pragma unroll
    for (int o = 1; o < 64; o <<= 1) v += __shfl_xor(v, o);
    return v;
}
__device__ __forceinline__ void sincos_rev(float ang, float& s, float& c) {
    float rev = ang * 0.15915494309189535f; rev = rev - floorf(rev);
    s = __builtin_amdgcn_sinf(rev); c = __builtin_amdgcn_cosf(rev);
}
__device__ __forceinline__ bf16x8 mk8(u32x2 lo, u32x2 hi) { u32x4 t; t.x = lo.x; t.y = lo.y; t.z = hi.x; t.w = hi.y; return __builtin_bit_cast(bf16x8, t); }
__device__ __forceinline__ bf16x8 pack8(f32x4 a, f32x4 b) { u32x4 t; t.x = pk2(a.x, a.y); t.y = pk2(a.z, a.w); t.z = pk2(b.x, b.y); t.w = pk2(b.z, b.w); return __builtin_bit_cast(bf16x8, t); }

#define XB_TMO      128
#define XB_XCNT(j)  (256  + 64 * (j))
#define XB_XSUB(j)  (1280 + 64 * (j))
#define XB_XGEN(j)  (2304 + 64 * (j))
#define XB_TOP      3328
#define XB_TOPGEN   3392
#define XCD_BAR_WORDS 3456
#define XB_SPIN_CAP (1u << 22)
__device__ __forceinline__ unsigned xb_ld(unsigned* p)              { return __hip_atomic_load(p, __ATOMIC_RELAXED, __HIP_MEMORY_SCOPE_AGENT); }
__device__ __forceinline__ unsigned xb_add(unsigned* p, unsigned v) { return __hip_atomic_fetch_add(p, v, __ATOMIC_RELAXED, __HIP_MEMORY_SCOPE_AGENT); }
__device__ __forceinline__ unsigned xb_xcc_id() { return (unsigned)__builtin_amdgcn_s_getreg((3 << 11) | 20) & 0xFu; }
#define XB_SPIN(cond, bar) do { unsigned _sp = 0; while (cond) { __builtin_amdgcn_s_sleep(1); \
    if ((++_sp & 255u) == 0u) { if (xb_ld(&(bar)[XB_TMO])) break; if (_sp > XB_SPIN_CAP) { atomicAdd(&(bar)[XB_TMO], 1u); break; } } } } while (0)
struct XcdBarrier { unsigned* bar; unsigned x; volatile LAS unsigned* st; };
__device__ __forceinline__ XcdBarrier xcd_barrier_post(unsigned* bar, volatile LAS unsigned* st) {
    XcdBarrier b; b.bar = bar; b.x = xb_xcc_id(); b.st = st;
    if (threadIdx.x == 0) (void)xb_add(&bar[XB_XCNT(b.x)], 1u);
    return b;
}
__device__ __forceinline__ void xcd_barrier_complete(unsigned* bar, unsigned x, unsigned& nloc, unsigned& nx) {
    const unsigned G = gridDim.x * gridDim.y * gridDim.z;
    unsigned sum, cnt, mine, sp = 0u;
    for (;;) {
        sum = 0u; cnt = 0u; mine = 0u;
#pragma unroll
        for (unsigned j = 0; j < 16; ++j) { const unsigned c = xb_ld(&bar[XB_XCNT(j)]); sum += c; cnt += (c > 0u) ? 1u : 0u; mine = (j == x) ? c : mine; }
        if (sum == G) break;
        __builtin_amdgcn_s_sleep(1);
        if ((++sp & 255u) == 0u) { if (xb_ld(&bar[XB_TMO])) break; if (sp > XB_SPIN_CAP) { atomicAdd(&bar[XB_TMO], 1u); break; } }
    }
    nloc = mine > 0u ? mine : 1u; nx = cnt > 0u ? cnt : 1u;
}
__device__ __forceinline__ void xcd_barrier(const XcdBarrier& b) {
    asm volatile("s_waitcnt vmcnt(0)" ::: "memory");
    __syncthreads();
    if (threadIdx.x == 0) {
        unsigned* bar = b.bar;
        __builtin_amdgcn_s_waitcnt(0);
        unsigned nloc = b.st[0], nx = b.st[1];
        if (nloc == 0u) { xcd_barrier_complete(bar, b.x, nloc, nx); b.st[0] = nloc; b.st[1] = nx; }
        const unsigned old = xb_add(&bar[XB_XSUB(b.x)], 1u);
        const unsigned gen = old / nloc;
        if (old + 1u == (gen + 1u) * nloc) {
            __builtin_amdgcn_fence(__ATOMIC_RELEASE, "agent");
            asm volatile("s_waitcnt vmcnt(0)" ::: "memory");
            const unsigned og = xb_add(&bar[XB_TOP], 1u);
            const unsigned tg = og / nx;
            if (og + 1u == (tg + 1u) * nx) xb_add(&bar[XB_TOPGEN], 1u);
            else XB_SPIN(xb_ld(&bar[XB_TOPGEN]) == tg, bar);
            __builtin_amdgcn_fence(__ATOMIC_ACQUIRE, "agent");
            xb_add(&bar[XB_XGEN(b.x)], 1u);
            asm volatile("s_waitcnt vmcnt(0)" ::: "memory");
        } else {
            XB_SPIN(xb_ld(&bar[XB_XGEN(b.x)]) == gen, bar);
            __builtin_amdgcn_fence(__ATOMIC_ACQUIRE, "agent");
            asm volatile("s_waitcnt vmcnt(0)" ::: "memory");
        }
    }
    __syncthreads();
}

namespace pg8 {
constexpr int BM = 256, BK = 64, HALF = 128, HTB = HALF * BK * 2, STAGE_BYTES = 8 * HTB, NXCD = 8, WGM = 8;
__host__ __device__ __forceinline__ int lds_byte(int r, int c) { const int st = (r >> 4) * 2 + (c >> 5), rr = r & 15, cc = c & 31, ob = rr * 64 + cc * 2; return st * 1024 + (ob ^ (((ob >> 9) & 1) << 5)); }
__host__ __device__ __forceinline__ void stage_rc(int b, int& R, int& C) { const int st = b / 1024, sb = b % 1024, swz = sb ^ (((sb >> 9) & 1) << 5); R = (st >> 1) * 16 + swz / 64; C = (st & 1) * 32 + (swz % 64) / 2; }
__host__ __device__ __forceinline__ int perm32(int rho) { const int n = rho >> 4, i = rho & 15; return 8 * (i >> 2) + 4 * n + (i & 3); }
struct Unit { int pm, pn; };
struct Gemm { const bf16_t* A; const bf16_t* Bt; int M, N, K; };
struct StaticOrder {
    int nM, nN, nwg, G, c;
    __host__ __device__ void init(int M, int N, int G_, int c_) { nM = M / BM; nN = N / BM; nwg = nM * nN; G = G_; c = c_; }
    __host__ __device__ bool next(int i, Unit& u) const {
        const long L = (long)i * G + c; if (L >= nwg) return false;
        int wgid = (int)L; { const int q = nwg / NXCD, r = nwg % NXCD, xcd = wgid % NXCD, off = wgid / NXCD; wgid = (xcd < r ? xcd * (q + 1) : r * (q + 1) + (xcd - r) * q) + off; }
        const int nig = WGM * nN, gid = wgid / nig, fm = gid * WGM, gsz = (nM - fm) < WGM ? (nM - fm) : WGM;
        u.pm = fm + ((wgid % nig) % gsz); u.pn = (wgid % nig) / gsz; return true;
    }
    __device__ __forceinline__ void a_ready(const Unit&) const {}
    __device__ __forceinline__ void done(const Unit&) const {}
};

template <int ACT> struct EpiScaleBf16 {
    static constexpr bool PERM = true;
    bf16_t* O; int ldc; const float* part;
    __device__ __forceinline__ void operator()(const f32x4 (&acc)[2][2][4][2], const Unit& u, int wr, int wc, int fr, int fq) const {
        const int row0 = u.pm * BM + wr * 64 + fr, col0 = u.pn * BM + wc * 32 + 8 * fq;
#pragma unroll
        for (int ai = 0; ai < 2; ++ai)
#pragma unroll
            for (int m = 0; m < 4; ++m) {
                const int row = row0 + ai * HALF + m * 16;
                float sc = 1.0f;
                if (part) { const f32x4* pp = (const f32x4*)(part + (size_t)row * 16); const f32x4 a = pp[0], b = pp[1], c = pp[2], d = pp[3];
                    const float s = ((a.x + a.y) + (a.z + a.w)) + ((b.x + b.y) + (b.z + b.w)) + ((c.x + c.y) + (c.z + c.w)) + ((d.x + d.y) + (d.z + d.w));
                    sc = rsqrtf(s * (1.0f / 1024.0f) + EPS); }
                bf16_t* rowp = O + (size_t)row * ldc + col0;
#pragma unroll
                for (int bj = 0; bj < 2; ++bj) { f32x4 v0 = acc[ai][bj][m][0] * sc, v1 = acc[ai][bj][m][1] * sc;
                    if (ACT == 1) {
#pragma unroll
                        for (int j = 0; j < 4; ++j) { const float a0 = fmaxf(v0[j], 0.f), a1 = fmaxf(v1[j], 0.f); v0[j] = a0 * a0; v1[j] = a1 * a1; } }
                    u32x4 w; w.x = pk2(v0[0], v0[1]); w.y = pk2(v0[2], v0[3]); w.z = pk2(v1[0], v1[1]); w.w = pk2(v1[2], v1[3]);
                    *(u32x4*)(rowp + bj * HALF) = w; }
            }
    }
};
struct EpiResid {
    static constexpr bool PERM = false;
    float* X; bf16_t* XB; float* part; float alpha;
    __device__ __forceinline__ void operator()(const f32x4 (&acc)[2][2][4][2], const Unit& u, int wr, int wc, int fr, int fq) const {
        const int row0 = u.pm * BM + wr * 64 + fr, col0 = u.pn * BM + wc * 32 + 4 * fq;
#pragma unroll
        for (int ai = 0; ai < 2; ++ai)
#pragma unroll
            for (int m = 0; m < 4; ++m) {
                const int row = row0 + ai * HALF + m * 16;
                float* xp = X + (size_t)row * DM + col0; bf16_t* bp = XB + (size_t)row * DM + col0;
                float ss = 0.f;
#pragma unroll
                for (int bj = 0; bj < 2; ++bj)
#pragma unroll
                    for (int n = 0; n < 2; ++n) { const f32x4 v = *(const f32x4*)(xp + bj * HALF + n * 16) + acc[ai][bj][m][n] * alpha;
                        *(f32x4*)(xp + bj * HALF + n * 16) = v; ss += (v.x * v.x + v.y * v.y) + (v.z * v.z + v.w * v.w);
                        u32x2 w; w.x = pk2(v.x, v.y); w.y = pk2(v.z, v.w); *(u32x2*)(bp + bj * HALF + n * 16) = w; }
                ss += __shfl_xor(ss, 16); ss += __shfl_xor(ss, 32);
                if (fq == 0) part[(size_t)row * 16 + u.pn * 4 + wc] = ss;
            }
    }
};

template <class Epi, class Sched>
__device__ __forceinline__ void gemm_phase(LAS unsigned char* lds, const Gemm g, const Sched& S, const Epi& E, const int tid) {
    const int wid = __builtin_amdgcn_readfirstlane(tid >> 6), lane = tid & 63, wr = wid >> 2, wc = wid & 3, fr = lane & 15, fq = lane >> 4;
    const int K = g.K, nt = K / BK;
    unsigned voffA[2], voffB[2];
#pragma unroll
    for (int i = 0; i < 2; ++i) { int R, C; stage_rc(tid * 16 + i * 8192, R, C); const int Rb = Epi::PERM ? ((R & ~31) + perm32(R & 31)) : R;
        voffA[i] = (unsigned)(R * K + C) * 2u; voffB[i] = (unsigned)(Rb * K + C) * 2u; }
    const size_t kstep = (size_t)(BK * 2);
    const size_t hstep = (size_t)HALF * K * 2;
    const size_t tstep = 2 * hstep;
    const unsigned ldsw = (unsigned)wid * 1024u;
    const int aoff = lds_byte(wr * 64 + fr, fq * 8), boff = lds_byte(wc * 32 + fr, fq * 8);
#define PG8_SA(b, h) (((b) * 2 + (h)) * HTB)
#define PG8_SB(b, h) ((4 + (b) * 2 + (h)) * HTB)
#define PG8_STAGE(bufoff, gbase, voff) do { _Pragma("unroll") for (int _i = 0; _i < 2; ++_i) \
        __builtin_amdgcn_global_load_lds((const unsigned*)((const char*)(gbase) + (voff)[_i]), (LAS unsigned*)(lds + (bufoff) + ldsw + _i * 8192), 16, 0, 0); } while (0)
#define PG8_LDA(dst, b, h) do { _Pragma("unroll") for (int m = 0; m < 4; ++m) _Pragma("unroll") for (int k = 0; k < 2; ++k) dst[m][k] = *(const LAS bf16x8*)(lds + PG8_SA(b, h) + aoff + m * 2048 + k * 1024); } while (0)
#define PG8_LDB(dst, b, h) do { _Pragma("unroll") for (int n = 0; n < 2; ++n) _Pragma("unroll") for (int k = 0; k < 2; ++k) dst[n][k] = *(const LAS bf16x8*)(lds + PG8_SB(b, h) + boff + n * 2048 + k * 1024); } while (0)
#define PG8_MMA(ai, bj, At, Bt) do { __builtin_amdgcn_s_setprio(1); _Pragma("unroll") for (int m = 0; m < 4; ++m) _Pragma("unroll") for (int n = 0; n < 2; ++n) _Pragma("unroll") for (int k = 0; k < 2; ++k) \
        acc[ai][bj][m][n] = __builtin_amdgcn_mfma_f32_16x16x32_bf16(Bt[n][k], At[m][k], acc[ai][bj][m][n], 0, 0, 0); __builtin_amdgcn_s_setprio(0); } while (0)
#define PG8_WAIT_V(n) asm volatile("s_waitcnt vmcnt(" #n ")" ::: "memory")
#define PG8_WAIT_L(n) asm volatile("s_waitcnt lgkmcnt(" #n ")" ::: "memory")
#define PG8_BAR __builtin_amdgcn_s_barrier()
#define PG8_SCHED __builtin_amdgcn_sched_barrier(0)
    Unit cur, nxt; int ui = 0;
    if (!S.next(0, cur)) return;
    f32x4 acc[2][2][4][2];
#pragma unroll
    for (int a = 0; a < 2; ++a)
#pragma unroll
        for (int b = 0; b < 2; ++b)
#pragma unroll
            for (int m = 0; m < 4; ++m)
#pragma unroll
                for (int n = 0; n < 2; ++n) acc[a][b][m][n] = (f32x4){0.f, 0.f, 0.f, 0.f};
    bf16x8 At[4][2], B0[2][2], B1[2][2];
    const char* cA = (const char*)g.A + (size_t)cur.pm * tstep; const char* cB = (const char*)g.Bt + (size_t)cur.pn * tstep;
    S.a_ready(cur);
    PG8_STAGE(PG8_SB(0, 0), cB, voffB); PG8_STAGE(PG8_SA(0, 0), cA, voffA); PG8_STAGE(PG8_SB(0, 1), cB + hstep, voffB); PG8_STAGE(PG8_SA(0, 1), cA + hstep, voffA);
    if (wr == 1) PG8_BAR;
    PG8_WAIT_V(4); PG8_BAR;
    PG8_STAGE(PG8_SB(1, 0), cB + kstep, voffB); PG8_STAGE(PG8_SA(1, 0), cA + kstep, voffA); PG8_STAGE(PG8_SB(1, 1), cB + hstep + kstep, voffB);
    PG8_WAIT_V(6); PG8_BAR;
    for (;;) {
        const bool has_next = S.next(ui + 1, nxt);
        const char* nA = has_next ? (const char*)g.A + (size_t)nxt.pm * tstep : cA; const char* nB = has_next ? (const char*)g.Bt + (size_t)nxt.pn * tstep : cB;
        for (int t = 0; t < nt; t += 2) {
            const bool last = (t == nt - 2);
            const char* a1 = cA + (size_t)(t + 1) * kstep;
            const char* a2 = last ? nA : cA + (size_t)(t + 2) * kstep; const char* b2 = last ? nB : cB + (size_t)(t + 2) * kstep;
            const char* a3 = a2 + kstep; const char* b3 = b2 + kstep;
            if (last && has_next) S.a_ready(nxt);
            PG8_LDB(B0, 0, 0); PG8_SCHED; PG8_LDA(At, 0, 0); PG8_STAGE(PG8_SA(1, 1), a1 + hstep, voffA);
            PG8_WAIT_L(8); PG8_BAR; PG8_WAIT_L(0); PG8_MMA(0, 0, At, B0); PG8_BAR; PG8_SCHED;
            PG8_LDB(B1, 0, 1); PG8_STAGE(PG8_SB(0, 0), b2, voffB);
            PG8_BAR; PG8_WAIT_L(0); PG8_MMA(0, 1, At, B1); PG8_BAR;
            PG8_LDA(At, 0, 1); PG8_STAGE(PG8_SA(0, 0), a2, voffA);
            PG8_BAR; PG8_WAIT_L(0); PG8_MMA(1, 0, At, B0); PG8_BAR; PG8_SCHED;
            PG8_STAGE(PG8_SB(0, 1), b2 + hstep, voffB);
            PG8_WAIT_V(6); PG8_BAR; PG8_MMA(1, 1, At, B1); PG8_BAR;
            PG8_LDB(B0, 1, 0); PG8_SCHED; PG8_LDA(At, 1, 0); PG8_STAGE(PG8_SA(0, 1), a2 + hstep, voffA);
            PG8_WAIT_L(8); PG8_BAR; PG8_WAIT_L(0); PG8_MMA(0, 0, At, B0); PG8_BAR; PG8_SCHED;
            PG8_LDB(B1, 1, 1); PG8_STAGE(PG8_SB(1, 0), b3, voffB);
            PG8_BAR; PG8_WAIT_L(0); PG8_MMA(0, 1, At, B1); PG8_BAR;
            PG8_LDA(At, 1, 1); PG8_STAGE(PG8_SA(1, 0), a3, voffA);
            PG8_BAR; PG8_WAIT_L(0); PG8_MMA(1, 0, At, B0); PG8_BAR; PG8_SCHED;
            PG8_STAGE(PG8_SB(1, 1), b3 + hstep, voffB);
            PG8_WAIT_V(6); PG8_BAR; PG8_MMA(1, 1, At, B1); PG8_BAR;
        }
        E(acc, cur, wr, wc, fr, fq); S.done(cur);
        if (!has_next) break;
#pragma unroll
        for (int a = 0; a < 2; ++a)
#pragma unroll
            for (int b = 0; b < 2; ++b)
#pragma unroll
                for (int m = 0; m < 4; ++m)
#pragma unroll
                    for (int n = 0; n < 2; ++n) acc[a][b][m][n] = (f32x4){0.f, 0.f, 0.f, 0.f};
        cur = nxt; cA = nA; cB = nB; ++ui;
    }
    PG8_WAIT_V(0);
    if (wr == 0) PG8_BAR;
    PG8_BAR;
#undef PG8_SA
#undef PG8_SB
#undef PG8_STAGE
#undef PG8_LDA
#undef PG8_LDB
#undef PG8_MMA
#undef PG8_WAIT_V
#undef PG8_WAIT_L
#undef PG8_BAR
#undef PG8_SCHED
}
}

struct Params {
    const float* x; const float* mem; const int* pos;
    const float* norm_mix; const float* w_in; const float* ret_gn;
    const float* lru_conv_w; const float* lru_conv_b; const float* lru_wa; const float* lru_ba; const float* lru_wx; const float* lru_bx; const float* lru_lambda;
    const float* mla_q_norm; const float* mla_w_uq; const float* mla_kv_norm; const float* mla_w_ukv;
    const float* gdn_conv_w; const float* gdn_a_log; const float* gdn_dt_bias; const float* gdn_norm;
    const float* w_out; const float* norm_xattn; const float* norm_mem; const float* xa_wq; const float* xa_wkv; const float* xa_wo;
    const float* norm_mlp; const float* mlp_w1; const float* mlp_w2; const float* final_norm;
    float* out; unsigned char* ws;
    int ph_lo, ph_hi;
};

__device__ __forceinline__ bf16_t* wl(const Params& P, int l, size_t off) { return (bf16_t*)(P.ws + WS_W) + (size_t)l * W_LAYER + off; }

__device__ __forceinline__ void transpose_tile(const float* src, int K, int N, const float* gain, float scale, bf16_t* dst, int kb, int nb, LAS float* scr, int tid) {
#pragma unroll
    for (int i = 0; i < 8; ++i) { const int kk = (tid >> 6) + 8 * i, k = kb * 64 + kk, n = nb * 64 + (tid & 63);
        float v = 0.f; if (n < N) { v = src[(size_t)k * N + n] * scale; if (gain) v *= gain[k]; }
        scr[kk * 65 + (tid & 63)] = v; }
    __syncthreads();
    { const int nl = tid >> 3, k0 = (tid & 7) * 8; const LAS float* s = scr + k0 * 65 + nl;
      u32x4 o; o.x = pk2(s[0], s[65]); o.y = pk2(s[2 * 65], s[3 * 65]); o.z = pk2(s[4 * 65], s[5 * 65]); o.w = pk2(s[6 * 65], s[7 * 65]);
      *(u32x4*)(dst + (size_t)(nb * 64 + nl) * K + kb * 64 + k0) = o; }
    __syncthreads();
}
__device__ __forceinline__ void p0_prologue(const Params& P, LAS unsigned char* lds, int tid) {
    LAS float* scr = (LAS float*)lds;
    constexpr int T_IN = 16 * 48, T_SQ = 256, T_KV = 512, T_W1 = 1024, T_W2 = 1024, T_UQ = 18, T_UKV = 16, T_LRU = 8;
    constexpr int T_LAYER = T_IN + 3 * T_SQ + T_KV + T_W1 + T_W2 + T_UQ + T_UKV + T_LRU;
    for (int it = blockIdx.x; it < 2 * T_LAYER; it += gridDim.x) {
        const int l = it / T_LAYER; int r = it % T_LAYER;
        const float* src; const float* gain = nullptr; float scale = 1.f; bf16_t* dst; int K, N, nnb;
        if (r < T_IN) { src = P.w_in + (size_t)l * DM * IN_COLS; K = DM; N = IN_COLS; nnb = 48; gain = P.norm_mix + l * DM; dst = wl(P, l, W_IN); }
        else if ((r -= T_IN) < T_SQ) { src = P.w_out + (size_t)l * DM * DM; K = DM; N = DM; nnb = 16; dst = wl(P, l, W_OUT); }
        else if ((r -= T_SQ) < T_SQ) { src = P.xa_wq + (size_t)l * DM * DM; K = DM; N = DM; nnb = 16; gain = P.norm_xattn + l * DM; scale = 0.0625f * LOG2E; dst = wl(P, l, W_Q); }
        else if ((r -= T_SQ) < T_KV) { src = P.xa_wkv + (size_t)l * DM * 2 * DM; K = DM; N = 2 * DM; nnb = 32; gain = P.norm_mem + l * DM; dst = wl(P, l, W_KV); }
        else if ((r -= T_KV) < T_SQ) { src = P.xa_wo + (size_t)l * DM * DM; K = DM; N = DM; nnb = 16; dst = wl(P, l, W_O); }
        else if ((r -= T_SQ) < T_W1) { src = P.mlp_w1 + (size_t)l * DM * DFF; K = DM; N = DFF; nnb = 64; gain = P.norm_mlp + l * DM; dst = wl(P, l, W_1); }
        else if ((r -= T_W1) < T_W2) { src = P.mlp_w2 + (size_t)l * DFF * DM; K = DFF; N = DM; nnb = 16; dst = wl(P, l, W_2); }
        else if ((r -= T_W2) < T_UQ) { src = P.mla_w_uq + (size_t)l * 192 * 384; K = 192; N = 384; nnb = 6; gain = P.mla_q_norm + l * 192; dst = wl(P, l, W_UQ); }
        else if ((r -= T_UQ) < T_UKV) { src = P.mla_w_ukv + (size_t)l * 128 * 512; K = 128; N = 512; nnb = 8; gain = P.mla_kv_norm + l * 128; dst = wl(P, l, W_UKV); }
        else { r -= T_UKV; const int which = r >> 2, nb4 = r & 3; src = (which ? P.lru_wx : P.lru_wa) + (size_t)l * 4 * 4096 + nb4 * 4096; K = 64; N = 64; nnb = 1; dst = wl(P, l, which ? W_X : W_A) + nb4 * 4096; r = 0; }
        transpose_tile(src, K, N, gain, scale, dst, r / nnb, r % nnb, scr, tid);
    }
    const int wave = tid >> 6, lane = tid & 63;
    const int gw = blockIdx.x * 8 + wave, ngw = gridDim.x * 8;
    bf16_t* xb = (bf16_t*)(P.ws + WS_XB); float* part = (float*)(P.ws + WS_PART); bf16_t* memn = (bf16_t*)(P.ws + WS_GDN);
    for (int row = gw; row < T_TOK + NBATCH * NMEM; row += ngw) {
        const bool isx = row < T_TOK; const int r2 = isx ? row : row - T_TOK;
        const f32x4* src = (const f32x4*)((isx ? P.x : P.mem) + (size_t)r2 * DM) + lane;
        f32x4 v[4]; float s = 0.f;
#pragma unroll
        for (int j = 0; j < 4; ++j) { v[j] = src[64 * j]; s += (v[j].x * v[j].x + v[j].y * v[j].y) + (v[j].z * v[j].z + v[j].w * v[j].w); }
        s = wave_sum(s);
        if (isx) {
            f32x4* o = (f32x4*)(P.out + (size_t)row * DM) + lane; u32x2* ob = (u32x2*)(xb + (size_t)row * DM) + lane;
#pragma unroll
            for (int j = 0; j < 4; ++j) { o[64 * j] = v[j]; u32x2 w; w.x = pk2(v[j].x, v[j].y); w.y = pk2(v[j].z, v[j].w); ob[64 * j] = w; }
            if (lane < 16) part[(size_t)row * 16 + lane] = lane == 0 ? s : 0.f;
        } else {
            const float rs = rsqrtf(s * (1.0f / 1024.0f) + EPS); u32x2* ob = (u32x2*)(memn + (size_t)r2 * DM) + lane;
#pragma unroll
            for (int j = 0; j < 4; ++j) { u32x2 w; w.x = pk2(v[j].x * rs, v[j].y * rs); w.y = pk2(v[j].z * rs, v[j].w * rs); ob[64 * j] = w; }
        }
    }
}
__device__ __forceinline__ void final_norm_phase(const Params& P, int tid) {
    const int wave = tid >> 6, lane = tid & 63; const float* part = (const float*)(P.ws + WS_PART);
    f32x4 g[4];
#pragma unroll
    for (int j = 0; j < 4; ++j) g[j] = ((const f32x4*)P.final_norm)[64 * j + lane];
    for (int row = blockIdx.x * 8 + wave; row < T_TOK; row += gridDim.x * 8) {
        float s = lane < 16 ? part[(size_t)row * 16 + lane] : 0.f; s = wave_sum(s);
        const float rs = rsqrtf(s * (1.0f / 1024.0f) + EPS);
        f32x4* o = (f32x4*)(P.out + (size_t)row * DM) + lane;
#pragma unroll
        for (int j = 0; j < 4; ++j) { f32x4 v = o[64 * j]; o[64 * j] = v * rs * g[j]; }
    }
}

__device__ __forceinline__ void mla_pre_tile(const Params& P, int l, int rt, int lane) {
    const int fr = lane & 15, fq = lane >> 4;
    const bf16_t* z = (const bf16_t*)(P.ws + WS_R);
    bf16_t* Qo = (bf16_t*)(P.ws + WS_XB + MLA_Q_OFF); bf16_t* Ko = (bf16_t*)(P.ws + WS_XB + MLA_K_OFF); bf16_t* Vo = (bf16_t*)(P.ws + WS_XB + MLA_VT_OFF);
    const bf16_t* Wuq = wl(P, l, W_UQ); const bf16_t* Wukv = wl(P, l, W_UKV);
    const int tok0 = rt * 16, b = tok0 >> 11, s0 = tok0 & 2047;
    const bf16_t* zr = z + (size_t)(tok0 + fr) * ZP;
    bf16x8 cq[6], ckv[4]; float sq = 0.f, skv = 0.f;
#pragma unroll
    for (int s = 0; s < 6; ++s) { const u32x4 w = *(const u32x4*)(zr + Z_CQ + 32 * s + 8 * fq); cq[s] = __builtin_bit_cast(bf16x8, w);
        sq += bflo(w.x) * bflo(w.x) + bfhi(w.x) * bfhi(w.x) + bflo(w.y) * bflo(w.y) + bfhi(w.y) * bfhi(w.y) + bflo(w.z) * bflo(w.z) + bfhi(w.z) * bfhi(w.z) + bflo(w.w) * bflo(w.w) + bfhi(w.w) * bfhi(w.w); }
#pragma unroll
    for (int s = 0; s < 4; ++s) { const u32x4 w = *(const u32x4*)(zr + Z_CKV + 32 * s + 8 * fq); ckv[s] = __builtin_bit_cast(bf16x8, w);
        skv += bflo(w.x) * bflo(w.x) + bfhi(w.x) * bfhi(w.x) + bflo(w.y) * bflo(w.y) + bfhi(w.y) * bfhi(w.y) + bflo(w.z) * bflo(w.z) + bfhi(w.z) * bfhi(w.z) + bflo(w.w) * bflo(w.w) + bfhi(w.w) * bfhi(w.w); }
    sq += __shfl_xor(sq, 16); sq += __shfl_xor(sq, 32); skv += __shfl_xor(skv, 16); skv += __shfl_xor(skv, 32);
    const float rq = rsqrtf(sq * (1.0f / 192.0f) + EPS), rkv = rsqrtf(skv * (1.0f / 128.0f) + EPS);
    const float qsc = rq * 0.10206207261596575f * LOG2E;
    const float pos = (float)P.pos[tok0 + fr];
    float sn[4], cs[4];
#pragma unroll
    for (int r = 0; r < 4; ++r) { const float invf = exp2f(-(float)(4 * fq + r) * (13.287712379549449f / 16.0f)); sincos_rev(pos * invf, sn[r], cs[r]); }
    const size_t tokrow = (size_t)b * 4 * SEQ + (s0 + fr);
#pragma unroll 1
    for (int h = 0; h < 4; ++h) {
        bf16_t* qrow = Qo + (tokrow + (size_t)h * SEQ) * 96;
#pragma unroll 1
        for (int nt = 0; nt < 4; ++nt) { f32x4 a = {0.f, 0.f, 0.f, 0.f};
#pragma unroll
            for (int s = 0; s < 6; ++s) { const bf16x8 wf = *(const bf16x8*)(Wuq + (size_t)(h * 96 + nt * 16 + fr) * 192 + 32 * s + 8 * fq); a = mfma16(wf, cq[s], a); }
            a = a * qsc; u32x2 w; w.x = pk2(a.x, a.y); w.y = pk2(a.z, a.w); *(u32x2*)(qrow + nt * 16 + 4 * fq) = w; }
        f32x4 x1 = {0.f, 0.f, 0.f, 0.f}, x2 = {0.f, 0.f, 0.f, 0.f}, y1, y2;
#pragma unroll
        for (int s = 0; s < 6; ++s) { const bf16x8 wf1 = *(const bf16x8*)(Wuq + (size_t)(h * 96 + 64 + fr) * 192 + 32 * s + 8 * fq), wf2 = *(const bf16x8*)(Wuq + (size_t)(h * 96 + 80 + fr) * 192 + 32 * s + 8 * fq);
            x1 = mfma16(wf1, cq[s], x1); x2 = mfma16(wf2, cq[s], x2); }
        x1 = x1 * qsc; x2 = x2 * qsc;
#pragma unroll
        for (int r = 0; r < 4; ++r) { y1[r] = x1[r] * cs[r] - x2[r] * sn[r]; y2[r] = x1[r] * sn[r] + x2[r] * cs[r]; }
        { u32x2 w; w.x = pk2(y1.x, y1.y); w.y = pk2(y1.z, y1.w); *(u32x2*)(qrow + 64 + 4 * fq) = w; w.x = pk2(y2.x, y2.y); w.y = pk2(y2.z, y2.w); *(u32x2*)(qrow + 80 + 4 * fq) = w; }
    }
    u32x2 kr1, kr2;
    { const u32x2 a = *(const u32x2*)(zr + Z_KR + 4 * fq), c = *(const u32x2*)(zr + Z_KR + 16 + 4 * fq);
      const float x1[4] = {bflo(a.x), bfhi(a.x), bflo(a.y), bfhi(a.y)}, x2[4] = {bflo(c.x), bfhi(c.x), bflo(c.y), bfhi(c.y)}; float y1[4], y2[4];
#pragma unroll
      for (int r = 0; r < 4; ++r) { y1[r] = x1[r] * cs[r] - x2[r] * sn[r]; y2[r] = x1[r] * sn[r] + x2[r] * cs[r]; }
      kr1.x = pk2(y1[0], y1[1]); kr1.y = pk2(y1[2], y1[3]); kr2.x = pk2(y2[0], y2[1]); kr2.y = pk2(y2[2], y2[3]); }
    float rkv_r[4];
#pragma unroll
    for (int r = 0; r < 4; ++r) rkv_r[r] = __shfl(rkv, 4 * fq + r);
    const int chunk = s0 >> 6, key0 = (s0 & 63) + 4 * fq;
#pragma unroll 1
    for (int h = 0; h < 4; ++h) {
        bf16_t* krow = Ko + (tokrow + (size_t)h * SEQ) * 96;
#pragma unroll 1
        for (int nt = 0; nt < 4; ++nt) { f32x4 a = {0.f, 0.f, 0.f, 0.f};
#pragma unroll
            for (int s = 0; s < 4; ++s) { const bf16x8 wf = *(const bf16x8*)(Wukv + (size_t)(h * 128 + nt * 16 + fr) * 128 + 32 * s + 8 * fq); a = mfma16(wf, ckv[s], a); }
            a = a * rkv; u32x2 w; w.x = pk2(a.x, a.y); w.y = pk2(a.z, a.w); *(u32x2*)(krow + nt * 16 + 4 * fq) = w; }
        *(u32x2*)(krow + 64 + 4 * fq) = kr1; *(u32x2*)(krow + 80 + 4 * fq) = kr2;
        bf16_t* vt = Vo + ((size_t)((b * 4 + h) * NCHUNK + chunk) * 64) * 64;
#pragma unroll 1
        for (int nt = 0; nt < 4; ++nt) { f32x4 a = {0.f, 0.f, 0.f, 0.f};
#pragma unroll
            for (int s = 0; s < 4; ++s) { const bf16x8 wf = *(const bf16x8*)(Wukv + (size_t)(h * 128 + 64 + nt * 16 + fr) * 128 + 32 * s + 8 * fq); a = mfma16(ckv[s], wf, a); }
            u32x2 w; w.x = pk2(a.x * rkv_r[0], a.y * rkv_r[1]); w.y = pk2(a.z * rkv_r[2], a.w * rkv_r[3]);
            *(u32x2*)(vt + (size_t)(nt * 16 + fr) * 64 + key0) = w; }
    }
}

template <int DQK, int DV>
__device__ __forceinline__ void flash_item(LAS unsigned char* lds, const bf16_t* Qw, int ldq, const bf16_t* Kb, int ldk, const bf16_t* VTb, int ldv, int vts,
                                           bf16_t* Ow, int ldo, int ntiles, int wave_limit, int tid, int lane) {
    constexpr int KROW = DQK + 8, KS = DQK / 32, ET = DV / 16;
    LAS bf16_t* Kt = (LAS bf16_t*)lds; LAS bf16_t* Vt = (LAS bf16_t*)(lds + 64 * KROW * 2);
    const int fr = lane & 15, fq = lane >> 4;
    bf16x8 qf[KS];
#pragma unroll
    for (int s = 0; s < KS; ++s) qf[s] = *(const bf16x8*)(Qw + (size_t)fr * ldq + 32 * s + 8 * fq);
    f32x4 ot[ET];
#pragma unroll
    for (int e = 0; e < ET; ++e) ot[e] = (f32x4){0.f, 0.f, 0.f, 0.f};
    float m_run = -1e30f, l_run = 0.f;
    for (int j = 0; j < ntiles; ++j) {
        __syncthreads();
        constexpr int KP = 64 * DQK / 8;
#pragma unroll
        for (int i = 0; i < (KP + 511) / 512; ++i) { const int idx = tid + i * 512; if (idx < KP) { const int row = idx / (DQK / 8), pc = idx % (DQK / 8);
            *(LAS u32x4*)(Kt + row * KROW + pc * 8) = *(const u32x4*)(Kb + (size_t)(j * 64 + row) * ldk + pc * 8); } }
        constexpr int VP = DV * 8;
#pragma unroll
        for (int i = 0; i < (VP + 511) / 512; ++i) { const int idx = tid + i * 512; if (idx < VP) { const int row = idx >> 3, pc = idx & 7;
            *(LAS u32x4*)(Vt + row * 72 + pc * 8) = *(const u32x4*)(VTb + (size_t)j * vts + (size_t)row * ldv + pc * 8); } }
        __syncthreads();
        if (j < wave_limit) {
            f32x4 st[4];
#pragma unroll
            for (int kt = 0; kt < 4; ++kt) { f32x4 a = {0.f, 0.f, 0.f, 0.f};
#pragma unroll
                for (int s = 0; s < KS; ++s) { const bf16x8 kf = *(const LAS bf16x8*)(Kt + (kt * 16 + fr) * KROW + 32 * s + 8 * fq); a = mfma16(kf, qf[s], a); }
                st[kt] = a; }
            float mx = fmaxf(fmaxf(fmaxf(st[0].x, st[0].y), fmaxf(st[0].z, st[0].w)), fmaxf(fmaxf(st[1].x, st[1].y), fmaxf(st[1].z, st[1].w)));
            mx = fmaxf(mx, fmaxf(fmaxf(fmaxf(st[2].x, st[2].y), fmaxf(st[2].z, st[2].w)), fmaxf(fmaxf(st[3].x, st[3].y), fmaxf(st[3].z, st[3].w))));
            mx = fmaxf(mx, __shfl_xor(mx, 16)); mx = fmaxf(mx, __shfl_xor(mx, 32));
            const float m_new = fmaxf(m_run, mx), alpha = exp2f(m_run - m_new);
            float ls = 0.f;
#pragma unroll
            for (int kt = 0; kt < 4; ++kt)
#pragma unroll
                for (int r = 0; r < 4; ++r) { const float p = exp2f(st[kt][r] - m_new); st[kt][r] = p; ls += p; }
            l_run = l_run * alpha + ls; m_run = m_new;
#pragma unroll
            for (int e = 0; e < ET; ++e) ot[e] = ot[e] * alpha;
            const bf16x8 pf0 = pack8(st[0], st[1]), pf1 = pack8(st[2], st[3]);
#pragma unroll
            for (int e = 0; e < ET; ++e) {
                const LAS bf16_t* vr = Vt + (e * 16 + fr) * 72 + 4 * fq;
                const bf16x8 v0 = mk8(*(const LAS u32x2*)(vr), *(const LAS u32x2*)(vr + 16)), v1 = mk8(*(const LAS u32x2*)(vr + 32), *(const LAS u32x2*)(vr + 48));
                ot[e] = mfma16(v0, pf0, ot[e]); ot[e] = mfma16(v1, pf1, ot[e]); }
        }
    }
    l_run += __shfl_xor(l_run, 16); l_run += __shfl_xor(l_run, 32);
    const float inv = 1.0f / l_run;
#pragma unroll
    for (int e = 0; e < ET; ++e) { u32x2 w; w.x = pk2(ot[e].x * inv, ot[e].y * inv); w.y = pk2(ot[e].z * inv, ot[e].w * inv);
        *(u32x2*)(Ow + (size_t)fr * ldo + e * 16 + 4 * fq) = w; }
}
__device__ __forceinline__ void mla_attn_item(const Params& P, LAS unsigned char* lds, int it, int tid, int wave, int lane) {
    const int qt = 15 - (it >> 6), bh = it & 63;
    const bf16_t* Q = (const bf16_t*)(P.ws + WS_XB + MLA_Q_OFF) + ((size_t)bh * SEQ + qt * 128 + wave * 16) * 96;
    const bf16_t* K = (const bf16_t*)(P.ws + WS_XB + MLA_K_OFF) + (size_t)bh * SEQ * 96;
    const bf16_t* VT = (const bf16_t*)(P.ws + WS_XB + MLA_VT_OFF) + (size_t)bh * NCHUNK * 4096;
    bf16_t* y = (bf16_t*)(P.ws + WS_R + R_Y) + ((size_t)(bh >> 2) * SEQ + qt * 128 + wave * 16) * DM + 512 + (bh & 3) * 64;
    flash_item<96, 64>(lds, Q, 96, K, 96, VT, 64, 4096, y, DM, 2 * qt + 2, 2 * qt + (wave >> 2) + 1, tid, lane);
}
__device__ __forceinline__ void xa_item(const Params& P, int l, LAS unsigned char* lds, int it, int tid, int wave, int lane) {
    const int qt = it & 15, h = (it >> 4) & 3, b = it >> 6;
    const size_t qoff = ((size_t)b * SEQ + qt * 128 + wave * 16) * DM + h * 256;
    const bf16_t* Q = (const bf16_t*)(P.ws + WS_R) + qoff; bf16_t* O = (bf16_t*)(P.ws + WS_R + R_OX) + qoff;
    const bf16_t* K = (const bf16_t*)(P.ws + WS_KVM + (size_t)l * KVM_LAYER) + (size_t)b * NMEM * DM + h * 256;
    const bf16_t* VT = (const bf16_t*)(P.ws + WS_KVM + (size_t)l * KVM_LAYER + (size_t)4096 * 1024 * 2) + (size_t)h * 256 * 4096 + b * NMEM;
    flash_item<256, 256>(lds, Q, DM, K, DM, VT, 4096, 64, O, DM, 4, 4, tid, lane);
}

constexpr int GP_KN = 0, GP_KB = 9216, GP_QN = 18432, GP_L = 9216, GP_RHS = 27648, GP_G = 60416, GP_GC = 60672, GP_HEAD = 61440;
__device__ __forceinline__ bf16_t* gdn_buf(const Params& P, int chh, int k) { return (bf16_t*)(P.ws + WS_GDN) + ((size_t)chh * 5 + k) * 4096; }
__device__ __forceinline__ void gdn_pre_item(const Params& P, int l, LAS unsigned char* lds, int it, int tid) {
    const int hp = it & 1, n = (it >> 1) & 31, b = it >> 6;
    const int hh = tid >> 8, h = 2 * hp + hh, tt = tid & 255, c = tt >> 2, qr = tt & 3, lane = tid & 63;
    LAS unsigned char* L = lds + hh * GP_HEAD;
    const bf16_t* z = (const bf16_t*)(P.ws + WS_R);
    const int s = n * 64 + c; const size_t tok = (size_t)b * SEQ + s;
    const float* cw = P.gdn_conv_w + (size_t)l * 4 * 768;
    const int chh = (b * NCHUNK + n) * 4 + h;
    float q[16], k[16], v[16];
#pragma unroll
    for (int part = 0; part < 3; ++part) {
        float* dst = part == 0 ? q : (part == 1 ? k : v);
        const int ch0 = part * 256 + h * 64 + qr * 16;
#pragma unroll
        for (int i = 0; i < 16; ++i) dst[i] = 0.f;
#pragma unroll
        for (int kk = 0; kk < 4; ++kk) { if (s - 3 + kk >= 0) {
            const bf16_t* zr = z + (tok - 3 + kk) * ZP + Z_GQKV + ch0; const u32x4 w0 = *(const u32x4*)zr, w1 = *(const u32x4*)(zr + 8);
            const float* wr = cw + kk * 768 + ch0; const f32x4 c0 = *(const f32x4*)wr, c1 = *(const f32x4*)(wr + 4), c2 = *(const f32x4*)(wr + 8), c3 = *(const f32x4*)(wr + 12);
            dst[0] += c0.x * bflo(w0.x); dst[1] += c0.y * bfhi(w0.x); dst[2] += c0.z * bflo(w0.y); dst[3] += c0.w * bfhi(w0.y);
            dst[4] += c1.x * bflo(w0.z); dst[5] += c1.y * bfhi(w0.z); dst[6] += c1.z * bflo(w0.w); dst[7] += c1.w * bfhi(w0.w);
            dst[8] += c2.x * bflo(w1.x); dst[9] += c2.y * bfhi(w1.x); dst[10] += c2.z * bflo(w1.y); dst[11] += c2.w * bfhi(w1.y);
            dst[12] += c3.x * bflo(w1.z); dst[13] += c3.y * bfhi(w1.z); dst[14] += c3.z * bflo(w1.w); dst[15] += c3.w * bfhi(w1.w); } }
#pragma unroll
        for (int i = 0; i < 16; ++i) dst[i] = siluf_(dst[i]);
    }
    float sq = 0.f, sk = 0.f;
#pragma unroll
    for (int i = 0; i < 16; ++i) { sq += q[i] * q[i]; sk += k[i] * k[i]; }
    sq += __shfl_xor(sq, 1); sq += __shfl_xor(sq, 2); sk += __shfl_xor(sk, 1); sk += __shfl_xor(sk, 2);
    const float rq = rsqrtf(sq + EPS) * 0.125f, rk = rsqrtf(sk + EPS);
    const bf16_t* zt = z + tok * ZP;
    const float beta = sigmoidf_(bf2f(zt[Z_GB + h]));
    const float g = -__expf(P.gdn_a_log[l * 4 + h]) * softplusf_(bf2f(zt[Z_GA + h]) + P.gdn_dt_bias[l * 4 + h]);
    {
        u32x4 w0, w1;
#define PK16(dst0, dst1, src, sc) do { dst0.x = pk2(src[0] * (sc), src[1] * (sc)); dst0.y = pk2(src[2] * (sc), src[3] * (sc)); dst0.z = pk2(src[4] * (sc), src[5] * (sc)); dst0.w = pk2(src[6] * (sc), src[7] * (sc)); \
        dst1.x = pk2(src[8] * (sc), src[9] * (sc)); dst1.y = pk2(src[10] * (sc), src[11] * (sc)); dst1.z = pk2(src[12] * (sc), src[13] * (sc)); dst1.w = pk2(src[14] * (sc), src[15] * (sc)); } while (0)
        PK16(w0, w1, k, rk);        *(LAS u32x4*)(L + GP_KN + (c * 72 + qr * 16) * 2) = w0; *(LAS u32x4*)(L + GP_KN + (c * 72 + qr * 16 + 8) * 2) = w1;
        PK16(w0, w1, k, rk * beta); *(LAS u32x4*)(L + GP_KB + (c * 72 + qr * 16) * 2) = w0; *(LAS u32x4*)(L + GP_KB + (c * 72 + qr * 16 + 8) * 2) = w1;
        PK16(w0, w1, q, rq);        *(LAS u32x4*)(L + GP_QN + (c * 72 + qr * 16) * 2) = w0; *(LAS u32x4*)(L + GP_QN + (c * 72 + qr * 16 + 8) * 2) = w1;
        LAS float* rhs = (LAS float*)(L + GP_RHS) + c * 128 + qr * 16;
#pragma unroll
        for (int i = 0; i < 4; ++i) *(LAS f32x4*)(rhs + 4 * i) = (f32x4){v[4 * i] * beta, v[4 * i + 1] * beta, v[4 * i + 2] * beta, v[4 * i + 3] * beta};
        if (qr == 0) ((LAS float*)(L + GP_G))[c] = g;
    }
    __syncthreads();
    {
        float gc = 0.f, run = 0.f; const LAS float* G = (const LAS float*)(L + GP_G);
        for (int i = 0; i < 64; ++i) { run += G[i]; gc = (i == c) ? run : gc; }
        const float eg = __expf(gc), ek = __expf(run - gc);
        LAS float* rhs = (LAS float*)(L + GP_RHS) + c * 128 + 64 + qr * 16;
#pragma unroll
        for (int i = 0; i < 4; ++i) *(LAS f32x4*)(rhs + 4 * i) = (f32x4){k[4 * i] * rk * beta * eg, k[4 * i + 1] * rk * beta * eg, k[4 * i + 2] * rk * beta * eg, k[4 * i + 3] * rk * beta * eg};
        u32x4 w0, w1; PK16(w0, w1, q, rq * eg);
        bf16_t* qd = gdn_buf(P, chh, 3) + c * 64 + qr * 16; *(u32x4*)qd = w0; *(u32x4*)(qd + 8) = w1;
        bf16_t* kdt = gdn_buf(P, chh, 4) + (qr * 16) * 64 + c;
#pragma unroll
        for (int i = 0; i < 16; ++i) kdt[i * 64] = f2bf(k[i] * rk * ek);
        if (qr == 0) ((LAS float*)(L + GP_GC))[c] = gc;
        if (tt == 0) ((float*)(P.ws + WS_GL))[chh] = __expf(run);
    }
#undef PK16
    __syncthreads();
    {
        const int it4 = (tid >> 6) & 3, fr = lane & 15, fq = lane >> 4;
        const LAS bf16_t* Kn = (const LAS bf16_t*)(L + GP_KN); const LAS bf16_t* KB = (const LAS bf16_t*)(L + GP_KB); const LAS bf16_t* Qn = (const LAS bf16_t*)(L + GP_QN);
        const LAS float* GC = (const LAS float*)(L + GP_GC);
        const bf16x8 a0 = *(const LAS bf16x8*)(KB + (it4 * 16 + fr) * 72 + 8 * fq), a1 = *(const LAS bf16x8*)(KB + (it4 * 16 + fr) * 72 + 32 + 8 * fq);
        const bf16x8 q0 = *(const LAS bf16x8*)(Qn + (it4 * 16 + fr) * 72 + 8 * fq), q1 = *(const LAS bf16x8*)(Qn + (it4 * 16 + fr) * 72 + 32 + 8 * fq);
        float gci[4];
#pragma unroll
        for (int r = 0; r < 4; ++r) gci[r] = GC[it4 * 16 + 4 * fq + r];
        f32x4 lv[4]; bf16_t* att = gdn_buf(P, chh, 2);
#pragma unroll
        for (int jt = 0; jt < 4; ++jt) {
            const bf16x8 b0 = *(const LAS bf16x8*)(Kn + (jt * 16 + fr) * 72 + 8 * fq), b1 = *(const LAS bf16x8*)(Kn + (jt * 16 + fr) * 72 + 32 + 8 * fq);
            f32x4 al = {0.f, 0.f, 0.f, 0.f}, aa = {0.f, 0.f, 0.f, 0.f};
            al = mfma16(a0, b0, al); al = mfma16(a1, b1, al); aa = mfma16(q0, b0, aa); aa = mfma16(q1, b1, aa);
            const int j = jt * 16 + fr; const float gcj = GC[j];
#pragma unroll
            for (int r = 0; r < 4; ++r) { const int i = it4 * 16 + 4 * fq + r; const float dec = __expf(fminf(gci[r] - gcj, 0.f));
                lv[jt][r] = (i > j) ? al[r] * dec : 0.f; att[i * 64 + j] = f2bf((i >= j) ? aa[r] * dec : 0.f); }
        }
        __syncthreads();
        LAS float* Lm = (LAS float*)(L + GP_L);
#pragma unroll
        for (int jt = 0; jt < 4; ++jt)
#pragma unroll
            for (int r = 0; r < 4; ++r) Lm[(it4 * 16 + 4 * fq + r) * 64 + jt * 16 + fr] = lv[jt][r];
    }
    __syncthreads();
    if (tt < 128) {
        const LAS float* Lm = (const LAS float*)(L + GP_L); const LAS float* rhs = (const LAS float*)(L + GP_RHS) + tt;
        float x[64];
#pragma unroll
        for (int i = 0; i < 64; ++i) {
            float a0 = rhs[i * 128], a1 = 0.f;
#pragma unroll
            for (int j4 = 0; j4 < (i + 3) / 4; ++j4) { const f32x4 lr = *(const LAS f32x4*)(Lm + i * 64 + 4 * j4);
                if (4 * j4 + 0 < i) a0 -= lr.x * x[4 * j4 + 0]; if (4 * j4 + 1 < i) a1 -= lr.y * x[4 * j4 + 1];
                if (4 * j4 + 2 < i) a0 -= lr.z * x[4 * j4 + 2]; if (4 * j4 + 3 < i) a1 -= lr.w * x[4 * j4 + 3]; }
            x[i] = a0 + a1;
        }
        if (tt < 64) { bf16_t* ut = gdn_buf(P, chh, 1) + tt * 64;
#pragma unroll
            for (int g8 = 0; g8 < 8; ++g8) { u32x4 w; w.x = pk2(x[8 * g8], x[8 * g8 + 1]); w.y = pk2(x[8 * g8 + 2], x[8 * g8 + 3]); w.z = pk2(x[8 * g8 + 4], x[8 * g8 + 5]); w.w = pk2(x[8 * g8 + 6], x[8 * g8 + 7]); *(u32x4*)(ut + 8 * g8) = w; }
        } else { bf16_t* wo = gdn_buf(P, chh, 0) + (tt - 64);
#pragma unroll
            for (int i = 0; i < 64; ++i) wo[i * 64] = f2bf(x[i]); }
    }
    __syncthreads();
}

constexpr int GC_W = 0, GC_UT = 9216, GC_ATT = 18432, GC_QD = 27648, GC_KDT = 36864, GC_O = 46080, GC_BH = 62720;
__device__ __forceinline__ bf16x8 lds_perm(const LAS unsigned char* M, int row, int s, int fq) { const LAS unsigned char* p = M + row * 144 + 64 * s + 8 * fq; return mk8(*(const LAS u32x2*)p, *(const LAS u32x2*)(p + 32)); }
__device__ __forceinline__ void gdn_chain_item(const Params& P, int l, LAS unsigned char* lds, int gi, int tid, int wave, int lane) {
    const int q2 = wave >> 2, bh = gi * 2 + q2, eb = wave & 3, b = bh >> 2, h = bh & 3, fr = lane & 15, fq = lane >> 4;
    const bf16_t* z = (const bf16_t*)(P.ws + WS_R); bf16_t* y = (bf16_t*)(P.ws + WS_R + R_Y);
    LAS unsigned char* L = lds + q2 * GC_BH;
    const int tt = tid & 255, ec = tt >> 2, eq = tt & 3;
    float ng[16];
#pragma unroll
    for (int j = 0; j < 16; ++j) ng[j] = P.gdn_norm[l * 64 + eq * 16 + j];
    u32x4 stg[10];
    const bf16_t* src0[2] = { gdn_buf(P, ((gi * 2 >> 2) * NCHUNK) * 4 + ((gi * 2) & 3), 0), gdn_buf(P, (((gi * 2 + 1) >> 2) * NCHUNK) * 4 + ((gi * 2 + 1) & 3), 0) };
#define GC_LOAD(n_) do { _Pragma("unroll") for (int i = 0; i < 10; ++i) { const int p = tid + 512 * i, qq = p / 2560, pp = p % 2560; \
        stg[i] = *(const u32x4*)(src0[qq] + (size_t)(n_) * 4 * 5 * 4096 + (size_t)pp * 8); } } while (0)
#define GC_WRITE() do { _Pragma("unroll") for (int i = 0; i < 10; ++i) { const int p = tid + 512 * i, qq = p / 2560, pp = p % 2560, mat = pp >> 9, row = (pp & 511) >> 3, pc = pp & 7; \
        *(LAS u32x4*)(lds + qq * GC_BH + mat * 9216 + row * 144 + pc * 16) = stg[i]; } } while (0)
    GC_LOAD(0); GC_WRITE();
    f32x4 S[4];
#pragma unroll
    for (int t = 0; t < 4; ++t) S[t] = (f32x4){0.f, 0.f, 0.f, 0.f};
    __syncthreads();
    for (int n = 0; n < NCHUNK; ++n) {
        const int chh = (b * NCHUNK + n) * 4 + h;
        if (n + 1 < NCHUNK) GC_LOAD(n + 1);
        const size_t etok = (size_t)(gi * 2 + (tid >> 8) >> 2) * SEQ + n * 64 + ec; const int eh = (gi * 2 + (tid >> 8)) & 3;
        const u32x4 gw0 = *(const u32x4*)(z + etok * ZP + Z_GG + eh * 64 + eq * 16), gw1 = *(const u32x4*)(z + etok * ZP + Z_GG + eh * 64 + eq * 16 + 8);
        const float egl = ((const float*)(P.ws + WS_GL))[chh];
        const bf16x8 sb0 = pack8(S[0], S[1]), sb1 = pack8(S[2], S[3]);
        f32x4 vn[4], o[4];
#pragma unroll
        for (int ct = 0; ct < 4; ++ct) {
            f32x4 a = {0.f, 0.f, 0.f, 0.f}; a = mfma16(lds_perm(L + GC_W, ct * 16 + fr, 0, fq), sb0, a); a = mfma16(lds_perm(L + GC_W, ct * 16 + fr, 1, fq), sb1, a);
            const u32x2 uw = *(const LAS u32x2*)(L + GC_UT + (eb * 16 + fr) * 144 + (ct * 16 + 4 * fq) * 2);
            vn[ct] = (f32x4){bflo(uw.x) - a.x, bfhi(uw.x) - a.y, bflo(uw.y) - a.z, bfhi(uw.y) - a.w};
            f32x4 oo = {0.f, 0.f, 0.f, 0.f}; oo = mfma16(lds_perm(L + GC_QD, ct * 16 + fr, 0, fq), sb0, oo); oo = mfma16(lds_perm(L + GC_QD, ct * 16 + fr, 1, fq), sb1, oo); o[ct] = oo;
        }
        const bf16x8 vb0 = pack8(vn[0], vn[1]), vb1 = pack8(vn[2], vn[3]);
#pragma unroll
        for (int ct = 0; ct < 4; ++ct) { o[ct] = mfma16(lds_perm(L + GC_ATT, ct * 16 + fr, 0, fq), vb0, o[ct]); o[ct] = mfma16(lds_perm(L + GC_ATT, ct * 16 + fr, 1, fq), vb1, o[ct]); }
#pragma unroll
        for (int dt = 0; dt < 4; ++dt) { f32x4 a = S[dt] * egl; a = mfma16(lds_perm(L + GC_KDT, dt * 16 + fr, 0, fq), vb0, a); a = mfma16(lds_perm(L + GC_KDT, dt * 16 + fr, 1, fq), vb1, a); S[dt] = a; }
        LAS float* Ol = (LAS float*)(L + GC_O);
#pragma unroll
        for (int ct = 0; ct < 4; ++ct)
#pragma unroll
            for (int r = 0; r < 4; ++r) Ol[(ct * 16 + 4 * fq + r) * 65 + eb * 16 + fr] = o[ct][r];
        __syncthreads();
        if (n + 1 < NCHUNK) GC_WRITE();
        {
            const LAS float* orow = (const LAS float*)(lds + (tid >> 8) * GC_BH + GC_O) + ec * 65 + eq * 16;
            float ov[16]; float s2 = 0.f;
#pragma unroll
            for (int j = 0; j < 16; ++j) { ov[j] = orow[j]; s2 += ov[j] * ov[j]; }
            s2 += __shfl_xor(s2, 1); s2 += __shfl_xor(s2, 2);
            const float rs = rsqrtf(s2 * (1.0f / 64.0f) + EPS);
            const unsigned gws[8] = {gw0.x, gw0.y, gw0.z, gw0.w, gw1.x, gw1.y, gw1.z, gw1.w};
            unsigned ow[8];
#pragma unroll
            for (int j = 0; j < 8; ++j) ow[j] = pk2(ov[2 * j] * rs * ng[2 * j] * siluf_(bflo(gws[j])), ov[2 * j + 1] * rs * ng[2 * j + 1] * siluf_(bfhi(gws[j])));
            bf16_t* yp = y + etok * DM + 768 + eh * 64 + eq * 16;
            *(u32x4*)yp = (u32x4){ow[0], ow[1], ow[2], ow[3]}; *(u32x4*)(yp + 8) = (u32x4){ow[4], ow[5], ow[6], ow[7]};
        }
        __syncthreads();
    }
#undef GC_LOAD
#undef GC_WRITE
}

constexpr int RT_BUF = 36864, RT_Q = 0, RT_K = 9216, RT_KZT = 18432, RT_VT = 27648, RT_P = 73728, RT_ST = 82944, RT_O = 92160;
__device__ __forceinline__ void ret_chain_item(const Params& P, int l, LAS unsigned char* lds, int it, int tid, int wave, int lane) {
    const int b = it >> 2, h = it & 3, fr = lane & 15, fq = lane >> 4;
    const bf16_t* z = (const bf16_t*)(P.ws + WS_R); bf16_t* y = (bf16_t*)(P.ws + WS_R + R_Y);
    LAS bf16_t* Pm = (LAS bf16_t*)(lds + RT_P); LAS bf16_t* ST = (LAS bf16_t*)(lds + RT_ST); LAS float* Of = (LAS float*)(lds + RT_O);
    const float lg = log1pf(-exp2f(-5.0f - (float)h));
    const float cdec = __expf(64.0f * lg);
    for (int i = tid; i < 64 * 72 / 2; i += 512) ((LAS unsigned*)ST)[i] = 0u;
    const int it4 = wave >> 1, jt0 = 2 * (wave & 1);
    f32x4 S[2] = {{0.f, 0.f, 0.f, 0.f}, {0.f, 0.f, 0.f, 0.f}};
    const int lc = tid >> 3, pg = tid & 7;
    float invf[4];
#pragma unroll
    for (int ii = 0; ii < 4; ++ii) invf[ii] = exp2f(-(float)(4 * pg + ii) * (13.287712379549449f / 32.0f));
    const float zeta = __expf((63.0f - (float)lc) * lg);
    const f32x4 gn0 = *(const f32x4*)(P.ret_gn + l * 256 + h * 64 + 8 * pg), gn1 = *(const f32x4*)(P.ret_gn + l * 256 + h * 64 + 8 * pg + 4);
    const size_t tok0 = (size_t)b * SEQ + lc;
    u32x2 q1w, q2w, k1w, k2w; u32x4 vw; int posi;
#define RT_LOAD(n_) do { const bf16_t* zr_ = z + (tok0 + (n_) * 64) * ZP; q1w = *(const u32x2*)(zr_ + Z_RQ + h * 64 + 4 * pg); q2w = *(const u32x2*)(zr_ + Z_RQ + h * 64 + 32 + 4 * pg); \
        k1w = *(const u32x2*)(zr_ + Z_RK + h * 64 + 4 * pg); k2w = *(const u32x2*)(zr_ + Z_RK + h * 64 + 32 + 4 * pg); vw = *(const u32x4*)(zr_ + Z_RV + h * 64 + 8 * pg); posi = P.pos[tok0 + (n_) * 64]; } while (0)
#define RT_STAGE(buf_) do { LAS bf16_t* Qs_ = (LAS bf16_t*)(lds + (buf_) * RT_BUF + RT_Q); LAS bf16_t* Ks_ = (LAS bf16_t*)(lds + (buf_) * RT_BUF + RT_K); \
        LAS bf16_t* KzT_ = (LAS bf16_t*)(lds + (buf_) * RT_BUF + RT_KZT); LAS bf16_t* VT_ = (LAS bf16_t*)(lds + (buf_) * RT_BUF + RT_VT); const float pos = (float)posi; \
        const float q1[4] = {bflo(q1w.x), bfhi(q1w.x), bflo(q1w.y), bfhi(q1w.y)}, q2[4] = {bflo(q2w.x), bfhi(q2w.x), bflo(q2w.y), bfhi(q2w.y)}; \
        const float k1[4] = {bflo(k1w.x), bfhi(k1w.x), bflo(k1w.y), bfhi(k1w.y)}, k2[4] = {bflo(k2w.x), bfhi(k2w.x), bflo(k2w.y), bfhi(k2w.y)}; \
        float qa[4], qb[4], ka[4], kb[4]; \
        _Pragma("unroll") for (int ii = 0; ii < 4; ++ii) { float sn, cs; sincos_rev(pos * invf[ii], sn, cs); \
            qa[ii] = (q1[ii] * cs - q2[ii] * sn) * 0.125f; qb[ii] = (q1[ii] * sn + q2[ii] * cs) * 0.125f; ka[ii] = k1[ii] * cs - k2[ii] * sn; kb[ii] = k1[ii] * sn + k2[ii] * cs; } \
        u32x2 w_; w_.x = pk2(qa[0], qa[1]); w_.y = pk2(qa[2], qa[3]); *(LAS u32x2*)(Qs_ + lc * 72 + 4 * pg) = w_; \
        w_.x = pk2(qb[0], qb[1]); w_.y = pk2(qb[2], qb[3]); *(LAS u32x2*)(Qs_ + lc * 72 + 32 + 4 * pg) = w_; \
        w_.x = pk2(ka[0], ka[1]); w_.y = pk2(ka[2], ka[3]); *(LAS u32x2*)(Ks_ + lc * 72 + 4 * pg) = w_; \
        w_.x = pk2(kb[0], kb[1]); w_.y = pk2(kb[2], kb[3]); *(LAS u32x2*)(Ks_ + lc * 72 + 32 + 4 * pg) = w_; \
        _Pragma("unroll") for (int ii = 0; ii < 4; ++ii) { KzT_[(4 * pg + ii) * 72 + lc] = f2bf(ka[ii] * zeta); KzT_[(32 + 4 * pg + ii) * 72 + lc] = f2bf(kb[ii] * zeta); } \
        const unsigned vv[4] = {vw.x, vw.y, vw.z, vw.w}; \
        _Pragma("unroll") for (int ii = 0; ii < 4; ++ii) { VT_[(8 * pg + 2 * ii) * 72 + lc] = (bf16_t)(vv[ii] & 0xffffu); VT_[(8 * pg + 2 * ii + 1) * 72 + lc] = (bf16_t)(vv[ii] >> 16); } } while (0)
    RT_LOAD(0); RT_STAGE(0);
    __syncthreads();
    for (int n = 0; n < NCHUNK; ++n) {
        const int cb = n & 1;
        const LAS bf16_t* Qs = (const LAS bf16_t*)(lds + cb * RT_BUF + RT_Q); const LAS bf16_t* Ks = (const LAS bf16_t*)(lds + cb * RT_BUF + RT_K);
        const LAS bf16_t* KzT = (const LAS bf16_t*)(lds + cb * RT_BUF + RT_KZT); const LAS bf16_t* VT = (const LAS bf16_t*)(lds + cb * RT_BUF + RT_VT);
        const size_t tok = tok0 + n * 64;
        if (n + 1 < NCHUNK) RT_LOAD(n + 1);
        const u32x4 gw = *(const u32x4*)(z + tok * ZP + Z_RG + h * 64 + 8 * pg);
        const bf16x8 a0 = *(const LAS bf16x8*)(Qs + (it4 * 16 + fr) * 72 + 8 * fq), a1 = *(const LAS bf16x8*)(Qs + (it4 * 16 + fr) * 72 + 32 + 8 * fq);
        f32x4 cross[2];
#pragma unroll
        for (int t = 0; t < 2; ++t) { const int jt = jt0 + t;
            f32x4 p = {0.f, 0.f, 0.f, 0.f};
            p = mfma16(a0, *(const LAS bf16x8*)(Ks + (jt * 16 + fr) * 72 + 8 * fq), p); p = mfma16(a1, *(const LAS bf16x8*)(Ks + (jt * 16 + fr) * 72 + 32 + 8 * fq), p);
            f32x4 cr = {0.f, 0.f, 0.f, 0.f};
            cr = mfma16(a0, *(const LAS bf16x8*)(ST + (jt * 16 + fr) * 72 + 8 * fq), cr); cr = mfma16(a1, *(const LAS bf16x8*)(ST + (jt * 16 + fr) * 72 + 32 + 8 * fq), cr);
#pragma unroll
            for (int r = 0; r < 4; ++r) { const int i = it4 * 16 + 4 * fq + r, j = jt * 16 + fr; const int dd = i > j ? i - j : j - i;
                Pm[i * 72 + j] = f2bf(p[r] * __expf((float)dd * lg)); cr[r] *= __expf((float)(i + 1) * lg); }
            cross[t] = cr; }
        __syncthreads();
        const bf16x8 p0 = *(const LAS bf16x8*)(Pm + (it4 * 16 + fr) * 72 + 8 * fq), p1 = *(const LAS bf16x8*)(Pm + (it4 * 16 + fr) * 72 + 32 + 8 * fq);
        const bf16x8 kz0 = *(const LAS bf16x8*)(KzT + (it4 * 16 + fr) * 72 + 8 * fq), kz1 = *(const LAS bf16x8*)(KzT + (it4 * 16 + fr) * 72 + 32 + 8 * fq);
#pragma unroll
        for (int t = 0; t < 2; ++t) { const int et = jt0 + t;
            const bf16x8 v0 = *(const LAS bf16x8*)(VT + (et * 16 + fr) * 72 + 8 * fq), v1 = *(const LAS bf16x8*)(VT + (et * 16 + fr) * 72 + 32 + 8 * fq);
            f32x4 o = cross[t]; o = mfma16(p0, v0, o); o = mfma16(p1, v1, o);
#pragma unroll
            for (int r = 0; r < 4; ++r) Of[(it4 * 16 + 4 * fq + r) * 65 + et * 16 + fr] = o[r];
            f32x4 sN = S[t] * cdec; sN = mfma16(kz0, v0, sN); sN = mfma16(kz1, v1, sN); S[t] = sN;
            u32x2 w; w.x = pk2(sN.x, sN.y); w.y = pk2(sN.z, sN.w); *(LAS u32x2*)(ST + (et * 16 + fr) * 72 + it4 * 16 + 4 * fq) = w; }
        if (n + 1 < NCHUNK) RT_STAGE(cb ^ 1);
        __syncthreads();
        {
            float ov[8]; float sm = 0.f;
#pragma unroll
            for (int j = 0; j < 8; ++j) { ov[j] = Of[lc * 65 + 8 * pg + j]; sm += ov[j]; }
            sm += __shfl_xor(sm, 1); sm += __shfl_xor(sm, 2); sm += __shfl_xor(sm, 4);
            const float mu = sm * (1.0f / 64.0f); float vs = 0.f;
#pragma unroll
            for (int j = 0; j < 8; ++j) { ov[j] -= mu; vs += ov[j] * ov[j]; }
            vs += __shfl_xor(vs, 1); vs += __shfl_xor(vs, 2); vs += __shfl_xor(vs, 4);
            const float rs = rsqrtf(vs * (1.0f / 64.0f) + EPS);
            const float gt[8] = {bflo(gw.x), bfhi(gw.x), bflo(gw.y), bfhi(gw.y), bflo(gw.z), bfhi(gw.z), bflo(gw.w), bfhi(gw.w)};
            const float gnv[8] = {gn0.x, gn0.y, gn0.z, gn0.w, gn1.x, gn1.y, gn1.z, gn1.w};
            float r8[8];
#pragma unroll
            for (int j = 0; j < 8; ++j) r8[j] = ov[j] * rs * gnv[j] * siluf_(gt[j]);
            u32x4 w; w.x = pk2(r8[0], r8[1]); w.y = pk2(r8[2], r8[3]); w.z = pk2(r8[4], r8[5]); w.w = pk2(r8[6], r8[7]);
            *(u32x4*)(y + tok * DM + h * 64 + 8 * pg) = w;
        }
    }
#undef RT_LOAD
#undef RT_STAGE
    __syncthreads();
}

constexpr int LR_XC = 0, LR_AU = 33792, LR_HIN = 99584;
__device__ __forceinline__ void lru_item(const Params& P, int l, LAS unsigned char* lds, int it, int mode, int tid, int wave, int lane) {
    const int b = it >> 5, n = it & 31, fr = lane & 15, fq = lane >> 4;
    const bf16_t* z = (const bf16_t*)(P.ws + WS_R); bf16_t* y = (bf16_t*)(P.ws + WS_R + R_Y);
    LAS bf16_t* XC = (LAS bf16_t*)(lds + LR_XC); LAS f32x2* AU = (LAS f32x2*)(lds + LR_AU); LAS float* HIN = (LAS float*)(lds + LR_HIN);
    float* sumA = (float*)(P.ws + WS_LRUS); float* sumH = sumA + 16 * 32 * 256;
    {
        const int c = tid >> 3, cg = tid & 7, s = n * 64 + c; const size_t tok = (size_t)b * SEQ + s;
        const float* cw = P.lru_conv_w + (size_t)l * 4 * 256; const float* cb = P.lru_conv_b + l * 256;
#pragma unroll
        for (int g = 0; g < 4; ++g) { const int ch0 = cg * 32 + g * 8;
            const f32x4 b0 = *(const f32x4*)(cb + ch0), b1 = *(const f32x4*)(cb + ch0 + 4);
            float a[8] = {b0.x, b0.y, b0.z, b0.w, b1.x, b1.y, b1.z, b1.w};
#pragma unroll
            for (int kk = 0; kk < 4; ++kk) if (s - 3 + kk >= 0) { const u32x4 w = *(const u32x4*)(z + (tok - 3 + kk) * ZP + Z_LX + ch0);
                const f32x4 c0 = *(const f32x4*)(cw + kk * 256 + ch0), c1 = *(const f32x4*)(cw + kk * 256 + ch0 + 4);
                a[0] += c0.x * bflo(w.x); a[1] += c0.y * bfhi(w.x); a[2] += c0.z * bflo(w.y); a[3] += c0.w * bfhi(w.y);
                a[4] += c1.x * bflo(w.z); a[5] += c1.y * bfhi(w.z); a[6] += c1.z * bflo(w.w); a[7] += c1.w * bfhi(w.w); }
            u32x4 o; o.x = pk2(a[0], a[1]); o.y = pk2(a[2], a[3]); o.z = pk2(a[4], a[5]); o.w = pk2(a[6], a[7]);
            *(LAS u32x4*)(XC + c * 264 + ch0) = o; }
    }
    float hcar = 0.f, aprod = 1.f;
    if (tid < 256) {
        if (mode == 1) { for (int m = 0; m < n; ++m) hcar = sumA[(b * 32 + m) * 256 + tid] * hcar + sumH[(b * 32 + m) * 256 + tid]; }
    }
    const int nb = wave >> 1, rt = wave & 1;
    const bf16_t* wa = wl(P, l, W_A) + nb * 4096; const bf16_t* wx = wl(P, l, W_X) + nb * 4096;
    bf16x8 fa[4][2], fx[4][2]; float ba[4], bx[4], spl[4];
#pragma unroll
    for (int dt = 0; dt < 4; ++dt) {
#pragma unroll
        for (int s = 0; s < 2; ++s) { fa[dt][s] = *(const bf16x8*)(wa + (dt * 16 + fr) * 64 + 32 * s + 8 * fq); fx[dt][s] = *(const bf16x8*)(wx + (dt * 16 + fr) * 64 + 32 * s + 8 * fq); }
        const int d = nb * 64 + dt * 16 + fr; ba[dt] = P.lru_ba[l * 256 + d]; bx[dt] = P.lru_bx[l * 256 + d]; spl[dt] = softplusf_(-P.lru_lambda[l * 256 + d]); }
    __syncthreads();
    for (int half = 0; half < 2; ++half) {
        const int trow = half * 32 + rt * 16;
        const bf16x8 x0 = *(const LAS bf16x8*)(XC + (trow + fr) * 264 + nb * 64 + 8 * fq), x1 = *(const LAS bf16x8*)(XC + (trow + fr) * 264 + nb * 64 + 32 + 8 * fq);
#pragma unroll
        for (int dt = 0; dt < 4; ++dt) {
            f32x4 ar = {0.f, 0.f, 0.f, 0.f}, ai = {0.f, 0.f, 0.f, 0.f};
            ar = mfma16(x0, fa[dt][0], ar); ar = mfma16(x1, fa[dt][1], ar); ai = mfma16(x0, fx[dt][0], ai); ai = mfma16(x1, fx[dt][1], ai);
            const int d = nb * 64 + dt * 16 + fr;
#pragma unroll
            for (int r = 0; r < 4; ++r) { const int tl = rt * 16 + 4 * fq + r;
                const float xcv = bf2f(XC[(half * 32 + tl) * 264 + d]);
                const float rr = sigmoidf_(ar[r] + ba[dt]), ii = sigmoidf_(ai[r] + bx[dt]);
                const float la = -8.0f * rr * spl[dt]; const float a = __expf(la);
                const float u = sqrtf(-expm1f(2.0f * la)) * (ii * xcv);
                AU[tl * 257 + d] = (f32x2){a, u}; }
        }
        __syncthreads();
        if (tid < 256) {
            const size_t tok0 = (size_t)b * SEQ + n * 64 + half * 32;
            for (int tk = 0; tk < 32; ++tk) { const f32x2 au = AU[tk * 257 + tid]; hcar = au.x * hcar + au.y; aprod *= au.x;
                if (mode == 1) { const float gate = bf2f(z[(tok0 + tk) * ZP + Z_LG + tid]); y[(tok0 + tk) * DM + 256 + tid] = f2bf(hcar * geluf_(gate)); } }
        }
        __syncthreads();
    }
    if (mode == 0 && tid < 256) { sumA[(b * 32 + n) * 256 + tid] = aprod; sumH[(b * 32 + n) * 256 + tid] = hcar; }
}

constexpr int N_PHASES = 21;
constexpr int Q_RET = 64, Q_GDN = 32, Q_LRU = 512, Q_MLA = 1024, Q_TOTAL = Q_RET + Q_GDN + Q_LRU + Q_MLA;

__global__ void __launch_bounds__(512, 2) hymba_fwd(Params P) {
    extern __shared__ __attribute__((aligned(16))) unsigned char lds_raw[];
    LAS unsigned char* lds = (LAS unsigned char*)lds_raw;
    volatile LAS unsigned* LC = (volatile LAS unsigned*)(lds + LDS_CTL);
    const int G = gridDim.x;
#define SUB_TID() int tid2 = tid; asm volatile("" : "+v"(tid2)); const int lane2 = tid2 & 63, wave2 = __builtin_amdgcn_readfirstlane(tid2 >> 6); (void)lane2; (void)wave2
#define PH_TID() int tid = threadIdx.x; asm volatile("" : "+v"(tid)); const int lane = tid & 63, wave = __builtin_amdgcn_readfirstlane(tid >> 6); (void)lane; (void)wave
    unsigned* ctl = (unsigned*)(P.ws + WS_CTL);
    if (threadIdx.x < 64) LC[threadIdx.x] = 0u;
    __syncthreads();
    const int lo = P.ph_lo, hi = P.ph_hi;
    XcdBarrier bar; bar.bar = ctl + CW_BAR; bar.x = 0; bar.st = LC;
    if (hi - lo > 1) bar = xcd_barrier_post(ctl + CW_BAR, LC);
#ifndef PHASE_MASK
#define PHASE_MASK 0xFFFFFFFFu
#endif
#define EN(t) ((PHASE_MASK >> (t)) & 1u)
#ifndef REPEAT_MASK
#define REPEAT_MASK 0u
#endif
#define REP(t) for (int rep_ = 0; rep_ <= (int)((REPEAT_MASK >> (t)) & 1u); ++rep_, (rep_ <= (int)((REPEAT_MASK >> (t)) & 1u) ? xcd_barrier(bar) : (void)0))
#define IN(k) (lo <= (k) && (k) < hi)
#define SEAM(k) do { if (IN(k) && IN((k) + 1)) xcd_barrier(bar); } while (0)

    bf16_t* xb = (bf16_t*)(P.ws + WS_XB); float* part = (float*)(P.ws + WS_PART);
    bf16_t* zb = (bf16_t*)(P.ws + WS_R); bf16_t* yb = (bf16_t*)(P.ws + WS_R + R_Y); bf16_t* oxb = (bf16_t*)(P.ws + WS_R + R_OX);

    if (IN(0) && EN(0)) REP(0) { PH_TID(); p0_prologue(P, lds, tid); __syncthreads(); }
    SEAM(0);
    if (IN(1) && EN(1)) REP(1) {
        PH_TID();
        const int which = blockIdx.x >> 6, l = which >> 1, isv = which & 1;
        if (which < 4) {
            const bf16_t* memn = (const bf16_t*)(P.ws + WS_GDN); const bf16_t* wkv = wl(P, l, W_KV);
            bf16_t* kout = (bf16_t*)(P.ws + WS_KVM + (size_t)l * KVM_LAYER); bf16_t* vout = kout + (size_t)4096 * 1024;
            pg8::Gemm g; pg8::EpiScaleBf16<0> E; pg8::StaticOrder S;
            if (!isv) { g = pg8::Gemm{memn, wkv, 4096, 1024, 1024}; E = pg8::EpiScaleBf16<0>{kout, 1024, nullptr}; S.init(4096, 1024, 64, blockIdx.x & 63); }
            else { g = pg8::Gemm{wkv + (size_t)1024 * 1024, memn, 1024, 4096, 1024}; E = pg8::EpiScaleBf16<0>{vout, 4096, nullptr}; S.init(1024, 4096, 64, blockIdx.x & 63); }
            pg8::gemm_phase(lds, g, S, E, tid);
        }
    }
    SEAM(1);
#pragma unroll 1
    for (int l = 0; l < 2; ++l) {
        const int pb = 2 + 9 * l;
        if (IN(pb + 0) && EN(2)) REP(2) { PH_TID();
            pg8::Gemm g{xb, wl(P, l, W_IN), T_TOK, ZP, DM}; pg8::StaticOrder S; S.init(T_TOK, ZP, G, blockIdx.x);
            pg8::EpiScaleBf16<0> E{zb, ZP, part}; pg8::gemm_phase(lds, g, S, E, tid);
        }
        SEAM(pb + 0);
        if (IN(pb + 1)) {
            PH_TID();
            if (EN(3)) REP(3) { SUB_TID(); for (int it = blockIdx.x; it < 1024; it += G) gdn_pre_item(P, l, lds, it, tid2); }
            if (EN(4)) REP(4) { SUB_TID(); for (int it = blockIdx.x; it < 512; it += G) { lru_item(P, l, lds, it, 0, tid2, wave2, lane2); __syncthreads(); } }
            if (EN(5)) REP(5) { SUB_TID(); for (int rt = blockIdx.x * 8 + wave2; rt < 2048; rt += G * 8) mla_pre_tile(P, l, rt, lane2); }
        }
        SEAM(pb + 1);
        if (IN(pb + 2)) REP(6) {
            PH_TID();
            unsigned* qh = ctl + CW_QUEUE + 64 * l + 32 * rep_;
            for (;;) {
                if (tid == 0) LC[4] = __hip_atomic_fetch_add(qh, 1u, __ATOMIC_RELAXED, __HIP_MEMORY_SCOPE_AGENT);
                __syncthreads();
                const int it = (int)LC[4];
                __syncthreads();
                if (it >= Q_TOTAL) break;
                if (it < Q_RET) { if (EN(6)) { SUB_TID(); ret_chain_item(P, l, lds, it, tid2, wave2, lane2); } }
                else if (it < Q_RET + Q_GDN) { if (EN(7)) { SUB_TID(); gdn_chain_item(P, l, lds, it - Q_RET, tid2, wave2, lane2); } }
                else if (it < Q_RET + Q_GDN + Q_LRU) { if (EN(8)) { SUB_TID(); lru_item(P, l, lds, it - Q_RET - Q_GDN, 1, tid2, wave2, lane2); } __syncthreads(); }
                else { if (EN(9)) { SUB_TID(); mla_attn_item(P, lds, it - Q_RET - Q_GDN - Q_LRU, tid2, wave2, lane2); } __syncthreads(); }
            }
        }
        SEAM(pb + 2);
        if (IN(pb + 3) && EN(10)) REP(10) { PH_TID();
            pg8::Gemm g{yb, wl(P, l, W_OUT), T_TOK, DM, DM}; pg8::StaticOrder S; S.init(T_TOK, DM, G, blockIdx.x);
            pg8::EpiResid E{P.out, xb, part, rep_ ? 0.f : 1.f}; pg8::gemm_phase(lds, g, S, E, tid);
        }
        SEAM(pb + 3);
        if (IN(pb + 4) && EN(11)) REP(11) { PH_TID();
            pg8::Gemm g{xb, wl(P, l, W_Q), T_TOK, DM, DM}; pg8::StaticOrder S; S.init(T_TOK, DM, G, blockIdx.x);
            pg8::EpiScaleBf16<0> E{zb, DM, part}; pg8::gemm_phase(lds, g, S, E, tid);
        }
        SEAM(pb + 4);
        if (IN(pb + 5) && EN(12)) REP(12) { PH_TID(); for (int it = blockIdx.x; it < 1024; it += G) { xa_item(P, l, lds, it, tid, wave, lane); __syncthreads(); } }
        SEAM(pb + 5);
        if (IN(pb + 6) && EN(13)) REP(13) { PH_TID();
            pg8::Gemm g{oxb, wl(P, l, W_O), T_TOK, DM, DM}; pg8::StaticOrder S; S.init(T_TOK, DM, G, blockIdx.x);
            pg8::EpiResid E{P.out, xb, part, rep_ ? 0.f : 1.f}; pg8::gemm_phase(lds, g, S, E, tid);
        }
        SEAM(pb + 6);
        if (IN(pb + 7) && EN(14)) REP(14) { PH_TID();
            pg8::Gemm g{xb, wl(P, l, W_1), T_TOK, DFF, DM}; pg8::StaticOrder S; S.init(T_TOK, DFF, G, blockIdx.x);
            pg8::EpiScaleBf16<1> E{zb, DFF, part}; pg8::gemm_phase(lds, g, S, E, tid);
        }
        SEAM(pb + 7);
        if (IN(pb + 8) && EN(15)) REP(15) { PH_TID();
            pg8::Gemm g{zb, wl(P, l, W_2), T_TOK, DM, DFF}; pg8::StaticOrder S; S.init(T_TOK, DM, G, blockIdx.x);
            pg8::EpiResid E{P.out, xb, part, rep_ ? 0.f : 1.f}; pg8::gemm_phase(lds, g, S, E, tid);
        }
        SEAM(pb + 8);
    }
    if (IN(20) && EN(16)) { PH_TID(); final_norm_phase(P, tid); }
#undef IN
#undef SEAM
}

extern "C" void kernel_launch(void* const* d_in, const int* in_sizes, int n_in, void* d_out, int out_size, void* d_ws, size_t ws_size, hipStream_t stream) {
    static int grid = 0;
    if (grid == 0) {
        if (n_in != 31 || out_size != T_TOK * DM || ws_size < WS_END) { fprintf(stderr, "kernel_launch: unexpected shapes (n_in %d out %d ws %zu, need %zu)\n", n_in, out_size, ws_size, (size_t)WS_END); grid = -1; return; }
        if (hipFuncSetAttribute((const void*)hymba_fwd, hipFuncAttributeMaxDynamicSharedMemorySize, LDS_BYTES) != hipSuccess) { fprintf(stderr, "kernel_launch: hipFuncSetAttribute failed\n"); grid = -1; return; }
        int dev = 0, cus = 0, per_cu = 0;
        (void)hipGetDevice(&dev); (void)hipDeviceGetAttribute(&cus, hipDeviceAttributeMultiprocessorCount, dev);
        (void)hipOccupancyMaxActiveBlocksPerMultiprocessor(&per_cu, (const void*)hymba_fwd, 512, LDS_BYTES);
        (void)hipGetLastError();
        if (cus != 256 || per_cu < 1) fprintf(stderr, "kernel_launch: note: cus %d per_cu %d\n", cus, per_cu);
        grid = 256;
    }
    if (grid < 0) return;
    (void)hipMemsetAsync((char*)d_ws + WS_CTL, 0, CTL_BYTES, stream);
    Params p{};
    p.x = (const float*)d_in[0]; p.mem = (const float*)d_in[1]; p.pos = (const int*)d_in[2];
    p.norm_mix = (const float*)d_in[3]; p.w_in = (const float*)d_in[4]; p.ret_gn = (const float*)d_in[5];
    p.lru_conv_w = (const float*)d_in[6]; p.lru_conv_b = (const float*)d_in[7]; p.lru_wa = (const float*)d_in[8]; p.lru_ba = (const float*)d_in[9];
    p.lru_wx = (const float*)d_in[10]; p.lru_bx = (const float*)d_in[11]; p.lru_lambda = (const float*)d_in[12];
    p.mla_q_norm = (const float*)d_in[13]; p.mla_w_uq = (const float*)d_in[14]; p.mla_kv_norm = (const float*)d_in[15]; p.mla_w_ukv = (const float*)d_in[16];
    p.gdn_conv_w = (const float*)d_in[17]; p.gdn_a_log = (const float*)d_in[18]; p.gdn_dt_bias = (const float*)d_in[19]; p.gdn_norm = (const float*)d_in[20];
    p.w_out = (const float*)d_in[21]; p.norm_xattn = (const float*)d_in[22]; p.norm_mem = (const float*)d_in[23];
    p.xa_wq = (const float*)d_in[24]; p.xa_wkv = (const float*)d_in[25]; p.xa_wo = (const float*)d_in[26];
    p.norm_mlp = (const float*)d_in[27]; p.mlp_w1 = (const float*)d_in[28]; p.mlp_w2 = (const float*)d_in[29]; p.final_norm = (const float*)d_in[30];
    p.out = (float*)d_out; p.ws = (unsigned char*)d_ws;
#if N_LAUNCHES == 1
    p.ph_lo = 0; p.ph_hi = N_PHASES;
    void* args[] = {&p};
    hipError_t e = hipLaunchCooperativeKernel((const void*)hymba_fwd, dim3(grid), dim3(512), args, LDS_BYTES, stream);
    if (e != hipSuccess) fprintf(stderr, "kernel_launch: cooperative launch failed: %s\n", hipGetErrorString(e));
#else
    for (int ph = 0; ph < N_PHASES; ++ph) { p.ph_lo = ph; p.ph_hi = ph + 1; hipLaunchKernelGGL(hymba_fwd, dim3(grid), dim3(512), LDS_BYTES, stream, p); }
#endif
}
```

```cpp
#include <hip/hip_runtime.h>
#include <cstdio>
#include <cstdint>

#ifndef N_LAUNCHES
#define N_LAUNCHES 1
#endif

#define LAS __attribute__((address_space(3)))
typedef unsigned short bf16_t;
typedef short bf16x8 __attribute__((ext_vector_type(8)));
typedef float f32x4 __attribute__((ext_vector_type(4)));
typedef float f32x2 __attribute__((ext_vector_type(2)));
typedef unsigned u32x4 __attribute__((ext_vector_type(4)));
typedef unsigned u32x2 __attribute__((ext_vector_type(2)));

constexpr int T_TOK = 32768, DM = 1024, SEQ = 2048, NBATCH = 16, NCHUNK = 32, ZP = 3072, DFF = 4096, NMEM = 256;
constexpr int Z_RQ = 0, Z_RK = 256, Z_RV = 512, Z_RG = 768, Z_LX = 1024, Z_LG = 1280, Z_CQ = 1536, Z_CKV = 1728, Z_KR = 1856,
              Z_GQKV = 1888, Z_GG = 2656, Z_GB = 2912, Z_GA = 2916, IN_COLS = 2920;
constexpr float EPS = 1e-6f;
constexpr float LOG2E = 1.4426950408889634f;

constexpr size_t MiB = 1024 * 1024;
constexpr size_t WS_CTL = 0;
constexpr size_t CTL_BYTES = 65536;
constexpr size_t WS_PART = WS_CTL + CTL_BYTES;
constexpr size_t WS_LRUS = WS_PART + (size_t)T_TOK * 16 * 4;
constexpr size_t WS_GL = WS_LRUS + (size_t)2 * 16 * 32 * 256 * 4;
constexpr size_t WS_W = WS_GL + 65536;
constexpr size_t W_IN = 0, W_OUT = W_IN + (size_t)ZP * DM, W_Q = W_OUT + (size_t)DM * DM, W_KV = W_Q + (size_t)DM * DM, W_O = W_KV + (size_t)2 * DM * DM,
                 W_1 = W_O + (size_t)DM * DM, W_2 = W_1 + (size_t)DFF * DM, W_UQ = W_2 + (size_t)DFF * DM, W_UKV = W_UQ + 384 * 192, W_A = W_UKV + 512 * 128,
                 W_X = W_A + 4 * 64 * 64, W_LAYER = W_X + 4 * 64 * 64;
constexpr size_t WS_XB = WS_W + 2 * W_LAYER * 2;
constexpr size_t XB_BYTES = (size_t)T_TOK * DM * 2;
constexpr size_t MLA_Q_OFF = 0, MLA_K_OFF = (size_t)T_TOK * 4 * 96 * 2, MLA_VT_OFF = 2 * MLA_K_OFF;
constexpr size_t WS_KVM = WS_XB + XB_BYTES;
constexpr size_t KVM_LAYER = (size_t)2 * 4096 * 1024 * 2;
constexpr size_t WS_R = WS_KVM + 2 * KVM_LAYER;
constexpr size_t R_Y = (size_t)T_TOK * ZP * 2;
constexpr size_t R_OX = (size_t)T_TOK * DM * 2;
constexpr size_t WS_GDN = WS_R + 256 * MiB;
constexpr size_t WS_END = WS_GDN + 80 * MiB;
static_assert(WS_END <= 512 * MiB, "workspace map exceeds 512 MiB");
static_assert(WS_XB % 256 == 0 && WS_R % 256 == 0 && WS_GDN % 256 == 0 && WS_W % 256 == 0, "alignment");
constexpr int CW_BAR = 0;
constexpr int CW_QUEUE = 4096;

constexpr int LDS_BYTES = 160 * 1024;
constexpr int LDS_CTL = LDS_BYTES - 256;

typedef __bf16 bf16x2_t __attribute__((ext_vector_type(2)));
__device__ __forceinline__ unsigned pk2(float lo, float hi) { f32x2 t = {lo, hi}; bf16x2_t v = __builtin_convertvector(t, bf16x2_t); return __builtin_bit_cast(unsigned, v); }
__device__ __forceinline__ float bflo(unsigned w) { return __uint_as_float(w << 16); }
__device__ __forceinline__ float bfhi(unsigned w) { return __uint_as_float(w & 0xffff0000u); }
__device__ __forceinline__ float bf2f(bf16_t v) { return __uint_as_float((unsigned)v << 16); }
__device__ __forceinline__ bf16_t f2bf(float f) { return (bf16_t)(pk2(f, 0.f) & 0xffffu); }
__device__ __forceinline__ f32x4 mfma16(bf16x8 a, bf16x8 b, f32x4 c) { return __builtin_amdgcn_mfma_f32_16x16x32_bf16(a, b, c, 0, 0, 0); }
__device__ __forceinline__ float sigmoidf_(float x) { return 1.0f / (1.0f + __expf(-x)); }
__device__ __forceinline__ float siluf_(float x) { return x / (1.0f + __expf(-x)); }
__device__ __forceinline__ float softplusf_(float x) { return x > 20.f ? x : log1pf(__expf(x)); }
__device__ __forceinline__ float geluf_(float x) { const float u = 0.7978845608028654f * (x + 0.044715f * x * x * x); const float e = __expf(2.f * u); const float th = 1.f - 2.f / (e + 1.f); return 0.5f * x * (1.f + th); }
__device__ __forceinline__ float wave_sum(float v) {
#pragma unroll
    for (int o = 1; o < 64; o <<= 1) v += __shfl_xor(v, o);
    return v;
}
__device__ __forceinline__ void sincos_rev(float ang, float& s, float& c) {
    float rev = ang * 0.15915494309189535f; rev = rev - floorf(rev);
    s = __builtin_amdgcn_sinf(rev); c = __builtin_amdgcn_cosf(rev);
}
__device__ __forceinline__ bf16x8 mk8(u32x2 lo, u32x2 hi) { u32x4 t; t.x = lo.x; t.y = lo.y; t.z = hi.x; t.w = hi.y; return __builtin_bit_cast(bf16x8, t); }
__device__ __forceinline__ bf16x8 pack8(f32x4 a, f32x4 b) { u32x4 t; t.x = pk2(a.x, a.y); t.y = pk2(a.z, a.w); t.z = pk2(b.x, b.y); t.w = pk2(b.z, b.w); return __builtin_bit_cast(bf16x8, t); }

#define XB_TMO      128
#define XB_XCNT(j)  (256  + 64 * (j))
#define XB_XSUB(j)  (1280 + 64 * (j))
#define XB_XGEN(j)  (2304 + 64 * (j))
#define XB_TOP      3328
#define XB_TOPGEN   3392
#define XCD_BAR_WORDS 3456
#define XB_SPIN_CAP (1u << 22)
__device__ __forceinline__ unsigned xb_ld(unsigned* p)              { return __hip_atomic_load(p, __ATOMIC_RELAXED, __HIP_MEMORY_SCOPE_AGENT); }
__device__ __forceinline__ unsigned xb_add(unsigned* p, unsigned v) { return __hip_atomic_fetch_add(p, v, __ATOMIC_RELAXED, __HIP_MEMORY_SCOPE_AGENT); }
__device__ __forceinline__ unsigned xb_xcc_id() { return (unsigned)__builtin_amdgcn_s_getreg((3 << 11) | 20) & 0xFu; }
#define XB_SPIN(cond, bar) do { unsigned _sp = 0; while (cond) { __builtin_amdgcn_s_sleep(1); \
    if ((++_sp & 255u) == 0u) { if (xb_ld(&(bar)[XB_TMO])) break; if (_sp > XB_SPIN_CAP) { atomicAdd(&(bar)[XB_TMO], 1u); break; } } } } while (0)
struct XcdBarrier { unsigned* bar; unsigned x; volatile LAS unsigned* st; };
__device__ __forceinline__ XcdBarrier xcd_barrier_post(unsigned* bar, volatile LAS unsigned* st) {
    XcdBarrier b; b.bar = bar; b.x = xb_xcc_id(); b.st = st;
    if (threadIdx.x == 0) (void)xb_add(&bar[XB_XCNT(b.x)], 1u);
    return b;
}
__device__ __forceinline__ void xcd_barrier_complete(unsigned* bar, unsigned x, unsigned& nloc, unsigned& nx) {
    const unsigned G = gridDim.x * gridDim.y * gridDim.z;
    unsigned sum, cnt, mine, sp = 0u;
    for (;;) {
        sum = 0u; cnt = 0u; mine = 0u;
#pragma unroll
        for (unsigned j = 0; j < 16; ++j) { const unsigned c = xb_ld(&bar[XB_XCNT(j)]); sum += c; cnt += (c > 0u) ? 1u : 0u; mine = (j == x) ? c : mine; }
        if (sum == G) break;
        __builtin_amdgcn_s_sleep(1);
        if ((++sp & 255u) == 0u) { if (xb_ld(&bar[XB_TMO])) break; if (sp > XB_SPIN_CAP) { atomicAdd(&bar[XB_TMO], 1u); break; } }
    }
    nloc = mine > 0u ? mine : 1u; nx = cnt > 0u ? cnt : 1u;
}
__device__ __forceinline__ void xcd_barrier(const XcdBarrier& b) {
    asm volatile("s_waitcnt vmcnt(0)" ::: "memory");
    __syncthreads();
    if (threadIdx.x == 0) {
        unsigned* bar = b.bar;
        __builtin_amdgcn_s_waitcnt(0);
        unsigned nloc = b.st[0], nx = b.st[1];
        if (nloc == 0u) { xcd_barrier_complete(bar, b.x, nloc, nx); b.st[0] = nloc; b.st[1] = nx; }
        const unsigned old = xb_add(&bar[XB_XSUB(b.x)], 1u);
        const unsigned gen = old / nloc;
        if (old + 1u == (gen + 1u) * nloc) {
            __builtin_amdgcn_fence(__ATOMIC_RELEASE, "agent");
            asm volatile("s_waitcnt vmcnt(0)" ::: "memory");
            const unsigned og = xb_add(&bar[XB_TOP], 1u);
            const unsigned tg = og / nx;
            if (og + 1u == (tg + 1u) * nx) xb_add(&bar[XB_TOPGEN], 1u);
            else XB_SPIN(xb_ld(&bar[XB_TOPGEN]) == tg, bar);
            __builtin_amdgcn_fence(__ATOMIC_ACQUIRE, "agent");
            xb_add(&bar[XB_XGEN(b.x)], 1u);
            asm volatile("s_waitcnt vmcnt(0)" ::: "memory");
        } else {
            XB_SPIN(xb_ld(&bar[XB_XGEN(b.x)]) == gen, bar);
            __builtin_amdgcn_fence(__ATOMIC_ACQUIRE, "agent");
            asm volatile("s_waitcnt vmcnt(0)" ::: "memory");
        }
    }
    __syncthreads();
}

namespace pg8 {
constexpr int BM = 256, BK = 64, HALF = 128, HTB = HALF * BK * 2, STAGE_BYTES = 8 * HTB, NXCD = 8, WGM = 8;
__host__ __device__ __forceinline__ int lds_byte(int r, int c) { const int st = (r >> 4) * 2 + (c >> 5), rr = r & 15, cc = c & 31, ob = rr * 64 + cc * 2; return st * 1024 + (ob ^ (((ob >> 9) & 1) << 5)); }
__host__ __device__ __forceinline__ void stage_rc(int b, int& R, int& C) { const int st = b / 1024, sb = b % 1024, swz = sb ^ (((sb >> 9) & 1) << 5); R = (st >> 1) * 16 + swz / 64; C = (st & 1) * 32 + (swz % 64) / 2; }
__host__ __device__ __forceinline__ int perm32(int rho) { const int n = rho >> 4, i = rho & 15; return 8 * (i >> 2) + 4 * n + (i & 3); }
struct Unit { int pm, pn; };
struct Gemm { const bf16_t* A; const bf16_t* Bt; int M, N, K; };
struct StaticOrder {
    int nM, nN, nwg, G, c;
    __host__ __device__ void init(int M, int N, int G_, int c_) { nM = M / BM; nN = N / BM; nwg = nM * nN; G = G_; c = c_; }
    __host__ __device__ bool next(int i, Unit& u) const {
        const long L = (long)i * G + c; if (L >= nwg) return false;
        int wgid = (int)L; { const int q = nwg / NXCD, r = nwg % NXCD, xcd = wgid % NXCD, off = wgid / NXCD; wgid = (xcd < r ? xcd * (q + 1) : r * (q + 1) + (xcd - r) * q) + off; }
        const int nig = WGM * nN, gid = wgid / nig, fm = gid * WGM, gsz = (nM - fm) < WGM ? (nM - fm) : WGM;
        u.pm = fm + ((wgid % nig) % gsz); u.pn = (wgid % nig) / gsz; return true;
    }
    __device__ __forceinline__ void a_ready(const Unit&) const {}
    __device__ __forceinline__ void done(const Unit&) const {}
};

template <int ACT> struct EpiScaleBf16 {
    static constexpr bool PERM = true;
    bf16_t* O; int ldc; const float* part;
    __device__ __forceinline__ void operator()(const f32x4 (&acc)[2][2][4][2], const Unit& u, int wr, int wc, int fr, int fq) const {
        const int row0 = u.pm * BM + wr * 64 + fr, col0 = u.pn * BM + wc * 32 + 8 * fq;
#pragma unroll
        for (int ai = 0; ai < 2; ++ai)
#pragma unroll
            for (int m = 0; m < 4; ++m) {
                const int row = row0 + ai * HALF + m * 16;
                float sc = 1.0f;
                if (part) { const f32x4* pp = (const f32x4*)(part + (size_t)row * 16); const f32x4 a = pp[0], b = pp[1], c = pp[2], d = pp[3];
                    const float s = ((a.x + a.y) + (a.z + a.w)) + ((b.x + b.y) + (b.z + b.w)) + ((c.x + c.y) + (c.z + c.w)) + ((d.x + d.y) + (d.z + d.w));
                    sc = rsqrtf(s * (1.0f / 1024.0f) + EPS); }
                bf16_t* rowp = O + (size_t)row * ldc + col0;
#pragma unroll
                for (int bj = 0; bj < 2; ++bj) { f32x4 v0 = acc[ai][bj][m][0] * sc, v1 = acc[ai][bj][m][1] * sc;
                    if (ACT == 1) {
#pragma unroll
                        for (int j = 0; j < 4; ++j) { const float a0 = fmaxf(v0[j], 0.f), a1 = fmaxf(v1[j], 0.f); v0[j] = a0 * a0; v1[j] = a1 * a1; } }
                    u32x4 w; w.x = pk2(v0[0], v0[1]); w.y = pk2(v0[2], v0[3]); w.z = pk2(v1[0], v1[1]); w.w = pk2(v1[2], v1[3]);
                    *(u32x4*)(rowp + bj * HALF) = w; }
            }
    }
};
struct EpiResid {
    static constexpr bool PERM = false;
    float* X; bf16_t* XB; float* part; float alpha;
    __device__ __forceinline__ void operator()(const f32x4 (&acc)[2][2][4][2], const Unit& u, int wr, int wc, int fr, int fq) const {
        const int row0 = u.pm * BM + wr * 64 + fr, col0 = u.pn * BM + wc * 32 + 4 * fq;
#pragma unroll
        for (int ai = 0; ai < 2; ++ai)
#pragma unroll
            for (int m = 0; m < 4; ++m) {
                const int row = row0 + ai * HALF + m * 16;
                float* xp = X + (size_t)row * DM + col0; bf16_t* bp = XB + (size_t)row * DM + col0;
                float ss = 0.f;
#pragma unroll
                for (int bj = 0; bj < 2; ++bj)
#pragma unroll
                    for (int n = 0; n < 2; ++n) { const f32x4 v = *(const f32x4*)(xp + bj * HALF + n * 16) + acc[ai][bj][m][n] * alpha;
                        *(f32x4*)(xp + bj * HALF + n * 16) = v; ss += (v.x * v.x + v.y * v.y) + (v.z * v.z + v.w * v.w);
                        u32x2 w; w.x = pk2(v.x, v.y); w.y = pk2(v.z, v.w); *(u32x2*)(bp + bj * HALF + n * 16) = w; }
                ss += __shfl_xor(ss, 16); ss += __shfl_xor(ss, 32);
                if (fq == 0) part[(size_t)row * 16 + u.pn * 4 + wc] = ss;
            }
    }
};

template <class Epi, class Sched>
__device__ __forceinline__ void gemm_phase(LAS unsigned char* lds, const Gemm g, const Sched& S, const Epi& E, const int tid) {
    const int wid = __builtin_amdgcn_readfirstlane(tid >> 6), lane = tid & 63, wr = wid >> 2, wc = wid & 3, fr = lane & 15, fq = lane >> 4;
    const int K = g.K, nt = K / BK;
    unsigned voffA[2], voffB[2];
#pragma unroll
    for (int i = 0; i < 2; ++i) { int R, C; stage_rc(tid * 16 + i * 8192, R, C); const int Rb = Epi::PERM ? ((R & ~31) + perm32(R & 31)) : R;
        voffA[i] = (unsigned)(R * K + C) * 2u; voffB[i] = (unsigned)(Rb * K + C) * 2u; }
    const size_t kstep = (size_t)(BK * 2);
    const size_t hstep = (size_t)HALF * K * 2;
    const size_t tstep = 2 * hstep;
    const unsigned ldsw = (unsigned)wid * 1024u;
    const int aoff = lds_byte(wr * 64 + fr, fq * 8), boff = lds_byte(wc * 32 + fr, fq * 8);
#define PG8_SA(b, h) (((b) * 2 + (h)) * HTB)
#define PG8_SB(b, h) ((4 + (b) * 2 + (h)) * HTB)
#define PG8_STAGE(bufoff, gbase, voff) do { _Pragma("unroll") for (int _i = 0; _i < 2; ++_i) \
        __builtin_amdgcn_global_load_lds((const unsigned*)((const char*)(gbase) + (voff)[_i]), (LAS unsigned*)(lds + (bufoff) + ldsw + _i * 8192), 16, 0, 0); } while (0)
#define PG8_LDA(dst, b, h) do { _Pragma("unroll") for (int m = 0; m < 4; ++m) _Pragma("unroll") for (int k = 0; k < 2; ++k) dst[m][k] = *(const LAS bf16x8*)(lds + PG8_SA(b, h) + aoff + m * 2048 + k * 1024); } while (0)
#define PG8_LDB(dst, b, h) do { _Pragma("unroll") for (int n = 0; n < 2; ++n) _Pragma("unroll") for (int k = 0; k < 2; ++k) dst[n][k] = *(const LAS bf16x8*)(lds + PG8_SB(b, h) + boff + n * 2048 + k * 1024); } while (0)
#define PG8_MMA(ai, bj, At, Bt) do { __builtin_amdgcn_s_setprio(1); _Pragma("unroll") for (int m = 0; m < 4; ++m) _Pragma("unroll") for (int n = 0; n < 2; ++n) _Pragma("unroll") for (int k = 0; k < 2; ++k) \
        acc[ai][bj][m][n] = __builtin_amdgcn_mfma_f32_16x16x32_bf16(Bt[n][k], At[m][k], acc[ai][bj][m][n], 0, 0, 0); __builtin_amdgcn_s_setprio(0); } while (0)
#define PG8_WAIT_V(n) asm volatile("s_waitcnt vmcnt(" #n ")" ::: "memory")
#define PG8_WAIT_L(n) asm volatile("s_waitcnt lgkmcnt(" #n ")" ::: "memory")
#define PG8_BAR __builtin_amdgcn_s_barrier()
#define PG8_SCHED __builtin_amdgcn_sched_barrier(0)
    Unit cur, nxt; int ui = 0;
    if (!S.next(0, cur)) return;
    f32x4 acc[2][2][4][2];
#pragma unroll
    for (int a = 0; a < 2; ++a)
#pragma unroll
        for (int b = 0; b < 2; ++b)
#pragma unroll
            for (int m = 0; m < 4; ++m)
#pragma unroll
                for (int n = 0; n < 2; ++n) acc[a][b][m][n] = (f32x4){0.f, 0.f, 0.f, 0.f};
    bf16x8 At[4][2], B0[2][2], B1[2][2];
    const char* cA = (const char*)g.A + (size_t)cur.pm * tstep; const char* cB = (const char*)g.Bt + (size_t)cur.pn * tstep;
    S.a_ready(cur);
    PG8_STAGE(PG8_SB(0, 0), cB, voffB); PG8_STAGE(PG8_SA(0, 0), cA, voffA); PG8_STAGE(PG8_SB(0, 1), cB + hstep, voffB); PG8_STAGE(PG8_SA(0, 1), cA + hstep, voffA);
    if (wr == 1) PG8_BAR;
    PG8_WAIT_V(4); PG8_BAR;
    PG8_STAGE(PG8_SB(1, 0), cB + kstep, voffB); PG8_STAGE(PG8_SA(1, 0), cA + kstep, voffA); PG8_STAGE(PG8_SB(1, 1), cB + hstep + kstep, voffB);
    PG8_WAIT_V(6); PG8_BAR;
    for (;;) {
        const bool has_next = S.next(ui + 1, nxt);
        const char* nA = has_next ? (const char*)g.A + (size_t)nxt.pm * tstep : cA; const char* nB = has_next ? (const char*)g.Bt + (size_t)nxt.pn * tstep : cB;
        for (int t = 0; t < nt; t += 2) {
            const bool last = (t == nt - 2);
            const char* a1 = cA + (size_t)(t + 1) * kstep;
            const char* a2 = last ? nA : cA + (size_t)(t + 2) * kstep; const char* b2 = last ? nB : cB + (size_t)(t + 2) * kstep;
            const char* a3 = a2 + kstep; const char* b3 = b2 + kstep;
            if (last && has_next) S.a_ready(nxt);
            PG8_LDB(B0, 0, 0); PG8_SCHED; PG8_LDA(At, 0, 0); PG8_STAGE(PG8_SA(1, 1), a1 + hstep, voffA);
            PG8_WAIT_L(8); PG8_BAR; PG8_WAIT_L(0); PG8_MMA(0, 0, At, B0); PG8_BAR; PG8_SCHED;
            PG8_LDB(B1, 0, 1); PG8_STAGE(PG8_SB(0, 0), b2, voffB);
            PG8_BAR; PG8_WAIT_L(0); PG8_MMA(0, 1, At, B1); PG8_BAR;
            PG8_LDA(At, 0, 1); PG8_STAGE(PG8_SA(0, 0), a2, voffA);
            PG8_BAR; PG8_WAIT_L(0); PG8_MMA(1, 0, At, B0); PG8_BAR; PG8_SCHED;
            PG8_STAGE(PG8_SB(0, 1), b2 + hstep, voffB);
            PG8_WAIT_V(6); PG8_BAR; PG8_MMA(1, 1, At, B1); PG8_BAR;
            PG8_LDB(B0, 1, 0); PG8_SCHED; PG8_LDA(At, 1, 0); PG8_STAGE(PG8_SA(0, 1), a2 + hstep, voffA);
            PG8_WAIT_L(8); PG8_BAR; PG8_WAIT_L(0); PG8_MMA(0, 0, At, B0); PG8_BAR; PG8_SCHED;
            PG8_LDB(B1, 1, 1); PG8_STAGE(PG8_SB(1, 0), b3, voffB);
            PG8_BAR; PG8_WAIT_L(0); PG8_MMA(0, 1, At, B1); PG8_BAR;
            PG8_LDA(At, 1, 1); PG8_STAGE(PG8_SA(1, 0), a3, voffA);
            PG8_BAR; PG8_WAIT_L(0); PG8_MMA(1, 0, At, B0); PG8_BAR; PG8_SCHED;
            PG8_STAGE(PG8_SB(1, 1), b3 + hstep, voffB);
            PG8_WAIT_V(6); PG8_BAR; PG8_MMA(1, 1, At, B1); PG8_BAR;
        }
        E(acc, cur, wr, wc, fr, fq); S.done(cur);
        if (!has_next) break;
#pragma unroll
        for (int a = 0; a < 2; ++a)
#pragma unroll
            for (int b = 0; b < 2; ++b)
#pragma unroll
                for (int m = 0; m < 4; ++m)
#pragma unroll
                    for (int n = 0; n < 2; ++n) acc[a][b][m][n] = (f32x4){0.f, 0.f, 0.f, 0.f};
        cur = nxt; cA = nA; cB = nB; ++ui;
    }
    PG8_WAIT_V(0);
    if (wr == 0) PG8_BAR;
    PG8_BAR;
#undef PG8_SA
#undef PG8_SB
#undef PG8_STAGE
#undef PG8_LDA
#undef PG8_LDB
#undef PG8_MMA
#undef PG8_WAIT_V
#undef PG8_WAIT_L
#undef PG8_BAR
#undef PG8_SCHED
}
}

struct Params {
    const float* x; const float* mem; const int* pos;
    const float* norm_mix; const float* w_in; const float* ret_gn;
    const float* lru_conv_w; const float* lru_conv_b; const float* lru_wa; const float* lru_ba; const float* lru_wx; const float* lru_bx; const float* lru_lambda;
    const float* mla_q_norm; const float* mla_w_uq; const float* mla_kv_norm; const float* mla_w_ukv;
    const float* gdn_conv_w; const float* gdn_a_log; const float* gdn_dt_bias; const float* gdn_norm;
    const float* w_out; const float* norm_xattn; const float* norm_mem; const float* xa_wq; const float* xa_wkv; const float* xa_wo;
    const float* norm_mlp; const float* mlp_w1; const float* mlp_w2; const float* final_norm;
    float* out; unsigned char* ws;
    int ph_lo, ph_hi;
};

__device__ __forceinline__ bf16_t* wl(const Params& P, int l, size_t off) { return (bf16_t*)(P.ws + WS_W) + (size_t)l * W_LAYER + off; }

__device__ __forceinline__ void transpose_tile(const float* src, int K, int N, const float* gain, float scale, bf16_t* dst, int kb, int nb, LAS float* scr, int tid) {
#pragma unroll
    for (int i = 0; i < 8; ++i) { const int kk = (tid >> 6) + 8 * i, k = kb * 64 + kk, n = nb * 64 + (tid & 63);
        float v = 0.f; if (n < N) { v = src[(size_t)k * N + n] * scale; if (gain) v *= gain[k]; }
        scr[kk * 65 + (tid & 63)] = v; }
    __syncthreads();
    { const int nl = tid >> 3, k0 = (tid & 7) * 8; const LAS float* s = scr + k0 * 65 + nl;
      u32x4 o; o.x = pk2(s[0], s[65]); o.y = pk2(s[2 * 65], s[3 * 65]); o.z = pk2(s[4 * 65], s[5 * 65]); o.w = pk2(s[6 * 65], s[7 * 65]);
      *(u32x4*)(dst + (size_t)(nb * 64 + nl) * K + kb * 64 + k0) = o; }
    __syncthreads();
}
__device__ __forceinline__ void p0_prologue(const Params& P, LAS unsigned char* lds, int tid) {
    LAS float* scr = (LAS float*)lds;
    constexpr int T_IN = 16 * 48, T_SQ = 256, T_KV = 512, T_W1 = 1024, T_W2 = 1024, T_UQ = 18, T_UKV = 16, T_LRU = 8;
    constexpr int T_LAYER = T_IN + 3 * T_SQ + T_KV + T_W1 + T_W2 + T_UQ + T_UKV + T_LRU;
    for (int it = blockIdx.x; it < 2 * T_LAYER; it += gridDim.x) {
        const int l = it / T_LAYER; int r = it % T_LAYER;
        const float* src; const float* gain = nullptr; float scale = 1.f; bf16_t* dst; int K, N, nnb;
        if (r < T_IN) { src = P.w_in + (size_t)l * DM * IN_COLS; K = DM; N = IN_COLS; nnb = 48; gain = P.norm_mix + l * DM; dst = wl(P, l, W_IN); }
        else if ((r -= T_IN) < T_SQ) { src = P.w_out + (size_t)l * DM * DM; K = DM; N = DM; nnb = 16; dst = wl(P, l, W_OUT); }
        else if ((r -= T_SQ) < T_SQ) { src = P.xa_wq + (size_t)l * DM * DM; K = DM; N = DM; nnb = 16; gain = P.norm_xattn + l * DM; scale = 0.0625f * LOG2E; dst = wl(P, l, W_Q); }
        else if ((r -= T_SQ) < T_KV) { src = P.xa_wkv + (size_t)l * DM * 2 * DM; K = DM; N = 2 * DM; nnb = 32; gain = P.norm_mem + l * DM; dst = wl(P, l, W_KV); }
        else if ((r -= T_KV) < T_SQ) { src = P.xa_wo + (size_t)l * DM * DM; K = DM; N = DM; nnb = 16; dst = wl(P, l, W_O); }
        else if ((r -= T_SQ) < T_W1) { src = P.mlp_w1 + (size_t)l * DM * DFF; K = DM; N = DFF; nnb = 64; gain = P.norm_mlp + l * DM; dst = wl(P, l, W_1); }
        else if ((r -= T_W1) < T_W2) { src = P.mlp_w2 + (size_t)l * DFF * DM; K = DFF; N = DM; nnb = 16; dst = wl(P, l, W_2); }
        else if ((r -= T_W2) < T_UQ) { src = P.mla_w_uq + (size_t)l * 192 * 384; K = 192; N = 384; nnb = 6; gain = P.mla_q_norm + l * 192; dst = wl(P, l, W_UQ); }
        else if ((r -= T_UQ) < T_UKV) { src = P.mla_w_ukv + (size_t)l * 128 * 512; K = 128; N = 512; nnb = 8; gain = P.mla_kv_norm + l * 128; dst = wl(P, l, W_UKV); }
        else { r -= T_UKV; const int which = r >> 2, nb4 = r & 3; src = (which ? P.lru_wx : P.lru_wa) + (size_t)l * 4 * 4096 + nb4 * 4096; K = 64; N = 64; nnb = 1; dst = wl(P, l, which ? W_X : W_A) + nb4 * 4096; r = 0; }
        transpose_tile(src, K, N, gain, scale, dst, r / nnb, r % nnb, scr, tid);
    }
    const int wave = tid >> 6, lane = tid & 63;
    const int gw = blockIdx.x * 8 + wave, ngw = gridDim.x * 8;
    bf16_t* xb = (bf16_t*)(P.ws + WS_XB); float* part = (float*)(P.ws + WS_PART); bf16_t* memn = (bf16_t*)(P.ws + WS_GDN);
    for (int row = gw; row < T_TOK + NBATCH * NMEM; row += ngw) {
        const bool isx = row < T_TOK; const int r2 = isx ? row : row - T_TOK;
        const f32x4* src = (const f32x4*)((isx ? P.x : P.mem) + (size_t)r2 * DM) + lane;
        f32x4 v[4]; float s = 0.f;
#pragma unroll
        for (int j = 0; j < 4; ++j) { v[j] = src[64 * j]; s += (v[j].x * v[j].x + v[j].y * v[j].y) + (v[j].z * v[j].z + v[j].w * v[j].w); }
        s = wave_sum(s);
        if (isx) {
            f32x4* o = (f32x4*)(P.out + (size_t)row * DM) + lane; u32x2* ob = (u32x2*)(xb + (size_t)row * DM) + lane;
#pragma unroll
            for (int j = 0; j < 4; ++j) { o[64 * j] = v[j]; u32x2 w; w.x = pk2(v[j].x, v[j].y); w.y = pk2(v[j].z, v[j].w); ob[64 * j] = w; }
            if (lane < 16) part[(size_t)row * 16 + lane] = lane == 0 ? s : 0.f;
        } else {
            const float rs = rsqrtf(s * (1.0f / 1024.0f) + EPS); u32x2* ob = (u32x2*)(memn + (size_t)r2 * DM) + lane;
#pragma unroll
            for (int j = 0; j < 4; ++j) { u32x2 w; w.x = pk2(v[j].x * rs, v[j].y * rs); w.y = pk2(v[j].z * rs, v[j].w * rs); ob[64 * j] = w; }
        }
    }
}
__device__ __forceinline__ void final_norm_phase(const Params& P, int tid) {
    const int wave = tid >> 6, lane = tid & 63; const float* part = (const float*)(P.ws + WS_PART);
    f32x4 g[4];
#pragma unroll
    for (int j = 0; j < 4; ++j) g[j] = ((const f32x4*)P.final_norm)[64 * j + lane];
    for (int row = blockIdx.x * 8 + wave; row < T_TOK; row += gridDim.x * 8) {
        float s = lane < 16 ? part[(size_t)row * 16 + lane] : 0.f; s = wave_sum(s);
        const float rs = rsqrtf(s * (1.0f / 1024.0f) + EPS);
        f32x4* o = (f32x4*)(P.out + (size_t)row * DM) + lane;
#pragma unroll
        for (int j = 0; j < 4; ++j) { f32x4 v = o[64 * j]; o[64 * j] = v * rs * g[j]; }
    }
}

__device__ __forceinline__ void mla_pre_tile(const Params& P, int l, int rt, int lane) {
    const int fr = lane & 15, fq = lane >> 4;
    const bf16_t* z = (const bf16_t*)(P.ws + WS_R);
    bf16_t* Qo = (bf16_t*)(P.ws + WS_XB + MLA_Q_OFF); bf16_t* Ko = (bf16_t*)(P.ws + WS_XB + MLA_K_OFF); bf16_t* Vo = (bf16_t*)(P.ws + WS_XB + MLA_VT_OFF);
    const bf16_t* Wuq = wl(P, l, W_UQ); const bf16_t* Wukv = wl(P, l, W_UKV);
    const int tok0 = rt * 16, b = tok0 >> 11, s0 = tok0 & 2047;
    const bf16_t* zr = z + (size_t)(tok0 + fr) * ZP;
    bf16x8 cq[6], ckv[4]; float sq = 0.f, skv = 0.f;
#pragma unroll
    for (int s = 0; s < 6; ++s) { const u32x4 w = *(const u32x4*)(zr + Z_CQ + 32 * s + 8 * fq); cq[s] = __builtin_bit_cast(bf16x8, w);
        sq += bflo(w.x) * bflo(w.x) + bfhi(w.x) * bfhi(w.x) + bflo(w.y) * bflo(w.y) + bfhi(w.y) * bfhi(w.y) + bflo(w.z) * bflo(w.z) + bfhi(w.z) * bfhi(w.z) + bflo(w.w) * bflo(w.w) + bfhi(w.w) * bfhi(w.w); }
#pragma unroll
    for (int s = 0; s < 4; ++s) { const u32x4 w = *(const u32x4*)(zr + Z_CKV + 32 * s + 8 * fq); ckv[s] = __builtin_bit_cast(bf16x8, w);
        skv += bflo(w.x) * bflo(w.x) + bfhi(w.x) * bfhi(w.x) + bflo(w.y) * bflo(w.y) + bfhi(w.y) * bfhi(w.y) + bflo(w.z) * bflo(w.z) + bfhi(w.z) * bfhi(w.z) + bflo(w.w) * bflo(w.w) + bfhi(w.w) * bfhi(w.w); }
    sq += __shfl_xor(sq, 16); sq += __shfl_xor(sq, 32); skv += __shfl_xor(skv, 16); skv += __shfl_xor(skv, 32);
    const float rq = rsqrtf(sq * (1.0f / 192.0f) + EPS), rkv = rsqrtf(skv * (1.0f / 128.0f) + EPS);
    const float qsc = rq * 0.10206207261596575f * LOG2E;
    const float pos = (float)P.pos[tok0 + fr];
    float sn[4], cs[4];
#pragma unroll
    for (int r = 0; r < 4; ++r) { const float invf = exp2f(-(float)(4 * fq + r) * (13.287712379549449f / 16.0f)); sincos_rev(pos * invf, sn[r], cs[r]); }
    const size_t tokrow = (size_t)b * 4 * SEQ + (s0 + fr);
#pragma unroll 1
    for (int h = 0; h < 4; ++h) {
        bf16_t* qrow = Qo + (tokrow + (size_t)h * SEQ) * 96;
#pragma unroll 1
        for (int nt = 0; nt < 4; ++nt) { f32x4 a = {0.f, 0.f, 0.f, 0.f};
#pragma unroll
            for (int s = 0; s < 6; ++s) { const bf16x8 wf = *(const bf16x8*)(Wuq + (size_t)(h * 96 + nt * 16 + fr) * 192 + 32 * s + 8 * fq); a = mfma16(wf, cq[s], a); }
            a = a * qsc; u32x2 w; w.x = pk2(a.x, a.y); w.y = pk2(a.z, a.w); *(u32x2*)(qrow + nt * 16 + 4 * fq) = w; }
        f32x4 x1 = {0.f, 0.f, 0.f, 0.f}, x2 = {0.f, 0.f, 0.f, 0.f}, y1, y2;
#pragma unroll
        for (int s = 0; s < 6; ++s) { const bf16x8 wf1 = *(const bf16x8*)(Wuq + (size_t)(h * 96 + 64 + fr) * 192 + 32 * s + 8 * fq), wf2 = *(const bf16x8*)(Wuq + (size_t)(h * 96 + 80 + fr) * 192 + 32 * s + 8 * fq);
            x1 = mfma16(wf1, cq[s], x1); x2 = mfma16(wf2, cq[s], x2); }
        x1 = x1 * qsc; x2 = x2 * qsc;
#pragma unroll
        for (int r = 0; r < 4; ++r) { y1[r] = x1[r] * cs[r] - x2[r] * sn[r]; y2[r] = x1[r] * sn[r] + x2[r] * cs[r]; }
        { u32x2 w; w.x = pk2(y1.x, y1.y); w.y = pk2(y1.z, y1.w); *(u32x2*)(qrow + 64 + 4 * fq) = w; w.x = pk2(y2.x, y2.y); w.y = pk2(y2.z, y2.w); *(u32x2*)(qrow + 80 + 4 * fq) = w; }
    }
    u32x2 kr1, kr2;
    { const u32x2 a = *(const u32x2*)(zr + Z_KR + 4 * fq), c = *(const u32x2*)(zr + Z_KR + 16 + 4 * fq);
      const float x1[4] = {bflo(a.x), bfhi(a.x), bflo(a.y), bfhi(a.y)}, x2[4] = {bflo(c.x), bfhi(c.x), bflo(c.y), bfhi(c.y)}; float y1[4], y2[4];
#pragma unroll
      for (int r = 0; r < 4; ++r) { y1[r] = x1[r] * cs[r] - x2[r] * sn[r]; y2[r] = x1[r] * sn[r] + x2[r] * cs[r]; }
      kr1.x = pk2(y1[0], y1[1]); kr1.y = pk2(y1[2], y1[3]); kr2.x = pk2(y2[0], y2[1]); kr2.y = pk2(y2[2], y2[3]); }
    float rkv_r[4];
#pragma unroll
    for (int r = 0; r < 4; ++r) rkv_r[r] = __shfl(rkv, 4 * fq + r);
    const int chunk = s0 >> 6, key0 = (s0 & 63) + 4 * fq;
#pragma unroll 1
    for (int h = 0; h < 4; ++h) {
        bf16_t* krow = Ko + (tokrow + (size_t)h * SEQ) * 96;
#pragma unroll 1
        for (int nt = 0; nt < 4; ++nt) { f32x4 a = {0.f, 0.f, 0.f, 0.f};
#pragma unroll
            for (int s = 0; s < 4; ++s) { const bf16x8 wf = *(const bf16x8*)(Wukv + (size_t)(h * 128 + nt * 16 + fr) * 128 + 32 * s + 8 * fq); a = mfma16(wf, ckv[s], a); }
            a = a * rkv; u32x2 w; w.x = pk2(a.x, a.y); w.y = pk2(a.z, a.w); *(u32x2*)(krow + nt * 16 + 4 * fq) = w; }
        *(u32x2*)(krow + 64 + 4 * fq) = kr1; *(u32x2*)(krow + 80 + 4 * fq) = kr2;
        bf16_t* vt = Vo + ((size_t)((b * 4 + h) * NCHUNK + chunk) * 64) * 64;
#pragma unroll 1
        for (int nt = 0; nt < 4; ++nt) { f32x4 a = {0.f, 0.f, 0.f, 0.f};
#pragma unroll
            for (int s = 0; s < 4; ++s) { const bf16x8 wf = *(const bf16x8*)(Wukv + (size_t)(h * 128 + 64 + nt * 16 + fr) * 128 + 32 * s + 8 * fq); a = mfma16(ckv[s], wf, a); }
            u32x2 w; w.x = pk2(a.x * rkv_r[0], a.y * rkv_r[1]); w.y = pk2(a.z * rkv_r[2], a.w * rkv_r[3]);
            *(u32x2*)(vt + (size_t)(nt * 16 + fr) * 64 + key0) = w; }
    }
}

template <int DQK, int DV, int KT>
__device__ __forceinline__ void flash_item(LAS unsigned char* lds, const bf16_t* Qw, int ldq, const bf16_t* Kb, int ldk, const bf16_t* VTb, int ldv, int vts,
                                           bf16_t* Ow, int ldo, int ntiles, int wave_limit, int tid, int lane) {
    constexpr int KROW = DQK + 8, VROW = KT + 8, KS = DQK / 32, ET = DV / 16, NKT = KT / 16, KBYTES = KT * KROW * 2, BUF = KBYTES + DV * VROW * 2;
    constexpr int KP = KT * DQK / 8, VPR = KT / 8, VP = DV * VPR, NKP = (KP + 511) / 512, NVP = (VP + 511) / 512, NP = NKP > NVP ? NKP : NVP;
    const int fr = lane & 15, fq = lane >> 4;
    bf16x8 qf[KS];
#pragma unroll
    for (int s = 0; s < KS; ++s) qf[s] = *(const bf16x8*)(Qw + (size_t)fr * ldq + 32 * s + 8 * fq);
    f32x4 ot[ET];
#pragma unroll
    for (int e = 0; e < ET; ++e) ot[e] = (f32x4){0.f, 0.f, 0.f, 0.f};
    float m_run = -1e30f, l_run = 0.f;
    u32x4 preg[NP];
#define FL_LOADK(j_) do { _Pragma("unroll") for (int i = 0; i < NKP; ++i) { const int idx = tid + i * 512; if (idx < KP) { const int row = idx / (DQK / 8), pc = idx % (DQK / 8); \
            preg[i] = *(const u32x4*)(Kb + (size_t)((j_) * KT + row) * ldk + pc * 8); } } } while (0)
#define FL_LOADV(j_) do { _Pragma("unroll") for (int i = 0; i < NVP; ++i) { const int idx = tid + i * 512; if (idx < VP) { const int row = idx / VPR, pc = idx % VPR; \
            preg[i] = *(const u32x4*)(VTb + (size_t)(j_) * vts + (size_t)row * ldv + pc * 8); } } } while (0)
#define FL_STOREK(buf_) do { LAS bf16_t* Kt_ = (LAS bf16_t*)(lds + (buf_) * BUF); \
        _Pragma("unroll") for (int i = 0; i < NKP; ++i) { const int idx = tid + i * 512; if (idx < KP) { const int row = idx / (DQK / 8), pc = idx % (DQK / 8); *(LAS u32x4*)(Kt_ + row * KROW + pc * 8) = preg[i]; } } } while (0)
#define FL_STOREV(buf_) do { LAS bf16_t* Vt_ = (LAS bf16_t*)(lds + (buf_) * BUF + KBYTES); \
        _Pragma("unroll") for (int i = 0; i < NVP; ++i) { const int idx = tid + i * 512; if (idx < VP) { const int row = idx / VPR, pc = idx % VPR; *(LAS u32x4*)(Vt_ + row * VROW + pc * 8) = preg[i]; } } } while (0)
    FL_LOADK(0); FL_STOREK(0); FL_LOADV(0); FL_STOREV(0);
    __syncthreads();
#pragma unroll 1
    for (int j = 0; j < ntiles; ++j) {
        const bool more = j + 1 < ntiles, act = j < wave_limit;
        const LAS bf16_t* Kt = (const LAS bf16_t*)(lds + (j & 1) * BUF); const LAS bf16_t* Vt = (const LAS bf16_t*)(lds + (j & 1) * BUF + KBYTES);
        if (more) FL_LOADK(j + 1);
        f32x4 st[NKT];
        if (act) {
#pragma unroll
            for (int kt = 0; kt < NKT; ++kt) { f32x4 a = {0.f, 0.f, 0.f, 0.f};
#pragma unroll
                for (int s = 0; s < KS; ++s) { const bf16x8 kf = *(const LAS bf16x8*)(Kt + (kt * 16 + fr) * KROW + 32 * s + 8 * fq); a = mfma16(kf, qf[s], a); }
                st[kt] = a; }
        }
        if (more) { FL_STOREK((j + 1) & 1); FL_LOADV(j + 1); }
        if (act) {
            float mx = fmaxf(fmaxf(st[0].x, st[0].y), fmaxf(st[0].z, st[0].w));
#pragma unroll
            for (int kt = 1; kt < NKT; ++kt) mx = fmaxf(mx, fmaxf(fmaxf(st[kt].x, st[kt].y), fmaxf(st[kt].z, st[kt].w)));
            mx = fmaxf(mx, __shfl_xor(mx, 16)); mx = fmaxf(mx, __shfl_xor(mx, 32));
            const float m_new = fmaxf(m_run, mx), alpha = exp2f(m_run - m_new);
            float ls = 0.f;
#pragma unroll
            for (int kt = 0; kt < NKT; ++kt)
#pragma unroll
                for (int r = 0; r < 4; ++r) { const float p = exp2f(st[kt][r] - m_new); st[kt][r] = p; ls += p; }
            l_run = l_run * alpha + ls; m_run = m_new;
#pragma unroll
            for (int e = 0; e < ET; ++e) ot[e] = ot[e] * alpha;
            bf16x8 pf[NKT / 2];
#pragma unroll
            for (int k2 = 0; k2 < NKT / 2; ++k2) pf[k2] = pack8(st[2 * k2], st[2 * k2 + 1]);
#pragma unroll
            for (int e = 0; e < ET; ++e) {
                const LAS bf16_t* vr = Vt + (e * 16 + fr) * VROW + 4 * fq;
#pragma unroll
                for (int k2 = 0; k2 < NKT / 2; ++k2) { const bf16x8 v0 = mk8(*(const LAS u32x2*)(vr + 32 * k2), *(const LAS u32x2*)(vr + 32 * k2 + 16)); ot[e] = mfma16(v0, pf[k2], ot[e]); }
            }
        }
        if (more) FL_STOREV((j + 1) & 1);
        __syncthreads();
    }
#undef FL_LOADK
#undef FL_LOADV
#undef FL_STOREK
#undef FL_STOREV
    l_run += __shfl_xor(l_run, 16); l_run += __shfl_xor(l_run, 32);
    const float inv = 1.0f / l_run;
#pragma unroll
    for (int e = 0; e < ET; ++e) { u32x2 w; w.x = pk2(ot[e].x * inv, ot[e].y * inv); w.y = pk2(ot[e].z * inv, ot[e].w * inv);
        *(u32x2*)(Ow + (size_t)fr * ldo + e * 16 + 4 * fq) = w; }
}
__device__ __forceinline__ void mla_attn_item(const Params& P, LAS unsigned char* lds, int it, int tid, int wave, int lane) {
    const int qt = 15 - (it >> 6), bh = it & 63;
    const bf16_t* Q = (const bf16_t*)(P.ws + WS_XB + MLA_Q_OFF) + ((size_t)bh * SEQ + qt * 128 + wave * 16) * 96;
    const bf16_t* K = (const bf16_t*)(P.ws + WS_XB + MLA_K_OFF) + (size_t)bh * SEQ * 96;
    const bf16_t* VT = (const bf16_t*)(P.ws + WS_XB + MLA_VT_OFF) + (size_t)bh * NCHUNK * 4096;
    bf16_t* y = (bf16_t*)(P.ws + WS_R + R_Y) + ((size_t)(bh >> 2) * SEQ + qt * 128 + wave * 16) * DM + 512 + (bh & 3) * 64;
    flash_item<96, 64, 64>(lds, Q, 96, K, 96, VT, 64, 4096, y, DM, 2 * qt + 2, 2 * qt + (wave >> 2) + 1, tid, lane);
}
__device__ __forceinline__ void xa_item(const Params& P, int l, LAS unsigned char* lds, int it, int tid, int wave, int lane) {
    const int qt = it & 15, h = (it >> 4) & 3, b = it >> 6;
    const size_t qoff = ((size_t)b * SEQ + qt * 128 + wave * 16) * DM + h * 256;
    const bf16_t* Q = (const bf16_t*)(P.ws + WS_R) + qoff; bf16_t* O = (bf16_t*)(P.ws + WS_R + R_OX) + qoff;
    const bf16_t* K = (const bf16_t*)(P.ws + WS_KVM + (size_t)l * KVM_LAYER) + (size_t)b * NMEM * DM + h * 256;
    const bf16_t* VT = (const bf16_t*)(P.ws + WS_KVM + (size_t)l * KVM_LAYER + (size_t)4096 * 1024 * 2) + (size_t)h * 256 * 4096 + b * NMEM;
    flash_item<256, 256, 32>(lds, Q, DM, K, DM, VT, 4096, 32, O, DM, 8, 8, tid, lane);
}

constexpr int GP_KN = 0, GP_KB = 9216, GP_QN = 18432, GP_L = 9216, GP_RHS = 27648, GP_G = 60416, GP_GC = 60672, GP_HEAD = 61440;
__device__ __forceinline__ bf16_t* gdn_buf(const Params& P, int chh, int k) { return (bf16_t*)(P.ws + WS_GDN) + ((size_t)chh * 5 + k) * 4096; }
__device__ __forceinline__ void gdn_pre_item(const Params& P, int l, LAS unsigned char* lds, int it, int tid) {
    const int hp = it & 1, n = (it >> 1) & 31, b = it >> 6;
    const int hh = tid >> 8, h = 2 * hp + hh, tt = tid & 255, c = tt >> 2, qr = tt & 3, lane = tid & 63;
    LAS unsigned char* L = lds + hh * GP_HEAD;
    const bf16_t* z = (const bf16_t*)(P.ws + WS_R);
    const int s = n * 64 + c; const size_t tok = (size_t)b * SEQ + s;
    const float* cw = P.gdn_conv_w + (size_t)l * 4 * 768;
    const int chh = (b * NCHUNK + n) * 4 + h;
    float q[16], k[16], v[16];
#pragma unroll
    for (int part = 0; part < 3; ++part) {
        float* dst = part == 0 ? q : (part == 1 ? k : v);
        const int ch0 = part * 256 + h * 64 + qr * 16;
#pragma unroll
        for (int i = 0; i < 16; ++i) dst[i] = 0.f;
#pragma unroll
        for (int kk = 0; kk < 4; ++kk) { if (s - 3 + kk >= 0) {
            const bf16_t* zr = z + (tok - 3 + kk) * ZP + Z_GQKV + ch0; const u32x4 w0 = *(const u32x4*)zr, w1 = *(const u32x4*)(zr + 8);
            const float* wr = cw + kk * 768 + ch0; const f32x4 c0 = *(const f32x4*)wr, c1 = *(const f32x4*)(wr + 4), c2 = *(const f32x4*)(wr + 8), c3 = *(const f32x4*)(wr + 12);
            dst[0] += c0.x * bflo(w0.x); dst[1] += c0.y * bfhi(w0.x); dst[2] += c0.z * bflo(w0.y); dst[3] += c0.w * bfhi(w0.y);
            dst[4] += c1.x * bflo(w0.z); dst[5] += c1.y * bfhi(w0.z); dst[6] += c1.z * bflo(w0.w); dst[7] += c1.w * bfhi(w0.w);
            dst[8] += c2.x * bflo(w1.x); dst[9] += c2.y * bfhi(w1.x); dst[10] += c2.z * bflo(w1.y); dst[11] += c2.w * bfhi(w1.y);
            dst[12] += c3.x * bflo(w1.z); dst[13] += c3.y * bfhi(w1.z); dst[14] += c3.z * bflo(w1.w); dst[15] += c3.w * bfhi(w1.w); } }
#pragma unroll
        for (int i = 0; i < 16; ++i) dst[i] = siluf_(dst[i]);
    }
    float sq = 0.f, sk = 0.f;
#pragma unroll
    for (int i = 0; i < 16; ++i) { sq += q[i] * q[i]; sk += k[i] * k[i]; }
    sq += __shfl_xor(sq, 1); sq += __shfl_xor(sq, 2); sk += __shfl_xor(sk, 1); sk += __shfl_xor(sk, 2);
    const float rq = rsqrtf(sq + EPS) * 0.125f, rk = rsqrtf(sk + EPS);
    const bf16_t* zt = z + tok * ZP;
    const float beta = sigmoidf_(bf2f(zt[Z_GB + h]));
    const float g = -__expf(P.gdn_a_log[l * 4 + h]) * softplusf_(bf2f(zt[Z_GA + h]) + P.gdn_dt_bias[l * 4 + h]);
    {
        u32x4 w0, w1;
#define PK16(dst0, dst1, src, sc) do { dst0.x = pk2(src[0] * (sc), src[1] * (sc)); dst0.y = pk2(src[2] * (sc), src[3] * (sc)); dst0.z = pk2(src[4] * (sc), src[5] * (sc)); dst0.w = pk2(src[6] * (sc), src[7] * (sc)); \
        dst1.x = pk2(src[8] * (sc), src[9] * (sc)); dst1.y = pk2(src[10] * (sc), src[11] * (sc)); dst1.z = pk2(src[12] * (sc), src[13] * (sc)); dst1.w = pk2(src[14] * (sc), src[15] * (sc)); } while (0)
        PK16(w0, w1, k, rk);        *(LAS u32x4*)(L + GP_KN + (c * 72 + qr * 16) * 2) = w0; *(LAS u32x4*)(L + GP_KN + (c * 72 + qr * 16 + 8) * 2) = w1;
        PK16(w0, w1, k, rk * beta); *(LAS u32x4*)(L + GP_KB + (c * 72 + qr * 16) * 2) = w0; *(LAS u32x4*)(L + GP_KB + (c * 72 + qr * 16 + 8) * 2) = w1;
        PK16(w0, w1, q, rq);        *(LAS u32x4*)(L + GP_QN + (c * 72 + qr * 16) * 2) = w0; *(LAS u32x4*)(L + GP_QN + (c * 72 + qr * 16 + 8) * 2) = w1;
        LAS float* rhs = (LAS float*)(L + GP_RHS) + c * 128 + qr * 16;
#pragma unroll
        for (int i = 0; i < 4; ++i) *(LAS f32x4*)(rhs + 4 * i) = (f32x4){v[4 * i] * beta, v[4 * i + 1] * beta, v[4 * i + 2] * beta, v[4 * i + 3] * beta};
        if (qr == 0) ((LAS float*)(L + GP_G))[c] = g;
    }
    __syncthreads();
    {
        float gc = 0.f, run = 0.f; const LAS float* G = (const LAS float*)(L + GP_G);
        for (int i = 0; i < 64; ++i) { run += G[i]; gc = (i == c) ? run : gc; }
        const float eg = __expf(gc), ek = __expf(run - gc);
        LAS float* rhs = (LAS float*)(L + GP_RHS) + c * 128 + 64 + qr * 16;
#pragma unroll
        for (int i = 0; i < 4; ++i) *(LAS f32x4*)(rhs + 4 * i) = (f32x4){k[4 * i] * rk * beta * eg, k[4 * i + 1] * rk * beta * eg, k[4 * i + 2] * rk * beta * eg, k[4 * i + 3] * rk * beta * eg};
        u32x4 w0, w1; PK16(w0, w1, q, rq * eg);
        bf16_t* qd = gdn_buf(P, chh, 3) + c * 64 + qr * 16; *(u32x4*)qd = w0; *(u32x4*)(qd + 8) = w1;
        bf16_t* kdt = gdn_buf(P, chh, 4) + (qr * 16) * 64 + c;
#pragma unroll
        for (int i = 0; i < 16; ++i) kdt[i * 64] = f2bf(k[i] * rk * ek);
        if (qr == 0) ((LAS float*)(L + GP_GC))[c] = gc;
        if (tt == 0) ((float*)(P.ws + WS_GL))[chh] = __expf(run);
    }
#undef PK16
    __syncthreads();
    {
        const int it4 = (tid >> 6) & 3, fr = lane & 15, fq = lane >> 4;
        const LAS bf16_t* Kn = (const LAS bf16_t*)(L + GP_KN); const LAS bf16_t* KB = (const LAS bf16_t*)(L + GP_KB); const LAS bf16_t* Qn = (const LAS bf16_t*)(L + GP_QN);
        const LAS float* GC = (const LAS float*)(L + GP_GC);
        const bf16x8 a0 = *(const LAS bf16x8*)(KB + (it4 * 16 + fr) * 72 + 8 * fq), a1 = *(const LAS bf16x8*)(KB + (it4 * 16 + fr) * 72 + 32 + 8 * fq);
        const bf16x8 q0 = *(const LAS bf16x8*)(Qn + (it4 * 16 + fr) * 72 + 8 * fq), q1 = *(const LAS bf16x8*)(Qn + (it4 * 16 + fr) * 72 + 32 + 8 * fq);
        float gci[4];
#pragma unroll
        for (int r = 0; r < 4; ++r) gci[r] = GC[it4 * 16 + 4 * fq + r];
        f32x4 lv[4]; bf16_t* att = gdn_buf(P, chh, 2);
#pragma unroll
        for (int jt = 0; jt < 4; ++jt) {
            const bf16x8 b0 = *(const LAS bf16x8*)(Kn + (jt * 16 + fr) * 72 + 8 * fq), b1 = *(const LAS bf16x8*)(Kn + (jt * 16 + fr) * 72 + 32 + 8 * fq);
            f32x4 al = {0.f, 0.f, 0.f, 0.f}, aa = {0.f, 0.f, 0.f, 0.f};
            al = mfma16(a0, b0, al); al = mfma16(a1, b1, al); aa = mfma16(q0, b0, aa); aa = mfma16(q1, b1, aa);
            const int j = jt * 16 + fr; const float gcj = GC[j];
#pragma unroll
            for (int r = 0; r < 4; ++r) { const int i = it4 * 16 + 4 * fq + r; const float dec = __expf(fminf(gci[r] - gcj, 0.f));
                lv[jt][r] = (i > j) ? al[r] * dec : 0.f; att[i * 64 + j] = f2bf((i >= j) ? aa[r] * dec : 0.f); }
        }
        __syncthreads();
        LAS float* Lm = (LAS float*)(L + GP_L);
#pragma unroll
        for (int jt = 0; jt < 4; ++jt)
#pragma unroll
            for (int r = 0; r < 4; ++r) Lm[(it4 * 16 + 4 * fq + r) * 64 + jt * 16 + fr] = lv[jt][r];
    }
    __syncthreads();
    if (tt < 128) {
        const LAS float* Lm = (const LAS float*)(L + GP_L); const LAS float* rhs = (const LAS float*)(L + GP_RHS) + tt;
        float x[64];
#pragma unroll
        for (int i = 0; i < 64; ++i) {
            float a0 = rhs[i * 128], a1 = 0.f;
#pragma unroll
            for (int j4 = 0; j4 < (i + 3) / 4; ++j4) { const f32x4 lr = *(const LAS f32x4*)(Lm + i * 64 + 4 * j4);
                if (4 * j4 + 0 < i) a0 -= lr.x * x[4 * j4 + 0]; if (4 * j4 + 1 < i) a1 -= lr.y * x[4 * j4 + 1];
                if (4 * j4 + 2 < i) a0 -= lr.z * x[4 * j4 + 2]; if (4 * j4 + 3 < i) a1 -= lr.w * x[4 * j4 + 3]; }
            x[i] = a0 + a1;
        }
        if (tt < 64) { bf16_t* ut = gdn_buf(P, chh, 1) + tt * 64;
#pragma unroll
            for (int g8 = 0; g8 < 8; ++g8) { u32x4 w; w.x = pk2(x[8 * g8], x[8 * g8 + 1]); w.y = pk2(x[8 * g8 + 2], x[8 * g8 + 3]); w.z = pk2(x[8 * g8 + 4], x[8 * g8 + 5]); w.w = pk2(x[8 * g8 + 6], x[8 * g8 + 7]); *(u32x4*)(ut + 8 * g8) = w; }
        } else { bf16_t* wo = gdn_buf(P, chh, 0) + (tt - 64);
#pragma unroll
            for (int i = 0; i < 64; ++i) wo[i * 64] = f2bf(x[i]); }
    }
    __syncthreads();
}

constexpr int GC_W = 0, GC_UT = 9216, GC_ATT = 18432, GC_QD = 27648, GC_KDT = 36864, GC_O = 46080, GC_BH = 62720;
__device__ __forceinline__ bf16x8 lds_perm(const LAS unsigned char* M, int row, int s, int fq) { const LAS unsigned char* p = M + row * 144 + 64 * s + 8 * fq; return mk8(*(const LAS u32x2*)p, *(const LAS u32x2*)(p + 32)); }
__device__ __forceinline__ void gdn_chain_item(const Params& P, int l, LAS unsigned char* lds, int gi, int tid, int wave, int lane) {
    const int q2 = wave >> 2, bh = gi * 2 + q2, eb = wave & 3, b = bh >> 2, h = bh & 3, fr = lane & 15, fq = lane >> 4;
    const bf16_t* z = (const bf16_t*)(P.ws + WS_R); bf16_t* y = (bf16_t*)(P.ws + WS_R + R_Y);
    LAS unsigned char* L = lds + q2 * GC_BH;
    const int tt = tid & 255, ec = tt >> 2, eq = tt & 3;
    float ng[16];
#pragma unroll
    for (int j = 0; j < 16; ++j) ng[j] = P.gdn_norm[l * 64 + eq * 16 + j];
    u32x4 stg[10];
    const bf16_t* src0[2] = { gdn_buf(P, ((gi * 2 >> 2) * NCHUNK) * 4 + ((gi * 2) & 3), 0), gdn_buf(P, (((gi * 2 + 1) >> 2) * NCHUNK) * 4 + ((gi * 2 + 1) & 3), 0) };
#define GC_LOAD(n_) do { _Pragma("unroll") for (int i = 0; i < 10; ++i) { const int p = tid + 512 * i, qq = p / 2560, pp = p % 2560; \
        stg[i] = *(const u32x4*)(src0[qq] + (size_t)(n_) * 4 * 5 * 4096 + (size_t)pp * 8); } } while (0)
#define GC_WRITE() do { _Pragma("unroll") for (int i = 0; i < 10; ++i) { const int p = tid + 512 * i, qq = p / 2560, pp = p % 2560, mat = pp >> 9, row = (pp & 511) >> 3, pc = pp & 7; \
        *(LAS u32x4*)(lds + qq * GC_BH + mat * 9216 + row * 144 + pc * 16) = stg[i]; } } while (0)
    GC_LOAD(0); GC_WRITE();
    f32x4 S[4];
#pragma unroll
    for (int t = 0; t < 4; ++t) S[t] = (f32x4){0.f, 0.f, 0.f, 0.f};
    __syncthreads();
    for (int n = 0; n < NCHUNK; ++n) {
        const int chh = (b * NCHUNK + n) * 4 + h;
        if (n + 1 < NCHUNK) GC_LOAD(n + 1);
        const size_t etok = (size_t)(gi * 2 + (tid >> 8) >> 2) * SEQ + n * 64 + ec; const int eh = (gi * 2 + (tid >> 8)) & 3;
        const u32x4 gw0 = *(const u32x4*)(z + etok * ZP + Z_GG + eh * 64 + eq * 16), gw1 = *(const u32x4*)(z + etok * ZP + Z_GG + eh * 64 + eq * 16 + 8);
        const float egl = ((const float*)(P.ws + WS_GL))[chh];
        const bf16x8 sb0 = pack8(S[0], S[1]), sb1 = pack8(S[2], S[3]);
        f32x4 vn[4], o[4];
#pragma unroll
        for (int ct = 0; ct < 4; ++ct) {
            f32x4 a = {0.f, 0.f, 0.f, 0.f}; a = mfma16(lds_perm(L + GC_W, ct * 16 + fr, 0, fq), sb0, a); a = mfma16(lds_perm(L + GC_W, ct * 16 + fr, 1, fq), sb1, a);
            const u32x2 uw = *(const LAS u32x2*)(L + GC_UT + (eb * 16 + fr) * 144 + (ct * 16 + 4 * fq) * 2);
            vn[ct] = (f32x4){bflo(uw.x) - a.x, bfhi(uw.x) - a.y, bflo(uw.y) - a.z, bfhi(uw.y) - a.w};
            f32x4 oo = {0.f, 0.f, 0.f, 0.f}; oo = mfma16(lds_perm(L + GC_QD, ct * 16 + fr, 0, fq), sb0, oo); oo = mfma16(lds_perm(L + GC_QD, ct * 16 + fr, 1, fq), sb1, oo); o[ct] = oo;
        }
        const bf16x8 vb0 = pack8(vn[0], vn[1]), vb1 = pack8(vn[2], vn[3]);
#pragma unroll
        for (int ct = 0; ct < 4; ++ct) { o[ct] = mfma16(lds_perm(L + GC_ATT, ct * 16 + fr, 0, fq), vb0, o[ct]); o[ct] = mfma16(lds_perm(L + GC_ATT, ct * 16 + fr, 1, fq), vb1, o[ct]); }
#pragma unroll
        for (int dt = 0; dt < 4; ++dt) { f32x4 a = S[dt] * egl; a = mfma16(lds_perm(L + GC_KDT, dt * 16 + fr, 0, fq), vb0, a); a = mfma16(lds_perm(L + GC_KDT, dt * 16 + fr, 1, fq), vb1, a); S[dt] = a; }
        LAS float* Ol = (LAS float*)(L + GC_O);
#pragma unroll
        for (int ct = 0; ct < 4; ++ct)
#pragma unroll
            for (int r = 0; r < 4; ++r) Ol[(ct * 16 + 4 * fq + r) * 65 + eb * 16 + fr] = o[ct][r];
        __syncthreads();
        if (n + 1 < NCHUNK) GC_WRITE();
        {
            const LAS float* orow = (const LAS float*)(lds + (tid >> 8) * GC_BH + GC_O) + ec * 65 + eq * 16;
            float ov[16]; float s2 = 0.f;
#pragma unroll
            for (int j = 0; j < 16; ++j) { ov[j] = orow[j]; s2 += ov[j] * ov[j]; }
            s2 += __shfl_xor(s2, 1); s2 += __shfl_xor(s2, 2);
            const float rs = rsqrtf(s2 * (1.0f / 64.0f) + EPS);
            const unsigned gws[8] = {gw0.x, gw0.y, gw0.z, gw0.w, gw1.x, gw1.y, gw1.z, gw1.w};
            unsigned ow[8];
#pragma unroll
            for (int j = 0; j < 8; ++j) ow[j] = pk2(ov[2 * j] * rs * ng[2 * j] * siluf_(bflo(gws[j])), ov[2 * j + 1] * rs * ng[2 * j + 1] * siluf_(bfhi(gws[j])));
            bf16_t* yp = y + etok * DM + 768 + eh * 64 + eq * 16;
            *(u32x4*)yp = (u32x4){ow[0], ow[1], ow[2], ow[3]}; *(u32x4*)(yp + 8) = (u32x4){ow[4], ow[5], ow[6], ow[7]};
        }
        __syncthreads();
    }
#undef GC_LOAD
#undef GC_WRITE
}

constexpr int RT_BUF = 36864, RT_Q = 0, RT_K = 9216, RT_KZT = 18432, RT_VT = 27648, RT_P = 73728, RT_ST = 82944, RT_O = 92160;
__device__ __forceinline__ void ret_chain_item(const Params& P, int l, LAS unsigned char* lds, int it, int tid, int wave, int lane) {
    const int b = it >> 2, h = it & 3, fr = lane & 15, fq = lane >> 4;
    const bf16_t* z = (const bf16_t*)(P.ws + WS_R); bf16_t* y = (bf16_t*)(P.ws + WS_R + R_Y);
    LAS bf16_t* Pm = (LAS bf16_t*)(lds + RT_P); LAS bf16_t* ST = (LAS bf16_t*)(lds + RT_ST); LAS float* Of = (LAS float*)(lds + RT_O);
    const float lg = log1pf(-exp2f(-5.0f - (float)h));
    const float cdec = __expf(64.0f * lg);
    for (int i = tid; i < 64 * 72 / 2; i += 512) ((LAS unsigned*)ST)[i] = 0u;
    const int it4 = wave >> 1, jt0 = 2 * (wave & 1);
    f32x4 S[2] = {{0.f, 0.f, 0.f, 0.f}, {0.f, 0.f, 0.f, 0.f}};
    const int lc = tid >> 3, pg = tid & 7;
    float invf[4];
#pragma unroll
    for (int ii = 0; ii < 4; ++ii) invf[ii] = exp2f(-(float)(4 * pg + ii) * (13.287712379549449f / 32.0f));
    const float zeta = __expf((63.0f - (float)lc) * lg);
    const f32x4 gn0 = *(const f32x4*)(P.ret_gn + l * 256 + h * 64 + 8 * pg), gn1 = *(const f32x4*)(P.ret_gn + l * 256 + h * 64 + 8 * pg + 4);
    const size_t tok0 = (size_t)b * SEQ + lc;
    u32x2 q1w, q2w, k1w, k2w; u32x4 vw; int posi;
#define RT_LOAD(n_) do { const bf16_t* zr_ = z + (tok0 + (n_) * 64) * ZP; q1w = *(const u32x2*)(zr_ + Z_RQ + h * 64 + 4 * pg); q2w = *(const u32x2*)(zr_ + Z_RQ + h * 64 + 32 + 4 * pg); \
        k1w = *(const u32x2*)(zr_ + Z_RK + h * 64 + 4 * pg); k2w = *(const u32x2*)(zr_ + Z_RK + h * 64 + 32 + 4 * pg); vw = *(const u32x4*)(zr_ + Z_RV + h * 64 + 8 * pg); posi = P.pos[tok0 + (n_) * 64]; } while (0)
#define RT_STAGE(buf_) do { LAS bf16_t* Qs_ = (LAS bf16_t*)(lds + (buf_) * RT_BUF + RT_Q); LAS bf16_t* Ks_ = (LAS bf16_t*)(lds + (buf_) * RT_BUF + RT_K); \
        LAS bf16_t* KzT_ = (LAS bf16_t*)(lds + (buf_) * RT_BUF + RT_KZT); LAS bf16_t* VT_ = (LAS bf16_t*)(lds + (buf_) * RT_BUF + RT_VT); const float pos = (float)posi; \
        const float q1[4] = {bflo(q1w.x), bfhi(q1w.x), bflo(q1w.y), bfhi(q1w.y)}, q2[4] = {bflo(q2w.x), bfhi(q2w.x), bflo(q2w.y), bfhi(q2w.y)}; \
        const float k1[4] = {bflo(k1w.x), bfhi(k1w.x), bflo(k1w.y), bfhi(k1w.y)}, k2[4] = {bflo(k2w.x), bfhi(k2w.x), bflo(k2w.y), bfhi(k2w.y)}; \
        float qa[4], qb[4], ka[4], kb[4]; \
        _Pragma("unroll") for (int ii = 0; ii < 4; ++ii) { float sn, cs; sincos_rev(pos * invf[ii], sn, cs); \
            qa[ii] = (q1[ii] * cs - q2[ii] * sn) * 0.125f; qb[ii] = (q1[ii] * sn + q2[ii] * cs) * 0.125f; ka[ii] = k1[ii] * cs - k2[ii] * sn; kb[ii] = k1[ii] * sn + k2[ii] * cs; } \
        u32x2 w_; w_.x = pk2(qa[0], qa[1]); w_.y = pk2(qa[2], qa[3]); *(LAS u32x2*)(Qs_ + lc * 72 + 4 * pg) = w_; \
        w_.x = pk2(qb[0], qb[1]); w_.y = pk2(qb[2], qb[3]); *(LAS u32x2*)(Qs_ + lc * 72 + 32 + 4 * pg) = w_; \
        w_.x = pk2(ka[0], ka[1]); w_.y = pk2(ka[2], ka[3]); *(LAS u32x2*)(Ks_ + lc * 72 + 4 * pg) = w_; \
        w_.x = pk2(kb[0], kb[1]); w_.y = pk2(kb[2], kb[3]); *(LAS u32x2*)(Ks_ + lc * 72 + 32 + 4 * pg) = w_; \
        _Pragma("unroll") for (int ii = 0; ii < 4; ++ii) { KzT_[(4 * pg + ii) * 72 + lc] = f2bf(ka[ii] * zeta); KzT_[(32 + 4 * pg + ii) * 72 + lc] = f2bf(kb[ii] * zeta); } \
        const unsigned vv[4] = {vw.x, vw.y, vw.z, vw.w}; \
        _Pragma("unroll") for (int ii = 0; ii < 4; ++ii) { VT_[(8 * pg + 2 * ii) * 72 + lc] = (bf16_t)(vv[ii] & 0xffffu); VT_[(8 * pg + 2 * ii + 1) * 72 + lc] = (bf16_t)(vv[ii] >> 16); } } while (0)
    RT_LOAD(0); RT_STAGE(0);
    __syncthreads();
    for (int n = 0; n < NCHUNK; ++n) {
        const int cb = n & 1;
        const LAS bf16_t* Qs = (const LAS bf16_t*)(lds + cb * RT_BUF + RT_Q); const LAS bf16_t* Ks = (const LAS bf16_t*)(lds + cb * RT_BUF + RT_K);
        const LAS bf16_t* KzT = (const LAS bf16_t*)(lds + cb * RT_BUF + RT_KZT); const LAS bf16_t* VT = (const LAS bf16_t*)(lds + cb * RT_BUF + RT_VT);
        const size_t tok = tok0 + n * 64;
        if (n + 1 < NCHUNK) RT_LOAD(n + 1);
        const u32x4 gw = *(const u32x4*)(z + tok * ZP + Z_RG + h * 64 + 8 * pg);
        const bf16x8 a0 = *(const LAS bf16x8*)(Qs + (it4 * 16 + fr) * 72 + 8 * fq), a1 = *(const LAS bf16x8*)(Qs + (it4 * 16 + fr) * 72 + 32 + 8 * fq);
        f32x4 cross[2];
#pragma unroll
        for (int t = 0; t < 2; ++t) { const int jt = jt0 + t;
            f32x4 p = {0.f, 0.f, 0.f, 0.f};
            p = mfma16(a0, *(const LAS bf16x8*)(Ks + (jt * 16 + fr) * 72 + 8 * fq), p); p = mfma16(a1, *(const LAS bf16x8*)(Ks + (jt * 16 + fr) * 72 + 32 + 8 * fq), p);
            f32x4 cr = {0.f, 0.f, 0.f, 0.f};
            cr = mfma16(a0, *(const LAS bf16x8*)(ST + (jt * 16 + fr) * 72 + 8 * fq), cr); cr = mfma16(a1, *(const LAS bf16x8*)(ST + (jt * 16 + fr) * 72 + 32 + 8 * fq), cr);
#pragma unroll
            for (int r = 0; r < 4; ++r) { const int i = it4 * 16 + 4 * fq + r, j = jt * 16 + fr; const int dd = i > j ? i - j : j - i;
                Pm[i * 72 + j] = f2bf(p[r] * __expf((float)dd * lg)); cr[r] *= __expf((float)(i + 1) * lg); }
            cross[t] = cr; }
        __syncthreads();
        const bf16x8 p0 = *(const LAS bf16x8*)(Pm + (it4 * 16 + fr) * 72 + 8 * fq), p1 = *(const LAS bf16x8*)(Pm + (it4 * 16 + fr) * 72 + 32 + 8 * fq);
        const bf16x8 kz0 = *(const LAS bf16x8*)(KzT + (it4 * 16 + fr) * 72 + 8 * fq), kz1 = *(const LAS bf16x8*)(KzT + (it4 * 16 + fr) * 72 + 32 + 8 * fq);
#pragma unroll
        for (int t = 0; t < 2; ++t) { const int et = jt0 + t;
            const bf16x8 v0 = *(const LAS bf16x8*)(VT + (et * 16 + fr) * 72 + 8 * fq), v1 = *(const LAS bf16x8*)(VT + (et * 16 + fr) * 72 + 32 + 8 * fq);
            f32x4 o = cross[t]; o = mfma16(p0, v0, o); o = mfma16(p1, v1, o);
#pragma unroll
            for (int r = 0; r < 4; ++r) Of[(it4 * 16 + 4 * fq + r) * 65 + et * 16 + fr] = o[r];
            f32x4 sN = S[t] * cdec; sN = mfma16(kz0, v0, sN); sN = mfma16(kz1, v1, sN); S[t] = sN;
            u32x2 w; w.x = pk2(sN.x, sN.y); w.y = pk2(sN.z, sN.w); *(LAS u32x2*)(ST + (et * 16 + fr) * 72 + it4 * 16 + 4 * fq) = w; }
        if (n + 1 < NCHUNK) RT_STAGE(cb ^ 1);
        __syncthreads();
        {
            float ov[8]; float sm = 0.f;
#pragma unroll
            for (int j = 0; j < 8; ++j) { ov[j] = Of[lc * 65 + 8 * pg + j]; sm += ov[j]; }
            sm += __shfl_xor(sm, 1); sm += __shfl_xor(sm, 2); sm += __shfl_xor(sm, 4);
            const float mu = sm * (1.0f / 64.0f); float vs = 0.f;
#pragma unroll
            for (int j = 0; j < 8; ++j) { ov[j] -= mu; vs += ov[j] * ov[j]; }
            vs += __shfl_xor(vs, 1); vs += __shfl_xor(vs, 2); vs += __shfl_xor(vs, 4);
            const float rs = rsqrtf(vs * (1.0f / 64.0f) + EPS);
            const float gt[8] = {bflo(gw.x), bfhi(gw.x), bflo(gw.y), bfhi(gw.y), bflo(gw.z), bfhi(gw.z), bflo(gw.w), bfhi(gw.w)};
            const float gnv[8] = {gn0.x, gn0.y, gn0.z, gn0.w, gn1.x, gn1.y, gn1.z, gn1.w};
            float r8[8];
#pragma unroll
            for (int j = 0; j < 8; ++j) r8[j] = ov[j] * rs * gnv[j] * siluf_(gt[j]);
            u32x4 w; w.x = pk2(r8[0], r8[1]); w.y = pk2(r8[2], r8[3]); w.z = pk2(r8[4], r8[5]); w.w = pk2(r8[6], r8[7]);
            *(u32x4*)(y + tok * DM + h * 64 + 8 * pg) = w;
        }
    }
#undef RT_LOAD
#undef RT_STAGE
    __syncthreads();
}

constexpr int LR_XC = 0, LR_AU = 33792, LR_HIN = 99584;
__device__ __forceinline__ void lru_item(const Params& P, int l, LAS unsigned char* lds, int it, int mode, int tid, int wave, int lane) {
    const int b = it >> 5, n = it & 31, fr = lane & 15, fq = lane >> 4;
    const bf16_t* z = (const bf16_t*)(P.ws + WS_R); bf16_t* y = (bf16_t*)(P.ws + WS_R + R_Y);
    LAS bf16_t* XC = (LAS bf16_t*)(lds + LR_XC); LAS f32x2* AU = (LAS f32x2*)(lds + LR_AU); LAS float* HIN = (LAS float*)(lds + LR_HIN);
    float* sumA = (float*)(P.ws + WS_LRUS); float* sumH = sumA + 16 * 32 * 256;
    {
        const int c = tid >> 3, cg = tid & 7, s = n * 64 + c; const size_t tok = (size_t)b * SEQ + s;
        const float* cw = P.lru_conv_w + (size_t)l * 4 * 256; const float* cb = P.lru_conv_b + l * 256;
#pragma unroll
        for (int g = 0; g < 4; ++g) { const int ch0 = cg * 32 + g * 8;
            const f32x4 b0 = *(const f32x4*)(cb + ch0), b1 = *(const f32x4*)(cb + ch0 + 4);
            float a[8] = {b0.x, b0.y, b0.z, b0.w, b1.x, b1.y, b1.z, b1.w};
#pragma unroll
            for (int kk = 0; kk < 4; ++kk) if (s - 3 + kk >= 0) { const u32x4 w = *(const u32x4*)(z + (tok - 3 + kk) * ZP + Z_LX + ch0);
                const f32x4 c0 = *(const f32x4*)(cw + kk * 256 + ch0), c1 = *(const f32x4*)(cw + kk * 256 + ch0 + 4);
                a[0] += c0.x * bflo(w.x); a[1] += c0.y * bfhi(w.x); a[2] += c0.z * bflo(w.y); a[3] += c0.w * bfhi(w.y);
                a[4] += c1.x * bflo(w.z); a[5] += c1.y * bfhi(w.z); a[6] += c1.z * bflo(w.w); a[7] += c1.w * bfhi(w.w); }
            u32x4 o; o.x = pk2(a[0], a[1]); o.y = pk2(a[2], a[3]); o.z = pk2(a[4], a[5]); o.w = pk2(a[6], a[7]);
            *(LAS u32x4*)(XC + c * 264 + ch0) = o; }
    }
    float hcar = 0.f, aprod = 1.f;
    if (tid < 256) {
        if (mode == 1) { for (int m = 0; m < n; ++m) hcar = sumA[(b * 32 + m) * 256 + tid] * hcar + sumH[(b * 32 + m) * 256 + tid]; }
    }
    const int nb = wave >> 1, rt = wave & 1;
    const bf16_t* wa = wl(P, l, W_A) + nb * 4096; const bf16_t* wx = wl(P, l, W_X) + nb * 4096;
    bf16x8 fa[4][2], fx[4][2]; float ba[4], bx[4], spl[4];
#pragma unroll
    for (int dt = 0; dt < 4; ++dt) {
#pragma unroll
        for (int s = 0; s < 2; ++s) { fa[dt][s] = *(const bf16x8*)(wa + (dt * 16 + fr) * 64 + 32 * s + 8 * fq); fx[dt][s] = *(const bf16x8*)(wx + (dt * 16 + fr) * 64 + 32 * s + 8 * fq); }
        const int d = nb * 64 + dt * 16 + fr; ba[dt] = P.lru_ba[l * 256 + d]; bx[dt] = P.lru_bx[l * 256 + d]; spl[dt] = softplusf_(-P.lru_lambda[l * 256 + d]); }
    __syncthreads();
    for (int half = 0; half < 2; ++half) {
        const int trow = half * 32 + rt * 16;
        const bf16x8 x0 = *(const LAS bf16x8*)(XC + (trow + fr) * 264 + nb * 64 + 8 * fq), x1 = *(const LAS bf16x8*)(XC + (trow + fr) * 264 + nb * 64 + 32 + 8 * fq);
#pragma unroll
        for (int dt = 0; dt < 4; ++dt) {
            f32x4 ar = {0.f, 0.f, 0.f, 0.f}, ai = {0.f, 0.f, 0.f, 0.f};
            ar = mfma16(x0, fa[dt][0], ar); ar = mfma16(x1, fa[dt][1], ar); ai = mfma16(x0, fx[dt][0], ai); ai = mfma16(x1, fx[dt][1], ai);
            const int d = nb * 64 + dt * 16 + fr;
#pragma unroll
            for (int r = 0; r < 4; ++r) { const int tl = rt * 16 + 4 * fq + r;
                const float xcv = bf2f(XC[(half * 32 + tl) * 264 + d]);
                const float rr = sigmoidf_(ar[r] + ba[dt]), ii = sigmoidf_(ai[r] + bx[dt]);
                const float la = -8.0f * rr * spl[dt]; const float a = __expf(la);
                const float u = sqrtf(-expm1f(2.0f * la)) * (ii * xcv);
                AU[tl * 257 + d] = (f32x2){a, u}; }
        }
        __syncthreads();
        if (tid < 256) {
            const size_t tok0 = (size_t)b * SEQ + n * 64 + half * 32;
            for (int tk = 0; tk < 32; ++tk) { const f32x2 au = AU[tk * 257 + tid]; hcar = au.x * hcar + au.y; aprod *= au.x;
                if (mode == 1) { const float gate = bf2f(z[(tok0 + tk) * ZP + Z_LG + tid]); y[(tok0 + tk) * DM + 256 + tid] = f2bf(hcar * geluf_(gate)); } }
        }
        __syncthreads();
    }
    if (mode == 0 && tid < 256) { sumA[(b * 32 + n) * 256 + tid] = aprod; sumH[(b * 32 + n) * 256 + tid] = hcar; }
}

constexpr int N_PHASES = 21;
constexpr int Q_RET = 64, Q_GDN = 32, Q_LRU = 512, Q_MLA = 1024, Q_TOTAL = Q_RET + Q_GDN + Q_LRU + Q_MLA;

__global__ void __launch_bounds__(512, 2) hymba_fwd(Params P_) {
    extern __shared__ __attribute__((aligned(16))) unsigned char lds_raw[];
    LAS unsigned char* lds = (LAS unsigned char*)lds_raw;
    volatile LAS unsigned* LC = (volatile LAS unsigned*)(lds + LDS_CTL);
    const int G = gridDim.x;
#define SUB_TID() int tid2 = tid; asm volatile("" : "+v"(tid2)); const int lane2 = tid2 & 63, wave2 = __builtin_amdgcn_readfirstlane(tid2 >> 6); (void)lane2; (void)wave2
#if defined(__HIP_DEVICE_COMPILE__)
#define PH_PARAMS() const __attribute__((address_space(4))) Params* pp_ = (const __attribute__((address_space(4))) Params*)__builtin_amdgcn_kernarg_segment_ptr(); asm volatile("" : "+s"(pp_)); const Params P = *pp_
#else
#define PH_PARAMS() const Params P = P_
#endif
#define PH_TID() PH_PARAMS(); \
    bf16_t* xb = (bf16_t*)(P.ws + WS_XB); float* part = (float*)(P.ws + WS_PART); bf16_t* zb = (bf16_t*)(P.ws + WS_R); bf16_t* yb = (bf16_t*)(P.ws + WS_R + R_Y); bf16_t* oxb = (bf16_t*)(P.ws + WS_R + R_OX); (void)xb; (void)part; (void)zb; (void)yb; (void)oxb; \
    int tid = threadIdx.x; asm volatile("" : "+v"(tid)); const int lane = tid & 63, wave = __builtin_amdgcn_readfirstlane(tid >> 6); (void)lane; (void)wave
    unsigned* ctl = (unsigned*)(P_.ws + WS_CTL);
    if (threadIdx.x < 64) LC[threadIdx.x] = 0u;
    __syncthreads();
    const int lo = P_.ph_lo, hi = P_.ph_hi;
    XcdBarrier bar; bar.bar = ctl + CW_BAR; bar.x = 0; bar.st = LC;
    if (hi - lo > 1) bar = xcd_barrier_post(ctl + CW_BAR, LC);
#ifndef PHASE_MASK
#define PHASE_MASK 0xFFFFFFFFu
#endif
#define EN(t) ((PHASE_MASK >> (t)) & 1u)
#ifndef REPEAT_MASK
#define REPEAT_MASK 0u
#endif
#define REP(t) for (int rep_ = 0; rep_ <= (int)((REPEAT_MASK >> (t)) & 1u); ++rep_, (rep_ <= (int)((REPEAT_MASK >> (t)) & 1u) ? xcd_barrier(bar) : (void)0))
#define IN(k) (lo <= (k) && (k) < hi)
#define SEAM(k) do { if (IN(k) && IN((k) + 1)) xcd_barrier(bar); } while (0)


    if (IN(0) && EN(0)) REP(0) { PH_TID(); p0_prologue(P, lds, tid); __syncthreads(); }
    SEAM(0);
    if (IN(1) && EN(1)) REP(1) {
        PH_TID();
        const int which = blockIdx.x >> 6, l = which >> 1, isv = which & 1;
        if (which < 4) {
            const bf16_t* memn = (const bf16_t*)(P.ws + WS_GDN); const bf16_t* wkv = wl(P, l, W_KV);
            bf16_t* kout = (bf16_t*)(P.ws + WS_KVM + (size_t)l * KVM_LAYER); bf16_t* vout = kout + (size_t)4096 * 1024;
            pg8::Gemm g; pg8::EpiScaleBf16<0> E; pg8::StaticOrder S;
            if (!isv) { g = pg8::Gemm{memn, wkv, 4096, 1024, 1024}; E = pg8::EpiScaleBf16<0>{kout, 1024, nullptr}; S.init(4096, 1024, 64, blockIdx.x & 63); }
            else { g = pg8::Gemm{wkv + (size_t)1024 * 1024, memn, 1024, 4096, 1024}; E = pg8::EpiScaleBf16<0>{vout, 4096, nullptr}; S.init(1024, 4096, 64, blockIdx.x & 63); }
            pg8::gemm_phase(lds, g, S, E, tid);
        }
    }
    SEAM(1);
#pragma unroll
    for (int l = 0; l < 2; ++l) {
        const int pb = 2 + 9 * l;
        if (IN(pb + 0) && EN(2)) REP(2) { PH_TID();
            pg8::Gemm g{xb, wl(P, l, W_IN), T_TOK, ZP, DM}; pg8::StaticOrder S; S.init(T_TOK, ZP, G, blockIdx.x);
            pg8::EpiScaleBf16<0> E{zb, ZP, part}; pg8::gemm_phase(lds, g, S, E, tid);
        }
        SEAM(pb + 0);
        if (IN(pb + 1)) {
            PH_TID();
            if (EN(3)) REP(3) { SUB_TID(); for (int it = blockIdx.x; it < 1024; it += G) gdn_pre_item(P, l, lds, it, tid2); }
            if (EN(4)) REP(4) { SUB_TID(); for (int it = blockIdx.x; it < 512; it += G) { lru_item(P, l, lds, it, 0, tid2, wave2, lane2); __syncthreads(); } }
            if (EN(5)) REP(5) { SUB_TID(); for (int rt = blockIdx.x * 8 + wave2; rt < 2048; rt += G * 8) mla_pre_tile(P, l, rt, lane2); }
        }
        SEAM(pb + 1);
        if (IN(pb + 2)) {
            PH_TID();
            unsigned* qh0 = ctl + CW_QUEUE + 64 * l;
#define QUEUE_LOOP(qi_, count_, body_) for (;;) { if (tid == 0) LC[4] = __hip_atomic_fetch_add(qh + (qi_), 1u, __ATOMIC_RELAXED, __HIP_MEMORY_SCOPE_AGENT); \
                __syncthreads(); const int it = (int)LC[4]; __syncthreads(); if (it >= (count_)) break; { SUB_TID(); body_; } __syncthreads(); }
            if (EN(6)) REP(6) { unsigned* qh = qh0 + 32 * rep_; QUEUE_LOOP(0, Q_RET, ret_chain_item(P, l, lds, it, tid2, wave2, lane2)) }
            if (EN(7)) REP(7) { unsigned* qh = qh0 + 32 * rep_; QUEUE_LOOP(1, Q_GDN, gdn_chain_item(P, l, lds, it, tid2, wave2, lane2)) }
            if (EN(8)) REP(8) { unsigned* qh = qh0 + 32 * rep_; QUEUE_LOOP(2, Q_LRU, lru_item(P, l, lds, it, 1, tid2, wave2, lane2)) }
            if (EN(9)) REP(9) { unsigned* qh = qh0 + 32 * rep_; QUEUE_LOOP(3, Q_MLA, mla_attn_item(P, lds, it, tid2, wave2, lane2)) }
#undef QUEUE_LOOP
        }
        SEAM(pb + 2);
        if (IN(pb + 3) && EN(10)) REP(10) { PH_TID();
            pg8::Gemm g{yb, wl(P, l, W_OUT), T_TOK, DM, DM}; pg8::StaticOrder S; S.init(T_TOK, DM, G, blockIdx.x);
            pg8::EpiResid E{P.out, xb, part, rep_ ? 0.f : 1.f}; pg8::gemm_phase(lds, g, S, E, tid);
        }
        SEAM(pb + 3);
        if (IN(pb + 4) && EN(11)) REP(11) { PH_TID();
            pg8::Gemm g{xb, wl(P, l, W_Q), T_TOK, DM, DM}; pg8::StaticOrder S; S.init(T_TOK, DM, G, blockIdx.x);
            pg8::EpiScaleBf16<0> E{zb, DM, part}; pg8::gemm_phase(lds, g, S, E, tid);
        }
        SEAM(pb + 4);
        if (IN(pb + 5) && EN(12)) REP(12) { PH_TID(); for (int it = blockIdx.x; it < 1024; it += G) { xa_item(P, l, lds, it, tid, wave, lane); __syncthreads(); } }
        SEAM(pb + 5);
        if (IN(pb + 6) && EN(13)) REP(13) { PH_TID();
            pg8::Gemm g{oxb, wl(P, l, W_O), T_TOK, DM, DM}; pg8::StaticOrder S; S.init(T_TOK, DM, G, blockIdx.x);
            pg8::EpiResid E{P.out, xb, part, rep_ ? 0.f : 1.f}; pg8::gemm_phase(lds, g, S, E, tid);
        }
        SEAM(pb + 6);
        if (IN(pb + 7) && EN(14)) REP(14) { PH_TID();
            pg8::Gemm g{xb, wl(P, l, W_1), T_TOK, DFF, DM}; pg8::StaticOrder S; S.init(T_TOK, DFF, G, blockIdx.x);
            pg8::EpiScaleBf16<1> E{zb, DFF, part}; pg8::gemm_phase(lds, g, S, E, tid);
        }
        SEAM(pb + 7);
        if (IN(pb + 8) && EN(15)) REP(15) { PH_TID();
            pg8::Gemm g{zb, wl(P, l, W_2), T_TOK, DM, DFF}; pg8::StaticOrder S; S.init(T_TOK, DM, G, blockIdx.x);
            pg8::EpiResid E{P.out, xb, part, rep_ ? 0.f : 1.f}; pg8::gemm_phase(lds, g, S, E, tid);
        }
        SEAM(pb + 8);
    }
    if (IN(20) && EN(16)) { PH_TID(); final_norm_phase(P, tid); }
#undef IN
#undef SEAM
}

extern "C" void kernel_launch(void* const* d_in, const int* in_sizes, int n_in, void* d_out, int out_size, void* d_ws, size_t ws_size, hipStream_t stream) {
    static int grid = 0;
    if (grid == 0) {
        if (n_in != 31 || out_size != T_TOK * DM || ws_size < WS_END) { fprintf(stderr, "kernel_launch: unexpected shapes (n_in %d out %d ws %zu, need %zu)\n", n_in, out_size, ws_size, (size_t)WS_END); grid = -1; return; }
        if (hipFuncSetAttribute((const void*)hymba_fwd, hipFuncAttributeMaxDynamicSharedMemorySize, LDS_BYTES) != hipSuccess) { fprintf(stderr, "kernel_launch: hipFuncSetAttribute failed\n"); grid = -1; return; }
        int dev = 0, cus = 0, per_cu = 0;
        (void)hipGetDevice(&dev); (void)hipDeviceGetAttribute(&cus, hipDeviceAttributeMultiprocessorCount, dev);
        (void)hipOccupancyMaxActiveBlocksPerMultiprocessor(&per_cu, (const void*)hymba_fwd, 512, LDS_BYTES);
        (void)hipGetLastError();
        if (cus != 256 || per_cu < 1) fprintf(stderr, "kernel_launch: note: cus %d per_cu %d\n", cus, per_cu);
        grid = 256;
    }
    if (grid < 0) return;
    (void)hipMemsetAsync((char*)d_ws + WS_CTL, 0, CTL_BYTES, stream);
    Params p{};
    p.x = (const float*)d_in[0]; p.mem = (const float*)d_in[1]; p.pos = (const int*)d_in[2];
    p.norm_mix = (const float*)d_in[3]; p.w_in = (const float*)d_in[4]; p.ret_gn = (const float*)d_in[5];
    p.lru_conv_w = (const float*)d_in[6]; p.lru_conv_b = (const float*)d_in[7]; p.lru_wa = (const float*)d_in[8]; p.lru_ba = (const float*)d_in[9];
    p.lru_wx = (const float*)d_in[10]; p.lru_bx = (const float*)d_in[11]; p.lru_lambda = (const float*)d_in[12];
    p.mla_q_norm = (const float*)d_in[13]; p.mla_w_uq = (const float*)d_in[14]; p.mla_kv_norm = (const float*)d_in[15]; p.mla_w_ukv = (const float*)d_in[16];
    p.gdn_conv_w = (const float*)d_in[17]; p.gdn_a_log = (const float*)d_in[18]; p.gdn_dt_bias = (const float*)d_in[19]; p.gdn_norm = (const float*)d_in[20];
    p.w_out = (const float*)d_in[21]; p.norm_xattn = (const float*)d_in[22]; p.norm_mem = (const float*)d_in[23];
    p.xa_wq = (const float*)d_in[24]; p.xa_wkv = (const float*)d_in[25]; p.xa_wo = (const float*)d_in[26];
    p.norm_mlp = (const float*)d_in[27]; p.mlp_w1 = (const float*)d_in[28]; p.mlp_w2 = (const float*)d_in[29]; p.final_norm = (const float*)d_in[30];
    p.out = (float*)d_out; p.ws = (unsigned char*)d_ws;
#if N_LAUNCHES == 1
    p.ph_lo = 0; p.ph_hi = N_PHASES;
    void* args[] = {&p};
    hipError_t e = hipLaunchCooperativeKernel((const void*)hymba_fwd, dim3(grid), dim3(512), args, LDS_BYTES, stream);
    if (e != hipSuccess) fprintf(stderr, "kernel_launch: cooperative launch failed: %s\n", hipGetErrorString(e));
#else
    for (int ph = 0; ph < N_PHASES; ++ph) { p.ph_lo = ph; p.ph_hi = ph + 1; hipLaunchKernelGGL(hymba_fwd, dim3(grid), dim3(512), LDS_BYTES, stream, p); }
#endif
}
```

```cpp
#include <hip/hip_runtime.h>
#include <cstdio>
#include <cstdint>

#ifndef N_LAUNCHES
#define N_LAUNCHES 1
#endif

#define LAS __attribute__((address_space(3)))
typedef unsigned short bf16_t;
typedef short bf16x8 __attribute__((ext_vector_type(8)));
typedef float f32x4 __attribute__((ext_vector_type(4)));
typedef float f32x2 __attribute__((ext_vector_type(2)));
typedef unsigned u32x4 __attribute__((ext_vector_type(4)));
typedef unsigned u32x2 __attribute__((ext_vector_type(2)));

constexpr int T_TOK = 32768, DM = 1024, SEQ = 2048, NBATCH = 16, NCHUNK = 32, ZP = 3072, DFF = 4096, NMEM = 256;
constexpr int Z_RQ = 0, Z_RK = 256, Z_RV = 512, Z_RG = 768, Z_LX = 1024, Z_LG = 1280, Z_CQ = 1536, Z_CKV = 1728, Z_KR = 1856,
              Z_GQKV = 1888, Z_GG = 2656, Z_GB = 2912, Z_GA = 2916, IN_COLS = 2920;
constexpr float EPS = 1e-6f;
constexpr float LOG2E = 1.4426950408889634f;

constexpr size_t MiB = 1024 * 1024;
constexpr size_t WS_CTL = 0;
constexpr size_t CTL_BYTES = 65536;
constexpr size_t WS_PART = WS_CTL + CTL_BYTES;
constexpr size_t WS_LRUS = WS_PART + (size_t)T_TOK * 16 * 4;
constexpr size_t WS_GL = WS_LRUS + (size_t)2 * 16 * 32 * 256 * 4;
constexpr size_t WS_W = WS_GL + 65536;
constexpr size_t W_IN = 0, W_OUT = W_IN + (size_t)ZP * DM, W_Q = W_OUT + (size_t)DM * DM, W_KV = W_Q + (size_t)DM * DM, W_O = W_KV + (size_t)2 * DM * DM,
                 W_1 = W_O + (size_t)DM * DM, W_2 = W_1 + (size_t)DFF * DM, W_UQ = W_2 + (size_t)DFF * DM, W_UKV = W_UQ + 384 * 192, W_A = W_UKV + 512 * 128,
                 W_X = W_A + 4 * 64 * 64, W_LAYER = W_X + 4 * 64 * 64;
constexpr size_t WS_XB = WS_W + 2 * W_LAYER * 2;
constexpr size_t XB_BYTES = (size_t)T_TOK * DM * 2;
constexpr size_t MLA_Q_OFF = 0, MLA_K_OFF = (size_t)T_TOK * 4 * 96 * 2, MLA_VT_OFF = 2 * MLA_K_OFF;
constexpr size_t WS_KVM = WS_XB + XB_BYTES;
constexpr size_t KVM_LAYER = (size_t)2 * 4096 * 1024 * 2;
constexpr size_t WS_R = WS_KVM + 2 * KVM_LAYER;
constexpr size_t R_Y = (size_t)T_TOK * ZP * 2;
constexpr size_t R_OX = (size_t)T_TOK * DM * 2;
constexpr size_t WS_GDN = WS_R + 256 * MiB;
constexpr size_t WS_END = WS_GDN + 80 * MiB;
static_assert(WS_END <= 512 * MiB, "workspace map exceeds 512 MiB");
static_assert(WS_XB % 256 == 0 && WS_R % 256 == 0 && WS_GDN % 256 == 0 && WS_W % 256 == 0, "alignment");
constexpr int CW_BAR = 0;
constexpr int CW_QUEUE = 4096;

constexpr int LDS_BYTES = 160 * 1024;
constexpr int LDS_CTL = LDS_BYTES - 256;

typedef __bf16 bf16x2_t __attribute__((ext_vector_type(2)));
__device__ __forceinline__ unsigned pk2(float lo, float hi) { f32x2 t = {lo, hi}; bf16x2_t v = __builtin_convertvector(t, bf16x2_t); return __builtin_bit_cast(unsigned, v); }
__device__ __forceinline__ float bflo(unsigned w) { return __uint_as_float(w << 16); }
__device__ __forceinline__ float bfhi(unsigned w) { return __uint_as_float(w & 0xffff0000u); }
__device__ __forceinline__ float bf2f(bf16_t v) { return __uint_as_float((unsigned)v << 16); }
__device__ __forceinline__ bf16_t f2bf(float f) { return (bf16_t)(pk2(f, 0.f) & 0xffffu); }
__device__ __forceinline__ f32x4 mfma16(bf16x8 a, bf16x8 b, f32x4 c) { return __builtin_amdgcn_mfma_f32_16x16x32_bf16(a, b, c, 0, 0, 0); }
__device__ __forceinline__ float sigmoidf_(float x) { return 1.0f / (1.0f + __expf(-x)); }
__device__ __forceinline__ float siluf_(float x) { return x / (1.0f + __expf(-x)); }
__device__ __forceinline__ float softplusf_(float x) { return x > 20.f ? x : log1pf(__expf(x)); }
__device__ __forceinline__ float geluf_(float x) { const float u = 0.7978845608028654f * (x + 0.044715f * x * x * x); const float e = __expf(2.f * u); const float th = 1.f - 2.f / (e + 1.f); return 0.5f * x * (1.f + th); }
__device__ __forceinline__ float wave_sum(float v) {
#pragma unroll
    for (int o = 1; o < 64; o <<= 1) v += __shfl_xor(v, o);
    return v;
}
__device__ __forceinline__ void sincos_rev(float ang, float& s, float& c) {
    float rev = ang * 0.15915494309189535f; rev = rev - floorf(rev);
    s = __builtin_amdgcn_sinf(rev); c = __builtin_amdgcn_cosf(rev);
}
__device__ __forceinline__ bf16x8 mk8(u32x2 lo, u32x2 hi) { u32x4 t; t.x = lo.x; t.y = lo.y; t.z = hi.x; t.w = hi.y; return __builtin_bit_cast(bf16x8, t); }
__device__ __forceinline__ bf16x8 pack8(f32x4 a, f32x4 b) { u32x4 t; t.x = pk2(a.x, a.y); t.y = pk2(a.z, a.w); t.z = pk2(b.x, b.y); t.w = pk2(b.z, b.w); return __builtin_bit_cast(bf16x8, t); }

#define XB_TMO      128
#define XB_XCNT(j)  (256  + 64 * (j))
#define XB_XSUB(j)  (1280 + 64 * (j))
#define XB_XGEN(j)  (2304 + 64 * (j))
#define XB_TOP      3328
#define XB_TOPGEN   3392
#define XCD_BAR_WORDS 3456
#define XB_SPIN_CAP (1u << 22)
__device__ __forceinline__ unsigned xb_ld(unsigned* p)              { return __hip_atomic_load(p, __ATOMIC_RELAXED, __HIP_MEMORY_SCOPE_AGENT); }
__device__ __forceinline__ unsigned xb_add(unsigned* p, unsigned v) { return __hip_atomic_fetch_add(p, v, __ATOMIC_RELAXED, __HIP_MEMORY_SCOPE_AGENT); }
__device__ __forceinline__ unsigned xb_xcc_id() { return (unsigned)__builtin_amdgcn_s_getreg((3 << 11) | 20) & 0xFu; }
#define XB_SPIN(cond, bar) do { unsigned _sp = 0; while (cond) { __builtin_amdgcn_s_sleep(1); \
    if ((++_sp & 255u) == 0u) { if (xb_ld(&(bar)[XB_TMO])) break; if (_sp > XB_SPIN_CAP) { atomicAdd(&(bar)[XB_TMO], 1u); break; } } } } while (0)
struct XcdBarrier { unsigned* bar; unsigned x; volatile LAS unsigned* st; };
__device__ __forceinline__ XcdBarrier xcd_barrier_post(unsigned* bar, volatile LAS unsigned* st) {
    XcdBarrier b; b.bar = bar; b.x = xb_xcc_id(); b.st = st;
    if (threadIdx.x == 0) (void)xb_add(&bar[XB_XCNT(b.x)], 1u);
    return b;
}
__device__ __forceinline__ void xcd_barrier_complete(unsigned* bar, unsigned x, unsigned& nloc, unsigned& nx) {
    const unsigned G = gridDim.x * gridDim.y * gridDim.z;
    unsigned sum, cnt, mine, sp = 0u;
    for (;;) {
        sum = 0u; cnt = 0u; mine = 0u;
#pragma unroll
        for (unsigned j = 0; j < 16; ++j) { const unsigned c = xb_ld(&bar[XB_XCNT(j)]); sum += c; cnt += (c > 0u) ? 1u : 0u; mine = (j == x) ? c : mine; }
        if (sum == G) break;
        __builtin_amdgcn_s_sleep(1);
        if ((++sp & 255u) == 0u) { if (xb_ld(&bar[XB_TMO])) break; if (sp > XB_SPIN_CAP) { atomicAdd(&bar[XB_TMO], 1u); break; } }
    }
    nloc = mine > 0u ? mine : 1u; nx = cnt > 0u ? cnt : 1u;
}
__device__ __forceinline__ void xcd_barrier(const XcdBarrier& b) {
    asm volatile("s_waitcnt vmcnt(0)" ::: "memory");
    __syncthreads();
    if (threadIdx.x == 0) {
        unsigned* bar = b.bar;
        __builtin_amdgcn_s_waitcnt(0);
        unsigned nloc = b.st[0], nx = b.st[1];
        if (nloc == 0u) { xcd_barrier_complete(bar, b.x, nloc, nx); b.st[0] = nloc; b.st[1] = nx; }
        const unsigned old = xb_add(&bar[XB_XSUB(b.x)], 1u);
        const unsigned gen = old / nloc;
        if (old + 1u == (gen + 1u) * nloc) {
            __builtin_amdgcn_fence(__ATOMIC_RELEASE, "agent");
            asm volatile("s_waitcnt vmcnt(0)" ::: "memory");
            const unsigned og = xb_add(&bar[XB_TOP], 1u);
            const unsigned tg = og / nx;
            if (og + 1u == (tg + 1u) * nx) xb_add(&bar[XB_TOPGEN], 1u);
            else XB_SPIN(xb_ld(&bar[XB_TOPGEN]) == tg, bar);
            __builtin_amdgcn_fence(__ATOMIC_ACQUIRE, "agent");
            xb_add(&bar[XB_XGEN(b.x)], 1u);
            asm volatile("s_waitcnt vmcnt(0)" ::: "memory");
        } else {
            XB_SPIN(xb_ld(&bar[XB_XGEN(b.x)]) == gen, bar);
            __builtin_amdgcn_fence(__ATOMIC_ACQUIRE, "agent");
            asm volatile("s_waitcnt vmcnt(0)" ::: "memory");
        }
    }
    __syncthreads();
}

namespace pg8 {
constexpr int BM = 256, BK = 64, HALF = 128, HTB = HALF * BK * 2, STAGE_BYTES = 8 * HTB, NXCD = 8, WGM = 8;
__host__ __device__ __forceinline__ int lds_byte(int r, int c) { const int st = (r >> 4) * 2 + (c >> 5), rr = r & 15, cc = c & 31, ob = rr * 64 + cc * 2; return st * 1024 + (ob ^ (((ob >> 9) & 1) << 5)); }
__host__ __device__ __forceinline__ void stage_rc(int b, int& R, int& C) { const int st = b / 1024, sb = b % 1024, swz = sb ^ (((sb >> 9) & 1) << 5); R = (st >> 1) * 16 + swz / 64; C = (st & 1) * 32 + (swz % 64) / 2; }
__host__ __device__ __forceinline__ int perm32(int rho) { const int n = rho >> 4, i = rho & 15; return 8 * (i >> 2) + 4 * n + (i & 3); }
struct Unit { int pm, pn; };
struct Gemm { const bf16_t* A; const bf16_t* Bt; int M, N, K; };
struct StaticOrder {
    int nM, nN, nwg, G, c;
    __host__ __device__ void init(int M, int N, int G_, int c_) { nM = M / BM; nN = N / BM; nwg = nM * nN; G = G_; c = c_; }
    __host__ __device__ bool next(int i, Unit& u) const {
        const long L = (long)i * G + c; if (L >= nwg) return false;
        int wgid = (int)L; { const int q = nwg / NXCD, r = nwg % NXCD, xcd = wgid % NXCD, off = wgid / NXCD; wgid = (xcd < r ? xcd * (q + 1) : r * (q + 1) + (xcd - r) * q) + off; }
        const int nig = WGM * nN, gid = wgid / nig, fm = gid * WGM, gsz = (nM - fm) < WGM ? (nM - fm) : WGM;
        u.pm = fm + ((wgid % nig) % gsz); u.pn = (wgid % nig) / gsz; return true;
    }
    __device__ __forceinline__ void a_ready(const Unit&) const {}
    __device__ __forceinline__ void done(const Unit&) const {}
};

template <int ACT> struct EpiScaleBf16 {
    static constexpr bool PERM = true;
    bf16_t* O; int ldc; const float* part;
    __device__ __forceinline__ void operator()(const f32x4 (&acc)[2][2][4][2], const Unit& u, int wr, int wc, int fr, int fq) const {
        const int row0 = u.pm * BM + wr * 64 + fr, col0 = u.pn * BM + wc * 32 + 8 * fq;
#pragma unroll
        for (int ai = 0; ai < 2; ++ai)
#pragma unroll
            for (int m = 0; m < 4; ++m) {
                const int row = row0 + ai * HALF + m * 16;
                float sc = 1.0f;
                if (part) { const f32x4* pp = (const f32x4*)(part + (size_t)row * 16); const f32x4 a = pp[0], b = pp[1], c = pp[2], d = pp[3];
                    const float s = ((a.x + a.y) + (a.z + a.w)) + ((b.x + b.y) + (b.z + b.w)) + ((c.x + c.y) + (c.z + c.w)) + ((d.x + d.y) + (d.z + d.w));
                    sc = rsqrtf(s * (1.0f / 1024.0f) + EPS); }
                bf16_t* rowp = O + (size_t)row * ldc + col0;
#pragma unroll
                for (int bj = 0; bj < 2; ++bj) { f32x4 v0 = acc[ai][bj][m][0] * sc, v1 = acc[ai][bj][m][1] * sc;
                    if (ACT == 1) {
#pragma unroll
                        for (int j = 0; j < 4; ++j) { const float a0 = fmaxf(v0[j], 0.f), a1 = fmaxf(v1[j], 0.f); v0[j] = a0 * a0; v1[j] = a1 * a1; } }
                    u32x4 w; w.x = pk2(v0[0], v0[1]); w.y = pk2(v0[2], v0[3]); w.z = pk2(v1[0], v1[1]); w.w = pk2(v1[2], v1[3]);
                    *(u32x4*)(rowp + bj * HALF) = w; }
            }
    }
};
struct EpiResid {
    static constexpr bool PERM = false;
    float* X; bf16_t* XB; float* part; float alpha;
    __device__ __forceinline__ void operator()(const f32x4 (&acc)[2][2][4][2], const Unit& u, int wr, int wc, int fr, int fq) const {
        const int row0 = u.pm * BM + wr * 64 + fr, col0 = u.pn * BM + wc * 32 + 4 * fq;
#pragma unroll
        for (int ai = 0; ai < 2; ++ai)
#pragma unroll
            for (int m = 0; m < 4; ++m) {
                const int row = row0 + ai * HALF + m * 16;
                float* xp = X + (size_t)row * DM + col0; bf16_t* bp = XB + (size_t)row * DM + col0;
                float ss = 0.f;
#pragma unroll
                for (int bj = 0; bj < 2; ++bj)
#pragma unroll
                    for (int n = 0; n < 2; ++n) { const f32x4 v = *(const f32x4*)(xp + bj * HALF + n * 16) + acc[ai][bj][m][n] * alpha;
                        *(f32x4*)(xp + bj * HALF + n * 16) = v; ss += (v.x * v.x + v.y * v.y) + (v.z * v.z + v.w * v.w);
                        u32x2 w; w.x = pk2(v.x, v.y); w.y = pk2(v.z, v.w); *(u32x2*)(bp + bj * HALF + n * 16) = w; }
                ss += __shfl_xor(ss, 16); ss += __shfl_xor(ss, 32);
                if (fq == 0) part[(size_t)row * 16 + u.pn * 4 + wc] = ss;
            }
    }
};

template <class Epi, class Sched>
__device__ __forceinline__ void gemm_phase(LAS unsigned char* lds, const Gemm g, const Sched& S, const Epi& E, const int tid) {
    const int wid = __builtin_amdgcn_readfirstlane(tid >> 6), lane = tid & 63, wr = wid >> 2, wc = wid & 3, fr = lane & 15, fq = lane >> 4;
    const int K = g.K, nt = K / BK;
    unsigned voffA[2], voffB[2];
#pragma unroll
    for (int i = 0; i < 2; ++i) { int R, C; stage_rc(tid * 16 + i * 8192, R, C); const int Rb = Epi::PERM ? ((R & ~31) + perm32(R & 31)) : R;
        voffA[i] = (unsigned)(R * K + C) * 2u; voffB[i] = (unsigned)(Rb * K + C) * 2u; }
    const size_t kstep = (size_t)(BK * 2);
    const size_t hstep = (size_t)HALF * K * 2;
    const size_t tstep = 2 * hstep;
    const unsigned ldsw = (unsigned)wid * 1024u;
    const int aoff = lds_byte(wr * 64 + fr, fq * 8), boff = lds_byte(wc * 32 + fr, fq * 8);
#define PG8_SA(b, h) (((b) * 2 + (h)) * HTB)
#define PG8_SB(b, h) ((4 + (b) * 2 + (h)) * HTB)
#define PG8_STAGE(bufoff, gbase, voff) do { _Pragma("unroll") for (int _i = 0; _i < 2; ++_i) \
        __builtin_amdgcn_global_load_lds((const unsigned*)((const char*)(gbase) + (voff)[_i]), (LAS unsigned*)(lds + (bufoff) + ldsw + _i * 8192), 16, 0, 0); } while (0)
#define PG8_LDA(dst, b, h) do { _Pragma("unroll") for (int m = 0; m < 4; ++m) _Pragma("unroll") for (int k = 0; k < 2; ++k) dst[m][k] = *(const LAS bf16x8*)(lds + PG8_SA(b, h) + aoff + m * 2048 + k * 1024); } while (0)
#define PG8_LDB(dst, b, h) do { _Pragma("unroll") for (int n = 0; n < 2; ++n) _Pragma("unroll") for (int k = 0; k < 2; ++k) dst[n][k] = *(const LAS bf16x8*)(lds + PG8_SB(b, h) + boff + n * 2048 + k * 1024); } while (0)
#define PG8_MMA(ai, bj, At, Bt) do { __builtin_amdgcn_s_setprio(1); _Pragma("unroll") for (int m = 0; m < 4; ++m) _Pragma("unroll") for (int n = 0; n < 2; ++n) _Pragma("unroll") for (int k = 0; k < 2; ++k) \
        acc[ai][bj][m][n] = __builtin_amdgcn_mfma_f32_16x16x32_bf16(Bt[n][k], At[m][k], acc[ai][bj][m][n], 0, 0, 0); __builtin_amdgcn_s_setprio(0); } while (0)
#define PG8_WAIT_V(n) asm volatile("s_waitcnt vmcnt(" #n ")" ::: "memory")
#define PG8_WAIT_L(n) asm volatile("s_waitcnt lgkmcnt(" #n ")" ::: "memory")
#define PG8_BAR __builtin_amdgcn_s_barrier()
#define PG8_SCHED __builtin_amdgcn_sched_barrier(0)
    Unit cur, nxt; int ui = 0;
    if (!S.next(0, cur)) return;
    f32x4 acc[2][2][4][2];
#pragma unroll
    for (int a = 0; a < 2; ++a)
#pragma unroll
        for (int b = 0; b < 2; ++b)
#pragma unroll
            for (int m = 0; m < 4; ++m)
#pragma unroll
                for (int n = 0; n < 2; ++n) acc[a][b][m][n] = (f32x4){0.f, 0.f, 0.f, 0.f};
    bf16x8 At[4][2], B0[2][2], B1[2][2];
    const char* cA = (const char*)g.A + (size_t)cur.pm * tstep; const char* cB = (const char*)g.Bt + (size_t)cur.pn * tstep;
    S.a_ready(cur);
    PG8_STAGE(PG8_SB(0, 0), cB, voffB); PG8_STAGE(PG8_SA(0, 0), cA, voffA); PG8_STAGE(PG8_SB(0, 1), cB + hstep, voffB); PG8_STAGE(PG8_SA(0, 1), cA + hstep, voffA);
    if (wr == 1) PG8_BAR;
    PG8_WAIT_V(4); PG8_BAR;
    PG8_STAGE(PG8_SB(1, 0), cB + kstep, voffB); PG8_STAGE(PG8_SA(1, 0), cA + kstep, voffA); PG8_STAGE(PG8_SB(1, 1), cB + hstep + kstep, voffB);
    PG8_WAIT_V(6); PG8_BAR;
    for (;;) {
        const bool has_next = S.next(ui + 1, nxt);
        const char* nA = has_next ? (const char*)g.A + (size_t)nxt.pm * tstep : cA; const char* nB = has_next ? (const char*)g.Bt + (size_t)nxt.pn * tstep : cB;
        for (int t = 0; t < nt; t += 2) {
            const bool last = (t == nt - 2);
            const char* a1 = cA + (size_t)(t + 1) * kstep;
            const char* a2 = last ? nA : cA + (size_t)(t + 2) * kstep; const char* b2 = last ? nB : cB + (size_t)(t + 2) * kstep;
            const char* a3 = a2 + kstep; const char* b3 = b2 + kstep;
            if (last && has_next) S.a_ready(nxt);
            PG8_LDB(B0, 0, 0); PG8_SCHED; PG8_LDA(At, 0, 0); PG8_STAGE(PG8_SA(1, 1), a1 + hstep, voffA);
            PG8_WAIT_L(8); PG8_BAR; PG8_WAIT_L(0); PG8_MMA(0, 0, At, B0); PG8_BAR; PG8_SCHED;
            PG8_LDB(B1, 0, 1); PG8_STAGE(PG8_SB(0, 0), b2, voffB);
            PG8_BAR; PG8_WAIT_L(0); PG8_MMA(0, 1, At, B1); PG8_BAR;
            PG8_LDA(At, 0, 1); PG8_STAGE(PG8_SA(0, 0), a2, voffA);
            PG8_BAR; PG8_WAIT_L(0); PG8_MMA(1, 0, At, B0); PG8_BAR; PG8_SCHED;
            PG8_STAGE(PG8_SB(0, 1), b2 + hstep, voffB);
            PG8_WAIT_V(6); PG8_BAR; PG8_MMA(1, 1, At, B1); PG8_BAR;
            PG8_LDB(B0, 1, 0); PG8_SCHED; PG8_LDA(At, 1, 0); PG8_STAGE(PG8_SA(0, 1), a2 + hstep, voffA);
            PG8_WAIT_L(8); PG8_BAR; PG8_WAIT_L(0); PG8_MMA(0, 0, At, B0); PG8_BAR; PG8_SCHED;
            PG8_LDB(B1, 1, 1); PG8_STAGE(PG8_SB(1, 0), b3, voffB);
            PG8_BAR; PG8_WAIT_L(0); PG8_MMA(0, 1, At, B1); PG8_BAR;
            PG8_LDA(At, 1, 1); PG8_STAGE(PG8_SA(1, 0), a3, voffA);
            PG8_BAR; PG8_WAIT_L(0); PG8_MMA(1, 0, At, B0); PG8_BAR; PG8_SCHED;
            PG8_STAGE(PG8_SB(1, 1), b3 + hstep, voffB);
            PG8_WAIT_V(6); PG8_BAR; PG8_MMA(1, 1, At, B1); PG8_BAR;
        }
        E(acc, cur, wr, wc, fr, fq); S.done(cur);
        if (!has_next) break;
#pragma unroll
        for (int a = 0; a < 2; ++a)
#pragma unroll
            for (int b = 0; b < 2; ++b)
#pragma unroll
                for (int m = 0; m < 4; ++m)
#pragma unroll
                    for (int n = 0; n < 2; ++n) acc[a][b][m][n] = (f32x4){0.f, 0.f, 0.f, 0.f};
        cur = nxt; cA = nA; cB = nB; ++ui;
    }
    PG8_WAIT_V(0);
    if (wr == 0) PG8_BAR;
    PG8_BAR;
#undef PG8_SA
#undef PG8_SB
#undef PG8_STAGE
#undef PG8_LDA
#undef PG8_LDB
#undef PG8_MMA
#undef PG8_WAIT_V
#undef PG8_WAIT_L
#undef PG8_BAR
#undef PG8_SCHED
}
}

struct Params {
    const float* x; const float* mem; const int* pos;
    const float* norm_mix; const float* w_in; const float* ret_gn;
    const float* lru_conv_w; const float* lru_conv_b; const float* lru_wa; const float* lru_ba; const float* lru_wx; const float* lru_bx; const float* lru_lambda;
    const float* mla_q_norm; const float* mla_w_uq; const float* mla_kv_norm; const float* mla_w_ukv;
    const float* gdn_conv_w; const float* gdn_a_log; const float* gdn_dt_bias; const float* gdn_norm;
    const float* w_out; const float* norm_xattn; const float* norm_mem; const float* xa_wq; const float* xa_wkv; const float* xa_wo;
    const float* norm_mlp; const float* mlp_w1; const float* mlp_w2; const float* final_norm;
    float* out; unsigned char* ws;
    int ph_lo, ph_hi;
};

__device__ __forceinline__ bf16_t* wl(const Params& P, int l, size_t off) { return (bf16_t*)(P.ws + WS_W) + (size_t)l * W_LAYER + off; }

__device__ __forceinline__ void transpose_tile(const float* src, int K, int N, const float* gain, float scale, bf16_t* dst, int kb, int nb, LAS float* scr, int tid) {
#pragma unroll
    for (int i = 0; i < 8; ++i) { const int kk = (tid >> 6) + 8 * i, k = kb * 64 + kk, n = nb * 64 + (tid & 63);
        float v = 0.f; if (n < N) { v = src[(size_t)k * N + n] * scale; if (gain) v *= gain[k]; }
        scr[kk * 65 + (tid & 63)] = v; }
    __syncthreads();
    { const int nl = tid >> 3, k0 = (tid & 7) * 8; const LAS float* s = scr + k0 * 65 + nl;
      u32x4 o; o.x = pk2(s[0], s[65]); o.y = pk2(s[2 * 65], s[3 * 65]); o.z = pk2(s[4 * 65], s[5 * 65]); o.w = pk2(s[6 * 65], s[7 * 65]);
      *(u32x4*)(dst + (size_t)(nb * 64 + nl) * K + kb * 64 + k0) = o; }
    __syncthreads();
}
__device__ __forceinline__ void p0_prologue(const Params& P, LAS unsigned char* lds, int tid) {
    LAS float* scr = (LAS float*)lds;
    constexpr int T_IN = 16 * 48, T_SQ = 256, T_KV = 512, T_W1 = 1024, T_W2 = 1024, T_UQ = 18, T_UKV = 16, T_LRU = 8;
    constexpr int T_LAYER = T_IN + 3 * T_SQ + T_KV + T_W1 + T_W2 + T_UQ + T_UKV + T_LRU;
    for (int it = blockIdx.x; it < 2 * T_LAYER; it += gridDim.x) {
        const int l = it / T_LAYER; int r = it % T_LAYER;
        const float* src; const float* gain = nullptr; float scale = 1.f; bf16_t* dst; int K, N, nnb;
        if (r < T_IN) { src = P.w_in + (size_t)l * DM * IN_COLS; K = DM; N = IN_COLS; nnb = 48; gain = P.norm_mix + l * DM; dst = wl(P, l, W_IN); }
        else if ((r -= T_IN) < T_SQ) { src = P.w_out + (size_t)l * DM * DM; K = DM; N = DM; nnb = 16; dst = wl(P, l, W_OUT); }
        else if ((r -= T_SQ) < T_SQ) { src = P.xa_wq + (size_t)l * DM * DM; K = DM; N = DM; nnb = 16; gain = P.norm_xattn + l * DM; scale = 0.0625f * LOG2E; dst = wl(P, l, W_Q); }
        else if ((r -= T_SQ) < T_KV) { src = P.xa_wkv + (size_t)l * DM * 2 * DM; K = DM; N = 2 * DM; nnb = 32; gain = P.norm_mem + l * DM; dst = wl(P, l, W_KV); }
        else if ((r -= T_KV) < T_SQ) { src = P.xa_wo + (size_t)l * DM * DM; K = DM; N = DM; nnb = 16; dst = wl(P, l, W_O); }
        else if ((r -= T_SQ) < T_W1) { src = P.mlp_w1 + (size_t)l * DM * DFF; K = DM; N = DFF; nnb = 64; gain = P.norm_mlp + l * DM; dst = wl(P, l, W_1); }
        else if ((r -= T_W1) < T_W2) { src = P.mlp_w2 + (size_t)l * DFF * DM; K = DFF; N = DM; nnb = 16; dst = wl(P, l, W_2); }
        else if ((r -= T_W2) < T_UQ) { src = P.mla_w_uq + (size_t)l * 192 * 384; K = 192; N = 384; nnb = 6; gain = P.mla_q_norm + l * 192; dst = wl(P, l, W_UQ); }
        else if ((r -= T_UQ) < T_UKV) { src = P.mla_w_ukv + (size_t)l * 128 * 512; K = 128; N = 512; nnb = 8; gain = P.mla_kv_norm + l * 128; dst = wl(P, l, W_UKV); }
        else { r -= T_UKV; const int which = r >> 2, nb4 = r & 3; src = (which ? P.lru_wx : P.lru_wa) + (size_t)l * 4 * 4096 + nb4 * 4096; K = 64; N = 64; nnb = 1; dst = wl(P, l, which ? W_X : W_A) + nb4 * 4096; r = 0; }
        transpose_tile(src, K, N, gain, scale, dst, r / nnb, r % nnb, scr, tid);
    }
    const int wave = tid >> 6, lane = tid & 63;
    const int gw = blockIdx.x * 8 + wave, ngw = gridDim.x * 8;
    bf16_t* xb = (bf16_t*)(P.ws + WS_XB); float* part = (float*)(P.ws + WS_PART); bf16_t* memn = (bf16_t*)(P.ws + WS_GDN);
    for (int row = gw; row < T_TOK + NBATCH * NMEM; row += ngw) {
        const bool isx = row < T_TOK; const int r2 = isx ? row : row - T_TOK;
        const f32x4* src = (const f32x4*)((isx ? P.x : P.mem) + (size_t)r2 * DM) + lane;
        f32x4 v[4]; float s = 0.f;
#pragma unroll
        for (int j = 0; j < 4; ++j) { v[j] = src[64 * j]; s += (v[j].x * v[j].x + v[j].y * v[j].y) + (v[j].z * v[j].z + v[j].w * v[j].w); }
        s = wave_sum(s);
        if (isx) {
            f32x4* o = (f32x4*)(P.out + (size_t)row * DM) + lane; u32x2* ob = (u32x2*)(xb + (size_t)row * DM) + lane;
#pragma unroll
            for (int j = 0; j < 4; ++j) { o[64 * j] = v[j]; u32x2 w; w.x = pk2(v[j].x, v[j].y); w.y = pk2(v[j].z, v[j].w); ob[64 * j] = w; }
            if (lane < 16) part[(size_t)row * 16 + lane] = lane == 0 ? s : 0.f;
        } else {
            const float rs = rsqrtf(s * (1.0f / 1024.0f) + EPS); u32x2* ob = (u32x2*)(memn + (size_t)r2 * DM) + lane;
#pragma unroll
            for (int j = 0; j < 4; ++j) { u32x2 w; w.x = pk2(v[j].x * rs, v[j].y * rs); w.y = pk2(v[j].z * rs, v[j].w * rs); ob[64 * j] = w; }
        }
    }
}
__device__ __forceinline__ void final_norm_phase(const Params& P, int tid) {
    const int wave = tid >> 6, lane = tid & 63; const float* part = (const float*)(P.ws + WS_PART);
    f32x4 g[4];
#pragma unroll
    for (int j = 0; j < 4; ++j) g[j] = ((const f32x4*)P.final_norm)[64 * j + lane];
    for (int row = blockIdx.x * 8 + wave; row < T_TOK; row += gridDim.x * 8) {
        float s = lane < 16 ? part[(size_t)row * 16 + lane] : 0.f; s = wave_sum(s);
        const float rs = rsqrtf(s * (1.0f / 1024.0f) + EPS);
        f32x4* o = (f32x4*)(P.out + (size_t)row * DM) + lane;
#pragma unroll
        for (int j = 0; j < 4; ++j) { f32x4 v = o[64 * j]; o[64 * j] = v * rs * g[j]; }
    }
}

__device__ __forceinline__ void mla_pre_tile(const Params& P, int l, int rt, int lane) {
    const int fr = lane & 15, fq = lane >> 4;
    const bf16_t* z = (const bf16_t*)(P.ws + WS_R);
    bf16_t* Qo = (bf16_t*)(P.ws + WS_XB + MLA_Q_OFF); bf16_t* Ko = (bf16_t*)(P.ws + WS_XB + MLA_K_OFF); bf16_t* Vo = (bf16_t*)(P.ws + WS_XB + MLA_VT_OFF);
    const bf16_t* Wuq = wl(P, l, W_UQ); const bf16_t* Wukv = wl(P, l, W_UKV);
    const int tok0 = rt * 16, b = tok0 >> 11, s0 = tok0 & 2047;
    const bf16_t* zr = z + (size_t)(tok0 + fr) * ZP;
    bf16x8 cq[6], ckv[4]; float sq = 0.f, skv = 0.f;
#pragma unroll
    for (int s = 0; s < 6; ++s) { const u32x4 w = *(const u32x4*)(zr + Z_CQ + 32 * s + 8 * fq); cq[s] = __builtin_bit_cast(bf16x8, w);
        sq += bflo(w.x) * bflo(w.x) + bfhi(w.x) * bfhi(w.x) + bflo(w.y) * bflo(w.y) + bfhi(w.y) * bfhi(w.y) + bflo(w.z) * bflo(w.z) + bfhi(w.z) * bfhi(w.z) + bflo(w.w) * bflo(w.w) + bfhi(w.w) * bfhi(w.w); }
#pragma unroll
    for (int s = 0; s < 4; ++s) { const u32x4 w = *(const u32x4*)(zr + Z_CKV + 32 * s + 8 * fq); ckv[s] = __builtin_bit_cast(bf16x8, w);
        skv += bflo(w.x) * bflo(w.x) + bfhi(w.x) * bfhi(w.x) + bflo(w.y) * bflo(w.y) + bfhi(w.y) * bfhi(w.y) + bflo(w.z) * bflo(w.z) + bfhi(w.z) * bfhi(w.z) + bflo(w.w) * bflo(w.w) + bfhi(w.w) * bfhi(w.w); }
    sq += __shfl_xor(sq, 16); sq += __shfl_xor(sq, 32); skv += __shfl_xor(skv, 16); skv += __shfl_xor(skv, 32);
    const float rq = rsqrtf(sq * (1.0f / 192.0f) + EPS), rkv = rsqrtf(skv * (1.0f / 128.0f) + EPS);
    const float qsc = rq * 0.10206207261596575f * LOG2E;
    const float pos = (float)P.pos[tok0 + fr];
    float sn[4], cs[4];
#pragma unroll
    for (int r = 0; r < 4; ++r) { const float invf = exp2f(-(float)(4 * fq + r) * (13.287712379549449f / 16.0f)); sincos_rev(pos * invf, sn[r], cs[r]); }
    const size_t tokrow = (size_t)b * 4 * SEQ + (s0 + fr);
#pragma unroll 1
    for (int h = 0; h < 4; ++h) {
        bf16_t* qrow = Qo + (tokrow + (size_t)h * SEQ) * 96;
#pragma unroll 1
        for (int nt = 0; nt < 4; ++nt) { f32x4 a = {0.f, 0.f, 0.f, 0.f};
#pragma unroll
            for (int s = 0; s < 6; ++s) { const bf16x8 wf = *(const bf16x8*)(Wuq + (size_t)(h * 96 + nt * 16 + fr) * 192 + 32 * s + 8 * fq); a = mfma16(wf, cq[s], a); }
            a = a * qsc; u32x2 w; w.x = pk2(a.x, a.y); w.y = pk2(a.z, a.w); *(u32x2*)(qrow + nt * 16 + 4 * fq) = w; }
        f32x4 x1 = {0.f, 0.f, 0.f, 0.f}, x2 = {0.f, 0.f, 0.f, 0.f}, y1, y2;
#pragma unroll
        for (int s = 0; s < 6; ++s) { const bf16x8 wf1 = *(const bf16x8*)(Wuq + (size_t)(h * 96 + 64 + fr) * 192 + 32 * s + 8 * fq), wf2 = *(const bf16x8*)(Wuq + (size_t)(h * 96 + 80 + fr) * 192 + 32 * s + 8 * fq);
            x1 = mfma16(wf1, cq[s], x1); x2 = mfma16(wf2, cq[s], x2); }
        x1 = x1 * qsc; x2 = x2 * qsc;
#pragma unroll
        for (int r = 0; r < 4; ++r) { y1[r] = x1[r] * cs[r] - x2[r] * sn[r]; y2[r] = x1[r] * sn[r] + x2[r] * cs[r]; }
        { u32x2 w; w.x = pk2(y1.x, y1.y); w.y = pk2(y1.z, y1.w); *(u32x2*)(qrow + 64 + 4 * fq) = w; w.x = pk2(y2.x, y2.y); w.y = pk2(y2.z, y2.w); *(u32x2*)(qrow + 80 + 4 * fq) = w; }
    }
    u32x2 kr1, kr2;
    { const u32x2 a = *(const u32x2*)(zr + Z_KR + 4 * fq), c = *(const u32x2*)(zr + Z_KR + 16 + 4 * fq);
      const float x1[4] = {bflo(a.x), bfhi(a.x), bflo(a.y), bfhi(a.y)}, x2[4] = {bflo(c.x), bfhi(c.x), bflo(c.y), bfhi(c.y)}; float y1[4], y2[4];
#pragma unroll
      for (int r = 0; r < 4; ++r) { y1[r] = x1[r] * cs[r] - x2[r] * sn[r]; y2[r] = x1[r] * sn[r] + x2[r] * cs[r]; }
      kr1.x = pk2(y1[0], y1[1]); kr1.y = pk2(y1[2], y1[3]); kr2.x = pk2(y2[0], y2[1]); kr2.y = pk2(y2[2], y2[3]); }
    float rkv_r[4];
#pragma unroll
    for (int r = 0; r < 4; ++r) rkv_r[r] = __shfl(rkv, 4 * fq + r);
    const int chunk = s0 >> 6, key0 = (s0 & 63) + 4 * fq;
#pragma unroll 1
    for (int h = 0; h < 4; ++h) {
        bf16_t* krow = Ko + (tokrow + (size_t)h * SEQ) * 96;
#pragma unroll 1
        for (int nt = 0; nt < 4; ++nt) { f32x4 a = {0.f, 0.f, 0.f, 0.f};
#pragma unroll
            for (int s = 0; s < 4; ++s) { const bf16x8 wf = *(const bf16x8*)(Wukv + (size_t)(h * 128 + nt * 16 + fr) * 128 + 32 * s + 8 * fq); a = mfma16(wf, ckv[s], a); }
            a = a * rkv; u32x2 w; w.x = pk2(a.x, a.y); w.y = pk2(a.z, a.w); *(u32x2*)(krow + nt * 16 + 4 * fq) = w; }
        *(u32x2*)(krow + 64 + 4 * fq) = kr1; *(u32x2*)(krow + 80 + 4 * fq) = kr2;
        bf16_t* vt = Vo + ((size_t)((b * 4 + h) * NCHUNK + chunk) * 64) * 64;
#pragma unroll 1
        for (int nt = 0; nt < 4; ++nt) { f32x4 a = {0.f, 0.f, 0.f, 0.f};
#pragma unroll
            for (int s = 0; s < 4; ++s) { const bf16x8 wf = *(const bf16x8*)(Wukv + (size_t)(h * 128 + 64 + nt * 16 + fr) * 128 + 32 * s + 8 * fq); a = mfma16(ckv[s], wf, a); }
            u32x2 w; w.x = pk2(a.x * rkv_r[0], a.y * rkv_r[1]); w.y = pk2(a.z * rkv_r[2], a.w * rkv_r[3]);
            *(u32x2*)(vt + (size_t)(nt * 16 + fr) * 64 + key0) = w; }
    }
}

template <int DQK, int DV, int KT>
__device__ __forceinline__ void flash_item(LAS unsigned char* lds, const bf16_t* Qw, int ldq, const bf16_t* Kb, int ldk, const bf16_t* VTb, int ldv, int vts,
                                           bf16_t* Ow, int ldo, int ntiles, int wave_limit, int tid, int lane) {
    constexpr int KROW = DQK + 8, VROW = KT + 8, KS = DQK / 32, ET = DV / 16, NKT = KT / 16, KBYTES = KT * KROW * 2, BUF = KBYTES + DV * VROW * 2;
    constexpr int KP = KT * DQK / 8, VPR = KT / 8, VP = DV * VPR, NKP = (KP + 511) / 512, NVP = (VP + 511) / 512, NP = NKP > NVP ? NKP : NVP;
    const int fr = lane & 15, fq = lane >> 4;
    bf16x8 qf[KS];
#pragma unroll
    for (int s = 0; s < KS; ++s) qf[s] = *(const bf16x8*)(Qw + (size_t)fr * ldq + 32 * s + 8 * fq);
    f32x4 ot[ET];
#pragma unroll
    for (int e = 0; e < ET; ++e) ot[e] = (f32x4){0.f, 0.f, 0.f, 0.f};
    float m_run = -1e30f, l_run = 0.f;
    u32x4 preg[NP];
#define FL_LOADK(j_) do { _Pragma("unroll") for (int i = 0; i < NKP; ++i) { const int idx = tid + i * 512; if (idx < KP) { const int row = idx / (DQK / 8), pc = idx % (DQK / 8); \
            preg[i] = *(const u32x4*)(Kb + (size_t)((j_) * KT + row) * ldk + pc * 8); } } } while (0)
#define FL_LOADV(j_) do { _Pragma("unroll") for (int i = 0; i < NVP; ++i) { const int idx = tid + i * 512; if (idx < VP) { const int row = idx / VPR, pc = idx % VPR; \
            preg[i] = *(const u32x4*)(VTb + (size_t)(j_) * vts + (size_t)row * ldv + pc * 8); } } } while (0)
#define FL_STOREK(buf_) do { LAS bf16_t* Kt_ = (LAS bf16_t*)(lds + (buf_) * BUF); \
        _Pragma("unroll") for (int i = 0; i < NKP; ++i) { const int idx = tid + i * 512; if (idx < KP) { const int row = idx / (DQK / 8), pc = idx % (DQK / 8); *(LAS u32x4*)(Kt_ + row * KROW + pc * 8) = preg[i]; } } } while (0)
#define FL_STOREV(buf_) do { LAS bf16_t* Vt_ = (LAS bf16_t*)(lds + (buf_) * BUF + KBYTES); \
        _Pragma("unroll") for (int i = 0; i < NVP; ++i) { const int idx = tid + i * 512; if (idx < VP) { const int row = idx / VPR, pc = idx % VPR; *(LAS u32x4*)(Vt_ + row * VROW + pc * 8) = preg[i]; } } } while (0)
    FL_LOADK(0); FL_STOREK(0); FL_LOADV(0); FL_STOREV(0);
    __syncthreads();
#pragma unroll 1
    for (int j = 0; j < ntiles; ++j) {
        const bool more = j + 1 < ntiles, act = j < wave_limit;
        const LAS bf16_t* Kt = (const LAS bf16_t*)(lds + (j & 1) * BUF); const LAS bf16_t* Vt = (const LAS bf16_t*)(lds + (j & 1) * BUF + KBYTES);
        if (more) FL_LOADK(j + 1);
        f32x4 st[NKT];
        if (act) {
#pragma unroll
            for (int kt = 0; kt < NKT; ++kt) { f32x4 a = {0.f, 0.f, 0.f, 0.f};
#pragma unroll
                for (int s = 0; s < KS; ++s) { const bf16x8 kf = *(const LAS bf16x8*)(Kt + (kt * 16 + fr) * KROW + 32 * s + 8 * fq); a = mfma16(kf, qf[s], a); }
                st[kt] = a; }
        }
        if (more) { FL_STOREK((j + 1) & 1); FL_LOADV(j + 1); }
        if (act) {
            float mx = fmaxf(fmaxf(st[0].x, st[0].y), fmaxf(st[0].z, st[0].w));
#pragma unroll
            for (int kt = 1; kt < NKT; ++kt) mx = fmaxf(mx, fmaxf(fmaxf(st[kt].x, st[kt].y), fmaxf(st[kt].z, st[kt].w)));
            mx = fmaxf(mx, __shfl_xor(mx, 16)); mx = fmaxf(mx, __shfl_xor(mx, 32));
            const float m_new = fmaxf(m_run, mx), alpha = exp2f(m_run - m_new);
            float ls = 0.f;
#pragma unroll
            for (int kt = 0; kt < NKT; ++kt)
#pragma unroll
                for (int r = 0; r < 4; ++r) { const float p = exp2f(st[kt][r] - m_new); st[kt][r] = p; ls += p; }
            l_run = l_run * alpha + ls; m_run = m_new;
#pragma unroll
            for (int e = 0; e < ET; ++e) ot[e] = ot[e] * alpha;
            bf16x8 pf[NKT / 2];
#pragma unroll
            for (int k2 = 0; k2 < NKT / 2; ++k2) pf[k2] = pack8(st[2 * k2], st[2 * k2 + 1]);
#pragma unroll
            for (int e = 0; e < ET; ++e) {
                const LAS bf16_t* vr = Vt + (e * 16 + fr) * VROW + 4 * fq;
#pragma unroll
                for (int k2 = 0; k2 < NKT / 2; ++k2) { const bf16x8 v0 = mk8(*(const LAS u32x2*)(vr + 32 * k2), *(const LAS u32x2*)(vr + 32 * k2 + 16)); ot[e] = mfma16(v0, pf[k2], ot[e]); }
            }
        }
        if (more) FL_STOREV((j + 1) & 1);
        __syncthreads();
    }
#undef FL_LOADK
#undef FL_LOADV
#undef FL_STOREK
#undef FL_STOREV
    l_run += __shfl_xor(l_run, 16); l_run += __shfl_xor(l_run, 32);
    const float inv = 1.0f / l_run;
#pragma unroll
    for (int e = 0; e < ET; ++e) { u32x2 w; w.x = pk2(ot[e].x * inv, ot[e].y * inv); w.y = pk2(ot[e].z * inv, ot[e].w * inv);
        *(u32x2*)(Ow + (size_t)fr * ldo + e * 16 + 4 * fq) = w; }
}
__device__ __forceinline__ void mla_attn_item(const Params& P, LAS unsigned char* lds, int it, int tid, int wave, int lane) {
    const int qt = 15 - (it >> 6), bh = it & 63;
    const bf16_t* Q = (const bf16_t*)(P.ws + WS_XB + MLA_Q_OFF) + ((size_t)bh * SEQ + qt * 128 + wave * 16) * 96;
    const bf16_t* K = (const bf16_t*)(P.ws + WS_XB + MLA_K_OFF) + (size_t)bh * SEQ * 96;
    const bf16_t* VT = (const bf16_t*)(P.ws + WS_XB + MLA_VT_OFF) + (size_t)bh * NCHUNK * 4096;
    bf16_t* y = (bf16_t*)(P.ws + WS_R + R_Y) + ((size_t)(bh >> 2) * SEQ + qt * 128 + wave * 16) * DM + 512 + (bh & 3) * 64;
    flash_item<96, 64, 64>(lds, Q, 96, K, 96, VT, 64, 4096, y, DM, 2 * qt + 2, 2 * qt + (wave >> 2) + 1, tid, lane);
}
__device__ __forceinline__ void xa_item(const Params& P, int l, LAS unsigned char* lds, int it, int tid, int wave, int lane) {
    const int qt = it & 15, h = (it >> 4) & 3, b = it >> 6;
    const size_t qoff = ((size_t)b * SEQ + qt * 128 + wave * 16) * DM + h * 256;
    const bf16_t* Q = (const bf16_t*)(P.ws + WS_R) + qoff; bf16_t* O = (bf16_t*)(P.ws + WS_R + R_OX) + qoff;
    const bf16_t* K = (const bf16_t*)(P.ws + WS_KVM + (size_t)l * KVM_LAYER) + (size_t)b * NMEM * DM + h * 256;
    const bf16_t* VT = (const bf16_t*)(P.ws + WS_KVM + (size_t)l * KVM_LAYER + (size_t)4096 * 1024 * 2) + (size_t)h * 256 * 4096 + b * NMEM;
    flash_item<256, 256, 32>(lds, Q, DM, K, DM, VT, 4096, 32, O, DM, 8, 8, tid, lane);
}

constexpr int GP_KN = 0, GP_KB = 9216, GP_QN = 18432, GP_L = 9216, GP_RHS = 27648, GP_G = 60416, GP_GC = 60672, GP_HEAD = 61440;
__device__ __forceinline__ bf16_t* gdn_buf(const Params& P, int chh, int k) { return (bf16_t*)(P.ws + WS_GDN) + ((size_t)chh * 5 + k) * 4096; }
__device__ __forceinline__ void gdn_pre_item(const Params& P, int l, LAS unsigned char* lds, int it, int tid) {
    const int hp = it & 1, n = (it >> 1) & 31, b = it >> 6;
    const int hh = tid >> 8, h = 2 * hp + hh, tt = tid & 255, c = tt >> 2, qr = tt & 3, lane = tid & 63;
    LAS unsigned char* L = lds + hh * GP_HEAD;
    const bf16_t* z = (const bf16_t*)(P.ws + WS_R);
    const int s = n * 64 + c; const size_t tok = (size_t)b * SEQ + s;
    const float* cw = P.gdn_conv_w + (size_t)l * 4 * 768;
    const int chh = (b * NCHUNK + n) * 4 + h;
    float q[16], k[16], v[16];
#pragma unroll
    for (int part = 0; part < 3; ++part) {
        float* dst = part == 0 ? q : (part == 1 ? k : v);
        const int ch0 = part * 256 + h * 64 + qr * 16;
#pragma unroll
        for (int i = 0; i < 16; ++i) dst[i] = 0.f;
#pragma unroll
        for (int kk = 0; kk < 4; ++kk) { {
            const bool okk = s - 3 + kk >= 0; const float mk = okk ? 1.f : 0.f;
            const bf16_t* zr = z + (okk ? tok - 3 + kk : tok) * ZP + Z_GQKV + ch0; const u32x4 w0 = *(const u32x4*)zr, w1 = *(const u32x4*)(zr + 8);
            const float* wr = cw + kk * 768 + ch0; const f32x4 c0 = *(const f32x4*)wr * mk, c1 = *(const f32x4*)(wr + 4) * mk, c2 = *(const f32x4*)(wr + 8) * mk, c3 = *(const f32x4*)(wr + 12) * mk;
            dst[0] += c0.x * bflo(w0.x); dst[1] += c0.y * bfhi(w0.x); dst[2] += c0.z * bflo(w0.y); dst[3] += c0.w * bfhi(w0.y);
            dst[4] += c1.x * bflo(w0.z); dst[5] += c1.y * bfhi(w0.z); dst[6] += c1.z * bflo(w0.w); dst[7] += c1.w * bfhi(w0.w);
            dst[8] += c2.x * bflo(w1.x); dst[9] += c2.y * bfhi(w1.x); dst[10] += c2.z * bflo(w1.y); dst[11] += c2.w * bfhi(w1.y);
            dst[12] += c3.x * bflo(w1.z); dst[13] += c3.y * bfhi(w1.z); dst[14] += c3.z * bflo(w1.w); dst[15] += c3.w * bfhi(w1.w); } }
#pragma unroll
        for (int i = 0; i < 16; ++i) dst[i] = siluf_(dst[i]);
    }
    float sq = 0.f, sk = 0.f;
#pragma unroll
    for (int i = 0; i < 16; ++i) { sq += q[i] * q[i]; sk += k[i] * k[i]; }
    sq += __shfl_xor(sq, 1); sq += __shfl_xor(sq, 2); sk += __shfl_xor(sk, 1); sk += __shfl_xor(sk, 2);
    const float rq = rsqrtf(sq + EPS) * 0.125f, rk = rsqrtf(sk + EPS);
    const bf16_t* zt = z + tok * ZP;
    const float beta = sigmoidf_(bf2f(zt[Z_GB + h]));
    const float g = -__expf(P.gdn_a_log[l * 4 + h]) * softplusf_(bf2f(zt[Z_GA + h]) + P.gdn_dt_bias[l * 4 + h]);
    {
        u32x4 w0, w1;
#define PK16(dst0, dst1, src, sc) do { dst0.x = pk2(src[0] * (sc), src[1] * (sc)); dst0.y = pk2(src[2] * (sc), src[3] * (sc)); dst0.z = pk2(src[4] * (sc), src[5] * (sc)); dst0.w = pk2(src[6] * (sc), src[7] * (sc)); \
        dst1.x = pk2(src[8] * (sc), src[9] * (sc)); dst1.y = pk2(src[10] * (sc), src[11] * (sc)); dst1.z = pk2(src[12] * (sc), src[13] * (sc)); dst1.w = pk2(src[14] * (sc), src[15] * (sc)); } while (0)
        PK16(w0, w1, k, rk);        *(LAS u32x4*)(L + GP_KN + (c * 72 + qr * 16) * 2) = w0; *(LAS u32x4*)(L + GP_KN + (c * 72 + qr * 16 + 8) * 2) = w1;
        PK16(w0, w1, k, rk * beta); *(LAS u32x4*)(L + GP_KB + (c * 72 + qr * 16) * 2) = w0; *(LAS u32x4*)(L + GP_KB + (c * 72 + qr * 16 + 8) * 2) = w1;
        PK16(w0, w1, q, rq);        *(LAS u32x4*)(L + GP_QN + (c * 72 + qr * 16) * 2) = w0; *(LAS u32x4*)(L + GP_QN + (c * 72 + qr * 16 + 8) * 2) = w1;
        LAS float* rhs = (LAS float*)(L + GP_RHS) + c * 128 + qr * 16;
#pragma unroll
        for (int i = 0; i < 4; ++i) *(LAS f32x4*)(rhs + 4 * i) = (f32x4){v[4 * i] * beta, v[4 * i + 1] * beta, v[4 * i + 2] * beta, v[4 * i + 3] * beta};
        if (qr == 0) ((LAS float*)(L + GP_G))[c] = g;
    }
    __syncthreads();
    {
        float gc = 0.f, run = 0.f; const LAS float* G = (const LAS float*)(L + GP_G);
        for (int i = 0; i < 64; ++i) { run += G[i]; gc = (i == c) ? run : gc; }
        const float eg = __expf(gc), ek = __expf(run - gc);
        LAS float* rhs = (LAS float*)(L + GP_RHS) + c * 128 + 64 + qr * 16;
#pragma unroll
        for (int i = 0; i < 4; ++i) *(LAS f32x4*)(rhs + 4 * i) = (f32x4){k[4 * i] * rk * beta * eg, k[4 * i + 1] * rk * beta * eg, k[4 * i + 2] * rk * beta * eg, k[4 * i + 3] * rk * beta * eg};
        u32x4 w0, w1; PK16(w0, w1, q, rq * eg);
        bf16_t* qd = gdn_buf(P, chh, 3) + c * 64 + qr * 16; *(u32x4*)qd = w0; *(u32x4*)(qd + 8) = w1;
        bf16_t* kdt = gdn_buf(P, chh, 4) + (qr * 16) * 64 + c;
#pragma unroll
        for (int i = 0; i < 16; ++i) kdt[i * 64] = f2bf(k[i] * rk * ek);
        if (qr == 0) ((LAS float*)(L + GP_GC))[c] = gc;
        if (tt == 0) ((float*)(P.ws + WS_GL))[chh] = __expf(run);
    }
#undef PK16
    __syncthreads();
    {
        const int it4 = (tid >> 6) & 3, fr = lane & 15, fq = lane >> 4;
        const LAS bf16_t* Kn = (const LAS bf16_t*)(L + GP_KN); const LAS bf16_t* KB = (const LAS bf16_t*)(L + GP_KB); const LAS bf16_t* Qn = (const LAS bf16_t*)(L + GP_QN);
        const LAS float* GC = (const LAS float*)(L + GP_GC);
        const bf16x8 a0 = *(const LAS bf16x8*)(KB + (it4 * 16 + fr) * 72 + 8 * fq), a1 = *(const LAS bf16x8*)(KB + (it4 * 16 + fr) * 72 + 32 + 8 * fq);
        const bf16x8 q0 = *(const LAS bf16x8*)(Qn + (it4 * 16 + fr) * 72 + 8 * fq), q1 = *(const LAS bf16x8*)(Qn + (it4 * 16 + fr) * 72 + 32 + 8 * fq);
        float gci[4];
#pragma unroll
        for (int r = 0; r < 4; ++r) gci[r] = GC[it4 * 16 + 4 * fq + r];
        f32x4 lv[4]; bf16_t* att = gdn_buf(P, chh, 2);
#pragma unroll
        for (int jt = 0; jt < 4; ++jt) {
            const bf16x8 b0 = *(const LAS bf16x8*)(Kn + (jt * 16 + fr) * 72 + 8 * fq), b1 = *(const LAS bf16x8*)(Kn + (jt * 16 + fr) * 72 + 32 + 8 * fq);
            f32x4 al = {0.f, 0.f, 0.f, 0.f}, aa = {0.f, 0.f, 0.f, 0.f};
            al = mfma16(a0, b0, al); al = mfma16(a1, b1, al); aa = mfma16(q0, b0, aa); aa = mfma16(q1, b1, aa);
            const int j = jt * 16 + fr; const float gcj = GC[j];
#pragma unroll
            for (int r = 0; r < 4; ++r) { const int i = it4 * 16 + 4 * fq + r; const float dec = __expf(fminf(gci[r] - gcj, 0.f));
                lv[jt][r] = (i > j) ? al[r] * dec : 0.f; att[i * 64 + j] = f2bf((i >= j) ? aa[r] * dec : 0.f); }
        }
        __syncthreads();
        LAS float* Lm = (LAS float*)(L + GP_L);
#pragma unroll
        for (int jt = 0; jt < 4; ++jt)
#pragma unroll
            for (int r = 0; r < 4; ++r) Lm[(it4 * 16 + 4 * fq + r) * 64 + jt * 16 + fr] = lv[jt][r];
    }
    __syncthreads();
    if (tt < 128) {
        const LAS float* Lm = (const LAS float*)(L + GP_L); const LAS float* rhs = (const LAS float*)(L + GP_RHS) + tt;
        float x[64];
#pragma unroll
        for (int i = 0; i < 64; ++i) {
            float a0 = rhs[i * 128], a1 = 0.f;
#pragma unroll
            for (int j4 = 0; j4 < (i + 3) / 4; ++j4) { const f32x4 lr = *(const LAS f32x4*)(Lm + i * 64 + 4 * j4);
                if (4 * j4 + 0 < i) a0 -= lr.x * x[4 * j4 + 0]; if (4 * j4 + 1 < i) a1 -= lr.y * x[4 * j4 + 1];
                if (4 * j4 + 2 < i) a0 -= lr.z * x[4 * j4 + 2]; if (4 * j4 + 3 < i) a1 -= lr.w * x[4 * j4 + 3]; }
            x[i] = a0 + a1;
        }
        if (tt < 64) { bf16_t* ut = gdn_buf(P, chh, 1) + tt * 64;
#pragma unroll
            for (int g8 = 0; g8 < 8; ++g8) { u32x4 w; w.x = pk2(x[8 * g8], x[8 * g8 + 1]); w.y = pk2(x[8 * g8 + 2], x[8 * g8 + 3]); w.z = pk2(x[8 * g8 + 4], x[8 * g8 + 5]); w.w = pk2(x[8 * g8 + 6], x[8 * g8 + 7]); *(u32x4*)(ut + 8 * g8) = w; }
        } else { bf16_t* wo = gdn_buf(P, chh, 0) + (tt - 64);
#pragma unroll
            for (int i = 0; i < 64; ++i) wo[i * 64] = f2bf(x[i]); }
    }
    __syncthreads();
}

constexpr int GC_W = 0, GC_UT = 9216, GC_ATT = 18432, GC_QD = 27648, GC_KDT = 36864, GC_O = 46080, GC_BH = 62720;
__device__ __forceinline__ bf16x8 lds_perm(const LAS unsigned char* M, int row, int s, int fq) { const LAS unsigned char* p = M + row * 144 + 64 * s + 8 * fq; return mk8(*(const LAS u32x2*)p, *(const LAS u32x2*)(p + 32)); }
__device__ __forceinline__ void gdn_chain_item(const Params& P, int l, LAS unsigned char* lds, int gi, int tid, int wave, int lane) {
    const int q2 = wave >> 2, bh = gi * 2 + q2, eb = wave & 3, b = bh >> 2, h = bh & 3, fr = lane & 15, fq = lane >> 4;
    const bf16_t* z = (const bf16_t*)(P.ws + WS_R); bf16_t* y = (bf16_t*)(P.ws + WS_R + R_Y);
    LAS unsigned char* L = lds + q2 * GC_BH;
    const int tt = tid & 255, ec = tt >> 2, eq = tt & 3;
    float ng[16];
#pragma unroll
    for (int j = 0; j < 16; ++j) ng[j] = P.gdn_norm[l * 64 + eq * 16 + j];
    u32x4 stg[10];
    const bf16_t* src0[2] = { gdn_buf(P, ((gi * 2 >> 2) * NCHUNK) * 4 + ((gi * 2) & 3), 0), gdn_buf(P, (((gi * 2 + 1) >> 2) * NCHUNK) * 4 + ((gi * 2 + 1) & 3), 0) };
#define GC_LOAD(n_) do { _Pragma("unroll") for (int i = 0; i < 10; ++i) { const int p = tid + 512 * i, qq = p / 2560, pp = p % 2560; \
        stg[i] = *(const u32x4*)(src0[qq] + (size_t)(n_) * 4 * 5 * 4096 + (size_t)pp * 8); } } while (0)
#define GC_WRITE() do { _Pragma("unroll") for (int i = 0; i < 10; ++i) { const int p = tid + 512 * i, qq = p / 2560, pp = p % 2560, mat = pp >> 9, row = (pp & 511) >> 3, pc = pp & 7; \
        *(LAS u32x4*)(lds + qq * GC_BH + mat * 9216 + row * 144 + pc * 16) = stg[i]; } } while (0)
    GC_LOAD(0); GC_WRITE();
    f32x4 S[4];
#pragma unroll
    for (int t = 0; t < 4; ++t) S[t] = (f32x4){0.f, 0.f, 0.f, 0.f};
    __syncthreads();
    for (int n = 0; n < NCHUNK; ++n) {
        const int chh = (b * NCHUNK + n) * 4 + h;
        if (n + 1 < NCHUNK) GC_LOAD(n + 1);
        const size_t etok = (size_t)(gi * 2 + (tid >> 8) >> 2) * SEQ + n * 64 + ec; const int eh = (gi * 2 + (tid >> 8)) & 3;
        const u32x4 gw0 = *(const u32x4*)(z + etok * ZP + Z_GG + eh * 64 + eq * 16), gw1 = *(const u32x4*)(z + etok * ZP + Z_GG + eh * 64 + eq * 16 + 8);
        const float egl = ((const float*)(P.ws + WS_GL))[chh];
        const bf16x8 sb0 = pack8(S[0], S[1]), sb1 = pack8(S[2], S[3]);
        f32x4 vn[4], o[4];
#pragma unroll
        for (int ct = 0; ct < 4; ++ct) {
            f32x4 a = {0.f, 0.f, 0.f, 0.f}; a = mfma16(lds_perm(L + GC_W, ct * 16 + fr, 0, fq), sb0, a); a = mfma16(lds_perm(L + GC_W, ct * 16 + fr, 1, fq), sb1, a);
            const u32x2 uw = *(const LAS u32x2*)(L + GC_UT + (eb * 16 + fr) * 144 + (ct * 16 + 4 * fq) * 2);
            vn[ct] = (f32x4){bflo(uw.x) - a.x, bfhi(uw.x) - a.y, bflo(uw.y) - a.z, bfhi(uw.y) - a.w};
            f32x4 oo = {0.f, 0.f, 0.f, 0.f}; oo = mfma16(lds_perm(L + GC_QD, ct * 16 + fr, 0, fq), sb0, oo); oo = mfma16(lds_perm(L + GC_QD, ct * 16 + fr, 1, fq), sb1, oo); o[ct] = oo;
        }
        const bf16x8 vb0 = pack8(vn[0], vn[1]), vb1 = pack8(vn[2], vn[3]);
#pragma unroll
        for (int ct = 0; ct < 4; ++ct) { o[ct] = mfma16(lds_perm(L + GC_ATT, ct * 16 + fr, 0, fq), vb0, o[ct]); o[ct] = mfma16(lds_perm(L + GC_ATT, ct * 16 + fr, 1, fq), vb1, o[ct]); }
#pragma unroll
        for (int dt = 0; dt < 4; ++dt) { f32x4 a = S[dt] * egl; a = mfma16(lds_perm(L + GC_KDT, dt * 16 + fr, 0, fq), vb0, a); a = mfma16(lds_perm(L + GC_KDT, dt * 16 + fr, 1, fq), vb1, a); S[dt] = a; }
        LAS float* Ol = (LAS float*)(L + GC_O);
#pragma unroll
        for (int ct = 0; ct < 4; ++ct)
#pragma unroll
            for (int r = 0; r < 4; ++r) Ol[(ct * 16 + 4 * fq + r) * 65 + eb * 16 + fr] = o[ct][r];
        __syncthreads();
        if (n + 1 < NCHUNK) GC_WRITE();
        {
            const LAS float* orow = (const LAS float*)(lds + (tid >> 8) * GC_BH + GC_O) + ec * 65 + eq * 16;
            float ov[16]; float s2 = 0.f;
#pragma unroll
            for (int j = 0; j < 16; ++j) { ov[j] = orow[j]; s2 += ov[j] * ov[j]; }
            s2 += __shfl_xor(s2, 1); s2 += __shfl_xor(s2, 2);
            const float rs = rsqrtf(s2 * (1.0f / 64.0f) + EPS);
            const unsigned gws[8] = {gw0.x, gw0.y, gw0.z, gw0.w, gw1.x, gw1.y, gw1.z, gw1.w};
            unsigned ow[8];
#pragma unroll
            for (int j = 0; j < 8; ++j) ow[j] = pk2(ov[2 * j] * rs * ng[2 * j] * siluf_(bflo(gws[j])), ov[2 * j + 1] * rs * ng[2 * j + 1] * siluf_(bfhi(gws[j])));
            bf16_t* yp = y + etok * DM + 768 + eh * 64 + eq * 16;
            *(u32x4*)yp = (u32x4){ow[0], ow[1], ow[2], ow[3]}; *(u32x4*)(yp + 8) = (u32x4){ow[4], ow[5], ow[6], ow[7]};
        }
        __syncthreads();
    }
#undef GC_LOAD
#undef GC_WRITE
}

constexpr int RT_BUF = 36864, RT_Q = 0, RT_K = 9216, RT_KZT = 18432, RT_VT = 27648, RT_P = 73728, RT_ST = 82944, RT_O = 92160;
__device__ __forceinline__ void ret_chain_item(const Params& P, int l, LAS unsigned char* lds, int it, int tid, int wave, int lane) {
    const int b = it >> 2, h = it & 3, fr = lane & 15, fq = lane >> 4;
    const bf16_t* z = (const bf16_t*)(P.ws + WS_R); bf16_t* y = (bf16_t*)(P.ws + WS_R + R_Y);
    LAS bf16_t* Pm = (LAS bf16_t*)(lds + RT_P); LAS bf16_t* ST = (LAS bf16_t*)(lds + RT_ST); LAS float* Of = (LAS float*)(lds + RT_O);
    const float lg = log1pf(-exp2f(-5.0f - (float)h));
    const float cdec = __expf(64.0f * lg);
    for (int i = tid; i < 64 * 72 / 2; i += 512) ((LAS unsigned*)ST)[i] = 0u;
    const int it4 = wave >> 1, jt0 = 2 * (wave & 1);
    f32x4 S[2] = {{0.f, 0.f, 0.f, 0.f}, {0.f, 0.f, 0.f, 0.f}};
    const int lc = tid >> 3, pg = tid & 7;
    float invf[4];
#pragma unroll
    for (int ii = 0; ii < 4; ++ii) invf[ii] = exp2f(-(float)(4 * pg + ii) * (13.287712379549449f / 32.0f));
    const float zeta = __expf((63.0f - (float)lc) * lg);
    const f32x4 gn0 = *(const f32x4*)(P.ret_gn + l * 256 + h * 64 + 8 * pg), gn1 = *(const f32x4*)(P.ret_gn + l * 256 + h * 64 + 8 * pg + 4);
    const size_t tok0 = (size_t)b * SEQ + lc;
    u32x2 q1w, q2w, k1w, k2w; u32x4 vw; int posi;
#define RT_LOAD(n_) do { const bf16_t* zr_ = z + (tok0 + (n_) * 64) * ZP; q1w = *(const u32x2*)(zr_ + Z_RQ + h * 64 + 4 * pg); q2w = *(const u32x2*)(zr_ + Z_RQ + h * 64 + 32 + 4 * pg); \
        k1w = *(const u32x2*)(zr_ + Z_RK + h * 64 + 4 * pg); k2w = *(const u32x2*)(zr_ + Z_RK + h * 64 + 32 + 4 * pg); vw = *(const u32x4*)(zr_ + Z_RV + h * 64 + 8 * pg); posi = P.pos[tok0 + (n_) * 64]; } while (0)
#define RT_STAGE(buf_) do { LAS bf16_t* Qs_ = (LAS bf16_t*)(lds + (buf_) * RT_BUF + RT_Q); LAS bf16_t* Ks_ = (LAS bf16_t*)(lds + (buf_) * RT_BUF + RT_K); \
        LAS bf16_t* KzT_ = (LAS bf16_t*)(lds + (buf_) * RT_BUF + RT_KZT); LAS bf16_t* VT_ = (LAS bf16_t*)(lds + (buf_) * RT_BUF + RT_VT); const float pos = (float)posi; \
        const float q1[4] = {bflo(q1w.x), bfhi(q1w.x), bflo(q1w.y), bfhi(q1w.y)}, q2[4] = {bflo(q2w.x), bfhi(q2w.x), bflo(q2w.y), bfhi(q2w.y)}; \
        const float k1[4] = {bflo(k1w.x), bfhi(k1w.x), bflo(k1w.y), bfhi(k1w.y)}, k2[4] = {bflo(k2w.x), bfhi(k2w.x), bflo(k2w.y), bfhi(k2w.y)}; \
        float qa[4], qb[4], ka[4], kb[4]; \
        _Pragma("unroll") for (int ii = 0; ii < 4; ++ii) { float sn, cs; sincos_rev(pos * invf[ii], sn, cs); \
            qa[ii] = (q1[ii] * cs - q2[ii] * sn) * 0.125f; qb[ii] = (q1[ii] * sn + q2[ii] * cs) * 0.125f; ka[ii] = k1[ii] * cs - k2[ii] * sn; kb[ii] = k1[ii] * sn + k2[ii] * cs; } \
        u32x2 w_; w_.x = pk2(qa[0], qa[1]); w_.y = pk2(qa[2], qa[3]); *(LAS u32x2*)(Qs_ + lc * 72 + 4 * pg) = w_; \
        w_.x = pk2(qb[0], qb[1]); w_.y = pk2(qb[2], qb[3]); *(LAS u32x2*)(Qs_ + lc * 72 + 32 + 4 * pg) = w_; \
        w_.x = pk2(ka[0], ka[1]); w_.y = pk2(ka[2], ka[3]); *(LAS u32x2*)(Ks_ + lc * 72 + 4 * pg) = w_; \
        w_.x = pk2(kb[0], kb[1]); w_.y = pk2(kb[2], kb[3]); *(LAS u32x2*)(Ks_ + lc * 72 + 32 + 4 * pg) = w_; \
        _Pragma("unroll") for (int ii = 0; ii < 4; ++ii) { KzT_[(4 * pg + ii) * 72 + lc] = f2bf(ka[ii] * zeta); KzT_[(32 + 4 * pg + ii) * 72 + lc] = f2bf(kb[ii] * zeta); } \
        const unsigned vv[4] = {vw.x, vw.y, vw.z, vw.w}; \
        _Pragma("unroll") for (int ii = 0; ii < 4; ++ii) { VT_[(8 * pg + 2 * ii) * 72 + lc] = (bf16_t)(vv[ii] & 0xffffu); VT_[(8 * pg + 2 * ii + 1) * 72 + lc] = (bf16_t)(vv[ii] >> 16); } } while (0)
    RT_LOAD(0); RT_STAGE(0);
    __syncthreads();
    for (int n = 0; n < NCHUNK; ++n) {
        const int cb = n & 1;
        const LAS bf16_t* Qs = (const LAS bf16_t*)(lds + cb * RT_BUF + RT_Q); const LAS bf16_t* Ks = (const LAS bf16_t*)(lds + cb * RT_BUF + RT_K);
        const LAS bf16_t* KzT = (const LAS bf16_t*)(lds + cb * RT_BUF + RT_KZT); const LAS bf16_t* VT = (const LAS bf16_t*)(lds + cb * RT_BUF + RT_VT);
        const size_t tok = tok0 + n * 64;
        if (n + 1 < NCHUNK) RT_LOAD(n + 1);
        const u32x4 gw = *(const u32x4*)(z + tok * ZP + Z_RG + h * 64 + 8 * pg);
        const bf16x8 a0 = *(const LAS bf16x8*)(Qs + (it4 * 16 + fr) * 72 + 8 * fq), a1 = *(const LAS bf16x8*)(Qs + (it4 * 16 + fr) * 72 + 32 + 8 * fq);
        f32x4 cross[2];
#pragma unroll
        for (int t = 0; t < 2; ++t) { const int jt = jt0 + t;
            f32x4 p = {0.f, 0.f, 0.f, 0.f};
            p = mfma16(a0, *(const LAS bf16x8*)(Ks + (jt * 16 + fr) * 72 + 8 * fq), p); p = mfma16(a1, *(const LAS bf16x8*)(Ks + (jt * 16 + fr) * 72 + 32 + 8 * fq), p);
            f32x4 cr = {0.f, 0.f, 0.f, 0.f};
            cr = mfma16(a0, *(const LAS bf16x8*)(ST + (jt * 16 + fr) * 72 + 8 * fq), cr); cr = mfma16(a1, *(const LAS bf16x8*)(ST + (jt * 16 + fr) * 72 + 32 + 8 * fq), cr);
#pragma unroll
            for (int r = 0; r < 4; ++r) { const int i = it4 * 16 + 4 * fq + r, j = jt * 16 + fr; const int dd = i > j ? i - j : j - i;
                Pm[i * 72 + j] = f2bf(p[r] * __expf((float)dd * lg)); cr[r] *= __expf((float)(i + 1) * lg); }
            cross[t] = cr; }
        __syncthreads();
        const bf16x8 p0 = *(const LAS bf16x8*)(Pm + (it4 * 16 + fr) * 72 + 8 * fq), p1 = *(const LAS bf16x8*)(Pm + (it4 * 16 + fr) * 72 + 32 + 8 * fq);
        const bf16x8 kz0 = *(const LAS bf16x8*)(KzT + (it4 * 16 + fr) * 72 + 8 * fq), kz1 = *(const LAS bf16x8*)(KzT + (it4 * 16 + fr) * 72 + 32 + 8 * fq);
#pragma unroll
        for (int t = 0; t < 2; ++t) { const int et = jt0 + t;
            const bf16x8 v0 = *(const LAS bf16x8*)(VT + (et * 16 + fr) * 72 + 8 * fq), v1 = *(const LAS bf16x8*)(VT + (et * 16 + fr) * 72 + 32 + 8 * fq);
            f32x4 o = cross[t]; o = mfma16(p0, v0, o); o = mfma16(p1, v1, o);
#pragma unroll
            for (int r = 0; r < 4; ++r) Of[(it4 * 16 + 4 * fq + r) * 65 + et * 16 + fr] = o[r];
            f32x4 sN = S[t] * cdec; sN = mfma16(kz0, v0, sN); sN = mfma16(kz1, v1, sN); S[t] = sN;
            u32x2 w; w.x = pk2(sN.x, sN.y); w.y = pk2(sN.z, sN.w); *(LAS u32x2*)(ST + (et * 16 + fr) * 72 + it4 * 16 + 4 * fq) = w; }
        if (n + 1 < NCHUNK) RT_STAGE(cb ^ 1);
        __syncthreads();
        {
            float ov[8]; float sm = 0.f;
#pragma unroll
            for (int j = 0; j < 8; ++j) { ov[j] = Of[lc * 65 + 8 * pg + j]; sm += ov[j]; }
            sm += __shfl_xor(sm, 1); sm += __shfl_xor(sm, 2); sm += __shfl_xor(sm, 4);
            const float mu = sm * (1.0f / 64.0f); float vs = 0.f;
#pragma unroll
            for (int j = 0; j < 8; ++j) { ov[j] -= mu; vs += ov[j] * ov[j]; }
            vs += __shfl_xor(vs, 1); vs += __shfl_xor(vs, 2); vs += __shfl_xor(vs, 4);
            const float rs = rsqrtf(vs * (1.0f / 64.0f) + EPS);
            const float gt[8] = {bflo(gw.x), bfhi(gw.x), bflo(gw.y), bfhi(gw.y), bflo(gw.z), bfhi(gw.z), bflo(gw.w), bfhi(gw.w)};
            const float gnv[8] = {gn0.x, gn0.y, gn0.z, gn0.w, gn1.x, gn1.y, gn1.z, gn1.w};
            float r8[8];
#pragma unroll
            for (int j = 0; j < 8; ++j) r8[j] = ov[j] * rs * gnv[j] * siluf_(gt[j]);
            u32x4 w; w.x = pk2(r8[0], r8[1]); w.y = pk2(r8[2], r8[3]); w.z = pk2(r8[4], r8[5]); w.w = pk2(r8[6], r8[7]);
            *(u32x4*)(y + tok * DM + h * 64 + 8 * pg) = w;
        }
    }
#undef RT_LOAD
#undef RT_STAGE
    __syncthreads();
}

constexpr int LR_XC = 0, LR_AU = 33792;
__device__ __forceinline__ void lru_item(const Params& P, int l, LAS unsigned char* lds, int it, int mode, int tid, int wave, int lane) {
    const int b = it >> 5, n = it & 31, fr = lane & 15, fq = lane >> 4;
    const bf16_t* z = (const bf16_t*)(P.ws + WS_R); bf16_t* y = (bf16_t*)(P.ws + WS_R + R_Y);
    LAS bf16_t* XC = (LAS bf16_t*)(lds + LR_XC); LAS f32x2* AU = (LAS f32x2*)(lds + LR_AU);
    float* sumA = (float*)(P.ws + WS_LRUS); float* sumH = sumA + 16 * 32 * 256;
    {
        const int c = tid >> 3, cg = tid & 7, s = n * 64 + c; const size_t tok = (size_t)b * SEQ + s;
        const float* cw = P.lru_conv_w + (size_t)l * 4 * 256; const float* cb = P.lru_conv_b + l * 256;
#pragma unroll
        for (int g = 0; g < 4; ++g) { const int ch0 = cg * 32 + g * 8;
            const f32x4 b0 = *(const f32x4*)(cb + ch0), b1 = *(const f32x4*)(cb + ch0 + 4);
            float a[8] = {b0.x, b0.y, b0.z, b0.w, b1.x, b1.y, b1.z, b1.w};
#pragma unroll
            for (int kk = 0; kk < 4; ++kk) { const bool okk = s - 3 + kk >= 0; const float mk = okk ? 1.f : 0.f;
                const u32x4 w = *(const u32x4*)(z + (okk ? tok - 3 + kk : tok) * ZP + Z_LX + ch0);
                const f32x4 c0 = *(const f32x4*)(cw + kk * 256 + ch0) * mk, c1 = *(const f32x4*)(cw + kk * 256 + ch0 + 4) * mk;
                a[0] += c0.x * bflo(w.x); a[1] += c0.y * bfhi(w.x); a[2] += c0.z * bflo(w.y); a[3] += c0.w * bfhi(w.y);
                a[4] += c1.x * bflo(w.z); a[5] += c1.y * bfhi(w.z); a[6] += c1.z * bflo(w.w); a[7] += c1.w * bfhi(w.w); }
            u32x4 o; o.x = pk2(a[0], a[1]); o.y = pk2(a[2], a[3]); o.z = pk2(a[4], a[5]); o.w = pk2(a[6], a[7]);
            *(LAS u32x4*)(XC + c * 264 + ch0) = o; }
    }
    float hcar = 0.f, aprod = 1.f;
    if (mode == 1 && tid < 256) {
        float av[32], hv[32];
#pragma unroll
        for (int m = 0; m < 32; ++m) { const int mm = m < n ? m : 0; av[m] = sumA[(b * 32 + mm) * 256 + tid]; hv[m] = sumH[(b * 32 + mm) * 256 + tid]; }
#pragma unroll
        for (int m = 0; m < 32; ++m) if (m < n) hcar = av[m] * hcar + hv[m];
    }
    const int nb = wave >> 1, rt = wave & 1;
    const bf16_t* wa = wl(P, l, W_A) + nb * 4096; const bf16_t* wx = wl(P, l, W_X) + nb * 4096;
    bf16x8 fa[4][2], fx[4][2]; float ba[4], bx[4], spl[4];
#pragma unroll
    for (int dt = 0; dt < 4; ++dt) {
#pragma unroll
        for (int s = 0; s < 2; ++s) { fa[dt][s] = *(const bf16x8*)(wa + (dt * 16 + fr) * 64 + 32 * s + 8 * fq); fx[dt][s] = *(const bf16x8*)(wx + (dt * 16 + fr) * 64 + 32 * s + 8 * fq); }
        const int d = nb * 64 + dt * 16 + fr; ba[dt] = P.lru_ba[l * 256 + d]; bx[dt] = P.lru_bx[l * 256 + d]; spl[dt] = -8.0f * softplusf_(-P.lru_lambda[l * 256 + d]); }
    __syncthreads();
    for (int half = 0; half < 2; ++half) {
        const int trow = half * 32 + rt * 16;
        const bf16x8 x0 = *(const LAS bf16x8*)(XC + (trow + fr) * 264 + nb * 64 + 8 * fq), x1 = *(const LAS bf16x8*)(XC + (trow + fr) * 264 + nb * 64 + 32 + 8 * fq);
#pragma unroll
        for (int dt = 0; dt < 4; ++dt) {
            f32x4 ar = {0.f, 0.f, 0.f, 0.f}, ai = {0.f, 0.f, 0.f, 0.f};
            ar = mfma16(x0, fa[dt][0], ar); ar = mfma16(x1, fa[dt][1], ar); ai = mfma16(x0, fx[dt][0], ai); ai = mfma16(x1, fx[dt][1], ai);
            const int d = nb * 64 + dt * 16 + fr;
#pragma unroll
            for (int r = 0; r < 4; ++r) { const int tl = rt * 16 + 4 * fq + r;
                const float xcv = bf2f(XC[(half * 32 + tl) * 264 + d]);
                const float rr = sigmoidf_(ar[r] + ba[dt]), ii = sigmoidf_(ai[r] + bx[dt]);
                const float a = __expf(rr * spl[dt]);
                const float u = sqrtf(fmaxf(1.0f - a * a, 0.f)) * (ii * xcv);
                AU[tl * 257 + d] = (f32x2){a, u}; }
        }
        __syncthreads();
        if (tid < 256) {
#pragma unroll 8
            for (int tk = 0; tk < 32; ++tk) { const f32x2 au = AU[tk * 257 + tid]; hcar = au.x * hcar + au.y; aprod *= au.x; if (mode == 1) AU[tk * 257 + tid].y = hcar; }
        }
        if (mode == 1) {
            __syncthreads();
            const int tk = tid >> 4, c0 = (tid & 15) * 16; const size_t tok = (size_t)b * SEQ + n * 64 + half * 32 + tk;
            const u32x4 g0 = *(const u32x4*)(z + tok * ZP + Z_LG + c0), g1 = *(const u32x4*)(z + tok * ZP + Z_LG + c0 + 8);
            const unsigned gws[8] = {g0.x, g0.y, g0.z, g0.w, g1.x, g1.y, g1.z, g1.w}; unsigned ow[8];
#pragma unroll
            for (int j = 0; j < 8; ++j) { const float h0 = AU[tk * 257 + c0 + 2 * j].y, h1 = AU[tk * 257 + c0 + 2 * j + 1].y; ow[j] = pk2(h0 * geluf_(bflo(gws[j])), h1 * geluf_(bfhi(gws[j]))); }
            bf16_t* yp = y + tok * DM + 256 + c0;
            *(u32x4*)yp = (u32x4){ow[0], ow[1], ow[2], ow[3]}; *(u32x4*)(yp + 8) = (u32x4){ow[4], ow[5], ow[6], ow[7]};
        }
        __syncthreads();
    }
    if (mode == 0 && tid < 256) { sumA[(b * 32 + n) * 256 + tid] = aprod; sumH[(b * 32 + n) * 256 + tid] = hcar; }
}

constexpr int N_PHASES = 21;
constexpr int Q_RET = 64, Q_GDN = 32, Q_LRU = 512, Q_MLA = 1024, Q_TOTAL = Q_RET + Q_GDN + Q_LRU + Q_MLA;

__global__ void __launch_bounds__(512, 2) hymba_fwd(Params P_) {
    extern __shared__ __attribute__((aligned(16))) unsigned char lds_raw[];
    LAS unsigned char* lds = (LAS unsigned char*)lds_raw;
    volatile LAS unsigned* LC = (volatile LAS unsigned*)(lds + LDS_CTL);
    const int G = gridDim.x;
#define SUB_TID() int tid2 = tid; asm volatile("" : "+v"(tid2)); const int lane2 = tid2 & 63, wave2 = __builtin_amdgcn_readfirstlane(tid2 >> 6); (void)lane2; (void)wave2
#if defined(__HIP_DEVICE_COMPILE__)
#define PH_PARAMS() const __attribute__((address_space(4))) Params* pp_ = (const __attribute__((address_space(4))) Params*)__builtin_amdgcn_kernarg_segment_ptr(); asm volatile("" : "+s"(pp_)); const Params P = *pp_
#else
#define PH_PARAMS() const Params P = P_
#endif
#define PH_TID() PH_PARAMS(); \
    bf16_t* xb = (bf16_t*)(P.ws + WS_XB); float* part = (float*)(P.ws + WS_PART); bf16_t* zb = (bf16_t*)(P.ws + WS_R); bf16_t* yb = (bf16_t*)(P.ws + WS_R + R_Y); bf16_t* oxb = (bf16_t*)(P.ws + WS_R + R_OX); (void)xb; (void)part; (void)zb; (void)yb; (void)oxb; \
    int tid = threadIdx.x; asm volatile("" : "+v"(tid)); const int lane = tid & 63, wave = __builtin_amdgcn_readfirstlane(tid >> 6); (void)lane; (void)wave
    unsigned* ctl = (unsigned*)(P_.ws + WS_CTL);
    if (threadIdx.x < 64) LC[threadIdx.x] = 0u;
    __syncthreads();
    const int lo = P_.ph_lo, hi = P_.ph_hi;
    XcdBarrier bar; bar.bar = ctl + CW_BAR; bar.x = 0; bar.st = LC;
    if (hi - lo > 1) bar = xcd_barrier_post(ctl + CW_BAR, LC);
#ifndef PHASE_MASK
#define PHASE_MASK 0xFFFFFFFFu
#endif
#define EN(t) ((PHASE_MASK >> (t)) & 1u)
#ifndef REPEAT_MASK
#define REPEAT_MASK 0u
#endif
#define REP(t) for (int rep_ = 0; rep_ <= (int)((REPEAT_MASK >> (t)) & 1u); ++rep_, (rep_ <= (int)((REPEAT_MASK >> (t)) & 1u) ? xcd_barrier(bar) : (void)0))
#define IN(k) (lo <= (k) && (k) < hi)
#define SEAM(k) do { if (IN(k) && IN((k) + 1)) xcd_barrier(bar); } while (0)


    if (IN(0) && EN(0)) REP(0) { PH_TID(); p0_prologue(P, lds, tid); __syncthreads(); }
    SEAM(0);
    if (IN(1) && EN(1)) REP(1) {
        PH_TID();
        const int which = blockIdx.x >> 6, l = which >> 1, isv = which & 1;
        if (which < 4) {
            const bf16_t* memn = (const bf16_t*)(P.ws + WS_GDN); const bf16_t* wkv = wl(P, l, W_KV);
            bf16_t* kout = (bf16_t*)(P.ws + WS_KVM + (size_t)l * KVM_LAYER); bf16_t* vout = kout + (size_t)4096 * 1024;
            pg8::Gemm g; pg8::EpiScaleBf16<0> E; pg8::StaticOrder S;
            if (!isv) { g = pg8::Gemm{memn, wkv, 4096, 1024, 1024}; E = pg8::EpiScaleBf16<0>{kout, 1024, nullptr}; S.init(4096, 1024, 64, blockIdx.x & 63); }
            else { g = pg8::Gemm{wkv + (size_t)1024 * 1024, memn, 1024, 4096, 1024}; E = pg8::EpiScaleBf16<0>{vout, 4096, nullptr}; S.init(1024, 4096, 64, blockIdx.x & 63); }
            pg8::gemm_phase(lds, g, S, E, tid);
        }
    }
    SEAM(1);
#pragma unroll
    for (int l = 0; l < 2; ++l) {
        const int pb = 2 + 9 * l;
        if (IN(pb + 0) && EN(2)) REP(2) { PH_TID();
            pg8::Gemm g{xb, wl(P, l, W_IN), T_TOK, ZP, DM}; pg8::StaticOrder S; S.init(T_TOK, ZP, G, blockIdx.x);
            pg8::EpiScaleBf16<0> E{zb, ZP, part}; pg8::gemm_phase(lds, g, S, E, tid);
        }
        SEAM(pb + 0);
        if (IN(pb + 1)) {
            PH_TID();
            if (EN(3)) REP(3) { SUB_TID(); for (int it = blockIdx.x; it < 1024; it += G) gdn_pre_item(P, l, lds, it, tid2); }
            if (EN(4)) REP(4) { SUB_TID(); for (int it = blockIdx.x; it < 512; it += G) { lru_item(P, l, lds, it, 0, tid2, wave2, lane2); __syncthreads(); } }
            if (EN(5)) REP(5) { SUB_TID(); for (int rt = blockIdx.x * 8 + wave2; rt < 2048; rt += G * 8) mla_pre_tile(P, l, rt, lane2); }
        }
        SEAM(pb + 1);
        if (IN(pb + 2)) {
            PH_TID();
            unsigned* qh0 = ctl + CW_QUEUE + 64 * l;
#define QUEUE_LOOP(qi_, count_, body_) for (;;) { if (tid == 0) LC[4] = __hip_atomic_fetch_add(qh + (qi_), 1u, __ATOMIC_RELAXED, __HIP_MEMORY_SCOPE_AGENT); \
                __syncthreads(); const int it = (int)LC[4]; __syncthreads(); if (it >= (count_)) break; { SUB_TID(); body_; } __syncthreads(); }
            if (EN(6)) REP(6) { unsigned* qh = qh0 + 32 * rep_; QUEUE_LOOP(0, Q_RET, ret_chain_item(P, l, lds, it, tid2, wave2, lane2)) }
            if (EN(7)) REP(7) { unsigned* qh = qh0 + 32 * rep_; QUEUE_LOOP(1, Q_GDN, gdn_chain_item(P, l, lds, it, tid2, wave2, lane2)) }
            if (EN(8)) REP(8) { unsigned* qh = qh0 + 32 * rep_; QUEUE_LOOP(2, Q_LRU, lru_item(P, l, lds, it, 1, tid2, wave2, lane2)) }
            if (EN(9)) REP(9) { unsigned* qh = qh0 + 32 * rep_; QUEUE_LOOP(3, Q_MLA, mla_attn_item(P, lds, it, tid2, wave2, lane2)) }
#undef QUEUE_LOOP
        }
        SEAM(pb + 2);
        if (IN(pb + 3) && EN(10)) REP(10) { PH_TID();
            pg8::Gemm g{yb, wl(P, l, W_OUT), T_TOK, DM, DM}; pg8::StaticOrder S; S.init(T_TOK, DM, G, blockIdx.x);
            pg8::EpiResid E{P.out, xb, part, rep_ ? 0.f : 1.f}; pg8::gemm_phase(lds, g, S, E, tid);
        }
        SEAM(pb + 3);
        if (IN(pb + 4) && EN(11)) REP(11) { PH_TID();
            pg8::Gemm g{xb, wl(P, l, W_Q), T_TOK, DM, DM}; pg8::StaticOrder S; S.init(T_TOK, DM, G, blockIdx.x);
            pg8::EpiScaleBf16<0> E{zb, DM, part}; pg8::gemm_phase(lds, g, S, E, tid);
        }
        SEAM(pb + 4);
        if (IN(pb + 5) && EN(12)) REP(12) { PH_TID(); for (int it = blockIdx.x; it < 1024; it += G) { xa_item(P, l, lds, it, tid, wave, lane); __syncthreads(); } }
        SEAM(pb + 5);
        if (IN(pb + 6) && EN(13)) REP(13) { PH_TID();
            pg8::Gemm g{oxb, wl(P, l, W_O), T_TOK, DM, DM}; pg8::StaticOrder S; S.init(T_TOK, DM, G, blockIdx.x);
            pg8::EpiResid E{P.out, xb, part, rep_ ? 0.f : 1.f}; pg8::gemm_phase(lds, g, S, E, tid);
        }
        SEAM(pb + 6);
        if (IN(pb + 7) && EN(14)) REP(14) { PH_TID();
            pg8::Gemm g{xb, wl(P, l, W_1), T_TOK, DFF, DM}; pg8::StaticOrder S; S.init(T_TOK, DFF, G, blockIdx.x);
            pg8::EpiScaleBf16<1> E{zb, DFF, part}; pg8::gemm_phase(lds, g, S, E, tid);
        }
        SEAM(pb + 7);
        if (IN(pb + 8) && EN(15)) REP(15) { PH_TID();
            pg8::Gemm g{zb, wl(P, l, W_2), T_TOK, DM, DFF}; pg8::StaticOrder S; S.init(T_TOK, DM, G, blockIdx.x);
            pg8::EpiResid E{P.out, xb, part, rep_ ? 0.f : 1.f}; pg8::gemm_phase(lds, g, S, E, tid);
        }
        SEAM(pb + 8);
    }
    if (IN(20) && EN(16)) { PH_TID(); final_norm_phase(P, tid); }
#undef IN
#undef SEAM
}

extern "C" void kernel_launch(void* const* d_in, const int* in_sizes, int n_in, void* d_out, int out_size, void* d_ws, size_t ws_size, hipStream_t stream) {
    static int grid = 0;
    if (grid == 0) {
        if (n_in != 31 || out_size != T_TOK * DM || ws_size < WS_END) { fprintf(stderr, "kernel_launch: unexpected shapes (n_in %d out %d ws %zu, need %zu)\n", n_in, out_size, ws_size, (size_t)WS_END); grid = -1; return; }
        if (hipFuncSetAttribute((const void*)hymba_fwd, hipFuncAttributeMaxDynamicSharedMemorySize, LDS_BYTES) != hipSuccess) { fprintf(stderr, "kernel_launch: hipFuncSetAttribute failed\n"); grid = -1; return; }
        int dev = 0, cus = 0, per_cu = 0;
        (void)hipGetDevice(&dev); (void)hipDeviceGetAttribute(&cus, hipDeviceAttributeMultiprocessorCount, dev);
        (void)hipOccupancyMaxActiveBlocksPerMultiprocessor(&per_cu, (const void*)hymba_fwd, 512, LDS_BYTES);
        (void)hipGetLastError();
        if (cus != 256 || per_cu < 1) fprintf(stderr, "kernel_launch: note: cus %d per_cu %d\n", cus, per_cu);
        grid = 256;
    }
    if (grid < 0) return;
    (void)hipMemsetAsync((char*)d_ws + WS_CTL, 0, CTL_BYTES, stream);
    Params p{};
    p.x = (const float*)d_in[0]; p.mem = (const float*)d_in[1]; p.pos = (const int*)d_in[2];
    p.norm_mix = (const float*)d_in[3]; p.w_in = (const float*)d_in[4]; p.ret_gn = (const float*)d_in[5];
    p.lru_conv_w = (const float*)d_in[6]; p.lru_conv_b = (const float*)d_in[7]; p.lru_wa = (const float*)d_in[8]; p.lru_ba = (const float*)d_in[9];
    p.lru_wx = (const float*)d_in[10]; p.lru_bx = (const float*)d_in[11]; p.lru_lambda = (const float*)d_in[12];
    p.mla_q_norm = (const float*)d_in[13]; p.mla_w_uq = (const float*)d_in[14]; p.mla_kv_norm = (const float*)d_in[15]; p.mla_w_ukv = (const float*)d_in[16];
    p.gdn_conv_w = (const float*)d_in[17]; p.gdn_a_log = (const float*)d_in[18]; p.gdn_dt_bias = (const float*)d_in[19]; p.gdn_norm = (const float*)d_in[20];
    p.w_out = (const float*)d_in[21]; p.norm_xattn = (const float*)d_in[22]; p.norm_mem = (const float*)d_in[23];
    p.xa_wq = (const float*)d_in[24]; p.xa_wkv = (const float*)d_in[25]; p.xa_wo = (const float*)d_in[26];
    p.norm_mlp = (const float*)d_in[27]; p.mlp_w1 = (const float*)d_in[28]; p.mlp_w2 = (const float*)d_in[29]; p.final_norm = (const float*)d_in[30];
    p.out = (float*)d_out; p.ws = (unsigned char*)d_ws;
#if N_LAUNCHES == 1
    p.ph_lo = 0; p.ph_hi = N_PHASES;
    void* args[] = {&p};
    hipError_t e = hipLaunchCooperativeKernel((const void*)hymba_fwd, dim3(grid), dim3(512), args, LDS_BYTES, stream);
    if (e != hipSuccess) fprintf(stderr, "kernel_launch: cooperative launch failed: %s\n", hipGetErrorString(e));
#else
    for (int ph = 0; ph < N_PHASES; ++ph) { p.ph_lo = ph; p.ph_hi = ph + 1; hipLaunchKernelGGL(hymba_fwd, dim3(grid), dim3(512), LDS_BYTES, stream, p); }
#endif
}
```

```cpp
#include <hip/hip_runtime.h>
#include <cstdio>
#include <cstdint>

#ifndef N_LAUNCHES
#define N_LAUNCHES 1
#endif

#define LAS __attribute__((address_space(3)))
typedef unsigned short bf16_t;
typedef short bf16x8 __attribute__((ext_vector_type(8)));
typedef float f32x4 __attribute__((ext_vector_type(4)));
typedef float f32x2 __attribute__((ext_vector_type(2)));
typedef unsigned u32x4 __attribute__((ext_vector_type(4)));
typedef unsigned u32x2 __attribute__((ext_vector_type(2)));

constexpr int T_TOK = 32768, DM = 1024, SEQ = 2048, NBATCH = 16, NCHUNK = 32, ZP = 3072, DFF = 4096, NMEM = 256;
constexpr int Z_RQ = 0, Z_RK = 256, Z_RV = 512, Z_RG = 768, Z_LX = 1024, Z_LG = 1280, Z_CQ = 1536, Z_CKV = 1728, Z_KR = 1856,
              Z_GQKV = 1888, Z_GG = 2656, Z_GB = 2912, Z_GA = 2916, IN_COLS = 2920;
constexpr float EPS = 1e-6f;
constexpr float LOG2E = 1.4426950408889634f;

constexpr size_t MiB = 1024 * 1024;
constexpr size_t WS_CTL = 0;
constexpr size_t CTL_BYTES = 65536;
constexpr size_t WS_PART = WS_CTL + CTL_BYTES;
constexpr size_t WS_LRUS = WS_PART + (size_t)T_TOK * 16 * 4;
constexpr size_t WS_GL = WS_LRUS + (size_t)2 * 16 * 32 * 256 * 4;
constexpr size_t WS_W = WS_GL + 65536;
constexpr size_t W_IN = 0, W_OUT = W_IN + (size_t)ZP * DM, W_Q = W_OUT + (size_t)DM * DM, W_KV = W_Q + (size_t)DM * DM, W_O = W_KV + (size_t)2 * DM * DM,
                 W_1 = W_O + (size_t)DM * DM, W_2 = W_1 + (size_t)DFF * DM, W_UQ = W_2 + (size_t)DFF * DM, W_UKV = W_UQ + 384 * 192, W_A = W_UKV + 512 * 128,
                 W_X = W_A + 4 * 64 * 64, W_LAYER = W_X + 4 * 64 * 64;
constexpr size_t WS_XB = WS_W + 2 * W_LAYER * 2;
constexpr size_t XB_BYTES = (size_t)T_TOK * DM * 2;
constexpr size_t MLA_Q_OFF = 0, MLA_K_OFF = (size_t)T_TOK * 4 * 96 * 2, MLA_VT_OFF = 2 * MLA_K_OFF;
constexpr size_t WS_KVM = WS_XB + XB_BYTES;
constexpr size_t KVM_LAYER = (size_t)2 * 4096 * 1024 * 2;
constexpr size_t WS_R = WS_KVM + 2 * KVM_LAYER;
constexpr size_t R_Y = (size_t)T_TOK * ZP * 2;
constexpr size_t R_OX = (size_t)T_TOK * DM * 2;
constexpr size_t WS_GDN = WS_R + 256 * MiB;
constexpr size_t WS_END = WS_GDN + 80 * MiB;
static_assert(WS_END <= 512 * MiB, "workspace map exceeds 512 MiB");
static_assert(WS_XB % 256 == 0 && WS_R % 256 == 0 && WS_GDN % 256 == 0 && WS_W % 256 == 0, "alignment");
constexpr int CW_BAR = 0;
constexpr int CW_QUEUE = 4096;

constexpr int LDS_BYTES = 160 * 1024;
constexpr int LDS_CTL = LDS_BYTES - 256;

typedef __bf16 bf16x2_t __attribute__((ext_vector_type(2)));
__device__ __forceinline__ unsigned pk2(float lo, float hi) { f32x2 t = {lo, hi}; bf16x2_t v = __builtin_convertvector(t, bf16x2_t); return __builtin_bit_cast(unsigned, v); }
__device__ __forceinline__ float bflo(unsigned w) { return __uint_as_float(w << 16); }
__device__ __forceinline__ float bfhi(unsigned w) { return __uint_as_float(w & 0xffff0000u); }
__device__ __forceinline__ float bf2f(bf16_t v) { return __uint_as_float((unsigned)v << 16); }
__device__ __forceinline__ bf16_t f2bf(float f) { return (bf16_t)(pk2(f, 0.f) & 0xffffu); }
__device__ __forceinline__ f32x4 mfma16(bf16x8 a, bf16x8 b, f32x4 c) { return __builtin_amdgcn_mfma_f32_16x16x32_bf16(a, b, c, 0, 0, 0); }
__device__ __forceinline__ float fexp2_(float x) { return __builtin_amdgcn_exp2f(x); }
__device__ __forceinline__ float fexp_(float x) { return __builtin_amdgcn_exp2f(x * LOG2E); }
__device__ __forceinline__ float frcp_(float x) { return __builtin_amdgcn_rcpf(x); }
__device__ __forceinline__ float frsq_(float x) { return __builtin_amdgcn_rsqf(x); }
__device__ __forceinline__ float fsqrt_(float x) { return __builtin_amdgcn_sqrtf(x); }
__device__ __forceinline__ float sigmoidf_(float x) { return frcp_(1.0f + fexp_(-x)); }
__device__ __forceinline__ float siluf_(float x) { return x * frcp_(1.0f + fexp_(-x)); }
__device__ __forceinline__ float softplusf_(float x) { return x > 20.f ? x : log1pf(__expf(x)); }
__device__ __forceinline__ float geluf_(float x) { const float u = 1.5957691216057308f * (x + 0.044715f * x * x * x); return x * frcp_(1.0f + fexp_(-u)); }
__device__ __forceinline__ float wave_sum(float v) {
#pragma unroll
    for (int o = 1; o < 64; o <<= 1) v += __shfl_xor(v, o);
    return v;
}
__device__ __forceinline__ void sincos_rev(float ang, float& s, float& c) {
    float rev = ang * 0.15915494309189535f; rev = rev - floorf(rev);
    s = __builtin_amdgcn_sinf(rev); c = __builtin_amdgcn_cosf(rev);
}
__device__ __forceinline__ bf16x8 mk8(u32x2 lo, u32x2 hi) { u32x4 t; t.x = lo.x; t.y = lo.y; t.z = hi.x; t.w = hi.y; return __builtin_bit_cast(bf16x8, t); }
__device__ __forceinline__ bf16x8 pack8(f32x4 a, f32x4 b) { u32x4 t; t.x = pk2(a.x, a.y); t.y = pk2(a.z, a.w); t.z = pk2(b.x, b.y); t.w = pk2(b.z, b.w); return __builtin_bit_cast(bf16x8, t); }

#define XB_TMO      128
#define XB_XCNT(j)  (256  + 64 * (j))
#define XB_XSUB(j)  (1280 + 64 * (j))
#define XB_XGEN(j)  (2304 + 64 * (j))
#define XB_TOP      3328
#define XB_TOPGEN   3392
#define XCD_BAR_WORDS 3456
#define XB_SPIN_CAP (1u << 22)
__device__ __forceinline__ unsigned xb_ld(unsigned* p)              { return __hip_atomic_load(p, __ATOMIC_RELAXED, __HIP_MEMORY_SCOPE_AGENT); }
__device__ __forceinline__ unsigned xb_add(unsigned* p, unsigned v) { return __hip_atomic_fetch_add(p, v, __ATOMIC_RELAXED, __HIP_MEMORY_SCOPE_AGENT); }
__device__ __forceinline__ unsigned xb_xcc_id() { return (unsigned)__builtin_amdgcn_s_getreg((3 << 11) | 20) & 0xFu; }
#define XB_SPIN(cond, bar) do { unsigned _sp = 0; while (cond) { __builtin_amdgcn_s_sleep(1); \
    if ((++_sp & 255u) == 0u) { if (xb_ld(&(bar)[XB_TMO])) break; if (_sp > XB_SPIN_CAP) { atomicAdd(&(bar)[XB_TMO], 1u); break; } } } } while (0)
struct XcdBarrier { unsigned* bar; unsigned x; volatile LAS unsigned* st; };
__device__ __forceinline__ XcdBarrier xcd_barrier_post(unsigned* bar, volatile LAS unsigned* st) {
    XcdBarrier b; b.bar = bar; b.x = xb_xcc_id(); b.st = st;
    if (threadIdx.x == 0) (void)xb_add(&bar[XB_XCNT(b.x)], 1u);
    return b;
}
__device__ __forceinline__ void xcd_barrier_complete(unsigned* bar, unsigned x, unsigned& nloc, unsigned& nx) {
    const unsigned G = gridDim.x * gridDim.y * gridDim.z;
    unsigned sum, cnt, mine, sp = 0u;
    for (;;) {
        sum = 0u; cnt = 0u; mine = 0u;
#pragma unroll
        for (unsigned j = 0; j < 16; ++j) { const unsigned c = xb_ld(&bar[XB_XCNT(j)]); sum += c; cnt += (c > 0u) ? 1u : 0u; mine = (j == x) ? c : mine; }
        if (sum == G) break;
        __builtin_amdgcn_s_sleep(1);
        if ((++sp & 255u) == 0u) { if (xb_ld(&bar[XB_TMO])) break; if (sp > XB_SPIN_CAP) { atomicAdd(&bar[XB_TMO], 1u); break; } }
    }
    nloc = mine > 0u ? mine : 1u; nx = cnt > 0u ? cnt : 1u;
}
__device__ __forceinline__ void xcd_barrier(const XcdBarrier& b) {
    asm volatile("s_waitcnt vmcnt(0)" ::: "memory");
    __syncthreads();
    if (threadIdx.x == 0) {
        unsigned* bar = b.bar;
        __builtin_amdgcn_s_waitcnt(0);
        unsigned nloc = b.st[0], nx = b.st[1];
        if (nloc == 0u) { xcd_barrier_complete(bar, b.x, nloc, nx); b.st[0] = nloc; b.st[1] = nx; }
        const unsigned old = xb_add(&bar[XB_XSUB(b.x)], 1u);
        const unsigned gen = old / nloc;
        if (old + 1u == (gen + 1u) * nloc) {
            __builtin_amdgcn_fence(__ATOMIC_RELEASE, "agent");
            asm volatile("s_waitcnt vmcnt(0)" ::: "memory");
            const unsigned og = xb_add(&bar[XB_TOP], 1u);
            const unsigned tg = og / nx;
            if (og + 1u == (tg + 1u) * nx) xb_add(&bar[XB_TOPGEN], 1u);
            else XB_SPIN(xb_ld(&bar[XB_TOPGEN]) == tg, bar);
            __builtin_amdgcn_fence(__ATOMIC_ACQUIRE, "agent");
            xb_add(&bar[XB_XGEN(b.x)], 1u);
            asm volatile("s_waitcnt vmcnt(0)" ::: "memory");
        } else {
            XB_SPIN(xb_ld(&bar[XB_XGEN(b.x)]) == gen, bar);
            __builtin_amdgcn_fence(__ATOMIC_ACQUIRE, "agent");
            asm volatile("s_waitcnt vmcnt(0)" ::: "memory");
        }
    }
    __syncthreads();
}

namespace pg8 {
constexpr int BM = 256, BK = 64, HALF = 128, HTB = HALF * BK * 2, STAGE_BYTES = 8 * HTB, NXCD = 8, WGM = 8;
__host__ __device__ __forceinline__ int lds_byte(int r, int c) { const int st = (r >> 4) * 2 + (c >> 5), rr = r & 15, cc = c & 31, ob = rr * 64 + cc * 2; return st * 1024 + (ob ^ (((ob >> 9) & 1) << 5)); }
__host__ __device__ __forceinline__ void stage_rc(int b, int& R, int& C) { const int st = b / 1024, sb = b % 1024, swz = sb ^ (((sb >> 9) & 1) << 5); R = (st >> 1) * 16 + swz / 64; C = (st & 1) * 32 + (swz % 64) / 2; }
__host__ __device__ __forceinline__ int perm32(int rho) { const int n = rho >> 4, i = rho & 15; return 8 * (i >> 2) + 4 * n + (i & 3); }
struct Unit { int pm, pn; };
struct Gemm { const bf16_t* A; const bf16_t* Bt; int M, N, K; };
struct StaticOrder {
    int nM, nN, nwg, G, c;
    __host__ __device__ void init(int M, int N, int G_, int c_) { nM = M / BM; nN = N / BM; nwg = nM * nN; G = G_; c = c_; }
    __host__ __device__ bool next(int i, Unit& u) const {
        const long L = (long)i * G + c; if (L >= nwg) return false;
        int wgid = (int)L; { const int q = nwg / NXCD, r = nwg % NXCD, xcd = wgid % NXCD, off = wgid / NXCD; wgid = (xcd < r ? xcd * (q + 1) : r * (q + 1) + (xcd - r) * q) + off; }
        const int nig = WGM * nN, gid = wgid / nig, fm = gid * WGM, gsz = (nM - fm) < WGM ? (nM - fm) : WGM;
        u.pm = fm + ((wgid % nig) % gsz); u.pn = (wgid % nig) / gsz; return true;
    }
    __device__ __forceinline__ void a_ready(const Unit&) const {}
    __device__ __forceinline__ void done(const Unit&) const {}
};

template <int ACT> struct EpiScaleBf16 {
    static constexpr bool PERM = true;
    bf16_t* O; int ldc; const float* part;
    __device__ __forceinline__ void operator()(const f32x4 (&acc)[2][2][4][2], const Unit& u, int wr, int wc, int fr, int fq) const {
        const int row0 = u.pm * BM + wr * 64 + fr, col0 = u.pn * BM + wc * 32 + 8 * fq;
#pragma unroll
        for (int ai = 0; ai < 2; ++ai)
#pragma unroll
            for (int m = 0; m < 4; ++m) {
                const int row = row0 + ai * HALF + m * 16;
                float sc = 1.0f;
                if (part) { const f32x4* pp = (const f32x4*)(part + (size_t)row * 16); const f32x4 a = pp[0], b = pp[1], c = pp[2], d = pp[3];
                    const float s = ((a.x + a.y) + (a.z + a.w)) + ((b.x + b.y) + (b.z + b.w)) + ((c.x + c.y) + (c.z + c.w)) + ((d.x + d.y) + (d.z + d.w));
                    sc = frsq_(s * (1.0f / 1024.0f) + EPS); }
                bf16_t* rowp = O + (size_t)row * ldc + col0;
#pragma unroll
                for (int bj = 0; bj < 2; ++bj) { f32x4 v0 = acc[ai][bj][m][0] * sc, v1 = acc[ai][bj][m][1] * sc;
                    if (ACT == 1) {
#pragma unroll
                        for (int j = 0; j < 4; ++j) { const float a0 = fmaxf(v0[j], 0.f), a1 = fmaxf(v1[j], 0.f); v0[j] = a0 * a0; v1[j] = a1 * a1; } }
                    u32x4 w; w.x = pk2(v0[0], v0[1]); w.y = pk2(v0[2], v0[3]); w.z = pk2(v1[0], v1[1]); w.w = pk2(v1[2], v1[3]);
                    *(u32x4*)(rowp + bj * HALF) = w; }
            }
    }
};
struct EpiResid {
    static constexpr bool PERM = false;
    float* X; bf16_t* XB; float* part; float alpha;
    __device__ __forceinline__ void operator()(const f32x4 (&acc)[2][2][4][2], const Unit& u, int wr, int wc, int fr, int fq) const {
        const int row0 = u.pm * BM + wr * 64 + fr, col0 = u.pn * BM + wc * 32 + 4 * fq;
#pragma unroll
        for (int ai = 0; ai < 2; ++ai)
#pragma unroll
            for (int m = 0; m < 4; ++m) {
                const int row = row0 + ai * HALF + m * 16;
                float* xp = X + (size_t)row * DM + col0; bf16_t* bp = XB + (size_t)row * DM + col0;
                float ss = 0.f;
#pragma unroll
                for (int bj = 0; bj < 2; ++bj)
#pragma unroll
                    for (int n = 0; n < 2; ++n) { const f32x4 v = *(const f32x4*)(xp + bj * HALF + n * 16) + acc[ai][bj][m][n] * alpha;
                        *(f32x4*)(xp + bj * HALF + n * 16) = v; ss += (v.x * v.x + v.y * v.y) + (v.z * v.z + v.w * v.w);
                        u32x2 w; w.x = pk2(v.x, v.y); w.y = pk2(v.z, v.w); *(u32x2*)(bp + bj * HALF + n * 16) = w; }
                ss += __shfl_xor(ss, 16); ss += __shfl_xor(ss, 32);
                if (fq == 0) part[(size_t)row * 16 + u.pn * 4 + wc] = ss;
            }
    }
};

template <class Epi, class Sched>
__device__ __forceinline__ void gemm_phase(LAS unsigned char* lds, const Gemm g, const Sched& S, const Epi& E, const int tid) {
    const int wid = __builtin_amdgcn_readfirstlane(tid >> 6), lane = tid & 63, wr = wid >> 2, wc = wid & 3, fr = lane & 15, fq = lane >> 4;
    const int K = g.K, nt = K / BK;
    unsigned voffA[2], voffB[2];
#pragma unroll
    for (int i = 0; i < 2; ++i) { int R, C; stage_rc(tid * 16 + i * 8192, R, C); const int Rb = Epi::PERM ? ((R & ~31) + perm32(R & 31)) : R;
        voffA[i] = (unsigned)(R * K + C) * 2u; voffB[i] = (unsigned)(Rb * K + C) * 2u; }
    const size_t kstep = (size_t)(BK * 2);
    const size_t hstep = (size_t)HALF * K * 2;
    const size_t tstep = 2 * hstep;
    const unsigned ldsw = (unsigned)wid * 1024u;
    const int aoff = lds_byte(wr * 64 + fr, fq * 8), boff = lds_byte(wc * 32 + fr, fq * 8);
#define PG8_SA(b, h) (((b) * 2 + (h)) * HTB)
#define PG8_SB(b, h) ((4 + (b) * 2 + (h)) * HTB)
#define PG8_STAGE(bufoff, gbase, voff) do { _Pragma("unroll") for (int _i = 0; _i < 2; ++_i) \
        __builtin_amdgcn_global_load_lds((const unsigned*)((const char*)(gbase) + (voff)[_i]), (LAS unsigned*)(lds + (bufoff) + ldsw + _i * 8192), 16, 0, 0); } while (0)
#define PG8_LDA(dst, b, h) do { _Pragma("unroll") for (int m = 0; m < 4; ++m) _Pragma("unroll") for (int k = 0; k < 2; ++k) dst[m][k] = *(const LAS bf16x8*)(lds + PG8_SA(b, h) + aoff + m * 2048 + k * 1024); } while (0)
#define PG8_LDB(dst, b, h) do { _Pragma("unroll") for (int n = 0; n < 2; ++n) _Pragma("unroll") for (int k = 0; k < 2; ++k) dst[n][k] = *(const LAS bf16x8*)(lds + PG8_SB(b, h) + boff + n * 2048 + k * 1024); } while (0)
#define PG8_MMA(ai, bj, At, Bt) do { __builtin_amdgcn_s_setprio(1); _Pragma("unroll") for (int m = 0; m < 4; ++m) _Pragma("unroll") for (int n = 0; n < 2; ++n) _Pragma("unroll") for (int k = 0; k < 2; ++k) \
        acc[ai][bj][m][n] = __builtin_amdgcn_mfma_f32_16x16x32_bf16(Bt[n][k], At[m][k], acc[ai][bj][m][n], 0, 0, 0); __builtin_amdgcn_s_setprio(0); } while (0)
#define PG8_WAIT_V(n) asm volatile("s_waitcnt vmcnt(" #n ")" ::: "memory")
#define PG8_WAIT_L(n) asm volatile("s_waitcnt lgkmcnt(" #n ")" ::: "memory")
#define PG8_BAR __builtin_amdgcn_s_barrier()
#define PG8_SCHED __builtin_amdgcn_sched_barrier(0)
    Unit cur, nxt; int ui = 0;
    if (!S.next(0, cur)) return;
    f32x4 acc[2][2][4][2];
#pragma unroll
    for (int a = 0; a < 2; ++a)
#pragma unroll
        for (int b = 0; b < 2; ++b)
#pragma unroll
            for (int m = 0; m < 4; ++m)
#pragma unroll
                for (int n = 0; n < 2; ++n) acc[a][b][m][n] = (f32x4){0.f, 0.f, 0.f, 0.f};
    bf16x8 At[4][2], B0[2][2], B1[2][2];
    const char* cA = (const char*)g.A + (size_t)cur.pm * tstep; const char* cB = (const char*)g.Bt + (size_t)cur.pn * tstep;
    S.a_ready(cur);
    PG8_STAGE(PG8_SB(0, 0), cB, voffB); PG8_STAGE(PG8_SA(0, 0), cA, voffA); PG8_STAGE(PG8_SB(0, 1), cB + hstep, voffB); PG8_STAGE(PG8_SA(0, 1), cA + hstep, voffA);
    if (wr == 1) PG8_BAR;
    PG8_WAIT_V(4); PG8_BAR;
    PG8_STAGE(PG8_SB(1, 0), cB + kstep, voffB); PG8_STAGE(PG8_SA(1, 0), cA + kstep, voffA); PG8_STAGE(PG8_SB(1, 1), cB + hstep + kstep, voffB);
    PG8_WAIT_V(6); PG8_BAR;
    for (;;) {
        const bool has_next = S.next(ui + 1, nxt);
        const char* nA = has_next ? (const char*)g.A + (size_t)nxt.pm * tstep : cA; const char* nB = has_next ? (const char*)g.Bt + (size_t)nxt.pn * tstep : cB;
        for (int t = 0; t < nt; t += 2) {
            const bool last = (t == nt - 2);
            const char* a1 = cA + (size_t)(t + 1) * kstep;
            const char* a2 = last ? nA : cA + (size_t)(t + 2) * kstep; const char* b2 = last ? nB : cB + (size_t)(t + 2) * kstep;
            const char* a3 = a2 + kstep; const char* b3 = b2 + kstep;
            if (last && has_next) S.a_ready(nxt);
            PG8_LDB(B0, 0, 0); PG8_SCHED; PG8_LDA(At, 0, 0); PG8_STAGE(PG8_SA(1, 1), a1 + hstep, voffA);
            PG8_WAIT_L(8); PG8_BAR; PG8_WAIT_L(0); PG8_MMA(0, 0, At, B0); PG8_BAR; PG8_SCHED;
            PG8_LDB(B1, 0, 1); PG8_STAGE(PG8_SB(0, 0), b2, voffB);
            PG8_BAR; PG8_WAIT_L(0); PG8_MMA(0, 1, At, B1); PG8_BAR;
            PG8_LDA(At, 0, 1); PG8_STAGE(PG8_SA(0, 0), a2, voffA);
            PG8_BAR; PG8_WAIT_L(0); PG8_MMA(1, 0, At, B0); PG8_BAR; PG8_SCHED;
            PG8_STAGE(PG8_SB(0, 1), b2 + hstep, voffB);
            PG8_WAIT_V(6); PG8_BAR; PG8_MMA(1, 1, At, B1); PG8_BAR;
            PG8_LDB(B0, 1, 0); PG8_SCHED; PG8_LDA(At, 1, 0); PG8_STAGE(PG8_SA(0, 1), a2 + hstep, voffA);
            PG8_WAIT_L(8); PG8_BAR; PG8_WAIT_L(0); PG8_MMA(0, 0, At, B0); PG8_BAR; PG8_SCHED;
            PG8_LDB(B1, 1, 1); PG8_STAGE(PG8_SB(1, 0), b3, voffB);
            PG8_BAR; PG8_WAIT_L(0); PG8_MMA(0, 1, At, B1); PG8_BAR;
            PG8_LDA(At, 1, 1); PG8_STAGE(PG8_SA(1, 0), a3, voffA);
            PG8_BAR; PG8_WAIT_L(0); PG8_MMA(1, 0, At, B0); PG8_BAR; PG8_SCHED;
            PG8_STAGE(PG8_SB(1, 1), b3 + hstep, voffB);
            PG8_WAIT_V(6); PG8_BAR; PG8_MMA(1, 1, At, B1); PG8_BAR;
        }
        E(acc, cur, wr, wc, fr, fq); S.done(cur);
        if (!has_next) break;
#pragma unroll
        for (int a = 0; a < 2; ++a)
#pragma unroll
            for (int b = 0; b < 2; ++b)
#pragma unroll
                for (int m = 0; m < 4; ++m)
#pragma unroll
                    for (int n = 0; n < 2; ++n) acc[a][b][m][n] = (f32x4){0.f, 0.f, 0.f, 0.f};
        cur = nxt; cA = nA; cB = nB; ++ui;
    }
    PG8_WAIT_V(0);
    if (wr == 0) PG8_BAR;
    PG8_BAR;
#undef PG8_SA
#undef PG8_SB
#undef PG8_STAGE
#undef PG8_LDA
#undef PG8_LDB
#undef PG8_MMA
#undef PG8_WAIT_V
#undef PG8_WAIT_L
#undef PG8_BAR
#undef PG8_SCHED
}
}

struct Params {
    const float* x; const float* mem; const int* pos;
    const float* norm_mix; const float* w_in; const float* ret_gn;
    const float* lru_conv_w; const float* lru_conv_b; const float* lru_wa; const float* lru_ba; const float* lru_wx; const float* lru_bx; const float* lru_lambda;
    const float* mla_q_norm; const float* mla_w_uq; const float* mla_kv_norm; const float* mla_w_ukv;
    const float* gdn_conv_w; const float* gdn_a_log; const float* gdn_dt_bias; const float* gdn_norm;
    const float* w_out; const float* norm_xattn; const float* norm_mem; const float* xa_wq; const float* xa_wkv; const float* xa_wo;
    const float* norm_mlp; const float* mlp_w1; const float* mlp_w2; const float* final_norm;
    float* out; unsigned char* ws;
    int ph_lo, ph_hi;
};

__device__ __forceinline__ bf16_t* wl(const Params& P, int l, size_t off) { return (bf16_t*)(P.ws + WS_W) + (size_t)l * W_LAYER + off; }

__device__ __forceinline__ void transpose_tile(const float* src, int K, int N, const float* gain, float scale, bf16_t* dst, int kb, int nb, LAS float* scr, int tid) {
#pragma unroll
    for (int i = 0; i < 8; ++i) { const int kk = (tid >> 6) + 8 * i, k = kb * 64 + kk, n = nb * 64 + (tid & 63);
        float v = 0.f; if (n < N) { v = src[(size_t)k * N + n] * scale; if (gain) v *= gain[k]; }
        scr[kk * 65 + (tid & 63)] = v; }
    __syncthreads();
    { const int nl = tid >> 3, k0 = (tid & 7) * 8; const LAS float* s = scr + k0 * 65 + nl;
      u32x4 o; o.x = pk2(s[0], s[65]); o.y = pk2(s[2 * 65], s[3 * 65]); o.z = pk2(s[4 * 65], s[5 * 65]); o.w = pk2(s[6 * 65], s[7 * 65]);
      *(u32x4*)(dst + (size_t)(nb * 64 + nl) * K + kb * 64 + k0) = o; }
    __syncthreads();
}
__device__ __forceinline__ void p0_prologue(const Params& P, LAS unsigned char* lds, int tid) {
    LAS float* scr = (LAS float*)lds;
    constexpr int T_IN = 16 * 48, T_SQ = 256, T_KV = 512, T_W1 = 1024, T_W2 = 1024, T_UQ = 18, T_UKV = 16, T_LRU = 8;
    constexpr int T_LAYER = T_IN + 3 * T_SQ + T_KV + T_W1 + T_W2 + T_UQ + T_UKV + T_LRU;
    for (int it = blockIdx.x; it < 2 * T_LAYER; it += gridDim.x) {
        const int l = it / T_LAYER; int r = it % T_LAYER;
        const float* src; const float* gain = nullptr; float scale = 1.f; bf16_t* dst; int K, N, nnb;
        if (r < T_IN) { src = P.w_in + (size_t)l * DM * IN_COLS; K = DM; N = IN_COLS; nnb = 48; gain = P.norm_mix + l * DM; dst = wl(P, l, W_IN); }
        else if ((r -= T_IN) < T_SQ) { src = P.w_out + (size_t)l * DM * DM; K = DM; N = DM; nnb = 16; dst = wl(P, l, W_OUT); }
        else if ((r -= T_SQ) < T_SQ) { src = P.xa_wq + (size_t)l * DM * DM; K = DM; N = DM; nnb = 16; gain = P.norm_xattn + l * DM; scale = 0.0625f * LOG2E; dst = wl(P, l, W_Q); }
        else if ((r -= T_SQ) < T_KV) { src = P.xa_wkv + (size_t)l * DM * 2 * DM; K = DM; N = 2 * DM; nnb = 32; gain = P.norm_mem + l * DM; dst = wl(P, l, W_KV); }
        else if ((r -= T_KV) < T_SQ) { src = P.xa_wo + (size_t)l * DM * DM; K = DM; N = DM; nnb = 16; dst = wl(P, l, W_O); }
        else if ((r -= T_SQ) < T_W1) { src = P.mlp_w1 + (size_t)l * DM * DFF; K = DM; N = DFF; nnb = 64; gain = P.norm_mlp + l * DM; dst = wl(P, l, W_1); }
        else if ((r -= T_W1) < T_W2) { src = P.mlp_w2 + (size_t)l * DFF * DM; K = DFF; N = DM; nnb = 16; dst = wl(P, l, W_2); }
        else if ((r -= T_W2) < T_UQ) { src = P.mla_w_uq + (size_t)l * 192 * 384; K = 192; N = 384; nnb = 6; gain = P.mla_q_norm + l * 192; dst = wl(P, l, W_UQ); }
        else if ((r -= T_UQ) < T_UKV) { src = P.mla_w_ukv + (size_t)l * 128 * 512; K = 128; N = 512; nnb = 8; gain = P.mla_kv_norm + l * 128; dst = wl(P, l, W_UKV); }
        else { r -= T_UKV; const int which = r >> 2, nb4 = r & 3; src = (which ? P.lru_wx : P.lru_wa) + (size_t)l * 4 * 4096 + nb4 * 4096; K = 64; N = 64; nnb = 1; dst = wl(P, l, which ? W_X : W_A) + nb4 * 4096; r = 0; }
        transpose_tile(src, K, N, gain, scale, dst, r / nnb, r % nnb, scr, tid);
    }
    const int wave = tid >> 6, lane = tid & 63;
    const int gw = blockIdx.x * 8 + wave, ngw = gridDim.x * 8;
    bf16_t* xb = (bf16_t*)(P.ws + WS_XB); float* part = (float*)(P.ws + WS_PART); bf16_t* memn = (bf16_t*)(P.ws + WS_GDN);
    for (int row = gw; row < T_TOK + NBATCH * NMEM; row += ngw) {
        const bool isx = row < T_TOK; const int r2 = isx ? row : row - T_TOK;
        const f32x4* src = (const f32x4*)((isx ? P.x : P.mem) + (size_t)r2 * DM) + lane;
        f32x4 v[4]; float s = 0.f;
#pragma unroll
        for (int j = 0; j < 4; ++j) { v[j] = src[64 * j]; s += (v[j].x * v[j].x + v[j].y * v[j].y) + (v[j].z * v[j].z + v[j].w * v[j].w); }
        s = wave_sum(s);
        if (isx) {
            f32x4* o = (f32x4*)(P.out + (size_t)row * DM) + lane; u32x2* ob = (u32x2*)(xb + (size_t)row * DM) + lane;
#pragma unroll
            for (int j = 0; j < 4; ++j) { o[64 * j] = v[j]; u32x2 w; w.x = pk2(v[j].x, v[j].y); w.y = pk2(v[j].z, v[j].w); ob[64 * j] = w; }
            if (lane < 16) part[(size_t)row * 16 + lane] = lane == 0 ? s : 0.f;
        } else {
            const float rs = frsq_(s * (1.0f / 1024.0f) + EPS); u32x2* ob = (u32x2*)(memn + (size_t)r2 * DM) + lane;
#pragma unroll
            for (int j = 0; j < 4; ++j) { u32x2 w; w.x = pk2(v[j].x * rs, v[j].y * rs); w.y = pk2(v[j].z * rs, v[j].w * rs); ob[64 * j] = w; }
        }
    }
}
__device__ __forceinline__ void final_norm_phase(const Params& P, int tid) {
    const int wave = tid >> 6, lane = tid & 63; const float* part = (const float*)(P.ws + WS_PART);
    f32x4 g[4];
#pragma unroll
    for (int j = 0; j < 4; ++j) g[j] = ((const f32x4*)P.final_norm)[64 * j + lane];
    for (int row = blockIdx.x * 8 + wave; row < T_TOK; row += gridDim.x * 8) {
        float s = lane < 16 ? part[(size_t)row * 16 + lane] : 0.f; s = wave_sum(s);
        const float rs = frsq_(s * (1.0f / 1024.0f) + EPS);
        f32x4* o = (f32x4*)(P.out + (size_t)row * DM) + lane;
#pragma unroll
        for (int j = 0; j < 4; ++j) { f32x4 v = o[64 * j]; o[64 * j] = v * rs * g[j]; }
    }
}

__device__ __forceinline__ void mla_pre_tile(const Params& P, int l, int rt, int lane) {
    const int fr = lane & 15, fq = lane >> 4;
    const bf16_t* z = (const bf16_t*)(P.ws + WS_R);
    bf16_t* Qo = (bf16_t*)(P.ws + WS_XB + MLA_Q_OFF); bf16_t* Ko = (bf16_t*)(P.ws + WS_XB + MLA_K_OFF); bf16_t* Vo = (bf16_t*)(P.ws + WS_XB + MLA_VT_OFF);
    const bf16_t* Wuq = wl(P, l, W_UQ); const bf16_t* Wukv = wl(P, l, W_UKV);
    const int tok0 = rt * 16, b = tok0 >> 11, s0 = tok0 & 2047;
    const bf16_t* zr = z + (size_t)(tok0 + fr) * ZP;
    bf16x8 cq[6], ckv[4]; float sq = 0.f, skv = 0.f;
#pragma unroll
    for (int s = 0; s < 6; ++s) { const u32x4 w = *(const u32x4*)(zr + Z_CQ + 32 * s + 8 * fq); cq[s] = __builtin_bit_cast(bf16x8, w);
        sq += bflo(w.x) * bflo(w.x) + bfhi(w.x) * bfhi(w.x) + bflo(w.y) * bflo(w.y) + bfhi(w.y) * bfhi(w.y) + bflo(w.z) * bflo(w.z) + bfhi(w.z) * bfhi(w.z) + bflo(w.w) * bflo(w.w) + bfhi(w.w) * bfhi(w.w); }
#pragma unroll
    for (int s = 0; s < 4; ++s) { const u32x4 w = *(const u32x4*)(zr + Z_CKV + 32 * s + 8 * fq); ckv[s] = __builtin_bit_cast(bf16x8, w);
        skv += bflo(w.x) * bflo(w.x) + bfhi(w.x) * bfhi(w.x) + bflo(w.y) * bflo(w.y) + bfhi(w.y) * bfhi(w.y) + bflo(w.z) * bflo(w.z) + bfhi(w.z) * bfhi(w.z) + bflo(w.w) * bflo(w.w) + bfhi(w.w) * bfhi(w.w); }
    sq += __shfl_xor(sq, 16); sq += __shfl_xor(sq, 32); skv += __shfl_xor(skv, 16); skv += __shfl_xor(skv, 32);
    const float rq = frsq_(sq * (1.0f / 192.0f) + EPS), rkv = frsq_(skv * (1.0f / 128.0f) + EPS);
    const float qsc = rq * 0.10206207261596575f * LOG2E;
    const float pos = (float)P.pos[tok0 + fr];
    float sn[4], cs[4];
#pragma unroll
    for (int r = 0; r < 4; ++r) { const float invf = exp2f(-(float)(4 * fq + r) * (13.287712379549449f / 16.0f)); sincos_rev(pos * invf, sn[r], cs[r]); }
    const size_t tokrow = (size_t)b * 4 * SEQ + (s0 + fr);
#pragma unroll 1
    for (int h = 0; h < 4; ++h) {
        bf16_t* qrow = Qo + (tokrow + (size_t)h * SEQ) * 96;
#pragma unroll 1
        for (int nt = 0; nt < 4; ++nt) { f32x4 a = {0.f, 0.f, 0.f, 0.f};
#pragma unroll
            for (int s = 0; s < 6; ++s) { const bf16x8 wf = *(const bf16x8*)(Wuq + (size_t)(h * 96 + nt * 16 + fr) * 192 + 32 * s + 8 * fq); a = mfma16(wf, cq[s], a); }
            a = a * qsc; u32x2 w; w.x = pk2(a.x, a.y); w.y = pk2(a.z, a.w); *(u32x2*)(qrow + nt * 16 + 4 * fq) = w; }
        f32x4 x1 = {0.f, 0.f, 0.f, 0.f}, x2 = {0.f, 0.f, 0.f, 0.f}, y1, y2;
#pragma unroll
        for (int s = 0; s < 6; ++s) { const bf16x8 wf1 = *(const bf16x8*)(Wuq + (size_t)(h * 96 + 64 + fr) * 192 + 32 * s + 8 * fq), wf2 = *(const bf16x8*)(Wuq + (size_t)(h * 96 + 80 + fr) * 192 + 32 * s + 8 * fq);
            x1 = mfma16(wf1, cq[s], x1); x2 = mfma16(wf2, cq[s], x2); }
        x1 = x1 * qsc; x2 = x2 * qsc;
#pragma unroll
        for (int r = 0; r < 4; ++r) { y1[r] = x1[r] * cs[r] - x2[r] * sn[r]; y2[r] = x1[r] * sn[r] + x2[r] * cs[r]; }
        { u32x2 w; w.x = pk2(y1.x, y1.y); w.y = pk2(y1.z, y1.w); *(u32x2*)(qrow + 64 + 4 * fq) = w; w.x = pk2(y2.x, y2.y); w.y = pk2(y2.z, y2.w); *(u32x2*)(qrow + 80 + 4 * fq) = w; }
    }
    u32x2 kr1, kr2;
    { const u32x2 a = *(const u32x2*)(zr + Z_KR + 4 * fq), c = *(const u32x2*)(zr + Z_KR + 16 + 4 * fq);
      const float x1[4] = {bflo(a.x), bfhi(a.x), bflo(a.y), bfhi(a.y)}, x2[4] = {bflo(c.x), bfhi(c.x), bflo(c.y), bfhi(c.y)}; float y1[4], y2[4];
#pragma unroll
      for (int r = 0; r < 4; ++r) { y1[r] = x1[r] * cs[r] - x2[r] * sn[r]; y2[r] = x1[r] * sn[r] + x2[r] * cs[r]; }
      kr1.x = pk2(y1[0], y1[1]); kr1.y = pk2(y1[2], y1[3]); kr2.x = pk2(y2[0], y2[1]); kr2.y = pk2(y2[2], y2[3]); }
    float rkv_r[4];
#pragma unroll
    for (int r = 0; r < 4; ++r) rkv_r[r] = __shfl(rkv, 4 * fq + r);
    const int chunk = s0 >> 6, key0 = (s0 & 63) + 4 * fq;
#pragma unroll 1
    for (int h = 0; h < 4; ++h) {
        bf16_t* krow = Ko + (tokrow + (size_t)h * SEQ) * 96;
#pragma unroll 1
        for (int nt = 0; nt < 4; ++nt) { f32x4 a = {0.f, 0.f, 0.f, 0.f};
#pragma unroll
            for (int s = 0; s < 4; ++s) { const bf16x8 wf = *(const bf16x8*)(Wukv + (size_t)(h * 128 + nt * 16 + fr) * 128 + 32 * s + 8 * fq); a = mfma16(wf, ckv[s], a); }
            a = a * rkv; u32x2 w; w.x = pk2(a.x, a.y); w.y = pk2(a.z, a.w); *(u32x2*)(krow + nt * 16 + 4 * fq) = w; }
        *(u32x2*)(krow + 64 + 4 * fq) = kr1; *(u32x2*)(krow + 80 + 4 * fq) = kr2;
        bf16_t* vt = Vo + ((size_t)((b * 4 + h) * NCHUNK + chunk) * 64) * 64;
#pragma unroll 1
        for (int nt = 0; nt < 4; ++nt) { f32x4 a = {0.f, 0.f, 0.f, 0.f};
#pragma unroll
            for (int s = 0; s < 4; ++s) { const bf16x8 wf = *(const bf16x8*)(Wukv + (size_t)(h * 128 + 64 + nt * 16 + fr) * 128 + 32 * s + 8 * fq); a = mfma16(ckv[s], wf, a); }
            u32x2 w; w.x = pk2(a.x * rkv_r[0], a.y * rkv_r[1]); w.y = pk2(a.z * rkv_r[2], a.w * rkv_r[3]);
            *(u32x2*)(vt + (size_t)(nt * 16 + fr) * 64 + key0) = w; }
    }
}

template <int DQK, int DV, int KT>
__device__ __forceinline__ void flash_item(LAS unsigned char* lds, const bf16_t* Qw, int ldq, const bf16_t* Kb, int ldk, const bf16_t* VTb, int ldv, int vts,
                                           bf16_t* Ow, int ldo, int ntiles, int wave_limit, int tid, int lane) {
    constexpr int KROW = DQK + 8, VROW = KT + 8, KS = DQK / 32, ET = DV / 16, NKT = KT / 16, KBYTES = KT * KROW * 2, BUF = KBYTES + DV * VROW * 2;
    constexpr int KP = KT * DQK / 8, VPR = KT / 8, VP = DV * VPR, NKP = (KP + 511) / 512, NVP = (VP + 511) / 512, NP = NKP > NVP ? NKP : NVP;
    const int fr = lane & 15, fq = lane >> 4;
    bf16x8 qf[KS];
#pragma unroll
    for (int s = 0; s < KS; ++s) qf[s] = *(const bf16x8*)(Qw + (size_t)fr * ldq + 32 * s + 8 * fq);
    f32x4 ot[ET];
#pragma unroll
    for (int e = 0; e < ET; ++e) ot[e] = (f32x4){0.f, 0.f, 0.f, 0.f};
    float m_run = -1e30f, l_run = 0.f;
    u32x4 preg[NP];
#define FL_LOADK(j_) do { _Pragma("unroll") for (int i = 0; i < NKP; ++i) { const int idx = tid + i * 512; if (idx < KP) { const int row = idx / (DQK / 8), pc = idx % (DQK / 8); \
            preg[i] = *(const u32x4*)(Kb + (size_t)((j_) * KT + row) * ldk + pc * 8); } } } while (0)
#define FL_LOADV(j_) do { _Pragma("unroll") for (int i = 0; i < NVP; ++i) { const int idx = tid + i * 512; if (idx < VP) { const int row = idx / VPR, pc = idx % VPR; \
            preg[i] = *(const u32x4*)(VTb + (size_t)(j_) * vts + (size_t)row * ldv + pc * 8); } } } while (0)
#define FL_STOREK(buf_) do { LAS bf16_t* Kt_ = (LAS bf16_t*)(lds + (buf_) * BUF); \
        _Pragma("unroll") for (int i = 0; i < NKP; ++i) { const int idx = tid + i * 512; if (idx < KP) { const int row = idx / (DQK / 8), pc = idx % (DQK / 8); *(LAS u32x4*)(Kt_ + row * KROW + pc * 8) = preg[i]; } } } while (0)
#define FL_STOREV(buf_) do { LAS bf16_t* Vt_ = (LAS bf16_t*)(lds + (buf_) * BUF + KBYTES); \
        _Pragma("unroll") for (int i = 0; i < NVP; ++i) { const int idx = tid + i * 512; if (idx < VP) { const int row = idx / VPR, pc = idx % VPR; *(LAS u32x4*)(Vt_ + row * VROW + pc * 8) = preg[i]; } } } while (0)
    FL_LOADK(0); FL_STOREK(0); FL_LOADV(0); FL_STOREV(0);
    __syncthreads();
#pragma unroll 1
    for (int j = 0; j < ntiles; ++j) {
        const bool more = j + 1 < ntiles, act = j < wave_limit;
        const LAS bf16_t* Kt = (const LAS bf16_t*)(lds + (j & 1) * BUF); const LAS bf16_t* Vt = (const LAS bf16_t*)(lds + (j & 1) * BUF + KBYTES);
        if (more) FL_LOADK(j + 1);
        f32x4 st[NKT];
        if (act) {
#pragma unroll
            for (int kt = 0; kt < NKT; ++kt) { f32x4 a = {0.f, 0.f, 0.f, 0.f};
#pragma unroll
                for (int s = 0; s < KS; ++s) { const bf16x8 kf = *(const LAS bf16x8*)(Kt + (kt * 16 + fr) * KROW + 32 * s + 8 * fq); a = mfma16(kf, qf[s], a); }
                st[kt] = a; }
        }
        if (more) { FL_STOREK((j + 1) & 1); FL_LOADV(j + 1); }
        if (act) {
            float mx = fmaxf(fmaxf(st[0].x, st[0].y), fmaxf(st[0].z, st[0].w));
#pragma unroll
            for (int kt = 1; kt < NKT; ++kt) mx = fmaxf(mx, fmaxf(fmaxf(st[kt].x, st[kt].y), fmaxf(st[kt].z, st[kt].w)));
            mx = fmaxf(mx, __shfl_xor(mx, 16)); mx = fmaxf(mx, __shfl_xor(mx, 32));
            const float m_new = fmaxf(m_run, mx), alpha = fexp2_(m_run - m_new);
            float ls = 0.f;
#pragma unroll
            for (int kt = 0; kt < NKT; ++kt)
#pragma unroll
                for (int r = 0; r < 4; ++r) { const float p = fexp2_(st[kt][r] - m_new); st[kt][r] = p; ls += p; }
            l_run = l_run * alpha + ls; m_run = m_new;
#pragma unroll
            for (int e = 0; e < ET; ++e) ot[e] = ot[e] * alpha;
            bf16x8 pf[NKT / 2];
#pragma unroll
            for (int k2 = 0; k2 < NKT / 2; ++k2) pf[k2] = pack8(st[2 * k2], st[2 * k2 + 1]);
#pragma unroll
            for (int e = 0; e < ET; ++e) {
                const LAS bf16_t* vr = Vt + (e * 16 + fr) * VROW + 4 * fq;
#pragma unroll
                for (int k2 = 0; k2 < NKT / 2; ++k2) { const bf16x8 v0 = mk8(*(const LAS u32x2*)(vr + 32 * k2), *(const LAS u32x2*)(vr + 32 * k2 + 16)); ot[e] = mfma16(v0, pf[k2], ot[e]); }
            }
        }
        if (more) FL_STOREV((j + 1) & 1);
        __syncthreads();
    }
#undef FL_LOADK
#undef FL_LOADV
#undef FL_STOREK
#undef FL_STOREV
    l_run += __shfl_xor(l_run, 16); l_run += __shfl_xor(l_run, 32);
    const float inv = frcp_(l_run);
#pragma unroll
    for (int e = 0; e < ET; ++e) { u32x2 w; w.x = pk2(ot[e].x * inv, ot[e].y * inv); w.y = pk2(ot[e].z * inv, ot[e].w * inv);
        *(u32x2*)(Ow + (size_t)fr * ldo + e * 16 + 4 * fq) = w; }
}
__device__ __forceinline__ void mla_attn_item(const Params& P, LAS unsigned char* lds, int it, int tid, int wave, int lane) {
    const int qt = 15 - (it >> 6), bh = it & 63;
    const bf16_t* Q = (const bf16_t*)(P.ws + WS_XB + MLA_Q_OFF) + ((size_t)bh * SEQ + qt * 128 + wave * 16) * 96;
    const bf16_t* K = (const bf16_t*)(P.ws + WS_XB + MLA_K_OFF) + (size_t)bh * SEQ * 96;
    const bf16_t* VT = (const bf16_t*)(P.ws + WS_XB + MLA_VT_OFF) + (size_t)bh * NCHUNK * 4096;
    bf16_t* y = (bf16_t*)(P.ws + WS_R + R_Y) + ((size_t)(bh >> 2) * SEQ + qt * 128 + wave * 16) * DM + 512 + (bh & 3) * 64;
    flash_item<96, 64, 64>(lds, Q, 96, K, 96, VT, 64, 4096, y, DM, 2 * qt + 2, 2 * qt + (wave >> 2) + 1, tid, lane);
}
__device__ __forceinline__ void xa_item(const Params& P, int l, LAS unsigned char* lds, int it, int tid, int wave, int lane) {
    const int qt = it & 15, h = (it >> 4) & 3, b = it >> 6;
    const size_t qoff = ((size_t)b * SEQ + qt * 128 + wave * 16) * DM + h * 256;
    const bf16_t* Q = (const bf16_t*)(P.ws + WS_R) + qoff; bf16_t* O = (bf16_t*)(P.ws + WS_R + R_OX) + qoff;
    const bf16_t* K = (const bf16_t*)(P.ws + WS_KVM + (size_t)l * KVM_LAYER) + (size_t)b * NMEM * DM + h * 256;
    const bf16_t* VT = (const bf16_t*)(P.ws + WS_KVM + (size_t)l * KVM_LAYER + (size_t)4096 * 1024 * 2) + (size_t)h * 256 * 4096 + b * NMEM;
    flash_item<256, 256, 32>(lds, Q, DM, K, DM, VT, 4096, 32, O, DM, 8, 8, tid, lane);
}

constexpr int GP_KN = 0, GP_KB = 9216, GP_QN = 18432, GP_L = 9216, GP_RHS = 27648, GP_G = 60416, GP_GC = 60672, GP_HEAD = 61440;
__device__ __forceinline__ bf16_t* gdn_buf(const Params& P, int chh, int k) { return (bf16_t*)(P.ws + WS_GDN) + ((size_t)chh * 5 + k) * 4096; }
__device__ __forceinline__ void gdn_pre_item(const Params& P, int l, LAS unsigned char* lds, int it, int tid) {
    const int hp = it & 1, n = (it >> 1) & 31, b = it >> 6;
    const int hh = tid >> 8, h = 2 * hp + hh, tt = tid & 255, c = tt >> 2, qr = tt & 3, lane = tid & 63;
    LAS unsigned char* L = lds + hh * GP_HEAD;
    const bf16_t* z = (const bf16_t*)(P.ws + WS_R);
    const int s = n * 64 + c; const size_t tok = (size_t)b * SEQ + s;
    const float* cw = P.gdn_conv_w + (size_t)l * 4 * 768;
    const int chh = (b * NCHUNK + n) * 4 + h;
    float q[16], k[16], v[16];
#pragma unroll
    for (int part = 0; part < 3; ++part) {
        float* dst = part == 0 ? q : (part == 1 ? k : v);
        const int ch0 = part * 256 + h * 64 + qr * 16;
#pragma unroll
        for (int i = 0; i < 16; ++i) dst[i] = 0.f;
#pragma unroll
        for (int kk = 0; kk < 4; ++kk) { {
            const bool okk = s - 3 + kk >= 0; const float mk = okk ? 1.f : 0.f;
            const bf16_t* zr = z + (okk ? tok - 3 + kk : tok) * ZP + Z_GQKV + ch0; const u32x4 w0 = *(const u32x4*)zr, w1 = *(const u32x4*)(zr + 8);
            const float* wr = cw + kk * 768 + ch0; const f32x4 c0 = *(const f32x4*)wr * mk, c1 = *(const f32x4*)(wr + 4) * mk, c2 = *(const f32x4*)(wr + 8) * mk, c3 = *(const f32x4*)(wr + 12) * mk;
            dst[0] += c0.x * bflo(w0.x); dst[1] += c0.y * bfhi(w0.x); dst[2] += c0.z * bflo(w0.y); dst[3] += c0.w * bfhi(w0.y);
            dst[4] += c1.x * bflo(w0.z); dst[5] += c1.y * bfhi(w0.z); dst[6] += c1.z * bflo(w0.w); dst[7] += c1.w * bfhi(w0.w);
            dst[8] += c2.x * bflo(w1.x); dst[9] += c2.y * bfhi(w1.x); dst[10] += c2.z * bflo(w1.y); dst[11] += c2.w * bfhi(w1.y);
            dst[12] += c3.x * bflo(w1.z); dst[13] += c3.y * bfhi(w1.z); dst[14] += c3.z * bflo(w1.w); dst[15] += c3.w * bfhi(w1.w); } }
#pragma unroll
        for (int i = 0; i < 16; ++i) dst[i] = siluf_(dst[i]);
    }
    float sq = 0.f, sk = 0.f;
#pragma unroll
    for (int i = 0; i < 16; ++i) { sq += q[i] * q[i]; sk += k[i] * k[i]; }
    sq += __shfl_xor(sq, 1); sq += __shfl_xor(sq, 2); sk += __shfl_xor(sk, 1); sk += __shfl_xor(sk, 2);
    const float rq = frsq_(sq + EPS) * 0.125f, rk = frsq_(sk + EPS);
    const bf16_t* zt = z + tok * ZP;
    const float beta = sigmoidf_(bf2f(zt[Z_GB + h]));
    const float g = -fexp_(P.gdn_a_log[l * 4 + h]) * softplusf_(bf2f(zt[Z_GA + h]) + P.gdn_dt_bias[l * 4 + h]);
    {
        u32x4 w0, w1;
#define PK16(dst0, dst1, src, sc) do { dst0.x = pk2(src[0] * (sc), src[1] * (sc)); dst0.y = pk2(src[2] * (sc), src[3] * (sc)); dst0.z = pk2(src[4] * (sc), src[5] * (sc)); dst0.w = pk2(src[6] * (sc), src[7] * (sc)); \
        dst1.x = pk2(src[8] * (sc), src[9] * (sc)); dst1.y = pk2(src[10] * (sc), src[11] * (sc)); dst1.z = pk2(src[12] * (sc), src[13] * (sc)); dst1.w = pk2(src[14] * (sc), src[15] * (sc)); } while (0)
        PK16(w0, w1, k, rk);        *(LAS u32x4*)(L + GP_KN + (c * 72 + qr * 16) * 2) = w0; *(LAS u32x4*)(L + GP_KN + (c * 72 + qr * 16 + 8) * 2) = w1;
        PK16(w0, w1, k, rk * beta); *(LAS u32x4*)(L + GP_KB + (c * 72 + qr * 16) * 2) = w0; *(LAS u32x4*)(L + GP_KB + (c * 72 + qr * 16 + 8) * 2) = w1;
        PK16(w0, w1, q, rq);        *(LAS u32x4*)(L + GP_QN + (c * 72 + qr * 16) * 2) = w0; *(LAS u32x4*)(L + GP_QN + (c * 72 + qr * 16 + 8) * 2) = w1;
        LAS float* rhs = (LAS float*)(L + GP_RHS) + c * 128 + qr * 16;
#pragma unroll
        for (int i = 0; i < 4; ++i) *(LAS f32x4*)(rhs + 4 * i) = (f32x4){v[4 * i] * beta, v[4 * i + 1] * beta, v[4 * i + 2] * beta, v[4 * i + 3] * beta};
        if (qr == 0) ((LAS float*)(L + GP_G))[c] = g;
    }
    __syncthreads();
    {
        float gc = 0.f, run = 0.f; const LAS float* G = (const LAS float*)(L + GP_G);
        for (int i = 0; i < 64; ++i) { run += G[i]; gc = (i == c) ? run : gc; }
        const float eg = fexp_(gc), ek = fexp_(run - gc);
        LAS float* rhs = (LAS float*)(L + GP_RHS) + c * 128 + 64 + qr * 16;
#pragma unroll
        for (int i = 0; i < 4; ++i) *(LAS f32x4*)(rhs + 4 * i) = (f32x4){k[4 * i] * rk * beta * eg, k[4 * i + 1] * rk * beta * eg, k[4 * i + 2] * rk * beta * eg, k[4 * i + 3] * rk * beta * eg};
        u32x4 w0, w1; PK16(w0, w1, q, rq * eg);
        bf16_t* qd = gdn_buf(P, chh, 3) + c * 64 + qr * 16; *(u32x4*)qd = w0; *(u32x4*)(qd + 8) = w1;
        bf16_t* kdt = gdn_buf(P, chh, 4) + (qr * 16) * 64 + c;
#pragma unroll
        for (int i = 0; i < 16; ++i) kdt[i * 64] = f2bf(k[i] * rk * ek);
        if (qr == 0) ((LAS float*)(L + GP_GC))[c] = gc;
        if (tt == 0) ((float*)(P.ws + WS_GL))[chh] = fexp_(run);
    }
#undef PK16
    __syncthreads();
    {
        const int it4 = (tid >> 6) & 3, fr = lane & 15, fq = lane >> 4;
        const LAS bf16_t* Kn = (const LAS bf16_t*)(L + GP_KN); const LAS bf16_t* KB = (const LAS bf16_t*)(L + GP_KB); const LAS bf16_t* Qn = (const LAS bf16_t*)(L + GP_QN);
        const LAS float* GC = (const LAS float*)(L + GP_GC);
        const bf16x8 a0 = *(const LAS bf16x8*)(KB + (it4 * 16 + fr) * 72 + 8 * fq), a1 = *(const LAS bf16x8*)(KB + (it4 * 16 + fr) * 72 + 32 + 8 * fq);
        const bf16x8 q0 = *(const LAS bf16x8*)(Qn + (it4 * 16 + fr) * 72 + 8 * fq), q1 = *(const LAS bf16x8*)(Qn + (it4 * 16 + fr) * 72 + 32 + 8 * fq);
        float gci[4];
#pragma unroll
        for (int r = 0; r < 4; ++r) gci[r] = GC[it4 * 16 + 4 * fq + r];
        f32x4 lv[4]; bf16_t* att = gdn_buf(P, chh, 2);
#pragma unroll
        for (int jt = 0; jt < 4; ++jt) {
            const bf16x8 b0 = *(const LAS bf16x8*)(Kn + (jt * 16 + fr) * 72 + 8 * fq), b1 = *(const LAS bf16x8*)(Kn + (jt * 16 + fr) * 72 + 32 + 8 * fq);
            f32x4 al = {0.f, 0.f, 0.f, 0.f}, aa = {0.f, 0.f, 0.f, 0.f};
            al = mfma16(a0, b0, al); al = mfma16(a1, b1, al); aa = mfma16(q0, b0, aa); aa = mfma16(q1, b1, aa);
            const int j = jt * 16 + fr; const float gcj = GC[j];
#pragma unroll
            for (int r = 0; r < 4; ++r) { const int i = it4 * 16 + 4 * fq + r; const float dec = fexp_(fminf(gci[r] - gcj, 0.f));
                lv[jt][r] = (i > j) ? al[r] * dec : 0.f; att[i * 64 + j] = f2bf((i >= j) ? aa[r] * dec : 0.f); }
        }
        __syncthreads();
        LAS float* Lm = (LAS float*)(L + GP_L);
#pragma unroll
        for (int jt = 0; jt < 4; ++jt)
#pragma unroll
            for (int r = 0; r < 4; ++r) Lm[(it4 * 16 + 4 * fq + r) * 64 + jt * 16 + fr] = lv[jt][r];
    }
    __syncthreads();
    if (tt < 128) {
        const LAS float* Lm = (const LAS float*)(L + GP_L); const LAS float* rhs = (const LAS float*)(L + GP_RHS) + tt;
        float x[64];
#pragma unroll
        for (int i = 0; i < 64; ++i) {
            float a0 = rhs[i * 128], a1 = 0.f;
#pragma unroll
            for (int j4 = 0; j4 < (i + 3) / 4; ++j4) { const f32x4 lr = *(const LAS f32x4*)(Lm + i * 64 + 4 * j4);
                if (4 * j4 + 0 < i) a0 -= lr.x * x[4 * j4 + 0]; if (4 * j4 + 1 < i) a1 -= lr.y * x[4 * j4 + 1];
                if (4 * j4 + 2 < i) a0 -= lr.z * x[4 * j4 + 2]; if (4 * j4 + 3 < i) a1 -= lr.w * x[4 * j4 + 3]; }
            x[i] = a0 + a1;
        }
        if (tt < 64) { bf16_t* ut = gdn_buf(P, chh, 1) + tt * 64;
#pragma unroll
            for (int g8 = 0; g8 < 8; ++g8) { u32x4 w; w.x = pk2(x[8 * g8], x[8 * g8 + 1]); w.y = pk2(x[8 * g8 + 2], x[8 * g8 + 3]); w.z = pk2(x[8 * g8 + 4], x[8 * g8 + 5]); w.w = pk2(x[8 * g8 + 6], x[8 * g8 + 7]); *(u32x4*)(ut + 8 * g8) = w; }
        } else { bf16_t* wo = gdn_buf(P, chh, 0) + (tt - 64);
#pragma unroll
            for (int i = 0; i < 64; ++i) wo[i * 64] = f2bf(x[i]); }
    }
    __syncthreads();
}

constexpr int GC_W = 0, GC_UT = 9216, GC_ATT = 18432, GC_QD = 27648, GC_KDT = 36864, GC_O = 46080, GC_BH = 62720;
__device__ __forceinline__ bf16x8 lds_perm(const LAS unsigned char* M, int row, int s, int fq) { const LAS unsigned char* p = M + row * 144 + 64 * s + 8 * fq; return mk8(*(const LAS u32x2*)p, *(const LAS u32x2*)(p + 32)); }
__device__ __forceinline__ void gdn_chain_item(const Params& P, int l, LAS unsigned char* lds, int gi, int tid, int wave, int lane) {
    const int q2 = wave >> 2, bh = gi * 2 + q2, eb = wave & 3, b = bh >> 2, h = bh & 3, fr = lane & 15, fq = lane >> 4;
    const bf16_t* z = (const bf16_t*)(P.ws + WS_R); bf16_t* y = (bf16_t*)(P.ws + WS_R + R_Y);
    LAS unsigned char* L = lds + q2 * GC_BH;
    const int tt = tid & 255, ec = tt >> 2, eq = tt & 3;
    float ng[16];
#pragma unroll
    for (int j = 0; j < 16; ++j) ng[j] = P.gdn_norm[l * 64 + eq * 16 + j];
    u32x4 stg[10];
    const bf16_t* src0[2] = { gdn_buf(P, ((gi * 2 >> 2) * NCHUNK) * 4 + ((gi * 2) & 3), 0), gdn_buf(P, (((gi * 2 + 1) >> 2) * NCHUNK) * 4 + ((gi * 2 + 1) & 3), 0) };
#define GC_LOAD(n_) do { _Pragma("unroll") for (int i = 0; i < 10; ++i) { const int p = tid + 512 * i, qq = p / 2560, pp = p % 2560; \
        stg[i] = *(const u32x4*)(src0[qq] + (size_t)(n_) * 4 * 5 * 4096 + (size_t)pp * 8); } } while (0)
#define GC_WRITE() do { _Pragma("unroll") for (int i = 0; i < 10; ++i) { const int p = tid + 512 * i, qq = p / 2560, pp = p % 2560, mat = pp >> 9, row = (pp & 511) >> 3, pc = pp & 7; \
        *(LAS u32x4*)(lds + qq * GC_BH + mat * 9216 + row * 144 + pc * 16) = stg[i]; } } while (0)
    GC_LOAD(0); GC_WRITE();
    f32x4 S[4];
#pragma unroll
    for (int t = 0; t < 4; ++t) S[t] = (f32x4){0.f, 0.f, 0.f, 0.f};
    __syncthreads();
    for (int n = 0; n < NCHUNK; ++n) {
        const int chh = (b * NCHUNK + n) * 4 + h;
        if (n + 1 < NCHUNK) GC_LOAD(n + 1);
        const size_t etok = (size_t)(gi * 2 + (tid >> 8) >> 2) * SEQ + n * 64 + ec; const int eh = (gi * 2 + (tid >> 8)) & 3;
        const u32x4 gw0 = *(const u32x4*)(z + etok * ZP + Z_GG + eh * 64 + eq * 16), gw1 = *(const u32x4*)(z + etok * ZP + Z_GG + eh * 64 + eq * 16 + 8);
        const float egl = ((const float*)(P.ws + WS_GL))[chh];
        const bf16x8 sb0 = pack8(S[0], S[1]), sb1 = pack8(S[2], S[3]);
        f32x4 vn[4], o[4];
#pragma unroll
        for (int ct = 0; ct < 4; ++ct) {
            f32x4 a = {0.f, 0.f, 0.f, 0.f}; a = mfma16(lds_perm(L + GC_W, ct * 16 + fr, 0, fq), sb0, a); a = mfma16(lds_perm(L + GC_W, ct * 16 + fr, 1, fq), sb1, a);
            const u32x2 uw = *(const LAS u32x2*)(L + GC_UT + (eb * 16 + fr) * 144 + (ct * 16 + 4 * fq) * 2);
            vn[ct] = (f32x4){bflo(uw.x) - a.x, bfhi(uw.x) - a.y, bflo(uw.y) - a.z, bfhi(uw.y) - a.w};
            f32x4 oo = {0.f, 0.f, 0.f, 0.f}; oo = mfma16(lds_perm(L + GC_QD, ct * 16 + fr, 0, fq), sb0, oo); oo = mfma16(lds_perm(L + GC_QD, ct * 16 + fr, 1, fq), sb1, oo); o[ct] = oo;
        }
        const bf16x8 vb0 = pack8(vn[0], vn[1]), vb1 = pack8(vn[2], vn[3]);
#pragma unroll
        for (int ct = 0; ct < 4; ++ct) { o[ct] = mfma16(lds_perm(L + GC_ATT, ct * 16 + fr, 0, fq), vb0, o[ct]); o[ct] = mfma16(lds_perm(L + GC_ATT, ct * 16 + fr, 1, fq), vb1, o[ct]); }
#pragma unroll
        for (int dt = 0; dt < 4; ++dt) { f32x4 a = S[dt] * egl; a = mfma16(lds_perm(L + GC_KDT, dt * 16 + fr, 0, fq), vb0, a); a = mfma16(lds_perm(L + GC_KDT, dt * 16 + fr, 1, fq), vb1, a); S[dt] = a; }
        LAS float* Ol = (LAS float*)(L + GC_O);
#pragma unroll
        for (int ct = 0; ct < 4; ++ct)
#pragma unroll
            for (int r = 0; r < 4; ++r) Ol[(ct * 16 + 4 * fq + r) * 65 + eb * 16 + fr] = o[ct][r];
        __syncthreads();
        if (n + 1 < NCHUNK) GC_WRITE();
        {
            const LAS float* orow = (const LAS float*)(lds + (tid >> 8) * GC_BH + GC_O) + ec * 65 + eq * 16;
            float ov[16]; float s2 = 0.f;
#pragma unroll
            for (int j = 0; j < 16; ++j) { ov[j] = orow[j]; s2 += ov[j] * ov[j]; }
            s2 += __shfl_xor(s2, 1); s2 += __shfl_xor(s2, 2);
            const float rs = frsq_(s2 * (1.0f / 64.0f) + EPS);
            const unsigned gws[8] = {gw0.x, gw0.y, gw0.z, gw0.w, gw1.x, gw1.y, gw1.z, gw1.w};
            unsigned ow[8];
#pragma unroll
            for (int j = 0; j < 8; ++j) ow[j] = pk2(ov[2 * j] * rs * ng[2 * j] * siluf_(bflo(gws[j])), ov[2 * j + 1] * rs * ng[2 * j + 1] * siluf_(bfhi(gws[j])));
            bf16_t* yp = y + etok * DM + 768 + eh * 64 + eq * 16;
            *(u32x4*)yp = (u32x4){ow[0], ow[1], ow[2], ow[3]}; *(u32x4*)(yp + 8) = (u32x4){ow[4], ow[5], ow[6], ow[7]};
        }
        __syncthreads();
    }
#undef GC_LOAD
#undef GC_WRITE
}

constexpr int RT_BUF = 36864, RT_Q = 0, RT_K = 9216, RT_KZT = 18432, RT_VT = 27648, RT_P = 73728, RT_ST = 82944, RT_O = 92160;
__device__ __forceinline__ void ret_chain_item(const Params& P, int l, LAS unsigned char* lds, int it, int tid, int wave, int lane) {
    const int b = it >> 2, h = it & 3, fr = lane & 15, fq = lane >> 4;
    const bf16_t* z = (const bf16_t*)(P.ws + WS_R); bf16_t* y = (bf16_t*)(P.ws + WS_R + R_Y);
    LAS bf16_t* Pm = (LAS bf16_t*)(lds + RT_P); LAS bf16_t* ST = (LAS bf16_t*)(lds + RT_ST); LAS float* Of = (LAS float*)(lds + RT_O);
    const float lg = log1pf(-exp2f(-5.0f - (float)h));
    const float cdec = fexp_(64.0f * lg);
    for (int i = tid; i < 64 * 72 / 2; i += 512) ((LAS unsigned*)ST)[i] = 0u;
    const int it4 = wave >> 1, jt0 = 2 * (wave & 1);
    f32x4 S[2] = {{0.f, 0.f, 0.f, 0.f}, {0.f, 0.f, 0.f, 0.f}};
    const int lc = tid >> 3, pg = tid & 7;
    float invf[4];
#pragma unroll
    for (int ii = 0; ii < 4; ++ii) invf[ii] = exp2f(-(float)(4 * pg + ii) * (13.287712379549449f / 32.0f));
    const float zeta = fexp_((63.0f - (float)lc) * lg);
    const f32x4 gn0 = *(const f32x4*)(P.ret_gn + l * 256 + h * 64 + 8 * pg), gn1 = *(const f32x4*)(P.ret_gn + l * 256 + h * 64 + 8 * pg + 4);
    const size_t tok0 = (size_t)b * SEQ + lc;
    u32x2 q1w, q2w, k1w, k2w; u32x4 vw; int posi;
#define RT_LOAD(n_) do { const bf16_t* zr_ = z + (tok0 + (n_) * 64) * ZP; q1w = *(const u32x2*)(zr_ + Z_RQ + h * 64 + 4 * pg); q2w = *(const u32x2*)(zr_ + Z_RQ + h * 64 + 32 + 4 * pg); \
        k1w = *(const u32x2*)(zr_ + Z_RK + h * 64 + 4 * pg); k2w = *(const u32x2*)(zr_ + Z_RK + h * 64 + 32 + 4 * pg); vw = *(const u32x4*)(zr_ + Z_RV + h * 64 + 8 * pg); posi = P.pos[tok0 + (n_) * 64]; } while (0)
#define RT_STAGE(buf_) do { LAS bf16_t* Qs_ = (LAS bf16_t*)(lds + (buf_) * RT_BUF + RT_Q); LAS bf16_t* Ks_ = (LAS bf16_t*)(lds + (buf_) * RT_BUF + RT_K); \
        LAS bf16_t* KzT_ = (LAS bf16_t*)(lds + (buf_) * RT_BUF + RT_KZT); LAS bf16_t* VT_ = (LAS bf16_t*)(lds + (buf_) * RT_BUF + RT_VT); const float pos = (float)posi; \
        const float q1[4] = {bflo(q1w.x), bfhi(q1w.x), bflo(q1w.y), bfhi(q1w.y)}, q2[4] = {bflo(q2w.x), bfhi(q2w.x), bflo(q2w.y), bfhi(q2w.y)}; \
        const float k1[4] = {bflo(k1w.x), bfhi(k1w.x), bflo(k1w.y), bfhi(k1w.y)}, k2[4] = {bflo(k2w.x), bfhi(k2w.x), bflo(k2w.y), bfhi(k2w.y)}; \
        float qa[4], qb[4], ka[4], kb[4]; \
        _Pragma("unroll") for (int ii = 0; ii < 4; ++ii) { float sn, cs; sincos_rev(pos * invf[ii], sn, cs); \
            qa[ii] = (q1[ii] * cs - q2[ii] * sn) * 0.125f; qb[ii] = (q1[ii] * sn + q2[ii] * cs) * 0.125f; ka[ii] = k1[ii] * cs - k2[ii] * sn; kb[ii] = k1[ii] * sn + k2[ii] * cs; } \
        u32x2 w_; w_.x = pk2(qa[0], qa[1]); w_.y = pk2(qa[2], qa[3]); *(LAS u32x2*)(Qs_ + lc * 72 + 4 * pg) = w_; \
        w_.x = pk2(qb[0], qb[1]); w_.y = pk2(qb[2], qb[3]); *(LAS u32x2*)(Qs_ + lc * 72 + 32 + 4 * pg) = w_; \
        w_.x = pk2(ka[0], ka[1]); w_.y = pk2(ka[2], ka[3]); *(LAS u32x2*)(Ks_ + lc * 72 + 4 * pg) = w_; \
        w_.x = pk2(kb[0], kb[1]); w_.y = pk2(kb[2], kb[3]); *(LAS u32x2*)(Ks_ + lc * 72 + 32 + 4 * pg) = w_; \
        _Pragma("unroll") for (int ii = 0; ii < 4; ++ii) { KzT_[(4 * pg + ii) * 72 + lc] = f2bf(ka[ii] * zeta); KzT_[(32 + 4 * pg + ii) * 72 + lc] = f2bf(kb[ii] * zeta); } \
        const unsigned vv[4] = {vw.x, vw.y, vw.z, vw.w}; \
        _Pragma("unroll") for (int ii = 0; ii < 4; ++ii) { VT_[(8 * pg + 2 * ii) * 72 + lc] = (bf16_t)(vv[ii] & 0xffffu); VT_[(8 * pg + 2 * ii + 1) * 72 + lc] = (bf16_t)(vv[ii] >> 16); } } while (0)
    RT_LOAD(0); RT_STAGE(0);
    __syncthreads();
    for (int n = 0; n < NCHUNK; ++n) {
        const int cb = n & 1;
        const LAS bf16_t* Qs = (const LAS bf16_t*)(lds + cb * RT_BUF + RT_Q); const LAS bf16_t* Ks = (const LAS bf16_t*)(lds + cb * RT_BUF + RT_K);
        const LAS bf16_t* KzT = (const LAS bf16_t*)(lds + cb * RT_BUF + RT_KZT); const LAS bf16_t* VT = (const LAS bf16_t*)(lds + cb * RT_BUF + RT_VT);
        const size_t tok = tok0 + n * 64;
        if (n + 1 < NCHUNK) RT_LOAD(n + 1);
        const u32x4 gw = *(const u32x4*)(z + tok * ZP + Z_RG + h * 64 + 8 * pg);
        const bf16x8 a0 = *(const LAS bf16x8*)(Qs + (it4 * 16 + fr) * 72 + 8 * fq), a1 = *(const LAS bf16x8*)(Qs + (it4 * 16 + fr) * 72 + 32 + 8 * fq);
        f32x4 cross[2];
#pragma unroll
        for (int t = 0; t < 2; ++t) { const int jt = jt0 + t;
            f32x4 p = {0.f, 0.f, 0.f, 0.f};
            p = mfma16(a0, *(const LAS bf16x8*)(Ks + (jt * 16 + fr) * 72 + 8 * fq), p); p = mfma16(a1, *(const LAS bf16x8*)(Ks + (jt * 16 + fr) * 72 + 32 + 8 * fq), p);
            f32x4 cr = {0.f, 0.f, 0.f, 0.f};
            cr = mfma16(a0, *(const LAS bf16x8*)(ST + (jt * 16 + fr) * 72 + 8 * fq), cr); cr = mfma16(a1, *(const LAS bf16x8*)(ST + (jt * 16 + fr) * 72 + 32 + 8 * fq), cr);
#pragma unroll
            for (int r = 0; r < 4; ++r) { const int i = it4 * 16 + 4 * fq + r, j = jt * 16 + fr; const int dd = i > j ? i - j : j - i;
                Pm[i * 72 + j] = f2bf(p[r] * fexp_((float)dd * lg)); cr[r] *= fexp_((float)(i + 1) * lg); }
            cross[t] = cr; }
        __syncthreads();
        const bf16x8 p0 = *(const LAS bf16x8*)(Pm + (it4 * 16 + fr) * 72 + 8 * fq), p1 = *(const LAS bf16x8*)(Pm + (it4 * 16 + fr) * 72 + 32 + 8 * fq);
        const bf16x8 kz0 = *(const LAS bf16x8*)(KzT + (it4 * 16 + fr) * 72 + 8 * fq), kz1 = *(const LAS bf16x8*)(KzT + (it4 * 16 + fr) * 72 + 32 + 8 * fq);
#pragma unroll
        for (int t = 0; t < 2; ++t) { const int et = jt0 + t;
            const bf16x8 v0 = *(const LAS bf16x8*)(VT + (et * 16 + fr) * 72 + 8 * fq), v1 = *(const LAS bf16x8*)(VT + (et * 16 + fr) * 72 + 32 + 8 * fq);
            f32x4 o = cross[t]; o = mfma16(p0, v0, o); o = mfma16(p1, v1, o);
#pragma unroll
            for (int r = 0; r < 4; ++r) Of[(it4 * 16 + 4 * fq + r) * 65 + et * 16 + fr] = o[r];
            f32x4 sN = S[t] * cdec; sN = mfma16(kz0, v0, sN); sN = mfma16(kz1, v1, sN); S[t] = sN;
            u32x2 w; w.x = pk2(sN.x, sN.y); w.y = pk2(sN.z, sN.w); *(LAS u32x2*)(ST + (et * 16 + fr) * 72 + it4 * 16 + 4 * fq) = w; }
        if (n + 1 < NCHUNK) RT_STAGE(cb ^ 1);
        __syncthreads();
        {
            float ov[8]; float sm = 0.f;
#pragma unroll
            for (int j = 0; j < 8; ++j) { ov[j] = Of[lc * 65 + 8 * pg + j]; sm += ov[j]; }
            sm += __shfl_xor(sm, 1); sm += __shfl_xor(sm, 2); sm += __shfl_xor(sm, 4);
            const float mu = sm * (1.0f / 64.0f); float vs = 0.f;
#pragma unroll
            for (int j = 0; j < 8; ++j) { ov[j] -= mu; vs += ov[j] * ov[j]; }
            vs += __shfl_xor(vs, 1); vs += __shfl_xor(vs, 2); vs += __shfl_xor(vs, 4);
            const float rs = frsq_(vs * (1.0f / 64.0f) + EPS);
            const float gt[8] = {bflo(gw.x), bfhi(gw.x), bflo(gw.y), bfhi(gw.y), bflo(gw.z), bfhi(gw.z), bflo(gw.w), bfhi(gw.w)};
            const float gnv[8] = {gn0.x, gn0.y, gn0.z, gn0.w, gn1.x, gn1.y, gn1.z, gn1.w};
            float r8[8];
#pragma unroll
            for (int j = 0; j < 8; ++j) r8[j] = ov[j] * rs * gnv[j] * siluf_(gt[j]);
            u32x4 w; w.x = pk2(r8[0], r8[1]); w.y = pk2(r8[2], r8[3]); w.z = pk2(r8[4], r8[5]); w.w = pk2(r8[6], r8[7]);
            *(u32x4*)(y + tok * DM + h * 64 + 8 * pg) = w;
        }
    }
#undef RT_LOAD
#undef RT_STAGE
    __syncthreads();
}

constexpr int LR_XC = 0, LR_AU = 33792;
__device__ __forceinline__ void lru_item(const Params& P, int l, LAS unsigned char* lds, int it, int mode, int tid, int wave, int lane) {
    const int b = it >> 5, n = it & 31, fr = lane & 15, fq = lane >> 4;
    const bf16_t* z = (const bf16_t*)(P.ws + WS_R); bf16_t* y = (bf16_t*)(P.ws + WS_R + R_Y);
    LAS bf16_t* XC = (LAS bf16_t*)(lds + LR_XC); LAS f32x2* AU = (LAS f32x2*)(lds + LR_AU);
    float* sumA = (float*)(P.ws + WS_LRUS); float* sumH = sumA + 16 * 32 * 256;
    {
        const int c = tid >> 3, cg = tid & 7, s = n * 64 + c; const size_t tok = (size_t)b * SEQ + s;
        const float* cw = P.lru_conv_w + (size_t)l * 4 * 256; const float* cb = P.lru_conv_b + l * 256;
#pragma unroll
        for (int g = 0; g < 4; ++g) { const int ch0 = cg * 32 + g * 8;
            const f32x4 b0 = *(const f32x4*)(cb + ch0), b1 = *(const f32x4*)(cb + ch0 + 4);
            float a[8] = {b0.x, b0.y, b0.z, b0.w, b1.x, b1.y, b1.z, b1.w};
#pragma unroll
            for (int kk = 0; kk < 4; ++kk) { const bool okk = s - 3 + kk >= 0; const float mk = okk ? 1.f : 0.f;
                const u32x4 w = *(const u32x4*)(z + (okk ? tok - 3 + kk : tok) * ZP + Z_LX + ch0);
                const f32x4 c0 = *(const f32x4*)(cw + kk * 256 + ch0) * mk, c1 = *(const f32x4*)(cw + kk * 256 + ch0 + 4) * mk;
                a[0] += c0.x * bflo(w.x); a[1] += c0.y * bfhi(w.x); a[2] += c0.z * bflo(w.y); a[3] += c0.w * bfhi(w.y);
                a[4] += c1.x * bflo(w.z); a[5] += c1.y * bfhi(w.z); a[6] += c1.z * bflo(w.w); a[7] += c1.w * bfhi(w.w); }
            u32x4 o; o.x = pk2(a[0], a[1]); o.y = pk2(a[2], a[3]); o.z = pk2(a[4], a[5]); o.w = pk2(a[6], a[7]);
            *(LAS u32x4*)(XC + c * 264 + ch0) = o; }
    }
    float hcar = 0.f, aprod = 1.f;
    if (mode == 1 && tid < 256) {
        float av[32], hv[32];
#pragma unroll
        for (int m = 0; m < 32; ++m) { const int mm = m < n ? m : 0; av[m] = sumA[(b * 32 + mm) * 256 + tid]; hv[m] = sumH[(b * 32 + mm) * 256 + tid]; }
#pragma unroll
        for (int m = 0; m < 32; ++m) if (m < n) hcar = av[m] * hcar + hv[m];
    }
    const int nb = wave >> 1, rt = wave & 1;
    const bf16_t* wa = wl(P, l, W_A) + nb * 4096; const bf16_t* wx = wl(P, l, W_X) + nb * 4096;
    bf16x8 fa[4][2], fx[4][2]; float ba[4], bx[4], spl[4];
#pragma unroll
    for (int dt = 0; dt < 4; ++dt) {
#pragma unroll
        for (int s = 0; s < 2; ++s) { fa[dt][s] = *(const bf16x8*)(wa + (dt * 16 + fr) * 64 + 32 * s + 8 * fq); fx[dt][s] = *(const bf16x8*)(wx + (dt * 16 + fr) * 64 + 32 * s + 8 * fq); }
        const int d = nb * 64 + dt * 16 + fr; ba[dt] = P.lru_ba[l * 256 + d]; bx[dt] = P.lru_bx[l * 256 + d]; spl[dt] = -8.0f * softplusf_(-P.lru_lambda[l * 256 + d]); }
    __syncthreads();
    for (int half = 0; half < 2; ++half) {
        const int trow = half * 32 + rt * 16;
        const bf16x8 x0 = *(const LAS bf16x8*)(XC + (trow + fr) * 264 + nb * 64 + 8 * fq), x1 = *(const LAS bf16x8*)(XC + (trow + fr) * 264 + nb * 64 + 32 + 8 * fq);
#pragma unroll
        for (int dt = 0; dt < 4; ++dt) {
            f32x4 ar = {0.f, 0.f, 0.f, 0.f}, ai = {0.f, 0.f, 0.f, 0.f};
            ar = mfma16(x0, fa[dt][0], ar); ar = mfma16(x1, fa[dt][1], ar); ai = mfma16(x0, fx[dt][0], ai); ai = mfma16(x1, fx[dt][1], ai);
            const int d = nb * 64 + dt * 16 + fr;
#pragma unroll
            for (int r = 0; r < 4; ++r) { const int tl = rt * 16 + 4 * fq + r;
                const float xcv = bf2f(XC[(half * 32 + tl) * 264 + d]);
                const float rr = sigmoidf_(ar[r] + ba[dt]), ii = sigmoidf_(ai[r] + bx[dt]);
                const float a = fexp_(rr * spl[dt]);
                const float u = fsqrt_(fmaxf(1.0f - a * a, 0.f)) * (ii * xcv);
                AU[tl * 257 + d] = (f32x2){a, u}; }
        }
        __syncthreads();
        if (tid < 256) {
#pragma unroll 8
            for (int tk = 0; tk < 32; ++tk) { const f32x2 au = AU[tk * 257 + tid]; hcar = au.x * hcar + au.y; aprod *= au.x; if (mode == 1) AU[tk * 257 + tid].y = hcar; }
        }
        if (mode == 1) {
            __syncthreads();
            const int tk = tid >> 4, c0 = (tid & 15) * 16; const size_t tok = (size_t)b * SEQ + n * 64 + half * 32 + tk;
            const u32x4 g0 = *(const u32x4*)(z + tok * ZP + Z_LG + c0), g1 = *(const u32x4*)(z + tok * ZP + Z_LG + c0 + 8);
            const unsigned gws[8] = {g0.x, g0.y, g0.z, g0.w, g1.x, g1.y, g1.z, g1.w}; unsigned ow[8];
#pragma unroll
            for (int j = 0; j < 8; ++j) { const float h0 = AU[tk * 257 + c0 + 2 * j].y, h1 = AU[tk * 257 + c0 + 2 * j + 1].y; ow[j] = pk2(h0 * geluf_(bflo(gws[j])), h1 * geluf_(bfhi(gws[j]))); }
            bf16_t* yp = y + tok * DM + 256 + c0;
            *(u32x4*)yp = (u32x4){ow[0], ow[1], ow[2], ow[3]}; *(u32x4*)(yp + 8) = (u32x4){ow[4], ow[5], ow[6], ow[7]};
        }
        __syncthreads();
    }
    if (mode == 0 && tid < 256) { sumA[(b * 32 + n) * 256 + tid] = aprod; sumH[(b * 32 + n) * 256 + tid] = hcar; }
}

constexpr int N_PHASES = 21;
constexpr int Q_RET = 64, Q_GDN = 32, Q_LRU = 512, Q_MLA = 1024, Q_TOTAL = Q_RET + Q_GDN + Q_LRU + Q_MLA;

__global__ void __launch_bounds__(512, 2) hymba_fwd(Params P_) {
    extern __shared__ __attribute__((aligned(16))) unsigned char lds_raw[];
    LAS unsigned char* lds = (LAS unsigned char*)lds_raw;
    volatile LAS unsigned* LC = (volatile LAS unsigned*)(lds + LDS_CTL);
    const int G = gridDim.x;
#define SUB_TID() int tid2 = tid; asm volatile("" : "+v"(tid2)); const int lane2 = tid2 & 63, wave2 = __builtin_amdgcn_readfirstlane(tid2 >> 6); (void)lane2; (void)wave2
#if defined(__HIP_DEVICE_COMPILE__)
#define PH_PARAMS() const __attribute__((address_space(4))) Params* pp_ = (const __attribute__((address_space(4))) Params*)__builtin_amdgcn_kernarg_segment_ptr(); asm volatile("" : "+s"(pp_)); const Params P = *pp_
#else
#define PH_PARAMS() const Params P = P_
#endif
#define PH_TID() PH_PARAMS(); \
    bf16_t* xb = (bf16_t*)(P.ws + WS_XB); float* part = (float*)(P.ws + WS_PART); bf16_t* zb = (bf16_t*)(P.ws + WS_R); bf16_t* yb = (bf16_t*)(P.ws + WS_R + R_Y); bf16_t* oxb = (bf16_t*)(P.ws + WS_R + R_OX); (void)xb; (void)part; (void)zb; (void)yb; (void)oxb; \
    int tid = threadIdx.x; asm volatile("" : "+v"(tid)); const int lane = tid & 63, wave = __builtin_amdgcn_readfirstlane(tid >> 6); (void)lane; (void)wave
    unsigned* ctl = (unsigned*)(P_.ws + WS_CTL);
    if (threadIdx.x < 64) LC[threadIdx.x] = 0u;
    __syncthreads();
    const int lo = P_.ph_lo, hi = P_.ph_hi;
    XcdBarrier bar; bar.bar = ctl + CW_BAR; bar.x = 0; bar.st = LC;
    if (hi - lo > 1) bar = xcd_barrier_post(ctl + CW_BAR, LC);
#ifndef PHASE_MASK
#define PHASE_MASK 0xFFFFFFFFu
#endif
#define EN(t) ((PHASE_MASK >> (t)) & 1u)
#ifndef REPEAT_MASK
#define REPEAT_MASK 0u
#endif
#define REP(t) for (int rep_ = 0; rep_ <= (int)((REPEAT_MASK >> (t)) & 1u); ++rep_, (rep_ <= (int)((REPEAT_MASK >> (t)) & 1u) ? xcd_barrier(bar) : (void)0))
#define IN(k) (lo <= (k) && (k) < hi)
#define SEAM(k) do { if (IN(k) && IN((k) + 1)) xcd_barrier(bar); } while (0)


    if (IN(0) && EN(0)) REP(0) { PH_TID(); p0_prologue(P, lds, tid); __syncthreads(); }
    SEAM(0);
    if (IN(1) && EN(1)) REP(1) {
        PH_TID();
        const int which = blockIdx.x >> 6, l = which >> 1, isv = which & 1;
        if (which < 4) {
            const bf16_t* memn = (const bf16_t*)(P.ws + WS_GDN); const bf16_t* wkv = wl(P, l, W_KV);
            bf16_t* kout = (bf16_t*)(P.ws + WS_KVM + (size_t)l * KVM_LAYER); bf16_t* vout = kout + (size_t)4096 * 1024;
            pg8::Gemm g; pg8::EpiScaleBf16<0> E; pg8::StaticOrder S;
            if (!isv) { g = pg8::Gemm{memn, wkv, 4096, 1024, 1024}; E = pg8::EpiScaleBf16<0>{kout, 1024, nullptr}; S.init(4096, 1024, 64, blockIdx.x & 63); }
            else { g = pg8::Gemm{wkv + (size_t)1024 * 1024, memn, 1024, 4096, 1024}; E = pg8::EpiScaleBf16<0>{vout, 4096, nullptr}; S.init(1024, 4096, 64, blockIdx.x & 63); }
            pg8::gemm_phase(lds, g, S, E, tid);
        }
    }
    SEAM(1);
#pragma unroll
    for (int l = 0; l < 2; ++l) {
        const int pb = 2 + 9 * l;
        if (IN(pb + 0) && EN(2)) REP(2) { PH_TID();
            pg8::Gemm g{xb, wl(P, l, W_IN), T_TOK, ZP, DM}; pg8::StaticOrder S; S.init(T_TOK, ZP, G, blockIdx.x);
            pg8::EpiScaleBf16<0> E{zb, ZP, part}; pg8::gemm_phase(lds, g, S, E, tid);
        }
        SEAM(pb + 0);
        if (IN(pb + 1)) {
            PH_TID();
            if (EN(3)) REP(3) { SUB_TID(); for (int it = blockIdx.x; it < 1024; it += G) gdn_pre_item(P, l, lds, it, tid2); }
            if (EN(4)) REP(4) { SUB_TID(); for (int it = blockIdx.x; it < 512; it += G) { lru_item(P, l, lds, it, 0, tid2, wave2, lane2); __syncthreads(); } }
            if (EN(5)) REP(5) { SUB_TID(); for (int rt = blockIdx.x * 8 + wave2; rt < 2048; rt += G * 8) mla_pre_tile(P, l, rt, lane2); }
        }
        SEAM(pb + 1);
        if (IN(pb + 2)) {
            PH_TID();
            unsigned* qh0 = ctl + CW_QUEUE + 64 * l;
#define QUEUE_LOOP(qi_, count_, body_) for (;;) { if (tid == 0) LC[4] = __hip_atomic_fetch_add(qh + (qi_), 1u, __ATOMIC_RELAXED, __HIP_MEMORY_SCOPE_AGENT); \
                __syncthreads(); const int it = (int)LC[4]; __syncthreads(); if (it >= (count_)) break; { SUB_TID(); body_; } __syncthreads(); }
            if (EN(6)) REP(6) { unsigned* qh = qh0 + 32 * rep_; QUEUE_LOOP(0, Q_RET, ret_chain_item(P, l, lds, it, tid2, wave2, lane2)) }
            if (EN(7)) REP(7) { unsigned* qh = qh0 + 32 * rep_; QUEUE_LOOP(1, Q_GDN, gdn_chain_item(P, l, lds, it, tid2, wave2, lane2)) }
            if (EN(8)) REP(8) { unsigned* qh = qh0 + 32 * rep_; QUEUE_LOOP(2, Q_LRU, lru_item(P, l, lds, it, 1, tid2, wave2, lane2)) }
            if (EN(9)) REP(9) { unsigned* qh = qh0 + 32 * rep_; QUEUE_LOOP(3, Q_MLA, mla_attn_item(P, lds, it, tid2, wave2, lane2)) }
#undef QUEUE_LOOP
        }
        SEAM(pb + 2);
        if (IN(pb + 3) && EN(10)) REP(10) { PH_TID();
            pg8::Gemm g{yb, wl(P, l, W_OUT), T_TOK, DM, DM}; pg8::StaticOrder S; S.init(T_TOK, DM, G, blockIdx.x);
            pg8::EpiResid E{P.out, xb, part, rep_ ? 0.f : 1.f}; pg8::gemm_phase(lds, g, S, E, tid);
        }
        SEAM(pb + 3);
        if (IN(pb + 4) && EN(11)) REP(11) { PH_TID();
            pg8::Gemm g{xb, wl(P, l, W_Q), T_TOK, DM, DM}; pg8::StaticOrder S; S.init(T_TOK, DM, G, blockIdx.x);
            pg8::EpiScaleBf16<0> E{zb, DM, part}; pg8::gemm_phase(lds, g, S, E, tid);
        }
        SEAM(pb + 4);
        if (IN(pb + 5) && EN(12)) REP(12) { PH_TID(); for (int it = blockIdx.x; it < 1024; it += G) { xa_item(P, l, lds, it, tid, wave, lane); __syncthreads(); } }
        SEAM(pb + 5);
        if (IN(pb + 6) && EN(13)) REP(13) { PH_TID();
            pg8::Gemm g{oxb, wl(P, l, W_O), T_TOK, DM, DM}; pg8::StaticOrder S; S.init(T_TOK, DM, G, blockIdx.x);
            pg8::EpiResid E{P.out, xb, part, rep_ ? 0.f : 1.f}; pg8::gemm_phase(lds, g, S, E, tid);
        }
        SEAM(pb + 6);
        if (IN(pb + 7) && EN(14)) REP(14) { PH_TID();
            pg8::Gemm g{xb, wl(P, l, W_1), T_TOK, DFF, DM}; pg8::StaticOrder S; S.init(T_TOK, DFF, G, blockIdx.x);
            pg8::EpiScaleBf16<1> E{zb, DFF, part}; pg8::gemm_phase(lds, g, S, E, tid);
        }
        SEAM(pb + 7);
        if (IN(pb + 8) && EN(15)) REP(15) { PH_TID();
            pg8::Gemm g{zb, wl(P, l, W_2), T_TOK, DM, DFF}; pg8::StaticOrder S; S.init(T_TOK, DM, G, blockIdx.x);
            pg8::EpiResid E{P.out, xb, part, rep_ ? 0.f : 1.f}; pg8::gemm_phase(lds, g, S, E, tid);
        }
        SEAM(pb + 8);
    }
    if (IN(20) && EN(16)) { PH_TID(); final_norm_phase(P, tid); }
#undef IN
#undef SEAM
}

extern "C" void kernel_launch(void* const* d_in, const int* in_sizes, int n_in, void* d_out, int out_size, void* d_ws, size_t ws_size, hipStream_t stream) {
    static int grid = 0;
    if (grid == 0) {
        if (n_in != 31 || out_size != T_TOK * DM || ws_size < WS_END) { fprintf(stderr, "kernel_launch: unexpected shapes (n_in %d out %d ws %zu, need %zu)\n", n_in, out_size, ws_size, (size_t)WS_END); grid = -1; return; }
        if (hipFuncSetAttribute((const void*)hymba_fwd, hipFuncAttributeMaxDynamicSharedMemorySize, LDS_BYTES) != hipSuccess) { fprintf(stderr, "kernel_launch: hipFuncSetAttribute failed\n"); grid = -1; return; }
        int dev = 0, cus = 0, per_cu = 0;
        (void)hipGetDevice(&dev); (void)hipDeviceGetAttribute(&cus, hipDeviceAttributeMultiprocessorCount, dev);
        (void)hipOccupancyMaxActiveBlocksPerMultiprocessor(&per_cu, (const void*)hymba_fwd, 512, LDS_BYTES);
        (void)hipGetLastError();
        if (cus != 256 || per_cu < 1) fprintf(stderr, "kernel_launch: note: cus %d per_cu %d\n", cus, per_cu);
        grid = 256;
    }
    if (grid < 0) return;
    (void)hipMemsetAsync((char*)d_ws + WS_CTL, 0, CTL_BYTES, stream);
    Params p{};
    p.x = (const float*)d_in[0]; p.mem = (const float*)d_in[1]; p.pos = (const int*)d_in[2];
    p.norm_mix = (const float*)d_in[3]; p.w_in = (const float*)d_in[4]; p.ret_gn = (const float*)d_in[5];
    p.lru_conv_w = (const float*)d_in[6]; p.lru_conv_b = (const float*)d_in[7]; p.lru_wa = (const float*)d_in[8]; p.lru_ba = (const float*)d_in[9];
    p.lru_wx = (const float*)d_in[10]; p.lru_bx = (const float*)d_in[11]; p.lru_lambda = (const float*)d_in[12];
    p.mla_q_norm = (const float*)d_in[13]; p.mla_w_uq = (const float*)d_in[14]; p.mla_kv_norm = (const float*)d_in[15]; p.mla_w_ukv = (const float*)d_in[16];
    p.gdn_conv_w = (const float*)d_in[17]; p.gdn_a_log = (const float*)d_in[18]; p.gdn_dt_bias = (const float*)d_in[19]; p.gdn_norm = (const float*)d_in[20];
    p.w_out = (const float*)d_in[21]; p.norm_xattn = (const float*)d_in[22]; p.norm_mem = (const float*)d_in[23];
    p.xa_wq = (const float*)d_in[24]; p.xa_wkv = (const float*)d_in[25]; p.xa_wo = (const float*)d_in[26];
    p.norm_mlp = (const float*)d_in[27]; p.mlp_w1 = (const float*)d_in[28]; p.mlp_w2 = (const float*)d_in[29]; p.final_norm = (const float*)d_in[30];
    p.out = (float*)d_out; p.ws = (unsigned char*)d_ws;
#if N_LAUNCHES == 1
    p.ph_lo = 0; p.ph_hi = N_PHASES;
    void* args[] = {&p};
    hipError_t e = hipLaunchCooperativeKernel((const void*)hymba_fwd, dim3(grid), dim3(512), args, LDS_BYTES, stream);
    if (e != hipSuccess) fprintf(stderr, "kernel_launch: cooperative launch failed: %s\n", hipGetErrorString(e));
#else
    for (int ph = 0; ph < N_PHASES; ++ph) { p.ph_lo = ph; p.ph_hi = ph + 1; hipLaunchKernelGGL(hymba_fwd, dim3(grid), dim3(512), LDS_BYTES, stream, p); }
#endif
}
```

```cpp
#include <hip/hip_runtime.h>
#include <cstdio>
#include <cstdint>

#ifndef N_LAUNCHES
#define N_LAUNCHES 1
#endif

#define LAS __attribute__((address_space(3)))
typedef unsigned short bf16_t;
typedef short bf16x8 __attribute__((ext_vector_type(8)));
typedef float f32x4 __attribute__((ext_vector_type(4)));
typedef float f32x2 __attribute__((ext_vector_type(2)));
typedef unsigned u32x4 __attribute__((ext_vector_type(4)));
typedef unsigned u32x2 __attribute__((ext_vector_type(2)));

constexpr int T_TOK = 32768, DM = 1024, SEQ = 2048, NBATCH = 16, NCHUNK = 32, ZP = 3072, DFF = 4096, NMEM = 256;
constexpr int Z_RQ = 0, Z_RK = 256, Z_RV = 512, Z_RG = 768, Z_LX = 1024, Z_LG = 1280, Z_CQ = 1536, Z_CKV = 1728, Z_KR = 1856,
              Z_GQKV = 1888, Z_GG = 2656, Z_GB = 2912, Z_GA = 2916, IN_COLS = 2920;
constexpr float EPS = 1e-6f;
constexpr float LOG2E = 1.4426950408889634f;

constexpr size_t MiB = 1024 * 1024;
constexpr size_t WS_CTL = 0;
constexpr size_t CTL_BYTES = 65536;
constexpr size_t WS_PART = WS_CTL + CTL_BYTES;
constexpr size_t WS_LRUS = WS_PART + (size_t)T_TOK * 16 * 4;
constexpr size_t WS_GL = WS_LRUS + (size_t)2 * 16 * 32 * 256 * 4;
constexpr size_t WS_W = WS_GL + 65536;
constexpr size_t W_IN = 0, W_OUT = W_IN + (size_t)ZP * DM, W_Q = W_OUT + (size_t)DM * DM, W_KV = W_Q + (size_t)DM * DM, W_O = W_KV + (size_t)2 * DM * DM,
                 W_1 = W_O + (size_t)DM * DM, W_2 = W_1 + (size_t)DFF * DM, W_UQ = W_2 + (size_t)DFF * DM, W_UKV = W_UQ + 384 * 192, W_A = W_UKV + 512 * 128,
                 W_X = W_A + 4 * 64 * 64, W_LAYER = W_X + 4 * 64 * 64;
constexpr size_t WS_XB = WS_W + 2 * W_LAYER * 2;
constexpr size_t XB_BYTES = (size_t)T_TOK * DM * 2;
constexpr size_t MLA_Q_OFF = 0, MLA_K_OFF = (size_t)T_TOK * 4 * 96 * 2, MLA_VT_OFF = 2 * MLA_K_OFF;
constexpr size_t WS_KVM = WS_XB + XB_BYTES;
constexpr size_t KVM_LAYER = (size_t)2 * 4096 * 1024 * 2;
constexpr size_t WS_R = WS_KVM + 2 * KVM_LAYER;
constexpr size_t R_Y = (size_t)T_TOK * ZP * 2;
constexpr size_t R_OX = (size_t)T_TOK * DM * 2;
constexpr size_t WS_GDN = WS_R + 256 * MiB;
constexpr size_t WS_END = WS_GDN + 80 * MiB;
static_assert(WS_END <= 512 * MiB, "workspace map exceeds 512 MiB");
static_assert(WS_XB % 256 == 0 && WS_R % 256 == 0 && WS_GDN % 256 == 0 && WS_W % 256 == 0, "alignment");
constexpr int CW_BAR = 0;
constexpr int CW_QUEUE = 4096;

constexpr int LDS_BYTES = 160 * 1024;
constexpr int LDS_CTL = LDS_BYTES - 256;

typedef __bf16 bf16x2_t __attribute__((ext_vector_type(2)));
__device__ __forceinline__ unsigned pk2(float lo, float hi) { f32x2 t = {lo, hi}; bf16x2_t v = __builtin_convertvector(t, bf16x2_t); return __builtin_bit_cast(unsigned, v); }
__device__ __forceinline__ float bflo(unsigned w) { return __uint_as_float(w << 16); }
__device__ __forceinline__ float bfhi(unsigned w) { return __uint_as_float(w & 0xffff0000u); }
__device__ __forceinline__ float bf2f(bf16_t v) { return __uint_as_float((unsigned)v << 16); }
__device__ __forceinline__ bf16_t f2bf(float f) { return (bf16_t)(pk2(f, 0.f) & 0xffffu); }
__device__ __forceinline__ f32x4 mfma16(bf16x8 a, bf16x8 b, f32x4 c) { return __builtin_amdgcn_mfma_f32_16x16x32_bf16(a, b, c, 0, 0, 0); }
__device__ __forceinline__ float fexp2_(float x) { return __builtin_amdgcn_exp2f(x); }
__device__ __forceinline__ float fexp_(float x) { return __builtin_amdgcn_exp2f(x * LOG2E); }
__device__ __forceinline__ float frcp_(float x) { return __builtin_amdgcn_rcpf(x); }
__device__ __forceinline__ float frsq_(float x) { return __builtin_amdgcn_rsqf(x); }
__device__ __forceinline__ float fsqrt_(float x) { return __builtin_amdgcn_sqrtf(x); }
__device__ __forceinline__ float sigmoidf_(float x) { return frcp_(1.0f + fexp_(-x)); }
__device__ __forceinline__ float siluf_(float x) { return x * frcp_(1.0f + fexp_(-x)); }
__device__ __forceinline__ float softplusf_(float x) { return x > 20.f ? x : log1pf(__expf(x)); }
__device__ __forceinline__ float geluf_(float x) { const float u = 1.5957691216057308f * (x + 0.044715f * x * x * x); return x * frcp_(1.0f + fexp_(-u)); }
__device__ __forceinline__ float wave_sum(float v) {
#pragma unroll
    for (int o = 1; o < 64; o <<= 1) v += __shfl_xor(v, o);
    return v;
}
__device__ __forceinline__ void sincos_rev(float ang, float& s, float& c) {
    float rev = ang * 0.15915494309189535f; rev = rev - floorf(rev);
    s = __builtin_amdgcn_sinf(rev); c = __builtin_amdgcn_cosf(rev);
}
__device__ __forceinline__ bf16x8 mk8(u32x2 lo, u32x2 hi) { u32x4 t; t.x = lo.x; t.y = lo.y; t.z = hi.x; t.w = hi.y; return __builtin_bit_cast(bf16x8, t); }
__device__ __forceinline__ bf16x8 pack8(f32x4 a, f32x4 b) { u32x4 t; t.x = pk2(a.x, a.y); t.y = pk2(a.z, a.w); t.z = pk2(b.x, b.y); t.w = pk2(b.z, b.w); return __builtin_bit_cast(bf16x8, t); }

#define XB_TMO      128
#define XB_XCNT(j)  (256  + 64 * (j))
#define XB_XSUB(j)  (1280 + 64 * (j))
#define XB_XGEN(j)  (2304 + 64 * (j))
#define XB_TOP      3328
#define XB_TOPGEN   3392
#define XCD_BAR_WORDS 3456
#define XB_SPIN_CAP (1u << 22)
__device__ __forceinline__ unsigned xb_ld(unsigned* p)              { return __hip_atomic_load(p, __ATOMIC_RELAXED, __HIP_MEMORY_SCOPE_AGENT); }
__device__ __forceinline__ unsigned xb_add(unsigned* p, unsigned v) { return __hip_atomic_fetch_add(p, v, __ATOMIC_RELAXED, __HIP_MEMORY_SCOPE_AGENT); }
__device__ __forceinline__ unsigned xb_xcc_id() { return (unsigned)__builtin_amdgcn_s_getreg((3 << 11) | 20) & 0xFu; }
#define XB_SPIN(cond, bar) do { unsigned _sp = 0; while (cond) { __builtin_amdgcn_s_sleep(1); \
    if ((++_sp & 255u) == 0u) { if (xb_ld(&(bar)[XB_TMO])) break; if (_sp > XB_SPIN_CAP) { atomicAdd(&(bar)[XB_TMO], 1u); break; } } } } while (0)
struct XcdBarrier { unsigned* bar; unsigned x; volatile LAS unsigned* st; };
__device__ __forceinline__ XcdBarrier xcd_barrier_post(unsigned* bar, volatile LAS unsigned* st) {
    XcdBarrier b; b.bar = bar; b.x = xb_xcc_id(); b.st = st;
    if (threadIdx.x == 0) (void)xb_add(&bar[XB_XCNT(b.x)], 1u);
    return b;
}
__device__ __forceinline__ void xcd_barrier_complete(unsigned* bar, unsigned x, unsigned& nloc, unsigned& nx) {
    const unsigned G = gridDim.x * gridDim.y * gridDim.z;
    unsigned sum, cnt, mine, sp = 0u;
    for (;;) {
        sum = 0u; cnt = 0u; mine = 0u;
#pragma unroll
        for (unsigned j = 0; j < 16; ++j) { const unsigned c = xb_ld(&bar[XB_XCNT(j)]); sum += c; cnt += (c > 0u) ? 1u : 0u; mine = (j == x) ? c : mine; }
        if (sum == G) break;
        __builtin_amdgcn_s_sleep(1);
        if ((++sp & 255u) == 0u) { if (xb_ld(&bar[XB_TMO])) break; if (sp > XB_SPIN_CAP) { atomicAdd(&bar[XB_TMO], 1u); break; } }
    }
    nloc = mine > 0u ? mine : 1u; nx = cnt > 0u ? cnt : 1u;
}
__device__ __forceinline__ void xcd_barrier(const XcdBarrier& b) {
    asm volatile("s_waitcnt vmcnt(0)" ::: "memory");
    __syncthreads();
    if (threadIdx.x == 0) {
        unsigned* bar = b.bar;
        __builtin_amdgcn_s_waitcnt(0);
        unsigned nloc = b.st[0], nx = b.st[1];
        if (nloc == 0u) { xcd_barrier_complete(bar, b.x, nloc, nx); b.st[0] = nloc; b.st[1] = nx; }
        const unsigned old = xb_add(&bar[XB_XSUB(b.x)], 1u);
        const unsigned gen = old / nloc;
        if (old + 1u == (gen + 1u) * nloc) {
            __builtin_amdgcn_fence(__ATOMIC_RELEASE, "agent");
            asm volatile("s_waitcnt vmcnt(0)" ::: "memory");
            const unsigned og = xb_add(&bar[XB_TOP], 1u);
            const unsigned tg = og / nx;
            if (og + 1u == (tg + 1u) * nx) xb_add(&bar[XB_TOPGEN], 1u);
            else XB_SPIN(xb_ld(&bar[XB_TOPGEN]) == tg, bar);
            __builtin_amdgcn_fence(__ATOMIC_ACQUIRE, "agent");
            xb_add(&bar[XB_XGEN(b.x)], 1u);
            asm volatile("s_waitcnt vmcnt(0)" ::: "memory");
        } else {
            XB_SPIN(xb_ld(&bar[XB_XGEN(b.x)]) == gen, bar);
            __builtin_amdgcn_fence(__ATOMIC_ACQUIRE, "agent");
            asm volatile("s_waitcnt vmcnt(0)" ::: "memory");
        }
    }
    __syncthreads();
}

namespace pg8 {
constexpr int BM = 256, BK = 64, HALF = 128, HTB = HALF * BK * 2, STAGE_BYTES = 8 * HTB, NXCD = 8, WGM = 8;
__host__ __device__ __forceinline__ int lds_byte(int r, int c) { const int st = (r >> 4) * 2 + (c >> 5), rr = r & 15, cc = c & 31, ob = rr * 64 + cc * 2; return st * 1024 + (ob ^ (((ob >> 9) & 1) << 5)); }
__host__ __device__ __forceinline__ void stage_rc(int b, int& R, int& C) { const int st = b / 1024, sb = b % 1024, swz = sb ^ (((sb >> 9) & 1) << 5); R = (st >> 1) * 16 + swz / 64; C = (st & 1) * 32 + (swz % 64) / 2; }
__host__ __device__ __forceinline__ int perm32(int rho) { const int n = rho >> 4, i = rho & 15; return 8 * (i >> 2) + 4 * n + (i & 3); }
struct Unit { int pm, pn; };
struct Gemm { const bf16_t* A; const bf16_t* Bt; int M, N, K; };
struct StaticOrder {
    int nM, nN, nwg, G, c;
    __host__ __device__ void init(int M, int N, int G_, int c_) { nM = M / BM; nN = N / BM; nwg = nM * nN; G = G_; c = c_; }
    __host__ __device__ bool next(int i, Unit& u) const {
        const long L = (long)i * G + c; if (L >= nwg) return false;
        int wgid = (int)L; { const int q = nwg / NXCD, r = nwg % NXCD, xcd = wgid % NXCD, off = wgid / NXCD; wgid = (xcd < r ? xcd * (q + 1) : r * (q + 1) + (xcd - r) * q) + off; }
        const int nig = WGM * nN, gid = wgid / nig, fm = gid * WGM, gsz = (nM - fm) < WGM ? (nM - fm) : WGM;
        u.pm = fm + ((wgid % nig) % gsz); u.pn = (wgid % nig) / gsz; return true;
    }
    __device__ __forceinline__ void a_ready(const Unit&) const {}
    __device__ __forceinline__ void done(const Unit&) const {}
};

template <int ACT> struct EpiScaleBf16 {
    static constexpr bool PERM = true;
    bf16_t* O; int ldc; const float* part;
    __device__ __forceinline__ void operator()(const f32x4 (&acc)[2][2][4][2], const Unit& u, int wr, int wc, int fr, int fq) const {
        const int row0 = u.pm * BM + wr * 64 + fr, col0 = u.pn * BM + wc * 32 + 8 * fq;
#pragma unroll
        for (int ai = 0; ai < 2; ++ai)
#pragma unroll
            for (int m = 0; m < 4; ++m) {
                const int row = row0 + ai * HALF + m * 16;
                float sc = 1.0f;
                if (part) { const f32x4* pp = (const f32x4*)(part + (size_t)row * 16); const f32x4 a = pp[0], b = pp[1], c = pp[2], d = pp[3];
                    const float s = ((a.x + a.y) + (a.z + a.w)) + ((b.x + b.y) + (b.z + b.w)) + ((c.x + c.y) + (c.z + c.w)) + ((d.x + d.y) + (d.z + d.w));
                    sc = frsq_(s * (1.0f / 1024.0f) + EPS); }
                bf16_t* rowp = O + (size_t)row * ldc + col0;
#pragma unroll
                for (int bj = 0; bj < 2; ++bj) { f32x4 v0 = acc[ai][bj][m][0] * sc, v1 = acc[ai][bj][m][1] * sc;
                    if (ACT == 1) {
#pragma unroll
                        for (int j = 0; j < 4; ++j) { const float a0 = fmaxf(v0[j], 0.f), a1 = fmaxf(v1[j], 0.f); v0[j] = a0 * a0; v1[j] = a1 * a1; } }
                    u32x4 w; w.x = pk2(v0[0], v0[1]); w.y = pk2(v0[2], v0[3]); w.z = pk2(v1[0], v1[1]); w.w = pk2(v1[2], v1[3]);
                    *(u32x4*)(rowp + bj * HALF) = w; }
            }
    }
};
struct EpiResid {
    static constexpr bool PERM = false;
    float* X; bf16_t* XB; float* part; float alpha;
    __device__ __forceinline__ void operator()(const f32x4 (&acc)[2][2][4][2], const Unit& u, int wr, int wc, int fr, int fq) const {
        const int row0 = u.pm * BM + wr * 64 + fr, col0 = u.pn * BM + wc * 32 + 4 * fq;
#pragma unroll
        for (int ai = 0; ai < 2; ++ai)
#pragma unroll
            for (int m = 0; m < 4; ++m) {
                const int row = row0 + ai * HALF + m * 16;
                float* xp = X + (size_t)row * DM + col0; bf16_t* bp = XB + (size_t)row * DM + col0;
                float ss = 0.f;
#pragma unroll
                for (int bj = 0; bj < 2; ++bj)
#pragma unroll
                    for (int n = 0; n < 2; ++n) { const f32x4 v = *(const f32x4*)(xp + bj * HALF + n * 16) + acc[ai][bj][m][n] * alpha;
                        *(f32x4*)(xp + bj * HALF + n * 16) = v; ss += (v.x * v.x + v.y * v.y) + (v.z * v.z + v.w * v.w);
                        u32x2 w; w.x = pk2(v.x, v.y); w.y = pk2(v.z, v.w); *(u32x2*)(bp + bj * HALF + n * 16) = w; }
                ss += __shfl_xor(ss, 16); ss += __shfl_xor(ss, 32);
                if (fq == 0) part[(size_t)row * 16 + u.pn * 4 + wc] = ss;
            }
    }
};

template <class Epi, class Sched>
__device__ __forceinline__ void gemm_phase(LAS unsigned char* lds, const Gemm g, const Sched& S, const Epi& E, const int tid) {
    const int wid = __builtin_amdgcn_readfirstlane(tid >> 6), lane = tid & 63, wr = wid >> 2, wc = wid & 3, fr = lane & 15, fq = lane >> 4;
    const int K = g.K, nt = K / BK;
    unsigned voffA[2], voffB[2];
#pragma unroll
    for (int i = 0; i < 2; ++i) { int R, C; stage_rc(tid * 16 + i * 8192, R, C); const int Rb = Epi::PERM ? ((R & ~31) + perm32(R & 31)) : R;
        voffA[i] = (unsigned)(R * K + C) * 2u; voffB[i] = (unsigned)(Rb * K + C) * 2u; }
    const size_t kstep = (size_t)(BK * 2);
    const size_t hstep = (size_t)HALF * K * 2;
    const size_t tstep = 2 * hstep;
    const unsigned ldsw = (unsigned)wid * 1024u;
    const int aoff = lds_byte(wr * 64 + fr, fq * 8), boff = lds_byte(wc * 32 + fr, fq * 8);
#define PG8_SA(b, h) (((b) * 2 + (h)) * HTB)
#define PG8_SB(b, h) ((4 + (b) * 2 + (h)) * HTB)
#define PG8_STAGE(bufoff, gbase, voff) do { _Pragma("unroll") for (int _i = 0; _i < 2; ++_i) \
        __builtin_amdgcn_global_load_lds((const unsigned*)((const char*)(gbase) + (voff)[_i]), (LAS unsigned*)(lds + (bufoff) + ldsw + _i * 8192), 16, 0, 0); } while (0)
#define PG8_LDA(dst, b, h) do { _Pragma("unroll") for (int m = 0; m < 4; ++m) _Pragma("unroll") for (int k = 0; k < 2; ++k) dst[m][k] = *(const LAS bf16x8*)(lds + PG8_SA(b, h) + aoff + m * 2048 + k * 1024); } while (0)
#define PG8_LDB(dst, b, h) do { _Pragma("unroll") for (int n = 0; n < 2; ++n) _Pragma("unroll") for (int k = 0; k < 2; ++k) dst[n][k] = *(const LAS bf16x8*)(lds + PG8_SB(b, h) + boff + n * 2048 + k * 1024); } while (0)
#define PG8_MMA(ai, bj, At, Bt) do { __builtin_amdgcn_s_setprio(1); _Pragma("unroll") for (int m = 0; m < 4; ++m) _Pragma("unroll") for (int n = 0; n < 2; ++n) _Pragma("unroll") for (int k = 0; k < 2; ++k) \
        acc[ai][bj][m][n] = __builtin_amdgcn_mfma_f32_16x16x32_bf16(Bt[n][k], At[m][k], acc[ai][bj][m][n], 0, 0, 0); __builtin_amdgcn_s_setprio(0); } while (0)
#define PG8_WAIT_V(n) asm volatile("s_waitcnt vmcnt(" #n ")" ::: "memory")
#define PG8_WAIT_L(n) asm volatile("s_waitcnt lgkmcnt(" #n ")" ::: "memory")
#define PG8_BAR __builtin_amdgcn_s_barrier()
#define PG8_SCHED __builtin_amdgcn_sched_barrier(0)
    Unit cur, nxt; int ui = 0;
    if (!S.next(0, cur)) return;
    f32x4 acc[2][2][4][2];
#pragma unroll
    for (int a = 0; a < 2; ++a)
#pragma unroll
        for (int b = 0; b < 2; ++b)
#pragma unroll
            for (int m = 0; m < 4; ++m)
#pragma unroll
                for (int n = 0; n < 2; ++n) acc[a][b][m][n] = (f32x4){0.f, 0.f, 0.f, 0.f};
    bf16x8 At[4][2], B0[2][2], B1[2][2];
    const char* cA = (const char*)g.A + (size_t)cur.pm * tstep; const char* cB = (const char*)g.Bt + (size_t)cur.pn * tstep;
    S.a_ready(cur);
    PG8_STAGE(PG8_SB(0, 0), cB, voffB); PG8_STAGE(PG8_SA(0, 0), cA, voffA); PG8_STAGE(PG8_SB(0, 1), cB + hstep, voffB); PG8_STAGE(PG8_SA(0, 1), cA + hstep, voffA);
    if (wr == 1) PG8_BAR;
    PG8_WAIT_V(4); PG8_BAR;
    PG8_STAGE(PG8_SB(1, 0), cB + kstep, voffB); PG8_STAGE(PG8_SA(1, 0), cA + kstep, voffA); PG8_STAGE(PG8_SB(1, 1), cB + hstep + kstep, voffB);
    PG8_WAIT_V(6); PG8_BAR;
    for (;;) {
        const bool has_next = S.next(ui + 1, nxt);
        const char* nA = has_next ? (const char*)g.A + (size_t)nxt.pm * tstep : cA; const char* nB = has_next ? (const char*)g.Bt + (size_t)nxt.pn * tstep : cB;
        for (int t = 0; t < nt; t += 2) {
            const bool last = (t == nt - 2);
            const char* a1 = cA + (size_t)(t + 1) * kstep;
            const char* a2 = last ? nA : cA + (size_t)(t + 2) * kstep; const char* b2 = last ? nB : cB + (size_t)(t + 2) * kstep;
            const char* a3 = a2 + kstep; const char* b3 = b2 + kstep;
            if (last && has_next) S.a_ready(nxt);
            PG8_LDB(B0, 0, 0); PG8_SCHED; PG8_LDA(At, 0, 0); PG8_STAGE(PG8_SA(1, 1), a1 + hstep, voffA);
            PG8_WAIT_L(8); PG8_BAR; PG8_WAIT_L(0); PG8_MMA(0, 0, At, B0); PG8_BAR; PG8_SCHED;
            PG8_LDB(B1, 0, 1); PG8_STAGE(PG8_SB(0, 0), b2, voffB);
            PG8_BAR; PG8_WAIT_L(0); PG8_MMA(0, 1, At, B1); PG8_BAR;
            PG8_LDA(At, 0, 1); PG8_STAGE(PG8_SA(0, 0), a2, voffA);
            PG8_BAR; PG8_WAIT_L(0); PG8_MMA(1, 0, At, B0); PG8_BAR; PG8_SCHED;
            PG8_STAGE(PG8_SB(0, 1), b2 + hstep, voffB);
            PG8_WAIT_V(6); PG8_BAR; PG8_MMA(1, 1, At, B1); PG8_BAR;
            PG8_LDB(B0, 1, 0); PG8_SCHED; PG8_LDA(At, 1, 0); PG8_STAGE(PG8_SA(0, 1), a2 + hstep, voffA);
            PG8_WAIT_L(8); PG8_BAR; PG8_WAIT_L(0); PG8_MMA(0, 0, At, B0); PG8_BAR; PG8_SCHED;
            PG8_LDB(B1, 1, 1); PG8_STAGE(PG8_SB(1, 0), b3, voffB);
            PG8_BAR; PG8_WAIT_L(0); PG8_MMA(0, 1, At, B1); PG8_BAR;
            PG8_LDA(At, 1, 1); PG8_STAGE(PG8_SA(1, 0), a3, voffA);
            PG8_BAR; PG8_WAIT_L(0); PG8_MMA(1, 0, At, B0); PG8_BAR; PG8_SCHED;
            PG8_STAGE(PG8_SB(1, 1), b3 + hstep, voffB);
            PG8_WAIT_V(6); PG8_BAR; PG8_MMA(1, 1, At, B1); PG8_BAR;
        }
        E(acc, cur, wr, wc, fr, fq); S.done(cur);
        if (!has_next) break;
#pragma unroll
        for (int a = 0; a < 2; ++a)
#pragma unroll
            for (int b = 0; b < 2; ++b)
#pragma unroll
                for (int m = 0; m < 4; ++m)
#pragma unroll
                    for (int n = 0; n < 2; ++n) acc[a][b][m][n] = (f32x4){0.f, 0.f, 0.f, 0.f};
        cur = nxt; cA = nA; cB = nB; ++ui;
    }
    PG8_WAIT_V(0);
    if (wr == 0) PG8_BAR;
    PG8_BAR;
#undef PG8_SA
#undef PG8_SB
#undef PG8_STAGE
#undef PG8_LDA
#undef PG8_LDB
#undef PG8_MMA
#undef PG8_WAIT_V
#undef PG8_WAIT_L
#undef PG8_BAR
#undef PG8_SCHED
}
}

struct Params {
    const float* x; const float* mem; const int* pos;
    const float* norm_mix; const float* w_in; const float* ret_gn;
    const float* lru_conv_w; const float* lru_conv_b; const float* lru_wa; const float* lru_ba; const float* lru_wx; const float* lru_bx; const float* lru_lambda;
    const float* mla_q_norm; const float* mla_w_uq; const float* mla_kv_norm; const float* mla_w_ukv;
    const float* gdn_conv_w; const float* gdn_a_log; const float* gdn_dt_bias; const float* gdn_norm;
    const float* w_out; const float* norm_xattn; const float* norm_mem; const float* xa_wq; const float* xa_wkv; const float* xa_wo;
    const float* norm_mlp; const float* mlp_w1; const float* mlp_w2; const float* final_norm;
    float* out; unsigned char* ws;
    int ph_lo, ph_hi;
};

__device__ __forceinline__ bf16_t* wl(const Params& P, int l, size_t off) { return (bf16_t*)(P.ws + WS_W) + (size_t)l * W_LAYER + off; }

__device__ __forceinline__ void transpose_tile(const float* src, int K, int N, const float* gain, float scale, bf16_t* dst, int kb, int nb, LAS float* scr, int tid) {
#pragma unroll
    for (int i = 0; i < 8; ++i) { const int kk = (tid >> 6) + 8 * i, k = kb * 64 + kk, n = nb * 64 + (tid & 63);
        float v = 0.f; if (n < N) { v = src[(size_t)k * N + n] * scale; if (gain) v *= gain[k]; }
        scr[kk * 65 + (tid & 63)] = v; }
    __syncthreads();
    { const int nl = tid >> 3, k0 = (tid & 7) * 8; const LAS float* s = scr + k0 * 65 + nl;
      u32x4 o; o.x = pk2(s[0], s[65]); o.y = pk2(s[2 * 65], s[3 * 65]); o.z = pk2(s[4 * 65], s[5 * 65]); o.w = pk2(s[6 * 65], s[7 * 65]);
      *(u32x4*)(dst + (size_t)(nb * 64 + nl) * K + kb * 64 + k0) = o; }
    __syncthreads();
}
__device__ __forceinline__ void p0_prologue(const Params& P, LAS unsigned char* lds, int tid) {
    LAS float* scr = (LAS float*)lds;
    constexpr int T_IN = 16 * 48, T_SQ = 256, T_KV = 512, T_W1 = 1024, T_W2 = 1024, T_UQ = 18, T_UKV = 16, T_LRU = 8;
    constexpr int T_LAYER = T_IN + 3 * T_SQ + T_KV + T_W1 + T_W2 + T_UQ + T_UKV + T_LRU;
    for (int it = blockIdx.x; it < 2 * T_LAYER; it += gridDim.x) {
        const int l = it / T_LAYER; int r = it % T_LAYER;
        const float* src; const float* gain = nullptr; float scale = 1.f; bf16_t* dst; int K, N, nnb;
        if (r < T_IN) { src = P.w_in + (size_t)l * DM * IN_COLS; K = DM; N = IN_COLS; nnb = 48; gain = P.norm_mix + l * DM; dst = wl(P, l, W_IN); }
        else if ((r -= T_IN) < T_SQ) { src = P.w_out + (size_t)l * DM * DM; K = DM; N = DM; nnb = 16; dst = wl(P, l, W_OUT); }
        else if ((r -= T_SQ) < T_SQ) { src = P.xa_wq + (size_t)l * DM * DM; K = DM; N = DM; nnb = 16; gain = P.norm_xattn + l * DM; scale = 0.0625f * LOG2E; dst = wl(P, l, W_Q); }
        else if ((r -= T_SQ) < T_KV) { src = P.xa_wkv + (size_t)l * DM * 2 * DM; K = DM; N = 2 * DM; nnb = 32; gain = P.norm_mem + l * DM; dst = wl(P, l, W_KV); }
        else if ((r -= T_KV) < T_SQ) { src = P.xa_wo + (size_t)l * DM * DM; K = DM; N = DM; nnb = 16; dst = wl(P, l, W_O); }
        else if ((r -= T_SQ) < T_W1) { src = P.mlp_w1 + (size_t)l * DM * DFF; K = DM; N = DFF; nnb = 64; gain = P.norm_mlp + l * DM; dst = wl(P, l, W_1); }
        else if ((r -= T_W1) < T_W2) { src = P.mlp_w2 + (size_t)l * DFF * DM; K = DFF; N = DM; nnb = 16; dst = wl(P, l, W_2); }
        else if ((r -= T_W2) < T_UQ) { src = P.mla_w_uq + (size_t)l * 192 * 384; K = 192; N = 384; nnb = 6; gain = P.mla_q_norm + l * 192; dst = wl(P, l, W_UQ); }
        else if ((r -= T_UQ) < T_UKV) { src = P.mla_w_ukv + (size_t)l * 128 * 512; K = 128; N = 512; nnb = 8; gain = P.mla_kv_norm + l * 128; dst = wl(P, l, W_UKV); }
        else { r -= T_UKV; const int which = r >> 2, nb4 = r & 3; src = (which ? P.lru_wx : P.lru_wa) + (size_t)l * 4 * 4096 + nb4 * 4096; K = 64; N = 64; nnb = 1; dst = wl(P, l, which ? W_X : W_A) + nb4 * 4096; r = 0; }
        transpose_tile(src, K, N, gain, scale, dst, r / nnb, r % nnb, scr, tid);
    }
    const int wave = tid >> 6, lane = tid & 63;
    const int gw = blockIdx.x * 8 + wave, ngw = gridDim.x * 8;
    bf16_t* xb = (bf16_t*)(P.ws + WS_XB); float* part = (float*)(P.ws + WS_PART); bf16_t* memn = (bf16_t*)(P.ws + WS_GDN);
    for (int row = gw; row < T_TOK + NBATCH * NMEM; row += ngw) {
        const bool isx = row < T_TOK; const int r2 = isx ? row : row - T_TOK;
        const f32x4* src = (const f32x4*)((isx ? P.x : P.mem) + (size_t)r2 * DM) + lane;
        f32x4 v[4]; float s = 0.f;
#pragma unroll
        for (int j = 0; j < 4; ++j) { v[j] = src[64 * j]; s += (v[j].x * v[j].x + v[j].y * v[j].y) + (v[j].z * v[j].z + v[j].w * v[j].w); }
        s = wave_sum(s);
        if (isx) {
            f32x4* o = (f32x4*)(P.out + (size_t)row * DM) + lane; u32x2* ob = (u32x2*)(xb + (size_t)row * DM) + lane;
#pragma unroll
            for (int j = 0; j < 4; ++j) { o[64 * j] = v[j]; u32x2 w; w.x = pk2(v[j].x, v[j].y); w.y = pk2(v[j].z, v[j].w); ob[64 * j] = w; }
            if (lane < 16) part[(size_t)row * 16 + lane] = lane == 0 ? s : 0.f;
        } else {
            const float rs = frsq_(s * (1.0f / 1024.0f) + EPS); u32x2* ob = (u32x2*)(memn + (size_t)r2 * DM) + lane;
#pragma unroll
            for (int j = 0; j < 4; ++j) { u32x2 w; w.x = pk2(v[j].x * rs, v[j].y * rs); w.y = pk2(v[j].z * rs, v[j].w * rs); ob[64 * j] = w; }
        }
    }
}
__device__ __forceinline__ void final_norm_phase(const Params& P, int tid) {
    const int wave = tid >> 6, lane = tid & 63; const float* part = (const float*)(P.ws + WS_PART);
    f32x4 g[4];
#pragma unroll
    for (int j = 0; j < 4; ++j) g[j] = ((const f32x4*)P.final_norm)[64 * j + lane];
    for (int row = blockIdx.x * 8 + wave; row < T_TOK; row += gridDim.x * 8) {
        float s = lane < 16 ? part[(size_t)row * 16 + lane] : 0.f; s = wave_sum(s);
        const float rs = frsq_(s * (1.0f / 1024.0f) + EPS);
        f32x4* o = (f32x4*)(P.out + (size_t)row * DM) + lane;
#pragma unroll
        for (int j = 0; j < 4; ++j) { f32x4 v = o[64 * j]; o[64 * j] = v * rs * g[j]; }
    }
}

__device__ __forceinline__ void mla_pre_tile(const Params& P, int l, int rt, int lane) {
    const int fr = lane & 15, fq = lane >> 4;
    const bf16_t* z = (const bf16_t*)(P.ws + WS_R);
    bf16_t* Qo = (bf16_t*)(P.ws + WS_XB + MLA_Q_OFF); bf16_t* Ko = (bf16_t*)(P.ws + WS_XB + MLA_K_OFF); bf16_t* Vo = (bf16_t*)(P.ws + WS_XB + MLA_VT_OFF);
    const bf16_t* Wuq = wl(P, l, W_UQ); const bf16_t* Wukv = wl(P, l, W_UKV);
    const int tok0 = rt * 16, b = tok0 >> 11, s0 = tok0 & 2047;
    const bf16_t* zr = z + (size_t)(tok0 + fr) * ZP;
    bf16x8 cq[6], ckv[4]; float sq = 0.f, skv = 0.f;
#pragma unroll
    for (int s = 0; s < 6; ++s) { const u32x4 w = *(const u32x4*)(zr + Z_CQ + 32 * s + 8 * fq); cq[s] = __builtin_bit_cast(bf16x8, w);
        sq += bflo(w.x) * bflo(w.x) + bfhi(w.x) * bfhi(w.x) + bflo(w.y) * bflo(w.y) + bfhi(w.y) * bfhi(w.y) + bflo(w.z) * bflo(w.z) + bfhi(w.z) * bfhi(w.z) + bflo(w.w) * bflo(w.w) + bfhi(w.w) * bfhi(w.w); }
#pragma unroll
    for (int s = 0; s < 4; ++s) { const u32x4 w = *(const u32x4*)(zr + Z_CKV + 32 * s + 8 * fq); ckv[s] = __builtin_bit_cast(bf16x8, w);
        skv += bflo(w.x) * bflo(w.x) + bfhi(w.x) * bfhi(w.x) + bflo(w.y) * bflo(w.y) + bfhi(w.y) * bfhi(w.y) + bflo(w.z) * bflo(w.z) + bfhi(w.z) * bfhi(w.z) + bflo(w.w) * bflo(w.w) + bfhi(w.w) * bfhi(w.w); }
    sq += __shfl_xor(sq, 16); sq += __shfl_xor(sq, 32); skv += __shfl_xor(skv, 16); skv += __shfl_xor(skv, 32);
    const float rq = frsq_(sq * (1.0f / 192.0f) + EPS), rkv = frsq_(skv * (1.0f / 128.0f) + EPS);
    const float qsc = rq * 0.10206207261596575f * LOG2E;
    const float pos = (float)P.pos[tok0 + fr];
    float sn[4], cs[4];
#pragma unroll
    for (int r = 0; r < 4; ++r) { const float invf = exp2f(-(float)(4 * fq + r) * (13.287712379549449f / 16.0f)); sincos_rev(pos * invf, sn[r], cs[r]); }
    const size_t tokrow = (size_t)b * 4 * SEQ + (s0 + fr);
#pragma unroll 1
    for (int h = 0; h < 4; ++h) {
        bf16_t* qrow = Qo + (tokrow + (size_t)h * SEQ) * 96;
#pragma unroll 1
        for (int nt = 0; nt < 4; ++nt) { f32x4 a = {0.f, 0.f, 0.f, 0.f};
#pragma unroll
            for (int s = 0; s < 6; ++s) { const bf16x8 wf = *(const bf16x8*)(Wuq + (size_t)(h * 96 + nt * 16 + fr) * 192 + 32 * s + 8 * fq); a = mfma16(wf, cq[s], a); }
            a = a * qsc; u32x2 w; w.x = pk2(a.x, a.y); w.y = pk2(a.z, a.w); *(u32x2*)(qrow + nt * 16 + 4 * fq) = w; }
        f32x4 x1 = {0.f, 0.f, 0.f, 0.f}, x2 = {0.f, 0.f, 0.f, 0.f}, y1, y2;
#pragma unroll
        for (int s = 0; s < 6; ++s) { const bf16x8 wf1 = *(const bf16x8*)(Wuq + (size_t)(h * 96 + 64 + fr) * 192 + 32 * s + 8 * fq), wf2 = *(const bf16x8*)(Wuq + (size_t)(h * 96 + 80 + fr) * 192 + 32 * s + 8 * fq);
            x1 = mfma16(wf1, cq[s], x1); x2 = mfma16(wf2, cq[s], x2); }
        x1 = x1 * qsc; x2 = x2 * qsc;
#pragma unroll
        for (int r = 0; r < 4; ++r) { y1[r] = x1[r] * cs[r] - x2[r] * sn[r]; y2[r] = x1[r] * sn[r] + x2[r] * cs[r]; }
        { u32x2 w; w.x = pk2(y1.x, y1.y); w.y = pk2(y1.z, y1.w); *(u32x2*)(qrow + 64 + 4 * fq) = w; w.x = pk2(y2.x, y2.y); w.y = pk2(y2.z, y2.w); *(u32x2*)(qrow + 80 + 4 * fq) = w; }
    }
    u32x2 kr1, kr2;
    { const u32x2 a = *(const u32x2*)(zr + Z_KR + 4 * fq), c = *(const u32x2*)(zr + Z_KR + 16 + 4 * fq);
      const float x1[4] = {bflo(a.x), bfhi(a.x), bflo(a.y), bfhi(a.y)}, x2[4] = {bflo(c.x), bfhi(c.x), bflo(c.y), bfhi(c.y)}; float y1[4], y2[4];
#pragma unroll
      for (int r = 0; r < 4; ++r) { y1[r] = x1[r] * cs[r] - x2[r] * sn[r]; y2[r] = x1[r] * sn[r] + x2[r] * cs[r]; }
      kr1.x = pk2(y1[0], y1[1]); kr1.y = pk2(y1[2], y1[3]); kr2.x = pk2(y2[0], y2[1]); kr2.y = pk2(y2[2], y2[3]); }
    float rkv_r[4];
#pragma unroll
    for (int r = 0; r < 4; ++r) rkv_r[r] = __shfl(rkv, 4 * fq + r);
    const int chunk = s0 >> 6, key0 = (s0 & 63) + 4 * fq;
#pragma unroll 1
    for (int h = 0; h < 4; ++h) {
        bf16_t* krow = Ko + (tokrow + (size_t)h * SEQ) * 96;
#pragma unroll 1
        for (int nt = 0; nt < 4; ++nt) { f32x4 a = {0.f, 0.f, 0.f, 0.f};
#pragma unroll
            for (int s = 0; s < 4; ++s) { const bf16x8 wf = *(const bf16x8*)(Wukv + (size_t)(h * 128 + nt * 16 + fr) * 128 + 32 * s + 8 * fq); a = mfma16(wf, ckv[s], a); }
            a = a * rkv; u32x2 w; w.x = pk2(a.x, a.y); w.y = pk2(a.z, a.w); *(u32x2*)(krow + nt * 16 + 4 * fq) = w; }
        *(u32x2*)(krow + 64 + 4 * fq) = kr1; *(u32x2*)(krow + 80 + 4 * fq) = kr2;
        bf16_t* vt = Vo + ((size_t)((b * 4 + h) * NCHUNK + chunk) * 64) * 64;
#pragma unroll 1
        for (int nt = 0; nt < 4; ++nt) { f32x4 a = {0.f, 0.f, 0.f, 0.f};
#pragma unroll
            for (int s = 0; s < 4; ++s) { const bf16x8 wf = *(const bf16x8*)(Wukv + (size_t)(h * 128 + 64 + nt * 16 + fr) * 128 + 32 * s + 8 * fq); a = mfma16(ckv[s], wf, a); }
            u32x2 w; w.x = pk2(a.x * rkv_r[0], a.y * rkv_r[1]); w.y = pk2(a.z * rkv_r[2], a.w * rkv_r[3]);
            *(u32x2*)(vt + (size_t)(nt * 16 + fr) * 64 + key0) = w; }
    }
}

template <int DQK, int DV, int KT, int QT>
__device__ __forceinline__ void flash_item(LAS unsigned char* lds, const bf16_t* Qw, int ldq, const bf16_t* Kb, int ldk, const bf16_t* VTb, int ldv, int vts,
                                           bf16_t* Ow, int ldo, int ntiles, int wave_limit, int tid, int lane) {
    constexpr int KROW = DQK + 8, VROW = KT + 8, KS = DQK / 32, ET = DV / 16, NKT = KT / 16, KBYTES = KT * KROW * 2, BUF = KBYTES + DV * VROW * 2;
    constexpr int KP = KT * DQK / 8, VPR = KT / 8, VP = DV * VPR, NKP = (KP + 511) / 512, NVP = (VP + 511) / 512, NP = NKP > NVP ? NKP : NVP;
    const int fr = lane & 15, fq = lane >> 4;
    bf16x8 qf[QT][KS];
#pragma unroll
    for (int qi = 0; qi < QT; ++qi)
#pragma unroll
        for (int s = 0; s < KS; ++s) qf[qi][s] = *(const bf16x8*)(Qw + (size_t)(qi * 16 + fr) * ldq + 32 * s + 8 * fq);
    f32x4 ot[QT][ET];
#pragma unroll
    for (int qi = 0; qi < QT; ++qi)
#pragma unroll
        for (int e = 0; e < ET; ++e) ot[qi][e] = (f32x4){0.f, 0.f, 0.f, 0.f};
    float m_run[QT], l_run[QT];
#pragma unroll
    for (int qi = 0; qi < QT; ++qi) { m_run[qi] = -1e30f; l_run[qi] = 0.f; }
    u32x4 preg[NP];
#define FL_LOADK(j_) do { _Pragma("unroll") for (int i = 0; i < NKP; ++i) { const int idx = tid + i * 512; if (idx < KP) { const int row = idx / (DQK / 8), pc = idx % (DQK / 8); \
            preg[i] = *(const u32x4*)(Kb + (size_t)((j_) * KT + row) * ldk + pc * 8); } } } while (0)
#define FL_LOADV(j_) do { _Pragma("unroll") for (int i = 0; i < NVP; ++i) { const int idx = tid + i * 512; if (idx < VP) { const int row = idx / VPR, pc = idx % VPR; \
            preg[i] = *(const u32x4*)(VTb + (size_t)(j_) * vts + (size_t)row * ldv + pc * 8); } } } while (0)
#define FL_STOREK(buf_) do { LAS bf16_t* Kt_ = (LAS bf16_t*)(lds + (buf_) * BUF); \
        _Pragma("unroll") for (int i = 0; i < NKP; ++i) { const int idx = tid + i * 512; if (idx < KP) { const int row = idx / (DQK / 8), pc = idx % (DQK / 8); *(LAS u32x4*)(Kt_ + row * KROW + pc * 8) = preg[i]; } } } while (0)
#define FL_STOREV(buf_) do { LAS bf16_t* Vt_ = (LAS bf16_t*)(lds + (buf_) * BUF + KBYTES); \
        _Pragma("unroll") for (int i = 0; i < NVP; ++i) { const int idx = tid + i * 512; if (idx < VP) { const int row = idx / VPR, pc = idx % VPR; *(LAS u32x4*)(Vt_ + row * VROW + pc * 8) = preg[i]; } } } while (0)
    FL_LOADK(0); FL_STOREK(0); FL_LOADV(0); FL_STOREV(0);
    __syncthreads();
#pragma unroll 1
    for (int j = 0; j < ntiles; ++j) {
        const bool more = j + 1 < ntiles, act = j < wave_limit;
        const LAS bf16_t* Kt = (const LAS bf16_t*)(lds + (j & 1) * BUF); const LAS bf16_t* Vt = (const LAS bf16_t*)(lds + (j & 1) * BUF + KBYTES);
        if (more) FL_LOADK(j + 1);
        f32x4 st[QT][NKT];
        if (act) {
#pragma unroll
            for (int kt = 0; kt < NKT; ++kt) {
#pragma unroll
                for (int qi = 0; qi < QT; ++qi) st[qi][kt] = (f32x4){0.f, 0.f, 0.f, 0.f};
#pragma unroll
                for (int s = 0; s < KS; ++s) { const bf16x8 kf = *(const LAS bf16x8*)(Kt + (kt * 16 + fr) * KROW + 32 * s + 8 * fq);
#pragma unroll
                    for (int qi = 0; qi < QT; ++qi) st[qi][kt] = mfma16(kf, qf[qi][s], st[qi][kt]); } }
        }
        if (more) { FL_STOREK((j + 1) & 1); FL_LOADV(j + 1); }
        if (act) {
            bf16x8 pf[QT][NKT / 2];
#pragma unroll
            for (int qi = 0; qi < QT; ++qi) {
                float mx = fmaxf(fmaxf(st[qi][0].x, st[qi][0].y), fmaxf(st[qi][0].z, st[qi][0].w));
#pragma unroll
                for (int kt = 1; kt < NKT; ++kt) mx = fmaxf(mx, fmaxf(fmaxf(st[qi][kt].x, st[qi][kt].y), fmaxf(st[qi][kt].z, st[qi][kt].w)));
                mx = fmaxf(mx, __shfl_xor(mx, 16)); mx = fmaxf(mx, __shfl_xor(mx, 32));
                const float m_new = fmaxf(m_run[qi], mx), alpha = fexp2_(m_run[qi] - m_new);
                float ls = 0.f;
#pragma unroll
                for (int kt = 0; kt < NKT; ++kt)
#pragma unroll
                    for (int r = 0; r < 4; ++r) { const float p = fexp2_(st[qi][kt][r] - m_new); st[qi][kt][r] = p; ls += p; }
                l_run[qi] = l_run[qi] * alpha + ls; m_run[qi] = m_new;
#pragma unroll
                for (int e = 0; e < ET; ++e) ot[qi][e] = ot[qi][e] * alpha;
#pragma unroll
                for (int k2 = 0; k2 < NKT / 2; ++k2) pf[qi][k2] = pack8(st[qi][2 * k2], st[qi][2 * k2 + 1]);
            }
#pragma unroll
            for (int e = 0; e < ET; ++e) {
                const LAS bf16_t* vr = Vt + (e * 16 + fr) * VROW + 4 * fq;
#pragma unroll
                for (int k2 = 0; k2 < NKT / 2; ++k2) { const bf16x8 v0 = mk8(*(const LAS u32x2*)(vr + 32 * k2), *(const LAS u32x2*)(vr + 32 * k2 + 16));
#pragma unroll
                    for (int qi = 0; qi < QT; ++qi) ot[qi][e] = mfma16(v0, pf[qi][k2], ot[qi][e]); }
            }
        }
        if (more) FL_STOREV((j + 1) & 1);
        __syncthreads();
    }
#undef FL_LOADK
#undef FL_LOADV
#undef FL_STOREK
#undef FL_STOREV
#pragma unroll
    for (int qi = 0; qi < QT; ++qi) {
        float l = l_run[qi]; l += __shfl_xor(l, 16); l += __shfl_xor(l, 32);
        const float inv = frcp_(l);
#pragma unroll
        for (int e = 0; e < ET; ++e) { u32x2 w; w.x = pk2(ot[qi][e].x * inv, ot[qi][e].y * inv); w.y = pk2(ot[qi][e].z * inv, ot[qi][e].w * inv);
            *(u32x2*)(Ow + (size_t)(qi * 16 + fr) * ldo + e * 16 + 4 * fq) = w; }
    }
}
__device__ __forceinline__ void mla_attn_item(const Params& P, LAS unsigned char* lds, int it, int tid, int wave, int lane) {
    const int qt = 7 - (it >> 6), bh = it & 63;
    const bf16_t* Q = (const bf16_t*)(P.ws + WS_XB + MLA_Q_OFF) + ((size_t)bh * SEQ + qt * 256 + wave * 32) * 96;
    const bf16_t* K = (const bf16_t*)(P.ws + WS_XB + MLA_K_OFF) + (size_t)bh * SEQ * 96;
    const bf16_t* VT = (const bf16_t*)(P.ws + WS_XB + MLA_VT_OFF) + (size_t)bh * NCHUNK * 4096;
    bf16_t* y = (bf16_t*)(P.ws + WS_R + R_Y) + ((size_t)(bh >> 2) * SEQ + qt * 256 + wave * 32) * DM + 512 + (bh & 3) * 64;
    flash_item<96, 64, 64, 2>(lds, Q, 96, K, 96, VT, 64, 4096, y, DM, 4 * qt + 4, 4 * qt + (wave >> 1) + 1, tid, lane);
}
__device__ __forceinline__ void xa_item(const Params& P, int l, LAS unsigned char* lds, int it, int tid, int wave, int lane) {
    const int qt = it & 15, h = (it >> 4) & 3, b = it >> 6;
    const size_t qoff = ((size_t)b * SEQ + qt * 128 + wave * 16) * DM + h * 256;
    const bf16_t* Q = (const bf16_t*)(P.ws + WS_R) + qoff; bf16_t* O = (bf16_t*)(P.ws + WS_R + R_OX) + qoff;
    const bf16_t* K = (const bf16_t*)(P.ws + WS_KVM + (size_t)l * KVM_LAYER) + (size_t)b * NMEM * DM + h * 256;
    const bf16_t* VT = (const bf16_t*)(P.ws + WS_KVM + (size_t)l * KVM_LAYER + (size_t)4096 * 1024 * 2) + (size_t)h * 256 * 4096 + b * NMEM;
    flash_item<256, 256, 32, 1>(lds, Q, DM, K, DM, VT, 4096, 32, O, DM, 8, 8, tid, lane);
}

constexpr int GP_KN = 0, GP_KB = 9216, GP_QN = 18432, GP_L = 9216, GP_RHS = 27648, GP_G = 60416, GP_GC = 60672, GP_HEAD = 61440;
__device__ __forceinline__ bf16_t* gdn_buf(const Params& P, int chh, int k) { return (bf16_t*)(P.ws + WS_GDN) + ((size_t)chh * 5 + k) * 4096; }
__device__ __forceinline__ void gdn_pre_item(const Params& P, int l, LAS unsigned char* lds, int it, int tid) {
    const int hp = it & 1, n = (it >> 1) & 31, b = it >> 6;
    const int hh = tid >> 8, h = 2 * hp + hh, tt = tid & 255, c = tt >> 2, qr = tt & 3, lane = tid & 63;
    LAS unsigned char* L = lds + hh * GP_HEAD;
    const bf16_t* z = (const bf16_t*)(P.ws + WS_R);
    const int s = n * 64 + c; const size_t tok = (size_t)b * SEQ + s;
    const float* cw = P.gdn_conv_w + (size_t)l * 4 * 768;
    const int chh = (b * NCHUNK + n) * 4 + h;
    float q[16], k[16], v[16];
#pragma unroll
    for (int part = 0; part < 3; ++part) {
        float* dst = part == 0 ? q : (part == 1 ? k : v);
        const int ch0 = part * 256 + h * 64 + qr * 16;
#pragma unroll
        for (int i = 0; i < 16; ++i) dst[i] = 0.f;
#pragma unroll
        for (int kk = 0; kk < 4; ++kk) { {
            const bool okk = s - 3 + kk >= 0; const float mk = okk ? 1.f : 0.f;
            const bf16_t* zr = z + (okk ? tok - 3 + kk : tok) * ZP + Z_GQKV + ch0; const u32x4 w0 = *(const u32x4*)zr, w1 = *(const u32x4*)(zr + 8);
            const float* wr = cw + kk * 768 + ch0; const f32x4 c0 = *(const f32x4*)wr * mk, c1 = *(const f32x4*)(wr + 4) * mk, c2 = *(const f32x4*)(wr + 8) * mk, c3 = *(const f32x4*)(wr + 12) * mk;
            dst[0] += c0.x * bflo(w0.x); dst[1] += c0.y * bfhi(w0.x); dst[2] += c0.z * bflo(w0.y); dst[3] += c0.w * bfhi(w0.y);
            dst[4] += c1.x * bflo(w0.z); dst[5] += c1.y * bfhi(w0.z); dst[6] += c1.z * bflo(w0.w); dst[7] += c1.w * bfhi(w0.w);
            dst[8] += c2.x * bflo(w1.x); dst[9] += c2.y * bfhi(w1.x); dst[10] += c2.z * bflo(w1.y); dst[11] += c2.w * bfhi(w1.y);
            dst[12] += c3.x * bflo(w1.z); dst[13] += c3.y * bfhi(w1.z); dst[14] += c3.z * bflo(w1.w); dst[15] += c3.w * bfhi(w1.w); } }
#pragma unroll
        for (int i = 0; i < 16; ++i) dst[i] = siluf_(dst[i]);
    }
    float sq = 0.f, sk = 0.f;
#pragma unroll
    for (int i = 0; i < 16; ++i) { sq += q[i] * q[i]; sk += k[i] * k[i]; }
    sq += __shfl_xor(sq, 1); sq += __shfl_xor(sq, 2); sk += __shfl_xor(sk, 1); sk += __shfl_xor(sk, 2);
    const float rq = frsq_(sq + EPS) * 0.125f, rk = frsq_(sk + EPS);
    const bf16_t* zt = z + tok * ZP;
    const float beta = sigmoidf_(bf2f(zt[Z_GB + h]));
    const float g = -fexp_(P.gdn_a_log[l * 4 + h]) * softplusf_(bf2f(zt[Z_GA + h]) + P.gdn_dt_bias[l * 4 + h]);
    {
        u32x4 w0, w1;
#define PK16(dst0, dst1, src, sc) do { dst0.x = pk2(src[0] * (sc), src[1] * (sc)); dst0.y = pk2(src[2] * (sc), src[3] * (sc)); dst0.z = pk2(src[4] * (sc), src[5] * (sc)); dst0.w = pk2(src[6] * (sc), src[7] * (sc)); \
        dst1.x = pk2(src[8] * (sc), src[9] * (sc)); dst1.y = pk2(src[10] * (sc), src[11] * (sc)); dst1.z = pk2(src[12] * (sc), src[13] * (sc)); dst1.w = pk2(src[14] * (sc), src[15] * (sc)); } while (0)
        PK16(w0, w1, k, rk);        *(LAS u32x4*)(L + GP_KN + (c * 72 + qr * 16) * 2) = w0; *(LAS u32x4*)(L + GP_KN + (c * 72 + qr * 16 + 8) * 2) = w1;
        PK16(w0, w1, k, rk * beta); *(LAS u32x4*)(L + GP_KB + (c * 72 + qr * 16) * 2) = w0; *(LAS u32x4*)(L + GP_KB + (c * 72 + qr * 16 + 8) * 2) = w1;
        PK16(w0, w1, q, rq);        *(LAS u32x4*)(L + GP_QN + (c * 72 + qr * 16) * 2) = w0; *(LAS u32x4*)(L + GP_QN + (c * 72 + qr * 16 + 8) * 2) = w1;
        LAS float* rhs = (LAS float*)(L + GP_RHS) + c * 128 + qr * 16;
#pragma unroll
        for (int i = 0; i < 4; ++i) *(LAS f32x4*)(rhs + 4 * i) = (f32x4){v[4 * i] * beta, v[4 * i + 1] * beta, v[4 * i + 2] * beta, v[4 * i + 3] * beta};
        if (qr == 0) ((LAS float*)(L + GP_G))[c] = g;
    }
    __syncthreads();
    {
        float gc = 0.f, run = 0.f; const LAS float* G = (const LAS float*)(L + GP_G);
        for (int i = 0; i < 64; ++i) { run += G[i]; gc = (i == c) ? run : gc; }
        const float eg = fexp_(gc), ek = fexp_(run - gc);
        LAS float* rhs = (LAS float*)(L + GP_RHS) + c * 128 + 64 + qr * 16;
#pragma unroll
        for (int i = 0; i < 4; ++i) *(LAS f32x4*)(rhs + 4 * i) = (f32x4){k[4 * i] * rk * beta * eg, k[4 * i + 1] * rk * beta * eg, k[4 * i + 2] * rk * beta * eg, k[4 * i + 3] * rk * beta * eg};
        u32x4 w0, w1; PK16(w0, w1, q, rq * eg);
        bf16_t* qd = gdn_buf(P, chh, 3) + c * 64 + qr * 16; *(u32x4*)qd = w0; *(u32x4*)(qd + 8) = w1;
        bf16_t* kdt = gdn_buf(P, chh, 4) + (qr * 16) * 64 + c;
#pragma unroll
        for (int i = 0; i < 16; ++i) kdt[i * 64] = f2bf(k[i] * rk * ek);
        if (qr == 0) ((LAS float*)(L + GP_GC))[c] = gc;
        if (tt == 0) ((float*)(P.ws + WS_GL))[chh] = fexp_(run);
    }
#undef PK16
    __syncthreads();
    {
        const int it4 = (tid >> 6) & 3, fr = lane & 15, fq = lane >> 4;
        const LAS bf16_t* Kn = (const LAS bf16_t*)(L + GP_KN); const LAS bf16_t* KB = (const LAS bf16_t*)(L + GP_KB); const LAS bf16_t* Qn = (const LAS bf16_t*)(L + GP_QN);
        const LAS float* GC = (const LAS float*)(L + GP_GC);
        const bf16x8 a0 = *(const LAS bf16x8*)(KB + (it4 * 16 + fr) * 72 + 8 * fq), a1 = *(const LAS bf16x8*)(KB + (it4 * 16 + fr) * 72 + 32 + 8 * fq);
        const bf16x8 q0 = *(const LAS bf16x8*)(Qn + (it4 * 16 + fr) * 72 + 8 * fq), q1 = *(const LAS bf16x8*)(Qn + (it4 * 16 + fr) * 72 + 32 + 8 * fq);
        float gci[4];
#pragma unroll
        for (int r = 0; r < 4; ++r) gci[r] = GC[it4 * 16 + 4 * fq + r];
        f32x4 lv[4]; bf16_t* att = gdn_buf(P, chh, 2);
#pragma unroll
        for (int jt = 0; jt < 4; ++jt) {
            const bf16x8 b0 = *(const LAS bf16x8*)(Kn + (jt * 16 + fr) * 72 + 8 * fq), b1 = *(const LAS bf16x8*)(Kn + (jt * 16 + fr) * 72 + 32 + 8 * fq);
            f32x4 al = {0.f, 0.f, 0.f, 0.f}, aa = {0.f, 0.f, 0.f, 0.f};
            al = mfma16(a0, b0, al); al = mfma16(a1, b1, al); aa = mfma16(q0, b0, aa); aa = mfma16(q1, b1, aa);
            const int j = jt * 16 + fr; const float gcj = GC[j];
#pragma unroll
            for (int r = 0; r < 4; ++r) { const int i = it4 * 16 + 4 * fq + r; const float dec = fexp_(fminf(gci[r] - gcj, 0.f));
                lv[jt][r] = (i > j) ? al[r] * dec : 0.f; att[i * 64 + j] = f2bf((i >= j) ? aa[r] * dec : 0.f); }
        }
        __syncthreads();
        LAS float* Lm = (LAS float*)(L + GP_L);
#pragma unroll
        for (int jt = 0; jt < 4; ++jt)
#pragma unroll
            for (int r = 0; r < 4; ++r) Lm[(it4 * 16 + 4 * fq + r) * 64 + jt * 16 + fr] = lv[jt][r];
    }
    __syncthreads();
    if (tt < 128) {
        const LAS float* Lm = (const LAS float*)(L + GP_L); const LAS float* rhs = (const LAS float*)(L + GP_RHS) + tt;
        float x[64];
#pragma unroll
        for (int i = 0; i < 64; ++i) {
            float a0 = rhs[i * 128], a1 = 0.f;
#pragma unroll
            for (int j4 = 0; j4 < (i + 3) / 4; ++j4) { const f32x4 lr = *(const LAS f32x4*)(Lm + i * 64 + 4 * j4);
                if (4 * j4 + 0 < i) a0 -= lr.x * x[4 * j4 + 0]; if (4 * j4 + 1 < i) a1 -= lr.y * x[4 * j4 + 1];
                if (4 * j4 + 2 < i) a0 -= lr.z * x[4 * j4 + 2]; if (4 * j4 + 3 < i) a1 -= lr.w * x[4 * j4 + 3]; }
            x[i] = a0 + a1;
        }
        if (tt < 64) { bf16_t* ut = gdn_buf(P, chh, 1) + tt * 64;
#pragma unroll
            for (int g8 = 0; g8 < 8; ++g8) { u32x4 w; w.x = pk2(x[8 * g8], x[8 * g8 + 1]); w.y = pk2(x[8 * g8 + 2], x[8 * g8 + 3]); w.z = pk2(x[8 * g8 + 4], x[8 * g8 + 5]); w.w = pk2(x[8 * g8 + 6], x[8 * g8 + 7]); *(u32x4*)(ut + 8 * g8) = w; }
        } else { bf16_t* wo = gdn_buf(P, chh, 0) + (tt - 64);
#pragma unroll
            for (int i = 0; i < 64; ++i) wo[i * 64] = f2bf(x[i]); }
    }
    __syncthreads();
}

constexpr int GC_W = 0, GC_UT = 9216, GC_ATT = 18432, GC_QD = 27648, GC_KDT = 36864, GC_O = 46080, GC_BH = 62720;
__device__ __forceinline__ bf16x8 lds_perm(const LAS unsigned char* M, int row, int s, int fq) { const LAS unsigned char* p = M + row * 144 + 64 * s + 8 * fq; return mk8(*(const LAS u32x2*)p, *(const LAS u32x2*)(p + 32)); }
__device__ __forceinline__ void gdn_chain_item(const Params& P, int l, LAS unsigned char* lds, int gi, int tid, int wave, int lane) {
    const int q2 = wave >> 2, bh = gi * 2 + q2, eb = wave & 3, b = bh >> 2, h = bh & 3, fr = lane & 15, fq = lane >> 4;
    const bf16_t* z = (const bf16_t*)(P.ws + WS_R); bf16_t* y = (bf16_t*)(P.ws + WS_R + R_Y);
    LAS unsigned char* L = lds + q2 * GC_BH;
    const int tt = tid & 255, ec = tt >> 2, eq = tt & 3;
    float ng[16];
#pragma unroll
    for (int j = 0; j < 16; ++j) ng[j] = P.gdn_norm[l * 64 + eq * 16 + j];
    u32x4 stg[10];
    const bf16_t* src0[2] = { gdn_buf(P, ((gi * 2 >> 2) * NCHUNK) * 4 + ((gi * 2) & 3), 0), gdn_buf(P, (((gi * 2 + 1) >> 2) * NCHUNK) * 4 + ((gi * 2 + 1) & 3), 0) };
#define GC_LOAD(n_) do { _Pragma("unroll") for (int i = 0; i < 10; ++i) { const int p = tid + 512 * i, qq = p / 2560, pp = p % 2560; \
        stg[i] = *(const u32x4*)(src0[qq] + (size_t)(n_) * 4 * 5 * 4096 + (size_t)pp * 8); } } while (0)
#define GC_WRITE() do { _Pragma("unroll") for (int i = 0; i < 10; ++i) { const int p = tid + 512 * i, qq = p / 2560, pp = p % 2560, mat = pp >> 9, row = (pp & 511) >> 3, pc = pp & 7; \
        *(LAS u32x4*)(lds + qq * GC_BH + mat * 9216 + row * 144 + pc * 16) = stg[i]; } } while (0)
    GC_LOAD(0); GC_WRITE();
    f32x4 S[4];
#pragma unroll
    for (int t = 0; t < 4; ++t) S[t] = (f32x4){0.f, 0.f, 0.f, 0.f};
    __syncthreads();
    for (int n = 0; n < NCHUNK; ++n) {
        const int chh = (b * NCHUNK + n) * 4 + h;
        if (n + 1 < NCHUNK) GC_LOAD(n + 1);
        const size_t etok = (size_t)(gi * 2 + (tid >> 8) >> 2) * SEQ + n * 64 + ec; const int eh = (gi * 2 + (tid >> 8)) & 3;
        const u32x4 gw0 = *(const u32x4*)(z + etok * ZP + Z_GG + eh * 64 + eq * 16), gw1 = *(const u32x4*)(z + etok * ZP + Z_GG + eh * 64 + eq * 16 + 8);
        const float egl = ((const float*)(P.ws + WS_GL))[chh];
        const bf16x8 sb0 = pack8(S[0], S[1]), sb1 = pack8(S[2], S[3]);
        f32x4 vn[4], o[4];
#pragma unroll
        for (int ct = 0; ct < 4; ++ct) {
            f32x4 a = {0.f, 0.f, 0.f, 0.f}; a = mfma16(lds_perm(L + GC_W, ct * 16 + fr, 0, fq), sb0, a); a = mfma16(lds_perm(L + GC_W, ct * 16 + fr, 1, fq), sb1, a);
            const u32x2 uw = *(const LAS u32x2*)(L + GC_UT + (eb * 16 + fr) * 144 + (ct * 16 + 4 * fq) * 2);
            vn[ct] = (f32x4){bflo(uw.x) - a.x, bfhi(uw.x) - a.y, bflo(uw.y) - a.z, bfhi(uw.y) - a.w};
            f32x4 oo = {0.f, 0.f, 0.f, 0.f}; oo = mfma16(lds_perm(L + GC_QD, ct * 16 + fr, 0, fq), sb0, oo); oo = mfma16(lds_perm(L + GC_QD, ct * 16 + fr, 1, fq), sb1, oo); o[ct] = oo;
        }
        const bf16x8 vb0 = pack8(vn[0], vn[1]), vb1 = pack8(vn[2], vn[3]);
#pragma unroll
        for (int ct = 0; ct < 4; ++ct) { o[ct] = mfma16(lds_perm(L + GC_ATT, ct * 16 + fr, 0, fq), vb0, o[ct]); o[ct] = mfma16(lds_perm(L + GC_ATT, ct * 16 + fr, 1, fq), vb1, o[ct]); }
#pragma unroll
        for (int dt = 0; dt < 4; ++dt) { f32x4 a = S[dt] * egl; a = mfma16(lds_perm(L + GC_KDT, dt * 16 + fr, 0, fq), vb0, a); a = mfma16(lds_perm(L + GC_KDT, dt * 16 + fr, 1, fq), vb1, a); S[dt] = a; }
        LAS float* Ol = (LAS float*)(L + GC_O);
#pragma unroll
        for (int ct = 0; ct < 4; ++ct)
#pragma unroll
            for (int r = 0; r < 4; ++r) Ol[(ct * 16 + 4 * fq + r) * 65 + eb * 16 + fr] = o[ct][r];
        __syncthreads();
        if (n + 1 < NCHUNK) GC_WRITE();
        {
            const LAS float* orow = (const LAS float*)(lds + (tid >> 8) * GC_BH + GC_O) + ec * 65 + eq * 16;
            float ov[16]; float s2 = 0.f;
#pragma unroll
            for (int j = 0; j < 16; ++j) { ov[j] = orow[j]; s2 += ov[j] * ov[j]; }
            s2 += __shfl_xor(s2, 1); s2 += __shfl_xor(s2, 2);
            const float rs = frsq_(s2 * (1.0f / 64.0f) + EPS);
            const unsigned gws[8] = {gw0.x, gw0.y, gw0.z, gw0.w, gw1.x, gw1.y, gw1.z, gw1.w};
            unsigned ow[8];
#pragma unroll
            for (int j = 0; j < 8; ++j) ow[j] = pk2(ov[2 * j] * rs * ng[2 * j] * siluf_(bflo(gws[j])), ov[2 * j + 1] * rs * ng[2 * j + 1] * siluf_(bfhi(gws[j])));
            bf16_t* yp = y + etok * DM + 768 + eh * 64 + eq * 16;
            *(u32x4*)yp = (u32x4){ow[0], ow[1], ow[2], ow[3]}; *(u32x4*)(yp + 8) = (u32x4){ow[4], ow[5], ow[6], ow[7]};
        }
        __syncthreads();
    }
#undef GC_LOAD
#undef GC_WRITE
}

constexpr int RT_BUF = 36864, RT_Q = 0, RT_K = 9216, RT_KZT = 18432, RT_VT = 27648, RT_P = 73728, RT_ST = 82944, RT_O = 92160;
__device__ __forceinline__ void ret_chain_item(const Params& P, int l, LAS unsigned char* lds, int it, int tid, int wave, int lane) {
    const int b = it >> 2, h = it & 3, fr = lane & 15, fq = lane >> 4;
    const bf16_t* z = (const bf16_t*)(P.ws + WS_R); bf16_t* y = (bf16_t*)(P.ws + WS_R + R_Y);
    LAS bf16_t* Pm = (LAS bf16_t*)(lds + RT_P); LAS bf16_t* ST = (LAS bf16_t*)(lds + RT_ST); LAS float* Of = (LAS float*)(lds + RT_O);
    const float lg = log1pf(-exp2f(-5.0f - (float)h));
    const float cdec = fexp_(64.0f * lg);
    for (int i = tid; i < 64 * 72 / 2; i += 512) ((LAS unsigned*)ST)[i] = 0u;
    const int it4 = wave >> 1, jt0 = 2 * (wave & 1);
    f32x4 S[2] = {{0.f, 0.f, 0.f, 0.f}, {0.f, 0.f, 0.f, 0.f}};
    const int lc = tid >> 3, pg = tid & 7;
    float invf[4];
#pragma unroll
    for (int ii = 0; ii < 4; ++ii) invf[ii] = exp2f(-(float)(4 * pg + ii) * (13.287712379549449f / 32.0f));
    const float zeta = fexp_((63.0f - (float)lc) * lg);
    const f32x4 gn0 = *(const f32x4*)(P.ret_gn + l * 256 + h * 64 + 8 * pg), gn1 = *(const f32x4*)(P.ret_gn + l * 256 + h * 64 + 8 * pg + 4);
    const size_t tok0 = (size_t)b * SEQ + lc;
    u32x2 q1w, q2w, k1w, k2w; u32x4 vw; int posi;
#define RT_LOAD(n_) do { const bf16_t* zr_ = z + (tok0 + (n_) * 64) * ZP; q1w = *(const u32x2*)(zr_ + Z_RQ + h * 64 + 4 * pg); q2w = *(const u32x2*)(zr_ + Z_RQ + h * 64 + 32 + 4 * pg); \
        k1w = *(const u32x2*)(zr_ + Z_RK + h * 64 + 4 * pg); k2w = *(const u32x2*)(zr_ + Z_RK + h * 64 + 32 + 4 * pg); vw = *(const u32x4*)(zr_ + Z_RV + h * 64 + 8 * pg); posi = P.pos[tok0 + (n_) * 64]; } while (0)
#define RT_STAGE(buf_) do { LAS bf16_t* Qs_ = (LAS bf16_t*)(lds + (buf_) * RT_BUF + RT_Q); LAS bf16_t* Ks_ = (LAS bf16_t*)(lds + (buf_) * RT_BUF + RT_K); \
        LAS bf16_t* KzT_ = (LAS bf16_t*)(lds + (buf_) * RT_BUF + RT_KZT); LAS bf16_t* VT_ = (LAS bf16_t*)(lds + (buf_) * RT_BUF + RT_VT); const float pos = (float)posi; \
        const float q1[4] = {bflo(q1w.x), bfhi(q1w.x), bflo(q1w.y), bfhi(q1w.y)}, q2[4] = {bflo(q2w.x), bfhi(q2w.x), bflo(q2w.y), bfhi(q2w.y)}; \
        const float k1[4] = {bflo(k1w.x), bfhi(k1w.x), bflo(k1w.y), bfhi(k1w.y)}, k2[4] = {bflo(k2w.x), bfhi(k2w.x), bflo(k2w.y), bfhi(k2w.y)}; \
        float qa[4], qb[4], ka[4], kb[4]; \
        _Pragma("unroll") for (int ii = 0; ii < 4; ++ii) { float sn, cs; sincos_rev(pos * invf[ii], sn, cs); \
            qa[ii] = (q1[ii] * cs - q2[ii] * sn) * 0.125f; qb[ii] = (q1[ii] * sn + q2[ii] * cs) * 0.125f; ka[ii] = k1[ii] * cs - k2[ii] * sn; kb[ii] = k1[ii] * sn + k2[ii] * cs; } \
        u32x2 w_; w_.x = pk2(qa[0], qa[1]); w_.y = pk2(qa[2], qa[3]); *(LAS u32x2*)(Qs_ + lc * 72 + 4 * pg) = w_; \
        w_.x = pk2(qb[0], qb[1]); w_.y = pk2(qb[2], qb[3]); *(LAS u32x2*)(Qs_ + lc * 72 + 32 + 4 * pg) = w_; \
        w_.x = pk2(ka[0], ka[1]); w_.y = pk2(ka[2], ka[3]); *(LAS u32x2*)(Ks_ + lc * 72 + 4 * pg) = w_; \
        w_.x = pk2(kb[0], kb[1]); w_.y = pk2(kb[2], kb[3]); *(LAS u32x2*)(Ks_ + lc * 72 + 32 + 4 * pg) = w_; \
        _Pragma("unroll") for (int ii = 0; ii < 4; ++ii) { KzT_[(4 * pg + ii) * 72 + lc] = f2bf(ka[ii] * zeta); KzT_[(32 + 4 * pg + ii) * 72 + lc] = f2bf(kb[ii] * zeta); } \
        const unsigned vv[4] = {vw.x, vw.y, vw.z, vw.w}; \
        _Pragma("unroll") for (int ii = 0; ii < 4; ++ii) { VT_[(8 * pg + 2 * ii) * 72 + lc] = (bf16_t)(vv[ii] & 0xffffu); VT_[(8 * pg + 2 * ii + 1) * 72 + lc] = (bf16_t)(vv[ii] >> 16); } } while (0)
    RT_LOAD(0); RT_STAGE(0);
    __syncthreads();
    for (int n = 0; n < NCHUNK; ++n) {
        const int cb = n & 1;
        const LAS bf16_t* Qs = (const LAS bf16_t*)(lds + cb * RT_BUF + RT_Q); const LAS bf16_t* Ks = (const LAS bf16_t*)(lds + cb * RT_BUF + RT_K);
        const LAS bf16_t* KzT = (const LAS bf16_t*)(lds + cb * RT_BUF + RT_KZT); const LAS bf16_t* VT = (const LAS bf16_t*)(lds + cb * RT_BUF + RT_VT);
        const size_t tok = tok0 + n * 64;
        if (n + 1 < NCHUNK) RT_LOAD(n + 1);
        const u32x4 gw = *(const u32x4*)(z + tok * ZP + Z_RG + h * 64 + 8 * pg);
        const bf16x8 a0 = *(const LAS bf16x8*)(Qs + (it4 * 16 + fr) * 72 + 8 * fq), a1 = *(const LAS bf16x8*)(Qs + (it4 * 16 + fr) * 72 + 32 + 8 * fq);
        f32x4 cross[2];
#pragma unroll
        for (int t = 0; t < 2; ++t) { const int jt = jt0 + t;
            f32x4 p = {0.f, 0.f, 0.f, 0.f};
            p = mfma16(a0, *(const LAS bf16x8*)(Ks + (jt * 16 + fr) * 72 + 8 * fq), p); p = mfma16(a1, *(const LAS bf16x8*)(Ks + (jt * 16 + fr) * 72 + 32 + 8 * fq), p);
            f32x4 cr = {0.f, 0.f, 0.f, 0.f};
            cr = mfma16(a0, *(const LAS bf16x8*)(ST + (jt * 16 + fr) * 72 + 8 * fq), cr); cr = mfma16(a1, *(const LAS bf16x8*)(ST + (jt * 16 + fr) * 72 + 32 + 8 * fq), cr);
#pragma unroll
            for (int r = 0; r < 4; ++r) { const int i = it4 * 16 + 4 * fq + r, j = jt * 16 + fr; const int dd = i > j ? i - j : j - i;
                Pm[i * 72 + j] = f2bf(p[r] * fexp_((float)dd * lg)); cr[r] *= fexp_((float)(i + 1) * lg); }
            cross[t] = cr; }
        __syncthreads();
        const bf16x8 p0 = *(const LAS bf16x8*)(Pm + (it4 * 16 + fr) * 72 + 8 * fq), p1 = *(const LAS bf16x8*)(Pm + (it4 * 16 + fr) * 72 + 32 + 8 * fq);
        const bf16x8 kz0 = *(const LAS bf16x8*)(KzT + (it4 * 16 + fr) * 72 + 8 * fq), kz1 = *(const LAS bf16x8*)(KzT + (it4 * 16 + fr) * 72 + 32 + 8 * fq);
#pragma unroll
        for (int t = 0; t < 2; ++t) { const int et = jt0 + t;
            const bf16x8 v0 = *(const LAS bf16x8*)(VT + (et * 16 + fr) * 72 + 8 * fq), v1 = *(const LAS bf16x8*)(VT + (et * 16 + fr) * 72 + 32 + 8 * fq);
            f32x4 o = cross[t]; o = mfma16(p0, v0, o); o = mfma16(p1, v1, o);
#pragma unroll
            for (int r = 0; r < 4; ++r) Of[(it4 * 16 + 4 * fq + r) * 65 + et * 16 + fr] = o[r];
            f32x4 sN = S[t] * cdec; sN = mfma16(kz0, v0, sN); sN = mfma16(kz1, v1, sN); S[t] = sN;
            u32x2 w; w.x = pk2(sN.x, sN.y); w.y = pk2(sN.z, sN.w); *(LAS u32x2*)(ST + (et * 16 + fr) * 72 + it4 * 16 + 4 * fq) = w; }
        if (n + 1 < NCHUNK) RT_STAGE(cb ^ 1);
        __syncthreads();
        {
            float ov[8]; float sm = 0.f;
#pragma unroll
            for (int j = 0; j < 8; ++j) { ov[j] = Of[lc * 65 + 8 * pg + j]; sm += ov[j]; }
            sm += __shfl_xor(sm, 1); sm += __shfl_xor(sm, 2); sm += __shfl_xor(sm, 4);
            const float mu = sm * (1.0f / 64.0f); float vs = 0.f;
#pragma unroll
            for (int j = 0; j < 8; ++j) { ov[j] -= mu; vs += ov[j] * ov[j]; }
            vs += __shfl_xor(vs, 1); vs += __shfl_xor(vs, 2); vs += __shfl_xor(vs, 4);
            const float rs = frsq_(vs * (1.0f / 64.0f) + EPS);
            const float gt[8] = {bflo(gw.x), bfhi(gw.x), bflo(gw.y), bfhi(gw.y), bflo(gw.z), bfhi(gw.z), bflo(gw.w), bfhi(gw.w)};
            const float gnv[8] = {gn0.x, gn0.y, gn0.z, gn0.w, gn1.x, gn1.y, gn1.z, gn1.w};
            float r8[8];
#pragma unroll
            for (int j = 0; j < 8; ++j) r8[j] = ov[j] * rs * gnv[j] * siluf_(gt[j]);
            u32x4 w; w.x = pk2(r8[0], r8[1]); w.y = pk2(r8[2], r8[3]); w.z = pk2(r8[4], r8[5]); w.w = pk2(r8[6], r8[7]);
            *(u32x4*)(y + tok * DM + h * 64 + 8 * pg) = w;
        }
    }
#undef RT_LOAD
#undef RT_STAGE
    __syncthreads();
}

constexpr int LR_XC = 0, LR_AU = 33792;
__device__ __forceinline__ void lru_item(const Params& P, int l, LAS unsigned char* lds, int it, int mode, int tid, int wave, int lane) {
    const int b = it >> 5, n = it & 31, fr = lane & 15, fq = lane >> 4;
    const bf16_t* z = (const bf16_t*)(P.ws + WS_R); bf16_t* y = (bf16_t*)(P.ws + WS_R + R_Y);
    LAS bf16_t* XC = (LAS bf16_t*)(lds + LR_XC); LAS f32x2* AU = (LAS f32x2*)(lds + LR_AU);
    float* sumA = (float*)(P.ws + WS_LRUS); float* sumH = sumA + 16 * 32 * 256;
    {
        const int c = tid >> 3, cg = tid & 7, s = n * 64 + c; const size_t tok = (size_t)b * SEQ + s;
        const float* cw = P.lru_conv_w + (size_t)l * 4 * 256; const float* cb = P.lru_conv_b + l * 256;
#pragma unroll
        for (int g = 0; g < 4; ++g) { const int ch0 = cg * 32 + g * 8;
            const f32x4 b0 = *(const f32x4*)(cb + ch0), b1 = *(const f32x4*)(cb + ch0 + 4);
            float a[8] = {b0.x, b0.y, b0.z, b0.w, b1.x, b1.y, b1.z, b1.w};
#pragma unroll
            for (int kk = 0; kk < 4; ++kk) { const bool okk = s - 3 + kk >= 0; const float mk = okk ? 1.f : 0.f;
                const u32x4 w = *(const u32x4*)(z + (okk ? tok - 3 + kk : tok) * ZP + Z_LX + ch0);
                const f32x4 c0 = *(const f32x4*)(cw + kk * 256 + ch0) * mk, c1 = *(const f32x4*)(cw + kk * 256 + ch0 + 4) * mk;
                a[0] += c0.x * bflo(w.x); a[1] += c0.y * bfhi(w.x); a[2] += c0.z * bflo(w.y); a[3] += c0.w * bfhi(w.y);
                a[4] += c1.x * bflo(w.z); a[5] += c1.y * bfhi(w.z); a[6] += c1.z * bflo(w.w); a[7] += c1.w * bfhi(w.w); }
            u32x4 o; o.x = pk2(a[0], a[1]); o.y = pk2(a[2], a[3]); o.z = pk2(a[4], a[5]); o.w = pk2(a[6], a[7]);
            *(LAS u32x4*)(XC + c * 264 + ch0) = o; }
    }
    float hcar = 0.f, aprod = 1.f;
    if (mode == 1 && tid < 256) {
        float av[32], hv[32];
#pragma unroll
        for (int m = 0; m < 32; ++m) { const int mm = m < n ? m : 0; av[m] = sumA[(b * 32 + mm) * 256 + tid]; hv[m] = sumH[(b * 32 + mm) * 256 + tid]; }
#pragma unroll
        for (int m = 0; m < 32; ++m) if (m < n) hcar = av[m] * hcar + hv[m];
    }
    const int nb = wave >> 1, rt = wave & 1;
    const bf16_t* wa = wl(P, l, W_A) + nb * 4096; const bf16_t* wx = wl(P, l, W_X) + nb * 4096;
    bf16x8 fa[4][2], fx[4][2]; float ba[4], bx[4], spl[4];
#pragma unroll
    for (int dt = 0; dt < 4; ++dt) {
#pragma unroll
        for (int s = 0; s < 2; ++s) { fa[dt][s] = *(const bf16x8*)(wa + (dt * 16 + fr) * 64 + 32 * s + 8 * fq); fx[dt][s] = *(const bf16x8*)(wx + (dt * 16 + fr) * 64 + 32 * s + 8 * fq); }
        const int d = nb * 64 + dt * 16 + fr; ba[dt] = P.lru_ba[l * 256 + d]; bx[dt] = P.lru_bx[l * 256 + d]; spl[dt] = -8.0f * softplusf_(-P.lru_lambda[l * 256 + d]); }
    __syncthreads();
    for (int half = 0; half < 2; ++half) {
        const int trow = half * 32 + rt * 16;
        const bf16x8 x0 = *(const LAS bf16x8*)(XC + (trow + fr) * 264 + nb * 64 + 8 * fq), x1 = *(const LAS bf16x8*)(XC + (trow + fr) * 264 + nb * 64 + 32 + 8 * fq);
#pragma unroll
        for (int dt = 0; dt < 4; ++dt) {
            f32x4 ar = {0.f, 0.f, 0.f, 0.f}, ai = {0.f, 0.f, 0.f, 0.f};
            ar = mfma16(x0, fa[dt][0], ar); ar = mfma16(x1, fa[dt][1], ar); ai = mfma16(x0, fx[dt][0], ai); ai = mfma16(x1, fx[dt][1], ai);
            const int d = nb * 64 + dt * 16 + fr;
#pragma unroll
            for (int r = 0; r < 4; ++r) { const int tl = rt * 16 + 4 * fq + r;
                const float xcv = bf2f(XC[(half * 32 + tl) * 264 + d]);
                const float rr = sigmoidf_(ar[r] + ba[dt]), ii = sigmoidf_(ai[r] + bx[dt]);
                const float a = fexp_(rr * spl[dt]);
                const float u = fsqrt_(fmaxf(1.0f - a * a, 0.f)) * (ii * xcv);
                AU[tl * 257 + d] = (f32x2){a, u}; }
        }
        __syncthreads();
        if (tid < 256) {
#pragma unroll 8
            for (int tk = 0; tk < 32; ++tk) { const f32x2 au = AU[tk * 257 + tid]; hcar = au.x * hcar + au.y; aprod *= au.x; if (mode == 1) AU[tk * 257 + tid].y = hcar; }
        }
        if (mode == 1) {
            __syncthreads();
            const int tk = tid >> 4, c0 = (tid & 15) * 16; const size_t tok = (size_t)b * SEQ + n * 64 + half * 32 + tk;
            const u32x4 g0 = *(const u32x4*)(z + tok * ZP + Z_LG + c0), g1 = *(const u32x4*)(z + tok * ZP + Z_LG + c0 + 8);
            const unsigned gws[8] = {g0.x, g0.y, g0.z, g0.w, g1.x, g1.y, g1.z, g1.w}; unsigned ow[8];
#pragma unroll
            for (int j = 0; j < 8; ++j) { const float h0 = AU[tk * 257 + c0 + 2 * j].y, h1 = AU[tk * 257 + c0 + 2 * j + 1].y; ow[j] = pk2(h0 * geluf_(bflo(gws[j])), h1 * geluf_(bfhi(gws[j]))); }
            bf16_t* yp = y + tok * DM + 256 + c0;
            *(u32x4*)yp = (u32x4){ow[0], ow[1], ow[2], ow[3]}; *(u32x4*)(yp + 8) = (u32x4){ow[4], ow[5], ow[6], ow[7]};
        }
        __syncthreads();
    }
    if (mode == 0 && tid < 256) { sumA[(b * 32 + n) * 256 + tid] = aprod; sumH[(b * 32 + n) * 256 + tid] = hcar; }
}

constexpr int N_PHASES = 21;
constexpr int Q_RET = 64, Q_GDN = 32, Q_LRU = 512, Q_MLA = 512, Q_TOTAL = Q_RET + Q_GDN + Q_LRU + Q_MLA;

__global__ void __launch_bounds__(512, 2) hymba_fwd(Params P_) {
    extern __shared__ __attribute__((aligned(16))) unsigned char lds_raw[];
    LAS unsigned char* lds = (LAS unsigned char*)lds_raw;
    volatile LAS unsigned* LC = (volatile LAS unsigned*)(lds + LDS_CTL);
    const int G = gridDim.x;
#define SUB_TID() int tid2 = tid; asm volatile("" : "+v"(tid2)); const int lane2 = tid2 & 63, wave2 = __builtin_amdgcn_readfirstlane(tid2 >> 6); (void)lane2; (void)wave2
#if defined(__HIP_DEVICE_COMPILE__)
#define PH_PARAMS() const __attribute__((address_space(4))) Params* pp_ = (const __attribute__((address_space(4))) Params*)__builtin_amdgcn_kernarg_segment_ptr(); asm volatile("" : "+s"(pp_)); const Params P = *pp_
#else
#define PH_PARAMS() const Params P = P_
#endif
#define PH_TID() PH_PARAMS(); \
    bf16_t* xb = (bf16_t*)(P.ws + WS_XB); float* part = (float*)(P.ws + WS_PART); bf16_t* zb = (bf16_t*)(P.ws + WS_R); bf16_t* yb = (bf16_t*)(P.ws + WS_R + R_Y); bf16_t* oxb = (bf16_t*)(P.ws + WS_R + R_OX); (void)xb; (void)part; (void)zb; (void)yb; (void)oxb; \
    int tid = threadIdx.x; asm volatile("" : "+v"(tid)); const int lane = tid & 63, wave = __builtin_amdgcn_readfirstlane(tid >> 6); (void)lane; (void)wave
    unsigned* ctl = (unsigned*)(P_.ws + WS_CTL);
    if (threadIdx.x < 64) LC[threadIdx.x] = 0u;
    __syncthreads();
    const int lo = P_.ph_lo, hi = P_.ph_hi;
    XcdBarrier bar; bar.bar = ctl + CW_BAR; bar.x = 0; bar.st = LC;
    if (hi - lo > 1) bar = xcd_barrier_post(ctl + CW_BAR, LC);
#ifndef PHASE_MASK
#define PHASE_MASK 0xFFFFFFFFu
#endif
#define EN(t) ((PHASE_MASK >> (t)) & 1u)
#ifndef REPEAT_MASK
#define REPEAT_MASK 0u
#endif
#define REP(t) for (int rep_ = 0; rep_ <= (int)((REPEAT_MASK >> (t)) & 1u); ++rep_, (rep_ <= (int)((REPEAT_MASK >> (t)) & 1u) ? xcd_barrier(bar) : (void)0))
#define IN(k) (lo <= (k) && (k) < hi)
#define SEAM(k) do { if (IN(k) && IN((k) + 1)) xcd_barrier(bar); } while (0)


    if (IN(0) && EN(0)) REP(0) { PH_TID(); p0_prologue(P, lds, tid); __syncthreads(); }
    SEAM(0);
    if (IN(1) && EN(1)) REP(1) {
        PH_TID();
        const int which = blockIdx.x >> 6, l = which >> 1, isv = which & 1;
        if (which < 4) {
            const bf16_t* memn = (const bf16_t*)(P.ws + WS_GDN); const bf16_t* wkv = wl(P, l, W_KV);
            bf16_t* kout = (bf16_t*)(P.ws + WS_KVM + (size_t)l * KVM_LAYER); bf16_t* vout = kout + (size_t)4096 * 1024;
            pg8::Gemm g; pg8::EpiScaleBf16<0> E; pg8::StaticOrder S;
            if (!isv) { g = pg8::Gemm{memn, wkv, 4096, 1024, 1024}; E = pg8::EpiScaleBf16<0>{kout, 1024, nullptr}; S.init(4096, 1024, 64, blockIdx.x & 63); }
            else { g = pg8::Gemm{wkv + (size_t)1024 * 1024, memn, 1024, 4096, 1024}; E = pg8::EpiScaleBf16<0>{vout, 4096, nullptr}; S.init(1024, 4096, 64, blockIdx.x & 63); }
            pg8::gemm_phase(lds, g, S, E, tid);
        }
    }
    SEAM(1);
#pragma unroll
    for (int l = 0; l < 2; ++l) {
        const int pb = 2 + 9 * l;
        if (IN(pb + 0) && EN(2)) REP(2) { PH_TID();
            pg8::Gemm g{xb, wl(P, l, W_IN), T_TOK, ZP, DM}; pg8::StaticOrder S; S.init(T_TOK, ZP, G, blockIdx.x);
            pg8::EpiScaleBf16<0> E{zb, ZP, part}; pg8::gemm_phase(lds, g, S, E, tid);
        }
        SEAM(pb + 0);
        if (IN(pb + 1)) {
            PH_TID();
            if (EN(3)) REP(3) { SUB_TID(); for (int it = blockIdx.x; it < 1024; it += G) gdn_pre_item(P, l, lds, it, tid2); }
            if (EN(4)) REP(4) { SUB_TID(); for (int it = blockIdx.x; it < 512; it += G) { lru_item(P, l, lds, it, 0, tid2, wave2, lane2); __syncthreads(); } }
            if (EN(5)) REP(5) { SUB_TID(); for (int rt = blockIdx.x * 8 + wave2; rt < 2048; rt += G * 8) mla_pre_tile(P, l, rt, lane2); }
        }
        SEAM(pb + 1);
        if (IN(pb + 2)) {
            PH_TID();
            for (int rep2_ = 0; rep2_ <= (int)((REPEAT_MASK >> 17) & 1u); ++rep2_, (rep2_ <= (int)((REPEAT_MASK >> 17) & 1u) ? xcd_barrier(bar) : (void)0)) {
            unsigned* qh0 = ctl + CW_QUEUE + 64 * l + 16 * rep2_;
#define QUEUE_LOOP(qi_, count_, body_) for (;;) { if (tid == 0) LC[4] = __hip_atomic_fetch_add(qh + (qi_), 1u, __ATOMIC_RELAXED, __HIP_MEMORY_SCOPE_AGENT); \
                __syncthreads(); const int it = (int)LC[4]; __syncthreads(); if (it >= (count_)) break; { SUB_TID(); body_; } __syncthreads(); }
            if (EN(6)) REP(6) { unsigned* qh = qh0 + 32 * rep_; QUEUE_LOOP(0, Q_RET, ret_chain_item(P, l, lds, it, tid2, wave2, lane2)) }
            if (EN(7)) REP(7) { unsigned* qh = qh0 + 32 * rep_; QUEUE_LOOP(1, Q_GDN, gdn_chain_item(P, l, lds, it, tid2, wave2, lane2)) }
            if (EN(8)) REP(8) { unsigned* qh = qh0 + 32 * rep_; QUEUE_LOOP(2, Q_LRU, lru_item(P, l, lds, it, 1, tid2, wave2, lane2)) }
            if (EN(9)) REP(9) { unsigned* qh = qh0 + 32 * rep_; QUEUE_LOOP(3, Q_MLA, mla_attn_item(P, lds, it, tid2, wave2, lane2)) }
#undef QUEUE_LOOP
            }
        }
        SEAM(pb + 2);
        if (IN(pb + 3) && EN(10)) REP(10) { PH_TID();
            pg8::Gemm g{yb, wl(P, l, W_OUT), T_TOK, DM, DM}; pg8::StaticOrder S; S.init(T_TOK, DM, G, blockIdx.x);
            pg8::EpiResid E{P.out, xb, part, rep_ ? 0.f : 1.f}; pg8::gemm_phase(lds, g, S, E, tid);
        }
        SEAM(pb + 3);
        if (IN(pb + 4) && EN(11)) REP(11) { PH_TID();
            pg8::Gemm g{xb, wl(P, l, W_Q), T_TOK, DM, DM}; pg8::StaticOrder S; S.init(T_TOK, DM, G, blockIdx.x);
            pg8::EpiScaleBf16<0> E{zb, DM, part}; pg8::gemm_phase(lds, g, S, E, tid);
        }
        SEAM(pb + 4);
        if (IN(pb + 5) && EN(12)) REP(12) { PH_TID(); for (int it = blockIdx.x; it < 1024; it += G) { xa_item(P, l, lds, it, tid, wave, lane); __syncthreads(); } }
        SEAM(pb + 5);
        if (IN(pb + 6) && EN(13)) REP(13) { PH_TID();
            pg8::Gemm g{oxb, wl(P, l, W_O), T_TOK, DM, DM}; pg8::StaticOrder S; S.init(T_TOK, DM, G, blockIdx.x);
            pg8::EpiResid E{P.out, xb, part, rep_ ? 0.f : 1.f}; pg8::gemm_phase(lds, g, S, E, tid);
        }
        SEAM(pb + 6);
        if (IN(pb + 7) && EN(14)) REP(14) { PH_TID();
            pg8::Gemm g{xb, wl(P, l, W_1), T_TOK, DFF, DM}; pg8::StaticOrder S; S.init(T_TOK, DFF, G, blockIdx.x);
            pg8::EpiScaleBf16<1> E{zb, DFF, part}; pg8::gemm_phase(lds, g, S, E, tid);
        }
        SEAM(pb + 7);
        if (IN(pb + 8) && EN(15)) REP(15) { PH_TID();
            pg8::Gemm g{zb, wl(P, l, W_2), T_TOK, DM, DFF}; pg8::StaticOrder S; S.init(T_TOK, DM, G, blockIdx.x);
            pg8::EpiResid E{P.out, xb, part, rep_ ? 0.f : 1.f}; pg8::gemm_phase(lds, g, S, E, tid);
        }
        SEAM(pb + 8);
    }
    if (IN(20) && EN(16)) { PH_TID(); final_norm_phase(P, tid); }
#undef IN
#undef SEAM
}

extern "C" void kernel_launch(void* const* d_in, const int* in_sizes, int n_in, void* d_out, int out_size, void* d_ws, size_t ws_size, hipStream_t stream) {
    static int grid = 0;
    if (grid == 0) {
        if (n_in != 31 || out_size != T_TOK * DM || ws_size < WS_END) { fprintf(stderr, "kernel_launch: unexpected shapes (n_in %d out %d ws %zu, need %zu)\n", n_in, out_size, ws_size, (size_t)WS_END); grid = -1; return; }
        if (hipFuncSetAttribute((const void*)hymba_fwd, hipFuncAttributeMaxDynamicSharedMemorySize, LDS_BYTES) != hipSuccess) { fprintf(stderr, "kernel_launch: hipFuncSetAttribute failed\n"); grid = -1; return; }
        int dev = 0, cus = 0, per_cu = 0;
        (void)hipGetDevice(&dev); (void)hipDeviceGetAttribute(&cus, hipDeviceAttributeMultiprocessorCount, dev);
        (void)hipOccupancyMaxActiveBlocksPerMultiprocessor(&per_cu, (const void*)hymba_fwd, 512, LDS_BYTES);
        (void)hipGetLastError();
        if (cus != 256 || per_cu < 1) fprintf(stderr, "kernel_launch: note: cus %d per_cu %d\n", cus, per_cu);
        grid = 256;
    }
    if (grid < 0) return;
    (void)hipMemsetAsync((char*)d_ws + WS_CTL, 0, CTL_BYTES, stream);
    Params p{};
    p.x = (const float*)d_in[0]; p.mem = (const float*)d_in[1]; p.pos = (const int*)d_in[2];
    p.norm_mix = (const float*)d_in[3]; p.w_in = (const float*)d_in[4]; p.ret_gn = (const float*)d_in[5];
    p.lru_conv_w = (const float*)d_in[6]; p.lru_conv_b = (const float*)d_in[7]; p.lru_wa = (const float*)d_in[8]; p.lru_ba = (const float*)d_in[9];
    p.lru_wx = (const float*)d_in[10]; p.lru_bx = (const float*)d_in[11]; p.lru_lambda = (const float*)d_in[12];
    p.mla_q_norm = (const float*)d_in[13]; p.mla_w_uq = (const float*)d_in[14]; p.mla_kv_norm = (const float*)d_in[15]; p.mla_w_ukv = (const float*)d_in[16];
    p.gdn_conv_w = (const float*)d_in[17]; p.gdn_a_log = (const float*)d_in[18]; p.gdn_dt_bias = (const float*)d_in[19]; p.gdn_norm = (const float*)d_in[20];
    p.w_out = (const float*)d_in[21]; p.norm_xattn = (const float*)d_in[22]; p.norm_mem = (const float*)d_in[23];
    p.xa_wq = (const float*)d_in[24]; p.xa_wkv = (const float*)d_in[25]; p.xa_wo = (const float*)d_in[26];
    p.norm_mlp = (const float*)d_in[27]; p.mlp_w1 = (const float*)d_in[28]; p.mlp_w2 = (const float*)d_in[29]; p.final_norm = (const float*)d_in[30];
    p.out = (float*)d_out; p.ws = (unsigned char*)d_ws;
#if N_LAUNCHES == 1
    p.ph_lo = 0; p.ph_hi = N_PHASES;
    void* args[] = {&p};
    hipError_t e = hipLaunchCooperativeKernel((const void*)hymba_fwd, dim3(grid), dim3(512), args, LDS_BYTES, stream);
    if (e != hipSuccess) fprintf(stderr, "kernel_launch: cooperative launch failed: %s\n", hipGetErrorString(e));
#else
    for (int ph = 0; ph < N_PHASES; ++ph) { p.ph_lo = ph; p.ph_hi = ph + 1; hipLaunchKernelGGL(hymba_fwd, dim3(grid), dim3(512), LDS_BYTES, stream, p); }
#endif
}
```

```cpp
#include <hip/hip_runtime.h>
#include <cstdio>
#include <cstdint>

#ifndef N_LAUNCHES
#define N_LAUNCHES 1
#endif

#define LAS __attribute__((address_space(3)))
typedef unsigned short bf16_t;
typedef short bf16x8 __attribute__((ext_vector_type(8)));
typedef float f32x4 __attribute__((ext_vector_type(4)));
typedef float f32x2 __attribute__((ext_vector_type(2)));
typedef unsigned u32x4 __attribute__((ext_vector_type(4)));
typedef unsigned u32x2 __attribute__((ext_vector_type(2)));

constexpr int T_TOK = 32768, DM = 1024, SEQ = 2048, NBATCH = 16, NCHUNK = 32, ZP = 3072, DFF = 4096, NMEM = 256;
constexpr int Z_RQ = 0, Z_RK = 256, Z_RV = 512, Z_RG = 768, Z_LX = 1024, Z_LG = 1280, Z_CQ = 1536, Z_CKV = 1728, Z_KR = 1856,
              Z_GQKV = 1888, Z_GG = 2656, Z_GB = 2912, Z_GA = 2916, IN_COLS = 2920;
constexpr float EPS = 1e-6f;
constexpr float LOG2E = 1.4426950408889634f;

constexpr size_t MiB = 1024 * 1024;
constexpr size_t WS_CTL = 0;
constexpr size_t CTL_BYTES = 65536;
constexpr size_t WS_PART = WS_CTL + CTL_BYTES;
constexpr size_t WS_LRUS = WS_PART + (size_t)T_TOK * 16 * 4;
constexpr size_t WS_GL = WS_LRUS + (size_t)2 * 16 * 32 * 256 * 4;
constexpr size_t WS_W = WS_GL + 65536;
constexpr size_t W_IN = 0, W_OUT = W_IN + (size_t)ZP * DM, W_Q = W_OUT + (size_t)DM * DM, W_KV = W_Q + (size_t)DM * DM, W_O = W_KV + (size_t)2 * DM * DM,
                 W_1 = W_O + (size_t)DM * DM, W_2 = W_1 + (size_t)DFF * DM, W_UQ = W_2 + (size_t)DFF * DM, W_UKV = W_UQ + 384 * 192, W_A = W_UKV + 512 * 128,
                 W_X = W_A + 4 * 64 * 64, W_LAYER = W_X + 4 * 64 * 64;
constexpr size_t WS_XB = WS_W + 2 * W_LAYER * 2;
constexpr size_t XB_BYTES = (size_t)T_TOK * DM * 2;
constexpr size_t MLA_Q_OFF = 0, MLA_K_OFF = (size_t)T_TOK * 4 * 96 * 2, MLA_VT_OFF = 2 * MLA_K_OFF;
constexpr size_t WS_KVM = WS_XB + XB_BYTES;
constexpr size_t KVM_LAYER = (size_t)2 * 4096 * 1024 * 2;
constexpr size_t WS_R = WS_KVM + 2 * KVM_LAYER;
constexpr size_t R_Y = (size_t)T_TOK * ZP * 2;
constexpr size_t R_OX = (size_t)T_TOK * DM * 2;
constexpr size_t WS_GDN = WS_R + 256 * MiB;
constexpr size_t WS_END = WS_GDN + 80 * MiB;
static_assert(WS_END <= 512 * MiB, "workspace map exceeds 512 MiB");
static_assert(WS_XB % 256 == 0 && WS_R % 256 == 0 && WS_GDN % 256 == 0 && WS_W % 256 == 0, "alignment");
constexpr int CW_BAR = 0;
constexpr int CW_QUEUE = 4096;

constexpr int LDS_BYTES = 160 * 1024;
constexpr int LDS_CTL = LDS_BYTES - 256;

typedef __bf16 bf16x2_t __attribute__((ext_vector_type(2)));
__device__ __forceinline__ unsigned pk2(float lo, float hi) { f32x2 t = {lo, hi}; bf16x2_t v = __builtin_convertvector(t, bf16x2_t); return __builtin_bit_cast(unsigned, v); }
__device__ __forceinline__ float bflo(unsigned w) { return __uint_as_float(w << 16); }
__device__ __forceinline__ float bfhi(unsigned w) { return __uint_as_float(w & 0xffff0000u); }
__device__ __forceinline__ float bf2f(bf16_t v) { return __uint_as_float((unsigned)v << 16); }
__device__ __forceinline__ bf16_t f2bf(float f) { return (bf16_t)(pk2(f, 0.f) & 0xffffu); }
__device__ __forceinline__ f32x4 mfma16(bf16x8 a, bf16x8 b, f32x4 c) { return __builtin_amdgcn_mfma_f32_16x16x32_bf16(a, b, c, 0, 0, 0); }
__device__ __forceinline__ float fexp2_(float x) { return __builtin_amdgcn_exp2f(x); }
__device__ __forceinline__ float fexp_(float x) { return __builtin_amdgcn_exp2f(x * LOG2E); }
__device__ __forceinline__ float frcp_(float x) { return __builtin_amdgcn_rcpf(x); }
__device__ __forceinline__ float frsq_(float x) { return __builtin_amdgcn_rsqf(x); }
__device__ __forceinline__ float fsqrt_(float x) { return __builtin_amdgcn_sqrtf(x); }
__device__ __forceinline__ float sigmoidf_(float x) { return frcp_(1.0f + fexp_(-x)); }
__device__ __forceinline__ float siluf_(float x) { return x * frcp_(1.0f + fexp_(-x)); }
__device__ __forceinline__ float softplusf_(float x) { return x > 20.f ? x : log1pf(__expf(x)); }
__device__ __forceinline__ float geluf_(float x) { const float u = 1.5957691216057308f * (x + 0.044715f * x * x * x); return x * frcp_(1.0f + fexp_(-u)); }
__device__ __forceinline__ float wave_sum(float v) {
#pragma unroll
    for (int o = 1; o < 64; o <<= 1) v += __shfl_xor(v, o);
    return v;
}
__device__ __forceinline__ void sincos_rev(float ang, float& s, float& c) {
    float rev = ang * 0.15915494309189535f; rev = rev - floorf(rev);
    s = __builtin_amdgcn_sinf(rev); c = __builtin_amdgcn_cosf(rev);
}
__device__ __forceinline__ bf16x8 mk8(u32x2 lo, u32x2 hi) { u32x4 t; t.x = lo.x; t.y = lo.y; t.z = hi.x; t.w = hi.y; return __builtin_bit_cast(bf16x8, t); }
__device__ __forceinline__ bf16x8 pack8(f32x4 a, f32x4 b) { u32x4 t; t.x = pk2(a.x, a.y); t.y = pk2(a.z, a.w); t.z = pk2(b.x, b.y); t.w = pk2(b.z, b.w); return __builtin_bit_cast(bf16x8, t); }

#define XB_TMO      128
#define XB_XCNT(j)  (256  + 64 * (j))
#define XB_XSUB(j)  (1280 + 64 * (j))
#define XB_XGEN(j)  (2304 + 64 * (j))
#define XB_TOP      3328
#define XB_TOPGEN   3392
#define XCD_BAR_WORDS 3456
#define XB_SPIN_CAP (1u << 22)
__device__ __forceinline__ unsigned xb_ld(unsigned* p)              { return __hip_atomic_load(p, __ATOMIC_RELAXED, __HIP_MEMORY_SCOPE_AGENT); }
__device__ __forceinline__ unsigned xb_add(unsigned* p, unsigned v) { return __hip_atomic_fetch_add(p, v, __ATOMIC_RELAXED, __HIP_MEMORY_SCOPE_AGENT); }
__device__ __forceinline__ unsigned xb_xcc_id() { return (unsigned)__builtin_amdgcn_s_getreg((3 << 11) | 20) & 0xFu; }
#define XB_SPIN(cond, bar) do { unsigned _sp = 0; while (cond) { __builtin_amdgcn_s_sleep(1); \
    if ((++_sp & 255u) == 0u) { if (xb_ld(&(bar)[XB_TMO])) break; if (_sp > XB_SPIN_CAP) { atomicAdd(&(bar)[XB_TMO], 1u); break; } } } } while (0)
struct XcdBarrier { unsigned* bar; unsigned x; volatile LAS unsigned* st; };
__device__ __forceinline__ XcdBarrier xcd_barrier_post(unsigned* bar, volatile LAS unsigned* st) {
    XcdBarrier b; b.bar = bar; b.x = xb_xcc_id(); b.st = st;
    if (threadIdx.x == 0) (void)xb_add(&bar[XB_XCNT(b.x)], 1u);
    return b;
}
__device__ __forceinline__ void xcd_barrier_complete(unsigned* bar, unsigned x, unsigned& nloc, unsigned& nx) {
    const unsigned G = gridDim.x * gridDim.y * gridDim.z;
    unsigned sum, cnt, mine, sp = 0u;
    for (;;) {
        sum = 0u; cnt = 0u; mine = 0u;
#pragma unroll
        for (unsigned j = 0; j < 16; ++j) { const unsigned c = xb_ld(&bar[XB_XCNT(j)]); sum += c; cnt += (c > 0u) ? 1u : 0u; mine = (j == x) ? c : mine; }
        if (sum == G) break;
        __builtin_amdgcn_s_sleep(1);
        if ((++sp & 255u) == 0u) { if (xb_ld(&bar[XB_TMO])) break; if (sp > XB_SPIN_CAP) { atomicAdd(&bar[XB_TMO], 1u); break; } }
    }
    nloc = mine > 0u ? mine : 1u; nx = cnt > 0u ? cnt : 1u;
}
__device__ __forceinline__ void xcd_barrier(const XcdBarrier& b) {
    asm volatile("s_waitcnt vmcnt(0)" ::: "memory");
    __syncthreads();
    if (threadIdx.x == 0) {
        unsigned* bar = b.bar;
        __builtin_amdgcn_s_waitcnt(0);
        unsigned nloc = b.st[0], nx = b.st[1];
        if (nloc == 0u) { xcd_barrier_complete(bar, b.x, nloc, nx); b.st[0] = nloc; b.st[1] = nx; }
        const unsigned old = xb_add(&bar[XB_XSUB(b.x)], 1u);
        const unsigned gen = old / nloc;
        if (old + 1u == (gen + 1u) * nloc) {
            __builtin_amdgcn_fence(__ATOMIC_RELEASE, "agent");
            asm volatile("s_waitcnt vmcnt(0)" ::: "memory");
            const unsigned og = xb_add(&bar[XB_TOP], 1u);
            const unsigned tg = og / nx;
            if (og + 1u == (tg + 1u) * nx) xb_add(&bar[XB_TOPGEN], 1u);
            else XB_SPIN(xb_ld(&bar[XB_TOPGEN]) == tg, bar);
            __builtin_amdgcn_fence(__ATOMIC_ACQUIRE, "agent");
            xb_add(&bar[XB_XGEN(b.x)], 1u);
            asm volatile("s_waitcnt vmcnt(0)" ::: "memory");
        } else {
            XB_SPIN(xb_ld(&bar[XB_XGEN(b.x)]) == gen, bar);
            __builtin_amdgcn_fence(__ATOMIC_ACQUIRE, "agent");
            asm volatile("s_waitcnt vmcnt(0)" ::: "memory");
        }
    }
    __syncthreads();
}

namespace pg8 {
constexpr int BM = 256, BK = 64, HALF = 128, HTB = HALF * BK * 2, STAGE_BYTES = 8 * HTB, NXCD = 8, WGM = 8;
__host__ __device__ __forceinline__ int lds_byte(int r, int c) { const int st = (r >> 4) * 2 + (c >> 5), rr = r & 15, cc = c & 31, ob = rr * 64 + cc * 2; return st * 1024 + (ob ^ (((ob >> 9) & 1) << 5)); }
__host__ __device__ __forceinline__ void stage_rc(int b, int& R, int& C) { const int st = b / 1024, sb = b % 1024, swz = sb ^ (((sb >> 9) & 1) << 5); R = (st >> 1) * 16 + swz / 64; C = (st & 1) * 32 + (swz % 64) / 2; }
__host__ __device__ __forceinline__ int perm32(int rho) { const int n = rho >> 4, i = rho & 15; return 8 * (i >> 2) + 4 * n + (i & 3); }
struct Unit { int pm, pn; };
struct Gemm { const bf16_t* A; const bf16_t* Bt; int M, N, K; };
struct StaticOrder {
    int nM, nN, nwg, G, c;
    __host__ __device__ void init(int M, int N, int G_, int c_) { nM = M / BM; nN = N / BM; nwg = nM * nN; G = G_; c = c_; }
    __host__ __device__ bool next(int i, Unit& u) const {
        const long L = (long)i * G + c; if (L >= nwg) return false;
        int wgid = (int)L; { const int q = nwg / NXCD, r = nwg % NXCD, xcd = wgid % NXCD, off = wgid / NXCD; wgid = (xcd < r ? xcd * (q + 1) : r * (q + 1) + (xcd - r) * q) + off; }
        const int nig = WGM * nN, gid = wgid / nig, fm = gid * WGM, gsz = (nM - fm) < WGM ? (nM - fm) : WGM;
        u.pm = fm + ((wgid % nig) % gsz); u.pn = (wgid % nig) / gsz; return true;
    }
    __device__ __forceinline__ void a_ready(const Unit&) const {}
    __device__ __forceinline__ void done(const Unit&) const {}
};

template <int ACT> struct EpiScaleBf16 {
    static constexpr bool PERM = true;
    bf16_t* O; int ldc; const float* part;
    __device__ __forceinline__ void operator()(const f32x4 (&acc)[2][2][4][2], const Unit& u, int wr, int wc, int fr, int fq) const {
        const int row0 = u.pm * BM + wr * 64 + fr, col0 = u.pn * BM + wc * 32 + 8 * fq;
#pragma unroll
        for (int ai = 0; ai < 2; ++ai)
#pragma unroll
            for (int m = 0; m < 4; ++m) {
                const int row = row0 + ai * HALF + m * 16;
                float sc = 1.0f;
                if (part) { const f32x4* pp = (const f32x4*)(part + (size_t)row * 16); const f32x4 a = pp[0], b = pp[1], c = pp[2], d = pp[3];
                    const float s = ((a.x + a.y) + (a.z + a.w)) + ((b.x + b.y) + (b.z + b.w)) + ((c.x + c.y) + (c.z + c.w)) + ((d.x + d.y) + (d.z + d.w));
                    sc = frsq_(s * (1.0f / 1024.0f) + EPS); }
                bf16_t* rowp = O + (size_t)row * ldc + col0;
#pragma unroll
                for (int bj = 0; bj < 2; ++bj) { f32x4 v0 = acc[ai][bj][m][0] * sc, v1 = acc[ai][bj][m][1] * sc;
                    if (ACT == 1) {
#pragma unroll
                        for (int j = 0; j < 4; ++j) { const float a0 = fmaxf(v0[j], 0.f), a1 = fmaxf(v1[j], 0.f); v0[j] = a0 * a0; v1[j] = a1 * a1; } }
                    u32x4 w; w.x = pk2(v0[0], v0[1]); w.y = pk2(v0[2], v0[3]); w.z = pk2(v1[0], v1[1]); w.w = pk2(v1[2], v1[3]);
                    *(u32x4*)(rowp + bj * HALF) = w; }
            }
    }
};
struct EpiResid {
    static constexpr bool PERM = false;
    float* X; bf16_t* XB; float* part; float alpha;
    __device__ __forceinline__ void operator()(const f32x4 (&acc)[2][2][4][2], const Unit& u, int wr, int wc, int fr, int fq) const {
        const int row0 = u.pm * BM + wr * 64 + fr, col0 = u.pn * BM + wc * 32 + 4 * fq;
#pragma unroll
        for (int ai = 0; ai < 2; ++ai)
#pragma unroll
            for (int m = 0; m < 4; ++m) {
                const int row = row0 + ai * HALF + m * 16;
                float* xp = X + (size_t)row * DM + col0; bf16_t* bp = XB + (size_t)row * DM + col0;
                float ss = 0.f;
#pragma unroll
                for (int bj = 0; bj < 2; ++bj)
#pragma unroll
                    for (int n = 0; n < 2; ++n) { const f32x4 v = *(const f32x4*)(xp + bj * HALF + n * 16) + acc[ai][bj][m][n] * alpha;
                        *(f32x4*)(xp + bj * HALF + n * 16) = v; ss += (v.x * v.x + v.y * v.y) + (v.z * v.z + v.w * v.w);
                        u32x2 w; w.x = pk2(v.x, v.y); w.y = pk2(v.z, v.w); *(u32x2*)(bp + bj * HALF + n * 16) = w; }
                ss += __shfl_xor(ss, 16); ss += __shfl_xor(ss, 32);
                if (fq == 0) part[(size_t)row * 16 + u.pn * 4 + wc] = ss;
            }
    }
};

template <class Epi, class Sched>
__device__ __forceinline__ void gemm_phase(LAS unsigned char* lds, const Gemm g, const Sched& S, const Epi& E, const int tid) {
    const int wid = __builtin_amdgcn_readfirstlane(tid >> 6), lane = tid & 63, wr = wid >> 2, wc = wid & 3, fr = lane & 15, fq = lane >> 4;
    const int K = g.K, nt = K / BK;
    unsigned voffA[2], voffB[2];
#pragma unroll
    for (int i = 0; i < 2; ++i) { int R, C; stage_rc(tid * 16 + i * 8192, R, C); const int Rb = Epi::PERM ? ((R & ~31) + perm32(R & 31)) : R;
        voffA[i] = (unsigned)(R * K + C) * 2u; voffB[i] = (unsigned)(Rb * K + C) * 2u; }
    const size_t kstep = (size_t)(BK * 2);
    const size_t hstep = (size_t)HALF * K * 2;
    const size_t tstep = 2 * hstep;
    const unsigned ldsw = (unsigned)wid * 1024u;
    const int aoff = lds_byte(wr * 64 + fr, fq * 8), boff = lds_byte(wc * 32 + fr, fq * 8);
#define PG8_SA(b, h) (((b) * 2 + (h)) * HTB)
#define PG8_SB(b, h) ((4 + (b) * 2 + (h)) * HTB)
#define PG8_STAGE(bufoff, gbase, voff) do { _Pragma("unroll") for (int _i = 0; _i < 2; ++_i) \
        __builtin_amdgcn_global_load_lds((const unsigned*)((const char*)(gbase) + (voff)[_i]), (LAS unsigned*)(lds + (bufoff) + ldsw + _i * 8192), 16, 0, 0); } while (0)
#define PG8_LDA(dst, b, h) do { _Pragma("unroll") for (int m = 0; m < 4; ++m) _Pragma("unroll") for (int k = 0; k < 2; ++k) dst[m][k] = *(const LAS bf16x8*)(lds + PG8_SA(b, h) + aoff + m * 2048 + k * 1024); } while (0)
#define PG8_LDB(dst, b, h) do { _Pragma("unroll") for (int n = 0; n < 2; ++n) _Pragma("unroll") for (int k = 0; k < 2; ++k) dst[n][k] = *(const LAS bf16x8*)(lds + PG8_SB(b, h) + boff + n * 2048 + k * 1024); } while (0)
#define PG8_MMA(ai, bj, At, Bt) do { __builtin_amdgcn_s_setprio(1); _Pragma("unroll") for (int m = 0; m < 4; ++m) _Pragma("unroll") for (int n = 0; n < 2; ++n) _Pragma("unroll") for (int k = 0; k < 2; ++k) \
        acc[ai][bj][m][n] = __builtin_amdgcn_mfma_f32_16x16x32_bf16(Bt[n][k], At[m][k], acc[ai][bj][m][n], 0, 0, 0); __builtin_amdgcn_s_setprio(0); } while (0)
#define PG8_WAIT_V(n) asm volatile("s_waitcnt vmcnt(" #n ")" ::: "memory")
#define PG8_WAIT_L(n) asm volatile("s_waitcnt lgkmcnt(" #n ")" ::: "memory")
#define PG8_BAR __builtin_amdgcn_s_barrier()
#define PG8_SCHED __builtin_amdgcn_sched_barrier(0)
    Unit cur, nxt; int ui = 0;
    if (!S.next(0, cur)) return;
    f32x4 acc[2][2][4][2];
#pragma unroll
    for (int a = 0; a < 2; ++a)
#pragma unroll
        for (int b = 0; b < 2; ++b)
#pragma unroll
            for (int m = 0; m < 4; ++m)
#pragma unroll
                for (int n = 0; n < 2; ++n) acc[a][b][m][n] = (f32x4){0.f, 0.f, 0.f, 0.f};
    bf16x8 At[4][2], B0[2][2], B1[2][2];
    const char* cA = (const char*)g.A + (size_t)cur.pm * tstep; const char* cB = (const char*)g.Bt + (size_t)cur.pn * tstep;
    S.a_ready(cur);
    PG8_STAGE(PG8_SB(0, 0), cB, voffB); PG8_STAGE(PG8_SA(0, 0), cA, voffA); PG8_STAGE(PG8_SB(0, 1), cB + hstep, voffB); PG8_STAGE(PG8_SA(0, 1), cA + hstep, voffA);
    if (wr == 1) PG8_BAR;
    PG8_WAIT_V(4); PG8_BAR;
    PG8_STAGE(PG8_SB(1, 0), cB + kstep, voffB); PG8_STAGE(PG8_SA(1, 0), cA + kstep, voffA); PG8_STAGE(PG8_SB(1, 1), cB + hstep + kstep, voffB);
    PG8_WAIT_V(6); PG8_BAR;
    for (;;) {
        const bool has_next = S.next(ui + 1, nxt);
        const char* nA = has_next ? (const char*)g.A + (size_t)nxt.pm * tstep : cA; const char* nB = has_next ? (const char*)g.Bt + (size_t)nxt.pn * tstep : cB;
        for (int t = 0; t < nt; t += 2) {
            const bool last = (t == nt - 2);
            const char* a1 = cA + (size_t)(t + 1) * kstep;
            const char* a2 = last ? nA : cA + (size_t)(t + 2) * kstep; const char* b2 = last ? nB : cB + (size_t)(t + 2) * kstep;
            const char* a3 = a2 + kstep; const char* b3 = b2 + kstep;
            if (last && has_next) S.a_ready(nxt);
            PG8_LDB(B0, 0, 0); PG8_SCHED; PG8_LDA(At, 0, 0); PG8_STAGE(PG8_SA(1, 1), a1 + hstep, voffA);
            PG8_WAIT_L(8); PG8_BAR; PG8_WAIT_L(0); PG8_MMA(0, 0, At, B0); PG8_BAR; PG8_SCHED;
            PG8_LDB(B1, 0, 1); PG8_STAGE(PG8_SB(0, 0), b2, voffB);
            PG8_BAR; PG8_WAIT_L(0); PG8_MMA(0, 1, At, B1); PG8_BAR;
            PG8_LDA(At, 0, 1); PG8_STAGE(PG8_SA(0, 0), a2, voffA);
            PG8_BAR; PG8_WAIT_L(0); PG8_MMA(1, 0, At, B0); PG8_BAR; PG8_SCHED;
            PG8_STAGE(PG8_SB(0, 1), b2 + hstep, voffB);
            PG8_WAIT_V(6); PG8_BAR; PG8_MMA(1, 1, At, B1); PG8_BAR;
            PG8_LDB(B0, 1, 0); PG8_SCHED; PG8_LDA(At, 1, 0); PG8_STAGE(PG8_SA(0, 1), a2 + hstep, voffA);
            PG8_WAIT_L(8); PG8_BAR; PG8_WAIT_L(0); PG8_MMA(0, 0, At, B0); PG8_BAR; PG8_SCHED;
            PG8_LDB(B1, 1, 1); PG8_STAGE(PG8_SB(1, 0), b3, voffB);
            PG8_BAR; PG8_WAIT_L(0); PG8_MMA(0, 1, At, B1); PG8_BAR;
            PG8_LDA(At, 1, 1); PG8_STAGE(PG8_SA(1, 0), a3, voffA);
            PG8_BAR; PG8_WAIT_L(0); PG8_MMA(1, 0, At, B0); PG8_BAR; PG8_SCHED;
            PG8_STAGE(PG8_SB(1, 1), b3 + hstep, voffB);
            PG8_WAIT_V(6); PG8_BAR; PG8_MMA(1, 1, At, B1); PG8_BAR;
        }
        E(acc, cur, wr, wc, fr, fq); S.done(cur);
        if (!has_next) break;
#pragma unroll
        for (int a = 0; a < 2; ++a)
#pragma unroll
            for (int b = 0; b < 2; ++b)
#pragma unroll
                for (int m = 0; m < 4; ++m)
#pragma unroll
                    for (int n = 0; n < 2; ++n) acc[a][b][m][n] = (f32x4){0.f, 0.f, 0.f, 0.f};
        cur = nxt; cA = nA; cB = nB; ++ui;
    }
    PG8_WAIT_V(0);
    if (wr == 0) PG8_BAR;
    PG8_BAR;
#undef PG8_SA
#undef PG8_SB
#undef PG8_STAGE
#undef PG8_LDA
#undef PG8_LDB
#undef PG8_MMA
#undef PG8_WAIT_V
#undef PG8_WAIT_L
#undef PG8_BAR
#undef PG8_SCHED
}
}

struct Params {
    const float* x; const float* mem; const int* pos;
    const float* norm_mix; const float* w_in; const float* ret_gn;
    const float* lru_conv_w; const float* lru_conv_b; const float* lru_wa; const float* lru_ba; const float* lru_wx; const float* lru_bx; const float* lru_lambda;
    const float* mla_q_norm; const float* mla_w_uq; const float* mla_kv_norm; const float* mla_w_ukv;
    const float* gdn_conv_w; const float* gdn_a_log; const float* gdn_dt_bias; const float* gdn_norm;
    const float* w_out; const float* norm_xattn; const float* norm_mem; const float* xa_wq; const float* xa_wkv; const float* xa_wo;
    const float* norm_mlp; const float* mlp_w1; const float* mlp_w2; const float* final_norm;
    float* out; unsigned char* ws;
    int ph_lo, ph_hi;
};

__device__ __forceinline__ bf16_t* wl(const Params& P, int l, size_t off) { return (bf16_t*)(P.ws + WS_W) + (size_t)l * W_LAYER + off; }

__device__ __forceinline__ void transpose_tile(const float* src, int K, int N, const float* gain, float scale, bf16_t* dst, int kb, int nb, LAS float* scr, int tid) {
#pragma unroll
    for (int i = 0; i < 8; ++i) { const int kk = (tid >> 6) + 8 * i, k = kb * 64 + kk, n = nb * 64 + (tid & 63);
        float v = 0.f; if (n < N) { v = src[(size_t)k * N + n] * scale; if (gain) v *= gain[k]; }
        scr[kk * 65 + (tid & 63)] = v; }
    __syncthreads();
    { const int nl = tid >> 3, k0 = (tid & 7) * 8; const LAS float* s = scr + k0 * 65 + nl;
      u32x4 o; o.x = pk2(s[0], s[65]); o.y = pk2(s[2 * 65], s[3 * 65]); o.z = pk2(s[4 * 65], s[5 * 65]); o.w = pk2(s[6 * 65], s[7 * 65]);
      *(u32x4*)(dst + (size_t)(nb * 64 + nl) * K + kb * 64 + k0) = o; }
    __syncthreads();
}
__device__ __forceinline__ void p0_prologue(const Params& P, LAS unsigned char* lds, int tid) {
    LAS float* scr = (LAS float*)lds;
    constexpr int T_IN = 16 * 48, T_SQ = 256, T_KV = 512, T_W1 = 1024, T_W2 = 1024, T_UQ = 18, T_UKV = 16, T_LRU = 8;
    constexpr int T_LAYER = T_IN + 3 * T_SQ + T_KV + T_W1 + T_W2 + T_UQ + T_UKV + T_LRU;
    for (int it = blockIdx.x; it < 2 * T_LAYER; it += gridDim.x) {
        const int l = it / T_LAYER; int r = it % T_LAYER;
        const float* src; const float* gain = nullptr; float scale = 1.f; bf16_t* dst; int K, N, nnb;
        if (r < T_IN) { src = P.w_in + (size_t)l * DM * IN_COLS; K = DM; N = IN_COLS; nnb = 48; gain = P.norm_mix + l * DM; dst = wl(P, l, W_IN); }
        else if ((r -= T_IN) < T_SQ) { src = P.w_out + (size_t)l * DM * DM; K = DM; N = DM; nnb = 16; dst = wl(P, l, W_OUT); }
        else if ((r -= T_SQ) < T_SQ) { src = P.xa_wq + (size_t)l * DM * DM; K = DM; N = DM; nnb = 16; gain = P.norm_xattn + l * DM; scale = 0.0625f * LOG2E; dst = wl(P, l, W_Q); }
        else if ((r -= T_SQ) < T_KV) { src = P.xa_wkv + (size_t)l * DM * 2 * DM; K = DM; N = 2 * DM; nnb = 32; gain = P.norm_mem + l * DM; dst = wl(P, l, W_KV); }
        else if ((r -= T_KV) < T_SQ) { src = P.xa_wo + (size_t)l * DM * DM; K = DM; N = DM; nnb = 16; dst = wl(P, l, W_O); }
        else if ((r -= T_SQ) < T_W1) { src = P.mlp_w1 + (size_t)l * DM * DFF; K = DM; N = DFF; nnb = 64; gain = P.norm_mlp + l * DM; dst = wl(P, l, W_1); }
        else if ((r -= T_W1) < T_W2) { src = P.mlp_w2 + (size_t)l * DFF * DM; K = DFF; N = DM; nnb = 16; dst = wl(P, l, W_2); }
        else if ((r -= T_W2) < T_UQ) { src = P.mla_w_uq + (size_t)l * 192 * 384; K = 192; N = 384; nnb = 6; gain = P.mla_q_norm + l * 192; dst = wl(P, l, W_UQ); }
        else if ((r -= T_UQ) < T_UKV) { src = P.mla_w_ukv + (size_t)l * 128 * 512; K = 128; N = 512; nnb = 8; gain = P.mla_kv_norm + l * 128; dst = wl(P, l, W_UKV); }
        else { r -= T_UKV; const int which = r >> 2, nb4 = r & 3; src = (which ? P.lru_wx : P.lru_wa) + (size_t)l * 4 * 4096 + nb4 * 4096; K = 64; N = 64; nnb = 1; dst = wl(P, l, which ? W_X : W_A) + nb4 * 4096; r = 0; }
        transpose_tile(src, K, N, gain, scale, dst, r / nnb, r % nnb, scr, tid);
    }
    const int wave = tid >> 6, lane = tid & 63;
    const int gw = blockIdx.x * 8 + wave, ngw = gridDim.x * 8;
    bf16_t* xb = (bf16_t*)(P.ws + WS_XB); float* part = (float*)(P.ws + WS_PART); bf16_t* memn = (bf16_t*)(P.ws + WS_GDN);
    for (int row = gw; row < T_TOK + NBATCH * NMEM; row += ngw) {
        const bool isx = row < T_TOK; const int r2 = isx ? row : row - T_TOK;
        const f32x4* src = (const f32x4*)((isx ? P.x : P.mem) + (size_t)r2 * DM) + lane;
        f32x4 v[4]; float s = 0.f;
#pragma unroll
        for (int j = 0; j < 4; ++j) { v[j] = src[64 * j]; s += (v[j].x * v[j].x + v[j].y * v[j].y) + (v[j].z * v[j].z + v[j].w * v[j].w); }
        s = wave_sum(s);
        if (isx) {
            f32x4* o = (f32x4*)(P.out + (size_t)row * DM) + lane; u32x2* ob = (u32x2*)(xb + (size_t)row * DM) + lane;
#pragma unroll
            for (int j = 0; j < 4; ++j) { o[64 * j] = v[j]; u32x2 w; w.x = pk2(v[j].x, v[j].y); w.y = pk2(v[j].z, v[j].w); ob[64 * j] = w; }
            if (lane < 16) part[(size_t)row * 16 + lane] = lane == 0 ? s : 0.f;
        } else {
            const float rs = frsq_(s * (1.0f / 1024.0f) + EPS); u32x2* ob = (u32x2*)(memn + (size_t)r2 * DM) + lane;
#pragma unroll
            for (int j = 0; j < 4; ++j) { u32x2 w; w.x = pk2(v[j].x * rs, v[j].y * rs); w.y = pk2(v[j].z * rs, v[j].w * rs); ob[64 * j] = w; }
        }
    }
}
__device__ __forceinline__ void final_norm_phase(const Params& P, int tid) {
    const int wave = tid >> 6, lane = tid & 63; const float* part = (const float*)(P.ws + WS_PART);
    f32x4 g[4];
#pragma unroll
    for (int j = 0; j < 4; ++j) g[j] = ((const f32x4*)P.final_norm)[64 * j + lane];
    for (int row = blockIdx.x * 8 + wave; row < T_TOK; row += gridDim.x * 8) {
        float s = lane < 16 ? part[(size_t)row * 16 + lane] : 0.f; s = wave_sum(s);
        const float rs = frsq_(s * (1.0f / 1024.0f) + EPS);
        f32x4* o = (f32x4*)(P.out + (size_t)row * DM) + lane;
#pragma unroll
        for (int j = 0; j < 4; ++j) { f32x4 v = o[64 * j]; o[64 * j] = v * rs * g[j]; }
    }
}

__device__ __forceinline__ void mla_pre_tile(const Params& P, int l, int rt, int lane) {
    const int fr = lane & 15, fq = lane >> 4;
    const bf16_t* z = (const bf16_t*)(P.ws + WS_R);
    bf16_t* Qo = (bf16_t*)(P.ws + WS_XB + MLA_Q_OFF); bf16_t* Ko = (bf16_t*)(P.ws + WS_XB + MLA_K_OFF); bf16_t* Vo = (bf16_t*)(P.ws + WS_XB + MLA_VT_OFF);
    const bf16_t* Wuq = wl(P, l, W_UQ); const bf16_t* Wukv = wl(P, l, W_UKV);
    const int tok0 = rt * 16, b = tok0 >> 11, s0 = tok0 & 2047;
    const bf16_t* zr = z + (size_t)(tok0 + fr) * ZP;
    bf16x8 cq[6], ckv[4]; float sq = 0.f, skv = 0.f;
#pragma unroll
    for (int s = 0; s < 6; ++s) { const u32x4 w = *(const u32x4*)(zr + Z_CQ + 32 * s + 8 * fq); cq[s] = __builtin_bit_cast(bf16x8, w);
        sq += bflo(w.x) * bflo(w.x) + bfhi(w.x) * bfhi(w.x) + bflo(w.y) * bflo(w.y) + bfhi(w.y) * bfhi(w.y) + bflo(w.z) * bflo(w.z) + bfhi(w.z) * bfhi(w.z) + bflo(w.w) * bflo(w.w) + bfhi(w.w) * bfhi(w.w); }
#pragma unroll
    for (int s = 0; s < 4; ++s) { const u32x4 w = *(const u32x4*)(zr + Z_CKV + 32 * s + 8 * fq); ckv[s] = __builtin_bit_cast(bf16x8, w);
        skv += bflo(w.x) * bflo(w.x) + bfhi(w.x) * bfhi(w.x) + bflo(w.y) * bflo(w.y) + bfhi(w.y) * bfhi(w.y) + bflo(w.z) * bflo(w.z) + bfhi(w.z) * bfhi(w.z) + bflo(w.w) * bflo(w.w) + bfhi(w.w) * bfhi(w.w); }
    sq += __shfl_xor(sq, 16); sq += __shfl_xor(sq, 32); skv += __shfl_xor(skv, 16); skv += __shfl_xor(skv, 32);
    const float rq = frsq_(sq * (1.0f / 192.0f) + EPS), rkv = frsq_(skv * (1.0f / 128.0f) + EPS);
    const float qsc = rq * 0.10206207261596575f * LOG2E;
    const float pos = (float)P.pos[tok0 + fr];
    float sn[4], cs[4];
#pragma unroll
    for (int r = 0; r < 4; ++r) { const float invf = exp2f(-(float)(4 * fq + r) * (13.287712379549449f / 16.0f)); sincos_rev(pos * invf, sn[r], cs[r]); }
    const size_t tokrow = (size_t)b * 4 * SEQ + (s0 + fr);
#pragma unroll 1
    for (int h = 0; h < 4; ++h) {
        bf16_t* qrow = Qo + (tokrow + (size_t)h * SEQ) * 96;
#pragma unroll 1
        for (int nt = 0; nt < 4; ++nt) { f32x4 a = {0.f, 0.f, 0.f, 0.f};
#pragma unroll
            for (int s = 0; s < 6; ++s) { const bf16x8 wf = *(const bf16x8*)(Wuq + (size_t)(h * 96 + nt * 16 + fr) * 192 + 32 * s + 8 * fq); a = mfma16(wf, cq[s], a); }
            a = a * qsc; u32x2 w; w.x = pk2(a.x, a.y); w.y = pk2(a.z, a.w); *(u32x2*)(qrow + nt * 16 + 4 * fq) = w; }
        f32x4 x1 = {0.f, 0.f, 0.f, 0.f}, x2 = {0.f, 0.f, 0.f, 0.f}, y1, y2;
#pragma unroll
        for (int s = 0; s < 6; ++s) { const bf16x8 wf1 = *(const bf16x8*)(Wuq + (size_t)(h * 96 + 64 + fr) * 192 + 32 * s + 8 * fq), wf2 = *(const bf16x8*)(Wuq + (size_t)(h * 96 + 80 + fr) * 192 + 32 * s + 8 * fq);
            x1 = mfma16(wf1, cq[s], x1); x2 = mfma16(wf2, cq[s], x2); }
        x1 = x1 * qsc; x2 = x2 * qsc;
#pragma unroll
        for (int r = 0; r < 4; ++r) { y1[r] = x1[r] * cs[r] - x2[r] * sn[r]; y2[r] = x1[r] * sn[r] + x2[r] * cs[r]; }
        { u32x2 w; w.x = pk2(y1.x, y1.y); w.y = pk2(y1.z, y1.w); *(u32x2*)(qrow + 64 + 4 * fq) = w; w.x = pk2(y2.x, y2.y); w.y = pk2(y2.z, y2.w); *(u32x2*)(qrow + 80 + 4 * fq) = w; }
    }
    u32x2 kr1, kr2;
    { const u32x2 a = *(const u32x2*)(zr + Z_KR + 4 * fq), c = *(const u32x2*)(zr + Z_KR + 16 + 4 * fq);
      const float x1[4] = {bflo(a.x), bfhi(a.x), bflo(a.y), bfhi(a.y)}, x2[4] = {bflo(c.x), bfhi(c.x), bflo(c.y), bfhi(c.y)}; float y1[4], y2[4];
#pragma unroll
      for (int r = 0; r < 4; ++r) { y1[r] = x1[r] * cs[r] - x2[r] * sn[r]; y2[r] = x1[r] * sn[r] + x2[r] * cs[r]; }
      kr1.x = pk2(y1[0], y1[1]); kr1.y = pk2(y1[2], y1[3]); kr2.x = pk2(y2[0], y2[1]); kr2.y = pk2(y2[2], y2[3]); }
    float rkv_r[4];
#pragma unroll
    for (int r = 0; r < 4; ++r) rkv_r[r] = __shfl(rkv, 4 * fq + r);
    const int chunk = s0 >> 6, key0 = (s0 & 63) + 4 * fq;
#pragma unroll 1
    for (int h = 0; h < 4; ++h) {
        bf16_t* krow = Ko + (tokrow + (size_t)h * SEQ) * 96;
#pragma unroll 1
        for (int nt = 0; nt < 4; ++nt) { f32x4 a = {0.f, 0.f, 0.f, 0.f};
#pragma unroll
            for (int s = 0; s < 4; ++s) { const bf16x8 wf = *(const bf16x8*)(Wukv + (size_t)(h * 128 + nt * 16 + fr) * 128 + 32 * s + 8 * fq); a = mfma16(wf, ckv[s], a); }
            a = a * rkv; u32x2 w; w.x = pk2(a.x, a.y); w.y = pk2(a.z, a.w); *(u32x2*)(krow + nt * 16 + 4 * fq) = w; }
        *(u32x2*)(krow + 64 + 4 * fq) = kr1; *(u32x2*)(krow + 80 + 4 * fq) = kr2;
        bf16_t* vt = Vo + ((size_t)((b * 4 + h) * NCHUNK + chunk) * 64) * 64;
#pragma unroll 1
        for (int nt = 0; nt < 4; ++nt) { f32x4 a = {0.f, 0.f, 0.f, 0.f};
#pragma unroll
            for (int s = 0; s < 4; ++s) { const bf16x8 wf = *(const bf16x8*)(Wukv + (size_t)(h * 128 + 64 + nt * 16 + fr) * 128 + 32 * s + 8 * fq); a = mfma16(ckv[s], wf, a); }
            u32x2 w; w.x = pk2(a.x * rkv_r[0], a.y * rkv_r[1]); w.y = pk2(a.z * rkv_r[2], a.w * rkv_r[3]);
            *(u32x2*)(vt + (size_t)(nt * 16 + fr) * 64 + key0) = w; }
    }
}

template <int DQK, int DV, int KT, int QT>
__device__ __forceinline__ void flash_item(LAS unsigned char* lds, const bf16_t* Qw, int ldq, const bf16_t* Kb, int ldk, const bf16_t* VTb, int ldv, int vts,
                                           bf16_t* Ow, int ldo, int ntiles, int wave_limit, int tid, int lane) {
    constexpr int KROW = DQK + 8, VROW = KT + 8, KS = DQK / 32, ET = DV / 16, NKT = KT / 16, KBYTES = KT * KROW * 2, BUF = KBYTES + DV * VROW * 2;
    constexpr int KP = KT * DQK / 8, VPR = KT / 8, VP = DV * VPR, NKP = (KP + 511) / 512, NVP = (VP + 511) / 512, NP = NKP > NVP ? NKP : NVP;
    const int fr = lane & 15, fq = lane >> 4;
    bf16x8 qf[QT][KS];
#pragma unroll
    for (int qi = 0; qi < QT; ++qi)
#pragma unroll
        for (int s = 0; s < KS; ++s) qf[qi][s] = *(const bf16x8*)(Qw + (size_t)(qi * 16 + fr) * ldq + 32 * s + 8 * fq);
    f32x4 ot[QT][ET];
#pragma unroll
    for (int qi = 0; qi < QT; ++qi)
#pragma unroll
        for (int e = 0; e < ET; ++e) ot[qi][e] = (f32x4){0.f, 0.f, 0.f, 0.f};
    float m_run[QT], l_run[QT];
#pragma unroll
    for (int qi = 0; qi < QT; ++qi) { m_run[qi] = -1e30f; l_run[qi] = 0.f; }
    u32x4 preg[NP];
#define FL_LOADK(j_) do { _Pragma("unroll") for (int i = 0; i < NKP; ++i) { const int idx = tid + i * 512; if (idx < KP) { const int row = idx / (DQK / 8), pc = idx % (DQK / 8); \
            preg[i] = *(const u32x4*)(Kb + (size_t)((j_) * KT + row) * ldk + pc * 8); } } } while (0)
#define FL_LOADV(j_) do { _Pragma("unroll") for (int i = 0; i < NVP; ++i) { const int idx = tid + i * 512; if (idx < VP) { const int row = idx / VPR, pc = idx % VPR; \
            preg[i] = *(const u32x4*)(VTb + (size_t)(j_) * vts + (size_t)row * ldv + pc * 8); } } } while (0)
#define FL_STOREK(buf_) do { LAS bf16_t* Kt_ = (LAS bf16_t*)(lds + (buf_) * BUF); \
        _Pragma("unroll") for (int i = 0; i < NKP; ++i) { const int idx = tid + i * 512; if (idx < KP) { const int row = idx / (DQK / 8), pc = idx % (DQK / 8); *(LAS u32x4*)(Kt_ + row * KROW + pc * 8) = preg[i]; } } } while (0)
#define FL_STOREV(buf_) do { LAS bf16_t* Vt_ = (LAS bf16_t*)(lds + (buf_) * BUF + KBYTES); \
        _Pragma("unroll") for (int i = 0; i < NVP; ++i) { const int idx = tid + i * 512; if (idx < VP) { const int row = idx / VPR, pc = idx % VPR; *(LAS u32x4*)(Vt_ + row * VROW + pc * 8) = preg[i]; } } } while (0)
    FL_LOADK(0); FL_STOREK(0); FL_LOADV(0); FL_STOREV(0);
    __syncthreads();
#pragma unroll 1
    for (int j = 0; j < ntiles; ++j) {
        const bool more = j + 1 < ntiles, act = j < wave_limit;
        const LAS bf16_t* Kt = (const LAS bf16_t*)(lds + (j & 1) * BUF); const LAS bf16_t* Vt = (const LAS bf16_t*)(lds + (j & 1) * BUF + KBYTES);
        if (more) FL_LOADK(j + 1);
        f32x4 st[QT][NKT];
        if (act) {
#pragma unroll
            for (int kt = 0; kt < NKT; ++kt) {
#pragma unroll
                for (int qi = 0; qi < QT; ++qi) st[qi][kt] = (f32x4){0.f, 0.f, 0.f, 0.f};
#pragma unroll
                for (int s = 0; s < KS; ++s) { const bf16x8 kf = *(const LAS bf16x8*)(Kt + (kt * 16 + fr) * KROW + 32 * s + 8 * fq);
#pragma unroll
                    for (int qi = 0; qi < QT; ++qi) st[qi][kt] = mfma16(kf, qf[qi][s], st[qi][kt]); } }
        }
        if (more) { FL_STOREK((j + 1) & 1); FL_LOADV(j + 1); }
        if (act) {
            bf16x8 pf[QT][NKT / 2];
#pragma unroll
            for (int qi = 0; qi < QT; ++qi) {
                float mx = fmaxf(fmaxf(st[qi][0].x, st[qi][0].y), fmaxf(st[qi][0].z, st[qi][0].w));
#pragma unroll
                for (int kt = 1; kt < NKT; ++kt) mx = fmaxf(mx, fmaxf(fmaxf(st[qi][kt].x, st[qi][kt].y), fmaxf(st[qi][kt].z, st[qi][kt].w)));
                mx = fmaxf(mx, __shfl_xor(mx, 16)); mx = fmaxf(mx, __shfl_xor(mx, 32));
                const float m_new = fmaxf(m_run[qi], mx), alpha = fexp2_(m_run[qi] - m_new);
                float ls = 0.f;
#pragma unroll
                for (int kt = 0; kt < NKT; ++kt)
#pragma unroll
                    for (int r = 0; r < 4; ++r) { const float p = fexp2_(st[qi][kt][r] - m_new); st[qi][kt][r] = p; ls += p; }
                l_run[qi] = l_run[qi] * alpha + ls; m_run[qi] = m_new;
#pragma unroll
                for (int e = 0; e < ET; ++e) ot[qi][e] = ot[qi][e] * alpha;
#pragma unroll
                for (int k2 = 0; k2 < NKT / 2; ++k2) pf[qi][k2] = pack8(st[qi][2 * k2], st[qi][2 * k2 + 1]);
            }
#pragma unroll
            for (int e = 0; e < ET; ++e) {
                const LAS bf16_t* vr = Vt + (e * 16 + fr) * VROW + 4 * fq;
#pragma unroll
                for (int k2 = 0; k2 < NKT / 2; ++k2) { const bf16x8 v0 = mk8(*(const LAS u32x2*)(vr + 32 * k2), *(const LAS u32x2*)(vr + 32 * k2 + 16));
#pragma unroll
                    for (int qi = 0; qi < QT; ++qi) ot[qi][e] = mfma16(v0, pf[qi][k2], ot[qi][e]); }
            }
        }
        if (more) FL_STOREV((j + 1) & 1);
        __syncthreads();
    }
#undef FL_LOADK
#undef FL_LOADV
#undef FL_STOREK
#undef FL_STOREV
#pragma unroll
    for (int qi = 0; qi < QT; ++qi) {
        float l = l_run[qi]; l += __shfl_xor(l, 16); l += __shfl_xor(l, 32);
        const float inv = frcp_(l);
#pragma unroll
        for (int e = 0; e < ET; ++e) { u32x2 w; w.x = pk2(ot[qi][e].x * inv, ot[qi][e].y * inv); w.y = pk2(ot[qi][e].z * inv, ot[qi][e].w * inv);
            *(u32x2*)(Ow + (size_t)(qi * 16 + fr) * ldo + e * 16 + 4 * fq) = w; }
    }
}
__device__ __forceinline__ void mla_attn_item(const Params& P, LAS unsigned char* lds, int it, int tid, int wave, int lane) {
    const int qt = 7 - (it >> 6), bh = it & 63;
    const bf16_t* Q = (const bf16_t*)(P.ws + WS_XB + MLA_Q_OFF) + ((size_t)bh * SEQ + qt * 256 + wave * 32) * 96;
    const bf16_t* K = (const bf16_t*)(P.ws + WS_XB + MLA_K_OFF) + (size_t)bh * SEQ * 96;
    const bf16_t* VT = (const bf16_t*)(P.ws + WS_XB + MLA_VT_OFF) + (size_t)bh * NCHUNK * 4096;
    bf16_t* y = (bf16_t*)(P.ws + WS_R + R_Y) + ((size_t)(bh >> 2) * SEQ + qt * 256 + wave * 32) * DM + 512 + (bh & 3) * 64;
    flash_item<96, 64, 64, 2>(lds, Q, 96, K, 96, VT, 64, 4096, y, DM, 4 * qt + 4, 4 * qt + (wave >> 1) + 1, tid, lane);
}
__device__ __forceinline__ void xa_item(const Params& P, int l, LAS unsigned char* lds, int it, int tid, int wave, int lane) {
    const int qt = it & 15, h = (it >> 4) & 3, b = it >> 6;
    const size_t qoff = ((size_t)b * SEQ + qt * 128 + wave * 16) * DM + h * 256;
    const bf16_t* Q = (const bf16_t*)(P.ws + WS_R) + qoff; bf16_t* O = (bf16_t*)(P.ws + WS_R + R_OX) + qoff;
    const bf16_t* K = (const bf16_t*)(P.ws + WS_KVM + (size_t)l * KVM_LAYER) + (size_t)b * NMEM * DM + h * 256;
    const bf16_t* VT = (const bf16_t*)(P.ws + WS_KVM + (size_t)l * KVM_LAYER + (size_t)4096 * 1024 * 2) + (size_t)h * 256 * 4096 + b * NMEM;
    flash_item<256, 256, 32, 1>(lds, Q, DM, K, DM, VT, 4096, 32, O, DM, 8, 8, tid, lane);
}

constexpr int GP_KN = 0, GP_KB = 9216, GP_QN = 18432, GP_L = 9216, GP_RHS = 27648, GP_G = 60416, GP_GC = 60672, GP_HEAD = 61440;
__device__ __forceinline__ bf16_t* gdn_buf(const Params& P, int chh, int k) { return (bf16_t*)(P.ws + WS_GDN) + ((size_t)chh * 5 + k) * 4096; }
__device__ __forceinline__ void gdn_pre_item(const Params& P, int l, LAS unsigned char* lds, int it, int tid) {
    const int hp = it & 1, n = (it >> 1) & 31, b = it >> 6;
    const int hh = tid >> 8, h = 2 * hp + hh, tt = tid & 255, c = tt >> 2, qr = tt & 3, lane = tid & 63;
    LAS unsigned char* L = lds + hh * GP_HEAD;
    const bf16_t* z = (const bf16_t*)(P.ws + WS_R);
    const int s = n * 64 + c; const size_t tok = (size_t)b * SEQ + s;
    const float* cw = P.gdn_conv_w + (size_t)l * 4 * 768;
    const int chh = (b * NCHUNK + n) * 4 + h;
    float q[16], k[16], v[16];
#pragma unroll
    for (int part = 0; part < 3; ++part) {
        float* dst = part == 0 ? q : (part == 1 ? k : v);
        const int ch0 = part * 256 + h * 64 + qr * 16;
#pragma unroll
        for (int i = 0; i < 16; ++i) dst[i] = 0.f;
#pragma unroll
        for (int kk = 0; kk < 4; ++kk) { {
            const bool okk = s - 3 + kk >= 0; const float mk = okk ? 1.f : 0.f;
            const bf16_t* zr = z + (okk ? tok - 3 + kk : tok) * ZP + Z_GQKV + ch0; const u32x4 w0 = *(const u32x4*)zr, w1 = *(const u32x4*)(zr + 8);
            const float* wr = cw + kk * 768 + ch0; const f32x4 c0 = *(const f32x4*)wr * mk, c1 = *(const f32x4*)(wr + 4) * mk, c2 = *(const f32x4*)(wr + 8) * mk, c3 = *(const f32x4*)(wr + 12) * mk;
            dst[0] += c0.x * bflo(w0.x); dst[1] += c0.y * bfhi(w0.x); dst[2] += c0.z * bflo(w0.y); dst[3] += c0.w * bfhi(w0.y);
            dst[4] += c1.x * bflo(w0.z); dst[5] += c1.y * bfhi(w0.z); dst[6] += c1.z * bflo(w0.w); dst[7] += c1.w * bfhi(w0.w);
            dst[8] += c2.x * bflo(w1.x); dst[9] += c2.y * bfhi(w1.x); dst[10] += c2.z * bflo(w1.y); dst[11] += c2.w * bfhi(w1.y);
            dst[12] += c3.x * bflo(w1.z); dst[13] += c3.y * bfhi(w1.z); dst[14] += c3.z * bflo(w1.w); dst[15] += c3.w * bfhi(w1.w); } }
#pragma unroll
        for (int i = 0; i < 16; ++i) dst[i] = siluf_(dst[i]);
    }
    float sq = 0.f, sk = 0.f;
#pragma unroll
    for (int i = 0; i < 16; ++i) { sq += q[i] * q[i]; sk += k[i] * k[i]; }
    sq += __shfl_xor(sq, 1); sq += __shfl_xor(sq, 2); sk += __shfl_xor(sk, 1); sk += __shfl_xor(sk, 2);
    const float rq = frsq_(sq + EPS) * 0.125f, rk = frsq_(sk + EPS);
    const bf16_t* zt = z + tok * ZP;
    const float beta = sigmoidf_(bf2f(zt[Z_GB + h]));
    const float g = -fexp_(P.gdn_a_log[l * 4 + h]) * softplusf_(bf2f(zt[Z_GA + h]) + P.gdn_dt_bias[l * 4 + h]);
    {
        u32x4 w0, w1;
#define PK16(dst0, dst1, src, sc) do { dst0.x = pk2(src[0] * (sc), src[1] * (sc)); dst0.y = pk2(src[2] * (sc), src[3] * (sc)); dst0.z = pk2(src[4] * (sc), src[5] * (sc)); dst0.w = pk2(src[6] * (sc), src[7] * (sc)); \
        dst1.x = pk2(src[8] * (sc), src[9] * (sc)); dst1.y = pk2(src[10] * (sc), src[11] * (sc)); dst1.z = pk2(src[12] * (sc), src[13] * (sc)); dst1.w = pk2(src[14] * (sc), src[15] * (sc)); } while (0)
        PK16(w0, w1, k, rk);        *(LAS u32x4*)(L + GP_KN + (c * 72 + qr * 16) * 2) = w0; *(LAS u32x4*)(L + GP_KN + (c * 72 + qr * 16 + 8) * 2) = w1;
        PK16(w0, w1, k, rk * beta); *(LAS u32x4*)(L + GP_KB + (c * 72 + qr * 16) * 2) = w0; *(LAS u32x4*)(L + GP_KB + (c * 72 + qr * 16 + 8) * 2) = w1;
        PK16(w0, w1, q, rq);        *(LAS u32x4*)(L + GP_QN + (c * 72 + qr * 16) * 2) = w0; *(LAS u32x4*)(L + GP_QN + (c * 72 + qr * 16 + 8) * 2) = w1;
        LAS float* rhs = (LAS float*)(L + GP_RHS) + c * 128 + qr * 16;
#pragma unroll
        for (int i = 0; i < 4; ++i) *(LAS f32x4*)(rhs + 4 * i) = (f32x4){v[4 * i] * beta, v[4 * i + 1] * beta, v[4 * i + 2] * beta, v[4 * i + 3] * beta};
        if (qr == 0) ((LAS float*)(L + GP_G))[c] = g;
    }
    __syncthreads();
    {
        float gc = 0.f, run = 0.f; const LAS float* G = (const LAS float*)(L + GP_G);
        for (int i = 0; i < 64; ++i) { run += G[i]; gc = (i == c) ? run : gc; }
        const float eg = fexp_(gc), ek = fexp_(run - gc);
        LAS float* rhs = (LAS float*)(L + GP_RHS) + c * 128 + 64 + qr * 16;
#pragma unroll
        for (int i = 0; i < 4; ++i) *(LAS f32x4*)(rhs + 4 * i) = (f32x4){k[4 * i] * rk * beta * eg, k[4 * i + 1] * rk * beta * eg, k[4 * i + 2] * rk * beta * eg, k[4 * i + 3] * rk * beta * eg};
        u32x4 w0, w1; PK16(w0, w1, q, rq * eg);
        bf16_t* qd = gdn_buf(P, chh, 3) + c * 64 + qr * 16; *(u32x4*)qd = w0; *(u32x4*)(qd + 8) = w1;
        bf16_t* kdt = gdn_buf(P, chh, 4) + (qr * 16) * 64 + c;
#pragma unroll
        for (int i = 0; i < 16; ++i) kdt[i * 64] = f2bf(k[i] * rk * ek);
        if (qr == 0) ((LAS float*)(L + GP_GC))[c] = gc;
        if (tt == 0) ((float*)(P.ws + WS_GL))[chh] = fexp_(run);
    }
#undef PK16
    __syncthreads();
    {
        const int it4 = (tid >> 6) & 3, fr = lane & 15, fq = lane >> 4;
        const LAS bf16_t* Kn = (const LAS bf16_t*)(L + GP_KN); const LAS bf16_t* KB = (const LAS bf16_t*)(L + GP_KB); const LAS bf16_t* Qn = (const LAS bf16_t*)(L + GP_QN);
        const LAS float* GC = (const LAS float*)(L + GP_GC);
        const bf16x8 a0 = *(const LAS bf16x8*)(KB + (it4 * 16 + fr) * 72 + 8 * fq), a1 = *(const LAS bf16x8*)(KB + (it4 * 16 + fr) * 72 + 32 + 8 * fq);
        const bf16x8 q0 = *(const LAS bf16x8*)(Qn + (it4 * 16 + fr) * 72 + 8 * fq), q1 = *(const LAS bf16x8*)(Qn + (it4 * 16 + fr) * 72 + 32 + 8 * fq);
        float gci[4];
#pragma unroll
        for (int r = 0; r < 4; ++r) gci[r] = GC[it4 * 16 + 4 * fq + r];
        f32x4 lv[4]; bf16_t* att = gdn_buf(P, chh, 2);
#pragma unroll
        for (int jt = 0; jt < 4; ++jt) {
            const bf16x8 b0 = *(const LAS bf16x8*)(Kn + (jt * 16 + fr) * 72 + 8 * fq), b1 = *(const LAS bf16x8*)(Kn + (jt * 16 + fr) * 72 + 32 + 8 * fq);
            f32x4 al = {0.f, 0.f, 0.f, 0.f}, aa = {0.f, 0.f, 0.f, 0.f};
            al = mfma16(a0, b0, al); al = mfma16(a1, b1, al); aa = mfma16(q0, b0, aa); aa = mfma16(q1, b1, aa);
            const int j = jt * 16 + fr; const float gcj = GC[j];
#pragma unroll
            for (int r = 0; r < 4; ++r) { const int i = it4 * 16 + 4 * fq + r; const float dec = fexp_(fminf(gci[r] - gcj, 0.f));
                lv[jt][r] = (i > j) ? al[r] * dec : 0.f; att[i * 64 + j] = f2bf((i >= j) ? aa[r] * dec : 0.f); }
        }
        __syncthreads();
        LAS float* Lm = (LAS float*)(L + GP_L);
#pragma unroll
        for (int jt = 0; jt < 4; ++jt)
#pragma unroll
            for (int r = 0; r < 4; ++r) Lm[(it4 * 16 + 4 * fq + r) * 64 + jt * 16 + fr] = lv[jt][r];
    }
    __syncthreads();
    if (tt < 128) {
        const LAS float* Lm = (const LAS float*)(L + GP_L); const LAS float* rhs = (const LAS float*)(L + GP_RHS) + tt;
        float x[64];
#pragma unroll
        for (int i = 0; i < 64; ++i) {
            float a0 = rhs[i * 128], a1 = 0.f;
#pragma unroll
            for (int j4 = 0; j4 < (i + 3) / 4; ++j4) { const f32x4 lr = *(const LAS f32x4*)(Lm + i * 64 + 4 * j4);
                if (4 * j4 + 0 < i) a0 -= lr.x * x[4 * j4 + 0]; if (4 * j4 + 1 < i) a1 -= lr.y * x[4 * j4 + 1];
                if (4 * j4 + 2 < i) a0 -= lr.z * x[4 * j4 + 2]; if (4 * j4 + 3 < i) a1 -= lr.w * x[4 * j4 + 3]; }
            x[i] = a0 + a1;
        }
        if (tt < 64) { bf16_t* ut = gdn_buf(P, chh, 1) + tt * 64;
#pragma unroll
            for (int g8 = 0; g8 < 8; ++g8) { u32x4 w; w.x = pk2(x[8 * g8], x[8 * g8 + 1]); w.y = pk2(x[8 * g8 + 2], x[8 * g8 + 3]); w.z = pk2(x[8 * g8 + 4], x[8 * g8 + 5]); w.w = pk2(x[8 * g8 + 6], x[8 * g8 + 7]); *(u32x4*)(ut + 8 * g8) = w; }
        } else { bf16_t* wo = gdn_buf(P, chh, 0) + (tt - 64);
#pragma unroll
            for (int i = 0; i < 64; ++i) wo[i * 64] = f2bf(x[i]); }
    }
    __syncthreads();
}

constexpr int GC_W = 0, GC_UT = 9216, GC_ATT = 18432, GC_QD = 27648, GC_KDT = 36864, GC_O = 46080, GC_BH = 62720;
__device__ __forceinline__ bf16x8 lds_perm(const LAS unsigned char* M, int row, int s, int fq) { const LAS unsigned char* p = M + row * 144 + 64 * s + 8 * fq; return mk8(*(const LAS u32x2*)p, *(const LAS u32x2*)(p + 32)); }
__device__ __forceinline__ void gdn_chain_item(const Params& P, int l, LAS unsigned char* lds, int gi, int tid, int wave, int lane) {
    const int q2 = wave >> 2, bh = gi * 2 + q2, eb = wave & 3, b = bh >> 2, h = bh & 3, fr = lane & 15, fq = lane >> 4;
    const bf16_t* z = (const bf16_t*)(P.ws + WS_R); bf16_t* y = (bf16_t*)(P.ws + WS_R + R_Y);
    LAS unsigned char* L = lds + q2 * GC_BH;
    const int tt = tid & 255, ec = tt >> 2, eq = tt & 3;
    float ng[16];
#pragma unroll
    for (int j = 0; j < 16; ++j) ng[j] = P.gdn_norm[l * 64 + eq * 16 + j];
    u32x4 stg[10];
    const bf16_t* src0[2] = { gdn_buf(P, ((gi * 2 >> 2) * NCHUNK) * 4 + ((gi * 2) & 3), 0), gdn_buf(P, (((gi * 2 + 1) >> 2) * NCHUNK) * 4 + ((gi * 2 + 1) & 3), 0) };
#define GC_LOAD(n_) do { _Pragma("unroll") for (int i = 0; i < 10; ++i) { const int p = tid + 512 * i, qq = p / 2560, pp = p % 2560; \
        stg[i] = *(const u32x4*)(src0[qq] + (size_t)(n_) * 4 * 5 * 4096 + (size_t)pp * 8); } } while (0)
#define GC_WRITE() do { _Pragma("unroll") for (int i = 0; i < 10; ++i) { const int p = tid + 512 * i, qq = p / 2560, pp = p % 2560, mat = pp >> 9, row = (pp & 511) >> 3, pc = pp & 7; \
        *(LAS u32x4*)(lds + qq * GC_BH + mat * 9216 + row * 144 + pc * 16) = stg[i]; } } while (0)
    GC_LOAD(0); GC_WRITE();
    f32x4 S[4];
#pragma unroll
    for (int t = 0; t < 4; ++t) S[t] = (f32x4){0.f, 0.f, 0.f, 0.f};
    __syncthreads();
    for (int n = 0; n < NCHUNK; ++n) {
        const int chh = (b * NCHUNK + n) * 4 + h;
        if (n + 1 < NCHUNK) GC_LOAD(n + 1);
        const size_t etok = (size_t)(gi * 2 + (tid >> 8) >> 2) * SEQ + n * 64 + ec; const int eh = (gi * 2 + (tid >> 8)) & 3;
        const u32x4 gw0 = *(const u32x4*)(z + etok * ZP + Z_GG + eh * 64 + eq * 16), gw1 = *(const u32x4*)(z + etok * ZP + Z_GG + eh * 64 + eq * 16 + 8);
        const float egl = ((const float*)(P.ws + WS_GL))[chh];
        const bf16x8 sb0 = pack8(S[0], S[1]), sb1 = pack8(S[2], S[3]);
        f32x4 vn[4], o[4];
#pragma unroll
        for (int ct = 0; ct < 4; ++ct) {
            f32x4 a = {0.f, 0.f, 0.f, 0.f}; a = mfma16(lds_perm(L + GC_W, ct * 16 + fr, 0, fq), sb0, a); a = mfma16(lds_perm(L + GC_W, ct * 16 + fr, 1, fq), sb1, a);
            const u32x2 uw = *(const LAS u32x2*)(L + GC_UT + (eb * 16 + fr) * 144 + (ct * 16 + 4 * fq) * 2);
            vn[ct] = (f32x4){bflo(uw.x) - a.x, bfhi(uw.x) - a.y, bflo(uw.y) - a.z, bfhi(uw.y) - a.w};
            f32x4 oo = {0.f, 0.f, 0.f, 0.f}; oo = mfma16(lds_perm(L + GC_QD, ct * 16 + fr, 0, fq), sb0, oo); oo = mfma16(lds_perm(L + GC_QD, ct * 16 + fr, 1, fq), sb1, oo); o[ct] = oo;
        }
        const bf16x8 vb0 = pack8(vn[0], vn[1]), vb1 = pack8(vn[2], vn[3]);
#pragma unroll
        for (int ct = 0; ct < 4; ++ct) { o[ct] = mfma16(lds_perm(L + GC_ATT, ct * 16 + fr, 0, fq), vb0, o[ct]); o[ct] = mfma16(lds_perm(L + GC_ATT, ct * 16 + fr, 1, fq), vb1, o[ct]); }
#pragma unroll
        for (int dt = 0; dt < 4; ++dt) { f32x4 a = S[dt] * egl; a = mfma16(lds_perm(L + GC_KDT, dt * 16 + fr, 0, fq), vb0, a); a = mfma16(lds_perm(L + GC_KDT, dt * 16 + fr, 1, fq), vb1, a); S[dt] = a; }
        LAS float* Ol = (LAS float*)(L + GC_O);
#pragma unroll
        for (int ct = 0; ct < 4; ++ct)
#pragma unroll
            for (int r = 0; r < 4; ++r) Ol[(ct * 16 + 4 * fq + r) * 65 + eb * 16 + fr] = o[ct][r];
        __syncthreads();
        if (n + 1 < NCHUNK) GC_WRITE();
        {
            const LAS float* orow = (const LAS float*)(lds + (tid >> 8) * GC_BH + GC_O) + ec * 65 + eq * 16;
            float ov[16]; float s2 = 0.f;
#pragma unroll
            for (int j = 0; j < 16; ++j) { ov[j] = orow[j]; s2 += ov[j] * ov[j]; }
            s2 += __shfl_xor(s2, 1); s2 += __shfl_xor(s2, 2);
            const float rs = frsq_(s2 * (1.0f / 64.0f) + EPS);
            const unsigned gws[8] = {gw0.x, gw0.y, gw0.z, gw0.w, gw1.x, gw1.y, gw1.z, gw1.w};
            unsigned ow[8];
#pragma unroll
            for (int j = 0; j < 8; ++j) ow[j] = pk2(ov[2 * j] * rs * ng[2 * j] * siluf_(bflo(gws[j])), ov[2 * j + 1] * rs * ng[2 * j + 1] * siluf_(bfhi(gws[j])));
            bf16_t* yp = y + etok * DM + 768 + eh * 64 + eq * 16;
            *(u32x4*)yp = (u32x4){ow[0], ow[1], ow[2], ow[3]}; *(u32x4*)(yp + 8) = (u32x4){ow[4], ow[5], ow[6], ow[7]};
        }
        __syncthreads();
    }
#undef GC_LOAD
#undef GC_WRITE
}

constexpr int RT_BUF = 36864, RT_Q = 0, RT_K = 9216, RT_KZT = 18432, RT_VT = 27648, RT_P = 73728, RT_ST = 82944, RT_O = 92160;
__device__ __forceinline__ void ret_chain_item(const Params& P, int l, LAS unsigned char* lds, int it, int tid, int wave, int lane) {
    const int b = it >> 2, h = it & 3, fr = lane & 15, fq = lane >> 4;
    const bf16_t* z = (const bf16_t*)(P.ws + WS_R); bf16_t* y = (bf16_t*)(P.ws + WS_R + R_Y);
    LAS bf16_t* Pm = (LAS bf16_t*)(lds + RT_P); LAS bf16_t* ST = (LAS bf16_t*)(lds + RT_ST); LAS float* Of = (LAS float*)(lds + RT_O);
    const float lg = log1pf(-exp2f(-5.0f - (float)h));
    const float cdec = fexp_(64.0f * lg);
    for (int i = tid; i < 64 * 72 / 2; i += 512) ((LAS unsigned*)ST)[i] = 0u;
    const int it4 = wave >> 1, jt0 = 2 * (wave & 1);
    f32x4 S[2] = {{0.f, 0.f, 0.f, 0.f}, {0.f, 0.f, 0.f, 0.f}};
    const int lc = tid >> 3, pg = tid & 7;
    float invf[4];
#pragma unroll
    for (int ii = 0; ii < 4; ++ii) invf[ii] = exp2f(-(float)(4 * pg + ii) * (13.287712379549449f / 32.0f));
    const float zeta = fexp_((63.0f - (float)lc) * lg);
    const f32x4 gn0 = *(const f32x4*)(P.ret_gn + l * 256 + h * 64 + 8 * pg), gn1 = *(const f32x4*)(P.ret_gn + l * 256 + h * 64 + 8 * pg + 4);
    const size_t tok0 = (size_t)b * SEQ + lc;
    u32x2 q1w, q2w, k1w, k2w; u32x4 vw; int posi;
#define RT_LOAD(n_) do { const bf16_t* zr_ = z + (tok0 + (n_) * 64) * ZP; q1w = *(const u32x2*)(zr_ + Z_RQ + h * 64 + 4 * pg); q2w = *(const u32x2*)(zr_ + Z_RQ + h * 64 + 32 + 4 * pg); \
        k1w = *(const u32x2*)(zr_ + Z_RK + h * 64 + 4 * pg); k2w = *(const u32x2*)(zr_ + Z_RK + h * 64 + 32 + 4 * pg); vw = *(const u32x4*)(zr_ + Z_RV + h * 64 + 8 * pg); posi = P.pos[tok0 + (n_) * 64]; } while (0)
#define RT_STAGE(buf_) do { LAS bf16_t* Qs_ = (LAS bf16_t*)(lds + (buf_) * RT_BUF + RT_Q); LAS bf16_t* Ks_ = (LAS bf16_t*)(lds + (buf_) * RT_BUF + RT_K); \
        LAS bf16_t* KzT_ = (LAS bf16_t*)(lds + (buf_) * RT_BUF + RT_KZT); LAS bf16_t* VT_ = (LAS bf16_t*)(lds + (buf_) * RT_BUF + RT_VT); const float pos = (float)posi; \
        const float q1[4] = {bflo(q1w.x), bfhi(q1w.x), bflo(q1w.y), bfhi(q1w.y)}, q2[4] = {bflo(q2w.x), bfhi(q2w.x), bflo(q2w.y), bfhi(q2w.y)}; \
        const float k1[4] = {bflo(k1w.x), bfhi(k1w.x), bflo(k1w.y), bfhi(k1w.y)}, k2[4] = {bflo(k2w.x), bfhi(k2w.x), bflo(k2w.y), bfhi(k2w.y)}; \
        float qa[4], qb[4], ka[4], kb[4]; \
        _Pragma("unroll") for (int ii = 0; ii < 4; ++ii) { float sn, cs; sincos_rev(pos * invf[ii], sn, cs); \
            qa[ii] = (q1[ii] * cs - q2[ii] * sn) * 0.125f; qb[ii] = (q1[ii] * sn + q2[ii] * cs) * 0.125f; ka[ii] = k1[ii] * cs - k2[ii] * sn; kb[ii] = k1[ii] * sn + k2[ii] * cs; } \
        u32x2 w_; w_.x = pk2(qa[0], qa[1]); w_.y = pk2(qa[2], qa[3]); *(LAS u32x2*)(Qs_ + lc * 72 + 4 * pg) = w_; \
        w_.x = pk2(qb[0], qb[1]); w_.y = pk2(qb[2], qb[3]); *(LAS u32x2*)(Qs_ + lc * 72 + 32 + 4 * pg) = w_; \
        w_.x = pk2(ka[0], ka[1]); w_.y = pk2(ka[2], ka[3]); *(LAS u32x2*)(Ks_ + lc * 72 + 4 * pg) = w_; \
        w_.x = pk2(kb[0], kb[1]); w_.y = pk2(kb[2], kb[3]); *(LAS u32x2*)(Ks_ + lc * 72 + 32 + 4 * pg) = w_; \
        _Pragma("unroll") for (int ii = 0; ii < 4; ++ii) { KzT_[(4 * pg + ii) * 72 + lc] = f2bf(ka[ii] * zeta); KzT_[(32 + 4 * pg + ii) * 72 + lc] = f2bf(kb[ii] * zeta); } \
        const unsigned vv[4] = {vw.x, vw.y, vw.z, vw.w}; \
        _Pragma("unroll") for (int ii = 0; ii < 4; ++ii) { VT_[(8 * pg + 2 * ii) * 72 + lc] = (bf16_t)(vv[ii] & 0xffffu); VT_[(8 * pg + 2 * ii + 1) * 72 + lc] = (bf16_t)(vv[ii] >> 16); } } while (0)
    RT_LOAD(0); RT_STAGE(0);
    __syncthreads();
    for (int n = 0; n < NCHUNK; ++n) {
        const int cb = n & 1;
        const LAS bf16_t* Qs = (const LAS bf16_t*)(lds + cb * RT_BUF + RT_Q); const LAS bf16_t* Ks = (const LAS bf16_t*)(lds + cb * RT_BUF + RT_K);
        const LAS bf16_t* KzT = (const LAS bf16_t*)(lds + cb * RT_BUF + RT_KZT); const LAS bf16_t* VT = (const LAS bf16_t*)(lds + cb * RT_BUF + RT_VT);
        const size_t tok = tok0 + n * 64;
        if (n + 1 < NCHUNK) RT_LOAD(n + 1);
        const u32x4 gw = *(const u32x4*)(z + tok * ZP + Z_RG + h * 64 + 8 * pg);
        const bf16x8 a0 = *(const LAS bf16x8*)(Qs + (it4 * 16 + fr) * 72 + 8 * fq), a1 = *(const LAS bf16x8*)(Qs + (it4 * 16 + fr) * 72 + 32 + 8 * fq);
        f32x4 cross[2];
#pragma unroll
        for (int t = 0; t < 2; ++t) { const int jt = jt0 + t;
            f32x4 p = {0.f, 0.f, 0.f, 0.f};
            p = mfma16(a0, *(const LAS bf16x8*)(Ks + (jt * 16 + fr) * 72 + 8 * fq), p); p = mfma16(a1, *(const LAS bf16x8*)(Ks + (jt * 16 + fr) * 72 + 32 + 8 * fq), p);
            f32x4 cr = {0.f, 0.f, 0.f, 0.f};
            cr = mfma16(a0, *(const LAS bf16x8*)(ST + (jt * 16 + fr) * 72 + 8 * fq), cr); cr = mfma16(a1, *(const LAS bf16x8*)(ST + (jt * 16 + fr) * 72 + 32 + 8 * fq), cr);
#pragma unroll
            for (int r = 0; r < 4; ++r) { const int i = it4 * 16 + 4 * fq + r, j = jt * 16 + fr; const int dd = i > j ? i - j : j - i;
                Pm[i * 72 + j] = f2bf(p[r] * fexp_((float)dd * lg)); cr[r] *= fexp_((float)(i + 1) * lg); }
            cross[t] = cr; }
        __syncthreads();
        const bf16x8 p0 = *(const LAS bf16x8*)(Pm + (it4 * 16 + fr) * 72 + 8 * fq), p1 = *(const LAS bf16x8*)(Pm + (it4 * 16 + fr) * 72 + 32 + 8 * fq);
        const bf16x8 kz0 = *(const LAS bf16x8*)(KzT + (it4 * 16 + fr) * 72 + 8 * fq), kz1 = *(const LAS bf16x8*)(KzT + (it4 * 16 + fr) * 72 + 32 + 8 * fq);
#pragma unroll
        for (int t = 0; t < 2; ++t) { const int et = jt0 + t;
            const bf16x8 v0 = *(const LAS bf16x8*)(VT + (et * 16 + fr) * 72 + 8 * fq), v1 = *(const LAS bf16x8*)(VT + (et * 16 + fr) * 72 + 32 + 8 * fq);
            f32x4 o = cross[t]; o = mfma16(p0, v0, o); o = mfma16(p1, v1, o);
#pragma unroll
            for (int r = 0; r < 4; ++r) Of[(it4 * 16 + 4 * fq + r) * 65 + et * 16 + fr] = o[r];
            f32x4 sN = S[t] * cdec; sN = mfma16(kz0, v0, sN); sN = mfma16(kz1, v1, sN); S[t] = sN;
            u32x2 w; w.x = pk2(sN.x, sN.y); w.y = pk2(sN.z, sN.w); *(LAS u32x2*)(ST + (et * 16 + fr) * 72 + it4 * 16 + 4 * fq) = w; }
        if (n + 1 < NCHUNK) RT_STAGE(cb ^ 1);
        __syncthreads();
        {
            float ov[8]; float sm = 0.f;
#pragma unroll
            for (int j = 0; j < 8; ++j) { ov[j] = Of[lc * 65 + 8 * pg + j]; sm += ov[j]; }
            sm += __shfl_xor(sm, 1); sm += __shfl_xor(sm, 2); sm += __shfl_xor(sm, 4);
            const float mu = sm * (1.0f / 64.0f); float vs = 0.f;
#pragma unroll
            for (int j = 0; j < 8; ++j) { ov[j] -= mu; vs += ov[j] * ov[j]; }
            vs += __shfl_xor(vs, 1); vs += __shfl_xor(vs, 2); vs += __shfl_xor(vs, 4);
            const float rs = frsq_(vs * (1.0f / 64.0f) + EPS);
            const float gt[8] = {bflo(gw.x), bfhi(gw.x), bflo(gw.y), bfhi(gw.y), bflo(gw.z), bfhi(gw.z), bflo(gw.w), bfhi(gw.w)};
            const float gnv[8] = {gn0.x, gn0.y, gn0.z, gn0.w, gn1.x, gn1.y, gn1.z, gn1.w};
            float r8[8];
#pragma unroll
            for (int j = 0; j < 8; ++j) r8[j] = ov[j] * rs * gnv[j] * siluf_(gt[j]);
            u32x4 w; w.x = pk2(r8[0], r8[1]); w.y = pk2(r8[2], r8[3]); w.z = pk2(r8[4], r8[5]); w.w = pk2(r8[6], r8[7]);
            *(u32x4*)(y + tok * DM + h * 64 + 8 * pg) = w;
        }
    }
#undef RT_LOAD
#undef RT_STAGE
    __syncthreads();
}

constexpr int LR_XC = 0, LR_AU = 33792;
__device__ __forceinline__ void lru_item(const Params& P, int l, LAS unsigned char* lds, int it, int mode, int tid, int wave, int lane) {
    const int b = it >> 5, n = it & 31, fr = lane & 15, fq = lane >> 4;
    const bf16_t* z = (const bf16_t*)(P.ws + WS_R); bf16_t* y = (bf16_t*)(P.ws + WS_R + R_Y);
    LAS bf16_t* XC = (LAS bf16_t*)(lds + LR_XC); LAS f32x2* AU = (LAS f32x2*)(lds + LR_AU);
    float* sumA = (float*)(P.ws + WS_LRUS); float* sumH = sumA + 16 * 32 * 256;
    {
        const int c = tid >> 3, cg = tid & 7, s = n * 64 + c; const size_t tok = (size_t)b * SEQ + s;
        const float* cw = P.lru_conv_w + (size_t)l * 4 * 256; const float* cb = P.lru_conv_b + l * 256;
#pragma unroll
        for (int g = 0; g < 4; ++g) { const int ch0 = cg * 32 + g * 8;
            const f32x4 b0 = *(const f32x4*)(cb + ch0), b1 = *(const f32x4*)(cb + ch0 + 4);
            float a[8] = {b0.x, b0.y, b0.z, b0.w, b1.x, b1.y, b1.z, b1.w};
#pragma unroll
            for (int kk = 0; kk < 4; ++kk) { const bool okk = s - 3 + kk >= 0; const float mk = okk ? 1.f : 0.f;
                const u32x4 w = *(const u32x4*)(z + (okk ? tok - 3 + kk : tok) * ZP + Z_LX + ch0);
                const f32x4 c0 = *(const f32x4*)(cw + kk * 256 + ch0) * mk, c1 = *(const f32x4*)(cw + kk * 256 + ch0 + 4) * mk;
                a[0] += c0.x * bflo(w.x); a[1] += c0.y * bfhi(w.x); a[2] += c0.z * bflo(w.y); a[3] += c0.w * bfhi(w.y);
                a[4] += c1.x * bflo(w.z); a[5] += c1.y * bfhi(w.z); a[6] += c1.z * bflo(w.w); a[7] += c1.w * bfhi(w.w); }
            u32x4 o; o.x = pk2(a[0], a[1]); o.y = pk2(a[2], a[3]); o.z = pk2(a[4], a[5]); o.w = pk2(a[6], a[7]);
            *(LAS u32x4*)(XC + c * 264 + ch0) = o; }
    }
    float hcar = 0.f, aprod = 1.f;
    if (mode == 1 && tid < 256) {
        float av[32], hv[32];
#pragma unroll
        for (int m = 0; m < 32; ++m) { const int mm = m < n ? m : 0; av[m] = sumA[(b * 32 + mm) * 256 + tid]; hv[m] = sumH[(b * 32 + mm) * 256 + tid]; }
#pragma unroll
        for (int m = 0; m < 32; ++m) if (m < n) hcar = av[m] * hcar + hv[m];
    }
    const int nb = wave >> 1, rt = wave & 1;
    const bf16_t* wa = wl(P, l, W_A) + nb * 4096; const bf16_t* wx = wl(P, l, W_X) + nb * 4096;
    bf16x8 fa[4][2], fx[4][2]; float ba[4], bx[4], spl[4];
#pragma unroll
    for (int dt = 0; dt < 4; ++dt) {
#pragma unroll
        for (int s = 0; s < 2; ++s) { fa[dt][s] = *(const bf16x8*)(wa + (dt * 16 + fr) * 64 + 32 * s + 8 * fq); fx[dt][s] = *(const bf16x8*)(wx + (dt * 16 + fr) * 64 + 32 * s + 8 * fq); }
        const int d = nb * 64 + dt * 16 + fr; ba[dt] = P.lru_ba[l * 256 + d]; bx[dt] = P.lru_bx[l * 256 + d]; spl[dt] = -8.0f * softplusf_(-P.lru_lambda[l * 256 + d]); }
    __syncthreads();
    for (int half = 0; half < 2; ++half) {
        const int trow = half * 32 + rt * 16;
        const bf16x8 x0 = *(const LAS bf16x8*)(XC + (trow + fr) * 264 + nb * 64 + 8 * fq), x1 = *(const LAS bf16x8*)(XC + (trow + fr) * 264 + nb * 64 + 32 + 8 * fq);
#pragma unroll
        for (int dt = 0; dt < 4; ++dt) {
            f32x4 ar = {0.f, 0.f, 0.f, 0.f}, ai = {0.f, 0.f, 0.f, 0.f};
            ar = mfma16(x0, fa[dt][0], ar); ar = mfma16(x1, fa[dt][1], ar); ai = mfma16(x0, fx[dt][0], ai); ai = mfma16(x1, fx[dt][1], ai);
            const int d = nb * 64 + dt * 16 + fr;
#pragma unroll
            for (int r = 0; r < 4; ++r) { const int tl = rt * 16 + 4 * fq + r;
                const float xcv = bf2f(XC[(half * 32 + tl) * 264 + d]);
                const float rr = sigmoidf_(ar[r] + ba[dt]), ii = sigmoidf_(ai[r] + bx[dt]);
                const float a = fexp_(rr * spl[dt]);
                const float u = fsqrt_(fmaxf(1.0f - a * a, 0.f)) * (ii * xcv);
                AU[tl * 257 + d] = (f32x2){a, u}; }
        }
        __syncthreads();
        if (tid < 256) {
#pragma unroll 8
            for (int tk = 0; tk < 32; ++tk) { const f32x2 au = AU[tk * 257 + tid]; hcar = au.x * hcar + au.y; aprod *= au.x; if (mode == 1) AU[tk * 257 + tid].y = hcar; }
        }
        if (mode == 1) {
            __syncthreads();
            const int tk = tid >> 4, c0 = (tid & 15) * 16; const size_t tok = (size_t)b * SEQ + n * 64 + half * 32 + tk;
            const u32x4 g0 = *(const u32x4*)(z + tok * ZP + Z_LG + c0), g1 = *(const u32x4*)(z + tok * ZP + Z_LG + c0 + 8);
            const unsigned gws[8] = {g0.x, g0.y, g0.z, g0.w, g1.x, g1.y, g1.z, g1.w}; unsigned ow[8];
#pragma unroll
            for (int j = 0; j < 8; ++j) { const float h0 = AU[tk * 257 + c0 + 2 * j].y, h1 = AU[tk * 257 + c0 + 2 * j + 1].y; ow[j] = pk2(h0 * geluf_(bflo(gws[j])), h1 * geluf_(bfhi(gws[j]))); }
            bf16_t* yp = y + tok * DM + 256 + c0;
            *(u32x4*)yp = (u32x4){ow[0], ow[1], ow[2], ow[3]}; *(u32x4*)(yp + 8) = (u32x4){ow[4], ow[5], ow[6], ow[7]};
        }
        __syncthreads();
    }
    if (mode == 0 && tid < 256) { sumA[(b * 32 + n) * 256 + tid] = aprod; sumH[(b * 32 + n) * 256 + tid] = hcar; }
}

constexpr int LC_XC = 0, LC_AU = 9216;
__device__ __forceinline__ void lru_chain_item(const Params& P, int l, LAS unsigned char* lds, int it, int tid, int wave, int lane) {
    const int b = it >> 2, nb = it & 3, fr = lane & 15, fq = lane >> 4;
    const bf16_t* z = (const bf16_t*)(P.ws + WS_R); bf16_t* y = (bf16_t*)(P.ws + WS_R + R_Y);
    LAS bf16_t* XC = (LAS bf16_t*)(lds + LC_XC); LAS f32x2* AU = (LAS f32x2*)(lds + LC_AU);
    const int c = tid >> 3, cg = tid & 7, ch0 = nb * 64 + cg * 8;
    f32x4 cw0[4], cw1[4];
#pragma unroll
    for (int kk = 0; kk < 4; ++kk) { cw0[kk] = *(const f32x4*)(P.lru_conv_w + (size_t)l * 1024 + kk * 256 + ch0); cw1[kk] = *(const f32x4*)(P.lru_conv_w + (size_t)l * 1024 + kk * 256 + ch0 + 4); }
    const f32x4 cb0 = *(const f32x4*)(P.lru_conv_b + l * 256 + ch0), cb1 = *(const f32x4*)(P.lru_conv_b + l * 256 + ch0 + 4);
    const int rt = wave >> 1, dt0 = (wave & 1) * 2;
    const bf16_t* wa = wl(P, l, W_A) + nb * 4096; const bf16_t* wx = wl(P, l, W_X) + nb * 4096;
    bf16x8 fa[2][2], fx[2][2]; float ba[2], bx[2], spl[2];
#pragma unroll
    for (int t = 0; t < 2; ++t) {
#pragma unroll
        for (int s = 0; s < 2; ++s) { fa[t][s] = *(const bf16x8*)(wa + ((dt0 + t) * 16 + fr) * 64 + 32 * s + 8 * fq); fx[t][s] = *(const bf16x8*)(wx + ((dt0 + t) * 16 + fr) * 64 + 32 * s + 8 * fq); }
        const int d = nb * 64 + (dt0 + t) * 16 + fr; ba[t] = P.lru_ba[l * 256 + d]; bx[t] = P.lru_bx[l * 256 + d]; spl[t] = -8.0f * softplusf_(-P.lru_lambda[l * 256 + d]); }
    const size_t tok0 = (size_t)b * SEQ + c;
    u32x4 xr[4], gr;
#define LC_LOAD(n_) do { const size_t t_ = tok0 + (size_t)(n_) * 64; _Pragma("unroll") for (int kk = 0; kk < 4; ++kk) { const bool ok_ = (n_) * 64 + c - 3 + kk >= 0; \
        xr[kk] = *(const u32x4*)(z + (ok_ ? t_ - 3 + kk : t_) * ZP + Z_LX + ch0); } gr = *(const u32x4*)(z + t_ * ZP + Z_LG + ch0); } while (0)
    LC_LOAD(0);
    float hcar = 0.f;
    for (int n = 0; n < NCHUNK; ++n) {
        {
            float a[8] = {cb0.x, cb0.y, cb0.z, cb0.w, cb1.x, cb1.y, cb1.z, cb1.w};
#pragma unroll
            for (int kk = 0; kk < 4; ++kk) { const float mk = (n * 64 + c - 3 + kk >= 0) ? 1.f : 0.f; const f32x4 c0 = cw0[kk] * mk, c1 = cw1[kk] * mk; const u32x4 w = xr[kk];
                a[0] += c0.x * bflo(w.x); a[1] += c0.y * bfhi(w.x); a[2] += c0.z * bflo(w.y); a[3] += c0.w * bfhi(w.y);
                a[4] += c1.x * bflo(w.z); a[5] += c1.y * bfhi(w.z); a[6] += c1.z * bflo(w.w); a[7] += c1.w * bfhi(w.w); }
            u32x4 o; o.x = pk2(a[0], a[1]); o.y = pk2(a[2], a[3]); o.z = pk2(a[4], a[5]); o.w = pk2(a[6], a[7]);
            *(LAS u32x4*)(XC + c * 72 + cg * 8) = o;
        }
        const u32x4 gcur = gr;
        if (n + 1 < NCHUNK) LC_LOAD(n + 1);
        __syncthreads();
        {
            const bf16x8 x0 = *(const LAS bf16x8*)(XC + (rt * 16 + fr) * 72 + 8 * fq), x1 = *(const LAS bf16x8*)(XC + (rt * 16 + fr) * 72 + 32 + 8 * fq);
#pragma unroll
            for (int t = 0; t < 2; ++t) {
                f32x4 ar = {0.f, 0.f, 0.f, 0.f}, ai = {0.f, 0.f, 0.f, 0.f};
                ar = mfma16(x0, fa[t][0], ar); ar = mfma16(x1, fa[t][1], ar); ai = mfma16(x0, fx[t][0], ai); ai = mfma16(x1, fx[t][1], ai);
                const int dl = (dt0 + t) * 16 + fr;
#pragma unroll
                for (int r = 0; r < 4; ++r) { const int tl = rt * 16 + 4 * fq + r;
                    const float xcv = bf2f(XC[tl * 72 + dl]);
                    const float rr = sigmoidf_(ar[r] + ba[t]), ii = sigmoidf_(ai[r] + bx[t]);
                    const float av = fexp_(rr * spl[t]);
                    AU[tl * 65 + dl] = (f32x2){av, fsqrt_(fmaxf(1.0f - av * av, 0.f)) * (ii * xcv)}; }
            }
        }
        __syncthreads();
        if (tid < 64) {
#pragma unroll
            for (int blk = 0; blk < 4; ++blk) { f32x2 au[16];
#pragma unroll
                for (int k = 0; k < 16; ++k) au[k] = AU[(blk * 16 + k) * 65 + tid];
#pragma unroll
                for (int k = 0; k < 16; ++k) { hcar = au[k].x * hcar + au[k].y; au[k].y = hcar; }
#pragma unroll
                for (int k = 0; k < 16; ++k) AU[(blk * 16 + k) * 65 + tid].y = au[k].y; }
        }
        __syncthreads();
        {
            const unsigned gws[4] = {gcur.x, gcur.y, gcur.z, gcur.w}; unsigned ow[4];
#pragma unroll
            for (int j = 0; j < 4; ++j) ow[j] = pk2(AU[c * 65 + cg * 8 + 2 * j].y * geluf_(bflo(gws[j])), AU[c * 65 + cg * 8 + 2 * j + 1].y * geluf_(bfhi(gws[j])));
            *(u32x4*)(y + (tok0 + (size_t)n * 64) * DM + 256 + ch0) = (u32x4){ow[0], ow[1], ow[2], ow[3]};
        }
    }
#undef LC_LOAD
    __syncthreads();
}

constexpr int N_PHASES = 21;
constexpr int Q_RET = 64, Q_GDN = 32, Q_LRU = 64, Q_MLA = 512, Q_TOTAL = Q_RET + Q_GDN + Q_LRU + Q_MLA;

__global__ void __launch_bounds__(512, 2) hymba_fwd(Params P_) {
    extern __shared__ __attribute__((aligned(16))) unsigned char lds_raw[];
    LAS unsigned char* lds = (LAS unsigned char*)lds_raw;
    volatile LAS unsigned* LC = (volatile LAS unsigned*)(lds + LDS_CTL);
    const int G = gridDim.x;
#define SUB_TID() int tid2 = tid; asm volatile("" : "+v"(tid2)); const int lane2 = tid2 & 63, wave2 = __builtin_amdgcn_readfirstlane(tid2 >> 6); (void)lane2; (void)wave2
#if defined(__HIP_DEVICE_COMPILE__)
#define PH_PARAMS() const __attribute__((address_space(4))) Params* pp_ = (const __attribute__((address_space(4))) Params*)__builtin_amdgcn_kernarg_segment_ptr(); asm volatile("" : "+s"(pp_)); const Params P = *pp_
#else
#define PH_PARAMS() const Params P = P_
#endif
#define PH_TID() PH_PARAMS(); \
    bf16_t* xb = (bf16_t*)(P.ws + WS_XB); float* part = (float*)(P.ws + WS_PART); bf16_t* zb = (bf16_t*)(P.ws + WS_R); bf16_t* yb = (bf16_t*)(P.ws + WS_R + R_Y); bf16_t* oxb = (bf16_t*)(P.ws + WS_R + R_OX); (void)xb; (void)part; (void)zb; (void)yb; (void)oxb; \
    int tid = threadIdx.x; asm volatile("" : "+v"(tid)); const int lane = tid & 63, wave = __builtin_amdgcn_readfirstlane(tid >> 6); (void)lane; (void)wave
    unsigned* ctl = (unsigned*)(P_.ws + WS_CTL);
    if (threadIdx.x < 64) LC[threadIdx.x] = 0u;
    __syncthreads();
    const int lo = P_.ph_lo, hi = P_.ph_hi;
    XcdBarrier bar; bar.bar = ctl + CW_BAR; bar.x = 0; bar.st = LC;
    if (hi - lo > 1) bar = xcd_barrier_post(ctl + CW_BAR, LC);
#ifndef PHASE_MASK
#define PHASE_MASK 0xFFFFFFFFu
#endif
#define EN(t) ((PHASE_MASK >> (t)) & 1u)
#ifndef REPEAT_MASK
#define REPEAT_MASK 0u
#endif
#define REP(t) for (int rep_ = 0; rep_ <= (int)((REPEAT_MASK >> (t)) & 1u); ++rep_, (rep_ <= (int)((REPEAT_MASK >> (t)) & 1u) ? xcd_barrier(bar) : (void)0))
#define IN(k) (lo <= (k) && (k) < hi)
#define SEAM(k) do { if (IN(k) && IN((k) + 1)) xcd_barrier(bar); } while (0)


    if (IN(0) && EN(0)) REP(0) { PH_TID(); p0_prologue(P, lds, tid); __syncthreads(); }
    SEAM(0);
    if (IN(1) && EN(1)) REP(1) {
        PH_TID();
        const int which = blockIdx.x >> 6, l = which >> 1, isv = which & 1;
        if (which < 4) {
            const bf16_t* memn = (const bf16_t*)(P.ws + WS_GDN); const bf16_t* wkv = wl(P, l, W_KV);
            bf16_t* kout = (bf16_t*)(P.ws + WS_KVM + (size_t)l * KVM_LAYER); bf16_t* vout = kout + (size_t)4096 * 1024;
            pg8::Gemm g; pg8::EpiScaleBf16<0> E; pg8::StaticOrder S;
            if (!isv) { g = pg8::Gemm{memn, wkv, 4096, 1024, 1024}; E = pg8::EpiScaleBf16<0>{kout, 1024, nullptr}; S.init(4096, 1024, 64, blockIdx.x & 63); }
            else { g = pg8::Gemm{wkv + (size_t)1024 * 1024, memn, 1024, 4096, 1024}; E = pg8::EpiScaleBf16<0>{vout, 4096, nullptr}; S.init(1024, 4096, 64, blockIdx.x & 63); }
            pg8::gemm_phase(lds, g, S, E, tid);
        }
    }
    SEAM(1);
#pragma unroll
    for (int l = 0; l < 2; ++l) {
        const int pb = 2 + 9 * l;
        if (IN(pb + 0) && EN(2)) REP(2) { PH_TID();
            pg8::Gemm g{xb, wl(P, l, W_IN), T_TOK, ZP, DM}; pg8::StaticOrder S; S.init(T_TOK, ZP, G, blockIdx.x);
            pg8::EpiScaleBf16<0> E{zb, ZP, part}; pg8::gemm_phase(lds, g, S, E, tid);
        }
        SEAM(pb + 0);
        if (IN(pb + 1)) {
            PH_TID();
            if (EN(3)) REP(3) { SUB_TID(); for (int it = blockIdx.x; it < 1024; it += G) gdn_pre_item(P, l, lds, it, tid2); }
            if (EN(5)) REP(5) { SUB_TID(); for (int rt = blockIdx.x * 8 + wave2; rt < 2048; rt += G * 8) mla_pre_tile(P, l, rt, lane2); }
        }
        SEAM(pb + 1);
        if (IN(pb + 2)) {
            PH_TID();
            for (int rep2_ = 0; rep2_ <= (int)((REPEAT_MASK >> 17) & 1u); ++rep2_, (rep2_ <= (int)((REPEAT_MASK >> 17) & 1u) ? xcd_barrier(bar) : (void)0)) {
            unsigned* qh0 = ctl + CW_QUEUE + 64 * l + 16 * rep2_;
#define QUEUE_LOOP(qi_, count_, body_) for (;;) { if (tid == 0) LC[4] = __hip_atomic_fetch_add(qh + (qi_), 1u, __ATOMIC_RELAXED, __HIP_MEMORY_SCOPE_AGENT); \
                __syncthreads(); const int it = (int)LC[4]; __syncthreads(); if (it >= (count_)) break; { SUB_TID(); body_; } __syncthreads(); }
            if (EN(6)) REP(6) { unsigned* qh = qh0 + 32 * rep_; QUEUE_LOOP(0, Q_RET, ret_chain_item(P, l, lds, it, tid2, wave2, lane2)) }
            if (EN(7)) REP(7) { unsigned* qh = qh0 + 32 * rep_; QUEUE_LOOP(1, Q_GDN, gdn_chain_item(P, l, lds, it, tid2, wave2, lane2)) }
            if (EN(8)) REP(8) { unsigned* qh = qh0 + 32 * rep_; QUEUE_LOOP(2, Q_LRU, lru_chain_item(P, l, lds, it, tid2, wave2, lane2)) }
            if (EN(9)) REP(9) { unsigned* qh = qh0 + 32 * rep_; QUEUE_LOOP(3, Q_MLA, mla_attn_item(P, lds, it, tid2, wave2, lane2)) }
#undef QUEUE_LOOP
            }
        }
        SEAM(pb + 2);
        if (IN(pb + 3) && EN(10)) REP(10) { PH_TID();
            pg8::Gemm g{yb, wl(P, l, W_OUT), T_TOK, DM, DM}; pg8::StaticOrder S; S.init(T_TOK, DM, G, blockIdx.x);
            pg8::EpiResid E{P.out, xb, part, rep_ ? 0.f : 1.f}; pg8::gemm_phase(lds, g, S, E, tid);
        }
        SEAM(pb + 3);
        if (IN(pb + 4) && EN(11)) REP(11) { PH_TID();
            pg8::Gemm g{xb, wl(P, l, W_Q), T_TOK, DM, DM}; pg8::StaticOrder S; S.init(T_TOK, DM, G, blockIdx.x);
            pg8::EpiScaleBf16<0> E{zb, DM, part}; pg8::gemm_phase(lds, g, S, E, tid);
        }
        SEAM(pb + 4);
        if (IN(pb + 5) && EN(12)) REP(12) { PH_TID(); for (int it = blockIdx.x; it < 1024; it += G) { xa_item(P, l, lds, it, tid, wave, lane); __syncthreads(); } }
        SEAM(pb + 5);
        if (IN(pb + 6) && EN(13)) REP(13) { PH_TID();
            pg8::Gemm g{oxb, wl(P, l, W_O), T_TOK, DM, DM}; pg8::StaticOrder S; S.init(T_TOK, DM, G, blockIdx.x);
            pg8::EpiResid E{P.out, xb, part, rep_ ? 0.f : 1.f}; pg8::gemm_phase(lds, g, S, E, tid);
        }
        SEAM(pb + 6);
        if (IN(pb + 7) && EN(14)) REP(14) { PH_TID();
            pg8::Gemm g{xb, wl(P, l, W_1), T_TOK, DFF, DM}; pg8::StaticOrder S; S.init(T_TOK, DFF, G, blockIdx.x);
            pg8::EpiScaleBf16<1> E{zb, DFF, part}; pg8::gemm_phase(lds, g, S, E, tid);
        }
        SEAM(pb + 7);
        if (IN(pb + 8) && EN(15)) REP(15) { PH_TID();
            pg8::Gemm g{zb, wl(P, l, W_2), T_TOK, DM, DFF}; pg8::StaticOrder S; S.init(T_TOK, DM, G, blockIdx.x);
            pg8::EpiResid E{P.out, xb, part, rep_ ? 0.f : 1.f}; pg8::gemm_phase(lds, g, S, E, tid);
        }
        SEAM(pb + 8);
    }
    if (IN(20) && EN(16)) { PH_TID(); final_norm_phase(P, tid); }
#undef IN
#undef SEAM
}

extern "C" void kernel_launch(void* const* d_in, const int* in_sizes, int n_in, void* d_out, int out_size, void* d_ws, size_t ws_size, hipStream_t stream) {
    static int grid = 0;
    if (grid == 0) {
        if (n_in != 31 || out_size != T_TOK * DM || ws_size < WS_END) { fprintf(stderr, "kernel_launch: unexpected shapes (n_in %d out %d ws %zu, need %zu)\n", n_in, out_size, ws_size, (size_t)WS_END); grid = -1; return; }
        if (hipFuncSetAttribute((const void*)hymba_fwd, hipFuncAttributeMaxDynamicSharedMemorySize, LDS_BYTES) != hipSuccess) { fprintf(stderr, "kernel_launch: hipFuncSetAttribute failed\n"); grid = -1; return; }
        int dev = 0, cus = 0, per_cu = 0;
        (void)hipGetDevice(&dev); (void)hipDeviceGetAttribute(&cus, hipDeviceAttributeMultiprocessorCount, dev);
        (void)hipOccupancyMaxActiveBlocksPerMultiprocessor(&per_cu, (const void*)hymba_fwd, 512, LDS_BYTES);
        (void)hipGetLastError();
        if (cus != 256 || per_cu < 1) fprintf(stderr, "kernel_launch: note: cus %d per_cu %d\n", cus, per_cu);
        grid = 256;
    }
    if (grid < 0) return;
    (void)hipMemsetAsync((char*)d_ws + WS_CTL, 0, CTL_BYTES, stream);
    Params p{};
    p.x = (const float*)d_in[0]; p.mem = (const float*)d_in[1]; p.pos = (const int*)d_in[2];
    p.norm_mix = (const float*)d_in[3]; p.w_in = (const float*)d_in[4]; p.ret_gn = (const float*)d_in[5];
    p.lru_conv_w = (const float*)d_in[6]; p.lru_conv_b = (const float*)d_in[7]; p.lru_wa = (const float*)d_in[8]; p.lru_ba = (const float*)d_in[9];
    p.lru_wx = (const float*)d_in[10]; p.lru_bx = (const float*)d_in[11]; p.lru_lambda = (const float*)d_in[12];
    p.mla_q_norm = (const float*)d_in[13]; p.mla_w_uq = (const float*)d_in[14]; p.mla_kv_norm = (const float*)d_in[15]; p.mla_w_ukv = (const float*)d_in[16];
    p.gdn_conv_w = (const float*)d_in[17]; p.gdn_a_log = (const float*)d_in[18]; p.gdn_dt_bias = (const float*)d_in[19]; p.gdn_norm = (const float*)d_in[20];
    p.w_out = (const float*)d_in[21]; p.norm_xattn = (const float*)d_in[22]; p.norm_mem = (const float*)d_in[23];
    p.xa_wq = (const float*)d_in[24]; p.xa_wkv = (const float*)d_in[25]; p.xa_wo = (const float*)d_in[26];
    p.norm_mlp = (const float*)d_in[27]; p.mlp_w1 = (const float*)d_in[28]; p.mlp_w2 = (const float*)d_in[29]; p.final_norm = (const float*)d_in[30];
    p.out = (float*)d_out; p.ws = (unsigned char*)d_ws;
#if N_LAUNCHES == 1
    p.ph_lo = 0; p.ph_hi = N_PHASES;
    void* args[] = {&p};
    hipError_t e = hipLaunchCooperativeKernel((const void*)hymba_fwd, dim3(grid), dim3(512), args, LDS_BYTES, stream);
    if (e != hipSuccess) fprintf(stderr, "kernel_launch: cooperative launch failed: %s\n", hipGetErrorString(e));
#else
    for (int ph = 0; ph < N_PHASES; ++ph) { p.ph_lo = ph; p.ph_hi = ph + 1; hipLaunchKernelGGL(hymba_fwd, dim3(grid), dim3(512), LDS_BYTES, stream, p); }
#endif
}
```

```cpp
#include <hip/hip_runtime.h>
#include <cstdio>
#include <cstdint>

#ifndef N_LAUNCHES
#define N_LAUNCHES 1
#endif

#define LAS __attribute__((address_space(3)))
typedef unsigned short bf16_t;
typedef short bf16x8 __attribute__((ext_vector_type(8)));
typedef float f32x4 __attribute__((ext_vector_type(4)));
typedef float f32x2 __attribute__((ext_vector_type(2)));
typedef unsigned u32x4 __attribute__((ext_vector_type(4)));
typedef unsigned u32x2 __attribute__((ext_vector_type(2)));

constexpr int T_TOK = 32768, DM = 1024, SEQ = 2048, NBATCH = 16, NCHUNK = 32, ZP = 3072, DFF = 4096, NMEM = 256;
constexpr int Z_RQ = 0, Z_RK = 256, Z_RV = 512, Z_RG = 768, Z_LX = 1024, Z_LG = 1280, Z_CQ = 1536, Z_CKV = 1728, Z_KR = 1856,
              Z_GQKV = 1888, Z_GG = 2656, Z_GB = 2912, Z_GA = 2916, IN_COLS = 2920;
constexpr float EPS = 1e-6f;
constexpr float LOG2E = 1.4426950408889634f;

constexpr size_t MiB = 1024 * 1024;
constexpr size_t WS_CTL = 0;
constexpr size_t CTL_BYTES = 65536;
constexpr size_t WS_PART = WS_CTL + CTL_BYTES;
constexpr size_t WS_LRUS = WS_PART + (size_t)T_TOK * 16 * 4;
constexpr size_t WS_GL = WS_LRUS + (size_t)2 * 16 * 32 * 256 * 4;
constexpr size_t WS_W = WS_GL + 65536;
constexpr size_t W_IN = 0, W_OUT = W_IN + (size_t)ZP * DM, W_Q = W_OUT + (size_t)DM * DM, W_KV = W_Q + (size_t)DM * DM, W_O = W_KV + (size_t)2 * DM * DM,
                 W_1 = W_O + (size_t)DM * DM, W_2 = W_1 + (size_t)DFF * DM, W_UQ = W_2 + (size_t)DFF * DM, W_UKV = W_UQ + 384 * 192, W_A = W_UKV + 512 * 128,
                 W_X = W_A + 4 * 64 * 64, W_LAYER = W_X + 4 * 64 * 64;
constexpr size_t WS_XB = WS_W + 2 * W_LAYER * 2;
constexpr size_t XB_BYTES = (size_t)T_TOK * DM * 2;
constexpr size_t MLA_Q_OFF = 0, MLA_K_OFF = (size_t)T_TOK * 4 * 96 * 2, MLA_VT_OFF = 2 * MLA_K_OFF;
constexpr size_t WS_KVM = WS_XB + XB_BYTES;
constexpr size_t KVM_LAYER = (size_t)2 * 4096 * 1024 * 2;
constexpr size_t WS_R = WS_KVM + 2 * KVM_LAYER;
constexpr size_t R_Y = (size_t)T_TOK * ZP * 2;
constexpr size_t R_OX = (size_t)T_TOK * DM * 2;
constexpr size_t WS_GDN = WS_R + 256 * MiB;
constexpr size_t WS_END = WS_GDN + 80 * MiB;
static_assert(WS_END <= 512 * MiB, "workspace map exceeds 512 MiB");
static_assert(WS_XB % 256 == 0 && WS_R % 256 == 0 && WS_GDN % 256 == 0 && WS_W % 256 == 0, "alignment");
constexpr int CW_BAR = 0;
constexpr int CW_QUEUE = 4096;

constexpr int LDS_BYTES = 160 * 1024;
constexpr int LDS_CTL = LDS_BYTES - 256;

typedef __bf16 bf16x2_t __attribute__((ext_vector_type(2)));
__device__ __forceinline__ unsigned pk2(float lo, float hi) { f32x2 t = {lo, hi}; bf16x2_t v = __builtin_convertvector(t, bf16x2_t); return __builtin_bit_cast(unsigned, v); }
__device__ __forceinline__ float bflo(unsigned w) { return __uint_as_float(w << 16); }
__device__ __forceinline__ float bfhi(unsigned w) { return __uint_as_float(w & 0xffff0000u); }
__device__ __forceinline__ float bf2f(bf16_t v) { return __uint_as_float((unsigned)v << 16); }
__device__ __forceinline__ bf16_t f2bf(float f) { return (bf16_t)(pk2(f, 0.f) & 0xffffu); }
__device__ __forceinline__ f32x4 mfma16(bf16x8 a, bf16x8 b, f32x4 c) { return __builtin_amdgcn_mfma_f32_16x16x32_bf16(a, b, c, 0, 0, 0); }
__device__ __forceinline__ float fexp2_(float x) { return __builtin_amdgcn_exp2f(x); }
__device__ __forceinline__ float fexp_(float x) { return __builtin_amdgcn_exp2f(x * LOG2E); }
__device__ __forceinline__ float frcp_(float x) { return __builtin_amdgcn_rcpf(x); }
__device__ __forceinline__ float frsq_(float x) { return __builtin_amdgcn_rsqf(x); }
__device__ __forceinline__ float fsqrt_(float x) { return __builtin_amdgcn_sqrtf(x); }
__device__ __forceinline__ float sigmoidf_(float x) { return frcp_(1.0f + fexp_(-x)); }
__device__ __forceinline__ float siluf_(float x) { return x * frcp_(1.0f + fexp_(-x)); }
__device__ __forceinline__ float softplusf_(float x) { return x > 20.f ? x : log1pf(__expf(x)); }
__device__ __forceinline__ float geluf_(float x) { const float u = 1.5957691216057308f * (x + 0.044715f * x * x * x); return x * frcp_(1.0f + fexp_(-u)); }
__device__ __forceinline__ float wave_sum(float v) {
#pragma unroll
    for (int o = 1; o < 64; o <<= 1) v += __shfl_xor(v, o);
    return v;
}
__device__ __forceinline__ void sincos_rev(float ang, float& s, float& c) {
    float rev = ang * 0.15915494309189535f; rev = rev - floorf(rev);
    s = __builtin_amdgcn_sinf(rev); c = __builtin_amdgcn_cosf(rev);
}
__device__ __forceinline__ bf16x8 mk8(u32x2 lo, u32x2 hi) { u32x4 t; t.x = lo.x; t.y = lo.y; t.z = hi.x; t.w = hi.y; return __builtin_bit_cast(bf16x8, t); }
__device__ __forceinline__ bf16x8 pack8(f32x4 a, f32x4 b) { u32x4 t; t.x = pk2(a.x, a.y); t.y = pk2(a.z, a.w); t.z = pk2(b.x, b.y); t.w = pk2(b.z, b.w); return __builtin_bit_cast(bf16x8, t); }

#define XB_TMO      128
#define XB_XCNT(j)  (256  + 64 * (j))
#define XB_XSUB(j)  (1280 + 64 * (j))
#define XB_XGEN(j)  (2304 + 64 * (j))
#define XB_TOP      3328
#define XB_TOPGEN   3392
#define XCD_BAR_WORDS 3456
#define XB_SPIN_CAP (1u << 22)
__device__ __forceinline__ unsigned xb_ld(unsigned* p)              { return __hip_atomic_load(p, __ATOMIC_RELAXED, __HIP_MEMORY_SCOPE_AGENT); }
__device__ __forceinline__ unsigned xb_add(unsigned* p, unsigned v) { return __hip_atomic_fetch_add(p, v, __ATOMIC_RELAXED, __HIP_MEMORY_SCOPE_AGENT); }
__device__ __forceinline__ unsigned xb_xcc_id() { return (unsigned)__builtin_amdgcn_s_getreg((3 << 11) | 20) & 0xFu; }
#define XB_SPIN(cond, bar) do { unsigned _sp = 0; while (cond) { __builtin_amdgcn_s_sleep(1); \
    if ((++_sp & 255u) == 0u) { if (xb_ld(&(bar)[XB_TMO])) break; if (_sp > XB_SPIN_CAP) { atomicAdd(&(bar)[XB_TMO], 1u); break; } } } } while (0)
struct XcdBarrier { unsigned* bar; unsigned x; volatile LAS unsigned* st; };
__device__ __forceinline__ XcdBarrier xcd_barrier_post(unsigned* bar, volatile LAS unsigned* st) {
    XcdBarrier b; b.bar = bar; b.x = xb_xcc_id(); b.st = st;
    if (threadIdx.x == 0) (void)xb_add(&bar[XB_XCNT(b.x)], 1u);
    return b;
}
__device__ __forceinline__ void xcd_barrier_complete(unsigned* bar, unsigned x, unsigned& nloc, unsigned& nx) {
    const unsigned G = gridDim.x * gridDim.y * gridDim.z;
    unsigned sum, cnt, mine, sp = 0u;
    for (;;) {
        sum = 0u; cnt = 0u; mine = 0u;
#pragma unroll
        for (unsigned j = 0; j < 16; ++j) { const unsigned c = xb_ld(&bar[XB_XCNT(j)]); sum += c; cnt += (c > 0u) ? 1u : 0u; mine = (j == x) ? c : mine; }
        if (sum == G) break;
        __builtin_amdgcn_s_sleep(1);
        if ((++sp & 255u) == 0u) { if (xb_ld(&bar[XB_TMO])) break; if (sp > XB_SPIN_CAP) { atomicAdd(&bar[XB_TMO], 1u); break; } }
    }
    nloc = mine > 0u ? mine : 1u; nx = cnt > 0u ? cnt : 1u;
}
__device__ __forceinline__ void xcd_barrier(const XcdBarrier& b) {
    asm volatile("s_waitcnt vmcnt(0)" ::: "memory");
    __syncthreads();
    if (threadIdx.x == 0) {
        unsigned* bar = b.bar;
        __builtin_amdgcn_s_waitcnt(0);
        unsigned nloc = b.st[0], nx = b.st[1];
        if (nloc == 0u) { xcd_barrier_complete(bar, b.x, nloc, nx); b.st[0] = nloc; b.st[1] = nx; }
        const unsigned old = xb_add(&bar[XB_XSUB(b.x)], 1u);
        const unsigned gen = old / nloc;
        if (old + 1u == (gen + 1u) * nloc) {
            __builtin_amdgcn_fence(__ATOMIC_RELEASE, "agent");
            asm volatile("s_waitcnt vmcnt(0)" ::: "memory");
            const unsigned og = xb_add(&bar[XB_TOP], 1u);
            const unsigned tg = og / nx;
            if (og + 1u == (tg + 1u) * nx) xb_add(&bar[XB_TOPGEN], 1u);
            else XB_SPIN(xb_ld(&bar[XB_TOPGEN]) == tg, bar);
            __builtin_amdgcn_fence(__ATOMIC_ACQUIRE, "agent");
            xb_add(&bar[XB_XGEN(b.x)], 1u);
            asm volatile("s_waitcnt vmcnt(0)" ::: "memory");
        } else {
            XB_SPIN(xb_ld(&bar[XB_XGEN(b.x)]) == gen, bar);
            __builtin_amdgcn_fence(__ATOMIC_ACQUIRE, "agent");
            asm volatile("s_waitcnt vmcnt(0)" ::: "memory");
        }
    }
    __syncthreads();
}

namespace pg8 {
constexpr int BM = 256, BK = 64, HALF = 128, HTB = HALF * BK * 2, STAGE_BYTES = 8 * HTB, NXCD = 8, WGM = 8;
__host__ __device__ __forceinline__ int lds_byte(int r, int c) { const int st = (r >> 4) * 2 + (c >> 5), rr = r & 15, cc = c & 31, ob = rr * 64 + cc * 2; return st * 1024 + (ob ^ (((ob >> 9) & 1) << 5)); }
__host__ __device__ __forceinline__ void stage_rc(int b, int& R, int& C) { const int st = b / 1024, sb = b % 1024, swz = sb ^ (((sb >> 9) & 1) << 5); R = (st >> 1) * 16 + swz / 64; C = (st & 1) * 32 + (swz % 64) / 2; }
__host__ __device__ __forceinline__ int perm32(int rho) { const int n = rho >> 4, i = rho & 15; return 8 * (i >> 2) + 4 * n + (i & 3); }
struct Unit { int pm, pn; };
struct Gemm { const bf16_t* A; const bf16_t* Bt; int M, N, K; };
struct StaticOrder {
    int nM, nN, nwg, G, c;
    __host__ __device__ void init(int M, int N, int G_, int c_) { nM = M / BM; nN = N / BM; nwg = nM * nN; G = G_; c = c_; }
    __host__ __device__ bool next(int i, Unit& u) const {
        const long L = (long)i * G + c; if (L >= nwg) return false;
        int wgid = (int)L; { const int q = nwg / NXCD, r = nwg % NXCD, xcd = wgid % NXCD, off = wgid / NXCD; wgid = (xcd < r ? xcd * (q + 1) : r * (q + 1) + (xcd - r) * q) + off; }
        const int nig = WGM * nN, gid = wgid / nig, fm = gid * WGM, gsz = (nM - fm) < WGM ? (nM - fm) : WGM;
        u.pm = fm + ((wgid % nig) % gsz); u.pn = (wgid % nig) / gsz; return true;
    }
    __device__ __forceinline__ void a_ready(const Unit&) const {}
    __device__ __forceinline__ void done(const Unit&) const {}
};

template <int ACT> struct EpiScaleBf16 {
    static constexpr bool PERM = true;
    bf16_t* O; int ldc; const float* part;
    __device__ __forceinline__ void operator()(const f32x4 (&acc)[2][2][4][2], const Unit& u, int wr, int wc, int fr, int fq) const {
        const int row0 = u.pm * BM + wr * 64 + fr, col0 = u.pn * BM + wc * 32 + 8 * fq;
#pragma unroll
        for (int ai = 0; ai < 2; ++ai)
#pragma unroll
            for (int m = 0; m < 4; ++m) {
                const int row = row0 + ai * HALF + m * 16;
                float sc = 1.0f;
                if (part) { const f32x4* pp = (const f32x4*)(part + (size_t)row * 16); const f32x4 a = pp[0], b = pp[1], c = pp[2], d = pp[3];
                    const float s = ((a.x + a.y) + (a.z + a.w)) + ((b.x + b.y) + (b.z + b.w)) + ((c.x + c.y) + (c.z + c.w)) + ((d.x + d.y) + (d.z + d.w));
                    sc = frsq_(s * (1.0f / 1024.0f) + EPS); }
                bf16_t* rowp = O + (size_t)row * ldc + col0;
#pragma unroll
                for (int bj = 0; bj < 2; ++bj) { f32x4 v0 = acc[ai][bj][m][0] * sc, v1 = acc[ai][bj][m][1] * sc;
                    if (ACT == 1) {
#pragma unroll
                        for (int j = 0; j < 4; ++j) { const float a0 = fmaxf(v0[j], 0.f), a1 = fmaxf(v1[j], 0.f); v0[j] = a0 * a0; v1[j] = a1 * a1; } }
                    u32x4 w; w.x = pk2(v0[0], v0[1]); w.y = pk2(v0[2], v0[3]); w.z = pk2(v1[0], v1[1]); w.w = pk2(v1[2], v1[3]);
                    *(u32x4*)(rowp + bj * HALF) = w; }
            }
    }
};
struct EpiResid {
    static constexpr bool PERM = false;
    float* X; bf16_t* XB; float* part; float alpha;
    __device__ __forceinline__ void operator()(const f32x4 (&acc)[2][2][4][2], const Unit& u, int wr, int wc, int fr, int fq) const {
        const int row0 = u.pm * BM + wr * 64 + fr, col0 = u.pn * BM + wc * 32 + 4 * fq;
#pragma unroll
        for (int ai = 0; ai < 2; ++ai)
#pragma unroll
            for (int m = 0; m < 4; ++m) {
                const int row = row0 + ai * HALF + m * 16;
                float* xp = X + (size_t)row * DM + col0; bf16_t* bp = XB + (size_t)row * DM + col0;
                float ss = 0.f;
#pragma unroll
                for (int bj = 0; bj < 2; ++bj)
#pragma unroll
                    for (int n = 0; n < 2; ++n) { const f32x4 v = *(const f32x4*)(xp + bj * HALF + n * 16) + acc[ai][bj][m][n] * alpha;
                        *(f32x4*)(xp + bj * HALF + n * 16) = v; ss += (v.x * v.x + v.y * v.y) + (v.z * v.z + v.w * v.w);
                        u32x2 w; w.x = pk2(v.x, v.y); w.y = pk2(v.z, v.w); *(u32x2*)(bp + bj * HALF + n * 16) = w; }
                ss += __shfl_xor(ss, 16); ss += __shfl_xor(ss, 32);
                if (fq == 0) part[(size_t)row * 16 + u.pn * 4 + wc] = ss;
            }
    }
};

template <class Epi, class Sched>
__device__ __forceinline__ void gemm_phase(LAS unsigned char* lds, const Gemm g, const Sched& S, const Epi& E, const int tid) {
    const int wid = __builtin_amdgcn_readfirstlane(tid >> 6), lane = tid & 63, wr = wid >> 2, wc = wid & 3, fr = lane & 15, fq = lane >> 4;
    const int K = g.K, nt = K / BK;
    unsigned voffA[2], voffB[2];
#pragma unroll
    for (int i = 0; i < 2; ++i) { int R, C; stage_rc(tid * 16 + i * 8192, R, C); const int Rb = Epi::PERM ? ((R & ~31) + perm32(R & 31)) : R;
        voffA[i] = (unsigned)(R * K + C) * 2u; voffB[i] = (unsigned)(Rb * K + C) * 2u; }
    const size_t kstep = (size_t)(BK * 2);
    const size_t hstep = (size_t)HALF * K * 2;
    const size_t tstep = 2 * hstep;
    const unsigned ldsw = (unsigned)wid * 1024u;
    const int aoff = lds_byte(wr * 64 + fr, fq * 8), boff = lds_byte(wc * 32 + fr, fq * 8);
#define PG8_SA(b, h) (((b) * 2 + (h)) * HTB)
#define PG8_SB(b, h) ((4 + (b) * 2 + (h)) * HTB)
#define PG8_STAGE(bufoff, gbase, voff) do { _Pragma("unroll") for (int _i = 0; _i < 2; ++_i) \
        __builtin_amdgcn_global_load_lds((const unsigned*)((const char*)(gbase) + (voff)[_i]), (LAS unsigned*)(lds + (bufoff) + ldsw + _i * 8192), 16, 0, 0); } while (0)
#define PG8_LDA(dst, b, h) do { _Pragma("unroll") for (int m = 0; m < 4; ++m) _Pragma("unroll") for (int k = 0; k < 2; ++k) dst[m][k] = *(const LAS bf16x8*)(lds + PG8_SA(b, h) + aoff + m * 2048 + k * 1024); } while (0)
#define PG8_LDB(dst, b, h) do { _Pragma("unroll") for (int n = 0; n < 2; ++n) _Pragma("unroll") for (int k = 0; k < 2; ++k) dst[n][k] = *(const LAS bf16x8*)(lds + PG8_SB(b, h) + boff + n * 2048 + k * 1024); } while (0)
#define PG8_MMA(ai, bj, At, Bt) do { __builtin_amdgcn_s_setprio(1); _Pragma("unroll") for (int m = 0; m < 4; ++m) _Pragma("unroll") for (int n = 0; n < 2; ++n) _Pragma("unroll") for (int k = 0; k < 2; ++k) \
        acc[ai][bj][m][n] = __builtin_amdgcn_mfma_f32_16x16x32_bf16(Bt[n][k], At[m][k], acc[ai][bj][m][n], 0, 0, 0); __builtin_amdgcn_s_setprio(0); } while (0)
#define PG8_WAIT_V(n) asm volatile("s_waitcnt vmcnt(" #n ")" ::: "memory")
#define PG8_WAIT_L(n) asm volatile("s_waitcnt lgkmcnt(" #n ")" ::: "memory")
#define PG8_BAR __builtin_amdgcn_s_barrier()
#define PG8_SCHED __builtin_amdgcn_sched_barrier(0)
    Unit cur, nxt; int ui = 0;
    if (!S.next(0, cur)) return;
    f32x4 acc[2][2][4][2];
#pragma unroll
    for (int a = 0; a < 2; ++a)
#pragma unroll
        for (int b = 0; b < 2; ++b)
#pragma unroll
            for (int m = 0; m < 4; ++m)
#pragma unroll
                for (int n = 0; n < 2; ++n) acc[a][b][m][n] = (f32x4){0.f, 0.f, 0.f, 0.f};
    bf16x8 At[4][2], B0[2][2], B1[2][2];
    const char* cA = (const char*)g.A + (size_t)cur.pm * tstep; const char* cB = (const char*)g.Bt + (size_t)cur.pn * tstep;
    S.a_ready(cur);
    PG8_STAGE(PG8_SB(0, 0), cB, voffB); PG8_STAGE(PG8_SA(0, 0), cA, voffA); PG8_STAGE(PG8_SB(0, 1), cB + hstep, voffB); PG8_STAGE(PG8_SA(0, 1), cA + hstep, voffA);
    if (wr == 1) PG8_BAR;
    PG8_WAIT_V(4); PG8_BAR;
    PG8_STAGE(PG8_SB(1, 0), cB + kstep, voffB); PG8_STAGE(PG8_SA(1, 0), cA + kstep, voffA); PG8_STAGE(PG8_SB(1, 1), cB + hstep + kstep, voffB);
    PG8_WAIT_V(6); PG8_BAR;
    for (;;) {
        const bool has_next = S.next(ui + 1, nxt);
        const char* nA = has_next ? (const char*)g.A + (size_t)nxt.pm * tstep : cA; const char* nB = has_next ? (const char*)g.Bt + (size_t)nxt.pn * tstep : cB;
        for (int t = 0; t < nt; t += 2) {
            const bool last = (t == nt - 2);
            const char* a1 = cA + (size_t)(t + 1) * kstep;
            const char* a2 = last ? nA : cA + (size_t)(t + 2) * kstep; const char* b2 = last ? nB : cB + (size_t)(t + 2) * kstep;
            const char* a3 = a2 + kstep; const char* b3 = b2 + kstep;
            if (last && has_next) S.a_ready(nxt);
            PG8_LDB(B0, 0, 0); PG8_SCHED; PG8_LDA(At, 0, 0); PG8_STAGE(PG8_SA(1, 1), a1 + hstep, voffA);
            PG8_WAIT_L(8); PG8_BAR; PG8_WAIT_L(0); PG8_MMA(0, 0, At, B0); PG8_BAR; PG8_SCHED;
            PG8_LDB(B1, 0, 1); PG8_STAGE(PG8_SB(0, 0), b2, voffB);
            PG8_BAR; PG8_WAIT_L(0); PG8_MMA(0, 1, At, B1); PG8_BAR;
            PG8_LDA(At, 0, 1); PG8_STAGE(PG8_SA(0, 0), a2, voffA);
            PG8_BAR; PG8_WAIT_L(0); PG8_MMA(1, 0, At, B0); PG8_BAR; PG8_SCHED;
            PG8_STAGE(PG8_SB(0, 1), b2 + hstep, voffB);
            PG8_WAIT_V(6); PG8_BAR; PG8_MMA(1, 1, At, B1); PG8_BAR;
            PG8_LDB(B0, 1, 0); PG8_SCHED; PG8_LDA(At, 1, 0); PG8_STAGE(PG8_SA(0, 1), a2 + hstep, voffA);
            PG8_WAIT_L(8); PG8_BAR; PG8_WAIT_L(0); PG8_MMA(0, 0, At, B0); PG8_BAR; PG8_SCHED;
            PG8_LDB(B1, 1, 1); PG8_STAGE(PG8_SB(1, 0), b3, voffB);
            PG8_BAR; PG8_WAIT_L(0); PG8_MMA(0, 1, At, B1); PG8_BAR;
            PG8_LDA(At, 1, 1); PG8_STAGE(PG8_SA(1, 0), a3, voffA);
            PG8_BAR; PG8_WAIT_L(0); PG8_MMA(1, 0, At, B0); PG8_BAR; PG8_SCHED;
            PG8_STAGE(PG8_SB(1, 1), b3 + hstep, voffB);
            PG8_WAIT_V(6); PG8_BAR; PG8_MMA(1, 1, At, B1); PG8_BAR;
        }
        E(acc, cur, wr, wc, fr, fq); S.done(cur);
        if (!has_next) break;
#pragma unroll
        for (int a = 0; a < 2; ++a)
#pragma unroll
            for (int b = 0; b < 2; ++b)
#pragma unroll
                for (int m = 0; m < 4; ++m)
#pragma unroll
                    for (int n = 0; n < 2; ++n) acc[a][b][m][n] = (f32x4){0.f, 0.f, 0.f, 0.f};
        cur = nxt; cA = nA; cB = nB; ++ui;
    }
    PG8_WAIT_V(0);
    if (wr == 0) PG8_BAR;
    PG8_BAR;
#undef PG8_SA
#undef PG8_SB
#undef PG8_STAGE
#undef PG8_LDA
#undef PG8_LDB
#undef PG8_MMA
#undef PG8_WAIT_V
#undef PG8_WAIT_L
#undef PG8_BAR
#undef PG8_SCHED
}
}

struct Params {
    const float* x; const float* mem; const int* pos;
    const float* norm_mix; const float* w_in; const float* ret_gn;
    const float* lru_conv_w; const float* lru_conv_b; const float* lru_wa; const float* lru_ba; const float* lru_wx; const float* lru_bx; const float* lru_lambda;
    const float* mla_q_norm; const float* mla_w_uq; const float* mla_kv_norm; const float* mla_w_ukv;
    const float* gdn_conv_w; const float* gdn_a_log; const float* gdn_dt_bias; const float* gdn_norm;
    const float* w_out; const float* norm_xattn; const float* norm_mem; const float* xa_wq; const float* xa_wkv; const float* xa_wo;
    const float* norm_mlp; const float* mlp_w1; const float* mlp_w2; const float* final_norm;
    float* out; unsigned char* ws;
    int ph_lo, ph_hi;
};

__device__ __forceinline__ bf16_t* wl(const Params& P, int l, size_t off) { return (bf16_t*)(P.ws + WS_W) + (size_t)l * W_LAYER + off; }

__device__ __forceinline__ void transpose_tile(const float* src, int K, int N, const float* gain, float scale, bf16_t* dst, int kb, int nb, LAS float* scr, int tid) {
#pragma unroll
    for (int i = 0; i < 8; ++i) { const int kk = (tid >> 6) + 8 * i, k = kb * 64 + kk, n = nb * 64 + (tid & 63);
        float v = 0.f; if (n < N) { v = src[(size_t)k * N + n] * scale; if (gain) v *= gain[k]; }
        scr[kk * 65 + (tid & 63)] = v; }
    __syncthreads();
    { const int nl = tid >> 3, k0 = (tid & 7) * 8; const LAS float* s = scr + k0 * 65 + nl;
      u32x4 o; o.x = pk2(s[0], s[65]); o.y = pk2(s[2 * 65], s[3 * 65]); o.z = pk2(s[4 * 65], s[5 * 65]); o.w = pk2(s[6 * 65], s[7 * 65]);
      *(u32x4*)(dst + (size_t)(nb * 64 + nl) * K + kb * 64 + k0) = o; }
    __syncthreads();
}
__device__ __forceinline__ void p0_prologue(const Params& P, LAS unsigned char* lds, int tid) {
    LAS float* scr = (LAS float*)lds;
    constexpr int T_IN = 16 * 48, T_SQ = 256, T_KV = 512, T_W1 = 1024, T_W2 = 1024, T_UQ = 18, T_UKV = 16, T_LRU = 8;
    constexpr int T_LAYER = T_IN + 3 * T_SQ + T_KV + T_W1 + T_W2 + T_UQ + T_UKV + T_LRU;
    for (int it = blockIdx.x; it < 2 * T_LAYER; it += gridDim.x) {
        const int l = it / T_LAYER; int r = it % T_LAYER;
        const float* src; const float* gain = nullptr; float scale = 1.f; bf16_t* dst; int K, N, nnb;
        if (r < T_IN) { src = P.w_in + (size_t)l * DM * IN_COLS; K = DM; N = IN_COLS; nnb = 48; gain = P.norm_mix + l * DM; dst = wl(P, l, W_IN); }
        else if ((r -= T_IN) < T_SQ) { src = P.w_out + (size_t)l * DM * DM; K = DM; N = DM; nnb = 16; dst = wl(P, l, W_OUT); }
        else if ((r -= T_SQ) < T_SQ) { src = P.xa_wq + (size_t)l * DM * DM; K = DM; N = DM; nnb = 16; gain = P.norm_xattn + l * DM; scale = 0.0625f * LOG2E; dst = wl(P, l, W_Q); }
        else if ((r -= T_SQ) < T_KV) { src = P.xa_wkv + (size_t)l * DM * 2 * DM; K = DM; N = 2 * DM; nnb = 32; gain = P.norm_mem + l * DM; dst = wl(P, l, W_KV); }
        else if ((r -= T_KV) < T_SQ) { src = P.xa_wo + (size_t)l * DM * DM; K = DM; N = DM; nnb = 16; dst = wl(P, l, W_O); }
        else if ((r -= T_SQ) < T_W1) { src = P.mlp_w1 + (size_t)l * DM * DFF; K = DM; N = DFF; nnb = 64; gain = P.norm_mlp + l * DM; dst = wl(P, l, W_1); }
        else if ((r -= T_W1) < T_W2) { src = P.mlp_w2 + (size_t)l * DFF * DM; K = DFF; N = DM; nnb = 16; dst = wl(P, l, W_2); }
        else if ((r -= T_W2) < T_UQ) { src = P.mla_w_uq + (size_t)l * 192 * 384; K = 192; N = 384; nnb = 6; gain = P.mla_q_norm + l * 192; dst = wl(P, l, W_UQ); }
        else if ((r -= T_UQ) < T_UKV) { src = P.mla_w_ukv + (size_t)l * 128 * 512; K = 128; N = 512; nnb = 8; gain = P.mla_kv_norm + l * 128; dst = wl(P, l, W_UKV); }
        else { r -= T_UKV; const int which = r >> 2, nb4 = r & 3; src = (which ? P.lru_wx : P.lru_wa) + (size_t)l * 4 * 4096 + nb4 * 4096; K = 64; N = 64; nnb = 1; dst = wl(P, l, which ? W_X : W_A) + nb4 * 4096; r = 0; }
        transpose_tile(src, K, N, gain, scale, dst, r / nnb, r % nnb, scr, tid);
    }
    const int wave = tid >> 6, lane = tid & 63;
    const int gw = blockIdx.x * 8 + wave, ngw = gridDim.x * 8;
    bf16_t* xb = (bf16_t*)(P.ws + WS_XB); float* part = (float*)(P.ws + WS_PART); bf16_t* memn = (bf16_t*)(P.ws + WS_GDN);
    for (int row = gw; row < T_TOK + NBATCH * NMEM; row += ngw) {
        const bool isx = row < T_TOK; const int r2 = isx ? row : row - T_TOK;
        const f32x4* src = (const f32x4*)((isx ? P.x : P.mem) + (size_t)r2 * DM) + lane;
        f32x4 v[4]; float s = 0.f;
#pragma unroll
        for (int j = 0; j < 4; ++j) { v[j] = src[64 * j]; s += (v[j].x * v[j].x + v[j].y * v[j].y) + (v[j].z * v[j].z + v[j].w * v[j].w); }
        s = wave_sum(s);
        if (isx) {
            f32x4* o = (f32x4*)(P.out + (size_t)row * DM) + lane; u32x2* ob = (u32x2*)(xb + (size_t)row * DM) + lane;
#pragma unroll
            for (int j = 0; j < 4; ++j) { o[64 * j] = v[j]; u32x2 w; w.x = pk2(v[j].x, v[j].y); w.y = pk2(v[j].z, v[j].w); ob[64 * j] = w; }
            if (lane < 16) part[(size_t)row * 16 + lane] = lane == 0 ? s : 0.f;
        } else {
            const float rs = frsq_(s * (1.0f / 1024.0f) + EPS); u32x2* ob = (u32x2*)(memn + (size_t)r2 * DM) + lane;
#pragma unroll
            for (int j = 0; j < 4; ++j) { u32x2 w; w.x = pk2(v[j].x * rs, v[j].y * rs); w.y = pk2(v[j].z * rs, v[j].w * rs); ob[64 * j] = w; }
        }
    }
}
__device__ __forceinline__ void final_norm_phase(const Params& P, int tid) {
    const int wave = tid >> 6, lane = tid & 63; const float* part = (const float*)(P.ws + WS_PART);
    f32x4 g[4];
#pragma unroll
    for (int j = 0; j < 4; ++j) g[j] = ((const f32x4*)P.final_norm)[64 * j + lane];
    for (int row = blockIdx.x * 8 + wave; row < T_TOK; row += gridDim.x * 8) {
        float s = lane < 16 ? part[(size_t)row * 16 + lane] : 0.f; s = wave_sum(s);
        const float rs = frsq_(s * (1.0f / 1024.0f) + EPS);
        f32x4* o = (f32x4*)(P.out + (size_t)row * DM) + lane;
#pragma unroll
        for (int j = 0; j < 4; ++j) { f32x4 v = o[64 * j]; o[64 * j] = v * rs * g[j]; }
    }
}

__device__ __forceinline__ void mla_pre_tile(const Params& P, int l, int rt, int lane) {
    const int fr = lane & 15, fq = lane >> 4;
    const bf16_t* z = (const bf16_t*)(P.ws + WS_R);
    bf16_t* Qo = (bf16_t*)(P.ws + WS_XB + MLA_Q_OFF); bf16_t* Ko = (bf16_t*)(P.ws + WS_XB + MLA_K_OFF); bf16_t* Vo = (bf16_t*)(P.ws + WS_XB + MLA_VT_OFF);
    const bf16_t* Wuq = wl(P, l, W_UQ); const bf16_t* Wukv = wl(P, l, W_UKV);
    const int tok0 = rt * 16, b = tok0 >> 11, s0 = tok0 & 2047;
    const bf16_t* zr = z + (size_t)(tok0 + fr) * ZP;
    bf16x8 cq[6], ckv[4]; float sq = 0.f, skv = 0.f;
#pragma unroll
    for (int s = 0; s < 6; ++s) { const u32x4 w = *(const u32x4*)(zr + Z_CQ + 32 * s + 8 * fq); cq[s] = __builtin_bit_cast(bf16x8, w);
        sq += bflo(w.x) * bflo(w.x) + bfhi(w.x) * bfhi(w.x) + bflo(w.y) * bflo(w.y) + bfhi(w.y) * bfhi(w.y) + bflo(w.z) * bflo(w.z) + bfhi(w.z) * bfhi(w.z) + bflo(w.w) * bflo(w.w) + bfhi(w.w) * bfhi(w.w); }
#pragma unroll
    for (int s = 0; s < 4; ++s) { const u32x4 w = *(const u32x4*)(zr + Z_CKV + 32 * s + 8 * fq); ckv[s] = __builtin_bit_cast(bf16x8, w);
        skv += bflo(w.x) * bflo(w.x) + bfhi(w.x) * bfhi(w.x) + bflo(w.y) * bflo(w.y) + bfhi(w.y) * bfhi(w.y) + bflo(w.z) * bflo(w.z) + bfhi(w.z) * bfhi(w.z) + bflo(w.w) * bflo(w.w) + bfhi(w.w) * bfhi(w.w); }
    sq += __shfl_xor(sq, 16); sq += __shfl_xor(sq, 32); skv += __shfl_xor(skv, 16); skv += __shfl_xor(skv, 32);
    const float rq = frsq_(sq * (1.0f / 192.0f) + EPS), rkv = frsq_(skv * (1.0f / 128.0f) + EPS);
    const float qsc = rq * 0.10206207261596575f * LOG2E;
    const float pos = (float)P.pos[tok0 + fr];
    float sn[4], cs[4];
#pragma unroll
    for (int r = 0; r < 4; ++r) { const float invf = exp2f(-(float)(4 * fq + r) * (13.287712379549449f / 16.0f)); sincos_rev(pos * invf, sn[r], cs[r]); }
    const size_t tokrow = (size_t)b * 4 * SEQ + (s0 + fr);
#pragma unroll 1
    for (int h = 0; h < 4; ++h) {
        bf16_t* qrow = Qo + (tokrow + (size_t)h * SEQ) * 96;
#pragma unroll 1
        for (int nt = 0; nt < 4; ++nt) { f32x4 a = {0.f, 0.f, 0.f, 0.f};
#pragma unroll
            for (int s = 0; s < 6; ++s) { const bf16x8 wf = *(const bf16x8*)(Wuq + (size_t)(h * 96 + nt * 16 + fr) * 192 + 32 * s + 8 * fq); a = mfma16(wf, cq[s], a); }
            a = a * qsc; u32x2 w; w.x = pk2(a.x, a.y); w.y = pk2(a.z, a.w); *(u32x2*)(qrow + nt * 16 + 4 * fq) = w; }
        f32x4 x1 = {0.f, 0.f, 0.f, 0.f}, x2 = {0.f, 0.f, 0.f, 0.f}, y1, y2;
#pragma unroll
        for (int s = 0; s < 6; ++s) { const bf16x8 wf1 = *(const bf16x8*)(Wuq + (size_t)(h * 96 + 64 + fr) * 192 + 32 * s + 8 * fq), wf2 = *(const bf16x8*)(Wuq + (size_t)(h * 96 + 80 + fr) * 192 + 32 * s + 8 * fq);
            x1 = mfma16(wf1, cq[s], x1); x2 = mfma16(wf2, cq[s], x2); }
        x1 = x1 * qsc; x2 = x2 * qsc;
#pragma unroll
        for (int r = 0; r < 4; ++r) { y1[r] = x1[r] * cs[r] - x2[r] * sn[r]; y2[r] = x1[r] * sn[r] + x2[r] * cs[r]; }
        { u32x2 w; w.x = pk2(y1.x, y1.y); w.y = pk2(y1.z, y1.w); *(u32x2*)(qrow + 64 + 4 * fq) = w; w.x = pk2(y2.x, y2.y); w.y = pk2(y2.z, y2.w); *(u32x2*)(qrow + 80 + 4 * fq) = w; }
    }
    u32x2 kr1, kr2;
    { const u32x2 a = *(const u32x2*)(zr + Z_KR + 4 * fq), c = *(const u32x2*)(zr + Z_KR + 16 + 4 * fq);
      const float x1[4] = {bflo(a.x), bfhi(a.x), bflo(a.y), bfhi(a.y)}, x2[4] = {bflo(c.x), bfhi(c.x), bflo(c.y), bfhi(c.y)}; float y1[4], y2[4];
#pragma unroll
      for (int r = 0; r < 4; ++r) { y1[r] = x1[r] * cs[r] - x2[r] * sn[r]; y2[r] = x1[r] * sn[r] + x2[r] * cs[r]; }
      kr1.x = pk2(y1[0], y1[1]); kr1.y = pk2(y1[2], y1[3]); kr2.x = pk2(y2[0], y2[1]); kr2.y = pk2(y2[2], y2[3]); }
    float rkv_r[4];
#pragma unroll
    for (int r = 0; r < 4; ++r) rkv_r[r] = __shfl(rkv, 4 * fq + r);
    const int chunk = s0 >> 6, key0 = (s0 & 63) + 4 * fq;
#pragma unroll 1
    for (int h = 0; h < 4; ++h) {
        bf16_t* krow = Ko + (tokrow + (size_t)h * SEQ) * 96;
#pragma unroll 1
        for (int nt = 0; nt < 4; ++nt) { f32x4 a = {0.f, 0.f, 0.f, 0.f};
#pragma unroll
            for (int s = 0; s < 4; ++s) { const bf16x8 wf = *(const bf16x8*)(Wukv + (size_t)(h * 128 + nt * 16 + fr) * 128 + 32 * s + 8 * fq); a = mfma16(wf, ckv[s], a); }
            a = a * rkv; u32x2 w; w.x = pk2(a.x, a.y); w.y = pk2(a.z, a.w); *(u32x2*)(krow + nt * 16 + 4 * fq) = w; }
        *(u32x2*)(krow + 64 + 4 * fq) = kr1; *(u32x2*)(krow + 80 + 4 * fq) = kr2;
        bf16_t* vt = Vo + ((size_t)((b * 4 + h) * NCHUNK + chunk) * 64) * 64;
#pragma unroll 1
        for (int nt = 0; nt < 4; ++nt) { f32x4 a = {0.f, 0.f, 0.f, 0.f};
#pragma unroll
            for (int s = 0; s < 4; ++s) { const bf16x8 wf = *(const bf16x8*)(Wukv + (size_t)(h * 128 + 64 + nt * 16 + fr) * 128 + 32 * s + 8 * fq); a = mfma16(ckv[s], wf, a); }
            u32x2 w; w.x = pk2(a.x * rkv_r[0], a.y * rkv_r[1]); w.y = pk2(a.z * rkv_r[2], a.w * rkv_r[3]);
            *(u32x2*)(vt + (size_t)(nt * 16 + fr) * 64 + key0) = w; }
    }
}

constexpr int MP_UQ_ROW = 200, MP_UKV_ROW = 136, MP_UKV_OFF = 96 * MP_UQ_ROW * 2, MP_BUF = MP_UKV_OFF + 128 * MP_UKV_ROW * 2;
__device__ __forceinline__ void mla_pre_item(const Params& P, int l, LAS unsigned char* lds, int it, int tid, int wave, int lane) {
    const int fr = lane & 15, fq = lane >> 4, rt = it * 8 + wave;
    const bf16_t* z = (const bf16_t*)(P.ws + WS_R);
    bf16_t* Qo = (bf16_t*)(P.ws + WS_XB + MLA_Q_OFF); bf16_t* Ko = (bf16_t*)(P.ws + WS_XB + MLA_K_OFF); bf16_t* Vo = (bf16_t*)(P.ws + WS_XB + MLA_VT_OFF);
    const bf16_t* Wuq = wl(P, l, W_UQ); const bf16_t* Wukv = wl(P, l, W_UKV);
    u32x4 stg[5];
#define MP_LOADQ(h_) do { _Pragma("unroll") for (int i = 0; i < 5; ++i) { const int p = tid + 512 * i; if (p < 2304) stg[i] = *(const u32x4*)(Wuq + (size_t)(h_) * 96 * 192 + (size_t)p * 8); } } while (0)
#define MP_STOREQ(buf_) do { _Pragma("unroll") for (int i = 0; i < 5; ++i) { const int p = tid + 512 * i; if (p < 2304) { const int row = p / 24, pc = p % 24; *(LAS u32x4*)(lds + (buf_) * MP_BUF + (row * MP_UQ_ROW + pc * 8) * 2) = stg[i]; } } } while (0)
#define MP_LOADKV(h_) do { _Pragma("unroll") for (int i = 0; i < 4; ++i) { const int p = tid + 512 * i; stg[i] = *(const u32x4*)(Wukv + (size_t)(h_) * 128 * 128 + (size_t)p * 8); } } while (0)
#define MP_STOREKV(buf_) do { _Pragma("unroll") for (int i = 0; i < 4; ++i) { const int p = tid + 512 * i, row = p >> 4, pc = p & 15; *(LAS u32x4*)(lds + (buf_) * MP_BUF + MP_UKV_OFF + (row * MP_UKV_ROW + pc * 8) * 2) = stg[i]; } } while (0)
    MP_LOADQ(0); MP_STOREQ(0); MP_LOADKV(0);
    const int tok0 = rt * 16, b = tok0 >> 11, s0 = tok0 & 2047;
    const bf16_t* zr = z + (size_t)(tok0 + fr) * ZP;
    bf16x8 cq[6], ckv[4]; float sq = 0.f, skv = 0.f;
#pragma unroll
    for (int s = 0; s < 6; ++s) { const u32x4 w = *(const u32x4*)(zr + Z_CQ + 32 * s + 8 * fq); cq[s] = __builtin_bit_cast(bf16x8, w);
        sq += bflo(w.x) * bflo(w.x) + bfhi(w.x) * bfhi(w.x) + bflo(w.y) * bflo(w.y) + bfhi(w.y) * bfhi(w.y) + bflo(w.z) * bflo(w.z) + bfhi(w.z) * bfhi(w.z) + bflo(w.w) * bflo(w.w) + bfhi(w.w) * bfhi(w.w); }
#pragma unroll
    for (int s = 0; s < 4; ++s) { const u32x4 w = *(const u32x4*)(zr + Z_CKV + 32 * s + 8 * fq); ckv[s] = __builtin_bit_cast(bf16x8, w);
        skv += bflo(w.x) * bflo(w.x) + bfhi(w.x) * bfhi(w.x) + bflo(w.y) * bflo(w.y) + bfhi(w.y) * bfhi(w.y) + bflo(w.z) * bflo(w.z) + bfhi(w.z) * bfhi(w.z) + bflo(w.w) * bflo(w.w) + bfhi(w.w) * bfhi(w.w); }
    const u32x2 kra = *(const u32x2*)(zr + Z_KR + 4 * fq), krc = *(const u32x2*)(zr + Z_KR + 16 + 4 * fq);
    const float pos = (float)P.pos[tok0 + fr];
    MP_STOREKV(0);
    sq += __shfl_xor(sq, 16); sq += __shfl_xor(sq, 32); skv += __shfl_xor(skv, 16); skv += __shfl_xor(skv, 32);
    const float rq = frsq_(sq * (1.0f / 192.0f) + EPS), rkv = frsq_(skv * (1.0f / 128.0f) + EPS);
    const float qsc = rq * 0.10206207261596575f * LOG2E;
    float sn[4], cs[4];
#pragma unroll
    for (int r = 0; r < 4; ++r) { const float invf = exp2f(-(float)(4 * fq + r) * (13.287712379549449f / 16.0f)); sincos_rev(pos * invf, sn[r], cs[r]); }
    const size_t tokrow = (size_t)b * 4 * SEQ + (s0 + fr);
    u32x2 kr1, kr2;
    { const float x1[4] = {bflo(kra.x), bfhi(kra.x), bflo(kra.y), bfhi(kra.y)}, x2[4] = {bflo(krc.x), bfhi(krc.x), bflo(krc.y), bfhi(krc.y)}; float y1[4], y2[4];
#pragma unroll
      for (int r = 0; r < 4; ++r) { y1[r] = x1[r] * cs[r] - x2[r] * sn[r]; y2[r] = x1[r] * sn[r] + x2[r] * cs[r]; }
      kr1.x = pk2(y1[0], y1[1]); kr1.y = pk2(y1[2], y1[3]); kr2.x = pk2(y2[0], y2[1]); kr2.y = pk2(y2[2], y2[3]); }
    float rkv_r[4];
#pragma unroll
    for (int r = 0; r < 4; ++r) rkv_r[r] = __shfl(rkv, 4 * fq + r);
    const int chunk = s0 >> 6, key0 = (s0 & 63) + 4 * fq;
    __syncthreads();
#pragma unroll 1
    for (int h = 0; h < 4; ++h) {
        if (h < 3) MP_LOADQ(h + 1);
        const LAS bf16_t* UQ = (const LAS bf16_t*)(lds + (h & 1) * MP_BUF); const LAS bf16_t* UKV = (const LAS bf16_t*)(lds + (h & 1) * MP_BUF + MP_UKV_OFF);
        bf16_t* qrow = Qo + (tokrow + (size_t)h * SEQ) * 96; bf16_t* krow = Ko + (tokrow + (size_t)h * SEQ) * 96;
        bf16_t* vt = Vo + ((size_t)((b * 4 + h) * NCHUNK + chunk) * 64) * 64;
#pragma unroll 1
        for (int nt = 0; nt < 4; ++nt) { f32x4 a = {0.f, 0.f, 0.f, 0.f};
#pragma unroll
            for (int s = 0; s < 6; ++s) a = mfma16(*(const LAS bf16x8*)(UQ + (nt * 16 + fr) * MP_UQ_ROW + 32 * s + 8 * fq), cq[s], a);
            a = a * qsc; u32x2 w; w.x = pk2(a.x, a.y); w.y = pk2(a.z, a.w); *(u32x2*)(qrow + nt * 16 + 4 * fq) = w; }
        {   f32x4 x1 = {0.f, 0.f, 0.f, 0.f}, x2 = {0.f, 0.f, 0.f, 0.f}, y1, y2;
#pragma unroll
            for (int s = 0; s < 6; ++s) { x1 = mfma16(*(const LAS bf16x8*)(UQ + (64 + fr) * MP_UQ_ROW + 32 * s + 8 * fq), cq[s], x1); x2 = mfma16(*(const LAS bf16x8*)(UQ + (80 + fr) * MP_UQ_ROW + 32 * s + 8 * fq), cq[s], x2); }
            x1 = x1 * qsc; x2 = x2 * qsc;
#pragma unroll
            for (int r = 0; r < 4; ++r) { y1[r] = x1[r] * cs[r] - x2[r] * sn[r]; y2[r] = x1[r] * sn[r] + x2[r] * cs[r]; }
            u32x2 w; w.x = pk2(y1.x, y1.y); w.y = pk2(y1.z, y1.w); *(u32x2*)(qrow + 64 + 4 * fq) = w; w.x = pk2(y2.x, y2.y); w.y = pk2(y2.z, y2.w); *(u32x2*)(qrow + 80 + 4 * fq) = w; }
        if (h < 3) { MP_STOREQ((h + 1) & 1); MP_LOADKV(h + 1); }
#pragma unroll 1
        for (int nt = 0; nt < 4; ++nt) { f32x4 a = {0.f, 0.f, 0.f, 0.f};
#pragma unroll
            for (int s = 0; s < 4; ++s) a = mfma16(*(const LAS bf16x8*)(UKV + (nt * 16 + fr) * MP_UKV_ROW + 32 * s + 8 * fq), ckv[s], a);
            a = a * rkv; u32x2 w; w.x = pk2(a.x, a.y); w.y = pk2(a.z, a.w); *(u32x2*)(krow + nt * 16 + 4 * fq) = w; }
        *(u32x2*)(krow + 64 + 4 * fq) = kr1; *(u32x2*)(krow + 80 + 4 * fq) = kr2;
#pragma unroll 1
        for (int nt = 0; nt < 4; ++nt) { f32x4 a = {0.f, 0.f, 0.f, 0.f};
#pragma unroll
            for (int s = 0; s < 4; ++s) a = mfma16(ckv[s], *(const LAS bf16x8*)(UKV + (64 + nt * 16 + fr) * MP_UKV_ROW + 32 * s + 8 * fq), a);
            u32x2 w; w.x = pk2(a.x * rkv_r[0], a.y * rkv_r[1]); w.y = pk2(a.z * rkv_r[2], a.w * rkv_r[3]);
            *(u32x2*)(vt + (size_t)(nt * 16 + fr) * 64 + key0) = w; }
        if (h < 3) MP_STOREKV((h + 1) & 1);
        __syncthreads();
    }
#undef MP_LOADQ
#undef MP_STOREQ
#undef MP_LOADKV
#undef MP_STOREKV
}

template <int DQK, int DV, int KT, int QT>
__device__ __forceinline__ void flash_item(LAS unsigned char* lds, const bf16_t* Qw, int ldq, const bf16_t* Kb, int ldk, const bf16_t* VTb, int ldv, int vts,
                                           bf16_t* Ow, int ldo, int ntiles, int wave_limit, int tid, int lane) {
    constexpr int KROW = DQK + 8, VROW = KT + 8, KS = DQK / 32, ET = DV / 16, NKT = KT / 16, KBYTES = KT * KROW * 2, BUF = KBYTES + DV * VROW * 2;
    constexpr int KP = KT * DQK / 8, VPR = KT / 8, VP = DV * VPR, NKP = (KP + 511) / 512, NVP = (VP + 511) / 512, NP = NKP > NVP ? NKP : NVP;
    const int fr = lane & 15, fq = lane >> 4;
    bf16x8 qf[QT][KS];
#pragma unroll
    for (int qi = 0; qi < QT; ++qi)
#pragma unroll
        for (int s = 0; s < KS; ++s) qf[qi][s] = *(const bf16x8*)(Qw + (size_t)(qi * 16 + fr) * ldq + 32 * s + 8 * fq);
    f32x4 ot[QT][ET];
#pragma unroll
    for (int qi = 0; qi < QT; ++qi)
#pragma unroll
        for (int e = 0; e < ET; ++e) ot[qi][e] = (f32x4){0.f, 0.f, 0.f, 0.f};
    float m_run[QT], l_run[QT];
#pragma unroll
    for (int qi = 0; qi < QT; ++qi) { m_run[qi] = -1e30f; l_run[qi] = 0.f; }
    u32x4 preg[NP];
#define FL_LOADK(j_) do { _Pragma("unroll") for (int i = 0; i < NKP; ++i) { const int idx = tid + i * 512; if (idx < KP) { const int row = idx / (DQK / 8), pc = idx % (DQK / 8); \
            preg[i] = *(const u32x4*)(Kb + (size_t)((j_) * KT + row) * ldk + pc * 8); } } } while (0)
#define FL_LOADV(j_) do { _Pragma("unroll") for (int i = 0; i < NVP; ++i) { const int idx = tid + i * 512; if (idx < VP) { const int row = idx / VPR, pc = idx % VPR; \
            preg[i] = *(const u32x4*)(VTb + (size_t)(j_) * vts + (size_t)row * ldv + pc * 8); } } } while (0)
#define FL_STOREK(buf_) do { LAS bf16_t* Kt_ = (LAS bf16_t*)(lds + (buf_) * BUF); \
        _Pragma("unroll") for (int i = 0; i < NKP; ++i) { const int idx = tid + i * 512; if (idx < KP) { const int row = idx / (DQK / 8), pc = idx % (DQK / 8); *(LAS u32x4*)(Kt_ + row * KROW + pc * 8) = preg[i]; } } } while (0)
#define FL_STOREV(buf_) do { LAS bf16_t* Vt_ = (LAS bf16_t*)(lds + (buf_) * BUF + KBYTES); \
        _Pragma("unroll") for (int i = 0; i < NVP; ++i) { const int idx = tid + i * 512; if (idx < VP) { const int row = idx / VPR, pc = idx % VPR; *(LAS u32x4*)(Vt_ + row * VROW + pc * 8) = preg[i]; } } } while (0)
    FL_LOADK(0); FL_STOREK(0); FL_LOADV(0); FL_STOREV(0);
    __syncthreads();
#pragma unroll 1
    for (int j = 0; j < ntiles; ++j) {
        const bool more = j + 1 < ntiles, act = j < wave_limit;
        const LAS bf16_t* Kt = (const LAS bf16_t*)(lds + (j & 1) * BUF); const LAS bf16_t* Vt = (const LAS bf16_t*)(lds + (j & 1) * BUF + KBYTES);
        if (more) FL_LOADK(j + 1);
        f32x4 st[QT][NKT];
        if (act) {
#pragma unroll
            for (int kt = 0; kt < NKT; ++kt) {
#pragma unroll
                for (int qi = 0; qi < QT; ++qi) st[qi][kt] = (f32x4){0.f, 0.f, 0.f, 0.f};
#pragma unroll
                for (int s = 0; s < KS; ++s) { const bf16x8 kf = *(const LAS bf16x8*)(Kt + (kt * 16 + fr) * KROW + 32 * s + 8 * fq);
#pragma unroll
                    for (int qi = 0; qi < QT; ++qi) st[qi][kt] = mfma16(kf, qf[qi][s], st[qi][kt]); } }
        }
        if (more) { FL_STOREK((j + 1) & 1); FL_LOADV(j + 1); }
        if (act) {
            bf16x8 pf[QT][NKT / 2];
#pragma unroll
            for (int qi = 0; qi < QT; ++qi) {
                float mx = fmaxf(fmaxf(st[qi][0].x, st[qi][0].y), fmaxf(st[qi][0].z, st[qi][0].w));
#pragma unroll
                for (int kt = 1; kt < NKT; ++kt) mx = fmaxf(mx, fmaxf(fmaxf(st[qi][kt].x, st[qi][kt].y), fmaxf(st[qi][kt].z, st[qi][kt].w)));
                mx = fmaxf(mx, __shfl_xor(mx, 16)); mx = fmaxf(mx, __shfl_xor(mx, 32));
                const float m_new = fmaxf(m_run[qi], mx), alpha = fexp2_(m_run[qi] - m_new);
                float ls = 0.f;
#pragma unroll
                for (int kt = 0; kt < NKT; ++kt)
#pragma unroll
                    for (int r = 0; r < 4; ++r) { const float p = fexp2_(st[qi][kt][r] - m_new); st[qi][kt][r] = p; ls += p; }
                l_run[qi] = l_run[qi] * alpha + ls; m_run[qi] = m_new;
#pragma unroll
                for (int e = 0; e < ET; ++e) ot[qi][e] = ot[qi][e] * alpha;
#pragma unroll
                for (int k2 = 0; k2 < NKT / 2; ++k2) pf[qi][k2] = pack8(st[qi][2 * k2], st[qi][2 * k2 + 1]);
            }
#pragma unroll
            for (int e = 0; e < ET; ++e) {
                const LAS bf16_t* vr = Vt + (e * 16 + fr) * VROW + 4 * fq;
#pragma unroll
                for (int k2 = 0; k2 < NKT / 2; ++k2) { const bf16x8 v0 = mk8(*(const LAS u32x2*)(vr + 32 * k2), *(const LAS u32x2*)(vr + 32 * k2 + 16));
#pragma unroll
                    for (int qi = 0; qi < QT; ++qi) ot[qi][e] = mfma16(v0, pf[qi][k2], ot[qi][e]); }
            }
        }
        if (more) FL_STOREV((j + 1) & 1);
        __syncthreads();
    }
#undef FL_LOADK
#undef FL_LOADV
#undef FL_STOREK
#undef FL_STOREV
#pragma unroll
    for (int qi = 0; qi < QT; ++qi) {
        float l = l_run[qi]; l += __shfl_xor(l, 16); l += __shfl_xor(l, 32);
        const float inv = frcp_(l);
#pragma unroll
        for (int e = 0; e < ET; ++e) { u32x2 w; w.x = pk2(ot[qi][e].x * inv, ot[qi][e].y * inv); w.y = pk2(ot[qi][e].z * inv, ot[qi][e].w * inv);
            *(u32x2*)(Ow + (size_t)(qi * 16 + fr) * ldo + e * 16 + 4 * fq) = w; }
    }
}
__device__ __forceinline__ void mla_attn_item(const Params& P, LAS unsigned char* lds, int it, int tid, int wave, int lane) {
    const int qt = 7 - (it >> 6), bh = it & 63;
    const bf16_t* Q = (const bf16_t*)(P.ws + WS_XB + MLA_Q_OFF) + ((size_t)bh * SEQ + qt * 256 + wave * 32) * 96;
    const bf16_t* K = (const bf16_t*)(P.ws + WS_XB + MLA_K_OFF) + (size_t)bh * SEQ * 96;
    const bf16_t* VT = (const bf16_t*)(P.ws + WS_XB + MLA_VT_OFF) + (size_t)bh * NCHUNK * 4096;
    bf16_t* y = (bf16_t*)(P.ws + WS_R + R_Y) + ((size_t)(bh >> 2) * SEQ + qt * 256 + wave * 32) * DM + 512 + (bh & 3) * 64;
    flash_item<96, 64, 64, 2>(lds, Q, 96, K, 96, VT, 64, 4096, y, DM, 4 * qt + 4, 4 * qt + (wave >> 1) + 1, tid, lane);
}
__device__ __forceinline__ void xa_item(const Params& P, int l, LAS unsigned char* lds, int it, int tid, int wave, int lane) {
    const int qt = it & 15, h = (it >> 4) & 3, b = it >> 6;
    const size_t qoff = ((size_t)b * SEQ + qt * 128 + wave * 16) * DM + h * 256;
    const bf16_t* Q = (const bf16_t*)(P.ws + WS_R) + qoff; bf16_t* O = (bf16_t*)(P.ws + WS_R + R_OX) + qoff;
    const bf16_t* K = (const bf16_t*)(P.ws + WS_KVM + (size_t)l * KVM_LAYER) + (size_t)b * NMEM * DM + h * 256;
    const bf16_t* VT = (const bf16_t*)(P.ws + WS_KVM + (size_t)l * KVM_LAYER + (size_t)4096 * 1024 * 2) + (size_t)h * 256 * 4096 + b * NMEM;
    flash_item<256, 256, 32, 1>(lds, Q, DM, K, DM, VT, 4096, 32, O, DM, 8, 8, tid, lane);
}

constexpr int GP_KN = 0, GP_KB = 9216, GP_QN = 18432, GP_L = 9216, GP_RHS = 27648, GP_G = 60416, GP_GC = 60672, GP_HEAD = 61440;
__device__ __forceinline__ bf16_t* gdn_buf(const Params& P, int chh, int k) { return (bf16_t*)(P.ws + WS_GDN) + ((size_t)chh * 5 + k) * 4096; }
__device__ __forceinline__ void gdn_pre_item(const Params& P, int l, LAS unsigned char* lds, int it, int tid) {
    const int hp = it & 1, n = (it >> 1) & 31, b = it >> 6;
    const int hh = tid >> 8, h = 2 * hp + hh, tt = tid & 255, c = tt >> 2, qr = tt & 3, lane = tid & 63;
    LAS unsigned char* L = lds + hh * GP_HEAD;
    const bf16_t* z = (const bf16_t*)(P.ws + WS_R);
    const int s = n * 64 + c; const size_t tok = (size_t)b * SEQ + s;
    const float* cw = P.gdn_conv_w + (size_t)l * 4 * 768;
    const int chh = (b * NCHUNK + n) * 4 + h;
    float q[16], k[16], v[16];
#pragma unroll
    for (int part = 0; part < 3; ++part) {
        float* dst = part == 0 ? q : (part == 1 ? k : v);
        const int ch0 = part * 256 + h * 64 + qr * 16;
#pragma unroll
        for (int i = 0; i < 16; ++i) dst[i] = 0.f;
#pragma unroll
        for (int kk = 0; kk < 4; ++kk) { {
            const bool okk = s - 3 + kk >= 0; const float mk = okk ? 1.f : 0.f;
            const bf16_t* zr = z + (okk ? tok - 3 + kk : tok) * ZP + Z_GQKV + ch0; const u32x4 w0 = *(const u32x4*)zr, w1 = *(const u32x4*)(zr + 8);
            const float* wr = cw + kk * 768 + ch0; const f32x4 c0 = *(const f32x4*)wr * mk, c1 = *(const f32x4*)(wr + 4) * mk, c2 = *(const f32x4*)(wr + 8) * mk, c3 = *(const f32x4*)(wr + 12) * mk;
            dst[0] += c0.x * bflo(w0.x); dst[1] += c0.y * bfhi(w0.x); dst[2] += c0.z * bflo(w0.y); dst[3] += c0.w * bfhi(w0.y);
            dst[4] += c1.x * bflo(w0.z); dst[5] += c1.y * bfhi(w0.z); dst[6] += c1.z * bflo(w0.w); dst[7] += c1.w * bfhi(w0.w);
            dst[8] += c2.x * bflo(w1.x); dst[9] += c2.y * bfhi(w1.x); dst[10] += c2.z * bflo(w1.y); dst[11] += c2.w * bfhi(w1.y);
            dst[12] += c3.x * bflo(w1.z); dst[13] += c3.y * bfhi(w1.z); dst[14] += c3.z * bflo(w1.w); dst[15] += c3.w * bfhi(w1.w); } }
#pragma unroll
        for (int i = 0; i < 16; ++i) dst[i] = siluf_(dst[i]);
    }
    float sq = 0.f, sk = 0.f;
#pragma unroll
    for (int i = 0; i < 16; ++i) { sq += q[i] * q[i]; sk += k[i] * k[i]; }
    sq += __shfl_xor(sq, 1); sq += __shfl_xor(sq, 2); sk += __shfl_xor(sk, 1); sk += __shfl_xor(sk, 2);
    const float rq = frsq_(sq + EPS) * 0.125f, rk = frsq_(sk + EPS);
    const bf16_t* zt = z + tok * ZP;
    const float beta = sigmoidf_(bf2f(zt[Z_GB + h]));
    const float g = -fexp_(P.gdn_a_log[l * 4 + h]) * softplusf_(bf2f(zt[Z_GA + h]) + P.gdn_dt_bias[l * 4 + h]);
    {
        u32x4 w0, w1;
#define PK16(dst0, dst1, src, sc) do { dst0.x = pk2(src[0] * (sc), src[1] * (sc)); dst0.y = pk2(src[2] * (sc), src[3] * (sc)); dst0.z = pk2(src[4] * (sc), src[5] * (sc)); dst0.w = pk2(src[6] * (sc), src[7] * (sc)); \
        dst1.x = pk2(src[8] * (sc), src[9] * (sc)); dst1.y = pk2(src[10] * (sc), src[11] * (sc)); dst1.z = pk2(src[12] * (sc), src[13] * (sc)); dst1.w = pk2(src[14] * (sc), src[15] * (sc)); } while (0)
        PK16(w0, w1, k, rk);        *(LAS u32x4*)(L + GP_KN + (c * 72 + qr * 16) * 2) = w0; *(LAS u32x4*)(L + GP_KN + (c * 72 + qr * 16 + 8) * 2) = w1;
        PK16(w0, w1, k, rk * beta); *(LAS u32x4*)(L + GP_KB + (c * 72 + qr * 16) * 2) = w0; *(LAS u32x4*)(L + GP_KB + (c * 72 + qr * 16 + 8) * 2) = w1;
        PK16(w0, w1, q, rq);        *(LAS u32x4*)(L + GP_QN + (c * 72 + qr * 16) * 2) = w0; *(LAS u32x4*)(L + GP_QN + (c * 72 + qr * 16 + 8) * 2) = w1;
        LAS float* rhs = (LAS float*)(L + GP_RHS) + c * 128 + qr * 16;
#pragma unroll
        for (int i = 0; i < 4; ++i) *(LAS f32x4*)(rhs + 4 * i) = (f32x4){v[4 * i] * beta, v[4 * i + 1] * beta, v[4 * i + 2] * beta, v[4 * i + 3] * beta};
        if (qr == 0) ((LAS float*)(L + GP_G))[c] = g;
    }
    __syncthreads();
    {
        float gc = 0.f, run = 0.f; const LAS float* G = (const LAS float*)(L + GP_G);
        for (int i = 0; i < 64; ++i) { run += G[i]; gc = (i == c) ? run : gc; }
        const float eg = fexp_(gc), ek = fexp_(run - gc);
        LAS float* rhs = (LAS float*)(L + GP_RHS) + c * 128 + 64 + qr * 16;
#pragma unroll
        for (int i = 0; i < 4; ++i) *(LAS f32x4*)(rhs + 4 * i) = (f32x4){k[4 * i] * rk * beta * eg, k[4 * i + 1] * rk * beta * eg, k[4 * i + 2] * rk * beta * eg, k[4 * i + 3] * rk * beta * eg};
        u32x4 w0, w1; PK16(w0, w1, q, rq * eg);
        bf16_t* qd = gdn_buf(P, chh, 3) + c * 64 + qr * 16; *(u32x4*)qd = w0; *(u32x4*)(qd + 8) = w1;
        bf16_t* kdt = gdn_buf(P, chh, 4) + (qr * 16) * 64 + c;
#pragma unroll
        for (int i = 0; i < 16; ++i) kdt[i * 64] = f2bf(k[i] * rk * ek);
        if (qr == 0) ((LAS float*)(L + GP_GC))[c] = gc;
        if (tt == 0) ((float*)(P.ws + WS_GL))[chh] = fexp_(run);
    }
#undef PK16
    __syncthreads();
    {
        const int it4 = (tid >> 6) & 3, fr = lane & 15, fq = lane >> 4;
        const LAS bf16_t* Kn = (const LAS bf16_t*)(L + GP_KN); const LAS bf16_t* KB = (const LAS bf16_t*)(L + GP_KB); const LAS bf16_t* Qn = (const LAS bf16_t*)(L + GP_QN);
        const LAS float* GC = (const LAS float*)(L + GP_GC);
        const bf16x8 a0 = *(const LAS bf16x8*)(KB + (it4 * 16 + fr) * 72 + 8 * fq), a1 = *(const LAS bf16x8*)(KB + (it4 * 16 + fr) * 72 + 32 + 8 * fq);
        const bf16x8 q0 = *(const LAS bf16x8*)(Qn + (it4 * 16 + fr) * 72 + 8 * fq), q1 = *(const LAS bf16x8*)(Qn + (it4 * 16 + fr) * 72 + 32 + 8 * fq);
        float gci[4];
#pragma unroll
        for (int r = 0; r < 4; ++r) gci[r] = GC[it4 * 16 + 4 * fq + r];
        f32x4 lv[4]; bf16_t* att = gdn_buf(P, chh, 2);
#pragma unroll
        for (int jt = 0; jt < 4; ++jt) {
            const bf16x8 b0 = *(const LAS bf16x8*)(Kn + (jt * 16 + fr) * 72 + 8 * fq), b1 = *(const LAS bf16x8*)(Kn + (jt * 16 + fr) * 72 + 32 + 8 * fq);
            f32x4 al = {0.f, 0.f, 0.f, 0.f}, aa = {0.f, 0.f, 0.f, 0.f};
            al = mfma16(a0, b0, al); al = mfma16(a1, b1, al); aa = mfma16(q0, b0, aa); aa = mfma16(q1, b1, aa);
            const int j = jt * 16 + fr; const float gcj = GC[j];
#pragma unroll
            for (int r = 0; r < 4; ++r) { const int i = it4 * 16 + 4 * fq + r; const float dec = fexp_(fminf(gci[r] - gcj, 0.f));
                lv[jt][r] = (i > j) ? al[r] * dec : 0.f; att[i * 64 + j] = f2bf((i >= j) ? aa[r] * dec : 0.f); }
        }
        __syncthreads();
        LAS float* Lm = (LAS float*)(L + GP_L);
#pragma unroll
        for (int jt = 0; jt < 4; ++jt)
#pragma unroll
            for (int r = 0; r < 4; ++r) Lm[(it4 * 16 + 4 * fq + r) * 64 + jt * 16 + fr] = lv[jt][r];
    }
    __syncthreads();
    if (tt < 128) {
        const LAS float* Lm = (const LAS float*)(L + GP_L); const LAS float* rhs = (const LAS float*)(L + GP_RHS) + tt;
        float x[64];
#pragma unroll
        for (int i = 0; i < 64; ++i) {
            float a0 = rhs[i * 128], a1 = 0.f;
#pragma unroll
            for (int j4 = 0; j4 < (i + 3) / 4; ++j4) { const f32x4 lr = *(const LAS f32x4*)(Lm + i * 64 + 4 * j4);
                if (4 * j4 + 0 < i) a0 -= lr.x * x[4 * j4 + 0]; if (4 * j4 + 1 < i) a1 -= lr.y * x[4 * j4 + 1];
                if (4 * j4 + 2 < i) a0 -= lr.z * x[4 * j4 + 2]; if (4 * j4 + 3 < i) a1 -= lr.w * x[4 * j4 + 3]; }
            x[i] = a0 + a1;
        }
        if (tt < 64) { bf16_t* ut = gdn_buf(P, chh, 1) + tt * 64;
#pragma unroll
            for (int g8 = 0; g8 < 8; ++g8) { u32x4 w; w.x = pk2(x[8 * g8], x[8 * g8 + 1]); w.y = pk2(x[8 * g8 + 2], x[8 * g8 + 3]); w.z = pk2(x[8 * g8 + 4], x[8 * g8 + 5]); w.w = pk2(x[8 * g8 + 6], x[8 * g8 + 7]); *(u32x4*)(ut + 8 * g8) = w; }
        } else { bf16_t* wo = gdn_buf(P, chh, 0) + (tt - 64);
#pragma unroll
            for (int i = 0; i < 64; ++i) wo[i * 64] = f2bf(x[i]); }
    }
    __syncthreads();
}

constexpr int GC_W = 0, GC_UT = 9216, GC_ATT = 18432, GC_QD = 27648, GC_KDT = 36864, GC_O = 46080, GC_BH = 62720;
__device__ __forceinline__ bf16x8 lds_perm(const LAS unsigned char* M, int row, int s, int fq) { const LAS unsigned char* p = M + row * 144 + 64 * s + 8 * fq; return mk8(*(const LAS u32x2*)p, *(const LAS u32x2*)(p + 32)); }
__device__ __forceinline__ void gdn_chain_item(const Params& P, int l, LAS unsigned char* lds, int gi, int tid, int wave, int lane) {
    const int q2 = wave >> 2, bh = gi * 2 + q2, eb = wave & 3, b = bh >> 2, h = bh & 3, fr = lane & 15, fq = lane >> 4;
    const bf16_t* z = (const bf16_t*)(P.ws + WS_R); bf16_t* y = (bf16_t*)(P.ws + WS_R + R_Y);
    LAS unsigned char* L = lds + q2 * GC_BH;
    const int tt = tid & 255, ec = tt >> 2, eq = tt & 3;
    float ng[16];
#pragma unroll
    for (int j = 0; j < 16; ++j) ng[j] = P.gdn_norm[l * 64 + eq * 16 + j];
    u32x4 stg[10];
    const bf16_t* src0[2] = { gdn_buf(P, ((gi * 2 >> 2) * NCHUNK) * 4 + ((gi * 2) & 3), 0), gdn_buf(P, (((gi * 2 + 1) >> 2) * NCHUNK) * 4 + ((gi * 2 + 1) & 3), 0) };
#define GC_LOAD(n_) do { _Pragma("unroll") for (int i = 0; i < 10; ++i) { const int p = tid + 512 * i, qq = p / 2560, pp = p % 2560; \
        stg[i] = *(const u32x4*)(src0[qq] + (size_t)(n_) * 4 * 5 * 4096 + (size_t)pp * 8); } } while (0)
#define GC_WRITE() do { _Pragma("unroll") for (int i = 0; i < 10; ++i) { const int p = tid + 512 * i, qq = p / 2560, pp = p % 2560, mat = pp >> 9, row = (pp & 511) >> 3, pc = pp & 7; \
        *(LAS u32x4*)(lds + qq * GC_BH + mat * 9216 + row * 144 + pc * 16) = stg[i]; } } while (0)
    GC_LOAD(0); GC_WRITE();
    f32x4 S[4];
#pragma unroll
    for (int t = 0; t < 4; ++t) S[t] = (f32x4){0.f, 0.f, 0.f, 0.f};
    __syncthreads();
    for (int n = 0; n < NCHUNK; ++n) {
        const int chh = (b * NCHUNK + n) * 4 + h;
        if (n + 1 < NCHUNK) GC_LOAD(n + 1);
        const size_t etok = (size_t)(gi * 2 + (tid >> 8) >> 2) * SEQ + n * 64 + ec; const int eh = (gi * 2 + (tid >> 8)) & 3;
        const u32x4 gw0 = *(const u32x4*)(z + etok * ZP + Z_GG + eh * 64 + eq * 16), gw1 = *(const u32x4*)(z + etok * ZP + Z_GG + eh * 64 + eq * 16 + 8);
        const float egl = ((const float*)(P.ws + WS_GL))[chh];
        const bf16x8 sb0 = pack8(S[0], S[1]), sb1 = pack8(S[2], S[3]);
        f32x4 vn[4], o[4];
#pragma unroll
        for (int ct = 0; ct < 4; ++ct) {
            f32x4 a = {0.f, 0.f, 0.f, 0.f}; a = mfma16(lds_perm(L + GC_W, ct * 16 + fr, 0, fq), sb0, a); a = mfma16(lds_perm(L + GC_W, ct * 16 + fr, 1, fq), sb1, a);
            const u32x2 uw = *(const LAS u32x2*)(L + GC_UT + (eb * 16 + fr) * 144 + (ct * 16 + 4 * fq) * 2);
            vn[ct] = (f32x4){bflo(uw.x) - a.x, bfhi(uw.x) - a.y, bflo(uw.y) - a.z, bfhi(uw.y) - a.w};
            f32x4 oo = {0.f, 0.f, 0.f, 0.f}; oo = mfma16(lds_perm(L + GC_QD, ct * 16 + fr, 0, fq), sb0, oo); oo = mfma16(lds_perm(L + GC_QD, ct * 16 + fr, 1, fq), sb1, oo); o[ct] = oo;
        }
        const bf16x8 vb0 = pack8(vn[0], vn[1]), vb1 = pack8(vn[2], vn[3]);
#pragma unroll
        for (int ct = 0; ct < 4; ++ct) { o[ct] = mfma16(lds_perm(L + GC_ATT, ct * 16 + fr, 0, fq), vb0, o[ct]); o[ct] = mfma16(lds_perm(L + GC_ATT, ct * 16 + fr, 1, fq), vb1, o[ct]); }
#pragma unroll
        for (int dt = 0; dt < 4; ++dt) { f32x4 a = S[dt] * egl; a = mfma16(lds_perm(L + GC_KDT, dt * 16 + fr, 0, fq), vb0, a); a = mfma16(lds_perm(L + GC_KDT, dt * 16 + fr, 1, fq), vb1, a); S[dt] = a; }
        LAS float* Ol = (LAS float*)(L + GC_O);
#pragma unroll
        for (int ct = 0; ct < 4; ++ct)
#pragma unroll
            for (int r = 0; r < 4; ++r) Ol[(ct * 16 + 4 * fq + r) * 65 + eb * 16 + fr] = o[ct][r];
        __syncthreads();
        if (n + 1 < NCHUNK) GC_WRITE();
        {
            const LAS float* orow = (const LAS float*)(lds + (tid >> 8) * GC_BH + GC_O) + ec * 65 + eq * 16;
            float ov[16]; float s2 = 0.f;
#pragma unroll
            for (int j = 0; j < 16; ++j) { ov[j] = orow[j]; s2 += ov[j] * ov[j]; }
            s2 += __shfl_xor(s2, 1); s2 += __shfl_xor(s2, 2);
            const float rs = frsq_(s2 * (1.0f / 64.0f) + EPS);
            const unsigned gws[8] = {gw0.x, gw0.y, gw0.z, gw0.w, gw1.x, gw1.y, gw1.z, gw1.w};
            unsigned ow[8];
#pragma unroll
            for (int j = 0; j < 8; ++j) ow[j] = pk2(ov[2 * j] * rs * ng[2 * j] * siluf_(bflo(gws[j])), ov[2 * j + 1] * rs * ng[2 * j + 1] * siluf_(bfhi(gws[j])));
            bf16_t* yp = y + etok * DM + 768 + eh * 64 + eq * 16;
            *(u32x4*)yp = (u32x4){ow[0], ow[1], ow[2], ow[3]}; *(u32x4*)(yp + 8) = (u32x4){ow[4], ow[5], ow[6], ow[7]};
        }
        __syncthreads();
    }
#undef GC_LOAD
#undef GC_WRITE
}

constexpr int RT_BUF = 36864, RT_Q = 0, RT_K = 9216, RT_KZT = 18432, RT_VT = 27648, RT_P = 73728, RT_ST = 82944, RT_O = 92160;
__device__ __forceinline__ void ret_chain_item(const Params& P, int l, LAS unsigned char* lds, int it, int tid, int wave, int lane) {
    const int b = it >> 2, h = it & 3, fr = lane & 15, fq = lane >> 4;
    const bf16_t* z = (const bf16_t*)(P.ws + WS_R); bf16_t* y = (bf16_t*)(P.ws + WS_R + R_Y);
    LAS bf16_t* Pm = (LAS bf16_t*)(lds + RT_P); LAS bf16_t* ST = (LAS bf16_t*)(lds + RT_ST); LAS float* Of = (LAS float*)(lds + RT_O);
    const float lg = log1pf(-exp2f(-5.0f - (float)h));
    const float cdec = fexp_(64.0f * lg);
    for (int i = tid; i < 64 * 72 / 2; i += 512) ((LAS unsigned*)ST)[i] = 0u;
    const int it4 = wave >> 1, jt0 = 2 * (wave & 1);
    f32x4 S[2] = {{0.f, 0.f, 0.f, 0.f}, {0.f, 0.f, 0.f, 0.f}};
    const int lc = tid >> 3, pg = tid & 7;
    float invf[4];
#pragma unroll
    for (int ii = 0; ii < 4; ++ii) invf[ii] = exp2f(-(float)(4 * pg + ii) * (13.287712379549449f / 32.0f));
    const float zeta = fexp_((63.0f - (float)lc) * lg);
    const f32x4 gn0 = *(const f32x4*)(P.ret_gn + l * 256 + h * 64 + 8 * pg), gn1 = *(const f32x4*)(P.ret_gn + l * 256 + h * 64 + 8 * pg + 4);
    const size_t tok0 = (size_t)b * SEQ + lc;
    u32x2 q1w, q2w, k1w, k2w; u32x4 vw; int posi;
#define RT_LOAD(n_) do { const bf16_t* zr_ = z + (tok0 + (n_) * 64) * ZP; q1w = *(const u32x2*)(zr_ + Z_RQ + h * 64 + 4 * pg); q2w = *(const u32x2*)(zr_ + Z_RQ + h * 64 + 32 + 4 * pg); \
        k1w = *(const u32x2*)(zr_ + Z_RK + h * 64 + 4 * pg); k2w = *(const u32x2*)(zr_ + Z_RK + h * 64 + 32 + 4 * pg); vw = *(const u32x4*)(zr_ + Z_RV + h * 64 + 8 * pg); posi = P.pos[tok0 + (n_) * 64]; } while (0)
#define RT_STAGE(buf_) do { LAS bf16_t* Qs_ = (LAS bf16_t*)(lds + (buf_) * RT_BUF + RT_Q); LAS bf16_t* Ks_ = (LAS bf16_t*)(lds + (buf_) * RT_BUF + RT_K); \
        LAS bf16_t* KzT_ = (LAS bf16_t*)(lds + (buf_) * RT_BUF + RT_KZT); LAS bf16_t* VT_ = (LAS bf16_t*)(lds + (buf_) * RT_BUF + RT_VT); const float pos = (float)posi; \
        const float q1[4] = {bflo(q1w.x), bfhi(q1w.x), bflo(q1w.y), bfhi(q1w.y)}, q2[4] = {bflo(q2w.x), bfhi(q2w.x), bflo(q2w.y), bfhi(q2w.y)}; \
        const float k1[4] = {bflo(k1w.x), bfhi(k1w.x), bflo(k1w.y), bfhi(k1w.y)}, k2[4] = {bflo(k2w.x), bfhi(k2w.x), bflo(k2w.y), bfhi(k2w.y)}; \
        float qa[4], qb[4], ka[4], kb[4]; \
        _Pragma("unroll") for (int ii = 0; ii < 4; ++ii) { float sn, cs; sincos_rev(pos * invf[ii], sn, cs); \
            qa[ii] = (q1[ii] * cs - q2[ii] * sn) * 0.125f; qb[ii] = (q1[ii] * sn + q2[ii] * cs) * 0.125f; ka[ii] = k1[ii] * cs - k2[ii] * sn; kb[ii] = k1[ii] * sn + k2[ii] * cs; } \
        u32x2 w_; w_.x = pk2(qa[0], qa[1]); w_.y = pk2(qa[2], qa[3]); *(LAS u32x2*)(Qs_ + lc * 72 + 4 * pg) = w_; \
        w_.x = pk2(qb[0], qb[1]); w_.y = pk2(qb[2], qb[3]); *(LAS u32x2*)(Qs_ + lc * 72 + 32 + 4 * pg) = w_; \
        w_.x = pk2(ka[0], ka[1]); w_.y = pk2(ka[2], ka[3]); *(LAS u32x2*)(Ks_ + lc * 72 + 4 * pg) = w_; \
        w_.x = pk2(kb[0], kb[1]); w_.y = pk2(kb[2], kb[3]); *(LAS u32x2*)(Ks_ + lc * 72 + 32 + 4 * pg) = w_; \
        _Pragma("unroll") for (int ii = 0; ii < 4; ++ii) { KzT_[(4 * pg + ii) * 72 + lc] = f2bf(ka[ii] * zeta); KzT_[(32 + 4 * pg + ii) * 72 + lc] = f2bf(kb[ii] * zeta); } \
        const unsigned vv[4] = {vw.x, vw.y, vw.z, vw.w}; \
        _Pragma("unroll") for (int ii = 0; ii < 4; ++ii) { VT_[(8 * pg + 2 * ii) * 72 + lc] = (bf16_t)(vv[ii] & 0xffffu); VT_[(8 * pg + 2 * ii + 1) * 72 + lc] = (bf16_t)(vv[ii] >> 16); } } while (0)
    RT_LOAD(0); RT_STAGE(0);
    __syncthreads();
    for (int n = 0; n < NCHUNK; ++n) {
        const int cb = n & 1;
        const LAS bf16_t* Qs = (const LAS bf16_t*)(lds + cb * RT_BUF + RT_Q); const LAS bf16_t* Ks = (const LAS bf16_t*)(lds + cb * RT_BUF + RT_K);
        const LAS bf16_t* KzT = (const LAS bf16_t*)(lds + cb * RT_BUF + RT_KZT); const LAS bf16_t* VT = (const LAS bf16_t*)(lds + cb * RT_BUF + RT_VT);
        const size_t tok = tok0 + n * 64;
        if (n + 1 < NCHUNK) RT_LOAD(n + 1);
        const u32x4 gw = *(const u32x4*)(z + tok * ZP + Z_RG + h * 64 + 8 * pg);
        const bf16x8 a0 = *(const LAS bf16x8*)(Qs + (it4 * 16 + fr) * 72 + 8 * fq), a1 = *(const LAS bf16x8*)(Qs + (it4 * 16 + fr) * 72 + 32 + 8 * fq);
        f32x4 cross[2];
#pragma unroll
        for (int t = 0; t < 2; ++t) { const int jt = jt0 + t;
            f32x4 p = {0.f, 0.f, 0.f, 0.f};
            p = mfma16(a0, *(const LAS bf16x8*)(Ks + (jt * 16 + fr) * 72 + 8 * fq), p); p = mfma16(a1, *(const LAS bf16x8*)(Ks + (jt * 16 + fr) * 72 + 32 + 8 * fq), p);
            f32x4 cr = {0.f, 0.f, 0.f, 0.f};
            cr = mfma16(a0, *(const LAS bf16x8*)(ST + (jt * 16 + fr) * 72 + 8 * fq), cr); cr = mfma16(a1, *(const LAS bf16x8*)(ST + (jt * 16 + fr) * 72 + 32 + 8 * fq), cr);
#pragma unroll
            for (int r = 0; r < 4; ++r) { const int i = it4 * 16 + 4 * fq + r, j = jt * 16 + fr; const int dd = i > j ? i - j : j - i;
                Pm[i * 72 + j] = f2bf(p[r] * fexp_((float)dd * lg)); cr[r] *= fexp_((float)(i + 1) * lg); }
            cross[t] = cr; }
        __syncthreads();
        const bf16x8 p0 = *(const LAS bf16x8*)(Pm + (it4 * 16 + fr) * 72 + 8 * fq), p1 = *(const LAS bf16x8*)(Pm + (it4 * 16 + fr) * 72 + 32 + 8 * fq);
        const bf16x8 kz0 = *(const LAS bf16x8*)(KzT + (it4 * 16 + fr) * 72 + 8 * fq), kz1 = *(const LAS bf16x8*)(KzT + (it4 * 16 + fr) * 72 + 32 + 8 * fq);
#pragma unroll
        for (int t = 0; t < 2; ++t) { const int et = jt0 + t;
            const bf16x8 v0 = *(const LAS bf16x8*)(VT + (et * 16 + fr) * 72 + 8 * fq), v1 = *(const LAS bf16x8*)(VT + (et * 16 + fr) * 72 + 32 + 8 * fq);
            f32x4 o = cross[t]; o = mfma16(p0, v0, o); o = mfma16(p1, v1, o);
#pragma unroll
            for (int r = 0; r < 4; ++r) Of[(it4 * 16 + 4 * fq + r) * 65 + et * 16 + fr] = o[r];
            f32x4 sN = S[t] * cdec; sN = mfma16(kz0, v0, sN); sN = mfma16(kz1, v1, sN); S[t] = sN;
            u32x2 w; w.x = pk2(sN.x, sN.y); w.y = pk2(sN.z, sN.w); *(LAS u32x2*)(ST + (et * 16 + fr) * 72 + it4 * 16 + 4 * fq) = w; }
        if (n + 1 < NCHUNK) RT_STAGE(cb ^ 1);
        __syncthreads();
        {
            float ov[8]; float sm = 0.f;
#pragma unroll
            for (int j = 0; j < 8; ++j) { ov[j] = Of[lc * 65 + 8 * pg + j]; sm += ov[j]; }
            sm += __shfl_xor(sm, 1); sm += __shfl_xor(sm, 2); sm += __shfl_xor(sm, 4);
            const float mu = sm * (1.0f / 64.0f); float vs = 0.f;
#pragma unroll
            for (int j = 0; j < 8; ++j) { ov[j] -= mu; vs += ov[j] * ov[j]; }
            vs += __shfl_xor(vs, 1); vs += __shfl_xor(vs, 2); vs += __shfl_xor(vs, 4);
            const float rs = frsq_(vs * (1.0f / 64.0f) + EPS);
            const float gt[8] = {bflo(gw.x), bfhi(gw.x), bflo(gw.y), bfhi(gw.y), bflo(gw.z), bfhi(gw.z), bflo(gw.w), bfhi(gw.w)};
            const float gnv[8] = {gn0.x, gn0.y, gn0.z, gn0.w, gn1.x, gn1.y, gn1.z, gn1.w};
            float r8[8];
#pragma unroll
            for (int j = 0; j < 8; ++j) r8[j] = ov[j] * rs * gnv[j] * siluf_(gt[j]);
            u32x4 w; w.x = pk2(r8[0], r8[1]); w.y = pk2(r8[2], r8[3]); w.z = pk2(r8[4], r8[5]); w.w = pk2(r8[6], r8[7]);
            *(u32x4*)(y + tok * DM + h * 64 + 8 * pg) = w;
        }
    }
#undef RT_LOAD
#undef RT_STAGE
    __syncthreads();
}

constexpr int LR_XC = 0, LR_AU = 33792;
__device__ __forceinline__ void lru_item(const Params& P, int l, LAS unsigned char* lds, int it, int mode, int tid, int wave, int lane) {
    const int b = it >> 5, n = it & 31, fr = lane & 15, fq = lane >> 4;
    const bf16_t* z = (const bf16_t*)(P.ws + WS_R); bf16_t* y = (bf16_t*)(P.ws + WS_R + R_Y);
    LAS bf16_t* XC = (LAS bf16_t*)(lds + LR_XC); LAS f32x2* AU = (LAS f32x2*)(lds + LR_AU);
    float* sumA = (float*)(P.ws + WS_LRUS); float* sumH = sumA + 16 * 32 * 256;
    {
        const int c = tid >> 3, cg = tid & 7, s = n * 64 + c; const size_t tok = (size_t)b * SEQ + s;
        const float* cw = P.lru_conv_w + (size_t)l * 4 * 256; const float* cb = P.lru_conv_b + l * 256;
#pragma unroll
        for (int g = 0; g < 4; ++g) { const int ch0 = cg * 32 + g * 8;
            const f32x4 b0 = *(const f32x4*)(cb + ch0), b1 = *(const f32x4*)(cb + ch0 + 4);
            float a[8] = {b0.x, b0.y, b0.z, b0.w, b1.x, b1.y, b1.z, b1.w};
#pragma unroll
            for (int kk = 0; kk < 4; ++kk) { const bool okk = s - 3 + kk >= 0; const float mk = okk ? 1.f : 0.f;
                const u32x4 w = *(const u32x4*)(z + (okk ? tok - 3 + kk : tok) * ZP + Z_LX + ch0);
                const f32x4 c0 = *(const f32x4*)(cw + kk * 256 + ch0) * mk, c1 = *(const f32x4*)(cw + kk * 256 + ch0 + 4) * mk;
                a[0] += c0.x * bflo(w.x); a[1] += c0.y * bfhi(w.x); a[2] += c0.z * bflo(w.y); a[3] += c0.w * bfhi(w.y);
                a[4] += c1.x * bflo(w.z); a[5] += c1.y * bfhi(w.z); a[6] += c1.z * bflo(w.w); a[7] += c1.w * bfhi(w.w); }
            u32x4 o; o.x = pk2(a[0], a[1]); o.y = pk2(a[2], a[3]); o.z = pk2(a[4], a[5]); o.w = pk2(a[6], a[7]);
            *(LAS u32x4*)(XC + c * 264 + ch0) = o; }
    }
    float hcar = 0.f, aprod = 1.f;
    if (mode == 1 && tid < 256) {
        float av[32], hv[32];
#pragma unroll
        for (int m = 0; m < 32; ++m) { const int mm = m < n ? m : 0; av[m] = sumA[(b * 32 + mm) * 256 + tid]; hv[m] = sumH[(b * 32 + mm) * 256 + tid]; }
#pragma unroll
        for (int m = 0; m < 32; ++m) if (m < n) hcar = av[m] * hcar + hv[m];
    }
    const int nb = wave >> 1, rt = wave & 1;
    const bf16_t* wa = wl(P, l, W_A) + nb * 4096; const bf16_t* wx = wl(P, l, W_X) + nb * 4096;
    bf16x8 fa[4][2], fx[4][2]; float ba[4], bx[4], spl[4];
#pragma unroll
    for (int dt = 0; dt < 4; ++dt) {
#pragma unroll
        for (int s = 0; s < 2; ++s) { fa[dt][s] = *(const bf16x8*)(wa + (dt * 16 + fr) * 64 + 32 * s + 8 * fq); fx[dt][s] = *(const bf16x8*)(wx + (dt * 16 + fr) * 64 + 32 * s + 8 * fq); }
        const int d = nb * 64 + dt * 16 + fr; ba[dt] = P.lru_ba[l * 256 + d]; bx[dt] = P.lru_bx[l * 256 + d]; spl[dt] = -8.0f * softplusf_(-P.lru_lambda[l * 256 + d]); }
    __syncthreads();
    for (int half = 0; half < 2; ++half) {
        const int trow = half * 32 + rt * 16;
        const bf16x8 x0 = *(const LAS bf16x8*)(XC + (trow + fr) * 264 + nb * 64 + 8 * fq), x1 = *(const LAS bf16x8*)(XC + (trow + fr) * 264 + nb * 64 + 32 + 8 * fq);
#pragma unroll
        for (int dt = 0; dt < 4; ++dt) {
            f32x4 ar = {0.f, 0.f, 0.f, 0.f}, ai = {0.f, 0.f, 0.f, 0.f};
            ar = mfma16(x0, fa[dt][0], ar); ar = mfma16(x1, fa[dt][1], ar); ai = mfma16(x0, fx[dt][0], ai); ai = mfma16(x1, fx[dt][1], ai);
            const int d = nb * 64 + dt * 16 + fr;
#pragma unroll
            for (int r = 0; r < 4; ++r) { const int tl = rt * 16 + 4 * fq + r;
                const float xcv = bf2f(XC[(half * 32 + tl) * 264 + d]);
                const float rr = sigmoidf_(ar[r] + ba[dt]), ii = sigmoidf_(ai[r] + bx[dt]);
                const float a = fexp_(rr * spl[dt]);
                const float u = fsqrt_(fmaxf(1.0f - a * a, 0.f)) * (ii * xcv);
                AU[tl * 257 + d] = (f32x2){a, u}; }
        }
        __syncthreads();
        if (tid < 256) {
#pragma unroll 8
            for (int tk = 0; tk < 32; ++tk) { const f32x2 au = AU[tk * 257 + tid]; hcar = au.x * hcar + au.y; aprod *= au.x; if (mode == 1) AU[tk * 257 + tid].y = hcar; }
        }
        if (mode == 1) {
            __syncthreads();
            const int tk = tid >> 4, c0 = (tid & 15) * 16; const size_t tok = (size_t)b * SEQ + n * 64 + half * 32 + tk;
            const u32x4 g0 = *(const u32x4*)(z + tok * ZP + Z_LG + c0), g1 = *(const u32x4*)(z + tok * ZP + Z_LG + c0 + 8);
            const unsigned gws[8] = {g0.x, g0.y, g0.z, g0.w, g1.x, g1.y, g1.z, g1.w}; unsigned ow[8];
#pragma unroll
            for (int j = 0; j < 8; ++j) { const float h0 = AU[tk * 257 + c0 + 2 * j].y, h1 = AU[tk * 257 + c0 + 2 * j + 1].y; ow[j] = pk2(h0 * geluf_(bflo(gws[j])), h1 * geluf_(bfhi(gws[j]))); }
            bf16_t* yp = y + tok * DM + 256 + c0;
            *(u32x4*)yp = (u32x4){ow[0], ow[1], ow[2], ow[3]}; *(u32x4*)(yp + 8) = (u32x4){ow[4], ow[5], ow[6], ow[7]};
        }
        __syncthreads();
    }
    if (mode == 0 && tid < 256) { sumA[(b * 32 + n) * 256 + tid] = aprod; sumH[(b * 32 + n) * 256 + tid] = hcar; }
}

constexpr int LC_XC = 0, LC_AU = 9216;
__device__ __forceinline__ void lru_chain_item(const Params& P, int l, LAS unsigned char* lds, int it, int tid, int wave, int lane) {
    const int b = it >> 2, nb = it & 3, fr = lane & 15, fq = lane >> 4;
    const bf16_t* z = (const bf16_t*)(P.ws + WS_R); bf16_t* y = (bf16_t*)(P.ws + WS_R + R_Y);
    LAS bf16_t* XC = (LAS bf16_t*)(lds + LC_XC); LAS f32x2* AU = (LAS f32x2*)(lds + LC_AU);
    const int c = tid >> 3, cg = tid & 7, ch0 = nb * 64 + cg * 8;
    f32x4 cw0[4], cw1[4];
#pragma unroll
    for (int kk = 0; kk < 4; ++kk) { cw0[kk] = *(const f32x4*)(P.lru_conv_w + (size_t)l * 1024 + kk * 256 + ch0); cw1[kk] = *(const f32x4*)(P.lru_conv_w + (size_t)l * 1024 + kk * 256 + ch0 + 4); }
    const f32x4 cb0 = *(const f32x4*)(P.lru_conv_b + l * 256 + ch0), cb1 = *(const f32x4*)(P.lru_conv_b + l * 256 + ch0 + 4);
    const int rt = wave >> 1, dt0 = (wave & 1) * 2;
    const bf16_t* wa = wl(P, l, W_A) + nb * 4096; const bf16_t* wx = wl(P, l, W_X) + nb * 4096;
    bf16x8 fa[2][2], fx[2][2]; float ba[2], bx[2], spl[2];
#pragma unroll
    for (int t = 0; t < 2; ++t) {
#pragma unroll
        for (int s = 0; s < 2; ++s) { fa[t][s] = *(const bf16x8*)(wa + ((dt0 + t) * 16 + fr) * 64 + 32 * s + 8 * fq); fx[t][s] = *(const bf16x8*)(wx + ((dt0 + t) * 16 + fr) * 64 + 32 * s + 8 * fq); }
        const int d = nb * 64 + (dt0 + t) * 16 + fr; ba[t] = P.lru_ba[l * 256 + d]; bx[t] = P.lru_bx[l * 256 + d]; spl[t] = -8.0f * softplusf_(-P.lru_lambda[l * 256 + d]); }
    const size_t tok0 = (size_t)b * SEQ + c;
    u32x4 xr[4], gr;
#define LC_LOAD(n_) do { const size_t t_ = tok0 + (size_t)(n_) * 64; _Pragma("unroll") for (int kk = 0; kk < 4; ++kk) { const bool ok_ = (n_) * 64 + c - 3 + kk >= 0; \
        xr[kk] = *(const u32x4*)(z + (ok_ ? t_ - 3 + kk : t_) * ZP + Z_LX + ch0); } gr = *(const u32x4*)(z + t_ * ZP + Z_LG + ch0); } while (0)
    LC_LOAD(0);
    float hcar = 0.f;
    for (int n = 0; n < NCHUNK; ++n) {
        {
            float a[8] = {cb0.x, cb0.y, cb0.z, cb0.w, cb1.x, cb1.y, cb1.z, cb1.w};
#pragma unroll
            for (int kk = 0; kk < 4; ++kk) { const float mk = (n * 64 + c - 3 + kk >= 0) ? 1.f : 0.f; const f32x4 c0 = cw0[kk] * mk, c1 = cw1[kk] * mk; const u32x4 w = xr[kk];
                a[0] += c0.x * bflo(w.x); a[1] += c0.y * bfhi(w.x); a[2] += c0.z * bflo(w.y); a[3] += c0.w * bfhi(w.y);
                a[4] += c1.x * bflo(w.z); a[5] += c1.y * bfhi(w.z); a[6] += c1.z * bflo(w.w); a[7] += c1.w * bfhi(w.w); }
            u32x4 o; o.x = pk2(a[0], a[1]); o.y = pk2(a[2], a[3]); o.z = pk2(a[4], a[5]); o.w = pk2(a[6], a[7]);
            *(LAS u32x4*)(XC + c * 72 + cg * 8) = o;
        }
        const u32x4 gcur = gr;
        if (n + 1 < NCHUNK) LC_LOAD(n + 1);
        __syncthreads();
        {
            const bf16x8 x0 = *(const LAS bf16x8*)(XC + (rt * 16 + fr) * 72 + 8 * fq), x1 = *(const LAS bf16x8*)(XC + (rt * 16 + fr) * 72 + 32 + 8 * fq);
#pragma unroll
            for (int t = 0; t < 2; ++t) {
                f32x4 ar = {0.f, 0.f, 0.f, 0.f}, ai = {0.f, 0.f, 0.f, 0.f};
                ar = mfma16(x0, fa[t][0], ar); ar = mfma16(x1, fa[t][1], ar); ai = mfma16(x0, fx[t][0], ai); ai = mfma16(x1, fx[t][1], ai);
                const int dl = (dt0 + t) * 16 + fr;
#pragma unroll
                for (int r = 0; r < 4; ++r) { const int tl = rt * 16 + 4 * fq + r;
                    const float xcv = bf2f(XC[tl * 72 + dl]);
                    const float rr = sigmoidf_(ar[r] + ba[t]), ii = sigmoidf_(ai[r] + bx[t]);
                    const float av = fexp_(rr * spl[t]);
                    AU[tl * 65 + dl] = (f32x2){av, fsqrt_(fmaxf(1.0f - av * av, 0.f)) * (ii * xcv)}; }
            }
        }
        __syncthreads();
        if (tid < 64) {
#pragma unroll
            for (int blk = 0; blk < 4; ++blk) { f32x2 au[16];
#pragma unroll
                for (int k = 0; k < 16; ++k) au[k] = AU[(blk * 16 + k) * 65 + tid];
#pragma unroll
                for (int k = 0; k < 16; ++k) { hcar = au[k].x * hcar + au[k].y; au[k].y = hcar; }
#pragma unroll
                for (int k = 0; k < 16; ++k) AU[(blk * 16 + k) * 65 + tid].y = au[k].y; }
        }
        __syncthreads();
        {
            const unsigned gws[4] = {gcur.x, gcur.y, gcur.z, gcur.w}; unsigned ow[4];
#pragma unroll
            for (int j = 0; j < 4; ++j) ow[j] = pk2(AU[c * 65 + cg * 8 + 2 * j].y * geluf_(bflo(gws[j])), AU[c * 65 + cg * 8 + 2 * j + 1].y * geluf_(bfhi(gws[j])));
            *(u32x4*)(y + (tok0 + (size_t)n * 64) * DM + 256 + ch0) = (u32x4){ow[0], ow[1], ow[2], ow[3]};
        }
    }
#undef LC_LOAD
    __syncthreads();
}

constexpr int N_PHASES = 21;
constexpr int Q_RET = 64, Q_GDN = 32, Q_LRU = 64, Q_MLA = 512, Q_TOTAL = Q_RET + Q_GDN + Q_LRU + Q_MLA;

__global__ void __launch_bounds__(512, 2) hymba_fwd(Params P_) {
    extern __shared__ __attribute__((aligned(16))) unsigned char lds_raw[];
    LAS unsigned char* lds = (LAS unsigned char*)lds_raw;
    volatile LAS unsigned* LC = (volatile LAS unsigned*)(lds + LDS_CTL);
    const int G = gridDim.x;
#define SUB_TID() int tid2 = tid; asm volatile("" : "+v"(tid2)); const int lane2 = tid2 & 63, wave2 = __builtin_amdgcn_readfirstlane(tid2 >> 6); (void)lane2; (void)wave2
#if defined(__HIP_DEVICE_COMPILE__)
#define PH_PARAMS() const __attribute__((address_space(4))) Params* pp_ = (const __attribute__((address_space(4))) Params*)__builtin_amdgcn_kernarg_segment_ptr(); asm volatile("" : "+s"(pp_)); const Params P = *pp_
#else
#define PH_PARAMS() const Params P = P_
#endif
#define PH_TID() PH_PARAMS(); \
    bf16_t* xb = (bf16_t*)(P.ws + WS_XB); float* part = (float*)(P.ws + WS_PART); bf16_t* zb = (bf16_t*)(P.ws + WS_R); bf16_t* yb = (bf16_t*)(P.ws + WS_R + R_Y); bf16_t* oxb = (bf16_t*)(P.ws + WS_R + R_OX); (void)xb; (void)part; (void)zb; (void)yb; (void)oxb; \
    int tid = threadIdx.x; asm volatile("" : "+v"(tid)); const int lane = tid & 63, wave = __builtin_amdgcn_readfirstlane(tid >> 6); (void)lane; (void)wave
    unsigned* ctl = (unsigned*)(P_.ws + WS_CTL);
    if (threadIdx.x < 64) LC[threadIdx.x] = 0u;
    __syncthreads();
    const int lo = P_.ph_lo, hi = P_.ph_hi;
    XcdBarrier bar; bar.bar = ctl + CW_BAR; bar.x = 0; bar.st = LC;
    if (hi - lo > 1) bar = xcd_barrier_post(ctl + CW_BAR, LC);
#ifndef PHASE_MASK
#define PHASE_MASK 0xFFFFFFFFu
#endif
#define EN(t) ((PHASE_MASK >> (t)) & 1u)
#ifndef REPEAT_MASK
#define REPEAT_MASK 0u
#endif
#define REP(t) for (int rep_ = 0; rep_ <= (int)((REPEAT_MASK >> (t)) & 1u); ++rep_, (rep_ <= (int)((REPEAT_MASK >> (t)) & 1u) ? xcd_barrier(bar) : (void)0))
#define IN(k) (lo <= (k) && (k) < hi)
#define SEAM(k) do { if (IN(k) && IN((k) + 1)) xcd_barrier(bar); } while (0)


    if (IN(0) && EN(0)) REP(0) { PH_TID(); p0_prologue(P, lds, tid); __syncthreads(); }
    SEAM(0);
    if (IN(1) && EN(1)) REP(1) {
        PH_TID();
        const int which = blockIdx.x >> 6, l = which >> 1, isv = which & 1;
        if (which < 4) {
            const bf16_t* memn = (const bf16_t*)(P.ws + WS_GDN); const bf16_t* wkv = wl(P, l, W_KV);
            bf16_t* kout = (bf16_t*)(P.ws + WS_KVM + (size_t)l * KVM_LAYER); bf16_t* vout = kout + (size_t)4096 * 1024;
            pg8::Gemm g; pg8::EpiScaleBf16<0> E; pg8::StaticOrder S;
            if (!isv) { g = pg8::Gemm{memn, wkv, 4096, 1024, 1024}; E = pg8::EpiScaleBf16<0>{kout, 1024, nullptr}; S.init(4096, 1024, 64, blockIdx.x & 63); }
            else { g = pg8::Gemm{wkv + (size_t)1024 * 1024, memn, 1024, 4096, 1024}; E = pg8::EpiScaleBf16<0>{vout, 4096, nullptr}; S.init(1024, 4096, 64, blockIdx.x & 63); }
            pg8::gemm_phase(lds, g, S, E, tid);
        }
    }
    SEAM(1);
#pragma unroll
    for (int l = 0; l < 2; ++l) {
        const int pb = 2 + 9 * l;
        if (IN(pb + 0) && EN(2)) REP(2) { PH_TID();
            pg8::Gemm g{xb, wl(P, l, W_IN), T_TOK, ZP, DM}; pg8::StaticOrder S; S.init(T_TOK, ZP, G, blockIdx.x);
            pg8::EpiScaleBf16<0> E{zb, ZP, part}; pg8::gemm_phase(lds, g, S, E, tid);
        }
        SEAM(pb + 0);
        if (IN(pb + 1)) {
            PH_TID();
            if (EN(3)) REP(3) { SUB_TID(); for (int it = blockIdx.x; it < 1024; it += G) gdn_pre_item(P, l, lds, it, tid2); }
            if (EN(5)) REP(5) { SUB_TID(); for (int it = blockIdx.x; it < 256; it += G) mla_pre_item(P, l, lds, it, tid2, wave2, lane2); }
        }
        SEAM(pb + 1);
        if (IN(pb + 2)) {
            PH_TID();
            for (int rep2_ = 0; rep2_ <= (int)((REPEAT_MASK >> 17) & 1u); ++rep2_, (rep2_ <= (int)((REPEAT_MASK >> 17) & 1u) ? xcd_barrier(bar) : (void)0)) {
            unsigned* qh0 = ctl + CW_QUEUE + 64 * l + 16 * rep2_;
#define QUEUE_LOOP(qi_, count_, body_) for (;;) { if (tid == 0) LC[4] = __hip_atomic_fetch_add(qh + (qi_), 1u, __ATOMIC_RELAXED, __HIP_MEMORY_SCOPE_AGENT); \
                __syncthreads(); const int it = (int)LC[4]; __syncthreads(); if (it >= (count_)) break; { SUB_TID(); body_; } __syncthreads(); }
            if (EN(6)) REP(6) { unsigned* qh = qh0 + 32 * rep_; QUEUE_LOOP(0, Q_RET, ret_chain_item(P, l, lds, it, tid2, wave2, lane2)) }
            if (EN(7)) REP(7) { unsigned* qh = qh0 + 32 * rep_; QUEUE_LOOP(1, Q_GDN, gdn_chain_item(P, l, lds, it, tid2, wave2, lane2)) }
            if (EN(8)) REP(8) { unsigned* qh = qh0 + 32 * rep_; QUEUE_LOOP(2, Q_LRU, lru_chain_item(P, l, lds, it, tid2, wave2, lane2)) }
            if (EN(9)) REP(9) { unsigned* qh = qh0 + 32 * rep_; QUEUE_LOOP(3, Q_MLA, mla_attn_item(P, lds, it, tid2, wave2, lane2)) }
#undef QUEUE_LOOP
            }
        }
        SEAM(pb + 2);
        if (IN(pb + 3) && EN(10)) REP(10) { PH_TID();
            pg8::Gemm g{yb, wl(P, l, W_OUT), T_TOK, DM, DM}; pg8::StaticOrder S; S.init(T_TOK, DM, G, blockIdx.x);
            pg8::EpiResid E{P.out, xb, part, rep_ ? 0.f : 1.f}; pg8::gemm_phase(lds, g, S, E, tid);
        }
        SEAM(pb + 3);
        if (IN(pb + 4) && EN(11)) REP(11) { PH_TID();
            pg8::Gemm g{xb, wl(P, l, W_Q), T_TOK, DM, DM}; pg8::StaticOrder S; S.init(T_TOK, DM, G, blockIdx.x);
            pg8::EpiScaleBf16<0> E{zb, DM, part}; pg8::gemm_phase(lds, g, S, E, tid);
        }
        SEAM(pb + 4);
        if (IN(pb + 5) && EN(12)) REP(12) { PH_TID(); for (int it = blockIdx.x; it < 1024; it += G) { xa_item(P, l, lds, it, tid, wave, lane); __syncthreads(); } }
        SEAM(pb + 5);
        if (IN(pb + 6) && EN(13)) REP(13) { PH_TID();
            pg8::Gemm g{oxb, wl(P, l, W_O), T_TOK, DM, DM}; pg8::StaticOrder S; S.init(T_TOK, DM, G, blockIdx.x);
            pg8::EpiResid E{P.out, xb, part, rep_ ? 0.f : 1.f}; pg8::gemm_phase(lds, g, S, E, tid);
        }
        SEAM(pb + 6);
        if (IN(pb + 7) && EN(14)) REP(14) { PH_TID();
            pg8::Gemm g{xb, wl(P, l, W_1), T_TOK, DFF, DM}; pg8::StaticOrder S; S.init(T_TOK, DFF, G, blockIdx.x);
            pg8::EpiScaleBf16<1> E{zb, DFF, part}; pg8::gemm_phase(lds, g, S, E, tid);
        }
        SEAM(pb + 7);
        if (IN(pb + 8) && EN(15)) REP(15) { PH_TID();
            pg8::Gemm g{zb, wl(P, l, W_2), T_TOK, DM, DFF}; pg8::StaticOrder S; S.init(T_TOK, DM, G, blockIdx.x);
            pg8::EpiResid E{P.out, xb, part, rep_ ? 0.f : 1.f}; pg8::gemm_phase(lds, g, S, E, tid);
        }
        SEAM(pb + 8);
    }
    if (IN(20) && EN(16)) { PH_TID(); final_norm_phase(P, tid); }
#undef IN
#undef SEAM
}

extern "C" void kernel_launch(void* const* d_in, const int* in_sizes, int n_in, void* d_out, int out_size, void* d_ws, size_t ws_size, hipStream_t stream) {
    static int grid = 0;
    if (grid == 0) {
        if (n_in != 31 || out_size != T_TOK * DM || ws_size < WS_END) { fprintf(stderr, "kernel_launch: unexpected shapes (n_in %d out %d ws %zu, need %zu)\n", n_in, out_size, ws_size, (size_t)WS_END); grid = -1; return; }
        if (hipFuncSetAttribute((const void*)hymba_fwd, hipFuncAttributeMaxDynamicSharedMemorySize, LDS_BYTES) != hipSuccess) { fprintf(stderr, "kernel_launch: hipFuncSetAttribute failed\n"); grid = -1; return; }
        int dev = 0, cus = 0, per_cu = 0;
        (void)hipGetDevice(&dev); (void)hipDeviceGetAttribute(&cus, hipDeviceAttributeMultiprocessorCount, dev);
        (void)hipOccupancyMaxActiveBlocksPerMultiprocessor(&per_cu, (const void*)hymba_fwd, 512, LDS_BYTES);
        (void)hipGetLastError();
        if (cus != 256 || per_cu < 1) fprintf(stderr, "kernel_launch: note: cus %d per_cu %d\n", cus, per_cu);
        grid = 256;
    }
    if (grid < 0) return;
    (void)hipMemsetAsync((char*)d_ws + WS_CTL, 0, CTL_BYTES, stream);
    Params p{};
    p.x = (const float*)d_in[0]; p.mem = (const float*)d_in[1]; p.pos = (const int*)d_in[2];
    p.norm_mix = (const float*)d_in[3]; p.w_in = (const float*)d_in[4]; p.ret_gn = (const float*)d_in[5];
    p.lru_conv_w = (const float*)d_in[6]; p.lru_conv_b = (const float*)d_in[7]; p.lru_wa = (const float*)d_in[8]; p.lru_ba = (const float*)d_in[9];
    p.lru_wx = (const float*)d_in[10]; p.lru_bx = (const float*)d_in[11]; p.lru_lambda = (const float*)d_in[12];
    p.mla_q_norm = (const float*)d_in[13]; p.mla_w_uq = (const float*)d_in[14]; p.mla_kv_norm = (const float*)d_in[15]; p.mla_w_ukv = (const float*)d_in[16];
    p.gdn_conv_w = (const float*)d_in[17]; p.gdn_a_log = (const float*)d_in[18]; p.gdn_dt_bias = (const float*)d_in[19]; p.gdn_norm = (const float*)d_in[20];
    p.w_out = (const float*)d_in[21]; p.norm_xattn = (const float*)d_in[22]; p.norm_mem = (const float*)d_in[23];
    p.xa_wq = (const float*)d_in[24]; p.xa_wkv = (const float*)d_in[25]; p.xa_wo = (const float*)d_in[26];
    p.norm_mlp = (const float*)d_in[27]; p.mlp_w1 = (const float*)d_in[28]; p.mlp_w2 = (const float*)d_in[29]; p.final_norm = (const float*)d_in[30];
    p.out = (float*)d_out; p.ws = (unsigned char*)d_ws;
#if N_LAUNCHES == 1
    p.ph_lo = 0; p.ph_hi = N_PHASES;
    void* args[] = {&p};
    hipError_t e = hipLaunchCooperativeKernel((const void*)hymba_fwd, dim3(grid), dim3(512), args, LDS_BYTES, stream);
    if (e != hipSuccess) fprintf(stderr, "kernel_launch: cooperative launch failed: %s\n", hipGetErrorString(e));
#else
    for (int ph = 0; ph < N_PHASES; ++ph) { p.ph_lo = ph; p.ph_hi = ph + 1; hipLaunchKernelGGL(hymba_fwd, dim3(grid), dim3(512), LDS_BYTES, stream, p); }
#endif
}
```

```cpp
#include <hip/hip_runtime.h>
#include <cstdio>
#include <cstdint>

#ifndef N_LAUNCHES
#define N_LAUNCHES 1
#endif

#define LAS __attribute__((address_space(3)))
typedef unsigned short bf16_t;
typedef short bf16x8 __attribute__((ext_vector_type(8)));
typedef float f32x4 __attribute__((ext_vector_type(4)));
typedef float f32x2 __attribute__((ext_vector_type(2)));
typedef unsigned u32x4 __attribute__((ext_vector_type(4)));
typedef unsigned u32x2 __attribute__((ext_vector_type(2)));

constexpr int T_TOK = 32768, DM = 1024, SEQ = 2048, NBATCH = 16, NCHUNK = 32, ZP = 3072, DFF = 4096, NMEM = 256;
constexpr int Z_RQ = 0, Z_RK = 256, Z_RV = 512, Z_RG = 768, Z_LX = 1024, Z_LG = 1280, Z_CQ = 1536, Z_CKV = 1728, Z_KR = 1856,
              Z_GQKV = 1888, Z_GG = 2656, Z_GB = 2912, Z_GA = 2916, IN_COLS = 2920;
constexpr float EPS = 1e-6f;
constexpr float LOG2E = 1.4426950408889634f;

constexpr size_t MiB = 1024 * 1024;
constexpr size_t WS_CTL = 0;
constexpr size_t CTL_BYTES = 65536;
constexpr size_t WS_PART = WS_CTL + CTL_BYTES;
constexpr size_t WS_LRUS = WS_PART + (size_t)T_TOK * 16 * 4;
constexpr size_t WS_GL = WS_LRUS + (size_t)2 * 16 * 32 * 256 * 4;
constexpr size_t WS_W = WS_GL + 65536;
constexpr size_t W_IN = 0, W_OUT = W_IN + (size_t)ZP * DM, W_Q = W_OUT + (size_t)DM * DM, W_KV = W_Q + (size_t)DM * DM, W_O = W_KV + (size_t)2 * DM * DM,
                 W_1 = W_O + (size_t)DM * DM, W_2 = W_1 + (size_t)DFF * DM, W_UQ = W_2 + (size_t)DFF * DM, W_UKV = W_UQ + 384 * 192, W_A = W_UKV + 512 * 128,
                 W_X = W_A + 4 * 64 * 64, W_LAYER = W_X + 4 * 64 * 64;
constexpr size_t WS_XB = WS_W + 2 * W_LAYER * 2;
constexpr size_t XB_BYTES = (size_t)T_TOK * DM * 2;
constexpr size_t MLA_Q_OFF = 0, MLA_K_OFF = (size_t)T_TOK * 4 * 96 * 2, MLA_VT_OFF = 2 * MLA_K_OFF;
constexpr size_t WS_KVM = WS_XB + XB_BYTES;
constexpr size_t KVM_LAYER = (size_t)2 * 4096 * 1024 * 2;
constexpr size_t WS_R = WS_KVM + 2 * KVM_LAYER;
constexpr size_t R_Y = (size_t)T_TOK * ZP * 2;
constexpr size_t R_OX = (size_t)T_TOK * DM * 2;
constexpr size_t WS_GDN = WS_R + 256 * MiB;
constexpr size_t WS_END = WS_GDN + 80 * MiB;
static_assert(WS_END <= 512 * MiB, "workspace map exceeds 512 MiB");
static_assert(WS_XB % 256 == 0 && WS_R % 256 == 0 && WS_GDN % 256 == 0 && WS_W % 256 == 0, "alignment");
constexpr int CW_BAR = 0;
constexpr int CW_QUEUE = 4096;

constexpr int LDS_BYTES = 160 * 1024;
constexpr int LDS_CTL = LDS_BYTES - 256;

typedef __bf16 bf16x2_t __attribute__((ext_vector_type(2)));
__device__ __forceinline__ unsigned pk2(float lo, float hi) { f32x2 t = {lo, hi}; bf16x2_t v = __builtin_convertvector(t, bf16x2_t); return __builtin_bit_cast(unsigned, v); }
__device__ __forceinline__ float bflo(unsigned w) { return __uint_as_float(w << 16); }
__device__ __forceinline__ float bfhi(unsigned w) { return __uint_as_float(w & 0xffff0000u); }
__device__ __forceinline__ float bf2f(bf16_t v) { return __uint_as_float((unsigned)v << 16); }
__device__ __forceinline__ bf16_t f2bf(float f) { return (bf16_t)(pk2(f, 0.f) & 0xffffu); }
__device__ __forceinline__ f32x4 mfma16(bf16x8 a, bf16x8 b, f32x4 c) { return __builtin_amdgcn_mfma_f32_16x16x32_bf16(a, b, c, 0, 0, 0); }
__device__ __forceinline__ float fexp2_(float x) { return __builtin_amdgcn_exp2f(x); }
__device__ __forceinline__ float fexp_(float x) { return __builtin_amdgcn_exp2f(x * LOG2E); }
__device__ __forceinline__ float frcp_(float x) { return __builtin_amdgcn_rcpf(x); }
__device__ __forceinline__ float frsq_(float x) { return __builtin_amdgcn_rsqf(x); }
__device__ __forceinline__ float fsqrt_(float x) { return __builtin_amdgcn_sqrtf(x); }
__device__ __forceinline__ float sigmoidf_(float x) { return frcp_(1.0f + fexp_(-x)); }
__device__ __forceinline__ float siluf_(float x) { return x * frcp_(1.0f + fexp_(-x)); }
__device__ __forceinline__ float softplusf_(float x) { return x > 20.f ? x : log1pf(__expf(x)); }
__device__ __forceinline__ float geluf_(float x) { const float u = 1.5957691216057308f * (x + 0.044715f * x * x * x); return x * frcp_(1.0f + fexp_(-u)); }
__device__ __forceinline__ float wave_sum(float v) {
#pragma unroll
    for (int o = 1; o < 64; o <<= 1) v += __shfl_xor(v, o);
    return v;
}
__device__ __forceinline__ void sincos_rev(float ang, float& s, float& c) {
    float rev = ang * 0.15915494309189535f; rev = rev - floorf(rev);
    s = __builtin_amdgcn_sinf(rev); c = __builtin_amdgcn_cosf(rev);
}
__device__ __forceinline__ bf16x8 mk8(u32x2 lo, u32x2 hi) { u32x4 t; t.x = lo.x; t.y = lo.y; t.z = hi.x; t.w = hi.y; return __builtin_bit_cast(bf16x8, t); }
__device__ __forceinline__ bf16x8 pack8(f32x4 a, f32x4 b) { u32x4 t; t.x = pk2(a.x, a.y); t.y = pk2(a.z, a.w); t.z = pk2(b.x, b.y); t.w = pk2(b.z, b.w); return __builtin_bit_cast(bf16x8, t); }

#define XB_TMO      128
#define XB_XCNT(j)  (256  + 64 * (j))
#define XB_XSUB(j)  (1280 + 64 * (j))
#define XB_XGEN(j)  (2304 + 64 * (j))
#define XB_TOP      3328
#define XB_TOPGEN   3392
#define XCD_BAR_WORDS 3456
#define XB_SPIN_CAP (1u << 22)
__device__ __forceinline__ unsigned xb_ld(unsigned* p)              { return __hip_atomic_load(p, __ATOMIC_RELAXED, __HIP_MEMORY_SCOPE_AGENT); }
__device__ __forceinline__ unsigned xb_add(unsigned* p, unsigned v) { return __hip_atomic_fetch_add(p, v, __ATOMIC_RELAXED, __HIP_MEMORY_SCOPE_AGENT); }
__device__ __forceinline__ unsigned xb_xcc_id() { return (unsigned)__builtin_amdgcn_s_getreg((3 << 11) | 20) & 0xFu; }
#define XB_SPIN(cond, bar) do { unsigned _sp = 0; while (cond) { __builtin_amdgcn_s_sleep(1); \
    if ((++_sp & 255u) == 0u) { if (xb_ld(&(bar)[XB_TMO])) break; if (_sp > XB_SPIN_CAP) { atomicAdd(&(bar)[XB_TMO], 1u); break; } } } } while (0)
struct XcdBarrier { unsigned* bar; unsigned x; volatile LAS unsigned* st; };
__device__ __forceinline__ XcdBarrier xcd_barrier_post(unsigned* bar, volatile LAS unsigned* st) {
    XcdBarrier b; b.bar = bar; b.x = xb_xcc_id(); b.st = st;
    if (threadIdx.x == 0) (void)xb_add(&bar[XB_XCNT(b.x)], 1u);
    return b;
}
__device__ __forceinline__ void xcd_barrier_complete(unsigned* bar, unsigned x, unsigned& nloc, unsigned& nx) {
    const unsigned G = gridDim.x * gridDim.y * gridDim.z;
    unsigned sum, cnt, mine, sp = 0u;
    for (;;) {
        sum = 0u; cnt = 0u; mine = 0u;
#pragma unroll
        for (unsigned j = 0; j < 16; ++j) { const unsigned c = xb_ld(&bar[XB_XCNT(j)]); sum += c; cnt += (c > 0u) ? 1u : 0u; mine = (j == x) ? c : mine; }
        if (sum == G) break;
        __builtin_amdgcn_s_sleep(1);
        if ((++sp & 255u) == 0u) { if (xb_ld(&bar[XB_TMO])) break; if (sp > XB_SPIN_CAP) { atomicAdd(&bar[XB_TMO], 1u); break; } }
    }
    nloc = mine > 0u ? mine : 1u; nx = cnt > 0u ? cnt : 1u;
}
__device__ __forceinline__ void xcd_barrier(const XcdBarrier& b) {
    asm volatile("s_waitcnt vmcnt(0)" ::: "memory");
    __syncthreads();
    if (threadIdx.x == 0) {
        unsigned* bar = b.bar;
        __builtin_amdgcn_s_waitcnt(0);
        unsigned nloc = b.st[0], nx = b.st[1];
        if (nloc == 0u) { xcd_barrier_complete(bar, b.x, nloc, nx); b.st[0] = nloc; b.st[1] = nx; }
        const unsigned old = xb_add(&bar[XB_XSUB(b.x)], 1u);
        const unsigned gen = old / nloc;
        if (old + 1u == (gen + 1u) * nloc) {
            __builtin_amdgcn_fence(__ATOMIC_RELEASE, "agent");
            asm volatile("s_waitcnt vmcnt(0)" ::: "memory");
            const unsigned og = xb_add(&bar[XB_TOP], 1u);
            const unsigned tg = og / nx;
            if (og + 1u == (tg + 1u) * nx) xb_add(&bar[XB_TOPGEN], 1u);
            else XB_SPIN(xb_ld(&bar[XB_TOPGEN]) == tg, bar);
            __builtin_amdgcn_fence(__ATOMIC_ACQUIRE, "agent");
            xb_add(&bar[XB_XGEN(b.x)], 1u);
            asm volatile("s_waitcnt vmcnt(0)" ::: "memory");
        } else {
            XB_SPIN(xb_ld(&bar[XB_XGEN(b.x)]) == gen, bar);
            __builtin_amdgcn_fence(__ATOMIC_ACQUIRE, "agent");
            asm volatile("s_waitcnt vmcnt(0)" ::: "memory");
        }
    }
    __syncthreads();
}

namespace pg8 {
constexpr int BM = 256, BK = 64, HALF = 128, HTB = HALF * BK * 2, STAGE_BYTES = 8 * HTB, NXCD = 8, WGM = 8;
__host__ __device__ __forceinline__ int lds_byte(int r, int c) { const int st = (r >> 4) * 2 + (c >> 5), rr = r & 15, cc = c & 31, ob = rr * 64 + cc * 2; return st * 1024 + (ob ^ (((ob >> 9) & 1) << 5)); }
__host__ __device__ __forceinline__ void stage_rc(int b, int& R, int& C) { const int st = b / 1024, sb = b % 1024, swz = sb ^ (((sb >> 9) & 1) << 5); R = (st >> 1) * 16 + swz / 64; C = (st & 1) * 32 + (swz % 64) / 2; }
__host__ __device__ __forceinline__ int perm32(int rho) { const int n = rho >> 4, i = rho & 15; return 8 * (i >> 2) + 4 * n + (i & 3); }
struct Unit { int pm, pn; };
struct Gemm { const bf16_t* A; const bf16_t* Bt; int M, N, K; };
struct StaticOrder {
    int nM, nN, nwg, G, c;
    __host__ __device__ void init(int M, int N, int G_, int c_) { nM = M / BM; nN = N / BM; nwg = nM * nN; G = G_; c = c_; }
    __host__ __device__ bool next(int i, Unit& u) const {
        const long L = (long)i * G + c; if (L >= nwg) return false;
        int wgid = (int)L; { const int q = nwg / NXCD, r = nwg % NXCD, xcd = wgid % NXCD, off = wgid / NXCD; wgid = (xcd < r ? xcd * (q + 1) : r * (q + 1) + (xcd - r) * q) + off; }
        const int nig = WGM * nN, gid = wgid / nig, fm = gid * WGM, gsz = (nM - fm) < WGM ? (nM - fm) : WGM;
        u.pm = fm + ((wgid % nig) % gsz); u.pn = (wgid % nig) / gsz; return true;
    }
    __device__ __forceinline__ void a_ready(const Unit&) const {}
    __device__ __forceinline__ void done(const Unit&) const {}
};

template <int ACT> struct EpiScaleBf16 {
    static constexpr bool PERM = true;
    bf16_t* O; int ldc; const float* part;
    __device__ __forceinline__ void operator()(const f32x4 (&acc)[2][2][4][2], const Unit& u, int wr, int wc, int fr, int fq) const {
        const int row0 = u.pm * BM + wr * 64 + fr, col0 = u.pn * BM + wc * 32 + 8 * fq;
#pragma unroll
        for (int ai = 0; ai < 2; ++ai)
#pragma unroll
            for (int m = 0; m < 4; ++m) {
                const int row = row0 + ai * HALF + m * 16;
                float sc = 1.0f;
                if (part) { const f32x4* pp = (const f32x4*)(part + (size_t)row * 16); const f32x4 a = pp[0], b = pp[1], c = pp[2], d = pp[3];
                    const float s = ((a.x + a.y) + (a.z + a.w)) + ((b.x + b.y) + (b.z + b.w)) + ((c.x + c.y) + (c.z + c.w)) + ((d.x + d.y) + (d.z + d.w));
                    sc = frsq_(s * (1.0f / 1024.0f) + EPS); }
                bf16_t* rowp = O + (size_t)row * ldc + col0;
#pragma unroll
                for (int bj = 0; bj < 2; ++bj) { f32x4 v0 = acc[ai][bj][m][0] * sc, v1 = acc[ai][bj][m][1] * sc;
                    if (ACT == 1) {
#pragma unroll
                        for (int j = 0; j < 4; ++j) { const float a0 = fmaxf(v0[j], 0.f), a1 = fmaxf(v1[j], 0.f); v0[j] = a0 * a0; v1[j] = a1 * a1; } }
                    u32x4 w; w.x = pk2(v0[0], v0[1]); w.y = pk2(v0[2], v0[3]); w.z = pk2(v1[0], v1[1]); w.w = pk2(v1[2], v1[3]);
                    *(u32x4*)(rowp + bj * HALF) = w; }
            }
    }
};
struct EpiResid {
    static constexpr bool PERM = false;
    float* X; bf16_t* XB; float* part; float alpha;
    __device__ __forceinline__ void operator()(const f32x4 (&acc)[2][2][4][2], const Unit& u, int wr, int wc, int fr, int fq) const {
        const int row0 = u.pm * BM + wr * 64 + fr, col0 = u.pn * BM + wc * 32 + 4 * fq;
#pragma unroll
        for (int ai = 0; ai < 2; ++ai)
#pragma unroll
            for (int m = 0; m < 4; ++m) {
                const int row = row0 + ai * HALF + m * 16;
                float* xp = X + (size_t)row * DM + col0; bf16_t* bp = XB + (size_t)row * DM + col0;
                float ss = 0.f;
#pragma unroll
                for (int bj = 0; bj < 2; ++bj)
#pragma unroll
                    for (int n = 0; n < 2; ++n) { const f32x4 v = *(const f32x4*)(xp + bj * HALF + n * 16) + acc[ai][bj][m][n] * alpha;
                        *(f32x4*)(xp + bj * HALF + n * 16) = v; ss += (v.x * v.x + v.y * v.y) + (v.z * v.z + v.w * v.w);
                        u32x2 w; w.x = pk2(v.x, v.y); w.y = pk2(v.z, v.w); *(u32x2*)(bp + bj * HALF + n * 16) = w; }
                ss += __shfl_xor(ss, 16); ss += __shfl_xor(ss, 32);
                if (fq == 0) part[(size_t)row * 16 + u.pn * 4 + wc] = ss;
            }
    }
};

template <class Epi, class Sched>
__device__ __forceinline__ void gemm_phase(LAS unsigned char* lds, const Gemm g, const Sched& S, const Epi& E, const int tid) {
    const int wid = __builtin_amdgcn_readfirstlane(tid >> 6), lane = tid & 63, wr = wid >> 2, wc = wid & 3, fr = lane & 15, fq = lane >> 4;
    const int K = g.K, nt = K / BK;
    unsigned voffA[2], voffB[2];
#pragma unroll
    for (int i = 0; i < 2; ++i) { int R, C; stage_rc(tid * 16 + i * 8192, R, C); const int Rb = Epi::PERM ? ((R & ~31) + perm32(R & 31)) : R;
        voffA[i] = (unsigned)(R * K + C) * 2u; voffB[i] = (unsigned)(Rb * K + C) * 2u; }
    const size_t kstep = (size_t)(BK * 2);
    const size_t hstep = (size_t)HALF * K * 2;
    const size_t tstep = 2 * hstep;
    const unsigned ldsw = (unsigned)wid * 1024u;
    const int aoff = lds_byte(wr * 64 + fr, fq * 8), boff = lds_byte(wc * 32 + fr, fq * 8);
#define PG8_SA(b, h) (((b) * 2 + (h)) * HTB)
#define PG8_SB(b, h) ((4 + (b) * 2 + (h)) * HTB)
#define PG8_STAGE(bufoff, gbase, voff) do { _Pragma("unroll") for (int _i = 0; _i < 2; ++_i) \
        __builtin_amdgcn_global_load_lds((const unsigned*)((const char*)(gbase) + (voff)[_i]), (LAS unsigned*)(lds + (bufoff) + ldsw + _i * 8192), 16, 0, 0); } while (0)
#define PG8_LDA(dst, b, h) do { _Pragma("unroll") for (int m = 0; m < 4; ++m) _Pragma("unroll") for (int k = 0; k < 2; ++k) dst[m][k] = *(const LAS bf16x8*)(lds + PG8_SA(b, h) + aoff + m * 2048 + k * 1024); } while (0)
#define PG8_LDB(dst, b, h) do { _Pragma("unroll") for (int n = 0; n < 2; ++n) _Pragma("unroll") for (int k = 0; k < 2; ++k) dst[n][k] = *(const LAS bf16x8*)(lds + PG8_SB(b, h) + boff + n * 2048 + k * 1024); } while (0)
#define PG8_MMA(ai, bj, At, Bt) do { __builtin_amdgcn_s_setprio(1); _Pragma("unroll") for (int m = 0; m < 4; ++m) _Pragma("unroll") for (int n = 0; n < 2; ++n) _Pragma("unroll") for (int k = 0; k < 2; ++k) \
        acc[ai][bj][m][n] = __builtin_amdgcn_mfma_f32_16x16x32_bf16(Bt[n][k], At[m][k], acc[ai][bj][m][n], 0, 0, 0); __builtin_amdgcn_s_setprio(0); } while (0)
#define PG8_WAIT_V(n) asm volatile("s_waitcnt vmcnt(" #n ")" ::: "memory")
#define PG8_WAIT_L(n) asm volatile("s_waitcnt lgkmcnt(" #n ")" ::: "memory")
#define PG8_BAR __builtin_amdgcn_s_barrier()
#define PG8_SCHED __builtin_amdgcn_sched_barrier(0)
    Unit cur, nxt; int ui = 0;
    if (!S.next(0, cur)) return;
    f32x4 acc[2][2][4][2];
#pragma unroll
    for (int a = 0; a < 2; ++a)
#pragma unroll
        for (int b = 0; b < 2; ++b)
#pragma unroll
            for (int m = 0; m < 4; ++m)
#pragma unroll
                for (int n = 0; n < 2; ++n) acc[a][b][m][n] = (f32x4){0.f, 0.f, 0.f, 0.f};
    bf16x8 At[4][2], B0[2][2], B1[2][2];
    const char* cA = (const char*)g.A + (size_t)cur.pm * tstep; const char* cB = (const char*)g.Bt + (size_t)cur.pn * tstep;
    S.a_ready(cur);
    PG8_STAGE(PG8_SB(0, 0), cB, voffB); PG8_STAGE(PG8_SA(0, 0), cA, voffA); PG8_STAGE(PG8_SB(0, 1), cB + hstep, voffB); PG8_STAGE(PG8_SA(0, 1), cA + hstep, voffA);
    if (wr == 1) PG8_BAR;
    PG8_WAIT_V(4); PG8_BAR;
    PG8_STAGE(PG8_SB(1, 0), cB + kstep, voffB); PG8_STAGE(PG8_SA(1, 0), cA + kstep, voffA); PG8_STAGE(PG8_SB(1, 1), cB + hstep + kstep, voffB);
    PG8_WAIT_V(6); PG8_BAR;
    for (;;) {
        const bool has_next = S.next(ui + 1, nxt);
        const char* nA = has_next ? (const char*)g.A + (size_t)nxt.pm * tstep : cA; const char* nB = has_next ? (const char*)g.Bt + (size_t)nxt.pn * tstep : cB;
        for (int t = 0; t < nt; t += 2) {
            const bool last = (t == nt - 2);
            const char* a1 = cA + (size_t)(t + 1) * kstep;
            const char* a2 = last ? nA : cA + (size_t)(t + 2) * kstep; const char* b2 = last ? nB : cB + (size_t)(t + 2) * kstep;
            const char* a3 = a2 + kstep; const char* b3 = b2 + kstep;
            if (last && has_next) S.a_ready(nxt);
            PG8_LDB(B0, 0, 0); PG8_SCHED; PG8_LDA(At, 0, 0); PG8_STAGE(PG8_SA(1, 1), a1 + hstep, voffA);
            PG8_WAIT_L(8); PG8_BAR; PG8_WAIT_L(0); PG8_MMA(0, 0, At, B0); PG8_BAR; PG8_SCHED;
            PG8_LDB(B1, 0, 1); PG8_STAGE(PG8_SB(0, 0), b2, voffB);
            PG8_BAR; PG8_WAIT_L(0); PG8_MMA(0, 1, At, B1); PG8_BAR;
            PG8_LDA(At, 0, 1); PG8_STAGE(PG8_SA(0, 0), a2, voffA);
            PG8_BAR; PG8_WAIT_L(0); PG8_MMA(1, 0, At, B0); PG8_BAR; PG8_SCHED;
            PG8_STAGE(PG8_SB(0, 1), b2 + hstep, voffB);
            PG8_WAIT_V(6); PG8_BAR; PG8_MMA(1, 1, At, B1); PG8_BAR;
            PG8_LDB(B0, 1, 0); PG8_SCHED; PG8_LDA(At, 1, 0); PG8_STAGE(PG8_SA(0, 1), a2 + hstep, voffA);
            PG8_WAIT_L(8); PG8_BAR; PG8_WAIT_L(0); PG8_MMA(0, 0, At, B0); PG8_BAR; PG8_SCHED;
            PG8_LDB(B1, 1, 1); PG8_STAGE(PG8_SB(1, 0), b3, voffB);
            PG8_BAR; PG8_WAIT_L(0); PG8_MMA(0, 1, At, B1); PG8_BAR;
            PG8_LDA(At, 1, 1); PG8_STAGE(PG8_SA(1, 0), a3, voffA);
            PG8_BAR; PG8_WAIT_L(0); PG8_MMA(1, 0, At, B0); PG8_BAR; PG8_SCHED;
            PG8_STAGE(PG8_SB(1, 1), b3 + hstep, voffB);
            PG8_WAIT_V(6); PG8_BAR; PG8_MMA(1, 1, At, B1); PG8_BAR;
        }
        E(acc, cur, wr, wc, fr, fq); S.done(cur);
        if (!has_next) break;
#pragma unroll
        for (int a = 0; a < 2; ++a)
#pragma unroll
            for (int b = 0; b < 2; ++b)
#pragma unroll
                for (int m = 0; m < 4; ++m)
#pragma unroll
                    for (int n = 0; n < 2; ++n) acc[a][b][m][n] = (f32x4){0.f, 0.f, 0.f, 0.f};
        cur = nxt; cA = nA; cB = nB; ++ui;
    }
    PG8_WAIT_V(0);
    if (wr == 0) PG8_BAR;
    PG8_BAR;
#undef PG8_SA
#undef PG8_SB
#undef PG8_STAGE
#undef PG8_LDA
#undef PG8_LDB
#undef PG8_MMA
#undef PG8_WAIT_V
#undef PG8_WAIT_L
#undef PG8_BAR
#undef PG8_SCHED
}
}

struct Params {
    const float* x; const float* mem; const int* pos;
    const float* norm_mix; const float* w_in; const float* ret_gn;
    const float* lru_conv_w; const float* lru_conv_b; const float* lru_wa; const float* lru_ba; const float* lru_wx; const float* lru_bx; const float* lru_lambda;
    const float* mla_q_norm; const float* mla_w_uq; const float* mla_kv_norm; const float* mla_w_ukv;
    const float* gdn_conv_w; const float* gdn_a_log; const float* gdn_dt_bias; const float* gdn_norm;
    const float* w_out; const float* norm_xattn; const float* norm_mem; const float* xa_wq; const float* xa_wkv; const float* xa_wo;
    const float* norm_mlp; const float* mlp_w1; const float* mlp_w2; const float* final_norm;
    float* out; unsigned char* ws;
    int ph_lo, ph_hi;
};

__device__ __forceinline__ bf16_t* wl(const Params& P, int l, size_t off) { return (bf16_t*)(P.ws + WS_W) + (size_t)l * W_LAYER + off; }

__device__ __forceinline__ void transpose_tile(const float* src, int K, int N, const float* gain, float scale, bf16_t* dst, int kb, int nb, LAS float* scr, int tid) {
#pragma unroll
    for (int i = 0; i < 8; ++i) { const int kk = (tid >> 6) + 8 * i, k = kb * 64 + kk, n = nb * 64 + (tid & 63);
        float v = 0.f; if (n < N) { v = src[(size_t)k * N + n] * scale; if (gain) v *= gain[k]; }
        scr[kk * 65 + (tid & 63)] = v; }
    __syncthreads();
    { const int nl = tid >> 3, k0 = (tid & 7) * 8; const LAS float* s = scr + k0 * 65 + nl;
      u32x4 o; o.x = pk2(s[0], s[65]); o.y = pk2(s[2 * 65], s[3 * 65]); o.z = pk2(s[4 * 65], s[5 * 65]); o.w = pk2(s[6 * 65], s[7 * 65]);
      *(u32x4*)(dst + (size_t)(nb * 64 + nl) * K + kb * 64 + k0) = o; }
    __syncthreads();
}
__device__ __forceinline__ void p0_prologue(const Params& P, LAS unsigned char* lds, int tid) {
    LAS float* scr = (LAS float*)lds;
    constexpr int T_IN = 16 * 48, T_SQ = 256, T_KV = 512, T_W1 = 1024, T_W2 = 1024, T_UQ = 18, T_UKV = 16, T_LRU = 8;
    constexpr int T_LAYER = T_IN + 3 * T_SQ + T_KV + T_W1 + T_W2 + T_UQ + T_UKV + T_LRU;
    for (int it = blockIdx.x; it < 2 * T_LAYER; it += gridDim.x) {
        const int l = it / T_LAYER; int r = it % T_LAYER;
        const float* src; const float* gain = nullptr; float scale = 1.f; bf16_t* dst; int K, N, nnb;
        if (r < T_IN) { src = P.w_in + (size_t)l * DM * IN_COLS; K = DM; N = IN_COLS; nnb = 48; gain = P.norm_mix + l * DM; dst = wl(P, l, W_IN); }
        else if ((r -= T_IN) < T_SQ) { src = P.w_out + (size_t)l * DM * DM; K = DM; N = DM; nnb = 16; dst = wl(P, l, W_OUT); }
        else if ((r -= T_SQ) < T_SQ) { src = P.xa_wq + (size_t)l * DM * DM; K = DM; N = DM; nnb = 16; gain = P.norm_xattn + l * DM; scale = 0.0625f * LOG2E; dst = wl(P, l, W_Q); }
        else if ((r -= T_SQ) < T_KV) { src = P.xa_wkv + (size_t)l * DM * 2 * DM; K = DM; N = 2 * DM; nnb = 32; gain = P.norm_mem + l * DM; dst = wl(P, l, W_KV); }
        else if ((r -= T_KV) < T_SQ) { src = P.xa_wo + (size_t)l * DM * DM; K = DM; N = DM; nnb = 16; dst = wl(P, l, W_O); }
        else if ((r -= T_SQ) < T_W1) { src = P.mlp_w1 + (size_t)l * DM * DFF; K = DM; N = DFF; nnb = 64; gain = P.norm_mlp + l * DM; dst = wl(P, l, W_1); }
        else if ((r -= T_W1) < T_W2) { src = P.mlp_w2 + (size_t)l * DFF * DM; K = DFF; N = DM; nnb = 16; dst = wl(P, l, W_2); }
        else if ((r -= T_W2) < T_UQ) { src = P.mla_w_uq + (size_t)l * 192 * 384; K = 192; N = 384; nnb = 6; gain = P.mla_q_norm + l * 192; dst = wl(P, l, W_UQ); }
        else if ((r -= T_UQ) < T_UKV) { src = P.mla_w_ukv + (size_t)l * 128 * 512; K = 128; N = 512; nnb = 8; gain = P.mla_kv_norm + l * 128; dst = wl(P, l, W_UKV); }
        else { r -= T_UKV; const int which = r >> 2, nb4 = r & 3; src = (which ? P.lru_wx : P.lru_wa) + (size_t)l * 4 * 4096 + nb4 * 4096; K = 64; N = 64; nnb = 1; dst = wl(P, l, which ? W_X : W_A) + nb4 * 4096; r = 0; }
        transpose_tile(src, K, N, gain, scale, dst, r / nnb, r % nnb, scr, tid);
    }
    const int wave = tid >> 6, lane = tid & 63;
    const int gw = blockIdx.x * 8 + wave, ngw = gridDim.x * 8;
    bf16_t* xb = (bf16_t*)(P.ws + WS_XB); float* part = (float*)(P.ws + WS_PART); bf16_t* memn = (bf16_t*)(P.ws + WS_GDN);
    for (int row = gw; row < T_TOK + NBATCH * NMEM; row += ngw) {
        const bool isx = row < T_TOK; const int r2 = isx ? row : row - T_TOK;
        const f32x4* src = (const f32x4*)((isx ? P.x : P.mem) + (size_t)r2 * DM) + lane;
        f32x4 v[4]; float s = 0.f;
#pragma unroll
        for (int j = 0; j < 4; ++j) { v[j] = src[64 * j]; s += (v[j].x * v[j].x + v[j].y * v[j].y) + (v[j].z * v[j].z + v[j].w * v[j].w); }
        s = wave_sum(s);
        if (isx) {
            f32x4* o = (f32x4*)(P.out + (size_t)row * DM) + lane; u32x2* ob = (u32x2*)(xb + (size_t)row * DM) + lane;
#pragma unroll
            for (int j = 0; j < 4; ++j) { o[64 * j] = v[j]; u32x2 w; w.x = pk2(v[j].x, v[j].y); w.y = pk2(v[j].z, v[j].w); ob[64 * j] = w; }
            if (lane < 16) part[(size_t)row * 16 + lane] = lane == 0 ? s : 0.f;
        } else {
            const float rs = frsq_(s * (1.0f / 1024.0f) + EPS); u32x2* ob = (u32x2*)(memn + (size_t)r2 * DM) + lane;
#pragma unroll
            for (int j = 0; j < 4; ++j) { u32x2 w; w.x = pk2(v[j].x * rs, v[j].y * rs); w.y = pk2(v[j].z * rs, v[j].w * rs); ob[64 * j] = w; }
        }
    }
}
__device__ __forceinline__ void final_norm_phase(const Params& P, int tid) {
    const int wave = tid >> 6, lane = tid & 63; const float* part = (const float*)(P.ws + WS_PART);
    f32x4 g[4];
#pragma unroll
    for (int j = 0; j < 4; ++j) g[j] = ((const f32x4*)P.final_norm)[64 * j + lane];
    for (int row = blockIdx.x * 8 + wave; row < T_TOK; row += gridDim.x * 8) {
        float s = lane < 16 ? part[(size_t)row * 16 + lane] : 0.f; s = wave_sum(s);
        const float rs = frsq_(s * (1.0f / 1024.0f) + EPS);
        f32x4* o = (f32x4*)(P.out + (size_t)row * DM) + lane;
#pragma unroll
        for (int j = 0; j < 4; ++j) { f32x4 v = o[64 * j]; o[64 * j] = v * rs * g[j]; }
    }
}

__device__ __forceinline__ void mla_pre_tile(const Params& P, int l, int rt, int lane) {
    const int fr = lane & 15, fq = lane >> 4;
    const bf16_t* z = (const bf16_t*)(P.ws + WS_R);
    bf16_t* Qo = (bf16_t*)(P.ws + WS_XB + MLA_Q_OFF); bf16_t* Ko = (bf16_t*)(P.ws + WS_XB + MLA_K_OFF); bf16_t* Vo = (bf16_t*)(P.ws + WS_XB + MLA_VT_OFF);
    const bf16_t* Wuq = wl(P, l, W_UQ); const bf16_t* Wukv = wl(P, l, W_UKV);
    const int tok0 = rt * 16, b = tok0 >> 11, s0 = tok0 & 2047;
    const bf16_t* zr = z + (size_t)(tok0 + fr) * ZP;
    bf16x8 cq[6], ckv[4]; float sq = 0.f, skv = 0.f;
#pragma unroll
    for (int s = 0; s < 6; ++s) { const u32x4 w = *(const u32x4*)(zr + Z_CQ + 32 * s + 8 * fq); cq[s] = __builtin_bit_cast(bf16x8, w);
        sq += bflo(w.x) * bflo(w.x) + bfhi(w.x) * bfhi(w.x) + bflo(w.y) * bflo(w.y) + bfhi(w.y) * bfhi(w.y) + bflo(w.z) * bflo(w.z) + bfhi(w.z) * bfhi(w.z) + bflo(w.w) * bflo(w.w) + bfhi(w.w) * bfhi(w.w); }
#pragma unroll
    for (int s = 0; s < 4; ++s) { const u32x4 w = *(const u32x4*)(zr + Z_CKV + 32 * s + 8 * fq); ckv[s] = __builtin_bit_cast(bf16x8, w);
        skv += bflo(w.x) * bflo(w.x) + bfhi(w.x) * bfhi(w.x) + bflo(w.y) * bflo(w.y) + bfhi(w.y) * bfhi(w.y) + bflo(w.z) * bflo(w.z) + bfhi(w.z) * bfhi(w.z) + bflo(w.w) * bflo(w.w) + bfhi(w.w) * bfhi(w.w); }
    sq += __shfl_xor(sq, 16); sq += __shfl_xor(sq, 32); skv += __shfl_xor(skv, 16); skv += __shfl_xor(skv, 32);
    const float rq = frsq_(sq * (1.0f / 192.0f) + EPS), rkv = frsq_(skv * (1.0f / 128.0f) + EPS);
    const float qsc = rq * 0.10206207261596575f * LOG2E;
    const float pos = (float)P.pos[tok0 + fr];
    float sn[4], cs[4];
#pragma unroll
    for (int r = 0; r < 4; ++r) { const float invf = exp2f(-(float)(4 * fq + r) * (13.287712379549449f / 16.0f)); sincos_rev(pos * invf, sn[r], cs[r]); }
    const size_t tokrow = (size_t)b * 4 * SEQ + (s0 + fr);
#pragma unroll 1
    for (int h = 0; h < 4; ++h) {
        bf16_t* qrow = Qo + (tokrow + (size_t)h * SEQ) * 96;
#pragma unroll 1
        for (int nt = 0; nt < 4; ++nt) { f32x4 a = {0.f, 0.f, 0.f, 0.f};
#pragma unroll
            for (int s = 0; s < 6; ++s) { const bf16x8 wf = *(const bf16x8*)(Wuq + (size_t)(h * 96 + nt * 16 + fr) * 192 + 32 * s + 8 * fq); a = mfma16(wf, cq[s], a); }
            a = a * qsc; u32x2 w; w.x = pk2(a.x, a.y); w.y = pk2(a.z, a.w); *(u32x2*)(qrow + nt * 16 + 4 * fq) = w; }
        f32x4 x1 = {0.f, 0.f, 0.f, 0.f}, x2 = {0.f, 0.f, 0.f, 0.f}, y1, y2;
#pragma unroll
        for (int s = 0; s < 6; ++s) { const bf16x8 wf1 = *(const bf16x8*)(Wuq + (size_t)(h * 96 + 64 + fr) * 192 + 32 * s + 8 * fq), wf2 = *(const bf16x8*)(Wuq + (size_t)(h * 96 + 80 + fr) * 192 + 32 * s + 8 * fq);
            x1 = mfma16(wf1, cq[s], x1); x2 = mfma16(wf2, cq[s], x2); }
        x1 = x1 * qsc; x2 = x2 * qsc;
#pragma unroll
        for (int r = 0; r < 4; ++r) { y1[r] = x1[r] * cs[r] - x2[r] * sn[r]; y2[r] = x1[r] * sn[r] + x2[r] * cs[r]; }
        { u32x2 w; w.x = pk2(y1.x, y1.y); w.y = pk2(y1.z, y1.w); *(u32x2*)(qrow + 64 + 4 * fq) = w; w.x = pk2(y2.x, y2.y); w.y = pk2(y2.z, y2.w); *(u32x2*)(qrow + 80 + 4 * fq) = w; }
    }
    u32x2 kr1, kr2;
    { const u32x2 a = *(const u32x2*)(zr + Z_KR + 4 * fq), c = *(const u32x2*)(zr + Z_KR + 16 + 4 * fq);
      const float x1[4] = {bflo(a.x), bfhi(a.x), bflo(a.y), bfhi(a.y)}, x2[4] = {bflo(c.x), bfhi(c.x), bflo(c.y), bfhi(c.y)}; float y1[4], y2[4];
#pragma unroll
      for (int r = 0; r < 4; ++r) { y1[r] = x1[r] * cs[r] - x2[r] * sn[r]; y2[r] = x1[r] * sn[r] + x2[r] * cs[r]; }
      kr1.x = pk2(y1[0], y1[1]); kr1.y = pk2(y1[2], y1[3]); kr2.x = pk2(y2[0], y2[1]); kr2.y = pk2(y2[2], y2[3]); }
    float rkv_r[4];
#pragma unroll
    for (int r = 0; r < 4; ++r) rkv_r[r] = __shfl(rkv, 4 * fq + r);
    const int chunk = s0 >> 6, key0 = (s0 & 63) + 4 * fq;
#pragma unroll 1
    for (int h = 0; h < 4; ++h) {
        bf16_t* krow = Ko + (tokrow + (size_t)h * SEQ) * 96;
#pragma unroll 1
        for (int nt = 0; nt < 4; ++nt) { f32x4 a = {0.f, 0.f, 0.f, 0.f};
#pragma unroll
            for (int s = 0; s < 4; ++s) { const bf16x8 wf = *(const bf16x8*)(Wukv + (size_t)(h * 128 + nt * 16 + fr) * 128 + 32 * s + 8 * fq); a = mfma16(wf, ckv[s], a); }
            a = a * rkv; u32x2 w; w.x = pk2(a.x, a.y); w.y = pk2(a.z, a.w); *(u32x2*)(krow + nt * 16 + 4 * fq) = w; }
        *(u32x2*)(krow + 64 + 4 * fq) = kr1; *(u32x2*)(krow + 80 + 4 * fq) = kr2;
        bf16_t* vt = Vo + ((size_t)((b * 4 + h) * NCHUNK + chunk) * 64) * 64;
#pragma unroll 1
        for (int nt = 0; nt < 4; ++nt) { f32x4 a = {0.f, 0.f, 0.f, 0.f};
#pragma unroll
            for (int s = 0; s < 4; ++s) { const bf16x8 wf = *(const bf16x8*)(Wukv + (size_t)(h * 128 + 64 + nt * 16 + fr) * 128 + 32 * s + 8 * fq); a = mfma16(ckv[s], wf, a); }
            u32x2 w; w.x = pk2(a.x * rkv_r[0], a.y * rkv_r[1]); w.y = pk2(a.z * rkv_r[2], a.w * rkv_r[3]);
            *(u32x2*)(vt + (size_t)(nt * 16 + fr) * 64 + key0) = w; }
    }
}

constexpr int MP_UQ_ROW = 200, MP_UKV_ROW = 136, MP_UKV_OFF = 96 * MP_UQ_ROW * 2, MP_BUF = MP_UKV_OFF + 128 * MP_UKV_ROW * 2;
__device__ __forceinline__ void mla_pre_item(const Params& P, int l, LAS unsigned char* lds, int it, int tid, int wave, int lane) {
    const int fr = lane & 15, fq = lane >> 4, rt = it * 8 + wave;
    const bf16_t* z = (const bf16_t*)(P.ws + WS_R);
    bf16_t* Qo = (bf16_t*)(P.ws + WS_XB + MLA_Q_OFF); bf16_t* Ko = (bf16_t*)(P.ws + WS_XB + MLA_K_OFF); bf16_t* Vo = (bf16_t*)(P.ws + WS_XB + MLA_VT_OFF);
    const bf16_t* Wuq = wl(P, l, W_UQ); const bf16_t* Wukv = wl(P, l, W_UKV);
    u32x4 stg[5];
#define MP_LOADQ(h_) do { _Pragma("unroll") for (int i = 0; i < 5; ++i) { const int p = tid + 512 * i; if (p < 2304) stg[i] = *(const u32x4*)(Wuq + (size_t)(h_) * 96 * 192 + (size_t)p * 8); } } while (0)
#define MP_STOREQ(buf_) do { _Pragma("unroll") for (int i = 0; i < 5; ++i) { const int p = tid + 512 * i; if (p < 2304) { const int row = p / 24, pc = p % 24; *(LAS u32x4*)(lds + (buf_) * MP_BUF + (row * MP_UQ_ROW + pc * 8) * 2) = stg[i]; } } } while (0)
#define MP_LOADKV(h_) do { _Pragma("unroll") for (int i = 0; i < 4; ++i) { const int p = tid + 512 * i; stg[i] = *(const u32x4*)(Wukv + (size_t)(h_) * 128 * 128 + (size_t)p * 8); } } while (0)
#define MP_STOREKV(buf_) do { _Pragma("unroll") for (int i = 0; i < 4; ++i) { const int p = tid + 512 * i, row = p >> 4, pc = p & 15; *(LAS u32x4*)(lds + (buf_) * MP_BUF + MP_UKV_OFF + (row * MP_UKV_ROW + pc * 8) * 2) = stg[i]; } } while (0)
    MP_LOADQ(0); MP_STOREQ(0); MP_LOADKV(0);
    const int tok0 = rt * 16, b = tok0 >> 11, s0 = tok0 & 2047;
    const bf16_t* zr = z + (size_t)(tok0 + fr) * ZP;
    bf16x8 cq[6], ckv[4]; float sq = 0.f, skv = 0.f;
#pragma unroll
    for (int s = 0; s < 6; ++s) { const u32x4 w = *(const u32x4*)(zr + Z_CQ + 32 * s + 8 * fq); cq[s] = __builtin_bit_cast(bf16x8, w);
        sq += bflo(w.x) * bflo(w.x) + bfhi(w.x) * bfhi(w.x) + bflo(w.y) * bflo(w.y) + bfhi(w.y) * bfhi(w.y) + bflo(w.z) * bflo(w.z) + bfhi(w.z) * bfhi(w.z) + bflo(w.w) * bflo(w.w) + bfhi(w.w) * bfhi(w.w); }
#pragma unroll
    for (int s = 0; s < 4; ++s) { const u32x4 w = *(const u32x4*)(zr + Z_CKV + 32 * s + 8 * fq); ckv[s] = __builtin_bit_cast(bf16x8, w);
        skv += bflo(w.x) * bflo(w.x) + bfhi(w.x) * bfhi(w.x) + bflo(w.y) * bflo(w.y) + bfhi(w.y) * bfhi(w.y) + bflo(w.z) * bflo(w.z) + bfhi(w.z) * bfhi(w.z) + bflo(w.w) * bflo(w.w) + bfhi(w.w) * bfhi(w.w); }
    const u32x2 kra = *(const u32x2*)(zr + Z_KR + 4 * fq), krc = *(const u32x2*)(zr + Z_KR + 16 + 4 * fq);
    const float pos = (float)P.pos[tok0 + fr];
    MP_STOREKV(0);
    sq += __shfl_xor(sq, 16); sq += __shfl_xor(sq, 32); skv += __shfl_xor(skv, 16); skv += __shfl_xor(skv, 32);
    const float rq = frsq_(sq * (1.0f / 192.0f) + EPS), rkv = frsq_(skv * (1.0f / 128.0f) + EPS);
    const float qsc = rq * 0.10206207261596575f * LOG2E;
    float sn[4], cs[4];
#pragma unroll
    for (int r = 0; r < 4; ++r) { const float invf = exp2f(-(float)(4 * fq + r) * (13.287712379549449f / 16.0f)); sincos_rev(pos * invf, sn[r], cs[r]); }
    const size_t tokrow = (size_t)b * 4 * SEQ + (s0 + fr);
    u32x2 kr1, kr2;
    { const float x1[4] = {bflo(kra.x), bfhi(kra.x), bflo(kra.y), bfhi(kra.y)}, x2[4] = {bflo(krc.x), bfhi(krc.x), bflo(krc.y), bfhi(krc.y)}; float y1[4], y2[4];
#pragma unroll
      for (int r = 0; r < 4; ++r) { y1[r] = x1[r] * cs[r] - x2[r] * sn[r]; y2[r] = x1[r] * sn[r] + x2[r] * cs[r]; }
      kr1.x = pk2(y1[0], y1[1]); kr1.y = pk2(y1[2], y1[3]); kr2.x = pk2(y2[0], y2[1]); kr2.y = pk2(y2[2], y2[3]); }
    float rkv_r[4];
#pragma unroll
    for (int r = 0; r < 4; ++r) rkv_r[r] = __shfl(rkv, 4 * fq + r);
    const int chunk = s0 >> 6, key0 = (s0 & 63) + 4 * fq;
    __syncthreads();
#pragma unroll 1
    for (int h = 0; h < 4; ++h) {
        if (h < 3) MP_LOADQ(h + 1);
        const LAS bf16_t* UQ = (const LAS bf16_t*)(lds + (h & 1) * MP_BUF); const LAS bf16_t* UKV = (const LAS bf16_t*)(lds + (h & 1) * MP_BUF + MP_UKV_OFF);
        bf16_t* qrow = Qo + (tokrow + (size_t)h * SEQ) * 96; bf16_t* krow = Ko + (tokrow + (size_t)h * SEQ) * 96;
        bf16_t* vt = Vo + ((size_t)((b * 4 + h) * NCHUNK + chunk) * 64) * 64;
#pragma unroll 1
        for (int nt = 0; nt < 4; ++nt) { f32x4 a = {0.f, 0.f, 0.f, 0.f};
#pragma unroll
            for (int s = 0; s < 6; ++s) a = mfma16(*(const LAS bf16x8*)(UQ + (nt * 16 + fr) * MP_UQ_ROW + 32 * s + 8 * fq), cq[s], a);
            a = a * qsc; u32x2 w; w.x = pk2(a.x, a.y); w.y = pk2(a.z, a.w); *(u32x2*)(qrow + nt * 16 + 4 * fq) = w; }
        {   f32x4 x1 = {0.f, 0.f, 0.f, 0.f}, x2 = {0.f, 0.f, 0.f, 0.f}, y1, y2;
#pragma unroll
            for (int s = 0; s < 6; ++s) { x1 = mfma16(*(const LAS bf16x8*)(UQ + (64 + fr) * MP_UQ_ROW + 32 * s + 8 * fq), cq[s], x1); x2 = mfma16(*(const LAS bf16x8*)(UQ + (80 + fr) * MP_UQ_ROW + 32 * s + 8 * fq), cq[s], x2); }
            x1 = x1 * qsc; x2 = x2 * qsc;
#pragma unroll
            for (int r = 0; r < 4; ++r) { y1[r] = x1[r] * cs[r] - x2[r] * sn[r]; y2[r] = x1[r] * sn[r] + x2[r] * cs[r]; }
            u32x2 w; w.x = pk2(y1.x, y1.y); w.y = pk2(y1.z, y1.w); *(u32x2*)(qrow + 64 + 4 * fq) = w; w.x = pk2(y2.x, y2.y); w.y = pk2(y2.z, y2.w); *(u32x2*)(qrow + 80 + 4 * fq) = w; }
        if (h < 3) { MP_STOREQ((h + 1) & 1); MP_LOADKV(h + 1); }
#pragma unroll 1
        for (int nt = 0; nt < 4; ++nt) { f32x4 a = {0.f, 0.f, 0.f, 0.f};
#pragma unroll
            for (int s = 0; s < 4; ++s) a = mfma16(*(const LAS bf16x8*)(UKV + (nt * 16 + fr) * MP_UKV_ROW + 32 * s + 8 * fq), ckv[s], a);
            a = a * rkv; u32x2 w; w.x = pk2(a.x, a.y); w.y = pk2(a.z, a.w); *(u32x2*)(krow + nt * 16 + 4 * fq) = w; }
        *(u32x2*)(krow + 64 + 4 * fq) = kr1; *(u32x2*)(krow + 80 + 4 * fq) = kr2;
#pragma unroll 1
        for (int nt = 0; nt < 4; ++nt) { f32x4 a = {0.f, 0.f, 0.f, 0.f};
#pragma unroll
            for (int s = 0; s < 4; ++s) a = mfma16(ckv[s], *(const LAS bf16x8*)(UKV + (64 + nt * 16 + fr) * MP_UKV_ROW + 32 * s + 8 * fq), a);
            u32x2 w; w.x = pk2(a.x * rkv_r[0], a.y * rkv_r[1]); w.y = pk2(a.z * rkv_r[2], a.w * rkv_r[3]);
            *(u32x2*)(vt + (size_t)(nt * 16 + fr) * 64 + key0) = w; }
        if (h < 3) MP_STOREKV((h + 1) & 1);
        __syncthreads();
    }
#undef MP_LOADQ
#undef MP_STOREQ
#undef MP_LOADKV
#undef MP_STOREKV
}

template <int DQK, int DV, int KT, int QT>
__device__ __forceinline__ void flash_item(LAS unsigned char* lds, const bf16_t* Qw, int ldq, const bf16_t* Kb, int ldk, const bf16_t* VTb, int ldv, int vts,
                                           bf16_t* Ow, int ldo, int ntiles, int wave_limit, int tid, int lane) {
    constexpr int KROW = DQK + 8, VROW = KT + 8, KS = DQK / 32, ET = DV / 16, NKT = KT / 16, KBYTES = KT * KROW * 2, BUF = KBYTES + DV * VROW * 2;
    constexpr int KP = KT * DQK / 8, VPR = KT / 8, VP = DV * VPR, NKP = (KP + 511) / 512, NVP = (VP + 511) / 512, NP = NKP > NVP ? NKP : NVP;
    const int fr = lane & 15, fq = lane >> 4;
    bf16x8 qf[QT][KS];
#pragma unroll
    for (int qi = 0; qi < QT; ++qi)
#pragma unroll
        for (int s = 0; s < KS; ++s) qf[qi][s] = *(const bf16x8*)(Qw + (size_t)(qi * 16 + fr) * ldq + 32 * s + 8 * fq);
    f32x4 ot[QT][ET];
#pragma unroll
    for (int qi = 0; qi < QT; ++qi)
#pragma unroll
        for (int e = 0; e < ET; ++e) ot[qi][e] = (f32x4){0.f, 0.f, 0.f, 0.f};
    float m_run[QT], l_run[QT];
#pragma unroll
    for (int qi = 0; qi < QT; ++qi) { m_run[qi] = -1e30f; l_run[qi] = 0.f; }
    u32x4 preg[NP];
#define FL_LOADK(j_) do { _Pragma("unroll") for (int i = 0; i < NKP; ++i) { const int idx = tid + i * 512; if (idx < KP) { const int row = idx / (DQK / 8), pc = idx % (DQK / 8); \
            preg[i] = *(const u32x4*)(Kb + (size_t)((j_) * KT + row) * ldk + pc * 8); } } } while (0)
#define FL_LOADV(j_) do { _Pragma("unroll") for (int i = 0; i < NVP; ++i) { const int idx = tid + i * 512; if (idx < VP) { const int row = idx / VPR, pc = idx % VPR; \
            preg[i] = *(const u32x4*)(VTb + (size_t)(j_) * vts + (size_t)row * ldv + pc * 8); } } } while (0)
#define FL_STOREK(buf_) do { LAS bf16_t* Kt_ = (LAS bf16_t*)(lds + (buf_) * BUF); \
        _Pragma("unroll") for (int i = 0; i < NKP; ++i) { const int idx = tid + i * 512; if (idx < KP) { const int row = idx / (DQK / 8), pc = idx % (DQK / 8); *(LAS u32x4*)(Kt_ + row * KROW + pc * 8) = preg[i]; } } } while (0)
#define FL_STOREV(buf_) do { LAS bf16_t* Vt_ = (LAS bf16_t*)(lds + (buf_) * BUF + KBYTES); \
        _Pragma("unroll") for (int i = 0; i < NVP; ++i) { const int idx = tid + i * 512; if (idx < VP) { const int row = idx / VPR, pc = idx % VPR; *(LAS u32x4*)(Vt_ + row * VROW + pc * 8) = preg[i]; } } } while (0)
    FL_LOADK(0); FL_STOREK(0); FL_LOADV(0); FL_STOREV(0);
    __syncthreads();
#pragma unroll 1
    for (int j = 0; j < ntiles; ++j) {
        const bool more = j + 1 < ntiles, act = j < wave_limit;
        const LAS bf16_t* Kt = (const LAS bf16_t*)(lds + (j & 1) * BUF); const LAS bf16_t* Vt = (const LAS bf16_t*)(lds + (j & 1) * BUF + KBYTES);
        if (more) FL_LOADK(j + 1);
        f32x4 st[QT][NKT];
        if (act) {
#pragma unroll
            for (int kt = 0; kt < NKT; ++kt) {
#pragma unroll
                for (int qi = 0; qi < QT; ++qi) st[qi][kt] = (f32x4){0.f, 0.f, 0.f, 0.f};
#pragma unroll
                for (int s = 0; s < KS; ++s) { const bf16x8 kf = *(const LAS bf16x8*)(Kt + (kt * 16 + fr) * KROW + 32 * s + 8 * fq);
#pragma unroll
                    for (int qi = 0; qi < QT; ++qi) st[qi][kt] = mfma16(kf, qf[qi][s], st[qi][kt]); } }
        }
        if (more) { FL_STOREK((j + 1) & 1); FL_LOADV(j + 1); }
        if (act) {
            bf16x8 pf[QT][NKT / 2];
#pragma unroll
            for (int qi = 0; qi < QT; ++qi) {
                float mx = fmaxf(fmaxf(st[qi][0].x, st[qi][0].y), fmaxf(st[qi][0].z, st[qi][0].w));
#pragma unroll
                for (int kt = 1; kt < NKT; ++kt) mx = fmaxf(mx, fmaxf(fmaxf(st[qi][kt].x, st[qi][kt].y), fmaxf(st[qi][kt].z, st[qi][kt].w)));
                mx = fmaxf(mx, __shfl_xor(mx, 16)); mx = fmaxf(mx, __shfl_xor(mx, 32));
                const float m_new = fmaxf(m_run[qi], mx), alpha = fexp2_(m_run[qi] - m_new);
                float ls = 0.f;
#pragma unroll
                for (int kt = 0; kt < NKT; ++kt)
#pragma unroll
                    for (int r = 0; r < 4; ++r) { const float p = fexp2_(st[qi][kt][r] - m_new); st[qi][kt][r] = p; ls += p; }
                l_run[qi] = l_run[qi] * alpha + ls; m_run[qi] = m_new;
#pragma unroll
                for (int e = 0; e < ET; ++e) ot[qi][e] = ot[qi][e] * alpha;
#pragma unroll
                for (int k2 = 0; k2 < NKT / 2; ++k2) pf[qi][k2] = pack8(st[qi][2 * k2], st[qi][2 * k2 + 1]);
            }
#pragma unroll
            for (int e = 0; e < ET; ++e) {
                const LAS bf16_t* vr = Vt + (e * 16 + fr) * VROW + 4 * fq;
#pragma unroll
                for (int k2 = 0; k2 < NKT / 2; ++k2) { const bf16x8 v0 = mk8(*(const LAS u32x2*)(vr + 32 * k2), *(const LAS u32x2*)(vr + 32 * k2 + 16));
#pragma unroll
                    for (int qi = 0; qi < QT; ++qi) ot[qi][e] = mfma16(v0, pf[qi][k2], ot[qi][e]); }
            }
        }
        if (more) FL_STOREV((j + 1) & 1);
        __syncthreads();
    }
#undef FL_LOADK
#undef FL_LOADV
#undef FL_STOREK
#undef FL_STOREV
#pragma unroll
    for (int qi = 0; qi < QT; ++qi) {
        float l = l_run[qi]; l += __shfl_xor(l, 16); l += __shfl_xor(l, 32);
        const float inv = frcp_(l);
#pragma unroll
        for (int e = 0; e < ET; ++e) { u32x2 w; w.x = pk2(ot[qi][e].x * inv, ot[qi][e].y * inv); w.y = pk2(ot[qi][e].z * inv, ot[qi][e].w * inv);
            *(u32x2*)(Ow + (size_t)(qi * 16 + fr) * ldo + e * 16 + 4 * fq) = w; }
    }
}
__device__ __forceinline__ void mla_attn_item(const Params& P, LAS unsigned char* lds, int it, int tid, int wave, int lane) {
    const int qt = 7 - (it >> 6), bh = it & 63;
    const bf16_t* Q = (const bf16_t*)(P.ws + WS_XB + MLA_Q_OFF) + ((size_t)bh * SEQ + qt * 256 + wave * 32) * 96;
    const bf16_t* K = (const bf16_t*)(P.ws + WS_XB + MLA_K_OFF) + (size_t)bh * SEQ * 96;
    const bf16_t* VT = (const bf16_t*)(P.ws + WS_XB + MLA_VT_OFF) + (size_t)bh * NCHUNK * 4096;
    bf16_t* y = (bf16_t*)(P.ws + WS_R + R_Y) + ((size_t)(bh >> 2) * SEQ + qt * 256 + wave * 32) * DM + 512 + (bh & 3) * 64;
    flash_item<96, 64, 64, 2>(lds, Q, 96, K, 96, VT, 64, 4096, y, DM, 4 * qt + 4, 4 * qt + (wave >> 1) + 1, tid, lane);
}
constexpr int XA_KROW = 264, XA_VROW = 72, XA_KBUF = 32 * XA_KROW * 2, XA_VBUF = 128 * XA_VROW * 2, XA_VOFF = 2 * XA_KBUF;
__device__ __forceinline__ void xa_item(const Params& P, int l, LAS unsigned char* lds, int it, int tid, int wave, int lane) {
    const int qt = it & 7, h = (it >> 3) & 3, b = it >> 5, fr = lane & 15, fq = lane >> 4;
    const size_t qoff = ((size_t)b * SEQ + qt * 256 + wave * 32) * DM + h * 256;
    const bf16_t* Q = (const bf16_t*)(P.ws + WS_R) + qoff; bf16_t* O = (bf16_t*)(P.ws + WS_R + R_OX) + qoff;
    const bf16_t* Kb = (const bf16_t*)(P.ws + WS_KVM + (size_t)l * KVM_LAYER) + (size_t)b * NMEM * DM + h * 256;
    const bf16_t* VTb = (const bf16_t*)(P.ws + WS_KVM + (size_t)l * KVM_LAYER + (size_t)4096 * 1024 * 2) + (size_t)h * 256 * 4096 + b * NMEM;
    u32x4 stg[2];
#define XA_LOADK(j_) do { _Pragma("unroll") for (int i = 0; i < 2; ++i) { const int p = tid + 512 * i, row = p >> 5, pc = p & 31; stg[i] = *(const u32x4*)(Kb + (size_t)((j_) * 32 + row) * DM + pc * 8); } } while (0)
#define XA_STOREK(buf_) do { _Pragma("unroll") for (int i = 0; i < 2; ++i) { const int p = tid + 512 * i, row = p >> 5, pc = p & 31; *(LAS u32x4*)(lds + (buf_) * XA_KBUF + (row * XA_KROW + pc * 8) * 2) = stg[i]; } } while (0)
#define XA_LOADV(t_) do { _Pragma("unroll") for (int i = 0; i < 2; ++i) { const int p = tid + 512 * i, row = p >> 3, pc = p & 7; stg[i] = *(const u32x4*)(VTb + (size_t)(((t_) >> 2) * 128 + row) * 4096 + ((t_) & 3) * 64 + pc * 8); } } while (0)
#define XA_STOREV(buf_) do { _Pragma("unroll") for (int i = 0; i < 2; ++i) { const int p = tid + 512 * i, row = p >> 3, pc = p & 7; *(LAS u32x4*)(lds + XA_VOFF + (buf_) * XA_VBUF + (row * XA_VROW + pc * 8) * 2) = stg[i]; } } while (0)
    XA_LOADK(0);
    bf16x8 pf[2][8];
    float linv[2], c1[2];
    {
        bf16x8 qf[2][8];
#pragma unroll
        for (int qi = 0; qi < 2; ++qi)
#pragma unroll
            for (int s = 0; s < 8; ++s) qf[qi][s] = *(const bf16x8*)(Q + (size_t)(qi * 16 + fr) * DM + 32 * s + 8 * fq);
        XA_STOREK(0);
        __syncthreads();
        float m1[2], l1[2];
#pragma unroll
        for (int half = 0; half < 2; ++half) {
            f32x4 S[2][8];
#pragma unroll
            for (int jj = 0; jj < 4; ++jj) { const int j = half * 4 + jj;
                if (j < 7) XA_LOADK(j + 1); else XA_LOADV(0);
                const LAS bf16_t* Kt = (const LAS bf16_t*)(lds + (j & 1) * XA_KBUF);
#pragma unroll
                for (int kt = 0; kt < 2; ++kt) {
                    f32x4 a0 = {0.f, 0.f, 0.f, 0.f}, a1 = {0.f, 0.f, 0.f, 0.f};
#pragma unroll
                    for (int s = 0; s < 8; ++s) { const bf16x8 kf = *(const LAS bf16x8*)(Kt + (kt * 16 + fr) * XA_KROW + 32 * s + 8 * fq); a0 = mfma16(kf, qf[0][s], a0); a1 = mfma16(kf, qf[1][s], a1); }
                    S[0][2 * jj + kt] = a0; S[1][2 * jj + kt] = a1; __builtin_amdgcn_sched_barrier(0); }
                if (j < 7) XA_STOREK((j + 1) & 1); else XA_STOREV(0);
                __syncthreads();
            }
#pragma unroll
            for (int qi = 0; qi < 2; ++qi) {
                float mx = -1e30f;
#pragma unroll
                for (int t = 0; t < 8; ++t) mx = fmaxf(mx, fmaxf(fmaxf(S[qi][t].x, S[qi][t].y), fmaxf(S[qi][t].z, S[qi][t].w)));
                mx = fmaxf(mx, __shfl_xor(mx, 16)); mx = fmaxf(mx, __shfl_xor(mx, 32));
                if (half == 1) { const float m = fmaxf(m1[qi], mx); c1[qi] = fexp2_(m1[qi] - m); mx = m; }
                float ls = 0.f;
#pragma unroll
                for (int t = 0; t < 4; ++t) { f32x4 pa, pb;
#pragma unroll
                    for (int r = 0; r < 4; ++r) { pa[r] = fexp2_(S[qi][2 * t][r] - mx); pb[r] = fexp2_(S[qi][2 * t + 1][r] - mx); }
                    ls += ((pa.x + pa.y) + (pa.z + pa.w)) + ((pb.x + pb.y) + (pb.z + pb.w));
                    pf[qi][half * 4 + t] = pack8(pa, pb);
                    asm volatile("" : "+v"(ls)); }
                ls += __shfl_xor(ls, 16); ls += __shfl_xor(ls, 32);
                if (half == 0) { m1[qi] = mx; l1[qi] = ls; } else linv[qi] = frcp_(l1[qi] * c1[qi] + ls);
            }
        }
    }
#pragma unroll
    for (int eh = 0; eh < 2; ++eh) {
        f32x4 ot[2][8];
#pragma unroll
        for (int qi = 0; qi < 2; ++qi)
#pragma unroll
            for (int e = 0; e < 8; ++e) ot[qi][e] = (f32x4){0.f, 0.f, 0.f, 0.f};
#pragma unroll
        for (int jv = 0; jv < 4; ++jv) { const int t = eh * 4 + jv;
            if (t < 7) XA_LOADV(t + 1);
            const LAS bf16_t* Vt = (const LAS bf16_t*)(lds + XA_VOFF + (t & 1) * XA_VBUF);
#pragma unroll
            for (int e = 0; e < 8; ++e) { const LAS bf16_t* vr = Vt + (e * 16 + fr) * XA_VROW + 4 * fq;
                const bf16x8 v0 = mk8(*(const LAS u32x2*)vr, *(const LAS u32x2*)(vr + 16)), v1 = mk8(*(const LAS u32x2*)(vr + 32), *(const LAS u32x2*)(vr + 48));
                ot[0][e] = mfma16(v0, pf[0][2 * jv], ot[0][e]); ot[1][e] = mfma16(v0, pf[1][2 * jv], ot[1][e]);
                ot[0][e] = mfma16(v1, pf[0][2 * jv + 1], ot[0][e]); ot[1][e] = mfma16(v1, pf[1][2 * jv + 1], ot[1][e]); if (e & 1) __builtin_amdgcn_sched_barrier(0); }
            if (jv == 1) {
#pragma unroll
                for (int e = 0; e < 8; ++e) { ot[0][e] = ot[0][e] * c1[0]; ot[1][e] = ot[1][e] * c1[1]; } }
            if (t < 7) XA_STOREV((t + 1) & 1);
            __syncthreads();
        }
#pragma unroll
        for (int qi = 0; qi < 2; ++qi)
#pragma unroll
            for (int e = 0; e < 8; ++e) { u32x2 w; w.x = pk2(ot[qi][e].x * linv[qi], ot[qi][e].y * linv[qi]); w.y = pk2(ot[qi][e].z * linv[qi], ot[qi][e].w * linv[qi]);
                *(u32x2*)(O + (size_t)(qi * 16 + fr) * DM + eh * 128 + e * 16 + 4 * fq) = w; }
    }
#undef XA_LOADK
#undef XA_STOREK
#undef XA_LOADV
#undef XA_STOREV
}
constexpr int GP_KN = 0, GP_KB = 9216, GP_QN = 18432, GP_L = 9216, GP_RHS = 27648, GP_G = 60416, GP_GC = 60672, GP_HEAD = 61440;
__device__ __forceinline__ bf16_t* gdn_buf(const Params& P, int chh, int k) { return (bf16_t*)(P.ws + WS_GDN) + ((size_t)chh * 5 + k) * 4096; }
__device__ __forceinline__ void gdn_pre_item(const Params& P, int l, LAS unsigned char* lds, int it, int tid) {
    const int hp = it & 1, n = (it >> 1) & 31, b = it >> 6;
    const int hh = tid >> 8, h = 2 * hp + hh, tt = tid & 255, c = tt >> 2, qr = tt & 3, lane = tid & 63;
    LAS unsigned char* L = lds + hh * GP_HEAD;
    const bf16_t* z = (const bf16_t*)(P.ws + WS_R);
    const int s = n * 64 + c; const size_t tok = (size_t)b * SEQ + s;
    const float* cw = P.gdn_conv_w + (size_t)l * 4 * 768;
    const int chh = (b * NCHUNK + n) * 4 + h;
    float q[16], k[16], v[16];
#pragma unroll
    for (int part = 0; part < 3; ++part) {
        float* dst = part == 0 ? q : (part == 1 ? k : v);
        const int ch0 = part * 256 + h * 64 + qr * 16;
#pragma unroll
        for (int i = 0; i < 16; ++i) dst[i] = 0.f;
#pragma unroll
        for (int kk = 0; kk < 4; ++kk) { {
            const bool okk = s - 3 + kk >= 0; const float mk = okk ? 1.f : 0.f;
            const bf16_t* zr = z + (okk ? tok - 3 + kk : tok) * ZP + Z_GQKV + ch0; const u32x4 w0 = *(const u32x4*)zr, w1 = *(const u32x4*)(zr + 8);
            const float* wr = cw + kk * 768 + ch0; const f32x4 c0 = *(const f32x4*)wr * mk, c1 = *(const f32x4*)(wr + 4) * mk, c2 = *(const f32x4*)(wr + 8) * mk, c3 = *(const f32x4*)(wr + 12) * mk;
            dst[0] += c0.x * bflo(w0.x); dst[1] += c0.y * bfhi(w0.x); dst[2] += c0.z * bflo(w0.y); dst[3] += c0.w * bfhi(w0.y);
            dst[4] += c1.x * bflo(w0.z); dst[5] += c1.y * bfhi(w0.z); dst[6] += c1.z * bflo(w0.w); dst[7] += c1.w * bfhi(w0.w);
            dst[8] += c2.x * bflo(w1.x); dst[9] += c2.y * bfhi(w1.x); dst[10] += c2.z * bflo(w1.y); dst[11] += c2.w * bfhi(w1.y);
            dst[12] += c3.x * bflo(w1.z); dst[13] += c3.y * bfhi(w1.z); dst[14] += c3.z * bflo(w1.w); dst[15] += c3.w * bfhi(w1.w); } }
#pragma unroll
        for (int i = 0; i < 16; ++i) dst[i] = siluf_(dst[i]);
    }
    float sq = 0.f, sk = 0.f;
#pragma unroll
    for (int i = 0; i < 16; ++i) { sq += q[i] * q[i]; sk += k[i] * k[i]; }
    sq += __shfl_xor(sq, 1); sq += __shfl_xor(sq, 2); sk += __shfl_xor(sk, 1); sk += __shfl_xor(sk, 2);
    const float rq = frsq_(sq + EPS) * 0.125f, rk = frsq_(sk + EPS);
    const bf16_t* zt = z + tok * ZP;
    const float beta = sigmoidf_(bf2f(zt[Z_GB + h]));
    const float g = -fexp_(P.gdn_a_log[l * 4 + h]) * softplusf_(bf2f(zt[Z_GA + h]) + P.gdn_dt_bias[l * 4 + h]);
    {
        u32x4 w0, w1;
#define PK16(dst0, dst1, src, sc) do { dst0.x = pk2(src[0] * (sc), src[1] * (sc)); dst0.y = pk2(src[2] * (sc), src[3] * (sc)); dst0.z = pk2(src[4] * (sc), src[5] * (sc)); dst0.w = pk2(src[6] * (sc), src[7] * (sc)); \
        dst1.x = pk2(src[8] * (sc), src[9] * (sc)); dst1.y = pk2(src[10] * (sc), src[11] * (sc)); dst1.z = pk2(src[12] * (sc), src[13] * (sc)); dst1.w = pk2(src[14] * (sc), src[15] * (sc)); } while (0)
        PK16(w0, w1, k, rk);        *(LAS u32x4*)(L + GP_KN + (c * 72 + qr * 16) * 2) = w0; *(LAS u32x4*)(L + GP_KN + (c * 72 + qr * 16 + 8) * 2) = w1;
        PK16(w0, w1, k, rk * beta); *(LAS u32x4*)(L + GP_KB + (c * 72 + qr * 16) * 2) = w0; *(LAS u32x4*)(L + GP_KB + (c * 72 + qr * 16 + 8) * 2) = w1;
        PK16(w0, w1, q, rq);        *(LAS u32x4*)(L + GP_QN + (c * 72 + qr * 16) * 2) = w0; *(LAS u32x4*)(L + GP_QN + (c * 72 + qr * 16 + 8) * 2) = w1;
        LAS float* rhs = (LAS float*)(L + GP_RHS) + c * 128 + qr * 16;
#pragma unroll
        for (int i = 0; i < 4; ++i) *(LAS f32x4*)(rhs + 4 * i) = (f32x4){v[4 * i] * beta, v[4 * i + 1] * beta, v[4 * i + 2] * beta, v[4 * i + 3] * beta};
        if (qr == 0) ((LAS float*)(L + GP_G))[c] = g;
    }
    __syncthreads();
    {
        float gc = 0.f, run = 0.f; const LAS float* G = (const LAS float*)(L + GP_G);
        for (int i = 0; i < 64; ++i) { run += G[i]; gc = (i == c) ? run : gc; }
        const float eg = fexp_(gc), ek = fexp_(run - gc);
        LAS float* rhs = (LAS float*)(L + GP_RHS) + c * 128 + 64 + qr * 16;
#pragma unroll
        for (int i = 0; i < 4; ++i) *(LAS f32x4*)(rhs + 4 * i) = (f32x4){k[4 * i] * rk * beta * eg, k[4 * i + 1] * rk * beta * eg, k[4 * i + 2] * rk * beta * eg, k[4 * i + 3] * rk * beta * eg};
        u32x4 w0, w1; PK16(w0, w1, q, rq * eg);
        bf16_t* qd = gdn_buf(P, chh, 3) + c * 64 + qr * 16; *(u32x4*)qd = w0; *(u32x4*)(qd + 8) = w1;
        bf16_t* kdt = gdn_buf(P, chh, 4) + (qr * 16) * 64 + c;
#pragma unroll
        for (int i = 0; i < 16; ++i) kdt[i * 64] = f2bf(k[i] * rk * ek);
        if (qr == 0) ((LAS float*)(L + GP_GC))[c] = gc;
        if (tt == 0) ((float*)(P.ws + WS_GL))[chh] = fexp_(run);
    }
#undef PK16
    __syncthreads();
    {
        const int it4 = (tid >> 6) & 3, fr = lane & 15, fq = lane >> 4;
        const LAS bf16_t* Kn = (const LAS bf16_t*)(L + GP_KN); const LAS bf16_t* KB = (const LAS bf16_t*)(L + GP_KB); const LAS bf16_t* Qn = (const LAS bf16_t*)(L + GP_QN);
        const LAS float* GC = (const LAS float*)(L + GP_GC);
        const bf16x8 a0 = *(const LAS bf16x8*)(KB + (it4 * 16 + fr) * 72 + 8 * fq), a1 = *(const LAS bf16x8*)(KB + (it4 * 16 + fr) * 72 + 32 + 8 * fq);
        const bf16x8 q0 = *(const LAS bf16x8*)(Qn + (it4 * 16 + fr) * 72 + 8 * fq), q1 = *(const LAS bf16x8*)(Qn + (it4 * 16 + fr) * 72 + 32 + 8 * fq);
        float gci[4];
#pragma unroll
        for (int r = 0; r < 4; ++r) gci[r] = GC[it4 * 16 + 4 * fq + r];
        f32x4 lv[4]; bf16_t* att = gdn_buf(P, chh, 2);
#pragma unroll
        for (int jt = 0; jt < 4; ++jt) {
            const bf16x8 b0 = *(const LAS bf16x8*)(Kn + (jt * 16 + fr) * 72 + 8 * fq), b1 = *(const LAS bf16x8*)(Kn + (jt * 16 + fr) * 72 + 32 + 8 * fq);
            f32x4 al = {0.f, 0.f, 0.f, 0.f}, aa = {0.f, 0.f, 0.f, 0.f};
            al = mfma16(a0, b0, al); al = mfma16(a1, b1, al); aa = mfma16(q0, b0, aa); aa = mfma16(q1, b1, aa);
            const int j = jt * 16 + fr; const float gcj = GC[j];
#pragma unroll
            for (int r = 0; r < 4; ++r) { const int i = it4 * 16 + 4 * fq + r; const float dec = fexp_(fminf(gci[r] - gcj, 0.f));
                lv[jt][r] = (i > j) ? al[r] * dec : 0.f; att[i * 64 + j] = f2bf((i >= j) ? aa[r] * dec : 0.f); }
        }
        __syncthreads();
        LAS float* Lm = (LAS float*)(L + GP_L);
#pragma unroll
        for (int jt = 0; jt < 4; ++jt)
#pragma unroll
            for (int r = 0; r < 4; ++r) Lm[(it4 * 16 + 4 * fq + r) * 64 + jt * 16 + fr] = lv[jt][r];
    }
    __syncthreads();
    if (tt < 128) {
        const LAS float* Lm = (const LAS float*)(L + GP_L); const LAS float* rhs = (const LAS float*)(L + GP_RHS) + tt;
        float x[64];
#pragma unroll
        for (int i = 0; i < 64; ++i) {
            float a0 = rhs[i * 128], a1 = 0.f;
#pragma unroll
            for (int j4 = 0; j4 < (i + 3) / 4; ++j4) { const f32x4 lr = *(const LAS f32x4*)(Lm + i * 64 + 4 * j4);
                if (4 * j4 + 0 < i) a0 -= lr.x * x[4 * j4 + 0]; if (4 * j4 + 1 < i) a1 -= lr.y * x[4 * j4 + 1];
                if (4 * j4 + 2 < i) a0 -= lr.z * x[4 * j4 + 2]; if (4 * j4 + 3 < i) a1 -= lr.w * x[4 * j4 + 3]; }
            x[i] = a0 + a1;
        }
        if (tt < 64) { bf16_t* ut = gdn_buf(P, chh, 1) + tt * 64;
#pragma unroll
            for (int g8 = 0; g8 < 8; ++g8) { u32x4 w; w.x = pk2(x[8 * g8], x[8 * g8 + 1]); w.y = pk2(x[8 * g8 + 2], x[8 * g8 + 3]); w.z = pk2(x[8 * g8 + 4], x[8 * g8 + 5]); w.w = pk2(x[8 * g8 + 6], x[8 * g8 + 7]); *(u32x4*)(ut + 8 * g8) = w; }
        } else { bf16_t* wo = gdn_buf(P, chh, 0) + (tt - 64);
#pragma unroll
            for (int i = 0; i < 64; ++i) wo[i * 64] = f2bf(x[i]); }
    }
    __syncthreads();
}

constexpr int GC_W = 0, GC_UT = 9216, GC_ATT = 18432, GC_QD = 27648, GC_KDT = 36864, GC_O = 46080, GC_BH = 62720;
__device__ __forceinline__ bf16x8 lds_perm(const LAS unsigned char* M, int row, int s, int fq) { const LAS unsigned char* p = M + row * 144 + 64 * s + 8 * fq; return mk8(*(const LAS u32x2*)p, *(const LAS u32x2*)(p + 32)); }
__device__ __forceinline__ void gdn_chain_item(const Params& P, int l, LAS unsigned char* lds, int gi, int tid, int wave, int lane) {
    const int q2 = wave >> 2, bh = gi * 2 + q2, eb = wave & 3, b = bh >> 2, h = bh & 3, fr = lane & 15, fq = lane >> 4;
    const bf16_t* z = (const bf16_t*)(P.ws + WS_R); bf16_t* y = (bf16_t*)(P.ws + WS_R + R_Y);
    LAS unsigned char* L = lds + q2 * GC_BH;
    const int tt = tid & 255, ec = tt >> 2, eq = tt & 3;
    float ng[16];
#pragma unroll
    for (int j = 0; j < 16; ++j) ng[j] = P.gdn_norm[l * 64 + eq * 16 + j];
    u32x4 stg[10];
    const bf16_t* src0[2] = { gdn_buf(P, ((gi * 2 >> 2) * NCHUNK) * 4 + ((gi * 2) & 3), 0), gdn_buf(P, (((gi * 2 + 1) >> 2) * NCHUNK) * 4 + ((gi * 2 + 1) & 3), 0) };
#define GC_LOAD(n_) do { _Pragma("unroll") for (int i = 0; i < 10; ++i) { const int p = tid + 512 * i, qq = p / 2560, pp = p % 2560; \
        stg[i] = *(const u32x4*)(src0[qq] + (size_t)(n_) * 4 * 5 * 4096 + (size_t)pp * 8); } } while (0)
#define GC_WRITE() do { _Pragma("unroll") for (int i = 0; i < 10; ++i) { const int p = tid + 512 * i, qq = p / 2560, pp = p % 2560, mat = pp >> 9, row = (pp & 511) >> 3, pc = pp & 7; \
        *(LAS u32x4*)(lds + qq * GC_BH + mat * 9216 + row * 144 + pc * 16) = stg[i]; } } while (0)
    GC_LOAD(0); GC_WRITE();
    f32x4 S[4];
#pragma unroll
    for (int t = 0; t < 4; ++t) S[t] = (f32x4){0.f, 0.f, 0.f, 0.f};
    __syncthreads();
    for (int n = 0; n < NCHUNK; ++n) {
        const int chh = (b * NCHUNK + n) * 4 + h;
        if (n + 1 < NCHUNK) GC_LOAD(n + 1);
        const size_t etok = (size_t)(gi * 2 + (tid >> 8) >> 2) * SEQ + n * 64 + ec; const int eh = (gi * 2 + (tid >> 8)) & 3;
        const u32x4 gw0 = *(const u32x4*)(z + etok * ZP + Z_GG + eh * 64 + eq * 16), gw1 = *(const u32x4*)(z + etok * ZP + Z_GG + eh * 64 + eq * 16 + 8);
        const float egl = ((const float*)(P.ws + WS_GL))[chh];
        const bf16x8 sb0 = pack8(S[0], S[1]), sb1 = pack8(S[2], S[3]);
        f32x4 vn[4], o[4];
#pragma unroll
        for (int ct = 0; ct < 4; ++ct) {
            f32x4 a = {0.f, 0.f, 0.f, 0.f}; a = mfma16(lds_perm(L + GC_W, ct * 16 + fr, 0, fq), sb0, a); a = mfma16(lds_perm(L + GC_W, ct * 16 + fr, 1, fq), sb1, a);
            const u32x2 uw = *(const LAS u32x2*)(L + GC_UT + (eb * 16 + fr) * 144 + (ct * 16 + 4 * fq) * 2);
            vn[ct] = (f32x4){bflo(uw.x) - a.x, bfhi(uw.x) - a.y, bflo(uw.y) - a.z, bfhi(uw.y) - a.w};
            f32x4 oo = {0.f, 0.f, 0.f, 0.f}; oo = mfma16(lds_perm(L + GC_QD, ct * 16 + fr, 0, fq), sb0, oo); oo = mfma16(lds_perm(L + GC_QD, ct * 16 + fr, 1, fq), sb1, oo); o[ct] = oo;
        }
        const bf16x8 vb0 = pack8(vn[0], vn[1]), vb1 = pack8(vn[2], vn[3]);
#pragma unroll
        for (int ct = 0; ct < 4; ++ct) { o[ct] = mfma16(lds_perm(L + GC_ATT, ct * 16 + fr, 0, fq), vb0, o[ct]); o[ct] = mfma16(lds_perm(L + GC_ATT, ct * 16 + fr, 1, fq), vb1, o[ct]); }
#pragma unroll
        for (int dt = 0; dt < 4; ++dt) { f32x4 a = S[dt] * egl; a = mfma16(lds_perm(L + GC_KDT, dt * 16 + fr, 0, fq), vb0, a); a = mfma16(lds_perm(L + GC_KDT, dt * 16 + fr, 1, fq), vb1, a); S[dt] = a; }
        LAS float* Ol = (LAS float*)(L + GC_O);
#pragma unroll
        for (int ct = 0; ct < 4; ++ct)
#pragma unroll
            for (int r = 0; r < 4; ++r) Ol[(ct * 16 + 4 * fq + r) * 65 + eb * 16 + fr] = o[ct][r];
        __syncthreads();
        if (n + 1 < NCHUNK) GC_WRITE();
        {
            const LAS float* orow = (const LAS float*)(lds + (tid >> 8) * GC_BH + GC_O) + ec * 65 + eq * 16;
            float ov[16]; float s2 = 0.f;
#pragma unroll
            for (int j = 0; j < 16; ++j) { ov[j] = orow[j]; s2 += ov[j] * ov[j]; }
            s2 += __shfl_xor(s2, 1); s2 += __shfl_xor(s2, 2);
            const float rs = frsq_(s2 * (1.0f / 64.0f) + EPS);
            const unsigned gws[8] = {gw0.x, gw0.y, gw0.z, gw0.w, gw1.x, gw1.y, gw1.z, gw1.w};
            unsigned ow[8];
#pragma unroll
            for (int j = 0; j < 8; ++j) ow[j] = pk2(ov[2 * j] * rs * ng[2 * j] * siluf_(bflo(gws[j])), ov[2 * j + 1] * rs * ng[2 * j + 1] * siluf_(bfhi(gws[j])));
            bf16_t* yp = y + etok * DM + 768 + eh * 64 + eq * 16;
            *(u32x4*)yp = (u32x4){ow[0], ow[1], ow[2], ow[3]}; *(u32x4*)(yp + 8) = (u32x4){ow[4], ow[5], ow[6], ow[7]};
        }
        __syncthreads();
    }
#undef GC_LOAD
#undef GC_WRITE
}

constexpr int RT_BUF = 36864, RT_Q = 0, RT_K = 9216, RT_KZT = 18432, RT_VT = 27648, RT_P = 73728, RT_ST = 82944, RT_O = 92160;
__device__ __forceinline__ void ret_chain_item(const Params& P, int l, LAS unsigned char* lds, int it, int tid, int wave, int lane) {
    const int b = it >> 2, h = it & 3, fr = lane & 15, fq = lane >> 4;
    const bf16_t* z = (const bf16_t*)(P.ws + WS_R); bf16_t* y = (bf16_t*)(P.ws + WS_R + R_Y);
    LAS bf16_t* Pm = (LAS bf16_t*)(lds + RT_P); LAS bf16_t* ST = (LAS bf16_t*)(lds + RT_ST); LAS float* Of = (LAS float*)(lds + RT_O);
    const float lg = log1pf(-exp2f(-5.0f - (float)h));
    const float cdec = fexp_(64.0f * lg);
    for (int i = tid; i < 64 * 72 / 2; i += 512) ((LAS unsigned*)ST)[i] = 0u;
    const int it4 = wave >> 1, jt0 = 2 * (wave & 1);
    f32x4 S[2] = {{0.f, 0.f, 0.f, 0.f}, {0.f, 0.f, 0.f, 0.f}};
    const int lc = tid >> 3, pg = tid & 7;
    float invf[4];
#pragma unroll
    for (int ii = 0; ii < 4; ++ii) invf[ii] = exp2f(-(float)(4 * pg + ii) * (13.287712379549449f / 32.0f));
    const float zeta = fexp_((63.0f - (float)lc) * lg);
    const f32x4 gn0 = *(const f32x4*)(P.ret_gn + l * 256 + h * 64 + 8 * pg), gn1 = *(const f32x4*)(P.ret_gn + l * 256 + h * 64 + 8 * pg + 4);
    const size_t tok0 = (size_t)b * SEQ + lc;
    u32x2 q1w, q2w, k1w, k2w; u32x4 vw; int posi;
#define RT_LOAD(n_) do { const bf16_t* zr_ = z + (tok0 + (n_) * 64) * ZP; q1w = *(const u32x2*)(zr_ + Z_RQ + h * 64 + 4 * pg); q2w = *(const u32x2*)(zr_ + Z_RQ + h * 64 + 32 + 4 * pg); \
        k1w = *(const u32x2*)(zr_ + Z_RK + h * 64 + 4 * pg); k2w = *(const u32x2*)(zr_ + Z_RK + h * 64 + 32 + 4 * pg); vw = *(const u32x4*)(zr_ + Z_RV + h * 64 + 8 * pg); posi = P.pos[tok0 + (n_) * 64]; } while (0)
#define RT_STAGE(buf_) do { LAS bf16_t* Qs_ = (LAS bf16_t*)(lds + (buf_) * RT_BUF + RT_Q); LAS bf16_t* Ks_ = (LAS bf16_t*)(lds + (buf_) * RT_BUF + RT_K); \
        LAS bf16_t* KzT_ = (LAS bf16_t*)(lds + (buf_) * RT_BUF + RT_KZT); LAS bf16_t* VT_ = (LAS bf16_t*)(lds + (buf_) * RT_BUF + RT_VT); const float pos = (float)posi; \
        const float q1[4] = {bflo(q1w.x), bfhi(q1w.x), bflo(q1w.y), bfhi(q1w.y)}, q2[4] = {bflo(q2w.x), bfhi(q2w.x), bflo(q2w.y), bfhi(q2w.y)}; \
        const float k1[4] = {bflo(k1w.x), bfhi(k1w.x), bflo(k1w.y), bfhi(k1w.y)}, k2[4] = {bflo(k2w.x), bfhi(k2w.x), bflo(k2w.y), bfhi(k2w.y)}; \
        float qa[4], qb[4], ka[4], kb[4]; \
        _Pragma("unroll") for (int ii = 0; ii < 4; ++ii) { float sn, cs; sincos_rev(pos * invf[ii], sn, cs); \
            qa[ii] = (q1[ii] * cs - q2[ii] * sn) * 0.125f; qb[ii] = (q1[ii] * sn + q2[ii] * cs) * 0.125f; ka[ii] = k1[ii] * cs - k2[ii] * sn; kb[ii] = k1[ii] * sn + k2[ii] * cs; } \
        u32x2 w_; w_.x = pk2(qa[0], qa[1]); w_.y = pk2(qa[2], qa[3]); *(LAS u32x2*)(Qs_ + lc * 72 + 4 * pg) = w_; \
        w_.x = pk2(qb[0], qb[1]); w_.y = pk2(qb[2], qb[3]); *(LAS u32x2*)(Qs_ + lc * 72 + 32 + 4 * pg) = w_; \
        w_.x = pk2(ka[0], ka[1]); w_.y = pk2(ka[2], ka[3]); *(LAS u32x2*)(Ks_ + lc * 72 + 4 * pg) = w_; \
        w_.x = pk2(kb[0], kb[1]); w_.y = pk2(kb[2], kb[3]); *(LAS u32x2*)(Ks_ + lc * 72 + 32 + 4 * pg) = w_; \
        _Pragma("unroll") for (int ii = 0; ii < 4; ++ii) { KzT_[(4 * pg + ii) * 72 + lc] = f2bf(ka[ii] * zeta); KzT_[(32 + 4 * pg + ii) * 72 + lc] = f2bf(kb[ii] * zeta); } \
        const unsigned vv[4] = {vw.x, vw.y, vw.z, vw.w}; \
        _Pragma("unroll") for (int ii = 0; ii < 4; ++ii) { VT_[(8 * pg + 2 * ii) * 72 + lc] = (bf16_t)(vv[ii] & 0xffffu); VT_[(8 * pg + 2 * ii + 1) * 72 + lc] = (bf16_t)(vv[ii] >> 16); } } while (0)
    RT_LOAD(0); RT_STAGE(0);
    __syncthreads();
    for (int n = 0; n < NCHUNK; ++n) {
        const int cb = n & 1;
        const LAS bf16_t* Qs = (const LAS bf16_t*)(lds + cb * RT_BUF + RT_Q); const LAS bf16_t* Ks = (const LAS bf16_t*)(lds + cb * RT_BUF + RT_K);
        const LAS bf16_t* KzT = (const LAS bf16_t*)(lds + cb * RT_BUF + RT_KZT); const LAS bf16_t* VT = (const LAS bf16_t*)(lds + cb * RT_BUF + RT_VT);
        const size_t tok = tok0 + n * 64;
        if (n + 1 < NCHUNK) RT_LOAD(n + 1);
        const u32x4 gw = *(const u32x4*)(z + tok * ZP + Z_RG + h * 64 + 8 * pg);
        const bf16x8 a0 = *(const LAS bf16x8*)(Qs + (it4 * 16 + fr) * 72 + 8 * fq), a1 = *(const LAS bf16x8*)(Qs + (it4 * 16 + fr) * 72 + 32 + 8 * fq);
        f32x4 cross[2];
#pragma unroll
        for (int t = 0; t < 2; ++t) { const int jt = jt0 + t;
            f32x4 p = {0.f, 0.f, 0.f, 0.f};
            p = mfma16(a0, *(const LAS bf16x8*)(Ks + (jt * 16 + fr) * 72 + 8 * fq), p); p = mfma16(a1, *(const LAS bf16x8*)(Ks + (jt * 16 + fr) * 72 + 32 + 8 * fq), p);
            f32x4 cr = {0.f, 0.f, 0.f, 0.f};
            cr = mfma16(a0, *(const LAS bf16x8*)(ST + (jt * 16 + fr) * 72 + 8 * fq), cr); cr = mfma16(a1, *(const LAS bf16x8*)(ST + (jt * 16 + fr) * 72 + 32 + 8 * fq), cr);
#pragma unroll
            for (int r = 0; r < 4; ++r) { const int i = it4 * 16 + 4 * fq + r, j = jt * 16 + fr; const int dd = i > j ? i - j : j - i;
                Pm[i * 72 + j] = f2bf(p[r] * fexp_((float)dd * lg)); cr[r] *= fexp_((float)(i + 1) * lg); }
            cross[t] = cr; }
        __syncthreads();
        const bf16x8 p0 = *(const LAS bf16x8*)(Pm + (it4 * 16 + fr) * 72 + 8 * fq), p1 = *(const LAS bf16x8*)(Pm + (it4 * 16 + fr) * 72 + 32 + 8 * fq);
        const bf16x8 kz0 = *(const LAS bf16x8*)(KzT + (it4 * 16 + fr) * 72 + 8 * fq), kz1 = *(const LAS bf16x8*)(KzT + (it4 * 16 + fr) * 72 + 32 + 8 * fq);
#pragma unroll
        for (int t = 0; t < 2; ++t) { const int et = jt0 + t;
            const bf16x8 v0 = *(const LAS bf16x8*)(VT + (et * 16 + fr) * 72 + 8 * fq), v1 = *(const LAS bf16x8*)(VT + (et * 16 + fr) * 72 + 32 + 8 * fq);
            f32x4 o = cross[t]; o = mfma16(p0, v0, o); o = mfma16(p1, v1, o);
#pragma unroll
            for (int r = 0; r < 4; ++r) Of[(it4 * 16 + 4 * fq + r) * 65 + et * 16 + fr] = o[r];
            f32x4 sN = S[t] * cdec; sN = mfma16(kz0, v0, sN); sN = mfma16(kz1, v1, sN); S[t] = sN;
            u32x2 w; w.x = pk2(sN.x, sN.y); w.y = pk2(sN.z, sN.w); *(LAS u32x2*)(ST + (et * 16 + fr) * 72 + it4 * 16 + 4 * fq) = w; }
        if (n + 1 < NCHUNK) RT_STAGE(cb ^ 1);
        __syncthreads();
        {
            float ov[8]; float sm = 0.f;
#pragma unroll
            for (int j = 0; j < 8; ++j) { ov[j] = Of[lc * 65 + 8 * pg + j]; sm += ov[j]; }
            sm += __shfl_xor(sm, 1); sm += __shfl_xor(sm, 2); sm += __shfl_xor(sm, 4);
            const float mu = sm * (1.0f / 64.0f); float vs = 0.f;
#pragma unroll
            for (int j = 0; j < 8; ++j) { ov[j] -= mu; vs += ov[j] * ov[j]; }
            vs += __shfl_xor(vs, 1); vs += __shfl_xor(vs, 2); vs += __shfl_xor(vs, 4);
            const float rs = frsq_(vs * (1.0f / 64.0f) + EPS);
            const float gt[8] = {bflo(gw.x), bfhi(gw.x), bflo(gw.y), bfhi(gw.y), bflo(gw.z), bfhi(gw.z), bflo(gw.w), bfhi(gw.w)};
            const float gnv[8] = {gn0.x, gn0.y, gn0.z, gn0.w, gn1.x, gn1.y, gn1.z, gn1.w};
            float r8[8];
#pragma unroll
            for (int j = 0; j < 8; ++j) r8[j] = ov[j] * rs * gnv[j] * siluf_(gt[j]);
            u32x4 w; w.x = pk2(r8[0], r8[1]); w.y = pk2(r8[2], r8[3]); w.z = pk2(r8[4], r8[5]); w.w = pk2(r8[6], r8[7]);
            *(u32x4*)(y + tok * DM + h * 64 + 8 * pg) = w;
        }
    }
#undef RT_LOAD
#undef RT_STAGE
    __syncthreads();
}

constexpr int LR_XC = 0, LR_AU = 33792;
__device__ __forceinline__ void lru_item(const Params& P, int l, LAS unsigned char* lds, int it, int mode, int tid, int wave, int lane) {
    const int b = it >> 5, n = it & 31, fr = lane & 15, fq = lane >> 4;
    const bf16_t* z = (const bf16_t*)(P.ws + WS_R); bf16_t* y = (bf16_t*)(P.ws + WS_R + R_Y);
    LAS bf16_t* XC = (LAS bf16_t*)(lds + LR_XC); LAS f32x2* AU = (LAS f32x2*)(lds + LR_AU);
    float* sumA = (float*)(P.ws + WS_LRUS); float* sumH = sumA + 16 * 32 * 256;
    {
        const int c = tid >> 3, cg = tid & 7, s = n * 64 + c; const size_t tok = (size_t)b * SEQ + s;
        const float* cw = P.lru_conv_w + (size_t)l * 4 * 256; const float* cb = P.lru_conv_b + l * 256;
#pragma unroll
        for (int g = 0; g < 4; ++g) { const int ch0 = cg * 32 + g * 8;
            const f32x4 b0 = *(const f32x4*)(cb + ch0), b1 = *(const f32x4*)(cb + ch0 + 4);
            float a[8] = {b0.x, b0.y, b0.z, b0.w, b1.x, b1.y, b1.z, b1.w};
#pragma unroll
            for (int kk = 0; kk < 4; ++kk) { const bool okk = s - 3 + kk >= 0; const float mk = okk ? 1.f : 0.f;
                const u32x4 w = *(const u32x4*)(z + (okk ? tok - 3 + kk : tok) * ZP + Z_LX + ch0);
                const f32x4 c0 = *(const f32x4*)(cw + kk * 256 + ch0) * mk, c1 = *(const f32x4*)(cw + kk * 256 + ch0 + 4) * mk;
                a[0] += c0.x * bflo(w.x); a[1] += c0.y * bfhi(w.x); a[2] += c0.z * bflo(w.y); a[3] += c0.w * bfhi(w.y);
                a[4] += c1.x * bflo(w.z); a[5] += c1.y * bfhi(w.z); a[6] += c1.z * bflo(w.w); a[7] += c1.w * bfhi(w.w); }
            u32x4 o; o.x = pk2(a[0], a[1]); o.y = pk2(a[2], a[3]); o.z = pk2(a[4], a[5]); o.w = pk2(a[6], a[7]);
            *(LAS u32x4*)(XC + c * 264 + ch0) = o; }
    }
    float hcar = 0.f, aprod = 1.f;
    if (mode == 1 && tid < 256) {
        float av[32], hv[32];
#pragma unroll
        for (int m = 0; m < 32; ++m) { const int mm = m < n ? m : 0; av[m] = sumA[(b * 32 + mm) * 256 + tid]; hv[m] = sumH[(b * 32 + mm) * 256 + tid]; }
#pragma unroll
        for (int m = 0; m < 32; ++m) if (m < n) hcar = av[m] * hcar + hv[m];
    }
    const int nb = wave >> 1, rt = wave & 1;
    const bf16_t* wa = wl(P, l, W_A) + nb * 4096; const bf16_t* wx = wl(P, l, W_X) + nb * 4096;
    bf16x8 fa[4][2], fx[4][2]; float ba[4], bx[4], spl[4];
#pragma unroll
    for (int dt = 0; dt < 4; ++dt) {
#pragma unroll
        for (int s = 0; s < 2; ++s) { fa[dt][s] = *(const bf16x8*)(wa + (dt * 16 + fr) * 64 + 32 * s + 8 * fq); fx[dt][s] = *(const bf16x8*)(wx + (dt * 16 + fr) * 64 + 32 * s + 8 * fq); }
        const int d = nb * 64 + dt * 16 + fr; ba[dt] = P.lru_ba[l * 256 + d]; bx[dt] = P.lru_bx[l * 256 + d]; spl[dt] = -8.0f * softplusf_(-P.lru_lambda[l * 256 + d]); }
    __syncthreads();
    for (int half = 0; half < 2; ++half) {
        const int trow = half * 32 + rt * 16;
        const bf16x8 x0 = *(const LAS bf16x8*)(XC + (trow + fr) * 264 + nb * 64 + 8 * fq), x1 = *(const LAS bf16x8*)(XC + (trow + fr) * 264 + nb * 64 + 32 + 8 * fq);
#pragma unroll
        for (int dt = 0; dt < 4; ++dt) {
            f32x4 ar = {0.f, 0.f, 0.f, 0.f}, ai = {0.f, 0.f, 0.f, 0.f};
            ar = mfma16(x0, fa[dt][0], ar); ar = mfma16(x1, fa[dt][1], ar); ai = mfma16(x0, fx[dt][0], ai); ai = mfma16(x1, fx[dt][1], ai);
            const int d = nb * 64 + dt * 16 + fr;
#pragma unroll
            for (int r = 0; r < 4; ++r) { const int tl = rt * 16 + 4 * fq + r;
                const float xcv = bf2f(XC[(half * 32 + tl) * 264 + d]);
                const float rr = sigmoidf_(ar[r] + ba[dt]), ii = sigmoidf_(ai[r] + bx[dt]);
                const float a = fexp_(rr * spl[dt]);
                const float u = fsqrt_(fmaxf(1.0f - a * a, 0.f)) * (ii * xcv);
                AU[tl * 257 + d] = (f32x2){a, u}; }
        }
        __syncthreads();
        if (tid < 256) {
#pragma unroll 8
            for (int tk = 0; tk < 32; ++tk) { const f32x2 au = AU[tk * 257 + tid]; hcar = au.x * hcar + au.y; aprod *= au.x; if (mode == 1) AU[tk * 257 + tid].y = hcar; }
        }
        if (mode == 1) {
            __syncthreads();
            const int tk = tid >> 4, c0 = (tid & 15) * 16; const size_t tok = (size_t)b * SEQ + n * 64 + half * 32 + tk;
            const u32x4 g0 = *(const u32x4*)(z + tok * ZP + Z_LG + c0), g1 = *(const u32x4*)(z + tok * ZP + Z_LG + c0 + 8);
            const unsigned gws[8] = {g0.x, g0.y, g0.z, g0.w, g1.x, g1.y, g1.z, g1.w}; unsigned ow[8];
#pragma unroll
            for (int j = 0; j < 8; ++j) { const float h0 = AU[tk * 257 + c0 + 2 * j].y, h1 = AU[tk * 257 + c0 + 2 * j + 1].y; ow[j] = pk2(h0 * geluf_(bflo(gws[j])), h1 * geluf_(bfhi(gws[j]))); }
            bf16_t* yp = y + tok * DM + 256 + c0;
            *(u32x4*)yp = (u32x4){ow[0], ow[1], ow[2], ow[3]}; *(u32x4*)(yp + 8) = (u32x4){ow[4], ow[5], ow[6], ow[7]};
        }
        __syncthreads();
    }
    if (mode == 0 && tid < 256) { sumA[(b * 32 + n) * 256 + tid] = aprod; sumH[(b * 32 + n) * 256 + tid] = hcar; }
}

constexpr int LC_XC = 0, LC_AU = 9216;
__device__ __forceinline__ void lru_chain_item(const Params& P, int l, LAS unsigned char* lds, int it, int tid, int wave, int lane) {
    const int b = it >> 2, nb = it & 3, fr = lane & 15, fq = lane >> 4;
    const bf16_t* z = (const bf16_t*)(P.ws + WS_R); bf16_t* y = (bf16_t*)(P.ws + WS_R + R_Y);
    LAS bf16_t* XC = (LAS bf16_t*)(lds + LC_XC); LAS f32x2* AU = (LAS f32x2*)(lds + LC_AU);
    const int c = tid >> 3, cg = tid & 7, ch0 = nb * 64 + cg * 8;
    f32x4 cw0[4], cw1[4];
#pragma unroll
    for (int kk = 0; kk < 4; ++kk) { cw0[kk] = *(const f32x4*)(P.lru_conv_w + (size_t)l * 1024 + kk * 256 + ch0); cw1[kk] = *(const f32x4*)(P.lru_conv_w + (size_t)l * 1024 + kk * 256 + ch0 + 4); }
    const f32x4 cb0 = *(const f32x4*)(P.lru_conv_b + l * 256 + ch0), cb1 = *(const f32x4*)(P.lru_conv_b + l * 256 + ch0 + 4);
    const int rt = wave >> 1, dt0 = (wave & 1) * 2;
    const bf16_t* wa = wl(P, l, W_A) + nb * 4096; const bf16_t* wx = wl(P, l, W_X) + nb * 4096;
    bf16x8 fa[2][2], fx[2][2]; float ba[2], bx[2], spl[2];
#pragma unroll
    for (int t = 0; t < 2; ++t) {
#pragma unroll
        for (int s = 0; s < 2; ++s) { fa[t][s] = *(const bf16x8*)(wa + ((dt0 + t) * 16 + fr) * 64 + 32 * s + 8 * fq); fx[t][s] = *(const bf16x8*)(wx + ((dt0 + t) * 16 + fr) * 64 + 32 * s + 8 * fq); }
        const int d = nb * 64 + (dt0 + t) * 16 + fr; ba[t] = P.lru_ba[l * 256 + d]; bx[t] = P.lru_bx[l * 256 + d]; spl[t] = -8.0f * softplusf_(-P.lru_lambda[l * 256 + d]); }
    const size_t tok0 = (size_t)b * SEQ + c;
    u32x4 xr[4], gr;
#define LC_LOAD(n_) do { const size_t t_ = tok0 + (size_t)(n_) * 64; _Pragma("unroll") for (int kk = 0; kk < 4; ++kk) { const bool ok_ = (n_) * 64 + c - 3 + kk >= 0; \
        xr[kk] = *(const u32x4*)(z + (ok_ ? t_ - 3 + kk : t_) * ZP + Z_LX + ch0); } gr = *(const u32x4*)(z + t_ * ZP + Z_LG + ch0); } while (0)
    LC_LOAD(0);
    float hcar = 0.f;
    for (int n = 0; n < NCHUNK; ++n) {
        {
            float a[8] = {cb0.x, cb0.y, cb0.z, cb0.w, cb1.x, cb1.y, cb1.z, cb1.w};
#pragma unroll
            for (int kk = 0; kk < 4; ++kk) { const float mk = (n * 64 + c - 3 + kk >= 0) ? 1.f : 0.f; const f32x4 c0 = cw0[kk] * mk, c1 = cw1[kk] * mk; const u32x4 w = xr[kk];
                a[0] += c0.x * bflo(w.x); a[1] += c0.y * bfhi(w.x); a[2] += c0.z * bflo(w.y); a[3] += c0.w * bfhi(w.y);
                a[4] += c1.x * bflo(w.z); a[5] += c1.y * bfhi(w.z); a[6] += c1.z * bflo(w.w); a[7] += c1.w * bfhi(w.w); }
            u32x4 o; o.x = pk2(a[0], a[1]); o.y = pk2(a[2], a[3]); o.z = pk2(a[4], a[5]); o.w = pk2(a[6], a[7]);
            *(LAS u32x4*)(XC + c * 72 + cg * 8) = o;
        }
        const u32x4 gcur = gr;
        if (n + 1 < NCHUNK) LC_LOAD(n + 1);
        __syncthreads();
        {
            const bf16x8 x0 = *(const LAS bf16x8*)(XC + (rt * 16 + fr) * 72 + 8 * fq), x1 = *(const LAS bf16x8*)(XC + (rt * 16 + fr) * 72 + 32 + 8 * fq);
#pragma unroll
            for (int t = 0; t < 2; ++t) {
                f32x4 ar = {0.f, 0.f, 0.f, 0.f}, ai = {0.f, 0.f, 0.f, 0.f};
                ar = mfma16(x0, fa[t][0], ar); ar = mfma16(x1, fa[t][1], ar); ai = mfma16(x0, fx[t][0], ai); ai = mfma16(x1, fx[t][1], ai);
                const int dl = (dt0 + t) * 16 + fr;
#pragma unroll
                for (int r = 0; r < 4; ++r) { const int tl = rt * 16 + 4 * fq + r;
                    const float xcv = bf2f(XC[tl * 72 + dl]);
                    const float rr = sigmoidf_(ar[r] + ba[t]), ii = sigmoidf_(ai[r] + bx[t]);
                    const float av = fexp_(rr * spl[t]);
                    AU[tl * 65 + dl] = (f32x2){av, fsqrt_(fmaxf(1.0f - av * av, 0.f)) * (ii * xcv)}; }
            }
        }
        __syncthreads();
        if (tid < 64) {
#pragma unroll
            for (int blk = 0; blk < 4; ++blk) { f32x2 au[16];
#pragma unroll
                for (int k = 0; k < 16; ++k) au[k] = AU[(blk * 16 + k) * 65 + tid];
#pragma unroll
                for (int k = 0; k < 16; ++k) { hcar = au[k].x * hcar + au[k].y; au[k].y = hcar; }
#pragma unroll
                for (int k = 0; k < 16; ++k) AU[(blk * 16 + k) * 65 + tid].y = au[k].y; }
        }
        __syncthreads();
        {
            const unsigned gws[4] = {gcur.x, gcur.y, gcur.z, gcur.w}; unsigned ow[4];
#pragma unroll
            for (int j = 0; j < 4; ++j) ow[j] = pk2(AU[c * 65 + cg * 8 + 2 * j].y * geluf_(bflo(gws[j])), AU[c * 65 + cg * 8 + 2 * j + 1].y * geluf_(bfhi(gws[j])));
            *(u32x4*)(y + (tok0 + (size_t)n * 64) * DM + 256 + ch0) = (u32x4){ow[0], ow[1], ow[2], ow[3]};
        }
    }
#undef LC_LOAD
    __syncthreads();
}

constexpr int N_PHASES = 21;
constexpr int Q_RET = 64, Q_GDN = 32, Q_LRU = 64, Q_MLA = 512, Q_TOTAL = Q_RET + Q_GDN + Q_LRU + Q_MLA;

__global__ void __launch_bounds__(512, 2) hymba_fwd(Params P_) {
    extern __shared__ __attribute__((aligned(16))) unsigned char lds_raw[];
    LAS unsigned char* lds = (LAS unsigned char*)lds_raw;
    volatile LAS unsigned* LC = (volatile LAS unsigned*)(lds + LDS_CTL);
    const int G = gridDim.x;
#define SUB_TID() int tid2 = tid; asm volatile("" : "+v"(tid2)); const int lane2 = tid2 & 63, wave2 = __builtin_amdgcn_readfirstlane(tid2 >> 6); (void)lane2; (void)wave2
#if defined(__HIP_DEVICE_COMPILE__)
#define PH_PARAMS() const __attribute__((address_space(4))) Params* pp_ = (const __attribute__((address_space(4))) Params*)__builtin_amdgcn_kernarg_segment_ptr(); asm volatile("" : "+s"(pp_)); const Params P = *pp_
#else
#define PH_PARAMS() const Params P = P_
#endif
#define PH_TID() PH_PARAMS(); \
    bf16_t* xb = (bf16_t*)(P.ws + WS_XB); float* part = (float*)(P.ws + WS_PART); bf16_t* zb = (bf16_t*)(P.ws + WS_R); bf16_t* yb = (bf16_t*)(P.ws + WS_R + R_Y); bf16_t* oxb = (bf16_t*)(P.ws + WS_R + R_OX); (void)xb; (void)part; (void)zb; (void)yb; (void)oxb; \
    int tid = threadIdx.x; asm volatile("" : "+v"(tid)); const int lane = tid & 63, wave = __builtin_amdgcn_readfirstlane(tid >> 6); (void)lane; (void)wave
    unsigned* ctl = (unsigned*)(P_.ws + WS_CTL);
    if (threadIdx.x < 64) LC[threadIdx.x] = 0u;
    __syncthreads();
    const int lo = P_.ph_lo, hi = P_.ph_hi;
    XcdBarrier bar; bar.bar = ctl + CW_BAR; bar.x = 0; bar.st = LC;
    if (hi - lo > 1) bar = xcd_barrier_post(ctl + CW_BAR, LC);
#ifndef PHASE_MASK
#define PHASE_MASK 0xFFFFFFFFu
#endif
#define EN(t) ((PHASE_MASK >> (t)) & 1u)
#ifndef REPEAT_MASK
#define REPEAT_MASK 0u
#endif
#define REP(t) for (int rep_ = 0; rep_ <= (int)((REPEAT_MASK >> (t)) & 1u); ++rep_, (rep_ <= (int)((REPEAT_MASK >> (t)) & 1u) ? xcd_barrier(bar) : (void)0))
#define IN(k) (lo <= (k) && (k) < hi)
#define SEAM(k) do { if (IN(k) && IN((k) + 1)) xcd_barrier(bar); } while (0)


    if (IN(0) && EN(0)) REP(0) { PH_TID(); p0_prologue(P, lds, tid); __syncthreads(); }
    SEAM(0);
    if (IN(1) && EN(1)) REP(1) {
        PH_TID();
        const int which = blockIdx.x >> 6, l = which >> 1, isv = which & 1;
        if (which < 4) {
            const bf16_t* memn = (const bf16_t*)(P.ws + WS_GDN); const bf16_t* wkv = wl(P, l, W_KV);
            bf16_t* kout = (bf16_t*)(P.ws + WS_KVM + (size_t)l * KVM_LAYER); bf16_t* vout = kout + (size_t)4096 * 1024;
            pg8::Gemm g; pg8::EpiScaleBf16<0> E; pg8::StaticOrder S;
            if (!isv) { g = pg8::Gemm{memn, wkv, 4096, 1024, 1024}; E = pg8::EpiScaleBf16<0>{kout, 1024, nullptr}; S.init(4096, 1024, 64, blockIdx.x & 63); }
            else { g = pg8::Gemm{wkv + (size_t)1024 * 1024, memn, 1024, 4096, 1024}; E = pg8::EpiScaleBf16<0>{vout, 4096, nullptr}; S.init(1024, 4096, 64, blockIdx.x & 63); }
            pg8::gemm_phase(lds, g, S, E, tid);
        }
    }
    SEAM(1);
#pragma unroll
    for (int l = 0; l < 2; ++l) {
        const int pb = 2 + 9 * l;
        if (IN(pb + 0) && EN(2)) REP(2) { PH_TID();
            pg8::Gemm g{xb, wl(P, l, W_IN), T_TOK, ZP, DM}; pg8::StaticOrder S; S.init(T_TOK, ZP, G, blockIdx.x);
            pg8::EpiScaleBf16<0> E{zb, ZP, part}; pg8::gemm_phase(lds, g, S, E, tid);
        }
        SEAM(pb + 0);
        if (IN(pb + 1)) {
            PH_TID();
            if (EN(3)) REP(3) { SUB_TID();
_Pragma("unroll 1")
            for (int it = blockIdx.x; it < 1024; it += G) gdn_pre_item(P, l, lds, it, tid2); }
            if (EN(5)) REP(5) { SUB_TID();
_Pragma("unroll 1")
            for (int it = blockIdx.x; it < 256; it += G) mla_pre_item(P, l, lds, it, tid2, wave2, lane2); }
        }
        SEAM(pb + 1);
        if (IN(pb + 2)) {
            PH_TID();
            for (int rep2_ = 0; rep2_ <= (int)((REPEAT_MASK >> 17) & 1u); ++rep2_, (rep2_ <= (int)((REPEAT_MASK >> 17) & 1u) ? xcd_barrier(bar) : (void)0)) {
            unsigned* qh0 = ctl + CW_QUEUE + 64 * l + 16 * rep2_;
#define QUEUE_LOOP(qi_, count_, body_) for (;;) { if (tid == 0) LC[4] = __hip_atomic_fetch_add(qh + (qi_), 1u, __ATOMIC_RELAXED, __HIP_MEMORY_SCOPE_AGENT); \
                __syncthreads(); const int it = (int)LC[4]; __syncthreads(); if (it >= (count_)) break; { SUB_TID(); body_; } __syncthreads(); }
            if (EN(6)) REP(6) { unsigned* qh = qh0 + 32 * rep_; QUEUE_LOOP(0, Q_RET, ret_chain_item(P, l, lds, it, tid2, wave2, lane2)) }
            if (EN(7)) REP(7) { unsigned* qh = qh0 + 32 * rep_; QUEUE_LOOP(1, Q_GDN, gdn_chain_item(P, l, lds, it, tid2, wave2, lane2)) }
            if (EN(8)) REP(8) { unsigned* qh = qh0 + 32 * rep_; QUEUE_LOOP(2, Q_LRU, lru_chain_item(P, l, lds, it, tid2, wave2, lane2)) }
            if (EN(9)) REP(9) { unsigned* qh = qh0 + 32 * rep_; QUEUE_LOOP(3, Q_MLA, mla_attn_item(P, lds, it, tid2, wave2, lane2)) }
#undef QUEUE_LOOP
            }
        }
        SEAM(pb + 2);
        if (IN(pb + 3) && EN(10)) REP(10) { PH_TID();
            pg8::Gemm g{yb, wl(P, l, W_OUT), T_TOK, DM, DM}; pg8::StaticOrder S; S.init(T_TOK, DM, G, blockIdx.x);
            pg8::EpiResid E{P.out, xb, part, rep_ ? 0.f : 1.f}; pg8::gemm_phase(lds, g, S, E, tid);
        }
        SEAM(pb + 3);
        if (IN(pb + 4) && EN(11)) REP(11) { PH_TID();
            pg8::Gemm g{xb, wl(P, l, W_Q), T_TOK, DM, DM}; pg8::StaticOrder S; S.init(T_TOK, DM, G, blockIdx.x);
            pg8::EpiScaleBf16<0> E{zb, DM, part}; pg8::gemm_phase(lds, g, S, E, tid);
        }
        SEAM(pb + 4);
        if (IN(pb + 5) && EN(12)) REP(12) { PH_TID();
_Pragma("unroll 1")
            for (int it = blockIdx.x; it < 512; it += G) { SUB_TID(); xa_item(P, l, lds, it, tid2, wave2, lane2); __syncthreads(); } }
        SEAM(pb + 5);
        if (IN(pb + 6) && EN(13)) REP(13) { PH_TID();
            pg8::Gemm g{oxb, wl(P, l, W_O), T_TOK, DM, DM}; pg8::StaticOrder S; S.init(T_TOK, DM, G, blockIdx.x);
            pg8::EpiResid E{P.out, xb, part, rep_ ? 0.f : 1.f}; pg8::gemm_phase(lds, g, S, E, tid);
        }
        SEAM(pb + 6);
        if (IN(pb + 7) && EN(14)) REP(14) { PH_TID();
            pg8::Gemm g{xb, wl(P, l, W_1), T_TOK, DFF, DM}; pg8::StaticOrder S; S.init(T_TOK, DFF, G, blockIdx.x);
            pg8::EpiScaleBf16<1> E{zb, DFF, part}; pg8::gemm_phase(lds, g, S, E, tid);
        }
        SEAM(pb + 7);
        if (IN(pb + 8) && EN(15)) REP(15) { PH_TID();
            pg8::Gemm g{zb, wl(P, l, W_2), T_TOK, DM, DFF}; pg8::StaticOrder S; S.init(T_TOK, DM, G, blockIdx.x);
            pg8::EpiResid E{P.out, xb, part, rep_ ? 0.f : 1.f}; pg8::gemm_phase(lds, g, S, E, tid);
        }
        SEAM(pb + 8);
    }
    if (IN(20) && EN(16)) { PH_TID(); final_norm_phase(P, tid); }
#undef IN
#undef SEAM
}

extern "C" void kernel_launch(void* const* d_in, const int* in_sizes, int n_in, void* d_out, int out_size, void* d_ws, size_t ws_size, hipStream_t stream) {
    static int grid = 0;
    if (grid == 0) {
        if (n_in != 31 || out_size != T_TOK * DM || ws_size < WS_END) { fprintf(stderr, "kernel_launch: unexpected shapes (n_in %d out %d ws %zu, need %zu)\n", n_in, out_size, ws_size, (size_t)WS_END); grid = -1; return; }
        if (hipFuncSetAttribute((const void*)hymba_fwd, hipFuncAttributeMaxDynamicSharedMemorySize, LDS_BYTES) != hipSuccess) { fprintf(stderr, "kernel_launch: hipFuncSetAttribute failed\n"); grid = -1; return; }
        int dev = 0, cus = 0, per_cu = 0;
        (void)hipGetDevice(&dev); (void)hipDeviceGetAttribute(&cus, hipDeviceAttributeMultiprocessorCount, dev);
        (void)hipOccupancyMaxActiveBlocksPerMultiprocessor(&per_cu, (const void*)hymba_fwd, 512, LDS_BYTES);
        (void)hipGetLastError();
        if (cus != 256 || per_cu < 1) fprintf(stderr, "kernel_launch: note: cus %d per_cu %d\n", cus, per_cu);
        grid = 256;
    }
    if (grid < 0) return;
    (void)hipMemsetAsync((char*)d_ws + WS_CTL, 0, CTL_BYTES, stream);
    Params p{};
    p.x = (const float*)d_in[0]; p.mem = (const float*)d_in[1]; p.pos = (const int*)d_in[2];
    p.norm_mix = (const float*)d_in[3]; p.w_in = (const float*)d_in[4]; p.ret_gn = (const float*)d_in[5];
    p.lru_conv_w = (const float*)d_in[6]; p.lru_conv_b = (const float*)d_in[7]; p.lru_wa = (const float*)d_in[8]; p.lru_ba = (const float*)d_in[9];
    p.lru_wx = (const float*)d_in[10]; p.lru_bx = (const float*)d_in[11]; p.lru_lambda = (const float*)d_in[12];
    p.mla_q_norm = (const float*)d_in[13]; p.mla_w_uq = (const float*)d_in[14]; p.mla_kv_norm = (const float*)d_in[15]; p.mla_w_ukv = (const float*)d_in[16];
    p.gdn_conv_w = (const float*)d_in[17]; p.gdn_a_log = (const float*)d_in[18]; p.gdn_dt_bias = (const float*)d_in[19]; p.gdn_norm = (const float*)d_in[20];
    p.w_out = (const float*)d_in[21]; p.norm_xattn = (const float*)d_in[22]; p.norm_mem = (const float*)d_in[23];
    p.xa_wq = (const float*)d_in[24]; p.xa_wkv = (const float*)d_in[25]; p.xa_wo = (const float*)d_in[26];
    p.norm_mlp = (const float*)d_in[27]; p.mlp_w1 = (const float*)d_in[28]; p.mlp_w2 = (const float*)d_in[29]; p.final_norm = (const float*)d_in[30];
    p.out = (float*)d_out; p.ws = (unsigned char*)d_ws;
#if N_LAUNCHES == 1
    p.ph_lo = 0; p.ph_hi = N_PHASES;
    void* args[] = {&p};
    hipError_t e = hipLaunchCooperativeKernel((const void*)hymba_fwd, dim3(grid), dim3(512), args, LDS_BYTES, stream);
    if (e != hipSuccess) fprintf(stderr, "kernel_launch: cooperative launch failed: %s\n", hipGetErrorString(e));
#else
    for (int ph = 0; ph < N_PHASES; ++ph) { p.ph_lo = ph; p.ph_hi = ph + 1; hipLaunchKernelGGL(hymba_fwd, dim3(grid), dim3(512), LDS_BYTES, stream, p); }
#endif
}
```

```cpp
#include <hip/hip_runtime.h>
#include <cstdio>
#include <cstdint>

#ifndef N_LAUNCHES
#define N_LAUNCHES 1
#endif

#define LAS __attribute__((address_space(3)))
typedef unsigned short bf16_t;
typedef short bf16x8 __attribute__((ext_vector_type(8)));
typedef float f32x4 __attribute__((ext_vector_type(4)));
typedef float f32x2 __attribute__((ext_vector_type(2)));
typedef unsigned u32x4 __attribute__((ext_vector_type(4)));
typedef unsigned u32x2 __attribute__((ext_vector_type(2)));

constexpr int T_TOK = 32768, DM = 1024, SEQ = 2048, NBATCH = 16, NCHUNK = 32, ZP = 3072, DFF = 4096, NMEM = 256;
constexpr int Z_RQ = 0, Z_RK = 256, Z_RV = 512, Z_RG = 768, Z_LX = 1024, Z_LG = 1280, Z_CQ = 1536, Z_CKV = 1728, Z_KR = 1856,
              Z_GQKV = 1888, Z_GG = 2656, Z_GB = 2912, Z_GA = 2916, IN_COLS = 2920;
constexpr float EPS = 1e-6f;
constexpr float LOG2E = 1.4426950408889634f;

constexpr size_t MiB = 1024 * 1024;
constexpr size_t WS_CTL = 0;
constexpr size_t CTL_BYTES = 65536;
constexpr size_t WS_PART = WS_CTL + CTL_BYTES;
constexpr size_t WS_LRUS = WS_PART + (size_t)T_TOK * 16 * 4;
constexpr size_t WS_GL = WS_LRUS + (size_t)2 * 16 * 32 * 256 * 4;
constexpr size_t WS_W = WS_GL + 65536;
constexpr size_t W_IN = 0, W_OUT = W_IN + (size_t)ZP * DM, W_Q = W_OUT + (size_t)DM * DM, W_KV = W_Q + (size_t)DM * DM, W_O = W_KV + (size_t)2 * DM * DM,
                 W_1 = W_O + (size_t)DM * DM, W_2 = W_1 + (size_t)DFF * DM, W_UQ = W_2 + (size_t)DFF * DM, W_UKV = W_UQ + 384 * 192, W_A = W_UKV + 512 * 128,
                 W_X = W_A + 4 * 64 * 64, W_LAYER = W_X + 4 * 64 * 64;
constexpr size_t WS_XB = WS_W + 2 * W_LAYER * 2;
constexpr size_t XB_BYTES = (size_t)T_TOK * DM * 2;
constexpr size_t MLA_Q_OFF = 0, MLA_K_OFF = (size_t)T_TOK * 4 * 96 * 2, MLA_VT_OFF = 2 * MLA_K_OFF;
constexpr size_t WS_KVM = WS_XB + XB_BYTES;
constexpr size_t KVM_LAYER = (size_t)2 * 4096 * 1024 * 2;
constexpr size_t WS_R = WS_KVM + 2 * KVM_LAYER;
constexpr size_t R_Y = (size_t)T_TOK * ZP * 2;
constexpr size_t R_OX = (size_t)T_TOK * DM * 2;
constexpr size_t WS_GDN = WS_R + 256 * MiB;
constexpr size_t WS_END = WS_GDN + 80 * MiB;
static_assert(WS_END <= 512 * MiB, "workspace map exceeds 512 MiB");
static_assert(WS_XB % 256 == 0 && WS_R % 256 == 0 && WS_GDN % 256 == 0 && WS_W % 256 == 0, "alignment");
constexpr int CW_BAR = 0;
constexpr int CW_QUEUE = 4096;

constexpr int LDS_BYTES = 160 * 1024;
constexpr int LDS_CTL = LDS_BYTES - 256;

typedef __bf16 bf16x2_t __attribute__((ext_vector_type(2)));
__device__ __forceinline__ unsigned pk2(float lo, float hi) { f32x2 t = {lo, hi}; bf16x2_t v = __builtin_convertvector(t, bf16x2_t); return __builtin_bit_cast(unsigned, v); }
__device__ __forceinline__ float bflo(unsigned w) { return __uint_as_float(w << 16); }
__device__ __forceinline__ float bfhi(unsigned w) { return __uint_as_float(w & 0xffff0000u); }
__device__ __forceinline__ float bf2f(bf16_t v) { return __uint_as_float((unsigned)v << 16); }
__device__ __forceinline__ bf16_t f2bf(float f) { return (bf16_t)(pk2(f, 0.f) & 0xffffu); }
__device__ __forceinline__ f32x4 mfma16(bf16x8 a, bf16x8 b, f32x4 c) { return __builtin_amdgcn_mfma_f32_16x16x32_bf16(a, b, c, 0, 0, 0); }
__device__ __forceinline__ float fexp2_(float x) { return __builtin_amdgcn_exp2f(x); }
__device__ __forceinline__ float fexp_(float x) { return __builtin_amdgcn_exp2f(x * LOG2E); }
__device__ __forceinline__ float frcp_(float x) { return __builtin_amdgcn_rcpf(x); }
__device__ __forceinline__ float frsq_(float x) { return __builtin_amdgcn_rsqf(x); }
__device__ __forceinline__ float fsqrt_(float x) { return __builtin_amdgcn_sqrtf(x); }
__device__ __forceinline__ float sigmoidf_(float x) { return frcp_(1.0f + fexp_(-x)); }
__device__ __forceinline__ float siluf_(float x) { return x * frcp_(1.0f + fexp_(-x)); }
__device__ __forceinline__ float softplusf_(float x) { return x > 20.f ? x : log1pf(__expf(x)); }
__device__ __forceinline__ float geluf_(float x) { const float u = 1.5957691216057308f * (x + 0.044715f * x * x * x); return x * frcp_(1.0f + fexp_(-u)); }
__device__ __forceinline__ float wave_sum(float v) {
#pragma unroll
    for (int o = 1; o < 64; o <<= 1) v += __shfl_xor(v, o);
    return v;
}
__device__ __forceinline__ void sincos_rev(float ang, float& s, float& c) {
    float rev = ang * 0.15915494309189535f; rev = rev - floorf(rev);
    s = __builtin_amdgcn_sinf(rev); c = __builtin_amdgcn_cosf(rev);
}
__device__ __forceinline__ bf16x8 mk8(u32x2 lo, u32x2 hi) { u32x4 t; t.x = lo.x; t.y = lo.y; t.z = hi.x; t.w = hi.y; return __builtin_bit_cast(bf16x8, t); }
__device__ __forceinline__ bf16x8 pack8(f32x4 a, f32x4 b) { u32x4 t; t.x = pk2(a.x, a.y); t.y = pk2(a.z, a.w); t.z = pk2(b.x, b.y); t.w = pk2(b.z, b.w); return __builtin_bit_cast(bf16x8, t); }

#define XB_TMO      128
#define XB_XCNT(j)  (256  + 64 * (j))
#define XB_XSUB(j)  (1280 + 64 * (j))
#define XB_XGEN(j)  (2304 + 64 * (j))
#define XB_TOP      3328
#define XB_TOPGEN   3392
#define XCD_BAR_WORDS 3456
#define XB_SPIN_CAP (1u << 22)
__device__ __forceinline__ unsigned xb_ld(unsigned* p)              { return __hip_atomic_load(p, __ATOMIC_RELAXED, __HIP_MEMORY_SCOPE_AGENT); }
__device__ __forceinline__ unsigned xb_add(unsigned* p, unsigned v) { return __hip_atomic_fetch_add(p, v, __ATOMIC_RELAXED, __HIP_MEMORY_SCOPE_AGENT); }
__device__ __forceinline__ unsigned xb_xcc_id() { return (unsigned)__builtin_amdgcn_s_getreg((3 << 11) | 20) & 0xFu; }
#define XB_SPIN(cond, bar) do { unsigned _sp = 0; while (cond) { __builtin_amdgcn_s_sleep(1); \
    if ((++_sp & 255u) == 0u) { if (xb_ld(&(bar)[XB_TMO])) break; if (_sp > XB_SPIN_CAP) { atomicAdd(&(bar)[XB_TMO], 1u); break; } } } } while (0)
struct XcdBarrier { unsigned* bar; unsigned x; volatile LAS unsigned* st; };
__device__ __forceinline__ XcdBarrier xcd_barrier_post(unsigned* bar, volatile LAS unsigned* st) {
    XcdBarrier b; b.bar = bar; b.x = xb_xcc_id(); b.st = st;
    if (threadIdx.x == 0) (void)xb_add(&bar[XB_XCNT(b.x)], 1u);
    return b;
}
__device__ __forceinline__ void xcd_barrier_complete(unsigned* bar, unsigned x, unsigned& nloc, unsigned& nx) {
    const unsigned G = gridDim.x * gridDim.y * gridDim.z;
    unsigned sum, cnt, mine, sp = 0u;
    for (;;) {
        sum = 0u; cnt = 0u; mine = 0u;
#pragma unroll
        for (unsigned j = 0; j < 16; ++j) { const unsigned c = xb_ld(&bar[XB_XCNT(j)]); sum += c; cnt += (c > 0u) ? 1u : 0u; mine = (j == x) ? c : mine; }
        if (sum == G) break;
        __builtin_amdgcn_s_sleep(1);
        if ((++sp & 255u) == 0u) { if (xb_ld(&bar[XB_TMO])) break; if (sp > XB_SPIN_CAP) { atomicAdd(&bar[XB_TMO], 1u); break; } }
    }
    nloc = mine > 0u ? mine : 1u; nx = cnt > 0u ? cnt : 1u;
}
__device__ __forceinline__ void xcd_barrier(const XcdBarrier& b) {
    asm volatile("s_waitcnt vmcnt(0)" ::: "memory");
    __syncthreads();
    if (threadIdx.x == 0) {
        unsigned* bar = b.bar;
        __builtin_amdgcn_s_waitcnt(0);
        unsigned nloc = b.st[0], nx = b.st[1];
        if (nloc == 0u) { xcd_barrier_complete(bar, b.x, nloc, nx); b.st[0] = nloc; b.st[1] = nx; }
        const unsigned old = xb_add(&bar[XB_XSUB(b.x)], 1u);
        const unsigned gen = old / nloc;
        if (old + 1u == (gen + 1u) * nloc) {
            __builtin_amdgcn_fence(__ATOMIC_RELEASE, "agent");
            asm volatile("s_waitcnt vmcnt(0)" ::: "memory");
            const unsigned og = xb_add(&bar[XB_TOP], 1u);
            const unsigned tg = og / nx;
            if (og + 1u == (tg + 1u) * nx) xb_add(&bar[XB_TOPGEN], 1u);
            else XB_SPIN(xb_ld(&bar[XB_TOPGEN]) == tg, bar);
            __builtin_amdgcn_fence(__ATOMIC_ACQUIRE, "agent");
            xb_add(&bar[XB_XGEN(b.x)], 1u);
            asm volatile("s_waitcnt vmcnt(0)" ::: "memory");
        } else {
            XB_SPIN(xb_ld(&bar[XB_XGEN(b.x)]) == gen, bar);
            __builtin_amdgcn_fence(__ATOMIC_ACQUIRE, "agent");
            asm volatile("s_waitcnt vmcnt(0)" ::: "memory");
        }
    }
    __syncthreads();
}

namespace pg8 {
constexpr int BM = 256, BK = 64, HALF = 128, HTB = HALF * BK * 2, STAGE_BYTES = 8 * HTB, NXCD = 8, WGM = 8;
__host__ __device__ __forceinline__ int lds_byte(int r, int c) { const int st = (r >> 4) * 2 + (c >> 5), rr = r & 15, cc = c & 31, ob = rr * 64 + cc * 2; return st * 1024 + (ob ^ (((ob >> 9) & 1) << 5)); }
__host__ __device__ __forceinline__ void stage_rc(int b, int& R, int& C) { const int st = b / 1024, sb = b % 1024, swz = sb ^ (((sb >> 9) & 1) << 5); R = (st >> 1) * 16 + swz / 64; C = (st & 1) * 32 + (swz % 64) / 2; }
__host__ __device__ __forceinline__ int perm32(int rho) { const int n = rho >> 4, i = rho & 15; return 8 * (i >> 2) + 4 * n + (i & 3); }
struct Unit { int pm, pn; };
struct Gemm { const bf16_t* A; const bf16_t* Bt; int M, N, K; };
struct StaticOrder {
    int nM, nN, nwg, G, c;
    __host__ __device__ void init(int M, int N, int G_, int c_) { nM = M / BM; nN = N / BM; nwg = nM * nN; G = G_; c = c_; }
    __host__ __device__ bool next(int i, Unit& u) const {
        const long L = (long)i * G + c; if (L >= nwg) return false;
        int wgid = (int)L; { const int q = nwg / NXCD, r = nwg % NXCD, xcd = wgid % NXCD, off = wgid / NXCD; wgid = (xcd < r ? xcd * (q + 1) : r * (q + 1) + (xcd - r) * q) + off; }
        const int nig = WGM * nN, gid = wgid / nig, fm = gid * WGM, gsz = (nM - fm) < WGM ? (nM - fm) : WGM;
        u.pm = fm + ((wgid % nig) % gsz); u.pn = (wgid % nig) / gsz; return true;
    }
    __device__ __forceinline__ void a_ready(const Unit&) const {}
    __device__ __forceinline__ void done(const Unit&) const {}
};

template <int ACT> struct EpiScaleBf16 {
    static constexpr bool PERM = true;
    bf16_t* O; int ldc; const float* part;
    __device__ __forceinline__ void operator()(const f32x4 (&acc)[2][2][4][2], const Unit& u, int wr, int wc, int fr, int fq) const {
        const int row0 = u.pm * BM + wr * 64 + fr, col0 = u.pn * BM + wc * 32 + 8 * fq;
#pragma unroll
        for (int ai = 0; ai < 2; ++ai)
#pragma unroll
            for (int m = 0; m < 4; ++m) {
                const int row = row0 + ai * HALF + m * 16;
                float sc = 1.0f;
                if (part) { const f32x4* pp = (const f32x4*)(part + (size_t)row * 16); const f32x4 a = pp[0], b = pp[1], c = pp[2], d = pp[3];
                    const float s = ((a.x + a.y) + (a.z + a.w)) + ((b.x + b.y) + (b.z + b.w)) + ((c.x + c.y) + (c.z + c.w)) + ((d.x + d.y) + (d.z + d.w));
                    sc = frsq_(s * (1.0f / 1024.0f) + EPS); }
                bf16_t* rowp = O + (size_t)row * ldc + col0;
#pragma unroll
                for (int bj = 0; bj < 2; ++bj) { f32x4 v0 = acc[ai][bj][m][0] * sc, v1 = acc[ai][bj][m][1] * sc;
                    if (ACT == 1) {
#pragma unroll
                        for (int j = 0; j < 4; ++j) { const float a0 = fmaxf(v0[j], 0.f), a1 = fmaxf(v1[j], 0.f); v0[j] = a0 * a0; v1[j] = a1 * a1; } }
                    u32x4 w; w.x = pk2(v0[0], v0[1]); w.y = pk2(v0[2], v0[3]); w.z = pk2(v1[0], v1[1]); w.w = pk2(v1[2], v1[3]);
                    *(u32x4*)(rowp + bj * HALF) = w; }
            }
    }
};
struct EpiResid {
    static constexpr bool PERM = false;
    bf16_t* XB; float* part; float alpha;
    __device__ __forceinline__ void operator()(const f32x4 (&acc)[2][2][4][2], const Unit& u, int wr, int wc, int fr, int fq) const {
        const int row0 = u.pm * BM + wr * 64 + fr, col0 = u.pn * BM + wc * 32 + 4 * fq;
#pragma unroll
        for (int ai = 0; ai < 2; ++ai)
#pragma unroll
            for (int m = 0; m < 4; ++m) {
                const int row = row0 + ai * HALF + m * 16;
                bf16_t* bp = XB + (size_t)row * DM + col0;
                float ss = 0.f;
#pragma unroll
                for (int bj = 0; bj < 2; ++bj)
#pragma unroll
                    for (int n = 0; n < 2; ++n) { const u32x2 xw = *(const u32x2*)(bp + bj * HALF + n * 16);
                        const f32x4 v = (f32x4){bflo(xw.x), bfhi(xw.x), bflo(xw.y), bfhi(xw.y)} + acc[ai][bj][m][n] * alpha;
                        ss += (v.x * v.x + v.y * v.y) + (v.z * v.z + v.w * v.w);
                        u32x2 w; w.x = pk2(v.x, v.y); w.y = pk2(v.z, v.w); *(u32x2*)(bp + bj * HALF + n * 16) = w; }
                ss += __shfl_xor(ss, 16); ss += __shfl_xor(ss, 32);
                if (fq == 0) part[(size_t)row * 16 + u.pn * 4 + wc] = ss;
            }
    }
};

template <class Epi, class Sched>
__device__ __forceinline__ void gemm_phase(LAS unsigned char* lds, const Gemm g, const Sched& S, const Epi& E, const int tid) {
    const int wid = __builtin_amdgcn_readfirstlane(tid >> 6), lane = tid & 63, wr = wid >> 2, wc = wid & 3, fr = lane & 15, fq = lane >> 4;
    const int K = g.K, nt = K / BK;
    unsigned voffA[2], voffB[2];
#pragma unroll
    for (int i = 0; i < 2; ++i) { int R, C; stage_rc(tid * 16 + i * 8192, R, C); const int Rb = Epi::PERM ? ((R & ~31) + perm32(R & 31)) : R;
        voffA[i] = (unsigned)(R * K + C) * 2u; voffB[i] = (unsigned)(Rb * K + C) * 2u; }
    const size_t kstep = (size_t)(BK * 2);
    const size_t hstep = (size_t)HALF * K * 2;
    const size_t tstep = 2 * hstep;
    const unsigned ldsw = (unsigned)wid * 1024u;
    const int aoff = lds_byte(wr * 64 + fr, fq * 8), boff = lds_byte(wc * 32 + fr, fq * 8);
#define PG8_SA(b, h) (((b) * 2 + (h)) * HTB)
#define PG8_SB(b, h) ((4 + (b) * 2 + (h)) * HTB)
#define PG8_STAGE(bufoff, gbase, voff) do { _Pragma("unroll") for (int _i = 0; _i < 2; ++_i) \
        __builtin_amdgcn_global_load_lds((const unsigned*)((const char*)(gbase) + (voff)[_i]), (LAS unsigned*)(lds + (bufoff) + ldsw + _i * 8192), 16, 0, 0); } while (0)
#define PG8_LDA(dst, b, h) do { _Pragma("unroll") for (int m = 0; m < 4; ++m) _Pragma("unroll") for (int k = 0; k < 2; ++k) dst[m][k] = *(const LAS bf16x8*)(lds + PG8_SA(b, h) + aoff + m * 2048 + k * 1024); } while (0)
#define PG8_LDB(dst, b, h) do { _Pragma("unroll") for (int n = 0; n < 2; ++n) _Pragma("unroll") for (int k = 0; k < 2; ++k) dst[n][k] = *(const LAS bf16x8*)(lds + PG8_SB(b, h) + boff + n * 2048 + k * 1024); } while (0)
#define PG8_MMA(ai, bj, At, Bt) do { __builtin_amdgcn_s_setprio(1); _Pragma("unroll") for (int m = 0; m < 4; ++m) _Pragma("unroll") for (int n = 0; n < 2; ++n) _Pragma("unroll") for (int k = 0; k < 2; ++k) \
        acc[ai][bj][m][n] = __builtin_amdgcn_mfma_f32_16x16x32_bf16(Bt[n][k], At[m][k], acc[ai][bj][m][n], 0, 0, 0); __builtin_amdgcn_s_setprio(0); } while (0)
#define PG8_WAIT_V(n) asm volatile("s_waitcnt vmcnt(" #n ")" ::: "memory")
#define PG8_WAIT_L(n) asm volatile("s_waitcnt lgkmcnt(" #n ")" ::: "memory")
#define PG8_BAR __builtin_amdgcn_s_barrier()
#define PG8_SCHED __builtin_amdgcn_sched_barrier(0)
    Unit cur, nxt; int ui = 0;
    if (!S.next(0, cur)) return;
    f32x4 acc[2][2][4][2];
#pragma unroll
    for (int a = 0; a < 2; ++a)
#pragma unroll
        for (int b = 0; b < 2; ++b)
#pragma unroll
            for (int m = 0; m < 4; ++m)
#pragma unroll
                for (int n = 0; n < 2; ++n) acc[a][b][m][n] = (f32x4){0.f, 0.f, 0.f, 0.f};
    bf16x8 At[4][2], B0[2][2], B1[2][2];
    const char* cA = (const char*)g.A + (size_t)cur.pm * tstep; const char* cB = (const char*)g.Bt + (size_t)cur.pn * tstep;
    S.a_ready(cur);
    PG8_STAGE(PG8_SB(0, 0), cB, voffB); PG8_STAGE(PG8_SA(0, 0), cA, voffA); PG8_STAGE(PG8_SB(0, 1), cB + hstep, voffB); PG8_STAGE(PG8_SA(0, 1), cA + hstep, voffA);
    if (wr == 1) PG8_BAR;
    PG8_WAIT_V(4); PG8_BAR;
    PG8_STAGE(PG8_SB(1, 0), cB + kstep, voffB); PG8_STAGE(PG8_SA(1, 0), cA + kstep, voffA); PG8_STAGE(PG8_SB(1, 1), cB + hstep + kstep, voffB);
    PG8_WAIT_V(6); PG8_BAR;
    for (;;) {
        const bool has_next = S.next(ui + 1, nxt);
        const char* nA = has_next ? (const char*)g.A + (size_t)nxt.pm * tstep : cA; const char* nB = has_next ? (const char*)g.Bt + (size_t)nxt.pn * tstep : cB;
        for (int t = 0; t < nt; t += 2) {
            const bool last = (t == nt - 2);
            const char* a1 = cA + (size_t)(t + 1) * kstep;
            const char* a2 = last ? nA : cA + (size_t)(t + 2) * kstep; const char* b2 = last ? nB : cB + (size_t)(t + 2) * kstep;
            const char* a3 = a2 + kstep; const char* b3 = b2 + kstep;
            if (last && has_next) S.a_ready(nxt);
            PG8_LDB(B0, 0, 0); PG8_SCHED; PG8_LDA(At, 0, 0); PG8_STAGE(PG8_SA(1, 1), a1 + hstep, voffA);
            PG8_WAIT_L(8); PG8_BAR; PG8_WAIT_L(0); PG8_MMA(0, 0, At, B0); PG8_BAR; PG8_SCHED;
            PG8_LDB(B1, 0, 1); PG8_STAGE(PG8_SB(0, 0), b2, voffB);
            PG8_BAR; PG8_WAIT_L(0); PG8_MMA(0, 1, At, B1); PG8_BAR;
            PG8_LDA(At, 0, 1); PG8_STAGE(PG8_SA(0, 0), a2, voffA);
            PG8_BAR; PG8_WAIT_L(0); PG8_MMA(1, 0, At, B0); PG8_BAR; PG8_SCHED;
            PG8_STAGE(PG8_SB(0, 1), b2 + hstep, voffB);
            PG8_WAIT_V(6); PG8_BAR; PG8_MMA(1, 1, At, B1); PG8_BAR;
            PG8_LDB(B0, 1, 0); PG8_SCHED; PG8_LDA(At, 1, 0); PG8_STAGE(PG8_SA(0, 1), a2 + hstep, voffA);
            PG8_WAIT_L(8); PG8_BAR; PG8_WAIT_L(0); PG8_MMA(0, 0, At, B0); PG8_BAR; PG8_SCHED;
            PG8_LDB(B1, 1, 1); PG8_STAGE(PG8_SB(1, 0), b3, voffB);
            PG8_BAR; PG8_WAIT_L(0); PG8_MMA(0, 1, At, B1); PG8_BAR;
            PG8_LDA(At, 1, 1); PG8_STAGE(PG8_SA(1, 0), a3, voffA);
            PG8_BAR; PG8_WAIT_L(0); PG8_MMA(1, 0, At, B0); PG8_BAR; PG8_SCHED;
            PG8_STAGE(PG8_SB(1, 1), b3 + hstep, voffB);
            PG8_WAIT_V(6); PG8_BAR; PG8_MMA(1, 1, At, B1); PG8_BAR;
        }
        E(acc, cur, wr, wc, fr, fq); S.done(cur);
        if (!has_next) break;
#pragma unroll
        for (int a = 0; a < 2; ++a)
#pragma unroll
            for (int b = 0; b < 2; ++b)
#pragma unroll
                for (int m = 0; m < 4; ++m)
#pragma unroll
                    for (int n = 0; n < 2; ++n) acc[a][b][m][n] = (f32x4){0.f, 0.f, 0.f, 0.f};
        cur = nxt; cA = nA; cB = nB; ++ui;
    }
    PG8_WAIT_V(0);
    if (wr == 0) PG8_BAR;
    PG8_BAR;
#undef PG8_SA
#undef PG8_SB
#undef PG8_STAGE
#undef PG8_LDA
#undef PG8_LDB
#undef PG8_MMA
#undef PG8_WAIT_V
#undef PG8_WAIT_L
#undef PG8_BAR
#undef PG8_SCHED
}
}

struct Params {
    const float* x; const float* mem; const int* pos;
    const float* norm_mix; const float* w_in; const float* ret_gn;
    const float* lru_conv_w; const float* lru_conv_b; const float* lru_wa; const float* lru_ba; const float* lru_wx; const float* lru_bx; const float* lru_lambda;
    const float* mla_q_norm; const float* mla_w_uq; const float* mla_kv_norm; const float* mla_w_ukv;
    const float* gdn_conv_w; const float* gdn_a_log; const float* gdn_dt_bias; const float* gdn_norm;
    const float* w_out; const float* norm_xattn; const float* norm_mem; const float* xa_wq; const float* xa_wkv; const float* xa_wo;
    const float* norm_mlp; const float* mlp_w1; const float* mlp_w2; const float* final_norm;
    float* out; unsigned char* ws;
    int ph_lo, ph_hi;
};

__device__ __forceinline__ bf16_t* wl(const Params& P, int l, size_t off) { return (bf16_t*)(P.ws + WS_W) + (size_t)l * W_LAYER + off; }

__device__ __forceinline__ void transpose_tile(const float* src, int K, int N, const float* gain, float scale, bf16_t* dst, int kb, int nb, LAS float* scr, int tid) {
#pragma unroll
    for (int i = 0; i < 8; ++i) { const int kk = (tid >> 6) + 8 * i, k = kb * 64 + kk, n = nb * 64 + (tid & 63);
        float v = 0.f; if (n < N) { v = src[(size_t)k * N + n] * scale; if (gain) v *= gain[k]; }
        scr[kk * 65 + (tid & 63)] = v; }
    __syncthreads();
    { const int nl = tid >> 3, k0 = (tid & 7) * 8; const LAS float* s = scr + k0 * 65 + nl;
      u32x4 o; o.x = pk2(s[0], s[65]); o.y = pk2(s[2 * 65], s[3 * 65]); o.z = pk2(s[4 * 65], s[5 * 65]); o.w = pk2(s[6 * 65], s[7 * 65]);
      *(u32x4*)(dst + (size_t)(nb * 64 + nl) * K + kb * 64 + k0) = o; }
    __syncthreads();
}
__device__ __forceinline__ void p0_prologue(const Params& P, LAS unsigned char* lds, int tid) {
    LAS float* scr = (LAS float*)lds;
    constexpr int T_IN = 16 * 48, T_SQ = 256, T_KV = 512, T_W1 = 1024, T_W2 = 1024, T_UQ = 18, T_UKV = 16, T_LRU = 8;
    constexpr int T_LAYER = T_IN + 3 * T_SQ + T_KV + T_W1 + T_W2 + T_UQ + T_UKV + T_LRU;
    for (int it = blockIdx.x; it < 2 * T_LAYER; it += gridDim.x) {
        const int l = it / T_LAYER; int r = it % T_LAYER;
        const float* src; const float* gain = nullptr; float scale = 1.f; bf16_t* dst; int K, N, nnb;
        if (r < T_IN) { src = P.w_in + (size_t)l * DM * IN_COLS; K = DM; N = IN_COLS; nnb = 48; gain = P.norm_mix + l * DM; dst = wl(P, l, W_IN); }
        else if ((r -= T_IN) < T_SQ) { src = P.w_out + (size_t)l * DM * DM; K = DM; N = DM; nnb = 16; dst = wl(P, l, W_OUT); }
        else if ((r -= T_SQ) < T_SQ) { src = P.xa_wq + (size_t)l * DM * DM; K = DM; N = DM; nnb = 16; gain = P.norm_xattn + l * DM; scale = 0.0625f * LOG2E; dst = wl(P, l, W_Q); }
        else if ((r -= T_SQ) < T_KV) { src = P.xa_wkv + (size_t)l * DM * 2 * DM; K = DM; N = 2 * DM; nnb = 32; gain = P.norm_mem + l * DM; dst = wl(P, l, W_KV); }
        else if ((r -= T_KV) < T_SQ) { src = P.xa_wo + (size_t)l * DM * DM; K = DM; N = DM; nnb = 16; dst = wl(P, l, W_O); }
        else if ((r -= T_SQ) < T_W1) { src = P.mlp_w1 + (size_t)l * DM * DFF; K = DM; N = DFF; nnb = 64; gain = P.norm_mlp + l * DM; dst = wl(P, l, W_1); }
        else if ((r -= T_W1) < T_W2) { src = P.mlp_w2 + (size_t)l * DFF * DM; K = DFF; N = DM; nnb = 16; dst = wl(P, l, W_2); }
        else if ((r -= T_W2) < T_UQ) { src = P.mla_w_uq + (size_t)l * 192 * 384; K = 192; N = 384; nnb = 6; gain = P.mla_q_norm + l * 192; dst = wl(P, l, W_UQ); }
        else if ((r -= T_UQ) < T_UKV) { src = P.mla_w_ukv + (size_t)l * 128 * 512; K = 128; N = 512; nnb = 8; gain = P.mla_kv_norm + l * 128; dst = wl(P, l, W_UKV); }
        else { r -= T_UKV; const int which = r >> 2, nb4 = r & 3; src = (which ? P.lru_wx : P.lru_wa) + (size_t)l * 4 * 4096 + nb4 * 4096; K = 64; N = 64; nnb = 1; dst = wl(P, l, which ? W_X : W_A) + nb4 * 4096; r = 0; }
        transpose_tile(src, K, N, gain, scale, dst, r / nnb, r % nnb, scr, tid);
    }
    const int wave = tid >> 6, lane = tid & 63;
    const int gw = blockIdx.x * 8 + wave, ngw = gridDim.x * 8;
    bf16_t* xb = (bf16_t*)(P.ws + WS_XB); float* part = (float*)(P.ws + WS_PART); bf16_t* memn = (bf16_t*)(P.ws + WS_GDN);
    for (int row = gw; row < T_TOK + NBATCH * NMEM; row += ngw) {
        const bool isx = row < T_TOK; const int r2 = isx ? row : row - T_TOK;
        const f32x4* src = (const f32x4*)((isx ? P.x : P.mem) + (size_t)r2 * DM) + lane;
        f32x4 v[4]; float s = 0.f;
#pragma unroll
        for (int j = 0; j < 4; ++j) { v[j] = src[64 * j]; s += (v[j].x * v[j].x + v[j].y * v[j].y) + (v[j].z * v[j].z + v[j].w * v[j].w); }
        s = wave_sum(s);
        if (isx) {
            u32x2* ob = (u32x2*)(xb + (size_t)row * DM) + lane;
#pragma unroll
            for (int j = 0; j < 4; ++j) { u32x2 w; w.x = pk2(v[j].x, v[j].y); w.y = pk2(v[j].z, v[j].w); ob[64 * j] = w; }
            if (lane < 16) part[(size_t)row * 16 + lane] = lane == 0 ? s : 0.f;
        } else {
            const float rs = frsq_(s * (1.0f / 1024.0f) + EPS); u32x2* ob = (u32x2*)(memn + (size_t)r2 * DM) + lane;
#pragma unroll
            for (int j = 0; j < 4; ++j) { u32x2 w; w.x = pk2(v[j].x * rs, v[j].y * rs); w.y = pk2(v[j].z * rs, v[j].w * rs); ob[64 * j] = w; }
        }
    }
}
__device__ __forceinline__ void final_norm_phase(const Params& P, int tid) {
    const int wave = tid >> 6, lane = tid & 63; const float* part = (const float*)(P.ws + WS_PART); const bf16_t* xb = (const bf16_t*)(P.ws + WS_XB);
    f32x4 g[4];
#pragma unroll
    for (int j = 0; j < 4; ++j) g[j] = ((const f32x4*)P.final_norm)[64 * j + lane];
    for (int row = blockIdx.x * 8 + wave; row < T_TOK; row += gridDim.x * 8) {
        float s = lane < 16 ? part[(size_t)row * 16 + lane] : 0.f; s = wave_sum(s);
        const float rs = frsq_(s * (1.0f / 1024.0f) + EPS);
        f32x4* o = (f32x4*)(P.out + (size_t)row * DM) + lane; const u32x2* xi = (const u32x2*)(xb + (size_t)row * DM) + lane;
#pragma unroll
        for (int j = 0; j < 4; ++j) { const u32x2 w = xi[64 * j]; o[64 * j] = (f32x4){bflo(w.x), bfhi(w.x), bflo(w.y), bfhi(w.y)} * rs * g[j]; }
    }
}
__device__ __forceinline__ void mla_pre_tile(const Params& P, int l, int rt, int lane) {
    const int fr = lane & 15, fq = lane >> 4;
    const bf16_t* z = (const bf16_t*)(P.ws + WS_R);
    bf16_t* Qo = (bf16_t*)((unsigned char*)P.out + MLA_Q_OFF); bf16_t* Ko = (bf16_t*)((unsigned char*)P.out + MLA_K_OFF); bf16_t* Vo = (bf16_t*)((unsigned char*)P.out + MLA_VT_OFF);
    const bf16_t* Wuq = wl(P, l, W_UQ); const bf16_t* Wukv = wl(P, l, W_UKV);
    const int tok0 = rt * 16, b = tok0 >> 11, s0 = tok0 & 2047;
    const bf16_t* zr = z + (size_t)(tok0 + fr) * ZP;
    bf16x8 cq[6], ckv[4]; float sq = 0.f, skv = 0.f;
#pragma unroll
    for (int s = 0; s < 6; ++s) { const u32x4 w = *(const u32x4*)(zr + Z_CQ + 32 * s + 8 * fq); cq[s] = __builtin_bit_cast(bf16x8, w);
        sq += bflo(w.x) * bflo(w.x) + bfhi(w.x) * bfhi(w.x) + bflo(w.y) * bflo(w.y) + bfhi(w.y) * bfhi(w.y) + bflo(w.z) * bflo(w.z) + bfhi(w.z) * bfhi(w.z) + bflo(w.w) * bflo(w.w) + bfhi(w.w) * bfhi(w.w); }
#pragma unroll
    for (int s = 0; s < 4; ++s) { const u32x4 w = *(const u32x4*)(zr + Z_CKV + 32 * s + 8 * fq); ckv[s] = __builtin_bit_cast(bf16x8, w);
        skv += bflo(w.x) * bflo(w.x) + bfhi(w.x) * bfhi(w.x) + bflo(w.y) * bflo(w.y) + bfhi(w.y) * bfhi(w.y) + bflo(w.z) * bflo(w.z) + bfhi(w.z) * bfhi(w.z) + bflo(w.w) * bflo(w.w) + bfhi(w.w) * bfhi(w.w); }
    sq += __shfl_xor(sq, 16); sq += __shfl_xor(sq, 32); skv += __shfl_xor(skv, 16); skv += __shfl_xor(skv, 32);
    const float rq = frsq_(sq * (1.0f / 192.0f) + EPS), rkv = frsq_(skv * (1.0f / 128.0f) + EPS);
    const float qsc = rq * 0.10206207261596575f * LOG2E;
    const float pos = (float)P.pos[tok0 + fr];
    float sn[4], cs[4];
#pragma unroll
    for (int r = 0; r < 4; ++r) { const float invf = exp2f(-(float)(4 * fq + r) * (13.287712379549449f / 16.0f)); sincos_rev(pos * invf, sn[r], cs[r]); }
    const size_t tokrow = (size_t)b * 4 * SEQ + (s0 + fr);
#pragma unroll 1
    for (int h = 0; h < 4; ++h) {
        bf16_t* qrow = Qo + (tokrow + (size_t)h * SEQ) * 96;
#pragma unroll 1
        for (int nt = 0; nt < 4; ++nt) { f32x4 a = {0.f, 0.f, 0.f, 0.f};
#pragma unroll
            for (int s = 0; s < 6; ++s) { const bf16x8 wf = *(const bf16x8*)(Wuq + (size_t)(h * 96 + nt * 16 + fr) * 192 + 32 * s + 8 * fq); a = mfma16(wf, cq[s], a); }
            a = a * qsc; u32x2 w; w.x = pk2(a.x, a.y); w.y = pk2(a.z, a.w); *(u32x2*)(qrow + nt * 16 + 4 * fq) = w; }
        f32x4 x1 = {0.f, 0.f, 0.f, 0.f}, x2 = {0.f, 0.f, 0.f, 0.f}, y1, y2;
#pragma unroll
        for (int s = 0; s < 6; ++s) { const bf16x8 wf1 = *(const bf16x8*)(Wuq + (size_t)(h * 96 + 64 + fr) * 192 + 32 * s + 8 * fq), wf2 = *(const bf16x8*)(Wuq + (size_t)(h * 96 + 80 + fr) * 192 + 32 * s + 8 * fq);
            x1 = mfma16(wf1, cq[s], x1); x2 = mfma16(wf2, cq[s], x2); }
        x1 = x1 * qsc; x2 = x2 * qsc;
#pragma unroll
        for (int r = 0; r < 4; ++r) { y1[r] = x1[r] * cs[r] - x2[r] * sn[r]; y2[r] = x1[r] * sn[r] + x2[r] * cs[r]; }
        { u32x2 w; w.x = pk2(y1.x, y1.y); w.y = pk2(y1.z, y1.w); *(u32x2*)(qrow + 64 + 4 * fq) = w; w.x = pk2(y2.x, y2.y); w.y = pk2(y2.z, y2.w); *(u32x2*)(qrow + 80 + 4 * fq) = w; }
    }
    u32x2 kr1, kr2;
    { const u32x2 a = *(const u32x2*)(zr + Z_KR + 4 * fq), c = *(const u32x2*)(zr + Z_KR + 16 + 4 * fq);
      const float x1[4] = {bflo(a.x), bfhi(a.x), bflo(a.y), bfhi(a.y)}, x2[4] = {bflo(c.x), bfhi(c.x), bflo(c.y), bfhi(c.y)}; float y1[4], y2[4];
#pragma unroll
      for (int r = 0; r < 4; ++r) { y1[r] = x1[r] * cs[r] - x2[r] * sn[r]; y2[r] = x1[r] * sn[r] + x2[r] * cs[r]; }
      kr1.x = pk2(y1[0], y1[1]); kr1.y = pk2(y1[2], y1[3]); kr2.x = pk2(y2[0], y2[1]); kr2.y = pk2(y2[2], y2[3]); }
    float rkv_r[4];
#pragma unroll
    for (int r = 0; r < 4; ++r) rkv_r[r] = __shfl(rkv, 4 * fq + r);
    const int chunk = s0 >> 6, key0 = (s0 & 63) + 4 * fq;
#pragma unroll 1
    for (int h = 0; h < 4; ++h) {
        bf16_t* krow = Ko + (tokrow + (size_t)h * SEQ) * 96;
#pragma unroll 1
        for (int nt = 0; nt < 4; ++nt) { f32x4 a = {0.f, 0.f, 0.f, 0.f};
#pragma unroll
            for (int s = 0; s < 4; ++s) { const bf16x8 wf = *(const bf16x8*)(Wukv + (size_t)(h * 128 + nt * 16 + fr) * 128 + 32 * s + 8 * fq); a = mfma16(wf, ckv[s], a); }
            a = a * rkv; u32x2 w; w.x = pk2(a.x, a.y); w.y = pk2(a.z, a.w); *(u32x2*)(krow + nt * 16 + 4 * fq) = w; }
        *(u32x2*)(krow + 64 + 4 * fq) = kr1; *(u32x2*)(krow + 80 + 4 * fq) = kr2;
        bf16_t* vt = Vo + ((size_t)((b * 4 + h) * NCHUNK + chunk) * 64) * 64;
#pragma unroll 1
        for (int nt = 0; nt < 4; ++nt) { f32x4 a = {0.f, 0.f, 0.f, 0.f};
#pragma unroll
            for (int s = 0; s < 4; ++s) { const bf16x8 wf = *(const bf16x8*)(Wukv + (size_t)(h * 128 + 64 + nt * 16 + fr) * 128 + 32 * s + 8 * fq); a = mfma16(ckv[s], wf, a); }
            u32x2 w; w.x = pk2(a.x * rkv_r[0], a.y * rkv_r[1]); w.y = pk2(a.z * rkv_r[2], a.w * rkv_r[3]);
            *(u32x2*)(vt + (size_t)(nt * 16 + fr) * 64 + key0) = w; }
    }
}

constexpr int MP_UQ_ROW = 200, MP_UKV_ROW = 136, MP_UKV_OFF = 96 * MP_UQ_ROW * 2, MP_BUF = MP_UKV_OFF + 128 * MP_UKV_ROW * 2;
__device__ __forceinline__ void mla_pre_item(const Params& P, int l, LAS unsigned char* lds, int it, int tid, int wave, int lane) {
    const int fr = lane & 15, fq = lane >> 4, rt = it * 8 + wave;
    const bf16_t* z = (const bf16_t*)(P.ws + WS_R);
    bf16_t* Qo = (bf16_t*)((unsigned char*)P.out + MLA_Q_OFF); bf16_t* Ko = (bf16_t*)((unsigned char*)P.out + MLA_K_OFF); bf16_t* Vo = (bf16_t*)((unsigned char*)P.out + MLA_VT_OFF);
    const bf16_t* Wuq = wl(P, l, W_UQ); const bf16_t* Wukv = wl(P, l, W_UKV);
    u32x4 stg[5];
#define MP_LOADQ(h_) do { _Pragma("unroll") for (int i = 0; i < 5; ++i) { const int p = tid + 512 * i; if (p < 2304) stg[i] = *(const u32x4*)(Wuq + (size_t)(h_) * 96 * 192 + (size_t)p * 8); } } while (0)
#define MP_STOREQ(buf_) do { _Pragma("unroll") for (int i = 0; i < 5; ++i) { const int p = tid + 512 * i; if (p < 2304) { const int row = p / 24, pc = p % 24; *(LAS u32x4*)(lds + (buf_) * MP_BUF + (row * MP_UQ_ROW + pc * 8) * 2) = stg[i]; } } } while (0)
#define MP_LOADKV(h_) do { _Pragma("unroll") for (int i = 0; i < 4; ++i) { const int p = tid + 512 * i; stg[i] = *(const u32x4*)(Wukv + (size_t)(h_) * 128 * 128 + (size_t)p * 8); } } while (0)
#define MP_STOREKV(buf_) do { _Pragma("unroll") for (int i = 0; i < 4; ++i) { const int p = tid + 512 * i, row = p >> 4, pc = p & 15; *(LAS u32x4*)(lds + (buf_) * MP_BUF + MP_UKV_OFF + (row * MP_UKV_ROW + pc * 8) * 2) = stg[i]; } } while (0)
    MP_LOADQ(0); MP_STOREQ(0); MP_LOADKV(0);
    const int tok0 = rt * 16, b = tok0 >> 11, s0 = tok0 & 2047;
    const bf16_t* zr = z + (size_t)(tok0 + fr) * ZP;
    bf16x8 cq[6], ckv[4]; float sq = 0.f, skv = 0.f;
#pragma unroll
    for (int s = 0; s < 6; ++s) { const u32x4 w = *(const u32x4*)(zr + Z_CQ + 32 * s + 8 * fq); cq[s] = __builtin_bit_cast(bf16x8, w);
        sq += bflo(w.x) * bflo(w.x) + bfhi(w.x) * bfhi(w.x) + bflo(w.y) * bflo(w.y) + bfhi(w.y) * bfhi(w.y) + bflo(w.z) * bflo(w.z) + bfhi(w.z) * bfhi(w.z) + bflo(w.w) * bflo(w.w) + bfhi(w.w) * bfhi(w.w); }
#pragma unroll
    for (int s = 0; s < 4; ++s) { const u32x4 w = *(const u32x4*)(zr + Z_CKV + 32 * s + 8 * fq); ckv[s] = __builtin_bit_cast(bf16x8, w);
        skv += bflo(w.x) * bflo(w.x) + bfhi(w.x) * bfhi(w.x) + bflo(w.y) * bflo(w.y) + bfhi(w.y) * bfhi(w.y) + bflo(w.z) * bflo(w.z) + bfhi(w.z) * bfhi(w.z) + bflo(w.w) * bflo(w.w) + bfhi(w.w) * bfhi(w.w); }
    const u32x2 kra = *(const u32x2*)(zr + Z_KR + 4 * fq), krc = *(const u32x2*)(zr + Z_KR + 16 + 4 * fq);
    const float pos = (float)P.pos[tok0 + fr];
    MP_STOREKV(0);
    sq += __shfl_xor(sq, 16); sq += __shfl_xor(sq, 32); skv += __shfl_xor(skv, 16); skv += __shfl_xor(skv, 32);
    const float rq = frsq_(sq * (1.0f / 192.0f) + EPS), rkv = frsq_(skv * (1.0f / 128.0f) + EPS);
    const float qsc = rq * 0.10206207261596575f * LOG2E;
    float sn[4], cs[4];
#pragma unroll
    for (int r = 0; r < 4; ++r) { const float invf = exp2f(-(float)(4 * fq + r) * (13.287712379549449f / 16.0f)); sincos_rev(pos * invf, sn[r], cs[r]); }
    const size_t tokrow = (size_t)b * 4 * SEQ + (s0 + fr);
    u32x2 kr1, kr2;
    { const float x1[4] = {bflo(kra.x), bfhi(kra.x), bflo(kra.y), bfhi(kra.y)}, x2[4] = {bflo(krc.x), bfhi(krc.x), bflo(krc.y), bfhi(krc.y)}; float y1[4], y2[4];
#pragma unroll
      for (int r = 0; r < 4; ++r) { y1[r] = x1[r] * cs[r] - x2[r] * sn[r]; y2[r] = x1[r] * sn[r] + x2[r] * cs[r]; }
      kr1.x = pk2(y1[0], y1[1]); kr1.y = pk2(y1[2], y1[3]); kr2.x = pk2(y2[0], y2[1]); kr2.y = pk2(y2[2], y2[3]); }
    float rkv_r[4];
#pragma unroll
    for (int r = 0; r < 4; ++r) rkv_r[r] = __shfl(rkv, 4 * fq + r);
    const int chunk = s0 >> 6, key0 = (s0 & 63) + 4 * fq;
    __syncthreads();
#pragma unroll 1
    for (int h = 0; h < 4; ++h) {
        if (h < 3) MP_LOADQ(h + 1);
        const LAS bf16_t* UQ = (const LAS bf16_t*)(lds + (h & 1) * MP_BUF); const LAS bf16_t* UKV = (const LAS bf16_t*)(lds + (h & 1) * MP_BUF + MP_UKV_OFF);
        bf16_t* qrow = Qo + (tokrow + (size_t)h * SEQ) * 96; bf16_t* krow = Ko + (tokrow + (size_t)h * SEQ) * 96;
        bf16_t* vt = Vo + ((size_t)((b * 4 + h) * NCHUNK + chunk) * 64) * 64;
#pragma unroll 1
        for (int nt = 0; nt < 4; ++nt) { f32x4 a = {0.f, 0.f, 0.f, 0.f};
#pragma unroll
            for (int s = 0; s < 6; ++s) a = mfma16(*(const LAS bf16x8*)(UQ + (nt * 16 + fr) * MP_UQ_ROW + 32 * s + 8 * fq), cq[s], a);
            a = a * qsc; u32x2 w; w.x = pk2(a.x, a.y); w.y = pk2(a.z, a.w); *(u32x2*)(qrow + nt * 16 + 4 * fq) = w; }
        {   f32x4 x1 = {0.f, 0.f, 0.f, 0.f}, x2 = {0.f, 0.f, 0.f, 0.f}, y1, y2;
#pragma unroll
            for (int s = 0; s < 6; ++s) { x1 = mfma16(*(const LAS bf16x8*)(UQ + (64 + fr) * MP_UQ_ROW + 32 * s + 8 * fq), cq[s], x1); x2 = mfma16(*(const LAS bf16x8*)(UQ + (80 + fr) * MP_UQ_ROW + 32 * s + 8 * fq), cq[s], x2); }
            x1 = x1 * qsc; x2 = x2 * qsc;
#pragma unroll
            for (int r = 0; r < 4; ++r) { y1[r] = x1[r] * cs[r] - x2[r] * sn[r]; y2[r] = x1[r] * sn[r] + x2[r] * cs[r]; }
            u32x2 w; w.x = pk2(y1.x, y1.y); w.y = pk2(y1.z, y1.w); *(u32x2*)(qrow + 64 + 4 * fq) = w; w.x = pk2(y2.x, y2.y); w.y = pk2(y2.z, y2.w); *(u32x2*)(qrow + 80 + 4 * fq) = w; }
        if (h < 3) { MP_STOREQ((h + 1) & 1); MP_LOADKV(h + 1); }
#pragma unroll 1
        for (int nt = 0; nt < 4; ++nt) { f32x4 a = {0.f, 0.f, 0.f, 0.f};
#pragma unroll
            for (int s = 0; s < 4; ++s) a = mfma16(*(const LAS bf16x8*)(UKV + (nt * 16 + fr) * MP_UKV_ROW + 32 * s + 8 * fq), ckv[s], a);
            a = a * rkv; u32x2 w; w.x = pk2(a.x, a.y); w.y = pk2(a.z, a.w); *(u32x2*)(krow + nt * 16 + 4 * fq) = w; }
        *(u32x2*)(krow + 64 + 4 * fq) = kr1; *(u32x2*)(krow + 80 + 4 * fq) = kr2;
#pragma unroll 1
        for (int nt = 0; nt < 4; ++nt) { f32x4 a = {0.f, 0.f, 0.f, 0.f};
#pragma unroll
            for (int s = 0; s < 4; ++s) a = mfma16(ckv[s], *(const LAS bf16x8*)(UKV + (64 + nt * 16 + fr) * MP_UKV_ROW + 32 * s + 8 * fq), a);
            u32x2 w; w.x = pk2(a.x * rkv_r[0], a.y * rkv_r[1]); w.y = pk2(a.z * rkv_r[2], a.w * rkv_r[3]);
            *(u32x2*)(vt + (size_t)(nt * 16 + fr) * 64 + key0) = w; }
        if (h < 3) MP_STOREKV((h + 1) & 1);
        __syncthreads();
    }
#undef MP_LOADQ
#undef MP_STOREQ
#undef MP_LOADKV
#undef MP_STOREKV
}

template <int DQK, int DV, int KT, int QT>
__device__ __forceinline__ void flash_item(LAS unsigned char* lds, const bf16_t* Qw, int ldq, const bf16_t* Kb, int ldk, const bf16_t* VTb, int ldv, int vts,
                                           bf16_t* Ow, int ldo, int ntiles, int wave_limit, int tid, int lane) {
    constexpr int KROW = DQK + 8, VROW = KT + 8, KS = DQK / 32, ET = DV / 16, NKT = KT / 16, KBYTES = KT * KROW * 2, BUF = KBYTES + DV * VROW * 2;
    constexpr int KP = KT * DQK / 8, VPR = KT / 8, VP = DV * VPR, NKP = (KP + 511) / 512, NVP = (VP + 511) / 512, NP = NKP > NVP ? NKP : NVP;
    const int fr = lane & 15, fq = lane >> 4;
    bf16x8 qf[QT][KS];
#pragma unroll
    for (int qi = 0; qi < QT; ++qi)
#pragma unroll
        for (int s = 0; s < KS; ++s) qf[qi][s] = *(const bf16x8*)(Qw + (size_t)(qi * 16 + fr) * ldq + 32 * s + 8 * fq);
    f32x4 ot[QT][ET];
#pragma unroll
    for (int qi = 0; qi < QT; ++qi)
#pragma unroll
        for (int e = 0; e < ET; ++e) ot[qi][e] = (f32x4){0.f, 0.f, 0.f, 0.f};
    float m_run[QT], l_run[QT];
#pragma unroll
    for (int qi = 0; qi < QT; ++qi) { m_run[qi] = -1e30f; l_run[qi] = 0.f; }
    u32x4 preg[NP];
#define FL_LOADK(j_) do { _Pragma("unroll") for (int i = 0; i < NKP; ++i) { const int idx = tid + i * 512; if (idx < KP) { const int row = idx / (DQK / 8), pc = idx % (DQK / 8); \
            preg[i] = *(const u32x4*)(Kb + (size_t)((j_) * KT + row) * ldk + pc * 8); } } } while (0)
#define FL_LOADV(j_) do { _Pragma("unroll") for (int i = 0; i < NVP; ++i) { const int idx = tid + i * 512; if (idx < VP) { const int row = idx / VPR, pc = idx % VPR; \
            preg[i] = *(const u32x4*)(VTb + (size_t)(j_) * vts + (size_t)row * ldv + pc * 8); } } } while (0)
#define FL_STOREK(buf_) do { LAS bf16_t* Kt_ = (LAS bf16_t*)(lds + (buf_) * BUF); \
        _Pragma("unroll") for (int i = 0; i < NKP; ++i) { const int idx = tid + i * 512; if (idx < KP) { const int row = idx / (DQK / 8), pc = idx % (DQK / 8); *(LAS u32x4*)(Kt_ + row * KROW + pc * 8) = preg[i]; } } } while (0)
#define FL_STOREV(buf_) do { LAS bf16_t* Vt_ = (LAS bf16_t*)(lds + (buf_) * BUF + KBYTES); \
        _Pragma("unroll") for (int i = 0; i < NVP; ++i) { const int idx = tid + i * 512; if (idx < VP) { const int row = idx / VPR, pc = idx % VPR; *(LAS u32x4*)(Vt_ + row * VROW + pc * 8) = preg[i]; } } } while (0)
    FL_LOADK(0); FL_STOREK(0); FL_LOADV(0); FL_STOREV(0);
    __syncthreads();
#pragma unroll 1
    for (int j = 0; j < ntiles; ++j) {
        const bool more = j + 1 < ntiles, act = j < wave_limit;
        const LAS bf16_t* Kt = (const LAS bf16_t*)(lds + (j & 1) * BUF); const LAS bf16_t* Vt = (const LAS bf16_t*)(lds + (j & 1) * BUF + KBYTES);
        if (more) FL_LOADK(j + 1);
        f32x4 st[QT][NKT];
        if (act) {
#pragma unroll
            for (int kt = 0; kt < NKT; ++kt) {
#pragma unroll
                for (int qi = 0; qi < QT; ++qi) st[qi][kt] = (f32x4){0.f, 0.f, 0.f, 0.f};
#pragma unroll
                for (int s = 0; s < KS; ++s) { const bf16x8 kf = *(const LAS bf16x8*)(Kt + (kt * 16 + fr) * KROW + 32 * s + 8 * fq);
#pragma unroll
                    for (int qi = 0; qi < QT; ++qi) st[qi][kt] = mfma16(kf, qf[qi][s], st[qi][kt]); } }
        }
        if (more) { FL_STOREK((j + 1) & 1); FL_LOADV(j + 1); }
        if (act) {
            bf16x8 pf[QT][NKT / 2];
#pragma unroll
            for (int qi = 0; qi < QT; ++qi) {
                float mx = fmaxf(fmaxf(st[qi][0].x, st[qi][0].y), fmaxf(st[qi][0].z, st[qi][0].w));
#pragma unroll
                for (int kt = 1; kt < NKT; ++kt) mx = fmaxf(mx, fmaxf(fmaxf(st[qi][kt].x, st[qi][kt].y), fmaxf(st[qi][kt].z, st[qi][kt].w)));
                mx = fmaxf(mx, __shfl_xor(mx, 16)); mx = fmaxf(mx, __shfl_xor(mx, 32));
                const float m_new = fmaxf(m_run[qi], mx), alpha = fexp2_(m_run[qi] - m_new);
                float ls = 0.f;
#pragma unroll
                for (int kt = 0; kt < NKT; ++kt)
#pragma unroll
                    for (int r = 0; r < 4; ++r) { const float p = fexp2_(st[qi][kt][r] - m_new); st[qi][kt][r] = p; ls += p; }
                l_run[qi] = l_run[qi] * alpha + ls; m_run[qi] = m_new;
#pragma unroll
                for (int e = 0; e < ET; ++e) ot[qi][e] = ot[qi][e] * alpha;
#pragma unroll
                for (int k2 = 0; k2 < NKT / 2; ++k2) pf[qi][k2] = pack8(st[qi][2 * k2], st[qi][2 * k2 + 1]);
            }
#pragma unroll
            for (int e = 0; e < ET; ++e) {
                const LAS bf16_t* vr = Vt + (e * 16 + fr) * VROW + 4 * fq;
#pragma unroll
                for (int k2 = 0; k2 < NKT / 2; ++k2) { const bf16x8 v0 = mk8(*(const LAS u32x2*)(vr + 32 * k2), *(const LAS u32x2*)(vr + 32 * k2 + 16));
#pragma unroll
                    for (int qi = 0; qi < QT; ++qi) ot[qi][e] = mfma16(v0, pf[qi][k2], ot[qi][e]); }
            }
        }
        if (more) FL_STOREV((j + 1) & 1);
        __syncthreads();
    }
#undef FL_LOADK
#undef FL_LOADV
#undef FL_STOREK
#undef FL_STOREV
#pragma unroll
    for (int qi = 0; qi < QT; ++qi) {
        float l = l_run[qi]; l += __shfl_xor(l, 16); l += __shfl_xor(l, 32);
        const float inv = frcp_(l);
#pragma unroll
        for (int e = 0; e < ET; ++e) { u32x2 w; w.x = pk2(ot[qi][e].x * inv, ot[qi][e].y * inv); w.y = pk2(ot[qi][e].z * inv, ot[qi][e].w * inv);
            *(u32x2*)(Ow + (size_t)(qi * 16 + fr) * ldo + e * 16 + 4 * fq) = w; }
    }
}
__device__ __forceinline__ void mla_attn_item(const Params& P, LAS unsigned char* lds, int it, int tid, int wave, int lane) {
    const int qt = 7 - (it >> 6), bh = it & 63;
    const bf16_t* Q = (const bf16_t*)((unsigned char*)P.out + MLA_Q_OFF) + ((size_t)bh * SEQ + qt * 256 + wave * 32) * 96;
    const bf16_t* K = (const bf16_t*)((unsigned char*)P.out + MLA_K_OFF) + (size_t)bh * SEQ * 96;
    const bf16_t* VT = (const bf16_t*)((unsigned char*)P.out + MLA_VT_OFF) + (size_t)bh * NCHUNK * 4096;
    bf16_t* y = (bf16_t*)(P.ws + WS_R + R_Y) + ((size_t)(bh >> 2) * SEQ + qt * 256 + wave * 32) * DM + 512 + (bh & 3) * 64;
    flash_item<96, 64, 64, 2>(lds, Q, 96, K, 96, VT, 64, 4096, y, DM, 4 * qt + 4, 4 * qt + (wave >> 1) + 1, tid, lane);
}
constexpr int XA_KROW = 264, XA_VROW = 72, XA_KBUF = 32 * XA_KROW * 2, XA_VBUF = 128 * XA_VROW * 2, XA_VOFF = 2 * XA_KBUF;
__device__ __forceinline__ void xa_item(const Params& P, int l, LAS unsigned char* lds, int it, int tid, int wave, int lane) {
    const int qt = it & 7, h = (it >> 3) & 3, b = it >> 5, fr = lane & 15, fq = lane >> 4;
    const size_t qoff = ((size_t)b * SEQ + qt * 256 + wave * 32) * DM + h * 256;
    const bf16_t* Q = (const bf16_t*)(P.ws + WS_R) + qoff; bf16_t* O = (bf16_t*)(P.ws + WS_R + R_OX) + qoff;
    const bf16_t* Kb = (const bf16_t*)(P.ws + WS_KVM + (size_t)l * KVM_LAYER) + (size_t)b * NMEM * DM + h * 256;
    const bf16_t* VTb = (const bf16_t*)(P.ws + WS_KVM + (size_t)l * KVM_LAYER + (size_t)4096 * 1024 * 2) + (size_t)h * 256 * 4096 + b * NMEM;
    u32x4 stg[2];
#define XA_LOADK(j_) do { _Pragma("unroll") for (int i = 0; i < 2; ++i) { const int p = tid + 512 * i, row = p >> 5, pc = p & 31; stg[i] = *(const u32x4*)(Kb + (size_t)((j_) * 32 + row) * DM + pc * 8); } } while (0)
#define XA_STOREK(buf_) do { _Pragma("unroll") for (int i = 0; i < 2; ++i) { const int p = tid + 512 * i, row = p >> 5, pc = p & 31; *(LAS u32x4*)(lds + (buf_) * XA_KBUF + (row * XA_KROW + pc * 8) * 2) = stg[i]; } } while (0)
#define XA_LOADV(t_) do { _Pragma("unroll") for (int i = 0; i < 2; ++i) { const int p = tid + 512 * i, row = p >> 3, pc = p & 7; stg[i] = *(const u32x4*)(VTb + (size_t)(((t_) >> 2) * 128 + row) * 4096 + ((t_) & 3) * 64 + pc * 8); } } while (0)
#define XA_STOREV(buf_) do { _Pragma("unroll") for (int i = 0; i < 2; ++i) { const int p = tid + 512 * i, row = p >> 3, pc = p & 7; *(LAS u32x4*)(lds + XA_VOFF + (buf_) * XA_VBUF + (row * XA_VROW + pc * 8) * 2) = stg[i]; } } while (0)
    XA_LOADK(0);
    bf16x8 pf[2][8];
    float linv[2], c1[2];
    {
        bf16x8 qf[2][8];
#pragma unroll
        for (int qi = 0; qi < 2; ++qi)
#pragma unroll
            for (int s = 0; s < 8; ++s) qf[qi][s] = *(const bf16x8*)(Q + (size_t)(qi * 16 + fr) * DM + 32 * s + 8 * fq);
        XA_STOREK(0);
        __syncthreads();
        float m1[2], l1[2];
#pragma unroll
        for (int half = 0; half < 2; ++half) {
            f32x4 S[2][8];
#pragma unroll
            for (int jj = 0; jj < 4; ++jj) { const int j = half * 4 + jj;
                if (j < 7) XA_LOADK(j + 1); else XA_LOADV(0);
                const LAS bf16_t* Kt = (const LAS bf16_t*)(lds + (j & 1) * XA_KBUF);
#pragma unroll
                for (int kt = 0; kt < 2; ++kt) {
                    f32x4 a0 = {0.f, 0.f, 0.f, 0.f}, a1 = {0.f, 0.f, 0.f, 0.f};
#pragma unroll
                    for (int s = 0; s < 8; ++s) { const bf16x8 kf = *(const LAS bf16x8*)(Kt + (kt * 16 + fr) * XA_KROW + 32 * s + 8 * fq); a0 = mfma16(kf, qf[0][s], a0); a1 = mfma16(kf, qf[1][s], a1); }
                    S[0][2 * jj + kt] = a0; S[1][2 * jj + kt] = a1; __builtin_amdgcn_sched_barrier(0); }
                if (j < 7) XA_STOREK((j + 1) & 1); else XA_STOREV(0);
                __syncthreads();
            }
#pragma unroll
            for (int qi = 0; qi < 2; ++qi) {
                float mx = -1e30f;
#pragma unroll
                for (int t = 0; t < 8; ++t) mx = fmaxf(mx, fmaxf(fmaxf(S[qi][t].x, S[qi][t].y), fmaxf(S[qi][t].z, S[qi][t].w)));
                mx = fmaxf(mx, __shfl_xor(mx, 16)); mx = fmaxf(mx, __shfl_xor(mx, 32));
                if (half == 1) { const float m = fmaxf(m1[qi], mx); c1[qi] = fexp2_(m1[qi] - m); mx = m; }
                float ls = 0.f;
#pragma unroll
                for (int t = 0; t < 4; ++t) { f32x4 pa, pb;
#pragma unroll
                    for (int r = 0; r < 4; ++r) { pa[r] = fexp2_(S[qi][2 * t][r] - mx); pb[r] = fexp2_(S[qi][2 * t + 1][r] - mx); }
                    ls += ((pa.x + pa.y) + (pa.z + pa.w)) + ((pb.x + pb.y) + (pb.z + pb.w));
                    pf[qi][half * 4 + t] = pack8(pa, pb);
                    asm volatile("" : "+v"(ls)); }
                ls += __shfl_xor(ls, 16); ls += __shfl_xor(ls, 32);
                if (half == 0) { m1[qi] = mx; l1[qi] = ls; } else linv[qi] = frcp_(l1[qi] * c1[qi] + ls);
            }
        }
    }
#pragma unroll
    for (int eh = 0; eh < 2; ++eh) {
        f32x4 ot[2][8];
#pragma unroll
        for (int qi = 0; qi < 2; ++qi)
#pragma unroll
            for (int e = 0; e < 8; ++e) ot[qi][e] = (f32x4){0.f, 0.f, 0.f, 0.f};
#pragma unroll
        for (int jv = 0; jv < 4; ++jv) { const int t = eh * 4 + jv;
            if (t < 7) XA_LOADV(t + 1);
            const LAS bf16_t* Vt = (const LAS bf16_t*)(lds + XA_VOFF + (t & 1) * XA_VBUF);
#pragma unroll
            for (int e = 0; e < 8; ++e) { const LAS bf16_t* vr = Vt + (e * 16 + fr) * XA_VROW + 4 * fq;
                const bf16x8 v0 = mk8(*(const LAS u32x2*)vr, *(const LAS u32x2*)(vr + 16)), v1 = mk8(*(const LAS u32x2*)(vr + 32), *(const LAS u32x2*)(vr + 48));
                ot[0][e] = mfma16(v0, pf[0][2 * jv], ot[0][e]); ot[1][e] = mfma16(v0, pf[1][2 * jv], ot[1][e]);
                ot[0][e] = mfma16(v1, pf[0][2 * jv + 1], ot[0][e]); ot[1][e] = mfma16(v1, pf[1][2 * jv + 1], ot[1][e]); if (e & 1) __builtin_amdgcn_sched_barrier(0); }
            if (jv == 1) {
#pragma unroll
                for (int e = 0; e < 8; ++e) { ot[0][e] = ot[0][e] * c1[0]; ot[1][e] = ot[1][e] * c1[1]; } }
            if (t < 7) XA_STOREV((t + 1) & 1);
            __syncthreads();
        }
#pragma unroll
        for (int qi = 0; qi < 2; ++qi)
#pragma unroll
            for (int e = 0; e < 8; ++e) { u32x2 w; w.x = pk2(ot[qi][e].x * linv[qi], ot[qi][e].y * linv[qi]); w.y = pk2(ot[qi][e].z * linv[qi], ot[qi][e].w * linv[qi]);
                *(u32x2*)(O + (size_t)(qi * 16 + fr) * DM + eh * 128 + e * 16 + 4 * fq) = w; }
    }
#undef XA_LOADK
#undef XA_STOREK
#undef XA_LOADV
#undef XA_STOREV
}
constexpr int GP_KN = 0, GP_KB = 9216, GP_QN = 18432, GP_L = 9216, GP_RHS = 27648, GP_G = 60416, GP_GC = 60672, GP_HEAD = 61440;
__device__ __forceinline__ bf16_t* gdn_buf(const Params& P, int chh, int k) { return (bf16_t*)(P.ws + WS_GDN) + ((size_t)chh * 5 + k) * 4096; }
__device__ __forceinline__ void gdn_pre_item(const Params& P, int l, LAS unsigned char* lds, int it, int tid) {
    const int hp = it & 1, n = (it >> 1) & 31, b = it >> 6;
    const int hh = tid >> 8, h = 2 * hp + hh, tt = tid & 255, c = tt >> 2, qr = tt & 3, lane = tid & 63;
    LAS unsigned char* L = lds + hh * GP_HEAD;
    const bf16_t* z = (const bf16_t*)(P.ws + WS_R);
    const int s = n * 64 + c; const size_t tok = (size_t)b * SEQ + s;
    const float* cw = P.gdn_conv_w + (size_t)l * 4 * 768;
    const int chh = (b * NCHUNK + n) * 4 + h;
    float q[16], k[16], v[16];
#pragma unroll
    for (int part = 0; part < 3; ++part) {
        float* dst = part == 0 ? q : (part == 1 ? k : v);
        const int ch0 = part * 256 + h * 64 + qr * 16;
#pragma unroll
        for (int i = 0; i < 16; ++i) dst[i] = 0.f;
#pragma unroll
        for (int kk = 0; kk < 4; ++kk) { {
            const bool okk = s - 3 + kk >= 0; const float mk = okk ? 1.f : 0.f;
            const bf16_t* zr = z + (okk ? tok - 3 + kk : tok) * ZP + Z_GQKV + ch0; const u32x4 w0 = *(const u32x4*)zr, w1 = *(const u32x4*)(zr + 8);
            const float* wr = cw + kk * 768 + ch0; const f32x4 c0 = *(const f32x4*)wr * mk, c1 = *(const f32x4*)(wr + 4) * mk, c2 = *(const f32x4*)(wr + 8) * mk, c3 = *(const f32x4*)(wr + 12) * mk;
            dst[0] += c0.x * bflo(w0.x); dst[1] += c0.y * bfhi(w0.x); dst[2] += c0.z * bflo(w0.y); dst[3] += c0.w * bfhi(w0.y);
            dst[4] += c1.x * bflo(w0.z); dst[5] += c1.y * bfhi(w0.z); dst[6] += c1.z * bflo(w0.w); dst[7] += c1.w * bfhi(w0.w);
            dst[8] += c2.x * bflo(w1.x); dst[9] += c2.y * bfhi(w1.x); dst[10] += c2.z * bflo(w1.y); dst[11] += c2.w * bfhi(w1.y);
            dst[12] += c3.x * bflo(w1.z); dst[13] += c3.y * bfhi(w1.z); dst[14] += c3.z * bflo(w1.w); dst[15] += c3.w * bfhi(w1.w); } }
#pragma unroll
        for (int i = 0; i < 16; ++i) dst[i] = siluf_(dst[i]);
    }
    float sq = 0.f, sk = 0.f;
#pragma unroll
    for (int i = 0; i < 16; ++i) { sq += q[i] * q[i]; sk += k[i] * k[i]; }
    sq += __shfl_xor(sq, 1); sq += __shfl_xor(sq, 2); sk += __shfl_xor(sk, 1); sk += __shfl_xor(sk, 2);
    const float rq = frsq_(sq + EPS) * 0.125f, rk = frsq_(sk + EPS);
    const bf16_t* zt = z + tok * ZP;
    const float beta = sigmoidf_(bf2f(zt[Z_GB + h]));
    const float g = -fexp_(P.gdn_a_log[l * 4 + h]) * softplusf_(bf2f(zt[Z_GA + h]) + P.gdn_dt_bias[l * 4 + h]);
    {
        u32x4 w0, w1;
#define PK16(dst0, dst1, src, sc) do { dst0.x = pk2(src[0] * (sc), src[1] * (sc)); dst0.y = pk2(src[2] * (sc), src[3] * (sc)); dst0.z = pk2(src[4] * (sc), src[5] * (sc)); dst0.w = pk2(src[6] * (sc), src[7] * (sc)); \
        dst1.x = pk2(src[8] * (sc), src[9] * (sc)); dst1.y = pk2(src[10] * (sc), src[11] * (sc)); dst1.z = pk2(src[12] * (sc), src[13] * (sc)); dst1.w = pk2(src[14] * (sc), src[15] * (sc)); } while (0)
        PK16(w0, w1, k, rk);        *(LAS u32x4*)(L + GP_KN + (c * 72 + qr * 16) * 2) = w0; *(LAS u32x4*)(L + GP_KN + (c * 72 + qr * 16 + 8) * 2) = w1;
        PK16(w0, w1, k, rk * beta); *(LAS u32x4*)(L + GP_KB + (c * 72 + qr * 16) * 2) = w0; *(LAS u32x4*)(L + GP_KB + (c * 72 + qr * 16 + 8) * 2) = w1;
        PK16(w0, w1, q, rq);        *(LAS u32x4*)(L + GP_QN + (c * 72 + qr * 16) * 2) = w0; *(LAS u32x4*)(L + GP_QN + (c * 72 + qr * 16 + 8) * 2) = w1;
        LAS float* rhs = (LAS float*)(L + GP_RHS) + c * 128 + qr * 16;
#pragma unroll
        for (int i = 0; i < 4; ++i) *(LAS f32x4*)(rhs + 4 * i) = (f32x4){v[4 * i] * beta, v[4 * i + 1] * beta, v[4 * i + 2] * beta, v[4 * i + 3] * beta};
        if (qr == 0) ((LAS float*)(L + GP_G))[c] = g;
    }
    __syncthreads();
    {
        float gc = 0.f, run = 0.f; const LAS float* G = (const LAS float*)(L + GP_G);
        for (int i = 0; i < 64; ++i) { run += G[i]; gc = (i == c) ? run : gc; }
        const float eg = fexp_(gc), ek = fexp_(run - gc);
        LAS float* rhs = (LAS float*)(L + GP_RHS) + c * 128 + 64 + qr * 16;
#pragma unroll
        for (int i = 0; i < 4; ++i) *(LAS f32x4*)(rhs + 4 * i) = (f32x4){k[4 * i] * rk * beta * eg, k[4 * i + 1] * rk * beta * eg, k[4 * i + 2] * rk * beta * eg, k[4 * i + 3] * rk * beta * eg};
        u32x4 w0, w1; PK16(w0, w1, q, rq * eg);
        bf16_t* qd = gdn_buf(P, chh, 3) + c * 64 + qr * 16; *(u32x4*)qd = w0; *(u32x4*)(qd + 8) = w1;
        bf16_t* kdt = gdn_buf(P, chh, 4) + (qr * 16) * 64 + c;
#pragma unroll
        for (int i = 0; i < 16; ++i) kdt[i * 64] = f2bf(k[i] * rk * ek);
        if (qr == 0) ((LAS float*)(L + GP_GC))[c] = gc;
        if (tt == 0) ((float*)(P.ws + WS_GL))[chh] = fexp_(run);
    }
#undef PK16
    __syncthreads();
    {
        const int it4 = (tid >> 6) & 3, fr = lane & 15, fq = lane >> 4;
        const LAS bf16_t* Kn = (const LAS bf16_t*)(L + GP_KN); const LAS bf16_t* KB = (const LAS bf16_t*)(L + GP_KB); const LAS bf16_t* Qn = (const LAS bf16_t*)(L + GP_QN);
        const LAS float* GC = (const LAS float*)(L + GP_GC);
        const bf16x8 a0 = *(const LAS bf16x8*)(KB + (it4 * 16 + fr) * 72 + 8 * fq), a1 = *(const LAS bf16x8*)(KB + (it4 * 16 + fr) * 72 + 32 + 8 * fq);
        const bf16x8 q0 = *(const LAS bf16x8*)(Qn + (it4 * 16 + fr) * 72 + 8 * fq), q1 = *(const LAS bf16x8*)(Qn + (it4 * 16 + fr) * 72 + 32 + 8 * fq);
        float gci[4];
#pragma unroll
        for (int r = 0; r < 4; ++r) gci[r] = GC[it4 * 16 + 4 * fq + r];
        f32x4 lv[4]; bf16_t* att = gdn_buf(P, chh, 2);
#pragma unroll
        for (int jt = 0; jt < 4; ++jt) {
            const bf16x8 b0 = *(const LAS bf16x8*)(Kn + (jt * 16 + fr) * 72 + 8 * fq), b1 = *(const LAS bf16x8*)(Kn + (jt * 16 + fr) * 72 + 32 + 8 * fq);
            f32x4 al = {0.f, 0.f, 0.f, 0.f}, aa = {0.f, 0.f, 0.f, 0.f};
            al = mfma16(a0, b0, al); al = mfma16(a1, b1, al); aa = mfma16(q0, b0, aa); aa = mfma16(q1, b1, aa);
            const int j = jt * 16 + fr; const float gcj = GC[j];
#pragma unroll
            for (int r = 0; r < 4; ++r) { const int i = it4 * 16 + 4 * fq + r; const float dec = fexp_(fminf(gci[r] - gcj, 0.f));
                lv[jt][r] = (i > j) ? al[r] * dec : 0.f; att[i * 64 + j] = f2bf((i >= j) ? aa[r] * dec : 0.f); }
        }
        __syncthreads();
        LAS float* Lm = (LAS float*)(L + GP_L);
#pragma unroll
        for (int jt = 0; jt < 4; ++jt)
#pragma unroll
            for (int r = 0; r < 4; ++r) Lm[(it4 * 16 + 4 * fq + r) * 64 + jt * 16 + fr] = lv[jt][r];
    }
    __syncthreads();
    if (tt < 128) {
        const LAS float* Lm = (const LAS float*)(L + GP_L); const LAS float* rhs = (const LAS float*)(L + GP_RHS) + tt;
        float x[64];
#pragma unroll
        for (int i = 0; i < 64; ++i) {
            float a0 = rhs[i * 128], a1 = 0.f;
#pragma unroll
            for (int j4 = 0; j4 < (i + 3) / 4; ++j4) { const f32x4 lr = *(const LAS f32x4*)(Lm + i * 64 + 4 * j4);
                if (4 * j4 + 0 < i) a0 -= lr.x * x[4 * j4 + 0]; if (4 * j4 + 1 < i) a1 -= lr.y * x[4 * j4 + 1];
                if (4 * j4 + 2 < i) a0 -= lr.z * x[4 * j4 + 2]; if (4 * j4 + 3 < i) a1 -= lr.w * x[4 * j4 + 3]; }
            x[i] = a0 + a1;
        }
        if (tt < 64) { bf16_t* ut = gdn_buf(P, chh, 1) + tt * 64;
#pragma unroll
            for (int g8 = 0; g8 < 8; ++g8) { u32x4 w; w.x = pk2(x[8 * g8], x[8 * g8 + 1]); w.y = pk2(x[8 * g8 + 2], x[8 * g8 + 3]); w.z = pk2(x[8 * g8 + 4], x[8 * g8 + 5]); w.w = pk2(x[8 * g8 + 6], x[8 * g8 + 7]); *(u32x4*)(ut + 8 * g8) = w; }
        } else { bf16_t* wo = gdn_buf(P, chh, 0) + (tt - 64);
#pragma unroll
            for (int i = 0; i < 64; ++i) wo[i * 64] = f2bf(x[i]); }
    }
    __syncthreads();
}

constexpr int GC_W = 0, GC_UT = 9216, GC_ATT = 18432, GC_QD = 27648, GC_KDT = 36864, GC_O = 46080, GC_BH = 62720;
__device__ __forceinline__ bf16x8 lds_perm(const LAS unsigned char* M, int row, int s, int fq) { const LAS unsigned char* p = M + row * 144 + 64 * s + 8 * fq; return mk8(*(const LAS u32x2*)p, *(const LAS u32x2*)(p + 32)); }
__device__ __forceinline__ void gdn_chain_item(const Params& P, int l, LAS unsigned char* lds, int gi, int tid, int wave, int lane) {
    const int q2 = wave >> 2, bh = gi * 2 + q2, eb = wave & 3, b = bh >> 2, h = bh & 3, fr = lane & 15, fq = lane >> 4;
    const bf16_t* z = (const bf16_t*)(P.ws + WS_R); bf16_t* y = (bf16_t*)(P.ws + WS_R + R_Y);
    LAS unsigned char* L = lds + q2 * GC_BH;
    const int tt = tid & 255, ec = tt >> 2, eq = tt & 3;
    float ng[16];
#pragma unroll
    for (int j = 0; j < 16; ++j) ng[j] = P.gdn_norm[l * 64 + eq * 16 + j];
    u32x4 stg[10];
    const bf16_t* src0[2] = { gdn_buf(P, ((gi * 2 >> 2) * NCHUNK) * 4 + ((gi * 2) & 3), 0), gdn_buf(P, (((gi * 2 + 1) >> 2) * NCHUNK) * 4 + ((gi * 2 + 1) & 3), 0) };
#define GC_LOAD(n_) do { _Pragma("unroll") for (int i = 0; i < 10; ++i) { const int p = tid + 512 * i, qq = p / 2560, pp = p % 2560; \
        stg[i] = *(const u32x4*)(src0[qq] + (size_t)(n_) * 4 * 5 * 4096 + (size_t)pp * 8); } } while (0)
#define GC_WRITE() do { _Pragma("unroll") for (int i = 0; i < 10; ++i) { const int p = tid + 512 * i, qq = p / 2560, pp = p % 2560, mat = pp >> 9, row = (pp & 511) >> 3, pc = pp & 7; \
        *(LAS u32x4*)(lds + qq * GC_BH + mat * 9216 + row * 144 + pc * 16) = stg[i]; } } while (0)
    GC_LOAD(0); GC_WRITE();
    f32x4 S[4];
#pragma unroll
    for (int t = 0; t < 4; ++t) S[t] = (f32x4){0.f, 0.f, 0.f, 0.f};
    __syncthreads();
    for (int n = 0; n < NCHUNK; ++n) {
        const int chh = (b * NCHUNK + n) * 4 + h;
        if (n + 1 < NCHUNK) GC_LOAD(n + 1);
        const size_t etok = (size_t)(gi * 2 + (tid >> 8) >> 2) * SEQ + n * 64 + ec; const int eh = (gi * 2 + (tid >> 8)) & 3;
        const u32x4 gw0 = *(const u32x4*)(z + etok * ZP + Z_GG + eh * 64 + eq * 16), gw1 = *(const u32x4*)(z + etok * ZP + Z_GG + eh * 64 + eq * 16 + 8);
        const float egl = ((const float*)(P.ws + WS_GL))[chh];
        const bf16x8 sb0 = pack8(S[0], S[1]), sb1 = pack8(S[2], S[3]);
        f32x4 vn[4], o[4];
#pragma unroll
        for (int ct = 0; ct < 4; ++ct) {
            f32x4 a = {0.f, 0.f, 0.f, 0.f}; a = mfma16(lds_perm(L + GC_W, ct * 16 + fr, 0, fq), sb0, a); a = mfma16(lds_perm(L + GC_W, ct * 16 + fr, 1, fq), sb1, a);
            const u32x2 uw = *(const LAS u32x2*)(L + GC_UT + (eb * 16 + fr) * 144 + (ct * 16 + 4 * fq) * 2);
            vn[ct] = (f32x4){bflo(uw.x) - a.x, bfhi(uw.x) - a.y, bflo(uw.y) - a.z, bfhi(uw.y) - a.w};
            f32x4 oo = {0.f, 0.f, 0.f, 0.f}; oo = mfma16(lds_perm(L + GC_QD, ct * 16 + fr, 0, fq), sb0, oo); oo = mfma16(lds_perm(L + GC_QD, ct * 16 + fr, 1, fq), sb1, oo); o[ct] = oo;
        }
        const bf16x8 vb0 = pack8(vn[0], vn[1]), vb1 = pack8(vn[2], vn[3]);
#pragma unroll
        for (int ct = 0; ct < 4; ++ct) { o[ct] = mfma16(lds_perm(L + GC_ATT, ct * 16 + fr, 0, fq), vb0, o[ct]); o[ct] = mfma16(lds_perm(L + GC_ATT, ct * 16 + fr, 1, fq), vb1, o[ct]); }
#pragma unroll
        for (int dt = 0; dt < 4; ++dt) { f32x4 a = S[dt] * egl; a = mfma16(lds_perm(L + GC_KDT, dt * 16 + fr, 0, fq), vb0, a); a = mfma16(lds_perm(L + GC_KDT, dt * 16 + fr, 1, fq), vb1, a); S[dt] = a; }
        LAS float* Ol = (LAS float*)(L + GC_O);
#pragma unroll
        for (int ct = 0; ct < 4; ++ct)
#pragma unroll
            for (int r = 0; r < 4; ++r) Ol[(ct * 16 + 4 * fq + r) * 65 + eb * 16 + fr] = o[ct][r];
        __syncthreads();
        if (n + 1 < NCHUNK) GC_WRITE();
        {
            const LAS float* orow = (const LAS float*)(lds + (tid >> 8) * GC_BH + GC_O) + ec * 65 + eq * 16;
            float ov[16]; float s2 = 0.f;
#pragma unroll
            for (int j = 0; j < 16; ++j) { ov[j] = orow[j]; s2 += ov[j] * ov[j]; }
            s2 += __shfl_xor(s2, 1); s2 += __shfl_xor(s2, 2);
            const float rs = frsq_(s2 * (1.0f / 64.0f) + EPS);
            const unsigned gws[8] = {gw0.x, gw0.y, gw0.z, gw0.w, gw1.x, gw1.y, gw1.z, gw1.w};
            unsigned ow[8];
#pragma unroll
            for (int j = 0; j < 8; ++j) ow[j] = pk2(ov[2 * j] * rs * ng[2 * j] * siluf_(bflo(gws[j])), ov[2 * j + 1] * rs * ng[2 * j + 1] * siluf_(bfhi(gws[j])));
            bf16_t* yp = y + etok * DM + 768 + eh * 64 + eq * 16;
            *(u32x4*)yp = (u32x4){ow[0], ow[1], ow[2], ow[3]}; *(u32x4*)(yp + 8) = (u32x4){ow[4], ow[5], ow[6], ow[7]};
        }
        __syncthreads();
    }
#undef GC_LOAD
#undef GC_WRITE
}

constexpr int RT_BUF = 36864, RT_Q = 0, RT_K = 9216, RT_KZT = 18432, RT_VT = 27648, RT_P = 73728, RT_ST = 82944, RT_O = 92160;
__device__ __forceinline__ void ret_chain_item(const Params& P, int l, LAS unsigned char* lds, int it, int tid, int wave, int lane) {
    const int b = it >> 2, h = it & 3, fr = lane & 15, fq = lane >> 4;
    const bf16_t* z = (const bf16_t*)(P.ws + WS_R); bf16_t* y = (bf16_t*)(P.ws + WS_R + R_Y);
    LAS bf16_t* Pm = (LAS bf16_t*)(lds + RT_P); LAS bf16_t* ST = (LAS bf16_t*)(lds + RT_ST); LAS float* Of = (LAS float*)(lds + RT_O);
    const float lg = log1pf(-exp2f(-5.0f - (float)h));
    const float cdec = fexp_(64.0f * lg);
    for (int i = tid; i < 64 * 72 / 2; i += 512) ((LAS unsigned*)ST)[i] = 0u;
    const int it4 = wave >> 1, jt0 = 2 * (wave & 1);
    f32x4 S[2] = {{0.f, 0.f, 0.f, 0.f}, {0.f, 0.f, 0.f, 0.f}};
    const int lc = tid >> 3, pg = tid & 7;
    float invf[4];
#pragma unroll
    for (int ii = 0; ii < 4; ++ii) invf[ii] = exp2f(-(float)(4 * pg + ii) * (13.287712379549449f / 32.0f));
    const float zeta = fexp_((63.0f - (float)lc) * lg);
    const f32x4 gn0 = *(const f32x4*)(P.ret_gn + l * 256 + h * 64 + 8 * pg), gn1 = *(const f32x4*)(P.ret_gn + l * 256 + h * 64 + 8 * pg + 4);
    const size_t tok0 = (size_t)b * SEQ + lc;
    u32x2 q1w, q2w, k1w, k2w; u32x4 vw; int posi;
#define RT_LOAD(n_) do { const bf16_t* zr_ = z + (tok0 + (n_) * 64) * ZP; q1w = *(const u32x2*)(zr_ + Z_RQ + h * 64 + 4 * pg); q2w = *(const u32x2*)(zr_ + Z_RQ + h * 64 + 32 + 4 * pg); \
        k1w = *(const u32x2*)(zr_ + Z_RK + h * 64 + 4 * pg); k2w = *(const u32x2*)(zr_ + Z_RK + h * 64 + 32 + 4 * pg); vw = *(const u32x4*)(zr_ + Z_RV + h * 64 + 8 * pg); posi = P.pos[tok0 + (n_) * 64]; } while (0)
#define RT_STAGE(buf_) do { LAS bf16_t* Qs_ = (LAS bf16_t*)(lds + (buf_) * RT_BUF + RT_Q); LAS bf16_t* Ks_ = (LAS bf16_t*)(lds + (buf_) * RT_BUF + RT_K); \
        LAS bf16_t* KzT_ = (LAS bf16_t*)(lds + (buf_) * RT_BUF + RT_KZT); LAS bf16_t* VT_ = (LAS bf16_t*)(lds + (buf_) * RT_BUF + RT_VT); const float pos = (float)posi; \
        const float q1[4] = {bflo(q1w.x), bfhi(q1w.x), bflo(q1w.y), bfhi(q1w.y)}, q2[4] = {bflo(q2w.x), bfhi(q2w.x), bflo(q2w.y), bfhi(q2w.y)}; \
        const float k1[4] = {bflo(k1w.x), bfhi(k1w.x), bflo(k1w.y), bfhi(k1w.y)}, k2[4] = {bflo(k2w.x), bfhi(k2w.x), bflo(k2w.y), bfhi(k2w.y)}; \
        float qa[4], qb[4], ka[4], kb[4]; \
        _Pragma("unroll") for (int ii = 0; ii < 4; ++ii) { float sn, cs; sincos_rev(pos * invf[ii], sn, cs); \
            qa[ii] = (q1[ii] * cs - q2[ii] * sn) * 0.125f; qb[ii] = (q1[ii] * sn + q2[ii] * cs) * 0.125f; ka[ii] = k1[ii] * cs - k2[ii] * sn; kb[ii] = k1[ii] * sn + k2[ii] * cs; } \
        u32x2 w_; w_.x = pk2(qa[0], qa[1]); w_.y = pk2(qa[2], qa[3]); *(LAS u32x2*)(Qs_ + lc * 72 + 4 * pg) = w_; \
        w_.x = pk2(qb[0], qb[1]); w_.y = pk2(qb[2], qb[3]); *(LAS u32x2*)(Qs_ + lc * 72 + 32 + 4 * pg) = w_; \
        w_.x = pk2(ka[0], ka[1]); w_.y = pk2(ka[2], ka[3]); *(LAS u32x2*)(Ks_ + lc * 72 + 4 * pg) = w_; \
        w_.x = pk2(kb[0], kb[1]); w_.y = pk2(kb[2], kb[3]); *(LAS u32x2*)(Ks_ + lc * 72 + 32 + 4 * pg) = w_; \
        _Pragma("unroll") for (int ii = 0; ii < 4; ++ii) { KzT_[(4 * pg + ii) * 72 + lc] = f2bf(ka[ii] * zeta); KzT_[(32 + 4 * pg + ii) * 72 + lc] = f2bf(kb[ii] * zeta); } \
        const unsigned vv[4] = {vw.x, vw.y, vw.z, vw.w}; \
        _Pragma("unroll") for (int ii = 0; ii < 4; ++ii) { VT_[(8 * pg + 2 * ii) * 72 + lc] = (bf16_t)(vv[ii] & 0xffffu); VT_[(8 * pg + 2 * ii + 1) * 72 + lc] = (bf16_t)(vv[ii] >> 16); } } while (0)
    RT_LOAD(0); RT_STAGE(0);
    __syncthreads();
    for (int n = 0; n < NCHUNK; ++n) {
        const int cb = n & 1;
        const LAS bf16_t* Qs = (const LAS bf16_t*)(lds + cb * RT_BUF + RT_Q); const LAS bf16_t* Ks = (const LAS bf16_t*)(lds + cb * RT_BUF + RT_K);
        const LAS bf16_t* KzT = (const LAS bf16_t*)(lds + cb * RT_BUF + RT_KZT); const LAS bf16_t* VT = (const LAS bf16_t*)(lds + cb * RT_BUF + RT_VT);
        const size_t tok = tok0 + n * 64;
        if (n + 1 < NCHUNK) RT_LOAD(n + 1);
        const u32x4 gw = *(const u32x4*)(z + tok * ZP + Z_RG + h * 64 + 8 * pg);
        const bf16x8 a0 = *(const LAS bf16x8*)(Qs + (it4 * 16 + fr) * 72 + 8 * fq), a1 = *(const LAS bf16x8*)(Qs + (it4 * 16 + fr) * 72 + 32 + 8 * fq);
        f32x4 cross[2];
#pragma unroll
        for (int t = 0; t < 2; ++t) { const int jt = jt0 + t;
            f32x4 p = {0.f, 0.f, 0.f, 0.f};
            p = mfma16(a0, *(const LAS bf16x8*)(Ks + (jt * 16 + fr) * 72 + 8 * fq), p); p = mfma16(a1, *(const LAS bf16x8*)(Ks + (jt * 16 + fr) * 72 + 32 + 8 * fq), p);
            f32x4 cr = {0.f, 0.f, 0.f, 0.f};
            cr = mfma16(a0, *(const LAS bf16x8*)(ST + (jt * 16 + fr) * 72 + 8 * fq), cr); cr = mfma16(a1, *(const LAS bf16x8*)(ST + (jt * 16 + fr) * 72 + 32 + 8 * fq), cr);
#pragma unroll
            for (int r = 0; r < 4; ++r) { const int i = it4 * 16 + 4 * fq + r, j = jt * 16 + fr; const int dd = i > j ? i - j : j - i;
                Pm[i * 72 + j] = f2bf(p[r] * fexp_((float)dd * lg)); cr[r] *= fexp_((float)(i + 1) * lg); }
            cross[t] = cr; }
        __syncthreads();
        const bf16x8 p0 = *(const LAS bf16x8*)(Pm + (it4 * 16 + fr) * 72 + 8 * fq), p1 = *(const LAS bf16x8*)(Pm + (it4 * 16 + fr) * 72 + 32 + 8 * fq);
        const bf16x8 kz0 = *(const LAS bf16x8*)(KzT + (it4 * 16 + fr) * 72 + 8 * fq), kz1 = *(const LAS bf16x8*)(KzT + (it4 * 16 + fr) * 72 + 32 + 8 * fq);
#pragma unroll
        for (int t = 0; t < 2; ++t) { const int et = jt0 + t;
            const bf16x8 v0 = *(const LAS bf16x8*)(VT + (et * 16 + fr) * 72 + 8 * fq), v1 = *(const LAS bf16x8*)(VT + (et * 16 + fr) * 72 + 32 + 8 * fq);
            f32x4 o = cross[t]; o = mfma16(p0, v0, o); o = mfma16(p1, v1, o);
#pragma unroll
            for (int r = 0; r < 4; ++r) Of[(it4 * 16 + 4 * fq + r) * 65 + et * 16 + fr] = o[r];
            f32x4 sN = S[t] * cdec; sN = mfma16(kz0, v0, sN); sN = mfma16(kz1, v1, sN); S[t] = sN;
            u32x2 w; w.x = pk2(sN.x, sN.y); w.y = pk2(sN.z, sN.w); *(LAS u32x2*)(ST + (et * 16 + fr) * 72 + it4 * 16 + 4 * fq) = w; }
        if (n + 1 < NCHUNK) RT_STAGE(cb ^ 1);
        __syncthreads();
        {
            float ov[8]; float sm = 0.f;
#pragma unroll
            for (int j = 0; j < 8; ++j) { ov[j] = Of[lc * 65 + 8 * pg + j]; sm += ov[j]; }
            sm += __shfl_xor(sm, 1); sm += __shfl_xor(sm, 2); sm += __shfl_xor(sm, 4);
            const float mu = sm * (1.0f / 64.0f); float vs = 0.f;
#pragma unroll
            for (int j = 0; j < 8; ++j) { ov[j] -= mu; vs += ov[j] * ov[j]; }
            vs += __shfl_xor(vs, 1); vs += __shfl_xor(vs, 2); vs += __shfl_xor(vs, 4);
            const float rs = frsq_(vs * (1.0f / 64.0f) + EPS);
            const float gt[8] = {bflo(gw.x), bfhi(gw.x), bflo(gw.y), bfhi(gw.y), bflo(gw.z), bfhi(gw.z), bflo(gw.w), bfhi(gw.w)};
            const float gnv[8] = {gn0.x, gn0.y, gn0.z, gn0.w, gn1.x, gn1.y, gn1.z, gn1.w};
            float r8[8];
#pragma unroll
            for (int j = 0; j < 8; ++j) r8[j] = ov[j] * rs * gnv[j] * siluf_(gt[j]);
            u32x4 w; w.x = pk2(r8[0], r8[1]); w.y = pk2(r8[2], r8[3]); w.z = pk2(r8[4], r8[5]); w.w = pk2(r8[6], r8[7]);
            *(u32x4*)(y + tok * DM + h * 64 + 8 * pg) = w;
        }
    }
#undef RT_LOAD
#undef RT_STAGE
    __syncthreads();
}

constexpr int LR_XC = 0, LR_AU = 33792;
__device__ __forceinline__ void lru_item(const Params& P, int l, LAS unsigned char* lds, int it, int mode, int tid, int wave, int lane) {
    const int b = it >> 5, n = it & 31, fr = lane & 15, fq = lane >> 4;
    const bf16_t* z = (const bf16_t*)(P.ws + WS_R); bf16_t* y = (bf16_t*)(P.ws + WS_R + R_Y);
    LAS bf16_t* XC = (LAS bf16_t*)(lds + LR_XC); LAS f32x2* AU = (LAS f32x2*)(lds + LR_AU);
    float* sumA = (float*)(P.ws + WS_LRUS); float* sumH = sumA + 16 * 32 * 256;
    {
        const int c = tid >> 3, cg = tid & 7, s = n * 64 + c; const size_t tok = (size_t)b * SEQ + s;
        const float* cw = P.lru_conv_w + (size_t)l * 4 * 256; const float* cb = P.lru_conv_b + l * 256;
#pragma unroll
        for (int g = 0; g < 4; ++g) { const int ch0 = cg * 32 + g * 8;
            const f32x4 b0 = *(const f32x4*)(cb + ch0), b1 = *(const f32x4*)(cb + ch0 + 4);
            float a[8] = {b0.x, b0.y, b0.z, b0.w, b1.x, b1.y, b1.z, b1.w};
#pragma unroll
            for (int kk = 0; kk < 4; ++kk) { const bool okk = s - 3 + kk >= 0; const float mk = okk ? 1.f : 0.f;
                const u32x4 w = *(const u32x4*)(z + (okk ? tok - 3 + kk : tok) * ZP + Z_LX + ch0);
                const f32x4 c0 = *(const f32x4*)(cw + kk * 256 + ch0) * mk, c1 = *(const f32x4*)(cw + kk * 256 + ch0 + 4) * mk;
                a[0] += c0.x * bflo(w.x); a[1] += c0.y * bfhi(w.x); a[2] += c0.z * bflo(w.y); a[3] += c0.w * bfhi(w.y);
                a[4] += c1.x * bflo(w.z); a[5] += c1.y * bfhi(w.z); a[6] += c1.z * bflo(w.w); a[7] += c1.w * bfhi(w.w); }
            u32x4 o; o.x = pk2(a[0], a[1]); o.y = pk2(a[2], a[3]); o.z = pk2(a[4], a[5]); o.w = pk2(a[6], a[7]);
            *(LAS u32x4*)(XC + c * 264 + ch0) = o; }
    }
    float hcar = 0.f, aprod = 1.f;
    if (mode == 1 && tid < 256) {
        float av[32], hv[32];
#pragma unroll
        for (int m = 0; m < 32; ++m) { const int mm = m < n ? m : 0; av[m] = sumA[(b * 32 + mm) * 256 + tid]; hv[m] = sumH[(b * 32 + mm) * 256 + tid]; }
#pragma unroll
        for (int m = 0; m < 32; ++m) if (m < n) hcar = av[m] * hcar + hv[m];
    }
    const int nb = wave >> 1, rt = wave & 1;
    const bf16_t* wa = wl(P, l, W_A) + nb * 4096; const bf16_t* wx = wl(P, l, W_X) + nb * 4096;
    bf16x8 fa[4][2], fx[4][2]; float ba[4], bx[4], spl[4];
#pragma unroll
    for (int dt = 0; dt < 4; ++dt) {
#pragma unroll
        for (int s = 0; s < 2; ++s) { fa[dt][s] = *(const bf16x8*)(wa + (dt * 16 + fr) * 64 + 32 * s + 8 * fq); fx[dt][s] = *(const bf16x8*)(wx + (dt * 16 + fr) * 64 + 32 * s + 8 * fq); }
        const int d = nb * 64 + dt * 16 + fr; ba[dt] = P.lru_ba[l * 256 + d]; bx[dt] = P.lru_bx[l * 256 + d]; spl[dt] = -8.0f * softplusf_(-P.lru_lambda[l * 256 + d]); }
    __syncthreads();
    for (int half = 0; half < 2; ++half) {
        const int trow = half * 32 + rt * 16;
        const bf16x8 x0 = *(const LAS bf16x8*)(XC + (trow + fr) * 264 + nb * 64 + 8 * fq), x1 = *(const LAS bf16x8*)(XC + (trow + fr) * 264 + nb * 64 + 32 + 8 * fq);
#pragma unroll
        for (int dt = 0; dt < 4; ++dt) {
            f32x4 ar = {0.f, 0.f, 0.f, 0.f}, ai = {0.f, 0.f, 0.f, 0.f};
            ar = mfma16(x0, fa[dt][0], ar); ar = mfma16(x1, fa[dt][1], ar); ai = mfma16(x0, fx[dt][0], ai); ai = mfma16(x1, fx[dt][1], ai);
            const int d = nb * 64 + dt * 16 + fr;
#pragma unroll
            for (int r = 0; r < 4; ++r) { const int tl = rt * 16 + 4 * fq + r;
                const float xcv = bf2f(XC[(half * 32 + tl) * 264 + d]);
                const float rr = sigmoidf_(ar[r] + ba[dt]), ii = sigmoidf_(ai[r] + bx[dt]);
                const float a = fexp_(rr * spl[dt]);
                const float u = fsqrt_(fmaxf(1.0f - a * a, 0.f)) * (ii * xcv);
                AU[tl * 257 + d] = (f32x2){a, u}; }
        }
        __syncthreads();
        if (tid < 256) {
#pragma unroll 8
            for (int tk = 0; tk < 32; ++tk) { const f32x2 au = AU[tk * 257 + tid]; hcar = au.x * hcar + au.y; aprod *= au.x; if (mode == 1) AU[tk * 257 + tid].y = hcar; }
        }
        if (mode == 1) {
            __syncthreads();
            const int tk = tid >> 4, c0 = (tid & 15) * 16; const size_t tok = (size_t)b * SEQ + n * 64 + half * 32 + tk;
            const u32x4 g0 = *(const u32x4*)(z + tok * ZP + Z_LG + c0), g1 = *(const u32x4*)(z + tok * ZP + Z_LG + c0 + 8);
            const unsigned gws[8] = {g0.x, g0.y, g0.z, g0.w, g1.x, g1.y, g1.z, g1.w}; unsigned ow[8];
#pragma unroll
            for (int j = 0; j < 8; ++j) { const float h0 = AU[tk * 257 + c0 + 2 * j].y, h1 = AU[tk * 257 + c0 + 2 * j + 1].y; ow[j] = pk2(h0 * geluf_(bflo(gws[j])), h1 * geluf_(bfhi(gws[j]))); }
            bf16_t* yp = y + tok * DM + 256 + c0;
            *(u32x4*)yp = (u32x4){ow[0], ow[1], ow[2], ow[3]}; *(u32x4*)(yp + 8) = (u32x4){ow[4], ow[5], ow[6], ow[7]};
        }
        __syncthreads();
    }
    if (mode == 0 && tid < 256) { sumA[(b * 32 + n) * 256 + tid] = aprod; sumH[(b * 32 + n) * 256 + tid] = hcar; }
}

constexpr int LC_XC = 0, LC_AU = 9216;
__device__ __forceinline__ void lru_chain_item(const Params& P, int l, LAS unsigned char* lds, int it, int tid, int wave, int lane) {
    const int b = it >> 2, nb = it & 3, fr = lane & 15, fq = lane >> 4;
    const bf16_t* z = (const bf16_t*)(P.ws + WS_R); bf16_t* y = (bf16_t*)(P.ws + WS_R + R_Y);
    LAS bf16_t* XC = (LAS bf16_t*)(lds + LC_XC); LAS f32x2* AU = (LAS f32x2*)(lds + LC_AU);
    const int c = tid >> 3, cg = tid & 7, ch0 = nb * 64 + cg * 8;
    f32x4 cw0[4], cw1[4];
#pragma unroll
    for (int kk = 0; kk < 4; ++kk) { cw0[kk] = *(const f32x4*)(P.lru_conv_w + (size_t)l * 1024 + kk * 256 + ch0); cw1[kk] = *(const f32x4*)(P.lru_conv_w + (size_t)l * 1024 + kk * 256 + ch0 + 4); }
    const f32x4 cb0 = *(const f32x4*)(P.lru_conv_b + l * 256 + ch0), cb1 = *(const f32x4*)(P.lru_conv_b + l * 256 + ch0 + 4);
    const int rt = wave >> 1, dt0 = (wave & 1) * 2;
    const bf16_t* wa = wl(P, l, W_A) + nb * 4096; const bf16_t* wx = wl(P, l, W_X) + nb * 4096;
    bf16x8 fa[2][2], fx[2][2]; float ba[2], bx[2], spl[2];
#pragma unroll
    for (int t = 0; t < 2; ++t) {
#pragma unroll
        for (int s = 0; s < 2; ++s) { fa[t][s] = *(const bf16x8*)(wa + ((dt0 + t) * 16 + fr) * 64 + 32 * s + 8 * fq); fx[t][s] = *(const bf16x8*)(wx + ((dt0 + t) * 16 + fr) * 64 + 32 * s + 8 * fq); }
        const int d = nb * 64 + (dt0 + t) * 16 + fr; ba[t] = P.lru_ba[l * 256 + d]; bx[t] = P.lru_bx[l * 256 + d]; spl[t] = -8.0f * softplusf_(-P.lru_lambda[l * 256 + d]); }
    const size_t tok0 = (size_t)b * SEQ + c;
    u32x4 xr[4], gr;
#define LC_LOAD(n_) do { const size_t t_ = tok0 + (size_t)(n_) * 64; _Pragma("unroll") for (int kk = 0; kk < 4; ++kk) { const bool ok_ = (n_) * 64 + c - 3 + kk >= 0; \
        xr[kk] = *(const u32x4*)(z + (ok_ ? t_ - 3 + kk : t_) * ZP + Z_LX + ch0); } gr = *(const u32x4*)(z + t_ * ZP + Z_LG + ch0); } while (0)
    LC_LOAD(0);
    float hcar = 0.f;
    for (int n = 0; n < NCHUNK; ++n) {
        {
            float a[8] = {cb0.x, cb0.y, cb0.z, cb0.w, cb1.x, cb1.y, cb1.z, cb1.w};
#pragma unroll
            for (int kk = 0; kk < 4; ++kk) { const float mk = (n * 64 + c - 3 + kk >= 0) ? 1.f : 0.f; const f32x4 c0 = cw0[kk] * mk, c1 = cw1[kk] * mk; const u32x4 w = xr[kk];
                a[0] += c0.x * bflo(w.x); a[1] += c0.y * bfhi(w.x); a[2] += c0.z * bflo(w.y); a[3] += c0.w * bfhi(w.y);
                a[4] += c1.x * bflo(w.z); a[5] += c1.y * bfhi(w.z); a[6] += c1.z * bflo(w.w); a[7] += c1.w * bfhi(w.w); }
            u32x4 o; o.x = pk2(a[0], a[1]); o.y = pk2(a[2], a[3]); o.z = pk2(a[4], a[5]); o.w = pk2(a[6], a[7]);
            *(LAS u32x4*)(XC + c * 72 + cg * 8) = o;
        }
        const u32x4 gcur = gr;
        if (n + 1 < NCHUNK) LC_LOAD(n + 1);
        __syncthreads();
        {
            const bf16x8 x0 = *(const LAS bf16x8*)(XC + (rt * 16 + fr) * 72 + 8 * fq), x1 = *(const LAS bf16x8*)(XC + (rt * 16 + fr) * 72 + 32 + 8 * fq);
#pragma unroll
            for (int t = 0; t < 2; ++t) {
                f32x4 ar = {0.f, 0.f, 0.f, 0.f}, ai = {0.f, 0.f, 0.f, 0.f};
                ar = mfma16(x0, fa[t][0], ar); ar = mfma16(x1, fa[t][1], ar); ai = mfma16(x0, fx[t][0], ai); ai = mfma16(x1, fx[t][1], ai);
                const int dl = (dt0 + t) * 16 + fr;
#pragma unroll
                for (int r = 0; r < 4; ++r) { const int tl = rt * 16 + 4 * fq + r;
                    const float xcv = bf2f(XC[tl * 72 + dl]);
                    const float rr = sigmoidf_(ar[r] + ba[t]), ii = sigmoidf_(ai[r] + bx[t]);
                    const float av = fexp_(rr * spl[t]);
                    AU[tl * 65 + dl] = (f32x2){av, fsqrt_(fmaxf(1.0f - av * av, 0.f)) * (ii * xcv)}; }
            }
        }
        __syncthreads();
        if (tid < 64) {
#pragma unroll
            for (int blk = 0; blk < 4; ++blk) { f32x2 au[16];
#pragma unroll
                for (int k = 0; k < 16; ++k) au[k] = AU[(blk * 16 + k) * 65 + tid];
#pragma unroll
                for (int k = 0; k < 16; ++k) { hcar = au[k].x * hcar + au[k].y; au[k].y = hcar; }
#pragma unroll
                for (int k = 0; k < 16; ++k) AU[(blk * 16 + k) * 65 + tid].y = au[k].y; }
        }
        __syncthreads();
        {
            const unsigned gws[4] = {gcur.x, gcur.y, gcur.z, gcur.w}; unsigned ow[4];
#pragma unroll
            for (int j = 0; j < 4; ++j) ow[j] = pk2(AU[c * 65 + cg * 8 + 2 * j].y * geluf_(bflo(gws[j])), AU[c * 65 + cg * 8 + 2 * j + 1].y * geluf_(bfhi(gws[j])));
            *(u32x4*)(y + (tok0 + (size_t)n * 64) * DM + 256 + ch0) = (u32x4){ow[0], ow[1], ow[2], ow[3]};
        }
    }
#undef LC_LOAD
    __syncthreads();
}

constexpr int N_PHASES = 21;
constexpr int Q_RET = 64, Q_GDN = 32, Q_LRU = 64, Q_MLA = 512, Q_TOTAL = Q_RET + Q_GDN + Q_LRU + Q_MLA;

__global__ void __launch_bounds__(512, 2) hymba_fwd(Params P_) {
    extern __shared__ __attribute__((aligned(16))) unsigned char lds_raw[];
    LAS unsigned char* lds = (LAS unsigned char*)lds_raw;
    volatile LAS unsigned* LC = (volatile LAS unsigned*)(lds + LDS_CTL);
    const int G = gridDim.x;
#define SUB_TID() int tid2 = tid; asm volatile("" : "+v"(tid2)); const int lane2 = tid2 & 63, wave2 = __builtin_amdgcn_readfirstlane(tid2 >> 6); (void)lane2; (void)wave2
#if defined(__HIP_DEVICE_COMPILE__)
#define PH_PARAMS() const __attribute__((address_space(4))) Params* pp_ = (const __attribute__((address_space(4))) Params*)__builtin_amdgcn_kernarg_segment_ptr(); asm volatile("" : "+s"(pp_)); const Params P = *pp_
#else
#define PH_PARAMS() const Params P = P_
#endif
#define PH_TID() PH_PARAMS(); \
    bf16_t* xb = (bf16_t*)(P.ws + WS_XB); float* part = (float*)(P.ws + WS_PART); bf16_t* zb = (bf16_t*)(P.ws + WS_R); bf16_t* yb = (bf16_t*)(P.ws + WS_R + R_Y); bf16_t* oxb = (bf16_t*)(P.ws + WS_R + R_OX); (void)xb; (void)part; (void)zb; (void)yb; (void)oxb; \
    int tid = threadIdx.x; asm volatile("" : "+v"(tid)); const int lane = tid & 63, wave = __builtin_amdgcn_readfirstlane(tid >> 6); (void)lane; (void)wave
    unsigned* ctl = (unsigned*)(P_.ws + WS_CTL);
    if (threadIdx.x < 64) LC[threadIdx.x] = 0u;
    __syncthreads();
    const int lo = P_.ph_lo, hi = P_.ph_hi;
    XcdBarrier bar; bar.bar = ctl + CW_BAR; bar.x = 0; bar.st = LC;
    if (hi - lo > 1) bar = xcd_barrier_post(ctl + CW_BAR, LC);
#ifndef PHASE_MASK
#define PHASE_MASK 0xFFFFFFFFu
#endif
#define EN(t) ((PHASE_MASK >> (t)) & 1u)
#ifndef REPEAT_MASK
#define REPEAT_MASK 0u
#endif
#define REP(t) for (int rep_ = 0; rep_ <= (int)((REPEAT_MASK >> (t)) & 1u); ++rep_, (rep_ <= (int)((REPEAT_MASK >> (t)) & 1u) ? xcd_barrier(bar) : (void)0))
#define IN(k) (lo <= (k) && (k) < hi)
#define SEAM(k) do { if (IN(k) && IN((k) + 1)) xcd_barrier(bar); } while (0)


    if (IN(0) && EN(0)) REP(0) { PH_TID(); p0_prologue(P, lds, tid); __syncthreads(); }
    SEAM(0);
    if (IN(1) && EN(1)) REP(1) {
        PH_TID();
        const int which = blockIdx.x >> 6, l = which >> 1, isv = which & 1;
        if (which < 4) {
            const bf16_t* memn = (const bf16_t*)(P.ws + WS_GDN); const bf16_t* wkv = wl(P, l, W_KV);
            bf16_t* kout = (bf16_t*)(P.ws + WS_KVM + (size_t)l * KVM_LAYER); bf16_t* vout = kout + (size_t)4096 * 1024;
            pg8::Gemm g; pg8::EpiScaleBf16<0> E; pg8::StaticOrder S;
            if (!isv) { g = pg8::Gemm{memn, wkv, 4096, 1024, 1024}; E = pg8::EpiScaleBf16<0>{kout, 1024, nullptr}; S.init(4096, 1024, 64, blockIdx.x & 63); }
            else { g = pg8::Gemm{wkv + (size_t)1024 * 1024, memn, 1024, 4096, 1024}; E = pg8::EpiScaleBf16<0>{vout, 4096, nullptr}; S.init(1024, 4096, 64, blockIdx.x & 63); }
            pg8::gemm_phase(lds, g, S, E, tid);
        }
    }
    SEAM(1);
#pragma unroll
    for (int l = 0; l < 2; ++l) {
        const int pb = 2 + 9 * l;
        if (IN(pb + 0) && EN(2)) REP(2) { PH_TID();
            pg8::Gemm g{xb, wl(P, l, W_IN), T_TOK, ZP, DM}; pg8::StaticOrder S; S.init(T_TOK, ZP, G, blockIdx.x);
            pg8::EpiScaleBf16<0> E{zb, ZP, part}; pg8::gemm_phase(lds, g, S, E, tid);
        }
        SEAM(pb + 0);
        if (IN(pb + 1)) {
            PH_TID();
            if (EN(3)) REP(3) { SUB_TID();
_Pragma("unroll 1")
            for (int it = blockIdx.x; it < 1024; it += G) gdn_pre_item(P, l, lds, it, tid2); }
            if (EN(5)) REP(5) { SUB_TID();
_Pragma("unroll 1")
            for (int it = blockIdx.x; it < 256; it += G) mla_pre_item(P, l, lds, it, tid2, wave2, lane2); }
        }
        SEAM(pb + 1);
        if (IN(pb + 2)) {
            PH_TID();
            for (int rep2_ = 0; rep2_ <= (int)((REPEAT_MASK >> 17) & 1u); ++rep2_, (rep2_ <= (int)((REPEAT_MASK >> 17) & 1u) ? xcd_barrier(bar) : (void)0)) {
            unsigned* qh0 = ctl + CW_QUEUE + 64 * l + 16 * rep2_;
#define QUEUE_LOOP(qi_, count_, body_) for (;;) { if (tid == 0) LC[4] = __hip_atomic_fetch_add(qh + (qi_), 1u, __ATOMIC_RELAXED, __HIP_MEMORY_SCOPE_AGENT); \
                __syncthreads(); const int it = (int)LC[4]; __syncthreads(); if (it >= (count_)) break; { SUB_TID(); body_; } __syncthreads(); }
            if (EN(6)) REP(6) { unsigned* qh = qh0 + 32 * rep_; QUEUE_LOOP(0, Q_RET, ret_chain_item(P, l, lds, it, tid2, wave2, lane2)) }
            if (EN(7)) REP(7) { unsigned* qh = qh0 + 32 * rep_; QUEUE_LOOP(1, Q_GDN, gdn_chain_item(P, l, lds, it, tid2, wave2, lane2)) }
            if (EN(8)) REP(8) { unsigned* qh = qh0 + 32 * rep_; QUEUE_LOOP(2, Q_LRU, lru_chain_item(P, l, lds, it, tid2, wave2, lane2)) }
            if (EN(9)) REP(9) { unsigned* qh = qh0 + 32 * rep_; QUEUE_LOOP(3, Q_MLA, mla_attn_item(P, lds, it, tid2, wave2, lane2)) }
#undef QUEUE_LOOP
            }
        }
        SEAM(pb + 2);
        if (IN(pb + 3) && EN(10)) REP(10) { PH_TID();
            pg8::Gemm g{yb, wl(P, l, W_OUT), T_TOK, DM, DM}; pg8::StaticOrder S; S.init(T_TOK, DM, G, blockIdx.x);
            pg8::EpiResid E{xb, part, rep_ ? 0.f : 1.f}; pg8::gemm_phase(lds, g, S, E, tid);
        }
        SEAM(pb + 3);
        if (IN(pb + 4) && EN(11)) REP(11) { PH_TID();
            pg8::Gemm g{xb, wl(P, l, W_Q), T_TOK, DM, DM}; pg8::StaticOrder S; S.init(T_TOK, DM, G, blockIdx.x);
            pg8::EpiScaleBf16<0> E{zb, DM, part}; pg8::gemm_phase(lds, g, S, E, tid);
        }
        SEAM(pb + 4);
        if (IN(pb + 5) && EN(12)) REP(12) { PH_TID();
_Pragma("unroll 1")
            for (int it = blockIdx.x; it < 512; it += G) { SUB_TID(); xa_item(P, l, lds, it, tid2, wave2, lane2); __syncthreads(); } }
        SEAM(pb + 5);
        if (IN(pb + 6) && EN(13)) REP(13) { PH_TID();
            pg8::Gemm g{oxb, wl(P, l, W_O), T_TOK, DM, DM}; pg8::StaticOrder S; S.init(T_TOK, DM, G, blockIdx.x);
            pg8::EpiResid E{xb, part, rep_ ? 0.f : 1.f}; pg8::gemm_phase(lds, g, S, E, tid);
        }
        SEAM(pb + 6);
        if (IN(pb + 7) && EN(14)) REP(14) { PH_TID();
            pg8::Gemm g{xb, wl(P, l, W_1), T_TOK, DFF, DM}; pg8::StaticOrder S; S.init(T_TOK, DFF, G, blockIdx.x);
            pg8::EpiScaleBf16<1> E{zb, DFF, part}; pg8::gemm_phase(lds, g, S, E, tid);
        }
        SEAM(pb + 7);
        if (IN(pb + 8) && EN(15)) REP(15) { PH_TID();
            pg8::Gemm g{zb, wl(P, l, W_2), T_TOK, DM, DFF}; pg8::StaticOrder S; S.init(T_TOK, DM, G, blockIdx.x);
            pg8::EpiResid E{xb, part, rep_ ? 0.f : 1.f}; pg8::gemm_phase(lds, g, S, E, tid);
        }
        SEAM(pb + 8);
    }
    if (IN(20) && EN(16)) { PH_TID(); final_norm_phase(P, tid); }
#undef IN
#undef SEAM
}

extern "C" void kernel_launch(void* const* d_in, const int* in_sizes, int n_in, void* d_out, int out_size, void* d_ws, size_t ws_size, hipStream_t stream) {
    static int grid = 0;
    if (grid == 0) {
        if (n_in != 31 || out_size != T_TOK * DM || ws_size < WS_END) { fprintf(stderr, "kernel_launch: unexpected shapes (n_in %d out %d ws %zu, need %zu)\n", n_in, out_size, ws_size, (size_t)WS_END); grid = -1; return; }
        if (hipFuncSetAttribute((const void*)hymba_fwd, hipFuncAttributeMaxDynamicSharedMemorySize, LDS_BYTES) != hipSuccess) { fprintf(stderr, "kernel_launch: hipFuncSetAttribute failed\n"); grid = -1; return; }
        int dev = 0, cus = 0, per_cu = 0;
        (void)hipGetDevice(&dev); (void)hipDeviceGetAttribute(&cus, hipDeviceAttributeMultiprocessorCount, dev);
        (void)hipOccupancyMaxActiveBlocksPerMultiprocessor(&per_cu, (const void*)hymba_fwd, 512, LDS_BYTES);
        (void)hipGetLastError();
        if (cus != 256 || per_cu < 1) fprintf(stderr, "kernel_launch: note: cus %d per_cu %d\n", cus, per_cu);
        grid = 256;
    }
    if (grid < 0) return;
    (void)hipMemsetAsync((char*)d_ws + WS_CTL, 0, CTL_BYTES, stream);
    Params p{};
    p.x = (const float*)d_in[0]; p.mem = (const float*)d_in[1]; p.pos = (const int*)d_in[2];
    p.norm_mix = (const float*)d_in[3]; p.w_in = (const float*)d_in[4]; p.ret_gn = (const float*)d_in[5];
    p.lru_conv_w = (const float*)d_in[6]; p.lru_conv_b = (const float*)d_in[7]; p.lru_wa = (const float*)d_in[8]; p.lru_ba = (const float*)d_in[9];
    p.lru_wx = (const float*)d_in[10]; p.lru_bx = (const float*)d_in[11]; p.lru_lambda = (const float*)d_in[12];
    p.mla_q_norm = (const float*)d_in[13]; p.mla_w_uq = (const float*)d_in[14]; p.mla_kv_norm = (const float*)d_in[15]; p.mla_w_ukv = (const float*)d_in[16];
    p.gdn_conv_w = (const float*)d_in[17]; p.gdn_a_log = (const float*)d_in[18]; p.gdn_dt_bias = (const float*)d_in[19]; p.gdn_norm = (const float*)d_in[20];
    p.w_out = (const float*)d_in[21]; p.norm_xattn = (const float*)d_in[22]; p.norm_mem = (const float*)d_in[23];
    p.xa_wq = (const float*)d_in[24]; p.xa_wkv = (const float*)d_in[25]; p.xa_wo = (const float*)d_in[26];
    p.norm_mlp = (const float*)d_in[27]; p.mlp_w1 = (const float*)d_in[28]; p.mlp_w2 = (const float*)d_in[29]; p.final_norm = (const float*)d_in[30];
    p.out = (float*)d_out; p.ws = (unsigned char*)d_ws;
#if N_LAUNCHES == 1
    p.ph_lo = 0; p.ph_hi = N_PHASES;
    void* args[] = {&p};
    hipError_t e = hipLaunchCooperativeKernel((const void*)hymba_fwd, dim3(grid), dim3(512), args, LDS_BYTES, stream);
    if (e != hipSuccess) fprintf(stderr, "kernel_launch: cooperative launch failed: %s\n", hipGetErrorString(e));
#else
    for (int ph = 0; ph < N_PHASES; ++ph) { p.ph_lo = ph; p.ph_hi = ph + 1; hipLaunchKernelGGL(hymba_fwd, dim3(grid), dim3(512), LDS_BYTES, stream, p); }
#endif
}
```

```cpp
#include <hip/hip_runtime.h>
#include <cstdio>
#include <cstdint>

#ifndef N_LAUNCHES
#define N_LAUNCHES 1
#endif

#define LAS __attribute__((address_space(3)))
typedef unsigned short bf16_t;
typedef short bf16x8 __attribute__((ext_vector_type(8)));
typedef float f32x4 __attribute__((ext_vector_type(4)));
typedef float f32x2 __attribute__((ext_vector_type(2)));
typedef unsigned u32x4 __attribute__((ext_vector_type(4)));
typedef unsigned u32x2 __attribute__((ext_vector_type(2)));

constexpr int T_TOK = 32768, DM = 1024, SEQ = 2048, NBATCH = 16, NCHUNK = 32, ZP = 3072, DFF = 4096, NMEM = 256;
constexpr int Z_RQ = 0, Z_RK = 256, Z_RV = 512, Z_RG = 768, Z_LX = 1024, Z_LG = 1280, Z_CQ = 1536, Z_CKV = 1728, Z_KR = 1856,
              Z_GQKV = 1888, Z_GG = 2656, Z_GB = 2912, Z_GA = 2916, IN_COLS = 2920;
constexpr float EPS = 1e-6f;
constexpr float LOG2E = 1.4426950408889634f;

constexpr size_t MiB = 1024 * 1024;
constexpr size_t WS_CTL = 0;
constexpr size_t CTL_BYTES = 65536;
constexpr size_t WS_PART = WS_CTL + CTL_BYTES;
constexpr size_t WS_LRUS = WS_PART + (size_t)T_TOK * 16 * 4;
constexpr size_t WS_GL = WS_LRUS + (size_t)2 * 16 * 32 * 256 * 4;
constexpr size_t WS_W = WS_GL + 65536;
constexpr size_t W_IN = 0, W_OUT = W_IN + (size_t)ZP * DM, W_Q = W_OUT + (size_t)DM * DM, W_KV = W_Q + (size_t)DM * DM, W_O = W_KV + (size_t)2 * DM * DM,
                 W_1 = W_O + (size_t)DM * DM, W_2 = W_1 + (size_t)DFF * DM, W_UQ = W_2 + (size_t)DFF * DM, W_UKV = W_UQ + 384 * 192, W_A = W_UKV + 512 * 128,
                 W_X = W_A + 4 * 64 * 64, W_LAYER = W_X + 4 * 64 * 64;
constexpr size_t WS_XB = WS_W + 2 * W_LAYER * 2;
constexpr size_t XB_BYTES = (size_t)T_TOK * DM * 2;
constexpr size_t MLA_Q_OFF = 0, MLA_K_OFF = (size_t)T_TOK * 4 * 96 * 2, MLA_VT_OFF = 2 * MLA_K_OFF;
constexpr size_t WS_KVM = WS_XB + XB_BYTES;
constexpr size_t KVM_LAYER = (size_t)2 * 4096 * 1024 * 2;
constexpr size_t WS_R = WS_KVM + 2 * KVM_LAYER;
constexpr size_t R_Y = (size_t)T_TOK * ZP * 2;
constexpr size_t R_OX = (size_t)T_TOK * DM * 2;
constexpr size_t WS_GDN = WS_R + 256 * MiB;
constexpr size_t WS_END = WS_GDN + 80 * MiB;
static_assert(WS_END <= 512 * MiB, "workspace map exceeds 512 MiB");
static_assert(WS_XB % 256 == 0 && WS_R % 256 == 0 && WS_GDN % 256 == 0 && WS_W % 256 == 0, "alignment");
constexpr int CW_BAR = 0;
constexpr int CW_QUEUE = 4096;

constexpr int LDS_BYTES = 160 * 1024;
constexpr int LDS_CTL = LDS_BYTES - 256;

typedef __bf16 bf16x2_t __attribute__((ext_vector_type(2)));
__device__ __forceinline__ unsigned pk2(float lo, float hi) { f32x2 t = {lo, hi}; bf16x2_t v = __builtin_convertvector(t, bf16x2_t); return __builtin_bit_cast(unsigned, v); }
__device__ __forceinline__ float bflo(unsigned w) { return __uint_as_float(w << 16); }
__device__ __forceinline__ float bfhi(unsigned w) { return __uint_as_float(w & 0xffff0000u); }
__device__ __forceinline__ float bf2f(bf16_t v) { return __uint_as_float((unsigned)v << 16); }
__device__ __forceinline__ bf16_t f2bf(float f) { return (bf16_t)(pk2(f, 0.f) & 0xffffu); }
__device__ __forceinline__ f32x4 mfma16(bf16x8 a, bf16x8 b, f32x4 c) { return __builtin_amdgcn_mfma_f32_16x16x32_bf16(a, b, c, 0, 0, 0); }
__device__ __forceinline__ float fexp2_(float x) { return __builtin_amdgcn_exp2f(x); }
__device__ __forceinline__ float fexp_(float x) { return __builtin_amdgcn_exp2f(x * LOG2E); }
__device__ __forceinline__ float frcp_(float x) { return __builtin_amdgcn_rcpf(x); }
__device__ __forceinline__ float frsq_(float x) { return __builtin_amdgcn_rsqf(x); }
__device__ __forceinline__ float fsqrt_(float x) { return __builtin_amdgcn_sqrtf(x); }
__device__ __forceinline__ float sigmoidf_(float x) { return frcp_(1.0f + fexp_(-x)); }
__device__ __forceinline__ float siluf_(float x) { return x * frcp_(1.0f + fexp_(-x)); }
__device__ __forceinline__ float softplusf_(float x) { return x > 20.f ? x : log1pf(__expf(x)); }
__device__ __forceinline__ float geluf_(float x) { const float u = 1.5957691216057308f * (x + 0.044715f * x * x * x); return x * frcp_(1.0f + fexp_(-u)); }
__device__ __forceinline__ float wave_sum(float v) {
#pragma unroll
    for (int o = 1; o < 64; o <<= 1) v += __shfl_xor(v, o);
    return v;
}
__device__ __forceinline__ void sincos_rev(float ang, float& s, float& c) {
    float rev = ang * 0.15915494309189535f; rev = rev - floorf(rev);
    s = __builtin_amdgcn_sinf(rev); c = __builtin_amdgcn_cosf(rev);
}
__device__ __forceinline__ bf16x8 mk8(u32x2 lo, u32x2 hi) { u32x4 t; t.x = lo.x; t.y = lo.y; t.z = hi.x; t.w = hi.y; return __builtin_bit_cast(bf16x8, t); }
__device__ __forceinline__ bf16x8 pack8(f32x4 a, f32x4 b) { u32x4 t; t.x = pk2(a.x, a.y); t.y = pk2(a.z, a.w); t.z = pk2(b.x, b.y); t.w = pk2(b.z, b.w); return __builtin_bit_cast(bf16x8, t); }

#define XB_TMO      128
#define XB_XCNT(j)  (256  + 64 * (j))
#define XB_XSUB(j)  (1280 + 64 * (j))
#define XB_XGEN(j)  (2304 + 64 * (j))
#define XB_TOP      3328
#define XB_TOPGEN   3392
#define XCD_BAR_WORDS 3456
#define XB_SPIN_CAP (1u << 22)
__device__ __forceinline__ unsigned xb_ld(unsigned* p)              { return __hip_atomic_load(p, __ATOMIC_RELAXED, __HIP_MEMORY_SCOPE_AGENT); }
__device__ __forceinline__ unsigned xb_add(unsigned* p, unsigned v) { return __hip_atomic_fetch_add(p, v, __ATOMIC_RELAXED, __HIP_MEMORY_SCOPE_AGENT); }
__device__ __forceinline__ unsigned xb_xcc_id() { return (unsigned)__builtin_amdgcn_s_getreg((3 << 11) | 20) & 0xFu; }
#define XB_SPIN(cond, bar) do { unsigned _sp = 0; while (cond) { __builtin_amdgcn_s_sleep(1); \
    if ((++_sp & 255u) == 0u) { if (xb_ld(&(bar)[XB_TMO])) break; if (_sp > XB_SPIN_CAP) { atomicAdd(&(bar)[XB_TMO], 1u); break; } } } } while (0)
struct XcdBarrier { unsigned* bar; unsigned x; volatile LAS unsigned* st; };
__device__ __forceinline__ XcdBarrier xcd_barrier_post(unsigned* bar, volatile LAS unsigned* st) {
    XcdBarrier b; b.bar = bar; b.x = xb_xcc_id(); b.st = st;
    if (threadIdx.x == 0) (void)xb_add(&bar[XB_XCNT(b.x)], 1u);
    return b;
}
__device__ __forceinline__ void xcd_barrier_complete(unsigned* bar, unsigned x, unsigned& nloc, unsigned& nx) {
    const unsigned G = gridDim.x * gridDim.y * gridDim.z;
    unsigned sum, cnt, mine, sp = 0u;
    for (;;) {
        sum = 0u; cnt = 0u; mine = 0u;
#pragma unroll
        for (unsigned j = 0; j < 16; ++j) { const unsigned c = xb_ld(&bar[XB_XCNT(j)]); sum += c; cnt += (c > 0u) ? 1u : 0u; mine = (j == x) ? c : mine; }
        if (sum == G) break;
        __builtin_amdgcn_s_sleep(1);
        if ((++sp & 255u) == 0u) { if (xb_ld(&bar[XB_TMO])) break; if (sp > XB_SPIN_CAP) { atomicAdd(&bar[XB_TMO], 1u); break; } }
    }
    nloc = mine > 0u ? mine : 1u; nx = cnt > 0u ? cnt : 1u;
}
__device__ __forceinline__ void xcd_barrier(const XcdBarrier& b) {
    asm volatile("s_waitcnt vmcnt(0)" ::: "memory");
    __syncthreads();
    if (threadIdx.x == 0) {
        unsigned* bar = b.bar;
        __builtin_amdgcn_s_waitcnt(0);
        unsigned nloc = b.st[0], nx = b.st[1];
        if (nloc == 0u) { xcd_barrier_complete(bar, b.x, nloc, nx); b.st[0] = nloc; b.st[1] = nx; }
        const unsigned old = xb_add(&bar[XB_XSUB(b.x)], 1u);
        const unsigned gen = old / nloc;
        if (old + 1u == (gen + 1u) * nloc) {
            __builtin_amdgcn_fence(__ATOMIC_RELEASE, "agent");
            asm volatile("s_waitcnt vmcnt(0)" ::: "memory");
            const unsigned og = xb_add(&bar[XB_TOP], 1u);
            const unsigned tg = og / nx;
            if (og + 1u == (tg + 1u) * nx) xb_add(&bar[XB_TOPGEN], 1u);
            else XB_SPIN(xb_ld(&bar[XB_TOPGEN]) == tg, bar);
            __builtin_amdgcn_fence(__ATOMIC_ACQUIRE, "agent");
            xb_add(&bar[XB_XGEN(b.x)], 1u);
            asm volatile("s_waitcnt vmcnt(0)" ::: "memory");
        } else {
            XB_SPIN(xb_ld(&bar[XB_XGEN(b.x)]) == gen, bar);
            __builtin_amdgcn_fence(__ATOMIC_ACQUIRE, "agent");
            asm volatile("s_waitcnt vmcnt(0)" ::: "memory");
        }
    }
    __syncthreads();
}

namespace pg8 {
constexpr int BM = 256, BK = 64, HALF = 128, HTB = HALF * BK * 2, STAGE_BYTES = 8 * HTB, NXCD = 8, WGM = 8;
__host__ __device__ __forceinline__ int lds_byte(int r, int c) { const int st = (r >> 4) * 2 + (c >> 5), rr = r & 15, cc = c & 31, ob = rr * 64 + cc * 2; return st * 1024 + (ob ^ (((ob >> 9) & 1) << 5)); }
__host__ __device__ __forceinline__ void stage_rc(int b, int& R, int& C) { const int st = b / 1024, sb = b % 1024, swz = sb ^ (((sb >> 9) & 1) << 5); R = (st >> 1) * 16 + swz / 64; C = (st & 1) * 32 + (swz % 64) / 2; }
__host__ __device__ __forceinline__ int perm32(int rho) { const int n = rho >> 4, i = rho & 15; return 8 * (i >> 2) + 4 * n + (i & 3); }
struct Unit { int pm, pn; };
struct Gemm { const bf16_t* A; const bf16_t* Bt; int M, N, K; };
struct StaticOrder {
    int nM, nN, nwg, G, c;
    __host__ __device__ void init(int M, int N, int G_, int c_) { nM = M / BM; nN = N / BM; nwg = nM * nN; G = G_; c = c_; }
    __host__ __device__ bool next(int i, Unit& u) const {
        const long L = (long)i * G + c; if (L >= nwg) return false;
        int wgid = (int)L; { const int q = nwg / NXCD, r = nwg % NXCD, xcd = wgid % NXCD, off = wgid / NXCD; wgid = (xcd < r ? xcd * (q + 1) : r * (q + 1) + (xcd - r) * q) + off; }
        const int nig = WGM * nN, gid = wgid / nig, fm = gid * WGM, gsz = (nM - fm) < WGM ? (nM - fm) : WGM;
        u.pm = fm + ((wgid % nig) % gsz); u.pn = (wgid % nig) / gsz; return true;
    }
    __device__ __forceinline__ void a_ready(const Unit&) const {}
    __device__ __forceinline__ void done(const Unit&) const {}
};

template <int ACT> struct EpiScaleBf16 {
    static constexpr bool PERM = true;
    bf16_t* O; int ldc; const float* part;
    __device__ __forceinline__ void operator()(const f32x4 (&acc)[2][2][4][2], const Unit& u, int wr, int wc, int fr, int fq) const {
        const int row0 = u.pm * BM + wr * 64 + fr, col0 = u.pn * BM + wc * 32 + 8 * fq;
#pragma unroll
        for (int ai = 0; ai < 2; ++ai)
#pragma unroll
            for (int m = 0; m < 4; ++m) {
                const int row = row0 + ai * HALF + m * 16;
                float sc = 1.0f;
                if (part) { const f32x4* pp = (const f32x4*)(part + (size_t)row * 16); const f32x4 a = pp[0], b = pp[1], c = pp[2], d = pp[3];
                    const float s = ((a.x + a.y) + (a.z + a.w)) + ((b.x + b.y) + (b.z + b.w)) + ((c.x + c.y) + (c.z + c.w)) + ((d.x + d.y) + (d.z + d.w));
                    sc = frsq_(s * (1.0f / 1024.0f) + EPS); }
                bf16_t* rowp = O + (size_t)row * ldc + col0;
#pragma unroll
                for (int bj = 0; bj < 2; ++bj) { f32x4 v0 = acc[ai][bj][m][0] * sc, v1 = acc[ai][bj][m][1] * sc;
                    if (ACT == 1) {
#pragma unroll
                        for (int j = 0; j < 4; ++j) { const float a0 = fmaxf(v0[j], 0.f), a1 = fmaxf(v1[j], 0.f); v0[j] = a0 * a0; v1[j] = a1 * a1; } }
                    u32x4 w; w.x = pk2(v0[0], v0[1]); w.y = pk2(v0[2], v0[3]); w.z = pk2(v1[0], v1[1]); w.w = pk2(v1[2], v1[3]);
                    *(u32x4*)(rowp + bj * HALF) = w; }
            }
    }
};
struct EpiResid {
    static constexpr bool PERM = false;
    bf16_t* XB; float* part; float alpha;
    __device__ __forceinline__ void operator()(const f32x4 (&acc)[2][2][4][2], const Unit& u, int wr, int wc, int fr, int fq) const {
        const int row0 = u.pm * BM + wr * 64 + fr, col0 = u.pn * BM + wc * 32 + 4 * fq;
#pragma unroll
        for (int ai = 0; ai < 2; ++ai)
#pragma unroll
            for (int m = 0; m < 4; ++m) {
                const int row = row0 + ai * HALF + m * 16;
                bf16_t* bp = XB + (size_t)row * DM + col0;
                float ss = 0.f;
#pragma unroll
                for (int bj = 0; bj < 2; ++bj)
#pragma unroll
                    for (int n = 0; n < 2; ++n) { const u32x2 xw = *(const u32x2*)(bp + bj * HALF + n * 16);
                        const f32x4 v = (f32x4){bflo(xw.x), bfhi(xw.x), bflo(xw.y), bfhi(xw.y)} + acc[ai][bj][m][n] * alpha;
                        ss += (v.x * v.x + v.y * v.y) + (v.z * v.z + v.w * v.w);
                        u32x2 w; w.x = pk2(v.x, v.y); w.y = pk2(v.z, v.w); *(u32x2*)(bp + bj * HALF + n * 16) = w; }
                ss += __shfl_xor(ss, 16); ss += __shfl_xor(ss, 32);
                if (fq == 0) part[(size_t)row * 16 + u.pn * 4 + wc] = ss;
            }
    }
};

template <class Epi, class Sched>
__device__ __forceinline__ void gemm_phase(LAS unsigned char* lds, const Gemm g, const Sched& S, const Epi& E, const int tid) {
    const int wid = __builtin_amdgcn_readfirstlane(tid >> 6), lane = tid & 63, wr = wid >> 2, wc = wid & 3, fr = lane & 15, fq = lane >> 4;
    const int K = g.K, nt = K / BK;
    unsigned voffA[2], voffB[2];
#pragma unroll
    for (int i = 0; i < 2; ++i) { int R, C; stage_rc(tid * 16 + i * 8192, R, C); const int Rb = Epi::PERM ? ((R & ~31) + perm32(R & 31)) : R;
        voffA[i] = (unsigned)(R * K + C) * 2u; voffB[i] = (unsigned)(Rb * K + C) * 2u; }
    const size_t kstep = (size_t)(BK * 2);
    const size_t hstep = (size_t)HALF * K * 2;
    const size_t tstep = 2 * hstep;
    const unsigned ldsw = (unsigned)wid * 1024u;
    const int aoff = lds_byte(wr * 64 + fr, fq * 8), boff = lds_byte(wc * 32 + fr, fq * 8);
#define PG8_SA(b, h) (((b) * 2 + (h)) * HTB)
#define PG8_SB(b, h) ((4 + (b) * 2 + (h)) * HTB)
#define PG8_STAGE(bufoff, gbase, voff) do { _Pragma("unroll") for (int _i = 0; _i < 2; ++_i) \
        __builtin_amdgcn_global_load_lds((const unsigned*)((const char*)(gbase) + (voff)[_i]), (LAS unsigned*)(lds + (bufoff) + ldsw + _i * 8192), 16, 0, 0); } while (0)
#define PG8_LDA(dst, b, h) do { _Pragma("unroll") for (int m = 0; m < 4; ++m) _Pragma("unroll") for (int k = 0; k < 2; ++k) dst[m][k] = *(const LAS bf16x8*)(lds + PG8_SA(b, h) + aoff + m * 2048 + k * 1024); } while (0)
#define PG8_LDB(dst, b, h) do { _Pragma("unroll") for (int n = 0; n < 2; ++n) _Pragma("unroll") for (int k = 0; k < 2; ++k) dst[n][k] = *(const LAS bf16x8*)(lds + PG8_SB(b, h) + boff + n * 2048 + k * 1024); } while (0)
#define PG8_MMA(ai, bj, At, Bt) do { __builtin_amdgcn_s_setprio(1); _Pragma("unroll") for (int m = 0; m < 4; ++m) _Pragma("unroll") for (int n = 0; n < 2; ++n) _Pragma("unroll") for (int k = 0; k < 2; ++k) \
        acc[ai][bj][m][n] = __builtin_amdgcn_mfma_f32_16x16x32_bf16(Bt[n][k], At[m][k], acc[ai][bj][m][n], 0, 0, 0); __builtin_amdgcn_s_setprio(0); } while (0)
#define PG8_WAIT_V(n) asm volatile("s_waitcnt vmcnt(" #n ")" ::: "memory")
#define PG8_WAIT_L(n) asm volatile("s_waitcnt lgkmcnt(" #n ")" ::: "memory")
#define PG8_BAR __builtin_amdgcn_s_barrier()
#define PG8_SCHED __builtin_amdgcn_sched_barrier(0)
    Unit cur, nxt; int ui = 0;
    if (!S.next(0, cur)) return;
    f32x4 acc[2][2][4][2];
#pragma unroll
    for (int a = 0; a < 2; ++a)
#pragma unroll
        for (int b = 0; b < 2; ++b)
#pragma unroll
            for (int m = 0; m < 4; ++m)
#pragma unroll
                for (int n = 0; n < 2; ++n) acc[a][b][m][n] = (f32x4){0.f, 0.f, 0.f, 0.f};
    bf16x8 At[4][2], B0[2][2], B1[2][2];
    const char* cA = (const char*)g.A + (size_t)cur.pm * tstep; const char* cB = (const char*)g.Bt + (size_t)cur.pn * tstep;
    S.a_ready(cur);
    PG8_STAGE(PG8_SB(0, 0), cB, voffB); PG8_STAGE(PG8_SA(0, 0), cA, voffA); PG8_STAGE(PG8_SB(0, 1), cB + hstep, voffB); PG8_STAGE(PG8_SA(0, 1), cA + hstep, voffA);
    if (wr == 1) PG8_BAR;
    PG8_WAIT_V(4); PG8_BAR;
    PG8_STAGE(PG8_SB(1, 0), cB + kstep, voffB); PG8_STAGE(PG8_SA(1, 0), cA + kstep, voffA); PG8_STAGE(PG8_SB(1, 1), cB + hstep + kstep, voffB);
    PG8_WAIT_V(6); PG8_BAR;
    for (;;) {
        const bool has_next = S.next(ui + 1, nxt);
        const char* nA = has_next ? (const char*)g.A + (size_t)nxt.pm * tstep : cA; const char* nB = has_next ? (const char*)g.Bt + (size_t)nxt.pn * tstep : cB;
        for (int t = 0; t < nt; t += 2) {
            const bool last = (t == nt - 2);
            const char* a1 = cA + (size_t)(t + 1) * kstep;
            const char* a2 = last ? nA : cA + (size_t)(t + 2) * kstep; const char* b2 = last ? nB : cB + (size_t)(t + 2) * kstep;
            const char* a3 = a2 + kstep; const char* b3 = b2 + kstep;
            if (last && has_next) S.a_ready(nxt);
            PG8_LDB(B0, 0, 0); PG8_SCHED; PG8_LDA(At, 0, 0); PG8_STAGE(PG8_SA(1, 1), a1 + hstep, voffA);
            PG8_WAIT_L(8); PG8_BAR; PG8_WAIT_L(0); PG8_MMA(0, 0, At, B0); PG8_BAR; PG8_SCHED;
            PG8_LDB(B1, 0, 1); PG8_STAGE(PG8_SB(0, 0), b2, voffB);
            PG8_BAR; PG8_WAIT_L(0); PG8_MMA(0, 1, At, B1); PG8_BAR;
            PG8_LDA(At, 0, 1); PG8_STAGE(PG8_SA(0, 0), a2, voffA);
            PG8_BAR; PG8_WAIT_L(0); PG8_MMA(1, 0, At, B0); PG8_BAR; PG8_SCHED;
            PG8_STAGE(PG8_SB(0, 1), b2 + hstep, voffB);
            PG8_WAIT_V(6); PG8_BAR; PG8_MMA(1, 1, At, B1); PG8_BAR;
            PG8_LDB(B0, 1, 0); PG8_SCHED; PG8_LDA(At, 1, 0); PG8_STAGE(PG8_SA(0, 1), a2 + hstep, voffA);
            PG8_WAIT_L(8); PG8_BAR; PG8_WAIT_L(0); PG8_MMA(0, 0, At, B0); PG8_BAR; PG8_SCHED;
            PG8_LDB(B1, 1, 1); PG8_STAGE(PG8_SB(1, 0), b3, voffB);
            PG8_BAR; PG8_WAIT_L(0); PG8_MMA(0, 1, At, B1); PG8_BAR;
            PG8_LDA(At, 1, 1); PG8_STAGE(PG8_SA(1, 0), a3, voffA);
            PG8_BAR; PG8_WAIT_L(0); PG8_MMA(1, 0, At, B0); PG8_BAR; PG8_SCHED;
            PG8_STAGE(PG8_SB(1, 1), b3 + hstep, voffB);
            PG8_WAIT_V(6); PG8_BAR; PG8_MMA(1, 1, At, B1); PG8_BAR;
        }
        E(acc, cur, wr, wc, fr, fq); S.done(cur);
        if (!has_next) break;
#pragma unroll
        for (int a = 0; a < 2; ++a)
#pragma unroll
            for (int b = 0; b < 2; ++b)
#pragma unroll
                for (int m = 0; m < 4; ++m)
#pragma unroll
                    for (int n = 0; n < 2; ++n) acc[a][b][m][n] = (f32x4){0.f, 0.f, 0.f, 0.f};
        cur = nxt; cA = nA; cB = nB; ++ui;
    }
    PG8_WAIT_V(0);
    if (wr == 0) PG8_BAR;
    PG8_BAR;
#undef PG8_SA
#undef PG8_SB
#undef PG8_STAGE
#undef PG8_LDA
#undef PG8_LDB
#undef PG8_MMA
#undef PG8_WAIT_V
#undef PG8_WAIT_L
#undef PG8_BAR
#undef PG8_SCHED
}
}

struct Params {
    const float* x; const float* mem; const int* pos;
    const float* norm_mix; const float* w_in; const float* ret_gn;
    const float* lru_conv_w; const float* lru_conv_b; const float* lru_wa; const float* lru_ba; const float* lru_wx; const float* lru_bx; const float* lru_lambda;
    const float* mla_q_norm; const float* mla_w_uq; const float* mla_kv_norm; const float* mla_w_ukv;
    const float* gdn_conv_w; const float* gdn_a_log; const float* gdn_dt_bias; const float* gdn_norm;
    const float* w_out; const float* norm_xattn; const float* norm_mem; const float* xa_wq; const float* xa_wkv; const float* xa_wo;
    const float* norm_mlp; const float* mlp_w1; const float* mlp_w2; const float* final_norm;
    float* out; unsigned char* ws;
    int ph_lo, ph_hi;
};

__device__ __forceinline__ bf16_t* wl(const Params& P, int l, size_t off) { return (bf16_t*)(P.ws + WS_W) + (size_t)l * W_LAYER + off; }

struct WTile { const float* src; const float* gain; bf16_t* dst; int K, N, kb, nb; float scale; };
__device__ __forceinline__ WTile p0_decode(const Params& P, int it) {
    constexpr int T_IN = 16 * 48, T_SQ = 256, T_KV = 512, T_W1 = 1024, T_W2 = 1024, T_UQ = 18, T_UKV = 16, T_LRU = 8;
    constexpr int T_LAYER = T_IN + 3 * T_SQ + T_KV + T_W1 + T_W2 + T_UQ + T_UKV + T_LRU;
    const int l = it / T_LAYER; int r = it % T_LAYER; int nnb; WTile t; t.gain = nullptr; t.scale = 1.f;
    if (r < T_IN) { t.src = P.w_in + (size_t)l * DM * IN_COLS; t.K = DM; t.N = IN_COLS; nnb = 48; t.gain = P.norm_mix + l * DM; t.dst = wl(P, l, W_IN); }
    else if ((r -= T_IN) < T_SQ) { t.src = P.w_out + (size_t)l * DM * DM; t.K = DM; t.N = DM; nnb = 16; t.dst = wl(P, l, W_OUT); }
    else if ((r -= T_SQ) < T_SQ) { t.src = P.xa_wq + (size_t)l * DM * DM; t.K = DM; t.N = DM; nnb = 16; t.gain = P.norm_xattn + l * DM; t.scale = 0.0625f * LOG2E; t.dst = wl(P, l, W_Q); }
    else if ((r -= T_SQ) < T_KV) { t.src = P.xa_wkv + (size_t)l * DM * 2 * DM; t.K = DM; t.N = 2 * DM; nnb = 32; t.gain = P.norm_mem + l * DM; t.dst = wl(P, l, W_KV); }
    else if ((r -= T_KV) < T_SQ) { t.src = P.xa_wo + (size_t)l * DM * DM; t.K = DM; t.N = DM; nnb = 16; t.dst = wl(P, l, W_O); }
    else if ((r -= T_SQ) < T_W1) { t.src = P.mlp_w1 + (size_t)l * DM * DFF; t.K = DM; t.N = DFF; nnb = 64; t.gain = P.norm_mlp + l * DM; t.dst = wl(P, l, W_1); }
    else if ((r -= T_W1) < T_W2) { t.src = P.mlp_w2 + (size_t)l * DFF * DM; t.K = DFF; t.N = DM; nnb = 16; t.dst = wl(P, l, W_2); }
    else if ((r -= T_W2) < T_UQ) { t.src = P.mla_w_uq + (size_t)l * 192 * 384; t.K = 192; t.N = 384; nnb = 6; t.gain = P.mla_q_norm + l * 192; t.dst = wl(P, l, W_UQ); }
    else if ((r -= T_UQ) < T_UKV) { t.src = P.mla_w_ukv + (size_t)l * 128 * 512; t.K = 128; t.N = 512; nnb = 8; t.gain = P.mla_kv_norm + l * 128; t.dst = wl(P, l, W_UKV); }
    else { r -= T_UKV; const int which = r >> 2, nb4 = r & 3; t.src = (which ? P.lru_wx : P.lru_wa) + (size_t)l * 4 * 4096 + nb4 * 4096; t.K = 64; t.N = 64; nnb = 1; t.dst = wl(P, l, which ? W_X : W_A) + nb4 * 4096; r = 0; }
    t.kb = r / nnb; t.nb = r % nnb; return t;
}
__device__ __forceinline__ void p0_fetch(const WTile& t, int tid, f32x4 (&v)[2]) {
#pragma unroll
    for (int i = 0; i < 2; ++i) { const int kk = (tid >> 4) + 32 * i, k = t.kb * 64 + kk, n = t.nb * 64 + (tid & 15) * 4;
        f32x4 x = {0.f, 0.f, 0.f, 0.f}; float g = t.scale;
        if (n < t.N) { x = *(const f32x4*)(t.src + (size_t)k * t.N + n); if (t.gain) g *= t.gain[k]; }
        v[i] = x * g; }
}
__device__ __forceinline__ void p0_prologue(const Params& P, LAS unsigned char* lds, int tid) {
    LAS float* scr = (LAS float*)lds;
    constexpr int NT = 2 * (16 * 48 + 3 * 256 + 512 + 1024 + 1024 + 18 + 16 + 8);
    int it = blockIdx.x;
    if (it < NT) {
        WTile cur = p0_decode(P, it); f32x4 v[2]; p0_fetch(cur, tid, v);
        for (;;) {
#pragma unroll
            for (int i = 0; i < 2; ++i) { LAS float* d = scr + ((tid >> 4) + 32 * i) * 65 + (tid & 15) * 4; d[0] = v[i].x; d[1] = v[i].y; d[2] = v[i].z; d[3] = v[i].w; }
            const int nxt = it + gridDim.x; const bool more = nxt < NT;
            WTile nx = cur; if (more) { nx = p0_decode(P, nxt); p0_fetch(nx, tid, v); }
            __syncthreads();
            { const int nl = tid >> 3, k0 = (tid & 7) * 8; const LAS float* s = scr + k0 * 65 + nl;
              u32x4 o; o.x = pk2(s[0], s[65]); o.y = pk2(s[2 * 65], s[3 * 65]); o.z = pk2(s[4 * 65], s[5 * 65]); o.w = pk2(s[6 * 65], s[7 * 65]);
              *(u32x4*)(cur.dst + (size_t)(cur.nb * 64 + nl) * cur.K + cur.kb * 64 + k0) = o; }
            __syncthreads();
            if (!more) break;
            cur = nx; it = nxt;
        }
    }
    const int wave = tid >> 6, lane = tid & 63;
    const int gw = blockIdx.x * 8 + wave, ngw = gridDim.x * 8;
    bf16_t* xb = (bf16_t*)(P.ws + WS_XB); float* part = (float*)(P.ws + WS_PART); bf16_t* memn = (bf16_t*)(P.ws + WS_GDN);
    constexpr int NR = T_TOK + NBATCH * NMEM;
    for (int row0 = gw; row0 < NR; row0 += 2 * ngw) {
        f32x4 v[2][4]; const int row1 = row0 + ngw; const bool has1 = row1 < NR;
#pragma unroll
        for (int q = 0; q < 2; ++q) { const int row = q ? (has1 ? row1 : row0) : row0; const bool isx = row < T_TOK; const int r2 = isx ? row : row - T_TOK;
            const f32x4* src = (const f32x4*)((isx ? P.x : P.mem) + (size_t)r2 * DM) + lane;
#pragma unroll
            for (int j = 0; j < 4; ++j) v[q][j] = src[64 * j]; }
#pragma unroll
        for (int q = 0; q < 2; ++q) { if (q && !has1) break; const int row = q ? row1 : row0; const bool isx = row < T_TOK; const int r2 = isx ? row : row - T_TOK;
            float s = 0.f;
#pragma unroll
            for (int j = 0; j < 4; ++j) s += (v[q][j].x * v[q][j].x + v[q][j].y * v[q][j].y) + (v[q][j].z * v[q][j].z + v[q][j].w * v[q][j].w);
            s = wave_sum(s);
            if (isx) { u32x2* ob = (u32x2*)(xb + (size_t)row * DM) + lane;
#pragma unroll
                for (int j = 0; j < 4; ++j) { u32x2 w; w.x = pk2(v[q][j].x, v[q][j].y); w.y = pk2(v[q][j].z, v[q][j].w); ob[64 * j] = w; }
                if (lane < 16) part[(size_t)row * 16 + lane] = lane == 0 ? s : 0.f;
            } else { const float rs = frsq_(s * (1.0f / 1024.0f) + EPS); u32x2* ob = (u32x2*)(memn + (size_t)r2 * DM) + lane;
#pragma unroll
                for (int j = 0; j < 4; ++j) { u32x2 w; w.x = pk2(v[q][j].x * rs, v[q][j].y * rs); w.y = pk2(v[q][j].z * rs, v[q][j].w * rs); ob[64 * j] = w; } }
        }
    }
}
__device__ __forceinline__ void final_norm_phase(const Params& P, int tid) {
    const int wave = tid >> 6, lane = tid & 63; const float* part = (const float*)(P.ws + WS_PART); const bf16_t* xb = (const bf16_t*)(P.ws + WS_XB);
    f32x4 g[4];
#pragma unroll
    for (int j = 0; j < 4; ++j) g[j] = ((const f32x4*)P.final_norm)[64 * j + lane];
    for (int row = blockIdx.x * 8 + wave; row < T_TOK; row += gridDim.x * 8) {
        float s = lane < 16 ? part[(size_t)row * 16 + lane] : 0.f; s = wave_sum(s);
        const float rs = frsq_(s * (1.0f / 1024.0f) + EPS);
        f32x4* o = (f32x4*)(P.out + (size_t)row * DM) + lane; const u32x2* xi = (const u32x2*)(xb + (size_t)row * DM) + lane;
#pragma unroll
        for (int j = 0; j < 4; ++j) { const u32x2 w = xi[64 * j]; o[64 * j] = (f32x4){bflo(w.x), bfhi(w.x), bflo(w.y), bfhi(w.y)} * rs * g[j]; }
    }
}
__device__ __forceinline__ void mla_pre_tile(const Params& P, int l, int rt, int lane) {
    const int fr = lane & 15, fq = lane >> 4;
    const bf16_t* z = (const bf16_t*)(P.ws + WS_R);
    bf16_t* Qo = (bf16_t*)((unsigned char*)P.out + MLA_Q_OFF); bf16_t* Ko = (bf16_t*)((unsigned char*)P.out + MLA_K_OFF); bf16_t* Vo = (bf16_t*)((unsigned char*)P.out + MLA_VT_OFF);
    const bf16_t* Wuq = wl(P, l, W_UQ); const bf16_t* Wukv = wl(P, l, W_UKV);
    const int tok0 = rt * 16, b = tok0 >> 11, s0 = tok0 & 2047;
    const bf16_t* zr = z + (size_t)(tok0 + fr) * ZP;
    bf16x8 cq[6], ckv[4]; float sq = 0.f, skv = 0.f;
#pragma unroll
    for (int s = 0; s < 6; ++s) { const u32x4 w = *(const u32x4*)(zr + Z_CQ + 32 * s + 8 * fq); cq[s] = __builtin_bit_cast(bf16x8, w);
        sq += bflo(w.x) * bflo(w.x) + bfhi(w.x) * bfhi(w.x) + bflo(w.y) * bflo(w.y) + bfhi(w.y) * bfhi(w.y) + bflo(w.z) * bflo(w.z) + bfhi(w.z) * bfhi(w.z) + bflo(w.w) * bflo(w.w) + bfhi(w.w) * bfhi(w.w); }
#pragma unroll
    for (int s = 0; s < 4; ++s) { const u32x4 w = *(const u32x4*)(zr + Z_CKV + 32 * s + 8 * fq); ckv[s] = __builtin_bit_cast(bf16x8, w);
        skv += bflo(w.x) * bflo(w.x) + bfhi(w.x) * bfhi(w.x) + bflo(w.y) * bflo(w.y) + bfhi(w.y) * bfhi(w.y) + bflo(w.z) * bflo(w.z) + bfhi(w.z) * bfhi(w.z) + bflo(w.w) * bflo(w.w) + bfhi(w.w) * bfhi(w.w); }
    sq += __shfl_xor(sq, 16); sq += __shfl_xor(sq, 32); skv += __shfl_xor(skv, 16); skv += __shfl_xor(skv, 32);
    const float rq = frsq_(sq * (1.0f / 192.0f) + EPS), rkv = frsq_(skv * (1.0f / 128.0f) + EPS);
    const float qsc = rq * 0.10206207261596575f * LOG2E;
    const float pos = (float)P.pos[tok0 + fr];
    float sn[4], cs[4];
#pragma unroll
    for (int r = 0; r < 4; ++r) { const float invf = exp2f(-(float)(4 * fq + r) * (13.287712379549449f / 16.0f)); sincos_rev(pos * invf, sn[r], cs[r]); }
    const size_t tokrow = (size_t)b * 4 * SEQ + (s0 + fr);
#pragma unroll 1
    for (int h = 0; h < 4; ++h) {
        bf16_t* qrow = Qo + (tokrow + (size_t)h * SEQ) * 96;
#pragma unroll 1
        for (int nt = 0; nt < 4; ++nt) { f32x4 a = {0.f, 0.f, 0.f, 0.f};
#pragma unroll
            for (int s = 0; s < 6; ++s) { const bf16x8 wf = *(const bf16x8*)(Wuq + (size_t)(h * 96 + nt * 16 + fr) * 192 + 32 * s + 8 * fq); a = mfma16(wf, cq[s], a); }
            a = a * qsc; u32x2 w; w.x = pk2(a.x, a.y); w.y = pk2(a.z, a.w); *(u32x2*)(qrow + nt * 16 + 4 * fq) = w; }
        f32x4 x1 = {0.f, 0.f, 0.f, 0.f}, x2 = {0.f, 0.f, 0.f, 0.f}, y1, y2;
#pragma unroll
        for (int s = 0; s < 6; ++s) { const bf16x8 wf1 = *(const bf16x8*)(Wuq + (size_t)(h * 96 + 64 + fr) * 192 + 32 * s + 8 * fq), wf2 = *(const bf16x8*)(Wuq + (size_t)(h * 96 + 80 + fr) * 192 + 32 * s + 8 * fq);
            x1 = mfma16(wf1, cq[s], x1); x2 = mfma16(wf2, cq[s], x2); }
        x1 = x1 * qsc; x2 = x2 * qsc;
#pragma unroll
        for (int r = 0; r < 4; ++r) { y1[r] = x1[r] * cs[r] - x2[r] * sn[r]; y2[r] = x1[r] * sn[r] + x2[r] * cs[r]; }
        { u32x2 w; w.x = pk2(y1.x, y1.y); w.y = pk2(y1.z, y1.w); *(u32x2*)(qrow + 64 + 4 * fq) = w; w.x = pk2(y2.x, y2.y); w.y = pk2(y2.z, y2.w); *(u32x2*)(qrow + 80 + 4 * fq) = w; }
    }
    u32x2 kr1, kr2;
    { const u32x2 a = *(const u32x2*)(zr + Z_KR + 4 * fq), c = *(const u32x2*)(zr + Z_KR + 16 + 4 * fq);
      const float x1[4] = {bflo(a.x), bfhi(a.x), bflo(a.y), bfhi(a.y)}, x2[4] = {bflo(c.x), bfhi(c.x), bflo(c.y), bfhi(c.y)}; float y1[4], y2[4];
#pragma unroll
      for (int r = 0; r < 4; ++r) { y1[r] = x1[r] * cs[r] - x2[r] * sn[r]; y2[r] = x1[r] * sn[r] + x2[r] * cs[r]; }
      kr1.x = pk2(y1[0], y1[1]); kr1.y = pk2(y1[2], y1[3]); kr2.x = pk2(y2[0], y2[1]); kr2.y = pk2(y2[2], y2[3]); }
    float rkv_r[4];
#pragma unroll
    for (int r = 0; r < 4; ++r) rkv_r[r] = __shfl(rkv, 4 * fq + r);
    const int chunk = s0 >> 6, key0 = (s0 & 63) + 4 * fq;
#pragma unroll 1
    for (int h = 0; h < 4; ++h) {
        bf16_t* krow = Ko + (tokrow + (size_t)h * SEQ) * 96;
#pragma unroll 1
        for (int nt = 0; nt < 4; ++nt) { f32x4 a = {0.f, 0.f, 0.f, 0.f};
#pragma unroll
            for (int s = 0; s < 4; ++s) { const bf16x8 wf = *(const bf16x8*)(Wukv + (size_t)(h * 128 + nt * 16 + fr) * 128 + 32 * s + 8 * fq); a = mfma16(wf, ckv[s], a); }
            a = a * rkv; u32x2 w; w.x = pk2(a.x, a.y); w.y = pk2(a.z, a.w); *(u32x2*)(krow + nt * 16 + 4 * fq) = w; }
        *(u32x2*)(krow + 64 + 4 * fq) = kr1; *(u32x2*)(krow + 80 + 4 * fq) = kr2;
        bf16_t* vt = Vo + ((size_t)((b * 4 + h) * NCHUNK + chunk) * 64) * 64;
#pragma unroll 1
        for (int nt = 0; nt < 4; ++nt) { f32x4 a = {0.f, 0.f, 0.f, 0.f};
#pragma unroll
            for (int s = 0; s < 4; ++s) { const bf16x8 wf = *(const bf16x8*)(Wukv + (size_t)(h * 128 + 64 + nt * 16 + fr) * 128 + 32 * s + 8 * fq); a = mfma16(ckv[s], wf, a); }
            u32x2 w; w.x = pk2(a.x * rkv_r[0], a.y * rkv_r[1]); w.y = pk2(a.z * rkv_r[2], a.w * rkv_r[3]);
            *(u32x2*)(vt + (size_t)(nt * 16 + fr) * 64 + key0) = w; }
    }
}

constexpr int MP_UQ_ROW = 200, MP_UKV_ROW = 136, MP_UKV_OFF = 96 * MP_UQ_ROW * 2, MP_BUF = MP_UKV_OFF + 128 * MP_UKV_ROW * 2;
__device__ __forceinline__ void mla_pre_item(const Params& P, int l, LAS unsigned char* lds, int it, int tid, int wave, int lane) {
    const int fr = lane & 15, fq = lane >> 4, rt = it * 8 + wave;
    const bf16_t* z = (const bf16_t*)(P.ws + WS_R);
    bf16_t* Qo = (bf16_t*)((unsigned char*)P.out + MLA_Q_OFF); bf16_t* Ko = (bf16_t*)((unsigned char*)P.out + MLA_K_OFF); bf16_t* Vo = (bf16_t*)((unsigned char*)P.out + MLA_VT_OFF);
    const bf16_t* Wuq = wl(P, l, W_UQ); const bf16_t* Wukv = wl(P, l, W_UKV);
    u32x4 stg[5];
#define MP_LOADQ(h_) do { _Pragma("unroll") for (int i = 0; i < 5; ++i) { const int p = tid + 512 * i; if (p < 2304) stg[i] = *(const u32x4*)(Wuq + (size_t)(h_) * 96 * 192 + (size_t)p * 8); } } while (0)
#define MP_STOREQ(buf_) do { _Pragma("unroll") for (int i = 0; i < 5; ++i) { const int p = tid + 512 * i; if (p < 2304) { const int row = p / 24, pc = p % 24; *(LAS u32x4*)(lds + (buf_) * MP_BUF + (row * MP_UQ_ROW + pc * 8) * 2) = stg[i]; } } } while (0)
#define MP_LOADKV(h_) do { _Pragma("unroll") for (int i = 0; i < 4; ++i) { const int p = tid + 512 * i; stg[i] = *(const u32x4*)(Wukv + (size_t)(h_) * 128 * 128 + (size_t)p * 8); } } while (0)
#define MP_STOREKV(buf_) do { _Pragma("unroll") for (int i = 0; i < 4; ++i) { const int p = tid + 512 * i, row = p >> 4, pc = p & 15; *(LAS u32x4*)(lds + (buf_) * MP_BUF + MP_UKV_OFF + (row * MP_UKV_ROW + pc * 8) * 2) = stg[i]; } } while (0)
    MP_LOADQ(0); MP_STOREQ(0); MP_LOADKV(0);
    const int tok0 = rt * 16, b = tok0 >> 11, s0 = tok0 & 2047;
    const bf16_t* zr = z + (size_t)(tok0 + fr) * ZP;
    bf16x8 cq[6], ckv[4]; float sq = 0.f, skv = 0.f;
#pragma unroll
    for (int s = 0; s < 6; ++s) { const u32x4 w = *(const u32x4*)(zr + Z_CQ + 32 * s + 8 * fq); cq[s] = __builtin_bit_cast(bf16x8, w);
        sq += bflo(w.x) * bflo(w.x) + bfhi(w.x) * bfhi(w.x) + bflo(w.y) * bflo(w.y) + bfhi(w.y) * bfhi(w.y) + bflo(w.z) * bflo(w.z) + bfhi(w.z) * bfhi(w.z) + bflo(w.w) * bflo(w.w) + bfhi(w.w) * bfhi(w.w); }
#pragma unroll
    for (int s = 0; s < 4; ++s) { const u32x4 w = *(const u32x4*)(zr + Z_CKV + 32 * s + 8 * fq); ckv[s] = __builtin_bit_cast(bf16x8, w);
        skv += bflo(w.x) * bflo(w.x) + bfhi(w.x) * bfhi(w.x) + bflo(w.y) * bflo(w.y) + bfhi(w.y) * bfhi(w.y) + bflo(w.z) * bflo(w.z) + bfhi(w.z) * bfhi(w.z) + bflo(w.w) * bflo(w.w) + bfhi(w.w) * bfhi(w.w); }
    const u32x2 kra = *(const u32x2*)(zr + Z_KR + 4 * fq), krc = *(const u32x2*)(zr + Z_KR + 16 + 4 * fq);
    const float pos = (float)P.pos[tok0 + fr];
    MP_STOREKV(0);
    sq += __shfl_xor(sq, 16); sq += __shfl_xor(sq, 32); skv += __shfl_xor(skv, 16); skv += __shfl_xor(skv, 32);
    const float rq = frsq_(sq * (1.0f / 192.0f) + EPS), rkv = frsq_(skv * (1.0f / 128.0f) + EPS);
    const float qsc = rq * 0.10206207261596575f * LOG2E;
    float sn[4], cs[4];
#pragma unroll
    for (int r = 0; r < 4; ++r) { const float invf = exp2f(-(float)(4 * fq + r) * (13.287712379549449f / 16.0f)); sincos_rev(pos * invf, sn[r], cs[r]); }
    const size_t tokrow = (size_t)b * 4 * SEQ + (s0 + fr);
    u32x2 kr1, kr2;
    { const float x1[4] = {bflo(kra.x), bfhi(kra.x), bflo(kra.y), bfhi(kra.y)}, x2[4] = {bflo(krc.x), bfhi(krc.x), bflo(krc.y), bfhi(krc.y)}; float y1[4], y2[4];
#pragma unroll
      for (int r = 0; r < 4; ++r) { y1[r] = x1[r] * cs[r] - x2[r] * sn[r]; y2[r] = x1[r] * sn[r] + x2[r] * cs[r]; }
      kr1.x = pk2(y1[0], y1[1]); kr1.y = pk2(y1[2], y1[3]); kr2.x = pk2(y2[0], y2[1]); kr2.y = pk2(y2[2], y2[3]); }
    float rkv_r[4];
#pragma unroll
    for (int r = 0; r < 4; ++r) rkv_r[r] = __shfl(rkv, 4 * fq + r);
    const int chunk = s0 >> 6, key0 = (s0 & 63) + 4 * fq;
    __syncthreads();
#pragma unroll 1
    for (int h = 0; h < 4; ++h) {
        if (h < 3) MP_LOADQ(h + 1);
        const LAS bf16_t* UQ = (const LAS bf16_t*)(lds + (h & 1) * MP_BUF); const LAS bf16_t* UKV = (const LAS bf16_t*)(lds + (h & 1) * MP_BUF + MP_UKV_OFF);
        bf16_t* qrow = Qo + (tokrow + (size_t)h * SEQ) * 96; bf16_t* krow = Ko + (tokrow + (size_t)h * SEQ) * 96;
        bf16_t* vt = Vo + ((size_t)((b * 4 + h) * NCHUNK + chunk) * 64) * 64;
#pragma unroll 1
        for (int nt = 0; nt < 4; ++nt) { f32x4 a = {0.f, 0.f, 0.f, 0.f};
#pragma unroll
            for (int s = 0; s < 6; ++s) a = mfma16(*(const LAS bf16x8*)(UQ + (nt * 16 + fr) * MP_UQ_ROW + 32 * s + 8 * fq), cq[s], a);
            a = a * qsc; u32x2 w; w.x = pk2(a.x, a.y); w.y = pk2(a.z, a.w); *(u32x2*)(qrow + nt * 16 + 4 * fq) = w; }
        {   f32x4 x1 = {0.f, 0.f, 0.f, 0.f}, x2 = {0.f, 0.f, 0.f, 0.f}, y1, y2;
#pragma unroll
            for (int s = 0; s < 6; ++s) { x1 = mfma16(*(const LAS bf16x8*)(UQ + (64 + fr) * MP_UQ_ROW + 32 * s + 8 * fq), cq[s], x1); x2 = mfma16(*(const LAS bf16x8*)(UQ + (80 + fr) * MP_UQ_ROW + 32 * s + 8 * fq), cq[s], x2); }
            x1 = x1 * qsc; x2 = x2 * qsc;
#pragma unroll
            for (int r = 0; r < 4; ++r) { y1[r] = x1[r] * cs[r] - x2[r] * sn[r]; y2[r] = x1[r] * sn[r] + x2[r] * cs[r]; }
            u32x2 w; w.x = pk2(y1.x, y1.y); w.y = pk2(y1.z, y1.w); *(u32x2*)(qrow + 64 + 4 * fq) = w; w.x = pk2(y2.x, y2.y); w.y = pk2(y2.z, y2.w); *(u32x2*)(qrow + 80 + 4 * fq) = w; }
        if (h < 3) { MP_STOREQ((h + 1) & 1); MP_LOADKV(h + 1); }
#pragma unroll 1
        for (int nt = 0; nt < 4; ++nt) { f32x4 a = {0.f, 0.f, 0.f, 0.f};
#pragma unroll
            for (int s = 0; s < 4; ++s) a = mfma16(*(const LAS bf16x8*)(UKV + (nt * 16 + fr) * MP_UKV_ROW + 32 * s + 8 * fq), ckv[s], a);
            a = a * rkv; u32x2 w; w.x = pk2(a.x, a.y); w.y = pk2(a.z, a.w); *(u32x2*)(krow + nt * 16 + 4 * fq) = w; }
        *(u32x2*)(krow + 64 + 4 * fq) = kr1; *(u32x2*)(krow + 80 + 4 * fq) = kr2;
#pragma unroll 1
        for (int nt = 0; nt < 4; ++nt) { f32x4 a = {0.f, 0.f, 0.f, 0.f};
#pragma unroll
            for (int s = 0; s < 4; ++s) a = mfma16(ckv[s], *(const LAS bf16x8*)(UKV + (64 + nt * 16 + fr) * MP_UKV_ROW + 32 * s + 8 * fq), a);
            u32x2 w; w.x = pk2(a.x * rkv_r[0], a.y * rkv_r[1]); w.y = pk2(a.z * rkv_r[2], a.w * rkv_r[3]);
            *(u32x2*)(vt + (size_t)(nt * 16 + fr) * 64 + key0) = w; }
        if (h < 3) MP_STOREKV((h + 1) & 1);
        __syncthreads();
    }
#undef MP_LOADQ
#undef MP_STOREQ
#undef MP_LOADKV
#undef MP_STOREKV
}

template <int DQK, int DV, int KT, int QT>
__device__ __forceinline__ void flash_item(LAS unsigned char* lds, const bf16_t* Qw, int ldq, const bf16_t* Kb, int ldk, const bf16_t* VTb, int ldv, int vts,
                                           bf16_t* Ow, int ldo, int ntiles, int wave_limit, int tid, int lane) {
    constexpr int KROW = DQK + 8, VROW = KT + 8, KS = DQK / 32, ET = DV / 16, NKT = KT / 16, KBYTES = KT * KROW * 2, BUF = KBYTES + DV * VROW * 2;
    constexpr int KP = KT * DQK / 8, VPR = KT / 8, VP = DV * VPR, NKP = (KP + 511) / 512, NVP = (VP + 511) / 512, NP = NKP > NVP ? NKP : NVP;
    const int fr = lane & 15, fq = lane >> 4;
    bf16x8 qf[QT][KS];
#pragma unroll
    for (int qi = 0; qi < QT; ++qi)
#pragma unroll
        for (int s = 0; s < KS; ++s) qf[qi][s] = *(const bf16x8*)(Qw + (size_t)(qi * 16 + fr) * ldq + 32 * s + 8 * fq);
    f32x4 ot[QT][ET];
#pragma unroll
    for (int qi = 0; qi < QT; ++qi)
#pragma unroll
        for (int e = 0; e < ET; ++e) ot[qi][e] = (f32x4){0.f, 0.f, 0.f, 0.f};
    float m_run[QT], l_run[QT];
#pragma unroll
    for (int qi = 0; qi < QT; ++qi) { m_run[qi] = -1e30f; l_run[qi] = 0.f; }
    u32x4 preg[NP];
#define FL_LOADK(j_) do { _Pragma("unroll") for (int i = 0; i < NKP; ++i) { const int idx = tid + i * 512; if (idx < KP) { const int row = idx / (DQK / 8), pc = idx % (DQK / 8); \
            preg[i] = *(const u32x4*)(Kb + (size_t)((j_) * KT + row) * ldk + pc * 8); } } } while (0)
#define FL_LOADV(j_) do { _Pragma("unroll") for (int i = 0; i < NVP; ++i) { const int idx = tid + i * 512; if (idx < VP) { const int row = idx / VPR, pc = idx % VPR; \
            preg[i] = *(const u32x4*)(VTb + (size_t)(j_) * vts + (size_t)row * ldv + pc * 8); } } } while (0)
#define FL_STOREK(buf_) do { LAS bf16_t* Kt_ = (LAS bf16_t*)(lds + (buf_) * BUF); \
        _Pragma("unroll") for (int i = 0; i < NKP; ++i) { const int idx = tid + i * 512; if (idx < KP) { const int row = idx / (DQK / 8), pc = idx % (DQK / 8); *(LAS u32x4*)(Kt_ + row * KROW + pc * 8) = preg[i]; } } } while (0)
#define FL_STOREV(buf_) do { LAS bf16_t* Vt_ = (LAS bf16_t*)(lds + (buf_) * BUF + KBYTES); \
        _Pragma("unroll") for (int i = 0; i < NVP; ++i) { const int idx = tid + i * 512; if (idx < VP) { const int row = idx / VPR, pc = idx % VPR; *(LAS u32x4*)(Vt_ + row * VROW + pc * 8) = preg[i]; } } } while (0)
    FL_LOADK(0); FL_STOREK(0); FL_LOADV(0); FL_STOREV(0);
    __syncthreads();
#pragma unroll 1
    for (int j = 0; j < ntiles; ++j) {
        const bool more = j + 1 < ntiles, act = j < wave_limit;
        const LAS bf16_t* Kt = (const LAS bf16_t*)(lds + (j & 1) * BUF); const LAS bf16_t* Vt = (const LAS bf16_t*)(lds + (j & 1) * BUF + KBYTES);
        if (more) FL_LOADK(j + 1);
        f32x4 st[QT][NKT];
        if (act) {
#pragma unroll
            for (int kt = 0; kt < NKT; ++kt) {
#pragma unroll
                for (int qi = 0; qi < QT; ++qi) st[qi][kt] = (f32x4){0.f, 0.f, 0.f, 0.f};
#pragma unroll
                for (int s = 0; s < KS; ++s) { const bf16x8 kf = *(const LAS bf16x8*)(Kt + (kt * 16 + fr) * KROW + 32 * s + 8 * fq);
#pragma unroll
                    for (int qi = 0; qi < QT; ++qi) st[qi][kt] = mfma16(kf, qf[qi][s], st[qi][kt]); } }
        }
        if (more) { FL_STOREK((j + 1) & 1); FL_LOADV(j + 1); }
        if (act) {
            bf16x8 pf[QT][NKT / 2];
#pragma unroll
            for (int qi = 0; qi < QT; ++qi) {
                float mx = fmaxf(fmaxf(st[qi][0].x, st[qi][0].y), fmaxf(st[qi][0].z, st[qi][0].w));
#pragma unroll
                for (int kt = 1; kt < NKT; ++kt) mx = fmaxf(mx, fmaxf(fmaxf(st[qi][kt].x, st[qi][kt].y), fmaxf(st[qi][kt].z, st[qi][kt].w)));
                mx = fmaxf(mx, __shfl_xor(mx, 16)); mx = fmaxf(mx, __shfl_xor(mx, 32));
                const float m_new = fmaxf(m_run[qi], mx), alpha = fexp2_(m_run[qi] - m_new);
                float ls = 0.f;
#pragma unroll
                for (int kt = 0; kt < NKT; ++kt)
#pragma unroll
                    for (int r = 0; r < 4; ++r) { const float p = fexp2_(st[qi][kt][r] - m_new); st[qi][kt][r] = p; ls += p; }
                l_run[qi] = l_run[qi] * alpha + ls; m_run[qi] = m_new;
#pragma unroll
                for (int e = 0; e < ET; ++e) ot[qi][e] = ot[qi][e] * alpha;
#pragma unroll
                for (int k2 = 0; k2 < NKT / 2; ++k2) pf[qi][k2] = pack8(st[qi][2 * k2], st[qi][2 * k2 + 1]);
            }
#pragma unroll
            for (int e = 0; e < ET; ++e) {
                const LAS bf16_t* vr = Vt + (e * 16 + fr) * VROW + 4 * fq;
#pragma unroll
                for (int k2 = 0; k2 < NKT / 2; ++k2) { const bf16x8 v0 = mk8(*(const LAS u32x2*)(vr + 32 * k2), *(const LAS u32x2*)(vr + 32 * k2 + 16));
#pragma unroll
                    for (int qi = 0; qi < QT; ++qi) ot[qi][e] = mfma16(v0, pf[qi][k2], ot[qi][e]); }
            }
        }
        if (more) FL_STOREV((j + 1) & 1);
        __syncthreads();
    }
#undef FL_LOADK
#undef FL_LOADV
#undef FL_STOREK
#undef FL_STOREV
#pragma unroll
    for (int qi = 0; qi < QT; ++qi) {
        float l = l_run[qi]; l += __shfl_xor(l, 16); l += __shfl_xor(l, 32);
        const float inv = frcp_(l);
#pragma unroll
        for (int e = 0; e < ET; ++e) { u32x2 w; w.x = pk2(ot[qi][e].x * inv, ot[qi][e].y * inv); w.y = pk2(ot[qi][e].z * inv, ot[qi][e].w * inv);
            *(u32x2*)(Ow + (size_t)(qi * 16 + fr) * ldo + e * 16 + 4 * fq) = w; }
    }
}
__device__ __forceinline__ void mla_attn_item(const Params& P, LAS unsigned char* lds, int it, int tid, int wave, int lane) {
    const int qt = 7 - (it >> 6), bh = it & 63;
    const bf16_t* Q = (const bf16_t*)((unsigned char*)P.out + MLA_Q_OFF) + ((size_t)bh * SEQ + qt * 256 + wave * 32) * 96;
    const bf16_t* K = (const bf16_t*)((unsigned char*)P.out + MLA_K_OFF) + (size_t)bh * SEQ * 96;
    const bf16_t* VT = (const bf16_t*)((unsigned char*)P.out + MLA_VT_OFF) + (size_t)bh * NCHUNK * 4096;
    bf16_t* y = (bf16_t*)(P.ws + WS_R + R_Y) + ((size_t)(bh >> 2) * SEQ + qt * 256 + wave * 32) * DM + 512 + (bh & 3) * 64;
    flash_item<96, 64, 64, 2>(lds, Q, 96, K, 96, VT, 64, 4096, y, DM, 4 * qt + 4, 4 * qt + (wave >> 1) + 1, tid, lane);
}
constexpr int XA_KROW = 264, XA_VROW = 72, XA_KBUF = 32 * XA_KROW * 2, XA_VBUF = 128 * XA_VROW * 2, XA_VOFF = 2 * XA_KBUF;
__device__ __forceinline__ void xa_item(const Params& P, int l, LAS unsigned char* lds, int it, int tid, int wave, int lane) {
    const int qt = it & 7, h = (it >> 3) & 3, b = it >> 5, fr = lane & 15, fq = lane >> 4;
    const size_t qoff = ((size_t)b * SEQ + qt * 256 + wave * 32) * DM + h * 256;
    const bf16_t* Q = (const bf16_t*)(P.ws + WS_R) + qoff; bf16_t* O = (bf16_t*)(P.ws + WS_R + R_OX) + qoff;
    const bf16_t* Kb = (const bf16_t*)(P.ws + WS_KVM + (size_t)l * KVM_LAYER) + (size_t)b * NMEM * DM + h * 256;
    const bf16_t* VTb = (const bf16_t*)(P.ws + WS_KVM + (size_t)l * KVM_LAYER + (size_t)4096 * 1024 * 2) + (size_t)h * 256 * 4096 + b * NMEM;
    u32x4 stg[2];
#define XA_LOADK(j_) do { _Pragma("unroll") for (int i = 0; i < 2; ++i) { const int p = tid + 512 * i, row = p >> 5, pc = p & 31; stg[i] = *(const u32x4*)(Kb + (size_t)((j_) * 32 + row) * DM + pc * 8); } } while (0)
#define XA_STOREK(buf_) do { _Pragma("unroll") for (int i = 0; i < 2; ++i) { const int p = tid + 512 * i, row = p >> 5, pc = p & 31; *(LAS u32x4*)(lds + (buf_) * XA_KBUF + (row * XA_KROW + pc * 8) * 2) = stg[i]; } } while (0)
#define XA_LOADV(t_) do { _Pragma("unroll") for (int i = 0; i < 2; ++i) { const int p = tid + 512 * i, row = p >> 3, pc = p & 7; stg[i] = *(const u32x4*)(VTb + (size_t)(((t_) >> 2) * 128 + row) * 4096 + ((t_) & 3) * 64 + pc * 8); } } while (0)
#define XA_STOREV(buf_) do { _Pragma("unroll") for (int i = 0; i < 2; ++i) { const int p = tid + 512 * i, row = p >> 3, pc = p & 7; *(LAS u32x4*)(lds + XA_VOFF + (buf_) * XA_VBUF + (row * XA_VROW + pc * 8) * 2) = stg[i]; } } while (0)
    XA_LOADK(0);
    bf16x8 pf[2][8];
    float linv[2], c1[2];
    {
        bf16x8 qf[2][8];
#pragma unroll
        for (int qi = 0; qi < 2; ++qi)
#pragma unroll
            for (int s = 0; s < 8; ++s) qf[qi][s] = *(const bf16x8*)(Q + (size_t)(qi * 16 + fr) * DM + 32 * s + 8 * fq);
        XA_STOREK(0);
        __syncthreads();
        float m1[2], l1[2];
#pragma unroll
        for (int half = 0; half < 2; ++half) {
            f32x4 S[2][8];
#pragma unroll
            for (int jj = 0; jj < 4; ++jj) { const int j = half * 4 + jj;
                if (j < 7) XA_LOADK(j + 1); else XA_LOADV(0);
                const LAS bf16_t* Kt = (const LAS bf16_t*)(lds + (j & 1) * XA_KBUF);
#pragma unroll
                for (int kt = 0; kt < 2; ++kt) {
                    f32x4 a0 = {0.f, 0.f, 0.f, 0.f}, a1 = {0.f, 0.f, 0.f, 0.f};
#pragma unroll
                    for (int s = 0; s < 8; ++s) { const bf16x8 kf = *(const LAS bf16x8*)(Kt + (kt * 16 + fr) * XA_KROW + 32 * s + 8 * fq); a0 = mfma16(kf, qf[0][s], a0); a1 = mfma16(kf, qf[1][s], a1); }
                    S[0][2 * jj + kt] = a0; S[1][2 * jj + kt] = a1; __builtin_amdgcn_sched_barrier(0); }
                if (j < 7) XA_STOREK((j + 1) & 1); else XA_STOREV(0);
                __syncthreads();
            }
#pragma unroll
            for (int qi = 0; qi < 2; ++qi) {
                float mx = -1e30f;
#pragma unroll
                for (int t = 0; t < 8; ++t) mx = fmaxf(mx, fmaxf(fmaxf(S[qi][t].x, S[qi][t].y), fmaxf(S[qi][t].z, S[qi][t].w)));
                mx = fmaxf(mx, __shfl_xor(mx, 16)); mx = fmaxf(mx, __shfl_xor(mx, 32));
                if (half == 1) { const float m = fmaxf(m1[qi], mx); c1[qi] = fexp2_(m1[qi] - m); mx = m; }
                float ls = 0.f;
#pragma unroll
                for (int t = 0; t < 4; ++t) { f32x4 pa, pb;
#pragma unroll
                    for (int r = 0; r < 4; ++r) { pa[r] = fexp2_(S[qi][2 * t][r] - mx); pb[r] = fexp2_(S[qi][2 * t + 1][r] - mx); }
                    ls += ((pa.x + pa.y) + (pa.z + pa.w)) + ((pb.x + pb.y) + (pb.z + pb.w));
                    pf[qi][half * 4 + t] = pack8(pa, pb);
                    asm volatile("" : "+v"(ls)); }
                ls += __shfl_xor(ls, 16); ls += __shfl_xor(ls, 32);
                if (half == 0) { m1[qi] = mx; l1[qi] = ls; } else linv[qi] = frcp_(l1[qi] * c1[qi] + ls);
            }
        }
    }
#pragma unroll
    for (int eh = 0; eh < 2; ++eh) {
        f32x4 ot[2][8];
#pragma unroll
        for (int qi = 0; qi < 2; ++qi)
#pragma unroll
            for (int e = 0; e < 8; ++e) ot[qi][e] = (f32x4){0.f, 0.f, 0.f, 0.f};
#pragma unroll
        for (int jv = 0; jv < 4; ++jv) { const int t = eh * 4 + jv;
            if (t < 7) XA_LOADV(t + 1);
            const LAS bf16_t* Vt = (const LAS bf16_t*)(lds + XA_VOFF + (t & 1) * XA_VBUF);
#pragma unroll
            for (int e = 0; e < 8; ++e) { const LAS bf16_t* vr = Vt + (e * 16 + fr) * XA_VROW + 4 * fq;
                const bf16x8 v0 = mk8(*(const LAS u32x2*)vr, *(const LAS u32x2*)(vr + 16)), v1 = mk8(*(const LAS u32x2*)(vr + 32), *(const LAS u32x2*)(vr + 48));
                ot[0][e] = mfma16(v0, pf[0][2 * jv], ot[0][e]); ot[1][e] = mfma16(v0, pf[1][2 * jv], ot[1][e]);
                ot[0][e] = mfma16(v1, pf[0][2 * jv + 1], ot[0][e]); ot[1][e] = mfma16(v1, pf[1][2 * jv + 1], ot[1][e]); if (e & 1) __builtin_amdgcn_sched_barrier(0); }
            if (jv == 1) {
#pragma unroll
                for (int e = 0; e < 8; ++e) { ot[0][e] = ot[0][e] * c1[0]; ot[1][e] = ot[1][e] * c1[1]; } }
            if (t < 7) XA_STOREV((t + 1) & 1);
            __syncthreads();
        }
#pragma unroll
        for (int qi = 0; qi < 2; ++qi)
#pragma unroll
            for (int e = 0; e < 8; ++e) { u32x2 w; w.x = pk2(ot[qi][e].x * linv[qi], ot[qi][e].y * linv[qi]); w.y = pk2(ot[qi][e].z * linv[qi], ot[qi][e].w * linv[qi]);
                *(u32x2*)(O + (size_t)(qi * 16 + fr) * DM + eh * 128 + e * 16 + 4 * fq) = w; }
    }
#undef XA_LOADK
#undef XA_STOREK
#undef XA_LOADV
#undef XA_STOREV
}
constexpr int GP_KN = 0, GP_KB = 9216, GP_QN = 18432, GP_L = 9216, GP_RHS = 27648, GP_G = 60416, GP_GC = 60672, GP_HEAD = 61440;
__device__ __forceinline__ bf16_t* gdn_buf(const Params& P, int chh, int k) { return (bf16_t*)(P.ws + WS_GDN) + ((size_t)chh * 5 + k) * 4096; }
__device__ __forceinline__ void gdn_pre_item(const Params& P, int l, LAS unsigned char* lds, int it, int tid) {
    const int hp = it & 1, n = (it >> 1) & 31, b = it >> 6;
    const int hh = tid >> 8, h = 2 * hp + hh, tt = tid & 255, c = tt >> 2, qr = tt & 3, lane = tid & 63;
    LAS unsigned char* L = lds + hh * GP_HEAD;
    const bf16_t* z = (const bf16_t*)(P.ws + WS_R);
    const int s = n * 64 + c; const size_t tok = (size_t)b * SEQ + s;
    const float* cw = P.gdn_conv_w + (size_t)l * 4 * 768;
    const int chh = (b * NCHUNK + n) * 4 + h;
    float q[16], k[16], v[16];
#pragma unroll
    for (int part = 0; part < 3; ++part) {
        float* dst = part == 0 ? q : (part == 1 ? k : v);
        const int ch0 = part * 256 + h * 64 + qr * 16;
#pragma unroll
        for (int i = 0; i < 16; ++i) dst[i] = 0.f;
#pragma unroll
        for (int kk = 0; kk < 4; ++kk) { {
            const bool okk = s - 3 + kk >= 0; const float mk = okk ? 1.f : 0.f;
            const bf16_t* zr = z + (okk ? tok - 3 + kk : tok) * ZP + Z_GQKV + ch0; const u32x4 w0 = *(const u32x4*)zr, w1 = *(const u32x4*)(zr + 8);
            const float* wr = cw + kk * 768 + ch0; const f32x4 c0 = *(const f32x4*)wr * mk, c1 = *(const f32x4*)(wr + 4) * mk, c2 = *(const f32x4*)(wr + 8) * mk, c3 = *(const f32x4*)(wr + 12) * mk;
            dst[0] += c0.x * bflo(w0.x); dst[1] += c0.y * bfhi(w0.x); dst[2] += c0.z * bflo(w0.y); dst[3] += c0.w * bfhi(w0.y);
            dst[4] += c1.x * bflo(w0.z); dst[5] += c1.y * bfhi(w0.z); dst[6] += c1.z * bflo(w0.w); dst[7] += c1.w * bfhi(w0.w);
            dst[8] += c2.x * bflo(w1.x); dst[9] += c2.y * bfhi(w1.x); dst[10] += c2.z * bflo(w1.y); dst[11] += c2.w * bfhi(w1.y);
            dst[12] += c3.x * bflo(w1.z); dst[13] += c3.y * bfhi(w1.z); dst[14] += c3.z * bflo(w1.w); dst[15] += c3.w * bfhi(w1.w); } }
#pragma unroll
        for (int i = 0; i < 16; ++i) dst[i] = siluf_(dst[i]);
    }
    float sq = 0.f, sk = 0.f;
#pragma unroll
    for (int i = 0; i < 16; ++i) { sq += q[i] * q[i]; sk += k[i] * k[i]; }
    sq += __shfl_xor(sq, 1); sq += __shfl_xor(sq, 2); sk += __shfl_xor(sk, 1); sk += __shfl_xor(sk, 2);
    const float rq = frsq_(sq + EPS) * 0.125f, rk = frsq_(sk + EPS);
    const bf16_t* zt = z + tok * ZP;
    const float beta = sigmoidf_(bf2f(zt[Z_GB + h]));
    const float g = -fexp_(P.gdn_a_log[l * 4 + h]) * softplusf_(bf2f(zt[Z_GA + h]) + P.gdn_dt_bias[l * 4 + h]);
    {
        u32x4 w0, w1;
#define PK16(dst0, dst1, src, sc) do { dst0.x = pk2(src[0] * (sc), src[1] * (sc)); dst0.y = pk2(src[2] * (sc), src[3] * (sc)); dst0.z = pk2(src[4] * (sc), src[5] * (sc)); dst0.w = pk2(src[6] * (sc), src[7] * (sc)); \
        dst1.x = pk2(src[8] * (sc), src[9] * (sc)); dst1.y = pk2(src[10] * (sc), src[11] * (sc)); dst1.z = pk2(src[12] * (sc), src[13] * (sc)); dst1.w = pk2(src[14] * (sc), src[15] * (sc)); } while (0)
        PK16(w0, w1, k, rk);        *(LAS u32x4*)(L + GP_KN + (c * 72 + qr * 16) * 2) = w0; *(LAS u32x4*)(L + GP_KN + (c * 72 + qr * 16 + 8) * 2) = w1;
        PK16(w0, w1, k, rk * beta); *(LAS u32x4*)(L + GP_KB + (c * 72 + qr * 16) * 2) = w0; *(LAS u32x4*)(L + GP_KB + (c * 72 + qr * 16 + 8) * 2) = w1;
        PK16(w0, w1, q, rq);        *(LAS u32x4*)(L + GP_QN + (c * 72 + qr * 16) * 2) = w0; *(LAS u32x4*)(L + GP_QN + (c * 72 + qr * 16 + 8) * 2) = w1;
        LAS float* rhs = (LAS float*)(L + GP_RHS) + c * 128 + qr * 16;
#pragma unroll
        for (int i = 0; i < 4; ++i) *(LAS f32x4*)(rhs + 4 * i) = (f32x4){v[4 * i] * beta, v[4 * i + 1] * beta, v[4 * i + 2] * beta, v[4 * i + 3] * beta};
        if (qr == 0) ((LAS float*)(L + GP_G))[c] = g;
    }
    __syncthreads();
    {
        float gc = 0.f, run = 0.f; const LAS float* G = (const LAS float*)(L + GP_G);
        for (int i = 0; i < 64; ++i) { run += G[i]; gc = (i == c) ? run : gc; }
        const float eg = fexp_(gc), ek = fexp_(run - gc);
        LAS float* rhs = (LAS float*)(L + GP_RHS) + c * 128 + 64 + qr * 16;
#pragma unroll
        for (int i = 0; i < 4; ++i) *(LAS f32x4*)(rhs + 4 * i) = (f32x4){k[4 * i] * rk * beta * eg, k[4 * i + 1] * rk * beta * eg, k[4 * i + 2] * rk * beta * eg, k[4 * i + 3] * rk * beta * eg};
        u32x4 w0, w1; PK16(w0, w1, q, rq * eg);
        bf16_t* qd = gdn_buf(P, chh, 3) + c * 64 + qr * 16; *(u32x4*)qd = w0; *(u32x4*)(qd + 8) = w1;
        bf16_t* kdt = gdn_buf(P, chh, 4) + (qr * 16) * 64 + c;
#pragma unroll
        for (int i = 0; i < 16; ++i) kdt[i * 64] = f2bf(k[i] * rk * ek);
        if (qr == 0) ((LAS float*)(L + GP_GC))[c] = gc;
        if (tt == 0) ((float*)(P.ws + WS_GL))[chh] = fexp_(run);
    }
#undef PK16
    __syncthreads();
    {
        const int it4 = (tid >> 6) & 3, fr = lane & 15, fq = lane >> 4;
        const LAS bf16_t* Kn = (const LAS bf16_t*)(L + GP_KN); const LAS bf16_t* KB = (const LAS bf16_t*)(L + GP_KB); const LAS bf16_t* Qn = (const LAS bf16_t*)(L + GP_QN);
        const LAS float* GC = (const LAS float*)(L + GP_GC);
        const bf16x8 a0 = *(const LAS bf16x8*)(KB + (it4 * 16 + fr) * 72 + 8 * fq), a1 = *(const LAS bf16x8*)(KB + (it4 * 16 + fr) * 72 + 32 + 8 * fq);
        const bf16x8 q0 = *(const LAS bf16x8*)(Qn + (it4 * 16 + fr) * 72 + 8 * fq), q1 = *(const LAS bf16x8*)(Qn + (it4 * 16 + fr) * 72 + 32 + 8 * fq);
        float gci[4];
#pragma unroll
        for (int r = 0; r < 4; ++r) gci[r] = GC[it4 * 16 + 4 * fq + r];
        f32x4 lv[4]; bf16_t* att = gdn_buf(P, chh, 2);
#pragma unroll
        for (int jt = 0; jt < 4; ++jt) {
            const bf16x8 b0 = *(const LAS bf16x8*)(Kn + (jt * 16 + fr) * 72 + 8 * fq), b1 = *(const LAS bf16x8*)(Kn + (jt * 16 + fr) * 72 + 32 + 8 * fq);
            f32x4 al = {0.f, 0.f, 0.f, 0.f}, aa = {0.f, 0.f, 0.f, 0.f};
            al = mfma16(a0, b0, al); al = mfma16(a1, b1, al); aa = mfma16(q0, b0, aa); aa = mfma16(q1, b1, aa);
            const int j = jt * 16 + fr; const float gcj = GC[j];
#pragma unroll
            for (int r = 0; r < 4; ++r) { const int i = it4 * 16 + 4 * fq + r; const float dec = fexp_(fminf(gci[r] - gcj, 0.f));
                lv[jt][r] = (i > j) ? al[r] * dec : 0.f; att[i * 64 + j] = f2bf((i >= j) ? aa[r] * dec : 0.f); }
        }
        __syncthreads();
        LAS float* Lm = (LAS float*)(L + GP_L);
#pragma unroll
        for (int jt = 0; jt < 4; ++jt)
#pragma unroll
            for (int r = 0; r < 4; ++r) Lm[(it4 * 16 + 4 * fq + r) * 64 + jt * 16 + fr] = lv[jt][r];
    }
    __syncthreads();
    if (tt < 128) {
        const LAS float* Lm = (const LAS float*)(L + GP_L); const LAS float* rhs = (const LAS float*)(L + GP_RHS) + tt;
        float x[64];
#pragma unroll
        for (int i = 0; i < 64; ++i) {
            float a0 = rhs[i * 128], a1 = 0.f;
#pragma unroll
            for (int j4 = 0; j4 < (i + 3) / 4; ++j4) { const f32x4 lr = *(const LAS f32x4*)(Lm + i * 64 + 4 * j4);
                if (4 * j4 + 0 < i) a0 -= lr.x * x[4 * j4 + 0]; if (4 * j4 + 1 < i) a1 -= lr.y * x[4 * j4 + 1];
                if (4 * j4 + 2 < i) a0 -= lr.z * x[4 * j4 + 2]; if (4 * j4 + 3 < i) a1 -= lr.w * x[4 * j4 + 3]; }
            x[i] = a0 + a1;
        }
        if (tt < 64) { bf16_t* ut = gdn_buf(P, chh, 1) + tt * 64;
#pragma unroll
            for (int g8 = 0; g8 < 8; ++g8) { u32x4 w; w.x = pk2(x[8 * g8], x[8 * g8 + 1]); w.y = pk2(x[8 * g8 + 2], x[8 * g8 + 3]); w.z = pk2(x[8 * g8 + 4], x[8 * g8 + 5]); w.w = pk2(x[8 * g8 + 6], x[8 * g8 + 7]); *(u32x4*)(ut + 8 * g8) = w; }
        } else { bf16_t* wo = gdn_buf(P, chh, 0) + (tt - 64);
#pragma unroll
            for (int i = 0; i < 64; ++i) wo[i * 64] = f2bf(x[i]); }
    }
    __syncthreads();
}

constexpr int GC_W = 0, GC_UT = 9216, GC_ATT = 18432, GC_QD = 27648, GC_KDT = 36864, GC_O = 46080, GC_BH = 62720;
__device__ __forceinline__ bf16x8 lds_perm(const LAS unsigned char* M, int row, int s, int fq) { const LAS unsigned char* p = M + row * 144 + 64 * s + 8 * fq; return mk8(*(const LAS u32x2*)p, *(const LAS u32x2*)(p + 32)); }
__device__ __forceinline__ void gdn_chain_item(const Params& P, int l, LAS unsigned char* lds, int gi, int tid, int wave, int lane) {
    const int q2 = wave >> 2, bh = gi * 2 + q2, eb = wave & 3, b = bh >> 2, h = bh & 3, fr = lane & 15, fq = lane >> 4;
    const bf16_t* z = (const bf16_t*)(P.ws + WS_R); bf16_t* y = (bf16_t*)(P.ws + WS_R + R_Y);
    LAS unsigned char* L = lds + q2 * GC_BH;
    const int tt = tid & 255, ec = tt >> 2, eq = tt & 3;
    float ng[16];
#pragma unroll
    for (int j = 0; j < 16; ++j) ng[j] = P.gdn_norm[l * 64 + eq * 16 + j];
    u32x4 stg[10];
    const bf16_t* src0[2] = { gdn_buf(P, ((gi * 2 >> 2) * NCHUNK) * 4 + ((gi * 2) & 3), 0), gdn_buf(P, (((gi * 2 + 1) >> 2) * NCHUNK) * 4 + ((gi * 2 + 1) & 3), 0) };
#define GC_LOAD(n_) do { _Pragma("unroll") for (int i = 0; i < 10; ++i) { const int p = tid + 512 * i, qq = p / 2560, pp = p % 2560; \
        stg[i] = *(const u32x4*)(src0[qq] + (size_t)(n_) * 4 * 5 * 4096 + (size_t)pp * 8); } } while (0)
#define GC_WRITE() do { _Pragma("unroll") for (int i = 0; i < 10; ++i) { const int p = tid + 512 * i, qq = p / 2560, pp = p % 2560, mat = pp >> 9, row = (pp & 511) >> 3, pc = pp & 7; \
        *(LAS u32x4*)(lds + qq * GC_BH + mat * 9216 + row * 144 + pc * 16) = stg[i]; } } while (0)
    GC_LOAD(0); GC_WRITE();
    f32x4 S[4];
#pragma unroll
    for (int t = 0; t < 4; ++t) S[t] = (f32x4){0.f, 0.f, 0.f, 0.f};
    __syncthreads();
    for (int n = 0; n < NCHUNK; ++n) {
        const int chh = (b * NCHUNK + n) * 4 + h;
        if (n + 1 < NCHUNK) GC_LOAD(n + 1);
        const size_t etok = (size_t)(gi * 2 + (tid >> 8) >> 2) * SEQ + n * 64 + ec; const int eh = (gi * 2 + (tid >> 8)) & 3;
        const u32x4 gw0 = *(const u32x4*)(z + etok * ZP + Z_GG + eh * 64 + eq * 16), gw1 = *(const u32x4*)(z + etok * ZP + Z_GG + eh * 64 + eq * 16 + 8);
        const float egl = ((const float*)(P.ws + WS_GL))[chh];
        const bf16x8 sb0 = pack8(S[0], S[1]), sb1 = pack8(S[2], S[3]);
        f32x4 vn[4], o[4];
#pragma unroll
        for (int ct = 0; ct < 4; ++ct) {
            f32x4 a = {0.f, 0.f, 0.f, 0.f}; a = mfma16(lds_perm(L + GC_W, ct * 16 + fr, 0, fq), sb0, a); a = mfma16(lds_perm(L + GC_W, ct * 16 + fr, 1, fq), sb1, a);
            const u32x2 uw = *(const LAS u32x2*)(L + GC_UT + (eb * 16 + fr) * 144 + (ct * 16 + 4 * fq) * 2);
            vn[ct] = (f32x4){bflo(uw.x) - a.x, bfhi(uw.x) - a.y, bflo(uw.y) - a.z, bfhi(uw.y) - a.w};
            f32x4 oo = {0.f, 0.f, 0.f, 0.f}; oo = mfma16(lds_perm(L + GC_QD, ct * 16 + fr, 0, fq), sb0, oo); oo = mfma16(lds_perm(L + GC_QD, ct * 16 + fr, 1, fq), sb1, oo); o[ct] = oo;
        }
        const bf16x8 vb0 = pack8(vn[0], vn[1]), vb1 = pack8(vn[2], vn[3]);
#pragma unroll
        for (int ct = 0; ct < 4; ++ct) { o[ct] = mfma16(lds_perm(L + GC_ATT, ct * 16 + fr, 0, fq), vb0, o[ct]); o[ct] = mfma16(lds_perm(L + GC_ATT, ct * 16 + fr, 1, fq), vb1, o[ct]); }
#pragma unroll
        for (int dt = 0; dt < 4; ++dt) { f32x4 a = S[dt] * egl; a = mfma16(lds_perm(L + GC_KDT, dt * 16 + fr, 0, fq), vb0, a); a = mfma16(lds_perm(L + GC_KDT, dt * 16 + fr, 1, fq), vb1, a); S[dt] = a; }
        LAS float* Ol = (LAS float*)(L + GC_O);
#pragma unroll
        for (int ct = 0; ct < 4; ++ct)
#pragma unroll
            for (int r = 0; r < 4; ++r) Ol[(ct * 16 + 4 * fq + r) * 65 + eb * 16 + fr] = o[ct][r];
        __syncthreads();
        if (n + 1 < NCHUNK) GC_WRITE();
        {
            const LAS float* orow = (const LAS float*)(lds + (tid >> 8) * GC_BH + GC_O) + ec * 65 + eq * 16;
            float ov[16]; float s2 = 0.f;
#pragma unroll
            for (int j = 0; j < 16; ++j) { ov[j] = orow[j]; s2 += ov[j] * ov[j]; }
            s2 += __shfl_xor(s2, 1); s2 += __shfl_xor(s2, 2);
            const float rs = frsq_(s2 * (1.0f / 64.0f) + EPS);
            const unsigned gws[8] = {gw0.x, gw0.y, gw0.z, gw0.w, gw1.x, gw1.y, gw1.z, gw1.w};
            unsigned ow[8];
#pragma unroll
            for (int j = 0; j < 8; ++j) ow[j] = pk2(ov[2 * j] * rs * ng[2 * j] * siluf_(bflo(gws[j])), ov[2 * j + 1] * rs * ng[2 * j + 1] * siluf_(bfhi(gws[j])));
            bf16_t* yp = y + etok * DM + 768 + eh * 64 + eq * 16;
            *(u32x4*)yp = (u32x4){ow[0], ow[1], ow[2], ow[3]}; *(u32x4*)(yp + 8) = (u32x4){ow[4], ow[5], ow[6], ow[7]};
        }
        __syncthreads();
    }
#undef GC_LOAD
#undef GC_WRITE
}

constexpr int RT_BUF = 36864, RT_Q = 0, RT_K = 9216, RT_KZT = 18432, RT_VT = 27648, RT_P = 73728, RT_ST = 82944, RT_O = 92160;
__device__ __forceinline__ void ret_chain_item(const Params& P, int l, LAS unsigned char* lds, int it, int tid, int wave, int lane) {
    const int b = it >> 2, h = it & 3, fr = lane & 15, fq = lane >> 4;
    const bf16_t* z = (const bf16_t*)(P.ws + WS_R); bf16_t* y = (bf16_t*)(P.ws + WS_R + R_Y);
    LAS bf16_t* Pm = (LAS bf16_t*)(lds + RT_P); LAS bf16_t* ST = (LAS bf16_t*)(lds + RT_ST); LAS float* Of = (LAS float*)(lds + RT_O);
    const float lg = log1pf(-exp2f(-5.0f - (float)h));
    const float cdec = fexp_(64.0f * lg);
    for (int i = tid; i < 64 * 72 / 2; i += 512) ((LAS unsigned*)ST)[i] = 0u;
    const int it4 = wave >> 1, jt0 = 2 * (wave & 1);
    f32x4 S[2] = {{0.f, 0.f, 0.f, 0.f}, {0.f, 0.f, 0.f, 0.f}};
    const int lc = tid >> 3, pg = tid & 7;
    float invf[4];
#pragma unroll
    for (int ii = 0; ii < 4; ++ii) invf[ii] = exp2f(-(float)(4 * pg + ii) * (13.287712379549449f / 32.0f));
    const float zeta = fexp_((63.0f - (float)lc) * lg);
    const f32x4 gn0 = *(const f32x4*)(P.ret_gn + l * 256 + h * 64 + 8 * pg), gn1 = *(const f32x4*)(P.ret_gn + l * 256 + h * 64 + 8 * pg + 4);
    const size_t tok0 = (size_t)b * SEQ + lc;
    u32x2 q1w, q2w, k1w, k2w; u32x4 vw; int posi;
#define RT_LOAD(n_) do { const bf16_t* zr_ = z + (tok0 + (n_) * 64) * ZP; q1w = *(const u32x2*)(zr_ + Z_RQ + h * 64 + 4 * pg); q2w = *(const u32x2*)(zr_ + Z_RQ + h * 64 + 32 + 4 * pg); \
        k1w = *(const u32x2*)(zr_ + Z_RK + h * 64 + 4 * pg); k2w = *(const u32x2*)(zr_ + Z_RK + h * 64 + 32 + 4 * pg); vw = *(const u32x4*)(zr_ + Z_RV + h * 64 + 8 * pg); posi = P.pos[tok0 + (n_) * 64]; } while (0)
#define RT_STAGE(buf_) do { LAS bf16_t* Qs_ = (LAS bf16_t*)(lds + (buf_) * RT_BUF + RT_Q); LAS bf16_t* Ks_ = (LAS bf16_t*)(lds + (buf_) * RT_BUF + RT_K); \
        LAS bf16_t* KzT_ = (LAS bf16_t*)(lds + (buf_) * RT_BUF + RT_KZT); LAS bf16_t* VT_ = (LAS bf16_t*)(lds + (buf_) * RT_BUF + RT_VT); const float pos = (float)posi; \
        const float q1[4] = {bflo(q1w.x), bfhi(q1w.x), bflo(q1w.y), bfhi(q1w.y)}, q2[4] = {bflo(q2w.x), bfhi(q2w.x), bflo(q2w.y), bfhi(q2w.y)}; \
        const float k1[4] = {bflo(k1w.x), bfhi(k1w.x), bflo(k1w.y), bfhi(k1w.y)}, k2[4] = {bflo(k2w.x), bfhi(k2w.x), bflo(k2w.y), bfhi(k2w.y)}; \
        float qa[4], qb[4], ka[4], kb[4]; \
        _Pragma("unroll") for (int ii = 0; ii < 4; ++ii) { float sn, cs; sincos_rev(pos * invf[ii], sn, cs); \
            qa[ii] = (q1[ii] * cs - q2[ii] * sn) * 0.125f; qb[ii] = (q1[ii] * sn + q2[ii] * cs) * 0.125f; ka[ii] = k1[ii] * cs - k2[ii] * sn; kb[ii] = k1[ii] * sn + k2[ii] * cs; } \
        u32x2 w_; w_.x = pk2(qa[0], qa[1]); w_.y = pk2(qa[2], qa[3]); *(LAS u32x2*)(Qs_ + lc * 72 + 4 * pg) = w_; \
        w_.x = pk2(qb[0], qb[1]); w_.y = pk2(qb[2], qb[3]); *(LAS u32x2*)(Qs_ + lc * 72 + 32 + 4 * pg) = w_; \
        w_.x = pk2(ka[0], ka[1]); w_.y = pk2(ka[2], ka[3]); *(LAS u32x2*)(Ks_ + lc * 72 + 4 * pg) = w_; \
        w_.x = pk2(kb[0], kb[1]); w_.y = pk2(kb[2], kb[3]); *(LAS u32x2*)(Ks_ + lc * 72 + 32 + 4 * pg) = w_; \
        _Pragma("unroll") for (int ii = 0; ii < 4; ++ii) { KzT_[(4 * pg + ii) * 72 + lc] = f2bf(ka[ii] * zeta); KzT_[(32 + 4 * pg + ii) * 72 + lc] = f2bf(kb[ii] * zeta); } \
        const unsigned vv[4] = {vw.x, vw.y, vw.z, vw.w}; \
        _Pragma("unroll") for (int ii = 0; ii < 4; ++ii) { VT_[(8 * pg + 2 * ii) * 72 + lc] = (bf16_t)(vv[ii] & 0xffffu); VT_[(8 * pg + 2 * ii + 1) * 72 + lc] = (bf16_t)(vv[ii] >> 16); } } while (0)
    RT_LOAD(0); RT_STAGE(0);
    __syncthreads();
    for (int n = 0; n < NCHUNK; ++n) {
        const int cb = n & 1;
        const LAS bf16_t* Qs = (const LAS bf16_t*)(lds + cb * RT_BUF + RT_Q); const LAS bf16_t* Ks = (const LAS bf16_t*)(lds + cb * RT_BUF + RT_K);
        const LAS bf16_t* KzT = (const LAS bf16_t*)(lds + cb * RT_BUF + RT_KZT); const LAS bf16_t* VT = (const LAS bf16_t*)(lds + cb * RT_BUF + RT_VT);
        const size_t tok = tok0 + n * 64;
        if (n + 1 < NCHUNK) RT_LOAD(n + 1);
        const u32x4 gw = *(const u32x4*)(z + tok * ZP + Z_RG + h * 64 + 8 * pg);
        const bf16x8 a0 = *(const LAS bf16x8*)(Qs + (it4 * 16 + fr) * 72 + 8 * fq), a1 = *(const LAS bf16x8*)(Qs + (it4 * 16 + fr) * 72 + 32 + 8 * fq);
        f32x4 cross[2];
#pragma unroll
        for (int t = 0; t < 2; ++t) { const int jt = jt0 + t;
            f32x4 p = {0.f, 0.f, 0.f, 0.f};
            p = mfma16(a0, *(const LAS bf16x8*)(Ks + (jt * 16 + fr) * 72 + 8 * fq), p); p = mfma16(a1, *(const LAS bf16x8*)(Ks + (jt * 16 + fr) * 72 + 32 + 8 * fq), p);
            f32x4 cr = {0.f, 0.f, 0.f, 0.f};
            cr = mfma16(a0, *(const LAS bf16x8*)(ST + (jt * 16 + fr) * 72 + 8 * fq), cr); cr = mfma16(a1, *(const LAS bf16x8*)(ST + (jt * 16 + fr) * 72 + 32 + 8 * fq), cr);
#pragma unroll
            for (int r = 0; r < 4; ++r) { const int i = it4 * 16 + 4 * fq + r, j = jt * 16 + fr; const int dd = i > j ? i - j : j - i;
                Pm[i * 72 + j] = f2bf(p[r] * fexp_((float)dd * lg)); cr[r] *= fexp_((float)(i + 1) * lg); }
            cross[t] = cr; }
        __syncthreads();
        const bf16x8 p0 = *(const LAS bf16x8*)(Pm + (it4 * 16 + fr) * 72 + 8 * fq), p1 = *(const LAS bf16x8*)(Pm + (it4 * 16 + fr) * 72 + 32 + 8 * fq);
        const bf16x8 kz0 = *(const LAS bf16x8*)(KzT + (it4 * 16 + fr) * 72 + 8 * fq), kz1 = *(const LAS bf16x8*)(KzT + (it4 * 16 + fr) * 72 + 32 + 8 * fq);
#pragma unroll
        for (int t = 0; t < 2; ++t) { const int et = jt0 + t;
            const bf16x8 v0 = *(const LAS bf16x8*)(VT + (et * 16 + fr) * 72 + 8 * fq), v1 = *(const LAS bf16x8*)(VT + (et * 16 + fr) * 72 + 32 + 8 * fq);
            f32x4 o = cross[t]; o = mfma16(p0, v0, o); o = mfma16(p1, v1, o);
#pragma unroll
            for (int r = 0; r < 4; ++r) Of[(it4 * 16 + 4 * fq + r) * 65 + et * 16 + fr] = o[r];
            f32x4 sN = S[t] * cdec; sN = mfma16(kz0, v0, sN); sN = mfma16(kz1, v1, sN); S[t] = sN;
            u32x2 w; w.x = pk2(sN.x, sN.y); w.y = pk2(sN.z, sN.w); *(LAS u32x2*)(ST + (et * 16 + fr) * 72 + it4 * 16 + 4 * fq) = w; }
        if (n + 1 < NCHUNK) RT_STAGE(cb ^ 1);
        __syncthreads();
        {
            float ov[8]; float sm = 0.f;
#pragma unroll
            for (int j = 0; j < 8; ++j) { ov[j] = Of[lc * 65 + 8 * pg + j]; sm += ov[j]; }
            sm += __shfl_xor(sm, 1); sm += __shfl_xor(sm, 2); sm += __shfl_xor(sm, 4);
            const float mu = sm * (1.0f / 64.0f); float vs = 0.f;
#pragma unroll
            for (int j = 0; j < 8; ++j) { ov[j] -= mu; vs += ov[j] * ov[j]; }
            vs += __shfl_xor(vs, 1); vs += __shfl_xor(vs, 2); vs += __shfl_xor(vs, 4);
            const float rs = frsq_(vs * (1.0f / 64.0f) + EPS);
            const float gt[8] = {bflo(gw.x), bfhi(gw.x), bflo(gw.y), bfhi(gw.y), bflo(gw.z), bfhi(gw.z), bflo(gw.w), bfhi(gw.w)};
            const float gnv[8] = {gn0.x, gn0.y, gn0.z, gn0.w, gn1.x, gn1.y, gn1.z, gn1.w};
            float r8[8];
#pragma unroll
            for (int j = 0; j < 8; ++j) r8[j] = ov[j] * rs * gnv[j] * siluf_(gt[j]);
            u32x4 w; w.x = pk2(r8[0], r8[1]); w.y = pk2(r8[2], r8[3]); w.z = pk2(r8[4], r8[5]); w.w = pk2(r8[6], r8[7]);
            *(u32x4*)(y + tok * DM + h * 64 + 8 * pg) = w;
        }
    }
#undef RT_LOAD
#undef RT_STAGE
    __syncthreads();
}

constexpr int LR_XC = 0, LR_AU = 33792;
__device__ __forceinline__ void lru_item(const Params& P, int l, LAS unsigned char* lds, int it, int mode, int tid, int wave, int lane) {
    const int b = it >> 5, n = it & 31, fr = lane & 15, fq = lane >> 4;
    const bf16_t* z = (const bf16_t*)(P.ws + WS_R); bf16_t* y = (bf16_t*)(P.ws + WS_R + R_Y);
    LAS bf16_t* XC = (LAS bf16_t*)(lds + LR_XC); LAS f32x2* AU = (LAS f32x2*)(lds + LR_AU);
    float* sumA = (float*)(P.ws + WS_LRUS); float* sumH = sumA + 16 * 32 * 256;
    {
        const int c = tid >> 3, cg = tid & 7, s = n * 64 + c; const size_t tok = (size_t)b * SEQ + s;
        const float* cw = P.lru_conv_w + (size_t)l * 4 * 256; const float* cb = P.lru_conv_b + l * 256;
#pragma unroll
        for (int g = 0; g < 4; ++g) { const int ch0 = cg * 32 + g * 8;
            const f32x4 b0 = *(const f32x4*)(cb + ch0), b1 = *(const f32x4*)(cb + ch0 + 4);
            float a[8] = {b0.x, b0.y, b0.z, b0.w, b1.x, b1.y, b1.z, b1.w};
#pragma unroll
            for (int kk = 0; kk < 4; ++kk) { const bool okk = s - 3 + kk >= 0; const float mk = okk ? 1.f : 0.f;
                const u32x4 w = *(const u32x4*)(z + (okk ? tok - 3 + kk : tok) * ZP + Z_LX + ch0);
                const f32x4 c0 = *(const f32x4*)(cw + kk * 256 + ch0) * mk, c1 = *(const f32x4*)(cw + kk * 256 + ch0 + 4) * mk;
                a[0] += c0.x * bflo(w.x); a[1] += c0.y * bfhi(w.x); a[2] += c0.z * bflo(w.y); a[3] += c0.w * bfhi(w.y);
                a[4] += c1.x * bflo(w.z); a[5] += c1.y * bfhi(w.z); a[6] += c1.z * bflo(w.w); a[7] += c1.w * bfhi(w.w); }
            u32x4 o; o.x = pk2(a[0], a[1]); o.y = pk2(a[2], a[3]); o.z = pk2(a[4], a[5]); o.w = pk2(a[6], a[7]);
            *(LAS u32x4*)(XC + c * 264 + ch0) = o; }
    }
    float hcar = 0.f, aprod = 1.f;
    if (mode == 1 && tid < 256) {
        float av[32], hv[32];
#pragma unroll
        for (int m = 0; m < 32; ++m) { const int mm = m < n ? m : 0; av[m] = sumA[(b * 32 + mm) * 256 + tid]; hv[m] = sumH[(b * 32 + mm) * 256 + tid]; }
#pragma unroll
        for (int m = 0; m < 32; ++m) if (m < n) hcar = av[m] * hcar + hv[m];
    }
    const int nb = wave >> 1, rt = wave & 1;
    const bf16_t* wa = wl(P, l, W_A) + nb * 4096; const bf16_t* wx = wl(P, l, W_X) + nb * 4096;
    bf16x8 fa[4][2], fx[4][2]; float ba[4], bx[4], spl[4];
#pragma unroll
    for (int dt = 0; dt < 4; ++dt) {
#pragma unroll
        for (int s = 0; s < 2; ++s) { fa[dt][s] = *(const bf16x8*)(wa + (dt * 16 + fr) * 64 + 32 * s + 8 * fq); fx[dt][s] = *(const bf16x8*)(wx + (dt * 16 + fr) * 64 + 32 * s + 8 * fq); }
        const int d = nb * 64 + dt * 16 + fr; ba[dt] = P.lru_ba[l * 256 + d]; bx[dt] = P.lru_bx[l * 256 + d]; spl[dt] = -8.0f * softplusf_(-P.lru_lambda[l * 256 + d]); }
    __syncthreads();
    for (int half = 0; half < 2; ++half) {
        const int trow = half * 32 + rt * 16;
        const bf16x8 x0 = *(const LAS bf16x8*)(XC + (trow + fr) * 264 + nb * 64 + 8 * fq), x1 = *(const LAS bf16x8*)(XC + (trow + fr) * 264 + nb * 64 + 32 + 8 * fq);
#pragma unroll
        for (int dt = 0; dt < 4; ++dt) {
            f32x4 ar = {0.f, 0.f, 0.f, 0.f}, ai = {0.f, 0.f, 0.f, 0.f};
            ar = mfma16(x0, fa[dt][0], ar); ar = mfma16(x1, fa[dt][1], ar); ai = mfma16(x0, fx[dt][0], ai); ai = mfma16(x1, fx[dt][1], ai);
            const int d = nb * 64 + dt * 16 + fr;
#pragma unroll
            for (int r = 0; r < 4; ++r) { const int tl = rt * 16 + 4 * fq + r;
                const float xcv = bf2f(XC[(half * 32 + tl) * 264 + d]);
                const float rr = sigmoidf_(ar[r] + ba[dt]), ii = sigmoidf_(ai[r] + bx[dt]);
                const float a = fexp_(rr * spl[dt]);
                const float u = fsqrt_(fmaxf(1.0f - a * a, 0.f)) * (ii * xcv);
                AU[tl * 257 + d] = (f32x2){a, u}; }
        }
        __syncthreads();
        if (tid < 256) {
#pragma unroll 8
            for (int tk = 0; tk < 32; ++tk) { const f32x2 au = AU[tk * 257 + tid]; hcar = au.x * hcar + au.y; aprod *= au.x; if (mode == 1) AU[tk * 257 + tid].y = hcar; }
        }
        if (mode == 1) {
            __syncthreads();
            const int tk = tid >> 4, c0 = (tid & 15) * 16; const size_t tok = (size_t)b * SEQ + n * 64 + half * 32 + tk;
            const u32x4 g0 = *(const u32x4*)(z + tok * ZP + Z_LG + c0), g1 = *(const u32x4*)(z + tok * ZP + Z_LG + c0 + 8);
            const unsigned gws[8] = {g0.x, g0.y, g0.z, g0.w, g1.x, g1.y, g1.z, g1.w}; unsigned ow[8];
#pragma unroll
            for (int j = 0; j < 8; ++j) { const float h0 = AU[tk * 257 + c0 + 2 * j].y, h1 = AU[tk * 257 + c0 + 2 * j + 1].y; ow[j] = pk2(h0 * geluf_(bflo(gws[j])), h1 * geluf_(bfhi(gws[j]))); }
            bf16_t* yp = y + tok * DM + 256 + c0;
            *(u32x4*)yp = (u32x4){ow[0], ow[1], ow[2], ow[3]}; *(u32x4*)(yp + 8) = (u32x4){ow[4], ow[5], ow[6], ow[7]};
        }
        __syncthreads();
    }
    if (mode == 0 && tid < 256) { sumA[(b * 32 + n) * 256 + tid] = aprod; sumH[(b * 32 + n) * 256 + tid] = hcar; }
}

constexpr int LC_XC = 0, LC_AU = 9216;
__device__ __forceinline__ void lru_chain_item(const Params& P, int l, LAS unsigned char* lds, int it, int tid, int wave, int lane) {
    const int b = it >> 2, nb = it & 3, fr = lane & 15, fq = lane >> 4;
    const bf16_t* z = (const bf16_t*)(P.ws + WS_R); bf16_t* y = (bf16_t*)(P.ws + WS_R + R_Y);
    LAS bf16_t* XC = (LAS bf16_t*)(lds + LC_XC); LAS f32x2* AU = (LAS f32x2*)(lds + LC_AU);
    const int c = tid >> 3, cg = tid & 7, ch0 = nb * 64 + cg * 8;
    f32x4 cw0[4], cw1[4];
#pragma unroll
    for (int kk = 0; kk < 4; ++kk) { cw0[kk] = *(const f32x4*)(P.lru_conv_w + (size_t)l * 1024 + kk * 256 + ch0); cw1[kk] = *(const f32x4*)(P.lru_conv_w + (size_t)l * 1024 + kk * 256 + ch0 + 4); }
    const f32x4 cb0 = *(const f32x4*)(P.lru_conv_b + l * 256 + ch0), cb1 = *(const f32x4*)(P.lru_conv_b + l * 256 + ch0 + 4);
    const int rt = wave >> 1, dt0 = (wave & 1) * 2;
    const bf16_t* wa = wl(P, l, W_A) + nb * 4096; const bf16_t* wx = wl(P, l, W_X) + nb * 4096;
    bf16x8 fa[2][2], fx[2][2]; float ba[2], bx[2], spl[2];
#pragma unroll
    for (int t = 0; t < 2; ++t) {
#pragma unroll
        for (int s = 0; s < 2; ++s) { fa[t][s] = *(const bf16x8*)(wa + ((dt0 + t) * 16 + fr) * 64 + 32 * s + 8 * fq); fx[t][s] = *(const bf16x8*)(wx + ((dt0 + t) * 16 + fr) * 64 + 32 * s + 8 * fq); }
        const int d = nb * 64 + (dt0 + t) * 16 + fr; ba[t] = P.lru_ba[l * 256 + d]; bx[t] = P.lru_bx[l * 256 + d]; spl[t] = -8.0f * softplusf_(-P.lru_lambda[l * 256 + d]); }
    const size_t tok0 = (size_t)b * SEQ + c;
    u32x4 xr[4], gr;
#define LC_LOAD(n_) do { const size_t t_ = tok0 + (size_t)(n_) * 64; _Pragma("unroll") for (int kk = 0; kk < 4; ++kk) { const bool ok_ = (n_) * 64 + c - 3 + kk >= 0; \
        xr[kk] = *(const u32x4*)(z + (ok_ ? t_ - 3 + kk : t_) * ZP + Z_LX + ch0); } gr = *(const u32x4*)(z + t_ * ZP + Z_LG + ch0); } while (0)
    LC_LOAD(0);
    float hcar = 0.f;
    for (int n = 0; n < NCHUNK; ++n) {
        {
            float a[8] = {cb0.x, cb0.y, cb0.z, cb0.w, cb1.x, cb1.y, cb1.z, cb1.w};
#pragma unroll
            for (int kk = 0; kk < 4; ++kk) { const float mk = (n * 64 + c - 3 + kk >= 0) ? 1.f : 0.f; const f32x4 c0 = cw0[kk] * mk, c1 = cw1[kk] * mk; const u32x4 w = xr[kk];
                a[0] += c0.x * bflo(w.x); a[1] += c0.y * bfhi(w.x); a[2] += c0.z * bflo(w.y); a[3] += c0.w * bfhi(w.y);
                a[4] += c1.x * bflo(w.z); a[5] += c1.y * bfhi(w.z); a[6] += c1.z * bflo(w.w); a[7] += c1.w * bfhi(w.w); }
            u32x4 o; o.x = pk2(a[0], a[1]); o.y = pk2(a[2], a[3]); o.z = pk2(a[4], a[5]); o.w = pk2(a[6], a[7]);
            *(LAS u32x4*)(XC + c * 72 + cg * 8) = o;
        }
        const u32x4 gcur = gr;
        if (n + 1 < NCHUNK) LC_LOAD(n + 1);
        __syncthreads();
        {
            const bf16x8 x0 = *(const LAS bf16x8*)(XC + (rt * 16 + fr) * 72 + 8 * fq), x1 = *(const LAS bf16x8*)(XC + (rt * 16 + fr) * 72 + 32 + 8 * fq);
#pragma unroll
            for (int t = 0; t < 2; ++t) {
                f32x4 ar = {0.f, 0.f, 0.f, 0.f}, ai = {0.f, 0.f, 0.f, 0.f};
                ar = mfma16(x0, fa[t][0], ar); ar = mfma16(x1, fa[t][1], ar); ai = mfma16(x0, fx[t][0], ai); ai = mfma16(x1, fx[t][1], ai);
                const int dl = (dt0 + t) * 16 + fr;
#pragma unroll
                for (int r = 0; r < 4; ++r) { const int tl = rt * 16 + 4 * fq + r;
                    const float xcv = bf2f(XC[tl * 72 + dl]);
                    const float rr = sigmoidf_(ar[r] + ba[t]), ii = sigmoidf_(ai[r] + bx[t]);
                    const float av = fexp_(rr * spl[t]);
                    AU[tl * 65 + dl] = (f32x2){av, fsqrt_(fmaxf(1.0f - av * av, 0.f)) * (ii * xcv)}; }
            }
        }
        __syncthreads();
        if (tid < 64) {
#pragma unroll
            for (int blk = 0; blk < 4; ++blk) { f32x2 au[16];
#pragma unroll
                for (int k = 0; k < 16; ++k) au[k] = AU[(blk * 16 + k) * 65 + tid];
#pragma unroll
                for (int k = 0; k < 16; ++k) { hcar = au[k].x * hcar + au[k].y; au[k].y = hcar; }
#pragma unroll
                for (int k = 0; k < 16; ++k) AU[(blk * 16 + k) * 65 + tid].y = au[k].y; }
        }
        __syncthreads();
        {
            const unsigned gws[4] = {gcur.x, gcur.y, gcur.z, gcur.w}; unsigned ow[4];
#pragma unroll
            for (int j = 0; j < 4; ++j) ow[j] = pk2(AU[c * 65 + cg * 8 + 2 * j].y * geluf_(bflo(gws[j])), AU[c * 65 + cg * 8 + 2 * j + 1].y * geluf_(bfhi(gws[j])));
            *(u32x4*)(y + (tok0 + (size_t)n * 64) * DM + 256 + ch0) = (u32x4){ow[0], ow[1], ow[2], ow[3]};
        }
    }
#undef LC_LOAD
    __syncthreads();
}

constexpr int N_PHASES = 21;
constexpr int Q_RET = 64, Q_GDN = 32, Q_LRU = 64, Q_MLA = 512, Q_TOTAL = Q_RET + Q_GDN + Q_LRU + Q_MLA;

__global__ void __launch_bounds__(512, 2) hymba_fwd(Params P_) {
    extern __shared__ __attribute__((aligned(16))) unsigned char lds_raw[];
    LAS unsigned char* lds = (LAS unsigned char*)lds_raw;
    volatile LAS unsigned* LC = (volatile LAS unsigned*)(lds + LDS_CTL);
    const int G = gridDim.x;
#define SUB_TID() int tid2 = tid; asm volatile("" : "+v"(tid2)); const int lane2 = tid2 & 63, wave2 = __builtin_amdgcn_readfirstlane(tid2 >> 6); (void)lane2; (void)wave2
#if defined(__HIP_DEVICE_COMPILE__)
#define PH_PARAMS() const __attribute__((address_space(4))) Params* pp_ = (const __attribute__((address_space(4))) Params*)__builtin_amdgcn_kernarg_segment_ptr(); asm volatile("" : "+s"(pp_)); const Params P = *pp_
#else
#define PH_PARAMS() const Params P = P_
#endif
#define PH_TID() PH_PARAMS(); \
    bf16_t* xb = (bf16_t*)(P.ws + WS_XB); float* part = (float*)(P.ws + WS_PART); bf16_t* zb = (bf16_t*)(P.ws + WS_R); bf16_t* yb = (bf16_t*)(P.ws + WS_R + R_Y); bf16_t* oxb = (bf16_t*)(P.ws + WS_R + R_OX); (void)xb; (void)part; (void)zb; (void)yb; (void)oxb; \
    int tid = threadIdx.x; asm volatile("" : "+v"(tid)); const int lane = tid & 63, wave = __builtin_amdgcn_readfirstlane(tid >> 6); (void)lane; (void)wave
    unsigned* ctl = (unsigned*)(P_.ws + WS_CTL);
    if (threadIdx.x < 64) LC[threadIdx.x] = 0u;
    __syncthreads();
    const int lo = P_.ph_lo, hi = P_.ph_hi;
    XcdBarrier bar; bar.bar = ctl + CW_BAR; bar.x = 0; bar.st = LC;
    if (hi - lo > 1) bar = xcd_barrier_post(ctl + CW_BAR, LC);
#ifndef PHASE_MASK
#define PHASE_MASK 0xFFFFFFFFu
#endif
#define EN(t) ((PHASE_MASK >> (t)) & 1u)
#ifndef REPEAT_MASK
#define REPEAT_MASK 0u
#endif
#define REP(t) for (int rep_ = 0; rep_ <= (int)((REPEAT_MASK >> (t)) & 1u); ++rep_, (rep_ <= (int)((REPEAT_MASK >> (t)) & 1u) ? xcd_barrier(bar) : (void)0))
#define IN(k) (lo <= (k) && (k) < hi)
#define SEAM(k) do { if (IN(k) && IN((k) + 1)) xcd_barrier(bar); } while (0)


    if (IN(0) && EN(0)) REP(0) { PH_TID(); p0_prologue(P, lds, tid); __syncthreads(); }
    SEAM(0);
    if (IN(1) && EN(1)) REP(1) {
        PH_TID();
        const int which = blockIdx.x >> 6, l = which >> 1, isv = which & 1;
        if (which < 4) {
            const bf16_t* memn = (const bf16_t*)(P.ws + WS_GDN); const bf16_t* wkv = wl(P, l, W_KV);
            bf16_t* kout = (bf16_t*)(P.ws + WS_KVM + (size_t)l * KVM_LAYER); bf16_t* vout = kout + (size_t)4096 * 1024;
            pg8::Gemm g; pg8::EpiScaleBf16<0> E; pg8::StaticOrder S;
            if (!isv) { g = pg8::Gemm{memn, wkv, 4096, 1024, 1024}; E = pg8::EpiScaleBf16<0>{kout, 1024, nullptr}; S.init(4096, 1024, 64, blockIdx.x & 63); }
            else { g = pg8::Gemm{wkv + (size_t)1024 * 1024, memn, 1024, 4096, 1024}; E = pg8::EpiScaleBf16<0>{vout, 4096, nullptr}; S.init(1024, 4096, 64, blockIdx.x & 63); }
            pg8::gemm_phase(lds, g, S, E, tid);
        }
    }
    SEAM(1);
#pragma unroll
    for (int l = 0; l < 2; ++l) {
        const int pb = 2 + 9 * l;
        if (IN(pb + 0) && EN(2)) REP(2) { PH_TID();
            pg8::Gemm g{xb, wl(P, l, W_IN), T_TOK, ZP, DM}; pg8::StaticOrder S; S.init(T_TOK, ZP, G, blockIdx.x);
            pg8::EpiScaleBf16<0> E{zb, ZP, part}; pg8::gemm_phase(lds, g, S, E, tid);
        }
        SEAM(pb + 0);
        if (IN(pb + 1)) {
            PH_TID();
            if (EN(3)) REP(3) { SUB_TID();
_Pragma("unroll 1")
            for (int it = blockIdx.x; it < 1024; it += G) gdn_pre_item(P, l, lds, it, tid2); }
            if (EN(5)) REP(5) { SUB_TID();
_Pragma("unroll 1")
            for (int it = blockIdx.x; it < 256; it += G) mla_pre_item(P, l, lds, it, tid2, wave2, lane2); }
        }
        SEAM(pb + 1);
        if (IN(pb + 2)) {
            PH_TID();
            for (int rep2_ = 0; rep2_ <= (int)((REPEAT_MASK >> 17) & 1u); ++rep2_, (rep2_ <= (int)((REPEAT_MASK >> 17) & 1u) ? xcd_barrier(bar) : (void)0)) {
            unsigned* qh0 = ctl + CW_QUEUE + 64 * l + 16 * rep2_;
#define QUEUE_LOOP(qi_, count_, body_) for (;;) { if (tid == 0) LC[4] = __hip_atomic_fetch_add(qh + (qi_), 1u, __ATOMIC_RELAXED, __HIP_MEMORY_SCOPE_AGENT); \
                __syncthreads(); const int it = (int)LC[4]; __syncthreads(); if (it >= (count_)) break; { SUB_TID(); body_; } __syncthreads(); }
            if (EN(6)) REP(6) { unsigned* qh = qh0 + 32 * rep_; QUEUE_LOOP(0, Q_RET, ret_chain_item(P, l, lds, it, tid2, wave2, lane2)) }
            if (EN(7)) REP(7) { unsigned* qh = qh0 + 32 * rep_; QUEUE_LOOP(1, Q_GDN, gdn_chain_item(P, l, lds, it, tid2, wave2, lane2)) }
            if (EN(8)) REP(8) { unsigned* qh = qh0 + 32 * rep_; QUEUE_LOOP(2, Q_LRU, lru_chain_item(P, l, lds, it, tid2, wave2, lane2)) }
            if (EN(9)) REP(9) { unsigned* qh = qh0 + 32 * rep_; QUEUE_LOOP(3, Q_MLA, mla_attn_item(P, lds, it, tid2, wave2, lane2)) }
#undef QUEUE_LOOP
            }
        }
        SEAM(pb + 2);
        if (IN(pb + 3) && EN(10)) REP(10) { PH_TID();
            pg8::Gemm g{yb, wl(P, l, W_OUT), T_TOK, DM, DM}; pg8::StaticOrder S; S.init(T_TOK, DM, G, blockIdx.x);
            pg8::EpiResid E{xb, part, rep_ ? 0.f : 1.f}; pg8::gemm_phase(lds, g, S, E, tid);
        }
        SEAM(pb + 3);
        if (IN(pb + 4) && EN(11)) REP(11) { PH_TID();
            pg8::Gemm g{xb, wl(P, l, W_Q), T_TOK, DM, DM}; pg8::StaticOrder S; S.init(T_TOK, DM, G, blockIdx.x);
            pg8::EpiScaleBf16<0> E{zb, DM, part}; pg8::gemm_phase(lds, g, S, E, tid);
        }
        SEAM(pb + 4);
        if (IN(pb + 5) && EN(12)) REP(12) { PH_TID();
_Pragma("unroll 1")
            for (int it = blockIdx.x; it < 512; it += G) { SUB_TID(); xa_item(P, l, lds, it, tid2, wave2, lane2); __syncthreads(); } }
        SEAM(pb + 5);
        if (IN(pb + 6) && EN(13)) REP(13) { PH_TID();
            pg8::Gemm g{oxb, wl(P, l, W_O), T_TOK, DM, DM}; pg8::StaticOrder S; S.init(T_TOK, DM, G, blockIdx.x);
            pg8::EpiResid E{xb, part, rep_ ? 0.f : 1.f}; pg8::gemm_phase(lds, g, S, E, tid);
        }
        SEAM(pb + 6);
        if (IN(pb + 7) && EN(14)) REP(14) { PH_TID();
            pg8::Gemm g{xb, wl(P, l, W_1), T_TOK, DFF, DM}; pg8::StaticOrder S; S.init(T_TOK, DFF, G, blockIdx.x);
            pg8::EpiScaleBf16<1> E{zb, DFF, part}; pg8::gemm_phase(lds, g, S, E, tid);
        }
        SEAM(pb + 7);
        if (IN(pb + 8) && EN(15)) REP(15) { PH_TID();
            pg8::Gemm g{zb, wl(P, l, W_2), T_TOK, DM, DFF}; pg8::StaticOrder S; S.init(T_TOK, DM, G, blockIdx.x);
            pg8::EpiResid E{xb, part, rep_ ? 0.f : 1.f}; pg8::gemm_phase(lds, g, S, E, tid);
        }
        SEAM(pb + 8);
    }
    if (IN(20) && EN(16)) { PH_TID(); final_norm_phase(P, tid); }
#undef IN
#undef SEAM
}

extern "C" void kernel_launch(void* const* d_in, const int* in_sizes, int n_in, void* d_out, int out_size, void* d_ws, size_t ws_size, hipStream_t stream) {
    static int grid = 0;
    if (grid == 0) {
        if (n_in != 31 || out_size != T_TOK * DM || ws_size < WS_END) { fprintf(stderr, "kernel_launch: unexpected shapes (n_in %d out %d ws %zu, need %zu)\n", n_in, out_size, ws_size, (size_t)WS_END); grid = -1; return; }
        if (hipFuncSetAttribute((const void*)hymba_fwd, hipFuncAttributeMaxDynamicSharedMemorySize, LDS_BYTES) != hipSuccess) { fprintf(stderr, "kernel_launch: hipFuncSetAttribute failed\n"); grid = -1; return; }
        int dev = 0, cus = 0, per_cu = 0;
        (void)hipGetDevice(&dev); (void)hipDeviceGetAttribute(&cus, hipDeviceAttributeMultiprocessorCount, dev);
        (void)hipOccupancyMaxActiveBlocksPerMultiprocessor(&per_cu, (const void*)hymba_fwd, 512, LDS_BYTES);
        (void)hipGetLastError();
        if (cus != 256 || per_cu < 1) fprintf(stderr, "kernel_launch: note: cus %d per_cu %d\n", cus, per_cu);
        grid = 256;
    }
    if (grid < 0) return;
    (void)hipMemsetAsync((char*)d_ws + WS_CTL, 0, CTL_BYTES, stream);
    Params p{};
    p.x = (const float*)d_in[0]; p.mem = (const float*)d_in[1]; p.pos = (const int*)d_in[2];
    p.norm_mix = (const float*)d_in[3]; p.w_in = (const float*)d_in[4]; p.ret_gn = (const float*)d_in[5];
    p.lru_conv_w = (const float*)d_in[6]; p.lru_conv_b = (const float*)d_in[7]; p.lru_wa = (const float*)d_in[8]; p.lru_ba = (const float*)d_in[9];
    p.lru_wx = (const float*)d_in[10]; p.lru_bx = (const float*)d_in[11]; p.lru_lambda = (const float*)d_in[12];
    p.mla_q_norm = (const float*)d_in[13]; p.mla_w_uq = (const float*)d_in[14]; p.mla_kv_norm = (const float*)d_in[15]; p.mla_w_ukv = (const float*)d_in[16];
    p.gdn_conv_w = (const float*)d_in[17]; p.gdn_a_log = (const float*)d_in[18]; p.gdn_dt_bias = (const float*)d_in[19]; p.gdn_norm = (const float*)d_in[20];
    p.w_out = (const float*)d_in[21]; p.norm_xattn = (const float*)d_in[22]; p.norm_mem = (const float*)d_in[23];
    p.xa_wq = (const float*)d_in[24]; p.xa_wkv = (const float*)d_in[25]; p.xa_wo = (const float*)d_in[26];
    p.norm_mlp = (const float*)d_in[27]; p.mlp_w1 = (const float*)d_in[28]; p.mlp_w2 = (const float*)d_in[29]; p.final_norm = (const float*)d_in[30];
    p.out = (float*)d_out; p.ws = (unsigned char*)d_ws;
#if N_LAUNCHES == 1
    p.ph_lo = 0; p.ph_hi = N_PHASES;
    void* args[] = {&p};
    hipError_t e = hipLaunchCooperativeKernel((const void*)hymba_fwd, dim3(grid), dim3(512), args, LDS_BYTES, stream);
    if (e != hipSuccess) fprintf(stderr, "kernel_launch: cooperative launch failed: %s\n", hipGetErrorString(e));
#else
    for (int ph = 0; ph < N_PHASES; ++ph) { p.ph_lo = ph; p.ph_hi = ph + 1; hipLaunchKernelGGL(hymba_fwd, dim3(grid), dim3(512), LDS_BYTES, stream, p); }
#endif
}
```

```cpp
#include <hip/hip_runtime.h>
#include <cstdio>
#include <cstdint>

#ifndef N_LAUNCHES
#define N_LAUNCHES 1
#endif

#define LAS __attribute__((address_space(3)))
typedef unsigned short bf16_t;
typedef short bf16x8 __attribute__((ext_vector_type(8)));
typedef float f32x4 __attribute__((ext_vector_type(4)));
typedef float f32x2 __attribute__((ext_vector_type(2)));
typedef unsigned u32x4 __attribute__((ext_vector_type(4)));
typedef unsigned u32x2 __attribute__((ext_vector_type(2)));

constexpr int T_TOK = 32768, DM = 1024, SEQ = 2048, NBATCH = 16, NCHUNK = 32, ZP = 3072, DFF = 4096, NMEM = 256;
constexpr int Z_RQ = 0, Z_RK = 256, Z_RV = 512, Z_RG = 768, Z_LX = 1024, Z_LG = 1280, Z_CQ = 1536, Z_CKV = 1728, Z_KR = 1856,
              Z_GQKV = 1888, Z_GG = 2656, Z_GB = 2912, Z_GA = 2916, IN_COLS = 2920;
constexpr float EPS = 1e-6f;
constexpr float LOG2E = 1.4426950408889634f;

constexpr size_t MiB = 1024 * 1024;
constexpr size_t WS_CTL = 0;
constexpr size_t CTL_BYTES = 65536;
constexpr size_t WS_PART = WS_CTL + CTL_BYTES;
constexpr size_t WS_LRUS = WS_PART + (size_t)T_TOK * 16 * 4;
constexpr size_t WS_GL = WS_LRUS + (size_t)2 * 16 * 32 * 256 * 4;
constexpr size_t WS_W = WS_GL + 65536;
constexpr size_t W_IN = 0, W_OUT = W_IN + (size_t)ZP * DM, W_Q = W_OUT + (size_t)DM * DM, W_KV = W_Q + (size_t)DM * DM, W_O = W_KV + (size_t)2 * DM * DM,
                 W_1 = W_O + (size_t)DM * DM, W_2 = W_1 + (size_t)DFF * DM, W_UQ = W_2 + (size_t)DFF * DM, W_UKV = W_UQ + 384 * 192, W_A = W_UKV + 512 * 128,
                 W_X = W_A + 4 * 64 * 64, W_LAYER = W_X + 4 * 64 * 64;
constexpr size_t WS_XB = WS_W + 2 * W_LAYER * 2;
constexpr size_t XB_BYTES = (size_t)T_TOK * DM * 2;
constexpr size_t MLA_Q_OFF = 0, MLA_K_OFF = (size_t)T_TOK * 4 * 96 * 2, MLA_VT_OFF = 2 * MLA_K_OFF;
constexpr size_t WS_KVM = WS_XB + XB_BYTES;
constexpr size_t KVM_LAYER = (size_t)2 * 4096 * 1024 * 2;
constexpr size_t WS_R = WS_KVM + 2 * KVM_LAYER;
constexpr size_t R_Y = (size_t)T_TOK * ZP * 2;
constexpr size_t R_OX = (size_t)T_TOK * DM * 2;
constexpr size_t WS_GDN = WS_R + 256 * MiB;
constexpr size_t WS_END = WS_GDN + 80 * MiB;
static_assert(WS_END <= 512 * MiB, "workspace map exceeds 512 MiB");
static_assert(WS_XB % 256 == 0 && WS_R % 256 == 0 && WS_GDN % 256 == 0 && WS_W % 256 == 0, "alignment");
constexpr int CW_BAR = 0;
constexpr int CW_QUEUE = 4096;

constexpr int LDS_BYTES = 160 * 1024;
constexpr int LDS_CTL = LDS_BYTES - 256;

typedef __bf16 bf16x2_t __attribute__((ext_vector_type(2)));
__device__ __forceinline__ unsigned pk2(float lo, float hi) { f32x2 t = {lo, hi}; bf16x2_t v = __builtin_convertvector(t, bf16x2_t); return __builtin_bit_cast(unsigned, v); }
__device__ __forceinline__ float bflo(unsigned w) { return __uint_as_float(w << 16); }
__device__ __forceinline__ float bfhi(unsigned w) { return __uint_as_float(w & 0xffff0000u); }
__device__ __forceinline__ float bf2f(bf16_t v) { return __uint_as_float((unsigned)v << 16); }
__device__ __forceinline__ bf16_t f2bf(float f) { return (bf16_t)(pk2(f, 0.f) & 0xffffu); }
__device__ __forceinline__ f32x4 mfma16(bf16x8 a, bf16x8 b, f32x4 c) { return __builtin_amdgcn_mfma_f32_16x16x32_bf16(a, b, c, 0, 0, 0); }
__device__ __forceinline__ float fexp2_(float x) { return __builtin_amdgcn_exp2f(x); }
__device__ __forceinline__ float fexp_(float x) { return __builtin_amdgcn_exp2f(x * LOG2E); }
__device__ __forceinline__ float frcp_(float x) { return __builtin_amdgcn_rcpf(x); }
__device__ __forceinline__ float frsq_(float x) { return __builtin_amdgcn_rsqf(x); }
__device__ __forceinline__ float fsqrt_(float x) { return __builtin_amdgcn_sqrtf(x); }
__device__ __forceinline__ float sigmoidf_(float x) { return frcp_(1.0f + fexp_(-x)); }
__device__ __forceinline__ float siluf_(float x) { return x * frcp_(1.0f + fexp_(-x)); }
__device__ __forceinline__ float softplusf_(float x) { return x > 20.f ? x : log1pf(__expf(x)); }
__device__ __forceinline__ float geluf_(float x) { const float u = 1.5957691216057308f * (x + 0.044715f * x * x * x); return x * frcp_(1.0f + fexp_(-u)); }
__device__ __forceinline__ float dpp_xor1(float x) { return __builtin_bit_cast(float, __builtin_amdgcn_update_dpp(0, __builtin_bit_cast(int, x), 0xB1, 0xF, 0xF, true)); }
__device__ __forceinline__ float dpp_xor2(float x) { return __builtin_bit_cast(float, __builtin_amdgcn_update_dpp(0, __builtin_bit_cast(int, x), 0x4E, 0xF, 0xF, true)); }
__device__ __forceinline__ float dpp_hmir(float x) { return __builtin_bit_cast(float, __builtin_amdgcn_update_dpp(0, __builtin_bit_cast(int, x), 0x141, 0xF, 0xF, true)); }
__device__ __forceinline__ float dpp_mir(float x) { return __builtin_bit_cast(float, __builtin_amdgcn_update_dpp(0, __builtin_bit_cast(int, x), 0x140, 0xF, 0xF, true)); }
__device__ __forceinline__ float sum4_(float x) { x += dpp_xor1(x); x += dpp_xor2(x); return x; }
__device__ __forceinline__ float sum8_(float x) { x = sum4_(x); x += dpp_hmir(x); return x; }
__device__ __forceinline__ float sum16_(float x) { x = sum8_(x); x += dpp_mir(x); return x; }
typedef unsigned u2v_ __attribute__((ext_vector_type(2)));
__device__ __forceinline__ float xrow_sum_(float x) { x += __shfl_xor(x, 16); x += __shfl_xor(x, 32); return x; }
__device__ __forceinline__ float xrow_max_(float x) { x = fmaxf(x, __shfl_xor(x, 16)); x = fmaxf(x, __shfl_xor(x, 32)); return x; }
__device__ __forceinline__ float wave_sum(float v) {
    return xrow_sum_(sum16_(v));
}
__device__ __forceinline__ void sincos_rev(float ang, float& s, float& c) {
    float rev = ang * 0.15915494309189535f; rev = rev - floorf(rev);
    s = __builtin_amdgcn_sinf(rev); c = __builtin_amdgcn_cosf(rev);
}
__device__ __forceinline__ bf16x8 mk8(u32x2 lo, u32x2 hi) { u32x4 t; t.x = lo.x; t.y = lo.y; t.z = hi.x; t.w = hi.y; return __builtin_bit_cast(bf16x8, t); }
__device__ __forceinline__ bf16x8 pack8(f32x4 a, f32x4 b) { u32x4 t; t.x = pk2(a.x, a.y); t.y = pk2(a.z, a.w); t.z = pk2(b.x, b.y); t.w = pk2(b.z, b.w); return __builtin_bit_cast(bf16x8, t); }

#define XB_TMO      128
#define XB_XCNT(j)  (256  + 64 * (j))
#define XB_XSUB(j)  (1280 + 64 * (j))
#define XB_XGEN(j)  (2304 + 64 * (j))
#define XB_TOP      3328
#define XB_TOPGEN   3392
#define XCD_BAR_WORDS 3456
#define XB_SPIN_CAP (1u << 22)
__device__ __forceinline__ unsigned xb_ld(unsigned* p)              { return __hip_atomic_load(p, __ATOMIC_RELAXED, __HIP_MEMORY_SCOPE_AGENT); }
__device__ __forceinline__ unsigned xb_add(unsigned* p, unsigned v) { return __hip_atomic_fetch_add(p, v, __ATOMIC_RELAXED, __HIP_MEMORY_SCOPE_AGENT); }
__device__ __forceinline__ unsigned xb_xcc_id() { return (unsigned)__builtin_amdgcn_s_getreg((3 << 11) | 20) & 0xFu; }
#define XB_SPIN(cond, bar) do { unsigned _sp = 0; while (cond) { __builtin_amdgcn_s_sleep(1); \
    if ((++_sp & 255u) == 0u) { if (xb_ld(&(bar)[XB_TMO])) break; if (_sp > XB_SPIN_CAP) { atomicAdd(&(bar)[XB_TMO], 1u); break; } } } } while (0)
struct XcdBarrier { unsigned* bar; unsigned x; volatile LAS unsigned* st; };
__device__ __forceinline__ XcdBarrier xcd_barrier_post(unsigned* bar, volatile LAS unsigned* st) {
    XcdBarrier b; b.bar = bar; b.x = xb_xcc_id(); b.st = st;
    if (threadIdx.x == 0) (void)xb_add(&bar[XB_XCNT(b.x)], 1u);
    return b;
}
__device__ __forceinline__ void xcd_barrier_complete(unsigned* bar, unsigned x, unsigned& nloc, unsigned& nx) {
    const unsigned G = gridDim.x * gridDim.y * gridDim.z;
    unsigned sum, cnt, mine, sp = 0u;
    for (;;) {
        sum = 0u; cnt = 0u; mine = 0u;
#pragma unroll
        for (unsigned j = 0; j < 16; ++j) { const unsigned c = xb_ld(&bar[XB_XCNT(j)]); sum += c; cnt += (c > 0u) ? 1u : 0u; mine = (j == x) ? c : mine; }
        if (sum == G) break;
        __builtin_amdgcn_s_sleep(1);
        if ((++sp & 255u) == 0u) { if (xb_ld(&bar[XB_TMO])) break; if (sp > XB_SPIN_CAP) { atomicAdd(&bar[XB_TMO], 1u); break; } }
    }
    nloc = mine > 0u ? mine : 1u; nx = cnt > 0u ? cnt : 1u;
}
__device__ __forceinline__ void xcd_barrier(const XcdBarrier& b) {
    asm volatile("s_waitcnt vmcnt(0)" ::: "memory");
    __syncthreads();
    if (threadIdx.x == 0) {
        unsigned* bar = b.bar;
        __builtin_amdgcn_s_waitcnt(0);
        unsigned nloc = b.st[0], nx = b.st[1];
        if (nloc == 0u) { xcd_barrier_complete(bar, b.x, nloc, nx); b.st[0] = nloc; b.st[1] = nx; }
        const unsigned old = xb_add(&bar[XB_XSUB(b.x)], 1u);
        const unsigned gen = old / nloc;
        if (old + 1u == (gen + 1u) * nloc) {
            __builtin_amdgcn_fence(__ATOMIC_RELEASE, "agent");
            asm volatile("s_waitcnt vmcnt(0)" ::: "memory");
            const unsigned og = xb_add(&bar[XB_TOP], 1u);
            const unsigned tg = og / nx;
            if (og + 1u == (tg + 1u) * nx) xb_add(&bar[XB_TOPGEN], 1u);
            else XB_SPIN(xb_ld(&bar[XB_TOPGEN]) == tg, bar);
            __builtin_amdgcn_fence(__ATOMIC_ACQUIRE, "agent");
            xb_add(&bar[XB_XGEN(b.x)], 1u);
            asm volatile("s_waitcnt vmcnt(0)" ::: "memory");
        } else {
            XB_SPIN(xb_ld(&bar[XB_XGEN(b.x)]) == gen, bar);
            __builtin_amdgcn_fence(__ATOMIC_ACQUIRE, "agent");
            asm volatile("s_waitcnt vmcnt(0)" ::: "memory");
        }
    }
    __syncthreads();
}

namespace pg8 {
constexpr int BM = 256, BK = 64, HALF = 128, HTB = HALF * BK * 2, STAGE_BYTES = 8 * HTB, NXCD = 8, WGM = 8;
__host__ __device__ __forceinline__ int lds_byte(int r, int c) { const int st = (r >> 4) * 2 + (c >> 5), rr = r & 15, cc = c & 31, ob = rr * 64 + cc * 2; return st * 1024 + (ob ^ (((ob >> 9) & 1) << 5)); }
__host__ __device__ __forceinline__ void stage_rc(int b, int& R, int& C) { const int st = b / 1024, sb = b % 1024, swz = sb ^ (((sb >> 9) & 1) << 5); R = (st >> 1) * 16 + swz / 64; C = (st & 1) * 32 + (swz % 64) / 2; }
__host__ __device__ __forceinline__ int perm32(int rho) { const int n = rho >> 4, i = rho & 15; return 8 * (i >> 2) + 4 * n + (i & 3); }
struct Unit { int pm, pn; };
struct Gemm { const bf16_t* A; const bf16_t* Bt; int M, N, K; };
struct StaticOrder {
    int nM, nN, nwg, G, c;
    __host__ __device__ void init(int M, int N, int G_, int c_) { nM = M / BM; nN = N / BM; nwg = nM * nN; G = G_; c = c_; }
    __host__ __device__ bool next(int i, Unit& u) const {
        const long L = (long)i * G + c; if (L >= nwg) return false;
        int wgid = (int)L; { const int q = nwg / NXCD, r = nwg % NXCD, xcd = wgid % NXCD, off = wgid / NXCD; wgid = (xcd < r ? xcd * (q + 1) : r * (q + 1) + (xcd - r) * q) + off; }
        const int nig = WGM * nN, gid = wgid / nig, fm = gid * WGM, gsz = (nM - fm) < WGM ? (nM - fm) : WGM;
        u.pm = fm + ((wgid % nig) % gsz); u.pn = (wgid % nig) / gsz; return true;
    }
    __device__ __forceinline__ void a_ready(const Unit&) const {}
    __device__ __forceinline__ void done(const Unit&) const {}
};

template <int ACT> struct EpiScaleBf16 {
    static constexpr bool PERM = true;
    bf16_t* O; int ldc; const float* part;
    __device__ __forceinline__ void operator()(const f32x4 (&acc)[2][2][4][2], const Unit& u, int wr, int wc, int fr, int fq) const {
        const int row0 = u.pm * BM + wr * 64 + fr, col0 = u.pn * BM + wc * 32 + 8 * fq;
#pragma unroll
        for (int ai = 0; ai < 2; ++ai)
#pragma unroll
            for (int m = 0; m < 4; ++m) {
                const int row = row0 + ai * HALF + m * 16;
                float sc = 1.0f;
                if (part) { const f32x4 a = *((const f32x4*)(part + (size_t)row * 16) + fq);
                    float s = (a.x + a.y) + (a.z + a.w); s = xrow_sum_(s);
                    sc = frsq_(s * (1.0f / 1024.0f) + EPS); }
                bf16_t* rowp = O + (size_t)row * ldc + col0;
#pragma unroll
                for (int bj = 0; bj < 2; ++bj) { f32x4 v0 = acc[ai][bj][m][0] * sc, v1 = acc[ai][bj][m][1] * sc;
                    if (ACT == 1) {
#pragma unroll
                        for (int j = 0; j < 4; ++j) { const float a0 = fmaxf(v0[j], 0.f), a1 = fmaxf(v1[j], 0.f); v0[j] = a0 * a0; v1[j] = a1 * a1; } }
                    u32x4 w; w.x = pk2(v0[0], v0[1]); w.y = pk2(v0[2], v0[3]); w.z = pk2(v1[0], v1[1]); w.w = pk2(v1[2], v1[3]);
                    *(u32x4*)(rowp + bj * HALF) = w; }
            }
    }
};
struct EpiResid {
    static constexpr bool PERM = false;
    bf16_t* XB; float* part; float alpha;
    __device__ __forceinline__ void operator()(const f32x4 (&acc)[2][2][4][2], const Unit& u, int wr, int wc, int fr, int fq) const {
        const int row0 = u.pm * BM + wr * 64 + fr, col0 = u.pn * BM + wc * 32 + 4 * fq;
#pragma unroll
        for (int ai = 0; ai < 2; ++ai)
#pragma unroll
            for (int m = 0; m < 4; ++m) {
                const int row = row0 + ai * HALF + m * 16;
                bf16_t* bp = XB + (size_t)row * DM + col0;
                float ss = 0.f;
#pragma unroll
                for (int bj = 0; bj < 2; ++bj)
#pragma unroll
                    for (int n = 0; n < 2; ++n) { const u32x2 xw = *(const u32x2*)(bp + bj * HALF + n * 16);
                        const f32x4 v = (f32x4){bflo(xw.x), bfhi(xw.x), bflo(xw.y), bfhi(xw.y)} + acc[ai][bj][m][n] * alpha;
                        ss += (v.x * v.x + v.y * v.y) + (v.z * v.z + v.w * v.w);
                        u32x2 w; w.x = pk2(v.x, v.y); w.y = pk2(v.z, v.w); *(u32x2*)(bp + bj * HALF + n * 16) = w; }
                ss = xrow_sum_(ss);
                if (fq == 0) part[(size_t)row * 16 + u.pn * 4 + wc] = ss;
            }
    }
};

template <class Epi, class Sched>
__device__ __forceinline__ void gemm_phase(LAS unsigned char* lds, const Gemm g, const Sched& S, const Epi& E, const int tid) {
    const int wid = __builtin_amdgcn_readfirstlane(tid >> 6), lane = tid & 63, wr = wid >> 2, wc = wid & 3, fr = lane & 15, fq = lane >> 4;
    const int K = g.K, nt = K / BK;
    unsigned voffA[2], voffB[2];
#pragma unroll
    for (int i = 0; i < 2; ++i) { int R, C; stage_rc(tid * 16 + i * 8192, R, C); const int Rb = Epi::PERM ? ((R & ~31) + perm32(R & 31)) : R;
        voffA[i] = (unsigned)(R * K + C) * 2u; voffB[i] = (unsigned)(Rb * K + C) * 2u; }
    const size_t kstep = (size_t)(BK * 2);
    const size_t hstep = (size_t)HALF * K * 2;
    const size_t tstep = 2 * hstep;
    const unsigned ldsw = (unsigned)wid * 1024u;
    const int aoff = lds_byte(wr * 64 + fr, fq * 8), boff = lds_byte(wc * 32 + fr, fq * 8);
#define PG8_SA(b, h) (((b) * 2 + (h)) * HTB)
#define PG8_SB(b, h) ((4 + (b) * 2 + (h)) * HTB)
#define PG8_STAGE(bufoff, gbase, voff) do { _Pragma("unroll") for (int _i = 0; _i < 2; ++_i) \
        __builtin_amdgcn_global_load_lds((const unsigned*)((const char*)(gbase) + (voff)[_i]), (LAS unsigned*)(lds + (bufoff) + ldsw + _i * 8192), 16, 0, 0); } while (0)
#define PG8_LDA(dst, b, h) do { _Pragma("unroll") for (int m = 0; m < 4; ++m) _Pragma("unroll") for (int k = 0; k < 2; ++k) dst[m][k] = *(const LAS bf16x8*)(lds + PG8_SA(b, h) + aoff + m * 2048 + k * 1024); } while (0)
#define PG8_LDB(dst, b, h) do { _Pragma("unroll") for (int n = 0; n < 2; ++n) _Pragma("unroll") for (int k = 0; k < 2; ++k) dst[n][k] = *(const LAS bf16x8*)(lds + PG8_SB(b, h) + boff + n * 2048 + k * 1024); } while (0)
#define PG8_MMA(ai, bj, At, Bt) do { __builtin_amdgcn_s_setprio(1); _Pragma("unroll") for (int m = 0; m < 4; ++m) _Pragma("unroll") for (int n = 0; n < 2; ++n) _Pragma("unroll") for (int k = 0; k < 2; ++k) \
        acc[ai][bj][m][n] = __builtin_amdgcn_mfma_f32_16x16x32_bf16(Bt[n][k], At[m][k], acc[ai][bj][m][n], 0, 0, 0); __builtin_amdgcn_s_setprio(0); } while (0)
#define PG8_WAIT_V(n) asm volatile("s_waitcnt vmcnt(" #n ")" ::: "memory")
#define PG8_WAIT_L(n) asm volatile("s_waitcnt lgkmcnt(" #n ")" ::: "memory")
#define PG8_BAR __builtin_amdgcn_s_barrier()
#define PG8_SCHED __builtin_amdgcn_sched_barrier(0)
    Unit cur, nxt; int ui = 0;
    if (!S.next(0, cur)) return;
    f32x4 acc[2][2][4][2];
#pragma unroll
    for (int a = 0; a < 2; ++a)
#pragma unroll
        for (int b = 0; b < 2; ++b)
#pragma unroll
            for (int m = 0; m < 4; ++m)
#pragma unroll
                for (int n = 0; n < 2; ++n) acc[a][b][m][n] = (f32x4){0.f, 0.f, 0.f, 0.f};
    bf16x8 At[4][2], B0[2][2], B1[2][2];
    const char* cA = (const char*)g.A + (size_t)cur.pm * tstep; const char* cB = (const char*)g.Bt + (size_t)cur.pn * tstep;
    S.a_ready(cur);
    PG8_STAGE(PG8_SB(0, 0), cB, voffB); PG8_STAGE(PG8_SA(0, 0), cA, voffA); PG8_STAGE(PG8_SB(0, 1), cB + hstep, voffB); PG8_STAGE(PG8_SA(0, 1), cA + hstep, voffA);
    if (wr == 1) PG8_BAR;
    PG8_WAIT_V(4); PG8_BAR;
    PG8_STAGE(PG8_SB(1, 0), cB + kstep, voffB); PG8_STAGE(PG8_SA(1, 0), cA + kstep, voffA); PG8_STAGE(PG8_SB(1, 1), cB + hstep + kstep, voffB);
    PG8_WAIT_V(6); PG8_BAR;
    for (;;) {
        const bool has_next = S.next(ui + 1, nxt);
        const char* nA = has_next ? (const char*)g.A + (size_t)nxt.pm * tstep : cA; const char* nB = has_next ? (const char*)g.Bt + (size_t)nxt.pn * tstep : cB;
        for (int t = 0; t < nt; t += 2) {
            const bool last = (t == nt - 2);
            const char* a1 = cA + (size_t)(t + 1) * kstep;
            const char* a2 = last ? nA : cA + (size_t)(t + 2) * kstep; const char* b2 = last ? nB : cB + (size_t)(t + 2) * kstep;
            const char* a3 = a2 + kstep; const char* b3 = b2 + kstep;
            if (last && has_next) S.a_ready(nxt);
            PG8_LDB(B0, 0, 0); PG8_SCHED; PG8_LDA(At, 0, 0); PG8_STAGE(PG8_SA(1, 1), a1 + hstep, voffA);
            PG8_WAIT_L(8); PG8_BAR; PG8_WAIT_L(0); PG8_MMA(0, 0, At, B0); PG8_BAR; PG8_SCHED;
            PG8_LDB(B1, 0, 1); PG8_STAGE(PG8_SB(0, 0), b2, voffB);
            PG8_BAR; PG8_WAIT_L(0); PG8_MMA(0, 1, At, B1); PG8_BAR;
            PG8_LDA(At, 0, 1); PG8_STAGE(PG8_SA(0, 0), a2, voffA);
            PG8_BAR; PG8_WAIT_L(0); PG8_MMA(1, 0, At, B0); PG8_BAR; PG8_SCHED;
            PG8_STAGE(PG8_SB(0, 1), b2 + hstep, voffB);
            PG8_WAIT_V(6); PG8_BAR; PG8_MMA(1, 1, At, B1); PG8_BAR;
            PG8_LDB(B0, 1, 0); PG8_SCHED; PG8_LDA(At, 1, 0); PG8_STAGE(PG8_SA(0, 1), a2 + hstep, voffA);
            PG8_WAIT_L(8); PG8_BAR; PG8_WAIT_L(0); PG8_MMA(0, 0, At, B0); PG8_BAR; PG8_SCHED;
            PG8_LDB(B1, 1, 1); PG8_STAGE(PG8_SB(1, 0), b3, voffB);
            PG8_BAR; PG8_WAIT_L(0); PG8_MMA(0, 1, At, B1); PG8_BAR;
            PG8_LDA(At, 1, 1); PG8_STAGE(PG8_SA(1, 0), a3, voffA);
            PG8_BAR; PG8_WAIT_L(0); PG8_MMA(1, 0, At, B0); PG8_BAR; PG8_SCHED;
            PG8_STAGE(PG8_SB(1, 1), b3 + hstep, voffB);
            PG8_WAIT_V(6); PG8_BAR; PG8_MMA(1, 1, At, B1); PG8_BAR;
        }
        E(acc, cur, wr, wc, fr, fq); S.done(cur);
        if (!has_next) break;
#pragma unroll
        for (int a = 0; a < 2; ++a)
#pragma unroll
            for (int b = 0; b < 2; ++b)
#pragma unroll
                for (int m = 0; m < 4; ++m)
#pragma unroll
                    for (int n = 0; n < 2; ++n) acc[a][b][m][n] = (f32x4){0.f, 0.f, 0.f, 0.f};
        cur = nxt; cA = nA; cB = nB; ++ui;
    }
    PG8_WAIT_V(0);
    if (wr == 0) PG8_BAR;
    PG8_BAR;
#undef PG8_SA
#undef PG8_SB
#undef PG8_STAGE
#undef PG8_LDA
#undef PG8_LDB
#undef PG8_MMA
#undef PG8_WAIT_V
#undef PG8_WAIT_L
#undef PG8_BAR
#undef PG8_SCHED
}
}

struct Params {
    const float* x; const float* mem; const int* pos;
    const float* norm_mix; const float* w_in; const float* ret_gn;
    const float* lru_conv_w; const float* lru_conv_b; const float* lru_wa; const float* lru_ba; const float* lru_wx; const float* lru_bx; const float* lru_lambda;
    const float* mla_q_norm; const float* mla_w_uq; const float* mla_kv_norm; const float* mla_w_ukv;
    const float* gdn_conv_w; const float* gdn_a_log; const float* gdn_dt_bias; const float* gdn_norm;
    const float* w_out; const float* norm_xattn; const float* norm_mem; const float* xa_wq; const float* xa_wkv; const float* xa_wo;
    const float* norm_mlp; const float* mlp_w1; const float* mlp_w2; const float* final_norm;
    float* out; unsigned char* ws;
    int ph_lo, ph_hi;
};

__device__ __forceinline__ bf16_t* wl(const Params& P, int l, size_t off) { return (bf16_t*)(P.ws + WS_W) + (size_t)l * W_LAYER + off; }

struct WTile { const float* src; const float* gain; bf16_t* dst; int K, N, kb, nb; float scale; };
__device__ __forceinline__ WTile p0_decode(const Params& P, int it) {
    constexpr int T_IN = 16 * 48, T_SQ = 256, T_KV = 512, T_W1 = 1024, T_W2 = 1024, T_UQ = 18, T_UKV = 16, T_LRU = 8;
    constexpr int T_LAYER = T_IN + 3 * T_SQ + T_KV + T_W1 + T_W2 + T_UQ + T_UKV + T_LRU;
    const int l = it / T_LAYER; int r = it % T_LAYER; int nnb; WTile t; t.gain = nullptr; t.scale = 1.f;
    if (r < T_IN) { t.src = P.w_in + (size_t)l * DM * IN_COLS; t.K = DM; t.N = IN_COLS; nnb = 48; t.gain = P.norm_mix + l * DM; t.dst = wl(P, l, W_IN); }
    else if ((r -= T_IN) < T_SQ) { t.src = P.w_out + (size_t)l * DM * DM; t.K = DM; t.N = DM; nnb = 16; t.dst = wl(P, l, W_OUT); }
    else if ((r -= T_SQ) < T_SQ) { t.src = P.xa_wq + (size_t)l * DM * DM; t.K = DM; t.N = DM; nnb = 16; t.gain = P.norm_xattn + l * DM; t.scale = 0.0625f * LOG2E; t.dst = wl(P, l, W_Q); }
    else if ((r -= T_SQ) < T_KV) { t.src = P.xa_wkv + (size_t)l * DM * 2 * DM; t.K = DM; t.N = 2 * DM; nnb = 32; t.gain = P.norm_mem + l * DM; t.dst = wl(P, l, W_KV); }
    else if ((r -= T_KV) < T_SQ) { t.src = P.xa_wo + (size_t)l * DM * DM; t.K = DM; t.N = DM; nnb = 16; t.dst = wl(P, l, W_O); }
    else if ((r -= T_SQ) < T_W1) { t.src = P.mlp_w1 + (size_t)l * DM * DFF; t.K = DM; t.N = DFF; nnb = 64; t.gain = P.norm_mlp + l * DM; t.dst = wl(P, l, W_1); }
    else if ((r -= T_W1) < T_W2) { t.src = P.mlp_w2 + (size_t)l * DFF * DM; t.K = DFF; t.N = DM; nnb = 16; t.dst = wl(P, l, W_2); }
    else if ((r -= T_W2) < T_UQ) { t.src = P.mla_w_uq + (size_t)l * 192 * 384; t.K = 192; t.N = 384; nnb = 6; t.gain = P.mla_q_norm + l * 192; t.dst = wl(P, l, W_UQ); }
    else if ((r -= T_UQ) < T_UKV) { t.src = P.mla_w_ukv + (size_t)l * 128 * 512; t.K = 128; t.N = 512; nnb = 8; t.gain = P.mla_kv_norm + l * 128; t.dst = wl(P, l, W_UKV); }
    else { r -= T_UKV; const int which = r >> 2, nb4 = r & 3; t.src = (which ? P.lru_wx : P.lru_wa) + (size_t)l * 4 * 4096 + nb4 * 4096; t.K = 64; t.N = 64; nnb = 1; t.dst = wl(P, l, which ? W_X : W_A) + nb4 * 4096; r = 0; }
    t.kb = r / nnb; t.nb = r % nnb; return t;
}
__device__ __forceinline__ void p0_fetch(const WTile& t, int tid, f32x4 (&v)[2]) {
#pragma unroll
    for (int i = 0; i < 2; ++i) { const int kk = (tid >> 4) + 32 * i, k = t.kb * 64 + kk, n = t.nb * 64 + (tid & 15) * 4;
        f32x4 x = {0.f, 0.f, 0.f, 0.f}; float g = t.scale;
        if (n < t.N) { x = *(const f32x4*)(t.src + (size_t)k * t.N + n); if (t.gain) g *= t.gain[k]; }
        v[i] = x * g; }
}
__device__ __forceinline__ void p0_prologue(const Params& P, LAS unsigned char* lds, int tid) {
    LAS float* scr = (LAS float*)lds;
    constexpr int NT = 2 * (16 * 48 + 3 * 256 + 512 + 1024 + 1024 + 18 + 16 + 8);
    int it = blockIdx.x;
    if (it < NT) {
        WTile cur = p0_decode(P, it); f32x4 v[2]; p0_fetch(cur, tid, v);
        for (;;) {
#pragma unroll
            for (int i = 0; i < 2; ++i) { LAS float* d = scr + ((tid >> 4) + 32 * i) * 65 + (tid & 15) * 4; d[0] = v[i].x; d[1] = v[i].y; d[2] = v[i].z; d[3] = v[i].w; }
            const int nxt = it + gridDim.x; const bool more = nxt < NT;
            WTile nx = cur; if (more) { nx = p0_decode(P, nxt); p0_fetch(nx, tid, v); }
            __syncthreads();
            { const int nl = tid >> 3, k0 = (tid & 7) * 8; const LAS float* s = scr + k0 * 65 + nl;
              u32x4 o; o.x = pk2(s[0], s[65]); o.y = pk2(s[2 * 65], s[3 * 65]); o.z = pk2(s[4 * 65], s[5 * 65]); o.w = pk2(s[6 * 65], s[7 * 65]);
              *(u32x4*)(cur.dst + (size_t)(cur.nb * 64 + nl) * cur.K + cur.kb * 64 + k0) = o; }
            __syncthreads();
            if (!more) break;
            cur = nx; it = nxt;
        }
    }
    const int wave = tid >> 6, lane = tid & 63;
    const int gw = blockIdx.x * 8 + wave, ngw = gridDim.x * 8;
    bf16_t* xb = (bf16_t*)(P.ws + WS_XB); float* part = (float*)(P.ws + WS_PART); bf16_t* memn = (bf16_t*)(P.ws + WS_GDN);
    constexpr int NR = T_TOK + NBATCH * NMEM;
    for (int row0 = gw; row0 < NR; row0 += 2 * ngw) {
        f32x4 v[2][4]; const int row1 = row0 + ngw; const bool has1 = row1 < NR;
#pragma unroll
        for (int q = 0; q < 2; ++q) { const int row = q ? (has1 ? row1 : row0) : row0; const bool isx = row < T_TOK; const int r2 = isx ? row : row - T_TOK;
            const f32x4* src = (const f32x4*)((isx ? P.x : P.mem) + (size_t)r2 * DM) + lane;
#pragma unroll
            for (int j = 0; j < 4; ++j) v[q][j] = src[64 * j]; }
#pragma unroll
        for (int q = 0; q < 2; ++q) { if (q && !has1) break; const int row = q ? row1 : row0; const bool isx = row < T_TOK; const int r2 = isx ? row : row - T_TOK;
            float s = 0.f;
#pragma unroll
            for (int j = 0; j < 4; ++j) s += (v[q][j].x * v[q][j].x + v[q][j].y * v[q][j].y) + (v[q][j].z * v[q][j].z + v[q][j].w * v[q][j].w);
            s = wave_sum(s);
            if (isx) { u32x2* ob = (u32x2*)(xb + (size_t)row * DM) + lane;
#pragma unroll
                for (int j = 0; j < 4; ++j) { u32x2 w; w.x = pk2(v[q][j].x, v[q][j].y); w.y = pk2(v[q][j].z, v[q][j].w); ob[64 * j] = w; }
                if (lane < 16) part[(size_t)row * 16 + lane] = lane == 0 ? s : 0.f;
            } else { const float rs = frsq_(s * (1.0f / 1024.0f) + EPS); u32x2* ob = (u32x2*)(memn + (size_t)r2 * DM) + lane;
#pragma unroll
                for (int j = 0; j < 4; ++j) { u32x2 w; w.x = pk2(v[q][j].x * rs, v[q][j].y * rs); w.y = pk2(v[q][j].z * rs, v[q][j].w * rs); ob[64 * j] = w; } }
        }
    }
}
__device__ __forceinline__ void final_norm_phase(const Params& P, int tid) {
    const int wave = tid >> 6, lane = tid & 63; const float* part = (const float*)(P.ws + WS_PART); const bf16_t* xb = (const bf16_t*)(P.ws + WS_XB);
    f32x4 g[4];
#pragma unroll
    for (int j = 0; j < 4; ++j) g[j] = ((const f32x4*)P.final_norm)[64 * j + lane];
    for (int row = blockIdx.x * 8 + wave; row < T_TOK; row += gridDim.x * 8) {
        float s = lane < 16 ? part[(size_t)row * 16 + lane] : 0.f; s = wave_sum(s);
        const float rs = frsq_(s * (1.0f / 1024.0f) + EPS);
        f32x4* o = (f32x4*)(P.out + (size_t)row * DM) + lane; const u32x2* xi = (const u32x2*)(xb + (size_t)row * DM) + lane;
#pragma unroll
        for (int j = 0; j < 4; ++j) { const u32x2 w = xi[64 * j]; o[64 * j] = (f32x4){bflo(w.x), bfhi(w.x), bflo(w.y), bfhi(w.y)} * rs * g[j]; }
    }
}
__device__ __forceinline__ void mla_pre_tile(const Params& P, int l, int rt, int lane) {
    const int fr = lane & 15, fq = lane >> 4;
    const bf16_t* z = (const bf16_t*)(P.ws + WS_R);
    bf16_t* Qo = (bf16_t*)((unsigned char*)P.out + MLA_Q_OFF); bf16_t* Ko = (bf16_t*)((unsigned char*)P.out + MLA_K_OFF); bf16_t* Vo = (bf16_t*)((unsigned char*)P.out + MLA_VT_OFF);
    const bf16_t* Wuq = wl(P, l, W_UQ); const bf16_t* Wukv = wl(P, l, W_UKV);
    const int tok0 = rt * 16, b = tok0 >> 11, s0 = tok0 & 2047;
    const bf16_t* zr = z + (size_t)(tok0 + fr) * ZP;
    bf16x8 cq[6], ckv[4]; float sq = 0.f, skv = 0.f;
#pragma unroll
    for (int s = 0; s < 6; ++s) { const u32x4 w = *(const u32x4*)(zr + Z_CQ + 32 * s + 8 * fq); cq[s] = __builtin_bit_cast(bf16x8, w);
        sq += bflo(w.x) * bflo(w.x) + bfhi(w.x) * bfhi(w.x) + bflo(w.y) * bflo(w.y) + bfhi(w.y) * bfhi(w.y) + bflo(w.z) * bflo(w.z) + bfhi(w.z) * bfhi(w.z) + bflo(w.w) * bflo(w.w) + bfhi(w.w) * bfhi(w.w); }
#pragma unroll
    for (int s = 0; s < 4; ++s) { const u32x4 w = *(const u32x4*)(zr + Z_CKV + 32 * s + 8 * fq); ckv[s] = __builtin_bit_cast(bf16x8, w);
        skv += bflo(w.x) * bflo(w.x) + bfhi(w.x) * bfhi(w.x) + bflo(w.y) * bflo(w.y) + bfhi(w.y) * bfhi(w.y) + bflo(w.z) * bflo(w.z) + bfhi(w.z) * bfhi(w.z) + bflo(w.w) * bflo(w.w) + bfhi(w.w) * bfhi(w.w); }
    sq = xrow_sum_(sq); skv = xrow_sum_(skv);
    const float rq = frsq_(sq * (1.0f / 192.0f) + EPS), rkv = frsq_(skv * (1.0f / 128.0f) + EPS);
    const float qsc = rq * 0.10206207261596575f * LOG2E;
    const float pos = (float)P.pos[tok0 + fr];
    float sn[4], cs[4];
#pragma unroll
    for (int r = 0; r < 4; ++r) { const float invf = exp2f(-(float)(4 * fq + r) * (13.287712379549449f / 16.0f)); sincos_rev(pos * invf, sn[r], cs[r]); }
    const size_t tokrow = (size_t)b * 4 * SEQ + (s0 + fr);
#pragma unroll 1
    for (int h = 0; h < 4; ++h) {
        bf16_t* qrow = Qo + (tokrow + (size_t)h * SEQ) * 96;
#pragma unroll 1
        for (int nt = 0; nt < 4; ++nt) { f32x4 a = {0.f, 0.f, 0.f, 0.f};
#pragma unroll
            for (int s = 0; s < 6; ++s) { const bf16x8 wf = *(const bf16x8*)(Wuq + (size_t)(h * 96 + nt * 16 + fr) * 192 + 32 * s + 8 * fq); a = mfma16(wf, cq[s], a); }
            a = a * qsc; u32x2 w; w.x = pk2(a.x, a.y); w.y = pk2(a.z, a.w); *(u32x2*)(qrow + nt * 16 + 4 * fq) = w; }
        f32x4 x1 = {0.f, 0.f, 0.f, 0.f}, x2 = {0.f, 0.f, 0.f, 0.f}, y1, y2;
#pragma unroll
        for (int s = 0; s < 6; ++s) { const bf16x8 wf1 = *(const bf16x8*)(Wuq + (size_t)(h * 96 + 64 + fr) * 192 + 32 * s + 8 * fq), wf2 = *(const bf16x8*)(Wuq + (size_t)(h * 96 + 80 + fr) * 192 + 32 * s + 8 * fq);
            x1 = mfma16(wf1, cq[s], x1); x2 = mfma16(wf2, cq[s], x2); }
        x1 = x1 * qsc; x2 = x2 * qsc;
#pragma unroll
        for (int r = 0; r < 4; ++r) { y1[r] = x1[r] * cs[r] - x2[r] * sn[r]; y2[r] = x1[r] * sn[r] + x2[r] * cs[r]; }
        { u32x2 w; w.x = pk2(y1.x, y1.y); w.y = pk2(y1.z, y1.w); *(u32x2*)(qrow + 64 + 4 * fq) = w; w.x = pk2(y2.x, y2.y); w.y = pk2(y2.z, y2.w); *(u32x2*)(qrow + 80 + 4 * fq) = w; }
    }
    u32x2 kr1, kr2;
    { const u32x2 a = *(const u32x2*)(zr + Z_KR + 4 * fq), c = *(const u32x2*)(zr + Z_KR + 16 + 4 * fq);
      const float x1[4] = {bflo(a.x), bfhi(a.x), bflo(a.y), bfhi(a.y)}, x2[4] = {bflo(c.x), bfhi(c.x), bflo(c.y), bfhi(c.y)}; float y1[4], y2[4];
#pragma unroll
      for (int r = 0; r < 4; ++r) { y1[r] = x1[r] * cs[r] - x2[r] * sn[r]; y2[r] = x1[r] * sn[r] + x2[r] * cs[r]; }
      kr1.x = pk2(y1[0], y1[1]); kr1.y = pk2(y1[2], y1[3]); kr2.x = pk2(y2[0], y2[1]); kr2.y = pk2(y2[2], y2[3]); }
    float rkv_r[4];
#pragma unroll
    for (int r = 0; r < 4; ++r) rkv_r[r] = __shfl(rkv, 4 * fq + r);
    const int chunk = s0 >> 6, key0 = (s0 & 63) + 4 * fq;
#pragma unroll 1
    for (int h = 0; h < 4; ++h) {
        bf16_t* krow = Ko + (tokrow + (size_t)h * SEQ) * 96;
#pragma unroll 1
        for (int nt = 0; nt < 4; ++nt) { f32x4 a = {0.f, 0.f, 0.f, 0.f};
#pragma unroll
            for (int s = 0; s < 4; ++s) { const bf16x8 wf = *(const bf16x8*)(Wukv + (size_t)(h * 128 + nt * 16 + fr) * 128 + 32 * s + 8 * fq); a = mfma16(wf, ckv[s], a); }
            a = a * rkv; u32x2 w; w.x = pk2(a.x, a.y); w.y = pk2(a.z, a.w); *(u32x2*)(krow + nt * 16 + 4 * fq) = w; }
        *(u32x2*)(krow + 64 + 4 * fq) = kr1; *(u32x2*)(krow + 80 + 4 * fq) = kr2;
        bf16_t* vt = Vo + ((size_t)((b * 4 + h) * NCHUNK + chunk) * 64) * 64;
#pragma unroll 1
        for (int nt = 0; nt < 4; ++nt) { f32x4 a = {0.f, 0.f, 0.f, 0.f};
#pragma unroll
            for (int s = 0; s < 4; ++s) { const bf16x8 wf = *(const bf16x8*)(Wukv + (size_t)(h * 128 + 64 + nt * 16 + fr) * 128 + 32 * s + 8 * fq); a = mfma16(ckv[s], wf, a); }
            u32x2 w; w.x = pk2(a.x * rkv_r[0], a.y * rkv_r[1]); w.y = pk2(a.z * rkv_r[2], a.w * rkv_r[3]);
            *(u32x2*)(vt + (size_t)(nt * 16 + fr) * 64 + key0) = w; }
    }
}

constexpr int MP_UQ_ROW = 200, MP_UKV_ROW = 136, MP_UKV_OFF = 96 * MP_UQ_ROW * 2, MP_BUF = MP_UKV_OFF + 128 * MP_UKV_ROW * 2;
__device__ __forceinline__ void mla_pre_item(const Params& P, int l, LAS unsigned char* lds, int it, int tid, int wave, int lane) {
    const int fr = lane & 15, fq = lane >> 4, rt = it * 8 + wave;
    const bf16_t* z = (const bf16_t*)(P.ws + WS_R);
    bf16_t* Qo = (bf16_t*)((unsigned char*)P.out + MLA_Q_OFF); bf16_t* Ko = (bf16_t*)((unsigned char*)P.out + MLA_K_OFF); bf16_t* Vo = (bf16_t*)((unsigned char*)P.out + MLA_VT_OFF);
    const bf16_t* Wuq = wl(P, l, W_UQ); const bf16_t* Wukv = wl(P, l, W_UKV);
    u32x4 stg[5];
#define MP_LOADQ(h_) do { _Pragma("unroll") for (int i = 0; i < 5; ++i) { const int p = tid + 512 * i; if (p < 2304) stg[i] = *(const u32x4*)(Wuq + (size_t)(h_) * 96 * 192 + (size_t)p * 8); } } while (0)
#define MP_STOREQ(buf_) do { _Pragma("unroll") for (int i = 0; i < 5; ++i) { const int p = tid + 512 * i; if (p < 2304) { const int row = p / 24, pc = p % 24; *(LAS u32x4*)(lds + (buf_) * MP_BUF + (row * MP_UQ_ROW + pc * 8) * 2) = stg[i]; } } } while (0)
#define MP_LOADKV(h_) do { _Pragma("unroll") for (int i = 0; i < 4; ++i) { const int p = tid + 512 * i; stg[i] = *(const u32x4*)(Wukv + (size_t)(h_) * 128 * 128 + (size_t)p * 8); } } while (0)
#define MP_STOREKV(buf_) do { _Pragma("unroll") for (int i = 0; i < 4; ++i) { const int p = tid + 512 * i, row = p >> 4, pc = p & 15; *(LAS u32x4*)(lds + (buf_) * MP_BUF + MP_UKV_OFF + (row * MP_UKV_ROW + pc * 8) * 2) = stg[i]; } } while (0)
    MP_LOADQ(0); MP_STOREQ(0); MP_LOADKV(0);
    const int tok0 = rt * 16, b = tok0 >> 11, s0 = tok0 & 2047;
    const bf16_t* zr = z + (size_t)(tok0 + fr) * ZP;
    bf16x8 cq[6], ckv[4]; float sq = 0.f, skv = 0.f;
#pragma unroll
    for (int s = 0; s < 6; ++s) { const u32x4 w = *(const u32x4*)(zr + Z_CQ + 32 * s + 8 * fq); cq[s] = __builtin_bit_cast(bf16x8, w);
        sq += bflo(w.x) * bflo(w.x) + bfhi(w.x) * bfhi(w.x) + bflo(w.y) * bflo(w.y) + bfhi(w.y) * bfhi(w.y) + bflo(w.z) * bflo(w.z) + bfhi(w.z) * bfhi(w.z) + bflo(w.w) * bflo(w.w) + bfhi(w.w) * bfhi(w.w); }
#pragma unroll
    for (int s = 0; s < 4; ++s) { const u32x4 w = *(const u32x4*)(zr + Z_CKV + 32 * s + 8 * fq); ckv[s] = __builtin_bit_cast(bf16x8, w);
        skv += bflo(w.x) * bflo(w.x) + bfhi(w.x) * bfhi(w.x) + bflo(w.y) * bflo(w.y) + bfhi(w.y) * bfhi(w.y) + bflo(w.z) * bflo(w.z) + bfhi(w.z) * bfhi(w.z) + bflo(w.w) * bflo(w.w) + bfhi(w.w) * bfhi(w.w); }
    const u32x2 kra = *(const u32x2*)(zr + Z_KR + 4 * fq), krc = *(const u32x2*)(zr + Z_KR + 16 + 4 * fq);
    const float pos = (float)P.pos[tok0 + fr];
    MP_STOREKV(0);
    sq = xrow_sum_(sq); skv = xrow_sum_(skv);
    const float rq = frsq_(sq * (1.0f / 192.0f) + EPS), rkv = frsq_(skv * (1.0f / 128.0f) + EPS);
    const float qsc = rq * 0.10206207261596575f * LOG2E;
    float sn[4], cs[4];
#pragma unroll
    for (int r = 0; r < 4; ++r) { const float invf = exp2f(-(float)(4 * fq + r) * (13.287712379549449f / 16.0f)); sincos_rev(pos * invf, sn[r], cs[r]); }
    const size_t tokrow = (size_t)b * 4 * SEQ + (s0 + fr);
    u32x2 kr1, kr2;
    { const float x1[4] = {bflo(kra.x), bfhi(kra.x), bflo(kra.y), bfhi(kra.y)}, x2[4] = {bflo(krc.x), bfhi(krc.x), bflo(krc.y), bfhi(krc.y)}; float y1[4], y2[4];
#pragma unroll
      for (int r = 0; r < 4; ++r) { y1[r] = x1[r] * cs[r] - x2[r] * sn[r]; y2[r] = x1[r] * sn[r] + x2[r] * cs[r]; }
      kr1.x = pk2(y1[0], y1[1]); kr1.y = pk2(y1[2], y1[3]); kr2.x = pk2(y2[0], y2[1]); kr2.y = pk2(y2[2], y2[3]); }
    float rkv_r[4];
#pragma unroll
    for (int r = 0; r < 4; ++r) rkv_r[r] = __shfl(rkv, 4 * fq + r);
    const int chunk = s0 >> 6, key0 = (s0 & 63) + 4 * fq;
    __syncthreads();
#pragma unroll 1
    for (int h = 0; h < 4; ++h) {
        if (h < 3) MP_LOADQ(h + 1);
        const LAS bf16_t* UQ = (const LAS bf16_t*)(lds + (h & 1) * MP_BUF); const LAS bf16_t* UKV = (const LAS bf16_t*)(lds + (h & 1) * MP_BUF + MP_UKV_OFF);
        bf16_t* qrow = Qo + (tokrow + (size_t)h * SEQ) * 96; bf16_t* krow = Ko + (tokrow + (size_t)h * SEQ) * 96;
        bf16_t* vt = Vo + ((size_t)((b * 4 + h) * NCHUNK + chunk) * 64) * 64;
#pragma unroll 1
        for (int nt = 0; nt < 4; ++nt) { f32x4 a = {0.f, 0.f, 0.f, 0.f};
#pragma unroll
            for (int s = 0; s < 6; ++s) a = mfma16(*(const LAS bf16x8*)(UQ + (nt * 16 + fr) * MP_UQ_ROW + 32 * s + 8 * fq), cq[s], a);
            a = a * qsc; u32x2 w; w.x = pk2(a.x, a.y); w.y = pk2(a.z, a.w); *(u32x2*)(qrow + nt * 16 + 4 * fq) = w; }
        {   f32x4 x1 = {0.f, 0.f, 0.f, 0.f}, x2 = {0.f, 0.f, 0.f, 0.f}, y1, y2;
#pragma unroll
            for (int s = 0; s < 6; ++s) { x1 = mfma16(*(const LAS bf16x8*)(UQ + (64 + fr) * MP_UQ_ROW + 32 * s + 8 * fq), cq[s], x1); x2 = mfma16(*(const LAS bf16x8*)(UQ + (80 + fr) * MP_UQ_ROW + 32 * s + 8 * fq), cq[s], x2); }
            x1 = x1 * qsc; x2 = x2 * qsc;
#pragma unroll
            for (int r = 0; r < 4; ++r) { y1[r] = x1[r] * cs[r] - x2[r] * sn[r]; y2[r] = x1[r] * sn[r] + x2[r] * cs[r]; }
            u32x2 w; w.x = pk2(y1.x, y1.y); w.y = pk2(y1.z, y1.w); *(u32x2*)(qrow + 64 + 4 * fq) = w; w.x = pk2(y2.x, y2.y); w.y = pk2(y2.z, y2.w); *(u32x2*)(qrow + 80 + 4 * fq) = w; }
        if (h < 3) { MP_STOREQ((h + 1) & 1); MP_LOADKV(h + 1); }
#pragma unroll 1
        for (int nt = 0; nt < 4; ++nt) { f32x4 a = {0.f, 0.f, 0.f, 0.f};
#pragma unroll
            for (int s = 0; s < 4; ++s) a = mfma16(*(const LAS bf16x8*)(UKV + (nt * 16 + fr) * MP_UKV_ROW + 32 * s + 8 * fq), ckv[s], a);
            a = a * rkv; u32x2 w; w.x = pk2(a.x, a.y); w.y = pk2(a.z, a.w); *(u32x2*)(krow + nt * 16 + 4 * fq) = w; }
        *(u32x2*)(krow + 64 + 4 * fq) = kr1; *(u32x2*)(krow + 80 + 4 * fq) = kr2;
#pragma unroll 1
        for (int nt = 0; nt < 4; ++nt) { f32x4 a = {0.f, 0.f, 0.f, 0.f};
#pragma unroll
            for (int s = 0; s < 4; ++s) a = mfma16(ckv[s], *(const LAS bf16x8*)(UKV + (64 + nt * 16 + fr) * MP_UKV_ROW + 32 * s + 8 * fq), a);
            u32x2 w; w.x = pk2(a.x * rkv_r[0], a.y * rkv_r[1]); w.y = pk2(a.z * rkv_r[2], a.w * rkv_r[3]);
            *(u32x2*)(vt + (size_t)(nt * 16 + fr) * 64 + key0) = w; }
        if (h < 3) MP_STOREKV((h + 1) & 1);
        __syncthreads();
    }
#undef MP_LOADQ
#undef MP_STOREQ
#undef MP_LOADKV
#undef MP_STOREKV
}

template <int DQK, int DV, int KT, int QT>
__device__ __forceinline__ void flash_item(LAS unsigned char* lds, const bf16_t* Qw, int ldq, const bf16_t* Kb, int ldk, const bf16_t* VTb, int ldv, int vts,
                                           bf16_t* Ow, int ldo, int ntiles, int wave_limit, int tid, int lane) {
    constexpr int KROW = DQK + 8, VROW = KT + 8, KS = DQK / 32, ET = DV / 16, NKT = KT / 16, KBYTES = KT * KROW * 2, BUF = KBYTES + DV * VROW * 2;
    constexpr int KP = KT * DQK / 8, VPR = KT / 8, VP = DV * VPR, NKP = (KP + 511) / 512, NVP = (VP + 511) / 512, NP = NKP > NVP ? NKP : NVP;
    const int fr = lane & 15, fq = lane >> 4;
    bf16x8 qf[QT][KS];
#pragma unroll
    for (int qi = 0; qi < QT; ++qi)
#pragma unroll
        for (int s = 0; s < KS; ++s) qf[qi][s] = *(const bf16x8*)(Qw + (size_t)(qi * 16 + fr) * ldq + 32 * s + 8 * fq);
    f32x4 ot[QT][ET];
#pragma unroll
    for (int qi = 0; qi < QT; ++qi)
#pragma unroll
        for (int e = 0; e < ET; ++e) ot[qi][e] = (f32x4){0.f, 0.f, 0.f, 0.f};
    float m_run[QT], l_run[QT];
#pragma unroll
    for (int qi = 0; qi < QT; ++qi) { m_run[qi] = -1e30f; l_run[qi] = 0.f; }
    u32x4 preg[NP];
#define FL_LOADK(j_) do { _Pragma("unroll") for (int i = 0; i < NKP; ++i) { const int idx = tid + i * 512; if (idx < KP) { const int row = idx / (DQK / 8), pc = idx % (DQK / 8); \
            preg[i] = *(const u32x4*)(Kb + (size_t)((j_) * KT + row) * ldk + pc * 8); } } } while (0)
#define FL_LOADV(j_) do { _Pragma("unroll") for (int i = 0; i < NVP; ++i) { const int idx = tid + i * 512; if (idx < VP) { const int row = idx / VPR, pc = idx % VPR; \
            preg[i] = *(const u32x4*)(VTb + (size_t)(j_) * vts + (size_t)row * ldv + pc * 8); } } } while (0)
#define FL_STOREK(buf_) do { LAS bf16_t* Kt_ = (LAS bf16_t*)(lds + (buf_) * BUF); \
        _Pragma("unroll") for (int i = 0; i < NKP; ++i) { const int idx = tid + i * 512; if (idx < KP) { const int row = idx / (DQK / 8), pc = idx % (DQK / 8); *(LAS u32x4*)(Kt_ + row * KROW + pc * 8) = preg[i]; } } } while (0)
#define FL_STOREV(buf_) do { LAS bf16_t* Vt_ = (LAS bf16_t*)(lds + (buf_) * BUF + KBYTES); \
        _Pragma("unroll") for (int i = 0; i < NVP; ++i) { const int idx = tid + i * 512; if (idx < VP) { const int row = idx / VPR, pc = idx % VPR; *(LAS u32x4*)(Vt_ + row * VROW + pc * 8) = preg[i]; } } } while (0)
    FL_LOADK(0); FL_STOREK(0); FL_LOADV(0); FL_STOREV(0);
    __syncthreads();
#pragma unroll 1
    for (int j = 0; j < ntiles; ++j) {
        const bool more = j + 1 < ntiles, act = j < wave_limit;
        const LAS bf16_t* Kt = (const LAS bf16_t*)(lds + (j & 1) * BUF); const LAS bf16_t* Vt = (const LAS bf16_t*)(lds + (j & 1) * BUF + KBYTES);
        if (more) FL_LOADK(j + 1);
        f32x4 st[QT][NKT];
        if (act) {
#pragma unroll
            for (int kt = 0; kt < NKT; ++kt) {
#pragma unroll
                for (int qi = 0; qi < QT; ++qi) st[qi][kt] = (f32x4){0.f, 0.f, 0.f, 0.f};
#pragma unroll
                for (int s = 0; s < KS; ++s) { const bf16x8 kf = *(const LAS bf16x8*)(Kt + (kt * 16 + fr) * KROW + 32 * s + 8 * fq);
#pragma unroll
                    for (int qi = 0; qi < QT; ++qi) st[qi][kt] = mfma16(kf, qf[qi][s], st[qi][kt]); } }
        }
        if (more) { FL_STOREK((j + 1) & 1); FL_LOADV(j + 1); }
        if (act) {
            bf16x8 pf[QT][NKT / 2];
#pragma unroll
            for (int qi = 0; qi < QT; ++qi) {
                float mx = fmaxf(fmaxf(st[qi][0].x, st[qi][0].y), fmaxf(st[qi][0].z, st[qi][0].w));
#pragma unroll
                for (int kt = 1; kt < NKT; ++kt) mx = fmaxf(mx, fmaxf(fmaxf(st[qi][kt].x, st[qi][kt].y), fmaxf(st[qi][kt].z, st[qi][kt].w)));
                mx = xrow_max_(mx);
                const float m_new = fmaxf(m_run[qi], mx), alpha = fexp2_(m_run[qi] - m_new);
                float ls = 0.f;
#pragma unroll
                for (int kt = 0; kt < NKT; ++kt)
#pragma unroll
                    for (int r = 0; r < 4; ++r) { const float p = fexp2_(st[qi][kt][r] - m_new); st[qi][kt][r] = p; ls += p; }
                l_run[qi] = l_run[qi] * alpha + ls; m_run[qi] = m_new;
#pragma unroll
                for (int e = 0; e < ET; ++e) ot[qi][e] = ot[qi][e] * alpha;
#pragma unroll
                for (int k2 = 0; k2 < NKT / 2; ++k2) pf[qi][k2] = pack8(st[qi][2 * k2], st[qi][2 * k2 + 1]);
            }
#pragma unroll
            for (int e = 0; e < ET; ++e) {
                const LAS bf16_t* vr = Vt + (e * 16 + fr) * VROW + 4 * fq;
#pragma unroll
                for (int k2 = 0; k2 < NKT / 2; ++k2) { const bf16x8 v0 = mk8(*(const LAS u32x2*)(vr + 32 * k2), *(const LAS u32x2*)(vr + 32 * k2 + 16));
#pragma unroll
                    for (int qi = 0; qi < QT; ++qi) ot[qi][e] = mfma16(v0, pf[qi][k2], ot[qi][e]); }
            }
        }
        if (more) FL_STOREV((j + 1) & 1);
        __syncthreads();
    }
#undef FL_LOADK
#undef FL_LOADV
#undef FL_STOREK
#undef FL_STOREV
#pragma unroll
    for (int qi = 0; qi < QT; ++qi) {
        float l = l_run[qi]; l = xrow_sum_(l);
        const float inv = frcp_(l);
#pragma unroll
        for (int e = 0; e < ET; ++e) { u32x2 w; w.x = pk2(ot[qi][e].x * inv, ot[qi][e].y * inv); w.y = pk2(ot[qi][e].z * inv, ot[qi][e].w * inv);
            *(u32x2*)(Ow + (size_t)(qi * 16 + fr) * ldo + e * 16 + 4 * fq) = w; }
    }
}
__device__ __forceinline__ void mla_attn_item(const Params& P, LAS unsigned char* lds, int it, int tid, int wave, int lane) {
    const int qt = 7 - (it >> 6), bh = it & 63;
    const bf16_t* Q = (const bf16_t*)((unsigned char*)P.out + MLA_Q_OFF) + ((size_t)bh * SEQ + qt * 256 + wave * 32) * 96;
    const bf16_t* K = (const bf16_t*)((unsigned char*)P.out + MLA_K_OFF) + (size_t)bh * SEQ * 96;
    const bf16_t* VT = (const bf16_t*)((unsigned char*)P.out + MLA_VT_OFF) + (size_t)bh * NCHUNK * 4096;
    bf16_t* y = (bf16_t*)(P.ws + WS_R + R_Y) + ((size_t)(bh >> 2) * SEQ + qt * 256 + wave * 32) * DM + 512 + (bh & 3) * 64;
    flash_item<96, 64, 64, 2>(lds, Q, 96, K, 96, VT, 64, 4096, y, DM, 4 * qt + 4, 4 * qt + (wave >> 1) + 1, tid, lane);
}
constexpr int XA_KROW = 264, XA_VROW = 72, XA_KBUF = 32 * XA_KROW * 2, XA_VBUF = 128 * XA_VROW * 2, XA_VOFF = 2 * XA_KBUF;
__device__ __forceinline__ void xa_item(const Params& P, int l, LAS unsigned char* lds, int it, int tid, int wave, int lane) {
    const int qt = it & 7, h = (it >> 3) & 3, b = it >> 5, fr = lane & 15, fq = lane >> 4;
    const size_t qoff = ((size_t)b * SEQ + qt * 256 + wave * 32) * DM + h * 256;
    const bf16_t* Q = (const bf16_t*)(P.ws + WS_R) + qoff; bf16_t* O = (bf16_t*)(P.ws + WS_R + R_OX) + qoff;
    const bf16_t* Kb = (const bf16_t*)(P.ws + WS_KVM + (size_t)l * KVM_LAYER) + (size_t)b * NMEM * DM + h * 256;
    const bf16_t* VTb = (const bf16_t*)(P.ws + WS_KVM + (size_t)l * KVM_LAYER + (size_t)4096 * 1024 * 2) + (size_t)h * 256 * 4096 + b * NMEM;
    u32x4 stg[2];
#define XA_LOADK(j_) do { _Pragma("unroll") for (int i = 0; i < 2; ++i) { const int p = tid + 512 * i, row = p >> 5, pc = p & 31; stg[i] = *(const u32x4*)(Kb + (size_t)((j_) * 32 + row) * DM + pc * 8); } } while (0)
#define XA_STOREK(buf_) do { _Pragma("unroll") for (int i = 0; i < 2; ++i) { const int p = tid + 512 * i, row = p >> 5, pc = p & 31; *(LAS u32x4*)(lds + (buf_) * XA_KBUF + (row * XA_KROW + pc * 8) * 2) = stg[i]; } } while (0)
#define XA_LOADV(t_) do { _Pragma("unroll") for (int i = 0; i < 2; ++i) { const int p = tid + 512 * i, row = p >> 3, pc = p & 7; stg[i] = *(const u32x4*)(VTb + (size_t)(((t_) >> 2) * 128 + row) * 4096 + ((t_) & 3) * 64 + pc * 8); } } while (0)
#define XA_STOREV(buf_) do { _Pragma("unroll") for (int i = 0; i < 2; ++i) { const int p = tid + 512 * i, row = p >> 3, pc = p & 7; *(LAS u32x4*)(lds + XA_VOFF + (buf_) * XA_VBUF + (row * XA_VROW + pc * 8) * 2) = stg[i]; } } while (0)
    XA_LOADK(0);
    bf16x8 pf[2][8];
    float linv[2], c1[2];
    {
        bf16x8 qf[2][8];
#pragma unroll
        for (int qi = 0; qi < 2; ++qi)
#pragma unroll
            for (int s = 0; s < 8; ++s) qf[qi][s] = *(const bf16x8*)(Q + (size_t)(qi * 16 + fr) * DM + 32 * s + 8 * fq);
        XA_STOREK(0);
        __syncthreads();
        float m1[2], l1[2];
#pragma unroll
        for (int half = 0; half < 2; ++half) {
            f32x4 S[2][8];
#pragma unroll
            for (int jj = 0; jj < 4; ++jj) { const int j = half * 4 + jj;
                if (j < 7) XA_LOADK(j + 1); else XA_LOADV(0);
                const LAS bf16_t* Kt = (const LAS bf16_t*)(lds + (j & 1) * XA_KBUF);
#pragma unroll
                for (int kt = 0; kt < 2; ++kt) {
                    f32x4 a0 = {0.f, 0.f, 0.f, 0.f}, a1 = {0.f, 0.f, 0.f, 0.f};
#pragma unroll
                    for (int s = 0; s < 8; ++s) { const bf16x8 kf = *(const LAS bf16x8*)(Kt + (kt * 16 + fr) * XA_KROW + 32 * s + 8 * fq); a0 = mfma16(kf, qf[0][s], a0); a1 = mfma16(kf, qf[1][s], a1); }
                    S[0][2 * jj + kt] = a0; S[1][2 * jj + kt] = a1; __builtin_amdgcn_sched_barrier(0); }
                if (j < 7) XA_STOREK((j + 1) & 1); else XA_STOREV(0);
                __syncthreads();
            }
#pragma unroll
            for (int qi = 0; qi < 2; ++qi) {
                float mx = -1e30f;
#pragma unroll
                for (int t = 0; t < 8; ++t) mx = fmaxf(mx, fmaxf(fmaxf(S[qi][t].x, S[qi][t].y), fmaxf(S[qi][t].z, S[qi][t].w)));
                mx = xrow_max_(mx);
                if (half == 1) { const float m = fmaxf(m1[qi], mx); c1[qi] = fexp2_(m1[qi] - m); mx = m; }
                float ls = 0.f;
#pragma unroll
                for (int t = 0; t < 4; ++t) { f32x4 pa, pb;
#pragma unroll
                    for (int r = 0; r < 4; ++r) { pa[r] = fexp2_(S[qi][2 * t][r] - mx); pb[r] = fexp2_(S[qi][2 * t + 1][r] - mx); }
                    ls += ((pa.x + pa.y) + (pa.z + pa.w)) + ((pb.x + pb.y) + (pb.z + pb.w));
                    pf[qi][half * 4 + t] = pack8(pa, pb);
                    asm volatile("" : "+v"(ls)); }
                ls = xrow_sum_(ls);
                if (half == 0) { m1[qi] = mx; l1[qi] = ls; } else linv[qi] = frcp_(l1[qi] * c1[qi] + ls);
            }
        }
    }
#pragma unroll
    for (int eh = 0; eh < 2; ++eh) {
        f32x4 ot[2][8];
#pragma unroll
        for (int qi = 0; qi < 2; ++qi)
#pragma unroll
            for (int e = 0; e < 8; ++e) ot[qi][e] = (f32x4){0.f, 0.f, 0.f, 0.f};
#pragma unroll
        for (int jv = 0; jv < 4; ++jv) { const int t = eh * 4 + jv;
            if (t < 7) XA_LOADV(t + 1);
            const LAS bf16_t* Vt = (const LAS bf16_t*)(lds + XA_VOFF + (t & 1) * XA_VBUF);
#pragma unroll
            for (int e = 0; e < 8; ++e) { const LAS bf16_t* vr = Vt + (e * 16 + fr) * XA_VROW + 4 * fq;
                const bf16x8 v0 = mk8(*(const LAS u32x2*)vr, *(const LAS u32x2*)(vr + 16)), v1 = mk8(*(const LAS u32x2*)(vr + 32), *(const LAS u32x2*)(vr + 48));
                ot[0][e] = mfma16(v0, pf[0][2 * jv], ot[0][e]); ot[1][e] = mfma16(v0, pf[1][2 * jv], ot[1][e]);
                ot[0][e] = mfma16(v1, pf[0][2 * jv + 1], ot[0][e]); ot[1][e] = mfma16(v1, pf[1][2 * jv + 1], ot[1][e]); if (e & 1) __builtin_amdgcn_sched_barrier(0); }
            if (jv == 1) {
#pragma unroll
                for (int e = 0; e < 8; ++e) { ot[0][e] = ot[0][e] * c1[0]; ot[1][e] = ot[1][e] * c1[1]; } }
            if (t < 7) XA_STOREV((t + 1) & 1);
            __syncthreads();
        }
#pragma unroll
        for (int qi = 0; qi < 2; ++qi)
#pragma unroll
            for (int e = 0; e < 8; ++e) { u32x2 w; w.x = pk2(ot[qi][e].x * linv[qi], ot[qi][e].y * linv[qi]); w.y = pk2(ot[qi][e].z * linv[qi], ot[qi][e].w * linv[qi]);
                *(u32x2*)(O + (size_t)(qi * 16 + fr) * DM + eh * 128 + e * 16 + 4 * fq) = w; }
    }
#undef XA_LOADK
#undef XA_STOREK
#undef XA_LOADV
#undef XA_STOREV
}
constexpr int GP_KN = 0, GP_KB = 9216, GP_QN = 18432, GP_L = 9216, GP_RHS = 27648, GP_G = 60416, GP_GC = 60672, GP_HEAD = 61440;
__device__ __forceinline__ bf16_t* gdn_buf(const Params& P, int chh, int k) { return (bf16_t*)(P.ws + WS_GDN) + ((size_t)chh * 5 + k) * 4096; }
__device__ __forceinline__ void gdn_pre_item(const Params& P, int l, LAS unsigned char* lds, int it, int tid) {
    const int hp = it & 1, n = (it >> 1) & 31, b = it >> 6;
    const int hh = tid >> 8, h = 2 * hp + hh, tt = tid & 255, c = tt >> 2, qr = tt & 3, lane = tid & 63;
    LAS unsigned char* L = lds + hh * GP_HEAD;
    const bf16_t* z = (const bf16_t*)(P.ws + WS_R);
    const int s = n * 64 + c; const size_t tok = (size_t)b * SEQ + s;
    const float* cw = P.gdn_conv_w + (size_t)l * 4 * 768;
    const int chh = (b * NCHUNK + n) * 4 + h;
    float q[16], k[16], v[16];
#pragma unroll
    for (int part = 0; part < 3; ++part) {
        float* dst = part == 0 ? q : (part == 1 ? k : v);
        const int ch0 = part * 256 + h * 64 + qr * 16;
#pragma unroll
        for (int i = 0; i < 16; ++i) dst[i] = 0.f;
#pragma unroll
        for (int kk = 0; kk < 4; ++kk) { {
            const bool okk = s - 3 + kk >= 0; const float mk = okk ? 1.f : 0.f;
            const bf16_t* zr = z + (okk ? tok - 3 + kk : tok) * ZP + Z_GQKV + ch0; const u32x4 w0 = *(const u32x4*)zr, w1 = *(const u32x4*)(zr + 8);
            const float* wr = cw + kk * 768 + ch0; const f32x4 c0 = *(const f32x4*)wr * mk, c1 = *(const f32x4*)(wr + 4) * mk, c2 = *(const f32x4*)(wr + 8) * mk, c3 = *(const f32x4*)(wr + 12) * mk;
            dst[0] += c0.x * bflo(w0.x); dst[1] += c0.y * bfhi(w0.x); dst[2] += c0.z * bflo(w0.y); dst[3] += c0.w * bfhi(w0.y);
            dst[4] += c1.x * bflo(w0.z); dst[5] += c1.y * bfhi(w0.z); dst[6] += c1.z * bflo(w0.w); dst[7] += c1.w * bfhi(w0.w);
            dst[8] += c2.x * bflo(w1.x); dst[9] += c2.y * bfhi(w1.x); dst[10] += c2.z * bflo(w1.y); dst[11] += c2.w * bfhi(w1.y);
            dst[12] += c3.x * bflo(w1.z); dst[13] += c3.y * bfhi(w1.z); dst[14] += c3.z * bflo(w1.w); dst[15] += c3.w * bfhi(w1.w); } }
#pragma unroll
        for (int i = 0; i < 16; ++i) dst[i] = siluf_(dst[i]);
    }
    float sq = 0.f, sk = 0.f;
#pragma unroll
    for (int i = 0; i < 16; ++i) { sq += q[i] * q[i]; sk += k[i] * k[i]; }
    sq = sum4_(sq); sk = sum4_(sk);
    const float rq = frsq_(sq + EPS) * 0.125f, rk = frsq_(sk + EPS);
    const bf16_t* zt = z + tok * ZP;
    const float beta = sigmoidf_(bf2f(zt[Z_GB + h]));
    const float g = -fexp_(P.gdn_a_log[l * 4 + h]) * softplusf_(bf2f(zt[Z_GA + h]) + P.gdn_dt_bias[l * 4 + h]);
    {
        u32x4 w0, w1;
#define PK16(dst0, dst1, src, sc) do { dst0.x = pk2(src[0] * (sc), src[1] * (sc)); dst0.y = pk2(src[2] * (sc), src[3] * (sc)); dst0.z = pk2(src[4] * (sc), src[5] * (sc)); dst0.w = pk2(src[6] * (sc), src[7] * (sc)); \
        dst1.x = pk2(src[8] * (sc), src[9] * (sc)); dst1.y = pk2(src[10] * (sc), src[11] * (sc)); dst1.z = pk2(src[12] * (sc), src[13] * (sc)); dst1.w = pk2(src[14] * (sc), src[15] * (sc)); } while (0)
        PK16(w0, w1, k, rk);        *(LAS u32x4*)(L + GP_KN + (c * 72 + qr * 16) * 2) = w0; *(LAS u32x4*)(L + GP_KN + (c * 72 + qr * 16 + 8) * 2) = w1;
        PK16(w0, w1, k, rk * beta); *(LAS u32x4*)(L + GP_KB + (c * 72 + qr * 16) * 2) = w0; *(LAS u32x4*)(L + GP_KB + (c * 72 + qr * 16 + 8) * 2) = w1;
        PK16(w0, w1, q, rq);        *(LAS u32x4*)(L + GP_QN + (c * 72 + qr * 16) * 2) = w0; *(LAS u32x4*)(L + GP_QN + (c * 72 + qr * 16 + 8) * 2) = w1;
        LAS float* rhs = (LAS float*)(L + GP_RHS) + c * 128 + qr * 16;
#pragma unroll
        for (int i = 0; i < 4; ++i) *(LAS f32x4*)(rhs + 4 * i) = (f32x4){v[4 * i] * beta, v[4 * i + 1] * beta, v[4 * i + 2] * beta, v[4 * i + 3] * beta};
        if (qr == 0) ((LAS float*)(L + GP_G))[c] = g;
    }
    __syncthreads();
    {
        float gc = 0.f, run = 0.f; const LAS float* G = (const LAS float*)(L + GP_G);
#pragma unroll 16
        for (int i = 0; i < 64; ++i) { run += G[i]; gc = (i == c) ? run : gc; }
        const float eg = fexp_(gc), ek = fexp_(run - gc);
        LAS float* rhs = (LAS float*)(L + GP_RHS) + c * 128 + 64 + qr * 16;
#pragma unroll
        for (int i = 0; i < 4; ++i) *(LAS f32x4*)(rhs + 4 * i) = (f32x4){k[4 * i] * rk * beta * eg, k[4 * i + 1] * rk * beta * eg, k[4 * i + 2] * rk * beta * eg, k[4 * i + 3] * rk * beta * eg};
        u32x4 w0, w1; PK16(w0, w1, q, rq * eg);
        bf16_t* qd = gdn_buf(P, chh, 3) + c * 64 + qr * 16; *(u32x4*)qd = w0; *(u32x4*)(qd + 8) = w1;
        bf16_t* kdt = gdn_buf(P, chh, 4) + (qr * 16) * 64 + c;
#pragma unroll
        for (int i = 0; i < 16; ++i) kdt[i * 64] = f2bf(k[i] * rk * ek);
        if (qr == 0) ((LAS float*)(L + GP_GC))[c] = gc;
        if (tt == 0) ((float*)(P.ws + WS_GL))[chh] = fexp_(run);
    }
#undef PK16
    __syncthreads();
    {
        const int it4 = (tid >> 6) & 3, fr = lane & 15, fq = lane >> 4;
        const LAS bf16_t* Kn = (const LAS bf16_t*)(L + GP_KN); const LAS bf16_t* KB = (const LAS bf16_t*)(L + GP_KB); const LAS bf16_t* Qn = (const LAS bf16_t*)(L + GP_QN);
        const LAS float* GC = (const LAS float*)(L + GP_GC);
        const bf16x8 a0 = *(const LAS bf16x8*)(KB + (it4 * 16 + fr) * 72 + 8 * fq), a1 = *(const LAS bf16x8*)(KB + (it4 * 16 + fr) * 72 + 32 + 8 * fq);
        const bf16x8 q0 = *(const LAS bf16x8*)(Qn + (it4 * 16 + fr) * 72 + 8 * fq), q1 = *(const LAS bf16x8*)(Qn + (it4 * 16 + fr) * 72 + 32 + 8 * fq);
        float gci[4];
#pragma unroll
        for (int r = 0; r < 4; ++r) gci[r] = GC[it4 * 16 + 4 * fq + r];
        f32x4 lv[4]; bf16_t* att = gdn_buf(P, chh, 2);
#pragma unroll
        for (int jt = 0; jt < 4; ++jt) {
            const bf16x8 b0 = *(const LAS bf16x8*)(Kn + (jt * 16 + fr) * 72 + 8 * fq), b1 = *(const LAS bf16x8*)(Kn + (jt * 16 + fr) * 72 + 32 + 8 * fq);
            f32x4 al = {0.f, 0.f, 0.f, 0.f}, aa = {0.f, 0.f, 0.f, 0.f};
            al = mfma16(a0, b0, al); al = mfma16(a1, b1, al); aa = mfma16(q0, b0, aa); aa = mfma16(q1, b1, aa);
            const int j = jt * 16 + fr; const float gcj = GC[j];
#pragma unroll
            for (int r = 0; r < 4; ++r) { const int i = it4 * 16 + 4 * fq + r; const float dec = fexp_(fminf(gci[r] - gcj, 0.f));
                lv[jt][r] = (i > j) ? al[r] * dec : 0.f; att[i * 64 + j] = f2bf((i >= j) ? aa[r] * dec : 0.f); }
        }
        __syncthreads();
        LAS float* Lm = (LAS float*)(L + GP_L);
#pragma unroll
        for (int jt = 0; jt < 4; ++jt)
#pragma unroll
            for (int r = 0; r < 4; ++r) Lm[(it4 * 16 + 4 * fq + r) * 64 + (fr & 1) * 32 + jt * 8 + (fr >> 1)] = lv[jt][r];
    }
    __syncthreads();
    {
        const int col = tt >> 1, p = tt & 1;
        const LAS float* Lp = (const LAS float*)(L + GP_L) + p * 32; const LAS float* rhs = (const LAS float*)(L + GP_RHS) + col;
        float xs[32];
#pragma unroll
        for (int k = 0; k < 32; ++k) xs[k] = 0.f;
#pragma unroll
        for (int ib = 0; ib < 4; ++ib) {
            float rv[16];
#pragma unroll
            for (int t = 0; t < 16; ++t) rv[t] = rhs[(ib * 16 + t) * 128];
#pragma unroll
            for (int t = 0; t < 16; ++t) { const int i = ib * 16 + t;
                float a0 = 0.f, a1 = 0.f;
#pragma unroll
                for (int k4 = 0; k4 < ((i + 1) / 2 + 3) / 4; ++k4) { const f32x4 lr = *(const LAS f32x4*)(Lp + i * 64 + 4 * k4);
                    a0 += lr.x * xs[4 * k4 + 0]; a1 += lr.y * xs[4 * k4 + 1]; a0 += lr.z * xs[4 * k4 + 2]; a1 += lr.w * xs[4 * k4 + 3]; }
                float acc = a0 + a1; acc += dpp_xor1(acc);
                const float xi = rv[t] - acc;
                xs[i >> 1] = (p == (i & 1)) ? xi : xs[i >> 1];
            }
        }
        if (col < 64) {
            bf16_t* ut = gdn_buf(P, chh, 1) + col * 64 + 32 * p;
            unsigned wv[16];
#pragma unroll
            for (int k = 0; k < 32; ++k) { const float other = dpp_xor1(xs[k]);
                const float lo = p ? other : xs[k], hi = p ? xs[k] : other;
                if ((k >> 4) == 0) { if (p == 0) wv[k & 15] = pk2(lo, hi); } else { if (p == 1) wv[k & 15] = pk2(lo, hi); } }
#pragma unroll
            for (int g4 = 0; g4 < 4; ++g4) *(u32x4*)(ut + 8 * g4) = (u32x4){wv[4 * g4], wv[4 * g4 + 1], wv[4 * g4 + 2], wv[4 * g4 + 3]};
        } else { bf16_t* wo = gdn_buf(P, chh, 0) + (col - 64) + p * 64;
#pragma unroll
            for (int k = 0; k < 32; ++k) wo[k * 128] = f2bf(xs[k]); }
    }
    __syncthreads();
}

constexpr int GC_W = 0, GC_UT = 9216, GC_ATT = 18432, GC_QD = 27648, GC_KDT = 36864, GC_O = 46080, GC_BH = 62720;
__device__ __forceinline__ bf16x8 lds_perm(const LAS unsigned char* M, int row, int s, int fq) { const LAS unsigned char* p = M + row * 144 + 64 * s + 8 * fq; return mk8(*(const LAS u32x2*)p, *(const LAS u32x2*)(p + 32)); }
__device__ __forceinline__ void gdn_chain_item(const Params& P, int l, LAS unsigned char* lds, int gi, int tid, int wave, int lane) {
    const int q2 = wave >> 2, bh = gi * 2 + q2, eb = wave & 3, b = bh >> 2, h = bh & 3, fr = lane & 15, fq = lane >> 4;
    const bf16_t* z = (const bf16_t*)(P.ws + WS_R); bf16_t* y = (bf16_t*)(P.ws + WS_R + R_Y);
    LAS unsigned char* L = lds + q2 * GC_BH;
    const int tt = tid & 255, ec = tt >> 2, eq = tt & 3;
    float ng[16];
#pragma unroll
    for (int j = 0; j < 16; ++j) ng[j] = P.gdn_norm[l * 64 + eq * 16 + j];
    u32x4 stg[10];
    const bf16_t* src0[2] = { gdn_buf(P, ((gi * 2 >> 2) * NCHUNK) * 4 + ((gi * 2) & 3), 0), gdn_buf(P, (((gi * 2 + 1) >> 2) * NCHUNK) * 4 + ((gi * 2 + 1) & 3), 0) };
#define GC_LOAD(n_) do { _Pragma("unroll") for (int i = 0; i < 10; ++i) { const int p = tid + 512 * i, qq = p / 2560, pp = p % 2560; \
        stg[i] = *(const u32x4*)(src0[qq] + (size_t)(n_) * 4 * 5 * 4096 + (size_t)pp * 8); } } while (0)
#define GC_WRITE() do { _Pragma("unroll") for (int i = 0; i < 10; ++i) { const int p = tid + 512 * i, qq = p / 2560, pp = p % 2560, mat = pp >> 9, row = (pp & 511) >> 3, pc = pp & 7; \
        *(LAS u32x4*)(lds + qq * GC_BH + mat * 9216 + row * 144 + pc * 16) = stg[i]; } } while (0)
    GC_LOAD(0); GC_WRITE();
    f32x4 S[4];
#pragma unroll
    for (int t = 0; t < 4; ++t) S[t] = (f32x4){0.f, 0.f, 0.f, 0.f};
    __syncthreads();
    for (int n = 0; n < NCHUNK; ++n) {
        const int chh = (b * NCHUNK + n) * 4 + h;
        if (n + 1 < NCHUNK) GC_LOAD(n + 1);
        const size_t etok = (size_t)(gi * 2 + (tid >> 8) >> 2) * SEQ + n * 64 + ec; const int eh = (gi * 2 + (tid >> 8)) & 3;
        const u32x4 gw0 = *(const u32x4*)(z + etok * ZP + Z_GG + eh * 64 + eq * 16), gw1 = *(const u32x4*)(z + etok * ZP + Z_GG + eh * 64 + eq * 16 + 8);
        const float egl = ((const float*)(P.ws + WS_GL))[chh];
        const bf16x8 sb0 = pack8(S[0], S[1]), sb1 = pack8(S[2], S[3]);
        f32x4 vn[4], o[4];
#pragma unroll
        for (int ct = 0; ct < 4; ++ct) {
            f32x4 a = {0.f, 0.f, 0.f, 0.f}; a = mfma16(lds_perm(L + GC_W, ct * 16 + fr, 0, fq), sb0, a); a = mfma16(lds_perm(L + GC_W, ct * 16 + fr, 1, fq), sb1, a);
            const u32x2 uw = *(const LAS u32x2*)(L + GC_UT + (eb * 16 + fr) * 144 + (ct * 16 + 4 * fq) * 2);
            vn[ct] = (f32x4){bflo(uw.x) - a.x, bfhi(uw.x) - a.y, bflo(uw.y) - a.z, bfhi(uw.y) - a.w};
            f32x4 oo = {0.f, 0.f, 0.f, 0.f}; oo = mfma16(lds_perm(L + GC_QD, ct * 16 + fr, 0, fq), sb0, oo); oo = mfma16(lds_perm(L + GC_QD, ct * 16 + fr, 1, fq), sb1, oo); o[ct] = oo;
        }
        const bf16x8 vb0 = pack8(vn[0], vn[1]), vb1 = pack8(vn[2], vn[3]);
#pragma unroll
        for (int ct = 0; ct < 4; ++ct) { o[ct] = mfma16(lds_perm(L + GC_ATT, ct * 16 + fr, 0, fq), vb0, o[ct]); o[ct] = mfma16(lds_perm(L + GC_ATT, ct * 16 + fr, 1, fq), vb1, o[ct]); }
#pragma unroll
        for (int dt = 0; dt < 4; ++dt) { f32x4 a = S[dt] * egl; a = mfma16(lds_perm(L + GC_KDT, dt * 16 + fr, 0, fq), vb0, a); a = mfma16(lds_perm(L + GC_KDT, dt * 16 + fr, 1, fq), vb1, a); S[dt] = a; }
        LAS float* Ol = (LAS float*)(L + GC_O);
#pragma unroll
        for (int ct = 0; ct < 4; ++ct)
#pragma unroll
            for (int r = 0; r < 4; ++r) Ol[(ct * 16 + 4 * fq + r) * 65 + eb * 16 + fr] = o[ct][r];
        __syncthreads();
        if (n + 1 < NCHUNK) GC_WRITE();
        {
            const LAS float* orow = (const LAS float*)(lds + (tid >> 8) * GC_BH + GC_O) + ec * 65 + eq * 16;
            float ov[16]; float s2 = 0.f;
#pragma unroll
            for (int j = 0; j < 16; ++j) { ov[j] = orow[j]; s2 += ov[j] * ov[j]; }
            s2 = sum4_(s2);
            const float rs = frsq_(s2 * (1.0f / 64.0f) + EPS);
            const unsigned gws[8] = {gw0.x, gw0.y, gw0.z, gw0.w, gw1.x, gw1.y, gw1.z, gw1.w};
            unsigned ow[8];
#pragma unroll
            for (int j = 0; j < 8; ++j) ow[j] = pk2(ov[2 * j] * rs * ng[2 * j] * siluf_(bflo(gws[j])), ov[2 * j + 1] * rs * ng[2 * j + 1] * siluf_(bfhi(gws[j])));
            bf16_t* yp = y + etok * DM + 768 + eh * 64 + eq * 16;
            *(u32x4*)yp = (u32x4){ow[0], ow[1], ow[2], ow[3]}; *(u32x4*)(yp + 8) = (u32x4){ow[4], ow[5], ow[6], ow[7]};
        }
        __syncthreads();
    }
#undef GC_LOAD
#undef GC_WRITE
}

constexpr int RT_BUF = 36864, RT_Q = 0, RT_K = 9216, RT_KZT = 18432, RT_VT = 27648, RT_P = 73728, RT_ST = 82944, RT_O = 92160;
__device__ __forceinline__ void ret_chain_item(const Params& P, int l, LAS unsigned char* lds, int it, int tid, int wave, int lane) {
    const int b = it >> 2, h = it & 3, fr = lane & 15, fq = lane >> 4;
    const bf16_t* z = (const bf16_t*)(P.ws + WS_R); bf16_t* y = (bf16_t*)(P.ws + WS_R + R_Y);
    LAS bf16_t* Pm = (LAS bf16_t*)(lds + RT_P); LAS bf16_t* ST = (LAS bf16_t*)(lds + RT_ST); LAS float* Of = (LAS float*)(lds + RT_O);
    const float lg = log1pf(-exp2f(-5.0f - (float)h));
    const float cdec = fexp_(64.0f * lg);
    for (int i = tid; i < 64 * 72 / 2; i += 512) ((LAS unsigned*)ST)[i] = 0u;
    const int it4 = wave >> 1, jt0 = 2 * (wave & 1);
    f32x4 S[2] = {{0.f, 0.f, 0.f, 0.f}, {0.f, 0.f, 0.f, 0.f}};
    const int lc = tid >> 3, pg = tid & 7;
    float invf[4];
#pragma unroll
    for (int ii = 0; ii < 4; ++ii) invf[ii] = exp2f(-(float)(4 * pg + ii) * (13.287712379549449f / 32.0f));
    const float zeta = fexp_((63.0f - (float)lc) * lg);
    const f32x4 gn0 = *(const f32x4*)(P.ret_gn + l * 256 + h * 64 + 8 * pg), gn1 = *(const f32x4*)(P.ret_gn + l * 256 + h * 64 + 8 * pg + 4);
    const size_t tok0 = (size_t)b * SEQ + lc;
    u32x2 q1w, q2w, k1w, k2w; u32x4 vw; int posi;
#define RT_LOAD(n_) do { const bf16_t* zr_ = z + (tok0 + (n_) * 64) * ZP; q1w = *(const u32x2*)(zr_ + Z_RQ + h * 64 + 4 * pg); q2w = *(const u32x2*)(zr_ + Z_RQ + h * 64 + 32 + 4 * pg); \
        k1w = *(const u32x2*)(zr_ + Z_RK + h * 64 + 4 * pg); k2w = *(const u32x2*)(zr_ + Z_RK + h * 64 + 32 + 4 * pg); vw = *(const u32x4*)(zr_ + Z_RV + h * 64 + 8 * pg); posi = P.pos[tok0 + (n_) * 64]; } while (0)
#define RT_STAGE(buf_) do { LAS bf16_t* Qs_ = (LAS bf16_t*)(lds + (buf_) * RT_BUF + RT_Q); LAS bf16_t* Ks_ = (LAS bf16_t*)(lds + (buf_) * RT_BUF + RT_K); \
        LAS bf16_t* KzT_ = (LAS bf16_t*)(lds + (buf_) * RT_BUF + RT_KZT); LAS bf16_t* VT_ = (LAS bf16_t*)(lds + (buf_) * RT_BUF + RT_VT); const float pos = (float)posi; \
        const float q1[4] = {bflo(q1w.x), bfhi(q1w.x), bflo(q1w.y), bfhi(q1w.y)}, q2[4] = {bflo(q2w.x), bfhi(q2w.x), bflo(q2w.y), bfhi(q2w.y)}; \
        const float k1[4] = {bflo(k1w.x), bfhi(k1w.x), bflo(k1w.y), bfhi(k1w.y)}, k2[4] = {bflo(k2w.x), bfhi(k2w.x), bflo(k2w.y), bfhi(k2w.y)}; \
        float qa[4], qb[4], ka[4], kb[4]; \
        _Pragma("unroll") for (int ii = 0; ii < 4; ++ii) { float sn, cs; sincos_rev(pos * invf[ii], sn, cs); \
            qa[ii] = (q1[ii] * cs - q2[ii] * sn) * 0.125f; qb[ii] = (q1[ii] * sn + q2[ii] * cs) * 0.125f; ka[ii] = k1[ii] * cs - k2[ii] * sn; kb[ii] = k1[ii] * sn + k2[ii] * cs; } \
        u32x2 w_; w_.x = pk2(qa[0], qa[1]); w_.y = pk2(qa[2], qa[3]); *(LAS u32x2*)(Qs_ + lc * 72 + 4 * pg) = w_; \
        w_.x = pk2(qb[0], qb[1]); w_.y = pk2(qb[2], qb[3]); *(LAS u32x2*)(Qs_ + lc * 72 + 32 + 4 * pg) = w_; \
        w_.x = pk2(ka[0], ka[1]); w_.y = pk2(ka[2], ka[3]); *(LAS u32x2*)(Ks_ + lc * 72 + 4 * pg) = w_; \
        w_.x = pk2(kb[0], kb[1]); w_.y = pk2(kb[2], kb[3]); *(LAS u32x2*)(Ks_ + lc * 72 + 32 + 4 * pg) = w_; \
        _Pragma("unroll") for (int ii = 0; ii < 4; ++ii) { KzT_[(4 * pg + ii) * 72 + lc] = f2bf(ka[ii] * zeta); KzT_[(32 + 4 * pg + ii) * 72 + lc] = f2bf(kb[ii] * zeta); } \
        const unsigned vv[4] = {vw.x, vw.y, vw.z, vw.w}; \
        _Pragma("unroll") for (int ii = 0; ii < 4; ++ii) { VT_[(8 * pg + 2 * ii) * 72 + lc] = (bf16_t)(vv[ii] & 0xffffu); VT_[(8 * pg + 2 * ii + 1) * 72 + lc] = (bf16_t)(vv[ii] >> 16); } } while (0)
    RT_LOAD(0); RT_STAGE(0);
    __syncthreads();
    for (int n = 0; n < NCHUNK; ++n) {
        const int cb = n & 1;
        const LAS bf16_t* Qs = (const LAS bf16_t*)(lds + cb * RT_BUF + RT_Q); const LAS bf16_t* Ks = (const LAS bf16_t*)(lds + cb * RT_BUF + RT_K);
        const LAS bf16_t* KzT = (const LAS bf16_t*)(lds + cb * RT_BUF + RT_KZT); const LAS bf16_t* VT = (const LAS bf16_t*)(lds + cb * RT_BUF + RT_VT);
        const size_t tok = tok0 + n * 64;
        if (n + 1 < NCHUNK) RT_LOAD(n + 1);
        const u32x4 gw = *(const u32x4*)(z + tok * ZP + Z_RG + h * 64 + 8 * pg);
        const bf16x8 a0 = *(const LAS bf16x8*)(Qs + (it4 * 16 + fr) * 72 + 8 * fq), a1 = *(const LAS bf16x8*)(Qs + (it4 * 16 + fr) * 72 + 32 + 8 * fq);
        f32x4 cross[2];
#pragma unroll
        for (int t = 0; t < 2; ++t) { const int jt = jt0 + t;
            f32x4 p = {0.f, 0.f, 0.f, 0.f};
            p = mfma16(a0, *(const LAS bf16x8*)(Ks + (jt * 16 + fr) * 72 + 8 * fq), p); p = mfma16(a1, *(const LAS bf16x8*)(Ks + (jt * 16 + fr) * 72 + 32 + 8 * fq), p);
            f32x4 cr = {0.f, 0.f, 0.f, 0.f};
            cr = mfma16(a0, *(const LAS bf16x8*)(ST + (jt * 16 + fr) * 72 + 8 * fq), cr); cr = mfma16(a1, *(const LAS bf16x8*)(ST + (jt * 16 + fr) * 72 + 32 + 8 * fq), cr);
#pragma unroll
            for (int r = 0; r < 4; ++r) { const int i = it4 * 16 + 4 * fq + r, j = jt * 16 + fr; const int dd = i > j ? i - j : j - i;
                Pm[i * 72 + j] = f2bf(p[r] * fexp_((float)dd * lg)); cr[r] *= fexp_((float)(i + 1) * lg); }
            cross[t] = cr; }
        __syncthreads();
        const bf16x8 p0 = *(const LAS bf16x8*)(Pm + (it4 * 16 + fr) * 72 + 8 * fq), p1 = *(const LAS bf16x8*)(Pm + (it4 * 16 + fr) * 72 + 32 + 8 * fq);
        const bf16x8 kz0 = *(const LAS bf16x8*)(KzT + (it4 * 16 + fr) * 72 + 8 * fq), kz1 = *(const LAS bf16x8*)(KzT + (it4 * 16 + fr) * 72 + 32 + 8 * fq);
#pragma unroll
        for (int t = 0; t < 2; ++t) { const int et = jt0 + t;
            const bf16x8 v0 = *(const LAS bf16x8*)(VT + (et * 16 + fr) * 72 + 8 * fq), v1 = *(const LAS bf16x8*)(VT + (et * 16 + fr) * 72 + 32 + 8 * fq);
            f32x4 o = cross[t]; o = mfma16(p0, v0, o); o = mfma16(p1, v1, o);
#pragma unroll
            for (int r = 0; r < 4; ++r) Of[(it4 * 16 + 4 * fq + r) * 65 + et * 16 + fr] = o[r];
            f32x4 sN = S[t] * cdec; sN = mfma16(kz0, v0, sN); sN = mfma16(kz1, v1, sN); S[t] = sN;
            u32x2 w; w.x = pk2(sN.x, sN.y); w.y = pk2(sN.z, sN.w); *(LAS u32x2*)(ST + (et * 16 + fr) * 72 + it4 * 16 + 4 * fq) = w; }
        if (n + 1 < NCHUNK) RT_STAGE(cb ^ 1);
        __syncthreads();
        {
            float ov[8]; float sm = 0.f;
#pragma unroll
            for (int j = 0; j < 8; ++j) { ov[j] = Of[lc * 65 + 8 * pg + j]; sm += ov[j]; }
            sm = sum8_(sm);
            const float mu = sm * (1.0f / 64.0f); float vs = 0.f;
#pragma unroll
            for (int j = 0; j < 8; ++j) { ov[j] -= mu; vs += ov[j] * ov[j]; }
            vs = sum8_(vs);
            const float rs = frsq_(vs * (1.0f / 64.0f) + EPS);
            const float gt[8] = {bflo(gw.x), bfhi(gw.x), bflo(gw.y), bfhi(gw.y), bflo(gw.z), bfhi(gw.z), bflo(gw.w), bfhi(gw.w)};
            const float gnv[8] = {gn0.x, gn0.y, gn0.z, gn0.w, gn1.x, gn1.y, gn1.z, gn1.w};
            float r8[8];
#pragma unroll
            for (int j = 0; j < 8; ++j) r8[j] = ov[j] * rs * gnv[j] * siluf_(gt[j]);
            u32x4 w; w.x = pk2(r8[0], r8[1]); w.y = pk2(r8[2], r8[3]); w.z = pk2(r8[4], r8[5]); w.w = pk2(r8[6], r8[7]);
            *(u32x4*)(y + tok * DM + h * 64 + 8 * pg) = w;
        }
    }
#undef RT_LOAD
#undef RT_STAGE
    __syncthreads();
}

constexpr int LR_XC = 0, LR_AU = 33792;
__device__ __forceinline__ void lru_item(const Params& P, int l, LAS unsigned char* lds, int it, int mode, int tid, int wave, int lane) {
    const int b = it >> 5, n = it & 31, fr = lane & 15, fq = lane >> 4;
    const bf16_t* z = (const bf16_t*)(P.ws + WS_R); bf16_t* y = (bf16_t*)(P.ws + WS_R + R_Y);
    LAS bf16_t* XC = (LAS bf16_t*)(lds + LR_XC); LAS f32x2* AU = (LAS f32x2*)(lds + LR_AU);
    float* sumA = (float*)(P.ws + WS_LRUS); float* sumH = sumA + 16 * 32 * 256;
    {
        const int c = tid >> 3, cg = tid & 7, s = n * 64 + c; const size_t tok = (size_t)b * SEQ + s;
        const float* cw = P.lru_conv_w + (size_t)l * 4 * 256; const float* cb = P.lru_conv_b + l * 256;
#pragma unroll
        for (int g = 0; g < 4; ++g) { const int ch0 = cg * 32 + g * 8;
            const f32x4 b0 = *(const f32x4*)(cb + ch0), b1 = *(const f32x4*)(cb + ch0 + 4);
            float a[8] = {b0.x, b0.y, b0.z, b0.w, b1.x, b1.y, b1.z, b1.w};
#pragma unroll
            for (int kk = 0; kk < 4; ++kk) { const bool okk = s - 3 + kk >= 0; const float mk = okk ? 1.f : 0.f;
                const u32x4 w = *(const u32x4*)(z + (okk ? tok - 3 + kk : tok) * ZP + Z_LX + ch0);
                const f32x4 c0 = *(const f32x4*)(cw + kk * 256 + ch0) * mk, c1 = *(const f32x4*)(cw + kk * 256 + ch0 + 4) * mk;
                a[0] += c0.x * bflo(w.x); a[1] += c0.y * bfhi(w.x); a[2] += c0.z * bflo(w.y); a[3] += c0.w * bfhi(w.y);
                a[4] += c1.x * bflo(w.z); a[5] += c1.y * bfhi(w.z); a[6] += c1.z * bflo(w.w); a[7] += c1.w * bfhi(w.w); }
            u32x4 o; o.x = pk2(a[0], a[1]); o.y = pk2(a[2], a[3]); o.z = pk2(a[4], a[5]); o.w = pk2(a[6], a[7]);
            *(LAS u32x4*)(XC + c * 264 + ch0) = o; }
    }
    float hcar = 0.f, aprod = 1.f;
    if (mode == 1 && tid < 256) {
        float av[32], hv[32];
#pragma unroll
        for (int m = 0; m < 32; ++m) { const int mm = m < n ? m : 0; av[m] = sumA[(b * 32 + mm) * 256 + tid]; hv[m] = sumH[(b * 32 + mm) * 256 + tid]; }
#pragma unroll
        for (int m = 0; m < 32; ++m) if (m < n) hcar = av[m] * hcar + hv[m];
    }
    const int nb = wave >> 1, rt = wave & 1;
    const bf16_t* wa = wl(P, l, W_A) + nb * 4096; const bf16_t* wx = wl(P, l, W_X) + nb * 4096;
    bf16x8 fa[4][2], fx[4][2]; float ba[4], bx[4], spl[4];
#pragma unroll
    for (int dt = 0; dt < 4; ++dt) {
#pragma unroll
        for (int s = 0; s < 2; ++s) { fa[dt][s] = *(const bf16x8*)(wa + (dt * 16 + fr) * 64 + 32 * s + 8 * fq); fx[dt][s] = *(const bf16x8*)(wx + (dt * 16 + fr) * 64 + 32 * s + 8 * fq); }
        const int d = nb * 64 + dt * 16 + fr; ba[dt] = P.lru_ba[l * 256 + d]; bx[dt] = P.lru_bx[l * 256 + d]; spl[dt] = -8.0f * softplusf_(-P.lru_lambda[l * 256 + d]); }
    __syncthreads();
    for (int half = 0; half < 2; ++half) {
        const int trow = half * 32 + rt * 16;
        const bf16x8 x0 = *(const LAS bf16x8*)(XC + (trow + fr) * 264 + nb * 64 + 8 * fq), x1 = *(const LAS bf16x8*)(XC + (trow + fr) * 264 + nb * 64 + 32 + 8 * fq);
#pragma unroll
        for (int dt = 0; dt < 4; ++dt) {
            f32x4 ar = {0.f, 0.f, 0.f, 0.f}, ai = {0.f, 0.f, 0.f, 0.f};
            ar = mfma16(x0, fa[dt][0], ar); ar = mfma16(x1, fa[dt][1], ar); ai = mfma16(x0, fx[dt][0], ai); ai = mfma16(x1, fx[dt][1], ai);
            const int d = nb * 64 + dt * 16 + fr;
#pragma unroll
            for (int r = 0; r < 4; ++r) { const int tl = rt * 16 + 4 * fq + r;
                const float xcv = bf2f(XC[(half * 32 + tl) * 264 + d]);
                const float rr = sigmoidf_(ar[r] + ba[dt]), ii = sigmoidf_(ai[r] + bx[dt]);
                const float a = fexp_(rr * spl[dt]);
                const float u = fsqrt_(fmaxf(1.0f - a * a, 0.f)) * (ii * xcv);
                AU[tl * 257 + d] = (f32x2){a, u}; }
        }
        __syncthreads();
        if (tid < 256) {
#pragma unroll 8
            for (int tk = 0; tk < 32; ++tk) { const f32x2 au = AU[tk * 257 + tid]; hcar = au.x * hcar + au.y; aprod *= au.x; if (mode == 1) AU[tk * 257 + tid].y = hcar; }
        }
        if (mode == 1) {
            __syncthreads();
            const int tk = tid >> 4, c0 = (tid & 15) * 16; const size_t tok = (size_t)b * SEQ + n * 64 + half * 32 + tk;
            const u32x4 g0 = *(const u32x4*)(z + tok * ZP + Z_LG + c0), g1 = *(const u32x4*)(z + tok * ZP + Z_LG + c0 + 8);
            const unsigned gws[8] = {g0.x, g0.y, g0.z, g0.w, g1.x, g1.y, g1.z, g1.w}; unsigned ow[8];
#pragma unroll
            for (int j = 0; j < 8; ++j) { const float h0 = AU[tk * 257 + c0 + 2 * j].y, h1 = AU[tk * 257 + c0 + 2 * j + 1].y; ow[j] = pk2(h0 * geluf_(bflo(gws[j])), h1 * geluf_(bfhi(gws[j]))); }
            bf16_t* yp = y + tok * DM + 256 + c0;
            *(u32x4*)yp = (u32x4){ow[0], ow[1], ow[2], ow[3]}; *(u32x4*)(yp + 8) = (u32x4){ow[4], ow[5], ow[6], ow[7]};
        }
        __syncthreads();
    }
    if (mode == 0 && tid < 256) { sumA[(b * 32 + n) * 256 + tid] = aprod; sumH[(b * 32 + n) * 256 + tid] = hcar; }
}

constexpr int LC_XC = 0, LC_AU = 9216;
__device__ __forceinline__ void lru_chain_item(const Params& P, int l, LAS unsigned char* lds, int it, int tid, int wave, int lane) {
    const int b = it >> 2, nb = it & 3, fr = lane & 15, fq = lane >> 4;
    const bf16_t* z = (const bf16_t*)(P.ws + WS_R); bf16_t* y = (bf16_t*)(P.ws + WS_R + R_Y);
    LAS bf16_t* XC = (LAS bf16_t*)(lds + LC_XC); LAS f32x2* AU = (LAS f32x2*)(lds + LC_AU);
    const int c = tid >> 3, cg = tid & 7, ch0 = nb * 64 + cg * 8;
    f32x4 cw0[4], cw1[4];
#pragma unroll
    for (int kk = 0; kk < 4; ++kk) { cw0[kk] = *(const f32x4*)(P.lru_conv_w + (size_t)l * 1024 + kk * 256 + ch0); cw1[kk] = *(const f32x4*)(P.lru_conv_w + (size_t)l * 1024 + kk * 256 + ch0 + 4); }
    const f32x4 cb0 = *(const f32x4*)(P.lru_conv_b + l * 256 + ch0), cb1 = *(const f32x4*)(P.lru_conv_b + l * 256 + ch0 + 4);
    const int rt = wave >> 1, dt0 = (wave & 1) * 2;
    const bf16_t* wa = wl(P, l, W_A) + nb * 4096; const bf16_t* wx = wl(P, l, W_X) + nb * 4096;
    bf16x8 fa[2][2], fx[2][2]; float ba[2], bx[2], spl[2];
#pragma unroll
    for (int t = 0; t < 2; ++t) {
#pragma unroll
        for (int s = 0; s < 2; ++s) { fa[t][s] = *(const bf16x8*)(wa + ((dt0 + t) * 16 + fr) * 64 + 32 * s + 8 * fq); fx[t][s] = *(const bf16x8*)(wx + ((dt0 + t) * 16 + fr) * 64 + 32 * s + 8 * fq); }
        const int d = nb * 64 + (dt0 + t) * 16 + fr; ba[t] = P.lru_ba[l * 256 + d]; bx[t] = P.lru_bx[l * 256 + d]; spl[t] = -8.0f * softplusf_(-P.lru_lambda[l * 256 + d]); }
    const size_t tok0 = (size_t)b * SEQ + c;
    u32x4 xr[4], gr;
#define LC_LOAD(n_) do { const size_t t_ = tok0 + (size_t)(n_) * 64; _Pragma("unroll") for (int kk = 0; kk < 4; ++kk) { const bool ok_ = (n_) * 64 + c - 3 + kk >= 0; \
        xr[kk] = *(const u32x4*)(z + (ok_ ? t_ - 3 + kk : t_) * ZP + Z_LX + ch0); } gr = *(const u32x4*)(z + t_ * ZP + Z_LG + ch0); } while (0)
    LC_LOAD(0);
    float hcar = 0.f;
    for (int n = 0; n < NCHUNK; ++n) {
        {
            float a[8] = {cb0.x, cb0.y, cb0.z, cb0.w, cb1.x, cb1.y, cb1.z, cb1.w};
#pragma unroll
            for (int kk = 0; kk < 4; ++kk) { const float mk = (n * 64 + c - 3 + kk >= 0) ? 1.f : 0.f; const f32x4 c0 = cw0[kk] * mk, c1 = cw1[kk] * mk; const u32x4 w = xr[kk];
                a[0] += c0.x * bflo(w.x); a[1] += c0.y * bfhi(w.x); a[2] += c0.z * bflo(w.y); a[3] += c0.w * bfhi(w.y);
                a[4] += c1.x * bflo(w.z); a[5] += c1.y * bfhi(w.z); a[6] += c1.z * bflo(w.w); a[7] += c1.w * bfhi(w.w); }
            u32x4 o; o.x = pk2(a[0], a[1]); o.y = pk2(a[2], a[3]); o.z = pk2(a[4], a[5]); o.w = pk2(a[6], a[7]);
            *(LAS u32x4*)(XC + c * 72 + cg * 8) = o;
        }
        const u32x4 gcur = gr;
        if (n + 1 < NCHUNK) LC_LOAD(n + 1);
        __syncthreads();
        {
            const bf16x8 x0 = *(const LAS bf16x8*)(XC + (rt * 16 + fr) * 72 + 8 * fq), x1 = *(const LAS bf16x8*)(XC + (rt * 16 + fr) * 72 + 32 + 8 * fq);
#pragma unroll
            for (int t = 0; t < 2; ++t) {
                f32x4 ar = {0.f, 0.f, 0.f, 0.f}, ai = {0.f, 0.f, 0.f, 0.f};
                ar = mfma16(x0, fa[t][0], ar); ar = mfma16(x1, fa[t][1], ar); ai = mfma16(x0, fx[t][0], ai); ai = mfma16(x1, fx[t][1], ai);
                const int dl = (dt0 + t) * 16 + fr;
#pragma unroll
                for (int r = 0; r < 4; ++r) { const int tl = rt * 16 + 4 * fq + r;
                    const float xcv = bf2f(XC[tl * 72 + dl]);
                    const float rr = sigmoidf_(ar[r] + ba[t]), ii = sigmoidf_(ai[r] + bx[t]);
                    const float av = fexp_(rr * spl[t]);
                    AU[tl * 65 + dl] = (f32x2){av, fsqrt_(fmaxf(1.0f - av * av, 0.f)) * (ii * xcv)}; }
            }
        }
        __syncthreads();
        if (tid < 64) {
#pragma unroll
            for (int blk = 0; blk < 4; ++blk) { f32x2 au[16];
#pragma unroll
                for (int k = 0; k < 16; ++k) au[k] = AU[(blk * 16 + k) * 65 + tid];
#pragma unroll
                for (int k = 0; k < 16; ++k) { hcar = au[k].x * hcar + au[k].y; au[k].y = hcar; }
#pragma unroll
                for (int k = 0; k < 16; ++k) AU[(blk * 16 + k) * 65 + tid].y = au[k].y; }
        }
        __syncthreads();
        {
            const unsigned gws[4] = {gcur.x, gcur.y, gcur.z, gcur.w}; unsigned ow[4];
#pragma unroll
            for (int j = 0; j < 4; ++j) ow[j] = pk2(AU[c * 65 + cg * 8 + 2 * j].y * geluf_(bflo(gws[j])), AU[c * 65 + cg * 8 + 2 * j + 1].y * geluf_(bfhi(gws[j])));
            *(u32x4*)(y + (tok0 + (size_t)n * 64) * DM + 256 + ch0) = (u32x4){ow[0], ow[1], ow[2], ow[3]};
        }
    }
#undef LC_LOAD
    __syncthreads();
}

constexpr int N_PHASES = 21;
constexpr int Q_RET = 64, Q_GDN = 32, Q_LRU = 64, Q_MLA = 512, Q_TOTAL = Q_RET + Q_GDN + Q_LRU + Q_MLA;

__global__ void __launch_bounds__(512, 2) hymba_fwd(Params P_) {
    extern __shared__ __attribute__((aligned(16))) unsigned char lds_raw[];
    LAS unsigned char* lds = (LAS unsigned char*)lds_raw;
    volatile LAS unsigned* LC = (volatile LAS unsigned*)(lds + LDS_CTL);
    const int G = gridDim.x;
#define SUB_TID() int tid2 = tid; asm volatile("" : "+v"(tid2)); const int lane2 = tid2 & 63, wave2 = __builtin_amdgcn_readfirstlane(tid2 >> 6); (void)lane2; (void)wave2
#if defined(__HIP_DEVICE_COMPILE__)
#define PH_PARAMS() const __attribute__((address_space(4))) Params* pp_ = (const __attribute__((address_space(4))) Params*)__builtin_amdgcn_kernarg_segment_ptr(); asm volatile("" : "+s"(pp_)); const Params P = *pp_
#else
#define PH_PARAMS() const Params P = P_
#endif
#define PH_TID() PH_PARAMS(); \
    bf16_t* xb = (bf16_t*)(P.ws + WS_XB); float* part = (float*)(P.ws + WS_PART); bf16_t* zb = (bf16_t*)(P.ws + WS_R); bf16_t* yb = (bf16_t*)(P.ws + WS_R + R_Y); bf16_t* oxb = (bf16_t*)(P.ws + WS_R + R_OX); (void)xb; (void)part; (void)zb; (void)yb; (void)oxb; \
    int tid = threadIdx.x; asm volatile("" : "+v"(tid)); const int lane = tid & 63, wave = __builtin_amdgcn_readfirstlane(tid >> 6); (void)lane; (void)wave
    unsigned* ctl = (unsigned*)(P_.ws + WS_CTL);
    if (threadIdx.x < 64) LC[threadIdx.x] = 0u;
    __syncthreads();
    const int lo = P_.ph_lo, hi = P_.ph_hi;
    XcdBarrier bar; bar.bar = ctl + CW_BAR; bar.x = 0; bar.st = LC;
    if (hi - lo > 1) bar = xcd_barrier_post(ctl + CW_BAR, LC);
#ifndef PHASE_MASK
#define PHASE_MASK 0xFFFFFFFFu
#endif
#define EN(t) ((PHASE_MASK >> (t)) & 1u)
#ifndef REPEAT_MASK
#define REPEAT_MASK 0u
#endif
#define REP(t) for (int rep_ = 0; rep_ <= (int)((REPEAT_MASK >> (t)) & 1u); ++rep_, (rep_ <= (int)((REPEAT_MASK >> (t)) & 1u) ? xcd_barrier(bar) : (void)0))
#define IN(k) (lo <= (k) && (k) < hi)
#define SEAM(k) do { if (IN(k) && IN((k) + 1)) xcd_barrier(bar); } while (0)


    if (IN(0) && EN(0)) REP(0) { PH_TID(); p0_prologue(P, lds, tid); __syncthreads(); }
    SEAM(0);
    if (IN(1) && EN(1)) REP(1) {
        PH_TID();
        const int which = blockIdx.x >> 6, l = which >> 1, isv = which & 1;
        if (which < 4) {
            const bf16_t* memn = (const bf16_t*)(P.ws + WS_GDN); const bf16_t* wkv = wl(P, l, W_KV);
            bf16_t* kout = (bf16_t*)(P.ws + WS_KVM + (size_t)l * KVM_LAYER); bf16_t* vout = kout + (size_t)4096 * 1024;
            pg8::Gemm g; pg8::EpiScaleBf16<0> E; pg8::StaticOrder S;
            if (!isv) { g = pg8::Gemm{memn, wkv, 4096, 1024, 1024}; E = pg8::EpiScaleBf16<0>{kout, 1024, nullptr}; S.init(4096, 1024, 64, blockIdx.x & 63); }
            else { g = pg8::Gemm{wkv + (size_t)1024 * 1024, memn, 1024, 4096, 1024}; E = pg8::EpiScaleBf16<0>{vout, 4096, nullptr}; S.init(1024, 4096, 64, blockIdx.x & 63); }
            pg8::gemm_phase(lds, g, S, E, tid);
        }
    }
    SEAM(1);
#pragma unroll
    for (int l = 0; l < 2; ++l) {
        const int pb = 2 + 9 * l;
        if (IN(pb + 0) && EN(2)) REP(2) { PH_TID();
            pg8::Gemm g{xb, wl(P, l, W_IN), T_TOK, ZP, DM}; pg8::StaticOrder S; S.init(T_TOK, ZP, G, blockIdx.x);
            pg8::EpiScaleBf16<0> E{zb, ZP, part}; pg8::gemm_phase(lds, g, S, E, tid);
        }
        SEAM(pb + 0);
        if (IN(pb + 1)) {
            PH_TID();
            if (EN(3)) REP(3) { SUB_TID();
_Pragma("unroll 1")
            for (int it = blockIdx.x; it < 1024; it += G) gdn_pre_item(P, l, lds, it, tid2); }
            if (EN(5)) REP(5) { SUB_TID();
_Pragma("unroll 1")
            for (int it = blockIdx.x; it < 256; it += G) mla_pre_item(P, l, lds, it, tid2, wave2, lane2); }
        }
        SEAM(pb + 1);
        if (IN(pb + 2)) {
            PH_TID();
            for (int rep2_ = 0; rep2_ <= (int)((REPEAT_MASK >> 17) & 1u); ++rep2_, (rep2_ <= (int)((REPEAT_MASK >> 17) & 1u) ? xcd_barrier(bar) : (void)0)) {
            unsigned* qh0 = ctl + CW_QUEUE + 64 * l + 16 * rep2_;
#define QUEUE_LOOP(qi_, count_, body_) for (;;) { if (tid == 0) LC[4] = __hip_atomic_fetch_add(qh + (qi_), 1u, __ATOMIC_RELAXED, __HIP_MEMORY_SCOPE_AGENT); \
                __syncthreads(); const int it = (int)LC[4]; __syncthreads(); if (it >= (count_)) break; { SUB_TID(); body_; } __syncthreads(); }
            if (EN(6)) REP(6) { unsigned* qh = qh0 + 32 * rep_; QUEUE_LOOP(0, Q_RET, ret_chain_item(P, l, lds, it, tid2, wave2, lane2)) }
            if (EN(7)) REP(7) { unsigned* qh = qh0 + 32 * rep_; QUEUE_LOOP(1, Q_GDN, gdn_chain_item(P, l, lds, it, tid2, wave2, lane2)) }
            if (EN(8)) REP(8) { unsigned* qh = qh0 + 32 * rep_; QUEUE_LOOP(2, Q_LRU, lru_chain_item(P, l, lds, it, tid2, wave2, lane2)) }
            if (EN(9)) REP(9) { unsigned* qh = qh0 + 32 * rep_; QUEUE_LOOP(3, Q_MLA, mla_attn_item(P, lds, it, tid2, wave2, lane2)) }
#undef QUEUE_LOOP
            }
        }
        SEAM(pb + 2);
        if (IN(pb + 3) && EN(10)) REP(10) { PH_TID();
            pg8::Gemm g{yb, wl(P, l, W_OUT), T_TOK, DM, DM}; pg8::StaticOrder S; S.init(T_TOK, DM, G, blockIdx.x);
            pg8::EpiResid E{xb, part, rep_ ? 0.f : 1.f}; pg8::gemm_phase(lds, g, S, E, tid);
        }
        SEAM(pb + 3);
        if (IN(pb + 4) && EN(11)) REP(11) { PH_TID();
            pg8::Gemm g{xb, wl(P, l, W_Q), T_TOK, DM, DM}; pg8::StaticOrder S; S.init(T_TOK, DM, G, blockIdx.x);
            pg8::EpiScaleBf16<0> E{zb, DM, part}; pg8::gemm_phase(lds, g, S, E, tid);
        }
        SEAM(pb + 4);
        if (IN(pb + 5) && EN(12)) REP(12) { PH_TID();
_Pragma("unroll 1")
            for (int it = blockIdx.x; it < 512; it += G) { SUB_TID(); xa_item(P, l, lds, it, tid2, wave2, lane2); __syncthreads(); } }
        SEAM(pb + 5);
        if (IN(pb + 6) && EN(13)) REP(13) { PH_TID();
            pg8::Gemm g{oxb, wl(P, l, W_O), T_TOK, DM, DM}; pg8::StaticOrder S; S.init(T_TOK, DM, G, blockIdx.x);
            pg8::EpiResid E{xb, part, rep_ ? 0.f : 1.f}; pg8::gemm_phase(lds, g, S, E, tid);
        }
        SEAM(pb + 6);
        if (IN(pb + 7) && EN(14)) REP(14) { PH_TID();
            pg8::Gemm g{xb, wl(P, l, W_1), T_TOK, DFF, DM}; pg8::StaticOrder S; S.init(T_TOK, DFF, G, blockIdx.x);
            pg8::EpiScaleBf16<1> E{zb, DFF, part}; pg8::gemm_phase(lds, g, S, E, tid);
        }
        SEAM(pb + 7);
        if (IN(pb + 8) && EN(15)) REP(15) { PH_TID();
            pg8::Gemm g{zb, wl(P, l, W_2), T_TOK, DM, DFF}; pg8::StaticOrder S; S.init(T_TOK, DM, G, blockIdx.x);
            pg8::EpiResid E{xb, part, rep_ ? 0.f : 1.f}; pg8::gemm_phase(lds, g, S, E, tid);
        }
        SEAM(pb + 8);
    }
    if (IN(20) && EN(16)) { PH_TID(); final_norm_phase(P, tid); }
#undef IN
#undef SEAM
}

extern "C" void kernel_launch(void* const* d_in, const int* in_sizes, int n_in, void* d_out, int out_size, void* d_ws, size_t ws_size, hipStream_t stream) {
    static int grid = 0;
    if (grid == 0) {
        if (n_in != 31 || out_size != T_TOK * DM || ws_size < WS_END) { fprintf(stderr, "kernel_launch: unexpected shapes (n_in %d out %d ws %zu, need %zu)\n", n_in, out_size, ws_size, (size_t)WS_END); grid = -1; return; }
        if (hipFuncSetAttribute((const void*)hymba_fwd, hipFuncAttributeMaxDynamicSharedMemorySize, LDS_BYTES) != hipSuccess) { fprintf(stderr, "kernel_launch: hipFuncSetAttribute failed\n"); grid = -1; return; }
        int dev = 0, cus = 0, per_cu = 0;
        (void)hipGetDevice(&dev); (void)hipDeviceGetAttribute(&cus, hipDeviceAttributeMultiprocessorCount, dev);
        (void)hipOccupancyMaxActiveBlocksPerMultiprocessor(&per_cu, (const void*)hymba_fwd, 512, LDS_BYTES);
        (void)hipGetLastError();
        if (cus != 256 || per_cu < 1) fprintf(stderr, "kernel_launch: note: cus %d per_cu %d\n", cus, per_cu);
        grid = 256;
    }
    if (grid < 0) return;
    (void)hipMemsetAsync((char*)d_ws + WS_CTL, 0, CTL_BYTES, stream);
    Params p{};
    p.x = (const float*)d_in[0]; p.mem = (const float*)d_in[1]; p.pos = (const int*)d_in[2];
    p.norm_mix = (const float*)d_in[3]; p.w_in = (const float*)d_in[4]; p.ret_gn = (const float*)d_in[5];
    p.lru_conv_w = (const float*)d_in[6]; p.lru_conv_b = (const float*)d_in[7]; p.lru_wa = (const float*)d_in[8]; p.lru_ba = (const float*)d_in[9];
    p.lru_wx = (const float*)d_in[10]; p.lru_bx = (const float*)d_in[11]; p.lru_lambda = (const float*)d_in[12];
    p.mla_q_norm = (const float*)d_in[13]; p.mla_w_uq = (const float*)d_in[14]; p.mla_kv_norm = (const float*)d_in[15]; p.mla_w_ukv = (const float*)d_in[16];
    p.gdn_conv_w = (const float*)d_in[17]; p.gdn_a_log = (const float*)d_in[18]; p.gdn_dt_bias = (const float*)d_in[19]; p.gdn_norm = (const float*)d_in[20];
    p.w_out = (const float*)d_in[21]; p.norm_xattn = (const float*)d_in[22]; p.norm_mem = (const float*)d_in[23];
    p.xa_wq = (const float*)d_in[24]; p.xa_wkv = (const float*)d_in[25]; p.xa_wo = (const float*)d_in[26];
    p.norm_mlp = (const float*)d_in[27]; p.mlp_w1 = (const float*)d_in[28]; p.mlp_w2 = (const float*)d_in[29]; p.final_norm = (const float*)d_in[30];
    p.out = (float*)d_out; p.ws = (unsigned char*)d_ws;
#if N_LAUNCHES == 1
    p.ph_lo = 0; p.ph_hi = N_PHASES;
    void* args[] = {&p};
    hipError_t e = hipLaunchCooperativeKernel((const void*)hymba_fwd, dim3(grid), dim3(512), args, LDS_BYTES, stream);
    if (e != hipSuccess) fprintf(stderr, "kernel_launch: cooperative launch failed: %s\n", hipGetErrorString(e));
#else
    for (int ph = 0; ph < N_PHASES; ++ph) { p.ph_lo = ph; p.ph_hi = ph + 1; hipLaunchKernelGGL(hymba_fwd, dim3(grid), dim3(512), LDS_BYTES, stream, p); }
#endif
}
```

```cpp
#include <hip/hip_runtime.h>
#include <cstdio>
#include <cstdint>

#ifndef N_LAUNCHES
#define N_LAUNCHES 1
#endif

#define LAS __attribute__((address_space(3)))
typedef unsigned short bf16_t;
typedef short bf16x8 __attribute__((ext_vector_type(8)));
typedef float f32x4 __attribute__((ext_vector_type(4)));
typedef float f32x2 __attribute__((ext_vector_type(2)));
typedef unsigned u32x4 __attribute__((ext_vector_type(4)));
typedef unsigned u32x2 __attribute__((ext_vector_type(2)));

constexpr int T_TOK = 32768, DM = 1024, SEQ = 2048, NBATCH = 16, NCHUNK = 32, ZP = 3072, DFF = 4096, NMEM = 256;
constexpr int Z_RQ = 0, Z_RK = 256, Z_RV = 512, Z_RG = 768, Z_LX = 1024, Z_LG = 1280, Z_CQ = 1536, Z_CKV = 1728, Z_KR = 1856,
              Z_GQKV = 1888, Z_GG = 2656, Z_GB = 2912, Z_GA = 2916, IN_COLS = 2920;
constexpr float EPS = 1e-6f;
constexpr float LOG2E = 1.4426950408889634f;

constexpr size_t MiB = 1024 * 1024;
constexpr size_t WS_CTL = 0;
constexpr size_t CTL_BYTES = 65536;
constexpr size_t WS_PART = WS_CTL + CTL_BYTES;
constexpr size_t WS_LRUS = WS_PART + (size_t)T_TOK * 16 * 4;
constexpr size_t WS_GL = WS_LRUS + (size_t)2 * 16 * 32 * 256 * 4;
constexpr size_t WS_W = WS_GL + 65536;
constexpr size_t W_IN = 0, W_OUT = W_IN + (size_t)ZP * DM, W_Q = W_OUT + (size_t)DM * DM, W_KV = W_Q + (size_t)DM * DM, W_O = W_KV + (size_t)2 * DM * DM,
                 W_1 = W_O + (size_t)DM * DM, W_2 = W_1 + (size_t)DFF * DM, W_UQ = W_2 + (size_t)DFF * DM, W_UKV = W_UQ + 384 * 192, W_A = W_UKV + 512 * 128,
                 W_X = W_A + 4 * 64 * 64, W_LAYER = W_X + 4 * 64 * 64;
constexpr size_t WS_XB = WS_W + 2 * W_LAYER * 2;
constexpr size_t XB_BYTES = (size_t)T_TOK * DM * 2;
constexpr size_t MLA_Q_OFF = 0, MLA_K_OFF = (size_t)T_TOK * 4 * 96 * 2, MLA_VT_OFF = 2 * MLA_K_OFF;
constexpr size_t WS_KVM = WS_XB + XB_BYTES;
constexpr size_t KVM_LAYER = (size_t)2 * 4096 * 1024 * 2;
constexpr size_t WS_R = WS_KVM + 2 * KVM_LAYER;
constexpr size_t R_Y = (size_t)T_TOK * ZP * 2;
constexpr size_t R_OX = (size_t)T_TOK * DM * 2;
constexpr size_t WS_GDN = WS_R + 256 * MiB;
constexpr size_t WS_END = WS_GDN + 80 * MiB;
static_assert(WS_END <= 512 * MiB, "workspace map exceeds 512 MiB");
static_assert(WS_XB % 256 == 0 && WS_R % 256 == 0 && WS_GDN % 256 == 0 && WS_W % 256 == 0, "alignment");
constexpr int CW_BAR = 0;
constexpr int CW_QUEUE = 4096;

constexpr int LDS_BYTES = 160 * 1024;
constexpr int LDS_CTL = LDS_BYTES - 256;

typedef __bf16 bf16x2_t __attribute__((ext_vector_type(2)));
__device__ __forceinline__ unsigned pk2(float lo, float hi) { f32x2 t = {lo, hi}; bf16x2_t v = __builtin_convertvector(t, bf16x2_t); return __builtin_bit_cast(unsigned, v); }
__device__ __forceinline__ float bflo(unsigned w) { return __uint_as_float(w << 16); }
__device__ __forceinline__ float bfhi(unsigned w) { return __uint_as_float(w & 0xffff0000u); }
__device__ __forceinline__ float bf2f(bf16_t v) { return __uint_as_float((unsigned)v << 16); }
__device__ __forceinline__ bf16_t f2bf(float f) { return (bf16_t)(pk2(f, 0.f) & 0xffffu); }
__device__ __forceinline__ f32x4 mfma16(bf16x8 a, bf16x8 b, f32x4 c) { return __builtin_amdgcn_mfma_f32_16x16x32_bf16(a, b, c, 0, 0, 0); }
__device__ __forceinline__ float fexp2_(float x) { return __builtin_amdgcn_exp2f(x); }
__device__ __forceinline__ float fexp_(float x) { return __builtin_amdgcn_exp2f(x * LOG2E); }
__device__ __forceinline__ float frcp_(float x) { return __builtin_amdgcn_rcpf(x); }
__device__ __forceinline__ float frsq_(float x) { return __builtin_amdgcn_rsqf(x); }
__device__ __forceinline__ float fsqrt_(float x) { return __builtin_amdgcn_sqrtf(x); }
__device__ __forceinline__ float sigmoidf_(float x) { return frcp_(1.0f + fexp_(-x)); }
__device__ __forceinline__ float siluf_(float x) { return x * frcp_(1.0f + fexp_(-x)); }
__device__ __forceinline__ float softplusf_(float x) { return x > 20.f ? x : log1pf(__expf(x)); }
__device__ __forceinline__ float geluf_(float x) { const float u = 1.5957691216057308f * (x + 0.044715f * x * x * x); return x * frcp_(1.0f + fexp_(-u)); }
__device__ __forceinline__ float dpp_xor1(float x) { return __builtin_bit_cast(float, __builtin_amdgcn_update_dpp(0, __builtin_bit_cast(int, x), 0xB1, 0xF, 0xF, true)); }
__device__ __forceinline__ float dpp_xor2(float x) { return __builtin_bit_cast(float, __builtin_amdgcn_update_dpp(0, __builtin_bit_cast(int, x), 0x4E, 0xF, 0xF, true)); }
__device__ __forceinline__ float dpp_hmir(float x) { return __builtin_bit_cast(float, __builtin_amdgcn_update_dpp(0, __builtin_bit_cast(int, x), 0x141, 0xF, 0xF, true)); }
__device__ __forceinline__ float dpp_mir(float x) { return __builtin_bit_cast(float, __builtin_amdgcn_update_dpp(0, __builtin_bit_cast(int, x), 0x140, 0xF, 0xF, true)); }
__device__ __forceinline__ float sum4_(float x) { x += dpp_xor1(x); x += dpp_xor2(x); return x; }
__device__ __forceinline__ float sum8_(float x) { x = sum4_(x); x += dpp_hmir(x); return x; }
__device__ __forceinline__ float sum16_(float x) { x = sum8_(x); x += dpp_mir(x); return x; }
typedef unsigned u2v_ __attribute__((ext_vector_type(2)));
__device__ __forceinline__ float xrow_sum_(float x) { unsigned a = __builtin_bit_cast(unsigned, x), b = a; asm volatile("" : "+v"(b));
    auto r = __builtin_amdgcn_permlane16_swap(a, b, false, false);
    x = __builtin_bit_cast(float, (unsigned)r[0]) + __builtin_bit_cast(float, (unsigned)r[1]); a = __builtin_bit_cast(unsigned, x); b = a; asm volatile("" : "+v"(b));
    auto r2 = __builtin_amdgcn_permlane32_swap(a, b, false, false);
    return __builtin_bit_cast(float, (unsigned)r2[0]) + __builtin_bit_cast(float, (unsigned)r2[1]); }
__device__ __forceinline__ float xrow_max_(float x) { unsigned a = __builtin_bit_cast(unsigned, x), b = a; asm volatile("" : "+v"(b));
    auto r = __builtin_amdgcn_permlane16_swap(a, b, false, false);
    x = fmaxf(__builtin_bit_cast(float, (unsigned)r[0]), __builtin_bit_cast(float, (unsigned)r[1])); a = __builtin_bit_cast(unsigned, x); b = a; asm volatile("" : "+v"(b));
    auto r2 = __builtin_amdgcn_permlane32_swap(a, b, false, false);
    return fmaxf(__builtin_bit_cast(float, (unsigned)r2[0]), __builtin_bit_cast(float, (unsigned)r2[1])); }
__device__ __forceinline__ float wave_sum(float v) {
    return xrow_sum_(sum16_(v));
}
__device__ __forceinline__ void sincos_rev(float ang, float& s, float& c) {
    float rev = ang * 0.15915494309189535f; rev = rev - floorf(rev);
    s = __builtin_amdgcn_sinf(rev); c = __builtin_amdgcn_cosf(rev);
}
__device__ __forceinline__ bf16x8 mk8(u32x2 lo, u32x2 hi) { u32x4 t; t.x = lo.x; t.y = lo.y; t.z = hi.x; t.w = hi.y; return __builtin_bit_cast(bf16x8, t); }
__device__ __forceinline__ bf16x8 pack8(f32x4 a, f32x4 b) { u32x4 t; t.x = pk2(a.x, a.y); t.y = pk2(a.z, a.w); t.z = pk2(b.x, b.y); t.w = pk2(b.z, b.w); return __builtin_bit_cast(bf16x8, t); }

#define XB_TMO      128
#define XB_XCNT(j)  (256  + 64 * (j))
#define XB_XSUB(j)  (1280 + 64 * (j))
#define XB_XGEN(j)  (2304 + 64 * (j))
#define XB_TOP      3328
#define XB_TOPGEN   3392
#define XCD_BAR_WORDS 3456
#define XB_SPIN_CAP (1u << 22)
__device__ __forceinline__ unsigned xb_ld(unsigned* p)              { return __hip_atomic_load(p, __ATOMIC_RELAXED, __HIP_MEMORY_SCOPE_AGENT); }
__device__ __forceinline__ unsigned xb_add(unsigned* p, unsigned v) { return __hip_atomic_fetch_add(p, v, __ATOMIC_RELAXED, __HIP_MEMORY_SCOPE_AGENT); }
__device__ __forceinline__ unsigned xb_xcc_id() { return (unsigned)__builtin_amdgcn_s_getreg((3 << 11) | 20) & 0xFu; }
#define XB_SPIN(cond, bar) do { unsigned _sp = 0; while (cond) { __builtin_amdgcn_s_sleep(1); \
    if ((++_sp & 255u) == 0u) { if (xb_ld(&(bar)[XB_TMO])) break; if (_sp > XB_SPIN_CAP) { atomicAdd(&(bar)[XB_TMO], 1u); break; } } } } while (0)
struct XcdBarrier { unsigned* bar; unsigned x; volatile LAS unsigned* st; };
__device__ __forceinline__ XcdBarrier xcd_barrier_post(unsigned* bar, volatile LAS unsigned* st) {
    XcdBarrier b; b.bar = bar; b.x = xb_xcc_id(); b.st = st;
    if (threadIdx.x == 0) (void)xb_add(&bar[XB_XCNT(b.x)], 1u);
    return b;
}
__device__ __forceinline__ void xcd_barrier_complete(unsigned* bar, unsigned x, unsigned& nloc, unsigned& nx) {
    const unsigned G = gridDim.x * gridDim.y * gridDim.z;
    unsigned sum, cnt, mine, sp = 0u;
    for (;;) {
        sum = 0u; cnt = 0u; mine = 0u;
#pragma unroll
        for (unsigned j = 0; j < 16; ++j) { const unsigned c = xb_ld(&bar[XB_XCNT(j)]); sum += c; cnt += (c > 0u) ? 1u : 0u; mine = (j == x) ? c : mine; }
        if (sum == G) break;
        __builtin_amdgcn_s_sleep(1);
        if ((++sp & 255u) == 0u) { if (xb_ld(&bar[XB_TMO])) break; if (sp > XB_SPIN_CAP) { atomicAdd(&bar[XB_TMO], 1u); break; } }
    }
    nloc = mine > 0u ? mine : 1u; nx = cnt > 0u ? cnt : 1u;
}
__device__ __forceinline__ void xcd_barrier(const XcdBarrier& b) {
    asm volatile("s_waitcnt vmcnt(0)" ::: "memory");
    __syncthreads();
    if (threadIdx.x == 0) {
        unsigned* bar = b.bar;
        __builtin_amdgcn_s_waitcnt(0);
        unsigned nloc = b.st[0], nx = b.st[1];
        if (nloc == 0u) { xcd_barrier_complete(bar, b.x, nloc, nx); b.st[0] = nloc; b.st[1] = nx; }
        const unsigned old = xb_add(&bar[XB_XSUB(b.x)], 1u);
        const unsigned gen = old / nloc;
        if (old + 1u == (gen + 1u) * nloc) {
            __builtin_amdgcn_fence(__ATOMIC_RELEASE, "agent");
            asm volatile("s_waitcnt vmcnt(0)" ::: "memory");
            const unsigned og = xb_add(&bar[XB_TOP], 1u);
            const unsigned tg = og / nx;
            if (og + 1u == (tg + 1u) * nx) xb_add(&bar[XB_TOPGEN], 1u);
            else XB_SPIN(xb_ld(&bar[XB_TOPGEN]) == tg, bar);
            __builtin_amdgcn_fence(__ATOMIC_ACQUIRE, "agent");
            xb_add(&bar[XB_XGEN(b.x)], 1u);
            asm volatile("s_waitcnt vmcnt(0)" ::: "memory");
        } else {
            XB_SPIN(xb_ld(&bar[XB_XGEN(b.x)]) == gen, bar);
            __builtin_amdgcn_fence(__ATOMIC_ACQUIRE, "agent");
            asm volatile("s_waitcnt vmcnt(0)" ::: "memory");
        }
    }
    __syncthreads();
}

namespace pg8 {
constexpr int BM = 256, BK = 64, HALF = 128, HTB = HALF * BK * 2, STAGE_BYTES = 8 * HTB, NXCD = 8, WGM = 8;
__host__ __device__ __forceinline__ int lds_byte(int r, int c) { const int st = (r >> 4) * 2 + (c >> 5), rr = r & 15, cc = c & 31, ob = rr * 64 + cc * 2; return st * 1024 + (ob ^ (((ob >> 9) & 1) << 5)); }
__host__ __device__ __forceinline__ void stage_rc(int b, int& R, int& C) { const int st = b / 1024, sb = b % 1024, swz = sb ^ (((sb >> 9) & 1) << 5); R = (st >> 1) * 16 + swz / 64; C = (st & 1) * 32 + (swz % 64) / 2; }
__host__ __device__ __forceinline__ int perm32(int rho) { const int n = rho >> 4, i = rho & 15; return 8 * (i >> 2) + 4 * n + (i & 3); }
struct Unit { int pm, pn; };
struct Gemm { const bf16_t* A; const bf16_t* Bt; int M, N, K; };
struct StaticOrder {
    int nM, nN, nwg, G, c;
    __host__ __device__ void init(int M, int N, int G_, int c_) { nM = M / BM; nN = N / BM; nwg = nM * nN; G = G_; c = c_; }
    __host__ __device__ bool next(int i, Unit& u) const {
        const long L = (long)i * G + c; if (L >= nwg) return false;
        int wgid = (int)L; { const int q = nwg / NXCD, r = nwg % NXCD, xcd = wgid % NXCD, off = wgid / NXCD; wgid = (xcd < r ? xcd * (q + 1) : r * (q + 1) + (xcd - r) * q) + off; }
        const int nig = WGM * nN, gid = wgid / nig, fm = gid * WGM, gsz = (nM - fm) < WGM ? (nM - fm) : WGM;
        u.pm = fm + ((wgid % nig) % gsz); u.pn = (wgid % nig) / gsz; return true;
    }
    __device__ __forceinline__ void a_ready(const Unit&) const {}
    __device__ __forceinline__ void done(const Unit&) const {}
};

template <int ACT> struct EpiScaleBf16 {
    static constexpr bool PERM = true;
    bf16_t* O; int ldc; const float* part;
    __device__ __forceinline__ void operator()(const f32x4 (&acc)[2][2][4][2], const Unit& u, int wr, int wc, int fr, int fq) const {
        const int row0 = u.pm * BM + wr * 64 + fr, col0 = u.pn * BM + wc * 32 + 8 * fq;
#pragma unroll
        for (int ai = 0; ai < 2; ++ai)
#pragma unroll
            for (int m = 0; m < 4; ++m) {
                const int row = row0 + ai * HALF + m * 16;
                float sc = 1.0f;
                if (part) { const f32x4 a = *((const f32x4*)(part + (size_t)row * 16) + fq);
                    float s = (a.x + a.y) + (a.z + a.w); s = xrow_sum_(s);
                    sc = frsq_(s * (1.0f / 1024.0f) + EPS); }
                bf16_t* rowp = O + (size_t)row * ldc + col0;
#pragma unroll
                for (int bj = 0; bj < 2; ++bj) { f32x4 v0 = acc[ai][bj][m][0] * sc, v1 = acc[ai][bj][m][1] * sc;
                    if (ACT == 1) {
#pragma unroll
                        for (int j = 0; j < 4; ++j) { const float a0 = fmaxf(v0[j], 0.f), a1 = fmaxf(v1[j], 0.f); v0[j] = a0 * a0; v1[j] = a1 * a1; } }
                    u32x4 w; w.x = pk2(v0[0], v0[1]); w.y = pk2(v0[2], v0[3]); w.z = pk2(v1[0], v1[1]); w.w = pk2(v1[2], v1[3]);
                    *(u32x4*)(rowp + bj * HALF) = w; }
            }
    }
};
struct EpiResid {
    static constexpr bool PERM = false;
    bf16_t* XB; float* part; float alpha;
    __device__ __forceinline__ void operator()(const f32x4 (&acc)[2][2][4][2], const Unit& u, int wr, int wc, int fr, int fq) const {
        const int row0 = u.pm * BM + wr * 64 + fr, col0 = u.pn * BM + wc * 32 + 4 * fq;
#pragma unroll
        for (int ai = 0; ai < 2; ++ai)
#pragma unroll
            for (int m = 0; m < 4; ++m) {
                const int row = row0 + ai * HALF + m * 16;
                bf16_t* bp = XB + (size_t)row * DM + col0;
                float ss = 0.f;
#pragma unroll
                for (int bj = 0; bj < 2; ++bj)
#pragma unroll
                    for (int n = 0; n < 2; ++n) { const u32x2 xw = *(const u32x2*)(bp + bj * HALF + n * 16);
                        const f32x4 v = (f32x4){bflo(xw.x), bfhi(xw.x), bflo(xw.y), bfhi(xw.y)} + acc[ai][bj][m][n] * alpha;
                        ss += (v.x * v.x + v.y * v.y) + (v.z * v.z + v.w * v.w);
                        u32x2 w; w.x = pk2(v.x, v.y); w.y = pk2(v.z, v.w); *(u32x2*)(bp + bj * HALF + n * 16) = w; }
                ss = xrow_sum_(ss);
                if (fq == 0) part[(size_t)row * 16 + u.pn * 4 + wc] = ss;
            }
    }
};

template <class Epi, class Sched>
__device__ __forceinline__ void gemm_phase(LAS unsigned char* lds, const Gemm g, const Sched& S, const Epi& E, const int tid) {
    const int wid = __builtin_amdgcn_readfirstlane(tid >> 6), lane = tid & 63, wr = wid >> 2, wc = wid & 3, fr = lane & 15, fq = lane >> 4;
    const int K = g.K, nt = K / BK;
    unsigned voffA[2], voffB[2];
#pragma unroll
    for (int i = 0; i < 2; ++i) { int R, C; stage_rc(tid * 16 + i * 8192, R, C); const int Rb = Epi::PERM ? ((R & ~31) + perm32(R & 31)) : R;
        voffA[i] = (unsigned)(R * K + C) * 2u; voffB[i] = (unsigned)(Rb * K + C) * 2u; }
    const size_t kstep = (size_t)(BK * 2);
    const size_t hstep = (size_t)HALF * K * 2;
    const size_t tstep = 2 * hstep;
    const unsigned ldsw = (unsigned)wid * 1024u;
    const int aoff = lds_byte(wr * 64 + fr, fq * 8), boff = lds_byte(wc * 32 + fr, fq * 8);
#define PG8_SA(b, h) (((b) * 2 + (h)) * HTB)
#define PG8_SB(b, h) ((4 + (b) * 2 + (h)) * HTB)
#define PG8_STAGE(bufoff, gbase, voff) do { _Pragma("unroll") for (int _i = 0; _i < 2; ++_i) \
        __builtin_amdgcn_global_load_lds((const unsigned*)((const char*)(gbase) + (voff)[_i]), (LAS unsigned*)(lds + (bufoff) + ldsw + _i * 8192), 16, 0, 0); } while (0)
#define PG8_LDA(dst, b, h) do { _Pragma("unroll") for (int m = 0; m < 4; ++m) _Pragma("unroll") for (int k = 0; k < 2; ++k) dst[m][k] = *(const LAS bf16x8*)(lds + PG8_SA(b, h) + aoff + m * 2048 + k * 1024); } while (0)
#define PG8_LDB(dst, b, h) do { _Pragma("unroll") for (int n = 0; n < 2; ++n) _Pragma("unroll") for (int k = 0; k < 2; ++k) dst[n][k] = *(const LAS bf16x8*)(lds + PG8_SB(b, h) + boff + n * 2048 + k * 1024); } while (0)
#define PG8_MMA(ai, bj, At, Bt) do { __builtin_amdgcn_s_setprio(1); _Pragma("unroll") for (int m = 0; m < 4; ++m) _Pragma("unroll") for (int n = 0; n < 2; ++n) _Pragma("unroll") for (int k = 0; k < 2; ++k) \
        acc[ai][bj][m][n] = __builtin_amdgcn_mfma_f32_16x16x32_bf16(Bt[n][k], At[m][k], acc[ai][bj][m][n], 0, 0, 0); __builtin_amdgcn_s_setprio(0); } while (0)
#define PG8_WAIT_V(n) asm volatile("s_waitcnt vmcnt(" #n ")" ::: "memory")
#define PG8_WAIT_L(n) asm volatile("s_waitcnt lgkmcnt(" #n ")" ::: "memory")
#define PG8_BAR __builtin_amdgcn_s_barrier()
#define PG8_SCHED __builtin_amdgcn_sched_barrier(0)
    Unit cur, nxt; int ui = 0;
    if (!S.next(0, cur)) return;
    f32x4 acc[2][2][4][2];
#pragma unroll
    for (int a = 0; a < 2; ++a)
#pragma unroll
        for (int b = 0; b < 2; ++b)
#pragma unroll
            for (int m = 0; m < 4; ++m)
#pragma unroll
                for (int n = 0; n < 2; ++n) acc[a][b][m][n] = (f32x4){0.f, 0.f, 0.f, 0.f};
    bf16x8 At[4][2], B0[2][2], B1[2][2];
    const char* cA = (const char*)g.A + (size_t)cur.pm * tstep; const char* cB = (const char*)g.Bt + (size_t)cur.pn * tstep;
    S.a_ready(cur);
    PG8_STAGE(PG8_SB(0, 0), cB, voffB); PG8_STAGE(PG8_SA(0, 0), cA, voffA); PG8_STAGE(PG8_SB(0, 1), cB + hstep, voffB); PG8_STAGE(PG8_SA(0, 1), cA + hstep, voffA);
    if (wr == 1) PG8_BAR;
    PG8_WAIT_V(4); PG8_BAR;
    PG8_STAGE(PG8_SB(1, 0), cB + kstep, voffB); PG8_STAGE(PG8_SA(1, 0), cA + kstep, voffA); PG8_STAGE(PG8_SB(1, 1), cB + hstep + kstep, voffB);
    PG8_WAIT_V(6); PG8_BAR;
    for (;;) {
        const bool has_next = S.next(ui + 1, nxt);
        const char* nA = has_next ? (const char*)g.A + (size_t)nxt.pm * tstep : cA; const char* nB = has_next ? (const char*)g.Bt + (size_t)nxt.pn * tstep : cB;
        for (int t = 0; t < nt; t += 2) {
            const bool last = (t == nt - 2);
            const char* a1 = cA + (size_t)(t + 1) * kstep;
            const char* a2 = last ? nA : cA + (size_t)(t + 2) * kstep; const char* b2 = last ? nB : cB + (size_t)(t + 2) * kstep;
            const char* a3 = a2 + kstep; const char* b3 = b2 + kstep;
            if (last && has_next) S.a_ready(nxt);
            PG8_LDB(B0, 0, 0); PG8_SCHED; PG8_LDA(At, 0, 0); PG8_STAGE(PG8_SA(1, 1), a1 + hstep, voffA);
            PG8_WAIT_L(8); PG8_BAR; PG8_WAIT_L(0); PG8_MMA(0, 0, At, B0); PG8_BAR; PG8_SCHED;
            PG8_LDB(B1, 0, 1); PG8_STAGE(PG8_SB(0, 0), b2, voffB);
            PG8_BAR; PG8_WAIT_L(0); PG8_MMA(0, 1, At, B1); PG8_BAR;
            PG8_LDA(At, 0, 1); PG8_STAGE(PG8_SA(0, 0), a2, voffA);
            PG8_BAR; PG8_WAIT_L(0); PG8_MMA(1, 0, At, B0); PG8_BAR; PG8_SCHED;
            PG8_STAGE(PG8_SB(0, 1), b2 + hstep, voffB);
            PG8_WAIT_V(6); PG8_BAR; PG8_MMA(1, 1, At, B1); PG8_BAR;
            PG8_LDB(B0, 1, 0); PG8_SCHED; PG8_LDA(At, 1, 0); PG8_STAGE(PG8_SA(0, 1), a2 + hstep, voffA);
            PG8_WAIT_L(8); PG8_BAR; PG8_WAIT_L(0); PG8_MMA(0, 0, At, B0); PG8_BAR; PG8_SCHED;
            PG8_LDB(B1, 1, 1); PG8_STAGE(PG8_SB(1, 0), b3, voffB);
            PG8_BAR; PG8_WAIT_L(0); PG8_MMA(0, 1, At, B1); PG8_BAR;
            PG8_LDA(At, 1, 1); PG8_STAGE(PG8_SA(1, 0), a3, voffA);
            PG8_BAR; PG8_WAIT_L(0); PG8_MMA(1, 0, At, B0); PG8_BAR; PG8_SCHED;
            PG8_STAGE(PG8_SB(1, 1), b3 + hstep, voffB);
            PG8_WAIT_V(6); PG8_BAR; PG8_MMA(1, 1, At, B1); PG8_BAR;
        }
        E(acc, cur, wr, wc, fr, fq); S.done(cur);
        if (!has_next) break;
#pragma unroll
        for (int a = 0; a < 2; ++a)
#pragma unroll
            for (int b = 0; b < 2; ++b)
#pragma unroll
                for (int m = 0; m < 4; ++m)
#pragma unroll
                    for (int n = 0; n < 2; ++n) acc[a][b][m][n] = (f32x4){0.f, 0.f, 0.f, 0.f};
        cur = nxt; cA = nA; cB = nB; ++ui;
    }
    PG8_WAIT_V(0);
    if (wr == 0) PG8_BAR;
    PG8_BAR;
#undef PG8_SA
#undef PG8_SB
#undef PG8_STAGE
#undef PG8_LDA
#undef PG8_LDB
#undef PG8_MMA
#undef PG8_WAIT_V
#undef PG8_WAIT_L
#undef PG8_BAR
#undef PG8_SCHED
}
}

struct Params {
    const float* x; const float* mem; const int* pos;
    const float* norm_mix; const float* w_in; const float* ret_gn;
    const float* lru_conv_w; const float* lru_conv_b; const float* lru_wa; const float* lru_ba; const float* lru_wx; const float* lru_bx; const float* lru_lambda;
    const float* mla_q_norm; const float* mla_w_uq; const float* mla_kv_norm; const float* mla_w_ukv;
    const float* gdn_conv_w; const float* gdn_a_log; const float* gdn_dt_bias; const float* gdn_norm;
    const float* w_out; const float* norm_xattn; const float* norm_mem; const float* xa_wq; const float* xa_wkv; const float* xa_wo;
    const float* norm_mlp; const float* mlp_w1; const float* mlp_w2; const float* final_norm;
    float* out; unsigned char* ws;
    int ph_lo, ph_hi;
};

__device__ __forceinline__ bf16_t* wl(const Params& P, int l, size_t off) { return (bf16_t*)(P.ws + WS_W) + (size_t)l * W_LAYER + off; }

struct WTile { const float* src; const float* gain; bf16_t* dst; int K, N, kb, nb; float scale; };
__device__ __forceinline__ WTile p0_decode(const Params& P, int it) {
    constexpr int T_IN = 16 * 48, T_SQ = 256, T_KV = 512, T_W1 = 1024, T_W2 = 1024, T_UQ = 18, T_UKV = 16, T_LRU = 8;
    constexpr int T_LAYER = T_IN + 3 * T_SQ + T_KV + T_W1 + T_W2 + T_UQ + T_UKV + T_LRU;
    const int l = it / T_LAYER; int r = it % T_LAYER; int nnb; WTile t; t.gain = nullptr; t.scale = 1.f;
    if (r < T_IN) { t.src = P.w_in + (size_t)l * DM * IN_COLS; t.K = DM; t.N = IN_COLS; nnb = 48; t.gain = P.norm_mix + l * DM; t.dst = wl(P, l, W_IN); }
    else if ((r -= T_IN) < T_SQ) { t.src = P.w_out + (size_t)l * DM * DM; t.K = DM; t.N = DM; nnb = 16; t.dst = wl(P, l, W_OUT); }
    else if ((r -= T_SQ) < T_SQ) { t.src = P.xa_wq + (size_t)l * DM * DM; t.K = DM; t.N = DM; nnb = 16; t.gain = P.norm_xattn + l * DM; t.scale = 0.0625f * LOG2E; t.dst = wl(P, l, W_Q); }
    else if ((r -= T_SQ) < T_KV) { t.src = P.xa_wkv + (size_t)l * DM * 2 * DM; t.K = DM; t.N = 2 * DM; nnb = 32; t.gain = P.norm_mem + l * DM; t.dst = wl(P, l, W_KV); }
    else if ((r -= T_KV) < T_SQ) { t.src = P.xa_wo + (size_t)l * DM * DM; t.K = DM; t.N = DM; nnb = 16; t.dst = wl(P, l, W_O); }
    else if ((r -= T_SQ) < T_W1) { t.src = P.mlp_w1 + (size_t)l * DM * DFF; t.K = DM; t.N = DFF; nnb = 64; t.gain = P.norm_mlp + l * DM; t.dst = wl(P, l, W_1); }
    else if ((r -= T_W1) < T_W2) { t.src = P.mlp_w2 + (size_t)l * DFF * DM; t.K = DFF; t.N = DM; nnb = 16; t.dst = wl(P, l, W_2); }
    else if ((r -= T_W2) < T_UQ) { t.src = P.mla_w_uq + (size_t)l * 192 * 384; t.K = 192; t.N = 384; nnb = 6; t.gain = P.mla_q_norm + l * 192; t.dst = wl(P, l, W_UQ); }
    else if ((r -= T_UQ) < T_UKV) { t.src = P.mla_w_ukv + (size_t)l * 128 * 512; t.K = 128; t.N = 512; nnb = 8; t.gain = P.mla_kv_norm + l * 128; t.dst = wl(P, l, W_UKV); }
    else { r -= T_UKV; const int which = r >> 2, nb4 = r & 3; t.src = (which ? P.lru_wx : P.lru_wa) + (size_t)l * 4 * 4096 + nb4 * 4096; t.K = 64; t.N = 64; nnb = 1; t.dst = wl(P, l, which ? W_X : W_A) + nb4 * 4096; r = 0; }
    t.kb = r / nnb; t.nb = r % nnb; return t;
}
__device__ __forceinline__ void p0_fetch(const WTile& t, int tid, f32x4 (&v)[2]) {
#pragma unroll
    for (int i = 0; i < 2; ++i) { const int kk = (tid >> 4) + 32 * i, k = t.kb * 64 + kk, n = t.nb * 64 + (tid & 15) * 4;
        f32x4 x = {0.f, 0.f, 0.f, 0.f}; float g = t.scale;
        if (n < t.N) { x = *(const f32x4*)(t.src + (size_t)k * t.N + n); if (t.gain) g *= t.gain[k]; }
        v[i] = x * g; }
}
__device__ __forceinline__ void p0_prologue(const Params& P, LAS unsigned char* lds, int tid) {
    LAS float* scr = (LAS float*)lds;
    constexpr int NT = 2 * (16 * 48 + 3 * 256 + 512 + 1024 + 1024 + 18 + 16 + 8);
    int it = blockIdx.x;
    if (it < NT) {
        WTile cur = p0_decode(P, it); f32x4 v[2]; p0_fetch(cur, tid, v);
        for (;;) {
#pragma unroll
            for (int i = 0; i < 2; ++i) { LAS float* d = scr + ((tid >> 4) + 32 * i) * 65 + (tid & 15) * 4; d[0] = v[i].x; d[1] = v[i].y; d[2] = v[i].z; d[3] = v[i].w; }
            const int nxt = it + gridDim.x; const bool more = nxt < NT;
            WTile nx = cur; if (more) { nx = p0_decode(P, nxt); p0_fetch(nx, tid, v); }
            __syncthreads();
            { const int nl = tid >> 3, k0 = (tid & 7) * 8; const LAS float* s = scr + k0 * 65 + nl;
              u32x4 o; o.x = pk2(s[0], s[65]); o.y = pk2(s[2 * 65], s[3 * 65]); o.z = pk2(s[4 * 65], s[5 * 65]); o.w = pk2(s[6 * 65], s[7 * 65]);
              *(u32x4*)(cur.dst + (size_t)(cur.nb * 64 + nl) * cur.K + cur.kb * 64 + k0) = o; }
            __syncthreads();
            if (!more) break;
            cur = nx; it = nxt;
        }
    }
    const int wave = tid >> 6, lane = tid & 63;
    const int gw = blockIdx.x * 8 + wave, ngw = gridDim.x * 8;
    bf16_t* xb = (bf16_t*)(P.ws + WS_XB); float* part = (float*)(P.ws + WS_PART); bf16_t* memn = (bf16_t*)(P.ws + WS_GDN);
    constexpr int NR = T_TOK + NBATCH * NMEM;
    for (int row0 = gw; row0 < NR; row0 += 2 * ngw) {
        f32x4 v[2][4]; const int row1 = row0 + ngw; const bool has1 = row1 < NR;
#pragma unroll
        for (int q = 0; q < 2; ++q) { const int row = q ? (has1 ? row1 : row0) : row0; const bool isx = row < T_TOK; const int r2 = isx ? row : row - T_TOK;
            const f32x4* src = (const f32x4*)((isx ? P.x : P.mem) + (size_t)r2 * DM) + lane;
#pragma unroll
            for (int j = 0; j < 4; ++j) v[q][j] = src[64 * j]; }
#pragma unroll
        for (int q = 0; q < 2; ++q) { if (q && !has1) break; const int row = q ? row1 : row0; const bool isx = row < T_TOK; const int r2 = isx ? row : row - T_TOK;
            float s = 0.f;
#pragma unroll
            for (int j = 0; j < 4; ++j) s += (v[q][j].x * v[q][j].x + v[q][j].y * v[q][j].y) + (v[q][j].z * v[q][j].z + v[q][j].w * v[q][j].w);
            s = wave_sum(s);
            if (isx) { u32x2* ob = (u32x2*)(xb + (size_t)row * DM) + lane;
#pragma unroll
                for (int j = 0; j < 4; ++j) { u32x2 w; w.x = pk2(v[q][j].x, v[q][j].y); w.y = pk2(v[q][j].z, v[q][j].w); ob[64 * j] = w; }
                if (lane < 16) part[(size_t)row * 16 + lane] = lane == 0 ? s : 0.f;
            } else { const float rs = frsq_(s * (1.0f / 1024.0f) + EPS); u32x2* ob = (u32x2*)(memn + (size_t)r2 * DM) + lane;
#pragma unroll
                for (int j = 0; j < 4; ++j) { u32x2 w; w.x = pk2(v[q][j].x * rs, v[q][j].y * rs); w.y = pk2(v[q][j].z * rs, v[q][j].w * rs); ob[64 * j] = w; } }
        }
    }
}
__device__ __forceinline__ void final_norm_phase(const Params& P, int tid) {
    const int wave = tid >> 6, lane = tid & 63; const float* part = (const float*)(P.ws + WS_PART); const bf16_t* xb = (const bf16_t*)(P.ws + WS_XB);
    f32x4 g[4];
#pragma unroll
    for (int j = 0; j < 4; ++j) g[j] = ((const f32x4*)P.final_norm)[64 * j + lane];
    for (int row = blockIdx.x * 8 + wave; row < T_TOK; row += gridDim.x * 8) {
        float s = lane < 16 ? part[(size_t)row * 16 + lane] : 0.f; s = wave_sum(s);
        const float rs = frsq_(s * (1.0f / 1024.0f) + EPS);
        f32x4* o = (f32x4*)(P.out + (size_t)row * DM) + lane; const u32x2* xi = (const u32x2*)(xb + (size_t)row * DM) + lane;
#pragma unroll
        for (int j = 0; j < 4; ++j) { const u32x2 w = xi[64 * j]; o[64 * j] = (f32x4){bflo(w.x), bfhi(w.x), bflo(w.y), bfhi(w.y)} * rs * g[j]; }
    }
}
__device__ __forceinline__ void mla_pre_tile(const Params& P, int l, int rt, int lane) {
    const int fr = lane & 15, fq = lane >> 4;
    const bf16_t* z = (const bf16_t*)(P.ws + WS_R);
    bf16_t* Qo = (bf16_t*)((unsigned char*)P.out + MLA_Q_OFF); bf16_t* Ko = (bf16_t*)((unsigned char*)P.out + MLA_K_OFF); bf16_t* Vo = (bf16_t*)((unsigned char*)P.out + MLA_VT_OFF);
    const bf16_t* Wuq = wl(P, l, W_UQ); const bf16_t* Wukv = wl(P, l, W_UKV);
    const int tok0 = rt * 16, b = tok0 >> 11, s0 = tok0 & 2047;
    const bf16_t* zr = z + (size_t)(tok0 + fr) * ZP;
    bf16x8 cq[6], ckv[4]; float sq = 0.f, skv = 0.f;
#pragma unroll
    for (int s = 0; s < 6; ++s) { const u32x4 w = *(const u32x4*)(zr + Z_CQ + 32 * s + 8 * fq); cq[s] = __builtin_bit_cast(bf16x8, w);
        sq += bflo(w.x) * bflo(w.x) + bfhi(w.x) * bfhi(w.x) + bflo(w.y) * bflo(w.y) + bfhi(w.y) * bfhi(w.y) + bflo(w.z) * bflo(w.z) + bfhi(w.z) * bfhi(w.z) + bflo(w.w) * bflo(w.w) + bfhi(w.w) * bfhi(w.w); }
#pragma unroll
    for (int s = 0; s < 4; ++s) { const u32x4 w = *(const u32x4*)(zr + Z_CKV + 32 * s + 8 * fq); ckv[s] = __builtin_bit_cast(bf16x8, w);
        skv += bflo(w.x) * bflo(w.x) + bfhi(w.x) * bfhi(w.x) + bflo(w.y) * bflo(w.y) + bfhi(w.y) * bfhi(w.y) + bflo(w.z) * bflo(w.z) + bfhi(w.z) * bfhi(w.z) + bflo(w.w) * bflo(w.w) + bfhi(w.w) * bfhi(w.w); }
    sq = xrow_sum_(sq); skv = xrow_sum_(skv);
    const float rq = frsq_(sq * (1.0f / 192.0f) + EPS), rkv = frsq_(skv * (1.0f / 128.0f) + EPS);
    const float qsc = rq * 0.10206207261596575f * LOG2E;
    const float pos = (float)P.pos[tok0 + fr];
    float sn[4], cs[4];
#pragma unroll
    for (int r = 0; r < 4; ++r) { const float invf = exp2f(-(float)(4 * fq + r) * (13.287712379549449f / 16.0f)); sincos_rev(pos * invf, sn[r], cs[r]); }
    const size_t tokrow = (size_t)b * 4 * SEQ + (s0 + fr);
#pragma unroll 1
    for (int h = 0; h < 4; ++h) {
        bf16_t* qrow = Qo + (tokrow + (size_t)h * SEQ) * 96;
#pragma unroll 1
        for (int nt = 0; nt < 4; ++nt) { f32x4 a = {0.f, 0.f, 0.f, 0.f};
#pragma unroll
            for (int s = 0; s < 6; ++s) { const bf16x8 wf = *(const bf16x8*)(Wuq + (size_t)(h * 96 + nt * 16 + fr) * 192 + 32 * s + 8 * fq); a = mfma16(wf, cq[s], a); }
            a = a * qsc; u32x2 w; w.x = pk2(a.x, a.y); w.y = pk2(a.z, a.w); *(u32x2*)(qrow + nt * 16 + 4 * fq) = w; }
        f32x4 x1 = {0.f, 0.f, 0.f, 0.f}, x2 = {0.f, 0.f, 0.f, 0.f}, y1, y2;
#pragma unroll
        for (int s = 0; s < 6; ++s) { const bf16x8 wf1 = *(const bf16x8*)(Wuq + (size_t)(h * 96 + 64 + fr) * 192 + 32 * s + 8 * fq), wf2 = *(const bf16x8*)(Wuq + (size_t)(h * 96 + 80 + fr) * 192 + 32 * s + 8 * fq);
            x1 = mfma16(wf1, cq[s], x1); x2 = mfma16(wf2, cq[s], x2); }
        x1 = x1 * qsc; x2 = x2 * qsc;
#pragma unroll
        for (int r = 0; r < 4; ++r) { y1[r] = x1[r] * cs[r] - x2[r] * sn[r]; y2[r] = x1[r] * sn[r] + x2[r] * cs[r]; }
        { u32x2 w; w.x = pk2(y1.x, y1.y); w.y = pk2(y1.z, y1.w); *(u32x2*)(qrow + 64 + 4 * fq) = w; w.x = pk2(y2.x, y2.y); w.y = pk2(y2.z, y2.w); *(u32x2*)(qrow + 80 + 4 * fq) = w; }
    }
    u32x2 kr1, kr2;
    { const u32x2 a = *(const u32x2*)(zr + Z_KR + 4 * fq), c = *(const u32x2*)(zr + Z_KR + 16 + 4 * fq);
      const float x1[4] = {bflo(a.x), bfhi(a.x), bflo(a.y), bfhi(a.y)}, x2[4] = {bflo(c.x), bfhi(c.x), bflo(c.y), bfhi(c.y)}; float y1[4], y2[4];
#pragma unroll
      for (int r = 0; r < 4; ++r) { y1[r] = x1[r] * cs[r] - x2[r] * sn[r]; y2[r] = x1[r] * sn[r] + x2[r] * cs[r]; }
      kr1.x = pk2(y1[0], y1[1]); kr1.y = pk2(y1[2], y1[3]); kr2.x = pk2(y2[0], y2[1]); kr2.y = pk2(y2[2], y2[3]); }
    float rkv_r[4];
#pragma unroll
    for (int r = 0; r < 4; ++r) rkv_r[r] = __shfl(rkv, 4 * fq + r);
    const int chunk = s0 >> 6, key0 = (s0 & 63) + 4 * fq;
#pragma unroll 1
    for (int h = 0; h < 4; ++h) {
        bf16_t* krow = Ko + (tokrow + (size_t)h * SEQ) * 96;
#pragma unroll 1
        for (int nt = 0; nt < 4; ++nt) { f32x4 a = {0.f, 0.f, 0.f, 0.f};
#pragma unroll
            for (int s = 0; s < 4; ++s) { const bf16x8 wf = *(const bf16x8*)(Wukv + (size_t)(h * 128 + nt * 16 + fr) * 128 + 32 * s + 8 * fq); a = mfma16(wf, ckv[s], a); }
            a = a * rkv; u32x2 w; w.x = pk2(a.x, a.y); w.y = pk2(a.z, a.w); *(u32x2*)(krow + nt * 16 + 4 * fq) = w; }
        *(u32x2*)(krow + 64 + 4 * fq) = kr1; *(u32x2*)(krow + 80 + 4 * fq) = kr2;
        bf16_t* vt = Vo + ((size_t)((b * 4 + h) * NCHUNK + chunk) * 64) * 64;
#pragma unroll 1
        for (int nt = 0; nt < 4; ++nt) { f32x4 a = {0.f, 0.f, 0.f, 0.f};
#pragma unroll
            for (int s = 0; s < 4; ++s) { const bf16x8 wf = *(const bf16x8*)(Wukv + (size_t)(h * 128 + 64 + nt * 16 + fr) * 128 + 32 * s + 8 * fq); a = mfma16(ckv[s], wf, a); }
            u32x2 w; w.x = pk2(a.x * rkv_r[0], a.y * rkv_r[1]); w.y = pk2(a.z * rkv_r[2], a.w * rkv_r[3]);
            *(u32x2*)(vt + (size_t)(nt * 16 + fr) * 64 + key0) = w; }
    }
}

constexpr int MP_UQ_ROW = 200, MP_UKV_ROW = 136, MP_UKV_OFF = 96 * MP_UQ_ROW * 2, MP_BUF = MP_UKV_OFF + 128 * MP_UKV_ROW * 2;
__device__ __forceinline__ void mla_pre_item(const Params& P, int l, LAS unsigned char* lds, int it, int tid, int wave, int lane) {
    const int fr = lane & 15, fq = lane >> 4, rt = it * 8 + wave;
    const bf16_t* z = (const bf16_t*)(P.ws + WS_R);
    bf16_t* Qo = (bf16_t*)((unsigned char*)P.out + MLA_Q_OFF); bf16_t* Ko = (bf16_t*)((unsigned char*)P.out + MLA_K_OFF); bf16_t* Vo = (bf16_t*)((unsigned char*)P.out + MLA_VT_OFF);
    const bf16_t* Wuq = wl(P, l, W_UQ); const bf16_t* Wukv = wl(P, l, W_UKV);
    u32x4 stg[5];
#define MP_LOADQ(h_) do { _Pragma("unroll") for (int i = 0; i < 5; ++i) { const int p = tid + 512 * i; if (p < 2304) stg[i] = *(const u32x4*)(Wuq + (size_t)(h_) * 96 * 192 + (size_t)p * 8); } } while (0)
#define MP_STOREQ(buf_) do { _Pragma("unroll") for (int i = 0; i < 5; ++i) { const int p = tid + 512 * i; if (p < 2304) { const int row = p / 24, pc = p % 24; *(LAS u32x4*)(lds + (buf_) * MP_BUF + (row * MP_UQ_ROW + pc * 8) * 2) = stg[i]; } } } while (0)
#define MP_LOADKV(h_) do { _Pragma("unroll") for (int i = 0; i < 4; ++i) { const int p = tid + 512 * i; stg[i] = *(const u32x4*)(Wukv + (size_t)(h_) * 128 * 128 + (size_t)p * 8); } } while (0)
#define MP_STOREKV(buf_) do { _Pragma("unroll") for (int i = 0; i < 4; ++i) { const int p = tid + 512 * i, row = p >> 4, pc = p & 15; *(LAS u32x4*)(lds + (buf_) * MP_BUF + MP_UKV_OFF + (row * MP_UKV_ROW + pc * 8) * 2) = stg[i]; } } while (0)
    MP_LOADQ(0); MP_STOREQ(0); MP_LOADKV(0);
    const int tok0 = rt * 16, b = tok0 >> 11, s0 = tok0 & 2047;
    const bf16_t* zr = z + (size_t)(tok0 + fr) * ZP;
    bf16x8 cq[6], ckv[4]; float sq = 0.f, skv = 0.f;
#pragma unroll
    for (int s = 0; s < 6; ++s) { const u32x4 w = *(const u32x4*)(zr + Z_CQ + 32 * s + 8 * fq); cq[s] = __builtin_bit_cast(bf16x8, w);
        sq += bflo(w.x) * bflo(w.x) + bfhi(w.x) * bfhi(w.x) + bflo(w.y) * bflo(w.y) + bfhi(w.y) * bfhi(w.y) + bflo(w.z) * bflo(w.z) + bfhi(w.z) * bfhi(w.z) + bflo(w.w) * bflo(w.w) + bfhi(w.w) * bfhi(w.w); }
#pragma unroll
    for (int s = 0; s < 4; ++s) { const u32x4 w = *(const u32x4*)(zr + Z_CKV + 32 * s + 8 * fq); ckv[s] = __builtin_bit_cast(bf16x8, w);
        skv += bflo(w.x) * bflo(w.x) + bfhi(w.x) * bfhi(w.x) + bflo(w.y) * bflo(w.y) + bfhi(w.y) * bfhi(w.y) + bflo(w.z) * bflo(w.z) + bfhi(w.z) * bfhi(w.z) + bflo(w.w) * bflo(w.w) + bfhi(w.w) * bfhi(w.w); }
    const u32x2 kra = *(const u32x2*)(zr + Z_KR + 4 * fq), krc = *(const u32x2*)(zr + Z_KR + 16 + 4 * fq);
    const float pos = (float)P.pos[tok0 + fr];
    MP_STOREKV(0);
    sq = xrow_sum_(sq); skv = xrow_sum_(skv);
    const float rq = frsq_(sq * (1.0f / 192.0f) + EPS), rkv = frsq_(skv * (1.0f / 128.0f) + EPS);
    const float qsc = rq * 0.10206207261596575f * LOG2E;
    float sn[4], cs[4];
#pragma unroll
    for (int r = 0; r < 4; ++r) { const float invf = exp2f(-(float)(4 * fq + r) * (13.287712379549449f / 16.0f)); sincos_rev(pos * invf, sn[r], cs[r]); }
    const size_t tokrow = (size_t)b * 4 * SEQ + (s0 + fr);
    u32x2 kr1, kr2;
    { const float x1[4] = {bflo(kra.x), bfhi(kra.x), bflo(kra.y), bfhi(kra.y)}, x2[4] = {bflo(krc.x), bfhi(krc.x), bflo(krc.y), bfhi(krc.y)}; float y1[4], y2[4];
#pragma unroll
      for (int r = 0; r < 4; ++r) { y1[r] = x1[r] * cs[r] - x2[r] * sn[r]; y2[r] = x1[r] * sn[r] + x2[r] * cs[r]; }
      kr1.x = pk2(y1[0], y1[1]); kr1.y = pk2(y1[2], y1[3]); kr2.x = pk2(y2[0], y2[1]); kr2.y = pk2(y2[2], y2[3]); }
    float rkv_r[4];
#pragma unroll
    for (int r = 0; r < 4; ++r) rkv_r[r] = __shfl(rkv, 4 * fq + r);
    const int chunk = s0 >> 6, key0 = (s0 & 63) + 4 * fq;
    __syncthreads();
#pragma unroll 1
    for (int h = 0; h < 4; ++h) {
        if (h < 3) MP_LOADQ(h + 1);
        const LAS bf16_t* UQ = (const LAS bf16_t*)(lds + (h & 1) * MP_BUF); const LAS bf16_t* UKV = (const LAS bf16_t*)(lds + (h & 1) * MP_BUF + MP_UKV_OFF);
        bf16_t* qrow = Qo + (tokrow + (size_t)h * SEQ) * 96; bf16_t* krow = Ko + (tokrow + (size_t)h * SEQ) * 96;
        bf16_t* vt = Vo + ((size_t)((b * 4 + h) * NCHUNK + chunk) * 64) * 64;
#pragma unroll 1
        for (int nt = 0; nt < 4; ++nt) { f32x4 a = {0.f, 0.f, 0.f, 0.f};
#pragma unroll
            for (int s = 0; s < 6; ++s) a = mfma16(*(const LAS bf16x8*)(UQ + (nt * 16 + fr) * MP_UQ_ROW + 32 * s + 8 * fq), cq[s], a);
            a = a * qsc; u32x2 w; w.x = pk2(a.x, a.y); w.y = pk2(a.z, a.w); *(u32x2*)(qrow + nt * 16 + 4 * fq) = w; }
        {   f32x4 x1 = {0.f, 0.f, 0.f, 0.f}, x2 = {0.f, 0.f, 0.f, 0.f}, y1, y2;
#pragma unroll
            for (int s = 0; s < 6; ++s) { x1 = mfma16(*(const LAS bf16x8*)(UQ + (64 + fr) * MP_UQ_ROW + 32 * s + 8 * fq), cq[s], x1); x2 = mfma16(*(const LAS bf16x8*)(UQ + (80 + fr) * MP_UQ_ROW + 32 * s + 8 * fq), cq[s], x2); }
            x1 = x1 * qsc; x2 = x2 * qsc;
#pragma unroll
            for (int r = 0; r < 4; ++r) { y1[r] = x1[r] * cs[r] - x2[r] * sn[r]; y2[r] = x1[r] * sn[r] + x2[r] * cs[r]; }
            u32x2 w; w.x = pk2(y1.x, y1.y); w.y = pk2(y1.z, y1.w); *(u32x2*)(qrow + 64 + 4 * fq) = w; w.x = pk2(y2.x, y2.y); w.y = pk2(y2.z, y2.w); *(u32x2*)(qrow + 80 + 4 * fq) = w; }
        if (h < 3) { MP_STOREQ((h + 1) & 1); MP_LOADKV(h + 1); }
#pragma unroll 1
        for (int nt = 0; nt < 4; ++nt) { f32x4 a = {0.f, 0.f, 0.f, 0.f};
#pragma unroll
            for (int s = 0; s < 4; ++s) a = mfma16(*(const LAS bf16x8*)(UKV + (nt * 16 + fr) * MP_UKV_ROW + 32 * s + 8 * fq), ckv[s], a);
            a = a * rkv; u32x2 w; w.x = pk2(a.x, a.y); w.y = pk2(a.z, a.w); *(u32x2*)(krow + nt * 16 + 4 * fq) = w; }
        *(u32x2*)(krow + 64 + 4 * fq) = kr1; *(u32x2*)(krow + 80 + 4 * fq) = kr2;
#pragma unroll 1
        for (int nt = 0; nt < 4; ++nt) { f32x4 a = {0.f, 0.f, 0.f, 0.f};
#pragma unroll
            for (int s = 0; s < 4; ++s) a = mfma16(ckv[s], *(const LAS bf16x8*)(UKV + (64 + nt * 16 + fr) * MP_UKV_ROW + 32 * s + 8 * fq), a);
            u32x2 w; w.x = pk2(a.x * rkv_r[0], a.y * rkv_r[1]); w.y = pk2(a.z * rkv_r[2], a.w * rkv_r[3]);
            *(u32x2*)(vt + (size_t)(nt * 16 + fr) * 64 + key0) = w; }
        if (h < 3) MP_STOREKV((h + 1) & 1);
        __syncthreads();
    }
#undef MP_LOADQ
#undef MP_STOREQ
#undef MP_LOADKV
#undef MP_STOREKV
}

template <int DQK, int DV, int KT, int QT>
__device__ __forceinline__ void flash_item(LAS unsigned char* lds, const bf16_t* Qw, int ldq, const bf16_t* Kb, int ldk, const bf16_t* VTb, int ldv, int vts,
                                           bf16_t* Ow, int ldo, int ntiles, int wave_limit, int tid, int lane) {
    constexpr int KROW = DQK + 8, VROW = KT + 8, KS = DQK / 32, ET = DV / 16, NKT = KT / 16, KBYTES = KT * KROW * 2, BUF = KBYTES + DV * VROW * 2;
    constexpr int KP = KT * DQK / 8, VPR = KT / 8, VP = DV * VPR, NKP = (KP + 511) / 512, NVP = (VP + 511) / 512, NP = NKP > NVP ? NKP : NVP;
    const int fr = lane & 15, fq = lane >> 4;
    bf16x8 qf[QT][KS];
#pragma unroll
    for (int qi = 0; qi < QT; ++qi)
#pragma unroll
        for (int s = 0; s < KS; ++s) qf[qi][s] = *(const bf16x8*)(Qw + (size_t)(qi * 16 + fr) * ldq + 32 * s + 8 * fq);
    f32x4 ot[QT][ET];
#pragma unroll
    for (int qi = 0; qi < QT; ++qi)
#pragma unroll
        for (int e = 0; e < ET; ++e) ot[qi][e] = (f32x4){0.f, 0.f, 0.f, 0.f};
    float m_run[QT], l_run[QT];
#pragma unroll
    for (int qi = 0; qi < QT; ++qi) { m_run[qi] = -1e30f; l_run[qi] = 0.f; }
    u32x4 preg[NP];
#define FL_LOADK(j_) do { _Pragma("unroll") for (int i = 0; i < NKP; ++i) { const int idx = tid + i * 512; if (idx < KP) { const int row = idx / (DQK / 8), pc = idx % (DQK / 8); \
            preg[i] = *(const u32x4*)(Kb + (size_t)((j_) * KT + row) * ldk + pc * 8); } } } while (0)
#define FL_LOADV(j_) do { _Pragma("unroll") for (int i = 0; i < NVP; ++i) { const int idx = tid + i * 512; if (idx < VP) { const int row = idx / VPR, pc = idx % VPR; \
            preg[i] = *(const u32x4*)(VTb + (size_t)(j_) * vts + (size_t)row * ldv + pc * 8); } } } while (0)
#define FL_STOREK(buf_) do { LAS bf16_t* Kt_ = (LAS bf16_t*)(lds + (buf_) * BUF); \
        _Pragma("unroll") for (int i = 0; i < NKP; ++i) { const int idx = tid + i * 512; if (idx < KP) { const int row = idx / (DQK / 8), pc = idx % (DQK / 8); *(LAS u32x4*)(Kt_ + row * KROW + pc * 8) = preg[i]; } } } while (0)
#define FL_STOREV(buf_) do { LAS bf16_t* Vt_ = (LAS bf16_t*)(lds + (buf_) * BUF + KBYTES); \
        _Pragma("unroll") for (int i = 0; i < NVP; ++i) { const int idx = tid + i * 512; if (idx < VP) { const int row = idx / VPR, pc = idx % VPR; *(LAS u32x4*)(Vt_ + row * VROW + pc * 8) = preg[i]; } } } while (0)
    FL_LOADK(0); FL_STOREK(0); FL_LOADV(0); FL_STOREV(0);
    __syncthreads();
#pragma unroll 1
    for (int j = 0; j < ntiles; ++j) {
        const bool more = j + 1 < ntiles, act = j < wave_limit;
        const LAS bf16_t* Kt = (const LAS bf16_t*)(lds + (j & 1) * BUF); const LAS bf16_t* Vt = (const LAS bf16_t*)(lds + (j & 1) * BUF + KBYTES);
        if (more) FL_LOADK(j + 1);
        f32x4 st[QT][NKT];
        if (act) {
#pragma unroll
            for (int kt = 0; kt < NKT; ++kt) {
#pragma unroll
                for (int qi = 0; qi < QT; ++qi) st[qi][kt] = (f32x4){0.f, 0.f, 0.f, 0.f};
#pragma unroll
                for (int s = 0; s < KS; ++s) { const bf16x8 kf = *(const LAS bf16x8*)(Kt + (kt * 16 + fr) * KROW + 32 * s + 8 * fq);
#pragma unroll
                    for (int qi = 0; qi < QT; ++qi) st[qi][kt] = mfma16(kf, qf[qi][s], st[qi][kt]); } }
        }
        if (more) { FL_STOREK((j + 1) & 1); FL_LOADV(j + 1); }
        if (act) {
            bf16x8 pf[QT][NKT / 2];
#pragma unroll
            for (int qi = 0; qi < QT; ++qi) {
                float mx = fmaxf(fmaxf(st[qi][0].x, st[qi][0].y), fmaxf(st[qi][0].z, st[qi][0].w));
#pragma unroll
                for (int kt = 1; kt < NKT; ++kt) mx = fmaxf(mx, fmaxf(fmaxf(st[qi][kt].x, st[qi][kt].y), fmaxf(st[qi][kt].z, st[qi][kt].w)));
                mx = xrow_max_(mx);
                const float m_new = fmaxf(m_run[qi], mx), alpha = fexp2_(m_run[qi] - m_new);
                float ls = 0.f;
#pragma unroll
                for (int kt = 0; kt < NKT; ++kt)
#pragma unroll
                    for (int r = 0; r < 4; ++r) { const float p = fexp2_(st[qi][kt][r] - m_new); st[qi][kt][r] = p; ls += p; }
                l_run[qi] = l_run[qi] * alpha + ls; m_run[qi] = m_new;
#pragma unroll
                for (int e = 0; e < ET; ++e) ot[qi][e] = ot[qi][e] * alpha;
#pragma unroll
                for (int k2 = 0; k2 < NKT / 2; ++k2) pf[qi][k2] = pack8(st[qi][2 * k2], st[qi][2 * k2 + 1]);
            }
#pragma unroll
            for (int e = 0; e < ET; ++e) {
                const LAS bf16_t* vr = Vt + (e * 16 + fr) * VROW + 4 * fq;
#pragma unroll
                for (int k2 = 0; k2 < NKT / 2; ++k2) { const bf16x8 v0 = mk8(*(const LAS u32x2*)(vr + 32 * k2), *(const LAS u32x2*)(vr + 32 * k2 + 16));
#pragma unroll
                    for (int qi = 0; qi < QT; ++qi) ot[qi][e] = mfma16(v0, pf[qi][k2], ot[qi][e]); }
            }
        }
        if (more) FL_STOREV((j + 1) & 1);
        __syncthreads();
    }
#undef FL_LOADK
#undef FL_LOADV
#undef FL_STOREK
#undef FL_STOREV
#pragma unroll
    for (int qi = 0; qi < QT; ++qi) {
        float l = l_run[qi]; l = xrow_sum_(l);
        const float inv = frcp_(l);
#pragma unroll
        for (int e = 0; e < ET; ++e) { u32x2 w; w.x = pk2(ot[qi][e].x * inv, ot[qi][e].y * inv); w.y = pk2(ot[qi][e].z * inv, ot[qi][e].w * inv);
            *(u32x2*)(Ow + (size_t)(qi * 16 + fr) * ldo + e * 16 + 4 * fq) = w; }
    }
}
__device__ __forceinline__ void mla_attn_item(const Params& P, LAS unsigned char* lds, int it, int tid, int wave, int lane) {
    const int qt = 7 - (it >> 6), bh = it & 63;
    const bf16_t* Q = (const bf16_t*)((unsigned char*)P.out + MLA_Q_OFF) + ((size_t)bh * SEQ + qt * 256 + wave * 32) * 96;
    const bf16_t* K = (const bf16_t*)((unsigned char*)P.out + MLA_K_OFF) + (size_t)bh * SEQ * 96;
    const bf16_t* VT = (const bf16_t*)((unsigned char*)P.out + MLA_VT_OFF) + (size_t)bh * NCHUNK * 4096;
    bf16_t* y = (bf16_t*)(P.ws + WS_R + R_Y) + ((size_t)(bh >> 2) * SEQ + qt * 256 + wave * 32) * DM + 512 + (bh & 3) * 64;
    flash_item<96, 64, 64, 2>(lds, Q, 96, K, 96, VT, 64, 4096, y, DM, 4 * qt + 4, 4 * qt + (wave >> 1) + 1, tid, lane);
}
constexpr int XA_KROW = 264, XA_VROW = 72, XA_KBUF = 32 * XA_KROW * 2, XA_VBUF = 128 * XA_VROW * 2, XA_VOFF = 2 * XA_KBUF;
__device__ __forceinline__ void xa_item(const Params& P, int l, LAS unsigned char* lds, int it, int tid, int wave, int lane) {
    const int qt = it & 7, h = (it >> 3) & 3, b = it >> 5, fr = lane & 15, fq = lane >> 4;
    const size_t qoff = ((size_t)b * SEQ + qt * 256 + wave * 32) * DM + h * 256;
    const bf16_t* Q = (const bf16_t*)(P.ws + WS_R) + qoff; bf16_t* O = (bf16_t*)(P.ws + WS_R + R_OX) + qoff;
    const bf16_t* Kb = (const bf16_t*)(P.ws + WS_KVM + (size_t)l * KVM_LAYER) + (size_t)b * NMEM * DM + h * 256;
    const bf16_t* VTb = (const bf16_t*)(P.ws + WS_KVM + (size_t)l * KVM_LAYER + (size_t)4096 * 1024 * 2) + (size_t)h * 256 * 4096 + b * NMEM;
    u32x4 stg[2];
#define XA_LOADK(j_) do { _Pragma("unroll") for (int i = 0; i < 2; ++i) { const int p = tid + 512 * i, row = p >> 5, pc = p & 31; stg[i] = *(const u32x4*)(Kb + (size_t)((j_) * 32 + row) * DM + pc * 8); } } while (0)
#define XA_STOREK(buf_) do { _Pragma("unroll") for (int i = 0; i < 2; ++i) { const int p = tid + 512 * i, row = p >> 5, pc = p & 31; *(LAS u32x4*)(lds + (buf_) * XA_KBUF + (row * XA_KROW + pc * 8) * 2) = stg[i]; } } while (0)
#define XA_LOADV(t_) do { _Pragma("unroll") for (int i = 0; i < 2; ++i) { const int p = tid + 512 * i, row = p >> 3, pc = p & 7; stg[i] = *(const u32x4*)(VTb + (size_t)(((t_) >> 2) * 128 + row) * 4096 + ((t_) & 3) * 64 + pc * 8); } } while (0)
#define XA_STOREV(buf_) do { _Pragma("unroll") for (int i = 0; i < 2; ++i) { const int p = tid + 512 * i, row = p >> 3, pc = p & 7; *(LAS u32x4*)(lds + XA_VOFF + (buf_) * XA_VBUF + (row * XA_VROW + pc * 8) * 2) = stg[i]; } } while (0)
    XA_LOADK(0);
    bf16x8 pf[2][8];
    float linv[2], c1[2];
    {
        bf16x8 qf[2][8];
#pragma unroll
        for (int qi = 0; qi < 2; ++qi)
#pragma unroll
            for (int s = 0; s < 8; ++s) qf[qi][s] = *(const bf16x8*)(Q + (size_t)(qi * 16 + fr) * DM + 32 * s + 8 * fq);
        XA_STOREK(0);
        __syncthreads();
        float m1[2], l1[2];
#pragma unroll
        for (int half = 0; half < 2; ++half) {
            f32x4 S[2][8];
#pragma unroll
            for (int jj = 0; jj < 4; ++jj) { const int j = half * 4 + jj;
                if (j < 7) XA_LOADK(j + 1); else XA_LOADV(0);
                const LAS bf16_t* Kt = (const LAS bf16_t*)(lds + (j & 1) * XA_KBUF);
#pragma unroll
                for (int kt = 0; kt < 2; ++kt) {
                    f32x4 a0 = {0.f, 0.f, 0.f, 0.f}, a1 = {0.f, 0.f, 0.f, 0.f};
#pragma unroll
                    for (int s = 0; s < 8; ++s) { const bf16x8 kf = *(const LAS bf16x8*)(Kt + (kt * 16 + fr) * XA_KROW + 32 * s + 8 * fq); a0 = mfma16(kf, qf[0][s], a0); a1 = mfma16(kf, qf[1][s], a1); }
                    S[0][2 * jj + kt] = a0; S[1][2 * jj + kt] = a1; __builtin_amdgcn_sched_barrier(0); }
                if (j < 7) XA_STOREK((j + 1) & 1); else XA_STOREV(0);
                __syncthreads();
            }
#pragma unroll
            for (int qi = 0; qi < 2; ++qi) {
                float mx = -1e30f;
#pragma unroll
                for (int t = 0; t < 8; ++t) mx = fmaxf(mx, fmaxf(fmaxf(S[qi][t].x, S[qi][t].y), fmaxf(S[qi][t].z, S[qi][t].w)));
                mx = xrow_max_(mx);
                if (half == 1) { const float m = fmaxf(m1[qi], mx); c1[qi] = fexp2_(m1[qi] - m); mx = m; }
                float ls = 0.f;
#pragma unroll
                for (int t = 0; t < 4; ++t) { f32x4 pa, pb;
#pragma unroll
                    for (int r = 0; r < 4; ++r) { pa[r] = fexp2_(S[qi][2 * t][r] - mx); pb[r] = fexp2_(S[qi][2 * t + 1][r] - mx); }
                    ls += ((pa.x + pa.y) + (pa.z + pa.w)) + ((pb.x + pb.y) + (pb.z + pb.w));
                    pf[qi][half * 4 + t] = pack8(pa, pb);
                    asm volatile("" : "+v"(ls)); }
                ls = xrow_sum_(ls);
                if (half == 0) { m1[qi] = mx; l1[qi] = ls; } else linv[qi] = frcp_(l1[qi] * c1[qi] + ls);
            }
        }
    }
#pragma unroll
    for (int eh = 0; eh < 2; ++eh) {
        f32x4 ot[2][8];
#pragma unroll
        for (int qi = 0; qi < 2; ++qi)
#pragma unroll
            for (int e = 0; e < 8; ++e) ot[qi][e] = (f32x4){0.f, 0.f, 0.f, 0.f};
#pragma unroll
        for (int jv = 0; jv < 4; ++jv) { const int t = eh * 4 + jv;
            if (t < 7) XA_LOADV(t + 1);
            const LAS bf16_t* Vt = (const LAS bf16_t*)(lds + XA_VOFF + (t & 1) * XA_VBUF);
#pragma unroll
            for (int e = 0; e < 8; ++e) { const LAS bf16_t* vr = Vt + (e * 16 + fr) * XA_VROW + 4 * fq;
                const bf16x8 v0 = mk8(*(const LAS u32x2*)vr, *(const LAS u32x2*)(vr + 16)), v1 = mk8(*(const LAS u32x2*)(vr + 32), *(const LAS u32x2*)(vr + 48));
                ot[0][e] = mfma16(v0, pf[0][2 * jv], ot[0][e]); ot[1][e] = mfma16(v0, pf[1][2 * jv], ot[1][e]);
                ot[0][e] = mfma16(v1, pf[0][2 * jv + 1], ot[0][e]); ot[1][e] = mfma16(v1, pf[1][2 * jv + 1], ot[1][e]); if (e & 1) __builtin_amdgcn_sched_barrier(0); }
            if (jv == 1) {
#pragma unroll
                for (int e = 0; e < 8; ++e) { ot[0][e] = ot[0][e] * c1[0]; ot[1][e] = ot[1][e] * c1[1]; } }
            if (t < 7) XA_STOREV((t + 1) & 1);
            __syncthreads();
        }
#pragma unroll
        for (int qi = 0; qi < 2; ++qi)
#pragma unroll
            for (int e = 0; e < 8; ++e) { u32x2 w; w.x = pk2(ot[qi][e].x * linv[qi], ot[qi][e].y * linv[qi]); w.y = pk2(ot[qi][e].z * linv[qi], ot[qi][e].w * linv[qi]);
                *(u32x2*)(O + (size_t)(qi * 16 + fr) * DM + eh * 128 + e * 16 + 4 * fq) = w; }
    }
#undef XA_LOADK
#undef XA_STOREK
#undef XA_LOADV
#undef XA_STOREV
}
constexpr int GP_KN = 0, GP_KB = 9216, GP_QN = 18432, GP_L = 9216, GP_RHS = 27648, GP_G = 60416, GP_GC = 60672, GP_HEAD = 61440;
__device__ __forceinline__ bf16_t* gdn_buf(const Params& P, int chh, int k) { return (bf16_t*)(P.ws + WS_GDN) + ((size_t)chh * 5 + k) * 4096; }
__device__ __forceinline__ void gdn_pre_item(const Params& P, int l, LAS unsigned char* lds, int it, int tid) {
    const int hp = it & 1, n = (it >> 1) & 31, b = it >> 6;
    const int hh = tid >> 8, h = 2 * hp + hh, tt = tid & 255, c = tt >> 2, qr = tt & 3, lane = tid & 63;
    LAS unsigned char* L = lds + hh * GP_HEAD;
    const bf16_t* z = (const bf16_t*)(P.ws + WS_R);
    const int s = n * 64 + c; const size_t tok = (size_t)b * SEQ + s;
    const float* cw = P.gdn_conv_w + (size_t)l * 4 * 768;
    const int chh = (b * NCHUNK + n) * 4 + h;
    float q[16], k[16], v[16];
#pragma unroll
    for (int part = 0; part < 3; ++part) {
        float* dst = part == 0 ? q : (part == 1 ? k : v);
        const int ch0 = part * 256 + h * 64 + qr * 16;
#pragma unroll
        for (int i = 0; i < 16; ++i) dst[i] = 0.f;
#pragma unroll
        for (int kk = 0; kk < 4; ++kk) { {
            const bool okk = s - 3 + kk >= 0; const float mk = okk ? 1.f : 0.f;
            const bf16_t* zr = z + (okk ? tok - 3 + kk : tok) * ZP + Z_GQKV + ch0; const u32x4 w0 = *(const u32x4*)zr, w1 = *(const u32x4*)(zr + 8);
            const float* wr = cw + kk * 768 + ch0; const f32x4 c0 = *(const f32x4*)wr * mk, c1 = *(const f32x4*)(wr + 4) * mk, c2 = *(const f32x4*)(wr + 8) * mk, c3 = *(const f32x4*)(wr + 12) * mk;
            dst[0] += c0.x * bflo(w0.x); dst[1] += c0.y * bfhi(w0.x); dst[2] += c0.z * bflo(w0.y); dst[3] += c0.w * bfhi(w0.y);
            dst[4] += c1.x * bflo(w0.z); dst[5] += c1.y * bfhi(w0.z); dst[6] += c1.z * bflo(w0.w); dst[7] += c1.w * bfhi(w0.w);
            dst[8] += c2.x * bflo(w1.x); dst[9] += c2.y * bfhi(w1.x); dst[10] += c2.z * bflo(w1.y); dst[11] += c2.w * bfhi(w1.y);
            dst[12] += c3.x * bflo(w1.z); dst[13] += c3.y * bfhi(w1.z); dst[14] += c3.z * bflo(w1.w); dst[15] += c3.w * bfhi(w1.w); } }
#pragma unroll
        for (int i = 0; i < 16; ++i) dst[i] = siluf_(dst[i]);
    }
    float sq = 0.f, sk = 0.f;
#pragma unroll
    for (int i = 0; i < 16; ++i) { sq += q[i] * q[i]; sk += k[i] * k[i]; }
    sq = sum4_(sq); sk = sum4_(sk);
    const float rq = frsq_(sq + EPS) * 0.125f, rk = frsq_(sk + EPS);
    const bf16_t* zt = z + tok * ZP;
    const float beta = sigmoidf_(bf2f(zt[Z_GB + h]));
    const float g = -fexp_(P.gdn_a_log[l * 4 + h]) * softplusf_(bf2f(zt[Z_GA + h]) + P.gdn_dt_bias[l * 4 + h]);
    {
        u32x4 w0, w1;
#define PK16(dst0, dst1, src, sc) do { dst0.x = pk2(src[0] * (sc), src[1] * (sc)); dst0.y = pk2(src[2] * (sc), src[3] * (sc)); dst0.z = pk2(src[4] * (sc), src[5] * (sc)); dst0.w = pk2(src[6] * (sc), src[7] * (sc)); \
        dst1.x = pk2(src[8] * (sc), src[9] * (sc)); dst1.y = pk2(src[10] * (sc), src[11] * (sc)); dst1.z = pk2(src[12] * (sc), src[13] * (sc)); dst1.w = pk2(src[14] * (sc), src[15] * (sc)); } while (0)
        PK16(w0, w1, k, rk);        *(LAS u32x4*)(L + GP_KN + (c * 72 + qr * 16) * 2) = w0; *(LAS u32x4*)(L + GP_KN + (c * 72 + qr * 16 + 8) * 2) = w1;
        PK16(w0, w1, k, rk * beta); *(LAS u32x4*)(L + GP_KB + (c * 72 + qr * 16) * 2) = w0; *(LAS u32x4*)(L + GP_KB + (c * 72 + qr * 16 + 8) * 2) = w1;
        PK16(w0, w1, q, rq);        *(LAS u32x4*)(L + GP_QN + (c * 72 + qr * 16) * 2) = w0; *(LAS u32x4*)(L + GP_QN + (c * 72 + qr * 16 + 8) * 2) = w1;
        LAS float* rhs = (LAS float*)(L + GP_RHS) + c * 128 + qr * 16;
#pragma unroll
        for (int i = 0; i < 4; ++i) *(LAS f32x4*)(rhs + 4 * i) = (f32x4){v[4 * i] * beta, v[4 * i + 1] * beta, v[4 * i + 2] * beta, v[4 * i + 3] * beta};
        if (qr == 0) ((LAS float*)(L + GP_G))[c] = g;
    }
    __syncthreads();
    {
        float gc = 0.f, run = 0.f; const LAS float* G = (const LAS float*)(L + GP_G);
#pragma unroll 16
        for (int i = 0; i < 64; ++i) { run += G[i]; gc = (i == c) ? run : gc; }
        const float eg = fexp_(gc), ek = fexp_(run - gc);
        LAS float* rhs = (LAS float*)(L + GP_RHS) + c * 128 + 64 + qr * 16;
#pragma unroll
        for (int i = 0; i < 4; ++i) *(LAS f32x4*)(rhs + 4 * i) = (f32x4){k[4 * i] * rk * beta * eg, k[4 * i + 1] * rk * beta * eg, k[4 * i + 2] * rk * beta * eg, k[4 * i + 3] * rk * beta * eg};
        u32x4 w0, w1; PK16(w0, w1, q, rq * eg);
        bf16_t* qd = gdn_buf(P, chh, 3) + c * 64 + qr * 16; *(u32x4*)qd = w0; *(u32x4*)(qd + 8) = w1;
        bf16_t* kdt = gdn_buf(P, chh, 4) + (qr * 16) * 64 + c;
#pragma unroll
        for (int i = 0; i < 16; ++i) kdt[i * 64] = f2bf(k[i] * rk * ek);
        if (qr == 0) ((LAS float*)(L + GP_GC))[c] = gc;
        if (tt == 0) ((float*)(P.ws + WS_GL))[chh] = fexp_(run);
    }
#undef PK16
    __syncthreads();
    {
        const int it4 = (tid >> 6) & 3, fr = lane & 15, fq = lane >> 4;
        const LAS bf16_t* Kn = (const LAS bf16_t*)(L + GP_KN); const LAS bf16_t* KB = (const LAS bf16_t*)(L + GP_KB); const LAS bf16_t* Qn = (const LAS bf16_t*)(L + GP_QN);
        const LAS float* GC = (const LAS float*)(L + GP_GC);
        const bf16x8 a0 = *(const LAS bf16x8*)(KB + (it4 * 16 + fr) * 72 + 8 * fq), a1 = *(const LAS bf16x8*)(KB + (it4 * 16 + fr) * 72 + 32 + 8 * fq);
        const bf16x8 q0 = *(const LAS bf16x8*)(Qn + (it4 * 16 + fr) * 72 + 8 * fq), q1 = *(const LAS bf16x8*)(Qn + (it4 * 16 + fr) * 72 + 32 + 8 * fq);
        float gci[4];
#pragma unroll
        for (int r = 0; r < 4; ++r) gci[r] = GC[it4 * 16 + 4 * fq + r];
        f32x4 lv[4]; bf16_t* att = gdn_buf(P, chh, 2);
#pragma unroll
        for (int jt = 0; jt < 4; ++jt) {
            const bf16x8 b0 = *(const LAS bf16x8*)(Kn + (jt * 16 + fr) * 72 + 8 * fq), b1 = *(const LAS bf16x8*)(Kn + (jt * 16 + fr) * 72 + 32 + 8 * fq);
            f32x4 al = {0.f, 0.f, 0.f, 0.f}, aa = {0.f, 0.f, 0.f, 0.f};
            al = mfma16(a0, b0, al); al = mfma16(a1, b1, al); aa = mfma16(q0, b0, aa); aa = mfma16(q1, b1, aa);
            const int j = jt * 16 + fr; const float gcj = GC[j];
#pragma unroll
            for (int r = 0; r < 4; ++r) { const int i = it4 * 16 + 4 * fq + r; const float dec = fexp_(fminf(gci[r] - gcj, 0.f));
                lv[jt][r] = (i > j) ? al[r] * dec : 0.f; att[i * 64 + j] = f2bf((i >= j) ? aa[r] * dec : 0.f); }
        }
        __syncthreads();
        LAS float* Lm = (LAS float*)(L + GP_L);
#pragma unroll
        for (int jt = 0; jt < 4; ++jt)
#pragma unroll
            for (int r = 0; r < 4; ++r) Lm[(it4 * 16 + 4 * fq + r) * 64 + (fr & 1) * 32 + jt * 8 + (fr >> 1)] = lv[jt][r];
    }
    __syncthreads();
    {
        const int col = tt >> 1, p = tt & 1;
        const LAS float* Lp = (const LAS float*)(L + GP_L) + p * 32; const LAS float* rhs = (const LAS float*)(L + GP_RHS) + col;
        float xs[32];
#pragma unroll
        for (int k = 0; k < 32; ++k) xs[k] = 0.f;
#pragma unroll
        for (int ib = 0; ib < 4; ++ib) {
            float rv[16];
#pragma unroll
            for (int t = 0; t < 16; ++t) rv[t] = rhs[(ib * 16 + t) * 128];
#pragma unroll
            for (int t = 0; t < 16; ++t) { const int i = ib * 16 + t;
                float a0 = 0.f, a1 = 0.f;
#pragma unroll
                for (int k4 = 0; k4 < ((i + 1) / 2 + 3) / 4; ++k4) { const f32x4 lr = *(const LAS f32x4*)(Lp + i * 64 + 4 * k4);
                    a0 += lr.x * xs[4 * k4 + 0]; a1 += lr.y * xs[4 * k4 + 1]; a0 += lr.z * xs[4 * k4 + 2]; a1 += lr.w * xs[4 * k4 + 3]; }
                float acc = a0 + a1; acc += dpp_xor1(acc);
                const float xi = rv[t] - acc;
                xs[i >> 1] = (p == (i & 1)) ? xi : xs[i >> 1];
            }
        }
        if (col < 64) {
            bf16_t* ut = gdn_buf(P, chh, 1) + col * 64 + 32 * p;
            unsigned wv[16];
#pragma unroll
            for (int k = 0; k < 32; ++k) { const float other = dpp_xor1(xs[k]);
                const float lo = p ? other : xs[k], hi = p ? xs[k] : other;
                if ((k >> 4) == 0) { if (p == 0) wv[k & 15] = pk2(lo, hi); } else { if (p == 1) wv[k & 15] = pk2(lo, hi); } }
#pragma unroll
            for (int g4 = 0; g4 < 4; ++g4) *(u32x4*)(ut + 8 * g4) = (u32x4){wv[4 * g4], wv[4 * g4 + 1], wv[4 * g4 + 2], wv[4 * g4 + 3]};
        } else { bf16_t* wo = gdn_buf(P, chh, 0) + (col - 64) + p * 64;
#pragma unroll
            for (int k = 0; k < 32; ++k) wo[k * 128] = f2bf(xs[k]); }
    }
    __syncthreads();
}

constexpr int GC_W = 0, GC_UT = 9216, GC_ATT = 18432, GC_QD = 27648, GC_KDT = 36864, GC_ST = 46080, GC_VNT = 55296, GC_BH = 64512;
__device__ __forceinline__ bf16x8 ldsA(const LAS unsigned char* M, int row, int s, int fq) { return *(const LAS bf16x8*)(M + row * 144 + 64 * s + 16 * fq); }
__device__ __forceinline__ void gdn_chain_item(const Params& P, int l, LAS unsigned char* lds, int gi, int tid, int wave, int lane) {
    const int q2 = wave >> 2, bh = gi * 2 + q2, ct = wave & 3, b = bh >> 2, h = bh & 3, fr = lane & 15, fq = lane >> 4;
    const bf16_t* z = (const bf16_t*)(P.ws + WS_R); bf16_t* y = (bf16_t*)(P.ws + WS_R + R_Y);
    LAS unsigned char* L = lds + q2 * GC_BH;
    float ng[4];
#pragma unroll
    for (int et = 0; et < 4; ++et) ng[et] = P.gdn_norm[l * 64 + et * 16 + fr];
    u32x4 stg[10];
    const bf16_t* src0[2] = { gdn_buf(P, ((gi * 2 >> 2) * NCHUNK) * 4 + ((gi * 2) & 3), 0), gdn_buf(P, (((gi * 2 + 1) >> 2) * NCHUNK) * 4 + ((gi * 2 + 1) & 3), 0) };
#define GC_LOAD(n_) do { _Pragma("unroll") for (int i = 0; i < 10; ++i) { const int p = tid + 512 * i, qq = p / 2560, pp = p % 2560; \
        stg[i] = *(const u32x4*)(src0[qq] + (size_t)(n_) * 4 * 5 * 4096 + (size_t)pp * 8); } } while (0)
#define GC_WRITE1(i_) do { const int p = tid + 512 * (i_), qq = p / 2560, pp = p % 2560, mat = pp >> 9, row = (pp & 511) >> 3, pc = pp & 7; \
        *(LAS u32x4*)(lds + qq * GC_BH + mat * 9216 + row * 144 + pc * 16) = stg[i_]; } while (0)
#define GC_WRITE_A() do { GC_WRITE1(0); GC_WRITE1(1); GC_WRITE1(3); GC_WRITE1(5); GC_WRITE1(6); GC_WRITE1(8); } while (0)
#define GC_WRITE_B() do { GC_WRITE1(2); GC_WRITE1(4); GC_WRITE1(7); GC_WRITE1(9); } while (0)
    GC_LOAD(0); GC_WRITE_A(); GC_WRITE_B();
    for (int i = tid; i < 64 * 72 / 2; i += 512) { ((LAS unsigned*)(lds + GC_ST))[i] = 0u; ((LAS unsigned*)(lds + GC_BH + GC_ST))[i] = 0u; }
    f32x4 S[4];
#pragma unroll
    for (int t = 0; t < 4; ++t) S[t] = (f32x4){0.f, 0.f, 0.f, 0.f};
    const size_t tokb = (size_t)b * SEQ + ct * 16 + 4 * fq;
    __syncthreads();
    for (int n = 0; n < NCHUNK; ++n) {
        const int chh = (b * NCHUNK + n) * 4 + h;
        if (n + 1 < NCHUNK) GC_LOAD(n + 1);
        bf16_t gate[4][4];
#pragma unroll
        for (int r = 0; r < 4; ++r)
#pragma unroll
            for (int et = 0; et < 4; ++et) gate[r][et] = z[(tokb + n * 64 + r) * ZP + Z_GG + h * 64 + et * 16 + fr];
        const float egl = ((const float*)(P.ws + WS_GL))[chh];
        f32x4 o[4];
        {
            const bf16x8 w0 = ldsA(L + GC_W, ct * 16 + fr, 0, fq), w1 = ldsA(L + GC_W, ct * 16 + fr, 1, fq), q0 = ldsA(L + GC_QD, ct * 16 + fr, 0, fq), q1 = ldsA(L + GC_QD, ct * 16 + fr, 1, fq);
#pragma unroll
            for (int et = 0; et < 4; ++et) {
                const bf16x8 s0 = ldsA(L + GC_ST, et * 16 + fr, 0, fq), s1 = ldsA(L + GC_ST, et * 16 + fr, 1, fq);
                f32x4 a = {0.f, 0.f, 0.f, 0.f}; a = mfma16(w0, s0, a); a = mfma16(w1, s1, a);
                f32x4 oo = {0.f, 0.f, 0.f, 0.f}; oo = mfma16(q0, s0, oo); oo = mfma16(q1, s1, oo); o[et] = oo;
                const u32x2 uw = *(const LAS u32x2*)(L + GC_UT + (et * 16 + fr) * 144 + (ct * 16 + 4 * fq) * 2);
                u32x2 vw; vw.x = pk2(bflo(uw.x) - a.x, bfhi(uw.x) - a.y); vw.y = pk2(bflo(uw.y) - a.z, bfhi(uw.y) - a.w);
                *(LAS u32x2*)(L + GC_VNT + (et * 16 + fr) * 144 + (ct * 16 + 4 * fq) * 2) = vw; }
        }
        __syncthreads();
        if (n + 1 < NCHUNK) GC_WRITE_A();
        {
            const bf16x8 a0 = ldsA(L + GC_ATT, ct * 16 + fr, 0, fq), a1 = ldsA(L + GC_ATT, ct * 16 + fr, 1, fq), k0 = ldsA(L + GC_KDT, ct * 16 + fr, 0, fq), k1 = ldsA(L + GC_KDT, ct * 16 + fr, 1, fq);
#pragma unroll
            for (int et = 0; et < 4; ++et) {
                const bf16x8 v0 = ldsA(L + GC_VNT, et * 16 + fr, 0, fq), v1 = ldsA(L + GC_VNT, et * 16 + fr, 1, fq);
                o[et] = mfma16(a0, v0, o[et]); o[et] = mfma16(a1, v1, o[et]);
                f32x4 sN = S[et] * egl; sN = mfma16(k0, v0, sN); sN = mfma16(k1, v1, sN); S[et] = sN;
                u32x2 sw; sw.x = pk2(sN.x, sN.y); sw.y = pk2(sN.z, sN.w);
                *(LAS u32x2*)(L + GC_ST + (et * 16 + fr) * 144 + (ct * 16 + 4 * fq) * 2) = sw; }
        }
        {
#pragma unroll
            for (int r = 0; r < 4; ++r) {
                float s2 = (o[0][r] * o[0][r] + o[1][r] * o[1][r]) + (o[2][r] * o[2][r] + o[3][r] * o[3][r]);
                s2 = sum16_(s2);
                const float rs = frsq_(s2 * (1.0f / 64.0f) + EPS);
#pragma unroll
                for (int et = 0; et < 4; ++et) y[(tokb + n * 64 + r) * DM + 768 + h * 64 + et * 16 + fr] = f2bf(o[et][r] * rs * ng[et] * siluf_(bf2f(gate[r][et])));
            }
        }
        __syncthreads();
        if (n + 1 < NCHUNK) GC_WRITE_B();
    }
#undef GC_LOAD
#undef GC_WRITE1
#undef GC_WRITE_A
#undef GC_WRITE_B
    __syncthreads();
}

constexpr int RT_BUF = 36864, RT_Q = 0, RT_K = 9216, RT_KZT = 18432, RT_VT = 27648, RT_P = 73728, RT_ST = 82944, RT_O = 92160;
__device__ __forceinline__ void ret_chain_item(const Params& P, int l, LAS unsigned char* lds, int it, int tid, int wave, int lane) {
    const int b = it >> 2, h = it & 3, fr = lane & 15, fq = lane >> 4;
    const bf16_t* z = (const bf16_t*)(P.ws + WS_R); bf16_t* y = (bf16_t*)(P.ws + WS_R + R_Y);
    LAS bf16_t* Pm = (LAS bf16_t*)(lds + RT_P); LAS bf16_t* ST = (LAS bf16_t*)(lds + RT_ST); LAS float* Of = (LAS float*)(lds + RT_O);
    const float lg = log1pf(-exp2f(-5.0f - (float)h));
    const float cdec = fexp_(64.0f * lg);
    for (int i = tid; i < 64 * 72 / 2; i += 512) ((LAS unsigned*)ST)[i] = 0u;
    const int it4 = wave >> 1, jt0 = 2 * (wave & 1);
    f32x4 S[2] = {{0.f, 0.f, 0.f, 0.f}, {0.f, 0.f, 0.f, 0.f}};
    const int lc = tid >> 3, pg = tid & 7;
    float invf[4];
#pragma unroll
    for (int ii = 0; ii < 4; ++ii) invf[ii] = exp2f(-(float)(4 * pg + ii) * (13.287712379549449f / 32.0f));
    const float zeta = fexp_((63.0f - (float)lc) * lg);
    const f32x4 gn0 = *(const f32x4*)(P.ret_gn + l * 256 + h * 64 + 8 * pg), gn1 = *(const f32x4*)(P.ret_gn + l * 256 + h * 64 + 8 * pg + 4);
    const size_t tok0 = (size_t)b * SEQ + lc;
    u32x2 q1w, q2w, k1w, k2w; u32x4 vw; int posi;
#define RT_LOAD(n_) do { const bf16_t* zr_ = z + (tok0 + (n_) * 64) * ZP; q1w = *(const u32x2*)(zr_ + Z_RQ + h * 64 + 4 * pg); q2w = *(const u32x2*)(zr_ + Z_RQ + h * 64 + 32 + 4 * pg); \
        k1w = *(const u32x2*)(zr_ + Z_RK + h * 64 + 4 * pg); k2w = *(const u32x2*)(zr_ + Z_RK + h * 64 + 32 + 4 * pg); vw = *(const u32x4*)(zr_ + Z_RV + h * 64 + 8 * pg); posi = P.pos[tok0 + (n_) * 64]; } while (0)
#define RT_STAGE(buf_) do { LAS bf16_t* Qs_ = (LAS bf16_t*)(lds + (buf_) * RT_BUF + RT_Q); LAS bf16_t* Ks_ = (LAS bf16_t*)(lds + (buf_) * RT_BUF + RT_K); \
        LAS bf16_t* KzT_ = (LAS bf16_t*)(lds + (buf_) * RT_BUF + RT_KZT); LAS bf16_t* VT_ = (LAS bf16_t*)(lds + (buf_) * RT_BUF + RT_VT); const float pos = (float)posi; \
        const float q1[4] = {bflo(q1w.x), bfhi(q1w.x), bflo(q1w.y), bfhi(q1w.y)}, q2[4] = {bflo(q2w.x), bfhi(q2w.x), bflo(q2w.y), bfhi(q2w.y)}; \
        const float k1[4] = {bflo(k1w.x), bfhi(k1w.x), bflo(k1w.y), bfhi(k1w.y)}, k2[4] = {bflo(k2w.x), bfhi(k2w.x), bflo(k2w.y), bfhi(k2w.y)}; \
        float qa[4], qb[4], ka[4], kb[4]; \
        _Pragma("unroll") for (int ii = 0; ii < 4; ++ii) { float sn, cs; sincos_rev(pos * invf[ii], sn, cs); \
            qa[ii] = (q1[ii] * cs - q2[ii] * sn) * 0.125f; qb[ii] = (q1[ii] * sn + q2[ii] * cs) * 0.125f; ka[ii] = k1[ii] * cs - k2[ii] * sn; kb[ii] = k1[ii] * sn + k2[ii] * cs; } \
        u32x2 w_; w_.x = pk2(qa[0], qa[1]); w_.y = pk2(qa[2], qa[3]); *(LAS u32x2*)(Qs_ + lc * 72 + 4 * pg) = w_; \
        w_.x = pk2(qb[0], qb[1]); w_.y = pk2(qb[2], qb[3]); *(LAS u32x2*)(Qs_ + lc * 72 + 32 + 4 * pg) = w_; \
        w_.x = pk2(ka[0], ka[1]); w_.y = pk2(ka[2], ka[3]); *(LAS u32x2*)(Ks_ + lc * 72 + 4 * pg) = w_; \
        w_.x = pk2(kb[0], kb[1]); w_.y = pk2(kb[2], kb[3]); *(LAS u32x2*)(Ks_ + lc * 72 + 32 + 4 * pg) = w_; \
        _Pragma("unroll") for (int ii = 0; ii < 4; ++ii) { KzT_[(4 * pg + ii) * 72 + lc] = f2bf(ka[ii] * zeta); KzT_[(32 + 4 * pg + ii) * 72 + lc] = f2bf(kb[ii] * zeta); } \
        const unsigned vv[4] = {vw.x, vw.y, vw.z, vw.w}; \
        _Pragma("unroll") for (int ii = 0; ii < 4; ++ii) { VT_[(8 * pg + 2 * ii) * 72 + lc] = (bf16_t)(vv[ii] & 0xffffu); VT_[(8 * pg + 2 * ii + 1) * 72 + lc] = (bf16_t)(vv[ii] >> 16); } } while (0)
    RT_LOAD(0); RT_STAGE(0);
    __syncthreads();
    for (int n = 0; n < NCHUNK; ++n) {
        const int cb = n & 1;
        const LAS bf16_t* Qs = (const LAS bf16_t*)(lds + cb * RT_BUF + RT_Q); const LAS bf16_t* Ks = (const LAS bf16_t*)(lds + cb * RT_BUF + RT_K);
        const LAS bf16_t* KzT = (const LAS bf16_t*)(lds + cb * RT_BUF + RT_KZT); const LAS bf16_t* VT = (const LAS bf16_t*)(lds + cb * RT_BUF + RT_VT);
        const size_t tok = tok0 + n * 64;
        if (n + 1 < NCHUNK) RT_LOAD(n + 1);
        const u32x4 gw = *(const u32x4*)(z + tok * ZP + Z_RG + h * 64 + 8 * pg);
        const bf16x8 a0 = *(const LAS bf16x8*)(Qs + (it4 * 16 + fr) * 72 + 8 * fq), a1 = *(const LAS bf16x8*)(Qs + (it4 * 16 + fr) * 72 + 32 + 8 * fq);
        f32x4 cross[2];
#pragma unroll
        for (int t = 0; t < 2; ++t) { const int jt = jt0 + t;
            f32x4 p = {0.f, 0.f, 0.f, 0.f};
            p = mfma16(a0, *(const LAS bf16x8*)(Ks + (jt * 16 + fr) * 72 + 8 * fq), p); p = mfma16(a1, *(const LAS bf16x8*)(Ks + (jt * 16 + fr) * 72 + 32 + 8 * fq), p);
            f32x4 cr = {0.f, 0.f, 0.f, 0.f};
            cr = mfma16(a0, *(const LAS bf16x8*)(ST + (jt * 16 + fr) * 72 + 8 * fq), cr); cr = mfma16(a1, *(const LAS bf16x8*)(ST + (jt * 16 + fr) * 72 + 32 + 8 * fq), cr);
#pragma unroll
            for (int r = 0; r < 4; ++r) { const int i = it4 * 16 + 4 * fq + r, j = jt * 16 + fr; const int dd = i > j ? i - j : j - i;
                Pm[i * 72 + j] = f2bf(p[r] * fexp_((float)dd * lg)); cr[r] *= fexp_((float)(i + 1) * lg); }
            cross[t] = cr; }
        __syncthreads();
        const bf16x8 p0 = *(const LAS bf16x8*)(Pm + (it4 * 16 + fr) * 72 + 8 * fq), p1 = *(const LAS bf16x8*)(Pm + (it4 * 16 + fr) * 72 + 32 + 8 * fq);
        const bf16x8 kz0 = *(const LAS bf16x8*)(KzT + (it4 * 16 + fr) * 72 + 8 * fq), kz1 = *(const LAS bf16x8*)(KzT + (it4 * 16 + fr) * 72 + 32 + 8 * fq);
#pragma unroll
        for (int t = 0; t < 2; ++t) { const int et = jt0 + t;
            const bf16x8 v0 = *(const LAS bf16x8*)(VT + (et * 16 + fr) * 72 + 8 * fq), v1 = *(const LAS bf16x8*)(VT + (et * 16 + fr) * 72 + 32 + 8 * fq);
            f32x4 o = cross[t]; o = mfma16(p0, v0, o); o = mfma16(p1, v1, o);
#pragma unroll
            for (int r = 0; r < 4; ++r) Of[(it4 * 16 + 4 * fq + r) * 65 + et * 16 + fr] = o[r];
            f32x4 sN = S[t] * cdec; sN = mfma16(kz0, v0, sN); sN = mfma16(kz1, v1, sN); S[t] = sN;
            u32x2 w; w.x = pk2(sN.x, sN.y); w.y = pk2(sN.z, sN.w); *(LAS u32x2*)(ST + (et * 16 + fr) * 72 + it4 * 16 + 4 * fq) = w; }
        if (n + 1 < NCHUNK) RT_STAGE(cb ^ 1);
        __syncthreads();
        {
            float ov[8]; float sm = 0.f;
#pragma unroll
            for (int j = 0; j < 8; ++j) { ov[j] = Of[lc * 65 + 8 * pg + j]; sm += ov[j]; }
            sm = sum8_(sm);
            const float mu = sm * (1.0f / 64.0f); float vs = 0.f;
#pragma unroll
            for (int j = 0; j < 8; ++j) { ov[j] -= mu; vs += ov[j] * ov[j]; }
            vs = sum8_(vs);
            const float rs = frsq_(vs * (1.0f / 64.0f) + EPS);
            const float gt[8] = {bflo(gw.x), bfhi(gw.x), bflo(gw.y), bfhi(gw.y), bflo(gw.z), bfhi(gw.z), bflo(gw.w), bfhi(gw.w)};
            const float gnv[8] = {gn0.x, gn0.y, gn0.z, gn0.w, gn1.x, gn1.y, gn1.z, gn1.w};
            float r8[8];
#pragma unroll
            for (int j = 0; j < 8; ++j) r8[j] = ov[j] * rs * gnv[j] * siluf_(gt[j]);
            u32x4 w; w.x = pk2(r8[0], r8[1]); w.y = pk2(r8[2], r8[3]); w.z = pk2(r8[4], r8[5]); w.w = pk2(r8[6], r8[7]);
            *(u32x4*)(y + tok * DM + h * 64 + 8 * pg) = w;
        }
    }
#undef RT_LOAD
#undef RT_STAGE
    __syncthreads();
}

constexpr int LR_XC = 0, LR_AU = 33792;
__device__ __forceinline__ void lru_item(const Params& P, int l, LAS unsigned char* lds, int it, int mode, int tid, int wave, int lane) {
    const int b = it >> 5, n = it & 31, fr = lane & 15, fq = lane >> 4;
    const bf16_t* z = (const bf16_t*)(P.ws + WS_R); bf16_t* y = (bf16_t*)(P.ws + WS_R + R_Y);
    LAS bf16_t* XC = (LAS bf16_t*)(lds + LR_XC); LAS f32x2* AU = (LAS f32x2*)(lds + LR_AU);
    float* sumA = (float*)(P.ws + WS_LRUS); float* sumH = sumA + 16 * 32 * 256;
    {
        const int c = tid >> 3, cg = tid & 7, s = n * 64 + c; const size_t tok = (size_t)b * SEQ + s;
        const float* cw = P.lru_conv_w + (size_t)l * 4 * 256; const float* cb = P.lru_conv_b + l * 256;
#pragma unroll
        for (int g = 0; g < 4; ++g) { const int ch0 = cg * 32 + g * 8;
            const f32x4 b0 = *(const f32x4*)(cb + ch0), b1 = *(const f32x4*)(cb + ch0 + 4);
            float a[8] = {b0.x, b0.y, b0.z, b0.w, b1.x, b1.y, b1.z, b1.w};
#pragma unroll
            for (int kk = 0; kk < 4; ++kk) { const bool okk = s - 3 + kk >= 0; const float mk = okk ? 1.f : 0.f;
                const u32x4 w = *(const u32x4*)(z + (okk ? tok - 3 + kk : tok) * ZP + Z_LX + ch0);
                const f32x4 c0 = *(const f32x4*)(cw + kk * 256 + ch0) * mk, c1 = *(const f32x4*)(cw + kk * 256 + ch0 + 4) * mk;
                a[0] += c0.x * bflo(w.x); a[1] += c0.y * bfhi(w.x); a[2] += c0.z * bflo(w.y); a[3] += c0.w * bfhi(w.y);
                a[4] += c1.x * bflo(w.z); a[5] += c1.y * bfhi(w.z); a[6] += c1.z * bflo(w.w); a[7] += c1.w * bfhi(w.w); }
            u32x4 o; o.x = pk2(a[0], a[1]); o.y = pk2(a[2], a[3]); o.z = pk2(a[4], a[5]); o.w = pk2(a[6], a[7]);
            *(LAS u32x4*)(XC + c * 264 + ch0) = o; }
    }
    float hcar = 0.f, aprod = 1.f;
    if (mode == 1 && tid < 256) {
        float av[32], hv[32];
#pragma unroll
        for (int m = 0; m < 32; ++m) { const int mm = m < n ? m : 0; av[m] = sumA[(b * 32 + mm) * 256 + tid]; hv[m] = sumH[(b * 32 + mm) * 256 + tid]; }
#pragma unroll
        for (int m = 0; m < 32; ++m) if (m < n) hcar = av[m] * hcar + hv[m];
    }
    const int nb = wave >> 1, rt = wave & 1;
    const bf16_t* wa = wl(P, l, W_A) + nb * 4096; const bf16_t* wx = wl(P, l, W_X) + nb * 4096;
    bf16x8 fa[4][2], fx[4][2]; float ba[4], bx[4], spl[4];
#pragma unroll
    for (int dt = 0; dt < 4; ++dt) {
#pragma unroll
        for (int s = 0; s < 2; ++s) { fa[dt][s] = *(const bf16x8*)(wa + (dt * 16 + fr) * 64 + 32 * s + 8 * fq); fx[dt][s] = *(const bf16x8*)(wx + (dt * 16 + fr) * 64 + 32 * s + 8 * fq); }
        const int d = nb * 64 + dt * 16 + fr; ba[dt] = P.lru_ba[l * 256 + d]; bx[dt] = P.lru_bx[l * 256 + d]; spl[dt] = -8.0f * softplusf_(-P.lru_lambda[l * 256 + d]); }
    __syncthreads();
    for (int half = 0; half < 2; ++half) {
        const int trow = half * 32 + rt * 16;
        const bf16x8 x0 = *(const LAS bf16x8*)(XC + (trow + fr) * 264 + nb * 64 + 8 * fq), x1 = *(const LAS bf16x8*)(XC + (trow + fr) * 264 + nb * 64 + 32 + 8 * fq);
#pragma unroll
        for (int dt = 0; dt < 4; ++dt) {
            f32x4 ar = {0.f, 0.f, 0.f, 0.f}, ai = {0.f, 0.f, 0.f, 0.f};
            ar = mfma16(x0, fa[dt][0], ar); ar = mfma16(x1, fa[dt][1], ar); ai = mfma16(x0, fx[dt][0], ai); ai = mfma16(x1, fx[dt][1], ai);
            const int d = nb * 64 + dt * 16 + fr;
#pragma unroll
            for (int r = 0; r < 4; ++r) { const int tl = rt * 16 + 4 * fq + r;
                const float xcv = bf2f(XC[(half * 32 + tl) * 264 + d]);
                const float rr = sigmoidf_(ar[r] + ba[dt]), ii = sigmoidf_(ai[r] + bx[dt]);
                const float a = fexp_(rr * spl[dt]);
                const float u = fsqrt_(fmaxf(1.0f - a * a, 0.f)) * (ii * xcv);
                AU[tl * 257 + d] = (f32x2){a, u}; }
        }
        __syncthreads();
        if (tid < 256) {
#pragma unroll 8
            for (int tk = 0; tk < 32; ++tk) { const f32x2 au = AU[tk * 257 + tid]; hcar = au.x * hcar + au.y; aprod *= au.x; if (mode == 1) AU[tk * 257 + tid].y = hcar; }
        }
        if (mode == 1) {
            __syncthreads();
            const int tk = tid >> 4, c0 = (tid & 15) * 16; const size_t tok = (size_t)b * SEQ + n * 64 + half * 32 + tk;
            const u32x4 g0 = *(const u32x4*)(z + tok * ZP + Z_LG + c0), g1 = *(const u32x4*)(z + tok * ZP + Z_LG + c0 + 8);
            const unsigned gws[8] = {g0.x, g0.y, g0.z, g0.w, g1.x, g1.y, g1.z, g1.w}; unsigned ow[8];
#pragma unroll
            for (int j = 0; j < 8; ++j) { const float h0 = AU[tk * 257 + c0 + 2 * j].y, h1 = AU[tk * 257 + c0 + 2 * j + 1].y; ow[j] = pk2(h0 * geluf_(bflo(gws[j])), h1 * geluf_(bfhi(gws[j]))); }
            bf16_t* yp = y + tok * DM + 256 + c0;
            *(u32x4*)yp = (u32x4){ow[0], ow[1], ow[2], ow[3]}; *(u32x4*)(yp + 8) = (u32x4){ow[4], ow[5], ow[6], ow[7]};
        }
        __syncthreads();
    }
    if (mode == 0 && tid < 256) { sumA[(b * 32 + n) * 256 + tid] = aprod; sumH[(b * 32 + n) * 256 + tid] = hcar; }
}

constexpr int LC_XC = 0, LC_AU = 9216;
__device__ __forceinline__ void lru_chain_item(const Params& P, int l, LAS unsigned char* lds, int it, int tid, int wave, int lane) {
    const int b = it >> 2, nb = it & 3, fr = lane & 15, fq = lane >> 4;
    const bf16_t* z = (const bf16_t*)(P.ws + WS_R); bf16_t* y = (bf16_t*)(P.ws + WS_R + R_Y);
    LAS bf16_t* XC = (LAS bf16_t*)(lds + LC_XC); LAS f32x2* AU = (LAS f32x2*)(lds + LC_AU);
    const int c = tid >> 3, cg = tid & 7, ch0 = nb * 64 + cg * 8;
    f32x4 cw0[4], cw1[4];
#pragma unroll
    for (int kk = 0; kk < 4; ++kk) { cw0[kk] = *(const f32x4*)(P.lru_conv_w + (size_t)l * 1024 + kk * 256 + ch0); cw1[kk] = *(const f32x4*)(P.lru_conv_w + (size_t)l * 1024 + kk * 256 + ch0 + 4); }
    const f32x4 cb0 = *(const f32x4*)(P.lru_conv_b + l * 256 + ch0), cb1 = *(const f32x4*)(P.lru_conv_b + l * 256 + ch0 + 4);
    const int rt = wave >> 1, dt0 = (wave & 1) * 2;
    const bf16_t* wa = wl(P, l, W_A) + nb * 4096; const bf16_t* wx = wl(P, l, W_X) + nb * 4096;
    bf16x8 fa[2][2], fx[2][2]; float ba[2], bx[2], spl[2];
#pragma unroll
    for (int t = 0; t < 2; ++t) {
#pragma unroll
        for (int s = 0; s < 2; ++s) { fa[t][s] = *(const bf16x8*)(wa + ((dt0 + t) * 16 + fr) * 64 + 32 * s + 8 * fq); fx[t][s] = *(const bf16x8*)(wx + ((dt0 + t) * 16 + fr) * 64 + 32 * s + 8 * fq); }
        const int d = nb * 64 + (dt0 + t) * 16 + fr; ba[t] = P.lru_ba[l * 256 + d]; bx[t] = P.lru_bx[l * 256 + d]; spl[t] = -8.0f * softplusf_(-P.lru_lambda[l * 256 + d]); }
    const size_t tok0 = (size_t)b * SEQ + c;
    u32x4 xr[4], gr;
#define LC_LOAD(n_) do { const size_t t_ = tok0 + (size_t)(n_) * 64; _Pragma("unroll") for (int kk = 0; kk < 4; ++kk) { const bool ok_ = (n_) * 64 + c - 3 + kk >= 0; \
        xr[kk] = *(const u32x4*)(z + (ok_ ? t_ - 3 + kk : t_) * ZP + Z_LX + ch0); } gr = *(const u32x4*)(z + t_ * ZP + Z_LG + ch0); } while (0)
    LC_LOAD(0);
    float hcar = 0.f;
    for (int n = 0; n < NCHUNK; ++n) {
        {
            float a[8] = {cb0.x, cb0.y, cb0.z, cb0.w, cb1.x, cb1.y, cb1.z, cb1.w};
#pragma unroll
            for (int kk = 0; kk < 4; ++kk) { const float mk = (n * 64 + c - 3 + kk >= 0) ? 1.f : 0.f; const f32x4 c0 = cw0[kk] * mk, c1 = cw1[kk] * mk; const u32x4 w = xr[kk];
                a[0] += c0.x * bflo(w.x); a[1] += c0.y * bfhi(w.x); a[2] += c0.z * bflo(w.y); a[3] += c0.w * bfhi(w.y);
                a[4] += c1.x * bflo(w.z); a[5] += c1.y * bfhi(w.z); a[6] += c1.z * bflo(w.w); a[7] += c1.w * bfhi(w.w); }
            u32x4 o; o.x = pk2(a[0], a[1]); o.y = pk2(a[2], a[3]); o.z = pk2(a[4], a[5]); o.w = pk2(a[6], a[7]);
            *(LAS u32x4*)(XC + c * 72 + cg * 8) = o;
        }
        const u32x4 gcur = gr;
        if (n + 1 < NCHUNK) LC_LOAD(n + 1);
        __syncthreads();
        {
            const bf16x8 x0 = *(const LAS bf16x8*)(XC + (rt * 16 + fr) * 72 + 8 * fq), x1 = *(const LAS bf16x8*)(XC + (rt * 16 + fr) * 72 + 32 + 8 * fq);
#pragma unroll
            for (int t = 0; t < 2; ++t) {
                f32x4 ar = {0.f, 0.f, 0.f, 0.f}, ai = {0.f, 0.f, 0.f, 0.f};
                ar = mfma16(x0, fa[t][0], ar); ar = mfma16(x1, fa[t][1], ar); ai = mfma16(x0, fx[t][0], ai); ai = mfma16(x1, fx[t][1], ai);
                const int dl = (dt0 + t) * 16 + fr;
#pragma unroll
                for (int r = 0; r < 4; ++r) { const int tl = rt * 16 + 4 * fq + r;
                    const float xcv = bf2f(XC[tl * 72 + dl]);
                    const float rr = sigmoidf_(ar[r] + ba[t]), ii = sigmoidf_(ai[r] + bx[t]);
                    const float av = fexp_(rr * spl[t]);
                    AU[tl * 65 + dl] = (f32x2){av, fsqrt_(fmaxf(1.0f - av * av, 0.f)) * (ii * xcv)}; }
            }
        }
        __syncthreads();
        if (tid < 64) {
#pragma unroll
            for (int blk = 0; blk < 4; ++blk) { f32x2 au[16];
#pragma unroll
                for (int k = 0; k < 16; ++k) au[k] = AU[(blk * 16 + k) * 65 + tid];
#pragma unroll
                for (int k = 0; k < 16; ++k) { hcar = au[k].x * hcar + au[k].y; au[k].y = hcar; }
#pragma unroll
                for (int k = 0; k < 16; ++k) AU[(blk * 16 + k) * 65 + tid].y = au[k].y; }
        }
        __syncthreads();
        {
            const unsigned gws[4] = {gcur.x, gcur.y, gcur.z, gcur.w}; unsigned ow[4];
#pragma unroll
            for (int j = 0; j < 4; ++j) ow[j] = pk2(AU[c * 65 + cg * 8 + 2 * j].y * geluf_(bflo(gws[j])), AU[c * 65 + cg * 8 + 2 * j + 1].y * geluf_(bfhi(gws[j])));
            *(u32x4*)(y + (tok0 + (size_t)n * 64) * DM + 256 + ch0) = (u32x4){ow[0], ow[1], ow[2], ow[3]};
        }
    }
#undef LC_LOAD
    __syncthreads();
}

constexpr int N_PHASES = 21;
constexpr int Q_RET = 64, Q_GDN = 32, Q_LRU = 64, Q_MLA = 512, Q_TOTAL = Q_RET + Q_GDN + Q_LRU + Q_MLA;

__global__ void __launch_bounds__(512, 2) hymba_fwd(Params P_) {
    extern __shared__ __attribute__((aligned(16))) unsigned char lds_raw[];
    LAS unsigned char* lds = (LAS unsigned char*)lds_raw;
    volatile LAS unsigned* LC = (volatile LAS unsigned*)(lds + LDS_CTL);
    const int G = gridDim.x;
#define SUB_TID() int tid2 = tid; asm volatile("" : "+v"(tid2)); const int lane2 = tid2 & 63, wave2 = __builtin_amdgcn_readfirstlane(tid2 >> 6); (void)lane2; (void)wave2
#if defined(__HIP_DEVICE_COMPILE__)
#define PH_PARAMS() const __attribute__((address_space(4))) Params* pp_ = (const __attribute__((address_space(4))) Params*)__builtin_amdgcn_kernarg_segment_ptr(); asm volatile("" : "+s"(pp_)); const Params P = *pp_
#else
#define PH_PARAMS() const Params P = P_
#endif
#define PH_TID() PH_PARAMS(); \
    bf16_t* xb = (bf16_t*)(P.ws + WS_XB); float* part = (float*)(P.ws + WS_PART); bf16_t* zb = (bf16_t*)(P.ws + WS_R); bf16_t* yb = (bf16_t*)(P.ws + WS_R + R_Y); bf16_t* oxb = (bf16_t*)(P.ws + WS_R + R_OX); (void)xb; (void)part; (void)zb; (void)yb; (void)oxb; \
    int tid = threadIdx.x; asm volatile("" : "+v"(tid)); const int lane = tid & 63, wave = __builtin_amdgcn_readfirstlane(tid >> 6); (void)lane; (void)wave
    unsigned* ctl = (unsigned*)(P_.ws + WS_CTL);
    if (threadIdx.x < 64) LC[threadIdx.x] = 0u;
    __syncthreads();
    const int lo = P_.ph_lo, hi = P_.ph_hi;
    XcdBarrier bar; bar.bar = ctl + CW_BAR; bar.x = 0; bar.st = LC;
    if (hi - lo > 1) bar = xcd_barrier_post(ctl + CW_BAR, LC);
#ifndef PHASE_MASK
#define PHASE_MASK 0xFFFFFFFFu
#endif
#define EN(t) ((PHASE_MASK >> (t)) & 1u)
#ifndef REPEAT_MASK
#define REPEAT_MASK 0u
#endif
#define REP(t) for (int rep_ = 0; rep_ <= (int)((REPEAT_MASK >> (t)) & 1u); ++rep_, (rep_ <= (int)((REPEAT_MASK >> (t)) & 1u) ? xcd_barrier(bar) : (void)0))
#define IN(k) (lo <= (k) && (k) < hi)
#define SEAM(k) do { if (IN(k) && IN((k) + 1)) xcd_barrier(bar); } while (0)


    if (IN(0) && EN(0)) REP(0) { PH_TID(); p0_prologue(P, lds, tid); __syncthreads(); }
    SEAM(0);
    if (IN(1) && EN(1)) REP(1) {
        PH_TID();
        const int which = blockIdx.x >> 6, l = which >> 1, isv = which & 1;
        if (which < 4) {
            const bf16_t* memn = (const bf16_t*)(P.ws + WS_GDN); const bf16_t* wkv = wl(P, l, W_KV);
            bf16_t* kout = (bf16_t*)(P.ws + WS_KVM + (size_t)l * KVM_LAYER); bf16_t* vout = kout + (size_t)4096 * 1024;
            pg8::Gemm g; pg8::EpiScaleBf16<0> E; pg8::StaticOrder S;
            if (!isv) { g = pg8::Gemm{memn, wkv, 4096, 1024, 1024}; E = pg8::EpiScaleBf16<0>{kout, 1024, nullptr}; S.init(4096, 1024, 64, blockIdx.x & 63); }
            else { g = pg8::Gemm{wkv + (size_t)1024 * 1024, memn, 1024, 4096, 1024}; E = pg8::EpiScaleBf16<0>{vout, 4096, nullptr}; S.init(1024, 4096, 64, blockIdx.x & 63); }
            pg8::gemm_phase(lds, g, S, E, tid);
        }
    }
    SEAM(1);
#pragma unroll
    for (int l = 0; l < 2; ++l) {
        const int pb = 2 + 9 * l;
        if (IN(pb + 0) && EN(2)) REP(2) { PH_TID();
            pg8::Gemm g{xb, wl(P, l, W_IN), T_TOK, ZP, DM}; pg8::StaticOrder S; S.init(T_TOK, ZP, G, blockIdx.x);
            pg8::EpiScaleBf16<0> E{zb, ZP, part}; pg8::gemm_phase(lds, g, S, E, tid);
        }
        SEAM(pb + 0);
        if (IN(pb + 1)) {
            PH_TID();
            if (EN(3)) REP(3) { SUB_TID();
_Pragma("unroll 1")
            for (int it = blockIdx.x; it < 1024; it += G) gdn_pre_item(P, l, lds, it, tid2); }
            if (EN(5)) REP(5) { SUB_TID();
_Pragma("unroll 1")
            for (int it = blockIdx.x; it < 256; it += G) mla_pre_item(P, l, lds, it, tid2, wave2, lane2); }
        }
        SEAM(pb + 1);
        if (IN(pb + 2)) {
            PH_TID();
            for (int rep2_ = 0; rep2_ <= (int)((REPEAT_MASK >> 17) & 1u); ++rep2_, (rep2_ <= (int)((REPEAT_MASK >> 17) & 1u) ? xcd_barrier(bar) : (void)0)) {
            unsigned* qh0 = ctl + CW_QUEUE + 64 * l + 16 * rep2_;
#define QUEUE_LOOP(qi_, count_, body_) for (;;) { if (tid == 0) LC[4] = __hip_atomic_fetch_add(qh + (qi_), 1u, __ATOMIC_RELAXED, __HIP_MEMORY_SCOPE_AGENT); \
                __syncthreads(); const int it = (int)LC[4]; __syncthreads(); if (it >= (count_)) break; { SUB_TID(); body_; } __syncthreads(); }
            if (EN(6)) REP(6) { unsigned* qh = qh0 + 32 * rep_; QUEUE_LOOP(0, Q_RET, ret_chain_item(P, l, lds, it, tid2, wave2, lane2)) }
            if (EN(7)) REP(7) { unsigned* qh = qh0 + 32 * rep_; QUEUE_LOOP(1, Q_GDN, gdn_chain_item(P, l, lds, it, tid2, wave2, lane2)) }
            if (EN(8)) REP(8) { unsigned* qh = qh0 + 32 * rep_; QUEUE_LOOP(2, Q_LRU, lru_chain_item(P, l, lds, it, tid2, wave2, lane2)) }
            if (EN(9)) REP(9) { unsigned* qh = qh0 + 32 * rep_; QUEUE_LOOP(3, Q_MLA, mla_attn_item(P, lds, it, tid2, wave2, lane2)) }
#undef QUEUE_LOOP
            }
        }
        SEAM(pb + 2);
        if (IN(pb + 3) && EN(10)) REP(10) { PH_TID();
            pg8::Gemm g{yb, wl(P, l, W_OUT), T_TOK, DM, DM}; pg8::StaticOrder S; S.init(T_TOK, DM, G, blockIdx.x);
            pg8::EpiResid E{xb, part, rep_ ? 0.f : 1.f}; pg8::gemm_phase(lds, g, S, E, tid);
        }
        SEAM(pb + 3);
        if (IN(pb + 4) && EN(11)) REP(11) { PH_TID();
            pg8::Gemm g{xb, wl(P, l, W_Q), T_TOK, DM, DM}; pg8::StaticOrder S; S.init(T_TOK, DM, G, blockIdx.x);
            pg8::EpiScaleBf16<0> E{zb, DM, part}; pg8::gemm_phase(lds, g, S, E, tid);
        }
        SEAM(pb + 4);
        if (IN(pb + 5) && EN(12)) REP(12) { PH_TID();
_Pragma("unroll 1")
            for (int it = blockIdx.x; it < 512; it += G) { SUB_TID(); xa_item(P, l, lds, it, tid2, wave2, lane2); __syncthreads(); } }
        SEAM(pb + 5);
        if (IN(pb + 6) && EN(13)) REP(13) { PH_TID();
            pg8::Gemm g{oxb, wl(P, l, W_O), T_TOK, DM, DM}; pg8::StaticOrder S; S.init(T_TOK, DM, G, blockIdx.x);
            pg8::EpiResid E{xb, part, rep_ ? 0.f : 1.f}; pg8::gemm_phase(lds, g, S, E, tid);
        }
        SEAM(pb + 6);
        if (IN(pb + 7) && EN(14)) REP(14) { PH_TID();
            pg8::Gemm g{xb, wl(P, l, W_1), T_TOK, DFF, DM}; pg8::StaticOrder S; S.init(T_TOK, DFF, G, blockIdx.x);
            pg8::EpiScaleBf16<1> E{zb, DFF, part}; pg8::gemm_phase(lds, g, S, E, tid);
        }
        SEAM(pb + 7);
        if (IN(pb + 8) && EN(15)) REP(15) { PH_TID();
            pg8::Gemm g{zb, wl(P, l, W_2), T_TOK, DM, DFF}; pg8::StaticOrder S; S.init(T_TOK, DM, G, blockIdx.x);
            pg8::EpiResid E{xb, part, rep_ ? 0.f : 1.f}; pg8::gemm_phase(lds, g, S, E, tid);
        }
        SEAM(pb + 8);
    }
    if (IN(20) && EN(16)) { PH_TID(); final_norm_phase(P, tid); }
#undef IN
#undef SEAM
}

extern "C" void kernel_launch(void* const* d_in, const int* in_sizes, int n_in, void* d_out, int out_size, void* d_ws, size_t ws_size, hipStream_t stream) {
    static int grid = 0;
    if (grid == 0) {
        if (n_in != 31 || out_size != T_TOK * DM || ws_size < WS_END) { fprintf(stderr, "kernel_launch: unexpected shapes (n_in %d out %d ws %zu, need %zu)\n", n_in, out_size, ws_size, (size_t)WS_END); grid = -1; return; }
        if (hipFuncSetAttribute((const void*)hymba_fwd, hipFuncAttributeMaxDynamicSharedMemorySize, LDS_BYTES) != hipSuccess) { fprintf(stderr, "kernel_launch: hipFuncSetAttribute failed\n"); grid = -1; return; }
        int dev = 0, cus = 0, per_cu = 0;
        (void)hipGetDevice(&dev); (void)hipDeviceGetAttribute(&cus, hipDeviceAttributeMultiprocessorCount, dev);
        (void)hipOccupancyMaxActiveBlocksPerMultiprocessor(&per_cu, (const void*)hymba_fwd, 512, LDS_BYTES);
        (void)hipGetLastError();
        if (cus != 256 || per_cu < 1) fprintf(stderr, "kernel_launch: note: cus %d per_cu %d\n", cus, per_cu);
        grid = 256;
    }
    if (grid < 0) return;
    (void)hipMemsetAsync((char*)d_ws + WS_CTL, 0, CTL_BYTES, stream);
    Params p{};
    p.x = (const float*)d_in[0]; p.mem = (const float*)d_in[1]; p.pos = (const int*)d_in[2];
    p.norm_mix = (const float*)d_in[3]; p.w_in = (const float*)d_in[4]; p.ret_gn = (const float*)d_in[5];
    p.lru_conv_w = (const float*)d_in[6]; p.lru_conv_b = (const float*)d_in[7]; p.lru_wa = (const float*)d_in[8]; p.lru_ba = (const float*)d_in[9];
    p.lru_wx = (const float*)d_in[10]; p.lru_bx = (const float*)d_in[11]; p.lru_lambda = (const float*)d_in[12];
    p.mla_q_norm = (const float*)d_in[13]; p.mla_w_uq = (const float*)d_in[14]; p.mla_kv_norm = (const float*)d_in[15]; p.mla_w_ukv = (const float*)d_in[16];
    p.gdn_conv_w = (const float*)d_in[17]; p.gdn_a_log = (const float*)d_in[18]; p.gdn_dt_bias = (const float*)d_in[19]; p.gdn_norm = (const float*)d_in[20];
    p.w_out = (const float*)d_in[21]; p.norm_xattn = (const float*)d_in[22]; p.norm_mem = (const float*)d_in[23];
    p.xa_wq = (const float*)d_in[24]; p.xa_wkv = (const float*)d_in[25]; p.xa_wo = (const float*)d_in[26];
    p.norm_mlp = (const float*)d_in[27]; p.mlp_w1 = (const float*)d_in[28]; p.mlp_w2 = (const float*)d_in[29]; p.final_norm = (const float*)d_in[30];
    p.out = (float*)d_out; p.ws = (unsigned char*)d_ws;
#if N_LAUNCHES == 1
    p.ph_lo = 0; p.ph_hi = N_PHASES;
    void* args[] = {&p};
    hipError_t e = hipLaunchCooperativeKernel((const void*)hymba_fwd, dim3(grid), dim3(512), args, LDS_BYTES, stream);
    if (e != hipSuccess) fprintf(stderr, "kernel_launch: cooperative launch failed: %s\n", hipGetErrorString(e));
#else
    for (int ph = 0; ph < N_PHASES; ++ph) { p.ph_lo = ph; p.ph_hi = ph + 1; hipLaunchKernelGGL(hymba_fwd, dim3(grid), dim3(512), LDS_BYTES, stream, p); }
#endif
}
```

```cpp
#include <hip/hip_runtime.h>
#include <cstdio>
#include <cstdint>

#ifndef N_LAUNCHES
#define N_LAUNCHES 1
#endif

#define LAS __attribute__((address_space(3)))
typedef unsigned short bf16_t;
typedef short bf16x8 __attribute__((ext_vector_type(8)));
typedef float f32x4 __attribute__((ext_vector_type(4)));
typedef float f32x2 __attribute__((ext_vector_type(2)));
typedef unsigned u32x4 __attribute__((ext_vector_type(4)));
typedef unsigned u32x2 __attribute__((ext_vector_type(2)));

constexpr int T_TOK = 32768, DM = 1024, SEQ = 2048, NBATCH = 16, NCHUNK = 32, ZP = 3072, DFF = 4096, NMEM = 256;
constexpr int Z_RQ = 0, Z_RK = 256, Z_RV = 512, Z_RG = 768, Z_LX = 1024, Z_LG = 1280, Z_CQ = 1536, Z_CKV = 1728, Z_KR = 1856,
              Z_GQKV = 1888, Z_GG = 2656, Z_GB = 2912, Z_GA = 2916, IN_COLS = 2920;
constexpr float EPS = 1e-6f;
constexpr float LOG2E = 1.4426950408889634f;

constexpr size_t MiB = 1024 * 1024;
constexpr size_t WS_CTL = 0;
constexpr size_t CTL_BYTES = 65536;
constexpr size_t WS_PART = WS_CTL + CTL_BYTES;
constexpr size_t WS_LRUS = WS_PART + (size_t)T_TOK * 16 * 4;
constexpr size_t WS_GL = WS_LRUS + (size_t)2 * 16 * 32 * 256 * 4;
constexpr size_t WS_W = WS_GL + 65536;
constexpr size_t W_IN = 0, W_OUT = W_IN + (size_t)ZP * DM, W_Q = W_OUT + (size_t)DM * DM, W_KV = W_Q + (size_t)DM * DM, W_O = W_KV + (size_t)2 * DM * DM,
                 W_1 = W_O + (size_t)DM * DM, W_2 = W_1 + (size_t)DFF * DM, W_UQ = W_2 + (size_t)DFF * DM, W_UKV = W_UQ + 384 * 192, W_A = W_UKV + 512 * 128,
                 W_X = W_A + 4 * 64 * 64, W_LAYER = W_X + 4 * 64 * 64;
constexpr size_t WS_XB = WS_W + 2 * W_LAYER * 2;
constexpr size_t XB_BYTES = (size_t)T_TOK * DM * 2;
constexpr size_t MLA_Q_OFF = 0, MLA_K_OFF = (size_t)T_TOK * 4 * 96 * 2, MLA_VT_OFF = 2 * MLA_K_OFF;
constexpr size_t WS_KVM = WS_XB + XB_BYTES;
constexpr size_t KVM_LAYER = (size_t)2 * 4096 * 1024 * 2;
constexpr size_t WS_R = WS_KVM + 2 * KVM_LAYER;
constexpr size_t R_Y = (size_t)T_TOK * ZP * 2;
constexpr size_t R_OX = (size_t)T_TOK * DM * 2;
constexpr size_t WS_GDN = WS_R + 256 * MiB;
constexpr size_t WS_END = WS_GDN + 80 * MiB;
static_assert(WS_END <= 512 * MiB, "workspace map exceeds 512 MiB");
static_assert(WS_XB % 256 == 0 && WS_R % 256 == 0 && WS_GDN % 256 == 0 && WS_W % 256 == 0, "alignment");
constexpr int CW_BAR = 0;
constexpr int CW_QUEUE = 4096;

constexpr int LDS_BYTES = 160 * 1024;
constexpr int LDS_CTL = LDS_BYTES - 256;

typedef __bf16 bf16x2_t __attribute__((ext_vector_type(2)));
__device__ __forceinline__ unsigned pk2(float lo, float hi) { f32x2 t = {lo, hi}; bf16x2_t v = __builtin_convertvector(t, bf16x2_t); return __builtin_bit_cast(unsigned, v); }
__device__ __forceinline__ float bflo(unsigned w) { return __uint_as_float(w << 16); }
__device__ __forceinline__ float bfhi(unsigned w) { return __uint_as_float(w & 0xffff0000u); }
__device__ __forceinline__ float bf2f(bf16_t v) { return __uint_as_float((unsigned)v << 16); }
__device__ __forceinline__ bf16_t f2bf(float f) { return (bf16_t)(pk2(f, 0.f) & 0xffffu); }
__device__ __forceinline__ f32x4 mfma16(bf16x8 a, bf16x8 b, f32x4 c) { return __builtin_amdgcn_mfma_f32_16x16x32_bf16(a, b, c, 0, 0, 0); }
__device__ __forceinline__ float fexp2_(float x) { return __builtin_amdgcn_exp2f(x); }
__device__ __forceinline__ float fexp_(float x) { return __builtin_amdgcn_exp2f(x * LOG2E); }
__device__ __forceinline__ float frcp_(float x) { return __builtin_amdgcn_rcpf(x); }
__device__ __forceinline__ float frsq_(float x) { return __builtin_amdgcn_rsqf(x); }
__device__ __forceinline__ float fsqrt_(float x) { return __builtin_amdgcn_sqrtf(x); }
__device__ __forceinline__ float sigmoidf_(float x) { return frcp_(1.0f + fexp_(-x)); }
__device__ __forceinline__ float siluf_(float x) { return x * frcp_(1.0f + fexp_(-x)); }
__device__ __forceinline__ float softplusf_(float x) { return x > 20.f ? x : log1pf(__expf(x)); }
__device__ __forceinline__ float geluf_(float x) { const float u = 1.5957691216057308f * (x + 0.044715f * x * x * x); return x * frcp_(1.0f + fexp_(-u)); }
__device__ __forceinline__ float dpp_xor1(float x) { return __builtin_bit_cast(float, __builtin_amdgcn_update_dpp(0, __builtin_bit_cast(int, x), 0xB1, 0xF, 0xF, true)); }
__device__ __forceinline__ float dpp_xor2(float x) { return __builtin_bit_cast(float, __builtin_amdgcn_update_dpp(0, __builtin_bit_cast(int, x), 0x4E, 0xF, 0xF, true)); }
__device__ __forceinline__ float dpp_hmir(float x) { return __builtin_bit_cast(float, __builtin_amdgcn_update_dpp(0, __builtin_bit_cast(int, x), 0x141, 0xF, 0xF, true)); }
__device__ __forceinline__ float dpp_mir(float x) { return __builtin_bit_cast(float, __builtin_amdgcn_update_dpp(0, __builtin_bit_cast(int, x), 0x140, 0xF, 0xF, true)); }
__device__ __forceinline__ float sum4_(float x) { x += dpp_xor1(x); x += dpp_xor2(x); return x; }
__device__ __forceinline__ float sum8_(float x) { x = sum4_(x); x += dpp_hmir(x); return x; }
__device__ __forceinline__ float sum16_(float x) { x = sum8_(x); x += dpp_mir(x); return x; }
typedef unsigned u2v_ __attribute__((ext_vector_type(2)));
__device__ __forceinline__ float xrow_sum_(float x) { unsigned a = __builtin_bit_cast(unsigned, x), b = a; asm volatile("" : "+v"(b));
    auto r = __builtin_amdgcn_permlane16_swap(a, b, false, false);
    x = __builtin_bit_cast(float, (unsigned)r[0]) + __builtin_bit_cast(float, (unsigned)r[1]); a = __builtin_bit_cast(unsigned, x); b = a; asm volatile("" : "+v"(b));
    auto r2 = __builtin_amdgcn_permlane32_swap(a, b, false, false);
    return __builtin_bit_cast(float, (unsigned)r2[0]) + __builtin_bit_cast(float, (unsigned)r2[1]); }
__device__ __forceinline__ float xrow_max_(float x) { unsigned a = __builtin_bit_cast(unsigned, x), b = a; asm volatile("" : "+v"(b));
    auto r = __builtin_amdgcn_permlane16_swap(a, b, false, false);
    x = fmaxf(__builtin_bit_cast(float, (unsigned)r[0]), __builtin_bit_cast(float, (unsigned)r[1])); a = __builtin_bit_cast(unsigned, x); b = a; asm volatile("" : "+v"(b));
    auto r2 = __builtin_amdgcn_permlane32_swap(a, b, false, false);
    return fmaxf(__builtin_bit_cast(float, (unsigned)r2[0]), __builtin_bit_cast(float, (unsigned)r2[1])); }
__device__ __forceinline__ u32x4 widen16_(u32x2 a, u32x2 b) { auto r0 = __builtin_amdgcn_permlane16_swap(a.x, b.x, false, false); auto r1 = __builtin_amdgcn_permlane16_swap(a.y, b.y, false, false);
    u32x4 o; o.x = (unsigned)r0[0]; o.y = (unsigned)r1[0]; o.z = (unsigned)r0[1]; o.w = (unsigned)r1[1]; return o; }
__device__ __forceinline__ float wave_sum(float v) {
    return xrow_sum_(sum16_(v));
}
__device__ __forceinline__ void sincos_rev(float ang, float& s, float& c) {
    float rev = ang * 0.15915494309189535f; rev = rev - floorf(rev);
    s = __builtin_amdgcn_sinf(rev); c = __builtin_amdgcn_cosf(rev);
}
__device__ __forceinline__ bf16x8 mk8(u32x2 lo, u32x2 hi) { u32x4 t; t.x = lo.x; t.y = lo.y; t.z = hi.x; t.w = hi.y; return __builtin_bit_cast(bf16x8, t); }
__device__ __forceinline__ bf16x8 pack8(f32x4 a, f32x4 b) { u32x4 t; t.x = pk2(a.x, a.y); t.y = pk2(a.z, a.w); t.z = pk2(b.x, b.y); t.w = pk2(b.z, b.w); return __builtin_bit_cast(bf16x8, t); }

#define XB_TMO      128
#define XB_XCNT(j)  (256  + 64 * (j))
#define XB_XSUB(j)  (1280 + 64 * (j))
#define XB_XGEN(j)  (2304 + 64 * (j))
#define XB_TOP      3328
#define XB_TOPGEN   3392
#define XCD_BAR_WORDS 3456
#define XB_SPIN_CAP (1u << 22)
__device__ __forceinline__ unsigned xb_ld(unsigned* p)              { return __hip_atomic_load(p, __ATOMIC_RELAXED, __HIP_MEMORY_SCOPE_AGENT); }
__device__ __forceinline__ unsigned xb_add(unsigned* p, unsigned v) { return __hip_atomic_fetch_add(p, v, __ATOMIC_RELAXED, __HIP_MEMORY_SCOPE_AGENT); }
__device__ __forceinline__ unsigned xb_xcc_id() { return (unsigned)__builtin_amdgcn_s_getreg((3 << 11) | 20) & 0xFu; }
#define XB_SPIN(cond, bar) do { unsigned _sp = 0; while (cond) { __builtin_amdgcn_s_sleep(1); \
    if ((++_sp & 255u) == 0u) { if (xb_ld(&(bar)[XB_TMO])) break; if (_sp > XB_SPIN_CAP) { atomicAdd(&(bar)[XB_TMO], 1u); break; } } } } while (0)
struct XcdBarrier { unsigned* bar; unsigned x; volatile LAS unsigned* st; };
__device__ __forceinline__ XcdBarrier xcd_barrier_post(unsigned* bar, volatile LAS unsigned* st) {
    XcdBarrier b; b.bar = bar; b.x = xb_xcc_id(); b.st = st;
    if (threadIdx.x == 0) (void)xb_add(&bar[XB_XCNT(b.x)], 1u);
    return b;
}
__device__ __forceinline__ void xcd_barrier_complete(unsigned* bar, unsigned x, unsigned& nloc, unsigned& nx) {
    const unsigned G = gridDim.x * gridDim.y * gridDim.z;
    unsigned sum, cnt, mine, sp = 0u;
    for (;;) {
        sum = 0u; cnt = 0u; mine = 0u;
#pragma unroll
        for (unsigned j = 0; j < 16; ++j) { const unsigned c = xb_ld(&bar[XB_XCNT(j)]); sum += c; cnt += (c > 0u) ? 1u : 0u; mine = (j == x) ? c : mine; }
        if (sum == G) break;
        __builtin_amdgcn_s_sleep(1);
        if ((++sp & 255u) == 0u) { if (xb_ld(&bar[XB_TMO])) break; if (sp > XB_SPIN_CAP) { atomicAdd(&bar[XB_TMO], 1u); break; } }
    }
    nloc = mine > 0u ? mine : 1u; nx = cnt > 0u ? cnt : 1u;
}
__device__ __forceinline__ void xcd_barrier(const XcdBarrier& b) {
    asm volatile("s_waitcnt vmcnt(0)" ::: "memory");
    __syncthreads();
    if (threadIdx.x == 0) {
        unsigned* bar = b.bar;
        __builtin_amdgcn_s_waitcnt(0);
        unsigned nloc = b.st[0], nx = b.st[1];
        if (nloc == 0u) { xcd_barrier_complete(bar, b.x, nloc, nx); b.st[0] = nloc; b.st[1] = nx; }
        const unsigned old = xb_add(&bar[XB_XSUB(b.x)], 1u);
        const unsigned gen = old / nloc;
        if (old + 1u == (gen + 1u) * nloc) {
            __builtin_amdgcn_fence(__ATOMIC_RELEASE, "agent");
            asm volatile("s_waitcnt vmcnt(0)" ::: "memory");
            const unsigned og = xb_add(&bar[XB_TOP], 1u);
            const unsigned tg = og / nx;
            if (og + 1u == (tg + 1u) * nx) xb_add(&bar[XB_TOPGEN], 1u);
            else XB_SPIN(xb_ld(&bar[XB_TOPGEN]) == tg, bar);
            __builtin_amdgcn_fence(__ATOMIC_ACQUIRE, "agent");
            xb_add(&bar[XB_XGEN(b.x)], 1u);
            asm volatile("s_waitcnt vmcnt(0)" ::: "memory");
        } else {
            XB_SPIN(xb_ld(&bar[XB_XGEN(b.x)]) == gen, bar);
            __builtin_amdgcn_fence(__ATOMIC_ACQUIRE, "agent");
            asm volatile("s_waitcnt vmcnt(0)" ::: "memory");
        }
    }
    __syncthreads();
}

namespace pg8 {
constexpr int BM = 256, BK = 64, HALF = 128, HTB = HALF * BK * 2, STAGE_BYTES = 8 * HTB, NXCD = 8, WGM = 8;
__host__ __device__ __forceinline__ int lds_byte(int r, int c) { const int st = (r >> 4) * 2 + (c >> 5), rr = r & 15, cc = c & 31, ob = rr * 64 + cc * 2; return st * 1024 + (ob ^ (((ob >> 9) & 1) << 5)); }
__host__ __device__ __forceinline__ void stage_rc(int b, int& R, int& C) { const int st = b / 1024, sb = b % 1024, swz = sb ^ (((sb >> 9) & 1) << 5); R = (st >> 1) * 16 + swz / 64; C = (st & 1) * 32 + (swz % 64) / 2; }
__host__ __device__ __forceinline__ int perm32(int rho) { const int n = rho >> 4, i = rho & 15; return 8 * (i >> 2) + 4 * n + (i & 3); }
struct Unit { int pm, pn; };
struct Gemm { const bf16_t* A; const bf16_t* Bt; int M, N, K; };
struct StaticOrder {
    int nM, nN, nwg, G, c;
    __host__ __device__ void init(int M, int N, int G_, int c_) { nM = M / BM; nN = N / BM; nwg = nM * nN; G = G_; c = c_; }
    __host__ __device__ bool next(int i, Unit& u) const {
        const long L = (long)i * G + c; if (L >= nwg) return false;
        int wgid = (int)L; { const int q = nwg / NXCD, r = nwg % NXCD, xcd = wgid % NXCD, off = wgid / NXCD; wgid = (xcd < r ? xcd * (q + 1) : r * (q + 1) + (xcd - r) * q) + off; }
        const int nig = WGM * nN, gid = wgid / nig, fm = gid * WGM, gsz = (nM - fm) < WGM ? (nM - fm) : WGM;
        u.pm = fm + ((wgid % nig) % gsz); u.pn = (wgid % nig) / gsz; return true;
    }
    __device__ __forceinline__ void a_ready(const Unit&) const {}
    __device__ __forceinline__ void done(const Unit&) const {}
};

struct OneUnit { int pm, pn;
    __device__ __forceinline__ bool next(int i, Unit& u) const { if (i) return false; u.pm = pm; u.pn = pn; return true; }
    __device__ __forceinline__ void a_ready(const Unit&) const {}
    __device__ __forceinline__ void done(const Unit&) const {}
};
constexpr int SCALE_TBL = STAGE_BYTES;
template <class Sched> __device__ __forceinline__ void scale_table(LAS unsigned char* lds, const Sched& S, const float* part, int tid) {
    Unit u;
#pragma unroll 1
    for (int i = 0; i < 8 && S.next(i, u); ++i)
        if (tid < 256) { const f32x4* pp = (const f32x4*)(part + (size_t)(u.pm * BM + tid) * 16); const f32x4 a = pp[0], b = pp[1], c = pp[2], d = pp[3];
            const float s = ((a.x + a.y) + (a.z + a.w)) + ((b.x + b.y) + (b.z + b.w)) + ((c.x + c.y) + (c.z + c.w)) + ((d.x + d.y) + (d.z + d.w));
            ((LAS float*)(lds + SCALE_TBL))[i * 256 + tid] = frsq_(s * (1.0f / 1024.0f) + EPS); }
    __syncthreads();
}
template <int ACT> struct EpiScaleBf16 {
    static constexpr bool PERM = true, AFTER_DRAIN = false;
    bf16_t* O; int ldc; const float* part;
    __device__ __forceinline__ void operator()(const f32x4 (&acc)[2][2][4][2], const Unit& u, int wr, int wc, int fr, int fq, int ui, LAS unsigned char* lds) const {
        const int row0 = u.pm * BM + wr * 64 + fr, col0 = u.pn * BM + wc * 32 + 8 * fq;
        float sc[2][4];
#pragma unroll
        for (int ai = 0; ai < 2; ++ai)
#pragma unroll
            for (int m = 0; m < 4; ++m) sc[ai][m] = part ? ((const LAS float*)(lds + SCALE_TBL))[ui * 256 + wr * 64 + ai * HALF + m * 16 + fr] : 1.0f;
#pragma unroll
        for (int ai = 0; ai < 2; ++ai)
#pragma unroll
            for (int m = 0; m < 4; ++m) {
                const int row = row0 + ai * HALF + m * 16; const float s1 = sc[ai][m];
                bf16_t* rowp = O + (size_t)row * ldc + col0;
#pragma unroll
                for (int bj = 0; bj < 2; ++bj) { f32x4 v0 = acc[ai][bj][m][0] * s1, v1 = acc[ai][bj][m][1] * s1;
                    if (ACT == 1) {
#pragma unroll
                        for (int j = 0; j < 4; ++j) { const float a0 = fmaxf(v0[j], 0.f), a1 = fmaxf(v1[j], 0.f); v0[j] = a0 * a0; v1[j] = a1 * a1; } }
                    u32x4 w; w.x = pk2(v0[0], v0[1]); w.y = pk2(v0[2], v0[3]); w.z = pk2(v1[0], v1[1]); w.w = pk2(v1[2], v1[3]);
                    *(u32x4*)(rowp + bj * HALF) = w; }
            }
    }
};
constexpr int QT_ROW = 264;
struct EpiScaleLds {
    static constexpr bool PERM = true, AFTER_DRAIN = true;
    const float* part;
    __device__ __forceinline__ void drained(const f32x4 (&acc)[2][2][4][2], const Unit& u, int wr, int wc, int fr, int fq, LAS unsigned char* lds) const {
        const int row0 = wr * 64 + fr, col0 = wc * 32 + 8 * fq;
#pragma unroll
        for (int ai = 0; ai < 2; ++ai)
#pragma unroll
            for (int m = 0; m < 4; ++m) {
                const int rl = row0 + ai * HALF + m * 16, row = u.pm * BM + rl;
                const f32x4 a = *((const f32x4*)(part + (size_t)row * 16) + fq);
                float s = (a.x + a.y) + (a.z + a.w); s = xrow_sum_(s);
                const float sc = frsq_(s * (1.0f / 1024.0f) + EPS);
#pragma unroll
                for (int bj = 0; bj < 2; ++bj) { const f32x4 v0 = acc[ai][bj][m][0] * sc, v1 = acc[ai][bj][m][1] * sc;
                    u32x4 w; w.x = pk2(v0[0], v0[1]); w.y = pk2(v0[2], v0[3]); w.z = pk2(v1[0], v1[1]); w.w = pk2(v1[2], v1[3]);
                    *(LAS u32x4*)(lds + (rl * QT_ROW + col0 + bj * HALF) * 2) = w; }
            }
    }
};
struct EpiResid {
    static constexpr bool PERM = true, AFTER_DRAIN = false;
    bf16_t* XB; float* part; float alpha;
    __device__ __forceinline__ void operator()(const f32x4 (&acc)[2][2][4][2], const Unit& u, int wr, int wc, int fr, int fq, int ui, LAS unsigned char* lds) const {
        const int row0 = u.pm * BM + wr * 64 + fr, col0 = u.pn * BM + wc * 32 + 8 * fq;
#pragma unroll
        for (int ai = 0; ai < 2; ++ai) {
            u32x4 xw[4][2];
#pragma unroll
            for (int m = 0; m < 4; ++m)
#pragma unroll
                for (int bj = 0; bj < 2; ++bj) xw[m][bj] = *(const u32x4*)(XB + (size_t)(row0 + ai * HALF + m * 16) * DM + col0 + bj * HALF);
#pragma unroll
            for (int m = 0; m < 4; ++m) {
                const int row = row0 + ai * HALF + m * 16;
                bf16_t* bp = XB + (size_t)row * DM + col0;
                float ss = 0.f;
#pragma unroll
                for (int bj = 0; bj < 2; ++bj) { const u32x4 x4 = xw[m][bj];
                    const f32x4 v0 = (f32x4){bflo(x4.x), bfhi(x4.x), bflo(x4.y), bfhi(x4.y)} + acc[ai][bj][m][0] * alpha;
                    const f32x4 v1 = (f32x4){bflo(x4.z), bfhi(x4.z), bflo(x4.w), bfhi(x4.w)} + acc[ai][bj][m][1] * alpha;
                    ss += ((v0.x * v0.x + v0.y * v0.y) + (v0.z * v0.z + v0.w * v0.w)) + ((v1.x * v1.x + v1.y * v1.y) + (v1.z * v1.z + v1.w * v1.w));
                    u32x4 w; w.x = pk2(v0.x, v0.y); w.y = pk2(v0.z, v0.w); w.z = pk2(v1.x, v1.y); w.w = pk2(v1.z, v1.w); *(u32x4*)(bp + bj * HALF) = w; }
                ss = xrow_sum_(ss);
                if (fq == 0) part[(size_t)row * 16 + u.pn * 4 + wc] = ss;
            }
        }
    }
};

template <class Epi, class Sched>
__device__ __forceinline__ void gemm_phase(LAS unsigned char* lds, const Gemm g, const Sched& S, const Epi& E, const int tid) {
    const int wid = __builtin_amdgcn_readfirstlane(tid >> 6), lane = tid & 63, wr = wid >> 2, wc = wid & 3, fr = lane & 15, fq = lane >> 4;
    const int K = g.K, nt = K / BK;
    unsigned voffA[2], voffB[2];
#pragma unroll
    for (int i = 0; i < 2; ++i) { int R, C; stage_rc(tid * 16 + i * 8192, R, C); const int Rb = Epi::PERM ? ((R & ~31) + perm32(R & 31)) : R;
        voffA[i] = (unsigned)(R * K + C) * 2u; voffB[i] = (unsigned)(Rb * K + C) * 2u; }
    const size_t kstep = (size_t)(BK * 2);
    const size_t hstep = (size_t)HALF * K * 2;
    const size_t tstep = 2 * hstep;
    const unsigned ldsw = (unsigned)wid * 1024u;
    const int aoff = lds_byte(wr * 64 + fr, fq * 8), boff = lds_byte(wc * 32 + fr, fq * 8);
#define PG8_SA(b, h) (((b) * 2 + (h)) * HTB)
#define PG8_SB(b, h) ((4 + (b) * 2 + (h)) * HTB)
#define PG8_STAGE(bufoff, gbase, voff) do { _Pragma("unroll") for (int _i = 0; _i < 2; ++_i) \
        __builtin_amdgcn_global_load_lds((const unsigned*)((const char*)(gbase) + (voff)[_i]), (LAS unsigned*)(lds + (bufoff) + ldsw + _i * 8192), 16, 0, 0); } while (0)
#define PG8_LDA(dst, b, h) do { _Pragma("unroll") for (int m = 0; m < 4; ++m) _Pragma("unroll") for (int k = 0; k < 2; ++k) dst[m][k] = *(const LAS bf16x8*)(lds + PG8_SA(b, h) + aoff + m * 2048 + k * 1024); } while (0)
#define PG8_LDB(dst, b, h) do { _Pragma("unroll") for (int n = 0; n < 2; ++n) _Pragma("unroll") for (int k = 0; k < 2; ++k) dst[n][k] = *(const LAS bf16x8*)(lds + PG8_SB(b, h) + boff + n * 2048 + k * 1024); } while (0)
#define PG8_MMA(ai, bj, At, Bt) do { __builtin_amdgcn_s_setprio(1); _Pragma("unroll") for (int m = 0; m < 4; ++m) _Pragma("unroll") for (int n = 0; n < 2; ++n) _Pragma("unroll") for (int k = 0; k < 2; ++k) \
        acc[ai][bj][m][n] = __builtin_amdgcn_mfma_f32_16x16x32_bf16(Bt[n][k], At[m][k], acc[ai][bj][m][n], 0, 0, 0); __builtin_amdgcn_s_setprio(0); } while (0)
#define PG8_WAIT_V(n) asm volatile("s_waitcnt vmcnt(" #n ")" ::: "memory")
#define PG8_WAIT_L(n) asm volatile("s_waitcnt lgkmcnt(" #n ")" ::: "memory")
#define PG8_BAR __builtin_amdgcn_s_barrier()
#define PG8_SCHED __builtin_amdgcn_sched_barrier(0)
    Unit cur, nxt; int ui = 0;
    if (!S.next(0, cur)) return;
    f32x4 acc[2][2][4][2];
#pragma unroll
    for (int a = 0; a < 2; ++a)
#pragma unroll
        for (int b = 0; b < 2; ++b)
#pragma unroll
            for (int m = 0; m < 4; ++m)
#pragma unroll
                for (int n = 0; n < 2; ++n) acc[a][b][m][n] = (f32x4){0.f, 0.f, 0.f, 0.f};
    bf16x8 At[4][2], B0[2][2], B1[2][2];
    const char* cA = (const char*)g.A + (size_t)cur.pm * tstep; const char* cB = (const char*)g.Bt + (size_t)cur.pn * tstep;
    S.a_ready(cur);
    PG8_STAGE(PG8_SB(0, 0), cB, voffB); PG8_STAGE(PG8_SA(0, 0), cA, voffA); PG8_STAGE(PG8_SB(0, 1), cB + hstep, voffB); PG8_STAGE(PG8_SA(0, 1), cA + hstep, voffA);
    if (wr == 1) PG8_BAR;
    PG8_WAIT_V(4); PG8_BAR;
    PG8_STAGE(PG8_SB(1, 0), cB + kstep, voffB); PG8_STAGE(PG8_SA(1, 0), cA + kstep, voffA); PG8_STAGE(PG8_SB(1, 1), cB + hstep + kstep, voffB);
    PG8_WAIT_V(6); PG8_BAR;
    for (;;) {
        const bool has_next = S.next(ui + 1, nxt);
        const char* nA = has_next ? (const char*)g.A + (size_t)nxt.pm * tstep : cA; const char* nB = has_next ? (const char*)g.Bt + (size_t)nxt.pn * tstep : cB;
        for (int t = 0; t < nt; t += 2) {
            const bool last = (t == nt - 2);
            const char* a1 = cA + (size_t)(t + 1) * kstep;
            const char* a2 = last ? nA : cA + (size_t)(t + 2) * kstep; const char* b2 = last ? nB : cB + (size_t)(t + 2) * kstep;
            const char* a3 = a2 + kstep; const char* b3 = b2 + kstep;
            if (last && has_next) S.a_ready(nxt);
            PG8_LDB(B0, 0, 0); PG8_SCHED; PG8_LDA(At, 0, 0); PG8_STAGE(PG8_SA(1, 1), a1 + hstep, voffA);
            PG8_WAIT_L(8); PG8_BAR; PG8_WAIT_L(0); PG8_MMA(0, 0, At, B0); PG8_BAR; PG8_SCHED;
            PG8_LDB(B1, 0, 1); PG8_STAGE(PG8_SB(0, 0), b2, voffB);
            PG8_BAR; PG8_WAIT_L(0); PG8_MMA(0, 1, At, B1); PG8_BAR;
            PG8_LDA(At, 0, 1); PG8_STAGE(PG8_SA(0, 0), a2, voffA);
            PG8_BAR; PG8_WAIT_L(0); PG8_MMA(1, 0, At, B0); PG8_BAR; PG8_SCHED;
            PG8_STAGE(PG8_SB(0, 1), b2 + hstep, voffB);
            PG8_WAIT_V(6); PG8_BAR; PG8_MMA(1, 1, At, B1); PG8_BAR;
            PG8_LDB(B0, 1, 0); PG8_SCHED; PG8_LDA(At, 1, 0); PG8_STAGE(PG8_SA(0, 1), a2 + hstep, voffA);
            PG8_WAIT_L(8); PG8_BAR; PG8_WAIT_L(0); PG8_MMA(0, 0, At, B0); PG8_BAR; PG8_SCHED;
            PG8_LDB(B1, 1, 1); PG8_STAGE(PG8_SB(1, 0), b3, voffB);
            PG8_BAR; PG8_WAIT_L(0); PG8_MMA(0, 1, At, B1); PG8_BAR;
            PG8_LDA(At, 1, 1); PG8_STAGE(PG8_SA(1, 0), a3, voffA);
            PG8_BAR; PG8_WAIT_L(0); PG8_MMA(1, 0, At, B0); PG8_BAR; PG8_SCHED;
            PG8_STAGE(PG8_SB(1, 1), b3 + hstep, voffB);
            PG8_WAIT_V(6); PG8_BAR; PG8_MMA(1, 1, At, B1); PG8_BAR;
        }
        if constexpr (!Epi::AFTER_DRAIN) { E(acc, cur, wr, wc, fr, fq, ui, lds); S.done(cur); }
        if (!has_next) break;
#pragma unroll
        for (int a = 0; a < 2; ++a)
#pragma unroll
            for (int b = 0; b < 2; ++b)
#pragma unroll
                for (int m = 0; m < 4; ++m)
#pragma unroll
                    for (int n = 0; n < 2; ++n) acc[a][b][m][n] = (f32x4){0.f, 0.f, 0.f, 0.f};
        cur = nxt; cA = nA; cB = nB; ++ui;
    }
    PG8_WAIT_V(0);
    if (wr == 0) PG8_BAR;
    PG8_BAR;
    if constexpr (Epi::AFTER_DRAIN) { E.drained(acc, cur, wr, wc, fr, fq, lds); S.done(cur); }
#undef PG8_SA
#undef PG8_SB
#undef PG8_STAGE
#undef PG8_LDA
#undef PG8_LDB
#undef PG8_MMA
#undef PG8_WAIT_V
#undef PG8_WAIT_L
#undef PG8_BAR
#undef PG8_SCHED
}
}

struct Params {
    const float* x; const float* mem; const int* pos;
    const float* norm_mix; const float* w_in; const float* ret_gn;
    const float* lru_conv_w; const float* lru_conv_b; const float* lru_wa; const float* lru_ba; const float* lru_wx; const float* lru_bx; const float* lru_lambda;
    const float* mla_q_norm; const float* mla_w_uq; const float* mla_kv_norm; const float* mla_w_ukv;
    const float* gdn_conv_w; const float* gdn_a_log; const float* gdn_dt_bias; const float* gdn_norm;
    const float* w_out; const float* norm_xattn; const float* norm_mem; const float* xa_wq; const float* xa_wkv; const float* xa_wo;
    const float* norm_mlp; const float* mlp_w1; const float* mlp_w2; const float* final_norm;
    float* out; unsigned char* ws;
    int ph_lo, ph_hi;
};

__device__ __forceinline__ bf16_t* wl(const Params& P, int l, size_t off) { return (bf16_t*)(P.ws + WS_W) + (size_t)l * W_LAYER + off; }

struct WTile { const float* src; const float* gain; bf16_t* dst; int K, N, kb, nb; float scale; };
__device__ __forceinline__ WTile p0_decode(const Params& P, int it) {
    constexpr int T_IN = 16 * 48, T_SQ = 256, T_KV = 512, T_W1 = 1024, T_W2 = 1024, T_UQ = 18, T_UKV = 16, T_LRU = 8;
    constexpr int T_LAYER = T_IN + 3 * T_SQ + T_KV + T_W1 + T_W2 + T_UQ + T_UKV + T_LRU;
    const int l = it / T_LAYER; int r = it % T_LAYER; int nnb; WTile t; t.gain = nullptr; t.scale = 1.f;
    if (r < T_IN) { t.src = P.w_in + (size_t)l * DM * IN_COLS; t.K = DM; t.N = IN_COLS; nnb = 48; t.gain = P.norm_mix + l * DM; t.dst = wl(P, l, W_IN); }
    else if ((r -= T_IN) < T_SQ) { t.src = P.w_out + (size_t)l * DM * DM; t.K = DM; t.N = DM; nnb = 16; t.dst = wl(P, l, W_OUT); }
    else if ((r -= T_SQ) < T_SQ) { t.src = P.xa_wq + (size_t)l * DM * DM; t.K = DM; t.N = DM; nnb = 16; t.gain = P.norm_xattn + l * DM; t.scale = 0.0625f * LOG2E; t.dst = wl(P, l, W_Q); }
    else if ((r -= T_SQ) < T_KV) { t.src = P.xa_wkv + (size_t)l * DM * 2 * DM; t.K = DM; t.N = 2 * DM; nnb = 32; t.gain = P.norm_mem + l * DM; t.dst = wl(P, l, W_KV); }
    else if ((r -= T_KV) < T_SQ) { t.src = P.xa_wo + (size_t)l * DM * DM; t.K = DM; t.N = DM; nnb = 16; t.dst = wl(P, l, W_O); }
    else if ((r -= T_SQ) < T_W1) { t.src = P.mlp_w1 + (size_t)l * DM * DFF; t.K = DM; t.N = DFF; nnb = 64; t.gain = P.norm_mlp + l * DM; t.dst = wl(P, l, W_1); }
    else if ((r -= T_W1) < T_W2) { t.src = P.mlp_w2 + (size_t)l * DFF * DM; t.K = DFF; t.N = DM; nnb = 16; t.dst = wl(P, l, W_2); }
    else if ((r -= T_W2) < T_UQ) { t.src = P.mla_w_uq + (size_t)l * 192 * 384; t.K = 192; t.N = 384; nnb = 6; t.gain = P.mla_q_norm + l * 192; t.dst = wl(P, l, W_UQ); }
    else if ((r -= T_UQ) < T_UKV) { t.src = P.mla_w_ukv + (size_t)l * 128 * 512; t.K = 128; t.N = 512; nnb = 8; t.gain = P.mla_kv_norm + l * 128; t.dst = wl(P, l, W_UKV); }
    else { r -= T_UKV; const int which = r >> 2, nb4 = r & 3; t.src = (which ? P.lru_wx : P.lru_wa) + (size_t)l * 4 * 4096 + nb4 * 4096; t.K = 64; t.N = 64; nnb = 1; t.dst = wl(P, l, which ? W_X : W_A) + nb4 * 4096; r = 0; }
    t.kb = r / nnb; t.nb = r % nnb; return t;
}
__device__ __forceinline__ void p0_fetch(const WTile& t, int tid, f32x4 (&v)[2]) {
#pragma unroll
    for (int i = 0; i < 2; ++i) { const int kk = (tid >> 4) + 32 * i, k = t.kb * 64 + kk, n = t.nb * 64 + (tid & 15) * 4;
        f32x4 x = {0.f, 0.f, 0.f, 0.f}; float g = t.scale;
        if (n < t.N) { x = *(const f32x4*)(t.src + (size_t)k * t.N + n); if (t.gain) g *= t.gain[k]; }
        v[i] = x * g; }
}
__device__ __forceinline__ void p0_prologue(const Params& P, LAS unsigned char* lds, int tid) {
    LAS float* scr = (LAS float*)lds;
    constexpr int NT = 2 * (16 * 48 + 3 * 256 + 512 + 1024 + 1024 + 18 + 16 + 8);
    int it = blockIdx.x;
    if (it < NT) {
        WTile cur = p0_decode(P, it); f32x4 v[2]; p0_fetch(cur, tid, v);
        for (;;) {
#pragma unroll
            for (int i = 0; i < 2; ++i) { LAS float* d = scr + ((tid >> 4) + 32 * i) * 65 + (tid & 15) * 4; d[0] = v[i].x; d[1] = v[i].y; d[2] = v[i].z; d[3] = v[i].w; }
            const int nxt = it + gridDim.x; const bool more = nxt < NT;
            WTile nx = cur; if (more) { nx = p0_decode(P, nxt); p0_fetch(nx, tid, v); }
            __syncthreads();
            { const int nl = tid >> 3, k0 = (tid & 7) * 8; const LAS float* s = scr + k0 * 65 + nl;
              u32x4 o; o.x = pk2(s[0], s[65]); o.y = pk2(s[2 * 65], s[3 * 65]); o.z = pk2(s[4 * 65], s[5 * 65]); o.w = pk2(s[6 * 65], s[7 * 65]);
              *(u32x4*)(cur.dst + (size_t)(cur.nb * 64 + nl) * cur.K + cur.kb * 64 + k0) = o; }
            __syncthreads();
            if (!more) break;
            cur = nx; it = nxt;
        }
    }
    const int wave = tid >> 6, lane = tid & 63;
    const int gw = blockIdx.x * 8 + wave, ngw = gridDim.x * 8;
    bf16_t* xb = (bf16_t*)(P.ws + WS_XB); float* part = (float*)(P.ws + WS_PART); bf16_t* memn = (bf16_t*)(P.ws + WS_GDN);
    constexpr int NR = T_TOK + NBATCH * NMEM;
    for (int row0 = gw; row0 < NR; row0 += 2 * ngw) {
        f32x4 v[2][4]; const int row1 = row0 + ngw; const bool has1 = row1 < NR;
#pragma unroll
        for (int q = 0; q < 2; ++q) { const int row = q ? (has1 ? row1 : row0) : row0; const bool isx = row < T_TOK; const int r2 = isx ? row : row - T_TOK;
            const f32x4* src = (const f32x4*)((isx ? P.x : P.mem) + (size_t)r2 * DM) + lane;
#pragma unroll
            for (int j = 0; j < 4; ++j) v[q][j] = src[64 * j]; }
#pragma unroll
        for (int q = 0; q < 2; ++q) { if (q && !has1) break; const int row = q ? row1 : row0; const bool isx = row < T_TOK; const int r2 = isx ? row : row - T_TOK;
            float s = 0.f;
#pragma unroll
            for (int j = 0; j < 4; ++j) s += (v[q][j].x * v[q][j].x + v[q][j].y * v[q][j].y) + (v[q][j].z * v[q][j].z + v[q][j].w * v[q][j].w);
            s = wave_sum(s);
            if (isx) { u32x2* ob = (u32x2*)(xb + (size_t)row * DM) + lane;
#pragma unroll
                for (int j = 0; j < 4; ++j) { u32x2 w; w.x = pk2(v[q][j].x, v[q][j].y); w.y = pk2(v[q][j].z, v[q][j].w); ob[64 * j] = w; }
                if (lane < 16) part[(size_t)row * 16 + lane] = lane == 0 ? s : 0.f;
            } else { const float rs = frsq_(s * (1.0f / 1024.0f) + EPS); u32x2* ob = (u32x2*)(memn + (size_t)r2 * DM) + lane;
#pragma unroll
                for (int j = 0; j < 4; ++j) { u32x2 w; w.x = pk2(v[q][j].x * rs, v[q][j].y * rs); w.y = pk2(v[q][j].z * rs, v[q][j].w * rs); ob[64 * j] = w; } }
        }
    }
}
__device__ __forceinline__ void final_norm_phase(const Params& P, int tid) {
    const int wave = tid >> 6, lane = tid & 63; const float* part = (const float*)(P.ws + WS_PART); const bf16_t* xb = (const bf16_t*)(P.ws + WS_XB);
    f32x4 g[4];
#pragma unroll
    for (int j = 0; j < 4; ++j) g[j] = ((const f32x4*)P.final_norm)[64 * j + lane];
    const int ngw = gridDim.x * 8;
    for (int row0 = blockIdx.x * 8 + wave; row0 < T_TOK; row0 += 4 * ngw) {
        u32x2 w[4][4]; float s[4];
#pragma unroll
        for (int q = 0; q < 4; ++q) { const int row = row0 + q * ngw; s[q] = lane < 16 ? part[(size_t)row * 16 + lane] : 0.f;
            const u32x2* xi = (const u32x2*)(xb + (size_t)row * DM) + lane;
#pragma unroll
            for (int j = 0; j < 4; ++j) w[q][j] = xi[64 * j]; }
#pragma unroll
        for (int q = 0; q < 4; ++q) { const int row = row0 + q * ngw;
            const float rs = frsq_(wave_sum(s[q]) * (1.0f / 1024.0f) + EPS);
            f32x4* o = (f32x4*)(P.out + (size_t)row * DM) + lane;
#pragma unroll
            for (int j = 0; j < 4; ++j) o[64 * j] = (f32x4){bflo(w[q][j].x), bfhi(w[q][j].x), bflo(w[q][j].y), bfhi(w[q][j].y)} * rs * g[j]; }
    }
}
__device__ __forceinline__ void mla_pre_tile(const Params& P, int l, int rt, int lane) {
    const int fr = lane & 15, fq = lane >> 4;
    const bf16_t* z = (const bf16_t*)(P.ws + WS_R);
    bf16_t* Qo = (bf16_t*)((unsigned char*)P.out + MLA_Q_OFF); bf16_t* Ko = (bf16_t*)((unsigned char*)P.out + MLA_K_OFF); bf16_t* Vo = (bf16_t*)((unsigned char*)P.out + MLA_VT_OFF);
    const bf16_t* Wuq = wl(P, l, W_UQ); const bf16_t* Wukv = wl(P, l, W_UKV);
    const int tok0 = rt * 16, b = tok0 >> 11, s0 = tok0 & 2047;
    const bf16_t* zr = z + (size_t)(tok0 + fr) * ZP;
    bf16x8 cq[6], ckv[4]; float sq = 0.f, skv = 0.f;
#pragma unroll
    for (int s = 0; s < 6; ++s) { const u32x4 w = *(const u32x4*)(zr + Z_CQ + 32 * s + 8 * fq); cq[s] = __builtin_bit_cast(bf16x8, w);
        sq += bflo(w.x) * bflo(w.x) + bfhi(w.x) * bfhi(w.x) + bflo(w.y) * bflo(w.y) + bfhi(w.y) * bfhi(w.y) + bflo(w.z) * bflo(w.z) + bfhi(w.z) * bfhi(w.z) + bflo(w.w) * bflo(w.w) + bfhi(w.w) * bfhi(w.w); }
#pragma unroll
    for (int s = 0; s < 4; ++s) { const u32x4 w = *(const u32x4*)(zr + Z_CKV + 32 * s + 8 * fq); ckv[s] = __builtin_bit_cast(bf16x8, w);
        skv += bflo(w.x) * bflo(w.x) + bfhi(w.x) * bfhi(w.x) + bflo(w.y) * bflo(w.y) + bfhi(w.y) * bfhi(w.y) + bflo(w.z) * bflo(w.z) + bfhi(w.z) * bfhi(w.z) + bflo(w.w) * bflo(w.w) + bfhi(w.w) * bfhi(w.w); }
    sq = xrow_sum_(sq); skv = xrow_sum_(skv);
    const float rq = frsq_(sq * (1.0f / 192.0f) + EPS), rkv = frsq_(skv * (1.0f / 128.0f) + EPS);
    const float qsc = rq * 0.10206207261596575f * LOG2E;
    const float pos = (float)P.pos[tok0 + fr];
    float sn[4], cs[4];
#pragma unroll
    for (int r = 0; r < 4; ++r) { const float invf = exp2f(-(float)(4 * fq + r) * (13.287712379549449f / 16.0f)); sincos_rev(pos * invf, sn[r], cs[r]); }
    const size_t tokrow = (size_t)b * 4 * SEQ + (s0 + fr);
#pragma unroll 1
    for (int h = 0; h < 4; ++h) {
        bf16_t* qrow = Qo + (tokrow + (size_t)h * SEQ) * 96;
#pragma unroll 1
        for (int nt = 0; nt < 4; ++nt) { f32x4 a = {0.f, 0.f, 0.f, 0.f};
#pragma unroll
            for (int s = 0; s < 6; ++s) { const bf16x8 wf = *(const bf16x8*)(Wuq + (size_t)(h * 96 + nt * 16 + fr) * 192 + 32 * s + 8 * fq); a = mfma16(wf, cq[s], a); }
            a = a * qsc; u32x2 w; w.x = pk2(a.x, a.y); w.y = pk2(a.z, a.w); *(u32x2*)(qrow + nt * 16 + 4 * fq) = w; }
        f32x4 x1 = {0.f, 0.f, 0.f, 0.f}, x2 = {0.f, 0.f, 0.f, 0.f}, y1, y2;
#pragma unroll
        for (int s = 0; s < 6; ++s) { const bf16x8 wf1 = *(const bf16x8*)(Wuq + (size_t)(h * 96 + 64 + fr) * 192 + 32 * s + 8 * fq), wf2 = *(const bf16x8*)(Wuq + (size_t)(h * 96 + 80 + fr) * 192 + 32 * s + 8 * fq);
            x1 = mfma16(wf1, cq[s], x1); x2 = mfma16(wf2, cq[s], x2); }
        x1 = x1 * qsc; x2 = x2 * qsc;
#pragma unroll
        for (int r = 0; r < 4; ++r) { y1[r] = x1[r] * cs[r] - x2[r] * sn[r]; y2[r] = x1[r] * sn[r] + x2[r] * cs[r]; }
        { u32x2 w; w.x = pk2(y1.x, y1.y); w.y = pk2(y1.z, y1.w); *(u32x2*)(qrow + 64 + 4 * fq) = w; w.x = pk2(y2.x, y2.y); w.y = pk2(y2.z, y2.w); *(u32x2*)(qrow + 80 + 4 * fq) = w; }
    }
    u32x2 kr1, kr2;
    { const u32x2 a = *(const u32x2*)(zr + Z_KR + 4 * fq), c = *(const u32x2*)(zr + Z_KR + 16 + 4 * fq);
      const float x1[4] = {bflo(a.x), bfhi(a.x), bflo(a.y), bfhi(a.y)}, x2[4] = {bflo(c.x), bfhi(c.x), bflo(c.y), bfhi(c.y)}; float y1[4], y2[4];
#pragma unroll
      for (int r = 0; r < 4; ++r) { y1[r] = x1[r] * cs[r] - x2[r] * sn[r]; y2[r] = x1[r] * sn[r] + x2[r] * cs[r]; }
      kr1.x = pk2(y1[0], y1[1]); kr1.y = pk2(y1[2], y1[3]); kr2.x = pk2(y2[0], y2[1]); kr2.y = pk2(y2[2], y2[3]); }
    float rkv_r[4];
#pragma unroll
    for (int r = 0; r < 4; ++r) rkv_r[r] = __shfl(rkv, 4 * fq + r);
    const int chunk = s0 >> 6, key0 = (s0 & 63) + 4 * fq;
#pragma unroll 1
    for (int h = 0; h < 4; ++h) {
        bf16_t* krow = Ko + (tokrow + (size_t)h * SEQ) * 96;
#pragma unroll 1
        for (int nt = 0; nt < 4; ++nt) { f32x4 a = {0.f, 0.f, 0.f, 0.f};
#pragma unroll
            for (int s = 0; s < 4; ++s) { const bf16x8 wf = *(const bf16x8*)(Wukv + (size_t)(h * 128 + nt * 16 + fr) * 128 + 32 * s + 8 * fq); a = mfma16(wf, ckv[s], a); }
            a = a * rkv; u32x2 w; w.x = pk2(a.x, a.y); w.y = pk2(a.z, a.w); *(u32x2*)(krow + nt * 16 + 4 * fq) = w; }
        *(u32x2*)(krow + 64 + 4 * fq) = kr1; *(u32x2*)(krow + 80 + 4 * fq) = kr2;
        bf16_t* vt = Vo + ((size_t)((b * 4 + h) * NCHUNK + chunk) * 64) * 64;
#pragma unroll 1
        for (int nt = 0; nt < 4; ++nt) { f32x4 a = {0.f, 0.f, 0.f, 0.f};
#pragma unroll
            for (int s = 0; s < 4; ++s) { const bf16x8 wf = *(const bf16x8*)(Wukv + (size_t)(h * 128 + 64 + nt * 16 + fr) * 128 + 32 * s + 8 * fq); a = mfma16(ckv[s], wf, a); }
            u32x2 w; w.x = pk2(a.x * rkv_r[0], a.y * rkv_r[1]); w.y = pk2(a.z * rkv_r[2], a.w * rkv_r[3]);
            *(u32x2*)(vt + (size_t)(nt * 16 + fr) * 64 + key0) = w; }
    }
}

constexpr int MP_UQ_ROW = 200, MP_UKV_ROW = 136, MP_UKV_OFF = 96 * MP_UQ_ROW * 2, MP_BUF = MP_UKV_OFF + 128 * MP_UKV_ROW * 2;
__device__ __forceinline__ void mla_pre_item(const Params& P, int l, LAS unsigned char* lds, int it, int tid, int wave, int lane) {
    const int fr = lane & 15, fq = lane >> 4, rt = it * 8 + wave;
    const bf16_t* z = (const bf16_t*)(P.ws + WS_R);
    bf16_t* Qo = (bf16_t*)((unsigned char*)P.out + MLA_Q_OFF); bf16_t* Ko = (bf16_t*)((unsigned char*)P.out + MLA_K_OFF); bf16_t* Vo = (bf16_t*)((unsigned char*)P.out + MLA_VT_OFF);
    const bf16_t* Wuq = wl(P, l, W_UQ); const bf16_t* Wukv = wl(P, l, W_UKV);
    u32x4 stg[5];
#define MP_LOADQ(h_) do { _Pragma("unroll") for (int i = 0; i < 5; ++i) { const int p = tid + 512 * i; if (p < 2304) stg[i] = *(const u32x4*)(Wuq + (size_t)(h_) * 96 * 192 + (size_t)p * 8); } } while (0)
#define MP_STOREQ(buf_) do { _Pragma("unroll") for (int i = 0; i < 5; ++i) { const int p = tid + 512 * i; if (p < 2304) { const int row = p / 24, pc = p % 24; *(LAS u32x4*)(lds + (buf_) * MP_BUF + (row * MP_UQ_ROW + pc * 8) * 2) = stg[i]; } } } while (0)
#define MP_LOADKV(h_) do { _Pragma("unroll") for (int i = 0; i < 4; ++i) { const int p = tid + 512 * i; stg[i] = *(const u32x4*)(Wukv + (size_t)(h_) * 128 * 128 + (size_t)p * 8); } } while (0)
#define MP_STOREKV(buf_) do { _Pragma("unroll") for (int i = 0; i < 4; ++i) { const int p = tid + 512 * i, row = p >> 4, pc = p & 15; *(LAS u32x4*)(lds + (buf_) * MP_BUF + MP_UKV_OFF + (row * MP_UKV_ROW + pc * 8) * 2) = stg[i]; } } while (0)
    MP_LOADQ(0); MP_STOREQ(0); MP_LOADKV(0);
    const int tok0 = rt * 16, b = tok0 >> 11, s0 = tok0 & 2047;
    const bf16_t* zr = z + (size_t)(tok0 + fr) * ZP;
    bf16x8 cq[6], ckv[4]; float sq = 0.f, skv = 0.f;
#pragma unroll
    for (int s = 0; s < 6; ++s) { const u32x4 w = *(const u32x4*)(zr + Z_CQ + 32 * s + 8 * fq); cq[s] = __builtin_bit_cast(bf16x8, w);
        sq += bflo(w.x) * bflo(w.x) + bfhi(w.x) * bfhi(w.x) + bflo(w.y) * bflo(w.y) + bfhi(w.y) * bfhi(w.y) + bflo(w.z) * bflo(w.z) + bfhi(w.z) * bfhi(w.z) + bflo(w.w) * bflo(w.w) + bfhi(w.w) * bfhi(w.w); }
#pragma unroll
    for (int s = 0; s < 4; ++s) { const u32x4 w = *(const u32x4*)(zr + Z_CKV + 32 * s + 8 * fq); ckv[s] = __builtin_bit_cast(bf16x8, w);
        skv += bflo(w.x) * bflo(w.x) + bfhi(w.x) * bfhi(w.x) + bflo(w.y) * bflo(w.y) + bfhi(w.y) * bfhi(w.y) + bflo(w.z) * bflo(w.z) + bfhi(w.z) * bfhi(w.z) + bflo(w.w) * bflo(w.w) + bfhi(w.w) * bfhi(w.w); }
    const u32x2 kra = *(const u32x2*)(zr + Z_KR + 4 * fq), krc = *(const u32x2*)(zr + Z_KR + 16 + 4 * fq);
    const float pos = (float)P.pos[tok0 + fr];
    MP_STOREKV(0);
    sq = xrow_sum_(sq); skv = xrow_sum_(skv);
    const float rq = frsq_(sq * (1.0f / 192.0f) + EPS), rkv = frsq_(skv * (1.0f / 128.0f) + EPS);
    const float qsc = rq * 0.10206207261596575f * LOG2E;
    float sn[4], cs[4];
#pragma unroll
    for (int r = 0; r < 4; ++r) { const float invf = exp2f(-(float)(4 * fq + r) * (13.287712379549449f / 16.0f)); sincos_rev(pos * invf, sn[r], cs[r]); }
    const size_t tokrow = (size_t)b * 4 * SEQ + (s0 + fr);
    u32x2 kr1, kr2;
    { const float x1[4] = {bflo(kra.x), bfhi(kra.x), bflo(kra.y), bfhi(kra.y)}, x2[4] = {bflo(krc.x), bfhi(krc.x), bflo(krc.y), bfhi(krc.y)}; float y1[4], y2[4];
#pragma unroll
      for (int r = 0; r < 4; ++r) { y1[r] = x1[r] * cs[r] - x2[r] * sn[r]; y2[r] = x1[r] * sn[r] + x2[r] * cs[r]; }
      kr1.x = pk2(y1[0], y1[1]); kr1.y = pk2(y1[2], y1[3]); kr2.x = pk2(y2[0], y2[1]); kr2.y = pk2(y2[2], y2[3]); }
    float rkv_r[4];
#pragma unroll
    for (int r = 0; r < 4; ++r) rkv_r[r] = __shfl(rkv, 4 * fq + r);
    const u32x4 kr16 = widen16_(kr1, kr2);
    const int chunk = s0 >> 6, key0 = (s0 & 63) + 4 * fq;
    __syncthreads();
#pragma unroll 1
    for (int h = 0; h < 4; ++h) {
        if (h < 3) MP_LOADQ(h + 1);
        const LAS bf16_t* UQ = (const LAS bf16_t*)(lds + (h & 1) * MP_BUF); const LAS bf16_t* UKV = (const LAS bf16_t*)(lds + (h & 1) * MP_BUF + MP_UKV_OFF);
        bf16_t* qrow = Qo + (tokrow + (size_t)h * SEQ) * 96; bf16_t* krow = Ko + (tokrow + (size_t)h * SEQ) * 96;
        bf16_t* vt = Vo + ((size_t)((b * 4 + h) * NCHUNK + chunk) * 64) * 64;
        const int wsel = fq & 1, woff = (fq >> 1) * 8;
#pragma unroll 1
        for (int np = 0; np < 2; ++np) { f32x4 a = {0.f, 0.f, 0.f, 0.f}, a2 = {0.f, 0.f, 0.f, 0.f};
#pragma unroll
            for (int s = 0; s < 6; ++s) { a = mfma16(*(const LAS bf16x8*)(UQ + (np * 32 + fr) * MP_UQ_ROW + 32 * s + 8 * fq), cq[s], a); a2 = mfma16(*(const LAS bf16x8*)(UQ + (np * 32 + 16 + fr) * MP_UQ_ROW + 32 * s + 8 * fq), cq[s], a2); }
            a = a * qsc; a2 = a2 * qsc; u32x2 w, w2; w.x = pk2(a.x, a.y); w.y = pk2(a.z, a.w); w2.x = pk2(a2.x, a2.y); w2.y = pk2(a2.z, a2.w);
            *(u32x4*)(qrow + (np * 2 + wsel) * 16 + woff) = widen16_(w, w2); }
        {   f32x4 x1 = {0.f, 0.f, 0.f, 0.f}, x2 = {0.f, 0.f, 0.f, 0.f}, y1, y2;
#pragma unroll
            for (int s = 0; s < 6; ++s) { x1 = mfma16(*(const LAS bf16x8*)(UQ + (64 + fr) * MP_UQ_ROW + 32 * s + 8 * fq), cq[s], x1); x2 = mfma16(*(const LAS bf16x8*)(UQ + (80 + fr) * MP_UQ_ROW + 32 * s + 8 * fq), cq[s], x2); }
            x1 = x1 * qsc; x2 = x2 * qsc;
#pragma unroll
            for (int r = 0; r < 4; ++r) { y1[r] = x1[r] * cs[r] - x2[r] * sn[r]; y2[r] = x1[r] * sn[r] + x2[r] * cs[r]; }
            u32x2 w, w2; w.x = pk2(y1.x, y1.y); w.y = pk2(y1.z, y1.w); w2.x = pk2(y2.x, y2.y); w2.y = pk2(y2.z, y2.w);
            *(u32x4*)(qrow + 64 + wsel * 16 + woff) = widen16_(w, w2); }
        if (h < 3) { MP_STOREQ((h + 1) & 1); MP_LOADKV(h + 1); }
#pragma unroll 1
        for (int np = 0; np < 2; ++np) { f32x4 a = {0.f, 0.f, 0.f, 0.f}, a2 = {0.f, 0.f, 0.f, 0.f};
#pragma unroll
            for (int s = 0; s < 4; ++s) { a = mfma16(*(const LAS bf16x8*)(UKV + (np * 32 + fr) * MP_UKV_ROW + 32 * s + 8 * fq), ckv[s], a); a2 = mfma16(*(const LAS bf16x8*)(UKV + (np * 32 + 16 + fr) * MP_UKV_ROW + 32 * s + 8 * fq), ckv[s], a2); }
            a = a * rkv; a2 = a2 * rkv; u32x2 w, w2; w.x = pk2(a.x, a.y); w.y = pk2(a.z, a.w); w2.x = pk2(a2.x, a2.y); w2.y = pk2(a2.z, a2.w);
            *(u32x4*)(krow + (np * 2 + wsel) * 16 + woff) = widen16_(w, w2); }
        *(u32x4*)(krow + 64 + wsel * 16 + woff) = kr16;
#pragma unroll 1
        for (int np = 0; np < 2; ++np) { f32x4 a = {0.f, 0.f, 0.f, 0.f}, a2 = {0.f, 0.f, 0.f, 0.f};
#pragma unroll
            for (int s = 0; s < 4; ++s) { a = mfma16(ckv[s], *(const LAS bf16x8*)(UKV + (64 + np * 32 + fr) * MP_UKV_ROW + 32 * s + 8 * fq), a); a2 = mfma16(ckv[s], *(const LAS bf16x8*)(UKV + (64 + np * 32 + 16 + fr) * MP_UKV_ROW + 32 * s + 8 * fq), a2); }
            u32x2 w, w2; w.x = pk2(a.x * rkv_r[0], a.y * rkv_r[1]); w.y = pk2(a.z * rkv_r[2], a.w * rkv_r[3]); w2.x = pk2(a2.x * rkv_r[0], a2.y * rkv_r[1]); w2.y = pk2(a2.z * rkv_r[2], a2.w * rkv_r[3]);
            *(u32x4*)(vt + (size_t)((np * 2 + wsel) * 16 + fr) * 64 + (s0 & 63) + woff) = widen16_(w, w2); }
        if (h < 3) MP_STOREKV((h + 1) & 1);
        __syncthreads();
    }
#undef MP_LOADQ
#undef MP_STOREQ
#undef MP_LOADKV
#undef MP_STOREKV
}

template <int DQK, int DV, int KT, int QT>
__device__ __forceinline__ void flash_item(LAS unsigned char* lds, const bf16_t* Qw, int ldq, const bf16_t* Kb, int ldk, const bf16_t* VTb, int ldv, int vts,
                                           bf16_t* Ow, int ldo, int ntiles, int wave_limit, int tid, int lane) {
    constexpr int KROW = DQK + 8, VROW = KT + 8, KS = DQK / 32, ET = DV / 16, NKT = KT / 16, KBYTES = KT * KROW * 2, BUF = KBYTES + DV * VROW * 2;
    constexpr int KP = KT * DQK / 8, VPR = KT / 8, VP = DV * VPR, NKP = (KP + 511) / 512, NVP = (VP + 511) / 512, NP = NKP > NVP ? NKP : NVP;
    const int fr = lane & 15, fq = lane >> 4;
    bf16x8 qf[QT][KS];
#pragma unroll
    for (int qi = 0; qi < QT; ++qi)
#pragma unroll
        for (int s = 0; s < KS; ++s) qf[qi][s] = *(const bf16x8*)(Qw + (size_t)(qi * 16 + fr) * ldq + 32 * s + 8 * fq);
    f32x4 ot[QT][ET];
#pragma unroll
    for (int qi = 0; qi < QT; ++qi)
#pragma unroll
        for (int e = 0; e < ET; ++e) ot[qi][e] = (f32x4){0.f, 0.f, 0.f, 0.f};
    float m_run[QT], l_run[QT];
#pragma unroll
    for (int qi = 0; qi < QT; ++qi) { m_run[qi] = -1e30f; l_run[qi] = 0.f; }
    u32x4 preg[NP];
#define FL_LOADK(j_) do { _Pragma("unroll") for (int i = 0; i < NKP; ++i) { const int idx = tid + i * 512; if (idx < KP) { const int row = idx / (DQK / 8), pc = idx % (DQK / 8); \
            preg[i] = *(const u32x4*)(Kb + (size_t)((j_) * KT + row) * ldk + pc * 8); } } } while (0)
#define FL_LOADV(j_) do { _Pragma("unroll") for (int i = 0; i < NVP; ++i) { const int idx = tid + i * 512; if (idx < VP) { const int row = idx / VPR, pc = idx % VPR; \
            preg[i] = *(const u32x4*)(VTb + (size_t)(j_) * vts + (size_t)row * ldv + pc * 8); } } } while (0)
#define FL_STOREK(buf_) do { LAS bf16_t* Kt_ = (LAS bf16_t*)(lds + (buf_) * BUF); \
        _Pragma("unroll") for (int i = 0; i < NKP; ++i) { const int idx = tid + i * 512; if (idx < KP) { const int row = idx / (DQK / 8), pc = idx % (DQK / 8); *(LAS u32x4*)(Kt_ + row * KROW + pc * 8) = preg[i]; } } } while (0)
#define FL_STOREV(buf_) do { LAS bf16_t* Vt_ = (LAS bf16_t*)(lds + (buf_) * BUF + KBYTES); \
        _Pragma("unroll") for (int i = 0; i < NVP; ++i) { const int idx = tid + i * 512; if (idx < VP) { const int row = idx / VPR, pc = idx % VPR; *(LAS u32x4*)(Vt_ + row * VROW + pc * 8) = preg[i]; } } } while (0)
    FL_LOADK(0); FL_STOREK(0); FL_LOADV(0); FL_STOREV(0);
    __syncthreads();
#pragma unroll 1
    for (int j = 0; j < ntiles; ++j) {
        const bool more = j + 1 < ntiles, act = j < wave_limit;
        const LAS bf16_t* Kt = (const LAS bf16_t*)(lds + (j & 1) * BUF); const LAS bf16_t* Vt = (const LAS bf16_t*)(lds + (j & 1) * BUF + KBYTES);
        if (more) FL_LOADK(j + 1);
        f32x4 st[QT][NKT];
        if (act) {
#pragma unroll
            for (int kt = 0; kt < NKT; ++kt) {
#pragma unroll
                for (int qi = 0; qi < QT; ++qi) st[qi][kt] = (f32x4){0.f, 0.f, 0.f, 0.f};
#pragma unroll
                for (int s = 0; s < KS; ++s) { const bf16x8 kf = *(const LAS bf16x8*)(Kt + (kt * 16 + fr) * KROW + 32 * s + 8 * fq);
#pragma unroll
                    for (int qi = 0; qi < QT; ++qi) st[qi][kt] = mfma16(kf, qf[qi][s], st[qi][kt]); } }
        }
        if (more) { FL_STOREK((j + 1) & 1); FL_LOADV(j + 1); }
        if (act) {
            bf16x8 pf[QT][NKT / 2];
#pragma unroll
            for (int qi = 0; qi < QT; ++qi) {
                float mx = fmaxf(fmaxf(st[qi][0].x, st[qi][0].y), fmaxf(st[qi][0].z, st[qi][0].w));
#pragma unroll
                for (int kt = 1; kt < NKT; ++kt) mx = fmaxf(mx, fmaxf(fmaxf(st[qi][kt].x, st[qi][kt].y), fmaxf(st[qi][kt].z, st[qi][kt].w)));
                mx = xrow_max_(mx);
                const float m_new = fmaxf(m_run[qi], mx), alpha = fexp2_(m_run[qi] - m_new);
                float ls = 0.f;
#pragma unroll
                for (int kt = 0; kt < NKT; ++kt)
#pragma unroll
                    for (int r = 0; r < 4; ++r) { const float p = fexp2_(st[qi][kt][r] - m_new); st[qi][kt][r] = p; ls += p; }
                l_run[qi] = l_run[qi] * alpha + ls; m_run[qi] = m_new;
#pragma unroll
                for (int e = 0; e < ET; ++e) ot[qi][e] = ot[qi][e] * alpha;
#pragma unroll
                for (int k2 = 0; k2 < NKT / 2; ++k2) pf[qi][k2] = pack8(st[qi][2 * k2], st[qi][2 * k2 + 1]);
            }
#pragma unroll
            for (int e = 0; e < ET; ++e) {
                const LAS bf16_t* vr = Vt + (e * 16 + fr) * VROW + 4 * fq;
#pragma unroll
                for (int k2 = 0; k2 < NKT / 2; ++k2) { const bf16x8 v0 = mk8(*(const LAS u32x2*)(vr + 32 * k2), *(const LAS u32x2*)(vr + 32 * k2 + 16));
#pragma unroll
                    for (int qi = 0; qi < QT; ++qi) ot[qi][e] = mfma16(v0, pf[qi][k2], ot[qi][e]); }
            }
        }
        if (more) FL_STOREV((j + 1) & 1);
        __syncthreads();
    }
#undef FL_LOADK
#undef FL_LOADV
#undef FL_STOREK
#undef FL_STOREV
#pragma unroll
    for (int qi = 0; qi < QT; ++qi) {
        float l = l_run[qi]; l = xrow_sum_(l);
        const float inv = frcp_(l);
#pragma unroll
        for (int e2 = 0; e2 < ET / 2; ++e2) { u32x2 w, w2;
            w.x = pk2(ot[qi][2 * e2].x * inv, ot[qi][2 * e2].y * inv); w.y = pk2(ot[qi][2 * e2].z * inv, ot[qi][2 * e2].w * inv);
            w2.x = pk2(ot[qi][2 * e2 + 1].x * inv, ot[qi][2 * e2 + 1].y * inv); w2.y = pk2(ot[qi][2 * e2 + 1].z * inv, ot[qi][2 * e2 + 1].w * inv);
            *(u32x4*)(Ow + (size_t)(qi * 16 + fr) * ldo + (2 * e2 + (fq & 1)) * 16 + (fq >> 1) * 8) = widen16_(w, w2); }
    }
}
__device__ __forceinline__ void mla_attn_item(const Params& P, LAS unsigned char* lds, int it, int tid, int wave, int lane) {
    const int qt = 7 - (it >> 6), bh = it & 63;
    const bf16_t* Q = (const bf16_t*)((unsigned char*)P.out + MLA_Q_OFF) + ((size_t)bh * SEQ + qt * 256 + wave * 32) * 96;
    const bf16_t* K = (const bf16_t*)((unsigned char*)P.out + MLA_K_OFF) + (size_t)bh * SEQ * 96;
    const bf16_t* VT = (const bf16_t*)((unsigned char*)P.out + MLA_VT_OFF) + (size_t)bh * NCHUNK * 4096;
    bf16_t* y = (bf16_t*)(P.ws + WS_R + R_Y) + ((size_t)(bh >> 2) * SEQ + qt * 256 + wave * 32) * DM + 512 + (bh & 3) * 64;
    flash_item<96, 64, 64, 2>(lds, Q, 96, K, 96, VT, 64, 4096, y, DM, 4 * qt + 4, 4 * qt + (wave >> 1) + 1, tid, lane);
}
constexpr int XA_KROW = 264, XA_VROW = 72, XA_KBUF = 32 * XA_KROW * 2, XA_VBUF = 128 * XA_VROW * 2, XA_VOFF = 2 * XA_KBUF;
__device__ __forceinline__ void xa_item(const Params& P, int l, LAS unsigned char* lds, int it, int tid, int wave, int lane) {
    const int qt = it & 7, h = (it >> 3) & 3, b = it >> 5, fr = lane & 15, fq = lane >> 4;
    const size_t qoff = ((size_t)b * SEQ + qt * 256 + wave * 32) * DM + h * 256;
    bf16_t* O = (bf16_t*)(P.ws + WS_R + R_OX) + qoff;
    const bf16_t* Kb = (const bf16_t*)(P.ws + WS_KVM + (size_t)l * KVM_LAYER) + (size_t)b * NMEM * DM + h * 256;
    const bf16_t* VTb = (const bf16_t*)(P.ws + WS_KVM + (size_t)l * KVM_LAYER + (size_t)4096 * 1024 * 2) + (size_t)h * 256 * 4096 + b * NMEM;
    u32x4 stg[2];
#define XA_LOADK(j_) do { _Pragma("unroll") for (int i = 0; i < 2; ++i) { const int p = tid + 512 * i, row = p >> 5, pc = p & 31; stg[i] = *(const u32x4*)(Kb + (size_t)((j_) * 32 + row) * DM + pc * 8); } } while (0)
#define XA_STOREK(buf_) do { _Pragma("unroll") for (int i = 0; i < 2; ++i) { const int p = tid + 512 * i, row = p >> 5, pc = p & 31; *(LAS u32x4*)(lds + (buf_) * XA_KBUF + (row * XA_KROW + pc * 8) * 2) = stg[i]; } } while (0)
#define XA_LOADV(t_) do { _Pragma("unroll") for (int i = 0; i < 2; ++i) { const int p = tid + 512 * i, row = p >> 3, pc = p & 7; stg[i] = *(const u32x4*)(VTb + (size_t)(((t_) >> 2) * 128 + row) * 4096 + ((t_) & 3) * 64 + pc * 8); } } while (0)
#define XA_STOREV(buf_) do { _Pragma("unroll") for (int i = 0; i < 2; ++i) { const int p = tid + 512 * i, row = p >> 3, pc = p & 7; *(LAS u32x4*)(lds + XA_VOFF + (buf_) * XA_VBUF + (row * XA_VROW + pc * 8) * 2) = stg[i]; } } while (0)
    XA_LOADK(0);
    bf16x8 pf[2][8];
    float linv[2], c1[2];
    {
        bf16x8 qf[2][8];
#pragma unroll
        for (int qi = 0; qi < 2; ++qi)
#pragma unroll
            for (int s = 0; s < 8; ++s) qf[qi][s] = *(const LAS bf16x8*)(lds + ((wave * 32 + qi * 16 + fr) * pg8::QT_ROW + 32 * s + 8 * fq) * 2);
        asm volatile("s_waitcnt lgkmcnt(0)" ::: "memory");
        __syncthreads();
        XA_STOREK(0);
        __syncthreads();
        float m1[2], l1[2];
#pragma unroll
        for (int half = 0; half < 2; ++half) {
            f32x4 S[2][8];
#pragma unroll
            for (int jj = 0; jj < 4; ++jj) { const int j = half * 4 + jj;
                if (j < 7) XA_LOADK(j + 1); else XA_LOADV(0);
                const LAS bf16_t* Kt = (const LAS bf16_t*)(lds + (j & 1) * XA_KBUF);
#pragma unroll
                for (int kt = 0; kt < 2; ++kt) {
                    f32x4 a0 = {0.f, 0.f, 0.f, 0.f}, a1 = {0.f, 0.f, 0.f, 0.f};
#pragma unroll
                    for (int s = 0; s < 8; ++s) { const bf16x8 kf = *(const LAS bf16x8*)(Kt + (kt * 16 + fr) * XA_KROW + 32 * s + 8 * fq); a0 = mfma16(kf, qf[0][s], a0); a1 = mfma16(kf, qf[1][s], a1); }
                    S[0][2 * jj + kt] = a0; S[1][2 * jj + kt] = a1; __builtin_amdgcn_sched_barrier(0); }
                if (j < 7) XA_STOREK((j + 1) & 1); else XA_STOREV(0);
                __syncthreads();
            }
#pragma unroll
            for (int qi = 0; qi < 2; ++qi) {
                float mx = -1e30f;
#pragma unroll
                for (int t = 0; t < 8; ++t) mx = fmaxf(mx, fmaxf(fmaxf(S[qi][t].x, S[qi][t].y), fmaxf(S[qi][t].z, S[qi][t].w)));
                mx = xrow_max_(mx);
                if (half == 1) { const float m = fmaxf(m1[qi], mx); c1[qi] = fexp2_(m1[qi] - m); mx = m; }
                float ls = 0.f;
#pragma unroll
                for (int t = 0; t < 4; ++t) { f32x4 pa, pb;
#pragma unroll
                    for (int r = 0; r < 4; ++r) { pa[r] = fexp2_(S[qi][2 * t][r] - mx); pb[r] = fexp2_(S[qi][2 * t + 1][r] - mx); }
                    ls += ((pa.x + pa.y) + (pa.z + pa.w)) + ((pb.x + pb.y) + (pb.z + pb.w));
                    pf[qi][half * 4 + t] = pack8(pa, pb);
                    asm volatile("" : "+v"(ls)); }
                ls = xrow_sum_(ls);
                if (half == 0) { m1[qi] = mx; l1[qi] = ls; } else linv[qi] = frcp_(l1[qi] * c1[qi] + ls);
            }
        }
    }
#pragma unroll
    for (int eh = 0; eh < 2; ++eh) {
        f32x4 ot[2][8];
#pragma unroll
        for (int qi = 0; qi < 2; ++qi)
#pragma unroll
            for (int e = 0; e < 8; ++e) ot[qi][e] = (f32x4){0.f, 0.f, 0.f, 0.f};
#pragma unroll
        for (int jv = 0; jv < 4; ++jv) { const int t = eh * 4 + jv;
            if (t < 7) XA_LOADV(t + 1);
            const LAS bf16_t* Vt = (const LAS bf16_t*)(lds + XA_VOFF + (t & 1) * XA_VBUF);
#pragma unroll
            for (int e = 0; e < 8; ++e) { const LAS bf16_t* vr = Vt + (e * 16 + fr) * XA_VROW + 4 * fq;
                const bf16x8 v0 = mk8(*(const LAS u32x2*)vr, *(const LAS u32x2*)(vr + 16)), v1 = mk8(*(const LAS u32x2*)(vr + 32), *(const LAS u32x2*)(vr + 48));
                ot[0][e] = mfma16(v0, pf[0][2 * jv], ot[0][e]); ot[1][e] = mfma16(v0, pf[1][2 * jv], ot[1][e]);
                ot[0][e] = mfma16(v1, pf[0][2 * jv + 1], ot[0][e]); ot[1][e] = mfma16(v1, pf[1][2 * jv + 1], ot[1][e]); if (e & 1) __builtin_amdgcn_sched_barrier(0); }
            if (jv == 1) {
#pragma unroll
                for (int e = 0; e < 8; ++e) { ot[0][e] = ot[0][e] * c1[0]; ot[1][e] = ot[1][e] * c1[1]; } }
            if (t < 7) XA_STOREV((t + 1) & 1);
            __syncthreads();
        }
#pragma unroll
        for (int qi = 0; qi < 2; ++qi)
#pragma unroll
            for (int e2 = 0; e2 < 4; ++e2) { u32x2 w, w2; const float li = linv[qi];
                w.x = pk2(ot[qi][2 * e2].x * li, ot[qi][2 * e2].y * li); w.y = pk2(ot[qi][2 * e2].z * li, ot[qi][2 * e2].w * li);
                w2.x = pk2(ot[qi][2 * e2 + 1].x * li, ot[qi][2 * e2 + 1].y * li); w2.y = pk2(ot[qi][2 * e2 + 1].z * li, ot[qi][2 * e2 + 1].w * li);
                *(u32x4*)(O + (size_t)(qi * 16 + fr) * DM + eh * 128 + (2 * e2 + (fq & 1)) * 16 + (fq >> 1) * 8) = widen16_(w, w2); }
    }
#undef XA_LOADK
#undef XA_STOREK
#undef XA_LOADV
#undef XA_STOREV
}
constexpr int GP_KN = 0, GP_KB = 9216, GP_QN = 18432, GP_L = 9216, GP_RHS = 27648, GP_G = 60416, GP_GC = 60672, GP_EK = 60928, GP_HEAD = 61440, GP_CW = 2 * 61440;
__device__ __forceinline__ bf16_t* gdn_buf(const Params& P, int chh, int k) { return (bf16_t*)(P.ws + WS_GDN) + ((size_t)chh * 5 + k) * 4096; }
__device__ __forceinline__ void gdn_pre_item(const Params& P, int l, LAS unsigned char* lds, int it, int tid) {
    const int hp = it & 1, n = (it >> 1) & 31, b = it >> 6;
    const int hh = tid >> 8, h = 2 * hp + hh, tt = tid & 255, c = tt >> 2, qr = tt & 3, lane = tid & 63;
    LAS unsigned char* L = lds + hh * GP_HEAD;
    const bf16_t* z = (const bf16_t*)(P.ws + WS_R);
    const int s = n * 64 + c; const size_t tok = (size_t)b * SEQ + s;
    const int chh = (b * NCHUNK + n) * 4 + h;
    float q[16], k[16], v[16];
    u32x4 zw[3][4][2];
#pragma unroll
    for (int part = 0; part < 3; ++part)
#pragma unroll
        for (int kk = 0; kk < 4; ++kk) { const bf16_t* zr = (s - 3 + kk >= 0) ? z + (tok - 3 + kk) * ZP + Z_GQKV + part * 256 + h * 64 + qr * 16 : z + tok * ZP + IN_COLS;
            zw[part][kk][0] = *(const u32x4*)zr; zw[part][kk][1] = *(const u32x4*)(zr + 8); }
    const bf16_t* zt = z + tok * ZP;
    const float beta_raw = bf2f(zt[Z_GB + h]), a_raw = bf2f(zt[Z_GA + h]);
    __builtin_amdgcn_sched_barrier(0);
    const LAS float* CW = (const LAS float*)(lds + GP_CW);
#pragma unroll
    for (int part = 0; part < 3; ++part) {
        float* dst = part == 0 ? q : (part == 1 ? k : v);
        const int ch0 = part * 256 + h * 64 + qr * 16;
#pragma unroll
        for (int i = 0; i < 16; ++i) dst[i] = 0.f;
#pragma unroll
        for (int kk = 0; kk < 4; ++kk) {
            const u32x4 w0 = zw[part][kk][0], w1 = zw[part][kk][1];
            const LAS float* wr = CW + kk * 768 + ch0; const f32x4 c0 = *(const LAS f32x4*)wr, c1 = *(const LAS f32x4*)(wr + 4), c2 = *(const LAS f32x4*)(wr + 8), c3 = *(const LAS f32x4*)(wr + 12);
            dst[0] += c0.x * bflo(w0.x); dst[1] += c0.y * bfhi(w0.x); dst[2] += c0.z * bflo(w0.y); dst[3] += c0.w * bfhi(w0.y);
            dst[4] += c1.x * bflo(w0.z); dst[5] += c1.y * bfhi(w0.z); dst[6] += c1.z * bflo(w0.w); dst[7] += c1.w * bfhi(w0.w);
            dst[8] += c2.x * bflo(w1.x); dst[9] += c2.y * bfhi(w1.x); dst[10] += c2.z * bflo(w1.y); dst[11] += c2.w * bfhi(w1.y);
            dst[12] += c3.x * bflo(w1.z); dst[13] += c3.y * bfhi(w1.z); dst[14] += c3.z * bflo(w1.w); dst[15] += c3.w * bfhi(w1.w); }
#pragma unroll
        for (int i = 0; i < 16; ++i) dst[i] = siluf_(dst[i]);
    }
    float sq = 0.f, sk = 0.f;
#pragma unroll
    for (int i = 0; i < 16; ++i) { sq += q[i] * q[i]; sk += k[i] * k[i]; }
    sq = sum4_(sq); sk = sum4_(sk);
    const float rq = frsq_(sq + EPS) * 0.125f, rk = frsq_(sk + EPS);
    const float beta = sigmoidf_(beta_raw);
    const float g = -fexp_(P.gdn_a_log[l * 4 + h]) * softplusf_(a_raw + P.gdn_dt_bias[l * 4 + h]);
    {
        u32x4 w0, w1;
#define PK16(dst0, dst1, src, sc) do { dst0.x = pk2(src[0] * (sc), src[1] * (sc)); dst0.y = pk2(src[2] * (sc), src[3] * (sc)); dst0.z = pk2(src[4] * (sc), src[5] * (sc)); dst0.w = pk2(src[6] * (sc), src[7] * (sc)); \
        dst1.x = pk2(src[8] * (sc), src[9] * (sc)); dst1.y = pk2(src[10] * (sc), src[11] * (sc)); dst1.z = pk2(src[12] * (sc), src[13] * (sc)); dst1.w = pk2(src[14] * (sc), src[15] * (sc)); } while (0)
        PK16(w0, w1, k, rk);        *(LAS u32x4*)(L + GP_KN + (c * 72 + qr * 16) * 2) = w0; *(LAS u32x4*)(L + GP_KN + (c * 72 + qr * 16 + 8) * 2) = w1;
        PK16(w0, w1, k, rk * beta); *(LAS u32x4*)(L + GP_KB + (c * 72 + qr * 16) * 2) = w0; *(LAS u32x4*)(L + GP_KB + (c * 72 + qr * 16 + 8) * 2) = w1;
        PK16(w0, w1, q, rq);        *(LAS u32x4*)(L + GP_QN + (c * 72 + qr * 16) * 2) = w0; *(LAS u32x4*)(L + GP_QN + (c * 72 + qr * 16 + 8) * 2) = w1;
        LAS float* rhs = (LAS float*)(L + GP_RHS) + c * 128 + qr * 16;
#pragma unroll
        for (int i = 0; i < 4; ++i) *(LAS f32x4*)(rhs + 4 * i) = (f32x4){v[4 * i] * beta, v[4 * i + 1] * beta, v[4 * i + 2] * beta, v[4 * i + 3] * beta};
        if (qr == 0) ((LAS float*)(L + GP_G))[c] = g;
    }
    __syncthreads();
    {
        float gc = 0.f, run = 0.f; const LAS float* G = (const LAS float*)(L + GP_G);
#pragma unroll 16
        for (int i = 0; i < 64; ++i) { run += G[i]; gc = (i == c) ? run : gc; }
        const float eg = fexp_(gc), ek = fexp_(run - gc);
        LAS float* rhs = (LAS float*)(L + GP_RHS) + c * 128 + 64 + qr * 16;
#pragma unroll
        for (int i = 0; i < 4; ++i) *(LAS f32x4*)(rhs + 4 * i) = (f32x4){k[4 * i] * rk * beta * eg, k[4 * i + 1] * rk * beta * eg, k[4 * i + 2] * rk * beta * eg, k[4 * i + 3] * rk * beta * eg};
        u32x4 w0, w1; PK16(w0, w1, q, rq * eg);
        bf16_t* qd = gdn_buf(P, chh, 3) + c * 64 + qr * 16; *(u32x4*)qd = w0; *(u32x4*)(qd + 8) = w1;
        if (qr == 0) { ((LAS float*)(L + GP_GC))[c] = gc; ((LAS float*)(L + GP_EK))[c] = ek; }
        if (tt == 0) ((float*)(P.ws + WS_GL))[chh] = fexp_(run);
    }
#undef PK16
    __syncthreads();
    {
        const int it4 = (tid >> 6) & 3, fr = lane & 15, fq = lane >> 4;
        const LAS bf16_t* Kn = (const LAS bf16_t*)(L + GP_KN); const LAS bf16_t* KB = (const LAS bf16_t*)(L + GP_KB); const LAS bf16_t* Qn = (const LAS bf16_t*)(L + GP_QN);
        const LAS float* GC = (const LAS float*)(L + GP_GC);
        const bf16x8 a0 = *(const LAS bf16x8*)(KB + (it4 * 16 + fr) * 72 + 8 * fq), a1 = *(const LAS bf16x8*)(KB + (it4 * 16 + fr) * 72 + 32 + 8 * fq);
        const bf16x8 q0 = *(const LAS bf16x8*)(Qn + (it4 * 16 + fr) * 72 + 8 * fq), q1 = *(const LAS bf16x8*)(Qn + (it4 * 16 + fr) * 72 + 32 + 8 * fq);
        float gci[4];
#pragma unroll
        for (int r = 0; r < 4; ++r) gci[r] = GC[it4 * 16 + 4 * fq + r];
        {
            const int d = tt >> 2, cq = tt & 3; const LAS float* EK = (const LAS float*)(L + GP_EK);
            unsigned wv[8];
#pragma unroll
            for (int i = 0; i < 8; ++i) { const int c0 = cq * 16 + 2 * i; wv[i] = pk2(bf2f(Kn[c0 * 72 + d]) * EK[c0], bf2f(Kn[(c0 + 1) * 72 + d]) * EK[c0 + 1]); }
            bf16_t* kd = gdn_buf(P, chh, 4) + d * 64 + cq * 16;
            *(u32x4*)kd = (u32x4){wv[0], wv[1], wv[2], wv[3]}; *(u32x4*)(kd + 8) = (u32x4){wv[4], wv[5], wv[6], wv[7]};
        }
        f32x4 lv[4], av[4];
#pragma unroll
        for (int jt = 0; jt < 4; ++jt) {
            const bf16x8 b0 = *(const LAS bf16x8*)(Kn + (jt * 16 + fr) * 72 + 8 * fq), b1 = *(const LAS bf16x8*)(Kn + (jt * 16 + fr) * 72 + 32 + 8 * fq);
            f32x4 al = {0.f, 0.f, 0.f, 0.f}, aa = {0.f, 0.f, 0.f, 0.f};
            al = mfma16(a0, b0, al); al = mfma16(a1, b1, al); aa = mfma16(q0, b0, aa); aa = mfma16(q1, b1, aa);
            const int j = jt * 16 + fr; const float gcj = GC[j];
#pragma unroll
            for (int r = 0; r < 4; ++r) { const int i = it4 * 16 + 4 * fq + r; const float dec = fexp_(fminf(gci[r] - gcj, 0.f));
                lv[jt][r] = (i > j) ? al[r] * dec : 0.f; av[jt][r] = (i >= j) ? aa[r] * dec : 0.f; }
        }
        __syncthreads();
        LAS float* Lm = (LAS float*)(L + GP_L); LAS bf16_t* ATl = (LAS bf16_t*)(L + GP_KN);
#pragma unroll
        for (int jt = 0; jt < 4; ++jt)
#pragma unroll
            for (int r = 0; r < 4; ++r) { Lm[(it4 * 16 + 4 * fq + r) * 64 + (fr & 1) * 32 + jt * 8 + (fr >> 1)] = lv[jt][r];
                ATl[(it4 * 16 + 4 * fq + r) * 72 + jt * 16 + fr] = f2bf(av[jt][r]); }
    }
    __syncthreads();
    {
        bf16_t* att = gdn_buf(P, chh, 2);
#pragma unroll
        for (int i = 0; i < 2; ++i) { const int pz = tt + 256 * i, row = pz >> 3, pc = pz & 7; *(u32x4*)(att + row * 64 + pc * 8) = *(const LAS u32x4*)(L + GP_KN + (row * 72 + pc * 8) * 2); }
    }
    {
        const int col = tt >> 1, p = tt & 1;
        const LAS float* Lp = (const LAS float*)(L + GP_L) + p * 32; const LAS float* rhs = (const LAS float*)(L + GP_RHS) + col;
        float xs[32];
#pragma unroll
        for (int k = 0; k < 32; ++k) xs[k] = 0.f;
#pragma unroll
        for (int ib = 0; ib < 4; ++ib) {
            float rv[16];
#pragma unroll
            for (int t = 0; t < 16; ++t) rv[t] = rhs[(ib * 16 + t) * 128];
#pragma unroll
            for (int t = 0; t < 16; ++t) { const int i = ib * 16 + t;
                float a0 = 0.f, a1 = 0.f;
#pragma unroll
                for (int k4 = 0; k4 < ((i + 1) / 2 + 3) / 4; ++k4) { const f32x4 lr = *(const LAS f32x4*)(Lp + i * 64 + 4 * k4);
                    a0 += lr.x * xs[4 * k4 + 0]; a1 += lr.y * xs[4 * k4 + 1]; a0 += lr.z * xs[4 * k4 + 2]; a1 += lr.w * xs[4 * k4 + 3]; }
                float acc = a0 + a1; acc += dpp_xor1(acc);
                const float xi = rv[t] - acc;
                xs[i >> 1] = (p == (i & 1)) ? xi : xs[i >> 1];
            }
        }
        if (col < 64) {
            bf16_t* ut = gdn_buf(P, chh, 1) + col * 64 + 32 * p;
            unsigned wv[16];
#pragma unroll
            for (int k = 0; k < 32; ++k) { const float other = dpp_xor1(xs[k]);
                const float lo = p ? other : xs[k], hi = p ? xs[k] : other;
                if ((k >> 4) == 0) { if (p == 0) wv[k & 15] = pk2(lo, hi); } else { if (p == 1) wv[k & 15] = pk2(lo, hi); } }
#pragma unroll
            for (int g4 = 0; g4 < 4; ++g4) *(u32x4*)(ut + 8 * g4) = (u32x4){wv[4 * g4], wv[4 * g4 + 1], wv[4 * g4 + 2], wv[4 * g4 + 3]};
        } else { bf16_t* wo = gdn_buf(P, chh, 0) + (col - 64) + p * 64;
#pragma unroll
            for (int k = 0; k < 32; ++k) wo[k * 128] = f2bf(xs[k]); }
    }
    __syncthreads();
}

constexpr int GC_W = 0, GC_UT = 9216, GC_ATT = 18432, GC_QD = 27648, GC_KDT = 36864, GC_ST = 46080, GC_VNT = 55296, GC_BH = 64512;
__device__ __forceinline__ bf16x8 ldsA(const LAS unsigned char* M, int row, int s, int fq) { return *(const LAS bf16x8*)(M + row * 144 + 64 * s + 16 * fq); }
__device__ __forceinline__ void gdn_chain_item(const Params& P, int l, LAS unsigned char* lds, int gi, int tid, int wave, int lane) {
    const int q2 = wave >> 2, bh = gi * 2 + q2, ct = wave & 3, b = bh >> 2, h = bh & 3, fr = lane & 15, fq = lane >> 4;
    const bf16_t* z = (const bf16_t*)(P.ws + WS_R); bf16_t* y = (bf16_t*)(P.ws + WS_R + R_Y);
    LAS unsigned char* L = lds + q2 * GC_BH;
    f32x4 ng[4];
#pragma unroll
    for (int et = 0; et < 4; ++et) ng[et] = *(const f32x4*)(P.gdn_norm + l * 64 + et * 16 + 4 * fq);
    u32x4 stg[10];
    const bf16_t* src0[2] = { gdn_buf(P, ((gi * 2 >> 2) * NCHUNK) * 4 + ((gi * 2) & 3), 0), gdn_buf(P, (((gi * 2 + 1) >> 2) * NCHUNK) * 4 + ((gi * 2 + 1) & 3), 0) };
#define GC_LOAD(n_) do { _Pragma("unroll") for (int i = 0; i < 10; ++i) { const int p = tid + 512 * i, qq = p / 2560, pp = p % 2560; \
        stg[i] = *(const u32x4*)(src0[qq] + (size_t)(n_) * 4 * 5 * 4096 + (size_t)pp * 8); } } while (0)
#define GC_WRITE1(i_) do { const int p = tid + 512 * (i_), qq = p / 2560, pp = p % 2560, mat = pp >> 9, row = (pp & 511) >> 3, pc = pp & 7; \
        *(LAS u32x4*)(lds + qq * GC_BH + mat * 9216 + row * 144 + pc * 16) = stg[i_]; } while (0)
#define GC_WRITE_A() do { GC_WRITE1(0); GC_WRITE1(1); GC_WRITE1(3); GC_WRITE1(5); GC_WRITE1(6); GC_WRITE1(8); } while (0)
#define GC_WRITE_B() do { GC_WRITE1(2); GC_WRITE1(4); GC_WRITE1(7); GC_WRITE1(9); } while (0)
    GC_LOAD(0); GC_WRITE_A(); GC_WRITE_B();
    for (int i = tid; i < 64 * 72 / 2; i += 512) { ((LAS unsigned*)(lds + GC_ST))[i] = 0u; ((LAS unsigned*)(lds + GC_BH + GC_ST))[i] = 0u; }
    f32x4 S[4];
#pragma unroll
    for (int t = 0; t < 4; ++t) S[t] = (f32x4){0.f, 0.f, 0.f, 0.f};
    const size_t tokb = (size_t)b * SEQ + ct * 16 + fr;
    __syncthreads();
    for (int n = 0; n < NCHUNK; ++n) {
        const int chh = (b * NCHUNK + n) * 4 + h;
        if (n + 1 < NCHUNK) GC_LOAD(n + 1);
        u32x2 gate[4];
#pragma unroll
        for (int et = 0; et < 4; ++et) gate[et] = *(const u32x2*)(z + (tokb + n * 64) * ZP + Z_GG + h * 64 + et * 16 + 4 * fq);
        const float egl = ((const float*)(P.ws + WS_GL))[chh];
        f32x4 o[4];
        {
            const bf16x8 w0 = ldsA(L + GC_W, ct * 16 + fr, 0, fq), w1 = ldsA(L + GC_W, ct * 16 + fr, 1, fq), q0 = ldsA(L + GC_QD, ct * 16 + fr, 0, fq), q1 = ldsA(L + GC_QD, ct * 16 + fr, 1, fq);
#pragma unroll
            for (int et = 0; et < 4; ++et) {
                const bf16x8 s0 = ldsA(L + GC_ST, et * 16 + fr, 0, fq), s1 = ldsA(L + GC_ST, et * 16 + fr, 1, fq);
                f32x4 a = {0.f, 0.f, 0.f, 0.f}; a = mfma16(w0, s0, a); a = mfma16(w1, s1, a);
                f32x4 oo = {0.f, 0.f, 0.f, 0.f}; oo = mfma16(s0, q0, oo); oo = mfma16(s1, q1, oo); o[et] = oo;
                const u32x2 uw = *(const LAS u32x2*)(L + GC_UT + (et * 16 + fr) * 144 + (ct * 16 + 4 * fq) * 2);
                u32x2 vw; vw.x = pk2(bflo(uw.x) - a.x, bfhi(uw.x) - a.y); vw.y = pk2(bflo(uw.y) - a.z, bfhi(uw.y) - a.w);
                *(LAS u32x2*)(L + GC_VNT + (et * 16 + fr) * 144 + (ct * 16 + 4 * fq) * 2) = vw; }
        }
        __syncthreads();
        if (n + 1 < NCHUNK) GC_WRITE_A();
        {
            const bf16x8 a0 = ldsA(L + GC_ATT, ct * 16 + fr, 0, fq), a1 = ldsA(L + GC_ATT, ct * 16 + fr, 1, fq), k0 = ldsA(L + GC_KDT, ct * 16 + fr, 0, fq), k1 = ldsA(L + GC_KDT, ct * 16 + fr, 1, fq);
#pragma unroll
            for (int et = 0; et < 4; ++et) {
                const bf16x8 v0 = ldsA(L + GC_VNT, et * 16 + fr, 0, fq), v1 = ldsA(L + GC_VNT, et * 16 + fr, 1, fq);
                o[et] = mfma16(v0, a0, o[et]); o[et] = mfma16(v1, a1, o[et]);
                f32x4 sN = S[et] * egl; sN = mfma16(k0, v0, sN); sN = mfma16(k1, v1, sN); S[et] = sN;
                u32x2 sw; sw.x = pk2(sN.x, sN.y); sw.y = pk2(sN.z, sN.w);
                *(LAS u32x2*)(L + GC_ST + (et * 16 + fr) * 144 + (ct * 16 + 4 * fq) * 2) = sw; }
        }
        {
            float s2 = 0.f;
#pragma unroll
            for (int et = 0; et < 4; ++et) s2 += (o[et].x * o[et].x + o[et].y * o[et].y) + (o[et].z * o[et].z + o[et].w * o[et].w);
            s2 = xrow_sum_(s2);
            const float rs = frsq_(s2 * (1.0f / 64.0f) + EPS);
            u32x2 w[4];
#pragma unroll
            for (int et = 0; et < 4; ++et) { const f32x4 v = o[et] * rs * ng[et];
                w[et].x = pk2(v.x * siluf_(bflo(gate[et].x)), v.y * siluf_(bfhi(gate[et].x))); w[et].y = pk2(v.z * siluf_(bflo(gate[et].y)), v.w * siluf_(bfhi(gate[et].y))); }
            bf16_t* yp = y + (tokb + n * 64) * DM + 768 + h * 64 + (fq >> 1) * 8;
            *(u32x4*)(yp + (0 + (fq & 1)) * 16) = widen16_(w[0], w[1]);
            *(u32x4*)(yp + (2 + (fq & 1)) * 16) = widen16_(w[2], w[3]);
        }
        __syncthreads();
        if (n + 1 < NCHUNK) GC_WRITE_B();
    }
#undef GC_LOAD
#undef GC_WRITE1
#undef GC_WRITE_A
#undef GC_WRITE_B
    __syncthreads();
}

constexpr int RT_BUF = 36864, RT_Q = 0, RT_K = 9216, RT_KZT = 18432, RT_VT = 27648, RT_P = 73728, RT_ST = 82944, RT_O = 92160;
__device__ __forceinline__ void ret_chain_item(const Params& P, int l, LAS unsigned char* lds, int it, int tid, int wave, int lane) {
    const int b = it >> 2, h = it & 3, fr = lane & 15, fq = lane >> 4;
    const bf16_t* z = (const bf16_t*)(P.ws + WS_R); bf16_t* y = (bf16_t*)(P.ws + WS_R + R_Y);
    LAS bf16_t* Pm = (LAS bf16_t*)(lds + RT_P); LAS bf16_t* ST = (LAS bf16_t*)(lds + RT_ST); LAS float* Of = (LAS float*)(lds + RT_O);
    const float lg = log1pf(-exp2f(-5.0f - (float)h));
    const float cdec = fexp_(64.0f * lg);
    for (int i = tid; i < 64 * 72 / 2; i += 512) ((LAS unsigned*)ST)[i] = 0u;
    const int it4 = wave >> 1, jt0 = 2 * (wave & 1);
    f32x4 S[2] = {{0.f, 0.f, 0.f, 0.f}, {0.f, 0.f, 0.f, 0.f}};
    const int lc = tid >> 3, pg = tid & 7;
    float invf[4];
#pragma unroll
    for (int ii = 0; ii < 4; ++ii) invf[ii] = exp2f(-(float)(4 * pg + ii) * (13.287712379549449f / 32.0f));
    const float zeta = fexp_((63.0f - (float)lc) * lg);
    const f32x4 gn0 = *(const f32x4*)(P.ret_gn + l * 256 + h * 64 + 8 * pg), gn1 = *(const f32x4*)(P.ret_gn + l * 256 + h * 64 + 8 * pg + 4);
    const size_t tok0 = (size_t)b * SEQ + lc;
    u32x2 q1w, q2w, k1w, k2w; u32x4 vw; int posi;
#define RT_LOAD(n_) do { const bf16_t* zr_ = z + (tok0 + (n_) * 64) * ZP; q1w = *(const u32x2*)(zr_ + Z_RQ + h * 64 + 4 * pg); q2w = *(const u32x2*)(zr_ + Z_RQ + h * 64 + 32 + 4 * pg); \
        k1w = *(const u32x2*)(zr_ + Z_RK + h * 64 + 4 * pg); k2w = *(const u32x2*)(zr_ + Z_RK + h * 64 + 32 + 4 * pg); vw = *(const u32x4*)(zr_ + Z_RV + h * 64 + 8 * pg); posi = P.pos[tok0 + (n_) * 64]; } while (0)
#define RT_STAGE(buf_) do { LAS bf16_t* Qs_ = (LAS bf16_t*)(lds + (buf_) * RT_BUF + RT_Q); LAS bf16_t* Ks_ = (LAS bf16_t*)(lds + (buf_) * RT_BUF + RT_K); \
        LAS bf16_t* KzT_ = (LAS bf16_t*)(lds + (buf_) * RT_BUF + RT_KZT); LAS bf16_t* VT_ = (LAS bf16_t*)(lds + (buf_) * RT_BUF + RT_VT); const float pos = (float)posi; \
        const float q1[4] = {bflo(q1w.x), bfhi(q1w.x), bflo(q1w.y), bfhi(q1w.y)}, q2[4] = {bflo(q2w.x), bfhi(q2w.x), bflo(q2w.y), bfhi(q2w.y)}; \
        const float k1[4] = {bflo(k1w.x), bfhi(k1w.x), bflo(k1w.y), bfhi(k1w.y)}, k2[4] = {bflo(k2w.x), bfhi(k2w.x), bflo(k2w.y), bfhi(k2w.y)}; \
        float qa[4], qb[4], ka[4], kb[4]; \
        _Pragma("unroll") for (int ii = 0; ii < 4; ++ii) { float sn, cs; sincos_rev(pos * invf[ii], sn, cs); \
            qa[ii] = (q1[ii] * cs - q2[ii] * sn) * 0.125f; qb[ii] = (q1[ii] * sn + q2[ii] * cs) * 0.125f; ka[ii] = k1[ii] * cs - k2[ii] * sn; kb[ii] = k1[ii] * sn + k2[ii] * cs; } \
        u32x2 w_; w_.x = pk2(qa[0], qa[1]); w_.y = pk2(qa[2], qa[3]); *(LAS u32x2*)(Qs_ + lc * 72 + 4 * pg) = w_; \
        w_.x = pk2(qb[0], qb[1]); w_.y = pk2(qb[2], qb[3]); *(LAS u32x2*)(Qs_ + lc * 72 + 32 + 4 * pg) = w_; \
        w_.x = pk2(ka[0], ka[1]); w_.y = pk2(ka[2], ka[3]); *(LAS u32x2*)(Ks_ + lc * 72 + 4 * pg) = w_; \
        w_.x = pk2(kb[0], kb[1]); w_.y = pk2(kb[2], kb[3]); *(LAS u32x2*)(Ks_ + lc * 72 + 32 + 4 * pg) = w_; \
        _Pragma("unroll") for (int ii = 0; ii < 4; ++ii) { KzT_[(4 * pg + ii) * 72 + lc] = f2bf(ka[ii] * zeta); KzT_[(32 + 4 * pg + ii) * 72 + lc] = f2bf(kb[ii] * zeta); } \
        const unsigned vv[4] = {vw.x, vw.y, vw.z, vw.w}; \
        _Pragma("unroll") for (int ii = 0; ii < 4; ++ii) { VT_[(8 * pg + 2 * ii) * 72 + lc] = (bf16_t)(vv[ii] & 0xffffu); VT_[(8 * pg + 2 * ii + 1) * 72 + lc] = (bf16_t)(vv[ii] >> 16); } } while (0)
    RT_LOAD(0); RT_STAGE(0);
    __syncthreads();
    for (int n = 0; n < NCHUNK; ++n) {
        const int cb = n & 1;
        const LAS bf16_t* Qs = (const LAS bf16_t*)(lds + cb * RT_BUF + RT_Q); const LAS bf16_t* Ks = (const LAS bf16_t*)(lds + cb * RT_BUF + RT_K);
        const LAS bf16_t* KzT = (const LAS bf16_t*)(lds + cb * RT_BUF + RT_KZT); const LAS bf16_t* VT = (const LAS bf16_t*)(lds + cb * RT_BUF + RT_VT);
        const size_t tok = tok0 + n * 64;
        if (n + 1 < NCHUNK) RT_LOAD(n + 1);
        const u32x4 gw = *(const u32x4*)(z + tok * ZP + Z_RG + h * 64 + 8 * pg);
        const bf16x8 a0 = *(const LAS bf16x8*)(Qs + (it4 * 16 + fr) * 72 + 8 * fq), a1 = *(const LAS bf16x8*)(Qs + (it4 * 16 + fr) * 72 + 32 + 8 * fq);
        f32x4 cross[2];
#pragma unroll
        for (int t = 0; t < 2; ++t) { const int jt = jt0 + t;
            f32x4 p = {0.f, 0.f, 0.f, 0.f};
            p = mfma16(a0, *(const LAS bf16x8*)(Ks + (jt * 16 + fr) * 72 + 8 * fq), p); p = mfma16(a1, *(const LAS bf16x8*)(Ks + (jt * 16 + fr) * 72 + 32 + 8 * fq), p);
            f32x4 cr = {0.f, 0.f, 0.f, 0.f};
            cr = mfma16(a0, *(const LAS bf16x8*)(ST + (jt * 16 + fr) * 72 + 8 * fq), cr); cr = mfma16(a1, *(const LAS bf16x8*)(ST + (jt * 16 + fr) * 72 + 32 + 8 * fq), cr);
#pragma unroll
            for (int r = 0; r < 4; ++r) { const int i = it4 * 16 + 4 * fq + r, j = jt * 16 + fr; const int dd = i > j ? i - j : j - i;
                Pm[i * 72 + j] = f2bf(p[r] * fexp_((float)dd * lg)); cr[r] *= fexp_((float)(i + 1) * lg); }
            cross[t] = cr; }
        __syncthreads();
        const bf16x8 p0 = *(const LAS bf16x8*)(Pm + (it4 * 16 + fr) * 72 + 8 * fq), p1 = *(const LAS bf16x8*)(Pm + (it4 * 16 + fr) * 72 + 32 + 8 * fq);
        const bf16x8 kz0 = *(const LAS bf16x8*)(KzT + (it4 * 16 + fr) * 72 + 8 * fq), kz1 = *(const LAS bf16x8*)(KzT + (it4 * 16 + fr) * 72 + 32 + 8 * fq);
#pragma unroll
        for (int t = 0; t < 2; ++t) { const int et = jt0 + t;
            const bf16x8 v0 = *(const LAS bf16x8*)(VT + (et * 16 + fr) * 72 + 8 * fq), v1 = *(const LAS bf16x8*)(VT + (et * 16 + fr) * 72 + 32 + 8 * fq);
            f32x4 o = cross[t]; o = mfma16(p0, v0, o); o = mfma16(p1, v1, o);
#pragma unroll
            for (int r = 0; r < 4; ++r) Of[(it4 * 16 + 4 * fq + r) * 65 + et * 16 + fr] = o[r];
            f32x4 sN = S[t] * cdec; sN = mfma16(kz0, v0, sN); sN = mfma16(kz1, v1, sN); S[t] = sN;
            u32x2 w; w.x = pk2(sN.x, sN.y); w.y = pk2(sN.z, sN.w); *(LAS u32x2*)(ST + (et * 16 + fr) * 72 + it4 * 16 + 4 * fq) = w; }
        if (n + 1 < NCHUNK) RT_STAGE(cb ^ 1);
        __syncthreads();
        {
            float ov[8]; float sm = 0.f;
#pragma unroll
            for (int j = 0; j < 8; ++j) { ov[j] = Of[lc * 65 + 8 * pg + j]; sm += ov[j]; }
            sm = sum8_(sm);
            const float mu = sm * (1.0f / 64.0f); float vs = 0.f;
#pragma unroll
            for (int j = 0; j < 8; ++j) { ov[j] -= mu; vs += ov[j] * ov[j]; }
            vs = sum8_(vs);
            const float rs = frsq_(vs * (1.0f / 64.0f) + EPS);
            const float gt[8] = {bflo(gw.x), bfhi(gw.x), bflo(gw.y), bfhi(gw.y), bflo(gw.z), bfhi(gw.z), bflo(gw.w), bfhi(gw.w)};
            const float gnv[8] = {gn0.x, gn0.y, gn0.z, gn0.w, gn1.x, gn1.y, gn1.z, gn1.w};
            float r8[8];
#pragma unroll
            for (int j = 0; j < 8; ++j) r8[j] = ov[j] * rs * gnv[j] * siluf_(gt[j]);
            u32x4 w; w.x = pk2(r8[0], r8[1]); w.y = pk2(r8[2], r8[3]); w.z = pk2(r8[4], r8[5]); w.w = pk2(r8[6], r8[7]);
            *(u32x4*)(y + tok * DM + h * 64 + 8 * pg) = w;
        }
    }
#undef RT_LOAD
#undef RT_STAGE
    __syncthreads();
}

constexpr int LR_XC = 0, LR_AU = 33792;
__device__ __forceinline__ void lru_item(const Params& P, int l, LAS unsigned char* lds, int it, int mode, int tid, int wave, int lane) {
    const int b = it >> 5, n = it & 31, fr = lane & 15, fq = lane >> 4;
    const bf16_t* z = (const bf16_t*)(P.ws + WS_R); bf16_t* y = (bf16_t*)(P.ws + WS_R + R_Y);
    LAS bf16_t* XC = (LAS bf16_t*)(lds + LR_XC); LAS f32x2* AU = (LAS f32x2*)(lds + LR_AU);
    float* sumA = (float*)(P.ws + WS_LRUS); float* sumH = sumA + 16 * 32 * 256;
    {
        const int c = tid >> 3, cg = tid & 7, s = n * 64 + c; const size_t tok = (size_t)b * SEQ + s;
        const float* cw = P.lru_conv_w + (size_t)l * 4 * 256; const float* cb = P.lru_conv_b + l * 256;
#pragma unroll
        for (int g = 0; g < 4; ++g) { const int ch0 = cg * 32 + g * 8;
            const f32x4 b0 = *(const f32x4*)(cb + ch0), b1 = *(const f32x4*)(cb + ch0 + 4);
            float a[8] = {b0.x, b0.y, b0.z, b0.w, b1.x, b1.y, b1.z, b1.w};
#pragma unroll
            for (int kk = 0; kk < 4; ++kk) { const bool okk = s - 3 + kk >= 0; const float mk = okk ? 1.f : 0.f;
                const u32x4 w = *(const u32x4*)(z + (okk ? tok - 3 + kk : tok) * ZP + Z_LX + ch0);
                const f32x4 c0 = *(const f32x4*)(cw + kk * 256 + ch0) * mk, c1 = *(const f32x4*)(cw + kk * 256 + ch0 + 4) * mk;
                a[0] += c0.x * bflo(w.x); a[1] += c0.y * bfhi(w.x); a[2] += c0.z * bflo(w.y); a[3] += c0.w * bfhi(w.y);
                a[4] += c1.x * bflo(w.z); a[5] += c1.y * bfhi(w.z); a[6] += c1.z * bflo(w.w); a[7] += c1.w * bfhi(w.w); }
            u32x4 o; o.x = pk2(a[0], a[1]); o.y = pk2(a[2], a[3]); o.z = pk2(a[4], a[5]); o.w = pk2(a[6], a[7]);
            *(LAS u32x4*)(XC + c * 264 + ch0) = o; }
    }
    float hcar = 0.f, aprod = 1.f;
    if (mode == 1 && tid < 256) {
        float av[32], hv[32];
#pragma unroll
        for (int m = 0; m < 32; ++m) { const int mm = m < n ? m : 0; av[m] = sumA[(b * 32 + mm) * 256 + tid]; hv[m] = sumH[(b * 32 + mm) * 256 + tid]; }
#pragma unroll
        for (int m = 0; m < 32; ++m) if (m < n) hcar = av[m] * hcar + hv[m];
    }
    const int nb = wave >> 1, rt = wave & 1;
    const bf16_t* wa = wl(P, l, W_A) + nb * 4096; const bf16_t* wx = wl(P, l, W_X) + nb * 4096;
    bf16x8 fa[4][2], fx[4][2]; float ba[4], bx[4], spl[4];
#pragma unroll
    for (int dt = 0; dt < 4; ++dt) {
#pragma unroll
        for (int s = 0; s < 2; ++s) { fa[dt][s] = *(const bf16x8*)(wa + (dt * 16 + fr) * 64 + 32 * s + 8 * fq); fx[dt][s] = *(const bf16x8*)(wx + (dt * 16 + fr) * 64 + 32 * s + 8 * fq); }
        const int d = nb * 64 + dt * 16 + fr; ba[dt] = P.lru_ba[l * 256 + d]; bx[dt] = P.lru_bx[l * 256 + d]; spl[dt] = -8.0f * softplusf_(-P.lru_lambda[l * 256 + d]); }
    __syncthreads();
    for (int half = 0; half < 2; ++half) {
        const int trow = half * 32 + rt * 16;
        const bf16x8 x0 = *(const LAS bf16x8*)(XC + (trow + fr) * 264 + nb * 64 + 8 * fq), x1 = *(const LAS bf16x8*)(XC + (trow + fr) * 264 + nb * 64 + 32 + 8 * fq);
#pragma unroll
        for (int dt = 0; dt < 4; ++dt) {
            f32x4 ar = {0.f, 0.f, 0.f, 0.f}, ai = {0.f, 0.f, 0.f, 0.f};
            ar = mfma16(x0, fa[dt][0], ar); ar = mfma16(x1, fa[dt][1], ar); ai = mfma16(x0, fx[dt][0], ai); ai = mfma16(x1, fx[dt][1], ai);
            const int d = nb * 64 + dt * 16 + fr;
#pragma unroll
            for (int r = 0; r < 4; ++r) { const int tl = rt * 16 + 4 * fq + r;
                const float xcv = bf2f(XC[(half * 32 + tl) * 264 + d]);
                const float rr = sigmoidf_(ar[r] + ba[dt]), ii = sigmoidf_(ai[r] + bx[dt]);
                const float a = fexp_(rr * spl[dt]);
                const float u = fsqrt_(fmaxf(1.0f - a * a, 0.f)) * (ii * xcv);
                AU[tl * 257 + d] = (f32x2){a, u}; }
        }
        __syncthreads();
        if (tid < 256) {
#pragma unroll 8
            for (int tk = 0; tk < 32; ++tk) { const f32x2 au = AU[tk * 257 + tid]; hcar = au.x * hcar + au.y; aprod *= au.x; if (mode == 1) AU[tk * 257 + tid].y = hcar; }
        }
        if (mode == 1) {
            __syncthreads();
            const int tk = tid >> 4, c0 = (tid & 15) * 16; const size_t tok = (size_t)b * SEQ + n * 64 + half * 32 + tk;
            const u32x4 g0 = *(const u32x4*)(z + tok * ZP + Z_LG + c0), g1 = *(const u32x4*)(z + tok * ZP + Z_LG + c0 + 8);
            const unsigned gws[8] = {g0.x, g0.y, g0.z, g0.w, g1.x, g1.y, g1.z, g1.w}; unsigned ow[8];
#pragma unroll
            for (int j = 0; j < 8; ++j) { const float h0 = AU[tk * 257 + c0 + 2 * j].y, h1 = AU[tk * 257 + c0 + 2 * j + 1].y; ow[j] = pk2(h0 * geluf_(bflo(gws[j])), h1 * geluf_(bfhi(gws[j]))); }
            bf16_t* yp = y + tok * DM + 256 + c0;
            *(u32x4*)yp = (u32x4){ow[0], ow[1], ow[2], ow[3]}; *(u32x4*)(yp + 8) = (u32x4){ow[4], ow[5], ow[6], ow[7]};
        }
        __syncthreads();
    }
    if (mode == 0 && tid < 256) { sumA[(b * 32 + n) * 256 + tid] = aprod; sumH[(b * 32 + n) * 256 + tid] = hcar; }
}

constexpr int LC_XC = 0, LC_AU = 9216;
__device__ __forceinline__ void lru_chain_item(const Params& P, int l, LAS unsigned char* lds, int it, int tid, int wave, int lane) {
    const int b = it >> 2, nb = it & 3, fr = lane & 15, fq = lane >> 4;
    const bf16_t* z = (const bf16_t*)(P.ws + WS_R); bf16_t* y = (bf16_t*)(P.ws + WS_R + R_Y);
    LAS bf16_t* XC = (LAS bf16_t*)(lds + LC_XC); LAS f32x2* AU = (LAS f32x2*)(lds + LC_AU);
    const int c = tid >> 3, cg = tid & 7, ch0 = nb * 64 + cg * 8;
    f32x4 cw0[4], cw1[4];
#pragma unroll
    for (int kk = 0; kk < 4; ++kk) { cw0[kk] = *(const f32x4*)(P.lru_conv_w + (size_t)l * 1024 + kk * 256 + ch0); cw1[kk] = *(const f32x4*)(P.lru_conv_w + (size_t)l * 1024 + kk * 256 + ch0 + 4); }
    const f32x4 cb0 = *(const f32x4*)(P.lru_conv_b + l * 256 + ch0), cb1 = *(const f32x4*)(P.lru_conv_b + l * 256 + ch0 + 4);
    const int rt = wave >> 1, dt0 = (wave & 1) * 2;
    const bf16_t* wa = wl(P, l, W_A) + nb * 4096; const bf16_t* wx = wl(P, l, W_X) + nb * 4096;
    bf16x8 fa[2][2], fx[2][2]; float ba[2], bx[2], spl[2];
#pragma unroll
    for (int t = 0; t < 2; ++t) {
#pragma unroll
        for (int s = 0; s < 2; ++s) { fa[t][s] = *(const bf16x8*)(wa + ((dt0 + t) * 16 + fr) * 64 + 32 * s + 8 * fq); fx[t][s] = *(const bf16x8*)(wx + ((dt0 + t) * 16 + fr) * 64 + 32 * s + 8 * fq); }
        const int d = nb * 64 + (dt0 + t) * 16 + fr; ba[t] = P.lru_ba[l * 256 + d]; bx[t] = P.lru_bx[l * 256 + d]; spl[t] = -8.0f * softplusf_(-P.lru_lambda[l * 256 + d]); }
    const size_t tok0 = (size_t)b * SEQ + c;
    u32x4 xr[4], gr;
#define LC_LOAD(n_) do { const size_t t_ = tok0 + (size_t)(n_) * 64; _Pragma("unroll") for (int kk = 0; kk < 4; ++kk) { const bool ok_ = (n_) * 64 + c - 3 + kk >= 0; \
        xr[kk] = *(const u32x4*)(z + (ok_ ? t_ - 3 + kk : t_) * ZP + Z_LX + ch0); } gr = *(const u32x4*)(z + t_ * ZP + Z_LG + ch0); } while (0)
    LC_LOAD(0);
    float hcar = 0.f;
    for (int n = 0; n < NCHUNK; ++n) {
        {
            float a[8] = {cb0.x, cb0.y, cb0.z, cb0.w, cb1.x, cb1.y, cb1.z, cb1.w};
#pragma unroll
            for (int kk = 0; kk < 4; ++kk) { const float mk = (n * 64 + c - 3 + kk >= 0) ? 1.f : 0.f; const f32x4 c0 = cw0[kk] * mk, c1 = cw1[kk] * mk; const u32x4 w = xr[kk];
                a[0] += c0.x * bflo(w.x); a[1] += c0.y * bfhi(w.x); a[2] += c0.z * bflo(w.y); a[3] += c0.w * bfhi(w.y);
                a[4] += c1.x * bflo(w.z); a[5] += c1.y * bfhi(w.z); a[6] += c1.z * bflo(w.w); a[7] += c1.w * bfhi(w.w); }
            u32x4 o; o.x = pk2(a[0], a[1]); o.y = pk2(a[2], a[3]); o.z = pk2(a[4], a[5]); o.w = pk2(a[6], a[7]);
            *(LAS u32x4*)(XC + c * 72 + cg * 8) = o;
        }
        const u32x4 gcur = gr;
        if (n + 1 < NCHUNK) LC_LOAD(n + 1);
        __syncthreads();
        {
            const bf16x8 x0 = *(const LAS bf16x8*)(XC + (rt * 16 + fr) * 72 + 8 * fq), x1 = *(const LAS bf16x8*)(XC + (rt * 16 + fr) * 72 + 32 + 8 * fq);
#pragma unroll
            for (int t = 0; t < 2; ++t) {
                f32x4 ar = {0.f, 0.f, 0.f, 0.f}, ai = {0.f, 0.f, 0.f, 0.f};
                ar = mfma16(x0, fa[t][0], ar); ar = mfma16(x1, fa[t][1], ar); ai = mfma16(x0, fx[t][0], ai); ai = mfma16(x1, fx[t][1], ai);
                const int dl = (dt0 + t) * 16 + fr;
#pragma unroll
                for (int r = 0; r < 4; ++r) { const int tl = rt * 16 + 4 * fq + r;
                    const float xcv = bf2f(XC[tl * 72 + dl]);
                    const float rr = sigmoidf_(ar[r] + ba[t]), ii = sigmoidf_(ai[r] + bx[t]);
                    const float av = fexp_(rr * spl[t]);
                    AU[tl * 65 + dl] = (f32x2){av, fsqrt_(fmaxf(1.0f - av * av, 0.f)) * (ii * xcv)}; }
            }
        }
        __syncthreads();
        if (tid < 64) {
#pragma unroll
            for (int blk = 0; blk < 4; ++blk) { f32x2 au[16];
#pragma unroll
                for (int k = 0; k < 16; ++k) au[k] = AU[(blk * 16 + k) * 65 + tid];
#pragma unroll
                for (int k = 0; k < 16; ++k) { hcar = au[k].x * hcar + au[k].y; au[k].y = hcar; }
#pragma unroll
                for (int k = 0; k < 16; ++k) AU[(blk * 16 + k) * 65 + tid].y = au[k].y; }
        }
        __syncthreads();
        {
            const unsigned gws[4] = {gcur.x, gcur.y, gcur.z, gcur.w}; unsigned ow[4];
#pragma unroll
            for (int j = 0; j < 4; ++j) ow[j] = pk2(AU[c * 65 + cg * 8 + 2 * j].y * geluf_(bflo(gws[j])), AU[c * 65 + cg * 8 + 2 * j + 1].y * geluf_(bfhi(gws[j])));
            *(u32x4*)(y + (tok0 + (size_t)n * 64) * DM + 256 + ch0) = (u32x4){ow[0], ow[1], ow[2], ow[3]};
        }
    }
#undef LC_LOAD
    __syncthreads();
}

constexpr int N_PHASES = 21;
constexpr int Q_RET = 64, Q_GDN = 32, Q_LRU = 64, Q_MLA = 512, Q_TOTAL = Q_RET + Q_GDN + Q_LRU + Q_MLA;

__global__ void __launch_bounds__(512, 2) hymba_fwd(Params P_) {
    extern __shared__ __attribute__((aligned(16))) unsigned char lds_raw[];
    LAS unsigned char* lds = (LAS unsigned char*)lds_raw;
    volatile LAS unsigned* LC = (volatile LAS unsigned*)(lds + LDS_CTL);
    const int G = gridDim.x;
#define SUB_TID() int tid2 = tid; asm volatile("" : "+v"(tid2)); const int lane2 = tid2 & 63, wave2 = __builtin_amdgcn_readfirstlane(tid2 >> 6); (void)lane2; (void)wave2
#if defined(__HIP_DEVICE_COMPILE__)
#define PH_PARAMS() const __attribute__((address_space(4))) Params* pp_ = (const __attribute__((address_space(4))) Params*)__builtin_amdgcn_kernarg_segment_ptr(); asm volatile("" : "+s"(pp_)); const Params P = *pp_
#else
#define PH_PARAMS() const Params P = P_
#endif
#define PH_TID() PH_PARAMS(); \
    bf16_t* xb = (bf16_t*)(P.ws + WS_XB); float* part = (float*)(P.ws + WS_PART); bf16_t* zb = (bf16_t*)(P.ws + WS_R); bf16_t* yb = (bf16_t*)(P.ws + WS_R + R_Y); bf16_t* oxb = (bf16_t*)(P.ws + WS_R + R_OX); (void)xb; (void)part; (void)zb; (void)yb; (void)oxb; \
    int tid = threadIdx.x; asm volatile("" : "+v"(tid)); const int lane = tid & 63, wave = __builtin_amdgcn_readfirstlane(tid >> 6); (void)lane; (void)wave
    unsigned* ctl = (unsigned*)(P_.ws + WS_CTL);
    if (threadIdx.x < 64) LC[threadIdx.x] = 0u;
    __syncthreads();
    const int lo = P_.ph_lo, hi = P_.ph_hi;
    XcdBarrier bar; bar.bar = ctl + CW_BAR; bar.x = 0; bar.st = LC;
    if (hi - lo > 1) bar = xcd_barrier_post(ctl + CW_BAR, LC);
#ifndef PHASE_MASK
#define PHASE_MASK 0xFFFFFFFFu
#endif
#define EN(t) ((PHASE_MASK >> (t)) & 1u)
#ifndef REPEAT_MASK
#define REPEAT_MASK 0u
#endif
#define REP(t) for (int rep_ = 0; rep_ <= (int)((REPEAT_MASK >> (t)) & 1u); ++rep_, (rep_ <= (int)((REPEAT_MASK >> (t)) & 1u) ? xcd_barrier(bar) : (void)0))
#define IN(k) (lo <= (k) && (k) < hi)
#define SEAM(k) do { if (IN(k) && IN((k) + 1)) xcd_barrier(bar); } while (0)


    if (IN(0) && EN(0)) REP(0) { PH_TID(); p0_prologue(P, lds, tid); __syncthreads(); }
    SEAM(0);
    if (IN(1) && EN(1)) REP(1) {
        PH_TID();
        const int which = blockIdx.x >> 6, l = which >> 1, isv = which & 1;
        if (which < 4) {
            const bf16_t* memn = (const bf16_t*)(P.ws + WS_GDN); const bf16_t* wkv = wl(P, l, W_KV);
            bf16_t* kout = (bf16_t*)(P.ws + WS_KVM + (size_t)l * KVM_LAYER); bf16_t* vout = kout + (size_t)4096 * 1024;
            pg8::Gemm g; pg8::EpiScaleBf16<0> E; pg8::StaticOrder S;
            if (!isv) { g = pg8::Gemm{memn, wkv, 4096, 1024, 1024}; E = pg8::EpiScaleBf16<0>{kout, 1024, nullptr}; S.init(4096, 1024, 64, blockIdx.x & 63); }
            else { g = pg8::Gemm{wkv + (size_t)1024 * 1024, memn, 1024, 4096, 1024}; E = pg8::EpiScaleBf16<0>{vout, 4096, nullptr}; S.init(1024, 4096, 64, blockIdx.x & 63); }
            pg8::gemm_phase(lds, g, S, E, tid);
        }
    }
#pragma unroll
    for (int l = 0; l < 2; ++l) {
        const int pb = 2 + 9 * l;
        if (IN(pb + 0) && EN(2)) REP(2) { PH_TID();
            pg8::Gemm g{xb, wl(P, l, W_IN), T_TOK, ZP, DM}; pg8::StaticOrder S; S.init(T_TOK, ZP, G, blockIdx.x);
            pg8::scale_table(lds, S, part, tid);
            pg8::EpiScaleBf16<0> E{zb, ZP, part}; pg8::gemm_phase(lds, g, S, E, tid);
        }
        SEAM(pb + 0);
        if (IN(pb + 1)) {
            PH_TID();
            if (EN(3)) REP(3) { SUB_TID();
                for (int i = tid2; i < 768; i += 512) *(LAS f32x4*)(lds + GP_CW + i * 16) = *(const f32x4*)(P.gdn_conv_w + (size_t)l * 3072 + i * 4);
                __syncthreads();
_Pragma("unroll 1")
            for (int it = blockIdx.x; it < 1024; it += G) gdn_pre_item(P, l, lds, it, tid2); }
            if (EN(5)) REP(5) { SUB_TID();
_Pragma("unroll 1")
            for (int it = blockIdx.x; it < 256; it += G) mla_pre_item(P, l, lds, it, tid2, wave2, lane2); }
        }
        SEAM(pb + 1);
        if (IN(pb + 2)) {
            PH_TID();
            for (int rep2_ = 0; rep2_ <= (int)((REPEAT_MASK >> 17) & 1u); ++rep2_, (rep2_ <= (int)((REPEAT_MASK >> 17) & 1u) ? xcd_barrier(bar) : (void)0)) {
            unsigned* qh0 = ctl + CW_QUEUE + 64 * l + 16 * rep2_;
#define QUEUE_LOOP(qi_, count_, body_) for (;;) { if (tid == 0) LC[4] = __hip_atomic_fetch_add(qh + (qi_), 1u, __ATOMIC_RELAXED, __HIP_MEMORY_SCOPE_AGENT); \
                __syncthreads(); const int it = (int)LC[4]; __syncthreads(); if (it >= (count_)) break; { SUB_TID(); body_; } __syncthreads(); }
            if (EN(6)) REP(6) { unsigned* qh = qh0 + 32 * rep_; QUEUE_LOOP(0, Q_RET, ret_chain_item(P, l, lds, it, tid2, wave2, lane2)) }
            if (EN(7)) REP(7) { unsigned* qh = qh0 + 32 * rep_; QUEUE_LOOP(1, Q_GDN, gdn_chain_item(P, l, lds, it, tid2, wave2, lane2)) }
            if (EN(8)) REP(8) { unsigned* qh = qh0 + 32 * rep_; QUEUE_LOOP(2, Q_LRU, lru_chain_item(P, l, lds, it, tid2, wave2, lane2)) }
            if (EN(9)) REP(9) { unsigned* qh = qh0 + 32 * rep_; QUEUE_LOOP(3, Q_MLA, mla_attn_item(P, lds, it, tid2, wave2, lane2)) }
#undef QUEUE_LOOP
            }
        }
        SEAM(pb + 2);
        if (IN(pb + 3) && EN(10)) REP(10) { PH_TID();
            pg8::Gemm g{yb, wl(P, l, W_OUT), T_TOK, DM, DM}; pg8::StaticOrder S; S.init(T_TOK, DM, G, blockIdx.x);
            pg8::EpiResid E{xb, part, rep_ ? 0.f : 1.f}; pg8::gemm_phase(lds, g, S, E, tid);
        }
        SEAM(pb + 3);
        if (IN(pb + 4) && EN(11)) REP(11) { PH_TID();
_Pragma("unroll 1")
            for (int u = blockIdx.x; u < 512; u += G) {
                const int pm = u >> 2, pn = u & 3;
                { pg8::Gemm g{xb, wl(P, l, W_Q), T_TOK, DM, DM}; pg8::OneUnit S{pm, pn};
                  pg8::EpiScaleLds E{part}; pg8::gemm_phase(lds, g, S, E, tid); }
                asm volatile("s_waitcnt lgkmcnt(0)" ::: "memory"); __syncthreads();
                { SUB_TID(); xa_item(P, l, lds, (pm >> 3) * 32 + pn * 8 + (pm & 7), tid2, wave2, lane2); }
                __syncthreads();
            }
        }
        SEAM(pb + 5);
        if (IN(pb + 6) && EN(13)) REP(13) { PH_TID();
            pg8::Gemm g{oxb, wl(P, l, W_O), T_TOK, DM, DM}; pg8::StaticOrder S; S.init(T_TOK, DM, G, blockIdx.x);
            pg8::EpiResid E{xb, part, rep_ ? 0.f : 1.f}; pg8::gemm_phase(lds, g, S, E, tid);
        }
        SEAM(pb + 6);
        if (IN(pb + 7) && EN(14)) REP(14) { PH_TID();
            pg8::Gemm g{xb, wl(P, l, W_1), T_TOK, DFF, DM}; pg8::StaticOrder S; S.init(T_TOK, DFF, G, blockIdx.x);
            pg8::scale_table(lds, S, part, tid);
            pg8::EpiScaleBf16<1> E{zb, DFF, part}; pg8::gemm_phase(lds, g, S, E, tid);
        }
        SEAM(pb + 7);
        if (IN(pb + 8) && EN(15)) REP(15) { PH_TID();
            pg8::Gemm g{zb, wl(P, l, W_2), T_TOK, DM, DFF}; pg8::StaticOrder S; S.init(T_TOK, DM, G, blockIdx.x);
            pg8::EpiResid E{xb, part, rep_ ? 0.f : 1.f}; pg8::gemm_phase(lds, g, S, E, tid);
        }
        SEAM(pb + 8);
    }
    if (IN(20) && EN(16)) { PH_TID(); final_norm_phase(P, tid); }
#undef IN
#undef SEAM
}

extern "C" void kernel_launch(void* const* d_in, const int* in_sizes, int n_in, void* d_out, int out_size, void* d_ws, size_t ws_size, hipStream_t stream) {
    static int grid = 0;
    if (grid == 0) {
        if (n_in != 31 || out_size != T_TOK * DM || ws_size < WS_END) { fprintf(stderr, "kernel_launch: unexpected shapes (n_in %d out %d ws %zu, need %zu)\n", n_in, out_size, ws_size, (size_t)WS_END); grid = -1; return; }
        if (hipFuncSetAttribute((const void*)hymba_fwd, hipFuncAttributeMaxDynamicSharedMemorySize, LDS_BYTES) != hipSuccess) { fprintf(stderr, "kernel_launch: hipFuncSetAttribute failed\n"); grid = -1; return; }
        int dev = 0, cus = 0, per_cu = 0;
        (void)hipGetDevice(&dev); (void)hipDeviceGetAttribute(&cus, hipDeviceAttributeMultiprocessorCount, dev);
        (void)hipOccupancyMaxActiveBlocksPerMultiprocessor(&per_cu, (const void*)hymba_fwd, 512, LDS_BYTES);
        (void)hipGetLastError();
        if (cus != 256 || per_cu < 1) fprintf(stderr, "kernel_launch: note: cus %d per_cu %d\n", cus, per_cu);
        grid = 256;
    }
    if (grid < 0) return;
    (void)hipMemsetAsync((char*)d_ws + WS_CTL, 0, CTL_BYTES, stream);
    Params p{};
    p.x = (const float*)d_in[0]; p.mem = (const float*)d_in[1]; p.pos = (const int*)d_in[2];
    p.norm_mix = (const float*)d_in[3]; p.w_in = (const float*)d_in[4]; p.ret_gn = (const float*)d_in[5];
    p.lru_conv_w = (const float*)d_in[6]; p.lru_conv_b = (const float*)d_in[7]; p.lru_wa = (const float*)d_in[8]; p.lru_ba = (const float*)d_in[9];
    p.lru_wx = (const float*)d_in[10]; p.lru_bx = (const float*)d_in[11]; p.lru_lambda = (const float*)d_in[12];
    p.mla_q_norm = (const float*)d_in[13]; p.mla_w_uq = (const float*)d_in[14]; p.mla_kv_norm = (const float*)d_in[15]; p.mla_w_ukv = (const float*)d_in[16];
    p.gdn_conv_w = (const float*)d_in[17]; p.gdn_a_log = (const float*)d_in[18]; p.gdn_dt_bias = (const float*)d_in[19]; p.gdn_norm = (const float*)d_in[20];
    p.w_out = (const float*)d_in[21]; p.norm_xattn = (const float*)d_in[22]; p.norm_mem = (const float*)d_in[23];
    p.xa_wq = (const float*)d_in[24]; p.xa_wkv = (const float*)d_in[25]; p.xa_wo = (const float*)d_in[26];
    p.norm_mlp = (const float*)d_in[27]; p.mlp_w1 = (const float*)d_in[28]; p.mlp_w2 = (const float*)d_in[29]; p.final_norm = (const float*)d_in[30];
    p.out = (float*)d_out; p.ws = (unsigned char*)d_ws;
#if N_LAUNCHES == 1
    p.ph_lo = 0; p.ph_hi = N_PHASES;
    void* args[] = {&p};
    hipError_t e = hipLaunchCooperativeKernel((const void*)hymba_fwd, dim3(grid), dim3(512), args, LDS_BYTES, stream);
    if (e != hipSuccess) fprintf(stderr, "kernel_launch: cooperative launch failed: %s\n", hipGetErrorString(e));
#else
    for (int ph = 0; ph < N_PHASES; ++ph) { p.ph_lo = ph; p.ph_hi = ph + 1; hipLaunchKernelGGL(hymba_fwd, dim3(grid), dim3(512), LDS_BYTES, stream, p); }
#endif
}
```

```cpp
#include <hip/hip_runtime.h>
#include <cstdio>
#include <cstdint>

#ifndef N_LAUNCHES
#define N_LAUNCHES 1
#endif

#define LAS __attribute__((address_space(3)))
typedef unsigned short bf16_t;
typedef short bf16x8 __attribute__((ext_vector_type(8)));
typedef float f32x4 __attribute__((ext_vector_type(4)));
typedef float f32x2 __attribute__((ext_vector_type(2)));
typedef unsigned u32x4 __attribute__((ext_vector_type(4)));
typedef unsigned u32x2 __attribute__((ext_vector_type(2)));

constexpr int T_TOK = 32768, DM = 1024, SEQ = 2048, NBATCH = 16, NCHUNK = 32, ZP = 3072, DFF = 4096, NMEM = 256;
constexpr int Z_RQ = 0, Z_RK = 256, Z_RV = 512, Z_RG = 768, Z_LX = 1024, Z_LG = 1280, Z_CQ = 1536, Z_CKV = 1728, Z_KR = 1856,
              Z_GQKV = 1888, Z_GG = 2656, Z_GB = 2912, Z_GA = 2916, IN_COLS = 2920;
constexpr float EPS = 1e-6f;
constexpr float LOG2E = 1.4426950408889634f;

constexpr size_t MiB = 1024 * 1024;
constexpr size_t WS_CTL = 0;
constexpr size_t CTL_BYTES = 65536;
constexpr size_t WS_PART = WS_CTL + CTL_BYTES;
constexpr size_t WS_LRUS = WS_PART + (size_t)T_TOK * 16 * 4;
constexpr size_t WS_GL = WS_LRUS + (size_t)2 * 16 * 32 * 256 * 4;
constexpr size_t WS_W = WS_GL + 65536;
constexpr size_t W_IN = 0, W_OUT = W_IN + (size_t)ZP * DM, W_Q = W_OUT + (size_t)DM * DM, W_KV = W_Q + (size_t)DM * DM, W_O = W_KV + (size_t)2 * DM * DM,
                 W_1 = W_O + (size_t)DM * DM, W_2 = W_1 + (size_t)DFF * DM, W_UQ = W_2 + (size_t)DFF * DM, W_UKV = W_UQ + 384 * 192, W_A = W_UKV + 512 * 128,
                 W_X = W_A + 4 * 64 * 64, W_LAYER = W_X + 4 * 64 * 64;
constexpr size_t WS_XB = WS_W + 2 * W_LAYER * 2;
constexpr size_t XB_BYTES = (size_t)T_TOK * DM * 2;
constexpr size_t MLA_Q_OFF = 0, MLA_K_OFF = (size_t)T_TOK * 4 * 96 * 2, MLA_VT_OFF = 2 * MLA_K_OFF;
constexpr size_t WS_KVM = WS_XB + XB_BYTES;
constexpr size_t KVM_LAYER = (size_t)2 * 4096 * 1024 * 2;
constexpr size_t WS_R = WS_KVM + 2 * KVM_LAYER;
constexpr size_t R_Y = (size_t)T_TOK * ZP * 2;
constexpr size_t R_OX = (size_t)T_TOK * DM * 2;
constexpr size_t WS_GDN = WS_R + 256 * MiB;
constexpr size_t WS_END = WS_GDN + 80 * MiB;
static_assert(WS_END <= 512 * MiB, "workspace map exceeds 512 MiB");
static_assert(WS_XB % 256 == 0 && WS_R % 256 == 0 && WS_GDN % 256 == 0 && WS_W % 256 == 0, "alignment");
constexpr int CW_BAR = 0;
constexpr int CW_QUEUE = 4096;

constexpr int LDS_BYTES = 160 * 1024;
constexpr int LDS_CTL = LDS_BYTES - 256;

typedef __bf16 bf16x2_t __attribute__((ext_vector_type(2)));
__device__ __forceinline__ unsigned pk2(float lo, float hi) { f32x2 t = {lo, hi}; bf16x2_t v = __builtin_convertvector(t, bf16x2_t); return __builtin_bit_cast(unsigned, v); }
__device__ __forceinline__ float bflo(unsigned w) { return __uint_as_float(w << 16); }
__device__ __forceinline__ float bfhi(unsigned w) { return __uint_as_float(w & 0xffff0000u); }
__device__ __forceinline__ float bf2f(bf16_t v) { return __uint_as_float((unsigned)v << 16); }
__device__ __forceinline__ bf16_t f2bf(float f) { return (bf16_t)(pk2(f, 0.f) & 0xffffu); }
__device__ __forceinline__ f32x4 mfma16(bf16x8 a, bf16x8 b, f32x4 c) { return __builtin_amdgcn_mfma_f32_16x16x32_bf16(a, b, c, 0, 0, 0); }
__device__ __forceinline__ float fexp2_(float x) { return __builtin_amdgcn_exp2f(x); }
__device__ __forceinline__ float fexp_(float x) { return __builtin_amdgcn_exp2f(x * LOG2E); }
__device__ __forceinline__ float frcp_(float x) { return __builtin_amdgcn_rcpf(x); }
__device__ __forceinline__ float frsq_(float x) { return __builtin_amdgcn_rsqf(x); }
__device__ __forceinline__ float fsqrt_(float x) { return __builtin_amdgcn_sqrtf(x); }
__device__ __forceinline__ float sigmoidf_(float x) { return frcp_(1.0f + fexp_(-x)); }
__device__ __forceinline__ float siluf_(float x) { return x * frcp_(1.0f + fexp_(-x)); }
__device__ __forceinline__ float softplusf_(float x) { return x > 20.f ? x : log1pf(__expf(x)); }
__device__ __forceinline__ float geluf_(float x) { const float u = 1.5957691216057308f * (x + 0.044715f * x * x * x); return x * frcp_(1.0f + fexp_(-u)); }
__device__ __forceinline__ float dpp_xor1(float x) { return __builtin_bit_cast(float, __builtin_amdgcn_update_dpp(0, __builtin_bit_cast(int, x), 0xB1, 0xF, 0xF, true)); }
__device__ __forceinline__ float dpp_xor2(float x) { return __builtin_bit_cast(float, __builtin_amdgcn_update_dpp(0, __builtin_bit_cast(int, x), 0x4E, 0xF, 0xF, true)); }
__device__ __forceinline__ float dpp_hmir(float x) { return __builtin_bit_cast(float, __builtin_amdgcn_update_dpp(0, __builtin_bit_cast(int, x), 0x141, 0xF, 0xF, true)); }
__device__ __forceinline__ float dpp_mir(float x) { return __builtin_bit_cast(float, __builtin_amdgcn_update_dpp(0, __builtin_bit_cast(int, x), 0x140, 0xF, 0xF, true)); }
__device__ __forceinline__ float sum4_(float x) { x += dpp_xor1(x); x += dpp_xor2(x); return x; }
__device__ __forceinline__ float sum8_(float x) { x = sum4_(x); x += dpp_hmir(x); return x; }
__device__ __forceinline__ float sum16_(float x) { x = sum8_(x); x += dpp_mir(x); return x; }
typedef unsigned u2v_ __attribute__((ext_vector_type(2)));
__device__ __forceinline__ float xrow_sum_(float x) { unsigned a = __builtin_bit_cast(unsigned, x), b = a; asm volatile("" : "+v"(b));
    auto r = __builtin_amdgcn_permlane16_swap(a, b, false, false);
    x = __builtin_bit_cast(float, (unsigned)r[0]) + __builtin_bit_cast(float, (unsigned)r[1]); a = __builtin_bit_cast(unsigned, x); b = a; asm volatile("" : "+v"(b));
    auto r2 = __builtin_amdgcn_permlane32_swap(a, b, false, false);
    return __builtin_bit_cast(float, (unsigned)r2[0]) + __builtin_bit_cast(float, (unsigned)r2[1]); }
__device__ __forceinline__ float xrow_max_(float x) { unsigned a = __builtin_bit_cast(unsigned, x), b = a; asm volatile("" : "+v"(b));
    auto r = __builtin_amdgcn_permlane16_swap(a, b, false, false);
    x = fmaxf(__builtin_bit_cast(float, (unsigned)r[0]), __builtin_bit_cast(float, (unsigned)r[1])); a = __builtin_bit_cast(unsigned, x); b = a; asm volatile("" : "+v"(b));
    auto r2 = __builtin_amdgcn_permlane32_swap(a, b, false, false);
    return fmaxf(__builtin_bit_cast(float, (unsigned)r2[0]), __builtin_bit_cast(float, (unsigned)r2[1])); }
__device__ __forceinline__ u32x4 widen16_(u32x2 a, u32x2 b) { auto r0 = __builtin_amdgcn_permlane16_swap(a.x, b.x, false, false); auto r1 = __builtin_amdgcn_permlane16_swap(a.y, b.y, false, false);
    u32x4 o; o.x = (unsigned)r0[0]; o.y = (unsigned)r1[0]; o.z = (unsigned)r0[1]; o.w = (unsigned)r1[1]; return o; }
__device__ __forceinline__ float wave_sum(float v) {
    return xrow_sum_(sum16_(v));
}
__device__ __forceinline__ void sincos_rev(float ang, float& s, float& c) {
    float rev = ang * 0.15915494309189535f; rev = rev - floorf(rev);
    s = __builtin_amdgcn_sinf(rev); c = __builtin_amdgcn_cosf(rev);
}
__device__ __forceinline__ bf16x8 mk8(u32x2 lo, u32x2 hi) { u32x4 t; t.x = lo.x; t.y = lo.y; t.z = hi.x; t.w = hi.y; return __builtin_bit_cast(bf16x8, t); }
__device__ __forceinline__ bf16x8 pack8(f32x4 a, f32x4 b) { u32x4 t; t.x = pk2(a.x, a.y); t.y = pk2(a.z, a.w); t.z = pk2(b.x, b.y); t.w = pk2(b.z, b.w); return __builtin_bit_cast(bf16x8, t); }

#define XB_TMO      128
#define XB_XCNT(j)  (256  + 64 * (j))
#define XB_XSUB(j)  (1280 + 64 * (j))
#define XB_XGEN(j)  (2304 + 64 * (j))
#define XB_TOP      3328
#define XB_TOPGEN   3392
#define XCD_BAR_WORDS 3456
#define XB_SPIN_CAP (1u << 22)
__device__ __forceinline__ unsigned xb_ld(unsigned* p)              { return __hip_atomic_load(p, __ATOMIC_RELAXED, __HIP_MEMORY_SCOPE_AGENT); }
__device__ __forceinline__ unsigned xb_add(unsigned* p, unsigned v) { return __hip_atomic_fetch_add(p, v, __ATOMIC_RELAXED, __HIP_MEMORY_SCOPE_AGENT); }
__device__ __forceinline__ unsigned xb_xcc_id() { return (unsigned)__builtin_amdgcn_s_getreg((3 << 11) | 20) & 0xFu; }
#define XB_SPIN(cond, bar) do { unsigned _sp = 0; while (cond) { __builtin_amdgcn_s_sleep(1); \
    if ((++_sp & 255u) == 0u) { if (xb_ld(&(bar)[XB_TMO])) break; if (_sp > XB_SPIN_CAP) { atomicAdd(&(bar)[XB_TMO], 1u); break; } } } } while (0)
struct XcdBarrier { unsigned* bar; unsigned x; volatile LAS unsigned* st; };
__device__ __forceinline__ XcdBarrier xcd_barrier_post(unsigned* bar, volatile LAS unsigned* st) {
    XcdBarrier b; b.bar = bar; b.x = xb_xcc_id(); b.st = st;
    if (threadIdx.x == 0) (void)xb_add(&bar[XB_XCNT(b.x)], 1u);
    return b;
}
__device__ __forceinline__ void xcd_barrier_complete(unsigned* bar, unsigned x, unsigned& nloc, unsigned& nx) {
    const unsigned G = gridDim.x * gridDim.y * gridDim.z;
    unsigned sum, cnt, mine, sp = 0u;
    for (;;) {
        sum = 0u; cnt = 0u; mine = 0u;
#pragma unroll
        for (unsigned j = 0; j < 16; ++j) { const unsigned c = xb_ld(&bar[XB_XCNT(j)]); sum += c; cnt += (c > 0u) ? 1u : 0u; mine = (j == x) ? c : mine; }
        if (sum == G) break;
        __builtin_amdgcn_s_sleep(1);
        if ((++sp & 255u) == 0u) { if (xb_ld(&bar[XB_TMO])) break; if (sp > XB_SPIN_CAP) { atomicAdd(&bar[XB_TMO], 1u); break; } }
    }
    nloc = mine > 0u ? mine : 1u; nx = cnt > 0u ? cnt : 1u;
}
__device__ __forceinline__ void xcd_barrier(const XcdBarrier& b) {
    asm volatile("s_waitcnt vmcnt(0)" ::: "memory");
    __syncthreads();
    if (threadIdx.x == 0) {
        unsigned* bar = b.bar;
        __builtin_amdgcn_s_waitcnt(0);
        unsigned nloc = b.st[0], nx = b.st[1];
        if (nloc == 0u) { xcd_barrier_complete(bar, b.x, nloc, nx); b.st[0] = nloc; b.st[1] = nx; }
        const unsigned old = xb_add(&bar[XB_XSUB(b.x)], 1u);
        const unsigned gen = old / nloc;
        if (old + 1u == (gen + 1u) * nloc) {
            __builtin_amdgcn_fence(__ATOMIC_RELEASE, "agent");
            asm volatile("s_waitcnt vmcnt(0)" ::: "memory");
            const unsigned og = xb_add(&bar[XB_TOP], 1u);
            const unsigned tg = og / nx;
            if (og + 1u == (tg + 1u) * nx) xb_add(&bar[XB_TOPGEN], 1u);
            else XB_SPIN(xb_ld(&bar[XB_TOPGEN]) == tg, bar);
            __builtin_amdgcn_fence(__ATOMIC_ACQUIRE, "agent");
            xb_add(&bar[XB_XGEN(b.x)], 1u);
            asm volatile("s_waitcnt vmcnt(0)" ::: "memory");
        } else {
            XB_SPIN(xb_ld(&bar[XB_XGEN(b.x)]) == gen, bar);
            __builtin_amdgcn_fence(__ATOMIC_ACQUIRE, "agent");
            asm volatile("s_waitcnt vmcnt(0)" ::: "memory");
        }
    }
    __syncthreads();
}

namespace pg8 {
constexpr int BM = 256, BK = 64, HALF = 128, HTB = HALF * BK * 2, STAGE_BYTES = 8 * HTB, NXCD = 8, WGM = 8;
__host__ __device__ __forceinline__ int lds_byte(int r, int c) { const int st = (r >> 4) * 2 + (c >> 5), rr = r & 15, cc = c & 31, ob = rr * 64 + cc * 2; return st * 1024 + (ob ^ (((ob >> 9) & 1) << 5)); }
__host__ __device__ __forceinline__ void stage_rc(int b, int& R, int& C) { const int st = b / 1024, sb = b % 1024, swz = sb ^ (((sb >> 9) & 1) << 5); R = (st >> 1) * 16 + swz / 64; C = (st & 1) * 32 + (swz % 64) / 2; }
__host__ __device__ __forceinline__ int perm32(int rho) { const int n = rho >> 4, i = rho & 15; return 8 * (i >> 2) + 4 * n + (i & 3); }
struct Unit { int pm, pn; };
struct Gemm { const bf16_t* A; const bf16_t* Bt; int M, N, K; };
struct StaticOrder {
    int nM, nN, nwg, G, c;
    __host__ __device__ void init(int M, int N, int G_, int c_) { nM = M / BM; nN = N / BM; nwg = nM * nN; G = G_; c = c_; }
    __host__ __device__ bool next(int i, Unit& u) const {
        const long L = (long)i * G + c; if (L >= nwg) return false;
        int wgid = (int)L; { const int q = nwg / NXCD, r = nwg % NXCD, xcd = wgid % NXCD, off = wgid / NXCD; wgid = (xcd < r ? xcd * (q + 1) : r * (q + 1) + (xcd - r) * q) + off; }
        const int nig = WGM * nN, gid = wgid / nig, fm = gid * WGM, gsz = (nM - fm) < WGM ? (nM - fm) : WGM;
        u.pm = fm + ((wgid % nig) % gsz); u.pn = (wgid % nig) / gsz; return true;
    }
    __device__ __forceinline__ void a_ready(const Unit&) const {}
    __device__ __forceinline__ void done(const Unit&) const {}
};

struct OneUnit { int pm, pn;
    __device__ __forceinline__ bool next(int i, Unit& u) const { if (i) return false; u.pm = pm; u.pn = pn; return true; }
    __device__ __forceinline__ void a_ready(const Unit&) const {}
    __device__ __forceinline__ void done(const Unit&) const {}
};
constexpr int SCALE_TBL = STAGE_BYTES;
template <class Sched> __device__ __forceinline__ void scale_table(LAS unsigned char* lds, const Sched& S, const float* part, int tid) {
    Unit u;
#pragma unroll 1
    for (int i = 0; i < 8 && S.next(i, u); ++i)
        if (tid < 256) { const f32x4* pp = (const f32x4*)(part + (size_t)(u.pm * BM + tid) * 16); const f32x4 a = pp[0], b = pp[1], c = pp[2], d = pp[3];
            const float s = ((a.x + a.y) + (a.z + a.w)) + ((b.x + b.y) + (b.z + b.w)) + ((c.x + c.y) + (c.z + c.w)) + ((d.x + d.y) + (d.z + d.w));
            ((LAS float*)(lds + SCALE_TBL))[i * 256 + tid] = frsq_(s * (1.0f / 1024.0f) + EPS); }
    __syncthreads();
}
template <int ACT> struct EpiScaleBf16 {
    static constexpr bool PERM = true, AFTER_DRAIN = false;
    bf16_t* O; int ldc; const float* part;
    __device__ __forceinline__ void operator()(const f32x4 (&acc)[2][2][4][2], const Unit& u, int wr, int wc, int fr, int fq, int ui, LAS unsigned char* lds) const {
        const int row0 = u.pm * BM + wr * 64 + fr, col0 = u.pn * BM + wc * 64 + 8 * fq;
        float sc[2][4];
#pragma unroll
        for (int ai = 0; ai < 2; ++ai)
#pragma unroll
            for (int m = 0; m < 4; ++m) sc[ai][m] = part ? ((const LAS float*)(lds + SCALE_TBL))[ui * 256 + wr * 64 + ai * HALF + m * 16 + fr] : 1.0f;
#pragma unroll
        for (int ai = 0; ai < 2; ++ai)
#pragma unroll
            for (int m = 0; m < 4; ++m) {
                const int row = row0 + ai * HALF + m * 16; const float s1 = sc[ai][m];
                bf16_t* rowp = O + (size_t)row * ldc + col0;
#pragma unroll
                for (int bj = 0; bj < 2; ++bj) { f32x4 v0 = acc[ai][bj][m][0] * s1, v1 = acc[ai][bj][m][1] * s1;
                    if (ACT == 1) {
#pragma unroll
                        for (int j = 0; j < 4; ++j) { const float a0 = fmaxf(v0[j], 0.f), a1 = fmaxf(v1[j], 0.f); v0[j] = a0 * a0; v1[j] = a1 * a1; } }
                    u32x4 w; w.x = pk2(v0[0], v0[1]); w.y = pk2(v0[2], v0[3]); w.z = pk2(v1[0], v1[1]); w.w = pk2(v1[2], v1[3]);
                    *(u32x4*)(rowp + bj * 32) = w; }
            }
    }
};
constexpr int QT_ROW = 264;
struct EpiScaleLds {
    static constexpr bool PERM = true, AFTER_DRAIN = true;
    const float* part;
    __device__ __forceinline__ void drained(const f32x4 (&acc)[2][2][4][2], const Unit& u, int wr, int wc, int fr, int fq, LAS unsigned char* lds) const {
        const int row0 = wr * 64 + fr, col0 = wc * 64 + 8 * fq;
#pragma unroll
        for (int ai = 0; ai < 2; ++ai)
#pragma unroll
            for (int m = 0; m < 4; ++m) {
                const int rl = row0 + ai * HALF + m * 16, row = u.pm * BM + rl;
                const f32x4 a = *((const f32x4*)(part + (size_t)row * 16) + fq);
                float s = (a.x + a.y) + (a.z + a.w); s = xrow_sum_(s);
                const float sc = frsq_(s * (1.0f / 1024.0f) + EPS);
#pragma unroll
                for (int bj = 0; bj < 2; ++bj) { const f32x4 v0 = acc[ai][bj][m][0] * sc, v1 = acc[ai][bj][m][1] * sc;
                    u32x4 w; w.x = pk2(v0[0], v0[1]); w.y = pk2(v0[2], v0[3]); w.z = pk2(v1[0], v1[1]); w.w = pk2(v1[2], v1[3]);
                    *(LAS u32x4*)(lds + (rl * QT_ROW + col0 + bj * 32) * 2) = w; }
            }
    }
};
struct EpiResid {
    static constexpr bool PERM = true, AFTER_DRAIN = false;
    bf16_t* XB; float* part; float alpha;
    __device__ __forceinline__ void operator()(const f32x4 (&acc)[2][2][4][2], const Unit& u, int wr, int wc, int fr, int fq, int ui, LAS unsigned char* lds) const {
        const int row0 = u.pm * BM + wr * 64 + fr, col0 = u.pn * BM + wc * 64 + 8 * fq;
#pragma unroll
        for (int ai = 0; ai < 2; ++ai) {
            u32x4 xw[4][2];
#pragma unroll
            for (int m = 0; m < 4; ++m)
#pragma unroll
                for (int bj = 0; bj < 2; ++bj) xw[m][bj] = *(const u32x4*)(XB + (size_t)(row0 + ai * HALF + m * 16) * DM + col0 + bj * 32);
#pragma unroll
            for (int m = 0; m < 4; ++m) {
                const int row = row0 + ai * HALF + m * 16;
                bf16_t* bp = XB + (size_t)row * DM + col0;
                float ss = 0.f;
#pragma unroll
                for (int bj = 0; bj < 2; ++bj) { const u32x4 x4 = xw[m][bj];
                    const f32x4 v0 = (f32x4){bflo(x4.x), bfhi(x4.x), bflo(x4.y), bfhi(x4.y)} + acc[ai][bj][m][0] * alpha;
                    const f32x4 v1 = (f32x4){bflo(x4.z), bfhi(x4.z), bflo(x4.w), bfhi(x4.w)} + acc[ai][bj][m][1] * alpha;
                    ss += ((v0.x * v0.x + v0.y * v0.y) + (v0.z * v0.z + v0.w * v0.w)) + ((v1.x * v1.x + v1.y * v1.y) + (v1.z * v1.z + v1.w * v1.w));
                    u32x4 w; w.x = pk2(v0.x, v0.y); w.y = pk2(v0.z, v0.w); w.z = pk2(v1.x, v1.y); w.w = pk2(v1.z, v1.w); *(u32x4*)(bp + bj * 32) = w; }
                ss = xrow_sum_(ss);
                if (fq == 0) part[(size_t)row * 16 + u.pn * 4 + wc] = ss;
            }
        }
    }
};

template <class Epi, class Sched>
__device__ __forceinline__ void gemm_phase(LAS unsigned char* lds, const Gemm g, const Sched& S, const Epi& E, const int tid) {
    const int wid = __builtin_amdgcn_readfirstlane(tid >> 6), lane = tid & 63, wr = wid >> 2, wc = wid & 3, fr = lane & 15, fq = lane >> 4;
    const int K = g.K, nt = K / BK;
    unsigned voffA[2], voffB[2];
#pragma unroll
    for (int i = 0; i < 2; ++i) { int R, C; stage_rc(tid * 16 + i * 8192, R, C); const int Rb = Epi::PERM ? (64 * (R >> 5) + perm32(R & 31)) : R;
        voffA[i] = (unsigned)(R * K + C) * 2u; voffB[i] = (unsigned)(Rb * K + C) * 2u; }
    const size_t kstep = (size_t)(BK * 2);
    const size_t hstep = (size_t)HALF * K * 2;
    const size_t tstep = 2 * hstep;
    const size_t bhstep = Epi::PERM ? (size_t)32 * K * 2 : hstep;
    const unsigned ldsw = (unsigned)wid * 1024u;
    const int aoff = lds_byte(wr * 64 + fr, fq * 8), boff = lds_byte(wc * 32 + fr, fq * 8);
#define PG8_SA(b, h) (((b) * 2 + (h)) * HTB)
#define PG8_SB(b, h) ((4 + (b) * 2 + (h)) * HTB)
#define PG8_STAGE(bufoff, gbase, voff) do { _Pragma("unroll") for (int _i = 0; _i < 2; ++_i) \
        __builtin_amdgcn_global_load_lds((const unsigned*)((const char*)(gbase) + (voff)[_i]), (LAS unsigned*)(lds + (bufoff) + ldsw + _i * 8192), 16, 0, 0); } while (0)
#define PG8_LDA(dst, b, h) do { _Pragma("unroll") for (int m = 0; m < 4; ++m) _Pragma("unroll") for (int k = 0; k < 2; ++k) dst[m][k] = *(const LAS bf16x8*)(lds + PG8_SA(b, h) + aoff + m * 2048 + k * 1024); } while (0)
#define PG8_LDB(dst, b, h) do { _Pragma("unroll") for (int n = 0; n < 2; ++n) _Pragma("unroll") for (int k = 0; k < 2; ++k) dst[n][k] = *(const LAS bf16x8*)(lds + PG8_SB(b, h) + boff + n * 2048 + k * 1024); } while (0)
#define PG8_MMA(ai, bj, At, Bt) do { __builtin_amdgcn_s_setprio(1); _Pragma("unroll") for (int m = 0; m < 4; ++m) _Pragma("unroll") for (int n = 0; n < 2; ++n) _Pragma("unroll") for (int k = 0; k < 2; ++k) \
        acc[ai][bj][m][n] = __builtin_amdgcn_mfma_f32_16x16x32_bf16(Bt[n][k], At[m][k], acc[ai][bj][m][n], 0, 0, 0); __builtin_amdgcn_s_setprio(0); } while (0)
#define PG8_WAIT_V(n) asm volatile("s_waitcnt vmcnt(" #n ")" ::: "memory")
#define PG8_WAIT_L(n) asm volatile("s_waitcnt lgkmcnt(" #n ")" ::: "memory")
#define PG8_BAR __builtin_amdgcn_s_barrier()
#define PG8_SCHED __builtin_amdgcn_sched_barrier(0)
    Unit cur, nxt; int ui = 0;
    if (!S.next(0, cur)) return;
    f32x4 acc[2][2][4][2];
#pragma unroll
    for (int a = 0; a < 2; ++a)
#pragma unroll
        for (int b = 0; b < 2; ++b)
#pragma unroll
            for (int m = 0; m < 4; ++m)
#pragma unroll
                for (int n = 0; n < 2; ++n) acc[a][b][m][n] = (f32x4){0.f, 0.f, 0.f, 0.f};
    bf16x8 At[4][2], B0[2][2], B1[2][2];
    const char* cA = (const char*)g.A + (size_t)cur.pm * tstep; const char* cB = (const char*)g.Bt + (size_t)cur.pn * tstep;
    S.a_ready(cur);
    PG8_STAGE(PG8_SB(0, 0), cB, voffB); PG8_STAGE(PG8_SA(0, 0), cA, voffA); PG8_STAGE(PG8_SB(0, 1), cB + bhstep, voffB); PG8_STAGE(PG8_SA(0, 1), cA + hstep, voffA);
    if (wr == 1) PG8_BAR;
    PG8_WAIT_V(4); PG8_BAR;
    PG8_STAGE(PG8_SB(1, 0), cB + kstep, voffB); PG8_STAGE(PG8_SA(1, 0), cA + kstep, voffA); PG8_STAGE(PG8_SB(1, 1), cB + bhstep + kstep, voffB);
    PG8_WAIT_V(6); PG8_BAR;
    for (;;) {
        const bool has_next = S.next(ui + 1, nxt);
        const char* nA = has_next ? (const char*)g.A + (size_t)nxt.pm * tstep : cA; const char* nB = has_next ? (const char*)g.Bt + (size_t)nxt.pn * tstep : cB;
        for (int t = 0; t < nt; t += 2) {
            const bool last = (t == nt - 2);
            const char* a1 = cA + (size_t)(t + 1) * kstep;
            const char* a2 = last ? nA : cA + (size_t)(t + 2) * kstep; const char* b2 = last ? nB : cB + (size_t)(t + 2) * kstep;
            const char* a3 = a2 + kstep; const char* b3 = b2 + kstep;
            if (last && has_next) S.a_ready(nxt);
            PG8_LDB(B0, 0, 0); PG8_SCHED; PG8_LDA(At, 0, 0); PG8_STAGE(PG8_SA(1, 1), a1 + hstep, voffA);
            PG8_WAIT_L(8); PG8_BAR; PG8_WAIT_L(0); PG8_MMA(0, 0, At, B0); PG8_BAR; PG8_SCHED;
            PG8_LDB(B1, 0, 1); PG8_STAGE(PG8_SB(0, 0), b2, voffB);
            PG8_BAR; PG8_WAIT_L(0); PG8_MMA(0, 1, At, B1); PG8_BAR;
            PG8_LDA(At, 0, 1); PG8_STAGE(PG8_SA(0, 0), a2, voffA);
            PG8_BAR; PG8_WAIT_L(0); PG8_MMA(1, 0, At, B0); PG8_BAR; PG8_SCHED;
            PG8_STAGE(PG8_SB(0, 1), b2 + bhstep, voffB);
            PG8_WAIT_V(6); PG8_BAR; PG8_MMA(1, 1, At, B1); PG8_BAR;
            PG8_LDB(B0, 1, 0); PG8_SCHED; PG8_LDA(At, 1, 0); PG8_STAGE(PG8_SA(0, 1), a2 + hstep, voffA);
            PG8_WAIT_L(8); PG8_BAR; PG8_WAIT_L(0); PG8_MMA(0, 0, At, B0); PG8_BAR; PG8_SCHED;
            PG8_LDB(B1, 1, 1); PG8_STAGE(PG8_SB(1, 0), b3, voffB);
            PG8_BAR; PG8_WAIT_L(0); PG8_MMA(0, 1, At, B1); PG8_BAR;
            PG8_LDA(At, 1, 1); PG8_STAGE(PG8_SA(1, 0), a3, voffA);
            PG8_BAR; PG8_WAIT_L(0); PG8_MMA(1, 0, At, B0); PG8_BAR; PG8_SCHED;
            PG8_STAGE(PG8_SB(1, 1), b3 + bhstep, voffB);
            PG8_WAIT_V(6); PG8_BAR; PG8_MMA(1, 1, At, B1); PG8_BAR;
        }
        if constexpr (!Epi::AFTER_DRAIN) { E(acc, cur, wr, wc, fr, fq, ui, lds); S.done(cur); }
        if (!has_next) break;
#pragma unroll
        for (int a = 0; a < 2; ++a)
#pragma unroll
            for (int b = 0; b < 2; ++b)
#pragma unroll
                for (int m = 0; m < 4; ++m)
#pragma unroll
                    for (int n = 0; n < 2; ++n) acc[a][b][m][n] = (f32x4){0.f, 0.f, 0.f, 0.f};
        cur = nxt; cA = nA; cB = nB; ++ui;
    }
    PG8_WAIT_V(0);
    if (wr == 0) PG8_BAR;
    PG8_BAR;
    if constexpr (Epi::AFTER_DRAIN) { E.drained(acc, cur, wr, wc, fr, fq, lds); S.done(cur); }
#undef PG8_SA
#undef PG8_SB
#undef PG8_STAGE
#undef PG8_LDA
#undef PG8_LDB
#undef PG8_MMA
#undef PG8_WAIT_V
#undef PG8_WAIT_L
#undef PG8_BAR
#undef PG8_SCHED
}
}

struct Params {
    const float* x; const float* mem; const int* pos;
    const float* norm_mix; const float* w_in; const float* ret_gn;
    const float* lru_conv_w; const float* lru_conv_b; const float* lru_wa; const float* lru_ba; const float* lru_wx; const float* lru_bx; const float* lru_lambda;
    const float* mla_q_norm; const float* mla_w_uq; const float* mla_kv_norm; const float* mla_w_ukv;
    const float* gdn_conv_w; const float* gdn_a_log; const float* gdn_dt_bias; const float* gdn_norm;
    const float* w_out; const float* norm_xattn; const float* norm_mem; const float* xa_wq; const float* xa_wkv; const float* xa_wo;
    const float* norm_mlp; const float* mlp_w1; const float* mlp_w2; const float* final_norm;
    float* out; unsigned char* ws;
    int ph_lo, ph_hi;
};

__device__ __forceinline__ bf16_t* wl(const Params& P, int l, size_t off) { return (bf16_t*)(P.ws + WS_W) + (size_t)l * W_LAYER + off; }

struct WTile { const float* src; const float* gain; bf16_t* dst; int K, N, kb, nb; float scale; };
__device__ __forceinline__ WTile p0_decode(const Params& P, int it) {
    constexpr int T_IN = 16 * 48, T_SQ = 256, T_KV = 512, T_W1 = 1024, T_W2 = 1024, T_UQ = 18, T_UKV = 16, T_LRU = 8;
    constexpr int T_LAYER = T_IN + 3 * T_SQ + T_KV + T_W1 + T_W2 + T_UQ + T_UKV + T_LRU;
    const int l = it / T_LAYER; int r = it % T_LAYER; int nnb; WTile t; t.gain = nullptr; t.scale = 1.f;
    if (r < T_IN) { t.src = P.w_in + (size_t)l * DM * IN_COLS; t.K = DM; t.N = IN_COLS; nnb = 48; t.gain = P.norm_mix + l * DM; t.dst = wl(P, l, W_IN); }
    else if ((r -= T_IN) < T_SQ) { t.src = P.w_out + (size_t)l * DM * DM; t.K = DM; t.N = DM; nnb = 16; t.dst = wl(P, l, W_OUT); }
    else if ((r -= T_SQ) < T_SQ) { t.src = P.xa_wq + (size_t)l * DM * DM; t.K = DM; t.N = DM; nnb = 16; t.gain = P.norm_xattn + l * DM; t.scale = 0.0625f * LOG2E; t.dst = wl(P, l, W_Q); }
    else if ((r -= T_SQ) < T_KV) { t.src = P.xa_wkv + (size_t)l * DM * 2 * DM; t.K = DM; t.N = 2 * DM; nnb = 32; t.gain = P.norm_mem + l * DM; t.dst = wl(P, l, W_KV); }
    else if ((r -= T_KV) < T_SQ) { t.src = P.xa_wo + (size_t)l * DM * DM; t.K = DM; t.N = DM; nnb = 16; t.dst = wl(P, l, W_O); }
    else if ((r -= T_SQ) < T_W1) { t.src = P.mlp_w1 + (size_t)l * DM * DFF; t.K = DM; t.N = DFF; nnb = 64; t.gain = P.norm_mlp + l * DM; t.dst = wl(P, l, W_1); }
    else if ((r -= T_W1) < T_W2) { t.src = P.mlp_w2 + (size_t)l * DFF * DM; t.K = DFF; t.N = DM; nnb = 16; t.dst = wl(P, l, W_2); }
    else if ((r -= T_W2) < T_UQ) { t.src = P.mla_w_uq + (size_t)l * 192 * 384; t.K = 192; t.N = 384; nnb = 6; t.gain = P.mla_q_norm + l * 192; t.dst = wl(P, l, W_UQ); }
    else if ((r -= T_UQ) < T_UKV) { t.src = P.mla_w_ukv + (size_t)l * 128 * 512; t.K = 128; t.N = 512; nnb = 8; t.gain = P.mla_kv_norm + l * 128; t.dst = wl(P, l, W_UKV); }
    else { r -= T_UKV; const int which = r >> 2, nb4 = r & 3; t.src = (which ? P.lru_wx : P.lru_wa) + (size_t)l * 4 * 4096 + nb4 * 4096; t.K = 64; t.N = 64; nnb = 1; t.dst = wl(P, l, which ? W_X : W_A) + nb4 * 4096; r = 0; }
    t.kb = r / nnb; t.nb = r % nnb; return t;
}
__device__ __forceinline__ void p0_fetch(const WTile& t, int tid, f32x4 (&v)[2]) {
#pragma unroll
    for (int i = 0; i < 2; ++i) { const int kk = (tid >> 4) + 32 * i, k = t.kb * 64 + kk, n = t.nb * 64 + (tid & 15) * 4;
        f32x4 x = {0.f, 0.f, 0.f, 0.f}; float g = t.scale;
        if (n < t.N) { x = *(const f32x4*)(t.src + (size_t)k * t.N + n); if (t.gain) g *= t.gain[k]; }
        v[i] = x * g; }
}
__device__ __forceinline__ void p0_prologue(const Params& P, LAS unsigned char* lds, int tid) {
    LAS float* scr = (LAS float*)lds;
    constexpr int NT = 2 * (16 * 48 + 3 * 256 + 512 + 1024 + 1024 + 18 + 16 + 8);
    int it = blockIdx.x;
    if (it < NT) {
        WTile cur = p0_decode(P, it); f32x4 v[2]; p0_fetch(cur, tid, v);
        for (;;) {
#pragma unroll
            for (int i = 0; i < 2; ++i) { LAS float* d = scr + ((tid >> 4) + 32 * i) * 65 + (tid & 15) * 4; d[0] = v[i].x; d[1] = v[i].y; d[2] = v[i].z; d[3] = v[i].w; }
            const int nxt = it + gridDim.x; const bool more = nxt < NT;
            WTile nx = cur; if (more) { nx = p0_decode(P, nxt); p0_fetch(nx, tid, v); }
            __syncthreads();
            { const int nl = tid >> 3, k0 = (tid & 7) * 8; const LAS float* s = scr + k0 * 65 + nl;
              u32x4 o; o.x = pk2(s[0], s[65]); o.y = pk2(s[2 * 65], s[3 * 65]); o.z = pk2(s[4 * 65], s[5 * 65]); o.w = pk2(s[6 * 65], s[7 * 65]);
              *(u32x4*)(cur.dst + (size_t)(cur.nb * 64 + nl) * cur.K + cur.kb * 64 + k0) = o; }
            __syncthreads();
            if (!more) break;
            cur = nx; it = nxt;
        }
    }
    const int wave = tid >> 6, lane = tid & 63;
    const int gw = blockIdx.x * 8 + wave, ngw = gridDim.x * 8;
    bf16_t* xb = (bf16_t*)(P.ws + WS_XB); float* part = (float*)(P.ws + WS_PART); bf16_t* memn = (bf16_t*)(P.ws + WS_GDN);
    constexpr int NR = T_TOK + NBATCH * NMEM;
    for (int row0 = gw; row0 < NR; row0 += 2 * ngw) {
        f32x4 v[2][4]; const int row1 = row0 + ngw; const bool has1 = row1 < NR;
#pragma unroll
        for (int q = 0; q < 2; ++q) { const int row = q ? (has1 ? row1 : row0) : row0; const bool isx = row < T_TOK; const int r2 = isx ? row : row - T_TOK;
            const f32x4* src = (const f32x4*)((isx ? P.x : P.mem) + (size_t)r2 * DM) + lane;
#pragma unroll
            for (int j = 0; j < 4; ++j) v[q][j] = src[64 * j]; }
#pragma unroll
        for (int q = 0; q < 2; ++q) { if (q && !has1) break; const int row = q ? row1 : row0; const bool isx = row < T_TOK; const int r2 = isx ? row : row - T_TOK;
            float s = 0.f;
#pragma unroll
            for (int j = 0; j < 4; ++j) s += (v[q][j].x * v[q][j].x + v[q][j].y * v[q][j].y) + (v[q][j].z * v[q][j].z + v[q][j].w * v[q][j].w);
            s = wave_sum(s);
            if (isx) { u32x2* ob = (u32x2*)(xb + (size_t)row * DM) + lane;
#pragma unroll
                for (int j = 0; j < 4; ++j) { u32x2 w; w.x = pk2(v[q][j].x, v[q][j].y); w.y = pk2(v[q][j].z, v[q][j].w); ob[64 * j] = w; }
                if (lane < 16) part[(size_t)row * 16 + lane] = lane == 0 ? s : 0.f;
            } else { const float rs = frsq_(s * (1.0f / 1024.0f) + EPS); u32x2* ob = (u32x2*)(memn + (size_t)r2 * DM) + lane;
#pragma unroll
                for (int j = 0; j < 4; ++j) { u32x2 w; w.x = pk2(v[q][j].x * rs, v[q][j].y * rs); w.y = pk2(v[q][j].z * rs, v[q][j].w * rs); ob[64 * j] = w; } }
        }
    }
}
__device__ __forceinline__ void final_norm_phase(const Params& P, int tid) {
    const int wave = tid >> 6, lane = tid & 63; const float* part = (const float*)(P.ws + WS_PART); const bf16_t* xb = (const bf16_t*)(P.ws + WS_XB);
    f32x4 g[4];
#pragma unroll
    for (int j = 0; j < 4; ++j) g[j] = ((const f32x4*)P.final_norm)[64 * j + lane];
    const int ngw = gridDim.x * 8;
    for (int row0 = blockIdx.x * 8 + wave; row0 < T_TOK; row0 += 4 * ngw) {
        u32x2 w[4][4]; float s[4];
#pragma unroll
        for (int q = 0; q < 4; ++q) { const int row = row0 + q * ngw; s[q] = lane < 16 ? part[(size_t)row * 16 + lane] : 0.f;
            const u32x2* xi = (const u32x2*)(xb + (size_t)row * DM) + lane;
#pragma unroll
            for (int j = 0; j < 4; ++j) w[q][j] = xi[64 * j]; }
#pragma unroll
        for (int q = 0; q < 4; ++q) { const int row = row0 + q * ngw;
            const float rs = frsq_(wave_sum(s[q]) * (1.0f / 1024.0f) + EPS);
            f32x4* o = (f32x4*)(P.out + (size_t)row * DM) + lane;
#pragma unroll
            for (int j = 0; j < 4; ++j) o[64 * j] = (f32x4){bflo(w[q][j].x), bfhi(w[q][j].x), bflo(w[q][j].y), bfhi(w[q][j].y)} * rs * g[j]; }
    }
}
__device__ __forceinline__ void mla_pre_tile(const Params& P, int l, int rt, int lane) {
    const int fr = lane & 15, fq = lane >> 4;
    const bf16_t* z = (const bf16_t*)(P.ws + WS_R);
    bf16_t* Qo = (bf16_t*)((unsigned char*)P.out + MLA_Q_OFF); bf16_t* Ko = (bf16_t*)((unsigned char*)P.out + MLA_K_OFF); bf16_t* Vo = (bf16_t*)((unsigned char*)P.out + MLA_VT_OFF);
    const bf16_t* Wuq = wl(P, l, W_UQ); const bf16_t* Wukv = wl(P, l, W_UKV);
    const int tok0 = rt * 16, b = tok0 >> 11, s0 = tok0 & 2047;
    const bf16_t* zr = z + (size_t)(tok0 + fr) * ZP;
    bf16x8 cq[6], ckv[4]; float sq = 0.f, skv = 0.f;
#pragma unroll
    for (int s = 0; s < 6; ++s) { const u32x4 w = *(const u32x4*)(zr + Z_CQ + 32 * s + 8 * fq); cq[s] = __builtin_bit_cast(bf16x8, w);
        sq += bflo(w.x) * bflo(w.x) + bfhi(w.x) * bfhi(w.x) + bflo(w.y) * bflo(w.y) + bfhi(w.y) * bfhi(w.y) + bflo(w.z) * bflo(w.z) + bfhi(w.z) * bfhi(w.z) + bflo(w.w) * bflo(w.w) + bfhi(w.w) * bfhi(w.w); }
#pragma unroll
    for (int s = 0; s < 4; ++s) { const u32x4 w = *(const u32x4*)(zr + Z_CKV + 32 * s + 8 * fq); ckv[s] = __builtin_bit_cast(bf16x8, w);
        skv += bflo(w.x) * bflo(w.x) + bfhi(w.x) * bfhi(w.x) + bflo(w.y) * bflo(w.y) + bfhi(w.y) * bfhi(w.y) + bflo(w.z) * bflo(w.z) + bfhi(w.z) * bfhi(w.z) + bflo(w.w) * bflo(w.w) + bfhi(w.w) * bfhi(w.w); }
    sq = xrow_sum_(sq); skv = xrow_sum_(skv);
    const float rq = frsq_(sq * (1.0f / 192.0f) + EPS), rkv = frsq_(skv * (1.0f / 128.0f) + EPS);
    const float qsc = rq * 0.10206207261596575f * LOG2E;
    const float pos = (float)P.pos[tok0 + fr];
    float sn[4], cs[4];
#pragma unroll
    for (int r = 0; r < 4; ++r) { const float invf = exp2f(-(float)(4 * fq + r) * (13.287712379549449f / 16.0f)); sincos_rev(pos * invf, sn[r], cs[r]); }
    const size_t tokrow = (size_t)b * 4 * SEQ + (s0 + fr);
#pragma unroll 1
    for (int h = 0; h < 4; ++h) {
        bf16_t* qrow = Qo + (tokrow + (size_t)h * SEQ) * 96;
#pragma unroll 1
        for (int nt = 0; nt < 4; ++nt) { f32x4 a = {0.f, 0.f, 0.f, 0.f};
#pragma unroll
            for (int s = 0; s < 6; ++s) { const bf16x8 wf = *(const bf16x8*)(Wuq + (size_t)(h * 96 + nt * 16 + fr) * 192 + 32 * s + 8 * fq); a = mfma16(wf, cq[s], a); }
            a = a * qsc; u32x2 w; w.x = pk2(a.x, a.y); w.y = pk2(a.z, a.w); *(u32x2*)(qrow + nt * 16 + 4 * fq) = w; }
        f32x4 x1 = {0.f, 0.f, 0.f, 0.f}, x2 = {0.f, 0.f, 0.f, 0.f}, y1, y2;
#pragma unroll
        for (int s = 0; s < 6; ++s) { const bf16x8 wf1 = *(const bf16x8*)(Wuq + (size_t)(h * 96 + 64 + fr) * 192 + 32 * s + 8 * fq), wf2 = *(const bf16x8*)(Wuq + (size_t)(h * 96 + 80 + fr) * 192 + 32 * s + 8 * fq);
            x1 = mfma16(wf1, cq[s], x1); x2 = mfma16(wf2, cq[s], x2); }
        x1 = x1 * qsc; x2 = x2 * qsc;
#pragma unroll
        for (int r = 0; r < 4; ++r) { y1[r] = x1[r] * cs[r] - x2[r] * sn[r]; y2[r] = x1[r] * sn[r] + x2[r] * cs[r]; }
        { u32x2 w; w.x = pk2(y1.x, y1.y); w.y = pk2(y1.z, y1.w); *(u32x2*)(qrow + 64 + 4 * fq) = w; w.x = pk2(y2.x, y2.y); w.y = pk2(y2.z, y2.w); *(u32x2*)(qrow + 80 + 4 * fq) = w; }
    }
    u32x2 kr1, kr2;
    { const u32x2 a = *(const u32x2*)(zr + Z_KR + 4 * fq), c = *(const u32x2*)(zr + Z_KR + 16 + 4 * fq);
      const float x1[4] = {bflo(a.x), bfhi(a.x), bflo(a.y), bfhi(a.y)}, x2[4] = {bflo(c.x), bfhi(c.x), bflo(c.y), bfhi(c.y)}; float y1[4], y2[4];
#pragma unroll
      for (int r = 0; r < 4; ++r) { y1[r] = x1[r] * cs[r] - x2[r] * sn[r]; y2[r] = x1[r] * sn[r] + x2[r] * cs[r]; }
      kr1.x = pk2(y1[0], y1[1]); kr1.y = pk2(y1[2], y1[3]); kr2.x = pk2(y2[0], y2[1]); kr2.y = pk2(y2[2], y2[3]); }
    float rkv_r[4];
#pragma unroll
    for (int r = 0; r < 4; ++r) rkv_r[r] = __builtin_bit_cast(float, __builtin_amdgcn_ds_bpermute((4 * fq + r) << 2, __builtin_bit_cast(int, rkv)));
    const int chunk = s0 >> 6, key0 = (s0 & 63) + 4 * fq;
#pragma unroll 1
    for (int h = 0; h < 4; ++h) {
        bf16_t* krow = Ko + (tokrow + (size_t)h * SEQ) * 96;
#pragma unroll 1
        for (int nt = 0; nt < 4; ++nt) { f32x4 a = {0.f, 0.f, 0.f, 0.f};
#pragma unroll
            for (int s = 0; s < 4; ++s) { const bf16x8 wf = *(const bf16x8*)(Wukv + (size_t)(h * 128 + nt * 16 + fr) * 128 + 32 * s + 8 * fq); a = mfma16(wf, ckv[s], a); }
            a = a * rkv; u32x2 w; w.x = pk2(a.x, a.y); w.y = pk2(a.z, a.w); *(u32x2*)(krow + nt * 16 + 4 * fq) = w; }
        *(u32x2*)(krow + 64 + 4 * fq) = kr1; *(u32x2*)(krow + 80 + 4 * fq) = kr2;
        bf16_t* vt = Vo + ((size_t)((b * 4 + h) * NCHUNK + chunk) * 64) * 64;
#pragma unroll 1
        for (int nt = 0; nt < 4; ++nt) { f32x4 a = {0.f, 0.f, 0.f, 0.f};
#pragma unroll
            for (int s = 0; s < 4; ++s) { const bf16x8 wf = *(const bf16x8*)(Wukv + (size_t)(h * 128 + 64 + nt * 16 + fr) * 128 + 32 * s + 8 * fq); a = mfma16(ckv[s], wf, a); }
            u32x2 w; w.x = pk2(a.x * rkv_r[0], a.y * rkv_r[1]); w.y = pk2(a.z * rkv_r[2], a.w * rkv_r[3]);
            *(u32x2*)(vt + (size_t)(nt * 16 + fr) * 64 + key0) = w; }
    }
}

constexpr int MP_UQ_ROW = 200, MP_UKV_ROW = 136, MP_UKV_OFF = 96 * MP_UQ_ROW * 2, MP_BUF = MP_UKV_OFF + 128 * MP_UKV_ROW * 2;
__device__ __forceinline__ void mla_pre_item(const Params& P, int l, LAS unsigned char* lds, int it, int tid, int wave, int lane) {
    const int fr = lane & 15, fq = lane >> 4, rt = it * 8 + wave;
    const bf16_t* z = (const bf16_t*)(P.ws + WS_R);
    bf16_t* Qo = (bf16_t*)((unsigned char*)P.out + MLA_Q_OFF); bf16_t* Ko = (bf16_t*)((unsigned char*)P.out + MLA_K_OFF); bf16_t* Vo = (bf16_t*)((unsigned char*)P.out + MLA_VT_OFF);
    const bf16_t* Wuq = wl(P, l, W_UQ); const bf16_t* Wukv = wl(P, l, W_UKV);
    u32x4 stg[5];
#define MP_LOADQ(h_) do { _Pragma("unroll") for (int i = 0; i < 5; ++i) { const int p = tid + 512 * i; if (p < 2304) stg[i] = *(const u32x4*)(Wuq + (size_t)(h_) * 96 * 192 + (size_t)p * 8); } } while (0)
#define MP_STOREQ(buf_) do { _Pragma("unroll") for (int i = 0; i < 5; ++i) { const int p = tid + 512 * i; if (p < 2304) { const int row = p / 24, pc = p % 24; *(LAS u32x4*)(lds + (buf_) * MP_BUF + (row * MP_UQ_ROW + pc * 8) * 2) = stg[i]; } } } while (0)
#define MP_LOADKV(h_) do { _Pragma("unroll") for (int i = 0; i < 4; ++i) { const int p = tid + 512 * i; stg[i] = *(const u32x4*)(Wukv + (size_t)(h_) * 128 * 128 + (size_t)p * 8); } } while (0)
#define MP_STOREKV(buf_) do { _Pragma("unroll") for (int i = 0; i < 4; ++i) { const int p = tid + 512 * i, row = p >> 4, pc = p & 15; *(LAS u32x4*)(lds + (buf_) * MP_BUF + MP_UKV_OFF + (row * MP_UKV_ROW + pc * 8) * 2) = stg[i]; } } while (0)
    MP_LOADQ(0); MP_STOREQ(0); MP_LOADKV(0);
    const int tok0 = rt * 16, b = tok0 >> 11, s0 = tok0 & 2047;
    const bf16_t* zr = z + (size_t)(tok0 + fr) * ZP;
    bf16x8 cq[6], ckv[4]; float sq = 0.f, skv = 0.f;
#pragma unroll
    for (int s = 0; s < 6; ++s) { const u32x4 w = *(const u32x4*)(zr + Z_CQ + 32 * s + 8 * fq); cq[s] = __builtin_bit_cast(bf16x8, w);
        sq += bflo(w.x) * bflo(w.x) + bfhi(w.x) * bfhi(w.x) + bflo(w.y) * bflo(w.y) + bfhi(w.y) * bfhi(w.y) + bflo(w.z) * bflo(w.z) + bfhi(w.z) * bfhi(w.z) + bflo(w.w) * bflo(w.w) + bfhi(w.w) * bfhi(w.w); }
#pragma unroll
    for (int s = 0; s < 4; ++s) { const u32x4 w = *(const u32x4*)(zr + Z_CKV + 32 * s + 8 * fq); ckv[s] = __builtin_bit_cast(bf16x8, w);
        skv += bflo(w.x) * bflo(w.x) + bfhi(w.x) * bfhi(w.x) + bflo(w.y) * bflo(w.y) + bfhi(w.y) * bfhi(w.y) + bflo(w.z) * bflo(w.z) + bfhi(w.z) * bfhi(w.z) + bflo(w.w) * bflo(w.w) + bfhi(w.w) * bfhi(w.w); }
    const u32x2 kra = *(const u32x2*)(zr + Z_KR + 4 * fq), krc = *(const u32x2*)(zr + Z_KR + 16 + 4 * fq);
    const float pos = (float)P.pos[tok0 + fr];
    MP_STOREKV(0);
    sq = xrow_sum_(sq); skv = xrow_sum_(skv);
    const float rq = frsq_(sq * (1.0f / 192.0f) + EPS), rkv = frsq_(skv * (1.0f / 128.0f) + EPS);
    const float qsc = rq * 0.10206207261596575f * LOG2E;
    float sn[4], cs[4];
#pragma unroll
    for (int r = 0; r < 4; ++r) { const float invf = exp2f(-(float)(4 * fq + r) * (13.287712379549449f / 16.0f)); sincos_rev(pos * invf, sn[r], cs[r]); }
    const size_t tokrow = (size_t)b * 4 * SEQ + (s0 + fr);
    u32x2 kr1, kr2;
    { const float x1[4] = {bflo(kra.x), bfhi(kra.x), bflo(kra.y), bfhi(kra.y)}, x2[4] = {bflo(krc.x), bfhi(krc.x), bflo(krc.y), bfhi(krc.y)}; float y1[4], y2[4];
#pragma unroll
      for (int r = 0; r < 4; ++r) { y1[r] = x1[r] * cs[r] - x2[r] * sn[r]; y2[r] = x1[r] * sn[r] + x2[r] * cs[r]; }
      kr1.x = pk2(y1[0], y1[1]); kr1.y = pk2(y1[2], y1[3]); kr2.x = pk2(y2[0], y2[1]); kr2.y = pk2(y2[2], y2[3]); }
    float rkv_r[4];
#pragma unroll
    for (int r = 0; r < 4; ++r) rkv_r[r] = __builtin_bit_cast(float, __builtin_amdgcn_ds_bpermute((4 * fq + r) << 2, __builtin_bit_cast(int, rkv)));
    const u32x4 kr16 = widen16_(kr1, kr2);
    const int chunk = s0 >> 6, key0 = (s0 & 63) + 4 * fq;
    __syncthreads();
#pragma unroll 1
    for (int h = 0; h < 4; ++h) {
        if (h < 3) MP_LOADQ(h + 1);
        const LAS bf16_t* UQ = (const LAS bf16_t*)(lds + (h & 1) * MP_BUF); const LAS bf16_t* UKV = (const LAS bf16_t*)(lds + (h & 1) * MP_BUF + MP_UKV_OFF);
        bf16_t* qrow = Qo + (tokrow + (size_t)h * SEQ) * 96; bf16_t* krow = Ko + (tokrow + (size_t)h * SEQ) * 96;
        bf16_t* vt = Vo + ((size_t)((b * 4 + h) * NCHUNK + chunk) * 64) * 64;
        const int wsel = fq & 1, woff = (fq >> 1) * 8;
#pragma unroll 1
        for (int np = 0; np < 2; ++np) { f32x4 a = {0.f, 0.f, 0.f, 0.f}, a2 = {0.f, 0.f, 0.f, 0.f};
#pragma unroll
            for (int s = 0; s < 6; ++s) { a = mfma16(*(const LAS bf16x8*)(UQ + (np * 32 + fr) * MP_UQ_ROW + 32 * s + 8 * fq), cq[s], a); a2 = mfma16(*(const LAS bf16x8*)(UQ + (np * 32 + 16 + fr) * MP_UQ_ROW + 32 * s + 8 * fq), cq[s], a2); }
            a = a * qsc; a2 = a2 * qsc; u32x2 w, w2; w.x = pk2(a.x, a.y); w.y = pk2(a.z, a.w); w2.x = pk2(a2.x, a2.y); w2.y = pk2(a2.z, a2.w);
            *(u32x4*)(qrow + (np * 2 + wsel) * 16 + woff) = widen16_(w, w2); }
        {   f32x4 x1 = {0.f, 0.f, 0.f, 0.f}, x2 = {0.f, 0.f, 0.f, 0.f}, y1, y2;
#pragma unroll
            for (int s = 0; s < 6; ++s) { x1 = mfma16(*(const LAS bf16x8*)(UQ + (64 + fr) * MP_UQ_ROW + 32 * s + 8 * fq), cq[s], x1); x2 = mfma16(*(const LAS bf16x8*)(UQ + (80 + fr) * MP_UQ_ROW + 32 * s + 8 * fq), cq[s], x2); }
            x1 = x1 * qsc; x2 = x2 * qsc;
#pragma unroll
            for (int r = 0; r < 4; ++r) { y1[r] = x1[r] * cs[r] - x2[r] * sn[r]; y2[r] = x1[r] * sn[r] + x2[r] * cs[r]; }
            u32x2 w, w2; w.x = pk2(y1.x, y1.y); w.y = pk2(y1.z, y1.w); w2.x = pk2(y2.x, y2.y); w2.y = pk2(y2.z, y2.w);
            *(u32x4*)(qrow + 64 + wsel * 16 + woff) = widen16_(w, w2); }
        if (h < 3) { MP_STOREQ((h + 1) & 1); MP_LOADKV(h + 1); }
#pragma unroll 1
        for (int np = 0; np < 2; ++np) { f32x4 a = {0.f, 0.f, 0.f, 0.f}, a2 = {0.f, 0.f, 0.f, 0.f};
#pragma unroll
            for (int s = 0; s < 4; ++s) { a = mfma16(*(const LAS bf16x8*)(UKV + (np * 32 + fr) * MP_UKV_ROW + 32 * s + 8 * fq), ckv[s], a); a2 = mfma16(*(const LAS bf16x8*)(UKV + (np * 32 + 16 + fr) * MP_UKV_ROW + 32 * s + 8 * fq), ckv[s], a2); }
            a = a * rkv; a2 = a2 * rkv; u32x2 w, w2; w.x = pk2(a.x, a.y); w.y = pk2(a.z, a.w); w2.x = pk2(a2.x, a2.y); w2.y = pk2(a2.z, a2.w);
            *(u32x4*)(krow + (np * 2 + wsel) * 16 + woff) = widen16_(w, w2); }
        *(u32x4*)(krow + 64 + wsel * 16 + woff) = kr16;
#pragma unroll 1
        for (int np = 0; np < 2; ++np) { f32x4 a = {0.f, 0.f, 0.f, 0.f}, a2 = {0.f, 0.f, 0.f, 0.f};
#pragma unroll
            for (int s = 0; s < 4; ++s) { a = mfma16(ckv[s], *(const LAS bf16x8*)(UKV + (64 + np * 32 + fr) * MP_UKV_ROW + 32 * s + 8 * fq), a); a2 = mfma16(ckv[s], *(const LAS bf16x8*)(UKV + (64 + np * 32 + 16 + fr) * MP_UKV_ROW + 32 * s + 8 * fq), a2); }
            u32x2 w, w2; w.x = pk2(a.x * rkv_r[0], a.y * rkv_r[1]); w.y = pk2(a.z * rkv_r[2], a.w * rkv_r[3]); w2.x = pk2(a2.x * rkv_r[0], a2.y * rkv_r[1]); w2.y = pk2(a2.z * rkv_r[2], a2.w * rkv_r[3]);
            *(u32x4*)(vt + (size_t)((np * 2 + wsel) * 16 + fr) * 64 + (s0 & 63) + woff) = widen16_(w, w2); }
        if (h < 3) MP_STOREKV((h + 1) & 1);
        __syncthreads();
    }
#undef MP_LOADQ
#undef MP_STOREQ
#undef MP_LOADKV
#undef MP_STOREKV
}

template <int DQK, int DV, int KT, int QT>
__device__ __forceinline__ void flash_item(LAS unsigned char* lds, const bf16_t* Qw, int ldq, const bf16_t* Kb, int ldk, const bf16_t* VTb, int ldv, int vts,
                                           bf16_t* Ow, int ldo, int ntiles, int wave_limit, int tid, int lane) {
    constexpr int KROW = DQK + 8, VROW = KT + 8, KS = DQK / 32, ET = DV / 16, NKT = KT / 16, KBYTES = KT * KROW * 2, BUF = KBYTES + DV * VROW * 2;
    constexpr int KP = KT * DQK / 8, VPR = KT / 8, VP = DV * VPR, NKP = (KP + 511) / 512, NVP = (VP + 511) / 512, NP = NKP > NVP ? NKP : NVP;
    const int fr = lane & 15, fq = lane >> 4;
    bf16x8 qf[QT][KS];
#pragma unroll
    for (int qi = 0; qi < QT; ++qi)
#pragma unroll
        for (int s = 0; s < KS; ++s) qf[qi][s] = *(const bf16x8*)(Qw + (size_t)(qi * 16 + fr) * ldq + 32 * s + 8 * fq);
    f32x4 ot[QT][ET];
#pragma unroll
    for (int qi = 0; qi < QT; ++qi)
#pragma unroll
        for (int e = 0; e < ET; ++e) ot[qi][e] = (f32x4){0.f, 0.f, 0.f, 0.f};
    float m_run[QT], l_run[QT];
#pragma unroll
    for (int qi = 0; qi < QT; ++qi) { m_run[qi] = -1e30f; l_run[qi] = 0.f; }
    u32x4 pregk[NKP], pregv[NVP];
    typedef const __attribute__((address_space(1))) u32x4* gp4_t;
#define FL_LOADK(j_) do { _Pragma("unroll") for (int i = 0; i < NKP; ++i) { const int idx0 = tid + i * 512, idx = idx0 < KP ? idx0 : idx0 - 512, row = idx / (DQK / 8), pc = idx % (DQK / 8); \
            pregk[i] = *(gp4_t)(Kb + (size_t)((j_) * KT + row) * ldk + pc * 8); } } while (0)
#define FL_LOADV(j_) do { _Pragma("unroll") for (int i = 0; i < NVP; ++i) { const int idx0 = tid + i * 512, idx = idx0 < VP ? idx0 : idx0 - 512, row = idx / VPR, pc = idx % VPR; \
            pregv[i] = *(gp4_t)(VTb + (size_t)(j_) * vts + (size_t)row * ldv + pc * 8); } } while (0)
#define FL_STOREK(buf_) do { LAS bf16_t* Kt_ = (LAS bf16_t*)(lds + (buf_) * BUF); \
        _Pragma("unroll") for (int i = 0; i < NKP; ++i) { const int idx0 = tid + i * 512, idx = idx0 < KP ? idx0 : idx0 - 512, row = idx / (DQK / 8), pc = idx % (DQK / 8); *(LAS u32x4*)(Kt_ + row * KROW + pc * 8) = pregk[i]; } } while (0)
#define FL_STOREV(buf_) do { LAS bf16_t* Vt_ = (LAS bf16_t*)(lds + (buf_) * BUF + KBYTES); \
        _Pragma("unroll") for (int i = 0; i < NVP; ++i) { const int idx0 = tid + i * 512, idx = idx0 < VP ? idx0 : idx0 - 512, row = idx / VPR, pc = idx % VPR; *(LAS u32x4*)(Vt_ + row * VROW + pc * 8) = pregv[i]; } } while (0)
    FL_LOADK(0); FL_LOADV(0); FL_STOREK(0); FL_STOREV(0);
    { const int j1 = 1 < ntiles ? 1 : 0; FL_LOADK(j1); FL_LOADV(j1); }
    __syncthreads();
#pragma unroll 1
    for (int j = 0; j < ntiles; ++j) {
        const bool act = j < wave_limit;
        const int jn = j + 2 < ntiles ? j + 2 : ntiles - 1;
        const LAS bf16_t* Kt = (const LAS bf16_t*)(lds + (j & 1) * BUF); const LAS bf16_t* Vt = (const LAS bf16_t*)(lds + (j & 1) * BUF + KBYTES);
        FL_STOREK((j + 1) & 1); FL_STOREV((j + 1) & 1);
        FL_LOADK(jn); FL_LOADV(jn);
        __builtin_amdgcn_sched_barrier(0);
        f32x4 st[QT][NKT];
        if (act) {
#pragma unroll
            for (int kt = 0; kt < NKT; ++kt) {
#pragma unroll
                for (int qi = 0; qi < QT; ++qi) st[qi][kt] = (f32x4){0.f, 0.f, 0.f, 0.f};
#pragma unroll
                for (int s = 0; s < KS; ++s) { const bf16x8 kf = *(const LAS bf16x8*)(Kt + (kt * 16 + fr) * KROW + 32 * s + 8 * fq);
#pragma unroll
                    for (int qi = 0; qi < QT; ++qi) st[qi][kt] = mfma16(kf, qf[qi][s], st[qi][kt]); } }
        }
        if (act) {
            bf16x8 pf[QT][NKT / 2];
#pragma unroll
            for (int qi = 0; qi < QT; ++qi) {
                float mx = fmaxf(fmaxf(st[qi][0].x, st[qi][0].y), fmaxf(st[qi][0].z, st[qi][0].w));
#pragma unroll
                for (int kt = 1; kt < NKT; ++kt) mx = fmaxf(mx, fmaxf(fmaxf(st[qi][kt].x, st[qi][kt].y), fmaxf(st[qi][kt].z, st[qi][kt].w)));
                mx = xrow_max_(mx);
                const float m_new = fmaxf(m_run[qi], mx), alpha = fexp2_(m_run[qi] - m_new);
                float ls = 0.f;
#pragma unroll
                for (int kt = 0; kt < NKT; ++kt)
#pragma unroll
                    for (int r = 0; r < 4; ++r) { const float p = fexp2_(st[qi][kt][r] - m_new); st[qi][kt][r] = p; ls += p; }
                l_run[qi] = l_run[qi] * alpha + ls; m_run[qi] = m_new;
#pragma unroll
                for (int e = 0; e < ET; ++e) ot[qi][e] = ot[qi][e] * alpha;
#pragma unroll
                for (int k2 = 0; k2 < NKT / 2; ++k2) pf[qi][k2] = pack8(st[qi][2 * k2], st[qi][2 * k2 + 1]);
            }
#pragma unroll
            for (int e = 0; e < ET; ++e) {
                const LAS bf16_t* vr = Vt + (e * 16 + fr) * VROW + 4 * fq;
#pragma unroll
                for (int k2 = 0; k2 < NKT / 2; ++k2) { const bf16x8 v0 = mk8(*(const LAS u32x2*)(vr + 32 * k2), *(const LAS u32x2*)(vr + 32 * k2 + 16));
#pragma unroll
                    for (int qi = 0; qi < QT; ++qi) ot[qi][e] = mfma16(v0, pf[qi][k2], ot[qi][e]); }
            }
        }
        __syncthreads();
    }
#undef FL_LOADK
#undef FL_LOADV
#undef FL_STOREK
#undef FL_STOREV
#pragma unroll
    for (int qi = 0; qi < QT; ++qi) {
        float l = l_run[qi]; l = xrow_sum_(l);
        const float inv = frcp_(l);
#pragma unroll
        for (int e2 = 0; e2 < ET / 2; ++e2) { u32x2 w, w2;
            w.x = pk2(ot[qi][2 * e2].x * inv, ot[qi][2 * e2].y * inv); w.y = pk2(ot[qi][2 * e2].z * inv, ot[qi][2 * e2].w * inv);
            w2.x = pk2(ot[qi][2 * e2 + 1].x * inv, ot[qi][2 * e2 + 1].y * inv); w2.y = pk2(ot[qi][2 * e2 + 1].z * inv, ot[qi][2 * e2 + 1].w * inv);
            *(u32x4*)(Ow + (size_t)(qi * 16 + fr) * ldo + (2 * e2 + (fq & 1)) * 16 + (fq >> 1) * 8) = widen16_(w, w2); }
    }
}
__device__ __forceinline__ void mla_attn_item(const Params& P, LAS unsigned char* lds, int it, int tid, int wave, int lane) {
    const int qt = 7 - (it >> 6), bh = it & 63;
    const bf16_t* Q = (const bf16_t*)((unsigned char*)P.out + MLA_Q_OFF) + ((size_t)bh * SEQ + qt * 256 + wave * 32) * 96;
    const bf16_t* K = (const bf16_t*)((unsigned char*)P.out + MLA_K_OFF) + (size_t)bh * SEQ * 96;
    const bf16_t* VT = (const bf16_t*)((unsigned char*)P.out + MLA_VT_OFF) + (size_t)bh * NCHUNK * 4096;
    bf16_t* y = (bf16_t*)(P.ws + WS_R + R_Y) + ((size_t)(bh >> 2) * SEQ + qt * 256 + wave * 32) * DM + 512 + (bh & 3) * 64;
    flash_item<96, 64, 64, 2>(lds, Q, 96, K, 96, VT, 64, 4096, y, DM, 4 * qt + 4, 4 * qt + (wave >> 1) + 1, tid, lane);
}
constexpr int XA_KROW = 264, XA_VROW = 72, XA_KBUF = 32 * XA_KROW * 2, XA_VBUF = 128 * XA_VROW * 2, XA_VOFF = 2 * XA_KBUF;
__device__ __forceinline__ void xa_item(const Params& P, int l, LAS unsigned char* lds, int it, int tid, int wave, int lane) {
    const int qt = it & 7, h = (it >> 3) & 3, b = it >> 5, fr = lane & 15, fq = lane >> 4;
    const size_t qoff = ((size_t)b * SEQ + qt * 256 + wave * 32) * DM + h * 256;
    bf16_t* O = (bf16_t*)(P.ws + WS_R + R_OX) + qoff;
    const bf16_t* Kb = (const bf16_t*)(P.ws + WS_KVM + (size_t)l * KVM_LAYER) + (size_t)b * NMEM * DM + h * 256;
    const bf16_t* VTb = (const bf16_t*)(P.ws + WS_KVM + (size_t)l * KVM_LAYER + (size_t)4096 * 1024 * 2) + (size_t)h * 256 * 4096 + b * NMEM;
    u32x4 stg[2];
#define XA_LOADK(j_) do { _Pragma("unroll") for (int i = 0; i < 2; ++i) { const int p = tid + 512 * i, row = p >> 5, pc = p & 31; stg[i] = *(const u32x4*)(Kb + (size_t)((j_) * 32 + row) * DM + pc * 8); } } while (0)
#define XA_STOREK(buf_) do { _Pragma("unroll") for (int i = 0; i < 2; ++i) { const int p = tid + 512 * i, row = p >> 5, pc = p & 31; *(LAS u32x4*)(lds + (buf_) * XA_KBUF + (row * XA_KROW + pc * 8) * 2) = stg[i]; } } while (0)
#define XA_LOADV(t_) do { _Pragma("unroll") for (int i = 0; i < 2; ++i) { const int p = tid + 512 * i, row = p >> 3, pc = p & 7; stg[i] = *(const u32x4*)(VTb + (size_t)(((t_) >> 2) * 128 + row) * 4096 + ((t_) & 3) * 64 + pc * 8); } } while (0)
#define XA_STOREV(buf_) do { _Pragma("unroll") for (int i = 0; i < 2; ++i) { const int p = tid + 512 * i, row = p >> 3, pc = p & 7; *(LAS u32x4*)(lds + XA_VOFF + (buf_) * XA_VBUF + (row * XA_VROW + pc * 8) * 2) = stg[i]; } } while (0)
    XA_LOADK(0);
    bf16x8 pf[2][8];
    float linv[2], c1[2];
    {
        bf16x8 qf[2][8];
#pragma unroll
        for (int qi = 0; qi < 2; ++qi)
#pragma unroll
            for (int s = 0; s < 8; ++s) qf[qi][s] = *(const LAS bf16x8*)(lds + ((wave * 32 + qi * 16 + fr) * pg8::QT_ROW + 32 * s + 8 * fq) * 2);
        asm volatile("s_waitcnt lgkmcnt(0)" ::: "memory");
        __syncthreads();
        XA_STOREK(0);
        __syncthreads();
        float m1[2], l1[2];
#pragma unroll
        for (int half = 0; half < 2; ++half) {
            f32x4 S[2][8];
#pragma unroll
            for (int jj = 0; jj < 4; ++jj) { const int j = half * 4 + jj;
                if (j < 7) XA_LOADK(j + 1); else XA_LOADV(0);
                const LAS bf16_t* Kt = (const LAS bf16_t*)(lds + (j & 1) * XA_KBUF);
#pragma unroll
                for (int kt = 0; kt < 2; ++kt) {
                    f32x4 a0 = {0.f, 0.f, 0.f, 0.f}, a1 = {0.f, 0.f, 0.f, 0.f};
#pragma unroll
                    for (int s = 0; s < 8; ++s) { const bf16x8 kf = *(const LAS bf16x8*)(Kt + (kt * 16 + fr) * XA_KROW + 32 * s + 8 * fq); a0 = mfma16(kf, qf[0][s], a0); a1 = mfma16(kf, qf[1][s], a1); }
                    S[0][2 * jj + kt] = a0; S[1][2 * jj + kt] = a1; __builtin_amdgcn_sched_barrier(0); }
                if (j < 7) XA_STOREK((j + 1) & 1); else XA_STOREV(0);
                __syncthreads();
            }
#pragma unroll
            for (int qi = 0; qi < 2; ++qi) {
                float mx = -1e30f;
#pragma unroll
                for (int t = 0; t < 8; ++t) mx = fmaxf(mx, fmaxf(fmaxf(S[qi][t].x, S[qi][t].y), fmaxf(S[qi][t].z, S[qi][t].w)));
                mx = xrow_max_(mx);
                if (half == 1) { const float m = fmaxf(m1[qi], mx); c1[qi] = fexp2_(m1[qi] - m); mx = m; }
                float ls = 0.f;
#pragma unroll
                for (int t = 0; t < 4; ++t) { f32x4 pa, pb;
#pragma unroll
                    for (int r = 0; r < 4; ++r) { pa[r] = fexp2_(S[qi][2 * t][r] - mx); pb[r] = fexp2_(S[qi][2 * t + 1][r] - mx); }
                    ls += ((pa.x + pa.y) + (pa.z + pa.w)) + ((pb.x + pb.y) + (pb.z + pb.w));
                    pf[qi][half * 4 + t] = pack8(pa, pb);
                    asm volatile("" : "+v"(ls)); }
                ls = xrow_sum_(ls);
                if (half == 0) { m1[qi] = mx; l1[qi] = ls; } else linv[qi] = frcp_(l1[qi] * c1[qi] + ls);
            }
        }
    }
#pragma unroll
    for (int eh = 0; eh < 2; ++eh) {
        f32x4 ot[2][8];
#pragma unroll
        for (int qi = 0; qi < 2; ++qi)
#pragma unroll
            for (int e = 0; e < 8; ++e) ot[qi][e] = (f32x4){0.f, 0.f, 0.f, 0.f};
#pragma unroll
        for (int jv = 0; jv < 4; ++jv) { const int t = eh * 4 + jv;
            if (t < 7) XA_LOADV(t + 1);
            const LAS bf16_t* Vt = (const LAS bf16_t*)(lds + XA_VOFF + (t & 1) * XA_VBUF);
#pragma unroll
            for (int e = 0; e < 8; ++e) { const LAS bf16_t* vr = Vt + (e * 16 + fr) * XA_VROW + 4 * fq;
                const bf16x8 v0 = mk8(*(const LAS u32x2*)vr, *(const LAS u32x2*)(vr + 16)), v1 = mk8(*(const LAS u32x2*)(vr + 32), *(const LAS u32x2*)(vr + 48));
                ot[0][e] = mfma16(v0, pf[0][2 * jv], ot[0][e]); ot[1][e] = mfma16(v0, pf[1][2 * jv], ot[1][e]);
                ot[0][e] = mfma16(v1, pf[0][2 * jv + 1], ot[0][e]); ot[1][e] = mfma16(v1, pf[1][2 * jv + 1], ot[1][e]); if (e & 1) __builtin_amdgcn_sched_barrier(0); }
            if (jv == 1) {
#pragma unroll
                for (int e = 0; e < 8; ++e) { ot[0][e] = ot[0][e] * c1[0]; ot[1][e] = ot[1][e] * c1[1]; } }
            if (t < 7) XA_STOREV((t + 1) & 1);
            __syncthreads();
        }
#pragma unroll
        for (int qi = 0; qi < 2; ++qi)
#pragma unroll
            for (int e2 = 0; e2 < 4; ++e2) { u32x2 w, w2; const float li = linv[qi];
                w.x = pk2(ot[qi][2 * e2].x * li, ot[qi][2 * e2].y * li); w.y = pk2(ot[qi][2 * e2].z * li, ot[qi][2 * e2].w * li);
                w2.x = pk2(ot[qi][2 * e2 + 1].x * li, ot[qi][2 * e2 + 1].y * li); w2.y = pk2(ot[qi][2 * e2 + 1].z * li, ot[qi][2 * e2 + 1].w * li);
                *(u32x4*)(O + (size_t)(qi * 16 + fr) * DM + eh * 128 + (2 * e2 + (fq & 1)) * 16 + (fq >> 1) * 8) = widen16_(w, w2); }
    }
#undef XA_LOADK
#undef XA_STOREK
#undef XA_LOADV
#undef XA_STOREV
}
constexpr int GP_KN = 0, GP_KB = 9216, GP_QN = 18432, GP_L = 9216, GP_RHS = 27648, GP_G = 60416, GP_GC = 60672, GP_EK = 60928, GP_HEAD = 61440, GP_CW = 2 * 61440;
__device__ __forceinline__ bf16_t* gdn_buf(const Params& P, int chh, int k) { return (bf16_t*)(P.ws + WS_GDN) + ((size_t)chh * 5 + k) * 4096; }
__device__ __forceinline__ void gdn_pre_item(const Params& P, int l, LAS unsigned char* lds, int it, int tid) {
    const int hp = it & 1, n = (it >> 1) & 31, b = it >> 6;
    const int hh = tid >> 8, h = 2 * hp + hh, tt = tid & 255, c = tt >> 2, qr = tt & 3, lane = tid & 63;
    LAS unsigned char* L = lds + hh * GP_HEAD;
    const bf16_t* z = (const bf16_t*)(P.ws + WS_R);
    const int s = n * 64 + c; const size_t tok = (size_t)b * SEQ + s;
    const int chh = (b * NCHUNK + n) * 4 + h;
    float q[16], k[16], v[16];
    u32x4 zw[3][4][2];
#pragma unroll
    for (int part = 0; part < 3; ++part)
#pragma unroll
        for (int kk = 0; kk < 4; ++kk) { const bf16_t* zr = (s - 3 + kk >= 0) ? z + (tok - 3 + kk) * ZP + Z_GQKV + part * 256 + h * 64 + qr * 16 : z + tok * ZP + IN_COLS;
            zw[part][kk][0] = *(const u32x4*)zr; zw[part][kk][1] = *(const u32x4*)(zr + 8); }
    const bf16_t* zt = z + tok * ZP;
    const float beta_raw = bf2f(zt[Z_GB + h]), a_raw = bf2f(zt[Z_GA + h]);
    __builtin_amdgcn_sched_barrier(0);
    const LAS float* CW = (const LAS float*)(lds + GP_CW);
#pragma unroll
    for (int part = 0; part < 3; ++part) {
        float* dst = part == 0 ? q : (part == 1 ? k : v);
        const int ch0 = part * 256 + h * 64 + qr * 16;
#pragma unroll
        for (int i = 0; i < 16; ++i) dst[i] = 0.f;
#pragma unroll
        for (int kk = 0; kk < 4; ++kk) {
            const u32x4 w0 = zw[part][kk][0], w1 = zw[part][kk][1];
            const LAS float* wr = CW + kk * 768 + ch0; const f32x4 c0 = *(const LAS f32x4*)wr, c1 = *(const LAS f32x4*)(wr + 4), c2 = *(const LAS f32x4*)(wr + 8), c3 = *(const LAS f32x4*)(wr + 12);
            dst[0] += c0.x * bflo(w0.x); dst[1] += c0.y * bfhi(w0.x); dst[2] += c0.z * bflo(w0.y); dst[3] += c0.w * bfhi(w0.y);
            dst[4] += c1.x * bflo(w0.z); dst[5] += c1.y * bfhi(w0.z); dst[6] += c1.z * bflo(w0.w); dst[7] += c1.w * bfhi(w0.w);
            dst[8] += c2.x * bflo(w1.x); dst[9] += c2.y * bfhi(w1.x); dst[10] += c2.z * bflo(w1.y); dst[11] += c2.w * bfhi(w1.y);
            dst[12] += c3.x * bflo(w1.z); dst[13] += c3.y * bfhi(w1.z); dst[14] += c3.z * bflo(w1.w); dst[15] += c3.w * bfhi(w1.w); }
#pragma unroll
        for (int i = 0; i < 16; ++i) dst[i] = siluf_(dst[i]);
    }
    float sq = 0.f, sk = 0.f;
#pragma unroll
    for (int i = 0; i < 16; ++i) { sq += q[i] * q[i]; sk += k[i] * k[i]; }
    sq = sum4_(sq); sk = sum4_(sk);
    const float rq = frsq_(sq + EPS) * 0.125f, rk = frsq_(sk + EPS);
    const float beta = sigmoidf_(beta_raw);
    const float g = -fexp_(P.gdn_a_log[l * 4 + h]) * softplusf_(a_raw + P.gdn_dt_bias[l * 4 + h]);
    {
        u32x4 w0, w1;
#define PK16(dst0, dst1, src, sc) do { dst0.x = pk2(src[0] * (sc), src[1] * (sc)); dst0.y = pk2(src[2] * (sc), src[3] * (sc)); dst0.z = pk2(src[4] * (sc), src[5] * (sc)); dst0.w = pk2(src[6] * (sc), src[7] * (sc)); \
        dst1.x = pk2(src[8] * (sc), src[9] * (sc)); dst1.y = pk2(src[10] * (sc), src[11] * (sc)); dst1.z = pk2(src[12] * (sc), src[13] * (sc)); dst1.w = pk2(src[14] * (sc), src[15] * (sc)); } while (0)
        PK16(w0, w1, k, rk);        *(LAS u32x4*)(L + GP_KN + (c * 72 + qr * 16) * 2) = w0; *(LAS u32x4*)(L + GP_KN + (c * 72 + qr * 16 + 8) * 2) = w1;
        PK16(w0, w1, k, rk * beta); *(LAS u32x4*)(L + GP_KB + (c * 72 + qr * 16) * 2) = w0; *(LAS u32x4*)(L + GP_KB + (c * 72 + qr * 16 + 8) * 2) = w1;
        PK16(w0, w1, q, rq);        *(LAS u32x4*)(L + GP_QN + (c * 72 + qr * 16) * 2) = w0; *(LAS u32x4*)(L + GP_QN + (c * 72 + qr * 16 + 8) * 2) = w1;
        LAS float* rhs = (LAS float*)(L + GP_RHS) + c * 128 + qr * 16;
#pragma unroll
        for (int i = 0; i < 4; ++i) *(LAS f32x4*)(rhs + 4 * i) = (f32x4){v[4 * i] * beta, v[4 * i + 1] * beta, v[4 * i + 2] * beta, v[4 * i + 3] * beta};
        if (qr == 0) ((LAS float*)(L + GP_G))[c] = g;
    }
    __syncthreads();
    {
        float gc = 0.f, run = 0.f; const LAS float* G = (const LAS float*)(L + GP_G);
#pragma unroll 16
        for (int i = 0; i < 64; ++i) { run += G[i]; gc = (i == c) ? run : gc; }
        const float eg = fexp_(gc), ek = fexp_(run - gc);
        LAS float* rhs = (LAS float*)(L + GP_RHS) + c * 128 + 64 + qr * 16;
#pragma unroll
        for (int i = 0; i < 4; ++i) *(LAS f32x4*)(rhs + 4 * i) = (f32x4){k[4 * i] * rk * beta * eg, k[4 * i + 1] * rk * beta * eg, k[4 * i + 2] * rk * beta * eg, k[4 * i + 3] * rk * beta * eg};
        u32x4 w0, w1; PK16(w0, w1, q, rq * eg);
        bf16_t* qd = gdn_buf(P, chh, 3) + c * 64 + qr * 16; *(u32x4*)qd = w0; *(u32x4*)(qd + 8) = w1;
        if (qr == 0) { ((LAS float*)(L + GP_GC))[c] = gc; ((LAS float*)(L + GP_EK))[c] = ek; }
        if (tt == 0) ((float*)(P.ws + WS_GL))[chh] = fexp_(run);
    }
#undef PK16
    __syncthreads();
    {
        const int it4 = (tid >> 6) & 3, fr = lane & 15, fq = lane >> 4;
        const LAS bf16_t* Kn = (const LAS bf16_t*)(L + GP_KN); const LAS bf16_t* KB = (const LAS bf16_t*)(L + GP_KB); const LAS bf16_t* Qn = (const LAS bf16_t*)(L + GP_QN);
        const LAS float* GC = (const LAS float*)(L + GP_GC);
        const bf16x8 a0 = *(const LAS bf16x8*)(KB + (it4 * 16 + fr) * 72 + 8 * fq), a1 = *(const LAS bf16x8*)(KB + (it4 * 16 + fr) * 72 + 32 + 8 * fq);
        const bf16x8 q0 = *(const LAS bf16x8*)(Qn + (it4 * 16 + fr) * 72 + 8 * fq), q1 = *(const LAS bf16x8*)(Qn + (it4 * 16 + fr) * 72 + 32 + 8 * fq);
        float gci[4];
#pragma unroll
        for (int r = 0; r < 4; ++r) gci[r] = GC[it4 * 16 + 4 * fq + r];
        {
            const int d = tt >> 2, cq = tt & 3; const LAS float* EK = (const LAS float*)(L + GP_EK);
            unsigned wv[8];
#pragma unroll
            for (int i = 0; i < 8; ++i) { const int c0 = cq * 16 + 2 * i; wv[i] = pk2(bf2f(Kn[c0 * 72 + d]) * EK[c0], bf2f(Kn[(c0 + 1) * 72 + d]) * EK[c0 + 1]); }
            bf16_t* kd = gdn_buf(P, chh, 4) + d * 64 + cq * 16;
            *(u32x4*)kd = (u32x4){wv[0], wv[1], wv[2], wv[3]}; *(u32x4*)(kd + 8) = (u32x4){wv[4], wv[5], wv[6], wv[7]};
        }
        f32x4 lv[4], av[4];
#pragma unroll
        for (int jt = 0; jt < 4; ++jt) {
            const bf16x8 b0 = *(const LAS bf16x8*)(Kn + (jt * 16 + fr) * 72 + 8 * fq), b1 = *(const LAS bf16x8*)(Kn + (jt * 16 + fr) * 72 + 32 + 8 * fq);
            f32x4 al = {0.f, 0.f, 0.f, 0.f}, aa = {0.f, 0.f, 0.f, 0.f};
            al = mfma16(a0, b0, al); al = mfma16(a1, b1, al); aa = mfma16(q0, b0, aa); aa = mfma16(q1, b1, aa);
            const int j = jt * 16 + fr; const float gcj = GC[j];
#pragma unroll
            for (int r = 0; r < 4; ++r) { const int i = it4 * 16 + 4 * fq + r; const float dec = fexp_(fminf(gci[r] - gcj, 0.f));
                lv[jt][r] = (i > j) ? al[r] * dec : 0.f; av[jt][r] = (i >= j) ? aa[r] * dec : 0.f; }
        }
        __syncthreads();
        LAS float* Lm = (LAS float*)(L + GP_L); LAS bf16_t* ATl = (LAS bf16_t*)(L + GP_KN);
#pragma unroll
        for (int jt = 0; jt < 4; ++jt)
#pragma unroll
            for (int r = 0; r < 4; ++r) { Lm[(it4 * 16 + 4 * fq + r) * 64 + (fr & 1) * 32 + jt * 8 + (fr >> 1)] = lv[jt][r];
                ATl[(it4 * 16 + 4 * fq + r) * 72 + jt * 16 + fr] = f2bf(av[jt][r]); }
    }
    __syncthreads();
    {
        bf16_t* att = gdn_buf(P, chh, 2);
#pragma unroll
        for (int i = 0; i < 2; ++i) { const int pz = tt + 256 * i, row = pz >> 3, pc = pz & 7; *(u32x4*)(att + row * 64 + pc * 8) = *(const LAS u32x4*)(L + GP_KN + (row * 72 + pc * 8) * 2); }
    }
    {
        const int col = tt >> 1, p = tt & 1;
        const LAS float* Lp = (const LAS float*)(L + GP_L) + p * 32; const LAS float* rhs = (const LAS float*)(L + GP_RHS) + col;
        float xs[32];
#pragma unroll
        for (int k = 0; k < 32; ++k) xs[k] = 0.f;
#pragma unroll
        for (int ib = 0; ib < 4; ++ib) {
            float rv[16];
#pragma unroll
            for (int t = 0; t < 16; ++t) rv[t] = rhs[(ib * 16 + t) * 128];
#pragma unroll
            for (int t = 0; t < 16; ++t) { const int i = ib * 16 + t;
                float a0 = 0.f, a1 = 0.f;
#pragma unroll
                for (int k4 = 0; k4 < ((i + 1) / 2 + 3) / 4; ++k4) { const f32x4 lr = *(const LAS f32x4*)(Lp + i * 64 + 4 * k4);
                    a0 += lr.x * xs[4 * k4 + 0]; a1 += lr.y * xs[4 * k4 + 1]; a0 += lr.z * xs[4 * k4 + 2]; a1 += lr.w * xs[4 * k4 + 3]; }
                float acc = a0 + a1; acc += dpp_xor1(acc);
                const float xi = rv[t] - acc;
                xs[i >> 1] = (p == (i & 1)) ? xi : xs[i >> 1];
            }
        }
        if (col < 64) {
            bf16_t* ut = gdn_buf(P, chh, 1) + col * 64 + 32 * p;
            unsigned wv[16];
#pragma unroll
            for (int k = 0; k < 32; ++k) { const float other = dpp_xor1(xs[k]);
                const float lo = p ? other : xs[k], hi = p ? xs[k] : other;
                if ((k >> 4) == 0) { if (p == 0) wv[k & 15] = pk2(lo, hi); } else { if (p == 1) wv[k & 15] = pk2(lo, hi); } }
#pragma unroll
            for (int g4 = 0; g4 < 4; ++g4) *(u32x4*)(ut + 8 * g4) = (u32x4){wv[4 * g4], wv[4 * g4 + 1], wv[4 * g4 + 2], wv[4 * g4 + 3]};
        } else { bf16_t* wo = gdn_buf(P, chh, 0) + (col - 64) + p * 64;
#pragma unroll
            for (int k = 0; k < 32; ++k) wo[k * 128] = f2bf(xs[k]); }
    }
    __syncthreads();
}

constexpr int GC_W = 0, GC_UT = 9216, GC_ATT = 18432, GC_QD = 27648, GC_KDT = 36864, GC_ST = 46080, GC_VNT = 55296, GC_BH = 64512;
__device__ __forceinline__ bf16x8 ldsA(const LAS unsigned char* M, int row, int s, int fq) { return *(const LAS bf16x8*)(M + row * 144 + 64 * s + 16 * fq); }
__device__ __forceinline__ void gdn_chain_item(const Params& P, int l, LAS unsigned char* lds, int gi, int tid, int wave, int lane) {
    const int q2 = wave >> 2, bh = gi * 2 + q2, ct = wave & 3, b = bh >> 2, h = bh & 3, fr = lane & 15, fq = lane >> 4;
    const bf16_t* z = (const bf16_t*)(P.ws + WS_R); bf16_t* y = (bf16_t*)(P.ws + WS_R + R_Y);
    LAS unsigned char* L = lds + q2 * GC_BH;
    f32x4 ng[4];
#pragma unroll
    for (int et = 0; et < 4; ++et) ng[et] = *(const f32x4*)(P.gdn_norm + l * 64 + et * 16 + 4 * fq);
    u32x4 stg[10];
    typedef const __attribute__((address_space(1))) u32x4* gp4_t;
    typedef const __attribute__((address_space(1))) u32x2* gp2_t;
    typedef const __attribute__((address_space(1))) float* gpf_t;
    const bf16_t* const srcq0 = gdn_buf(P, ((gi * 2 >> 2) * NCHUNK) * 4 + ((gi * 2) & 3), 0);
    const bf16_t* const srcq1 = gdn_buf(P, (((gi * 2 + 1) >> 2) * NCHUNK) * 4 + ((gi * 2 + 1) & 3), 0);
#define GC_LD1(i_, n_) stg[i_] = *(gp4_t)(((i_) < 5 ? srcq0 : srcq1) + (size_t)(n_) * 4 * 5 * 4096 + (size_t)(tid + 512 * ((i_) % 5)) * 8)
#define GC_LOAD_A(n_) do { GC_LD1(0, n_); GC_LD1(1, n_); GC_LD1(3, n_); GC_LD1(5, n_); GC_LD1(6, n_); GC_LD1(8, n_); } while (0)
#define GC_LOAD_B(n_) do { GC_LD1(2, n_); GC_LD1(4, n_); GC_LD1(7, n_); GC_LD1(9, n_); } while (0)
#define GC_WRITE1(i_) do { const int p = tid + 512 * (i_), qq = p / 2560, pp = p % 2560, mat = pp >> 9, row = (pp & 511) >> 3, pc = pp & 7; \
        *(LAS u32x4*)(lds + qq * GC_BH + mat * 9216 + row * 144 + pc * 16) = stg[i_]; } while (0)
#define GC_WRITE_A() do { GC_WRITE1(0); GC_WRITE1(1); GC_WRITE1(3); GC_WRITE1(5); GC_WRITE1(6); GC_WRITE1(8); } while (0)
#define GC_WRITE_B() do { GC_WRITE1(2); GC_WRITE1(4); GC_WRITE1(7); GC_WRITE1(9); } while (0)
    GC_LOAD_A(0); GC_LOAD_B(0); GC_WRITE_A(); GC_WRITE_B();
    for (int i = tid; i < 64 * 72 / 2; i += 512) { ((LAS unsigned*)(lds + GC_ST))[i] = 0u; ((LAS unsigned*)(lds + GC_BH + GC_ST))[i] = 0u; }
    f32x4 S[4];
#pragma unroll
    for (int t = 0; t < 4; ++t) S[t] = (f32x4){0.f, 0.f, 0.f, 0.f};
    const size_t tokb = (size_t)b * SEQ + ct * 16 + fr;
    u32x2 gate_n[4]; float egl_n;
#pragma unroll
    for (int et = 0; et < 4; ++et) gate_n[et] = *(gp2_t)(z + tokb * ZP + Z_GG + h * 64 + et * 16 + 4 * fq);
    egl_n = *(gpf_t)((const float*)(P.ws + WS_GL) + (b * NCHUNK) * 4 + h);
    __builtin_amdgcn_sched_barrier(0);
    GC_LOAD_A(1); GC_LOAD_B(1);
    __builtin_amdgcn_sched_barrier(0);
    __syncthreads();
    for (int n = 0; n < NCHUNK; ++n) {
        const int n1 = n + 1 < NCHUNK ? n + 1 : NCHUNK - 1, n2 = n + 2 < NCHUNK ? n + 2 : NCHUNK - 1;
        u32x2 gate[4];
#pragma unroll
        for (int et = 0; et < 4; ++et) gate[et] = gate_n[et];
        const float egl = egl_n;
#pragma unroll
        for (int et = 0; et < 4; ++et) gate_n[et] = *(gp2_t)(z + (tokb + n1 * 64) * ZP + Z_GG + h * 64 + et * 16 + 4 * fq);
        egl_n = *(gpf_t)((const float*)(P.ws + WS_GL) + (b * NCHUNK + n1) * 4 + h);
        __builtin_amdgcn_sched_barrier(0);
        f32x4 o[4];
        {
            const bf16x8 w0 = ldsA(L + GC_W, ct * 16 + fr, 0, fq), w1 = ldsA(L + GC_W, ct * 16 + fr, 1, fq), q0 = ldsA(L + GC_QD, ct * 16 + fr, 0, fq), q1 = ldsA(L + GC_QD, ct * 16 + fr, 1, fq);
#pragma unroll
            for (int et = 0; et < 4; ++et) {
                const bf16x8 s0 = ldsA(L + GC_ST, et * 16 + fr, 0, fq), s1 = ldsA(L + GC_ST, et * 16 + fr, 1, fq);
                f32x4 a = {0.f, 0.f, 0.f, 0.f}; a = mfma16(w0, s0, a); a = mfma16(w1, s1, a);
                f32x4 oo = {0.f, 0.f, 0.f, 0.f}; oo = mfma16(s0, q0, oo); oo = mfma16(s1, q1, oo); o[et] = oo;
                const u32x2 uw = *(const LAS u32x2*)(L + GC_UT + (et * 16 + fr) * 144 + (ct * 16 + 4 * fq) * 2);
                u32x2 vw; vw.x = pk2(bflo(uw.x) - a.x, bfhi(uw.x) - a.y); vw.y = pk2(bflo(uw.y) - a.z, bfhi(uw.y) - a.w);
                *(LAS u32x2*)(L + GC_VNT + (et * 16 + fr) * 144 + (ct * 16 + 4 * fq) * 2) = vw; }
        }
        __syncthreads();
        GC_WRITE_A(); GC_LOAD_A(n2);
        __builtin_amdgcn_sched_barrier(0);
        {
            const bf16x8 a0 = ldsA(L + GC_ATT, ct * 16 + fr, 0, fq), a1 = ldsA(L + GC_ATT, ct * 16 + fr, 1, fq), k0 = ldsA(L + GC_KDT, ct * 16 + fr, 0, fq), k1 = ldsA(L + GC_KDT, ct * 16 + fr, 1, fq);
#pragma unroll
            for (int et = 0; et < 4; ++et) {
                const bf16x8 v0 = ldsA(L + GC_VNT, et * 16 + fr, 0, fq), v1 = ldsA(L + GC_VNT, et * 16 + fr, 1, fq);
                o[et] = mfma16(v0, a0, o[et]); o[et] = mfma16(v1, a1, o[et]);
                f32x4 sN = S[et] * egl; sN = mfma16(k0, v0, sN); sN = mfma16(k1, v1, sN); S[et] = sN;
                u32x2 sw; sw.x = pk2(sN.x, sN.y); sw.y = pk2(sN.z, sN.w);
                *(LAS u32x2*)(L + GC_ST + (et * 16 + fr) * 144 + (ct * 16 + 4 * fq) * 2) = sw; }
        }
        {
            float s2 = 0.f;
#pragma unroll
            for (int et = 0; et < 4; ++et) s2 += (o[et].x * o[et].x + o[et].y * o[et].y) + (o[et].z * o[et].z + o[et].w * o[et].w);
            s2 = xrow_sum_(s2);
            const float rs = frsq_(s2 * (1.0f / 64.0f) + EPS);
            u32x2 w[4];
#pragma unroll
            for (int et = 0; et < 4; ++et) { const f32x4 v = o[et] * rs * ng[et];
                w[et].x = pk2(v.x * siluf_(bflo(gate[et].x)), v.y * siluf_(bfhi(gate[et].x))); w[et].y = pk2(v.z * siluf_(bflo(gate[et].y)), v.w * siluf_(bfhi(gate[et].y))); }
            bf16_t* yp = y + (tokb + n * 64) * DM + 768 + h * 64 + (fq >> 1) * 8;
            *(u32x4*)(yp + (0 + (fq & 1)) * 16) = widen16_(w[0], w[1]);
            *(u32x4*)(yp + (2 + (fq & 1)) * 16) = widen16_(w[2], w[3]);
        }
        __syncthreads();
        GC_WRITE_B(); GC_LOAD_B(n2);
        __builtin_amdgcn_sched_barrier(0);
    }
#undef GC_LD1
#undef GC_LOAD_A
#undef GC_LOAD_B
#undef GC_WRITE1
#undef GC_WRITE_A
#undef GC_WRITE_B
    __syncthreads();
}

constexpr int RT_BUF = 36864, RT_Q = 0, RT_K = 9216, RT_KZT = 18432, RT_VT = 27648, RT_P = 73728, RT_ST = 82944, RT_O = 92160;
__device__ __forceinline__ void ret_chain_item(const Params& P, int l, LAS unsigned char* lds, int it, int tid, int wave, int lane) {
    const int b = it >> 2, h = it & 3, fr = lane & 15, fq = lane >> 4;
    const bf16_t* z = (const bf16_t*)(P.ws + WS_R); bf16_t* y = (bf16_t*)(P.ws + WS_R + R_Y);
    LAS bf16_t* Pm = (LAS bf16_t*)(lds + RT_P); LAS bf16_t* ST = (LAS bf16_t*)(lds + RT_ST); LAS float* Of = (LAS float*)(lds + RT_O);
    const float lg = log1pf(-exp2f(-5.0f - (float)h));
    const float cdec = fexp_(64.0f * lg);
    for (int i = tid; i < 64 * 72 / 2; i += 512) ((LAS unsigned*)ST)[i] = 0u;
    const int it4 = wave >> 1, jt0 = 2 * (wave & 1);
    f32x4 S[2] = {{0.f, 0.f, 0.f, 0.f}, {0.f, 0.f, 0.f, 0.f}};
    const int lc = tid >> 3, pg = tid & 7;
    float invf[4];
#pragma unroll
    for (int ii = 0; ii < 4; ++ii) invf[ii] = exp2f(-(float)(4 * pg + ii) * (13.287712379549449f / 32.0f));
    const float zeta = fexp_((63.0f - (float)lc) * lg);
    const f32x4 gn0 = *(const f32x4*)(P.ret_gn + l * 256 + h * 64 + 8 * pg), gn1 = *(const f32x4*)(P.ret_gn + l * 256 + h * 64 + 8 * pg + 4);
    const size_t tok0 = (size_t)b * SEQ + lc;
    u32x2 q1w, q2w, k1w, k2w; u32x4 vw; int posi;
#define RT_LOAD(n_) do { const bf16_t* zr_ = z + (tok0 + (n_) * 64) * ZP; q1w = *(const u32x2*)(zr_ + Z_RQ + h * 64 + 4 * pg); q2w = *(const u32x2*)(zr_ + Z_RQ + h * 64 + 32 + 4 * pg); \
        k1w = *(const u32x2*)(zr_ + Z_RK + h * 64 + 4 * pg); k2w = *(const u32x2*)(zr_ + Z_RK + h * 64 + 32 + 4 * pg); vw = *(const u32x4*)(zr_ + Z_RV + h * 64 + 8 * pg); posi = P.pos[tok0 + (n_) * 64]; } while (0)
#define RT_STAGE(buf_) do { LAS bf16_t* Qs_ = (LAS bf16_t*)(lds + (buf_) * RT_BUF + RT_Q); LAS bf16_t* Ks_ = (LAS bf16_t*)(lds + (buf_) * RT_BUF + RT_K); \
        LAS bf16_t* KzT_ = (LAS bf16_t*)(lds + (buf_) * RT_BUF + RT_KZT); LAS bf16_t* VT_ = (LAS bf16_t*)(lds + (buf_) * RT_BUF + RT_VT); const float pos = (float)posi; \
        const float q1[4] = {bflo(q1w.x), bfhi(q1w.x), bflo(q1w.y), bfhi(q1w.y)}, q2[4] = {bflo(q2w.x), bfhi(q2w.x), bflo(q2w.y), bfhi(q2w.y)}; \
        const float k1[4] = {bflo(k1w.x), bfhi(k1w.x), bflo(k1w.y), bfhi(k1w.y)}, k2[4] = {bflo(k2w.x), bfhi(k2w.x), bflo(k2w.y), bfhi(k2w.y)}; \
        float qa[4], qb[4], ka[4], kb[4]; \
        _Pragma("unroll") for (int ii = 0; ii < 4; ++ii) { float sn, cs; sincos_rev(pos * invf[ii], sn, cs); \
            qa[ii] = (q1[ii] * cs - q2[ii] * sn) * 0.125f; qb[ii] = (q1[ii] * sn + q2[ii] * cs) * 0.125f; ka[ii] = k1[ii] * cs - k2[ii] * sn; kb[ii] = k1[ii] * sn + k2[ii] * cs; } \
        u32x2 w_; w_.x = pk2(qa[0], qa[1]); w_.y = pk2(qa[2], qa[3]); *(LAS u32x2*)(Qs_ + lc * 72 + 4 * pg) = w_; \
        w_.x = pk2(qb[0], qb[1]); w_.y = pk2(qb[2], qb[3]); *(LAS u32x2*)(Qs_ + lc * 72 + 32 + 4 * pg) = w_; \
        w_.x = pk2(ka[0], ka[1]); w_.y = pk2(ka[2], ka[3]); *(LAS u32x2*)(Ks_ + lc * 72 + 4 * pg) = w_; \
        w_.x = pk2(kb[0], kb[1]); w_.y = pk2(kb[2], kb[3]); *(LAS u32x2*)(Ks_ + lc * 72 + 32 + 4 * pg) = w_; \
        _Pragma("unroll") for (int ii = 0; ii < 4; ++ii) { KzT_[(4 * pg + ii) * 72 + lc] = f2bf(ka[ii] * zeta); KzT_[(32 + 4 * pg + ii) * 72 + lc] = f2bf(kb[ii] * zeta); } \
        const unsigned vv[4] = {vw.x, vw.y, vw.z, vw.w}; \
        _Pragma("unroll") for (int ii = 0; ii < 4; ++ii) { VT_[(8 * pg + 2 * ii) * 72 + lc] = (bf16_t)(vv[ii] & 0xffffu); VT_[(8 * pg + 2 * ii + 1) * 72 + lc] = (bf16_t)(vv[ii] >> 16); } } while (0)
    RT_LOAD(0); RT_STAGE(0);
    __syncthreads();
    for (int n = 0; n < NCHUNK; ++n) {
        const int cb = n & 1;
        const LAS bf16_t* Qs = (const LAS bf16_t*)(lds + cb * RT_BUF + RT_Q); const LAS bf16_t* Ks = (const LAS bf16_t*)(lds + cb * RT_BUF + RT_K);
        const LAS bf16_t* KzT = (const LAS bf16_t*)(lds + cb * RT_BUF + RT_KZT); const LAS bf16_t* VT = (const LAS bf16_t*)(lds + cb * RT_BUF + RT_VT);
        const size_t tok = tok0 + n * 64;
        if (n + 1 < NCHUNK) RT_LOAD(n + 1);
        const u32x4 gw = *(const u32x4*)(z + tok * ZP + Z_RG + h * 64 + 8 * pg);
        const bf16x8 a0 = *(const LAS bf16x8*)(Qs + (it4 * 16 + fr) * 72 + 8 * fq), a1 = *(const LAS bf16x8*)(Qs + (it4 * 16 + fr) * 72 + 32 + 8 * fq);
        f32x4 cross[2];
#pragma unroll
        for (int t = 0; t < 2; ++t) { const int jt = jt0 + t;
            f32x4 p = {0.f, 0.f, 0.f, 0.f};
            p = mfma16(a0, *(const LAS bf16x8*)(Ks + (jt * 16 + fr) * 72 + 8 * fq), p); p = mfma16(a1, *(const LAS bf16x8*)(Ks + (jt * 16 + fr) * 72 + 32 + 8 * fq), p);
            f32x4 cr = {0.f, 0.f, 0.f, 0.f};
            cr = mfma16(a0, *(const LAS bf16x8*)(ST + (jt * 16 + fr) * 72 + 8 * fq), cr); cr = mfma16(a1, *(const LAS bf16x8*)(ST + (jt * 16 + fr) * 72 + 32 + 8 * fq), cr);
#pragma unroll
            for (int r = 0; r < 4; ++r) { const int i = it4 * 16 + 4 * fq + r, j = jt * 16 + fr; const int dd = i > j ? i - j : j - i;
                Pm[i * 72 + j] = f2bf(p[r] * fexp_((float)dd * lg)); cr[r] *= fexp_((float)(i + 1) * lg); }
            cross[t] = cr; }
        __syncthreads();
        const bf16x8 p0 = *(const LAS bf16x8*)(Pm + (it4 * 16 + fr) * 72 + 8 * fq), p1 = *(const LAS bf16x8*)(Pm + (it4 * 16 + fr) * 72 + 32 + 8 * fq);
        const bf16x8 kz0 = *(const LAS bf16x8*)(KzT + (it4 * 16 + fr) * 72 + 8 * fq), kz1 = *(const LAS bf16x8*)(KzT + (it4 * 16 + fr) * 72 + 32 + 8 * fq);
#pragma unroll
        for (int t = 0; t < 2; ++t) { const int et = jt0 + t;
            const bf16x8 v0 = *(const LAS bf16x8*)(VT + (et * 16 + fr) * 72 + 8 * fq), v1 = *(const LAS bf16x8*)(VT + (et * 16 + fr) * 72 + 32 + 8 * fq);
            f32x4 o = cross[t]; o = mfma16(p0, v0, o); o = mfma16(p1, v1, o);
#pragma unroll
            for (int r = 0; r < 4; ++r) Of[(it4 * 16 + 4 * fq + r) * 65 + et * 16 + fr] = o[r];
            f32x4 sN = S[t] * cdec; sN = mfma16(kz0, v0, sN); sN = mfma16(kz1, v1, sN); S[t] = sN;
            u32x2 w; w.x = pk2(sN.x, sN.y); w.y = pk2(sN.z, sN.w); *(LAS u32x2*)(ST + (et * 16 + fr) * 72 + it4 * 16 + 4 * fq) = w; }
        if (n + 1 < NCHUNK) RT_STAGE(cb ^ 1);
        __syncthreads();
        {
            float ov[8]; float sm = 0.f;
#pragma unroll
            for (int j = 0; j < 8; ++j) { ov[j] = Of[lc * 65 + 8 * pg + j]; sm += ov[j]; }
            sm = sum8_(sm);
            const float mu = sm * (1.0f / 64.0f); float vs = 0.f;
#pragma unroll
            for (int j = 0; j < 8; ++j) { ov[j] -= mu; vs += ov[j] * ov[j]; }
            vs = sum8_(vs);
            const float rs = frsq_(vs * (1.0f / 64.0f) + EPS);
            const float gt[8] = {bflo(gw.x), bfhi(gw.x), bflo(gw.y), bfhi(gw.y), bflo(gw.z), bfhi(gw.z), bflo(gw.w), bfhi(gw.w)};
            const float gnv[8] = {gn0.x, gn0.y, gn0.z, gn0.w, gn1.x, gn1.y, gn1.z, gn1.w};
            float r8[8];
#pragma unroll
            for (int j = 0; j < 8; ++j) r8[j] = ov[j] * rs * gnv[j] * siluf_(gt[j]);
            u32x4 w; w.x = pk2(r8[0], r8[1]); w.y = pk2(r8[2], r8[3]); w.z = pk2(r8[4], r8[5]); w.w = pk2(r8[6], r8[7]);
            *(u32x4*)(y + tok * DM + h * 64 + 8 * pg) = w;
        }
    }
#undef RT_LOAD
#undef RT_STAGE
    __syncthreads();
}

constexpr int LR_XC = 0, LR_AU = 33792;
__device__ __forceinline__ void lru_item(const Params& P, int l, LAS unsigned char* lds, int it, int mode, int tid, int wave, int lane) {
    const int b = it >> 5, n = it & 31, fr = lane & 15, fq = lane >> 4;
    const bf16_t* z = (const bf16_t*)(P.ws + WS_R); bf16_t* y = (bf16_t*)(P.ws + WS_R + R_Y);
    LAS bf16_t* XC = (LAS bf16_t*)(lds + LR_XC); LAS f32x2* AU = (LAS f32x2*)(lds + LR_AU);
    float* sumA = (float*)(P.ws + WS_LRUS); float* sumH = sumA + 16 * 32 * 256;
    {
        const int c = tid >> 3, cg = tid & 7, s = n * 64 + c; const size_t tok = (size_t)b * SEQ + s;
        const float* cw = P.lru_conv_w + (size_t)l * 4 * 256; const float* cb = P.lru_conv_b + l * 256;
#pragma unroll
        for (int g = 0; g < 4; ++g) { const int ch0 = cg * 32 + g * 8;
            const f32x4 b0 = *(const f32x4*)(cb + ch0), b1 = *(const f32x4*)(cb + ch0 + 4);
            float a[8] = {b0.x, b0.y, b0.z, b0.w, b1.x, b1.y, b1.z, b1.w};
#pragma unroll
            for (int kk = 0; kk < 4; ++kk) { const bool okk = s - 3 + kk >= 0; const float mk = okk ? 1.f : 0.f;
                const u32x4 w = *(const u32x4*)(z + (okk ? tok - 3 + kk : tok) * ZP + Z_LX + ch0);
                const f32x4 c0 = *(const f32x4*)(cw + kk * 256 + ch0) * mk, c1 = *(const f32x4*)(cw + kk * 256 + ch0 + 4) * mk;
                a[0] += c0.x * bflo(w.x); a[1] += c0.y * bfhi(w.x); a[2] += c0.z * bflo(w.y); a[3] += c0.w * bfhi(w.y);
                a[4] += c1.x * bflo(w.z); a[5] += c1.y * bfhi(w.z); a[6] += c1.z * bflo(w.w); a[7] += c1.w * bfhi(w.w); }
            u32x4 o; o.x = pk2(a[0], a[1]); o.y = pk2(a[2], a[3]); o.z = pk2(a[4], a[5]); o.w = pk2(a[6], a[7]);
            *(LAS u32x4*)(XC + c * 264 + ch0) = o; }
    }
    float hcar = 0.f, aprod = 1.f;
    if (mode == 1 && tid < 256) {
        float av[32], hv[32];
#pragma unroll
        for (int m = 0; m < 32; ++m) { const int mm = m < n ? m : 0; av[m] = sumA[(b * 32 + mm) * 256 + tid]; hv[m] = sumH[(b * 32 + mm) * 256 + tid]; }
#pragma unroll
        for (int m = 0; m < 32; ++m) if (m < n) hcar = av[m] * hcar + hv[m];
    }
    const int nb = wave >> 1, rt = wave & 1;
    const bf16_t* wa = wl(P, l, W_A) + nb * 4096; const bf16_t* wx = wl(P, l, W_X) + nb * 4096;
    bf16x8 fa[4][2], fx[4][2]; float ba[4], bx[4], spl[4];
#pragma unroll
    for (int dt = 0; dt < 4; ++dt) {
#pragma unroll
        for (int s = 0; s < 2; ++s) { fa[dt][s] = *(const bf16x8*)(wa + (dt * 16 + fr) * 64 + 32 * s + 8 * fq); fx[dt][s] = *(const bf16x8*)(wx + (dt * 16 + fr) * 64 + 32 * s + 8 * fq); }
        const int d = nb * 64 + dt * 16 + fr; ba[dt] = P.lru_ba[l * 256 + d]; bx[dt] = P.lru_bx[l * 256 + d]; spl[dt] = -8.0f * softplusf_(-P.lru_lambda[l * 256 + d]); }
    __syncthreads();
    for (int half = 0; half < 2; ++half) {
        const int trow = half * 32 + rt * 16;
        const bf16x8 x0 = *(const LAS bf16x8*)(XC + (trow + fr) * 264 + nb * 64 + 8 * fq), x1 = *(const LAS bf16x8*)(XC + (trow + fr) * 264 + nb * 64 + 32 + 8 * fq);
#pragma unroll
        for (int dt = 0; dt < 4; ++dt) {
            f32x4 ar = {0.f, 0.f, 0.f, 0.f}, ai = {0.f, 0.f, 0.f, 0.f};
            ar = mfma16(x0, fa[dt][0], ar); ar = mfma16(x1, fa[dt][1], ar); ai = mfma16(x0, fx[dt][0], ai); ai = mfma16(x1, fx[dt][1], ai);
            const int d = nb * 64 + dt * 16 + fr;
#pragma unroll
            for (int r = 0; r < 4; ++r) { const int tl = rt * 16 + 4 * fq + r;
                const float xcv = bf2f(XC[(half * 32 + tl) * 264 + d]);
                const float rr = sigmoidf_(ar[r] + ba[dt]), ii = sigmoidf_(ai[r] + bx[dt]);
                const float a = fexp_(rr * spl[dt]);
                const float u = fsqrt_(fmaxf(1.0f - a * a, 0.f)) * (ii * xcv);
                AU[tl * 257 + d] = (f32x2){a, u}; }
        }
        __syncthreads();
        if (tid < 256) {
#pragma unroll 8
            for (int tk = 0; tk < 32; ++tk) { const f32x2 au = AU[tk * 257 + tid]; hcar = au.x * hcar + au.y; aprod *= au.x; if (mode == 1) AU[tk * 257 + tid].y = hcar; }
        }
        if (mode == 1) {
            __syncthreads();
            const int tk = tid >> 4, c0 = (tid & 15) * 16; const size_t tok = (size_t)b * SEQ + n * 64 + half * 32 + tk;
            const u32x4 g0 = *(const u32x4*)(z + tok * ZP + Z_LG + c0), g1 = *(const u32x4*)(z + tok * ZP + Z_LG + c0 + 8);
            const unsigned gws[8] = {g0.x, g0.y, g0.z, g0.w, g1.x, g1.y, g1.z, g1.w}; unsigned ow[8];
#pragma unroll
            for (int j = 0; j < 8; ++j) { const float h0 = AU[tk * 257 + c0 + 2 * j].y, h1 = AU[tk * 257 + c0 + 2 * j + 1].y; ow[j] = pk2(h0 * geluf_(bflo(gws[j])), h1 * geluf_(bfhi(gws[j]))); }
            bf16_t* yp = y + tok * DM + 256 + c0;
            *(u32x4*)yp = (u32x4){ow[0], ow[1], ow[2], ow[3]}; *(u32x4*)(yp + 8) = (u32x4){ow[4], ow[5], ow[6], ow[7]};
        }
        __syncthreads();
    }
    if (mode == 0 && tid < 256) { sumA[(b * 32 + n) * 256 + tid] = aprod; sumH[(b * 32 + n) * 256 + tid] = hcar; }
}

constexpr int LC_XC = 0, LC_AU = 9216;
__device__ __forceinline__ void lru_chain_item(const Params& P, int l, LAS unsigned char* lds, int it, int tid, int wave, int lane) {
    const int b = it >> 2, nb = it & 3, fr = lane & 15, fq = lane >> 4;
    const bf16_t* z = (const bf16_t*)(P.ws + WS_R); bf16_t* y = (bf16_t*)(P.ws + WS_R + R_Y);
    LAS bf16_t* XC = (LAS bf16_t*)(lds + LC_XC); LAS f32x2* AU = (LAS f32x2*)(lds + LC_AU);
    const int c = tid >> 3, cg = tid & 7, ch0 = nb * 64 + cg * 8;
    f32x4 cw0[4], cw1[4];
#pragma unroll
    for (int kk = 0; kk < 4; ++kk) { cw0[kk] = *(const f32x4*)(P.lru_conv_w + (size_t)l * 1024 + kk * 256 + ch0); cw1[kk] = *(const f32x4*)(P.lru_conv_w + (size_t)l * 1024 + kk * 256 + ch0 + 4); }
    const f32x4 cb0 = *(const f32x4*)(P.lru_conv_b + l * 256 + ch0), cb1 = *(const f32x4*)(P.lru_conv_b + l * 256 + ch0 + 4);
    const int rt = wave >> 1, dt0 = (wave & 1) * 2;
    const bf16_t* wa = wl(P, l, W_A) + nb * 4096; const bf16_t* wx = wl(P, l, W_X) + nb * 4096;
    bf16x8 fa[2][2], fx[2][2]; float ba[2], bx[2], spl[2];
#pragma unroll
    for (int t = 0; t < 2; ++t) {
#pragma unroll
        for (int s = 0; s < 2; ++s) { fa[t][s] = *(const bf16x8*)(wa + ((dt0 + t) * 16 + fr) * 64 + 32 * s + 8 * fq); fx[t][s] = *(const bf16x8*)(wx + ((dt0 + t) * 16 + fr) * 64 + 32 * s + 8 * fq); }
        const int d = nb * 64 + (dt0 + t) * 16 + fr; ba[t] = P.lru_ba[l * 256 + d]; bx[t] = P.lru_bx[l * 256 + d]; spl[t] = -8.0f * softplusf_(-P.lru_lambda[l * 256 + d]); }
    const size_t tok0 = (size_t)b * SEQ + c;
    u32x4 xr[4], gr;
#define LC_LOAD(n_) do { const size_t t_ = tok0 + (size_t)(n_) * 64; _Pragma("unroll") for (int kk = 0; kk < 4; ++kk) { const bool ok_ = (n_) * 64 + c - 3 + kk >= 0; \
        xr[kk] = *(const u32x4*)(z + (ok_ ? t_ - 3 + kk : t_) * ZP + Z_LX + ch0); } gr = *(const u32x4*)(z + t_ * ZP + Z_LG + ch0); } while (0)
    LC_LOAD(0);
    float hcar = 0.f;
    for (int n = 0; n < NCHUNK; ++n) {
        {
            float a[8] = {cb0.x, cb0.y, cb0.z, cb0.w, cb1.x, cb1.y, cb1.z, cb1.w};
#pragma unroll
            for (int kk = 0; kk < 4; ++kk) { const float mk = (n * 64 + c - 3 + kk >= 0) ? 1.f : 0.f; const f32x4 c0 = cw0[kk] * mk, c1 = cw1[kk] * mk; const u32x4 w = xr[kk];
                a[0] += c0.x * bflo(w.x); a[1] += c0.y * bfhi(w.x); a[2] += c0.z * bflo(w.y); a[3] += c0.w * bfhi(w.y);
                a[4] += c1.x * bflo(w.z); a[5] += c1.y * bfhi(w.z); a[6] += c1.z * bflo(w.w); a[7] += c1.w * bfhi(w.w); }
            u32x4 o; o.x = pk2(a[0], a[1]); o.y = pk2(a[2], a[3]); o.z = pk2(a[4], a[5]); o.w = pk2(a[6], a[7]);
            *(LAS u32x4*)(XC + c * 72 + cg * 8) = o;
        }
        const u32x4 gcur = gr;
        if (n + 1 < NCHUNK) LC_LOAD(n + 1);
        __syncthreads();
        {
            const bf16x8 x0 = *(const LAS bf16x8*)(XC + (rt * 16 + fr) * 72 + 8 * fq), x1 = *(const LAS bf16x8*)(XC + (rt * 16 + fr) * 72 + 32 + 8 * fq);
#pragma unroll
            for (int t = 0; t < 2; ++t) {
                f32x4 ar = {0.f, 0.f, 0.f, 0.f}, ai = {0.f, 0.f, 0.f, 0.f};
                ar = mfma16(x0, fa[t][0], ar); ar = mfma16(x1, fa[t][1], ar); ai = mfma16(x0, fx[t][0], ai); ai = mfma16(x1, fx[t][1], ai);
                const int dl = (dt0 + t) * 16 + fr;
#pragma unroll
                for (int r = 0; r < 4; ++r) { const int tl = rt * 16 + 4 * fq + r;
                    const float xcv = bf2f(XC[tl * 72 + dl]);
                    const float rr = sigmoidf_(ar[r] + ba[t]), ii = sigmoidf_(ai[r] + bx[t]);
                    const float av = fexp_(rr * spl[t]);
                    AU[tl * 65 + dl] = (f32x2){av, fsqrt_(fmaxf(1.0f - av * av, 0.f)) * (ii * xcv)}; }
            }
        }
        __syncthreads();
        if (tid < 64) {
#pragma unroll
            for (int blk = 0; blk < 4; ++blk) { f32x2 au[16];
#pragma unroll
                for (int k = 0; k < 16; ++k) au[k] = AU[(blk * 16 + k) * 65 + tid];
#pragma unroll
                for (int k = 0; k < 16; ++k) { hcar = au[k].x * hcar + au[k].y; au[k].y = hcar; }
#pragma unroll
                for (int k = 0; k < 16; ++k) AU[(blk * 16 + k) * 65 + tid].y = au[k].y; }
        }
        __syncthreads();
        {
            const unsigned gws[4] = {gcur.x, gcur.y, gcur.z, gcur.w}; unsigned ow[4];
#pragma unroll
            for (int j = 0; j < 4; ++j) ow[j] = pk2(AU[c * 65 + cg * 8 + 2 * j].y * geluf_(bflo(gws[j])), AU[c * 65 + cg * 8 + 2 * j + 1].y * geluf_(bfhi(gws[j])));
            *(u32x4*)(y + (tok0 + (size_t)n * 64) * DM + 256 + ch0) = (u32x4){ow[0], ow[1], ow[2], ow[3]};
        }
    }
#undef LC_LOAD
    __syncthreads();
}

constexpr int N_PHASES = 21;
constexpr int Q_RET = 64, Q_GDN = 32, Q_LRU = 64, Q_MLA = 512, Q_TOTAL = Q_RET + Q_GDN + Q_LRU + Q_MLA;

__global__ void __launch_bounds__(512, 2) hymba_fwd(Params P_) {
    extern __shared__ __attribute__((aligned(16))) unsigned char lds_raw[];
    LAS unsigned char* lds = (LAS unsigned char*)lds_raw;
    volatile LAS unsigned* LC = (volatile LAS unsigned*)(lds + LDS_CTL);
    const int G = gridDim.x;
#define SUB_TID() int tid2 = tid; asm volatile("" : "+v"(tid2)); const int lane2 = tid2 & 63, wave2 = __builtin_amdgcn_readfirstlane(tid2 >> 6); (void)lane2; (void)wave2
#if defined(__HIP_DEVICE_COMPILE__)
#define PH_PARAMS() const __attribute__((address_space(4))) Params* pp_ = (const __attribute__((address_space(4))) Params*)__builtin_amdgcn_kernarg_segment_ptr(); asm volatile("" : "+s"(pp_)); const Params P = *pp_
#else
#define PH_PARAMS() const Params P = P_
#endif
#define PH_TID() PH_PARAMS(); \
    bf16_t* xb = (bf16_t*)(P.ws + WS_XB); float* part = (float*)(P.ws + WS_PART); bf16_t* zb = (bf16_t*)(P.ws + WS_R); bf16_t* yb = (bf16_t*)(P.ws + WS_R + R_Y); bf16_t* oxb = (bf16_t*)(P.ws + WS_R + R_OX); (void)xb; (void)part; (void)zb; (void)yb; (void)oxb; \
    int tid = threadIdx.x; asm volatile("" : "+v"(tid)); const int lane = tid & 63, wave = __builtin_amdgcn_readfirstlane(tid >> 6); (void)lane; (void)wave
    unsigned* ctl = (unsigned*)(P_.ws + WS_CTL);
    if (threadIdx.x < 64) LC[threadIdx.x] = 0u;
    __syncthreads();
    const int lo = P_.ph_lo, hi = P_.ph_hi;
    XcdBarrier bar; bar.bar = ctl + CW_BAR; bar.x = 0; bar.st = LC;
    if (hi - lo > 1) bar = xcd_barrier_post(ctl + CW_BAR, LC);
#ifndef PHASE_MASK
#define PHASE_MASK 0xFFFFFFFFu
#endif
#define EN(t) ((PHASE_MASK >> (t)) & 1u)
#ifndef REPEAT_MASK
#define REPEAT_MASK 0u
#endif
#define REP(t) for (int rep_ = 0; rep_ <= (int)((REPEAT_MASK >> (t)) & 1u); ++rep_, (rep_ <= (int)((REPEAT_MASK >> (t)) & 1u) ? xcd_barrier(bar) : (void)0))
#define IN(k) (lo <= (k) && (k) < hi)
#define SEAM(k) do { if (IN(k) && IN((k) + 1)) xcd_barrier(bar); } while (0)


    if (IN(0) && EN(0)) REP(0) { PH_TID(); p0_prologue(P, lds, tid); __syncthreads(); }
    SEAM(0);
    if (IN(1) && EN(1)) REP(1) {
        PH_TID();
        const int which = blockIdx.x >> 6, l = which >> 1, isv = which & 1;
        if (which < 4) {
            const bf16_t* memn = (const bf16_t*)(P.ws + WS_GDN); const bf16_t* wkv = wl(P, l, W_KV);
            bf16_t* kout = (bf16_t*)(P.ws + WS_KVM + (size_t)l * KVM_LAYER); bf16_t* vout = kout + (size_t)4096 * 1024;
            pg8::Gemm g; pg8::EpiScaleBf16<0> E; pg8::StaticOrder S;
            if (!isv) { g = pg8::Gemm{memn, wkv, 4096, 1024, 1024}; E = pg8::EpiScaleBf16<0>{kout, 1024, nullptr}; S.init(4096, 1024, 64, blockIdx.x & 63); }
            else { g = pg8::Gemm{wkv + (size_t)1024 * 1024, memn, 1024, 4096, 1024}; E = pg8::EpiScaleBf16<0>{vout, 4096, nullptr}; S.init(1024, 4096, 64, blockIdx.x & 63); }
            pg8::gemm_phase(lds, g, S, E, tid);
        }
    }
#pragma unroll
    for (int l = 0; l < 2; ++l) {
        const int pb = 2 + 9 * l;
        if (IN(pb + 0) && EN(2)) REP(2) { PH_TID();
            pg8::Gemm g{xb, wl(P, l, W_IN), T_TOK, ZP, DM}; pg8::StaticOrder S; S.init(T_TOK, ZP, G, blockIdx.x);
            pg8::scale_table(lds, S, part, tid);
            pg8::EpiScaleBf16<0> E{zb, ZP, part}; pg8::gemm_phase(lds, g, S, E, tid);
        }
        SEAM(pb + 0);
        if (IN(pb + 1)) {
            PH_TID();
            if (EN(3)) REP(3) { SUB_TID();
                for (int i = tid2; i < 768; i += 512) *(LAS f32x4*)(lds + GP_CW + i * 16) = *(const f32x4*)(P.gdn_conv_w + (size_t)l * 3072 + i * 4);
                __syncthreads();
_Pragma("unroll 1")
            for (int it = blockIdx.x; it < 1024; it += G) gdn_pre_item(P, l, lds, it, tid2); }
            if (EN(5)) REP(5) { SUB_TID();
_Pragma("unroll 1")
            for (int it = blockIdx.x; it < 256; it += G) mla_pre_item(P, l, lds, it, tid2, wave2, lane2); }
        }
        SEAM(pb + 1);
        if (IN(pb + 2)) {
            PH_TID();
            for (int rep2_ = 0; rep2_ <= (int)((REPEAT_MASK >> 17) & 1u); ++rep2_, (rep2_ <= (int)((REPEAT_MASK >> 17) & 1u) ? xcd_barrier(bar) : (void)0)) {
            unsigned* qh0 = ctl + CW_QUEUE + 64 * l + 16 * rep2_;
#define QUEUE_LOOP(qi_, count_, body_) for (;;) { if (tid == 0) LC[4] = __hip_atomic_fetch_add(qh + (qi_), 1u, __ATOMIC_RELAXED, __HIP_MEMORY_SCOPE_AGENT); \
                __syncthreads(); const int it = (int)LC[4]; __syncthreads(); if (it >= (count_)) break; { SUB_TID(); body_; } __syncthreads(); }
            if (EN(6)) REP(6) { unsigned* qh = qh0 + 32 * rep_; QUEUE_LOOP(0, Q_RET, ret_chain_item(P, l, lds, it, tid2, wave2, lane2)) }
            if (EN(7)) REP(7) { unsigned* qh = qh0 + 32 * rep_; QUEUE_LOOP(1, Q_GDN, gdn_chain_item(P, l, lds, it, tid2, wave2, lane2)) }
            if (EN(8)) REP(8) { unsigned* qh = qh0 + 32 * rep_; QUEUE_LOOP(2, Q_LRU, lru_chain_item(P, l, lds, it, tid2, wave2, lane2)) }
            if (EN(9)) REP(9) { unsigned* qh = qh0 + 32 * rep_; QUEUE_LOOP(3, Q_MLA, mla_attn_item(P, lds, it, tid2, wave2, lane2)) }
#undef QUEUE_LOOP
            }
        }
        SEAM(pb + 2);
        if (IN(pb + 3) && EN(10)) REP(10) { PH_TID();
            pg8::Gemm g{yb, wl(P, l, W_OUT), T_TOK, DM, DM}; pg8::StaticOrder S; S.init(T_TOK, DM, G, blockIdx.x);
            pg8::EpiResid E{xb, part, rep_ ? 0.f : 1.f}; pg8::gemm_phase(lds, g, S, E, tid);
        }
        SEAM(pb + 3);
        if (IN(pb + 4) && EN(11)) REP(11) { PH_TID();
_Pragma("unroll 1")
            for (int u = blockIdx.x; u < 512; u += G) {
                const int pm = u >> 2, pn = u & 3;
                { pg8::Gemm g{xb, wl(P, l, W_Q), T_TOK, DM, DM}; pg8::OneUnit S{pm, pn};
                  pg8::EpiScaleLds E{part}; pg8::gemm_phase(lds, g, S, E, tid); }
                asm volatile("s_waitcnt lgkmcnt(0)" ::: "memory"); __syncthreads();
                { SUB_TID(); xa_item(P, l, lds, (pm >> 3) * 32 + pn * 8 + (pm & 7), tid2, wave2, lane2); }
                __syncthreads();
            }
        }
        SEAM(pb + 5);
        if (IN(pb + 6) && EN(13)) REP(13) { PH_TID();
            pg8::Gemm g{oxb, wl(P, l, W_O), T_TOK, DM, DM}; pg8::StaticOrder S; S.init(T_TOK, DM, G, blockIdx.x);
            pg8::EpiResid E{xb, part, rep_ ? 0.f : 1.f}; pg8::gemm_phase(lds, g, S, E, tid);
        }
        SEAM(pb + 6);
        if (IN(pb + 7) && EN(14)) REP(14) { PH_TID();
            pg8::Gemm g{xb, wl(P, l, W_1), T_TOK, DFF, DM}; pg8::StaticOrder S; S.init(T_TOK, DFF, G, blockIdx.x);
            pg8::scale_table(lds, S, part, tid);
            pg8::EpiScaleBf16<1> E{zb, DFF, part}; pg8::gemm_phase(lds, g, S, E, tid);
        }
        SEAM(pb + 7);
        if (IN(pb + 8) && EN(15)) REP(15) { PH_TID();
            pg8::Gemm g{zb, wl(P, l, W_2), T_TOK, DM, DFF}; pg8::StaticOrder S; S.init(T_TOK, DM, G, blockIdx.x);
            pg8::EpiResid E{xb, part, rep_ ? 0.f : 1.f}; pg8::gemm_phase(lds, g, S, E, tid);
        }
        SEAM(pb + 8);
    }
    if (IN(20) && EN(16)) { PH_TID(); final_norm_phase(P, tid); }
#undef IN
#undef SEAM
}

extern "C" void kernel_launch(void* const* d_in, const int* in_sizes, int n_in, void* d_out, int out_size, void* d_ws, size_t ws_size, hipStream_t stream) {
    static int grid = 0;
    if (grid == 0) {
        if (n_in != 31 || out_size != T_TOK * DM || ws_size < WS_END) { fprintf(stderr, "kernel_launch: unexpected shapes (n_in %d out %d ws %zu, need %zu)\n", n_in, out_size, ws_size, (size_t)WS_END); grid = -1; return; }
        if (hipFuncSetAttribute((const void*)hymba_fwd, hipFuncAttributeMaxDynamicSharedMemorySize, LDS_BYTES) != hipSuccess) { fprintf(stderr, "kernel_launch: hipFuncSetAttribute failed\n"); grid = -1; return; }
        int dev = 0, cus = 0, per_cu = 0;
        (void)hipGetDevice(&dev); (void)hipDeviceGetAttribute(&cus, hipDeviceAttributeMultiprocessorCount, dev);
        (void)hipOccupancyMaxActiveBlocksPerMultiprocessor(&per_cu, (const void*)hymba_fwd, 512, LDS_BYTES);
        (void)hipGetLastError();
        if (cus != 256 || per_cu < 1) fprintf(stderr, "kernel_launch: note: cus %d per_cu %d\n", cus, per_cu);
        grid = 256;
    }
    if (grid < 0) return;
    (void)hipMemsetAsync((char*)d_ws + WS_CTL, 0, CTL_BYTES, stream);
    Params p{};
    p.x = (const float*)d_in[0]; p.mem = (const float*)d_in[1]; p.pos = (const int*)d_in[2];
    p.norm_mix = (const float*)d_in[3]; p.w_in = (const float*)d_in[4]; p.ret_gn = (const float*)d_in[5];
    p.lru_conv_w = (const float*)d_in[6]; p.lru_conv_b = (const float*)d_in[7]; p.lru_wa = (const float*)d_in[8]; p.lru_ba = (const float*)d_in[9];
    p.lru_wx = (const float*)d_in[10]; p.lru_bx = (const float*)d_in[11]; p.lru_lambda = (const float*)d_in[12];
    p.mla_q_norm = (const float*)d_in[13]; p.mla_w_uq = (const float*)d_in[14]; p.mla_kv_norm = (const float*)d_in[15]; p.mla_w_ukv = (const float*)d_in[16];
    p.gdn_conv_w = (const float*)d_in[17]; p.gdn_a_log = (const float*)d_in[18]; p.gdn_dt_bias = (const float*)d_in[19]; p.gdn_norm = (const float*)d_in[20];
    p.w_out = (const float*)d_in[21]; p.norm_xattn = (const float*)d_in[22]; p.norm_mem = (const float*)d_in[23];
    p.xa_wq = (const float*)d_in[24]; p.xa_wkv = (const float*)d_in[25]; p.xa_wo = (const float*)d_in[26];
    p.norm_mlp = (const float*)d_in[27]; p.mlp_w1 = (const float*)d_in[28]; p.mlp_w2 = (const float*)d_in[29]; p.final_norm = (const float*)d_in[30];
    p.out = (float*)d_out; p.ws = (unsigned char*)d_ws;
#if N_LAUNCHES == 1
    p.ph_lo = 0; p.ph_hi = N_PHASES;
    void* args[] = {&p};
    hipError_t e = hipLaunchCooperativeKernel((const void*)hymba_fwd, dim3(grid), dim3(512), args, LDS_BYTES, stream);
    if (e != hipSuccess) fprintf(stderr, "kernel_launch: cooperative launch failed: %s\n", hipGetErrorString(e));
#else
    for (int ph = 0; ph < N_PHASES; ++ph) { p.ph_lo = ph; p.ph_hi = ph + 1; hipLaunchKernelGGL(hymba_fwd, dim3(grid), dim3(512), LDS_BYTES, stream, p); }
#endif
}
```

```cpp
#include <hip/hip_runtime.h>
#include <cstdio>
#include <cstdint>

#ifndef N_LAUNCHES
#define N_LAUNCHES 1
#endif

#define LAS __attribute__((address_space(3)))
typedef unsigned short bf16_t;
typedef short bf16x8 __attribute__((ext_vector_type(8)));
typedef float f32x4 __attribute__((ext_vector_type(4)));
typedef float f32x2 __attribute__((ext_vector_type(2)));
typedef unsigned u32x4 __attribute__((ext_vector_type(4)));
typedef unsigned u32x2 __attribute__((ext_vector_type(2)));

constexpr int T_TOK = 32768, DM = 1024, SEQ = 2048, NBATCH = 16, NCHUNK = 32, ZP = 3072, DFF = 4096, NMEM = 256;
constexpr int Z_RQ = 0, Z_RK = 256, Z_RV = 512, Z_RG = 768, Z_LX = 1024, Z_LG = 1280, Z_CQ = 1536, Z_CKV = 1728, Z_KR = 1856,
              Z_GQKV = 1888, Z_GG = 2656, Z_GB = 2912, Z_GA = 2916, IN_COLS = 2920;
constexpr float EPS = 1e-6f;
constexpr float LOG2E = 1.4426950408889634f;

constexpr size_t MiB = 1024 * 1024;
constexpr size_t WS_CTL = 0;
constexpr size_t CTL_BYTES = 65536;
constexpr size_t WS_PART = WS_CTL + CTL_BYTES;
constexpr size_t WS_LRUS = WS_PART + (size_t)T_TOK * 16 * 4;
constexpr size_t WS_GL = WS_LRUS + (size_t)2 * 16 * 32 * 256 * 4;
constexpr size_t WS_W = WS_GL + 65536;
constexpr size_t W_IN = 0, W_OUT = W_IN + (size_t)ZP * DM, W_Q = W_OUT + (size_t)DM * DM, W_KV = W_Q + (size_t)DM * DM, W_O = W_KV + (size_t)2 * DM * DM,
                 W_1 = W_O + (size_t)DM * DM, W_2 = W_1 + (size_t)DFF * DM, W_UQ = W_2 + (size_t)DFF * DM, W_UKV = W_UQ + 384 * 192, W_A = W_UKV + 512 * 128,
                 W_X = W_A + 4 * 64 * 64, W_LAYER = W_X + 4 * 64 * 64;
constexpr size_t WS_XB = WS_W + 2 * W_LAYER * 2;
constexpr size_t XB_BYTES = (size_t)T_TOK * DM * 2;
constexpr size_t MLA_Q_OFF = 0, MLA_K_OFF = (size_t)T_TOK * 4 * 96 * 2, MLA_VT_OFF = 2 * MLA_K_OFF;
constexpr size_t WS_KVM = WS_XB + XB_BYTES;
constexpr size_t KVM_LAYER = (size_t)2 * 4096 * 1024 * 2;
constexpr size_t WS_R = WS_KVM + 2 * KVM_LAYER;
constexpr size_t R_Y = (size_t)T_TOK * ZP * 2;
constexpr size_t R_OX = (size_t)T_TOK * DM * 2;
constexpr size_t WS_GDN = WS_R + 256 * MiB;
constexpr size_t WS_END = WS_GDN + 80 * MiB;
static_assert(WS_END <= 512 * MiB, "workspace map exceeds 512 MiB");
static_assert(WS_XB % 256 == 0 && WS_R % 256 == 0 && WS_GDN % 256 == 0 && WS_W % 256 == 0, "alignment");
constexpr int CW_BAR = 0;
constexpr int CW_QUEUE = 4096;

constexpr int LDS_BYTES = 160 * 1024;
constexpr int LDS_CTL = LDS_BYTES - 256;

typedef __bf16 bf16x2_t __attribute__((ext_vector_type(2)));
__device__ __forceinline__ unsigned pk2(float lo, float hi) { f32x2 t = {lo, hi}; bf16x2_t v = __builtin_convertvector(t, bf16x2_t); return __builtin_bit_cast(unsigned, v); }
__device__ __forceinline__ float bflo(unsigned w) { return __uint_as_float(w << 16); }
__device__ __forceinline__ float bfhi(unsigned w) { return __uint_as_float(w & 0xffff0000u); }
__device__ __forceinline__ float bf2f(bf16_t v) { return __uint_as_float((unsigned)v << 16); }
__device__ __forceinline__ bf16_t f2bf(float f) { return (bf16_t)(pk2(f, 0.f) & 0xffffu); }
__device__ __forceinline__ f32x4 mfma16(bf16x8 a, bf16x8 b, f32x4 c) { return __builtin_amdgcn_mfma_f32_16x16x32_bf16(a, b, c, 0, 0, 0); }
__device__ __forceinline__ float fexp2_(float x) { return __builtin_amdgcn_exp2f(x); }
__device__ __forceinline__ float fexp_(float x) { return __builtin_amdgcn_exp2f(x * LOG2E); }
__device__ __forceinline__ float frcp_(float x) { return __builtin_amdgcn_rcpf(x); }
__device__ __forceinline__ float frsq_(float x) { return __builtin_amdgcn_rsqf(x); }
__device__ __forceinline__ float fsqrt_(float x) { return __builtin_amdgcn_sqrtf(x); }
__device__ __forceinline__ float sigmoidf_(float x) { return frcp_(1.0f + fexp_(-x)); }
__device__ __forceinline__ float siluf_(float x) { return x * frcp_(1.0f + fexp_(-x)); }
__device__ __forceinline__ float softplusf_(float x) { return x > 20.f ? x : log1pf(__expf(x)); }
__device__ __forceinline__ float geluf_(float x) { const float u = 1.5957691216057308f * (x + 0.044715f * x * x * x); return x * frcp_(1.0f + fexp_(-u)); }
__device__ __forceinline__ float dpp_xor1(float x) { return __builtin_bit_cast(float, __builtin_amdgcn_update_dpp(0, __builtin_bit_cast(int, x), 0xB1, 0xF, 0xF, true)); }
__device__ __forceinline__ float dpp_xor2(float x) { return __builtin_bit_cast(float, __builtin_amdgcn_update_dpp(0, __builtin_bit_cast(int, x), 0x4E, 0xF, 0xF, true)); }
__device__ __forceinline__ float dpp_hmir(float x) { return __builtin_bit_cast(float, __builtin_amdgcn_update_dpp(0, __builtin_bit_cast(int, x), 0x141, 0xF, 0xF, true)); }
__device__ __forceinline__ float dpp_mir(float x) { return __builtin_bit_cast(float, __builtin_amdgcn_update_dpp(0, __builtin_bit_cast(int, x), 0x140, 0xF, 0xF, true)); }
__device__ __forceinline__ float sum4_(float x) { x += dpp_xor1(x); x += dpp_xor2(x); return x; }
__device__ __forceinline__ float sum8_(float x) { x = sum4_(x); x += dpp_hmir(x); return x; }
__device__ __forceinline__ float sum16_(float x) { x = sum8_(x); x += dpp_mir(x); return x; }
typedef unsigned u2v_ __attribute__((ext_vector_type(2)));
__device__ __forceinline__ float xrow_sum_(float x) { unsigned a = __builtin_bit_cast(unsigned, x), b = a; asm("" : "+v"(b));
    auto r = __builtin_amdgcn_permlane16_swap(a, b, false, false);
    x = __builtin_bit_cast(float, (unsigned)r[0]) + __builtin_bit_cast(float, (unsigned)r[1]); a = __builtin_bit_cast(unsigned, x); b = a; asm("" : "+v"(b));
    auto r2 = __builtin_amdgcn_permlane32_swap(a, b, false, false);
    return __builtin_bit_cast(float, (unsigned)r2[0]) + __builtin_bit_cast(float, (unsigned)r2[1]); }
__device__ __forceinline__ float xrow_max_(float x) { unsigned a = __builtin_bit_cast(unsigned, x), b = a; asm("" : "+v"(b));
    auto r = __builtin_amdgcn_permlane16_swap(a, b, false, false);
    x = fmaxf(__builtin_bit_cast(float, (unsigned)r[0]), __builtin_bit_cast(float, (unsigned)r[1])); a = __builtin_bit_cast(unsigned, x); b = a; asm("" : "+v"(b));
    auto r2 = __builtin_amdgcn_permlane32_swap(a, b, false, false);
    return fmaxf(__builtin_bit_cast(float, (unsigned)r2[0]), __builtin_bit_cast(float, (unsigned)r2[1])); }
__device__ __forceinline__ u32x4 widen16_(u32x2 a, u32x2 b) { auto r0 = __builtin_amdgcn_permlane16_swap(a.x, b.x, false, false); auto r1 = __builtin_amdgcn_permlane16_swap(a.y, b.y, false, false);
    u32x4 o; o.x = (unsigned)r0[0]; o.y = (unsigned)r1[0]; o.z = (unsigned)r0[1]; o.w = (unsigned)r1[1]; return o; }
__device__ __forceinline__ float wave_sum(float v) {
    return xrow_sum_(sum16_(v));
}
__device__ __forceinline__ void sincos_rev(float ang, float& s, float& c) {
    float rev = ang * 0.15915494309189535f; rev = rev - floorf(rev);
    s = __builtin_amdgcn_sinf(rev); c = __builtin_amdgcn_cosf(rev);
}
__device__ __forceinline__ bf16x8 mk8(u32x2 lo, u32x2 hi) { u32x4 t; t.x = lo.x; t.y = lo.y; t.z = hi.x; t.w = hi.y; return __builtin_bit_cast(bf16x8, t); }
__device__ __forceinline__ bf16x8 pack8(f32x4 a, f32x4 b) { u32x4 t; t.x = pk2(a.x, a.y); t.y = pk2(a.z, a.w); t.z = pk2(b.x, b.y); t.w = pk2(b.z, b.w); return __builtin_bit_cast(bf16x8, t); }

#define XB_TMO      128
#define XB_XCNT(j)  (256  + 64 * (j))
#define XB_XSUB(j)  (1280 + 64 * (j))
#define XB_XGEN(j)  (2304 + 64 * (j))
#define XB_TOP      3328
#define XB_TOPGEN   3392
#define XCD_BAR_WORDS 3456
#define XB_SPIN_CAP (1u << 22)
__device__ __forceinline__ unsigned xb_ld(unsigned* p)              { return __hip_atomic_load(p, __ATOMIC_RELAXED, __HIP_MEMORY_SCOPE_AGENT); }
__device__ __forceinline__ unsigned xb_add(unsigned* p, unsigned v) { return __hip_atomic_fetch_add(p, v, __ATOMIC_RELAXED, __HIP_MEMORY_SCOPE_AGENT); }
__device__ __forceinline__ unsigned xb_xcc_id() { return (unsigned)__builtin_amdgcn_s_getreg((3 << 11) | 20) & 0xFu; }
#define XB_SPIN(cond, bar) do { unsigned _sp = 0; while (cond) { __builtin_amdgcn_s_sleep(1); \
    if ((++_sp & 255u) == 0u) { if (xb_ld(&(bar)[XB_TMO])) break; if (_sp > XB_SPIN_CAP) { atomicAdd(&(bar)[XB_TMO], 1u); break; } } } } while (0)
struct XcdBarrier { unsigned* bar; unsigned x; volatile LAS unsigned* st; };
__device__ __forceinline__ XcdBarrier xcd_barrier_post(unsigned* bar, volatile LAS unsigned* st) {
    XcdBarrier b; b.bar = bar; b.x = xb_xcc_id(); b.st = st;
    if (threadIdx.x == 0) (void)xb_add(&bar[XB_XCNT(b.x)], 1u);
    return b;
}
__device__ __forceinline__ void xcd_barrier_complete(unsigned* bar, unsigned x, unsigned& nloc, unsigned& nx) {
    const unsigned G = gridDim.x * gridDim.y * gridDim.z;
    unsigned sum, cnt, mine, sp = 0u;
    for (;;) {
        sum = 0u; cnt = 0u; mine = 0u;
#pragma unroll
        for (unsigned j = 0; j < 16; ++j) { const unsigned c = xb_ld(&bar[XB_XCNT(j)]); sum += c; cnt += (c > 0u) ? 1u : 0u; mine = (j == x) ? c : mine; }
        if (sum == G) break;
        __builtin_amdgcn_s_sleep(1);
        if ((++sp & 255u) == 0u) { if (xb_ld(&bar[XB_TMO])) break; if (sp > XB_SPIN_CAP) { atomicAdd(&bar[XB_TMO], 1u); break; } }
    }
    nloc = mine > 0u ? mine : 1u; nx = cnt > 0u ? cnt : 1u;
}
__device__ __forceinline__ void xcd_barrier(const XcdBarrier& b) {
    asm volatile("s_waitcnt vmcnt(0)" ::: "memory");
    __syncthreads();
    if (threadIdx.x == 0) {
        unsigned* bar = b.bar;
        __builtin_amdgcn_s_waitcnt(0);
        unsigned nloc = b.st[0], nx = b.st[1];
        if (nloc == 0u) { xcd_barrier_complete(bar, b.x, nloc, nx); b.st[0] = nloc; b.st[1] = nx; }
        const unsigned old = xb_add(&bar[XB_XSUB(b.x)], 1u);
        const unsigned gen = old / nloc;
        if (old + 1u == (gen + 1u) * nloc) {
            __builtin_amdgcn_fence(__ATOMIC_RELEASE, "agent");
            asm volatile("s_waitcnt vmcnt(0)" ::: "memory");
            const unsigned og = xb_add(&bar[XB_TOP], 1u);
            const unsigned tg = og / nx;
            if (og + 1u == (tg + 1u) * nx) xb_add(&bar[XB_TOPGEN], 1u);
            else XB_SPIN(xb_ld(&bar[XB_TOPGEN]) == tg, bar);
            __builtin_amdgcn_fence(__ATOMIC_ACQUIRE, "agent");
            xb_add(&bar[XB_XGEN(b.x)], 1u);
            asm volatile("s_waitcnt vmcnt(0)" ::: "memory");
        } else {
            XB_SPIN(xb_ld(&bar[XB_XGEN(b.x)]) == gen, bar);
            __builtin_amdgcn_fence(__ATOMIC_ACQUIRE, "agent");
            asm volatile("s_waitcnt vmcnt(0)" ::: "memory");
        }
    }
    __syncthreads();
}

namespace pg8 {
constexpr int BM = 256, BK = 64, HALF = 128, HTB = HALF * BK * 2, STAGE_BYTES = 8 * HTB, NXCD = 8, WGM = 4;
__host__ __device__ __forceinline__ int lds_byte(int r, int c) { const int st = (r >> 4) * 2 + (c >> 5), rr = r & 15, cc = c & 31, ob = rr * 64 + cc * 2; return st * 1024 + (ob ^ (((ob >> 9) & 1) << 5)); }
__host__ __device__ __forceinline__ void stage_rc(int b, int& R, int& C) { const int st = b / 1024, sb = b % 1024, swz = sb ^ (((sb >> 9) & 1) << 5); R = (st >> 1) * 16 + swz / 64; C = (st & 1) * 32 + (swz % 64) / 2; }
__host__ __device__ __forceinline__ int perm32(int rho) { const int n = rho >> 4, i = rho & 15; return 8 * (i >> 2) + 4 * n + (i & 3); }
struct Unit { int pm, pn; };
struct Gemm { const bf16_t* A; const bf16_t* Bt; int M, N, K; };
struct StaticOrder {
    int nM, nN, nwg, G, c;
    __host__ __device__ void init(int M, int N, int G_, int c_) { nM = M / BM; nN = N / BM; nwg = nM * nN; G = G_; c = c_; }
    __host__ __device__ bool next(int i, Unit& u) const {
        const long L = (long)i * G + c; if (L >= nwg) return false;
        int wgid = (int)L; { const int q = nwg / NXCD, r = nwg % NXCD, xcd = wgid % NXCD, off = wgid / NXCD; wgid = (xcd < r ? xcd * (q + 1) : r * (q + 1) + (xcd - r) * q) + off; }
        const int nig = WGM * nN, gid = wgid / nig, fm = gid * WGM, gsz = (nM - fm) < WGM ? (nM - fm) : WGM;
        u.pm = fm + ((wgid % nig) % gsz); u.pn = (wgid % nig) / gsz; return true;
    }
    __device__ __forceinline__ void a_ready(const Unit&) const {}
    __device__ __forceinline__ void done(const Unit&) const {}
};

struct OneUnit { int pm, pn;
    __device__ __forceinline__ bool next(int i, Unit& u) const { if (i) return false; u.pm = pm; u.pn = pn; return true; }
    __device__ __forceinline__ void a_ready(const Unit&) const {}
    __device__ __forceinline__ void done(const Unit&) const {}
};
constexpr int SCALE_TBL = STAGE_BYTES;
template <class Sched> __device__ __forceinline__ void scale_table(LAS unsigned char* lds, const Sched& S, const float* part, int tid) {
    const int h = tid >> 8, row = tid & 255;
    Unit u0; (void)S.next(0, u0);
    f32x4 v[4][4]; bool ok[4];
#pragma unroll
    for (int k = 0; k < 4; ++k) { Unit u; ok[k] = S.next(2 * k + h, u); const int pm = ok[k] ? u.pm : u0.pm;
        const __attribute__((address_space(1))) f32x4* pp = (const __attribute__((address_space(1))) f32x4*)(part + (size_t)(pm * BM + row) * 16);
#pragma unroll
        for (int j = 0; j < 4; ++j) v[k][j] = pp[j]; }
    __builtin_amdgcn_sched_barrier(0);
#pragma unroll
    for (int k = 0; k < 4; ++k) { const f32x4 a = v[k][0], b = v[k][1], c = v[k][2], d = v[k][3];
        const float s = ((a.x + a.y) + (a.z + a.w)) + ((b.x + b.y) + (b.z + b.w)) + ((c.x + c.y) + (c.z + c.w)) + ((d.x + d.y) + (d.z + d.w));
        if (ok[k]) ((LAS float*)(lds + SCALE_TBL))[(2 * k + h) * 256 + row] = frsq_(s * (1.0f / 1024.0f) + EPS); }
    __syncthreads();
}
template <int ACT> struct EpiScaleBf16 {
    static constexpr bool PERM = true, AFTER_DRAIN = false;
    bf16_t* O; int ldc; const float* part;
    __device__ __forceinline__ void operator()(const f32x4 (&acc)[2][2][4][2], const Unit& u, int wr, int wc, int fr, int fq, int ui, LAS unsigned char* lds) const {
        const int row0 = u.pm * BM + wr * 64 + fr, col0 = u.pn * BM + wc * 64 + 8 * fq;
        float sc[2][4];
#pragma unroll
        for (int ai = 0; ai < 2; ++ai)
#pragma unroll
            for (int m = 0; m < 4; ++m) sc[ai][m] = part ? ((const LAS float*)(lds + SCALE_TBL))[ui * 256 + wr * 64 + ai * HALF + m * 16 + fr] : 1.0f;
#pragma unroll
        for (int ai = 0; ai < 2; ++ai)
#pragma unroll
            for (int m = 0; m < 4; ++m) {
                const int row = row0 + ai * HALF + m * 16; const float s1 = sc[ai][m];
                bf16_t* rowp = O + (size_t)row * ldc + col0;
#pragma unroll
                for (int bj = 0; bj < 2; ++bj) { f32x4 v0 = acc[ai][bj][m][0] * s1, v1 = acc[ai][bj][m][1] * s1;
                    if (ACT == 1) {
#pragma unroll
                        for (int j = 0; j < 4; ++j) { const float a0 = fmaxf(v0[j], 0.f), a1 = fmaxf(v1[j], 0.f); v0[j] = a0 * a0; v1[j] = a1 * a1; } }
                    u32x4 w; w.x = pk2(v0[0], v0[1]); w.y = pk2(v0[2], v0[3]); w.z = pk2(v1[0], v1[1]); w.w = pk2(v1[2], v1[3]);
                    *(u32x4*)(rowp + bj * 32) = w; }
            }
    }
};
constexpr int QT_ROW = 264;
struct EpiScaleLds {
    static constexpr bool PERM = true, AFTER_DRAIN = true;
    const float* part;
    __device__ __forceinline__ void drained(const f32x4 (&acc)[2][2][4][2], const Unit& u, int wr, int wc, int fr, int fq, LAS unsigned char* lds) const {
        const int row0 = wr * 64 + fr, col0 = wc * 64 + 8 * fq;
        f32x4 pa[2][4];
#pragma unroll
        for (int ai = 0; ai < 2; ++ai)
#pragma unroll
            for (int m = 0; m < 4; ++m) pa[ai][m] = *((const __attribute__((address_space(1))) f32x4*)(part + (size_t)(u.pm * BM + row0 + ai * HALF + m * 16) * 16) + fq);
        __builtin_amdgcn_sched_barrier(0);
#pragma unroll
        for (int ai = 0; ai < 2; ++ai)
#pragma unroll
            for (int m = 0; m < 4; ++m) {
                const int rl = row0 + ai * HALF + m * 16;
                const f32x4 a = pa[ai][m];
                float s = (a.x + a.y) + (a.z + a.w); s = xrow_sum_(s);
                const float sc = frsq_(s * (1.0f / 1024.0f) + EPS);
#pragma unroll
                for (int bj = 0; bj < 2; ++bj) { const f32x4 v0 = acc[ai][bj][m][0] * sc, v1 = acc[ai][bj][m][1] * sc;
                    u32x4 w; w.x = pk2(v0[0], v0[1]); w.y = pk2(v0[2], v0[3]); w.z = pk2(v1[0], v1[1]); w.w = pk2(v1[2], v1[3]);
                    *(LAS u32x4*)(lds + (rl * QT_ROW + col0 + bj * 32) * 2) = w; }
            }
    }
};
struct EpiResid {
    static constexpr bool PERM = true, AFTER_DRAIN = false;
    bf16_t* XB; float* part; float alpha;
    __device__ __forceinline__ void operator()(const f32x4 (&acc)[2][2][4][2], const Unit& u, int wr, int wc, int fr, int fq, int ui, LAS unsigned char* lds) const {
        const int row0 = u.pm * BM + wr * 64 + fr, col0 = u.pn * BM + wc * 64 + 8 * fq;
        typedef const __attribute__((address_space(1))) u32x4* gp4_t;
        u32x4 xw[2][2][2];
#define ER_LOAD(q_) do { const int ai_ = (q_) >> 1, mh_ = (q_) & 1; _Pragma("unroll") for (int mm = 0; mm < 2; ++mm) _Pragma("unroll") for (int bj = 0; bj < 2; ++bj) \
            xw[(q_) & 1][mm][bj] = *(gp4_t)(XB + (size_t)(row0 + ai_ * HALF + (mh_ * 2 + mm) * 16) * DM + col0 + bj * 32); } while (0)
        ER_LOAD(0); ER_LOAD(1);
        __builtin_amdgcn_sched_barrier(0);
#pragma unroll
        for (int q = 0; q < 4; ++q) { const int ai = q >> 1, mh = q & 1;
#pragma unroll
            for (int mm = 0; mm < 2; ++mm) { const int m = mh * 2 + mm;
                const int row = row0 + ai * HALF + m * 16;
                bf16_t* bp = XB + (size_t)row * DM + col0;
                float ss = 0.f;
#pragma unroll
                for (int bj = 0; bj < 2; ++bj) { const u32x4 x4 = xw[q & 1][mm][bj];
                    const f32x4 v0 = (f32x4){bflo(x4.x), bfhi(x4.x), bflo(x4.y), bfhi(x4.y)} + acc[ai][bj][m][0] * alpha;
                    const f32x4 v1 = (f32x4){bflo(x4.z), bfhi(x4.z), bflo(x4.w), bfhi(x4.w)} + acc[ai][bj][m][1] * alpha;
                    ss += ((v0.x * v0.x + v0.y * v0.y) + (v0.z * v0.z + v0.w * v0.w)) + ((v1.x * v1.x + v1.y * v1.y) + (v1.z * v1.z + v1.w * v1.w));
                    u32x4 w; w.x = pk2(v0.x, v0.y); w.y = pk2(v0.z, v0.w); w.z = pk2(v1.x, v1.y); w.w = pk2(v1.z, v1.w); *(u32x4*)(bp + bj * 32) = w; }
                ss = xrow_sum_(ss);
                if (fq == 0) part[(size_t)row * 16 + u.pn * 4 + wc] = ss;
            }
            __builtin_amdgcn_sched_barrier(0);
            if (q + 2 < 4) { ER_LOAD(q + 2); __builtin_amdgcn_sched_barrier(0); }
        }
#undef ER_LOAD
    }
};

template <class Epi, class Sched>
__device__ __forceinline__ void gemm_phase(LAS unsigned char* lds, const Gemm g, const Sched& S, const Epi& E, const int tid) {
    const int wid = __builtin_amdgcn_readfirstlane(tid >> 6), lane = tid & 63, wr = wid >> 2, wc = wid & 3, fr = lane & 15, fq = lane >> 4;
    const int K = g.K, nt = K / BK;
    unsigned voffA[2], voffB[2];
#pragma unroll
    for (int i = 0; i < 2; ++i) { int R, C; stage_rc(tid * 16 + i * 8192, R, C); const int Rb = Epi::PERM ? (64 * (R >> 5) + perm32(R & 31)) : R;
        voffA[i] = (unsigned)(R * K + C) * 2u; voffB[i] = (unsigned)(Rb * K + C) * 2u; }
    const size_t kstep = (size_t)(BK * 2);
    const size_t hstep = (size_t)HALF * K * 2;
    const size_t tstep = 2 * hstep;
    const size_t bhstep = Epi::PERM ? (size_t)32 * K * 2 : hstep;
    const unsigned ldsw = (unsigned)wid * 1024u;
    const int aoff = lds_byte(wr * 64 + fr, fq * 8), boff = lds_byte(wc * 32 + fr, fq * 8);
#define PG8_SA(b, h) (((b) * 2 + (h)) * HTB)
#define PG8_SB(b, h) ((4 + (b) * 2 + (h)) * HTB)
#define PG8_STAGE(bufoff, gbase, voff) do { _Pragma("unroll") for (int _i = 0; _i < 2; ++_i) \
        __builtin_amdgcn_global_load_lds((const unsigned*)((const char*)(gbase) + (voff)[_i]), (LAS unsigned*)(lds + (bufoff) + ldsw + _i * 8192), 16, 0, 0); } while (0)
#define PG8_LDA(dst, b, h) do { _Pragma("unroll") for (int m = 0; m < 4; ++m) _Pragma("unroll") for (int k = 0; k < 2; ++k) dst[m][k] = *(const LAS bf16x8*)(lds + PG8_SA(b, h) + aoff + m * 2048 + k * 1024); } while (0)
#define PG8_LDB(dst, b, h) do { _Pragma("unroll") for (int n = 0; n < 2; ++n) _Pragma("unroll") for (int k = 0; k < 2; ++k) dst[n][k] = *(const LAS bf16x8*)(lds + PG8_SB(b, h) + boff + n * 2048 + k * 1024); } while (0)
#define PG8_MMA(ai, bj, At, Bt) do { __builtin_amdgcn_s_setprio(1); _Pragma("unroll") for (int m = 0; m < 4; ++m) _Pragma("unroll") for (int n = 0; n < 2; ++n) _Pragma("unroll") for (int k = 0; k < 2; ++k) \
        acc[ai][bj][m][n] = __builtin_amdgcn_mfma_f32_16x16x32_bf16(Bt[n][k], At[m][k], acc[ai][bj][m][n], 0, 0, 0); __builtin_amdgcn_s_setprio(0); } while (0)
#define PG8_WAIT_V(n) asm volatile("s_waitcnt vmcnt(" #n ")" ::: "memory")
#define PG8_WAIT_L(n) asm volatile("s_waitcnt lgkmcnt(" #n ")" ::: "memory")
#define PG8_BAR __builtin_amdgcn_s_barrier()
#define PG8_SCHED __builtin_amdgcn_sched_barrier(0)
    Unit cur, nxt; int ui = 0;
    if (!S.next(0, cur)) return;
    f32x4 acc[2][2][4][2];
#pragma unroll
    for (int a = 0; a < 2; ++a)
#pragma unroll
        for (int b = 0; b < 2; ++b)
#pragma unroll
            for (int m = 0; m < 4; ++m)
#pragma unroll
                for (int n = 0; n < 2; ++n) acc[a][b][m][n] = (f32x4){0.f, 0.f, 0.f, 0.f};
    bf16x8 At[4][2], B0[2][2], B1[2][2];
    const char* cA = (const char*)g.A + (size_t)cur.pm * tstep; const char* cB = (const char*)g.Bt + (size_t)cur.pn * tstep;
    S.a_ready(cur);
    PG8_STAGE(PG8_SB(0, 0), cB, voffB); PG8_STAGE(PG8_SA(0, 0), cA, voffA); PG8_STAGE(PG8_SB(0, 1), cB + bhstep, voffB); PG8_STAGE(PG8_SA(0, 1), cA + hstep, voffA);
    if (wr == 1) PG8_BAR;
    PG8_WAIT_V(4); PG8_BAR;
    PG8_STAGE(PG8_SB(1, 0), cB + kstep, voffB); PG8_STAGE(PG8_SA(1, 0), cA + kstep, voffA); PG8_STAGE(PG8_SB(1, 1), cB + bhstep + kstep, voffB);
    PG8_WAIT_V(6); PG8_BAR;
    for (;;) {
        const bool has_next = S.next(ui + 1, nxt);
        const char* nA = has_next ? (const char*)g.A + (size_t)nxt.pm * tstep : cA; const char* nB = has_next ? (const char*)g.Bt + (size_t)nxt.pn * tstep : cB;
        for (int t = 0; t < nt; t += 2) {
            const bool last = (t == nt - 2);
            const char* a1 = cA + (size_t)(t + 1) * kstep;
            const char* a2 = last ? nA : cA + (size_t)(t + 2) * kstep; const char* b2 = last ? nB : cB + (size_t)(t + 2) * kstep;
            const char* a3 = a2 + kstep; const char* b3 = b2 + kstep;
            if (last && has_next) S.a_ready(nxt);
            PG8_LDB(B0, 0, 0); PG8_SCHED; PG8_LDA(At, 0, 0); PG8_STAGE(PG8_SA(1, 1), a1 + hstep, voffA);
            PG8_WAIT_L(8); PG8_BAR; PG8_WAIT_L(0); PG8_MMA(0, 0, At, B0); PG8_BAR; PG8_SCHED;
            PG8_LDB(B1, 0, 1); PG8_STAGE(PG8_SB(0, 0), b2, voffB);
            PG8_BAR; PG8_WAIT_L(0); PG8_MMA(0, 1, At, B1); PG8_BAR;
            PG8_LDA(At, 0, 1); PG8_STAGE(PG8_SA(0, 0), a2, voffA);
            PG8_BAR; PG8_WAIT_L(0); PG8_MMA(1, 0, At, B0); PG8_BAR; PG8_SCHED;
            PG8_STAGE(PG8_SB(0, 1), b2 + bhstep, voffB);
            PG8_WAIT_V(6); PG8_BAR; PG8_MMA(1, 1, At, B1); PG8_BAR;
            PG8_LDB(B0, 1, 0); PG8_SCHED; PG8_LDA(At, 1, 0); PG8_STAGE(PG8_SA(0, 1), a2 + hstep, voffA);
            PG8_WAIT_L(8); PG8_BAR; PG8_WAIT_L(0); PG8_MMA(0, 0, At, B0); PG8_BAR; PG8_SCHED;
            PG8_LDB(B1, 1, 1); PG8_STAGE(PG8_SB(1, 0), b3, voffB);
            PG8_BAR; PG8_WAIT_L(0); PG8_MMA(0, 1, At, B1); PG8_BAR;
            PG8_LDA(At, 1, 1); PG8_STAGE(PG8_SA(1, 0), a3, voffA);
            PG8_BAR; PG8_WAIT_L(0); PG8_MMA(1, 0, At, B0); PG8_BAR; PG8_SCHED;
            PG8_STAGE(PG8_SB(1, 1), b3 + bhstep, voffB);
            PG8_WAIT_V(6); PG8_BAR; PG8_MMA(1, 1, At, B1); PG8_BAR;
        }
        if constexpr (!Epi::AFTER_DRAIN) { E(acc, cur, wr, wc, fr, fq, ui, lds); S.done(cur); }
        if (!has_next) break;
#pragma unroll
        for (int a = 0; a < 2; ++a)
#pragma unroll
            for (int b = 0; b < 2; ++b)
#pragma unroll
                for (int m = 0; m < 4; ++m)
#pragma unroll
                    for (int n = 0; n < 2; ++n) acc[a][b][m][n] = (f32x4){0.f, 0.f, 0.f, 0.f};
        cur = nxt; cA = nA; cB = nB; ++ui;
    }
    PG8_WAIT_V(0);
    if (wr == 0) PG8_BAR;
    PG8_BAR;
    if constexpr (Epi::AFTER_DRAIN) { E.drained(acc, cur, wr, wc, fr, fq, lds); S.done(cur); }
#undef PG8_SA
#undef PG8_SB
#undef PG8_STAGE
#undef PG8_LDA
#undef PG8_LDB
#undef PG8_MMA
#undef PG8_WAIT_V
#undef PG8_WAIT_L
#undef PG8_BAR
#undef PG8_SCHED
}
}

struct Params {
    const float* x; const float* mem; const int* pos;
    const float* norm_mix; const float* w_in; const float* ret_gn;
    const float* lru_conv_w; const float* lru_conv_b; const float* lru_wa; const float* lru_ba; const float* lru_wx; const float* lru_bx; const float* lru_lambda;
    const float* mla_q_norm; const float* mla_w_uq; const float* mla_kv_norm; const float* mla_w_ukv;
    const float* gdn_conv_w; const float* gdn_a_log; const float* gdn_dt_bias; const float* gdn_norm;
    const float* w_out; const float* norm_xattn; const float* norm_mem; const float* xa_wq; const float* xa_wkv; const float* xa_wo;
    const float* norm_mlp; const float* mlp_w1; const float* mlp_w2; const float* final_norm;
    float* out; unsigned char* ws;
    int ph_lo, ph_hi;
};

__device__ __forceinline__ bf16_t* wl(const Params& P, int l, size_t off) { return (bf16_t*)(P.ws + WS_W) + (size_t)l * W_LAYER + off; }

struct WTile { const float* src; const float* gain; bf16_t* dst; int K, N, kb, nb; float scale; };
__device__ __forceinline__ WTile p0_decode(const Params& P, int it) {
    constexpr int T_IN = 16 * 48, T_SQ = 256, T_KV = 512, T_W1 = 1024, T_W2 = 1024, T_UQ = 18, T_UKV = 16, T_LRU = 8;
    constexpr int T_LAYER = T_IN + 3 * T_SQ + T_KV + T_W1 + T_W2 + T_UQ + T_UKV + T_LRU;
    const int l = it / T_LAYER; int r = it % T_LAYER; int nnb; WTile t; t.gain = nullptr; t.scale = 1.f;
    if (r < T_IN) { t.src = P.w_in + (size_t)l * DM * IN_COLS; t.K = DM; t.N = IN_COLS; nnb = 48; t.gain = P.norm_mix + l * DM; t.dst = wl(P, l, W_IN); }
    else if ((r -= T_IN) < T_SQ) { t.src = P.w_out + (size_t)l * DM * DM; t.K = DM; t.N = DM; nnb = 16; t.dst = wl(P, l, W_OUT); }
    else if ((r -= T_SQ) < T_SQ) { t.src = P.xa_wq + (size_t)l * DM * DM; t.K = DM; t.N = DM; nnb = 16; t.gain = P.norm_xattn + l * DM; t.scale = 0.0625f * LOG2E; t.dst = wl(P, l, W_Q); }
    else if ((r -= T_SQ) < T_KV) { t.src = P.xa_wkv + (size_t)l * DM * 2 * DM; t.K = DM; t.N = 2 * DM; nnb = 32; t.gain = P.norm_mem + l * DM; t.dst = wl(P, l, W_KV); }
    else if ((r -= T_KV) < T_SQ) { t.src = P.xa_wo + (size_t)l * DM * DM; t.K = DM; t.N = DM; nnb = 16; t.dst = wl(P, l, W_O); }
    else if ((r -= T_SQ) < T_W1) { t.src = P.mlp_w1 + (size_t)l * DM * DFF; t.K = DM; t.N = DFF; nnb = 64; t.gain = P.norm_mlp + l * DM; t.dst = wl(P, l, W_1); }
    else if ((r -= T_W1) < T_W2) { t.src = P.mlp_w2 + (size_t)l * DFF * DM; t.K = DFF; t.N = DM; nnb = 16; t.dst = wl(P, l, W_2); }
    else if ((r -= T_W2) < T_UQ) { t.src = P.mla_w_uq + (size_t)l * 192 * 384; t.K = 192; t.N = 384; nnb = 6; t.gain = P.mla_q_norm + l * 192; t.dst = wl(P, l, W_UQ); }
    else if ((r -= T_UQ) < T_UKV) { t.src = P.mla_w_ukv + (size_t)l * 128 * 512; t.K = 128; t.N = 512; nnb = 8; t.gain = P.mla_kv_norm + l * 128; t.dst = wl(P, l, W_UKV); }
    else { r -= T_UKV; const int which = r >> 2, nb4 = r & 3; t.src = (which ? P.lru_wx : P.lru_wa) + (size_t)l * 4 * 4096 + nb4 * 4096; t.K = 64; t.N = 64; nnb = 1; t.dst = wl(P, l, which ? W_X : W_A) + nb4 * 4096; r = 0; }
    t.kb = r / nnb; t.nb = r % nnb; return t;
}
__device__ __forceinline__ void p0_fetch(const WTile& t, int tid, f32x4 (&x)[2], float (&gl)[2]) {
#pragma unroll
    for (int i = 0; i < 2; ++i) { const int kk = (tid >> 4) + 32 * i, k = t.kb * 64 + kk, n = t.nb * 64 + (tid & 15) * 4, nc = n < t.N ? n : 0;
        x[i] = *(const __attribute__((address_space(1))) f32x4*)(t.src + (size_t)k * t.N + nc);
        gl[i] = *(const __attribute__((address_space(1))) float*)((t.gain ? t.gain : t.src) + k); }
}
__device__ __forceinline__ f32x4 p0_apply(const WTile& t, int tid, int i, f32x4 x, float gl) {
    const int n = t.nb * 64 + (tid & 15) * 4;
    float g = t.scale * (t.gain ? gl : 1.0f); g = n < t.N ? g : 0.f;
    return x * g;
}
__device__ __forceinline__ void p0_prologue(const Params& P, LAS unsigned char* lds, int tid) {
    LAS float* scr = (LAS float*)lds;
    constexpr int NT = 2 * (16 * 48 + 3 * 256 + 512 + 1024 + 1024 + 18 + 16 + 8);
    int it = blockIdx.x;
    if (it < NT) {
        WTile cur = p0_decode(P, it); f32x4 x[2]; float gl[2]; p0_fetch(cur, tid, x, gl);
        for (;;) {
#pragma unroll
            for (int i = 0; i < 2; ++i) { const f32x4 v = p0_apply(cur, tid, i, x[i], gl[i]); LAS float* d = scr + ((tid >> 4) + 32 * i) * 65 + (tid & 15) * 4; d[0] = v.x; d[1] = v.y; d[2] = v.z; d[3] = v.w; }
            const int nxt = it + gridDim.x; const bool more = nxt < NT;
            const WTile nx = p0_decode(P, more ? nxt : it); p0_fetch(nx, tid, x, gl);
            __builtin_amdgcn_sched_barrier(0);
            __syncthreads();
            { const int nl = tid >> 3, k0 = (tid & 7) * 8; const LAS float* s = scr + k0 * 65 + nl;
              u32x4 o; o.x = pk2(s[0], s[65]); o.y = pk2(s[2 * 65], s[3 * 65]); o.z = pk2(s[4 * 65], s[5 * 65]); o.w = pk2(s[6 * 65], s[7 * 65]);
              *(u32x4*)(cur.dst + (size_t)(cur.nb * 64 + nl) * cur.K + cur.kb * 64 + k0) = o; }
            __syncthreads();
            if (!more) break;
            cur = nx; it = nxt;
        }
    }
    const int wave = tid >> 6, lane = tid & 63;
    const int gw = blockIdx.x * 8 + wave, ngw = gridDim.x * 8;
    bf16_t* xb = (bf16_t*)(P.ws + WS_XB); float* part = (float*)(P.ws + WS_PART); bf16_t* memn = (bf16_t*)(P.ws + WS_GDN);
    constexpr int NR = T_TOK + NBATCH * NMEM;
    for (int row0 = gw; row0 < NR; row0 += 2 * ngw) {
        f32x4 v[2][4]; const int row1 = row0 + ngw; const bool has1 = row1 < NR;
#pragma unroll
        for (int q = 0; q < 2; ++q) { const int row = q ? (has1 ? row1 : row0) : row0; const bool isx = row < T_TOK; const int r2 = isx ? row : row - T_TOK;
            const f32x4* src = (const f32x4*)((isx ? P.x : P.mem) + (size_t)r2 * DM) + lane;
#pragma unroll
            for (int j = 0; j < 4; ++j) v[q][j] = src[64 * j]; }
#pragma unroll
        for (int q = 0; q < 2; ++q) { if (q && !has1) break; const int row = q ? row1 : row0; const bool isx = row < T_TOK; const int r2 = isx ? row : row - T_TOK;
            float s = 0.f;
#pragma unroll
            for (int j = 0; j < 4; ++j) s += (v[q][j].x * v[q][j].x + v[q][j].y * v[q][j].y) + (v[q][j].z * v[q][j].z + v[q][j].w * v[q][j].w);
            s = wave_sum(s);
            if (isx) { u32x2* ob = (u32x2*)(xb + (size_t)row * DM) + lane;
#pragma unroll
                for (int j = 0; j < 4; ++j) { u32x2 w; w.x = pk2(v[q][j].x, v[q][j].y); w.y = pk2(v[q][j].z, v[q][j].w); ob[64 * j] = w; }
                if (lane < 16) part[(size_t)row * 16 + lane] = lane == 0 ? s : 0.f;
            } else { const float rs = frsq_(s * (1.0f / 1024.0f) + EPS); u32x2* ob = (u32x2*)(memn + (size_t)r2 * DM) + lane;
#pragma unroll
                for (int j = 0; j < 4; ++j) { u32x2 w; w.x = pk2(v[q][j].x * rs, v[q][j].y * rs); w.y = pk2(v[q][j].z * rs, v[q][j].w * rs); ob[64 * j] = w; } }
        }
    }
}
__device__ __forceinline__ void final_norm_phase(const Params& P, int tid) {
    const int wave = tid >> 6, lane = tid & 63; const float* part = (const float*)(P.ws + WS_PART); const bf16_t* xb = (const bf16_t*)(P.ws + WS_XB);
    f32x4 g[4];
#pragma unroll
    for (int j = 0; j < 4; ++j) g[j] = ((const f32x4*)P.final_norm)[64 * j + lane];
    const int ngw = gridDim.x * 8;
    for (int row0 = blockIdx.x * 8 + wave; row0 < T_TOK; row0 += 4 * ngw) {
        u32x2 w[4][4]; float s[4];
#pragma unroll
        for (int q = 0; q < 4; ++q) { const int row = row0 + q * ngw; s[q] = lane < 16 ? part[(size_t)row * 16 + lane] : 0.f;
            const u32x2* xi = (const u32x2*)(xb + (size_t)row * DM) + lane;
#pragma unroll
            for (int j = 0; j < 4; ++j) w[q][j] = xi[64 * j]; }
#pragma unroll
        for (int q = 0; q < 4; ++q) { const int row = row0 + q * ngw;
            const float rs = frsq_(wave_sum(s[q]) * (1.0f / 1024.0f) + EPS);
            f32x4* o = (f32x4*)(P.out + (size_t)row * DM) + lane;
#pragma unroll
            for (int j = 0; j < 4; ++j) o[64 * j] = (f32x4){bflo(w[q][j].x), bfhi(w[q][j].x), bflo(w[q][j].y), bfhi(w[q][j].y)} * rs * g[j]; }
    }
}
constexpr int MP_UQ_ROW = 200, MP_UKV_ROW = 136, MP_UKV_OFF = 96 * MP_UQ_ROW * 2, MP_BUF = MP_UKV_OFF + 128 * MP_UKV_ROW * 2;
__device__ __forceinline__ void mla_pre_item(const Params& P, int l, LAS unsigned char* lds, int it, int tid, int wave, int lane) {
    const int fr = lane & 15, fq = lane >> 4, rt = it * 8 + wave;
    const bf16_t* z = (const bf16_t*)(P.ws + WS_R);
    bf16_t* Qo = (bf16_t*)((unsigned char*)P.out + MLA_Q_OFF); bf16_t* Ko = (bf16_t*)((unsigned char*)P.out + MLA_K_OFF); bf16_t* Vo = (bf16_t*)((unsigned char*)P.out + MLA_VT_OFF);
    const bf16_t* Wuq = wl(P, l, W_UQ); const bf16_t* Wukv = wl(P, l, W_UKV);
    u32x4 stg[5];
    typedef const __attribute__((address_space(1))) u32x4* gp4_t; typedef const __attribute__((address_space(1))) u32x2* gp2_t;
#define MP_LOADQ(h_) do { _Pragma("unroll") for (int i = 0; i < 5; ++i) { const int p0 = tid + 512 * i, p = p0 < 2304 ? p0 : p0 - 2048; stg[i] = *(gp4_t)(Wuq + (size_t)(h_) * 96 * 192 + (size_t)p * 8); } } while (0)
#define MP_STOREQ(buf_) do { _Pragma("unroll") for (int i = 0; i < 5; ++i) { const int p0 = tid + 512 * i, p = p0 < 2304 ? p0 : p0 - 2048, row = p / 24, pc = p % 24; *(LAS u32x4*)(lds + (buf_) * MP_BUF + (row * MP_UQ_ROW + pc * 8) * 2) = stg[i]; } } while (0)
#define MP_LOADKV(h_) do { _Pragma("unroll") for (int i = 0; i < 4; ++i) { const int p = tid + 512 * i; stg[i] = *(gp4_t)(Wukv + (size_t)(h_) * 128 * 128 + (size_t)p * 8); } } while (0)
#define MP_STOREKV(buf_) do { _Pragma("unroll") for (int i = 0; i < 4; ++i) { const int p = tid + 512 * i, row = p >> 4, pc = p & 15; *(LAS u32x4*)(lds + (buf_) * MP_BUF + MP_UKV_OFF + (row * MP_UKV_ROW + pc * 8) * 2) = stg[i]; } } while (0)
    MP_LOADQ(0); MP_STOREQ(0); MP_LOADKV(0);
    const int tok0 = rt * 16, b = tok0 >> 11, s0 = tok0 & 2047;
    const bf16_t* zr = z + (size_t)(tok0 + fr) * ZP;
    bf16x8 cq[6], ckv[4]; float sq = 0.f, skv = 0.f;
    u32x4 zq[6], zkv[4];
#pragma unroll
    for (int s = 0; s < 6; ++s) zq[s] = *(gp4_t)(zr + Z_CQ + 32 * s + 8 * fq);
#pragma unroll
    for (int s = 0; s < 4; ++s) zkv[s] = *(gp4_t)(zr + Z_CKV + 32 * s + 8 * fq);
    const u32x2 kra = *(gp2_t)(zr + Z_KR + 4 * fq), krc = *(gp2_t)(zr + Z_KR + 16 + 4 * fq);
    const float pos = (float)P.pos[tok0 + fr];
    __builtin_amdgcn_sched_barrier(0);
#pragma unroll
    for (int s = 0; s < 6; ++s) { const u32x4 w = zq[s]; cq[s] = __builtin_bit_cast(bf16x8, w);
        sq += bflo(w.x) * bflo(w.x) + bfhi(w.x) * bfhi(w.x) + bflo(w.y) * bflo(w.y) + bfhi(w.y) * bfhi(w.y) + bflo(w.z) * bflo(w.z) + bfhi(w.z) * bfhi(w.z) + bflo(w.w) * bflo(w.w) + bfhi(w.w) * bfhi(w.w); }
#pragma unroll
    for (int s = 0; s < 4; ++s) { const u32x4 w = zkv[s]; ckv[s] = __builtin_bit_cast(bf16x8, w);
        skv += bflo(w.x) * bflo(w.x) + bfhi(w.x) * bfhi(w.x) + bflo(w.y) * bflo(w.y) + bfhi(w.y) * bfhi(w.y) + bflo(w.z) * bflo(w.z) + bfhi(w.z) * bfhi(w.z) + bflo(w.w) * bflo(w.w) + bfhi(w.w) * bfhi(w.w); }
    MP_STOREKV(0);
    sq = xrow_sum_(sq); skv = xrow_sum_(skv);
    const float rq = frsq_(sq * (1.0f / 192.0f) + EPS), rkv = frsq_(skv * (1.0f / 128.0f) + EPS);
    const float qsc = rq * 0.10206207261596575f * LOG2E;
    float sn[4], cs[4];
#pragma unroll
    for (int r = 0; r < 4; ++r) { const float invf = exp2f(-(float)(4 * fq + r) * (13.287712379549449f / 16.0f)); sincos_rev(pos * invf, sn[r], cs[r]); }
    const size_t tokrow = (size_t)b * 4 * SEQ + (s0 + fr);
    u32x2 kr1, kr2;
    { const float x1[4] = {bflo(kra.x), bfhi(kra.x), bflo(kra.y), bfhi(kra.y)}, x2[4] = {bflo(krc.x), bfhi(krc.x), bflo(krc.y), bfhi(krc.y)}; float y1[4], y2[4];
#pragma unroll
      for (int r = 0; r < 4; ++r) { y1[r] = x1[r] * cs[r] - x2[r] * sn[r]; y2[r] = x1[r] * sn[r] + x2[r] * cs[r]; }
      kr1.x = pk2(y1[0], y1[1]); kr1.y = pk2(y1[2], y1[3]); kr2.x = pk2(y2[0], y2[1]); kr2.y = pk2(y2[2], y2[3]); }
    float rkv_r[4];
#pragma unroll
    for (int r = 0; r < 4; ++r) rkv_r[r] = __builtin_bit_cast(float, __builtin_amdgcn_ds_bpermute((4 * fq + r) << 2, __builtin_bit_cast(int, rkv)));
    const u32x4 kr16 = widen16_(kr1, kr2);
    const int chunk = s0 >> 6, key0 = (s0 & 63) + 4 * fq;
    __syncthreads();
#pragma unroll 1
    for (int h = 0; h < 4; ++h) {
        const int hn = h < 3 ? h + 1 : 3;
        MP_LOADQ(hn);
        __builtin_amdgcn_sched_barrier(0);
        const LAS bf16_t* UQ = (const LAS bf16_t*)(lds + (h & 1) * MP_BUF); const LAS bf16_t* UKV = (const LAS bf16_t*)(lds + (h & 1) * MP_BUF + MP_UKV_OFF);
        bf16_t* qrow = Qo + (tokrow + (size_t)h * SEQ) * 96; bf16_t* krow = Ko + (tokrow + (size_t)h * SEQ) * 96;
        bf16_t* vt = Vo + ((size_t)((b * 4 + h) * NCHUNK + chunk) * 64) * 64;
        const int wsel = fq & 1, woff = (fq >> 1) * 8;
#pragma unroll 1
        for (int np = 0; np < 2; ++np) { f32x4 a = {0.f, 0.f, 0.f, 0.f}, a2 = {0.f, 0.f, 0.f, 0.f};
#pragma unroll
            for (int s = 0; s < 6; ++s) { a = mfma16(*(const LAS bf16x8*)(UQ + (np * 32 + fr) * MP_UQ_ROW + 32 * s + 8 * fq), cq[s], a); a2 = mfma16(*(const LAS bf16x8*)(UQ + (np * 32 + 16 + fr) * MP_UQ_ROW + 32 * s + 8 * fq), cq[s], a2); }
            a = a * qsc; a2 = a2 * qsc; u32x2 w, w2; w.x = pk2(a.x, a.y); w.y = pk2(a.z, a.w); w2.x = pk2(a2.x, a2.y); w2.y = pk2(a2.z, a2.w);
            *(u32x4*)(qrow + (np * 2 + wsel) * 16 + woff) = widen16_(w, w2); }
        {   f32x4 x1 = {0.f, 0.f, 0.f, 0.f}, x2 = {0.f, 0.f, 0.f, 0.f}, y1, y2;
#pragma unroll
            for (int s = 0; s < 6; ++s) { x1 = mfma16(*(const LAS bf16x8*)(UQ + (64 + fr) * MP_UQ_ROW + 32 * s + 8 * fq), cq[s], x1); x2 = mfma16(*(const LAS bf16x8*)(UQ + (80 + fr) * MP_UQ_ROW + 32 * s + 8 * fq), cq[s], x2); }
            x1 = x1 * qsc; x2 = x2 * qsc;
#pragma unroll
            for (int r = 0; r < 4; ++r) { y1[r] = x1[r] * cs[r] - x2[r] * sn[r]; y2[r] = x1[r] * sn[r] + x2[r] * cs[r]; }
            u32x2 w, w2; w.x = pk2(y1.x, y1.y); w.y = pk2(y1.z, y1.w); w2.x = pk2(y2.x, y2.y); w2.y = pk2(y2.z, y2.w);
            *(u32x4*)(qrow + 64 + wsel * 16 + woff) = widen16_(w, w2); }
        __builtin_amdgcn_sched_barrier(0);
        MP_STOREQ((h + 1) & 1); MP_LOADKV(hn);
        __builtin_amdgcn_sched_barrier(0);
#pragma unroll 1
        for (int np = 0; np < 2; ++np) { f32x4 a = {0.f, 0.f, 0.f, 0.f}, a2 = {0.f, 0.f, 0.f, 0.f};
#pragma unroll
            for (int s = 0; s < 4; ++s) { a = mfma16(*(const LAS bf16x8*)(UKV + (np * 32 + fr) * MP_UKV_ROW + 32 * s + 8 * fq), ckv[s], a); a2 = mfma16(*(const LAS bf16x8*)(UKV + (np * 32 + 16 + fr) * MP_UKV_ROW + 32 * s + 8 * fq), ckv[s], a2); }
            a = a * rkv; a2 = a2 * rkv; u32x2 w, w2; w.x = pk2(a.x, a.y); w.y = pk2(a.z, a.w); w2.x = pk2(a2.x, a2.y); w2.y = pk2(a2.z, a2.w);
            *(u32x4*)(krow + (np * 2 + wsel) * 16 + woff) = widen16_(w, w2); }
        *(u32x4*)(krow + 64 + wsel * 16 + woff) = kr16;
#pragma unroll 1
        for (int np = 0; np < 2; ++np) { f32x4 a = {0.f, 0.f, 0.f, 0.f}, a2 = {0.f, 0.f, 0.f, 0.f};
#pragma unroll
            for (int s = 0; s < 4; ++s) { a = mfma16(ckv[s], *(const LAS bf16x8*)(UKV + (64 + np * 32 + fr) * MP_UKV_ROW + 32 * s + 8 * fq), a); a2 = mfma16(ckv[s], *(const LAS bf16x8*)(UKV + (64 + np * 32 + 16 + fr) * MP_UKV_ROW + 32 * s + 8 * fq), a2); }
            u32x2 w, w2; w.x = pk2(a.x * rkv_r[0], a.y * rkv_r[1]); w.y = pk2(a.z * rkv_r[2], a.w * rkv_r[3]); w2.x = pk2(a2.x * rkv_r[0], a2.y * rkv_r[1]); w2.y = pk2(a2.z * rkv_r[2], a2.w * rkv_r[3]);
            *(u32x4*)(vt + (size_t)((np * 2 + wsel) * 16 + fr) * 64 + (s0 & 63) + woff) = widen16_(w, w2); }
        __builtin_amdgcn_sched_barrier(0);
        MP_STOREKV((h + 1) & 1);
        __syncthreads();
    }
#undef MP_LOADQ
#undef MP_STOREQ
#undef MP_LOADKV
#undef MP_STOREKV
}

template <int DQK, int DV, int KT, int QT>
__device__ __forceinline__ void flash_item(LAS unsigned char* lds, const bf16_t* Qw, int ldq, const bf16_t* Kb, int ldk, const bf16_t* VTb, int ldv, int vts,
                                           bf16_t* Ow, int ldo, int ntiles, int wave_limit, int tid, int lane) {
    constexpr int KROW = DQK + 8, VROW = KT + 16  , KS = DQK / 32, ET = DV / 16, NKT = KT / 16, KBYTES = KT * KROW * 2, BUF = KBYTES + DV * VROW * 2;
    constexpr int KP = KT * DQK / 8, VPR = KT / 8, VP = DV * VPR, NKP = (KP + 511) / 512, NVP = (VP + 511) / 512, NP = NKP > NVP ? NKP : NVP;
    const int fr = lane & 15, fq = lane >> 4;
    bf16x8 qf[QT][KS];
#pragma unroll
    for (int qi = 0; qi < QT; ++qi)
#pragma unroll
        for (int s = 0; s < KS; ++s) qf[qi][s] = *(const bf16x8*)(Qw + (size_t)(qi * 16 + fr) * ldq + 32 * s + 8 * fq);
    f32x4 ot[QT][ET];
#pragma unroll
    for (int qi = 0; qi < QT; ++qi)
#pragma unroll
        for (int e = 0; e < ET; ++e) ot[qi][e] = (f32x4){0.f, 0.f, 0.f, 0.f};
    float m_run[QT]; f32x4 ol[QT];
#pragma unroll
    for (int qi = 0; qi < QT; ++qi) { m_run[qi] = 0.f; ol[qi] = (f32x4){0.f, 0.f, 0.f, 0.f}; }
    const unsigned one2 = fr == 0 ? 0x3F803F80u : 0u; const bf16x8 ones_f = __builtin_bit_cast(bf16x8, (u32x4){one2, one2, one2, one2});
    u32x4 pregk[NKP], pregv[NVP];
    typedef const __attribute__((address_space(1))) u32x4* gp4_t;
#define FL_LOADK(j_) do { _Pragma("unroll") for (int i = 0; i < NKP; ++i) { const int idx0 = tid + i * 512, idx = idx0 < KP ? idx0 : idx0 - 512, row = idx / (DQK / 8), pc = idx % (DQK / 8); \
            pregk[i] = *(gp4_t)(Kb + (size_t)((j_) * KT + row) * ldk + pc * 8); } } while (0)
#define FL_LOADV(j_) do { _Pragma("unroll") for (int i = 0; i < NVP; ++i) { const int idx0 = tid + i * 512, idx = idx0 < VP ? idx0 : idx0 - 512, row = idx / VPR, pc = idx % VPR; \
            pregv[i] = *(gp4_t)(VTb + (size_t)(j_) * vts + (size_t)row * ldv + pc * 8); } } while (0)
#define FL_STOREK(buf_) do { LAS bf16_t* Kt_ = (LAS bf16_t*)(lds + (buf_) * BUF); \
        _Pragma("unroll") for (int i = 0; i < NKP; ++i) { const int idx0 = tid + i * 512, idx = idx0 < KP ? idx0 : idx0 - 512, row = idx / (DQK / 8), pc = idx % (DQK / 8); *(LAS u32x4*)(Kt_ + row * KROW + pc * 8) = pregk[i]; } } while (0)
#define FL_STOREV(buf_) do { LAS bf16_t* Vt_ = (LAS bf16_t*)(lds + (buf_) * BUF + KBYTES); \
        _Pragma("unroll") for (int i = 0; i < NVP; ++i) { const int idx0 = tid + i * 512, idx = idx0 < VP ? idx0 : idx0 - 512, row = idx / VPR, pc = idx % VPR; *(LAS u32x4*)(Vt_ + row * VROW + pc * 8) = pregv[i]; } } while (0)
    FL_LOADK(0); FL_LOADV(0); FL_STOREK(0); FL_STOREV(0);
    { const int j1 = 1 < ntiles ? 1 : 0; FL_LOADK(j1); FL_LOADV(j1); }
    __syncthreads();
#pragma unroll 1
    for (int j = 0; j < ntiles; ++j) {
        const bool act = j < wave_limit;
        const int jn = j + 2 < ntiles ? j + 2 : ntiles - 1;
        const LAS bf16_t* Kt = (const LAS bf16_t*)(lds + (j & 1) * BUF); const LAS bf16_t* Vt = (const LAS bf16_t*)(lds + (j & 1) * BUF + KBYTES);
        FL_STOREK((j + 1) & 1); FL_STOREV((j + 1) & 1);
        FL_LOADK(jn); FL_LOADV(jn);
        __builtin_amdgcn_sched_barrier(0);
        f32x4 st[QT][NKT];
        if (act) {
            bf16x8 kf[NKT][KS], vf[ET][NKT / 2];
#pragma unroll
            for (int kt = 0; kt < NKT; ++kt)
#pragma unroll
                for (int s = 0; s < KS; ++s) kf[kt][s] = *(const LAS bf16x8*)(Kt + (32 * (kt >> 1) + 8 * (fr >> 2) + 4 * (kt & 1) + (fr & 3)) * KROW + 32 * s + 8 * fq);
#pragma unroll
            for (int e = 0; e < ET; ++e) { const LAS bf16_t* vr = Vt + (e * 16 + fr) * VROW + 8 * fq;
#pragma unroll
                for (int k2 = 0; k2 < NKT / 2; ++k2) vf[e][k2] = *(const LAS bf16x8*)(vr + 32 * k2); }
#pragma unroll
            for (int kt = 0; kt < NKT; ++kt) {
#pragma unroll
                for (int qi = 0; qi < QT; ++qi) { const float nm = -m_run[qi]; st[qi][kt] = (f32x4){nm, nm, nm, nm}; }
#pragma unroll
                for (int s = 0; s < KS; ++s)
#pragma unroll
                    for (int qi = 0; qi < QT; ++qi) st[qi][kt] = mfma16(kf[kt][s], qf[qi][s], st[qi][kt]); }
            typedef int i32x4_t __attribute__((ext_vector_type(4)));
            i32x4_t im4 = __builtin_bit_cast(i32x4_t, st[0][0]);
#pragma unroll
            for (int qi = 0; qi < QT; ++qi)
#pragma unroll
                for (int kt = 0; kt < NKT; ++kt) im4 = __builtin_elementwise_max(im4, __builtin_bit_cast(i32x4_t, st[qi][kt]));
            const int im01 = im4.x > im4.y ? im4.x : im4.y, im23 = im4.z > im4.w ? im4.z : im4.w, im = im01 > im23 ? im01 : im23;
            if (j == 0 || __builtin_amdgcn_ballot_w64(im > 0x41000000) != 0ull) {
#pragma unroll
                for (int qi = 0; qi < QT; ++qi) {
                    float mx = fmaxf(fmaxf(st[qi][0].x, st[qi][0].y), fmaxf(st[qi][0].z, st[qi][0].w));
#pragma unroll
                    for (int kt = 1; kt < NKT; ++kt) mx = fmaxf(mx, fmaxf(fmaxf(st[qi][kt].x, st[qi][kt].y), fmaxf(st[qi][kt].z, st[qi][kt].w)));
                    mx = xrow_max_(mx);
                    if (j > 0) mx = fmaxf(mx, 0.f);
                    const float alpha = fexp2_(-mx);
                    m_run[qi] += mx;
#pragma unroll
                    for (int kt = 0; kt < NKT; ++kt) st[qi][kt] = st[qi][kt] - mx;
#pragma unroll
                    for (int e = 0; e < ET; ++e) ot[qi][e] = ot[qi][e] * alpha;
                    ol[qi] = ol[qi] * alpha;
                }
            }
            bf16x8 pf[QT][NKT / 2];
#pragma unroll
            for (int qi = 0; qi < QT; ++qi) {
#pragma unroll
                for (int kt = 0; kt < NKT; ++kt)
#pragma unroll
                    for (int r = 0; r < 4; ++r) st[qi][kt][r] = fexp2_(st[qi][kt][r]);
#pragma unroll
                for (int k2 = 0; k2 < NKT / 2; ++k2) pf[qi][k2] = pack8(st[qi][2 * k2], st[qi][2 * k2 + 1]);
            }
#pragma unroll
            for (int e = 0; e < ET; ++e)
#pragma unroll
                for (int k2 = 0; k2 < NKT / 2; ++k2)
#pragma unroll
                    for (int qi = 0; qi < QT; ++qi) ot[qi][e] = mfma16(vf[e][k2], pf[qi][k2], ot[qi][e]);
#pragma unroll
            for (int k2 = 0; k2 < NKT / 2; ++k2)
#pragma unroll
                for (int qi = 0; qi < QT; ++qi) ol[qi] = mfma16(ones_f, pf[qi][k2], ol[qi]);
        }
        __syncthreads();
    }
#undef FL_LOADK
#undef FL_LOADV
#undef FL_STOREK
#undef FL_STOREV
#pragma unroll
    for (int qi = 0; qi < QT; ++qi) {
        float l = ol[qi].x; l = xrow_sum_(l);
        const float inv = frcp_(l);
#pragma unroll
        for (int e2 = 0; e2 < ET / 2; ++e2) { u32x2 w, w2;
            w.x = pk2(ot[qi][2 * e2].x * inv, ot[qi][2 * e2].y * inv); w.y = pk2(ot[qi][2 * e2].z * inv, ot[qi][2 * e2].w * inv);
            w2.x = pk2(ot[qi][2 * e2 + 1].x * inv, ot[qi][2 * e2 + 1].y * inv); w2.y = pk2(ot[qi][2 * e2 + 1].z * inv, ot[qi][2 * e2 + 1].w * inv);
            *(u32x4*)(Ow + (size_t)(qi * 16 + fr) * ldo + (2 * e2 + (fq & 1)) * 16 + (fq >> 1) * 8) = widen16_(w, w2); }
    }
}
__device__ __forceinline__ void mla_attn_item(const Params& P, LAS unsigned char* lds, int it, int tid, int wave, int lane) {
    const int qt = (int)((0x01243657u >> (4 * (it >> 6))) & 15u), bh = it & 63;
    const bf16_t* Q = (const bf16_t*)((unsigned char*)P.out + MLA_Q_OFF) + ((size_t)bh * SEQ + qt * 256 + wave * 32) * 96;
    const bf16_t* K = (const bf16_t*)((unsigned char*)P.out + MLA_K_OFF) + (size_t)bh * SEQ * 96;
    const bf16_t* VT = (const bf16_t*)((unsigned char*)P.out + MLA_VT_OFF) + (size_t)bh * NCHUNK * 4096;
    bf16_t* y = (bf16_t*)(P.ws + WS_R + R_Y) + ((size_t)(bh >> 2) * SEQ + qt * 256 + wave * 32) * DM + 512 + (bh & 3) * 64;
    flash_item<96, 64, 64, 2>(lds, Q, 96, K, 96, VT, 64, 4096, y, DM, 4 * qt + 4, 4 * qt + (wave >> 1) + 1, tid, lane);
}
constexpr int XA_KROW = 264, XA_VROW = 80, XA_KBUF = 32 * XA_KROW * 2, XA_VBUF = 128 * XA_VROW * 2, XA_VOFF = 2 * XA_KBUF;
__device__ __forceinline__ void xa_item(const Params& P, int l, LAS unsigned char* lds, int it, int tid, int wave, int lane) {
    const int qt = it & 7, h = (it >> 3) & 3, b = it >> 5, fr = lane & 15, fq = lane >> 4;
    const size_t qoff = ((size_t)b * SEQ + qt * 256 + wave * 32) * DM + h * 256;
    bf16_t* O = (bf16_t*)(P.ws + WS_R + R_OX) + qoff;
    const bf16_t* Kb = (const bf16_t*)(P.ws + WS_KVM + (size_t)l * KVM_LAYER) + (size_t)b * NMEM * DM + h * 256;
    const bf16_t* VTb = (const bf16_t*)(P.ws + WS_KVM + (size_t)l * KVM_LAYER + (size_t)4096 * 1024 * 2) + (size_t)h * 256 * 4096 + b * NMEM;
    u32x4 stg[2];
#define XA_LOADK(j_) do { _Pragma("unroll") for (int i = 0; i < 2; ++i) { const int p = tid + 512 * i, row = p >> 5, pc = p & 31; stg[i] = *(const u32x4*)(Kb + (size_t)((j_) * 32 + row) * DM + pc * 8); } } while (0)
#define XA_STOREK(buf_) do { _Pragma("unroll") for (int i = 0; i < 2; ++i) { const int p = tid + 512 * i, row = p >> 5, pc = p & 31; *(LAS u32x4*)(lds + (buf_) * XA_KBUF + (row * XA_KROW + pc * 8) * 2) = stg[i]; } } while (0)
#define XA_LOADV(t_) do { _Pragma("unroll") for (int i = 0; i < 2; ++i) { const int p = tid + 512 * i, row = p >> 3, pc = p & 7; stg[i] = *(const u32x4*)(VTb + (size_t)(((t_) >> 2) * 128 + row) * 4096 + ((t_) & 3) * 64 + pc * 8); } } while (0)
#define XA_STOREV(buf_) do { _Pragma("unroll") for (int i = 0; i < 2; ++i) { const int p = tid + 512 * i, row = p >> 3, pc = p & 7; *(LAS u32x4*)(lds + XA_VOFF + (buf_) * XA_VBUF + (row * XA_VROW + pc * 8) * 2) = stg[i]; } } while (0)
    XA_LOADK(0);
    bf16x8 pf[2][8];
    float linv[2], c1[2];
    {
        bf16x8 qf[2][8];
#pragma unroll
        for (int qi = 0; qi < 2; ++qi)
#pragma unroll
            for (int s = 0; s < 8; ++s) qf[qi][s] = *(const LAS bf16x8*)(lds + ((wave * 32 + qi * 16 + fr) * pg8::QT_ROW + 32 * s + 8 * fq) * 2);
        asm volatile("s_waitcnt lgkmcnt(0)" ::: "memory");
        __syncthreads();
        XA_STOREK(0);
        __syncthreads();
        float m1[2], l1[2];
#pragma unroll
        for (int half = 0; half < 2; ++half) {
            f32x4 S[2][8];
#pragma unroll
            for (int jj = 0; jj < 4; ++jj) { const int j = half * 4 + jj;
                if (j < 7) XA_LOADK(j + 1); else XA_LOADV(0);
                const LAS bf16_t* Kt = (const LAS bf16_t*)(lds + (j & 1) * XA_KBUF);
#pragma unroll
                for (int kt = 0; kt < 2; ++kt) {
                    f32x4 a0 = {0.f, 0.f, 0.f, 0.f}, a1 = {0.f, 0.f, 0.f, 0.f};
#pragma unroll
                    for (int s = 0; s < 8; ++s) { const bf16x8 kf = *(const LAS bf16x8*)(Kt + (8 * (fr >> 2) + 4 * kt + (fr & 3)) * XA_KROW + 32 * s + 8 * fq); a0 = mfma16(kf, qf[0][s], a0); a1 = mfma16(kf, qf[1][s], a1); }
                    S[0][2 * jj + kt] = a0; S[1][2 * jj + kt] = a1; __builtin_amdgcn_sched_barrier(0); }
                if (j < 7) XA_STOREK((j + 1) & 1); else XA_STOREV(0);
                __syncthreads();
            }
#pragma unroll
            for (int qi = 0; qi < 2; ++qi) {
                float mx = -1e30f;
#pragma unroll
                for (int t = 0; t < 8; ++t) mx = fmaxf(mx, fmaxf(fmaxf(S[qi][t].x, S[qi][t].y), fmaxf(S[qi][t].z, S[qi][t].w)));
                mx = xrow_max_(mx);
                if (half == 1) { const float m = fmaxf(m1[qi], mx); c1[qi] = fexp2_(m1[qi] - m); mx = m; }
                float ls = 0.f;
#pragma unroll
                for (int t = 0; t < 4; ++t) { f32x4 pa, pb;
#pragma unroll
                    for (int r = 0; r < 4; ++r) { pa[r] = fexp2_(S[qi][2 * t][r] - mx); pb[r] = fexp2_(S[qi][2 * t + 1][r] - mx); }
                    ls += ((pa.x + pa.y) + (pa.z + pa.w)) + ((pb.x + pb.y) + (pb.z + pb.w));
                    pf[qi][half * 4 + t] = pack8(pa, pb);
                    asm volatile("" : "+v"(ls)); }
                ls = xrow_sum_(ls);
                if (half == 0) { m1[qi] = mx; l1[qi] = ls; } else linv[qi] = frcp_(l1[qi] * c1[qi] + ls);
            }
        }
    }
#pragma unroll
    for (int eh = 0; eh < 2; ++eh) {
        f32x4 ot[2][8];
#pragma unroll
        for (int qi = 0; qi < 2; ++qi)
#pragma unroll
            for (int e = 0; e < 8; ++e) ot[qi][e] = (f32x4){0.f, 0.f, 0.f, 0.f};
#pragma unroll
        for (int jv = 0; jv < 4; ++jv) { const int t = eh * 4 + jv;
            if (t < 7) XA_LOADV(t + 1);
            const LAS bf16_t* Vt = (const LAS bf16_t*)(lds + XA_VOFF + (t & 1) * XA_VBUF);
#pragma unroll
            for (int e = 0; e < 8; ++e) { const LAS bf16_t* vr = Vt + (e * 16 + fr) * XA_VROW + 8 * fq;
                const bf16x8 v0 = *(const LAS bf16x8*)vr, v1 = *(const LAS bf16x8*)(vr + 32);
                ot[0][e] = mfma16(v0, pf[0][2 * jv], ot[0][e]); ot[1][e] = mfma16(v0, pf[1][2 * jv], ot[1][e]);
                ot[0][e] = mfma16(v1, pf[0][2 * jv + 1], ot[0][e]); ot[1][e] = mfma16(v1, pf[1][2 * jv + 1], ot[1][e]); if (e & 1) __builtin_amdgcn_sched_barrier(0); }
            if (jv == 1) {
#pragma unroll
                for (int e = 0; e < 8; ++e) { ot[0][e] = ot[0][e] * c1[0]; ot[1][e] = ot[1][e] * c1[1]; } }
            if (t < 7) XA_STOREV((t + 1) & 1);
            __syncthreads();
        }
#pragma unroll
        for (int qi = 0; qi < 2; ++qi)
#pragma unroll
            for (int e2 = 0; e2 < 4; ++e2) { u32x2 w, w2; const float li = linv[qi];
                w.x = pk2(ot[qi][2 * e2].x * li, ot[qi][2 * e2].y * li); w.y = pk2(ot[qi][2 * e2].z * li, ot[qi][2 * e2].w * li);
                w2.x = pk2(ot[qi][2 * e2 + 1].x * li, ot[qi][2 * e2 + 1].y * li); w2.y = pk2(ot[qi][2 * e2 + 1].z * li, ot[qi][2 * e2 + 1].w * li);
                *(u32x4*)(O + (size_t)(qi * 16 + fr) * DM + eh * 128 + (2 * e2 + (fq & 1)) * 16 + (fq >> 1) * 8) = widen16_(w, w2); }
    }
#undef XA_LOADK
#undef XA_STOREK
#undef XA_LOADV
#undef XA_STOREV
}
constexpr int GP_KN = 0, GP_KB = 9216, GP_QN = 18432, GP_L = 9216, GP_RHS = 27648, GP_G = 60416, GP_GC = 60672, GP_EK = 60928, GP_HEAD = 61440, GP_CW = 2 * 61440;
__device__ __forceinline__ bf16_t* gdn_buf(const Params& P, int chh, int k) { return (bf16_t*)(P.ws + WS_GDN) + ((size_t)chh * 5 + k) * 4096; }
__device__ __forceinline__ void gdn_pre_item(const Params& P, int l, LAS unsigned char* lds, int it, int tid) {
    const int hp = it & 1, n = (it >> 1) & 31, b = it >> 6;
    const int hh = tid >> 8, h = 2 * hp + hh, tt = tid & 255, c = tt >> 2, qr = tt & 3, lane = tid & 63;
    LAS unsigned char* L = lds + hh * GP_HEAD;
    const bf16_t* z = (const bf16_t*)(P.ws + WS_R);
    const int s = n * 64 + c; const size_t tok = (size_t)b * SEQ + s;
    const int chh = (b * NCHUNK + n) * 4 + h;
    float q[16], k[16], v[16];
    u32x4 zw[3][4][2];
#pragma unroll
    for (int part = 0; part < 3; ++part)
#pragma unroll
        for (int kk = 0; kk < 4; ++kk) { const bf16_t* zr = (s - 3 + kk >= 0) ? z + (tok - 3 + kk) * ZP + Z_GQKV + part * 256 + h * 64 + qr * 16 : z + tok * ZP + IN_COLS;
            zw[part][kk][0] = *(const u32x4*)zr; zw[part][kk][1] = *(const u32x4*)(zr + 8); }
    const bf16_t* zt = z + tok * ZP;
    const float beta_raw = bf2f(zt[Z_GB + h]), a_raw = bf2f(zt[Z_GA + h]);
    __builtin_amdgcn_sched_barrier(0);
    const LAS float* CW = (const LAS float*)(lds + GP_CW);
#pragma unroll
    for (int part = 0; part < 3; ++part) {
        float* dst = part == 0 ? q : (part == 1 ? k : v);
        const int ch0 = part * 256 + h * 64 + qr * 16;
#pragma unroll
        for (int i = 0; i < 16; ++i) dst[i] = 0.f;
#pragma unroll
        for (int kk = 0; kk < 4; ++kk) {
            const u32x4 w0 = zw[part][kk][0], w1 = zw[part][kk][1];
            const LAS float* wr = CW + kk * 768 + ch0; const f32x4 c0 = *(const LAS f32x4*)wr, c1 = *(const LAS f32x4*)(wr + 4), c2 = *(const LAS f32x4*)(wr + 8), c3 = *(const LAS f32x4*)(wr + 12);
            dst[0] += c0.x * bflo(w0.x); dst[1] += c0.y * bfhi(w0.x); dst[2] += c0.z * bflo(w0.y); dst[3] += c0.w * bfhi(w0.y);
            dst[4] += c1.x * bflo(w0.z); dst[5] += c1.y * bfhi(w0.z); dst[6] += c1.z * bflo(w0.w); dst[7] += c1.w * bfhi(w0.w);
            dst[8] += c2.x * bflo(w1.x); dst[9] += c2.y * bfhi(w1.x); dst[10] += c2.z * bflo(w1.y); dst[11] += c2.w * bfhi(w1.y);
            dst[12] += c3.x * bflo(w1.z); dst[13] += c3.y * bfhi(w1.z); dst[14] += c3.z * bflo(w1.w); dst[15] += c3.w * bfhi(w1.w); }
#pragma unroll
        for (int i = 0; i < 16; ++i) dst[i] = siluf_(dst[i]);
    }
    float sq = 0.f, sk = 0.f;
#pragma unroll
    for (int i = 0; i < 16; ++i) { sq += q[i] * q[i]; sk += k[i] * k[i]; }
    sq = sum4_(sq); sk = sum4_(sk);
    const float rq = frsq_(sq + EPS) * 0.125f, rk = frsq_(sk + EPS);
    const float beta = sigmoidf_(beta_raw);
    const float g = -fexp_(P.gdn_a_log[l * 4 + h]) * softplusf_(a_raw + P.gdn_dt_bias[l * 4 + h]);
    {
        u32x4 w0, w1;
#define PK16(dst0, dst1, src, sc) do { dst0.x = pk2(src[0] * (sc), src[1] * (sc)); dst0.y = pk2(src[2] * (sc), src[3] * (sc)); dst0.z = pk2(src[4] * (sc), src[5] * (sc)); dst0.w = pk2(src[6] * (sc), src[7] * (sc)); \
        dst1.x = pk2(src[8] * (sc), src[9] * (sc)); dst1.y = pk2(src[10] * (sc), src[11] * (sc)); dst1.z = pk2(src[12] * (sc), src[13] * (sc)); dst1.w = pk2(src[14] * (sc), src[15] * (sc)); } while (0)
        PK16(w0, w1, k, rk);        *(LAS u32x4*)(L + GP_KN + (c * 72 + qr * 16) * 2) = w0; *(LAS u32x4*)(L + GP_KN + (c * 72 + qr * 16 + 8) * 2) = w1;
        PK16(w0, w1, k, rk * beta); *(LAS u32x4*)(L + GP_KB + (c * 72 + qr * 16) * 2) = w0; *(LAS u32x4*)(L + GP_KB + (c * 72 + qr * 16 + 8) * 2) = w1;
        PK16(w0, w1, q, rq);        *(LAS u32x4*)(L + GP_QN + (c * 72 + qr * 16) * 2) = w0; *(LAS u32x4*)(L + GP_QN + (c * 72 + qr * 16 + 8) * 2) = w1;
        LAS float* rhs = (LAS float*)(L + GP_RHS) + c * 128 + qr * 16;
#pragma unroll
        for (int i = 0; i < 4; ++i) *(LAS f32x4*)(rhs + 4 * i) = (f32x4){v[4 * i] * beta, v[4 * i + 1] * beta, v[4 * i + 2] * beta, v[4 * i + 3] * beta};
        if (qr == 0) ((LAS float*)(L + GP_G))[c] = g;
    }
    __syncthreads();
    {
        float gc = 0.f, run = 0.f; const LAS float* G = (const LAS float*)(L + GP_G);
#pragma unroll 16
        for (int i = 0; i < 64; ++i) { run += G[i]; gc = (i == c) ? run : gc; }
        const float eg = fexp_(gc), ek = fexp_(run - gc);
        LAS float* rhs = (LAS float*)(L + GP_RHS) + c * 128 + 64 + qr * 16;
#pragma unroll
        for (int i = 0; i < 4; ++i) *(LAS f32x4*)(rhs + 4 * i) = (f32x4){k[4 * i] * rk * beta * eg, k[4 * i + 1] * rk * beta * eg, k[4 * i + 2] * rk * beta * eg, k[4 * i + 3] * rk * beta * eg};
        u32x4 w0, w1; PK16(w0, w1, q, rq * eg);
        bf16_t* qd = gdn_buf(P, chh, 3) + c * 64 + qr * 16; *(u32x4*)qd = w0; *(u32x4*)(qd + 8) = w1;
        if (qr == 0) { ((LAS float*)(L + GP_GC))[c] = gc; ((LAS float*)(L + GP_EK))[c] = ek; }
        if (tt == 0) ((float*)(P.ws + WS_GL))[chh] = fexp_(run);
    }
#undef PK16
    __syncthreads();
    {
        const int it4 = (tid >> 6) & 3, fr = lane & 15, fq = lane >> 4;
        const LAS bf16_t* Kn = (const LAS bf16_t*)(L + GP_KN); const LAS bf16_t* KB = (const LAS bf16_t*)(L + GP_KB); const LAS bf16_t* Qn = (const LAS bf16_t*)(L + GP_QN);
        const LAS float* GC = (const LAS float*)(L + GP_GC);
        const bf16x8 a0 = *(const LAS bf16x8*)(KB + (it4 * 16 + fr) * 72 + 8 * fq), a1 = *(const LAS bf16x8*)(KB + (it4 * 16 + fr) * 72 + 32 + 8 * fq);
        const bf16x8 q0 = *(const LAS bf16x8*)(Qn + (it4 * 16 + fr) * 72 + 8 * fq), q1 = *(const LAS bf16x8*)(Qn + (it4 * 16 + fr) * 72 + 32 + 8 * fq);
        float gci[4];
#pragma unroll
        for (int r = 0; r < 4; ++r) gci[r] = GC[it4 * 16 + 4 * fq + r];
        {
            const int d = tt >> 2, cq = tt & 3; const LAS float* EK = (const LAS float*)(L + GP_EK);
            unsigned wv[8];
#pragma unroll
            for (int i = 0; i < 8; ++i) { const int c0 = cq * 16 + 2 * i; wv[i] = pk2(bf2f(Kn[c0 * 72 + d]) * EK[c0], bf2f(Kn[(c0 + 1) * 72 + d]) * EK[c0 + 1]); }
            bf16_t* kd = gdn_buf(P, chh, 4) + d * 64 + cq * 16;
            *(u32x4*)kd = (u32x4){wv[0], wv[1], wv[2], wv[3]}; *(u32x4*)(kd + 8) = (u32x4){wv[4], wv[5], wv[6], wv[7]};
        }
        f32x4 lv[4], av[4];
#pragma unroll
        for (int jt = 0; jt < 4; ++jt) {
            const bf16x8 b0 = *(const LAS bf16x8*)(Kn + (jt * 16 + fr) * 72 + 8 * fq), b1 = *(const LAS bf16x8*)(Kn + (jt * 16 + fr) * 72 + 32 + 8 * fq);
            f32x4 al = {0.f, 0.f, 0.f, 0.f}, aa = {0.f, 0.f, 0.f, 0.f};
            al = mfma16(a0, b0, al); al = mfma16(a1, b1, al); aa = mfma16(q0, b0, aa); aa = mfma16(q1, b1, aa);
            const int j = jt * 16 + fr; const float gcj = GC[j];
#pragma unroll
            for (int r = 0; r < 4; ++r) { const int i = it4 * 16 + 4 * fq + r; const float dec = fexp_(fminf(gci[r] - gcj, 0.f));
                lv[jt][r] = (i > j) ? al[r] * dec : 0.f; av[jt][r] = (i >= j) ? aa[r] * dec : 0.f; }
        }
        __syncthreads();
        LAS float* Lm = (LAS float*)(L + GP_L); LAS bf16_t* ATl = (LAS bf16_t*)(L + GP_KN);
#pragma unroll
        for (int jt = 0; jt < 4; ++jt)
#pragma unroll
            for (int r = 0; r < 4; ++r) { Lm[(it4 * 16 + 4 * fq + r) * 64 + (fr & 1) * 32 + jt * 8 + (fr >> 1)] = lv[jt][r];
                ATl[(it4 * 16 + 4 * fq + r) * 72 + jt * 16 + fr] = f2bf(av[jt][r]); }
    }
    __syncthreads();
    {
        bf16_t* att = gdn_buf(P, chh, 2);
#pragma unroll
        for (int i = 0; i < 2; ++i) { const int pz = tt + 256 * i, row = pz >> 3, pc = pz & 7; *(u32x4*)(att + row * 64 + pc * 8) = *(const LAS u32x4*)(L + GP_KN + (row * 72 + pc * 8) * 2); }
    }
    {
        const int col = tt >> 1, p = tt & 1;
        const LAS float* Lp = (const LAS float*)(L + GP_L) + p * 32; const LAS float* rhs = (const LAS float*)(L + GP_RHS) + col;
        float xs[32]; f32x4 lrw[2][8];
#pragma unroll
        for (int k = 0; k < 32; ++k) xs[k] = 0.f;
#pragma unroll
        for (int ib = 0; ib < 4; ++ib) {
            float rv[16];
#pragma unroll
            for (int t = 0; t < 16; ++t) rv[t] = rhs[(ib * 16 + t) * 128];
#pragma unroll
            for (int t = 0; t < 16; ++t) { const int i = ib * 16 + t;
                if (i + 1 < 64) {
#pragma unroll
                    for (int k4 = 0; k4 < ((i + 2) / 2 + 3) / 4; ++k4) lrw[(i + 1) & 1][k4] = *(const LAS f32x4*)(Lp + (i + 1) * 64 + 4 * k4);
                }
                __builtin_amdgcn_sched_barrier(0);
                float a0 = 0.f, a1 = 0.f;
#pragma unroll
                for (int k4 = 0; k4 < ((i + 1) / 2 + 3) / 4; ++k4) { const f32x4 lr = lrw[i & 1][k4];
                    a0 += lr.x * xs[4 * k4 + 0]; a1 += lr.y * xs[4 * k4 + 1]; a0 += lr.z * xs[4 * k4 + 2]; a1 += lr.w * xs[4 * k4 + 3]; }
                float acc = a0 + a1; acc += dpp_xor1(acc);
                const float xi = rv[t] - acc;
                xs[i >> 1] = (p == (i & 1)) ? xi : xs[i >> 1];
            }
        }
        if (col < 64) {
            bf16_t* ut = gdn_buf(P, chh, 1) + col * 64 + 32 * p;
            unsigned wv[16];
#pragma unroll
            for (int k = 0; k < 32; ++k) { const float other = dpp_xor1(xs[k]);
                const float lo = p ? other : xs[k], hi = p ? xs[k] : other;
                if ((k >> 4) == 0) { if (p == 0) wv[k & 15] = pk2(lo, hi); } else { if (p == 1) wv[k & 15] = pk2(lo, hi); } }
#pragma unroll
            for (int g4 = 0; g4 < 4; ++g4) *(u32x4*)(ut + 8 * g4) = (u32x4){wv[4 * g4], wv[4 * g4 + 1], wv[4 * g4 + 2], wv[4 * g4 + 3]};
        } else { bf16_t* wo = gdn_buf(P, chh, 0) + (col - 64) + p * 64;
#pragma unroll
            for (int k = 0; k < 32; ++k) wo[k * 128] = f2bf(xs[k]); }
    }
    __syncthreads();
}

constexpr int GC_W = 0, GC_UT = 9216, GC_ATT = 18432, GC_QD = 27648, GC_KDT = 36864, GC_ST = 46080, GC_VNT = 55296, GC_BH = 64512;
__device__ __forceinline__ bf16x8 ldsA(const LAS unsigned char* M, int row, int s, int fq) { return *(const LAS bf16x8*)(M + row * 144 + 64 * s + 16 * fq); }
__device__ __forceinline__ void gdn_chain_item(const Params& P, int l, LAS unsigned char* lds, int gi, int tid, int wave, int lane) {
    const int q2 = wave >> 2, bh = gi * 2 + q2, ct = wave & 3, b = bh >> 2, h = bh & 3, fr = lane & 15, fq = lane >> 4;
    const bf16_t* z = (const bf16_t*)(P.ws + WS_R); bf16_t* y = (bf16_t*)(P.ws + WS_R + R_Y);
    LAS unsigned char* L = lds + q2 * GC_BH;
    f32x4 ng[4];
#pragma unroll
    for (int et = 0; et < 4; ++et) ng[et] = *(const f32x4*)(P.gdn_norm + l * 64 + et * 16 + 4 * fq);
    u32x4 stg[10];
    typedef const __attribute__((address_space(1))) u32x4* gp4_t;
    typedef const __attribute__((address_space(1))) u32x2* gp2_t;
    typedef const __attribute__((address_space(1))) float* gpf_t;
    const bf16_t* const srcq0 = gdn_buf(P, ((gi * 2 >> 2) * NCHUNK) * 4 + ((gi * 2) & 3), 0);
    const bf16_t* const srcq1 = gdn_buf(P, (((gi * 2 + 1) >> 2) * NCHUNK) * 4 + ((gi * 2 + 1) & 3), 0);
#define GC_LD1(i_, n_) stg[i_] = *(gp4_t)(((i_) < 5 ? srcq0 : srcq1) + (size_t)(n_) * 4 * 5 * 4096 + (size_t)(tid + 512 * ((i_) % 5)) * 8)
#define GC_LOAD_A(n_) do { GC_LD1(0, n_); GC_LD1(1, n_); GC_LD1(3, n_); GC_LD1(5, n_); GC_LD1(6, n_); GC_LD1(8, n_); } while (0)
#define GC_LOAD_B(n_) do { GC_LD1(2, n_); GC_LD1(4, n_); GC_LD1(7, n_); GC_LD1(9, n_); } while (0)
#define GC_WRITE1(i_) do { const int p = tid + 512 * (i_), qq = p / 2560, pp = p % 2560, mat = pp >> 9, row = (pp & 511) >> 3, pc = pp & 7; \
        *(LAS u32x4*)(lds + qq * GC_BH + mat * 9216 + row * 144 + pc * 16) = stg[i_]; } while (0)
#define GC_WRITE_A() do { GC_WRITE1(0); GC_WRITE1(1); GC_WRITE1(3); GC_WRITE1(5); GC_WRITE1(6); GC_WRITE1(8); } while (0)
#define GC_WRITE_B() do { GC_WRITE1(2); GC_WRITE1(4); GC_WRITE1(7); GC_WRITE1(9); } while (0)
    GC_LOAD_A(0); GC_LOAD_B(0); GC_WRITE_A(); GC_WRITE_B();
    for (int i = tid; i < 64 * 72 / 2; i += 512) { ((LAS unsigned*)(lds + GC_ST))[i] = 0u; ((LAS unsigned*)(lds + GC_BH + GC_ST))[i] = 0u; }
    f32x4 S[4];
#pragma unroll
    for (int t = 0; t < 4; ++t) S[t] = (f32x4){0.f, 0.f, 0.f, 0.f};
    const size_t tokb = (size_t)b * SEQ + ct * 16 + fr;
    u32x2 gate_n[4]; float egl_n;
#pragma unroll
    for (int et = 0; et < 4; ++et) gate_n[et] = *(gp2_t)(z + tokb * ZP + Z_GG + h * 64 + et * 16 + 4 * fq);
    egl_n = *(gpf_t)((const float*)(P.ws + WS_GL) + (b * NCHUNK) * 4 + h);
    __builtin_amdgcn_sched_barrier(0);
    GC_LOAD_A(1); GC_LOAD_B(1);
    __builtin_amdgcn_sched_barrier(0);
    __syncthreads();
    for (int n = 0; n < NCHUNK; ++n) {
        const int n1 = n + 1 < NCHUNK ? n + 1 : NCHUNK - 1, n2 = n + 2 < NCHUNK ? n + 2 : NCHUNK - 1;
        u32x2 gate[4];
#pragma unroll
        for (int et = 0; et < 4; ++et) gate[et] = gate_n[et];
        const float egl = egl_n;
#pragma unroll
        for (int et = 0; et < 4; ++et) gate_n[et] = *(gp2_t)(z + (tokb + n1 * 64) * ZP + Z_GG + h * 64 + et * 16 + 4 * fq);
        egl_n = *(gpf_t)((const float*)(P.ws + WS_GL) + (b * NCHUNK + n1) * 4 + h);
        __builtin_amdgcn_sched_barrier(0);
        f32x4 o[4];
        {
            const bf16x8 w0 = ldsA(L + GC_W, ct * 16 + fr, 0, fq), w1 = ldsA(L + GC_W, ct * 16 + fr, 1, fq), q0 = ldsA(L + GC_QD, ct * 16 + fr, 0, fq), q1 = ldsA(L + GC_QD, ct * 16 + fr, 1, fq);
#pragma unroll
            for (int et = 0; et < 4; ++et) {
                const bf16x8 s0 = ldsA(L + GC_ST, et * 16 + fr, 0, fq), s1 = ldsA(L + GC_ST, et * 16 + fr, 1, fq);
                f32x4 a = {0.f, 0.f, 0.f, 0.f}; a = mfma16(w0, s0, a); a = mfma16(w1, s1, a);
                f32x4 oo = {0.f, 0.f, 0.f, 0.f}; oo = mfma16(s0, q0, oo); oo = mfma16(s1, q1, oo); o[et] = oo;
                const u32x2 uw = *(const LAS u32x2*)(L + GC_UT + (et * 16 + fr) * 144 + (ct * 16 + 4 * fq) * 2);
                u32x2 vw; vw.x = pk2(bflo(uw.x) - a.x, bfhi(uw.x) - a.y); vw.y = pk2(bflo(uw.y) - a.z, bfhi(uw.y) - a.w);
                *(LAS u32x2*)(L + GC_VNT + (et * 16 + fr) * 144 + (ct * 16 + 4 * fq) * 2) = vw; }
        }
        __syncthreads();
        GC_WRITE_A(); GC_LOAD_A(n2);
        __builtin_amdgcn_sched_barrier(0);
        {
            const bf16x8 a0 = ldsA(L + GC_ATT, ct * 16 + fr, 0, fq), a1 = ldsA(L + GC_ATT, ct * 16 + fr, 1, fq), k0 = ldsA(L + GC_KDT, ct * 16 + fr, 0, fq), k1 = ldsA(L + GC_KDT, ct * 16 + fr, 1, fq);
#pragma unroll
            for (int et = 0; et < 4; ++et) {
                const bf16x8 v0 = ldsA(L + GC_VNT, et * 16 + fr, 0, fq), v1 = ldsA(L + GC_VNT, et * 16 + fr, 1, fq);
                o[et] = mfma16(v0, a0, o[et]); o[et] = mfma16(v1, a1, o[et]);
                f32x4 sN = S[et] * egl; sN = mfma16(k0, v0, sN); sN = mfma16(k1, v1, sN); S[et] = sN;
                u32x2 sw; sw.x = pk2(sN.x, sN.y); sw.y = pk2(sN.z, sN.w);
                *(LAS u32x2*)(L + GC_ST + (et * 16 + fr) * 144 + (ct * 16 + 4 * fq) * 2) = sw; }
        }
        {
            float s2 = 0.f;
#pragma unroll
            for (int et = 0; et < 4; ++et) s2 += (o[et].x * o[et].x + o[et].y * o[et].y) + (o[et].z * o[et].z + o[et].w * o[et].w);
            s2 = xrow_sum_(s2);
            const float rs = frsq_(s2 * (1.0f / 64.0f) + EPS);
            u32x2 w[4];
#pragma unroll
            for (int et = 0; et < 4; ++et) { const f32x4 v = o[et] * rs * ng[et];
                w[et].x = pk2(v.x * siluf_(bflo(gate[et].x)), v.y * siluf_(bfhi(gate[et].x))); w[et].y = pk2(v.z * siluf_(bflo(gate[et].y)), v.w * siluf_(bfhi(gate[et].y))); }
            bf16_t* yp = y + (tokb + n * 64) * DM + 768 + h * 64 + (fq >> 1) * 8;
            *(u32x4*)(yp + (0 + (fq & 1)) * 16) = widen16_(w[0], w[1]);
            *(u32x4*)(yp + (2 + (fq & 1)) * 16) = widen16_(w[2], w[3]);
        }
        __syncthreads();
        GC_WRITE_B(); GC_LOAD_B(n2);
        __builtin_amdgcn_sched_barrier(0);
    }
#undef GC_LD1
#undef GC_LOAD_A
#undef GC_LOAD_B
#undef GC_WRITE1
#undef GC_WRITE_A
#undef GC_WRITE_B
    __syncthreads();
}

constexpr int RT_BUF = 36864, RT_Q = 0, RT_K = 9216, RT_KZT = 18432, RT_VT = 27648, RT_P = 73728, RT_ST = 82944, RT_O = 92160;
__device__ __forceinline__ void ret_chain_item(const Params& P, int l, LAS unsigned char* lds, int it, int tid, int wave, int lane) {
    const int b = it >> 2, h = it & 3, fr = lane & 15, fq = lane >> 4;
    const bf16_t* z = (const bf16_t*)(P.ws + WS_R); bf16_t* y = (bf16_t*)(P.ws + WS_R + R_Y);
    LAS bf16_t* Pm = (LAS bf16_t*)(lds + RT_P); LAS bf16_t* ST = (LAS bf16_t*)(lds + RT_ST); LAS float* Of = (LAS float*)(lds + RT_O);
    const float lg = log1pf(-exp2f(-5.0f - (float)h));
    const float cdec = fexp_(64.0f * lg);
    for (int i = tid; i < 64 * 72 / 2; i += 512) ((LAS unsigned*)ST)[i] = 0u;
    const int it4 = wave >> 1, jt0 = 2 * (wave & 1);
    f32x4 S[2] = {{0.f, 0.f, 0.f, 0.f}, {0.f, 0.f, 0.f, 0.f}};
    const int lc = tid >> 3, pg = tid & 7;
    float invf[4];
#pragma unroll
    for (int ii = 0; ii < 4; ++ii) invf[ii] = exp2f(-(float)(4 * pg + ii) * (13.287712379549449f / 32.0f));
    const float zeta = fexp_((63.0f - (float)lc) * lg);
    const f32x4 gn0 = *(const f32x4*)(P.ret_gn + l * 256 + h * 64 + 8 * pg), gn1 = *(const f32x4*)(P.ret_gn + l * 256 + h * 64 + 8 * pg + 4);
    const size_t tok0 = (size_t)b * SEQ + lc;
    u32x2 q1w, q2w, k1w, k2w; u32x4 vw; int posi;
#define RT_LOAD(n_) do { const bf16_t* zr_ = z + (tok0 + (n_) * 64) * ZP; q1w = *(const u32x2*)(zr_ + Z_RQ + h * 64 + 4 * pg); q2w = *(const u32x2*)(zr_ + Z_RQ + h * 64 + 32 + 4 * pg); \
        k1w = *(const u32x2*)(zr_ + Z_RK + h * 64 + 4 * pg); k2w = *(const u32x2*)(zr_ + Z_RK + h * 64 + 32 + 4 * pg); vw = *(const u32x4*)(zr_ + Z_RV + h * 64 + 8 * pg); posi = P.pos[tok0 + (n_) * 64]; } while (0)
#define RT_STAGE(buf_) do { LAS bf16_t* Qs_ = (LAS bf16_t*)(lds + (buf_) * RT_BUF + RT_Q); LAS bf16_t* Ks_ = (LAS bf16_t*)(lds + (buf_) * RT_BUF + RT_K); \
        LAS bf16_t* KzT_ = (LAS bf16_t*)(lds + (buf_) * RT_BUF + RT_KZT); LAS bf16_t* VT_ = (LAS bf16_t*)(lds + (buf_) * RT_BUF + RT_VT); const float pos = (float)posi; \
        const float q1[4] = {bflo(q1w.x), bfhi(q1w.x), bflo(q1w.y), bfhi(q1w.y)}, q2[4] = {bflo(q2w.x), bfhi(q2w.x), bflo(q2w.y), bfhi(q2w.y)}; \
        const float k1[4] = {bflo(k1w.x), bfhi(k1w.x), bflo(k1w.y), bfhi(k1w.y)}, k2[4] = {bflo(k2w.x), bfhi(k2w.x), bflo(k2w.y), bfhi(k2w.y)}; \
        float qa[4], qb[4], ka[4], kb[4]; \
        _Pragma("unroll") for (int ii = 0; ii < 4; ++ii) { float sn, cs; sincos_rev(pos * invf[ii], sn, cs); \
            qa[ii] = (q1[ii] * cs - q2[ii] * sn) * 0.125f; qb[ii] = (q1[ii] * sn + q2[ii] * cs) * 0.125f; ka[ii] = k1[ii] * cs - k2[ii] * sn; kb[ii] = k1[ii] * sn + k2[ii] * cs; } \
        u32x2 w_; w_.x = pk2(qa[0], qa[1]); w_.y = pk2(qa[2], qa[3]); *(LAS u32x2*)(Qs_ + lc * 72 + 4 * pg) = w_; \
        w_.x = pk2(qb[0], qb[1]); w_.y = pk2(qb[2], qb[3]); *(LAS u32x2*)(Qs_ + lc * 72 + 32 + 4 * pg) = w_; \
        w_.x = pk2(ka[0], ka[1]); w_.y = pk2(ka[2], ka[3]); *(LAS u32x2*)(Ks_ + lc * 72 + 4 * pg) = w_; \
        w_.x = pk2(kb[0], kb[1]); w_.y = pk2(kb[2], kb[3]); *(LAS u32x2*)(Ks_ + lc * 72 + 32 + 4 * pg) = w_; \
        _Pragma("unroll") for (int ii = 0; ii < 4; ++ii) { KzT_[(4 * pg + ii) * 72 + lc] = f2bf(ka[ii] * zeta); KzT_[(32 + 4 * pg + ii) * 72 + lc] = f2bf(kb[ii] * zeta); } \
        const unsigned vv[4] = {vw.x, vw.y, vw.z, vw.w}; \
        _Pragma("unroll") for (int ii = 0; ii < 4; ++ii) { VT_[(8 * pg + 2 * ii) * 72 + lc] = (bf16_t)(vv[ii] & 0xffffu); VT_[(8 * pg + 2 * ii + 1) * 72 + lc] = (bf16_t)(vv[ii] >> 16); } } while (0)
    RT_LOAD(0); RT_STAGE(0);
    __syncthreads();
    for (int n = 0; n < NCHUNK; ++n) {
        const int cb = n & 1;
        const LAS bf16_t* Qs = (const LAS bf16_t*)(lds + cb * RT_BUF + RT_Q); const LAS bf16_t* Ks = (const LAS bf16_t*)(lds + cb * RT_BUF + RT_K);
        const LAS bf16_t* KzT = (const LAS bf16_t*)(lds + cb * RT_BUF + RT_KZT); const LAS bf16_t* VT = (const LAS bf16_t*)(lds + cb * RT_BUF + RT_VT);
        const size_t tok = tok0 + n * 64;
        if (n + 1 < NCHUNK) RT_LOAD(n + 1);
        const u32x4 gw = *(const u32x4*)(z + tok * ZP + Z_RG + h * 64 + 8 * pg);
        const bf16x8 a0 = *(const LAS bf16x8*)(Qs + (it4 * 16 + fr) * 72 + 8 * fq), a1 = *(const LAS bf16x8*)(Qs + (it4 * 16 + fr) * 72 + 32 + 8 * fq);
        f32x4 cross[2];
#pragma unroll
        for (int t = 0; t < 2; ++t) { const int jt = jt0 + t;
            f32x4 p = {0.f, 0.f, 0.f, 0.f};
            p = mfma16(a0, *(const LAS bf16x8*)(Ks + (jt * 16 + fr) * 72 + 8 * fq), p); p = mfma16(a1, *(const LAS bf16x8*)(Ks + (jt * 16 + fr) * 72 + 32 + 8 * fq), p);
            f32x4 cr = {0.f, 0.f, 0.f, 0.f};
            cr = mfma16(a0, *(const LAS bf16x8*)(ST + (jt * 16 + fr) * 72 + 8 * fq), cr); cr = mfma16(a1, *(const LAS bf16x8*)(ST + (jt * 16 + fr) * 72 + 32 + 8 * fq), cr);
#pragma unroll
            for (int r = 0; r < 4; ++r) { const int i = it4 * 16 + 4 * fq + r, j = jt * 16 + fr; const int dd = i > j ? i - j : j - i;
                Pm[i * 72 + j] = f2bf(p[r] * fexp_((float)dd * lg)); cr[r] *= fexp_((float)(i + 1) * lg); }
            cross[t] = cr; }
        __syncthreads();
        const bf16x8 p0 = *(const LAS bf16x8*)(Pm + (it4 * 16 + fr) * 72 + 8 * fq), p1 = *(const LAS bf16x8*)(Pm + (it4 * 16 + fr) * 72 + 32 + 8 * fq);
        const bf16x8 kz0 = *(const LAS bf16x8*)(KzT + (it4 * 16 + fr) * 72 + 8 * fq), kz1 = *(const LAS bf16x8*)(KzT + (it4 * 16 + fr) * 72 + 32 + 8 * fq);
#pragma unroll
        for (int t = 0; t < 2; ++t) { const int et = jt0 + t;
            const bf16x8 v0 = *(const LAS bf16x8*)(VT + (et * 16 + fr) * 72 + 8 * fq), v1 = *(const LAS bf16x8*)(VT + (et * 16 + fr) * 72 + 32 + 8 * fq);
            f32x4 o = cross[t]; o = mfma16(p0, v0, o); o = mfma16(p1, v1, o);
#pragma unroll
            for (int r = 0; r < 4; ++r) Of[(it4 * 16 + 4 * fq + r) * 65 + et * 16 + fr] = o[r];
            f32x4 sN = S[t] * cdec; sN = mfma16(kz0, v0, sN); sN = mfma16(kz1, v1, sN); S[t] = sN;
            u32x2 w; w.x = pk2(sN.x, sN.y); w.y = pk2(sN.z, sN.w); *(LAS u32x2*)(ST + (et * 16 + fr) * 72 + it4 * 16 + 4 * fq) = w; }
        if (n + 1 < NCHUNK) RT_STAGE(cb ^ 1);
        __syncthreads();
        {
            float ov[8]; float sm = 0.f;
#pragma unroll
            for (int j = 0; j < 8; ++j) { ov[j] = Of[lc * 65 + 8 * pg + j]; sm += ov[j]; }
            sm = sum8_(sm);
            const float mu = sm * (1.0f / 64.0f); float vs = 0.f;
#pragma unroll
            for (int j = 0; j < 8; ++j) { ov[j] -= mu; vs += ov[j] * ov[j]; }
            vs = sum8_(vs);
            const float rs = frsq_(vs * (1.0f / 64.0f) + EPS);
            const float gt[8] = {bflo(gw.x), bfhi(gw.x), bflo(gw.y), bfhi(gw.y), bflo(gw.z), bfhi(gw.z), bflo(gw.w), bfhi(gw.w)};
            const float gnv[8] = {gn0.x, gn0.y, gn0.z, gn0.w, gn1.x, gn1.y, gn1.z, gn1.w};
            float r8[8];
#pragma unroll
            for (int j = 0; j < 8; ++j) r8[j] = ov[j] * rs * gnv[j] * siluf_(gt[j]);
            u32x4 w; w.x = pk2(r8[0], r8[1]); w.y = pk2(r8[2], r8[3]); w.z = pk2(r8[4], r8[5]); w.w = pk2(r8[6], r8[7]);
            *(u32x4*)(y + tok * DM + h * 64 + 8 * pg) = w;
        }
    }
#undef RT_LOAD
#undef RT_STAGE
    __syncthreads();
}

constexpr int LR_XC = 0, LR_AU = 33792;
__device__ __forceinline__ void lru_item(const Params& P, int l, LAS unsigned char* lds, int it, int mode, int tid, int wave, int lane) {
    const int b = it >> 5, n = it & 31, fr = lane & 15, fq = lane >> 4;
    const bf16_t* z = (const bf16_t*)(P.ws + WS_R); bf16_t* y = (bf16_t*)(P.ws + WS_R + R_Y);
    LAS bf16_t* XC = (LAS bf16_t*)(lds + LR_XC); LAS f32x2* AU = (LAS f32x2*)(lds + LR_AU);
    float* sumA = (float*)(P.ws + WS_LRUS); float* sumH = sumA + 16 * 32 * 256;
    {
        const int c = tid >> 3, cg = tid & 7, s = n * 64 + c; const size_t tok = (size_t)b * SEQ + s;
        const float* cw = P.lru_conv_w + (size_t)l * 4 * 256; const float* cb = P.lru_conv_b + l * 256;
#pragma unroll
        for (int g = 0; g < 4; ++g) { const int ch0 = cg * 32 + g * 8;
            const f32x4 b0 = *(const f32x4*)(cb + ch0), b1 = *(const f32x4*)(cb + ch0 + 4);
            float a[8] = {b0.x, b0.y, b0.z, b0.w, b1.x, b1.y, b1.z, b1.w};
#pragma unroll
            for (int kk = 0; kk < 4; ++kk) { const bool okk = s - 3 + kk >= 0; const float mk = okk ? 1.f : 0.f;
                const u32x4 w = *(const u32x4*)(z + (okk ? tok - 3 + kk : tok) * ZP + Z_LX + ch0);
                const f32x4 c0 = *(const f32x4*)(cw + kk * 256 + ch0) * mk, c1 = *(const f32x4*)(cw + kk * 256 + ch0 + 4) * mk;
                a[0] += c0.x * bflo(w.x); a[1] += c0.y * bfhi(w.x); a[2] += c0.z * bflo(w.y); a[3] += c0.w * bfhi(w.y);
                a[4] += c1.x * bflo(w.z); a[5] += c1.y * bfhi(w.z); a[6] += c1.z * bflo(w.w); a[7] += c1.w * bfhi(w.w); }
            u32x4 o; o.x = pk2(a[0], a[1]); o.y = pk2(a[2], a[3]); o.z = pk2(a[4], a[5]); o.w = pk2(a[6], a[7]);
            *(LAS u32x4*)(XC + c * 264 + ch0) = o; }
    }
    float hcar = 0.f, aprod = 1.f;
    if (mode == 1 && tid < 256) {
        float av[32], hv[32];
#pragma unroll
        for (int m = 0; m < 32; ++m) { const int mm = m < n ? m : 0; av[m] = sumA[(b * 32 + mm) * 256 + tid]; hv[m] = sumH[(b * 32 + mm) * 256 + tid]; }
#pragma unroll
        for (int m = 0; m < 32; ++m) if (m < n) hcar = av[m] * hcar + hv[m];
    }
    const int nb = wave >> 1, rt = wave & 1;
    const bf16_t* wa = wl(P, l, W_A) + nb * 4096; const bf16_t* wx = wl(P, l, W_X) + nb * 4096;
    bf16x8 fa[4][2], fx[4][2]; float ba[4], bx[4], spl[4];
#pragma unroll
    for (int dt = 0; dt < 4; ++dt) {
#pragma unroll
        for (int s = 0; s < 2; ++s) { fa[dt][s] = *(const bf16x8*)(wa + (dt * 16 + fr) * 64 + 32 * s + 8 * fq); fx[dt][s] = *(const bf16x8*)(wx + (dt * 16 + fr) * 64 + 32 * s + 8 * fq); }
        const int d = nb * 64 + dt * 16 + fr; ba[dt] = P.lru_ba[l * 256 + d]; bx[dt] = P.lru_bx[l * 256 + d]; spl[dt] = -8.0f * softplusf_(-P.lru_lambda[l * 256 + d]); }
    __syncthreads();
    for (int half = 0; half < 2; ++half) {
        const int trow = half * 32 + rt * 16;
        const bf16x8 x0 = *(const LAS bf16x8*)(XC + (trow + fr) * 264 + nb * 64 + 8 * fq), x1 = *(const LAS bf16x8*)(XC + (trow + fr) * 264 + nb * 64 + 32 + 8 * fq);
#pragma unroll
        for (int dt = 0; dt < 4; ++dt) {
            f32x4 ar = {0.f, 0.f, 0.f, 0.f}, ai = {0.f, 0.f, 0.f, 0.f};
            ar = mfma16(x0, fa[dt][0], ar); ar = mfma16(x1, fa[dt][1], ar); ai = mfma16(x0, fx[dt][0], ai); ai = mfma16(x1, fx[dt][1], ai);
            const int d = nb * 64 + dt * 16 + fr;
#pragma unroll
            for (int r = 0; r < 4; ++r) { const int tl = rt * 16 + 4 * fq + r;
                const float xcv = bf2f(XC[(half * 32 + tl) * 264 + d]);
                const float rr = sigmoidf_(ar[r] + ba[dt]), ii = sigmoidf_(ai[r] + bx[dt]);
                const float a = fexp_(rr * spl[dt]);
                const float u = fsqrt_(fmaxf(1.0f - a * a, 0.f)) * (ii * xcv);
                AU[tl * 257 + d] = (f32x2){a, u}; }
        }
        __syncthreads();
        if (tid < 256) {
#pragma unroll 8
            for (int tk = 0; tk < 32; ++tk) { const f32x2 au = AU[tk * 257 + tid]; hcar = au.x * hcar + au.y; aprod *= au.x; if (mode == 1) AU[tk * 257 + tid].y = hcar; }
        }
        if (mode == 1) {
            __syncthreads();
            const int tk = tid >> 4, c0 = (tid & 15) * 16; const size_t tok = (size_t)b * SEQ + n * 64 + half * 32 + tk;
            const u32x4 g0 = *(const u32x4*)(z + tok * ZP + Z_LG + c0), g1 = *(const u32x4*)(z + tok * ZP + Z_LG + c0 + 8);
            const unsigned gws[8] = {g0.x, g0.y, g0.z, g0.w, g1.x, g1.y, g1.z, g1.w}; unsigned ow[8];
#pragma unroll
            for (int j = 0; j < 8; ++j) { const float h0 = AU[tk * 257 + c0 + 2 * j].y, h1 = AU[tk * 257 + c0 + 2 * j + 1].y; ow[j] = pk2(h0 * geluf_(bflo(gws[j])), h1 * geluf_(bfhi(gws[j]))); }
            bf16_t* yp = y + tok * DM + 256 + c0;
            *(u32x4*)yp = (u32x4){ow[0], ow[1], ow[2], ow[3]}; *(u32x4*)(yp + 8) = (u32x4){ow[4], ow[5], ow[6], ow[7]};
        }
        __syncthreads();
    }
    if (mode == 0 && tid < 256) { sumA[(b * 32 + n) * 256 + tid] = aprod; sumH[(b * 32 + n) * 256 + tid] = hcar; }
}

constexpr int LC_XC = 0, LC_AU = 9216, LC_SEG = LC_AU + 64 * 65 * 8;
__device__ __forceinline__ void lru_chain_item(const Params& P, int l, LAS unsigned char* lds, int it, int tid, int wave, int lane) {
    const int b = it >> 2, nb = it & 3, fr = lane & 15, fq = lane >> 4;
    const bf16_t* z = (const bf16_t*)(P.ws + WS_R); bf16_t* y = (bf16_t*)(P.ws + WS_R + R_Y);
    LAS bf16_t* XC = (LAS bf16_t*)(lds + LC_XC); LAS f32x2* AU = (LAS f32x2*)(lds + LC_AU);
    const int c = tid >> 3, cg = tid & 7, ch0 = nb * 64 + cg * 8;
    f32x4 cw0[4], cw1[4];
#pragma unroll
    for (int kk = 0; kk < 4; ++kk) { cw0[kk] = *(const f32x4*)(P.lru_conv_w + (size_t)l * 1024 + kk * 256 + ch0); cw1[kk] = *(const f32x4*)(P.lru_conv_w + (size_t)l * 1024 + kk * 256 + ch0 + 4); }
    const f32x4 cb0 = *(const f32x4*)(P.lru_conv_b + l * 256 + ch0), cb1 = *(const f32x4*)(P.lru_conv_b + l * 256 + ch0 + 4);
    const int rt = wave >> 1, dt0 = (wave & 1) * 2;
    const bf16_t* wa = wl(P, l, W_A) + nb * 4096; const bf16_t* wx = wl(P, l, W_X) + nb * 4096;
    bf16x8 fa[2][2], fx[2][2]; float ba[2], bx[2], spl[2];
#pragma unroll
    for (int t = 0; t < 2; ++t) {
#pragma unroll
        for (int s = 0; s < 2; ++s) { fa[t][s] = *(const bf16x8*)(wa + ((dt0 + t) * 16 + fr) * 64 + 32 * s + 8 * fq); fx[t][s] = *(const bf16x8*)(wx + ((dt0 + t) * 16 + fr) * 64 + 32 * s + 8 * fq); }
        const int d = nb * 64 + (dt0 + t) * 16 + fr; ba[t] = P.lru_ba[l * 256 + d]; bx[t] = P.lru_bx[l * 256 + d]; spl[t] = -8.0f * softplusf_(-P.lru_lambda[l * 256 + d]); }
    const size_t tok0 = (size_t)b * SEQ + c;
    u32x4 xr[4], gr;
#define LC_LOAD(n_) do { const size_t t_ = tok0 + (size_t)(n_) * 64; _Pragma("unroll") for (int kk = 0; kk < 4; ++kk) { const bool ok_ = (n_) * 64 + c - 3 + kk >= 0; \
        xr[kk] = *(const u32x4*)(z + (ok_ ? t_ - 3 + kk : t_) * ZP + Z_LX + ch0); } gr = *(const u32x4*)(z + t_ * ZP + Z_LG + ch0); } while (0)
    LC_LOAD(0);
    float hcar = 0.f;
    for (int n = 0; n < NCHUNK; ++n) {
        {
            float a[8] = {cb0.x, cb0.y, cb0.z, cb0.w, cb1.x, cb1.y, cb1.z, cb1.w};
#pragma unroll
            for (int kk = 0; kk < 4; ++kk) { const float mk = (n * 64 + c - 3 + kk >= 0) ? 1.f : 0.f; const f32x4 c0 = cw0[kk] * mk, c1 = cw1[kk] * mk; const u32x4 w = xr[kk];
                a[0] += c0.x * bflo(w.x); a[1] += c0.y * bfhi(w.x); a[2] += c0.z * bflo(w.y); a[3] += c0.w * bfhi(w.y);
                a[4] += c1.x * bflo(w.z); a[5] += c1.y * bfhi(w.z); a[6] += c1.z * bflo(w.w); a[7] += c1.w * bfhi(w.w); }
            u32x4 o; o.x = pk2(a[0], a[1]); o.y = pk2(a[2], a[3]); o.z = pk2(a[4], a[5]); o.w = pk2(a[6], a[7]);
            *(LAS u32x4*)(XC + c * 72 + cg * 8) = o;
        }
        const u32x4 gcur = gr;
        if (n + 1 < NCHUNK) LC_LOAD(n + 1);
        __syncthreads();
        {
            const bf16x8 x0 = *(const LAS bf16x8*)(XC + (rt * 16 + fr) * 72 + 8 * fq), x1 = *(const LAS bf16x8*)(XC + (rt * 16 + fr) * 72 + 32 + 8 * fq);
            float xcr[2][4];
#pragma unroll
            for (int t = 0; t < 2; ++t)
#pragma unroll
                for (int r = 0; r < 4; ++r) xcr[t][r] = bf2f(XC[(rt * 16 + 4 * fq + r) * 72 + (dt0 + t) * 16 + fr]);
#pragma unroll
            for (int t = 0; t < 2; ++t) {
                f32x4 ar = {0.f, 0.f, 0.f, 0.f}, ai = {0.f, 0.f, 0.f, 0.f};
                ar = mfma16(x0, fa[t][0], ar); ar = mfma16(x1, fa[t][1], ar); ai = mfma16(x0, fx[t][0], ai); ai = mfma16(x1, fx[t][1], ai);
                const int dl = (dt0 + t) * 16 + fr;
#pragma unroll
                for (int r = 0; r < 4; ++r) { const int tl = rt * 16 + 4 * fq + r;
                    const float xcv = xcr[t][r];
                    const float rr = sigmoidf_(ar[r] + ba[t]), ii = sigmoidf_(ai[r] + bx[t]);
                    const float av = fexp_(rr * spl[t]);
                    AU[tl * 65 + dl] = (f32x2){av, fsqrt_(fmaxf(1.0f - av * av, 0.f)) * (ii * xcv)}; }
            }
        }
        __syncthreads();
        {
            LAS f32x2* SEG = (LAS f32x2*)(lds + LC_SEG);
            f32x2 au[8]; float hl = 0.f, pl = 1.f, hloc[8], ploc[8];
#pragma unroll
            for (int k = 0; k < 8; ++k) au[k] = AU[(wave * 8 + k) * 65 + lane];
#pragma unroll
            for (int k = 0; k < 8; ++k) { hl = au[k].x * hl + au[k].y; pl *= au[k].x; hloc[k] = hl; ploc[k] = pl; }
            SEG[wave * 64 + lane] = (f32x2){pl, hl};
            __syncthreads();
            float cin = 0.f, cc = hcar;
#pragma unroll
            for (int sg = 0; sg < 8; ++sg) { const f32x2 sv = SEG[sg * 64 + lane]; cin = (sg == wave) ? cc : cin; cc = sv.x * cc + sv.y; }
            hcar = cc;
#pragma unroll
            for (int k = 0; k < 8; ++k) AU[(wave * 8 + k) * 65 + lane].y = hloc[k] + ploc[k] * cin;
        }
        __syncthreads();
        {
            const unsigned gws[4] = {gcur.x, gcur.y, gcur.z, gcur.w}; unsigned ow[4]; float hv[8];
#pragma unroll
            for (int j = 0; j < 8; ++j) hv[j] = AU[c * 65 + cg * 8 + j].y;
#pragma unroll
            for (int j = 0; j < 4; ++j) ow[j] = pk2(hv[2 * j] * geluf_(bflo(gws[j])), hv[2 * j + 1] * geluf_(bfhi(gws[j])));
            *(u32x4*)(y + (tok0 + (size_t)n * 64) * DM + 256 + ch0) = (u32x4){ow[0], ow[1], ow[2], ow[3]};
        }
    }
#undef LC_LOAD
    __syncthreads();
}

constexpr int N_PHASES = 21;
constexpr int Q_RET = 64, Q_GDN = 32, Q_LRU = 64, Q_MLA = 512, Q_TOTAL = Q_RET + Q_GDN + Q_LRU + Q_MLA;

__global__ void __launch_bounds__(512, 2) hymba_fwd(Params P_) {
    extern __shared__ __attribute__((aligned(16))) unsigned char lds_raw[];
    LAS unsigned char* lds = (LAS unsigned char*)lds_raw;
    volatile LAS unsigned* LC = (volatile LAS unsigned*)(lds + LDS_CTL);
    const int G = gridDim.x;
#define SUB_TID() int tid2 = tid; asm volatile("" : "+v"(tid2)); const int lane2 = tid2 & 63, wave2 = __builtin_amdgcn_readfirstlane(tid2 >> 6); (void)lane2; (void)wave2
#if defined(__HIP_DEVICE_COMPILE__)
#define PH_PARAMS() const __attribute__((address_space(4))) Params* pp_ = (const __attribute__((address_space(4))) Params*)__builtin_amdgcn_kernarg_segment_ptr(); asm volatile("" : "+s"(pp_)); const Params P = *pp_
#else
#define PH_PARAMS() const Params P = P_
#endif
#define PH_TID() PH_PARAMS(); \
    bf16_t* xb = (bf16_t*)(P.ws + WS_XB); float* part = (float*)(P.ws + WS_PART); bf16_t* zb = (bf16_t*)(P.ws + WS_R); bf16_t* yb = (bf16_t*)(P.ws + WS_R + R_Y); bf16_t* oxb = (bf16_t*)(P.ws + WS_R + R_OX); (void)xb; (void)part; (void)zb; (void)yb; (void)oxb; \
    int tid = threadIdx.x; asm volatile("" : "+v"(tid)); const int lane = tid & 63, wave = __builtin_amdgcn_readfirstlane(tid >> 6); (void)lane; (void)wave
    unsigned* ctl = (unsigned*)(P_.ws + WS_CTL);
    if (threadIdx.x < 64) LC[threadIdx.x] = 0u;
    __syncthreads();
    const int lo = P_.ph_lo, hi = P_.ph_hi;
    XcdBarrier bar; bar.bar = ctl + CW_BAR; bar.x = 0; bar.st = LC;
    if (hi - lo > 1) bar = xcd_barrier_post(ctl + CW_BAR, LC);
#ifndef PHASE_MASK
#define PHASE_MASK 0xFFFFFFFFu
#endif
#define EN(t) ((PHASE_MASK >> (t)) & 1u)
#ifndef REPEAT_MASK
#define REPEAT_MASK 0u
#endif
#define REP(t) for (int rep_ = 0; rep_ <= (int)((REPEAT_MASK >> (t)) & 1u); ++rep_, (rep_ <= (int)((REPEAT_MASK >> (t)) & 1u) ? xcd_barrier(bar) : (void)0))
#define IN(k) (lo <= (k) && (k) < hi)
#define SEAM(k) do { if (IN(k) && IN((k) + 1)) xcd_barrier(bar); } while (0)


    if (IN(0) && EN(0)) REP(0) { PH_TID(); p0_prologue(P, lds, tid); __syncthreads(); }
    SEAM(0);
    if (IN(1) && EN(1)) REP(1) {
        PH_TID();
        const int which = blockIdx.x >> 6, l = which >> 1, isv = which & 1;
        if (which < 4) {
            const bf16_t* memn = (const bf16_t*)(P.ws + WS_GDN); const bf16_t* wkv = wl(P, l, W_KV);
            bf16_t* kout = (bf16_t*)(P.ws + WS_KVM + (size_t)l * KVM_LAYER); bf16_t* vout = kout + (size_t)4096 * 1024;
            pg8::Gemm g; pg8::EpiScaleBf16<0> E; pg8::StaticOrder S;
            if (!isv) { g = pg8::Gemm{memn, wkv, 4096, 1024, 1024}; E = pg8::EpiScaleBf16<0>{kout, 1024, nullptr}; S.init(4096, 1024, 64, blockIdx.x & 63); }
            else { g = pg8::Gemm{wkv + (size_t)1024 * 1024, memn, 1024, 4096, 1024}; E = pg8::EpiScaleBf16<0>{vout, 4096, nullptr}; S.init(1024, 4096, 64, blockIdx.x & 63); }
            pg8::gemm_phase(lds, g, S, E, tid);
        }
    }
#pragma unroll
    for (int l = 0; l < 2; ++l) {
        const int pb = 2 + 9 * l;
        if (IN(pb + 0) && EN(2)) REP(2) { PH_TID();
            pg8::Gemm g{xb, wl(P, l, W_IN), T_TOK, ZP, DM}; pg8::StaticOrder S; S.init(T_TOK, ZP, G, blockIdx.x);
            pg8::scale_table(lds, S, part, tid);
            pg8::EpiScaleBf16<0> E{zb, ZP, part}; pg8::gemm_phase(lds, g, S, E, tid);
        }
        SEAM(pb + 0);
        if (IN(pb + 1)) {
            PH_TID();
            if (EN(3)) REP(3) { SUB_TID();
                for (int i = tid2; i < 768; i += 512) *(LAS f32x4*)(lds + GP_CW + i * 16) = *(const f32x4*)(P.gdn_conv_w + (size_t)l * 3072 + i * 4);
                __syncthreads();
_Pragma("unroll 1")
            for (int it = blockIdx.x; it < 1024; it += G) gdn_pre_item(P, l, lds, it, tid2); }
            if (EN(5)) REP(5) { SUB_TID();
_Pragma("unroll 1")
            for (int it = blockIdx.x; it < 256; it += G) mla_pre_item(P, l, lds, it, tid2, wave2, lane2); }
        }
        SEAM(pb + 1);
        if (IN(pb + 2)) {
            PH_TID();
            for (int rep2_ = 0; rep2_ <= (int)((REPEAT_MASK >> 17) & 1u); ++rep2_, (rep2_ <= (int)((REPEAT_MASK >> 17) & 1u) ? xcd_barrier(bar) : (void)0)) {
            unsigned* qh0 = ctl + CW_QUEUE + 64 * l + 16 * rep2_;
            unsigned* qh = qh0; unsigned qnx = 0; int qit;
#define Q_POP_ISSUE() do { if (tid == 0) qnx = __hip_atomic_fetch_add(qh, 1u, __ATOMIC_RELAXED, __HIP_MEMORY_SCOPE_AGENT); } while (0)
#define Q_POP_GET() do { if (tid == 0) LC[4] = qnx; __syncthreads(); qit = (int)LC[4]; __syncthreads(); } while (0)
#define QUEUE_STAGE(lo_, hi_, body_) _Pragma("unroll 1") while (qit < (hi_)) { const int it = qit - (lo_); { SUB_TID(); body_; } __syncthreads(); Q_POP_ISSUE(); Q_POP_GET(); }
            Q_POP_ISSUE(); Q_POP_GET();
            QUEUE_STAGE(0, Q_RET, ret_chain_item(P, l, lds, it, tid2, wave2, lane2))
            QUEUE_STAGE(Q_RET, Q_RET + Q_GDN, gdn_chain_item(P, l, lds, it, tid2, wave2, lane2))
            QUEUE_STAGE(Q_RET + Q_GDN, Q_RET + Q_GDN + Q_LRU, lru_chain_item(P, l, lds, it, tid2, wave2, lane2))
            QUEUE_STAGE(Q_RET + Q_GDN + Q_LRU, Q_TOTAL, mla_attn_item(P, lds, it, tid2, wave2, lane2))
#undef Q_POP_ISSUE
#undef Q_POP_GET
#undef QUEUE_STAGE
            }
        }
        SEAM(pb + 2);
        if (IN(pb + 3) && EN(10)) REP(10) { PH_TID();
            pg8::Gemm g{yb, wl(P, l, W_OUT), T_TOK, DM, DM}; pg8::StaticOrder S; S.init(T_TOK, DM, G, blockIdx.x);
            pg8::EpiResid E{xb, part, rep_ ? 0.f : 1.f}; pg8::gemm_phase(lds, g, S, E, tid);
        }
        SEAM(pb + 3);
        if (IN(pb + 4) && EN(11)) REP(11) { PH_TID();
_Pragma("unroll 1")
            for (int u = blockIdx.x; u < 512; u += G) {
                const int pm = u >> 2, pn = u & 3;
                { pg8::Gemm g{xb, wl(P, l, W_Q), T_TOK, DM, DM}; pg8::OneUnit S{pm, pn};
                  pg8::EpiScaleLds E{part}; pg8::gemm_phase(lds, g, S, E, tid); }
                asm volatile("s_waitcnt lgkmcnt(0)" ::: "memory"); __syncthreads();
                { SUB_TID(); xa_item(P, l, lds, (pm >> 3) * 32 + pn * 8 + (pm & 7), tid2, wave2, lane2); }
                __syncthreads();
            }
        }
        SEAM(pb + 5);
        if (IN(pb + 6) && EN(13)) REP(13) { PH_TID();
            pg8::Gemm g{oxb, wl(P, l, W_O), T_TOK, DM, DM}; pg8::StaticOrder S; S.init(T_TOK, DM, G, blockIdx.x);
            pg8::EpiResid E{xb, part, rep_ ? 0.f : 1.f}; pg8::gemm_phase(lds, g, S, E, tid);
        }
        SEAM(pb + 6);
        if (IN(pb + 7) && EN(14)) REP(14) { PH_TID();
            pg8::Gemm g{xb, wl(P, l, W_1), T_TOK, DFF, DM}; pg8::StaticOrder S; S.init(T_TOK, DFF, G, blockIdx.x);
            pg8::scale_table(lds, S, part, tid);
            pg8::EpiScaleBf16<1> E{zb, DFF, part}; pg8::gemm_phase(lds, g, S, E, tid);
        }
        SEAM(pb + 7);
        if (IN(pb + 8) && EN(15)) REP(15) { PH_TID();
            pg8::Gemm g{zb, wl(P, l, W_2), T_TOK, DM, DFF}; pg8::StaticOrder S; S.init(T_TOK, DM, G, blockIdx.x);
            pg8::EpiResid E{xb, part, rep_ ? 0.f : 1.f}; pg8::gemm_phase(lds, g, S, E, tid);
        }
        SEAM(pb + 8);
    }
    if (IN(20) && EN(16)) { PH_TID(); final_norm_phase(P, tid); }
#undef IN
#undef SEAM
}

extern "C" void kernel_launch(void* const* d_in, const int* in_sizes, int n_in, void* d_out, int out_size, void* d_ws, size_t ws_size, hipStream_t stream) {
    static int grid = 0;
    if (grid == 0) {
        if (n_in != 31 || out_size != T_TOK * DM || ws_size < WS_END) { fprintf(stderr, "kernel_launch: unexpected shapes (n_in %d out %d ws %zu, need %zu)\n", n_in, out_size, ws_size, (size_t)WS_END); grid = -1; return; }
        if (hipFuncSetAttribute((const void*)hymba_fwd, hipFuncAttributeMaxDynamicSharedMemorySize, LDS_BYTES) != hipSuccess) { fprintf(stderr, "kernel_launch: hipFuncSetAttribute failed\n"); grid = -1; return; }
        int dev = 0, cus = 0, per_cu = 0;
        (void)hipGetDevice(&dev); (void)hipDeviceGetAttribute(&cus, hipDeviceAttributeMultiprocessorCount, dev);
        (void)hipOccupancyMaxActiveBlocksPerMultiprocessor(&per_cu, (const void*)hymba_fwd, 512, LDS_BYTES);
        (void)hipGetLastError();
        if (cus != 256 || per_cu < 1) fprintf(stderr, "kernel_launch: note: cus %d per_cu %d\n", cus, per_cu);
        grid = 256;
    }
    if (grid < 0) return;
    (void)hipMemsetAsync((char*)d_ws + WS_CTL, 0, CTL_BYTES, stream);
    Params p{};
    p.x = (const float*)d_in[0]; p.mem = (const float*)d_in[1]; p.pos = (const int*)d_in[2];
    p.norm_mix = (const float*)d_in[3]; p.w_in = (const float*)d_in[4]; p.ret_gn = (const float*)d_in[5];
    p.lru_conv_w = (const float*)d_in[6]; p.lru_conv_b = (const float*)d_in[7]; p.lru_wa = (const float*)d_in[8]; p.lru_ba = (const float*)d_in[9];
    p.lru_wx = (const float*)d_in[10]; p.lru_bx = (const float*)d_in[11]; p.lru_lambda = (const float*)d_in[12];
    p.mla_q_norm = (const float*)d_in[13]; p.mla_w_uq = (const float*)d_in[14]; p.mla_kv_norm = (const float*)d_in[15]; p.mla_w_ukv = (const float*)d_in[16];
    p.gdn_conv_w = (const float*)d_in[17]; p.gdn_a_log = (const float*)d_in[18]; p.gdn_dt_bias = (const float*)d_in[19]; p.gdn_norm = (const float*)d_in[20];
    p.w_out = (const float*)d_in[21]; p.norm_xattn = (const float*)d_in[22]; p.norm_mem = (const float*)d_in[23];
    p.xa_wq = (const float*)d_in[24]; p.xa_wkv = (const float*)d_in[25]; p.xa_wo = (const float*)d_in[26];
    p.norm_mlp = (const float*)d_in[27]; p.mlp_w1 = (const float*)d_in[28]; p.mlp_w2 = (const float*)d_in[29]; p.final_norm = (const float*)d_in[30];
    p.out = (float*)d_out; p.ws = (unsigned char*)d_ws;
#if N_LAUNCHES == 1
    p.ph_lo = 0; p.ph_hi = N_PHASES;
    void* args[] = {&p};
    hipError_t e = hipLaunchCooperativeKernel((const void*)hymba_fwd, dim3(grid), dim3(512), args, LDS_BYTES, stream);
    if (e != hipSuccess) fprintf(stderr, "kernel_launch: cooperative launch failed: %s\n", hipGetErrorString(e));
#else
    for (int ph = 0; ph < N_PHASES; ++ph) { p.ph_lo = ph; p.ph_hi = ph + 1; hipLaunchKernelGGL(hymba_fwd, dim3(grid), dim3(512), LDS_BYTES, stream, p); }
#endif
}
```
